# Optimizing an MI355X kernel written in HIP

```python
import jax, jax.numpy as jnp
from jax import lax
import numpy as np

D_MODEL = 1024
BATCH = 8
SEQ = 2048
DEPTH = 4
DEC_BATCH = 128
DEC_SEQ = 1
PAST_LEN = 16384
PAGE_SIZE = 128

W_A = D_MODEL
W_B = D_MODEL
W_C = 2 * D_MODEL
POOL_WINDOWS = (2, 4, 8, 16)
POOL_GROUPS = 4
POOL_GW = W_A // POOL_GROUPS
POOL_CTX = 15
SGU_GROUPS = 4
SGU_GW = W_B // SGU_GROUPS
CHUNK = 128
CONV_WIDTH = 3
CONV_CTX = CONV_WIDTH - 1
N_MEM = 256
XA_HEADS = 4
XA_HD = D_MODEL // XA_HEADS
EPS = 1e-6

kernel_name = "hybrid_pool_sgu_conv_memxattn_step"


def rms_norm(x, g):
    xf = x.astype(jnp.float32)
    y = xf * lax.rsqrt(jnp.mean(xf * xf, axis=-1, keepdims=True) + EPS)
    return (y * g.astype(jnp.float32)).astype(x.dtype)


def causal_multi_pool(ext, n_new, pos0):
    n_ctx = ext.shape[1] - n_new
    cs = jnp.cumsum(ext.astype(jnp.float32), axis=1)
    cs = jnp.pad(cs, ((0, 0), (1, 0), (0, 0)))
    pos = pos0 + jnp.arange(n_new)
    outs = []
    for g, w in enumerate(POOL_WINDOWS):
        sl = slice(g * POOL_GW, (g + 1) * POOL_GW)
        hi = cs[:, n_ctx + 1:n_ctx + 1 + n_new, sl]
        lo = cs[:, n_ctx + 1 - w:n_ctx + 1 - w + n_new, sl]
        cnt = jnp.minimum(pos + 1, w).astype(jnp.float32)[None, :, None]
        outs.append((hi - lo) / cnt)
    mean = jnp.concatenate(outs, axis=-1)
    return (mean - ext[:, n_ctx:].astype(jnp.float32)).astype(ext.dtype)


def chunk_spatial_mix(v, w_s, b_s):
    b, L, _ = v.shape
    n_chunks = -(-L // CHUNK)
    lp = n_chunks * CHUNK
    vp = jnp.pad(v, ((0, 0), (0, lp - L), (0, 0))).reshape(b, n_chunks, CHUNK, SGU_GROUPS, SGU_GW)
    mask = jnp.tril(jnp.ones((CHUNK, CHUNK), dtype=bool))
    w = jnp.where(mask[None], w_s, jnp.zeros_like(w_s))
    mixed = jnp.einsum('gts,bnsgc->bntgc', w, vp) + b_s.T[None, None, :, :, None]
    return mixed.reshape(b, lp, W_B)[:, :L]


def pool_sgu_mixer(h, pool_buf, pos0, w_in, pool_maps, pool_scale, sgu_w, sgu_b, sgu_g, w_out):
    b, L, _ = h.shape
    z = h @ w_in
    xa = z[..., :W_A]
    ga = z[..., W_A:2 * W_A]
    u = z[..., 2 * W_A:2 * W_A + W_B]
    v = z[..., 2 * W_A + W_B:2 * W_A + 2 * W_B]
    gb = z[..., 2 * W_A + 2 * W_B:]
    ext = jnp.concatenate([pool_buf, xa], axis=1)
    pooled = causal_multi_pool(ext, L, pos0).reshape(b, L, POOL_GROUPS, POOL_GW)
    ya = jnp.einsum('blgc,gcd->blgd', pooled, pool_maps).reshape(b, L, W_A) * pool_scale
    ya = ya * jax.nn.silu(ga)
    vn = rms_norm(v, sgu_g)
    yb = u * chunk_spatial_mix(vn, sgu_w, sgu_b) * jax.nn.silu(gb)
    out = jnp.concatenate([ya, yb], axis=-1) @ w_out
    return out, ext[:, -POOL_CTX:], vn


def short_conv_mixer(h, conv_buf, w_in, conv_w, w_out):
    L = h.shape[1]
    z = h @ w_in
    bg = z[..., :W_C]
    cg = z[..., W_C:2 * W_C]
    xc = z[..., 2 * W_C:3 * W_C]
    g = z[..., 3 * W_C:]
    ext = jnp.concatenate([conv_buf, cg * xc], axis=1)
    y = conv_w[0] * ext[:, 0:L] + conv_w[1] * ext[:, 1:L + 1] + conv_w[2] * ext[:, 2:L + 2]
    out = (bg * y * jax.nn.silu(g)) @ w_out
    return out, ext[:, -CONV_CTX:]


def memory_kv(mem, g, w_k, w_v):
    b, m, _ = mem.shape
    mn = rms_norm(mem, g)
    k = (mn @ w_k).reshape(b, m, XA_HEADS, XA_HD)
    v = (mn @ w_v).reshape(b, m, XA_HEADS, XA_HD)
    return k, v


def cross_attend(h, k, v, w_q, w_o):
    b, L, _ = h.shape
    q = (h @ w_q).reshape(b, L, XA_HEADS, XA_HD)
    s = jnp.einsum('blhd,bmhd->bhlm', q, k).astype(jnp.float32) * (XA_HD ** -0.5)
    p = jax.nn.softmax(s, axis=-1).astype(v.dtype)
    o = jnp.einsum('bhlm,bmhd->blhd', p, v).reshape(b, L, D_MODEL)
    return o @ w_o


def setup_inputs(seed: int = 0) -> dict:
    key = jax.random.key(seed)
    ks = jax.random.split(key, 26)
    n_even = (DEPTH + 1) // 2
    n_odd = DEPTH // 2

    def nrm(k, shape, scale=1.0):
        return jax.random.normal(k, shape, jnp.float32) * scale

    return {
        "x_prompt": nrm(ks[0], (BATCH, SEQ, D_MODEL)),
        "x_sample": nrm(ks[1], (DEC_BATCH, DEC_SEQ, D_MODEL)),
        "mem_prompt": nrm(ks[2], (BATCH, N_MEM, D_MODEL)),
        "state_pool": nrm(ks[3], (n_even, DEC_BATCH, POOL_CTX, W_A)),
        "state_conv": nrm(ks[4], (n_odd, DEC_BATCH, CONV_CTX, W_C)),
        "cache_mem_k": nrm(ks[5], (DEPTH, DEC_BATCH, N_MEM, XA_HEADS, XA_HD)),
        "cache_mem_v": nrm(ks[6], (DEPTH, DEC_BATCH, N_MEM, XA_HEADS, XA_HD)),
        "norm_mix_g": 1.0 + nrm(ks[7], (DEPTH, D_MODEL), 0.05),
        "norm_xattn_g": 1.0 + nrm(ks[8], (DEPTH, D_MODEL), 0.05),
        "norm_mem_g": 1.0 + nrm(ks[9], (DEPTH, D_MODEL), 0.05),
        "w_in_ab": nrm(ks[10], (n_even, D_MODEL, 2 * W_A + 3 * W_B), D_MODEL ** -0.5),
        "pool_maps": nrm(ks[11], (n_even, POOL_GROUPS, POOL_GW, POOL_GW), POOL_GW ** -0.5),
        "pool_scale": 0.5 + nrm(ks[12], (n_even, W_A), 0.05),
        "sgu_w": nrm(ks[13], (n_even, SGU_GROUPS, CHUNK, CHUNK), CHUNK ** -0.5),
        "sgu_b": 1.0 + nrm(ks[14], (n_even, SGU_GROUPS, CHUNK), 0.1),
        "sgu_g": 1.0 + nrm(ks[15], (n_even, W_B), 0.05),
        "w_out_ab": nrm(ks[16], (n_even, W_A + W_B, D_MODEL), (W_A + W_B) ** -0.5),
        "w_in_c": nrm(ks[17], (n_odd, D_MODEL, 4 * W_C), D_MODEL ** -0.5),
        "conv_w": nrm(ks[18], (n_odd, CONV_WIDTH, W_C), CONV_WIDTH ** -0.5),
        "w_out_c": nrm(ks[19], (n_odd, W_C, D_MODEL), W_C ** -0.5),
        "w_q": nrm(ks[20], (DEPTH, D_MODEL, D_MODEL), D_MODEL ** -0.5),
        "w_k": nrm(ks[21], (DEPTH, D_MODEL, D_MODEL), D_MODEL ** -0.5),
        "w_v": nrm(ks[22], (DEPTH, D_MODEL, D_MODEL), D_MODEL ** -0.5),
        "w_o": nrm(ks[23], (DEPTH, D_MODEL, D_MODEL), D_MODEL ** -0.5),
        "norm_final_g": 1.0 + nrm(ks[24], (D_MODEL,), 0.05),
    }


def reference(x_prompt, x_sample, mem_prompt, state_pool, state_conv, cache_mem_k, cache_mem_v,
              norm_mix_g, norm_xattn_g, norm_mem_g, w_in_ab, pool_maps, pool_scale, sgu_w, sgu_b,
              sgu_g, w_out_ab, w_in_c, conv_w, w_out_c, w_q, w_k, w_v, w_o, norm_final_g):
    bp = x_prompt.shape[0]
    xp, xs = x_prompt, x_sample
    pool_p, pool_s, conv_p, conv_s, vrows_s, mem_k_p, mem_v_p = [], [], [], [], [], [], []
    for i in range(DEPTH):
        j = i // 2
        hp = rms_norm(xp, norm_mix_g[i])
        hs = rms_norm(xs, norm_mix_g[i])
        if i % 2 == 0:
            prm = (w_in_ab[j], pool_maps[j], pool_scale[j], sgu_w[j], sgu_b[j], sgu_g[j], w_out_ab[j])
            zero_buf = jnp.zeros((bp, POOL_CTX, W_A), xp.dtype)
            op, buf_p, _ = pool_sgu_mixer(hp, zero_buf, 0, *prm)
            os_, buf_s, v_s = pool_sgu_mixer(hs, state_pool[j], PAST_LEN, *prm)
            pool_p.append(buf_p)
            pool_s.append(buf_s)
            vrows_s.append(v_s)
        else:
            zero_buf = jnp.zeros((bp, CONV_CTX, W_C), xp.dtype)
            op, buf_p = short_conv_mixer(hp, zero_buf, w_in_c[j], conv_w[j], w_out_c[j])
            os_, buf_s = short_conv_mixer(hs, state_conv[j], w_in_c[j], conv_w[j], w_out_c[j])
            conv_p.append(buf_p)
            conv_s.append(buf_s)
        xp = xp + op
        xs = xs + os_
        kp, vp = memory_kv(mem_prompt, norm_mem_g[i], w_k[i], w_v[i])
        mem_k_p.append(kp)
        mem_v_p.append(vp)
        xp = xp + cross_attend(rms_norm(xp, norm_xattn_g[i]), kp, vp, w_q[i], w_o[i])
        xs = xs + cross_attend(rms_norm(xs, norm_xattn_g[i]), cache_mem_k[i], cache_mem_v[i], w_q[i], w_o[i])
    y_prompt = rms_norm(xp, norm_final_g)
    y_sample = rms_norm(xs, norm_final_g)
    return (y_prompt, y_sample, jnp.stack(pool_p), jnp.stack(pool_s), jnp.stack(conv_p), jnp.stack(conv_s),
            jnp.stack(vrows_s), jnp.stack(mem_k_p), jnp.stack(mem_v_p))
```

```cpp
#include <hip/hip_runtime.h>
#include <cstdio>
#include <cstdint>
namespace pg8 {
#define PG8_LAS __attribute__((address_space(3)))
typedef unsigned short bf16_t;
typedef short bf16x8 __attribute__((ext_vector_type(8)));
typedef float f32x4 __attribute__((ext_vector_type(4)));
typedef unsigned u32x4 __attribute__((ext_vector_type(4)));
constexpr int BM = 256, BK = 64, HALF = 128, HTB = HALF * BK * 2  , STAGE_BYTES = 8 * HTB, NXCD = 8, WGM = 8;

__host__ __device__ __forceinline__ int lds_byte(int r, int c) { const int st = (r >> 4) * 2 + (c >> 5), rr = r & 15, cc = c & 31, ob = rr * 64 + cc * 2; return st * 1024 + (ob ^ (((ob >> 9) & 1) << 5)); }
__host__ __device__ __forceinline__ void stage_rc(int b, int& R, int& C) { const int st = b / 1024, sb = b % 1024, swz = sb ^ (((sb >> 9) & 1) << 5); R = (st >> 1) * 16 + swz / 64; C = (st & 1) * 32 + (swz % 64) / 2; }
__host__ __device__ __forceinline__ int perm32(int rho) { const int n = rho >> 4, i = rho & 15; return 8 * (i >> 2) + 4 * n + (i & 3); }

struct Unit { int pm, pn; };
struct Gemm { const bf16_t* A; const bf16_t* Bt; int M, N, K; };

struct StaticOrder {
    int nM, nN, nwg, G, c;
    __host__ __device__ void init(int M, int N, int G_, int c_) { nM = M / BM; nN = N / BM; nwg = nM * nN; G = G_; c = c_; }
    __host__ __device__ bool next(int i, Unit& u) const {
        const long L = (long)i * G + c; if (L >= nwg) return false;
        int wgid = (int)L; { const int q = nwg / NXCD, r = nwg % NXCD, xcd = wgid % NXCD, off = wgid / NXCD; wgid = (xcd < r ? xcd * (q + 1) : r * (q + 1) + (xcd - r) * q) + off; }
        const int nig = WGM * nN, gid = wgid / nig, fm = gid * WGM, gsz = (nM - fm) < WGM ? (nM - fm) : WGM;
        u.pm = fm + ((wgid % nig) % gsz); u.pn = (wgid % nig) / gsz; return true;
    }
    __device__ __forceinline__ void a_ready(const Unit&) const {}
    __device__ __forceinline__ void done(const Unit&) const {}
};

__device__ __forceinline__ unsigned cvt_pk_bf16(float lo, float hi) { unsigned r; asm volatile("v_cvt_pk_bf16_f32 %0, %1, %2" : "=v"(r) : "v"(lo), "v"(hi)); return r; }
template <class Epi, class Sched, bool ALIGN_EPI = false, bool SP2 = false>
__device__ __forceinline__ void gemm_phase(PG8_LAS unsigned char* lds, const Gemm g, const Sched& S, const Epi& E) {
    int tid_ = threadIdx.x; asm volatile("" : "+v"(tid_));
    const int tid = tid_, wid = __builtin_amdgcn_readfirstlane(tid >> 6), lane = tid & 63, wr = wid >> 2, wc = wid & 3, fr = lane & 15, fq = lane >> 4;
    const int K = g.K, nt = K / BK;
    unsigned voffA[2], voffB[2];
#pragma unroll
    for (int i = 0; i < 2; ++i) { int R, C; stage_rc(tid * 16 + i * 8192, R, C); const int Rb = Epi::PERM ? ((R & ~31) + perm32(R & 31)) : R;
        voffA[i] = (unsigned)(R * K + C) * 2u; voffB[i] = (unsigned)(Rb * K + C) * 2u; }
    const size_t kstep = (size_t)(BK * 2);
    const size_t hstep = (size_t)HALF * K * 2;
    const size_t tstep = 2 * hstep;
    const unsigned ldsw = (unsigned)wid * 1024u;
    const int aoff = lds_byte(wr * 64 + fr, fq * 8), boff = lds_byte(wc * 32 + fr, fq * 8);
#define PG8_SA(b, h) (((b) * 2 + (h)) * HTB)
#define PG8_SB(b, h) ((4 + (b) * 2 + (h)) * HTB)
#define PG8_STAGE(bufoff, gbase, voff) do { _Pragma("unroll") for (int _i = 0; _i < 2; ++_i) \
        __builtin_amdgcn_global_load_lds((const unsigned*)((const char*)(gbase) + (voff)[_i]), (PG8_LAS unsigned*)(lds + (bufoff) + ldsw + _i * 8192), 16, 0, 0); } while (0)
#define PG8_LDA(dst, b, h) do { _Pragma("unroll") for (int m = 0; m < 4; ++m) _Pragma("unroll") for (int k = 0; k < 2; ++k) dst[m][k] = *(const PG8_LAS bf16x8*)(lds + PG8_SA(b, h) + aoff + m * 2048 + k * 1024); } while (0)
#define PG8_LDB(dst, b, h) do { _Pragma("unroll") for (int n = 0; n < 2; ++n) _Pragma("unroll") for (int k = 0; k < 2; ++k) dst[n][k] = *(const PG8_LAS bf16x8*)(lds + PG8_SB(b, h) + boff + n * 2048 + k * 1024); } while (0)
#define PG8_MMA(ai, bj, At, Bt) do { __builtin_amdgcn_s_setprio(1); _Pragma("unroll") for (int m = 0; m < 4; ++m) _Pragma("unroll") for (int n = 0; n < 2; ++n) _Pragma("unroll") for (int k = 0; k < 2; ++k) \
        acc[ai][bj][m][n] = __builtin_amdgcn_mfma_f32_16x16x32_bf16(Bt[n][k], At[m][k], acc[ai][bj][m][n], 0, 0, 0); __builtin_amdgcn_s_setprio(0); } while (0)
#define PG8_WAIT_V(n) asm volatile("s_waitcnt vmcnt(" #n ")" ::: "memory")
#define PG8_WAIT_L(n) asm volatile("s_waitcnt lgkmcnt(" #n ")" ::: "memory")
#define PG8_BAR __builtin_amdgcn_s_barrier()
#define PG8_SCHED __builtin_amdgcn_sched_barrier(0)
    Unit cur, nxt; int ui = 0;
    if (!S.next(0, cur)) return;
    f32x4 acc[2][2][4][2];
#pragma unroll
    for (int a = 0; a < 2; ++a)
#pragma unroll
        for (int b = 0; b < 2; ++b)
#pragma unroll
            for (int m = 0; m < 4; ++m)
#pragma unroll
                for (int n = 0; n < 2; ++n) acc[a][b][m][n] = (f32x4){0.f, 0.f, 0.f, 0.f};
    bf16x8 At[4][2], B0[2][2], B1[2][2];
    const char* cA = (const char*)g.A + (size_t)cur.pm * tstep; const char* cB = (const char*)g.Bt + (size_t)cur.pn * tstep;
    S.a_ready(cur);
    if constexpr (SP2) {
        PG8_STAGE(PG8_SB(0, 0), cB, voffB); PG8_STAGE(PG8_SB(0, 1), cB + hstep, voffB); PG8_STAGE(PG8_SA(0, 0), cA, voffA); PG8_STAGE(PG8_SA(0, 1), cA + hstep, voffA);
        if (wr == 1) PG8_BAR;
        PG8_WAIT_V(2); PG8_BAR;
        PG8_STAGE(PG8_SB(1, 0), cB + kstep, voffB); PG8_STAGE(PG8_SA(1, 0), cA + kstep, voffA); PG8_STAGE(PG8_SB(1, 1), cB + hstep + kstep, voffB);
        PG8_WAIT_V(6); PG8_BAR;
    } else {
        PG8_STAGE(PG8_SB(0, 0), cB, voffB); PG8_STAGE(PG8_SA(0, 0), cA, voffA); PG8_STAGE(PG8_SB(0, 1), cB + hstep, voffB); PG8_STAGE(PG8_SA(0, 1), cA + hstep, voffA);
        if (wr == 1) PG8_BAR;
        PG8_WAIT_V(4); PG8_BAR;
        PG8_STAGE(PG8_SB(1, 0), cB + kstep, voffB); PG8_STAGE(PG8_SA(1, 0), cA + kstep, voffA); PG8_STAGE(PG8_SB(1, 1), cB + hstep + kstep, voffB);
        PG8_WAIT_V(6); PG8_BAR;
    }
    for (;;) {
        const bool has_next = S.next(ui + 1, nxt);
        const char* nA = has_next ? (const char*)g.A + (size_t)nxt.pm * tstep : cA; const char* nB = has_next ? (const char*)g.Bt + (size_t)nxt.pn * tstep : cB;
        for (int t = 0; t < nt; t += 2) {
            const bool last = (t == nt - 2);
            const char* a1 = cA + (size_t)(t + 1) * kstep;
            const char* a2 = last ? nA : cA + (size_t)(t + 2) * kstep; const char* b2 = last ? nB : cB + (size_t)(t + 2) * kstep;
            const char* a3 = a2 + kstep; const char* b3 = b2 + kstep;
            if (last && has_next) S.a_ready(nxt);
            if constexpr (SP2) {
            PG8_LDB(B0, 0, 0); PG8_LDB(B1, 0, 1); PG8_SCHED; PG8_LDA(At, 0, 0); PG8_STAGE(PG8_SA(1, 1), a1 + hstep, voffA);
            PG8_WAIT_V(8); PG8_WAIT_L(0); PG8_BAR; PG8_MMA(0, 0, At, B0); PG8_MMA(0, 1, At, B1); PG8_BAR; PG8_SCHED;
            PG8_LDA(At, 0, 1); PG8_STAGE(PG8_SB(0, 0), b2, voffB); PG8_STAGE(PG8_SB(0, 1), b2 + hstep, voffB); PG8_STAGE(PG8_SA(0, 0), a2, voffA);
            PG8_WAIT_V(8); PG8_WAIT_L(0); PG8_BAR; PG8_MMA(1, 0, At, B0); PG8_MMA(1, 1, At, B1); PG8_BAR; PG8_SCHED;
            PG8_LDB(B0, 1, 0); PG8_LDB(B1, 1, 1); PG8_SCHED; PG8_LDA(At, 1, 0); PG8_STAGE(PG8_SA(0, 1), a2 + hstep, voffA);
            PG8_WAIT_V(8); PG8_WAIT_L(0); PG8_BAR; PG8_MMA(0, 0, At, B0); PG8_MMA(0, 1, At, B1); PG8_BAR; PG8_SCHED;
            PG8_LDA(At, 1, 1); PG8_STAGE(PG8_SB(1, 0), b3, voffB); PG8_STAGE(PG8_SB(1, 1), b3 + hstep, voffB); PG8_STAGE(PG8_SA(1, 0), a3, voffA);
            PG8_WAIT_V(8); PG8_WAIT_L(0); PG8_BAR; PG8_MMA(1, 0, At, B0); PG8_MMA(1, 1, At, B1); PG8_BAR; PG8_SCHED;
            } else {
            PG8_LDB(B0, 0, 0); PG8_SCHED; PG8_LDA(At, 0, 0); PG8_STAGE(PG8_SA(1, 1), a1 + hstep, voffA);
            PG8_WAIT_L(8); PG8_BAR; PG8_WAIT_L(0); PG8_MMA(0, 0, At, B0); PG8_BAR; PG8_SCHED;
            PG8_LDB(B1, 0, 1); PG8_STAGE(PG8_SB(0, 0), b2, voffB);
            PG8_BAR; PG8_WAIT_L(0); PG8_MMA(0, 1, At, B1); PG8_BAR;
            PG8_LDA(At, 0, 1); PG8_STAGE(PG8_SA(0, 0), a2, voffA);
            PG8_BAR; PG8_WAIT_L(0); PG8_MMA(1, 0, At, B0); PG8_BAR; PG8_SCHED;
            PG8_STAGE(PG8_SB(0, 1), b2 + hstep, voffB);
            PG8_WAIT_V(6); PG8_BAR; PG8_MMA(1, 1, At, B1); PG8_BAR;
            PG8_LDB(B0, 1, 0); PG8_SCHED; PG8_LDA(At, 1, 0); PG8_STAGE(PG8_SA(0, 1), a2 + hstep, voffA);
            PG8_WAIT_L(8); PG8_BAR; PG8_WAIT_L(0); PG8_MMA(0, 0, At, B0); PG8_BAR; PG8_SCHED;
            PG8_LDB(B1, 1, 1); PG8_STAGE(PG8_SB(1, 0), b3, voffB);
            PG8_BAR; PG8_WAIT_L(0); PG8_MMA(0, 1, At, B1); PG8_BAR;
            PG8_LDA(At, 1, 1); PG8_STAGE(PG8_SA(1, 0), a3, voffA);
            PG8_BAR; PG8_WAIT_L(0); PG8_MMA(1, 0, At, B0); PG8_BAR; PG8_SCHED;
            PG8_STAGE(PG8_SB(1, 1), b3 + hstep, voffB);
            PG8_WAIT_V(6); PG8_BAR; PG8_MMA(1, 1, At, B1); PG8_BAR;
            }
        }
        if constexpr (ALIGN_EPI) { if (wr == 0) PG8_BAR; }
        if constexpr (!Epi::AFTER_DRAIN) { E(acc, cur, wr, wc, fr, fq); S.done(cur); }
        if (!has_next) break;
#pragma unroll
        for (int a = 0; a < 2; ++a)
#pragma unroll
            for (int b = 0; b < 2; ++b)
#pragma unroll
                for (int m = 0; m < 4; ++m)
#pragma unroll
                    for (int n = 0; n < 2; ++n) acc[a][b][m][n] = (f32x4){0.f, 0.f, 0.f, 0.f};
        cur = nxt; cA = nA; cB = nB; ++ui;
        if constexpr (ALIGN_EPI) { if (wr == 1) PG8_BAR; }
    }
    PG8_WAIT_V(0);
    if constexpr (!ALIGN_EPI) { if (wr == 0) PG8_BAR; }
    PG8_BAR;
    if constexpr (Epi::AFTER_DRAIN) { E.fused(acc, cur, wr, wc, fr, fq, lds, wid, lane); S.done(cur); }
#undef PG8_SA
#undef PG8_SB
#undef PG8_STAGE
#undef PG8_LDA
#undef PG8_LDB
#undef PG8_MMA
#undef PG8_WAIT_V
#undef PG8_WAIT_L
#undef PG8_BAR
#undef PG8_SCHED
}
}

using pg8::bf16_t; using pg8::bf16x8; using pg8::f32x4; using pg8::u32x4; using pg8::Unit; using pg8::cvt_pk_bf16;
#define GAS __attribute__((address_space(1)))
#define LAS __attribute__((address_space(3)))
typedef unsigned u32x2 __attribute__((ext_vector_type(2)));
typedef short s16x4 __attribute__((ext_vector_type(4)));
typedef GAS unsigned gu32;
#define RLX_AGENT __ATOMIC_RELAXED, __HIP_MEMORY_SCOPE_AGENT

constexpr int NWAVES = 8;
constexpr int D = 1024, MP = 16384, MS = 128, SEQ = 2048, NBATCH = 8, NMEM = 256, MMEM = 2048, DEPTH = 4;
constexpr int NAB = 5120, NC = 8192;
constexpr float EPS = 1e-6f;
constexpr float QSCALE = 0.0625f * 1.4426950408889634f;

constexpr size_t O_Y = 0, O_YS = O_Y + (size_t)MP * D, O_POOLP = O_YS + (size_t)MS * D, O_POOLS = O_POOLP + 2 * 8 * 15 * 1024,
                 O_CONVP = O_POOLS + (size_t)2 * 128 * 15 * 1024, O_CONVS = O_CONVP + 2 * 8 * 2 * 2048, O_SGUV = O_CONVS + (size_t)2 * 128 * 2 * 2048,
                 O_MEMK = O_SGUV + 2 * 128 * 1024, O_MEMV = O_MEMK + (size_t)4 * MMEM * D, O_END = O_MEMV + (size_t)4 * MMEM * D;
static_assert(O_END == 39239680, "output size");

constexpr size_t MiB = 1u << 20;
constexpr size_t WS_CTL = 0, CTL_ZERO_BYTES = 1 * MiB;
constexpr size_t WS_AB1 = 2 * MiB, WS_C1 = 22 * MiB, WS_AB2 = 54 * MiB, WS_C2 = 62 * MiB, WS_WQ = 70 * MiB, WS_WKV = 78 * MiB, WS_WO = 94 * MiB, WS_PMT = 102 * MiB;
constexpr size_t WS_XB = 104 * MiB;
constexpr size_t WS_RSQ = 137 * MiB, WS_VSQ = 138 * MiB;
constexpr size_t WS_SMALL = 139 * MiB;
constexpr size_t WS_Z = 140 * MiB;
constexpr size_t WS_A2 = 268 * MiB;
constexpr size_t WS_Q = 332 * MiB, WS_O = 364 * MiB;
constexpr size_t WS_MEMB = 396 * MiB, WS_KB = 400 * MiB, WS_VB = 416 * MiB;
constexpr size_t WS_XS = 432 * MiB, WS_SZ = 433 * MiB, WS_SA2 = 437 * MiB, WS_SQ = 438 * MiB, WS_SO = 439 * MiB, WS_END = 440 * MiB;
constexpr int CW_BAR = 4096;

constexpr int RING_BYTES = 131072, LDSCTL_OFF = RING_BYTES, MISC_OFF = LDSCTL_OFF + 320, LDS_BYTES = 147456;

#define LDS_WAIT() asm volatile("s_waitcnt lgkmcnt(0)" ::: "memory")

#define XB_TMO      128
#define XB_XCNT(j)  (256  + 64 * (j))
#define XB_XSUB(j)  (1280 + 64 * (j))
#define XB_XGEN(j)  (2304 + 64 * (j))
#define XB_TOP      3328
#define XB_TOPGEN   3392
#define XCD_BAR_WORDS 3456
#define XB_SPIN_CAP (1u << 18)

__device__ __forceinline__ unsigned xb_ld(unsigned* p)              { return __hip_atomic_load(p, __ATOMIC_RELAXED, __HIP_MEMORY_SCOPE_AGENT); }
__device__ __forceinline__ unsigned xb_add(unsigned* p, unsigned v) { return __hip_atomic_fetch_add(p, v, __ATOMIC_RELAXED, __HIP_MEMORY_SCOPE_AGENT); }
__device__ __forceinline__ unsigned xb_xcc_id() { return (unsigned)__builtin_amdgcn_s_getreg((3 << 11) | 20) & 0xFu; }
#define XB_SPIN(cond, bar) do { unsigned _sp = 0; while (cond) { __builtin_amdgcn_s_sleep(1); \
    if ((++_sp & 255u) == 0u) { if (xb_ld(&(bar)[XB_TMO])) break; if (_sp > XB_SPIN_CAP) { atomicAdd(&(bar)[XB_TMO], 1u); break; } } } } while (0)

struct XcdBarrier {
    unsigned* bar; unsigned x;
    volatile LAS unsigned* st;
};

__device__ __forceinline__ XcdBarrier xcd_barrier_post(unsigned* bar, volatile LAS unsigned* st) {
    XcdBarrier b; b.bar = bar; b.x = xb_xcc_id(); b.st = st;
    if (threadIdx.x == 0) (void)xb_add(&bar[XB_XCNT(b.x)], 1u);
    return b;
}
__device__ __forceinline__ void xcd_barrier_complete(unsigned* bar, unsigned x, unsigned& nloc, unsigned& nx) {
    const unsigned G = gridDim.x * gridDim.y * gridDim.z;
    unsigned sum, cnt, mine, sp = 0u;
    for (;;) {
        sum = 0u; cnt = 0u; mine = 0u;
#pragma unroll
        for (unsigned j = 0; j < 16; ++j) { const unsigned c = xb_ld(&bar[XB_XCNT(j)]); sum += c; cnt += (c > 0u) ? 1u : 0u; mine = (j == x) ? c : mine; }
        if (sum == G) break;
        __builtin_amdgcn_s_sleep(1);
        if ((++sp & 255u) == 0u) { if (xb_ld(&bar[XB_TMO])) break; if (sp > XB_SPIN_CAP) { atomicAdd(&bar[XB_TMO], 1u); break; } }
    }
    nloc = mine > 0u ? mine : 1u; nx = cnt > 0u ? cnt : 1u;
}

__device__ __forceinline__ void xcd_barrier(const XcdBarrier& b) {
    asm volatile("s_waitcnt vmcnt(0)" ::: "memory");
    __syncthreads();
    if (threadIdx.x == 0) {
        unsigned* bar = b.bar;
        __builtin_amdgcn_s_waitcnt(0);
        unsigned nloc = b.st[0], nx = b.st[1];
        if (nloc == 0u) { xcd_barrier_complete(bar, b.x, nloc, nx); b.st[0] = nloc; b.st[1] = nx; }
        const unsigned old = xb_add(&bar[XB_XSUB(b.x)], 1u);
        const unsigned gen = old / nloc;
        if (old + 1u == (gen + 1u) * nloc) {
            __builtin_amdgcn_fence(__ATOMIC_RELEASE, "agent");
            asm volatile("s_waitcnt vmcnt(0)" ::: "memory");
            const unsigned og = xb_add(&bar[XB_TOP], 1u);
            const unsigned tg = og / nx;
            if (og + 1u == (tg + 1u) * nx) xb_add(&bar[XB_TOPGEN], 1u);
            else XB_SPIN(xb_ld(&bar[XB_TOPGEN]) == tg, bar);
            __builtin_amdgcn_fence(__ATOMIC_ACQUIRE, "agent");
            xb_add(&bar[XB_XGEN(b.x)], 1u);
            asm volatile("s_waitcnt vmcnt(0)" ::: "memory");
        } else {
            XB_SPIN(xb_ld(&bar[XB_XGEN(b.x)]) == gen, bar);
            __builtin_amdgcn_fence(__ATOMIC_ACQUIRE, "agent");
            asm volatile("s_waitcnt vmcnt(0)" ::: "memory");
        }
    }
    __syncthreads();
}

typedef const float* fptr_t;
typedef __attribute__((address_space(4))) const fptr_t* in_tab_t;
struct Frame {
    LAS unsigned char* lds;
    int tid, lane, wave, G, bx;
    in_tab_t in;
    float* out;
    unsigned char* ws;
};
__device__ __forceinline__ unsigned long long uni64(unsigned long long v) { const unsigned lo = __builtin_amdgcn_readfirstlane((unsigned)v), hi = __builtin_amdgcn_readfirstlane((unsigned)(v >> 32)); return ((unsigned long long)hi << 32) | lo; }
__device__ __forceinline__ Frame launder(const Frame& F0) {
    Frame F = F0;
    int g_ = __builtin_amdgcn_readfirstlane(F0.G), b_ = __builtin_amdgcn_readfirstlane(F0.bx);
    unsigned long long w_ = uni64((unsigned long long)F0.ws), o_ = uni64((unsigned long long)F0.out), i_ = uni64((unsigned long long)F0.in);
    asm volatile("" : "+v"(F.tid), "+s"(g_), "+s"(b_), "+s"(w_), "+s"(o_), "+s"(i_));
    F.G = g_; F.bx = b_; F.ws = (unsigned char*)(GAS unsigned char*)w_; F.out = (float*)(GAS float*)o_; F.in = (in_tab_t)i_;
    F.lane = F.tid & 63; F.wave = __builtin_amdgcn_readfirstlane(F.tid >> 6);
    return F;
}
#define FIN(k) ((const float*)(const GAS float*)(F.in[k]))


__device__ __forceinline__ float wave_sum(float v) {
#pragma unroll
    for (int o = 1; o < 64; o <<= 1) v += __shfl_xor(v, o);
    return v;
}
__device__ __forceinline__ float silu_f(float x) { return x * __builtin_amdgcn_rcpf(1.f + __builtin_amdgcn_exp2f(-1.4426950408889634f * x)); }
__device__ __forceinline__ f32x4 silu4(f32x4 v) { return (f32x4){silu_f(v[0]), silu_f(v[1]), silu_f(v[2]), silu_f(v[3])}; }
__device__ __forceinline__ float dot4(f32x4 a, f32x4 b) { return (a[0] * b[0] + a[1] * b[1]) + (a[2] * b[2] + a[3] * b[3]); }
__device__ __forceinline__ u32x4 pack8(f32x4 a, f32x4 b) { u32x4 w; w.x = cvt_pk_bf16(a[0], a[1]); w.y = cvt_pk_bf16(a[2], a[3]); w.z = cvt_pk_bf16(b[0], b[1]); w.w = cvt_pk_bf16(b[2], b[3]); return w; }
__device__ __forceinline__ u32x2 pack4(f32x4 a) { u32x2 w; w.x = cvt_pk_bf16(a[0], a[1]); w.y = cvt_pk_bf16(a[2], a[3]); return w; }
__device__ __forceinline__ float bflo(unsigned w) { return __uint_as_float(w << 16); }
__device__ __forceinline__ float bfhi(unsigned w) { return __uint_as_float(w & 0xffff0000u); }
__device__ __forceinline__ void unpack8(u32x4 w, f32x4& a, f32x4& b) { a = (f32x4){bflo(w.x), bfhi(w.x), bflo(w.y), bfhi(w.y)}; b = (f32x4){bflo(w.z), bfhi(w.z), bflo(w.w), bfhi(w.w)}; }
__device__ __forceinline__ f32x4 unpack4(u32x2 w) { return (f32x4){bflo(w.x), bfhi(w.x), bflo(w.y), bfhi(w.y)}; }
__device__ __forceinline__ float rstd16(const float* p) {
    const f32x4 a = ((const f32x4*)p)[0], b = ((const f32x4*)p)[1], c = ((const f32x4*)p)[2], d = ((const f32x4*)p)[3];
    const f32x4 s = (a + b) + (c + d);
    return rsqrtf(((s[0] + s[1]) + (s[2] + s[3])) * (1.0f / D) + EPS);
}
__device__ __forceinline__ float rstd32(const float* p) {
    f32x4 s = ((const f32x4*)p)[0];
#pragma unroll
    for (int i = 1; i < 8; ++i) s += ((const f32x4*)p)[i];
    return rsqrtf(((s[0] + s[1]) + (s[2] + s[3])) * (1.0f / D) + EPS);
}
__host__ __device__ __forceinline__ int src_even(int n) {
    const int tile = n >> 8, o = n & 255;
    if (tile < 8) return n;
    if (tile < 12) return 3072 + (n - 2048);
    const int cb = tile - 12;
    return o < 128 ? 2048 + 128 * cb + o : 4096 + 128 * cb + (o - 128);
}
__host__ __device__ __forceinline__ int src_odd(int n) {
    const int tile = n >> 8, o = n & 255;
    if (tile < 16) return o < 128 ? 2048 + 128 * tile + o : 4096 + 128 * tile + (o - 128);
    const int cb = tile - 16;
    return o < 128 ? 128 * cb + o : 6144 + 128 * cb + (o - 128);
}

struct EpiG1Even {
    static constexpr bool PERM = true, AFTER_DRAIN = false;
    const float* rsq; bf16_t* Z; float* vsq; float* pool_out;
    __device__ __forceinline__ void operator()(const f32x4 (&acc)[2][2][4][2], const Unit& u, int wr, int wc, int fr, int fq) const {
        const int tile = u.pn, cw = wc * 32 + 8 * fq;
#pragma unroll
        for (int ai = 0; ai < 2; ++ai)
#pragma unroll
            for (int m = 0; m < 4; ++m) {
                const int row = u.pm * 256 + ai * 128 + wr * 64 + m * 16 + fr;
                const float rs = rstd16(rsq + (size_t)row * 16);
                if (tile < 12) {
                    const int kind = tile >> 2;
                    bf16_t* dst = Z + (size_t)kind * MP * D + (size_t)row * D + (tile & 3) * 256 + cw;
                    float ss = 0.f;
#pragma unroll
                    for (int bj = 0; bj < 2; ++bj) {
                        f32x4 v0 = acc[ai][bj][m][0] * rs, v1 = acc[ai][bj][m][1] * rs;
                        if (kind == 1) { v0 = silu4(v0); v1 = silu4(v1); }
                        if (kind == 2) ss += dot4(v0, v0) + dot4(v1, v1);
                        *(u32x4*)(dst + bj * 128) = pack8(v0, v1);
                        if (kind == 0 && (row & 2047) >= 2033) {
                            float* po = pool_out + ((size_t)(row >> 11) * 15 + ((row & 2047) - 2033)) * 1024 + (tile & 3) * 256 + bj * 128 + cw;
                            *(f32x4*)po = v0; *(f32x4*)(po + 4) = v1;
                        }
                    }
                    if (kind == 2) { ss += __shfl_xor(ss, 16); ss += __shfl_xor(ss, 32); if (fq == 0) vsq[(size_t)row * 16 + (tile - 8) * 4 + wc] = ss; }
                } else {
                    const int cb = tile - 12;
                    bf16_t* dst = Z + (size_t)3 * MP * D + (size_t)row * D + cb * 128 + cw;
                    const f32x4 u0 = acc[ai][0][m][0] * rs, u1 = acc[ai][0][m][1] * rs, g0 = acc[ai][1][m][0] * rs, g1 = acc[ai][1][m][1] * rs;
                    *(u32x4*)dst = pack8(u0 * silu4(g0), u1 * silu4(g1));
                }
            }
    }
};
struct EpiG1Odd {
    static constexpr bool PERM = true, AFTER_DRAIN = false;
    const float* rsq; bf16_t* Z; float* conv_out;
    __device__ __forceinline__ void operator()(const f32x4 (&acc)[2][2][4][2], const Unit& u, int wr, int wc, int fr, int fq) const {
        const int tile = u.pn, cw = wc * 32 + 8 * fq;
#pragma unroll
        for (int ai = 0; ai < 2; ++ai)
#pragma unroll
            for (int m = 0; m < 4; ++m) {
                const int row = u.pm * 256 + ai * 128 + wr * 64 + m * 16 + fr;
                const float rs = rstd16(rsq + (size_t)row * 16);
                const f32x4 a0 = acc[ai][0][m][0] * rs, a1 = acc[ai][0][m][1] * rs, b0 = acc[ai][1][m][0] * rs, b1 = acc[ai][1][m][1] * rs;
                if (tile < 16) {
                    const f32x4 e0 = a0 * b0, e1 = a1 * b1;
                    *(u32x4*)(Z + (size_t)row * 2048 + tile * 128 + cw) = pack8(e0, e1);
                    if ((row & 2047) >= 2046) { float* po = conv_out + ((size_t)(row >> 11) * 2 + ((row & 2047) - 2046)) * 2048 + tile * 128 + cw; *(f32x4*)po = e0; *(f32x4*)(po + 4) = e1; }
                } else {
                    *(u32x4*)(Z + (size_t)MP * 2048 + (size_t)row * 2048 + (tile - 16) * 128 + cw) = pack8(a0 * silu4(b0), a1 * silu4(b1));
                }
            }
    }
};
struct EpiRes {
    static constexpr bool PERM = true, AFTER_DRAIN = false;
    const float* base; float* out; bf16_t* xb; float* rsq;
    __device__ __forceinline__ void operator()(const f32x4 (&acc)[2][2][4][2], const Unit& u, int wr, int wc, int fr, int fq) const {
        const int cw = wc * 32 + 8 * fq;
#pragma unroll
        for (int ai = 0; ai < 2; ++ai)
#pragma unroll
            for (int m = 0; m < 4; ++m) {
                const int row = u.pm * 256 + ai * 128 + wr * 64 + m * 16 + fr;
                float ss = 0.f;
#pragma unroll
                for (int bj = 0; bj < 2; ++bj) {
                    const size_t off = (size_t)row * D + u.pn * 256 + bj * 128 + cw;
                    const f32x4 o0 = *(const f32x4*)(base + off) + acc[ai][bj][m][0], o1 = *(const f32x4*)(base + off + 4) + acc[ai][bj][m][1];
                    *(f32x4*)(out + off) = o0; *(f32x4*)(out + off + 4) = o1;
                    *(u32x4*)(xb + off) = pack8(o0, o1);
                    ss += dot4(o0, o0) + dot4(o1, o1);
                }
                ss += __shfl_xor(ss, 16); ss += __shfl_xor(ss, 32);
                if (fq == 0) rsq[(size_t)row * 16 + u.pn * 4 + wc] = ss;
                asm volatile("" ::: "memory");
            }
    }
};
struct EpiQ {
    static constexpr bool PERM = true, AFTER_DRAIN = false;
    const float* rsq; bf16_t* Q;
    __device__ __forceinline__ void operator()(const f32x4 (&acc)[2][2][4][2], const Unit& u, int wr, int wc, int fr, int fq) const {
        const int cw = wc * 32 + 8 * fq;
#pragma unroll
        for (int ai = 0; ai < 2; ++ai)
#pragma unroll
            for (int m = 0; m < 4; ++m) {
                const int row = u.pm * 256 + ai * 128 + wr * 64 + m * 16 + fr;
                const float rs = rstd16(rsq + (size_t)row * 16);
#pragma unroll
                for (int bj = 0; bj < 2; ++bj) *(u32x4*)(Q + (size_t)row * D + u.pn * 256 + bj * 128 + cw) = pack8(acc[ai][bj][m][0] * rs, acc[ai][bj][m][1] * rs);
            }
    }
};
struct EpiMemKV {
    static constexpr bool PERM = true, AFTER_DRAIN = false;
    const float* rstdm; float* outk; float* outv; bf16_t* kb; bf16_t* vb;
    __device__ __forceinline__ void operator()(const f32x4 (&acc)[2][2][4][2], const Unit& u, int wr, int wc, int fr, int fq) const {
        const int layer = u.pn >> 3, isv = (u.pn >> 2) & 1, cw = (u.pn & 3) * 256 + wc * 32 + 8 * fq;
        float* of = (isv ? outv : outk) + (size_t)layer * MMEM * D; bf16_t* ob = (isv ? vb : kb) + (size_t)layer * MMEM * D;
#pragma unroll
        for (int ai = 0; ai < 2; ++ai)
#pragma unroll
            for (int m = 0; m < 4; ++m) {
                const int row = u.pm * 256 + ai * 128 + wr * 64 + m * 16 + fr;
                const float rs = rstdm[row];
#pragma unroll
                for (int bj = 0; bj < 2; ++bj) {
                    const size_t off = (size_t)row * D + bj * 128 + cw;
                    const f32x4 v0 = acc[ai][bj][m][0] * rs, v1 = acc[ai][bj][m][1] * rs;
                    *(f32x4*)(of + off) = v0; *(f32x4*)(of + off + 4) = v1;
                    *(u32x4*)(ob + off) = pack8(v0, v1);
                }
            }
    }
};

__device__ __forceinline__ void p0_tr_item(const float* W, int ldw, int k0, int srcn0, const float* gk, float sc, bf16_t* WT, int K, int dstn0, LAS float* scr, int lane) {
#pragma unroll 8
    for (int i = 0; i < 32; ++i) {
        const int kk = 2 * i + (lane >> 5);
        const float s = gk ? gk[k0 + kk] * sc : sc;
        scr[kk * 33 + (lane & 31)] = W[(size_t)(k0 + kk) * ldw + srcn0 + (lane & 31)] * s;
    }
    LDS_WAIT(); asm volatile("" ::: "memory");
    const int c = lane & 7;
#pragma unroll
    for (int jj = 0; jj < 4; ++jj) {
        const int n = (lane >> 3) + 8 * jj; const LAS float* s = scr + (8 * c) * 33 + n;
        u32x4 o; o.x = cvt_pk_bf16(s[0 * 33], s[1 * 33]); o.y = cvt_pk_bf16(s[2 * 33], s[3 * 33]); o.z = cvt_pk_bf16(s[4 * 33], s[5 * 33]); o.w = cvt_pk_bf16(s[6 * 33], s[7 * 33]);
        *(u32x4*)(WT + (size_t)(dstn0 + n) * K + k0 + 8 * c) = o;
    }
    LDS_WAIT(); asm volatile("" ::: "memory");
}
__device__ __forceinline__ void p0_tr_matrix(const float* W, int ldw, int K, int Nd, const float* gk, float sc, bf16_t* WT, int perm, int r, LAS float* scr, int lane) {
    const int nblk = Nd / 32, kb = r / nblk, nb = r % nblk, dstn0 = 32 * nb;
    const int srcn0 = perm == 0 ? dstn0 : (perm == 1 ? src_even(dstn0) : src_odd(dstn0));
    p0_tr_item(W, ldw, 64 * kb, srcn0, gk, sc, WT, K, dstn0, scr, lane);
}
__device__ __forceinline__ float p0_row(const float* src, bf16_t* dst, float* copy, int lane) {
    const f32x4* xr = (const f32x4*)src + lane;
    f32x4 v[4]; float s = 0.f;
#pragma unroll
    for (int jj = 0; jj < 4; ++jj) { v[jj] = xr[64 * jj]; s += dot4(v[jj], v[jj]); }
    s = wave_sum(s);
    u32x2* o8 = (u32x2*)dst + lane;
#pragma unroll
    for (int jj = 0; jj < 4; ++jj) o8[64 * jj] = pack4(v[jj]);
    if (copy) {
#pragma unroll
        for (int jj = 0; jj < 4; ++jj) ((f32x4*)copy + lane)[64 * jj] = v[jj];
    }
    return s;
}
__device__ __forceinline__ void p0_prologue(Frame& F0) {
    Frame F = launder(F0);
    LAS float* scr = (LAS float*)(F.lds + F.wave * 16384);
    const int gw = F.bx * NWAVES + F.wave, NGW = F.G * NWAVES, lane = F.lane;
    constexpr int I_AB1 = 16 * (NAB / 32), I_C1 = 16 * (NC / 32), I_2 = 32 * 32, I_SQ = 16 * 32, I_PM = 4 * 8;
    constexpr int NITEMS = 2 * I_AB1 + 2 * I_C1 + 4 * I_2 + 16 * I_SQ + 8 * I_PM;
    for (int it = gw; it < NITEMS; it += NGW) {
        int r = it;
        if (r < 2 * I_AB1) { const int jj = r / I_AB1; p0_tr_matrix(FIN(10) + (size_t)jj * D * NAB, NAB, D, NAB, FIN(7) + 2 * jj * D, 1.f, ((bf16_t*)(F.ws + WS_AB1)) + (size_t)jj * NAB * D, 1, r % I_AB1, scr, lane); continue; } r -= 2 * I_AB1;
        if (r < 2 * I_C1) { const int jj = r / I_C1; p0_tr_matrix(FIN(17) + (size_t)jj * D * NC, NC, D, NC, FIN(7) + (2 * jj + 1) * D, 1.f, ((bf16_t*)(F.ws + WS_C1)) + (size_t)jj * NC * D, 2, r % I_C1, scr, lane); continue; } r -= 2 * I_C1;
        if (r < 2 * I_2) { const int jj = r / I_2; p0_tr_matrix(FIN(16) + (size_t)jj * 2048 * D, D, 2048, D, nullptr, 1.f, ((bf16_t*)(F.ws + WS_AB2)) + (size_t)jj * D * 2048, 0, r % I_2, scr, lane); continue; } r -= 2 * I_2;
        if (r < 2 * I_2) { const int jj = r / I_2; p0_tr_matrix(FIN(19) + (size_t)jj * 2048 * D, D, 2048, D, nullptr, 1.f, ((bf16_t*)(F.ws + WS_C2)) + (size_t)jj * D * 2048, 0, r % I_2, scr, lane); continue; } r -= 2 * I_2;
        if (r < 4 * I_SQ) { const int l = r / I_SQ; p0_tr_matrix(FIN(20) + (size_t)l * D * D, D, D, D, FIN(8) + l * D, QSCALE, ((bf16_t*)(F.ws + WS_WQ)) + (size_t)l * D * D, 0, r % I_SQ, scr, lane); continue; } r -= 4 * I_SQ;
        if (r < 4 * I_SQ) { const int l = r / I_SQ; p0_tr_matrix(FIN(21) + (size_t)l * D * D, D, D, D, FIN(9) + l * D, 1.f, ((bf16_t*)(F.ws + WS_WKV)) + (size_t)(2 * l) * D * D, 0, r % I_SQ, scr, lane); continue; } r -= 4 * I_SQ;
        if (r < 4 * I_SQ) { const int l = r / I_SQ; p0_tr_matrix(FIN(22) + (size_t)l * D * D, D, D, D, FIN(9) + l * D, 1.f, ((bf16_t*)(F.ws + WS_WKV)) + (size_t)(2 * l + 1) * D * D, 0, r % I_SQ, scr, lane); continue; } r -= 4 * I_SQ;
        if (r < 4 * I_SQ) { const int l = r / I_SQ; p0_tr_matrix(FIN(23) + (size_t)l * D * D, D, D, D, nullptr, 1.f, ((bf16_t*)(F.ws + WS_WO)) + (size_t)l * D * D, 0, r % I_SQ, scr, lane); continue; } r -= 4 * I_SQ;
        { const int jg = r / I_PM; p0_tr_matrix(FIN(11) + (size_t)jg * 65536, 256, 256, 256, nullptr, 1.f, ((bf16_t*)(F.ws + WS_PMT)) + (size_t)jg * 65536, 0, r % I_PM, scr, lane); }
    }
    for (int m = gw; m < MP + MS + MMEM; m += NGW) {
        if (m < MP) {
            const float s = p0_row(FIN(0) + (size_t)m * D, ((bf16_t*)(F.ws + WS_XB)) + (size_t)m * D, nullptr, lane);
            if (lane < 16) ((float*)(F.ws + WS_RSQ))[(size_t)m * 16 + lane] = lane == 0 ? s : 0.f;
        } else if (m < MP + MS) {
            const int b = m - MP;
            const float s = p0_row(FIN(1) + (size_t)b * D, ((bf16_t*)(F.ws + WS_XB)) + (size_t)m * D, ((float*)(F.ws + WS_XS)) + (size_t)b * D, lane);
            if (lane < 32) ((float*)(F.ws + WS_SMALL))[b * 32 + lane] = lane == 0 ? s : 0.f;
        } else {
            const int t = m - MP - MS;
            const float s = p0_row(FIN(2) + (size_t)t * D, ((bf16_t*)(F.ws + WS_MEMB)) + (size_t)t * D, nullptr, lane);
            if (lane == 0) ((float*)(F.ws + WS_SMALL + 65536))[t] = rsqrtf(s * (1.0f / D) + EPS);
        }
    }
}

__device__ __forceinline__ bf16x8 tr_frag(LAS unsigned char* p0, LAS unsigned char* p1) {
    const s16x4 lo = __builtin_amdgcn_ds_read_tr16_b64_v4i16((LAS s16x4*)p0);
    const s16x4 hi = __builtin_amdgcn_ds_read_tr16_b64_v4i16((LAS s16x4*)p1);
    return (bf16x8){lo[0], lo[1], lo[2], lo[3], hi[0], hi[1], hi[2], hi[3]};
}
#define MFMA16(a, b, c) __builtin_amdgcn_mfma_f32_16x16x32_bf16((a), (b), (c), 0, 0, 0)

constexpr int SGU_AS = 0, SGU_VS = 34816, SGU_RV = 34816 + 67584;
__device__ __forceinline__ void sgu_unit(Frame& F0, int j, int n, int g) {
    Frame F = launder(F0);
    LAS unsigned char* lds = F.lds;
    const int tid = F.tid, lane = F.lane, w = F.wave, fr = lane & 15, fq = lane >> 4, row0 = n * 128;
    LAS float* rvs = (LAS float*)(lds + SGU_RV);
    if (tid < 128) rvs[tid] = rstd16(((float*)(F.ws + WS_VSQ)) + (size_t)(row0 + tid) * 16);
    const bf16_t* ZV = ((bf16_t*)(F.ws + WS_Z)) + (size_t)2 * MP * D;
#pragma unroll
    for (int i = 0; i < 8; ++i) {
        const int idx = tid + 512 * i, s = idx >> 5, c8 = idx & 31;
        *(LAS u32x4*)(lds + SGU_VS + s * 528 + c8 * 16) = *(const u32x4*)(ZV + (size_t)(row0 + s) * D + g * 256 + c8 * 8);
    }
    __syncthreads();
    const float* wg = FIN(13) + (size_t)(j * 4 + g) * 16384;
#pragma unroll
    for (int i = 0; i < 4; ++i) {
        const int idx = tid + 512 * i, t = idx >> 4, s0 = (idx & 15) * 8;
        const f32x4 a = *(const f32x4*)(wg + t * 128 + s0), b = *(const f32x4*)(wg + t * 128 + s0 + 4);
        float v[8];
#pragma unroll
        for (int e = 0; e < 4; ++e) { v[e] = (s0 + e <= t) ? a[e] * rvs[s0 + e] : 0.f; v[4 + e] = (s0 + 4 + e <= t) ? b[e] * rvs[s0 + 4 + e] : 0.f; }
        u32x4 o; o.x = cvt_pk_bf16(v[0], v[1]); o.y = cvt_pk_bf16(v[2], v[3]); o.z = cvt_pk_bf16(v[4], v[5]); o.w = cvt_pk_bf16(v[6], v[7]);
        *(LAS u32x4*)(lds + SGU_AS + t * 272 + s0 * 2) = o;
    }
    __syncthreads();
    f32x4 acc[8][2];
#pragma unroll
    for (int mt = 0; mt < 8; ++mt) { acc[mt][0] = (f32x4){0.f, 0.f, 0.f, 0.f}; acc[mt][1] = (f32x4){0.f, 0.f, 0.f, 0.f}; }
#pragma unroll
    for (int ks = 0; ks < 4; ++ks) {
        bf16x8 Bf[2];
#pragma unroll
        for (int nt = 0; nt < 2; ++nt) {
            LAS unsigned char* p = lds + SGU_VS + (32 * ks + 8 * fq + (fr >> 2)) * 528 + (32 * w + 16 * nt + 4 * (fr & 3)) * 2;
            Bf[nt] = tr_frag(p, p + 4 * 528);
        }
#pragma unroll
        for (int mt = 0; mt < 8; ++mt) {
            if (32 * ks <= 16 * mt + 15) {
                const bf16x8 Af = *(LAS bf16x8*)(lds + SGU_AS + (16 * mt + fr) * 272 + (32 * ks + 8 * fq) * 2);
                acc[mt][0] = MFMA16(Bf[0], Af, acc[mt][0]); acc[mt][1] = MFMA16(Bf[1], Af, acc[mt][1]);
            }
        }
    }
    const bf16_t* ZUG = ((bf16_t*)(F.ws + WS_Z)) + (size_t)3 * MP * D;
#pragma unroll
    for (int nt = 0; nt < 2; ++nt) {
        const int c = g * 256 + 32 * w + 16 * nt + 4 * fq;
        const f32x4 gg = *(const f32x4*)(FIN(15) + j * 1024 + c);
#pragma unroll
        for (int mt = 0; mt < 8; ++mt) {
            const int t = 16 * mt + fr;
            const float bb = FIN(14)[(j * 4 + g) * 128 + t];
            const f32x4 ug = unpack4(*(const u32x2*)(ZUG + (size_t)(row0 + t) * D + c));
            *(u32x2*)(((bf16_t*)(F.ws + WS_A2)) + (size_t)(row0 + t) * 2048 + 1024 + c) = pack4(ug * (acc[mt][nt] * gg + bb));
        }
    }
    __syncthreads();
}
__device__ __forceinline__ void pool_unit(Frame& F0, int j, int n, int g) {
    Frame F = launder(F0);
    LAS unsigned char* lds = F.lds;
    const int tid = F.tid, lane = F.lane, w = F.wave, fr = lane & 15, fq = lane >> 4, row0 = n * 128;
    {
        const int cb = tid & 31, t0 = (tid >> 5) * 8, win = 2 << g, pos0 = (row0 & 2047) + t0;
        const bf16_t* xa = ((bf16_t*)(F.ws + WS_Z)) + (size_t)(row0 + t0) * D + g * 256 + cb * 8;
        f32x4 S0 = (f32x4){0.f, 0.f, 0.f, 0.f}, S1 = S0;
        for (int i = 1; i < win; ++i) if (pos0 - i >= 0) { f32x4 a, b; unpack8(*(const u32x4*)(xa - (size_t)i * D), a, b); S0 += a; S1 += b; }
#pragma unroll
        for (int r = 0; r < 8; ++r) {
            f32x4 a, b; unpack8(*(const u32x4*)(xa + (size_t)r * D), a, b); S0 += a; S1 += b;
            const int cnt = (pos0 + r + 1) < win ? (pos0 + r + 1) : win; const float ic = 1.0f / (float)cnt;
            *(LAS u32x4*)(lds + (t0 + r) * 528 + cb * 16) = pack8(S0 * ic - a, S1 * ic - b);
            if (pos0 + r - (win - 1) >= 0) { f32x4 c, d; unpack8(*(const u32x4*)(xa + ((ptrdiff_t)r - (win - 1)) * D), c, d); S0 -= c; S1 -= d; }
        }
    }
    __syncthreads();
    f32x4 acc[8][2];
#pragma unroll
    for (int mt = 0; mt < 8; ++mt) { acc[mt][0] = (f32x4){0.f, 0.f, 0.f, 0.f}; acc[mt][1] = (f32x4){0.f, 0.f, 0.f, 0.f}; }
    const bf16_t* pm = ((bf16_t*)(F.ws + WS_PMT)) + (size_t)(j * 4 + g) * 65536 + (size_t)(32 * w + fr) * 256 + 8 * fq;
#pragma unroll
    for (int ks = 0; ks < 8; ++ks) {
        const bf16x8 B0 = *(const bf16x8*)(pm + 32 * ks), B1 = *(const bf16x8*)(pm + 16 * 256 + 32 * ks);
#pragma unroll
        for (int mt = 0; mt < 8; ++mt) {
            const bf16x8 Af = *(LAS bf16x8*)(lds + (16 * mt + fr) * 528 + (32 * ks + 8 * fq) * 2);
            acc[mt][0] = MFMA16(B0, Af, acc[mt][0]); acc[mt][1] = MFMA16(B1, Af, acc[mt][1]);
        }
    }
    const bf16_t* ZSGA = ((bf16_t*)(F.ws + WS_Z)) + (size_t)1 * MP * D;
#pragma unroll
    for (int nt = 0; nt < 2; ++nt) {
        const int c = g * 256 + 32 * w + 16 * nt + 4 * fq;
        const f32x4 ps = *(const f32x4*)(FIN(12) + j * 1024 + c);
#pragma unroll
        for (int mt = 0; mt < 8; ++mt) {
            const int t = 16 * mt + fr;
            const f32x4 sg = unpack4(*(const u32x2*)(ZSGA + (size_t)(row0 + t) * D + c));
            *(u32x2*)(((bf16_t*)(F.ws + WS_A2)) + (size_t)(row0 + t) * 2048 + c) = pack4(acc[mt][nt] * ps * sg);
        }
    }
    __syncthreads();
}
__device__ __forceinline__ void conv_phase(Frame& F0, int j) {
    Frame F = launder(F0);
    const bf16_t* ZE = ((bf16_t*)(F.ws + WS_Z)); const bf16_t* ZSG = ((bf16_t*)(F.ws + WS_Z)) + (size_t)MP * 2048;
    const int tid = F.tid, c = (tid & 255) * 8, rh = tid >> 8;
    const float* cw = FIN(18) + (size_t)j * 3 * 2048 + c;
    const f32x4 w0a = *(const f32x4*)cw, w0b = *(const f32x4*)(cw + 4), w1a = *(const f32x4*)(cw + 2048), w1b = *(const f32x4*)(cw + 2052), w2a = *(const f32x4*)(cw + 4096), w2b = *(const f32x4*)(cw + 4100);
    for (int item = F.bx; item < MP / 32; item += F.G) {
        const int t0 = item * 32 + rh * 16, pos = t0 & 2047;
        f32x4 m2a = (f32x4){0.f, 0.f, 0.f, 0.f}, m2b = m2a, m1a = m2a, m1b = m2a;
        if (pos >= 2) { unpack8(*(const u32x4*)(ZE + (size_t)(t0 - 2) * 2048 + c), m2a, m2b); unpack8(*(const u32x4*)(ZE + (size_t)(t0 - 1) * 2048 + c), m1a, m1b); }
#pragma unroll 4
        for (int r = 0; r < 16; ++r) {
            f32x4 ea, eb, sa, sb; unpack8(*(const u32x4*)(ZE + (size_t)(t0 + r) * 2048 + c), ea, eb); unpack8(*(const u32x4*)(ZSG + (size_t)(t0 + r) * 2048 + c), sa, sb);
            const f32x4 ya = w0a * m2a + w1a * m1a + w2a * ea, yb = w0b * m2b + w1b * m1b + w2b * eb;
            *(u32x4*)(((bf16_t*)(F.ws + WS_A2)) + (size_t)(t0 + r) * 2048 + c) = pack8(sa * ya, sb * yb);
            m2a = m1a; m2b = m1b; m1a = ea; m1b = eb;
        }
    }
}

constexpr int ATT_SLOT = 64 * 528;
__device__ __forceinline__ void attn_prompt(Frame& F0, int layer) {
    Frame F = launder(F0);
    LAS unsigned char* lds = F.lds;
    const int tid = F.tid, lane = F.lane, w = F.wave, fr = lane & 15, fq = lane >> 4;
    const bf16_t* Kl = ((bf16_t*)(F.ws + WS_KB)) + (size_t)layer * MMEM * D; const bf16_t* Vl = ((bf16_t*)(F.ws + WS_VB)) + (size_t)layer * MMEM * D;
    for (int unit = F.bx; unit < 512; unit += F.G) {
        const int bh = unit >> 4, b = bh >> 2, h = bh & 3, qb = unit & 15;
        const size_t rowq = (size_t)b * SEQ + qb * 128 + 16 * w + fr;
        bf16x8 Qf[8];
#pragma unroll
        for (int ks = 0; ks < 8; ++ks) Qf[ks] = *(const bf16x8*)(((bf16_t*)(F.ws + WS_Q)) + rowq * D + h * 256 + 32 * ks + 8 * fq);
        const bf16_t* kbase = Kl + (size_t)(b * 256) * D + h * 256; const bf16_t* vbase = Vl + (size_t)(b * 256) * D + h * 256;
        u32x4 st[4];
#define ATT_GLOAD(c) do { const bf16_t* src_ = ((c) < 4 ? kbase : vbase) + (size_t)(64 * ((c) & 3)) * D; _Pragma("unroll") for (int i_ = 0; i_ < 4; ++i_) { const int idx_ = tid + 512 * i_; st[i_] = *(const u32x4*)(src_ + (size_t)(idx_ >> 5) * D + (idx_ & 31) * 8); } } while (0)
#define ATT_LSTORE(slot) do { _Pragma("unroll") for (int i_ = 0; i_ < 4; ++i_) { const int idx_ = tid + 512 * i_; *(LAS u32x4*)(lds + (slot) * ATT_SLOT + (idx_ >> 5) * 528 + (idx_ & 31) * 16) = st[i_]; } } while (0)
        f32x4 S[16], Oa[16]; bf16x8 Pf[8]; float inv = 0.f;
#pragma unroll
        for (int i = 0; i < 16; ++i) { S[i] = (f32x4){0.f, 0.f, 0.f, 0.f}; Oa[i] = (f32x4){0.f, 0.f, 0.f, 0.f}; }
        ATT_GLOAD(0); ATT_LSTORE(0); __syncthreads();
#pragma unroll
        for (int c = 0; c < 8; ++c) {
            if (c < 7) ATT_GLOAD(c + 1);
            LAS unsigned char* slot = lds + (c & 1) * ATT_SLOT;
            if (c < 4) {
#pragma unroll
                for (int ml = 0; ml < 4; ++ml)
#pragma unroll
                    for (int ks = 0; ks < 8; ++ks) {
                        const bf16x8 Kf = *(LAS bf16x8*)(slot + (16 * ml + fr) * 528 + (32 * ks + 8 * fq) * 2);
                        S[4 * c + ml] = MFMA16(Kf, Qf[ks], S[4 * c + ml]);
                    }
                if (c == 3) {
                    float mx = S[0][0];
#pragma unroll
                    for (int i = 0; i < 16; ++i) { mx = fmaxf(mx, fmaxf(fmaxf(S[i][0], S[i][1]), fmaxf(S[i][2], S[i][3]))); }
                    mx = fmaxf(mx, __shfl_xor(mx, 16)); mx = fmaxf(mx, __shfl_xor(mx, 32));
                    float sum = 0.f;
#pragma unroll
                    for (int i = 0; i < 16; ++i) {
#pragma unroll
                        for (int e = 0; e < 4; ++e) { S[i][e] = __builtin_amdgcn_exp2f(S[i][e] - mx); sum += S[i][e]; }
                    }
                    sum += __shfl_xor(sum, 16); sum += __shfl_xor(sum, 32);
                    inv = 1.0f / sum;
#pragma unroll
                    for (int a = 0; a < 8; ++a) {
                        u32x4 pw; pw.x = cvt_pk_bf16(S[2 * a][0], S[2 * a][1]); pw.y = cvt_pk_bf16(S[2 * a][2], S[2 * a][3]); pw.z = cvt_pk_bf16(S[2 * a + 1][0], S[2 * a + 1][1]); pw.w = cvt_pk_bf16(S[2 * a + 1][2], S[2 * a + 1][3]);
                        Pf[a] = __builtin_bit_cast(bf16x8, pw);
                    }
                }
            } else {
#pragma unroll
                for (int al = 0; al < 2; ++al)
#pragma unroll
                    for (int dt = 0; dt < 16; ++dt) {
                        LAS unsigned char* p = slot + (32 * al + 4 * fq + (fr >> 2)) * 528 + (16 * dt + 4 * (fr & 3)) * 2;
                        const bf16x8 Vf = tr_frag(p, p + 16 * 528);
                        Oa[dt] = MFMA16(Vf, Pf[2 * (c - 4) + al], Oa[dt]);
                    }
            }
            if (c < 7) ATT_LSTORE((c + 1) & 1);
            __syncthreads();
        }
#pragma unroll
        for (int dt = 0; dt < 16; ++dt) *(u32x2*)(((bf16_t*)(F.ws + WS_O)) + rowq * D + h * 256 + 16 * dt + 4 * fq) = pack4(Oa[dt] * inv);
#undef ATT_GLOAD
#undef ATT_LSTORE
    }
}

template <class Epi>
__device__ __forceinline__ void skinny_gemm(Frame& F0, const bf16_t* A, const bf16_t* Bt, int N, int K, const Epi& E) {
    Frame F = launder(F0);
    LAS unsigned char* lds = F.lds;
    const int tid = F.tid, lane = F.lane, w = F.wave, fr = lane & 15, fq = lane >> 4;
    const int nstrips = N / 32, kslice = K / 8, nks = kslice / 32;
    for (int strip = F.bx; strip < nstrips; strip += F.G) {
        f32x4 acc[8][2];
#pragma unroll
        for (int mt = 0; mt < 8; ++mt) { acc[mt][0] = (f32x4){0.f, 0.f, 0.f, 0.f}; acc[mt][1] = (f32x4){0.f, 0.f, 0.f, 0.f}; }
        const bf16_t* ap = A + (size_t)fr * K + w * kslice + 8 * fq; const bf16_t* bp = Bt + (size_t)(strip * 32 + fr) * K + w * kslice + 8 * fq;
#pragma unroll 2
        for (int ks = 0; ks < nks; ++ks) {
            const bf16x8 B0 = *(const bf16x8*)(bp + 32 * ks), B1 = *(const bf16x8*)(bp + (size_t)16 * K + 32 * ks);
#pragma unroll
            for (int mt = 0; mt < 8; ++mt) {
                const bf16x8 Af = *(const bf16x8*)(ap + (size_t)(16 * mt) * K + 32 * ks);
                acc[mt][0] = MFMA16(B0, Af, acc[mt][0]); acc[mt][1] = MFMA16(B1, Af, acc[mt][1]);
            }
        }
#pragma unroll
        for (int mt = 0; mt < 8; ++mt)
#pragma unroll
            for (int nt = 0; nt < 2; ++nt) *(LAS f32x4*)(lds + ((size_t)((w * 128 + 16 * mt + fr) * 32 + 16 * nt + 4 * fq)) * 4) = acc[mt][nt];
        __syncthreads();
        const int row = tid >> 2, cq = tid & 3;
        f32x4 s0 = (f32x4){0.f, 0.f, 0.f, 0.f}, s1 = s0;
#pragma unroll
        for (int ww = 0; ww < 8; ++ww) { const LAS f32x4* p = (const LAS f32x4*)(lds + ((size_t)((ww * 128 + row) * 32 + 8 * cq)) * 4); s0 += p[0]; s1 += p[1]; }
        E(row, strip, strip * 32 + 8 * cq, s0, s1);
        __syncthreads();
    }
}
struct SEpiZ {
    const float* rsqs; float* SZ; int ldz, mode;
    __device__ __forceinline__ void operator()(int row, int strip, int col, f32x4 s0, f32x4 s1) const {
        const float rs = rstd32(rsqs + row * 32); const int oc = mode == 0 ? src_even(col) : src_odd(col);
        float* p = SZ + (size_t)row * ldz + oc; *(f32x4*)p = s0 * rs; *(f32x4*)(p + 4) = s1 * rs;
    }
};
struct SEpiRes {
    float* xs; bf16_t* xb; float* rsqs;
    __device__ __forceinline__ void operator()(int row, int strip, int col, f32x4 s0, f32x4 s1) const {
        float* p = xs + (size_t)row * D + col; const f32x4 o0 = *(const f32x4*)p + s0, o1 = *(const f32x4*)(p + 4) + s1;
        *(f32x4*)p = o0; *(f32x4*)(p + 4) = o1; *(u32x4*)(xb + (size_t)row * D + col) = pack8(o0, o1);
        float ss = dot4(o0, o0) + dot4(o1, o1); ss += __shfl_xor(ss, 1); ss += __shfl_xor(ss, 2);
        if ((col & 31) == 0) rsqs[row * 32 + strip] = ss;
    }
};
struct SEpiQ {
    const float* rsqs; float* SQ;
    __device__ __forceinline__ void operator()(int row, int strip, int col, f32x4 s0, f32x4 s1) const {
        const float rs = rstd32(rsqs + row * 32); float* p = SQ + (size_t)row * D + col; *(f32x4*)p = s0 * rs; *(f32x4*)(p + 4) = s1 * rs;
    }
};
__device__ __forceinline__ void sample_mix_even(Frame& F0, int j, int b) {
    Frame F = launder(F0);
    LAS float* pl = (LAS float*)F.lds; LAS float* red = pl + 1024;
    const int tid = F.tid, lane = F.lane, w = F.wave;
    const float* z = ((float*)(F.ws + WS_SZ)) + (size_t)b * 8192;
    float vv[2], ss = 0.f;
#pragma unroll
    for (int k = 0; k < 2; ++k) { vv[k] = z[3072 + tid + 512 * k]; ss += vv[k] * vv[k]; }
    ss = wave_sum(ss); if (lane == 0) red[w] = ss;
#pragma unroll
    for (int k = 0; k < 2; ++k) {
        const int c = tid + 512 * k, g = c >> 8, win = 2 << g; const float xa = z[c];
        const float* st = FIN(3) + ((size_t)(j * 128 + b) * 15) * 1024 + c;
        float s = xa; for (int r = 16 - win; r < 15; ++r) s += st[(size_t)r * 1024];
        pl[c] = s / (float)win - xa;
        float* po = F.out + O_POOLS + ((size_t)(j * 128 + b) * 15) * 1024 + c;
        for (int r = 0; r < 14; ++r) po[(size_t)r * 1024] = st[(size_t)(r + 1) * 1024];
        po[(size_t)14 * 1024] = xa;
    }
    __syncthreads();
    float tot = 0.f;
#pragma unroll
    for (int i = 0; i < 8; ++i) tot += red[i];
    const float rv = rsqrtf(tot * (1.0f / D) + EPS);
#pragma unroll
    for (int k = 0; k < 2; ++k) {
        const int d = tid + 512 * k, g = d >> 8, dd = d & 255;
        const float* pm = FIN(11) + (size_t)(j * 4 + g) * 65536 + dd; const LAS float* pg = pl + g * 256;
        float a = 0.f;
#pragma unroll 8
        for (int c = 0; c < 256; ++c) a += pg[c] * pm[(size_t)c * 256];
        const float ya = a * FIN(12)[j * 1024 + d] * silu_f(z[1024 + d]);
        const float vn = vv[k] * rv * FIN(15)[j * 1024 + d];
        F.out[O_SGUV + (size_t)(j * 128 + b) * 1024 + d] = vn;
        const float mixed = FIN(13)[(size_t)(j * 4 + g) * 16384] * vn + FIN(14)[(j * 4 + g) * 128];
        const float yb = z[2048 + d] * mixed * silu_f(z[4096 + d]);
        ((bf16_t*)(F.ws + WS_SA2))[(size_t)b * 2048 + d] = (bf16_t)(cvt_pk_bf16(ya, 0.f) & 0xffffu); ((bf16_t*)(F.ws + WS_SA2))[(size_t)b * 2048 + 1024 + d] = (bf16_t)(cvt_pk_bf16(yb, 0.f) & 0xffffu);
    }
    __syncthreads();
}
__device__ __forceinline__ void sample_conv_odd(Frame& F0, int j, int b) {
    Frame F = launder(F0);
    const int tid = F.tid;
    const float* z = ((float*)(F.ws + WS_SZ)) + (size_t)b * 8192;
    const float* cw = FIN(18) + (size_t)j * 3 * 2048;
#pragma unroll
    for (int k = 0; k < 4; ++k) {
        const int c = tid + 512 * k;
        const float e = z[2048 + c] * z[4096 + c];
        const float s0 = FIN(4)[((size_t)(j * 128 + b) * 2 + 0) * 2048 + c], s1 = FIN(4)[((size_t)(j * 128 + b) * 2 + 1) * 2048 + c];
        const float y = cw[c] * s0 + cw[2048 + c] * s1 + cw[4096 + c] * e;
        ((bf16_t*)(F.ws + WS_SA2))[(size_t)b * 2048 + c] = (bf16_t)(cvt_pk_bf16(z[c] * y * silu_f(z[6144 + c]), 0.f) & 0xffffu);
        float* po = F.out + O_CONVS + ((size_t)(j * 128 + b) * 2) * 2048 + c; po[0] = s1; po[2048] = e;
    }
}
__device__ __forceinline__ void attn_sample(Frame& F0, int layer) {
    Frame F = launder(F0);
    LAS float* sc = (LAS float*)F.lds;
    LAS float* red = sc + 512;
    const int tid = F.tid, lane = F.lane, w = F.wave;
    for (int item = F.bx; item < 256; item += F.G) {
        const int b = item >> 1, hp = item & 1;
        const float* qp = ((float*)(F.ws + WS_SQ)) + (size_t)b * D + hp * 512;
        const f32x4 q0 = *(const f32x4*)(qp + 4 * lane), q1 = *(const f32x4*)(qp + 256 + 4 * lane);
        const float* kp = FIN(5) + ((size_t)(layer * 128 + b) * 256) * 1024 + hp * 512 + 4 * lane;
        const float* vp = FIN(6) + ((size_t)(layer * 128 + b) * 256) * 1024 + hp * 512 + 4 * lane;
#pragma unroll 8
        for (int mi = 0; mi < 32; ++mi) {
            const int m = 32 * w + mi;
            const f32x4 k0 = __builtin_nontemporal_load((const f32x4*)(kp + (size_t)m * 1024)), k1 = __builtin_nontemporal_load((const f32x4*)(kp + (size_t)m * 1024 + 256));
            const float d0 = wave_sum(dot4(k0, q0)), d1 = wave_sum(dot4(k1, q1));
            if (lane == 0) { sc[m] = d0; sc[256 + m] = d1; }
        }
        __syncthreads();
        float p0[4], p1[4], mx0 = -INFINITY, mx1 = -INFINITY;
#pragma unroll
        for (int i = 0; i < 4; ++i) { p0[i] = sc[lane + 64 * i]; p1[i] = sc[256 + lane + 64 * i]; mx0 = fmaxf(mx0, p0[i]); mx1 = fmaxf(mx1, p1[i]); }
#pragma unroll
        for (int o = 1; o < 64; o <<= 1) { mx0 = fmaxf(mx0, __shfl_xor(mx0, o)); mx1 = fmaxf(mx1, __shfl_xor(mx1, o)); }
        float sm0 = 0.f, sm1 = 0.f;
#pragma unroll
        for (int i = 0; i < 4; ++i) { p0[i] = __builtin_amdgcn_exp2f(p0[i] - mx0); p1[i] = __builtin_amdgcn_exp2f(p1[i] - mx1); sm0 += p0[i]; sm1 += p1[i]; }
        sm0 = wave_sum(sm0); sm1 = wave_sum(sm1);
        const float i0 = 1.0f / sm0, i1 = 1.0f / sm1;
        __syncthreads();
        if (w == 0) {
#pragma unroll
            for (int i = 0; i < 4; ++i) { sc[lane + 64 * i] = p0[i] * i0; sc[256 + lane + 64 * i] = p1[i] * i1; }
        }
        __syncthreads();
        f32x4 a0 = (f32x4){0.f, 0.f, 0.f, 0.f}, a1 = a0;
#pragma unroll 8
        for (int mi = 0; mi < 32; ++mi) {
            const int m = 32 * w + mi;
            const f32x4 v0 = __builtin_nontemporal_load((const f32x4*)(vp + (size_t)m * 1024)), v1 = __builtin_nontemporal_load((const f32x4*)(vp + (size_t)m * 1024 + 256));
            a0 += v0 * sc[m]; a1 += v1 * sc[256 + m];
        }
        *(LAS f32x4*)(red + w * 512 + 4 * lane) = a0; *(LAS f32x4*)(red + w * 512 + 256 + 4 * lane) = a1;
        __syncthreads();
        {
            float o = 0.f;
#pragma unroll
            for (int ww = 0; ww < 8; ++ww) o += red[ww * 512 + tid];
            ((bf16_t*)(F.ws + WS_SO))[(size_t)b * D + hp * 512 + tid] = (bf16_t)(cvt_pk_bf16(o, 0.f) & 0xffffu);
        }
        __syncthreads();
    }
}
__device__ __forceinline__ void final_norm(Frame& F0) {
    Frame F = launder(F0);
    const int gw = F.bx * NWAVES + F.wave, NGW = F.G * NWAVES, lane = F.lane;
    f32x4 g[4];
#pragma unroll
    for (int jj = 0; jj < 4; ++jj) g[jj] = ((const f32x4*)FIN(24) + lane)[64 * jj];
    for (int m = gw; m < MP + MS; m += NGW) {
        const float* src = m < MP ? F.out + O_Y + (size_t)m * D : ((float*)(F.ws + WS_XS)) + (size_t)(m - MP) * D;
        float* dst = m < MP ? F.out + O_Y + (size_t)m * D : F.out + O_YS + (size_t)(m - MP) * D;
        f32x4 v[4]; float s = 0.f;
#pragma unroll
        for (int jj = 0; jj < 4; ++jj) { v[jj] = ((const f32x4*)src + lane)[64 * jj]; s += dot4(v[jj], v[jj]); }
        const float rs = rsqrtf(wave_sum(s) * (1.0f / D) + EPS);
#pragma unroll
        for (int jj = 0; jj < 4; ++jj) ((f32x4*)dst + lane)[64 * jj] = v[jj] * rs * g[jj];
    }
}

struct Args { const float* in[25]; float* out; unsigned char* ws; int ph_lo, ph_hi; };
#ifndef MK_SPLIT
#define MK_SPLIT 0
#endif
__global__ void __launch_bounds__(NWAVES * 64, 2) fwd(Args args) {
    extern __shared__ __attribute__((aligned(16))) unsigned char lds_raw[];
    Frame F0;
    F0.lds = (LAS unsigned char*)lds_raw;
    F0.tid = threadIdx.x; F0.lane = F0.tid & 63; F0.wave = __builtin_amdgcn_readfirstlane(F0.tid >> 6); F0.G = gridDim.x; F0.bx = blockIdx.x;
    F0.in = (in_tab_t)__builtin_amdgcn_kernarg_segment_ptr();     F0.out = args.out; F0.ws = args.ws;
    for (int u = F0.tid; u < (LDS_BYTES - LDSCTL_OFF) / 4; u += NWAVES * 64) ((LAS unsigned*)(F0.lds + LDSCTL_OFF))[u] = 0u;
    __syncthreads();
    XcdBarrier bar; bar.bar = (unsigned*)(args.ws + WS_CTL) + CW_BAR; bar.x = 0; bar.st = nullptr;
    if (!MK_SPLIT) bar = xcd_barrier_post((unsigned*)(args.ws + WS_CTL) + CW_BAR, (volatile LAS unsigned*)(F0.lds + MISC_OFF) + 8);
    int ph = 0;
    const int lo = args.ph_lo, hi = args.ph_hi;
#define PH_BEGIN if (ph >= lo && ph < hi) { Frame F = launder(F0);
#define PH_END } { const bool both_ = (ph >= lo && ph + 1 < hi); ++ph; if (!MK_SPLIT && both_) xcd_barrier(bar); }

    PH_BEGIN p0_prologue(F0); PH_END
    PH_BEGIN {
        pg8::Gemm g{((bf16_t*)(F.ws + WS_MEMB)), ((bf16_t*)(F.ws + WS_WKV)), MMEM, 8192, D}; pg8::StaticOrder S; S.init(MMEM, 8192, F.G, (int)F.bx);
        EpiMemKV E{((float*)(F.ws + WS_SMALL + 65536)), F.out + O_MEMK, F.out + O_MEMV, ((bf16_t*)(F.ws + WS_KB)), ((bf16_t*)(F.ws + WS_VB))};
        pg8::gemm_phase<EpiMemKV, pg8::StaticOrder, true, true>(F.lds, g, S, E);
    } PH_END
#pragma unroll 1
    for (int l = 0; l < DEPTH; ++l) {
        const int j = l >> 1;
        if ((l & 1) == 0) {
            PH_BEGIN {
                pg8::Gemm g{((bf16_t*)(F.ws + WS_XB)), ((bf16_t*)(F.ws + WS_AB1)) + (size_t)j * NAB * D, MP, NAB, D}; pg8::StaticOrder S; S.init(MP, NAB, F.G, (int)F.bx);
                EpiG1Even E{((float*)(F.ws + WS_RSQ)), ((bf16_t*)(F.ws + WS_Z)), ((float*)(F.ws + WS_VSQ)), F.out + O_POOLP + (size_t)j * 8 * 15 * 1024};
                pg8::gemm_phase<EpiG1Even, pg8::StaticOrder, true, true>(F.lds, g, S, E);
                SEpiZ SE{((float*)(F.ws + WS_SMALL)), ((float*)(F.ws + WS_SZ)), 8192, 0};
                skinny_gemm<SEpiZ>(F, ((bf16_t*)(F.ws + WS_XB)) + (size_t)MP * D, ((bf16_t*)(F.ws + WS_AB1)) + (size_t)j * NAB * D, NAB, D, SE);
            } PH_END
            PH_BEGIN {
                for (int un = F.bx; un < 1024; un += F.G) { const int kind = un & 1, g = (un >> 1) & 3, n = un >> 3; if (kind == 0) sgu_unit(F, j, n, g); else pool_unit(F, j, n, g); }
                for (int b = F.bx; b < MS; b += F.G) sample_mix_even(F, j, b);
            } PH_END
        } else {
            PH_BEGIN {
                pg8::Gemm g{((bf16_t*)(F.ws + WS_XB)), ((bf16_t*)(F.ws + WS_C1)) + (size_t)j * NC * D, MP, NC, D}; pg8::StaticOrder S; S.init(MP, NC, F.G, (int)F.bx);
                EpiG1Odd E{((float*)(F.ws + WS_RSQ)), ((bf16_t*)(F.ws + WS_Z)), F.out + O_CONVP + (size_t)j * 8 * 2 * 2048};
                pg8::gemm_phase<EpiG1Odd, pg8::StaticOrder, true, true>(F.lds, g, S, E);
                SEpiZ SE{((float*)(F.ws + WS_SMALL)), ((float*)(F.ws + WS_SZ)), 8192, 1};
                skinny_gemm<SEpiZ>(F, ((bf16_t*)(F.ws + WS_XB)) + (size_t)MP * D, ((bf16_t*)(F.ws + WS_C1)) + (size_t)j * NC * D, NC, D, SE);
            } PH_END
            PH_BEGIN {
                conv_phase(F, j);
                for (int b = F.bx; b < MS; b += F.G) sample_conv_odd(F, j, b);
            } PH_END
        }
        PH_BEGIN {
            const bf16_t* W2 = ((l & 1) ? ((bf16_t*)(F.ws + WS_C2)) : ((bf16_t*)(F.ws + WS_AB2))) + (size_t)j * D * 2048;
            pg8::Gemm g{((bf16_t*)(F.ws + WS_A2)), W2, MP, D, 2048}; pg8::StaticOrder S; S.init(MP, D, F.G, (int)F.bx);
            EpiRes E{l == 0 ? FIN(0) : F.out + O_Y, F.out + O_Y, ((bf16_t*)(F.ws + WS_XB)), ((float*)(F.ws + WS_RSQ))};
            pg8::gemm_phase<EpiRes, pg8::StaticOrder, true, true>(F.lds, g, S, E);
            SEpiRes SE{((float*)(F.ws + WS_XS)), ((bf16_t*)(F.ws + WS_XB)) + (size_t)MP * D, ((float*)(F.ws + WS_SMALL))};
            skinny_gemm<SEpiRes>(F, ((bf16_t*)(F.ws + WS_SA2)), W2, D, 2048, SE);
        } PH_END
        PH_BEGIN {
            pg8::Gemm g{((bf16_t*)(F.ws + WS_XB)), ((bf16_t*)(F.ws + WS_WQ)) + (size_t)l * D * D, MP, D, D}; pg8::StaticOrder S; S.init(MP, D, F.G, (int)F.bx);
            EpiQ E{((float*)(F.ws + WS_RSQ)), ((bf16_t*)(F.ws + WS_Q))};
            pg8::gemm_phase<EpiQ, pg8::StaticOrder, true, true>(F.lds, g, S, E);
            SEpiQ SE{((float*)(F.ws + WS_SMALL)), ((float*)(F.ws + WS_SQ))};
            skinny_gemm<SEpiQ>(F, ((bf16_t*)(F.ws + WS_XB)) + (size_t)MP * D, ((bf16_t*)(F.ws + WS_WQ)) + (size_t)l * D * D, D, D, SE);
        } PH_END
        PH_BEGIN {
            attn_prompt(F, l);
            attn_sample(F, l);
        } PH_END
        PH_BEGIN {
            pg8::Gemm g{((bf16_t*)(F.ws + WS_O)), ((bf16_t*)(F.ws + WS_WO)) + (size_t)l * D * D, MP, D, D}; pg8::StaticOrder S; S.init(MP, D, F.G, (int)F.bx);
            EpiRes E{F.out + O_Y, F.out + O_Y, ((bf16_t*)(F.ws + WS_XB)), ((float*)(F.ws + WS_RSQ))};
            pg8::gemm_phase<EpiRes, pg8::StaticOrder, true, true>(F.lds, g, S, E);
            SEpiRes SE{((float*)(F.ws + WS_XS)), ((bf16_t*)(F.ws + WS_XB)) + (size_t)MP * D, ((float*)(F.ws + WS_SMALL))};
            skinny_gemm<SEpiRes>(F, ((bf16_t*)(F.ws + WS_SO)), ((bf16_t*)(F.ws + WS_WO)) + (size_t)l * D * D, D, D, SE);
        } PH_END
    }
    PH_BEGIN final_norm(F0); PH_END
#undef PH_BEGIN
#undef PH_END
}
constexpr int N_PHASES = 2 + 6 * DEPTH + 1;

extern "C" void kernel_launch(void* const* d_in, const int* in_sizes, int n_in, void* d_out, int out_size, void* d_ws, size_t ws_size, hipStream_t stream) {
    static int grid = 0;
    if (grid == 0) {
        if (n_in != 25 || in_sizes[0] != MP * D || (size_t)out_size != O_END || ws_size < WS_END) { fprintf(stderr, "kernel_launch: unexpected shapes (n_in %d, in0 %d, out %d, ws %zu); nothing launched\n", n_in, n_in > 0 ? in_sizes[0] : -1, out_size, ws_size); grid = -1; return; }
        int dev = 0, cus = 0, per_cu = 0;
        if (hipGetDevice(&dev) != hipSuccess || hipDeviceGetAttribute(&cus, hipDeviceAttributeMultiprocessorCount, dev) != hipSuccess) { fprintf(stderr, "kernel_launch: device query failed\n"); grid = -1; return; }
        if (hipFuncSetAttribute((const void*)fwd, hipFuncAttributeMaxDynamicSharedMemorySize, LDS_BYTES) != hipSuccess) { fprintf(stderr, "kernel_launch: hipFuncSetAttribute failed\n"); grid = -1; return; }
        if (hipOccupancyMaxActiveBlocksPerMultiprocessor(&per_cu, (const void*)fwd, NWAVES * 64, LDS_BYTES) != hipSuccess || per_cu < 1) fprintf(stderr, "kernel_launch: note: occupancy query reports %d workgroups per CU\n", per_cu);
        (void)hipGetLastError();
        grid = cus;
    }
    if (grid < 0) return;
    if (hipMemsetAsync((char*)d_ws + WS_CTL, 0, CTL_ZERO_BYTES, stream) != hipSuccess) { fprintf(stderr, "kernel_launch: memset failed\n"); return; }
    Args a{};
    for (int i = 0; i < 25; ++i) a.in[i] = (const float*)d_in[i];
    a.out = (float*)d_out; a.ws = (unsigned char*)d_ws;
#if MK_SPLIT
    for (int p = 0; p < N_PHASES; ++p) { a.ph_lo = p; a.ph_hi = p + 1; hipLaunchKernelGGL(fwd, dim3(grid), dim3(NWAVES * 64), LDS_BYTES, stream, a); }
#else
    a.ph_lo = 0; a.ph_hi = N_PHASES;
    hipLaunchKernelGGL(fwd, dim3(grid), dim3(NWAVES * 64), LDS_BYTES, stream, a);
#endif
    const hipError_t le = hipPeekAtLastError();
    if (le != hipSuccess) fprintf(stderr, "kernel_launch: launch failed: %s\n", hipGetErrorName(le));
}
```

```cpp
#include <hip/hip_runtime.h>
#include <cstdio>
#include <cstdint>
#ifndef REP_MASK
#define REP_MASK 0
#endif
namespace pg8 {
#define PG8_LAS __attribute__((address_space(3)))
typedef unsigned short bf16_t;
typedef short bf16x8 __attribute__((ext_vector_type(8)));
typedef float f32x4 __attribute__((ext_vector_type(4)));
typedef unsigned u32x4 __attribute__((ext_vector_type(4)));
constexpr int BM = 256, BK = 64, HALF = 128, HTB = HALF * BK * 2  , STAGE_BYTES = 8 * HTB, NXCD = 8, WGM = 8;

__host__ __device__ __forceinline__ int lds_byte(int r, int c) { const int st = (r >> 4) * 2 + (c >> 5), rr = r & 15, cc = c & 31, ob = rr * 64 + cc * 2; return st * 1024 + (ob ^ (((ob >> 9) & 1) << 5)); }
__host__ __device__ __forceinline__ void stage_rc(int b, int& R, int& C) { const int st = b / 1024, sb = b % 1024, swz = sb ^ (((sb >> 9) & 1) << 5); R = (st >> 1) * 16 + swz / 64; C = (st & 1) * 32 + (swz % 64) / 2; }
__host__ __device__ __forceinline__ int perm32(int rho) { const int n = rho >> 4, i = rho & 15; return 8 * (i >> 2) + 4 * n + (i & 3); }

struct Unit { int pm, pn; };
struct Gemm { const bf16_t* A; const bf16_t* Bt; int M, N, K; };

struct StaticOrder {
    int nM, nN, nwg, G, c;
    __host__ __device__ void init(int M, int N, int G_, int c_) { nM = M / BM; nN = N / BM; nwg = nM * nN; G = G_; c = c_; }
    __host__ __device__ bool next(int i, Unit& u) const {
        const long L = (long)i * G + c; if (L >= nwg) return false;
        int wgid = (int)L; { const int q = nwg / NXCD, r = nwg % NXCD, xcd = wgid % NXCD, off = wgid / NXCD; wgid = (xcd < r ? xcd * (q + 1) : r * (q + 1) + (xcd - r) * q) + off; }
        const int nig = WGM * nN, gid = wgid / nig, fm = gid * WGM, gsz = (nM - fm) < WGM ? (nM - fm) : WGM;
        u.pm = fm + ((wgid % nig) % gsz); u.pn = (wgid % nig) / gsz; return true;
    }
    __device__ __forceinline__ void a_ready(const Unit&) const {}
    __device__ __forceinline__ void done(const Unit&) const {}
};

__device__ __forceinline__ unsigned cvt_pk_bf16(float lo, float hi) { unsigned r; asm volatile("v_cvt_pk_bf16_f32 %0, %1, %2" : "=v"(r) : "v"(lo), "v"(hi)); return r; }
template <class Epi, class Sched, bool ALIGN_EPI = false, bool SP2 = false>
__device__ __forceinline__ void gemm_phase(PG8_LAS unsigned char* lds, const Gemm g, const Sched& S, const Epi& E) {
    int tid_ = threadIdx.x; asm volatile("" : "+v"(tid_));
    const int tid = tid_, wid = __builtin_amdgcn_readfirstlane(tid >> 6), lane = tid & 63, wr = wid >> 2, wc = wid & 3, fr = lane & 15, fq = lane >> 4;
    const int K = g.K, nt = K / BK;
    unsigned voffA[2], voffB[2];
#pragma unroll
    for (int i = 0; i < 2; ++i) { int R, C; stage_rc(tid * 16 + i * 8192, R, C); const int Rb = Epi::PERM ? ((R & ~31) + perm32(R & 31)) : R;
        voffA[i] = (unsigned)(R * K + C) * 2u; voffB[i] = (unsigned)(Rb * K + C) * 2u; }
    const size_t kstep = (size_t)(BK * 2);
    const size_t hstep = (size_t)HALF * K * 2;
    const size_t tstep = 2 * hstep;
    const unsigned ldsw = (unsigned)wid * 1024u;
    const int aoff = lds_byte(wr * 64 + fr, fq * 8), boff = lds_byte(wc * 32 + fr, fq * 8);
#define PG8_SA(b, h) (((b) * 2 + (h)) * HTB)
#define PG8_SB(b, h) ((4 + (b) * 2 + (h)) * HTB)
#define PG8_STAGE(bufoff, gbase, voff) do { _Pragma("unroll") for (int _i = 0; _i < 2; ++_i) \
        __builtin_amdgcn_global_load_lds((const unsigned*)((const char*)(gbase) + (voff)[_i]), (PG8_LAS unsigned*)(lds + (bufoff) + ldsw + _i * 8192), 16, 0, 0); } while (0)
#define PG8_LDA(dst, b, h) do { _Pragma("unroll") for (int m = 0; m < 4; ++m) _Pragma("unroll") for (int k = 0; k < 2; ++k) dst[m][k] = *(const PG8_LAS bf16x8*)(lds + PG8_SA(b, h) + aoff + m * 2048 + k * 1024); } while (0)
#define PG8_LDB(dst, b, h) do { _Pragma("unroll") for (int n = 0; n < 2; ++n) _Pragma("unroll") for (int k = 0; k < 2; ++k) dst[n][k] = *(const PG8_LAS bf16x8*)(lds + PG8_SB(b, h) + boff + n * 2048 + k * 1024); } while (0)
#define PG8_MMA(ai, bj, At, Bt) do { __builtin_amdgcn_s_setprio(1); _Pragma("unroll") for (int m = 0; m < 4; ++m) _Pragma("unroll") for (int n = 0; n < 2; ++n) _Pragma("unroll") for (int k = 0; k < 2; ++k) \
        acc[ai][bj][m][n] = __builtin_amdgcn_mfma_f32_16x16x32_bf16(Bt[n][k], At[m][k], acc[ai][bj][m][n], 0, 0, 0); __builtin_amdgcn_s_setprio(0); } while (0)
#define PG8_WAIT_V(n) asm volatile("s_waitcnt vmcnt(" #n ")" ::: "memory")
#define PG8_WAIT_L(n) asm volatile("s_waitcnt lgkmcnt(" #n ")" ::: "memory")
#define PG8_BAR __builtin_amdgcn_s_barrier()
#define PG8_SCHED __builtin_amdgcn_sched_barrier(0)
    Unit cur, nxt; int ui = 0;
    if (!S.next(0, cur)) return;
    f32x4 acc[2][2][4][2];
#pragma unroll
    for (int a = 0; a < 2; ++a)
#pragma unroll
        for (int b = 0; b < 2; ++b)
#pragma unroll
            for (int m = 0; m < 4; ++m)
#pragma unroll
                for (int n = 0; n < 2; ++n) acc[a][b][m][n] = (f32x4){0.f, 0.f, 0.f, 0.f};
    bf16x8 At[4][2], B0[2][2], B1[2][2];
    const char* cA = (const char*)g.A + (size_t)cur.pm * tstep; const char* cB = (const char*)g.Bt + (size_t)cur.pn * tstep;
    S.a_ready(cur);
    if constexpr (SP2) {
        PG8_STAGE(PG8_SB(0, 0), cB, voffB); PG8_STAGE(PG8_SB(0, 1), cB + hstep, voffB); PG8_STAGE(PG8_SA(0, 0), cA, voffA); PG8_STAGE(PG8_SA(0, 1), cA + hstep, voffA);
        if (wr == 1) PG8_BAR;
        PG8_WAIT_V(2); PG8_BAR;
        PG8_STAGE(PG8_SB(1, 0), cB + kstep, voffB); PG8_STAGE(PG8_SA(1, 0), cA + kstep, voffA); PG8_STAGE(PG8_SB(1, 1), cB + hstep + kstep, voffB);
        PG8_WAIT_V(6); PG8_BAR;
    } else {
        PG8_STAGE(PG8_SB(0, 0), cB, voffB); PG8_STAGE(PG8_SA(0, 0), cA, voffA); PG8_STAGE(PG8_SB(0, 1), cB + hstep, voffB); PG8_STAGE(PG8_SA(0, 1), cA + hstep, voffA);
        if (wr == 1) PG8_BAR;
        PG8_WAIT_V(4); PG8_BAR;
        PG8_STAGE(PG8_SB(1, 0), cB + kstep, voffB); PG8_STAGE(PG8_SA(1, 0), cA + kstep, voffA); PG8_STAGE(PG8_SB(1, 1), cB + hstep + kstep, voffB);
        PG8_WAIT_V(6); PG8_BAR;
    }
    for (;;) {
        const bool has_next = S.next(ui + 1, nxt);
        const char* nA = has_next ? (const char*)g.A + (size_t)nxt.pm * tstep : cA; const char* nB = has_next ? (const char*)g.Bt + (size_t)nxt.pn * tstep : cB;
        for (int t = 0; t < nt; t += 2) {
            const bool last = (t == nt - 2);
            const char* a1 = cA + (size_t)(t + 1) * kstep;
            const char* a2 = last ? nA : cA + (size_t)(t + 2) * kstep; const char* b2 = last ? nB : cB + (size_t)(t + 2) * kstep;
            const char* a3 = a2 + kstep; const char* b3 = b2 + kstep;
            if (last && has_next) S.a_ready(nxt);
            if constexpr (SP2) {
            PG8_LDB(B0, 0, 0); PG8_LDB(B1, 0, 1); PG8_SCHED; PG8_LDA(At, 0, 0); PG8_STAGE(PG8_SA(1, 1), a1 + hstep, voffA);
            PG8_WAIT_V(8); PG8_WAIT_L(0); PG8_BAR; PG8_MMA(0, 0, At, B0); PG8_MMA(0, 1, At, B1); PG8_BAR; PG8_SCHED;
            PG8_LDA(At, 0, 1); PG8_STAGE(PG8_SB(0, 0), b2, voffB); PG8_STAGE(PG8_SB(0, 1), b2 + hstep, voffB); PG8_STAGE(PG8_SA(0, 0), a2, voffA);
            PG8_WAIT_V(8); PG8_WAIT_L(0); PG8_BAR; PG8_MMA(1, 0, At, B0); PG8_MMA(1, 1, At, B1); PG8_BAR; PG8_SCHED;
            PG8_LDB(B0, 1, 0); PG8_LDB(B1, 1, 1); PG8_SCHED; PG8_LDA(At, 1, 0); PG8_STAGE(PG8_SA(0, 1), a2 + hstep, voffA);
            PG8_WAIT_V(8); PG8_WAIT_L(0); PG8_BAR; PG8_MMA(0, 0, At, B0); PG8_MMA(0, 1, At, B1); PG8_BAR; PG8_SCHED;
            PG8_LDA(At, 1, 1); PG8_STAGE(PG8_SB(1, 0), b3, voffB); PG8_STAGE(PG8_SB(1, 1), b3 + hstep, voffB); PG8_STAGE(PG8_SA(1, 0), a3, voffA);
            PG8_WAIT_V(8); PG8_WAIT_L(0); PG8_BAR; PG8_MMA(1, 0, At, B0); PG8_MMA(1, 1, At, B1); PG8_BAR; PG8_SCHED;
            } else {
            PG8_LDB(B0, 0, 0); PG8_SCHED; PG8_LDA(At, 0, 0); PG8_STAGE(PG8_SA(1, 1), a1 + hstep, voffA);
            PG8_WAIT_L(8); PG8_BAR; PG8_WAIT_L(0); PG8_MMA(0, 0, At, B0); PG8_BAR; PG8_SCHED;
            PG8_LDB(B1, 0, 1); PG8_STAGE(PG8_SB(0, 0), b2, voffB);
            PG8_BAR; PG8_WAIT_L(0); PG8_MMA(0, 1, At, B1); PG8_BAR;
            PG8_LDA(At, 0, 1); PG8_STAGE(PG8_SA(0, 0), a2, voffA);
            PG8_BAR; PG8_WAIT_L(0); PG8_MMA(1, 0, At, B0); PG8_BAR; PG8_SCHED;
            PG8_STAGE(PG8_SB(0, 1), b2 + hstep, voffB);
            PG8_WAIT_V(6); PG8_BAR; PG8_MMA(1, 1, At, B1); PG8_BAR;
            PG8_LDB(B0, 1, 0); PG8_SCHED; PG8_LDA(At, 1, 0); PG8_STAGE(PG8_SA(0, 1), a2 + hstep, voffA);
            PG8_WAIT_L(8); PG8_BAR; PG8_WAIT_L(0); PG8_MMA(0, 0, At, B0); PG8_BAR; PG8_SCHED;
            PG8_LDB(B1, 1, 1); PG8_STAGE(PG8_SB(1, 0), b3, voffB);
            PG8_BAR; PG8_WAIT_L(0); PG8_MMA(0, 1, At, B1); PG8_BAR;
            PG8_LDA(At, 1, 1); PG8_STAGE(PG8_SA(1, 0), a3, voffA);
            PG8_BAR; PG8_WAIT_L(0); PG8_MMA(1, 0, At, B0); PG8_BAR; PG8_SCHED;
            PG8_STAGE(PG8_SB(1, 1), b3 + hstep, voffB);
            PG8_WAIT_V(6); PG8_BAR; PG8_MMA(1, 1, At, B1); PG8_BAR;
            }
        }
        if constexpr (ALIGN_EPI) { if (wr == 0) PG8_BAR; }
        if constexpr (!Epi::AFTER_DRAIN) { for (int rep_ = 0; rep_ < 1 + (Epi::REP_EPI ? 1 : 0); ++rep_) E(acc, cur, wr, wc, fr, fq); S.done(cur); }
        if (!has_next) break;
#pragma unroll
        for (int a = 0; a < 2; ++a)
#pragma unroll
            for (int b = 0; b < 2; ++b)
#pragma unroll
                for (int m = 0; m < 4; ++m)
#pragma unroll
                    for (int n = 0; n < 2; ++n) acc[a][b][m][n] = (f32x4){0.f, 0.f, 0.f, 0.f};
        cur = nxt; cA = nA; cB = nB; ++ui;
        if constexpr (ALIGN_EPI) { if (wr == 1) PG8_BAR; }
    }
    PG8_WAIT_V(0);
    if constexpr (!ALIGN_EPI) { if (wr == 0) PG8_BAR; }
    PG8_BAR;
    if constexpr (Epi::AFTER_DRAIN) { E.fused(acc, cur, wr, wc, fr, fq, lds, wid, lane); S.done(cur); }
#undef PG8_SA
#undef PG8_SB
#undef PG8_STAGE
#undef PG8_LDA
#undef PG8_LDB
#undef PG8_MMA
#undef PG8_WAIT_V
#undef PG8_WAIT_L
#undef PG8_BAR
#undef PG8_SCHED
}
}

using pg8::bf16_t; using pg8::bf16x8; using pg8::f32x4; using pg8::u32x4; using pg8::Unit; using pg8::cvt_pk_bf16;
#define GAS __attribute__((address_space(1)))
#define LAS __attribute__((address_space(3)))
typedef unsigned u32x2 __attribute__((ext_vector_type(2)));
typedef short s16x4 __attribute__((ext_vector_type(4)));
typedef GAS unsigned gu32;
#define RLX_AGENT __ATOMIC_RELAXED, __HIP_MEMORY_SCOPE_AGENT

constexpr int NWAVES = 8;
constexpr int D = 1024, MP = 16384, MS = 128, SEQ = 2048, NBATCH = 8, NMEM = 256, MMEM = 2048, DEPTH = 4;
constexpr int NAB = 5120, NC = 8192;
constexpr float EPS = 1e-6f;
constexpr float QSCALE = 0.0625f * 1.4426950408889634f;

constexpr size_t O_Y = 0, O_YS = O_Y + (size_t)MP * D, O_POOLP = O_YS + (size_t)MS * D, O_POOLS = O_POOLP + 2 * 8 * 15 * 1024,
                 O_CONVP = O_POOLS + (size_t)2 * 128 * 15 * 1024, O_CONVS = O_CONVP + 2 * 8 * 2 * 2048, O_SGUV = O_CONVS + (size_t)2 * 128 * 2 * 2048,
                 O_MEMK = O_SGUV + 2 * 128 * 1024, O_MEMV = O_MEMK + (size_t)4 * MMEM * D, O_END = O_MEMV + (size_t)4 * MMEM * D;
static_assert(O_END == 39239680, "output size");

constexpr size_t MiB = 1u << 20;
constexpr size_t WS_CTL = 0, CTL_ZERO_BYTES = 1 * MiB;
constexpr size_t WS_AB1 = 2 * MiB, WS_C1 = 22 * MiB, WS_AB2 = 54 * MiB, WS_C2 = 62 * MiB, WS_WQ = 70 * MiB, WS_WKV = 78 * MiB, WS_WO = 94 * MiB, WS_PMT = 102 * MiB;
constexpr size_t WS_XB = 104 * MiB;
constexpr size_t WS_RSQ = 137 * MiB, WS_VSQ = 138 * MiB;
constexpr size_t WS_SMALL = 139 * MiB;
constexpr size_t WS_Z = 140 * MiB;
constexpr size_t WS_A2 = 268 * MiB;
constexpr size_t WS_Q = 332 * MiB, WS_O = 364 * MiB;
constexpr size_t WS_MEMB = 396 * MiB, WS_KB = 400 * MiB, WS_VB = 416 * MiB;
constexpr size_t WS_XS = 432 * MiB, WS_SZ = 433 * MiB, WS_SA2 = 437 * MiB, WS_SQ = 438 * MiB, WS_SO = 439 * MiB, WS_SIDE = 440 * MiB  , WS_END = 444 * MiB;
constexpr int CW_BAR = 4096;

constexpr int RING_BYTES = 131072, LDSCTL_OFF = RING_BYTES, MISC_OFF = LDSCTL_OFF + 320, HALO_OFF = RING_BYTES + 1024  , LDS_BYTES = 147456;

#define LDS_WAIT() asm volatile("s_waitcnt lgkmcnt(0)" ::: "memory")

#define XB_TMO      128
#define XB_XCNT(j)  (256  + 64 * (j))
#define XB_XSUB(j)  (1280 + 64 * (j))
#define XB_XGEN(j)  (2304 + 64 * (j))
#define XB_TOP      3328
#define XB_TOPGEN   3392
#define XCD_BAR_WORDS 3456
#define XB_SPIN_CAP (1u << 18)

__device__ __forceinline__ unsigned xb_ld(unsigned* p)              { return __hip_atomic_load(p, __ATOMIC_RELAXED, __HIP_MEMORY_SCOPE_AGENT); }
__device__ __forceinline__ unsigned xb_add(unsigned* p, unsigned v) { return __hip_atomic_fetch_add(p, v, __ATOMIC_RELAXED, __HIP_MEMORY_SCOPE_AGENT); }
__device__ __forceinline__ unsigned xb_xcc_id() { return (unsigned)__builtin_amdgcn_s_getreg((3 << 11) | 20) & 0xFu; }
#define XB_SPIN(cond, bar) do { unsigned _sp = 0; while (cond) { __builtin_amdgcn_s_sleep(1); \
    if ((++_sp & 255u) == 0u) { if (xb_ld(&(bar)[XB_TMO])) break; if (_sp > XB_SPIN_CAP) { atomicAdd(&(bar)[XB_TMO], 1u); break; } } } } while (0)

struct XcdBarrier {
    unsigned* bar; unsigned x;
    volatile LAS unsigned* st;
};

__device__ __forceinline__ XcdBarrier xcd_barrier_post(unsigned* bar, volatile LAS unsigned* st) {
    XcdBarrier b; b.bar = bar; b.x = xb_xcc_id(); b.st = st;
    if (threadIdx.x == 0) (void)xb_add(&bar[XB_XCNT(b.x)], 1u);
    return b;
}
__device__ __forceinline__ void xcd_barrier_complete(unsigned* bar, unsigned x, unsigned& nloc, unsigned& nx) {
    const unsigned G = gridDim.x * gridDim.y * gridDim.z;
    unsigned sum, cnt, mine, sp = 0u;
    for (;;) {
        sum = 0u; cnt = 0u; mine = 0u;
#pragma unroll
        for (unsigned j = 0; j < 16; ++j) { const unsigned c = xb_ld(&bar[XB_XCNT(j)]); sum += c; cnt += (c > 0u) ? 1u : 0u; mine = (j == x) ? c : mine; }
        if (sum == G) break;
        __builtin_amdgcn_s_sleep(1);
        if ((++sp & 255u) == 0u) { if (xb_ld(&bar[XB_TMO])) break; if (sp > XB_SPIN_CAP) { atomicAdd(&bar[XB_TMO], 1u); break; } }
    }
    nloc = mine > 0u ? mine : 1u; nx = cnt > 0u ? cnt : 1u;
}

__device__ __forceinline__ void xcd_barrier(const XcdBarrier& b) {
    asm volatile("s_waitcnt vmcnt(0)" ::: "memory");
    __syncthreads();
    if (threadIdx.x == 0) {
        unsigned* bar = b.bar;
        __builtin_amdgcn_s_waitcnt(0);
        unsigned nloc = b.st[0], nx = b.st[1];
        if (nloc == 0u) { xcd_barrier_complete(bar, b.x, nloc, nx); b.st[0] = nloc; b.st[1] = nx; }
        const unsigned old = xb_add(&bar[XB_XSUB(b.x)], 1u);
        const unsigned gen = old / nloc;
        if (old + 1u == (gen + 1u) * nloc) {
            __builtin_amdgcn_fence(__ATOMIC_RELEASE, "agent");
            asm volatile("s_waitcnt vmcnt(0)" ::: "memory");
            const unsigned og = xb_add(&bar[XB_TOP], 1u);
            const unsigned tg = og / nx;
            if (og + 1u == (tg + 1u) * nx) xb_add(&bar[XB_TOPGEN], 1u);
            else XB_SPIN(xb_ld(&bar[XB_TOPGEN]) == tg, bar);
            __builtin_amdgcn_fence(__ATOMIC_ACQUIRE, "agent");
            xb_add(&bar[XB_XGEN(b.x)], 1u);
            asm volatile("s_waitcnt vmcnt(0)" ::: "memory");
        } else {
            XB_SPIN(xb_ld(&bar[XB_XGEN(b.x)]) == gen, bar);
            __builtin_amdgcn_fence(__ATOMIC_ACQUIRE, "agent");
            asm volatile("s_waitcnt vmcnt(0)" ::: "memory");
        }
    }
    __syncthreads();
}

typedef const float* fptr_t;
typedef __attribute__((address_space(4))) const fptr_t* in_tab_t;
struct Frame {
    LAS unsigned char* lds;
    int tid, lane, wave, G, bx;
    in_tab_t in;
    float* out;
    unsigned char* ws;
};
__device__ __forceinline__ unsigned long long uni64(unsigned long long v) { const unsigned lo = __builtin_amdgcn_readfirstlane((unsigned)v), hi = __builtin_amdgcn_readfirstlane((unsigned)(v >> 32)); return ((unsigned long long)hi << 32) | lo; }
__device__ __forceinline__ Frame launder(const Frame& F0) {
    Frame F = F0;
    int g_ = __builtin_amdgcn_readfirstlane(F0.G), b_ = __builtin_amdgcn_readfirstlane(F0.bx);
    unsigned long long w_ = uni64((unsigned long long)F0.ws), o_ = uni64((unsigned long long)F0.out), i_ = uni64((unsigned long long)F0.in);
    asm volatile("" : "+v"(F.tid), "+s"(g_), "+s"(b_), "+s"(w_), "+s"(o_), "+s"(i_));
    F.G = g_; F.bx = b_; F.ws = (unsigned char*)(GAS unsigned char*)w_; F.out = (float*)(GAS float*)o_; F.in = (in_tab_t)i_;
    F.lane = F.tid & 63; F.wave = __builtin_amdgcn_readfirstlane(F.tid >> 6);
    return F;
}
#define FIN(k) ((const float*)(const GAS float*)(F.in[k]))


__device__ __forceinline__ float wave_sum(float v) {
#pragma unroll
    for (int o = 1; o < 64; o <<= 1) v += __shfl_xor(v, o);
    return v;
}
__device__ __forceinline__ float silu_f(float x) { return x * __builtin_amdgcn_rcpf(1.f + __builtin_amdgcn_exp2f(-1.4426950408889634f * x)); }
__device__ __forceinline__ f32x4 silu4(f32x4 v) { return (f32x4){silu_f(v[0]), silu_f(v[1]), silu_f(v[2]), silu_f(v[3])}; }
__device__ __forceinline__ float dot4(f32x4 a, f32x4 b) { return (a[0] * b[0] + a[1] * b[1]) + (a[2] * b[2] + a[3] * b[3]); }
__device__ __forceinline__ u32x4 pack8(f32x4 a, f32x4 b) { u32x4 w; w.x = cvt_pk_bf16(a[0], a[1]); w.y = cvt_pk_bf16(a[2], a[3]); w.z = cvt_pk_bf16(b[0], b[1]); w.w = cvt_pk_bf16(b[2], b[3]); return w; }
__device__ __forceinline__ u32x2 pack4(f32x4 a) { u32x2 w; w.x = cvt_pk_bf16(a[0], a[1]); w.y = cvt_pk_bf16(a[2], a[3]); return w; }
__device__ __forceinline__ float bflo(unsigned w) { return __uint_as_float(w << 16); }
__device__ __forceinline__ float bfhi(unsigned w) { return __uint_as_float(w & 0xffff0000u); }
__device__ __forceinline__ void unpack8(u32x4 w, f32x4& a, f32x4& b) { a = (f32x4){bflo(w.x), bfhi(w.x), bflo(w.y), bfhi(w.y)}; b = (f32x4){bflo(w.z), bfhi(w.z), bflo(w.w), bfhi(w.w)}; }
__device__ __forceinline__ f32x4 unpack4(u32x2 w) { return (f32x4){bflo(w.x), bfhi(w.x), bflo(w.y), bfhi(w.y)}; }
__device__ __forceinline__ float rstd16(const float* p) {
    const f32x4 a = ((const f32x4*)p)[0], b = ((const f32x4*)p)[1], c = ((const f32x4*)p)[2], d = ((const f32x4*)p)[3];
    const f32x4 s = (a + b) + (c + d);
    return rsqrtf(((s[0] + s[1]) + (s[2] + s[3])) * (1.0f / D) + EPS);
}
__device__ __forceinline__ float rstd32(const float* p) {
    f32x4 s = ((const f32x4*)p)[0];
#pragma unroll
    for (int i = 1; i < 8; ++i) s += ((const f32x4*)p)[i];
    return rsqrtf(((s[0] + s[1]) + (s[2] + s[3])) * (1.0f / D) + EPS);
}
__host__ __device__ __forceinline__ int src_even(int n) {
    const int tile = n >> 8, o = n & 255;
    if (tile < 8) return n;
    if (tile < 12) return 3072 + (n - 2048);
    const int cb = tile - 12;
    return o < 128 ? 2048 + 128 * cb + o : 4096 + 128 * cb + (o - 128);
}
__host__ __device__ __forceinline__ int src_odd(int n) {
    const int pn = n >> 8, p = n & 255, q = ((p >> 7) << 1) | ((p >> 2) & 1), ch = 64 * pn + 16 * ((p >> 5) & 3) + 4 * ((p >> 3) & 3) + (p & 3);
    const int base = q == 0 ? 2048 : (q == 1 ? 4096 : (q == 2 ? 0 : 6144));
    return base + ch;
}

struct EpiG1Even {
    static constexpr bool PERM = true, AFTER_DRAIN = false, REP_EPI = (REP_MASK >> 12) & 1;
    const float* rsq; bf16_t* Z; float* vsq; float* pool_out;
    __device__ __forceinline__ void operator()(const f32x4 (&acc)[2][2][4][2], const Unit& u, int wr, int wc, int fr_, int fq_) const {
        int fr = fr_, fq = fq_; asm volatile("" : "+v"(fr), "+v"(fq));
        const int tile = u.pn, cw = wc * 32 + 8 * fq;
#pragma unroll
        for (int ai = 0; ai < 2; ++ai)
#pragma unroll
            for (int m = 0; m < 4; ++m) {
                const int row = u.pm * 256 + ai * 128 + wr * 64 + m * 16 + fr;
                const float rs = rstd16(rsq + (size_t)row * 16);
                if (tile < 12) {
                    const int kind = tile >> 2;
                    bf16_t* dst = Z + (size_t)kind * MP * D + (size_t)row * D + (tile & 3) * 256 + cw;
                    float ss = 0.f;
#pragma unroll
                    for (int bj = 0; bj < 2; ++bj) {
                        f32x4 v0 = acc[ai][bj][m][0] * rs, v1 = acc[ai][bj][m][1] * rs;
                        if (kind == 1) { v0 = silu4(v0); v1 = silu4(v1); }
                        if (kind == 2) ss += dot4(v0, v0) + dot4(v1, v1);
                        *(u32x4*)(dst + bj * 128) = pack8(v0, v1);
                        if (kind == 0 && (row & 2047) >= 2033) {
                            float* po = pool_out + ((size_t)(row >> 11) * 15 + ((row & 2047) - 2033)) * 1024 + (tile & 3) * 256 + bj * 128 + cw;
                            *(f32x4*)po = v0; *(f32x4*)(po + 4) = v1;
                        }
                    }
                    if (kind == 2) { ss += __shfl_xor(ss, 16); ss += __shfl_xor(ss, 32); if (fq == 0) vsq[(size_t)row * 16 + (tile - 8) * 4 + wc] = ss; }
                } else {
                    const int cb = tile - 12;
                    bf16_t* dst = Z + (size_t)3 * MP * D + (size_t)row * D + cb * 128 + cw;
                    const f32x4 u0 = acc[ai][0][m][0] * rs, u1 = acc[ai][0][m][1] * rs, g0 = acc[ai][1][m][0] * rs, g1 = acc[ai][1][m][1] * rs;
                    *(u32x4*)dst = pack8(u0 * silu4(g0), u1 * silu4(g1));
                }
            }
    }
};
__device__ __forceinline__ float dpp_shr1(float old, float v) { return __builtin_bit_cast(float, __builtin_amdgcn_update_dpp(__builtin_bit_cast(int, old), __builtin_bit_cast(int, v), 0x111, 0xf, 0xf, false)); }
__device__ __forceinline__ float dpp_shr2(float old, float v) { return __builtin_bit_cast(float, __builtin_amdgcn_update_dpp(__builtin_bit_cast(int, old), __builtin_bit_cast(int, v), 0x112, 0xf, 0xf, false)); }
struct EpiG1Odd {
    static constexpr bool PERM = true, AFTER_DRAIN = false, REP_EPI = false;
    const float* rsq; bf16_t* A2; const float* cw; float* conv_out; float* side; LAS float* halo;
    __device__ __forceinline__ void operator()(const f32x4 (&acc)[2][2][4][2], const Unit& u, int wr, int wc, int fr_, int fq_) const {
        int fr = fr_, fq = fq_; asm volatile("" : "+v"(fr), "+v"(fq));
        const int chl = wc * 16 + 4 * fq, ch = u.pn * 64 + chl;
        const f32x4 w0 = *(const f32x4*)(cw + ch), w1 = *(const f32x4*)(cw + 2048 + ch), w2 = *(const f32x4*)(cw + 4096 + ch);
        f32x4 e[2][4]; float rsv[2][4];
#pragma unroll
        for (int ai = 0; ai < 2; ++ai)
#pragma unroll
            for (int m = 0; m < 4; ++m) {
                const int rb = 8 * ai + 4 * wr + m, row = u.pm * 256 + 16 * rb + fr;
                const float rs = rstd16(rsq + (size_t)row * 16); rsv[ai][m] = rs;
                e[ai][m] = (acc[ai][0][m][0] * rs) * (acc[ai][0][m][1] * rs);
                if (fr >= 14) *(LAS f32x4*)(halo + (rb * 2 + (fr - 14)) * 64 + chl) = e[ai][m];
                if (m & 1) asm volatile("" ::: "memory");
            }
        asm volatile("s_waitcnt lgkmcnt(0)" ::: "memory"); __builtin_amdgcn_s_barrier(); asm volatile("" ::: "memory");
        float* sd = side + (size_t)u.pm * 6 * 2048 + ch;
#pragma unroll
        for (int ai = 0; ai < 2; ++ai)
#pragma unroll
            for (int m = 0; m < 4; ++m) {
                const int rb = 8 * ai + 4 * wr + m, row = u.pm * 256 + 16 * rb + fr;
                const float rs = rsv[ai][m];
                const f32x4 sg = (acc[ai][1][m][0] * rs) * silu4(acc[ai][1][m][1] * rs);
                f32x4 h0 = (f32x4){0.f, 0.f, 0.f, 0.f}, h1 = h0;
                if (rb > 0) { h0 = *(const LAS f32x4*)(halo + ((rb - 1) * 2 + 0) * 64 + chl); h1 = *(const LAS f32x4*)(halo + ((rb - 1) * 2 + 1) * 64 + chl); }
                const f32x4 hx = fr == 0 ? h0 : h1, ev = e[ai][m];
                f32x4 e1, e2;
#pragma unroll
                for (int k = 0; k < 4; ++k) { e1[k] = dpp_shr1(h1[k], ev[k]); e2[k] = dpp_shr2(hx[k], ev[k]); }
                const f32x4 a = sg * (w0 * e2 + w1 * e1 + w2 * ev);
                const bool top = (rb == 0 && fr < 2);
                if (!(top && (u.pm & 7) != 0)) *(u32x2*)(A2 + (size_t)row * 2048 + ch) = pack4(a);
                if (top) { *(f32x4*)(sd + fr * 2048) = ev; *(f32x4*)(sd + (4 + fr) * 2048) = sg; }
                if (rb == 15 && fr >= 14) {
                    *(f32x4*)(sd + (2 + fr - 14) * 2048) = ev;
                    if ((u.pm & 7) == 7) *(f32x4*)(conv_out + ((size_t)(u.pm >> 3) * 2 + (fr - 14)) * 2048 + ch) = ev;
                }
            }
    }
};
__device__ __forceinline__ void conv_fixup(const float* side, const float* cw, bf16_t* A2, int pm, int tid) {
    if ((pm & 7) == 0) return;
    const int ch = 4 * tid;
    const float* sp = side + (size_t)(pm - 1) * 6 * 2048 + ch; const float* sc = side + (size_t)pm * 6 * 2048 + ch;
    const f32x4 em2 = *(const f32x4*)(sp + 2 * 2048), em1 = *(const f32x4*)(sp + 3 * 2048), e0 = *(const f32x4*)sc, e1 = *(const f32x4*)(sc + 2048), s0 = *(const f32x4*)(sc + 4 * 2048), s1 = *(const f32x4*)(sc + 5 * 2048);
    const f32x4 w0 = *(const f32x4*)(cw + ch), w1 = *(const f32x4*)(cw + 2048 + ch), w2 = *(const f32x4*)(cw + 4096 + ch);
    *(u32x2*)(A2 + (size_t)(pm * 256) * 2048 + ch) = pack4(s0 * (w0 * em2 + w1 * em1 + w2 * e0));
    *(u32x2*)(A2 + (size_t)(pm * 256 + 1) * 2048 + ch) = pack4(s1 * (w0 * em1 + w1 * e0 + w2 * e1));
}
struct EpiRes {
    static constexpr bool PERM = true, AFTER_DRAIN = false, REP_EPI = false;
    const float* base; float* out; bf16_t* xb; float* rsq;
    __device__ __forceinline__ void operator()(const f32x4 (&acc)[2][2][4][2], const Unit& u, int wr, int wc, int fr_, int fq_) const {
        int fr = fr_, fq = fq_; asm volatile("" : "+v"(fr), "+v"(fq));
        const int cw = wc * 32 + 8 * fq;
#pragma unroll
        for (int ai = 0; ai < 2; ++ai)
#pragma unroll
            for (int m = 0; m < 4; ++m) {
                const int row = u.pm * 256 + ai * 128 + wr * 64 + m * 16 + fr;
                float ss = 0.f;
#pragma unroll
                for (int bj = 0; bj < 2; ++bj) {
                    const size_t off = (size_t)row * D + u.pn * 256 + bj * 128 + cw;
                    const f32x4 o0 = *(const f32x4*)(base + off) + acc[ai][bj][m][0], o1 = *(const f32x4*)(base + off + 4) + acc[ai][bj][m][1];
                    *(f32x4*)(out + off) = o0; *(f32x4*)(out + off + 4) = o1;
                    *(u32x4*)(xb + off) = pack8(o0, o1);
                    ss += dot4(o0, o0) + dot4(o1, o1);
                }
                ss += __shfl_xor(ss, 16); ss += __shfl_xor(ss, 32);
                if (fq == 0) rsq[(size_t)row * 16 + u.pn * 4 + wc] = ss;
                asm volatile("" ::: "memory");
            }
    }
};
struct EpiQ {
    static constexpr bool PERM = true, AFTER_DRAIN = false, REP_EPI = false;
    const float* rsq; bf16_t* Q;
    __device__ __forceinline__ void operator()(const f32x4 (&acc)[2][2][4][2], const Unit& u, int wr, int wc, int fr_, int fq_) const {
        int fr = fr_, fq = fq_; asm volatile("" : "+v"(fr), "+v"(fq));
        const int cw = wc * 32 + 8 * fq;
#pragma unroll
        for (int ai = 0; ai < 2; ++ai)
#pragma unroll
            for (int m = 0; m < 4; ++m) {
                const int row = u.pm * 256 + ai * 128 + wr * 64 + m * 16 + fr;
                const float rs = rstd16(rsq + (size_t)row * 16);
#pragma unroll
                for (int bj = 0; bj < 2; ++bj) *(u32x4*)(Q + (size_t)row * D + u.pn * 256 + bj * 128 + cw) = pack8(acc[ai][bj][m][0] * rs, acc[ai][bj][m][1] * rs);
            }
    }
};
struct EpiMemKV {
    static constexpr bool PERM = true, AFTER_DRAIN = false, REP_EPI = false;
    const float* rstdm; float* outk; float* outv; bf16_t* kb; bf16_t* vb;
    __device__ __forceinline__ void operator()(const f32x4 (&acc)[2][2][4][2], const Unit& u, int wr, int wc, int fr_, int fq_) const {
        int fr = fr_, fq = fq_; asm volatile("" : "+v"(fr), "+v"(fq));
        const int layer = u.pn >> 3, isv = (u.pn >> 2) & 1, cw = (u.pn & 3) * 256 + wc * 32 + 8 * fq;
        float* of = (isv ? outv : outk) + (size_t)layer * MMEM * D; bf16_t* ob = (isv ? vb : kb) + (size_t)layer * MMEM * D;
#pragma unroll
        for (int ai = 0; ai < 2; ++ai)
#pragma unroll
            for (int m = 0; m < 4; ++m) {
                const int row = u.pm * 256 + ai * 128 + wr * 64 + m * 16 + fr;
                const float rs = rstdm[row];
#pragma unroll
                for (int bj = 0; bj < 2; ++bj) {
                    const size_t off = (size_t)row * D + bj * 128 + cw;
                    const f32x4 v0 = acc[ai][bj][m][0] * rs, v1 = acc[ai][bj][m][1] * rs;
                    *(f32x4*)(of + off) = v0; *(f32x4*)(of + off + 4) = v1;
                    *(u32x4*)(ob + off) = pack8(v0, v1);
                }
            }
    }
};

__device__ __forceinline__ void p0_tr_item(const float* W, int ldw, int k0, int srccol, const float* gk, float sc, bf16_t* WT, int K, int dstn0, LAS float* scr, int lane) {
    float v[32];
    const float* wp = W + (size_t)(k0 + (lane >> 5)) * ldw + srccol;
#pragma unroll
    for (int i = 0; i < 32; ++i) v[i] = wp[(size_t)(2 * i) * ldw];
#pragma unroll
    for (int i = 0; i < 32; ++i) scr[(2 * i + (lane >> 5)) * 33 + (lane & 31)] = v[i];
    LDS_WAIT(); asm volatile("" ::: "memory");
    const int c = lane & 7;
    f32x4 g0 = (f32x4){sc, sc, sc, sc}, g1 = g0;
    if (gk) { g0 = *(const f32x4*)(gk + k0 + 8 * c) * sc; g1 = *(const f32x4*)(gk + k0 + 8 * c + 4) * sc; }
#pragma unroll
    for (int jj = 0; jj < 4; ++jj) {
        const int n = (lane >> 3) + 8 * jj; const LAS float* s = scr + (8 * c) * 33 + n;
        u32x4 o; o.x = cvt_pk_bf16(s[0 * 33] * g0[0], s[1 * 33] * g0[1]); o.y = cvt_pk_bf16(s[2 * 33] * g0[2], s[3 * 33] * g0[3]); o.z = cvt_pk_bf16(s[4 * 33] * g1[0], s[5 * 33] * g1[1]); o.w = cvt_pk_bf16(s[6 * 33] * g1[2], s[7 * 33] * g1[3]);
        *(u32x4*)(WT + (size_t)(dstn0 + n) * K + k0 + 8 * c) = o;
    }
    LDS_WAIT(); asm volatile("" ::: "memory");
}
__device__ __forceinline__ void p0_tr_matrix(const float* W, int ldw, int K, int Nd, const float* gk, float sc, bf16_t* WT, int perm, int r, LAS float* scr, int lane) {
    const int nblk = Nd / 32, kb = r / nblk, nb = r % nblk, dstn0 = 32 * nb, dn = dstn0 + (lane & 31);
    const int srccol = perm == 0 ? dn : (perm == 1 ? src_even(dn) : src_odd(dn));
    p0_tr_item(W, ldw, 64 * kb, srccol, gk, sc, WT, K, dstn0, scr, lane);
}
__device__ __forceinline__ float p0_row(const float* src, bf16_t* dst, float* copy, int lane) {
    const f32x4* xr = (const f32x4*)src + lane;
    f32x4 v[4]; float s = 0.f;
#pragma unroll
    for (int jj = 0; jj < 4; ++jj) { v[jj] = xr[64 * jj]; s += dot4(v[jj], v[jj]); }
    s = wave_sum(s);
    u32x2* o8 = (u32x2*)dst + lane;
#pragma unroll
    for (int jj = 0; jj < 4; ++jj) o8[64 * jj] = pack4(v[jj]);
    if (copy) {
#pragma unroll
        for (int jj = 0; jj < 4; ++jj) ((f32x4*)copy + lane)[64 * jj] = v[jj];
    }
    return s;
}
__device__ __forceinline__ void p0_prologue(Frame& F0) {
    Frame F = launder(F0);
    LAS float* scr = (LAS float*)(F.lds + F.wave * 16384);
    const int gw = F.bx * NWAVES + F.wave, NGW = F.G * NWAVES, lane = F.lane;
    constexpr int I_AB1 = 16 * (NAB / 32), I_C1 = 16 * (NC / 32), I_2 = 32 * 32, I_SQ = 16 * 32, I_PM = 4 * 8;
    constexpr int NITEMS = 2 * I_AB1 + 2 * I_C1 + 4 * I_2 + 16 * I_SQ + 8 * I_PM;
    for (int it = gw; it < NITEMS; it += NGW) {
        int r = it;
        if (r < 2 * I_AB1) { const int jj = r / I_AB1; p0_tr_matrix(FIN(10) + (size_t)jj * D * NAB, NAB, D, NAB, FIN(7) + 2 * jj * D, 1.f, ((bf16_t*)(F.ws + WS_AB1)) + (size_t)jj * NAB * D, 1, r % I_AB1, scr, lane); continue; } r -= 2 * I_AB1;
        if (r < 2 * I_C1) { const int jj = r / I_C1; p0_tr_matrix(FIN(17) + (size_t)jj * D * NC, NC, D, NC, FIN(7) + (2 * jj + 1) * D, 1.f, ((bf16_t*)(F.ws + WS_C1)) + (size_t)jj * NC * D, 2, r % I_C1, scr, lane); continue; } r -= 2 * I_C1;
        if (r < 2 * I_2) { const int jj = r / I_2; p0_tr_matrix(FIN(16) + (size_t)jj * 2048 * D, D, 2048, D, nullptr, 1.f, ((bf16_t*)(F.ws + WS_AB2)) + (size_t)jj * D * 2048, 0, r % I_2, scr, lane); continue; } r -= 2 * I_2;
        if (r < 2 * I_2) { const int jj = r / I_2; p0_tr_matrix(FIN(19) + (size_t)jj * 2048 * D, D, 2048, D, nullptr, 1.f, ((bf16_t*)(F.ws + WS_C2)) + (size_t)jj * D * 2048, 0, r % I_2, scr, lane); continue; } r -= 2 * I_2;
        if (r < 4 * I_SQ) { const int l = r / I_SQ; p0_tr_matrix(FIN(20) + (size_t)l * D * D, D, D, D, FIN(8) + l * D, QSCALE, ((bf16_t*)(F.ws + WS_WQ)) + (size_t)l * D * D, 0, r % I_SQ, scr, lane); continue; } r -= 4 * I_SQ;
        if (r < 4 * I_SQ) { const int l = r / I_SQ; p0_tr_matrix(FIN(21) + (size_t)l * D * D, D, D, D, FIN(9) + l * D, 1.f, ((bf16_t*)(F.ws + WS_WKV)) + (size_t)(2 * l) * D * D, 0, r % I_SQ, scr, lane); continue; } r -= 4 * I_SQ;
        if (r < 4 * I_SQ) { const int l = r / I_SQ; p0_tr_matrix(FIN(22) + (size_t)l * D * D, D, D, D, FIN(9) + l * D, 1.f, ((bf16_t*)(F.ws + WS_WKV)) + (size_t)(2 * l + 1) * D * D, 0, r % I_SQ, scr, lane); continue; } r -= 4 * I_SQ;
        if (r < 4 * I_SQ) { const int l = r / I_SQ; p0_tr_matrix(FIN(23) + (size_t)l * D * D, D, D, D, nullptr, 1.f, ((bf16_t*)(F.ws + WS_WO)) + (size_t)l * D * D, 0, r % I_SQ, scr, lane); continue; } r -= 4 * I_SQ;
        { const int jg = r / I_PM; p0_tr_matrix(FIN(11) + (size_t)jg * 65536, 256, 256, 256, nullptr, 1.f, ((bf16_t*)(F.ws + WS_PMT)) + (size_t)jg * 65536, 0, r % I_PM, scr, lane); }
    }
    for (int m = gw; m < MP + MS + MMEM; m += NGW) {
        if (m < MP) {
            const float s = p0_row(FIN(0) + (size_t)m * D, ((bf16_t*)(F.ws + WS_XB)) + (size_t)m * D, nullptr, lane);
            if (lane < 16) ((float*)(F.ws + WS_RSQ))[(size_t)m * 16 + lane] = lane == 0 ? s : 0.f;
        } else if (m < MP + MS) {
            const int b = m - MP;
            const float s = p0_row(FIN(1) + (size_t)b * D, ((bf16_t*)(F.ws + WS_XB)) + (size_t)m * D, ((float*)(F.ws + WS_XS)) + (size_t)b * D, lane);
            if (lane < 32) ((float*)(F.ws + WS_SMALL))[b * 32 + lane] = lane == 0 ? s : 0.f;
        } else {
            const int t = m - MP - MS;
            const float s = p0_row(FIN(2) + (size_t)t * D, ((bf16_t*)(F.ws + WS_MEMB)) + (size_t)t * D, nullptr, lane);
            if (lane == 0) ((float*)(F.ws + WS_SMALL + 65536))[t] = rsqrtf(s * (1.0f / D) + EPS);
        }
    }
}

__device__ __forceinline__ bf16x8 tr_frag(LAS unsigned char* p0, LAS unsigned char* p1) {
    const s16x4 lo = __builtin_amdgcn_ds_read_tr16_b64_v4i16((LAS s16x4*)p0);
    const s16x4 hi = __builtin_amdgcn_ds_read_tr16_b64_v4i16((LAS s16x4*)p1);
    return (bf16x8){lo[0], lo[1], lo[2], lo[3], hi[0], hi[1], hi[2], hi[3]};
}
#define MFMA16(a, b, c) __builtin_amdgcn_mfma_f32_16x16x32_bf16((a), (b), (c), 0, 0, 0)

constexpr int SGU_AS = 0, SGU_VS = 34816, SGU_RV = 34816 + 67584;
__device__ __forceinline__ void sgu_unit(Frame& F0, int j, int n, int g) {
    Frame F = launder(F0);
    LAS unsigned char* lds = F.lds;
    const int tid = F.tid, lane = F.lane, w = F.wave, fr = lane & 15, fq = lane >> 4, row0 = n * 128;
    LAS float* rvs = (LAS float*)(lds + SGU_RV);
    if (tid < 128) rvs[tid] = rstd16(((float*)(F.ws + WS_VSQ)) + (size_t)(row0 + tid) * 16);
    const bf16_t* ZV = ((bf16_t*)(F.ws + WS_Z)) + (size_t)2 * MP * D;
#pragma unroll
    for (int i = 0; i < 8; ++i) {
        const int idx = tid + 512 * i, s = idx >> 5, c8 = idx & 31;
        *(LAS u32x4*)(lds + SGU_VS + s * 528 + c8 * 16) = *(const u32x4*)(ZV + (size_t)(row0 + s) * D + g * 256 + c8 * 8);
    }
    __syncthreads();
    const float* wg = FIN(13) + (size_t)(j * 4 + g) * 16384;
#pragma unroll
    for (int i = 0; i < 4; ++i) {
        const int idx = tid + 512 * i, t = idx >> 4, s0 = (idx & 15) * 8;
        const f32x4 a = *(const f32x4*)(wg + t * 128 + s0), b = *(const f32x4*)(wg + t * 128 + s0 + 4);
        float v[8];
#pragma unroll
        for (int e = 0; e < 4; ++e) { v[e] = (s0 + e <= t) ? a[e] * rvs[s0 + e] : 0.f; v[4 + e] = (s0 + 4 + e <= t) ? b[e] * rvs[s0 + 4 + e] : 0.f; }
        u32x4 o; o.x = cvt_pk_bf16(v[0], v[1]); o.y = cvt_pk_bf16(v[2], v[3]); o.z = cvt_pk_bf16(v[4], v[5]); o.w = cvt_pk_bf16(v[6], v[7]);
        *(LAS u32x4*)(lds + SGU_AS + t * 272 + s0 * 2) = o;
    }
    __syncthreads();
    f32x4 acc[8][2];
#pragma unroll
    for (int mt = 0; mt < 8; ++mt) { acc[mt][0] = (f32x4){0.f, 0.f, 0.f, 0.f}; acc[mt][1] = (f32x4){0.f, 0.f, 0.f, 0.f}; }
#pragma unroll
    for (int ks = 0; ks < 4; ++ks) {
        bf16x8 Bf[2];
#pragma unroll
        for (int nt = 0; nt < 2; ++nt) {
            LAS unsigned char* p = lds + SGU_VS + (32 * ks + 8 * fq + (fr >> 2)) * 528 + (32 * w + 16 * nt + 4 * (fr & 3)) * 2;
            Bf[nt] = tr_frag(p, p + 4 * 528);
        }
#pragma unroll
        for (int mt = 0; mt < 8; ++mt) {
            if (32 * ks <= 16 * mt + 15) {
                const bf16x8 Af = *(LAS bf16x8*)(lds + SGU_AS + (16 * mt + fr) * 272 + (32 * ks + 8 * fq) * 2);
                acc[mt][0] = MFMA16(Bf[0], Af, acc[mt][0]); acc[mt][1] = MFMA16(Bf[1], Af, acc[mt][1]);
            }
        }
    }
    const bf16_t* ZUG = ((bf16_t*)(F.ws + WS_Z)) + (size_t)3 * MP * D;
#pragma unroll
    for (int nt = 0; nt < 2; ++nt) {
        const int c = g * 256 + 32 * w + 16 * nt + 4 * fq;
        const f32x4 gg = *(const f32x4*)(FIN(15) + j * 1024 + c);
#pragma unroll
        for (int mt = 0; mt < 8; ++mt) {
            const int t = 16 * mt + fr;
            const float bb = FIN(14)[(j * 4 + g) * 128 + t];
            const f32x4 ug = unpack4(*(const u32x2*)(ZUG + (size_t)(row0 + t) * D + c));
            *(u32x2*)(((bf16_t*)(F.ws + WS_A2)) + (size_t)(row0 + t) * 2048 + 1024 + c) = pack4(ug * (acc[mt][nt] * gg + bb));
        }
    }
    __syncthreads();
}
__device__ __forceinline__ void pool_unit(Frame& F0, int j, int n, int g) {
    Frame F = launder(F0);
    LAS unsigned char* lds = F.lds;
    const int tid = F.tid, lane = F.lane, w = F.wave, fr = lane & 15, fq = lane >> 4, row0 = n * 128;
    {
        const int cb = tid & 31, t0 = (tid >> 5) * 8, win = 2 << g, pos0 = (row0 & 2047) + t0;
        const bf16_t* xa = ((bf16_t*)(F.ws + WS_Z)) + (size_t)(row0 + t0) * D + g * 256 + cb * 8;
        f32x4 S0 = (f32x4){0.f, 0.f, 0.f, 0.f}, S1 = S0;
        for (int i = 1; i < win; ++i) if (pos0 - i >= 0) { f32x4 a, b; unpack8(*(const u32x4*)(xa - (size_t)i * D), a, b); S0 += a; S1 += b; }
#pragma unroll
        for (int r = 0; r < 8; ++r) {
            f32x4 a, b; unpack8(*(const u32x4*)(xa + (size_t)r * D), a, b); S0 += a; S1 += b;
            const int cnt = (pos0 + r + 1) < win ? (pos0 + r + 1) : win; const float ic = 1.0f / (float)cnt;
            *(LAS u32x4*)(lds + (t0 + r) * 528 + cb * 16) = pack8(S0 * ic - a, S1 * ic - b);
            if (pos0 + r - (win - 1) >= 0) { f32x4 c, d; unpack8(*(const u32x4*)(xa + ((ptrdiff_t)r - (win - 1)) * D), c, d); S0 -= c; S1 -= d; }
        }
    }
    __syncthreads();
    f32x4 acc[8][2];
#pragma unroll
    for (int mt = 0; mt < 8; ++mt) { acc[mt][0] = (f32x4){0.f, 0.f, 0.f, 0.f}; acc[mt][1] = (f32x4){0.f, 0.f, 0.f, 0.f}; }
    const bf16_t* pm = ((bf16_t*)(F.ws + WS_PMT)) + (size_t)(j * 4 + g) * 65536 + (size_t)(32 * w + fr) * 256 + 8 * fq;
#pragma unroll
    for (int ks = 0; ks < 8; ++ks) {
        const bf16x8 B0 = *(const bf16x8*)(pm + 32 * ks), B1 = *(const bf16x8*)(pm + 16 * 256 + 32 * ks);
#pragma unroll
        for (int mt = 0; mt < 8; ++mt) {
            const bf16x8 Af = *(LAS bf16x8*)(lds + (16 * mt + fr) * 528 + (32 * ks + 8 * fq) * 2);
            acc[mt][0] = MFMA16(B0, Af, acc[mt][0]); acc[mt][1] = MFMA16(B1, Af, acc[mt][1]);
        }
    }
    const bf16_t* ZSGA = ((bf16_t*)(F.ws + WS_Z)) + (size_t)1 * MP * D;
#pragma unroll
    for (int nt = 0; nt < 2; ++nt) {
        const int c = g * 256 + 32 * w + 16 * nt + 4 * fq;
        const f32x4 ps = *(const f32x4*)(FIN(12) + j * 1024 + c);
#pragma unroll
        for (int mt = 0; mt < 8; ++mt) {
            const int t = 16 * mt + fr;
            const f32x4 sg = unpack4(*(const u32x2*)(ZSGA + (size_t)(row0 + t) * D + c));
            *(u32x2*)(((bf16_t*)(F.ws + WS_A2)) + (size_t)(row0 + t) * 2048 + c) = pack4(acc[mt][nt] * ps * sg);
        }
    }
    __syncthreads();
}
constexpr int ATT_SLOT = 64 * 528;
__device__ __forceinline__ void attn_prompt(Frame& F0, int layer) {
    Frame F = launder(F0);
    LAS unsigned char* lds = F.lds;
    const int tid = F.tid, lane = F.lane, w = F.wave, fr = lane & 15, fq = lane >> 4;
    const bf16_t* Kl = ((bf16_t*)(F.ws + WS_KB)) + (size_t)layer * MMEM * D; const bf16_t* Vl = ((bf16_t*)(F.ws + WS_VB)) + (size_t)layer * MMEM * D;
    for (int unit = F.bx; unit < 512; unit += F.G) {
        const int bh = unit >> 4, b = bh >> 2, h = bh & 3, qb = unit & 15;
        const size_t rowq = (size_t)b * SEQ + qb * 128 + 16 * w + fr;
        bf16x8 Qf[8];
#pragma unroll
        for (int ks = 0; ks < 8; ++ks) Qf[ks] = *(const bf16x8*)(((bf16_t*)(F.ws + WS_Q)) + rowq * D + h * 256 + 32 * ks + 8 * fq);
        const bf16_t* kbase = Kl + (size_t)(b * 256) * D + h * 256; const bf16_t* vbase = Vl + (size_t)(b * 256) * D + h * 256;
        u32x4 st[4];
#define ATT_GLOAD(c) do { const bf16_t* src_ = ((c) < 4 ? kbase : vbase) + (size_t)(64 * ((c) & 3)) * D; _Pragma("unroll") for (int i_ = 0; i_ < 4; ++i_) { const int idx_ = tid + 512 * i_; st[i_] = *(const u32x4*)(src_ + (size_t)(idx_ >> 5) * D + (idx_ & 31) * 8); } } while (0)
#define ATT_LSTORE(slot) do { _Pragma("unroll") for (int i_ = 0; i_ < 4; ++i_) { const int idx_ = tid + 512 * i_; *(LAS u32x4*)(lds + (slot) * ATT_SLOT + (idx_ >> 5) * 528 + (idx_ & 31) * 16) = st[i_]; } } while (0)
        f32x4 S[16], Oa[16]; bf16x8 Pf[8]; float inv = 0.f;
#pragma unroll
        for (int i = 0; i < 16; ++i) { S[i] = (f32x4){0.f, 0.f, 0.f, 0.f}; Oa[i] = (f32x4){0.f, 0.f, 0.f, 0.f}; }
        ATT_GLOAD(0); ATT_LSTORE(0); __syncthreads();
#pragma unroll
        for (int c = 0; c < 8; ++c) {
            if (c < 7) ATT_GLOAD(c + 1);
            LAS unsigned char* slot = lds + (c & 1) * ATT_SLOT;
            if (c < 4) {
#pragma unroll
                for (int ml = 0; ml < 4; ++ml)
#pragma unroll
                    for (int ks = 0; ks < 8; ++ks) {
                        const bf16x8 Kf = *(LAS bf16x8*)(slot + (16 * ml + fr) * 528 + (32 * ks + 8 * fq) * 2);
                        S[4 * c + ml] = MFMA16(Kf, Qf[ks], S[4 * c + ml]);
                    }
                if (c == 3) {
                    float mx = S[0][0];
#pragma unroll
                    for (int i = 0; i < 16; ++i) { mx = fmaxf(mx, fmaxf(fmaxf(S[i][0], S[i][1]), fmaxf(S[i][2], S[i][3]))); }
                    mx = fmaxf(mx, __shfl_xor(mx, 16)); mx = fmaxf(mx, __shfl_xor(mx, 32));
                    float sum = 0.f;
#pragma unroll
                    for (int i = 0; i < 16; ++i) {
#pragma unroll
                        for (int e = 0; e < 4; ++e) { S[i][e] = __builtin_amdgcn_exp2f(S[i][e] - mx); sum += S[i][e]; }
                    }
                    sum += __shfl_xor(sum, 16); sum += __shfl_xor(sum, 32);
                    inv = 1.0f / sum;
#pragma unroll
                    for (int a = 0; a < 8; ++a) {
                        u32x4 pw; pw.x = cvt_pk_bf16(S[2 * a][0], S[2 * a][1]); pw.y = cvt_pk_bf16(S[2 * a][2], S[2 * a][3]); pw.z = cvt_pk_bf16(S[2 * a + 1][0], S[2 * a + 1][1]); pw.w = cvt_pk_bf16(S[2 * a + 1][2], S[2 * a + 1][3]);
                        Pf[a] = __builtin_bit_cast(bf16x8, pw);
                    }
                }
            } else {
#pragma unroll
                for (int al = 0; al < 2; ++al)
#pragma unroll
                    for (int dt = 0; dt < 16; ++dt) {
                        LAS unsigned char* p = slot + (32 * al + 4 * fq + (fr >> 2)) * 528 + (16 * dt + 4 * (fr & 3)) * 2;
                        const bf16x8 Vf = tr_frag(p, p + 16 * 528);
                        Oa[dt] = MFMA16(Vf, Pf[2 * (c - 4) + al], Oa[dt]);
                    }
            }
            if (c < 7) ATT_LSTORE((c + 1) & 1);
            __syncthreads();
        }
#pragma unroll
        for (int dt = 0; dt < 16; ++dt) *(u32x2*)(((bf16_t*)(F.ws + WS_O)) + rowq * D + h * 256 + 16 * dt + 4 * fq) = pack4(Oa[dt] * inv);
#undef ATT_GLOAD
#undef ATT_LSTORE
    }
}

template <class Epi>
__device__ __forceinline__ void skinny_gemm(Frame& F0, const bf16_t* A, const bf16_t* Bt, int N, int K, const Epi& E) {
    Frame F = launder(F0);
    LAS unsigned char* lds = F.lds;
    const int tid = F.tid, lane = F.lane, w = F.wave, fr = lane & 15, fq = lane >> 4;
    const int nstrips = N / 32, kslice = K / 8, nks = kslice / 32;
    for (int strip = F.bx; strip < nstrips; strip += F.G) {
        f32x4 acc[8][2];
#pragma unroll
        for (int mt = 0; mt < 8; ++mt) { acc[mt][0] = (f32x4){0.f, 0.f, 0.f, 0.f}; acc[mt][1] = (f32x4){0.f, 0.f, 0.f, 0.f}; }
        const bf16_t* ap = A + (size_t)fr * K + w * kslice + 8 * fq; const bf16_t* bp = Bt + (size_t)(strip * 32 + fr) * K + w * kslice + 8 * fq;
#pragma unroll 2
        for (int ks = 0; ks < nks; ++ks) {
            const bf16x8 B0 = *(const bf16x8*)(bp + 32 * ks), B1 = *(const bf16x8*)(bp + (size_t)16 * K + 32 * ks);
#pragma unroll
            for (int mt = 0; mt < 8; ++mt) {
                const bf16x8 Af = *(const bf16x8*)(ap + (size_t)(16 * mt) * K + 32 * ks);
                acc[mt][0] = MFMA16(B0, Af, acc[mt][0]); acc[mt][1] = MFMA16(B1, Af, acc[mt][1]);
            }
        }
#pragma unroll
        for (int mt = 0; mt < 8; ++mt)
#pragma unroll
            for (int nt = 0; nt < 2; ++nt) *(LAS f32x4*)(lds + ((size_t)((w * 128 + 16 * mt + fr) * 32 + 16 * nt + 4 * fq)) * 4) = acc[mt][nt];
        __syncthreads();
        const int row = tid >> 2, cq = tid & 3;
        f32x4 s0 = (f32x4){0.f, 0.f, 0.f, 0.f}, s1 = s0;
#pragma unroll
        for (int ww = 0; ww < 8; ++ww) { const LAS f32x4* p = (const LAS f32x4*)(lds + ((size_t)((ww * 128 + row) * 32 + 8 * cq)) * 4); s0 += p[0]; s1 += p[1]; }
        E(row, strip, strip * 32 + 8 * cq, s0, s1);
        __syncthreads();
    }
}
struct SEpiZ {
    const float* rsqs; float* SZ; int ldz, mode;
    __device__ __forceinline__ void operator()(int row, int strip, int col, f32x4 s0, f32x4 s1) const {
        const float rs = rstd32(rsqs + row * 32); const int oc0 = mode == 0 ? src_even(col) : src_odd(col), oc1 = mode == 0 ? src_even(col + 4) : src_odd(col + 4);
        float* p = SZ + (size_t)row * ldz; *(f32x4*)(p + oc0) = s0 * rs; *(f32x4*)(p + oc1) = s1 * rs;
    }
};
struct SEpiRes {
    float* xs; bf16_t* xb; float* rsqs;
    __device__ __forceinline__ void operator()(int row, int strip, int col, f32x4 s0, f32x4 s1) const {
        float* p = xs + (size_t)row * D + col; const f32x4 o0 = *(const f32x4*)p + s0, o1 = *(const f32x4*)(p + 4) + s1;
        *(f32x4*)p = o0; *(f32x4*)(p + 4) = o1; *(u32x4*)(xb + (size_t)row * D + col) = pack8(o0, o1);
        float ss = dot4(o0, o0) + dot4(o1, o1); ss += __shfl_xor(ss, 1); ss += __shfl_xor(ss, 2);
        if ((col & 31) == 0) rsqs[row * 32 + strip] = ss;
    }
};
struct SEpiQ {
    const float* rsqs; float* SQ;
    __device__ __forceinline__ void operator()(int row, int strip, int col, f32x4 s0, f32x4 s1) const {
        const float rs = rstd32(rsqs + row * 32); float* p = SQ + (size_t)row * D + col; *(f32x4*)p = s0 * rs; *(f32x4*)(p + 4) = s1 * rs;
    }
};
__device__ __forceinline__ void sample_mix_even(Frame& F0, int j, int b) {
    Frame F = launder(F0);
    LAS float* pl = (LAS float*)F.lds; LAS float* red = pl + 1024;
    const int tid = F.tid, lane = F.lane, w = F.wave;
    const float* z = ((float*)(F.ws + WS_SZ)) + (size_t)b * 8192;
    float vv[2], ss = 0.f;
#pragma unroll
    for (int k = 0; k < 2; ++k) { vv[k] = z[3072 + tid + 512 * k]; ss += vv[k] * vv[k]; }
    ss = wave_sum(ss); if (lane == 0) red[w] = ss;
#pragma unroll
    for (int k = 0; k < 2; ++k) {
        const int c = tid + 512 * k, g = c >> 8, win = 2 << g; const float xa = z[c];
        const float* st = FIN(3) + ((size_t)(j * 128 + b) * 15) * 1024 + c;
        float s = xa; for (int r = 16 - win; r < 15; ++r) s += st[(size_t)r * 1024];
        pl[c] = s / (float)win - xa;
        float* po = F.out + O_POOLS + ((size_t)(j * 128 + b) * 15) * 1024 + c;
        for (int r = 0; r < 14; ++r) po[(size_t)r * 1024] = st[(size_t)(r + 1) * 1024];
        po[(size_t)14 * 1024] = xa;
    }
    __syncthreads();
    float tot = 0.f;
#pragma unroll
    for (int i = 0; i < 8; ++i) tot += red[i];
    const float rv = rsqrtf(tot * (1.0f / D) + EPS);
#pragma unroll
    for (int k = 0; k < 2; ++k) {
        const int d = tid + 512 * k, g = d >> 8, dd = d & 255;
        const float* pm = FIN(11) + (size_t)(j * 4 + g) * 65536 + dd; const LAS float* pg = pl + g * 256;
        float a = 0.f;
#pragma unroll 8
        for (int c = 0; c < 256; ++c) a += pg[c] * pm[(size_t)c * 256];
        const float ya = a * FIN(12)[j * 1024 + d] * silu_f(z[1024 + d]);
        const float vn = vv[k] * rv * FIN(15)[j * 1024 + d];
        F.out[O_SGUV + (size_t)(j * 128 + b) * 1024 + d] = vn;
        const float mixed = FIN(13)[(size_t)(j * 4 + g) * 16384] * vn + FIN(14)[(j * 4 + g) * 128];
        const float yb = z[2048 + d] * mixed * silu_f(z[4096 + d]);
        ((bf16_t*)(F.ws + WS_SA2))[(size_t)b * 2048 + d] = (bf16_t)(cvt_pk_bf16(ya, 0.f) & 0xffffu); ((bf16_t*)(F.ws + WS_SA2))[(size_t)b * 2048 + 1024 + d] = (bf16_t)(cvt_pk_bf16(yb, 0.f) & 0xffffu);
    }
    __syncthreads();
}
__device__ __forceinline__ void sample_conv_odd(Frame& F0, int j, int b) {
    Frame F = launder(F0);
    const int tid = F.tid;
    const float* z = ((float*)(F.ws + WS_SZ)) + (size_t)b * 8192;
    const float* cw = FIN(18) + (size_t)j * 3 * 2048;
#pragma unroll
    for (int k = 0; k < 4; ++k) {
        const int c = tid + 512 * k;
        const float e = z[2048 + c] * z[4096 + c];
        const float s0 = FIN(4)[((size_t)(j * 128 + b) * 2 + 0) * 2048 + c], s1 = FIN(4)[((size_t)(j * 128 + b) * 2 + 1) * 2048 + c];
        const float y = cw[c] * s0 + cw[2048 + c] * s1 + cw[4096 + c] * e;
        ((bf16_t*)(F.ws + WS_SA2))[(size_t)b * 2048 + c] = (bf16_t)(cvt_pk_bf16(z[c] * y * silu_f(z[6144 + c]), 0.f) & 0xffffu);
        float* po = F.out + O_CONVS + ((size_t)(j * 128 + b) * 2) * 2048 + c; po[0] = s1; po[2048] = e;
    }
}
__device__ __forceinline__ void attn_sample(Frame& F0, int layer) {
    Frame F = launder(F0);
    LAS float* sc = (LAS float*)F.lds;
    LAS float* red = sc + 512;
    const int tid = F.tid, lane = F.lane, w = F.wave;
    for (int item = F.bx; item < 256; item += F.G) {
        const int b = item >> 1, hp = item & 1;
        const float* qp = ((float*)(F.ws + WS_SQ)) + (size_t)b * D + hp * 512;
        const f32x4 q0 = *(const f32x4*)(qp + 4 * lane), q1 = *(const f32x4*)(qp + 256 + 4 * lane);
        const float* kp = FIN(5) + ((size_t)(layer * 128 + b) * 256) * 1024 + hp * 512 + 4 * lane;
        const float* vp = FIN(6) + ((size_t)(layer * 128 + b) * 256) * 1024 + hp * 512 + 4 * lane;
#pragma unroll 8
        for (int mi = 0; mi < 32; ++mi) {
            const int m = 32 * w + mi;
            const f32x4 k0 = __builtin_nontemporal_load((const f32x4*)(kp + (size_t)m * 1024)), k1 = __builtin_nontemporal_load((const f32x4*)(kp + (size_t)m * 1024 + 256));
            const float d0 = wave_sum(dot4(k0, q0)), d1 = wave_sum(dot4(k1, q1));
            if (lane == 0) { sc[m] = d0; sc[256 + m] = d1; }
        }
        __syncthreads();
        float p0[4], p1[4], mx0 = -INFINITY, mx1 = -INFINITY;
#pragma unroll
        for (int i = 0; i < 4; ++i) { p0[i] = sc[lane + 64 * i]; p1[i] = sc[256 + lane + 64 * i]; mx0 = fmaxf(mx0, p0[i]); mx1 = fmaxf(mx1, p1[i]); }
#pragma unroll
        for (int o = 1; o < 64; o <<= 1) { mx0 = fmaxf(mx0, __shfl_xor(mx0, o)); mx1 = fmaxf(mx1, __shfl_xor(mx1, o)); }
        float sm0 = 0.f, sm1 = 0.f;
#pragma unroll
        for (int i = 0; i < 4; ++i) { p0[i] = __builtin_amdgcn_exp2f(p0[i] - mx0); p1[i] = __builtin_amdgcn_exp2f(p1[i] - mx1); sm0 += p0[i]; sm1 += p1[i]; }
        sm0 = wave_sum(sm0); sm1 = wave_sum(sm1);
        const float i0 = 1.0f / sm0, i1 = 1.0f / sm1;
        __syncthreads();
        if (w == 0) {
#pragma unroll
            for (int i = 0; i < 4; ++i) { sc[lane + 64 * i] = p0[i] * i0; sc[256 + lane + 64 * i] = p1[i] * i1; }
        }
        __syncthreads();
        f32x4 a0 = (f32x4){0.f, 0.f, 0.f, 0.f}, a1 = a0;
#pragma unroll 8
        for (int mi = 0; mi < 32; ++mi) {
            const int m = 32 * w + mi;
            const f32x4 v0 = __builtin_nontemporal_load((const f32x4*)(vp + (size_t)m * 1024)), v1 = __builtin_nontemporal_load((const f32x4*)(vp + (size_t)m * 1024 + 256));
            a0 += v0 * sc[m]; a1 += v1 * sc[256 + m];
        }
        *(LAS f32x4*)(red + w * 512 + 4 * lane) = a0; *(LAS f32x4*)(red + w * 512 + 256 + 4 * lane) = a1;
        __syncthreads();
        {
            float o = 0.f;
#pragma unroll
            for (int ww = 0; ww < 8; ++ww) o += red[ww * 512 + tid];
            ((bf16_t*)(F.ws + WS_SO))[(size_t)b * D + hp * 512 + tid] = (bf16_t)(cvt_pk_bf16(o, 0.f) & 0xffffu);
        }
        __syncthreads();
    }
}
__device__ __forceinline__ void final_norm(Frame& F0) {
    Frame F = launder(F0);
    const int gw = F.bx * NWAVES + F.wave, NGW = F.G * NWAVES, lane = F.lane;
    f32x4 g[4];
#pragma unroll
    for (int jj = 0; jj < 4; ++jj) g[jj] = ((const f32x4*)FIN(24) + lane)[64 * jj];
    for (int m = gw; m < MP + MS; m += NGW) {
        const float* src = m < MP ? F.out + O_Y + (size_t)m * D : ((float*)(F.ws + WS_XS)) + (size_t)(m - MP) * D;
        float* dst = m < MP ? F.out + O_Y + (size_t)m * D : F.out + O_YS + (size_t)(m - MP) * D;
        f32x4 v[4]; float s = 0.f;
#pragma unroll
        for (int jj = 0; jj < 4; ++jj) { v[jj] = ((const f32x4*)src + lane)[64 * jj]; s += dot4(v[jj], v[jj]); }
        const float rs = rsqrtf(wave_sum(s) * (1.0f / D) + EPS);
#pragma unroll
        for (int jj = 0; jj < 4; ++jj) ((f32x4*)dst + lane)[64 * jj] = v[jj] * rs * g[jj];
    }
}

struct Args { const float* in[25]; float* out; unsigned char* ws; int ph_lo, ph_hi; };
#define REP(bit) for (int rep_ = 0; rep_ < 1 + ((REP_MASK >> (bit)) & 1); ++rep_)
#ifndef MK_SPLIT
#define MK_SPLIT 0
#endif
__global__ void __launch_bounds__(NWAVES * 64, 2) fwd(Args args) {
    extern __shared__ __attribute__((aligned(16))) unsigned char lds_raw[];
    Frame F0;
    F0.lds = (LAS unsigned char*)lds_raw;
    F0.tid = threadIdx.x; F0.lane = F0.tid & 63; F0.wave = __builtin_amdgcn_readfirstlane(F0.tid >> 6); F0.G = gridDim.x; F0.bx = blockIdx.x;
    F0.in = (in_tab_t)__builtin_amdgcn_kernarg_segment_ptr();     F0.out = args.out; F0.ws = args.ws;
    for (int u = F0.tid; u < (LDS_BYTES - LDSCTL_OFF) / 4; u += NWAVES * 64) ((LAS unsigned*)(F0.lds + LDSCTL_OFF))[u] = 0u;
    __syncthreads();
    XcdBarrier bar; bar.bar = (unsigned*)(args.ws + WS_CTL) + CW_BAR; bar.x = 0; bar.st = nullptr;
    if (!MK_SPLIT) bar = xcd_barrier_post((unsigned*)(args.ws + WS_CTL) + CW_BAR, (volatile LAS unsigned*)(F0.lds + MISC_OFF) + 8);
    int ph = 0;
    const int lo = args.ph_lo, hi = args.ph_hi;
#define PH_BEGIN if (ph >= lo && ph < hi) { Frame F = launder(F0);
#define PH_END } { const bool both_ = (ph >= lo && ph + 1 < hi); ++ph; if (!MK_SPLIT && both_) { XcdBarrier b2_ = bar; unsigned long long bp_ = uni64((unsigned long long)bar.bar); unsigned bx_ = __builtin_amdgcn_readfirstlane(bar.x); asm volatile("" : "+s"(bp_), "+s"(bx_)); b2_.bar = (unsigned*)(GAS unsigned*)bp_; b2_.x = bx_; xcd_barrier(b2_); } }

    PH_BEGIN REP(0) { p0_prologue(F0); __syncthreads(); } PH_END
    PH_BEGIN {
        pg8::Gemm g{((bf16_t*)(F.ws + WS_MEMB)), ((bf16_t*)(F.ws + WS_WKV)), MMEM, 8192, D}; pg8::StaticOrder S; S.init(MMEM, 8192, F.G, (int)F.bx);
        EpiMemKV E{((float*)(F.ws + WS_SMALL + 65536)), F.out + O_MEMK, F.out + O_MEMV, ((bf16_t*)(F.ws + WS_KB)), ((bf16_t*)(F.ws + WS_VB))};
        REP(1) pg8::gemm_phase<EpiMemKV, pg8::StaticOrder, true, true>(F.lds, g, S, E);
    } PH_END
#pragma unroll 1
    for (int l = 0; l < DEPTH; ++l) {
        const int j = l >> 1;
        if ((l & 1) == 0) {
            PH_BEGIN {
                pg8::Gemm g{((bf16_t*)(F.ws + WS_XB)), ((bf16_t*)(F.ws + WS_AB1)) + (size_t)j * NAB * D, MP, NAB, D}; pg8::StaticOrder S; S.init(MP, NAB, F.G, (int)F.bx);
                EpiG1Even E{((float*)(F.ws + WS_RSQ)), ((bf16_t*)(F.ws + WS_Z)), ((float*)(F.ws + WS_VSQ)), F.out + O_POOLP + (size_t)j * 8 * 15 * 1024};
                REP(2) pg8::gemm_phase<EpiG1Even, pg8::StaticOrder, true, true>(F.lds, g, S, E);
                SEpiZ SE{((float*)(F.ws + WS_SMALL)), ((float*)(F.ws + WS_SZ)), 8192, 0};
                REP(3) skinny_gemm<SEpiZ>(F, ((bf16_t*)(F.ws + WS_XB)) + (size_t)MP * D, ((bf16_t*)(F.ws + WS_AB1)) + (size_t)j * NAB * D, NAB, D, SE);
            } PH_END
            PH_BEGIN {
                REP(4) for (int un = F.bx; un < 1024; un += F.G) { const int kind = un & 1, g = (un >> 1) & 3, n = un >> 3; if (kind == 0) sgu_unit(F, j, n, g); else pool_unit(F, j, n, g); }
                REP(5) for (int b = F.bx; b < MS; b += F.G) sample_mix_even(F, j, b);
            } PH_END
        } else {
            PH_BEGIN {
                pg8::Gemm g{((bf16_t*)(F.ws + WS_XB)), ((bf16_t*)(F.ws + WS_C1)) + (size_t)j * NC * D, MP, NC, D}; pg8::StaticOrder S; S.init(MP, NC, F.G, (int)F.bx);
                EpiG1Odd E{((float*)(F.ws + WS_RSQ)), ((bf16_t*)(F.ws + WS_A2)), FIN(18) + (size_t)j * 3 * 2048, F.out + O_CONVP + (size_t)j * 8 * 2 * 2048, ((float*)(F.ws + WS_SIDE)), (LAS float*)(F.lds + HALO_OFF)};
                REP(6) pg8::gemm_phase<EpiG1Odd, pg8::StaticOrder, true, true>(F.lds, g, S, E);
                SEpiZ SE{((float*)(F.ws + WS_SMALL)), ((float*)(F.ws + WS_SZ)), 8192, 1};
                REP(3) skinny_gemm<SEpiZ>(F, ((bf16_t*)(F.ws + WS_XB)) + (size_t)MP * D, ((bf16_t*)(F.ws + WS_C1)) + (size_t)j * NC * D, NC, D, SE);
            } PH_END
            PH_BEGIN {
                REP(5) for (int b = F.bx; b < MS; b += F.G) sample_conv_odd(F, j, b);
            } PH_END
        }
        PH_BEGIN {
            const bf16_t* W2 = ((l & 1) ? ((bf16_t*)(F.ws + WS_C2)) : ((bf16_t*)(F.ws + WS_AB2))) + (size_t)j * D * 2048;
            pg8::Gemm g{((bf16_t*)(F.ws + WS_A2)), W2, MP, D, 2048}; pg8::StaticOrder S; S.init(MP, D, F.G, (int)F.bx);
            if (l & 1) { Unit fu; for (int i = 0; S.next(i, fu); ++i) conv_fixup(((float*)(F.ws + WS_SIDE)), FIN(18) + (size_t)j * 3 * 2048, ((bf16_t*)(F.ws + WS_A2)), fu.pm, F.tid); asm volatile("s_waitcnt vmcnt(0)" ::: "memory"); __syncthreads(); }
            EpiRes E{l == 0 ? FIN(0) : F.out + O_Y, F.out + O_Y, ((bf16_t*)(F.ws + WS_XB)), ((float*)(F.ws + WS_RSQ))};
            pg8::gemm_phase<EpiRes, pg8::StaticOrder, true, true>(F.lds, g, S, E);
            SEpiRes SE{((float*)(F.ws + WS_XS)), ((bf16_t*)(F.ws + WS_XB)) + (size_t)MP * D, ((float*)(F.ws + WS_SMALL))};
            skinny_gemm<SEpiRes>(F, ((bf16_t*)(F.ws + WS_SA2)), W2, D, 2048, SE);
        } PH_END
        PH_BEGIN {
            pg8::Gemm g{((bf16_t*)(F.ws + WS_XB)), ((bf16_t*)(F.ws + WS_WQ)) + (size_t)l * D * D, MP, D, D}; pg8::StaticOrder S; S.init(MP, D, F.G, (int)F.bx);
            EpiQ E{((float*)(F.ws + WS_RSQ)), ((bf16_t*)(F.ws + WS_Q))};
            REP(8) pg8::gemm_phase<EpiQ, pg8::StaticOrder, true, true>(F.lds, g, S, E);
            SEpiQ SE{((float*)(F.ws + WS_SMALL)), ((float*)(F.ws + WS_SQ))};
            REP(9) skinny_gemm<SEpiQ>(F, ((bf16_t*)(F.ws + WS_XB)) + (size_t)MP * D, ((bf16_t*)(F.ws + WS_WQ)) + (size_t)l * D * D, D, D, SE);
        } PH_END
        PH_BEGIN {
            REP(10) attn_prompt(F, l);
            REP(11) attn_sample(F, l);
        } PH_END
        PH_BEGIN {
            pg8::Gemm g{((bf16_t*)(F.ws + WS_O)), ((bf16_t*)(F.ws + WS_WO)) + (size_t)l * D * D, MP, D, D}; pg8::StaticOrder S; S.init(MP, D, F.G, (int)F.bx);
            EpiRes E{F.out + O_Y, F.out + O_Y, ((bf16_t*)(F.ws + WS_XB)), ((float*)(F.ws + WS_RSQ))};
            pg8::gemm_phase<EpiRes, pg8::StaticOrder, true, true>(F.lds, g, S, E);
            SEpiRes SE{((float*)(F.ws + WS_XS)), ((bf16_t*)(F.ws + WS_XB)) + (size_t)MP * D, ((float*)(F.ws + WS_SMALL))};
            skinny_gemm<SEpiRes>(F, ((bf16_t*)(F.ws + WS_SO)), ((bf16_t*)(F.ws + WS_WO)) + (size_t)l * D * D, D, D, SE);
        } PH_END
    }
    PH_BEGIN final_norm(F0); PH_END
#undef PH_BEGIN
#undef PH_END
}
constexpr int N_PHASES = 2 + 6 * DEPTH + 1;

extern "C" void kernel_launch(void* const* d_in, const int* in_sizes, int n_in, void* d_out, int out_size, void* d_ws, size_t ws_size, hipStream_t stream) {
    static int grid = 0;
    if (grid == 0) {
        if (n_in != 25 || in_sizes[0] != MP * D || (size_t)out_size != O_END || ws_size < WS_END) { fprintf(stderr, "kernel_launch: unexpected shapes (n_in %d, in0 %d, out %d, ws %zu); nothing launched\n", n_in, n_in > 0 ? in_sizes[0] : -1, out_size, ws_size); grid = -1; return; }
        int dev = 0, cus = 0, per_cu = 0;
        if (hipGetDevice(&dev) != hipSuccess || hipDeviceGetAttribute(&cus, hipDeviceAttributeMultiprocessorCount, dev) != hipSuccess) { fprintf(stderr, "kernel_launch: device query failed\n"); grid = -1; return; }
        if (hipFuncSetAttribute((const void*)fwd, hipFuncAttributeMaxDynamicSharedMemorySize, LDS_BYTES) != hipSuccess) { fprintf(stderr, "kernel_launch: hipFuncSetAttribute failed\n"); grid = -1; return; }
        if (hipOccupancyMaxActiveBlocksPerMultiprocessor(&per_cu, (const void*)fwd, NWAVES * 64, LDS_BYTES) != hipSuccess || per_cu < 1) fprintf(stderr, "kernel_launch: note: occupancy query reports %d workgroups per CU\n", per_cu);
        (void)hipGetLastError();
        grid = cus;
    }
    if (grid < 0) return;
    if (hipMemsetAsync((char*)d_ws + WS_CTL, 0, CTL_ZERO_BYTES, stream) != hipSuccess) { fprintf(stderr, "kernel_launch: memset failed\n"); return; }
    Args a{};
    for (int i = 0; i < 25; ++i) a.in[i] = (const float*)d_in[i];
    a.out = (float*)d_out; a.ws = (unsigned char*)d_ws;
#if MK_SPLIT
    for (int p = 0; p < N_PHASES; ++p) { a.ph_lo = p; a.ph_hi = p + 1; hipLaunchKernelGGL(fwd, dim3(grid), dim3(NWAVES * 64), LDS_BYTES, stream, a); }
#else
    a.ph_lo = 0; a.ph_hi = N_PHASES;
    hipLaunchKernelGGL(fwd, dim3(grid), dim3(NWAVES * 64), LDS_BYTES, stream, a);
#endif
    const hipError_t le = hipPeekAtLastError();
    if (le != hipSuccess) fprintf(stderr, "kernel_launch: launch failed: %s\n", hipGetErrorName(le));
}
```

```cpp
#include <hip/hip_runtime.h>
#include <cstdio>
#include <cstdint>
#ifndef REP_MASK
#define REP_MASK 0
#endif
namespace pg8 {
#define PG8_LAS __attribute__((address_space(3)))
typedef unsigned short bf16_t;
typedef short bf16x8 __attribute__((ext_vector_type(8)));
typedef float f32x4 __attribute__((ext_vector_type(4)));
typedef unsigned u32x4 __attribute__((ext_vector_type(4)));
constexpr int BM = 256, BK = 64, HALF = 128, HTB = HALF * BK * 2  , STAGE_BYTES = 8 * HTB, NXCD = 8, WGM = 8;

__host__ __device__ __forceinline__ int lds_byte(int r, int c) { const int st = (r >> 4) * 2 + (c >> 5), rr = r & 15, cc = c & 31, ob = rr * 64 + cc * 2; return st * 1024 + (ob ^ (((ob >> 9) & 1) << 5)); }
__host__ __device__ __forceinline__ void stage_rc(int b, int& R, int& C) { const int st = b / 1024, sb = b % 1024, swz = sb ^ (((sb >> 9) & 1) << 5); R = (st >> 1) * 16 + swz / 64; C = (st & 1) * 32 + (swz % 64) / 2; }
__host__ __device__ __forceinline__ int perm32(int rho) { const int n = rho >> 4, i = rho & 15; return 8 * (i >> 2) + 4 * n + (i & 3); }

struct Unit { int pm, pn; };
struct Gemm { const bf16_t* A; const bf16_t* Bt; int M, N, K; };

struct StaticOrder {
    int nM, nN, nwg, G, c;
    __host__ __device__ __forceinline__ void init(int M, int N, int G_, int c_) { nM = M / BM; nN = N / BM; nwg = nM * nN; G = G_; c = c_; }
    __host__ __device__ __forceinline__ bool next(int i, Unit& u) const {
        const long L = (long)i * G + c; if (L >= nwg) return false;
        int wgid = (int)L; { const int q = nwg / NXCD, r = nwg % NXCD, xcd = wgid % NXCD, off = wgid / NXCD; wgid = (xcd < r ? xcd * (q + 1) : r * (q + 1) + (xcd - r) * q) + off; }
        const int nig = WGM * nN, gid = wgid / nig, fm = gid * WGM, gsz = (nM - fm) < WGM ? (nM - fm) : WGM;
        u.pm = fm + ((wgid % nig) % gsz); u.pn = (wgid % nig) / gsz; return true;
    }
    __device__ __forceinline__ void a_ready(const Unit&) const {}
    __device__ __forceinline__ void done(const Unit&) const {}
};

__device__ __forceinline__ unsigned cvt_pk_bf16(float lo, float hi) { unsigned r; asm volatile("v_cvt_pk_bf16_f32 %0, %1, %2" : "=v"(r) : "v"(lo), "v"(hi)); return r; }
template <class Epi, class Sched, bool ALIGN_EPI = false, bool SP2 = false>
__device__ __forceinline__ void gemm_phase(PG8_LAS unsigned char* lds, const Gemm g, const Sched& S, const Epi& E) {
    int tid_ = threadIdx.x; asm volatile("" : "+v"(tid_));
    const int tid = tid_, wid = __builtin_amdgcn_readfirstlane(tid >> 6), lane = tid & 63, wr = wid >> 2, wc = wid & 3, fr = lane & 15, fq = lane >> 4;
    const int K = g.K, nt = K / BK;
    unsigned voffA[2], voffB[2];
#pragma unroll
    for (int i = 0; i < 2; ++i) { int R, C; stage_rc(tid * 16 + i * 8192, R, C); const int Rb = Epi::PERM ? ((R & ~31) + perm32(R & 31)) : R;
        voffA[i] = (unsigned)(R * K + C) * 2u; voffB[i] = (unsigned)(Rb * K + C) * 2u; }
    const size_t kstep = (size_t)(BK * 2);
    const size_t hstep = (size_t)HALF * K * 2;
    const size_t tstep = 2 * hstep;
    const unsigned ldsw = (unsigned)wid * 1024u;
    const int aoff = lds_byte(wr * 64 + fr, fq * 8), boff = lds_byte(wc * 32 + fr, fq * 8);
#define PG8_SA(b, h) (((b) * 2 + (h)) * HTB)
#define PG8_SB(b, h) ((4 + (b) * 2 + (h)) * HTB)
#define PG8_STAGE(bufoff, gbase, voff) do { _Pragma("unroll") for (int _i = 0; _i < 2; ++_i) \
        __builtin_amdgcn_global_load_lds((const unsigned*)((const char*)(gbase) + (voff)[_i]), (PG8_LAS unsigned*)(lds + (bufoff) + ldsw + _i * 8192), 16, 0, 0); } while (0)
#define PG8_LDA(dst, b, h) do { _Pragma("unroll") for (int m = 0; m < 4; ++m) _Pragma("unroll") for (int k = 0; k < 2; ++k) dst[m][k] = *(const PG8_LAS bf16x8*)(lds + PG8_SA(b, h) + aoff + m * 2048 + k * 1024); } while (0)
#define PG8_LDB(dst, b, h) do { _Pragma("unroll") for (int n = 0; n < 2; ++n) _Pragma("unroll") for (int k = 0; k < 2; ++k) dst[n][k] = *(const PG8_LAS bf16x8*)(lds + PG8_SB(b, h) + boff + n * 2048 + k * 1024); } while (0)
#define PG8_MMA(ai, bj, At, Bt) do { __builtin_amdgcn_s_setprio(1); _Pragma("unroll") for (int m = 0; m < 4; ++m) _Pragma("unroll") for (int n = 0; n < 2; ++n) _Pragma("unroll") for (int k = 0; k < 2; ++k) \
        acc[ai][bj][m][n] = __builtin_amdgcn_mfma_f32_16x16x32_bf16(Bt[n][k], At[m][k], acc[ai][bj][m][n], 0, 0, 0); __builtin_amdgcn_s_setprio(0); } while (0)
#define PG8_WAIT_V(n) asm volatile("s_waitcnt vmcnt(" #n ")" ::: "memory")
#define PG8_WAIT_L(n) asm volatile("s_waitcnt lgkmcnt(" #n ")" ::: "memory")
#define PG8_BAR __builtin_amdgcn_s_barrier()
#define PG8_SCHED __builtin_amdgcn_sched_barrier(0)
    Unit cur, nxt; int ui = 0;
    if (!S.next(0, cur)) return;
    f32x4 acc[2][2][4][2];
#pragma unroll
    for (int a = 0; a < 2; ++a)
#pragma unroll
        for (int b = 0; b < 2; ++b)
#pragma unroll
            for (int m = 0; m < 4; ++m)
#pragma unroll
                for (int n = 0; n < 2; ++n) acc[a][b][m][n] = (f32x4){0.f, 0.f, 0.f, 0.f};
    bf16x8 At[4][2], B0[2][2], B1[2][2];
    const char* cA = (const char*)g.A + (size_t)cur.pm * tstep; const char* cB = (const char*)g.Bt + (size_t)cur.pn * tstep;
    S.a_ready(cur);
    if constexpr (SP2) {
        PG8_STAGE(PG8_SB(0, 0), cB, voffB); PG8_STAGE(PG8_SB(0, 1), cB + hstep, voffB); PG8_STAGE(PG8_SA(0, 0), cA, voffA); PG8_STAGE(PG8_SA(0, 1), cA + hstep, voffA);
        if (wr == 1) PG8_BAR;
        PG8_WAIT_V(2); PG8_BAR;
        PG8_STAGE(PG8_SB(1, 0), cB + kstep, voffB); PG8_STAGE(PG8_SA(1, 0), cA + kstep, voffA); PG8_STAGE(PG8_SB(1, 1), cB + hstep + kstep, voffB);
        PG8_WAIT_V(6); PG8_BAR;
    } else {
        PG8_STAGE(PG8_SB(0, 0), cB, voffB); PG8_STAGE(PG8_SA(0, 0), cA, voffA); PG8_STAGE(PG8_SB(0, 1), cB + hstep, voffB); PG8_STAGE(PG8_SA(0, 1), cA + hstep, voffA);
        if (wr == 1) PG8_BAR;
        PG8_WAIT_V(4); PG8_BAR;
        PG8_STAGE(PG8_SB(1, 0), cB + kstep, voffB); PG8_STAGE(PG8_SA(1, 0), cA + kstep, voffA); PG8_STAGE(PG8_SB(1, 1), cB + hstep + kstep, voffB);
        PG8_WAIT_V(6); PG8_BAR;
    }
    for (;;) {
        const bool has_next = S.next(ui + 1, nxt);
        const char* nA = has_next ? (const char*)g.A + (size_t)nxt.pm * tstep : cA; const char* nB = has_next ? (const char*)g.Bt + (size_t)nxt.pn * tstep : cB;
        for (int t = 0; t < nt; t += 2) {
            const bool last = (t == nt - 2);
            const char* a1 = cA + (size_t)(t + 1) * kstep;
            const char* a2 = last ? nA : cA + (size_t)(t + 2) * kstep; const char* b2 = last ? nB : cB + (size_t)(t + 2) * kstep;
            const char* a3 = a2 + kstep; const char* b3 = b2 + kstep;
            if (last && has_next) S.a_ready(nxt);
            if constexpr (SP2) {
            PG8_LDB(B0, 0, 0); PG8_LDB(B1, 0, 1); PG8_SCHED; PG8_LDA(At, 0, 0); PG8_STAGE(PG8_SA(1, 1), a1 + hstep, voffA);
            PG8_WAIT_V(8); PG8_WAIT_L(0); PG8_BAR; PG8_MMA(0, 0, At, B0); PG8_MMA(0, 1, At, B1); PG8_BAR; PG8_SCHED;
            PG8_LDA(At, 0, 1); PG8_STAGE(PG8_SB(0, 0), b2, voffB); PG8_STAGE(PG8_SB(0, 1), b2 + hstep, voffB); PG8_STAGE(PG8_SA(0, 0), a2, voffA);
            PG8_WAIT_V(8); PG8_WAIT_L(0); PG8_BAR; PG8_MMA(1, 0, At, B0); PG8_MMA(1, 1, At, B1); PG8_BAR; PG8_SCHED;
            PG8_LDB(B0, 1, 0); PG8_LDB(B1, 1, 1); PG8_SCHED; PG8_LDA(At, 1, 0); PG8_STAGE(PG8_SA(0, 1), a2 + hstep, voffA);
            PG8_WAIT_V(8); PG8_WAIT_L(0); PG8_BAR; PG8_MMA(0, 0, At, B0); PG8_MMA(0, 1, At, B1); PG8_BAR; PG8_SCHED;
            PG8_LDA(At, 1, 1); PG8_STAGE(PG8_SB(1, 0), b3, voffB); PG8_STAGE(PG8_SB(1, 1), b3 + hstep, voffB); PG8_STAGE(PG8_SA(1, 0), a3, voffA);
            PG8_WAIT_V(8); PG8_WAIT_L(0); PG8_BAR; PG8_MMA(1, 0, At, B0); PG8_MMA(1, 1, At, B1); PG8_BAR; PG8_SCHED;
            } else {
            PG8_LDB(B0, 0, 0); PG8_SCHED; PG8_LDA(At, 0, 0); PG8_STAGE(PG8_SA(1, 1), a1 + hstep, voffA);
            PG8_WAIT_L(8); PG8_BAR; PG8_WAIT_L(0); PG8_MMA(0, 0, At, B0); PG8_BAR; PG8_SCHED;
            PG8_LDB(B1, 0, 1); PG8_STAGE(PG8_SB(0, 0), b2, voffB);
            PG8_BAR; PG8_WAIT_L(0); PG8_MMA(0, 1, At, B1); PG8_BAR;
            PG8_LDA(At, 0, 1); PG8_STAGE(PG8_SA(0, 0), a2, voffA);
            PG8_BAR; PG8_WAIT_L(0); PG8_MMA(1, 0, At, B0); PG8_BAR; PG8_SCHED;
            PG8_STAGE(PG8_SB(0, 1), b2 + hstep, voffB);
            PG8_WAIT_V(6); PG8_BAR; PG8_MMA(1, 1, At, B1); PG8_BAR;
            PG8_LDB(B0, 1, 0); PG8_SCHED; PG8_LDA(At, 1, 0); PG8_STAGE(PG8_SA(0, 1), a2 + hstep, voffA);
            PG8_WAIT_L(8); PG8_BAR; PG8_WAIT_L(0); PG8_MMA(0, 0, At, B0); PG8_BAR; PG8_SCHED;
            PG8_LDB(B1, 1, 1); PG8_STAGE(PG8_SB(1, 0), b3, voffB);
            PG8_BAR; PG8_WAIT_L(0); PG8_MMA(0, 1, At, B1); PG8_BAR;
            PG8_LDA(At, 1, 1); PG8_STAGE(PG8_SA(1, 0), a3, voffA);
            PG8_BAR; PG8_WAIT_L(0); PG8_MMA(1, 0, At, B0); PG8_BAR; PG8_SCHED;
            PG8_STAGE(PG8_SB(1, 1), b3 + hstep, voffB);
            PG8_WAIT_V(6); PG8_BAR; PG8_MMA(1, 1, At, B1); PG8_BAR;
            }
        }
        if constexpr (ALIGN_EPI) { if (wr == 0) PG8_BAR; }
        if constexpr (!Epi::AFTER_DRAIN) { for (int rep_ = 0; rep_ < 1 + (Epi::REP_EPI ? 1 : 0); ++rep_) E(acc, cur, wr, wc, fr, fq); S.done(cur); }
        if (!has_next) break;
#pragma unroll
        for (int a = 0; a < 2; ++a)
#pragma unroll
            for (int b = 0; b < 2; ++b)
#pragma unroll
                for (int m = 0; m < 4; ++m)
#pragma unroll
                    for (int n = 0; n < 2; ++n) acc[a][b][m][n] = (f32x4){0.f, 0.f, 0.f, 0.f};
        cur = nxt; cA = nA; cB = nB; ++ui;
        if constexpr (ALIGN_EPI) { if (wr == 1) PG8_BAR; }
    }
    PG8_WAIT_V(0);
    if constexpr (!ALIGN_EPI) { if (wr == 0) PG8_BAR; }
    PG8_BAR;
    if constexpr (Epi::AFTER_DRAIN) { E.fused(acc, cur, wr, wc, fr, fq, lds, wid, lane); S.done(cur); }
#undef PG8_SA
#undef PG8_SB
#undef PG8_STAGE
#undef PG8_LDA
#undef PG8_LDB
#undef PG8_MMA
#undef PG8_WAIT_V
#undef PG8_WAIT_L
#undef PG8_BAR
#undef PG8_SCHED
}
}

using pg8::bf16_t; using pg8::bf16x8; using pg8::f32x4; using pg8::u32x4; using pg8::Unit; using pg8::cvt_pk_bf16;
#define GAS __attribute__((address_space(1)))
#define LAS __attribute__((address_space(3)))
typedef unsigned u32x2 __attribute__((ext_vector_type(2)));
typedef short s16x4 __attribute__((ext_vector_type(4)));
typedef GAS unsigned gu32;
#define RLX_AGENT __ATOMIC_RELAXED, __HIP_MEMORY_SCOPE_AGENT

constexpr int NWAVES = 8;
constexpr int D = 1024, MP = 16384, MS = 128, SEQ = 2048, NBATCH = 8, NMEM = 256, MMEM = 2048, DEPTH = 4;
constexpr int NAB = 5120, NC = 8192;
constexpr float EPS = 1e-6f;
constexpr float QSCALE = 0.0625f * 1.4426950408889634f;

constexpr size_t O_Y = 0, O_YS = O_Y + (size_t)MP * D, O_POOLP = O_YS + (size_t)MS * D, O_POOLS = O_POOLP + 2 * 8 * 15 * 1024,
                 O_CONVP = O_POOLS + (size_t)2 * 128 * 15 * 1024, O_CONVS = O_CONVP + 2 * 8 * 2 * 2048, O_SGUV = O_CONVS + (size_t)2 * 128 * 2 * 2048,
                 O_MEMK = O_SGUV + 2 * 128 * 1024, O_MEMV = O_MEMK + (size_t)4 * MMEM * D, O_END = O_MEMV + (size_t)4 * MMEM * D;
static_assert(O_END == 39239680, "output size");

constexpr size_t MiB = 1u << 20;
constexpr size_t WS_CTL = 0, CTL_ZERO_BYTES = 1 * MiB;
constexpr size_t WS_AB1 = 2 * MiB, WS_C1 = 22 * MiB, WS_AB2 = 54 * MiB, WS_C2 = 62 * MiB, WS_WQ = 70 * MiB, WS_WKV = 78 * MiB, WS_WO = 94 * MiB, WS_PMT = 102 * MiB;
constexpr size_t WS_XB = 104 * MiB;
constexpr size_t WS_RSQ = 137 * MiB, WS_VSQ = 138 * MiB;
constexpr size_t WS_SMALL = 139 * MiB;
constexpr size_t WS_Z = 140 * MiB;
constexpr size_t WS_A2 = 268 * MiB;
constexpr size_t WS_Q = 332 * MiB, WS_O = 364 * MiB;
constexpr size_t WS_MEMB = 396 * MiB, WS_KB = 400 * MiB, WS_VB = 416 * MiB;
constexpr size_t WS_XS = 432 * MiB, WS_SZ = 433 * MiB, WS_SA2 = 437 * MiB, WS_SQ = 438 * MiB, WS_SO = 439 * MiB, WS_SIDE = 440 * MiB  , WS_END = 444 * MiB;
constexpr int CW_BAR = 4096;

constexpr int RING_BYTES = 131072, LDSCTL_OFF = RING_BYTES, MISC_OFF = LDSCTL_OFF + 320, HALO_OFF = RING_BYTES + 1024  , LDS_BYTES = 147456;

#define LDS_WAIT() asm volatile("s_waitcnt lgkmcnt(0)" ::: "memory")

#define XB_TMO      128
#define XB_XCNT(j)  (256  + 64 * (j))
#define XB_XSUB(j)  (1280 + 64 * (j))
#define XB_XGEN(j)  (2304 + 64 * (j))
#define XB_TOP      3328
#define XB_TOPGEN   3392
#define XCD_BAR_WORDS 3456
#define XB_SPIN_CAP (1u << 18)

__device__ __forceinline__ unsigned xb_ld(unsigned* p)              { return __hip_atomic_load(p, __ATOMIC_RELAXED, __HIP_MEMORY_SCOPE_AGENT); }
__device__ __forceinline__ unsigned xb_add(unsigned* p, unsigned v) { return __hip_atomic_fetch_add(p, v, __ATOMIC_RELAXED, __HIP_MEMORY_SCOPE_AGENT); }
__device__ __forceinline__ unsigned xb_xcc_id() { return (unsigned)__builtin_amdgcn_s_getreg((3 << 11) | 20) & 0xFu; }
#define XB_SPIN(cond, bar) do { unsigned _sp = 0; while (cond) { __builtin_amdgcn_s_sleep(1); \
    if ((++_sp & 255u) == 0u) { if (xb_ld(&(bar)[XB_TMO])) break; if (_sp > XB_SPIN_CAP) { atomicAdd(&(bar)[XB_TMO], 1u); break; } } } } while (0)

struct XcdBarrier {
    unsigned* bar; unsigned x;
    volatile LAS unsigned* st;
};

__device__ __forceinline__ XcdBarrier xcd_barrier_post(unsigned* bar, volatile LAS unsigned* st) {
    XcdBarrier b; b.bar = bar; b.x = xb_xcc_id(); b.st = st;
    if (threadIdx.x == 0) (void)xb_add(&bar[XB_XCNT(b.x)], 1u);
    return b;
}
__device__ __forceinline__ void xcd_barrier_complete(unsigned* bar, unsigned x, unsigned& nloc, unsigned& nx) {
    const unsigned G = gridDim.x * gridDim.y * gridDim.z;
    unsigned sum, cnt, mine, sp = 0u;
    for (;;) {
        sum = 0u; cnt = 0u; mine = 0u;
#pragma unroll
        for (unsigned j = 0; j < 16; ++j) { const unsigned c = xb_ld(&bar[XB_XCNT(j)]); sum += c; cnt += (c > 0u) ? 1u : 0u; mine = (j == x) ? c : mine; }
        if (sum == G) break;
        __builtin_amdgcn_s_sleep(1);
        if ((++sp & 255u) == 0u) { if (xb_ld(&bar[XB_TMO])) break; if (sp > XB_SPIN_CAP) { atomicAdd(&bar[XB_TMO], 1u); break; } }
    }
    nloc = mine > 0u ? mine : 1u; nx = cnt > 0u ? cnt : 1u;
}

__device__ __forceinline__ void xcd_barrier(const XcdBarrier& b) {
    asm volatile("s_waitcnt vmcnt(0)" ::: "memory");
    __syncthreads();
    if (threadIdx.x == 0) {
        unsigned* bar = b.bar;
        __builtin_amdgcn_s_waitcnt(0);
        unsigned nloc = b.st[0], nx = b.st[1];
        if (nloc == 0u) { xcd_barrier_complete(bar, b.x, nloc, nx); b.st[0] = nloc; b.st[1] = nx; }
        const unsigned old = xb_add(&bar[XB_XSUB(b.x)], 1u);
        const unsigned gen = old / nloc;
        if (old + 1u == (gen + 1u) * nloc) {
            __builtin_amdgcn_fence(__ATOMIC_RELEASE, "agent");
            asm volatile("s_waitcnt vmcnt(0)" ::: "memory");
            const unsigned og = xb_add(&bar[XB_TOP], 1u);
            const unsigned tg = og / nx;
            if (og + 1u == (tg + 1u) * nx) xb_add(&bar[XB_TOPGEN], 1u);
            else XB_SPIN(xb_ld(&bar[XB_TOPGEN]) == tg, bar);
            __builtin_amdgcn_fence(__ATOMIC_ACQUIRE, "agent");
            xb_add(&bar[XB_XGEN(b.x)], 1u);
            asm volatile("s_waitcnt vmcnt(0)" ::: "memory");
        } else {
            XB_SPIN(xb_ld(&bar[XB_XGEN(b.x)]) == gen, bar);
            __builtin_amdgcn_fence(__ATOMIC_ACQUIRE, "agent");
            asm volatile("s_waitcnt vmcnt(0)" ::: "memory");
        }
    }
    __syncthreads();
}

typedef const float* fptr_t;
typedef __attribute__((address_space(4))) const fptr_t* in_tab_t;
struct Frame {
    LAS unsigned char* lds;
    int tid, lane, wave, G, bx;
    in_tab_t in;
    float* out;
    unsigned char* ws;
};
__device__ __forceinline__ unsigned long long uni64(unsigned long long v) { const unsigned lo = __builtin_amdgcn_readfirstlane((unsigned)v), hi = __builtin_amdgcn_readfirstlane((unsigned)(v >> 32)); return ((unsigned long long)hi << 32) | lo; }
__device__ __forceinline__ Frame launder(const Frame& F0) {
    Frame F = F0;
    int g_ = __builtin_amdgcn_readfirstlane(F0.G), b_ = __builtin_amdgcn_readfirstlane(F0.bx);
    unsigned long long w_ = uni64((unsigned long long)F0.ws), o_ = uni64((unsigned long long)F0.out), i_ = uni64((unsigned long long)F0.in);
    asm volatile("" : "+v"(F.tid), "+s"(g_), "+s"(b_), "+s"(w_), "+s"(o_), "+s"(i_));
    F.G = g_; F.bx = b_; F.ws = (unsigned char*)(GAS unsigned char*)w_; F.out = (float*)(GAS float*)o_; F.in = (in_tab_t)i_;
    F.lane = F.tid & 63; F.wave = __builtin_amdgcn_readfirstlane(F.tid >> 6);
    return F;
}
#define FIN(k) ((const float*)(const GAS float*)(F.in[k]))


__device__ __forceinline__ float wave_sum(float v) {
#pragma unroll
    for (int o = 1; o < 64; o <<= 1) v += __shfl_xor(v, o);
    return v;
}
__device__ __forceinline__ float silu_f(float x) { return x * __builtin_amdgcn_rcpf(1.f + __builtin_amdgcn_exp2f(-1.4426950408889634f * x)); }
__device__ __forceinline__ f32x4 silu4(f32x4 v) { return (f32x4){silu_f(v[0]), silu_f(v[1]), silu_f(v[2]), silu_f(v[3])}; }
__device__ __forceinline__ float dot4(f32x4 a, f32x4 b) { return (a[0] * b[0] + a[1] * b[1]) + (a[2] * b[2] + a[3] * b[3]); }
__device__ __forceinline__ u32x4 pack8(f32x4 a, f32x4 b) { u32x4 w; w.x = cvt_pk_bf16(a[0], a[1]); w.y = cvt_pk_bf16(a[2], a[3]); w.z = cvt_pk_bf16(b[0], b[1]); w.w = cvt_pk_bf16(b[2], b[3]); return w; }
__device__ __forceinline__ u32x2 pack4(f32x4 a) { u32x2 w; w.x = cvt_pk_bf16(a[0], a[1]); w.y = cvt_pk_bf16(a[2], a[3]); return w; }
__device__ __forceinline__ float bflo(unsigned w) { return __uint_as_float(w << 16); }
__device__ __forceinline__ float bfhi(unsigned w) { return __uint_as_float(w & 0xffff0000u); }
__device__ __forceinline__ void unpack8(u32x4 w, f32x4& a, f32x4& b) { a = (f32x4){bflo(w.x), bfhi(w.x), bflo(w.y), bfhi(w.y)}; b = (f32x4){bflo(w.z), bfhi(w.z), bflo(w.w), bfhi(w.w)}; }
__device__ __forceinline__ f32x4 unpack4(u32x2 w) { return (f32x4){bflo(w.x), bfhi(w.x), bflo(w.y), bfhi(w.y)}; }
__device__ __forceinline__ float rstd16(const float* p) {
    const f32x4 a = ((const f32x4*)p)[0], b = ((const f32x4*)p)[1], c = ((const f32x4*)p)[2], d = ((const f32x4*)p)[3];
    const f32x4 s = (a + b) + (c + d);
    return rsqrtf(((s[0] + s[1]) + (s[2] + s[3])) * (1.0f / D) + EPS);
}
__device__ __forceinline__ float rstd32(const float* p) {
    f32x4 s = ((const f32x4*)p)[0];
#pragma unroll
    for (int i = 1; i < 8; ++i) s += ((const f32x4*)p)[i];
    return rsqrtf(((s[0] + s[1]) + (s[2] + s[3])) * (1.0f / D) + EPS);
}
__host__ __device__ __forceinline__ int src_even(int n) {
    const int tile = n >> 8, o = n & 255;
    if (tile < 8) return n;
    if (tile < 12) return 3072 + (n - 2048);
    const int cb = tile - 12;
    return o < 128 ? 2048 + 128 * cb + o : 4096 + 128 * cb + (o - 128);
}
__host__ __device__ __forceinline__ int src_odd(int n) {
    const int pn = n >> 8, p = n & 255, q = ((p >> 7) << 1) | ((p >> 2) & 1), ch = 64 * pn + 16 * ((p >> 5) & 3) + 4 * ((p >> 3) & 3) + (p & 3);
    const int base = q == 0 ? 2048 : (q == 1 ? 4096 : (q == 2 ? 0 : 6144));
    return base + ch;
}

struct EpiG1Even {
    static constexpr bool PERM = true, AFTER_DRAIN = false, REP_EPI = (REP_MASK >> 12) & 1;
    const float* rsq; bf16_t* Z; float* vsq; float* pool_out;
    __device__ __forceinline__ void operator()(const f32x4 (&acc)[2][2][4][2], const Unit& u, int wr, int wc, int fr_, int fq_) const {
        int fr = fr_, fq = fq_; asm volatile("" : "+v"(fr), "+v"(fq));
        const int tile = u.pn, cw = wc * 32 + 8 * fq;
#pragma unroll
        for (int ai = 0; ai < 2; ++ai)
#pragma unroll
            for (int m = 0; m < 4; ++m) {
                const int row = u.pm * 256 + ai * 128 + wr * 64 + m * 16 + fr;
                const float rs = rstd16(rsq + (size_t)row * 16);
                if (tile < 12) {
                    const int kind = tile >> 2;
                    bf16_t* dst = Z + (size_t)kind * MP * D + (size_t)row * D + (tile & 3) * 256 + cw;
                    float ss = 0.f;
#pragma unroll
                    for (int bj = 0; bj < 2; ++bj) {
                        f32x4 v0 = acc[ai][bj][m][0] * rs, v1 = acc[ai][bj][m][1] * rs;
                        if (kind == 1) { v0 = silu4(v0); v1 = silu4(v1); }
                        if (kind == 2) ss += dot4(v0, v0) + dot4(v1, v1);
                        *(u32x4*)(dst + bj * 128) = pack8(v0, v1);
                        if (kind == 0 && (row & 2047) >= 2033) {
                            float* po = pool_out + ((size_t)(row >> 11) * 15 + ((row & 2047) - 2033)) * 1024 + (tile & 3) * 256 + bj * 128 + cw;
                            *(f32x4*)po = v0; *(f32x4*)(po + 4) = v1;
                        }
                    }
                    if (kind == 2) { ss += __shfl_xor(ss, 16); ss += __shfl_xor(ss, 32); if (fq == 0) vsq[(size_t)row * 16 + (tile - 8) * 4 + wc] = ss; }
                } else {
                    const int cb = tile - 12;
                    bf16_t* dst = Z + (size_t)3 * MP * D + (size_t)row * D + cb * 128 + cw;
                    const f32x4 u0 = acc[ai][0][m][0] * rs, u1 = acc[ai][0][m][1] * rs, g0 = acc[ai][1][m][0] * rs, g1 = acc[ai][1][m][1] * rs;
                    *(u32x4*)dst = pack8(u0 * silu4(g0), u1 * silu4(g1));
                }
            }
    }
};
__device__ __forceinline__ float dpp_shr1(float old, float v) { return __builtin_bit_cast(float, __builtin_amdgcn_update_dpp(__builtin_bit_cast(int, old), __builtin_bit_cast(int, v), 0x111, 0xf, 0xf, false)); }
__device__ __forceinline__ float dpp_shr2(float old, float v) { return __builtin_bit_cast(float, __builtin_amdgcn_update_dpp(__builtin_bit_cast(int, old), __builtin_bit_cast(int, v), 0x112, 0xf, 0xf, false)); }
struct EpiG1Odd {
    static constexpr bool PERM = true, AFTER_DRAIN = false, REP_EPI = false;
    const float* rsq; bf16_t* A2; const float* cw; float* conv_out; float* side; LAS float* halo;
    __device__ __forceinline__ void operator()(const f32x4 (&acc)[2][2][4][2], const Unit& u, int wr, int wc, int fr_, int fq_) const {
        int fr = fr_, fq = fq_; asm volatile("" : "+v"(fr), "+v"(fq));
        const int chl = wc * 16 + 4 * fq, ch = u.pn * 64 + chl;
        const f32x4 w0 = *(const f32x4*)(cw + ch), w1 = *(const f32x4*)(cw + 2048 + ch), w2 = *(const f32x4*)(cw + 4096 + ch);
        f32x4 e[2][4]; float rsv[2][4];
#pragma unroll
        for (int ai = 0; ai < 2; ++ai)
#pragma unroll
            for (int m = 0; m < 4; ++m) {
                const int rb = 8 * ai + 4 * wr + m, row = u.pm * 256 + 16 * rb + fr;
                const float rs = rstd16(rsq + (size_t)row * 16); rsv[ai][m] = rs;
                e[ai][m] = (acc[ai][0][m][0] * rs) * (acc[ai][0][m][1] * rs);
                if (fr >= 14) *(LAS f32x4*)(halo + (rb * 2 + (fr - 14)) * 64 + chl) = e[ai][m];
                if (m & 1) asm volatile("" ::: "memory");
            }
        asm volatile("s_waitcnt lgkmcnt(0)" ::: "memory"); __builtin_amdgcn_s_barrier(); asm volatile("" ::: "memory");
        float* sd = side + (size_t)u.pm * 6 * 2048 + ch;
#pragma unroll
        for (int ai = 0; ai < 2; ++ai)
#pragma unroll
            for (int m = 0; m < 4; ++m) {
                const int rb = 8 * ai + 4 * wr + m, row = u.pm * 256 + 16 * rb + fr;
                const float rs = rsv[ai][m];
                const f32x4 sg = (acc[ai][1][m][0] * rs) * silu4(acc[ai][1][m][1] * rs);
                f32x4 h0 = (f32x4){0.f, 0.f, 0.f, 0.f}, h1 = h0;
                if (rb > 0) { h0 = *(const LAS f32x4*)(halo + ((rb - 1) * 2 + 0) * 64 + chl); h1 = *(const LAS f32x4*)(halo + ((rb - 1) * 2 + 1) * 64 + chl); }
                const f32x4 hx = fr == 0 ? h0 : h1, ev = e[ai][m];
                f32x4 e1, e2;
#pragma unroll
                for (int k = 0; k < 4; ++k) { e1[k] = dpp_shr1(h1[k], ev[k]); e2[k] = dpp_shr2(hx[k], ev[k]); }
                const f32x4 a = sg * (w0 * e2 + w1 * e1 + w2 * ev);
                const bool top = (rb == 0 && fr < 2);
                if (!(top && (u.pm & 7) != 0)) *(u32x2*)(A2 + (size_t)row * 2048 + ch) = pack4(a);
                if (top) { *(f32x4*)(sd + fr * 2048) = ev; *(f32x4*)(sd + (4 + fr) * 2048) = sg; }
                if (rb == 15 && fr >= 14) {
                    *(f32x4*)(sd + (2 + fr - 14) * 2048) = ev;
                    if ((u.pm & 7) == 7) *(f32x4*)(conv_out + ((size_t)(u.pm >> 3) * 2 + (fr - 14)) * 2048 + ch) = ev;
                }
            }
    }
};
__device__ __forceinline__ void conv_fixup(const float* side, const float* cw, bf16_t* A2, int pm, int tid) {
    if ((pm & 7) == 0) return;
    const int ch = 4 * tid;
    const float* sp = side + (size_t)(pm - 1) * 6 * 2048 + ch; const float* sc = side + (size_t)pm * 6 * 2048 + ch;
    const f32x4 em2 = *(const f32x4*)(sp + 2 * 2048), em1 = *(const f32x4*)(sp + 3 * 2048), e0 = *(const f32x4*)sc, e1 = *(const f32x4*)(sc + 2048), s0 = *(const f32x4*)(sc + 4 * 2048), s1 = *(const f32x4*)(sc + 5 * 2048);
    const f32x4 w0 = *(const f32x4*)(cw + ch), w1 = *(const f32x4*)(cw + 2048 + ch), w2 = *(const f32x4*)(cw + 4096 + ch);
    *(u32x2*)(A2 + (size_t)(pm * 256) * 2048 + ch) = pack4(s0 * (w0 * em2 + w1 * em1 + w2 * e0));
    *(u32x2*)(A2 + (size_t)(pm * 256 + 1) * 2048 + ch) = pack4(s1 * (w0 * em1 + w1 * e0 + w2 * e1));
}
struct EpiRes {
    static constexpr bool PERM = true, AFTER_DRAIN = false, REP_EPI = false;
    const float* base; float* out; bf16_t* xb; float* rsq;
    __device__ __forceinline__ void operator()(const f32x4 (&acc)[2][2][4][2], const Unit& u, int wr, int wc, int fr_, int fq_) const {
        int fr = fr_, fq = fq_; asm volatile("" : "+v"(fr), "+v"(fq));
        const int cw = wc * 32 + 8 * fq;
#pragma unroll
        for (int ai = 0; ai < 2; ++ai)
#pragma unroll
            for (int m = 0; m < 4; ++m) {
                const int row = u.pm * 256 + ai * 128 + wr * 64 + m * 16 + fr;
                float ss = 0.f;
#pragma unroll
                for (int bj = 0; bj < 2; ++bj) {
                    const size_t off = (size_t)row * D + u.pn * 256 + bj * 128 + cw;
                    const f32x4 o0 = *(const f32x4*)(base + off) + acc[ai][bj][m][0], o1 = *(const f32x4*)(base + off + 4) + acc[ai][bj][m][1];
                    *(f32x4*)(out + off) = o0; *(f32x4*)(out + off + 4) = o1;
                    *(u32x4*)(xb + off) = pack8(o0, o1);
                    ss += dot4(o0, o0) + dot4(o1, o1);
                }
                ss += __shfl_xor(ss, 16); ss += __shfl_xor(ss, 32);
                if (fq == 0) rsq[(size_t)row * 16 + u.pn * 4 + wc] = ss;
                asm volatile("" ::: "memory");
            }
    }
};
struct EpiQ {
    static constexpr bool PERM = true, AFTER_DRAIN = false, REP_EPI = false;
    const float* rsq; bf16_t* Q;
    __device__ __forceinline__ void operator()(const f32x4 (&acc)[2][2][4][2], const Unit& u, int wr, int wc, int fr_, int fq_) const {
        int fr = fr_, fq = fq_; asm volatile("" : "+v"(fr), "+v"(fq));
        const int cw = wc * 32 + 8 * fq;
#pragma unroll
        for (int ai = 0; ai < 2; ++ai)
#pragma unroll
            for (int m = 0; m < 4; ++m) {
                const int row = u.pm * 256 + ai * 128 + wr * 64 + m * 16 + fr;
                const float rs = rstd16(rsq + (size_t)row * 16);
#pragma unroll
                for (int bj = 0; bj < 2; ++bj) *(u32x4*)(Q + (size_t)row * D + u.pn * 256 + bj * 128 + cw) = pack8(acc[ai][bj][m][0] * rs, acc[ai][bj][m][1] * rs);
            }
    }
};
struct EpiMemKV {
    static constexpr bool PERM = true, AFTER_DRAIN = false, REP_EPI = false;
    const float* rstdm; float* outk; float* outv; bf16_t* kb; bf16_t* vb;
    __device__ __forceinline__ void operator()(const f32x4 (&acc)[2][2][4][2], const Unit& u, int wr, int wc, int fr_, int fq_) const {
        int fr = fr_, fq = fq_; asm volatile("" : "+v"(fr), "+v"(fq));
        const int layer = u.pn >> 3, isv = (u.pn >> 2) & 1, cw = (u.pn & 3) * 256 + wc * 32 + 8 * fq;
        float* of = (isv ? outv : outk) + (size_t)layer * MMEM * D; bf16_t* ob = (isv ? vb : kb) + (size_t)layer * MMEM * D;
#pragma unroll
        for (int ai = 0; ai < 2; ++ai)
#pragma unroll
            for (int m = 0; m < 4; ++m) {
                const int row = u.pm * 256 + ai * 128 + wr * 64 + m * 16 + fr;
                const float rs = rstdm[row];
#pragma unroll
                for (int bj = 0; bj < 2; ++bj) {
                    const size_t off = (size_t)row * D + bj * 128 + cw;
                    const f32x4 v0 = acc[ai][bj][m][0] * rs, v1 = acc[ai][bj][m][1] * rs;
                    *(f32x4*)(of + off) = v0; *(f32x4*)(of + off + 4) = v1;
                    *(u32x4*)(ob + off) = pack8(v0, v1);
                }
            }
    }
};

__device__ __forceinline__ void p0_tr_item(const float* W, int ldw, int k0, int srccol, const float* gk, float sc, bf16_t* WT, int K, int dstn0, LAS float* scr, int lane) {
    float v[32];
    const float* wp = W + (size_t)(k0 + (lane >> 5)) * ldw + srccol;
#pragma unroll
    for (int i = 0; i < 32; ++i) v[i] = wp[(size_t)(2 * i) * ldw];
#pragma unroll
    for (int i = 0; i < 32; ++i) scr[(2 * i + (lane >> 5)) * 33 + (lane & 31)] = v[i];
    LDS_WAIT(); asm volatile("" ::: "memory");
    const int c = lane & 7;
    f32x4 g0 = (f32x4){sc, sc, sc, sc}, g1 = g0;
    if (gk) { g0 = *(const f32x4*)(gk + k0 + 8 * c) * sc; g1 = *(const f32x4*)(gk + k0 + 8 * c + 4) * sc; }
#pragma unroll
    for (int jj = 0; jj < 4; ++jj) {
        const int n = (lane >> 3) + 8 * jj; const LAS float* s = scr + (8 * c) * 33 + n;
        u32x4 o; o.x = cvt_pk_bf16(s[0 * 33] * g0[0], s[1 * 33] * g0[1]); o.y = cvt_pk_bf16(s[2 * 33] * g0[2], s[3 * 33] * g0[3]); o.z = cvt_pk_bf16(s[4 * 33] * g1[0], s[5 * 33] * g1[1]); o.w = cvt_pk_bf16(s[6 * 33] * g1[2], s[7 * 33] * g1[3]);
        *(u32x4*)(WT + (size_t)(dstn0 + n) * K + k0 + 8 * c) = o;
    }
    LDS_WAIT(); asm volatile("" ::: "memory");
}
__device__ __forceinline__ void p0_tr_matrix(const float* W, int ldw, int K, int Nd, const float* gk, float sc, bf16_t* WT, int perm, int r, LAS float* scr, int lane) {
    const int nblk = Nd / 32, kb = r / nblk, nb = r % nblk, dstn0 = 32 * nb, dn = dstn0 + (lane & 31);
    const int srccol = perm == 0 ? dn : (perm == 1 ? src_even(dn) : src_odd(dn));
    p0_tr_item(W, ldw, 64 * kb, srccol, gk, sc, WT, K, dstn0, scr, lane);
}
__device__ __forceinline__ float p0_row(const float* src, bf16_t* dst, float* copy, int lane) {
    const f32x4* xr = (const f32x4*)src + lane;
    f32x4 v[4]; float s = 0.f;
#pragma unroll
    for (int jj = 0; jj < 4; ++jj) { v[jj] = xr[64 * jj]; s += dot4(v[jj], v[jj]); }
    s = wave_sum(s);
    u32x2* o8 = (u32x2*)dst + lane;
#pragma unroll
    for (int jj = 0; jj < 4; ++jj) o8[64 * jj] = pack4(v[jj]);
    if (copy) {
#pragma unroll
        for (int jj = 0; jj < 4; ++jj) ((f32x4*)copy + lane)[64 * jj] = v[jj];
    }
    return s;
}
__device__ __forceinline__ void p0_prologue(Frame& F0) {
    Frame F = launder(F0);
    LAS float* scr = (LAS float*)(F.lds + F.wave * 16384);
    const int gw = F.bx * NWAVES + F.wave, NGW = F.G * NWAVES, lane = F.lane;
    constexpr int I_AB1 = 16 * (NAB / 32), I_C1 = 16 * (NC / 32), I_2 = 32 * 32, I_SQ = 16 * 32, I_PM = 4 * 8;
    constexpr int NITEMS = 2 * I_AB1 + 2 * I_C1 + 4 * I_2 + 16 * I_SQ + 8 * I_PM;
    for (int it = gw; it < NITEMS; it += NGW) {
        int r = it;
        if (r < 2 * I_AB1) { const int jj = r / I_AB1; p0_tr_matrix(FIN(10) + (size_t)jj * D * NAB, NAB, D, NAB, FIN(7) + 2 * jj * D, 1.f, ((bf16_t*)(F.ws + WS_AB1)) + (size_t)jj * NAB * D, 1, r % I_AB1, scr, lane); continue; } r -= 2 * I_AB1;
        if (r < 2 * I_C1) { const int jj = r / I_C1; p0_tr_matrix(FIN(17) + (size_t)jj * D * NC, NC, D, NC, FIN(7) + (2 * jj + 1) * D, 1.f, ((bf16_t*)(F.ws + WS_C1)) + (size_t)jj * NC * D, 2, r % I_C1, scr, lane); continue; } r -= 2 * I_C1;
        if (r < 2 * I_2) { const int jj = r / I_2; p0_tr_matrix(FIN(16) + (size_t)jj * 2048 * D, D, 2048, D, nullptr, 1.f, ((bf16_t*)(F.ws + WS_AB2)) + (size_t)jj * D * 2048, 0, r % I_2, scr, lane); continue; } r -= 2 * I_2;
        if (r < 2 * I_2) { const int jj = r / I_2; p0_tr_matrix(FIN(19) + (size_t)jj * 2048 * D, D, 2048, D, nullptr, 1.f, ((bf16_t*)(F.ws + WS_C2)) + (size_t)jj * D * 2048, 0, r % I_2, scr, lane); continue; } r -= 2 * I_2;
        if (r < 4 * I_SQ) { const int l = r / I_SQ; p0_tr_matrix(FIN(20) + (size_t)l * D * D, D, D, D, FIN(8) + l * D, QSCALE, ((bf16_t*)(F.ws + WS_WQ)) + (size_t)l * D * D, 0, r % I_SQ, scr, lane); continue; } r -= 4 * I_SQ;
        if (r < 4 * I_SQ) { const int l = r / I_SQ; p0_tr_matrix(FIN(21) + (size_t)l * D * D, D, D, D, FIN(9) + l * D, 1.f, ((bf16_t*)(F.ws + WS_WKV)) + (size_t)(2 * l) * D * D, 0, r % I_SQ, scr, lane); continue; } r -= 4 * I_SQ;
        if (r < 4 * I_SQ) { const int l = r / I_SQ; p0_tr_matrix(FIN(22) + (size_t)l * D * D, D, D, D, FIN(9) + l * D, 1.f, ((bf16_t*)(F.ws + WS_WKV)) + (size_t)(2 * l + 1) * D * D, 0, r % I_SQ, scr, lane); continue; } r -= 4 * I_SQ;
        if (r < 4 * I_SQ) { const int l = r / I_SQ; p0_tr_matrix(FIN(23) + (size_t)l * D * D, D, D, D, nullptr, 1.f, ((bf16_t*)(F.ws + WS_WO)) + (size_t)l * D * D, 0, r % I_SQ, scr, lane); continue; } r -= 4 * I_SQ;
        { const int jg = r / I_PM; p0_tr_matrix(FIN(11) + (size_t)jg * 65536, 256, 256, 256, nullptr, 1.f, ((bf16_t*)(F.ws + WS_PMT)) + (size_t)jg * 65536, 0, r % I_PM, scr, lane); }
    }
    for (int m = gw; m < MP + MS + MMEM; m += NGW) {
        if (m < MP) {
            const float s = p0_row(FIN(0) + (size_t)m * D, ((bf16_t*)(F.ws + WS_XB)) + (size_t)m * D, nullptr, lane);
            if (lane < 16) ((float*)(F.ws + WS_RSQ))[(size_t)m * 16 + lane] = lane == 0 ? s : 0.f;
        } else if (m < MP + MS) {
            const int b = m - MP;
            const float s = p0_row(FIN(1) + (size_t)b * D, ((bf16_t*)(F.ws + WS_XB)) + (size_t)m * D, ((float*)(F.ws + WS_XS)) + (size_t)b * D, lane);
            if (lane < 32) ((float*)(F.ws + WS_SMALL))[b * 32 + lane] = lane == 0 ? s : 0.f;
        } else {
            const int t = m - MP - MS;
            const float s = p0_row(FIN(2) + (size_t)t * D, ((bf16_t*)(F.ws + WS_MEMB)) + (size_t)t * D, nullptr, lane);
            if (lane == 0) ((float*)(F.ws + WS_SMALL + 65536))[t] = rsqrtf(s * (1.0f / D) + EPS);
        }
    }
}

__device__ __forceinline__ bf16x8 tr_frag(LAS unsigned char* p0, LAS unsigned char* p1) {
    const s16x4 lo = __builtin_amdgcn_ds_read_tr16_b64_v4i16((LAS s16x4*)p0);
    const s16x4 hi = __builtin_amdgcn_ds_read_tr16_b64_v4i16((LAS s16x4*)p1);
    return (bf16x8){lo[0], lo[1], lo[2], lo[3], hi[0], hi[1], hi[2], hi[3]};
}
#define MFMA16(a, b, c) __builtin_amdgcn_mfma_f32_16x16x32_bf16((a), (b), (c), 0, 0, 0)

constexpr int SGU_AS = 0, SGU_VS = 34816, SGU_RV = 34816 + 67584;
__device__ __forceinline__ void sgu_unit(Frame& F0, int j, int n, int g) {
    Frame F = launder(F0);
    LAS unsigned char* lds = F.lds;
    const int tid = F.tid, lane = F.lane, w = F.wave, fr = lane & 15, fq = lane >> 4, row0 = n * 128;
    LAS float* rvs = (LAS float*)(lds + SGU_RV);
    if (tid < 128) rvs[tid] = rstd16(((float*)(F.ws + WS_VSQ)) + (size_t)(row0 + tid) * 16);
    const bf16_t* ZV = ((bf16_t*)(F.ws + WS_Z)) + (size_t)2 * MP * D;
#pragma unroll
    for (int i = 0; i < 8; ++i) {
        const int idx = tid + 512 * i, s = idx >> 5, c8 = idx & 31;
        *(LAS u32x4*)(lds + SGU_VS + s * 528 + c8 * 16) = *(const u32x4*)(ZV + (size_t)(row0 + s) * D + g * 256 + c8 * 8);
    }
    __syncthreads();
    const float* wg = FIN(13) + (size_t)(j * 4 + g) * 16384;
#pragma unroll
    for (int i = 0; i < 4; ++i) {
        const int idx = tid + 512 * i, t = idx >> 4, s0 = (idx & 15) * 8;
        const f32x4 a = *(const f32x4*)(wg + t * 128 + s0), b = *(const f32x4*)(wg + t * 128 + s0 + 4);
        float v[8];
#pragma unroll
        for (int e = 0; e < 4; ++e) { v[e] = (s0 + e <= t) ? a[e] * rvs[s0 + e] : 0.f; v[4 + e] = (s0 + 4 + e <= t) ? b[e] * rvs[s0 + 4 + e] : 0.f; }
        u32x4 o; o.x = cvt_pk_bf16(v[0], v[1]); o.y = cvt_pk_bf16(v[2], v[3]); o.z = cvt_pk_bf16(v[4], v[5]); o.w = cvt_pk_bf16(v[6], v[7]);
        *(LAS u32x4*)(lds + SGU_AS + t * 272 + s0 * 2) = o;
    }
    __syncthreads();
    f32x4 acc[8][2];
#pragma unroll
    for (int mt = 0; mt < 8; ++mt) { acc[mt][0] = (f32x4){0.f, 0.f, 0.f, 0.f}; acc[mt][1] = (f32x4){0.f, 0.f, 0.f, 0.f}; }
#pragma unroll
    for (int ks = 0; ks < 4; ++ks) {
        bf16x8 Bf[2];
#pragma unroll
        for (int nt = 0; nt < 2; ++nt) {
            LAS unsigned char* p = lds + SGU_VS + (32 * ks + 8 * fq + (fr >> 2)) * 528 + (32 * w + 16 * nt + 4 * (fr & 3)) * 2;
            Bf[nt] = tr_frag(p, p + 4 * 528);
        }
#pragma unroll
        for (int mt = 0; mt < 8; ++mt) {
            if (32 * ks <= 16 * mt + 15) {
                const bf16x8 Af = *(LAS bf16x8*)(lds + SGU_AS + (16 * mt + fr) * 272 + (32 * ks + 8 * fq) * 2);
                acc[mt][0] = MFMA16(Bf[0], Af, acc[mt][0]); acc[mt][1] = MFMA16(Bf[1], Af, acc[mt][1]);
            }
        }
    }
    const bf16_t* ZUG = ((bf16_t*)(F.ws + WS_Z)) + (size_t)3 * MP * D;
#pragma unroll
    for (int nt = 0; nt < 2; ++nt) {
        const int c = g * 256 + 32 * w + 16 * nt + 4 * fq;
        const f32x4 gg = *(const f32x4*)(FIN(15) + j * 1024 + c);
#pragma unroll
        for (int mt = 0; mt < 8; ++mt) {
            const int t = 16 * mt + fr;
            const float bb = FIN(14)[(j * 4 + g) * 128 + t];
            const f32x4 ug = unpack4(*(const u32x2*)(ZUG + (size_t)(row0 + t) * D + c));
            *(u32x2*)(((bf16_t*)(F.ws + WS_A2)) + (size_t)(row0 + t) * 2048 + 1024 + c) = pack4(ug * (acc[mt][nt] * gg + bb));
        }
    }
    __syncthreads();
}
__device__ __forceinline__ void pool_unit(Frame& F0, int j, int n, int g) {
    Frame F = launder(F0);
    LAS unsigned char* lds = F.lds;
    const int tid = F.tid, lane = F.lane, w = F.wave, fr = lane & 15, fq = lane >> 4, row0 = n * 128;
    {
        const int cb = tid & 31, t0 = (tid >> 5) * 8, win = 2 << g, pos0 = (row0 & 2047) + t0;
        const bf16_t* xa = ((bf16_t*)(F.ws + WS_Z)) + (size_t)(row0 + t0) * D + g * 256 + cb * 8;
        f32x4 S0 = (f32x4){0.f, 0.f, 0.f, 0.f}, S1 = S0;
        for (int i = 1; i < win; ++i) if (pos0 - i >= 0) { f32x4 a, b; unpack8(*(const u32x4*)(xa - (size_t)i * D), a, b); S0 += a; S1 += b; }
#pragma unroll
        for (int r = 0; r < 8; ++r) {
            f32x4 a, b; unpack8(*(const u32x4*)(xa + (size_t)r * D), a, b); S0 += a; S1 += b;
            const int cnt = (pos0 + r + 1) < win ? (pos0 + r + 1) : win; const float ic = 1.0f / (float)cnt;
            *(LAS u32x4*)(lds + (t0 + r) * 528 + cb * 16) = pack8(S0 * ic - a, S1 * ic - b);
            if (pos0 + r - (win - 1) >= 0) { f32x4 c, d; unpack8(*(const u32x4*)(xa + ((ptrdiff_t)r - (win - 1)) * D), c, d); S0 -= c; S1 -= d; }
        }
    }
    __syncthreads();
    f32x4 acc[8][2];
#pragma unroll
    for (int mt = 0; mt < 8; ++mt) { acc[mt][0] = (f32x4){0.f, 0.f, 0.f, 0.f}; acc[mt][1] = (f32x4){0.f, 0.f, 0.f, 0.f}; }
    const bf16_t* pm = ((bf16_t*)(F.ws + WS_PMT)) + (size_t)(j * 4 + g) * 65536 + (size_t)(32 * w + fr) * 256 + 8 * fq;
#pragma unroll
    for (int ks = 0; ks < 8; ++ks) {
        const bf16x8 B0 = *(const bf16x8*)(pm + 32 * ks), B1 = *(const bf16x8*)(pm + 16 * 256 + 32 * ks);
#pragma unroll
        for (int mt = 0; mt < 8; ++mt) {
            const bf16x8 Af = *(LAS bf16x8*)(lds + (16 * mt + fr) * 528 + (32 * ks + 8 * fq) * 2);
            acc[mt][0] = MFMA16(B0, Af, acc[mt][0]); acc[mt][1] = MFMA16(B1, Af, acc[mt][1]);
        }
    }
    const bf16_t* ZSGA = ((bf16_t*)(F.ws + WS_Z)) + (size_t)1 * MP * D;
#pragma unroll
    for (int nt = 0; nt < 2; ++nt) {
        const int c = g * 256 + 32 * w + 16 * nt + 4 * fq;
        const f32x4 ps = *(const f32x4*)(FIN(12) + j * 1024 + c);
#pragma unroll
        for (int mt = 0; mt < 8; ++mt) {
            const int t = 16 * mt + fr;
            const f32x4 sg = unpack4(*(const u32x2*)(ZSGA + (size_t)(row0 + t) * D + c));
            *(u32x2*)(((bf16_t*)(F.ws + WS_A2)) + (size_t)(row0 + t) * 2048 + c) = pack4(acc[mt][nt] * ps * sg);
        }
    }
    __syncthreads();
}
constexpr int ATT_SLOT = 64 * 528;
__device__ __forceinline__ void attn_prompt(Frame& F0, int layer) {
    Frame F = launder(F0);
    LAS unsigned char* lds = F.lds;
    const int tid = F.tid, lane = F.lane, w = F.wave, fr = lane & 15, fq = lane >> 4;
    const bf16_t* Kl = ((bf16_t*)(F.ws + WS_KB)) + (size_t)layer * MMEM * D; const bf16_t* Vl = ((bf16_t*)(F.ws + WS_VB)) + (size_t)layer * MMEM * D;
    for (int unit = F.bx; unit < 512; unit += F.G) {
        const int bh = unit >> 4, b = bh >> 2, h = bh & 3, qb = unit & 15;
        const size_t rowq = (size_t)b * SEQ + qb * 128 + 16 * w + fr;
        bf16x8 Qf[8];
#pragma unroll
        for (int ks = 0; ks < 8; ++ks) Qf[ks] = *(const bf16x8*)(((bf16_t*)(F.ws + WS_Q)) + rowq * D + h * 256 + 32 * ks + 8 * fq);
        const bf16_t* kbase = Kl + (size_t)(b * 256) * D + h * 256; const bf16_t* vbase = Vl + (size_t)(b * 256) * D + h * 256;
        u32x4 st[4];
#define ATT_GLOAD(c) do { const bf16_t* src_ = ((c) < 4 ? kbase : vbase) + (size_t)(64 * ((c) & 3)) * D; _Pragma("unroll") for (int i_ = 0; i_ < 4; ++i_) { const int idx_ = tid + 512 * i_; st[i_] = *(const u32x4*)(src_ + (size_t)(idx_ >> 5) * D + (idx_ & 31) * 8); } } while (0)
#define ATT_LSTORE(slot) do { _Pragma("unroll") for (int i_ = 0; i_ < 4; ++i_) { const int idx_ = tid + 512 * i_; *(LAS u32x4*)(lds + (slot) * ATT_SLOT + (idx_ >> 5) * 528 + (idx_ & 31) * 16) = st[i_]; } } while (0)
        f32x4 S[16], Oa[16]; bf16x8 Pf[8]; float inv = 0.f;
#pragma unroll
        for (int i = 0; i < 16; ++i) { S[i] = (f32x4){0.f, 0.f, 0.f, 0.f}; Oa[i] = (f32x4){0.f, 0.f, 0.f, 0.f}; }
        ATT_GLOAD(0); ATT_LSTORE(0); __syncthreads();
#pragma unroll
        for (int c = 0; c < 8; ++c) {
            if (c < 7) ATT_GLOAD(c + 1);
            LAS unsigned char* slot = lds + (c & 1) * ATT_SLOT;
            if (c < 4) {
#pragma unroll
                for (int ml = 0; ml < 4; ++ml)
#pragma unroll
                    for (int ks = 0; ks < 8; ++ks) {
                        const bf16x8 Kf = *(LAS bf16x8*)(slot + (16 * ml + fr) * 528 + (32 * ks + 8 * fq) * 2);
                        S[4 * c + ml] = MFMA16(Kf, Qf[ks], S[4 * c + ml]);
                    }
                if (c == 3) {
                    float mx = S[0][0];
#pragma unroll
                    for (int i = 0; i < 16; ++i) { mx = fmaxf(mx, fmaxf(fmaxf(S[i][0], S[i][1]), fmaxf(S[i][2], S[i][3]))); }
                    mx = fmaxf(mx, __shfl_xor(mx, 16)); mx = fmaxf(mx, __shfl_xor(mx, 32));
                    float sum = 0.f;
#pragma unroll
                    for (int i = 0; i < 16; ++i) {
#pragma unroll
                        for (int e = 0; e < 4; ++e) { S[i][e] = __builtin_amdgcn_exp2f(S[i][e] - mx); sum += S[i][e]; }
                    }
                    sum += __shfl_xor(sum, 16); sum += __shfl_xor(sum, 32);
                    inv = 1.0f / sum;
#pragma unroll
                    for (int a = 0; a < 8; ++a) {
                        u32x4 pw; pw.x = cvt_pk_bf16(S[2 * a][0], S[2 * a][1]); pw.y = cvt_pk_bf16(S[2 * a][2], S[2 * a][3]); pw.z = cvt_pk_bf16(S[2 * a + 1][0], S[2 * a + 1][1]); pw.w = cvt_pk_bf16(S[2 * a + 1][2], S[2 * a + 1][3]);
                        Pf[a] = __builtin_bit_cast(bf16x8, pw);
                    }
                }
            } else {
#pragma unroll
                for (int al = 0; al < 2; ++al)
#pragma unroll
                    for (int dt = 0; dt < 16; ++dt) {
                        LAS unsigned char* p = slot + (32 * al + 4 * fq + (fr >> 2)) * 528 + (16 * dt + 4 * (fr & 3)) * 2;
                        const bf16x8 Vf = tr_frag(p, p + 16 * 528);
                        Oa[dt] = MFMA16(Vf, Pf[2 * (c - 4) + al], Oa[dt]);
                    }
            }
            if (c < 7) ATT_LSTORE((c + 1) & 1);
            __syncthreads();
        }
#pragma unroll
        for (int dt = 0; dt < 16; ++dt) *(u32x2*)(((bf16_t*)(F.ws + WS_O)) + rowq * D + h * 256 + 16 * dt + 4 * fq) = pack4(Oa[dt] * inv);
#undef ATT_GLOAD
#undef ATT_LSTORE
    }
}

template <class Epi>
__device__ __forceinline__ void skinny_gemm(Frame& F0, const bf16_t* A, const bf16_t* Bt, int N, int K, const Epi& E) {
    Frame F = launder(F0);
    LAS unsigned char* lds = F.lds;
    const int tid = F.tid, lane = F.lane, w = F.wave, fr = lane & 15, fq = lane >> 4;
    const int nstrips = N / 32, kslice = K / 8, nks = kslice / 32;
    for (int strip = F.bx; strip < nstrips; strip += F.G) {
        f32x4 acc[8][2];
#pragma unroll
        for (int mt = 0; mt < 8; ++mt) { acc[mt][0] = (f32x4){0.f, 0.f, 0.f, 0.f}; acc[mt][1] = (f32x4){0.f, 0.f, 0.f, 0.f}; }
        const bf16_t* ap = A + (size_t)fr * K + w * kslice + 8 * fq; const bf16_t* bp = Bt + (size_t)(strip * 32 + fr) * K + w * kslice + 8 * fq;
#pragma unroll 2
        for (int ks = 0; ks < nks; ++ks) {
            const bf16x8 B0 = *(const bf16x8*)(bp + 32 * ks), B1 = *(const bf16x8*)(bp + (size_t)16 * K + 32 * ks);
#pragma unroll
            for (int mt = 0; mt < 8; ++mt) {
                const bf16x8 Af = *(const bf16x8*)(ap + (size_t)(16 * mt) * K + 32 * ks);
                acc[mt][0] = MFMA16(B0, Af, acc[mt][0]); acc[mt][1] = MFMA16(B1, Af, acc[mt][1]);
            }
        }
#pragma unroll
        for (int mt = 0; mt < 8; ++mt)
#pragma unroll
            for (int nt = 0; nt < 2; ++nt) *(LAS f32x4*)(lds + ((size_t)((w * 128 + 16 * mt + fr) * 32 + 16 * nt + 4 * fq)) * 4) = acc[mt][nt];
        __syncthreads();
        const int row = tid >> 2, cq = tid & 3;
        f32x4 s0 = (f32x4){0.f, 0.f, 0.f, 0.f}, s1 = s0;
#pragma unroll
        for (int ww = 0; ww < 8; ++ww) { const LAS f32x4* p = (const LAS f32x4*)(lds + ((size_t)((ww * 128 + row) * 32 + 8 * cq)) * 4); s0 += p[0]; s1 += p[1]; }
        E(row, strip, strip * 32 + 8 * cq, s0, s1);
        __syncthreads();
    }
}
struct SEpiZ {
    const float* rsqs; float* SZ; int ldz, mode;
    __device__ __forceinline__ void operator()(int row, int strip, int col, f32x4 s0, f32x4 s1) const {
        const float rs = rstd32(rsqs + row * 32); const int oc0 = mode == 0 ? src_even(col) : src_odd(col), oc1 = mode == 0 ? src_even(col + 4) : src_odd(col + 4);
        float* p = SZ + (size_t)row * ldz; *(f32x4*)(p + oc0) = s0 * rs; *(f32x4*)(p + oc1) = s1 * rs;
    }
};
struct SEpiRes {
    float* xs; bf16_t* xb; float* rsqs;
    __device__ __forceinline__ void operator()(int row, int strip, int col, f32x4 s0, f32x4 s1) const {
        float* p = xs + (size_t)row * D + col; const f32x4 o0 = *(const f32x4*)p + s0, o1 = *(const f32x4*)(p + 4) + s1;
        *(f32x4*)p = o0; *(f32x4*)(p + 4) = o1; *(u32x4*)(xb + (size_t)row * D + col) = pack8(o0, o1);
        float ss = dot4(o0, o0) + dot4(o1, o1); ss += __shfl_xor(ss, 1); ss += __shfl_xor(ss, 2);
        if ((col & 31) == 0) rsqs[row * 32 + strip] = ss;
    }
};
struct SEpiQ {
    const float* rsqs; float* SQ;
    __device__ __forceinline__ void operator()(int row, int strip, int col, f32x4 s0, f32x4 s1) const {
        const float rs = rstd32(rsqs + row * 32); float* p = SQ + (size_t)row * D + col; *(f32x4*)p = s0 * rs; *(f32x4*)(p + 4) = s1 * rs;
    }
};
__device__ __forceinline__ void sample_mix_even(Frame& F0, int j, int b) {
    Frame F = launder(F0);
    LAS float* pl = (LAS float*)F.lds; LAS float* red = pl + 1024;
    const int tid = F.tid, lane = F.lane, w = F.wave;
    const float* z = ((float*)(F.ws + WS_SZ)) + (size_t)b * 8192;
    float vv[2], ss = 0.f;
#pragma unroll
    for (int k = 0; k < 2; ++k) { vv[k] = z[3072 + tid + 512 * k]; ss += vv[k] * vv[k]; }
    ss = wave_sum(ss); if (lane == 0) red[w] = ss;
#pragma unroll
    for (int k = 0; k < 2; ++k) {
        const int c = tid + 512 * k, g = c >> 8, win = 2 << g; const float xa = z[c];
        const float* st = FIN(3) + ((size_t)(j * 128 + b) * 15) * 1024 + c;
        float s = xa; for (int r = 16 - win; r < 15; ++r) s += st[(size_t)r * 1024];
        pl[c] = s / (float)win - xa;
        float* po = F.out + O_POOLS + ((size_t)(j * 128 + b) * 15) * 1024 + c;
        for (int r = 0; r < 14; ++r) po[(size_t)r * 1024] = st[(size_t)(r + 1) * 1024];
        po[(size_t)14 * 1024] = xa;
    }
    __syncthreads();
    float tot = 0.f;
#pragma unroll
    for (int i = 0; i < 8; ++i) tot += red[i];
    const float rv = rsqrtf(tot * (1.0f / D) + EPS);
#pragma unroll
    for (int k = 0; k < 2; ++k) {
        const int d = tid + 512 * k, g = d >> 8, dd = d & 255;
        const float* pm = FIN(11) + (size_t)(j * 4 + g) * 65536 + dd; const LAS float* pg = pl + g * 256;
        float a = 0.f;
#pragma unroll 8
        for (int c = 0; c < 256; ++c) a += pg[c] * pm[(size_t)c * 256];
        const float ya = a * FIN(12)[j * 1024 + d] * silu_f(z[1024 + d]);
        const float vn = vv[k] * rv * FIN(15)[j * 1024 + d];
        F.out[O_SGUV + (size_t)(j * 128 + b) * 1024 + d] = vn;
        const float mixed = FIN(13)[(size_t)(j * 4 + g) * 16384] * vn + FIN(14)[(j * 4 + g) * 128];
        const float yb = z[2048 + d] * mixed * silu_f(z[4096 + d]);
        ((bf16_t*)(F.ws + WS_SA2))[(size_t)b * 2048 + d] = (bf16_t)(cvt_pk_bf16(ya, 0.f) & 0xffffu); ((bf16_t*)(F.ws + WS_SA2))[(size_t)b * 2048 + 1024 + d] = (bf16_t)(cvt_pk_bf16(yb, 0.f) & 0xffffu);
    }
    __syncthreads();
}
__device__ __forceinline__ void sample_conv_odd(Frame& F0, int j, int b) {
    Frame F = launder(F0);
    const int tid = F.tid;
    const float* z = ((float*)(F.ws + WS_SZ)) + (size_t)b * 8192;
    const float* cw = FIN(18) + (size_t)j * 3 * 2048;
#pragma unroll
    for (int k = 0; k < 4; ++k) {
        const int c = tid + 512 * k;
        const float e = z[2048 + c] * z[4096 + c];
        const float s0 = FIN(4)[((size_t)(j * 128 + b) * 2 + 0) * 2048 + c], s1 = FIN(4)[((size_t)(j * 128 + b) * 2 + 1) * 2048 + c];
        const float y = cw[c] * s0 + cw[2048 + c] * s1 + cw[4096 + c] * e;
        ((bf16_t*)(F.ws + WS_SA2))[(size_t)b * 2048 + c] = (bf16_t)(cvt_pk_bf16(z[c] * y * silu_f(z[6144 + c]), 0.f) & 0xffffu);
        float* po = F.out + O_CONVS + ((size_t)(j * 128 + b) * 2) * 2048 + c; po[0] = s1; po[2048] = e;
    }
}
__device__ __forceinline__ void attn_sample(Frame& F0, int layer) {
    Frame F = launder(F0);
    LAS float* sc = (LAS float*)F.lds;
    LAS float* red = sc + 512;
    const int tid = F.tid, lane = F.lane, w = F.wave;
    for (int item = F.bx; item < 256; item += F.G) {
        const int b = item >> 1, hp = item & 1;
        const float* qp = ((float*)(F.ws + WS_SQ)) + (size_t)b * D + hp * 512;
        const f32x4 q0 = *(const f32x4*)(qp + 4 * lane), q1 = *(const f32x4*)(qp + 256 + 4 * lane);
        const float* kp = FIN(5) + ((size_t)(layer * 128 + b) * 256) * 1024 + hp * 512 + 4 * lane;
        const float* vp = FIN(6) + ((size_t)(layer * 128 + b) * 256) * 1024 + hp * 512 + 4 * lane;
#pragma unroll 8
        for (int mi = 0; mi < 32; ++mi) {
            const int m = 32 * w + mi;
            const f32x4 k0 = __builtin_nontemporal_load((const f32x4*)(kp + (size_t)m * 1024)), k1 = __builtin_nontemporal_load((const f32x4*)(kp + (size_t)m * 1024 + 256));
            const float d0 = wave_sum(dot4(k0, q0)), d1 = wave_sum(dot4(k1, q1));
            if (lane == 0) { sc[m] = d0; sc[256 + m] = d1; }
        }
        __syncthreads();
        float p0[4], p1[4], mx0 = -INFINITY, mx1 = -INFINITY;
#pragma unroll
        for (int i = 0; i < 4; ++i) { p0[i] = sc[lane + 64 * i]; p1[i] = sc[256 + lane + 64 * i]; mx0 = fmaxf(mx0, p0[i]); mx1 = fmaxf(mx1, p1[i]); }
#pragma unroll
        for (int o = 1; o < 64; o <<= 1) { mx0 = fmaxf(mx0, __shfl_xor(mx0, o)); mx1 = fmaxf(mx1, __shfl_xor(mx1, o)); }
        float sm0 = 0.f, sm1 = 0.f;
#pragma unroll
        for (int i = 0; i < 4; ++i) { p0[i] = __builtin_amdgcn_exp2f(p0[i] - mx0); p1[i] = __builtin_amdgcn_exp2f(p1[i] - mx1); sm0 += p0[i]; sm1 += p1[i]; }
        sm0 = wave_sum(sm0); sm1 = wave_sum(sm1);
        const float i0 = 1.0f / sm0, i1 = 1.0f / sm1;
        __syncthreads();
        if (w == 0) {
#pragma unroll
            for (int i = 0; i < 4; ++i) { sc[lane + 64 * i] = p0[i] * i0; sc[256 + lane + 64 * i] = p1[i] * i1; }
        }
        __syncthreads();
        f32x4 a0 = (f32x4){0.f, 0.f, 0.f, 0.f}, a1 = a0;
#pragma unroll 8
        for (int mi = 0; mi < 32; ++mi) {
            const int m = 32 * w + mi;
            const f32x4 v0 = __builtin_nontemporal_load((const f32x4*)(vp + (size_t)m * 1024)), v1 = __builtin_nontemporal_load((const f32x4*)(vp + (size_t)m * 1024 + 256));
            a0 += v0 * sc[m]; a1 += v1 * sc[256 + m];
        }
        *(LAS f32x4*)(red + w * 512 + 4 * lane) = a0; *(LAS f32x4*)(red + w * 512 + 256 + 4 * lane) = a1;
        __syncthreads();
        {
            float o = 0.f;
#pragma unroll
            for (int ww = 0; ww < 8; ++ww) o += red[ww * 512 + tid];
            ((bf16_t*)(F.ws + WS_SO))[(size_t)b * D + hp * 512 + tid] = (bf16_t)(cvt_pk_bf16(o, 0.f) & 0xffffu);
        }
        __syncthreads();
    }
}
#define dpp_mov(v, ctrl, row_mask) __builtin_bit_cast(float, __builtin_amdgcn_update_dpp(0, __builtin_bit_cast(int, (float)(v)), (ctrl), (row_mask), 0xf, false))
__device__ __forceinline__ float wave_sum_dpp(float x) {
    x += dpp_mov(x, 0xB1, 0xf);
    x += dpp_mov(x, 0x4E, 0xf);
    x += dpp_mov(x, 0x141, 0xf);
    x += dpp_mov(x, 0x140, 0xf);
    x += dpp_mov(x, 0x142, 0xa);
    x += dpp_mov(x, 0x143, 0xc);
    return x;
}
constexpr int FA_SC = 69632, FA_RED = 71680;
__device__ __forceinline__ void attn_fused(Frame& F0, int layer) {
    Frame F = launder(F0);
    LAS unsigned char* lds = F.lds;
    const int tid = F.tid, lane = F.lane, w = F.wave, fr = lane & 15, fq = lane >> 4;
    const bf16_t* Kl = ((bf16_t*)(F.ws + WS_KB)) + (size_t)layer * MMEM * D; const bf16_t* Vl = ((bf16_t*)(F.ws + WS_VB)) + (size_t)layer * MMEM * D;
    LAS float* sc = (LAS float*)(lds + FA_SC); LAS float* red = (LAS float*)(lds + FA_RED);
    const int sb = F.bx >> 1, hp = F.bx & 1;
    const float* qp = ((float*)(F.ws + WS_SQ)) + (size_t)sb * D + hp * 512;
    const f32x4 q0 = *(const f32x4*)(qp + 4 * lane), q1 = *(const f32x4*)(qp + 256 + 4 * lane);
    const float* kp = FIN(5) + ((size_t)(layer * 128 + sb) * 256 + 4 * w) * 1024 + hp * 512;
    const float* vp = FIN(6) + ((size_t)(layer * 128 + sb) * 256 + 4 * w) * 1024 + hp * 512;
    const unsigned lo16 = (unsigned)lane * 16u;
    f32x4 sv[8]; f32x4 a0 = (f32x4){0.f, 0.f, 0.f, 0.f}, a1 = a0; float mx0 = 0.f, mx1 = 0.f, iv0 = 0.f, iv1 = 0.f;
#define FA_SLOAD(base, slice) do { unsigned long long pu_ = uni64((unsigned long long)((base) + (size_t)(32 * (slice)) * 1024)); asm volatile("" : "+s"(pu_)); const char* pc_ = (const char*)(const GAS char*)pu_; \
        _Pragma("unroll") for (int r_ = 0; r_ < 4; ++r_) { sv[2 * r_] = __builtin_nontemporal_load((const f32x4*)(pc_ + r_ * 4096 + lo16)); sv[2 * r_ + 1] = __builtin_nontemporal_load((const f32x4*)(pc_ + r_ * 4096 + 1024 + lo16)); } } while (0)
    FA_SLOAD(kp, 0);
#pragma unroll 1
    for (int ui = 0; ui < 2; ++ui) {
        const int unit = F.bx + 256 * ui;
        const int bh = unit >> 4, b = bh >> 2, h = bh & 3, qb = unit & 15;
        const size_t rowq = (size_t)b * SEQ + qb * 128 + 16 * w + fr;
        bf16x8 Qf[8];
#pragma unroll
        for (int ks = 0; ks < 8; ++ks) Qf[ks] = *(const bf16x8*)(((bf16_t*)(F.ws + WS_Q)) + rowq * D + h * 256 + 32 * ks + 8 * fq);
        const bf16_t* kbase = Kl + (size_t)(b * 256) * D + h * 256; const bf16_t* vbase = Vl + (size_t)(b * 256) * D + h * 256;
        u32x4 st[4];
        const unsigned goff = (unsigned)(tid >> 5) * (D * 2) + (unsigned)(tid & 31) * 16u, loff = (unsigned)(tid >> 5) * 528u + (unsigned)(tid & 31) * 16u;
#define ATT_GLOAD(c) do { unsigned long long pu_ = uni64((unsigned long long)(((c) < 4 ? kbase : vbase) + (size_t)(64 * ((c) & 3)) * D)); asm volatile("" : "+s"(pu_)); const char* pc_ = (const char*)(const GAS char*)pu_; \
        _Pragma("unroll") for (int i_ = 0; i_ < 4; ++i_) st[i_] = *(const u32x4*)(pc_ + (size_t)(16 * i_) * D * 2 + goff); } while (0)
#define ATT_LSTORE(slot) do { _Pragma("unroll") for (int i_ = 0; i_ < 4; ++i_) *(LAS u32x4*)(lds + (slot) * ATT_SLOT + 16 * i_ * 528 + loff) = st[i_]; } while (0)
        f32x4 S[16], Oa[16]; bf16x8 Pf[8]; float inv = 0.f;
        const f32x4 zero4 = (f32x4){0.f, 0.f, 0.f, 0.f};
        if (ui == 1) {
            float p0[4], p1[4]; mx0 = -INFINITY; mx1 = -INFINITY;
#pragma unroll
            for (int i = 0; i < 4; ++i) { p0[i] = sc[lane + 64 * i]; p1[i] = sc[256 + lane + 64 * i]; mx0 = fmaxf(mx0, p0[i]); mx1 = fmaxf(mx1, p1[i]); }
#pragma unroll
            for (int o = 1; o < 64; o <<= 1) { mx0 = fmaxf(mx0, __shfl_xor(mx0, o)); mx1 = fmaxf(mx1, __shfl_xor(mx1, o)); }
            float sm0 = 0.f, sm1 = 0.f;
#pragma unroll
            for (int i = 0; i < 4; ++i) { sm0 += __builtin_amdgcn_exp2f(p0[i] - mx0); sm1 += __builtin_amdgcn_exp2f(p1[i] - mx1); }
            sm0 = wave_sum(sm0); sm1 = wave_sum(sm1);
            iv0 = 1.0f / sm0; iv1 = 1.0f / sm1;
        }
        ATT_GLOAD(0); ATT_LSTORE(0); __syncthreads();
#pragma unroll
        for (int c = 0; c < 8; ++c) {
            if (c < 7) ATT_GLOAD(c + 1);
            if (ui == 0) {
#pragma unroll
                for (int r = 0; r < 4; ++r) {
                    const int m = 32 * c + 4 * w + r;
                    const float d0 = wave_sum_dpp(dot4(sv[2 * r], q0)), d1 = wave_sum_dpp(dot4(sv[2 * r + 1], q1));
                    if (lane == 63) { sc[m] = d0; sc[256 + m] = d1; }
                }
                if (c < 7) FA_SLOAD(kp, c + 1); else FA_SLOAD(vp, 0);
            } else {
#pragma unroll
                for (int r = 0; r < 4; ++r) {
                    const int m = 32 * c + 4 * w + r;
                    const float p0 = __builtin_amdgcn_exp2f(sc[m] - mx0) * iv0, p1 = __builtin_amdgcn_exp2f(sc[256 + m] - mx1) * iv1;
                    a0 += sv[2 * r] * p0; a1 += sv[2 * r + 1] * p1;
                }
                if (c < 7) FA_SLOAD(vp, c + 1);
            }
            LAS unsigned char* slot = lds + (c & 1) * ATT_SLOT;
            if (c < 4) {
#pragma unroll
                for (int ml = 0; ml < 4; ++ml)
#pragma unroll
                    for (int ks = 0; ks < 8; ++ks) {
                        const bf16x8 Kf = *(LAS bf16x8*)(slot + (16 * ml + fr) * 528 + (32 * ks + 8 * fq) * 2);
                        S[4 * c + ml] = MFMA16(Kf, Qf[ks], ks == 0 ? zero4 : S[4 * c + ml]);
                    }
                if (c == 3) {
                    float mx = S[0][0];
#pragma unroll
                    for (int i = 0; i < 16; ++i) { mx = fmaxf(mx, fmaxf(fmaxf(S[i][0], S[i][1]), fmaxf(S[i][2], S[i][3]))); }
                    mx = fmaxf(mx, __shfl_xor(mx, 16)); mx = fmaxf(mx, __shfl_xor(mx, 32));
                    float sum = 0.f;
#pragma unroll
                    for (int i = 0; i < 16; ++i) {
#pragma unroll
                        for (int e = 0; e < 4; ++e) { S[i][e] = __builtin_amdgcn_exp2f(S[i][e] - mx); sum += S[i][e]; }
                    }
                    sum += __shfl_xor(sum, 16); sum += __shfl_xor(sum, 32);
                    inv = 1.0f / sum;
#pragma unroll
                    for (int a = 0; a < 8; ++a) {
                        u32x4 pw; pw.x = cvt_pk_bf16(S[2 * a][0], S[2 * a][1]); pw.y = cvt_pk_bf16(S[2 * a][2], S[2 * a][3]); pw.z = cvt_pk_bf16(S[2 * a + 1][0], S[2 * a + 1][1]); pw.w = cvt_pk_bf16(S[2 * a + 1][2], S[2 * a + 1][3]);
                        Pf[a] = __builtin_bit_cast(bf16x8, pw);
                    }
                }
            } else {
#pragma unroll
                for (int al = 0; al < 2; ++al)
#pragma unroll
                    for (int dt = 0; dt < 16; ++dt) {
                        LAS unsigned char* p = slot + (32 * al + 4 * fq + (fr >> 2)) * 528 + (16 * dt + 4 * (fr & 3)) * 2;
                        const bf16x8 Vf = tr_frag(p, p + 16 * 528);
                        Oa[dt] = MFMA16(Vf, Pf[2 * (c - 4) + al], (c == 4 && al == 0) ? zero4 : Oa[dt]);
                    }
            }
            if (c < 7) ATT_LSTORE((c + 1) & 1);
            __syncthreads();
        }
#pragma unroll
        for (int dt = 0; dt < 16; ++dt) *(u32x2*)(((bf16_t*)(F.ws + WS_O)) + rowq * D + h * 256 + 16 * dt + 4 * fq) = pack4(Oa[dt] * inv);
#undef ATT_GLOAD
#undef ATT_LSTORE
    }
#undef FA_SLOAD
    *(LAS f32x4*)(red + w * 512 + 4 * lane) = a0; *(LAS f32x4*)(red + w * 512 + 256 + 4 * lane) = a1;
    __syncthreads();
    {
        float o = 0.f;
#pragma unroll
        for (int ww = 0; ww < 8; ++ww) o += red[ww * 512 + tid];
        ((bf16_t*)(F.ws + WS_SO))[(size_t)sb * D + hp * 512 + tid] = (bf16_t)(cvt_pk_bf16(o, 0.f) & 0xffffu);
    }
    __syncthreads();
}
__device__ __forceinline__ void final_norm(Frame& F0) {
    Frame F = launder(F0);
    const int gw = F.bx * NWAVES + F.wave, NGW = F.G * NWAVES, lane = F.lane;
    f32x4 g[4];
#pragma unroll
    for (int jj = 0; jj < 4; ++jj) g[jj] = ((const f32x4*)FIN(24) + lane)[64 * jj];
    for (int m = gw; m < MP + MS; m += NGW) {
        const float* src = m < MP ? F.out + O_Y + (size_t)m * D : ((float*)(F.ws + WS_XS)) + (size_t)(m - MP) * D;
        float* dst = m < MP ? F.out + O_Y + (size_t)m * D : F.out + O_YS + (size_t)(m - MP) * D;
        f32x4 v[4]; float s = 0.f;
#pragma unroll
        for (int jj = 0; jj < 4; ++jj) { v[jj] = ((const f32x4*)src + lane)[64 * jj]; s += dot4(v[jj], v[jj]); }
        const float rs = rsqrtf(wave_sum(s) * (1.0f / D) + EPS);
#pragma unroll
        for (int jj = 0; jj < 4; ++jj) ((f32x4*)dst + lane)[64 * jj] = v[jj] * rs * g[jj];
    }
}

struct Args { const float* in[25]; float* out; unsigned char* ws; int ph_lo, ph_hi; };
#define REP(bit) for (int rep_ = 0; rep_ < 1 + ((REP_MASK >> (bit)) & 1); ++rep_)
#ifndef MK_SPLIT
#define MK_SPLIT 0
#endif
__global__ void __launch_bounds__(NWAVES * 64, 2) fwd(Args args) {
    extern __shared__ __attribute__((aligned(16))) unsigned char lds_raw[];
    Frame F0;
    F0.lds = (LAS unsigned char*)lds_raw;
    F0.tid = threadIdx.x; F0.lane = F0.tid & 63; F0.wave = __builtin_amdgcn_readfirstlane(F0.tid >> 6); F0.G = gridDim.x; F0.bx = blockIdx.x;
    F0.in = (in_tab_t)__builtin_amdgcn_kernarg_segment_ptr();     F0.out = args.out; F0.ws = args.ws;
    for (int u = F0.tid; u < (LDS_BYTES - LDSCTL_OFF) / 4; u += NWAVES * 64) ((LAS unsigned*)(F0.lds + LDSCTL_OFF))[u] = 0u;
    __syncthreads();
    XcdBarrier bar; bar.bar = (unsigned*)(args.ws + WS_CTL) + CW_BAR; bar.x = 0; bar.st = nullptr;
    if (!MK_SPLIT) bar = xcd_barrier_post((unsigned*)(args.ws + WS_CTL) + CW_BAR, (volatile LAS unsigned*)(F0.lds + MISC_OFF) + 8);
    int ph = 0;
    const int lo = args.ph_lo, hi = args.ph_hi;
#define PH_BEGIN if (ph >= lo && ph < hi) { Frame F = launder(F0);
#define PH_END } { const bool both_ = (ph >= lo && ph + 1 < hi); ++ph; if (!MK_SPLIT && both_) { XcdBarrier b2_ = bar; unsigned long long bp_ = uni64((unsigned long long)bar.bar); unsigned bx_ = __builtin_amdgcn_readfirstlane(bar.x); asm volatile("" : "+s"(bp_), "+s"(bx_)); b2_.bar = (unsigned*)(GAS unsigned*)bp_; b2_.x = bx_; xcd_barrier(b2_); } }

    PH_BEGIN REP(0) { p0_prologue(F0); __syncthreads(); } PH_END
    PH_BEGIN {
        pg8::Gemm g{((bf16_t*)(F.ws + WS_MEMB)), ((bf16_t*)(F.ws + WS_WKV)), MMEM, 8192, D}; pg8::StaticOrder S; S.init(MMEM, 8192, F.G, (int)F.bx);
        EpiMemKV E{((float*)(F.ws + WS_SMALL + 65536)), F.out + O_MEMK, F.out + O_MEMV, ((bf16_t*)(F.ws + WS_KB)), ((bf16_t*)(F.ws + WS_VB))};
        REP(1) pg8::gemm_phase<EpiMemKV, pg8::StaticOrder, true, true>(F.lds, g, S, E);
    } PH_END
#pragma unroll 1
    for (int l = 0; l < DEPTH; ++l) {
        const int j = l >> 1;
        if ((l & 1) == 0) {
            PH_BEGIN {
                pg8::Gemm g{((bf16_t*)(F.ws + WS_XB)), ((bf16_t*)(F.ws + WS_AB1)) + (size_t)j * NAB * D, MP, NAB, D}; pg8::StaticOrder S; S.init(MP, NAB, F.G, (int)F.bx);
                EpiG1Even E{((float*)(F.ws + WS_RSQ)), ((bf16_t*)(F.ws + WS_Z)), ((float*)(F.ws + WS_VSQ)), F.out + O_POOLP + (size_t)j * 8 * 15 * 1024};
                REP(2) pg8::gemm_phase<EpiG1Even, pg8::StaticOrder, true, true>(F.lds, g, S, E);
                SEpiZ SE{((float*)(F.ws + WS_SMALL)), ((float*)(F.ws + WS_SZ)), 8192, 0};
                REP(3) skinny_gemm<SEpiZ>(F, ((bf16_t*)(F.ws + WS_XB)) + (size_t)MP * D, ((bf16_t*)(F.ws + WS_AB1)) + (size_t)j * NAB * D, NAB, D, SE);
            } PH_END
            PH_BEGIN {
                REP(4) for (int un = F.bx; un < 1024; un += F.G) { const int kind = un & 1, g = (un >> 1) & 3, n = un >> 3; if (kind == 0) sgu_unit(F, j, n, g); else pool_unit(F, j, n, g); }
                REP(5) for (int b = F.bx; b < MS; b += F.G) sample_mix_even(F, j, b);
            } PH_END
        } else {
            PH_BEGIN {
                pg8::Gemm g{((bf16_t*)(F.ws + WS_XB)), ((bf16_t*)(F.ws + WS_C1)) + (size_t)j * NC * D, MP, NC, D}; pg8::StaticOrder S; S.init(MP, NC, F.G, (int)F.bx);
                EpiG1Odd E{((float*)(F.ws + WS_RSQ)), ((bf16_t*)(F.ws + WS_A2)), FIN(18) + (size_t)j * 3 * 2048, F.out + O_CONVP + (size_t)j * 8 * 2 * 2048, ((float*)(F.ws + WS_SIDE)), (LAS float*)(F.lds + HALO_OFF)};
                REP(6) pg8::gemm_phase<EpiG1Odd, pg8::StaticOrder, true, true>(F.lds, g, S, E);
                SEpiZ SE{((float*)(F.ws + WS_SMALL)), ((float*)(F.ws + WS_SZ)), 8192, 1};
                REP(3) skinny_gemm<SEpiZ>(F, ((bf16_t*)(F.ws + WS_XB)) + (size_t)MP * D, ((bf16_t*)(F.ws + WS_C1)) + (size_t)j * NC * D, NC, D, SE);
            } PH_END
            PH_BEGIN {
                REP(5) for (int b = F.bx; b < MS; b += F.G) sample_conv_odd(F, j, b);
            } PH_END
        }
        PH_BEGIN {
            const bf16_t* W2 = ((l & 1) ? ((bf16_t*)(F.ws + WS_C2)) : ((bf16_t*)(F.ws + WS_AB2))) + (size_t)j * D * 2048;
            pg8::Gemm g{((bf16_t*)(F.ws + WS_A2)), W2, MP, D, 2048}; pg8::StaticOrder S; S.init(MP, D, F.G, (int)F.bx);
            if (l & 1) { Unit fu; for (int i = 0; S.next(i, fu); ++i) conv_fixup(((float*)(F.ws + WS_SIDE)), FIN(18) + (size_t)j * 3 * 2048, ((bf16_t*)(F.ws + WS_A2)), fu.pm, F.tid); asm volatile("s_waitcnt vmcnt(0)" ::: "memory"); __syncthreads(); }
            EpiRes E{l == 0 ? FIN(0) : F.out + O_Y, F.out + O_Y, ((bf16_t*)(F.ws + WS_XB)), ((float*)(F.ws + WS_RSQ))};
            pg8::gemm_phase<EpiRes, pg8::StaticOrder, true, true>(F.lds, g, S, E);
            SEpiRes SE{((float*)(F.ws + WS_XS)), ((bf16_t*)(F.ws + WS_XB)) + (size_t)MP * D, ((float*)(F.ws + WS_SMALL))};
            skinny_gemm<SEpiRes>(F, ((bf16_t*)(F.ws + WS_SA2)), W2, D, 2048, SE);
        } PH_END
        PH_BEGIN {
            pg8::Gemm g{((bf16_t*)(F.ws + WS_XB)), ((bf16_t*)(F.ws + WS_WQ)) + (size_t)l * D * D, MP, D, D}; pg8::StaticOrder S; S.init(MP, D, F.G, (int)F.bx);
            EpiQ E{((float*)(F.ws + WS_RSQ)), ((bf16_t*)(F.ws + WS_Q))};
            REP(8) pg8::gemm_phase<EpiQ, pg8::StaticOrder, true, true>(F.lds, g, S, E);
            SEpiQ SE{((float*)(F.ws + WS_SMALL)), ((float*)(F.ws + WS_SQ))};
            REP(9) skinny_gemm<SEpiQ>(F, ((bf16_t*)(F.ws + WS_XB)) + (size_t)MP * D, ((bf16_t*)(F.ws + WS_WQ)) + (size_t)l * D * D, D, D, SE);
        } PH_END
        PH_BEGIN {
            if (F.G == 256) { REP(10) attn_fused(F, l); }
            else { attn_prompt(F, l); attn_sample(F, l); }
        } PH_END
        PH_BEGIN {
            pg8::Gemm g{((bf16_t*)(F.ws + WS_O)), ((bf16_t*)(F.ws + WS_WO)) + (size_t)l * D * D, MP, D, D}; pg8::StaticOrder S; S.init(MP, D, F.G, (int)F.bx);
            EpiRes E{F.out + O_Y, F.out + O_Y, ((bf16_t*)(F.ws + WS_XB)), ((float*)(F.ws + WS_RSQ))};
            pg8::gemm_phase<EpiRes, pg8::StaticOrder, true, true>(F.lds, g, S, E);
            SEpiRes SE{((float*)(F.ws + WS_XS)), ((bf16_t*)(F.ws + WS_XB)) + (size_t)MP * D, ((float*)(F.ws + WS_SMALL))};
            skinny_gemm<SEpiRes>(F, ((bf16_t*)(F.ws + WS_SO)), ((bf16_t*)(F.ws + WS_WO)) + (size_t)l * D * D, D, D, SE);
        } PH_END
    }
    PH_BEGIN final_norm(F0); PH_END
#undef PH_BEGIN
#undef PH_END
}
constexpr int N_PHASES = 2 + 6 * DEPTH + 1;

extern "C" void kernel_launch(void* const* d_in, const int* in_sizes, int n_in, void* d_out, int out_size, void* d_ws, size_t ws_size, hipStream_t stream) {
    static int grid = 0;
    if (grid == 0) {
        if (n_in != 25 || in_sizes[0] != MP * D || (size_t)out_size != O_END || ws_size < WS_END) { fprintf(stderr, "kernel_launch: unexpected shapes (n_in %d, in0 %d, out %d, ws %zu); nothing launched\n", n_in, n_in > 0 ? in_sizes[0] : -1, out_size, ws_size); grid = -1; return; }
        int dev = 0, cus = 0, per_cu = 0;
        if (hipGetDevice(&dev) != hipSuccess || hipDeviceGetAttribute(&cus, hipDeviceAttributeMultiprocessorCount, dev) != hipSuccess) { fprintf(stderr, "kernel_launch: device query failed\n"); grid = -1; return; }
        if (hipFuncSetAttribute((const void*)fwd, hipFuncAttributeMaxDynamicSharedMemorySize, LDS_BYTES) != hipSuccess) { fprintf(stderr, "kernel_launch: hipFuncSetAttribute failed\n"); grid = -1; return; }
        if (hipOccupancyMaxActiveBlocksPerMultiprocessor(&per_cu, (const void*)fwd, NWAVES * 64, LDS_BYTES) != hipSuccess || per_cu < 1) fprintf(stderr, "kernel_launch: note: occupancy query reports %d workgroups per CU\n", per_cu);
        (void)hipGetLastError();
        grid = cus;
    }
    if (grid < 0) return;
    if (hipMemsetAsync((char*)d_ws + WS_CTL, 0, CTL_ZERO_BYTES, stream) != hipSuccess) { fprintf(stderr, "kernel_launch: memset failed\n"); return; }
    Args a{};
    for (int i = 0; i < 25; ++i) a.in[i] = (const float*)d_in[i];
    a.out = (float*)d_out; a.ws = (unsigned char*)d_ws;
#if MK_SPLIT
    for (int p = 0; p < N_PHASES; ++p) { a.ph_lo = p; a.ph_hi = p + 1; hipLaunchKernelGGL(fwd, dim3(grid), dim3(NWAVES * 64), LDS_BYTES, stream, a); }
#else
    a.ph_lo = 0; a.ph_hi = N_PHASES;
    hipLaunchKernelGGL(fwd, dim3(grid), dim3(NWAVES * 64), LDS_BYTES, stream, a);
#endif
    const hipError_t le = hipPeekAtLastError();
    if (le != hipSuccess) fprintf(stderr, "kernel_launch: launch failed: %s\n", hipGetErrorName(le));
}
```

```cpp
#include <hip/hip_runtime.h>
#include <cstdio>
#include <cstdint>
#ifndef REP_MASK
#define REP_MASK 0
#endif
namespace pg8 {
#define PG8_LAS __attribute__((address_space(3)))
typedef unsigned short bf16_t;
typedef short bf16x8 __attribute__((ext_vector_type(8)));
typedef float f32x4 __attribute__((ext_vector_type(4)));
typedef unsigned u32x4 __attribute__((ext_vector_type(4)));
constexpr int BM = 256, BK = 64, HALF = 128, HTB = HALF * BK * 2  , STAGE_BYTES = 8 * HTB, NXCD = 8, WGM = 8;

__host__ __device__ __forceinline__ int lds_byte(int r, int c) { const int st = (r >> 4) * 2 + (c >> 5), rr = r & 15, cc = c & 31, ob = rr * 64 + cc * 2; return st * 1024 + (ob ^ (((ob >> 9) & 1) << 5)); }
__host__ __device__ __forceinline__ void stage_rc(int b, int& R, int& C) { const int st = b / 1024, sb = b % 1024, swz = sb ^ (((sb >> 9) & 1) << 5); R = (st >> 1) * 16 + swz / 64; C = (st & 1) * 32 + (swz % 64) / 2; }
__host__ __device__ __forceinline__ int perm32(int rho) { const int n = rho >> 4, i = rho & 15; return 8 * (i >> 2) + 4 * n + (i & 3); }

struct Unit { int pm, pn; };
struct Gemm { const bf16_t* A; const bf16_t* Bt; int M, N, K; };

struct StaticOrder {
    int nM, nN, nwg, G, c;
    __host__ __device__ __forceinline__ void init(int M, int N, int G_, int c_) { nM = M / BM; nN = N / BM; nwg = nM * nN; G = G_; c = c_; }
    __host__ __device__ __forceinline__ bool next(int i, Unit& u) const {
        const long L = (long)i * G + c; if (L >= nwg) return false;
        int wgid = (int)L; { const int q = nwg / NXCD, r = nwg % NXCD, xcd = wgid % NXCD, off = wgid / NXCD; wgid = (xcd < r ? xcd * (q + 1) : r * (q + 1) + (xcd - r) * q) + off; }
        const int nig = WGM * nN, gid = wgid / nig, fm = gid * WGM, gsz = (nM - fm) < WGM ? (nM - fm) : WGM;
        u.pm = fm + ((wgid % nig) % gsz); u.pn = (wgid % nig) / gsz; return true;
    }
    __device__ __forceinline__ void a_ready(const Unit&) const {}
    __device__ __forceinline__ void done(const Unit&) const {}
};

__device__ __forceinline__ unsigned cvt_pk_bf16(float lo, float hi) { unsigned r; asm volatile("v_cvt_pk_bf16_f32 %0, %1, %2" : "=v"(r) : "v"(lo), "v"(hi)); return r; }
template <class Epi, class Sched, bool ALIGN_EPI = false, bool SP2 = false>
__device__ __forceinline__ void gemm_phase(PG8_LAS unsigned char* lds, const Gemm g, const Sched& S, const Epi& E) {
    int tid_ = threadIdx.x; asm volatile("" : "+v"(tid_));
    const int tid = tid_, wid = __builtin_amdgcn_readfirstlane(tid >> 6), lane = tid & 63, wr = wid >> 2, wc = wid & 3, fr = lane & 15, fq = lane >> 4;
    const int K = g.K, nt = K / BK;
    unsigned voffA[2], voffB[2];
#pragma unroll
    for (int i = 0; i < 2; ++i) { int R, C; stage_rc(tid * 16 + i * 8192, R, C); const int Rb = Epi::PERM ? ((R & ~31) + perm32(R & 31)) : R;
        voffA[i] = (unsigned)(R * K + C) * 2u; voffB[i] = (unsigned)(Rb * K + C) * 2u; }
    const size_t kstep = (size_t)(BK * 2);
    const size_t hstep = (size_t)HALF * K * 2;
    const size_t tstep = 2 * hstep;
    const unsigned ldsw = (unsigned)wid * 1024u;
    const int aoff = lds_byte(wr * 64 + fr, fq * 8), boff = lds_byte(wc * 32 + fr, fq * 8);
#define PG8_SA(b, h) (((b) * 2 + (h)) * HTB)
#define PG8_SB(b, h) ((4 + (b) * 2 + (h)) * HTB)
#define PG8_STAGE(bufoff, gbase, voff) do { _Pragma("unroll") for (int _i = 0; _i < 2; ++_i) \
        __builtin_amdgcn_global_load_lds((const unsigned*)((const char*)(gbase) + (voff)[_i]), (PG8_LAS unsigned*)(lds + (bufoff) + ldsw + _i * 8192), 16, 0, 0); } while (0)
#define PG8_LDA(dst, b, h) do { _Pragma("unroll") for (int m = 0; m < 4; ++m) _Pragma("unroll") for (int k = 0; k < 2; ++k) dst[m][k] = *(const PG8_LAS bf16x8*)(lds + PG8_SA(b, h) + aoff + m * 2048 + k * 1024); } while (0)
#define PG8_LDB(dst, b, h) do { _Pragma("unroll") for (int n = 0; n < 2; ++n) _Pragma("unroll") for (int k = 0; k < 2; ++k) dst[n][k] = *(const PG8_LAS bf16x8*)(lds + PG8_SB(b, h) + boff + n * 2048 + k * 1024); } while (0)
#define PG8_MMA(ai, bj, At, Bt) do { __builtin_amdgcn_s_setprio(1); _Pragma("unroll") for (int m = 0; m < 4; ++m) _Pragma("unroll") for (int n = 0; n < 2; ++n) _Pragma("unroll") for (int k = 0; k < 2; ++k) \
        acc[ai][bj][m][n] = __builtin_amdgcn_mfma_f32_16x16x32_bf16(Bt[n][k], At[m][k], acc[ai][bj][m][n], 0, 0, 0); __builtin_amdgcn_s_setprio(0); } while (0)
#define PG8_WAIT_V(n) asm volatile("s_waitcnt vmcnt(" #n ")" ::: "memory")
#define PG8_WAIT_L(n) asm volatile("s_waitcnt lgkmcnt(" #n ")" ::: "memory")
#define PG8_BAR __builtin_amdgcn_s_barrier()
#define PG8_SCHED __builtin_amdgcn_sched_barrier(0)
    Unit cur, nxt; int ui = 0;
    if (!S.next(0, cur)) return;
    f32x4 acc[2][2][4][2];
#pragma unroll
    for (int a = 0; a < 2; ++a)
#pragma unroll
        for (int b = 0; b < 2; ++b)
#pragma unroll
            for (int m = 0; m < 4; ++m)
#pragma unroll
                for (int n = 0; n < 2; ++n) acc[a][b][m][n] = (f32x4){0.f, 0.f, 0.f, 0.f};
    bf16x8 At[4][2], B0[2][2], B1[2][2];
    const char* cA = (const char*)g.A + (size_t)cur.pm * tstep; const char* cB = (const char*)g.Bt + (size_t)cur.pn * tstep;
    S.a_ready(cur);
    if constexpr (SP2) {
        PG8_STAGE(PG8_SB(0, 0), cB, voffB); PG8_STAGE(PG8_SB(0, 1), cB + hstep, voffB); PG8_STAGE(PG8_SA(0, 0), cA, voffA); PG8_STAGE(PG8_SA(0, 1), cA + hstep, voffA);
        if (wr == 1) PG8_BAR;
        PG8_WAIT_V(2); PG8_BAR;
        PG8_STAGE(PG8_SB(1, 0), cB + kstep, voffB); PG8_STAGE(PG8_SA(1, 0), cA + kstep, voffA); PG8_STAGE(PG8_SB(1, 1), cB + hstep + kstep, voffB);
        PG8_WAIT_V(6); PG8_BAR;
    } else {
        PG8_STAGE(PG8_SB(0, 0), cB, voffB); PG8_STAGE(PG8_SA(0, 0), cA, voffA); PG8_STAGE(PG8_SB(0, 1), cB + hstep, voffB); PG8_STAGE(PG8_SA(0, 1), cA + hstep, voffA);
        if (wr == 1) PG8_BAR;
        PG8_WAIT_V(4); PG8_BAR;
        PG8_STAGE(PG8_SB(1, 0), cB + kstep, voffB); PG8_STAGE(PG8_SA(1, 0), cA + kstep, voffA); PG8_STAGE(PG8_SB(1, 1), cB + hstep + kstep, voffB);
        PG8_WAIT_V(6); PG8_BAR;
    }
    for (;;) {
        const bool has_next = S.next(ui + 1, nxt);
        const char* nA = has_next ? (const char*)g.A + (size_t)nxt.pm * tstep : cA; const char* nB = has_next ? (const char*)g.Bt + (size_t)nxt.pn * tstep : cB;
        for (int t = 0; t < nt; t += 2) {
            const bool last = (t == nt - 2);
            const char* a1 = cA + (size_t)(t + 1) * kstep;
            const char* a2 = last ? nA : cA + (size_t)(t + 2) * kstep; const char* b2 = last ? nB : cB + (size_t)(t + 2) * kstep;
            const char* a3 = a2 + kstep; const char* b3 = b2 + kstep;
            if (last && has_next) S.a_ready(nxt);
            if constexpr (SP2) {
            PG8_LDB(B0, 0, 0); PG8_LDB(B1, 0, 1); PG8_SCHED; PG8_LDA(At, 0, 0); PG8_STAGE(PG8_SA(1, 1), a1 + hstep, voffA);
            PG8_WAIT_V(8); PG8_WAIT_L(0); PG8_BAR; PG8_MMA(0, 0, At, B0); PG8_MMA(0, 1, At, B1); PG8_BAR; PG8_SCHED;
            PG8_LDA(At, 0, 1); PG8_STAGE(PG8_SB(0, 0), b2, voffB); PG8_STAGE(PG8_SB(0, 1), b2 + hstep, voffB); PG8_STAGE(PG8_SA(0, 0), a2, voffA);
            PG8_WAIT_V(8); PG8_WAIT_L(0); PG8_BAR; PG8_MMA(1, 0, At, B0); PG8_MMA(1, 1, At, B1); PG8_BAR; PG8_SCHED;
            PG8_LDB(B0, 1, 0); PG8_LDB(B1, 1, 1); PG8_SCHED; PG8_LDA(At, 1, 0); PG8_STAGE(PG8_SA(0, 1), a2 + hstep, voffA);
            PG8_WAIT_V(8); PG8_WAIT_L(0); PG8_BAR; PG8_MMA(0, 0, At, B0); PG8_MMA(0, 1, At, B1); PG8_BAR; PG8_SCHED;
            PG8_LDA(At, 1, 1); PG8_STAGE(PG8_SB(1, 0), b3, voffB); PG8_STAGE(PG8_SB(1, 1), b3 + hstep, voffB); PG8_STAGE(PG8_SA(1, 0), a3, voffA);
            PG8_WAIT_V(8); PG8_WAIT_L(0); PG8_BAR; PG8_MMA(1, 0, At, B0); PG8_MMA(1, 1, At, B1); PG8_BAR; PG8_SCHED;
            } else {
            PG8_LDB(B0, 0, 0); PG8_SCHED; PG8_LDA(At, 0, 0); PG8_STAGE(PG8_SA(1, 1), a1 + hstep, voffA);
            PG8_WAIT_L(8); PG8_BAR; PG8_WAIT_L(0); PG8_MMA(0, 0, At, B0); PG8_BAR; PG8_SCHED;
            PG8_LDB(B1, 0, 1); PG8_STAGE(PG8_SB(0, 0), b2, voffB);
            PG8_BAR; PG8_WAIT_L(0); PG8_MMA(0, 1, At, B1); PG8_BAR;
            PG8_LDA(At, 0, 1); PG8_STAGE(PG8_SA(0, 0), a2, voffA);
            PG8_BAR; PG8_WAIT_L(0); PG8_MMA(1, 0, At, B0); PG8_BAR; PG8_SCHED;
            PG8_STAGE(PG8_SB(0, 1), b2 + hstep, voffB);
            PG8_WAIT_V(6); PG8_BAR; PG8_MMA(1, 1, At, B1); PG8_BAR;
            PG8_LDB(B0, 1, 0); PG8_SCHED; PG8_LDA(At, 1, 0); PG8_STAGE(PG8_SA(0, 1), a2 + hstep, voffA);
            PG8_WAIT_L(8); PG8_BAR; PG8_WAIT_L(0); PG8_MMA(0, 0, At, B0); PG8_BAR; PG8_SCHED;
            PG8_LDB(B1, 1, 1); PG8_STAGE(PG8_SB(1, 0), b3, voffB);
            PG8_BAR; PG8_WAIT_L(0); PG8_MMA(0, 1, At, B1); PG8_BAR;
            PG8_LDA(At, 1, 1); PG8_STAGE(PG8_SA(1, 0), a3, voffA);
            PG8_BAR; PG8_WAIT_L(0); PG8_MMA(1, 0, At, B0); PG8_BAR; PG8_SCHED;
            PG8_STAGE(PG8_SB(1, 1), b3 + hstep, voffB);
            PG8_WAIT_V(6); PG8_BAR; PG8_MMA(1, 1, At, B1); PG8_BAR;
            }
        }
        if constexpr (ALIGN_EPI) { if (wr == 0) PG8_BAR; }
        if constexpr (!Epi::AFTER_DRAIN) { for (int rep_ = 0; rep_ < 1 + (Epi::REP_EPI ? 1 : 0); ++rep_) E(acc, cur, wr, wc, fr, fq); S.done(cur); }
        if (!has_next) break;
#pragma unroll
        for (int a = 0; a < 2; ++a)
#pragma unroll
            for (int b = 0; b < 2; ++b)
#pragma unroll
                for (int m = 0; m < 4; ++m)
#pragma unroll
                    for (int n = 0; n < 2; ++n) acc[a][b][m][n] = (f32x4){0.f, 0.f, 0.f, 0.f};
        cur = nxt; cA = nA; cB = nB; ++ui;
        if constexpr (ALIGN_EPI) { if (wr == 1) PG8_BAR; }
    }
    PG8_WAIT_V(0);
    if constexpr (!ALIGN_EPI) { if (wr == 0) PG8_BAR; }
    PG8_BAR;
    if constexpr (Epi::AFTER_DRAIN) { E.fused(acc, cur, wr, wc, fr, fq, lds, wid, lane); S.done(cur); }
#undef PG8_SA
#undef PG8_SB
#undef PG8_STAGE
#undef PG8_LDA
#undef PG8_LDB
#undef PG8_MMA
#undef PG8_WAIT_V
#undef PG8_WAIT_L
#undef PG8_BAR
#undef PG8_SCHED
}
}

using pg8::bf16_t; using pg8::bf16x8; using pg8::f32x4; using pg8::u32x4; using pg8::Unit; using pg8::cvt_pk_bf16;
#define GAS __attribute__((address_space(1)))
#define LAS __attribute__((address_space(3)))
typedef unsigned u32x2 __attribute__((ext_vector_type(2)));
typedef short s16x4 __attribute__((ext_vector_type(4)));
typedef GAS unsigned gu32;
#define RLX_AGENT __ATOMIC_RELAXED, __HIP_MEMORY_SCOPE_AGENT

constexpr int NWAVES = 8;
constexpr int D = 1024, MP = 16384, MS = 128, SEQ = 2048, NBATCH = 8, NMEM = 256, MMEM = 2048, DEPTH = 4;
constexpr int NAB = 5120, NC = 8192;
constexpr float EPS = 1e-6f;
constexpr float QSCALE = 0.0625f * 1.4426950408889634f;

constexpr size_t O_Y = 0, O_YS = O_Y + (size_t)MP * D, O_POOLP = O_YS + (size_t)MS * D, O_POOLS = O_POOLP + 2 * 8 * 15 * 1024,
                 O_CONVP = O_POOLS + (size_t)2 * 128 * 15 * 1024, O_CONVS = O_CONVP + 2 * 8 * 2 * 2048, O_SGUV = O_CONVS + (size_t)2 * 128 * 2 * 2048,
                 O_MEMK = O_SGUV + 2 * 128 * 1024, O_MEMV = O_MEMK + (size_t)4 * MMEM * D, O_END = O_MEMV + (size_t)4 * MMEM * D;
static_assert(O_END == 39239680, "output size");

constexpr size_t MiB = 1u << 20;
constexpr size_t WS_CTL = 0, CTL_ZERO_BYTES = 1 * MiB;
constexpr size_t WS_AB1 = 2 * MiB, WS_C1 = 22 * MiB, WS_AB2 = 54 * MiB, WS_C2 = 62 * MiB, WS_WQ = 70 * MiB, WS_WKV = 78 * MiB, WS_WO = 94 * MiB, WS_PMT = 102 * MiB;
constexpr size_t WS_XB = 104 * MiB;
constexpr size_t WS_RSQ = 137 * MiB, WS_VSQ = 138 * MiB;
constexpr size_t WS_SMALL = 139 * MiB;
constexpr size_t WS_Z = 140 * MiB;
constexpr size_t WS_A2 = 268 * MiB;
constexpr size_t WS_Q = 332 * MiB, WS_O = 364 * MiB;
constexpr size_t WS_MEMB = 396 * MiB, WS_KB = 400 * MiB, WS_VB = 416 * MiB;
constexpr size_t WS_XS = 432 * MiB, WS_SZ = 433 * MiB, WS_SA2 = 437 * MiB, WS_SQ = 438 * MiB, WS_SO = 439 * MiB, WS_SIDE = 440 * MiB  , WS_END = 444 * MiB;
constexpr int CW_BAR = 4096;

constexpr int RING_BYTES = 131072, LDSCTL_OFF = RING_BYTES, MISC_OFF = LDSCTL_OFF + 320, HALO_OFF = RING_BYTES + 1024  , LDS_BYTES = 147456;

#define LDS_WAIT() asm volatile("s_waitcnt lgkmcnt(0)" ::: "memory")

#define XB_TMO      128
#define XB_XCNT(j)  (256  + 64 * (j))
#define XB_XSUB(j)  (1280 + 64 * (j))
#define XB_XGEN(j)  (2304 + 64 * (j))
#define XB_TOP      3328
#define XB_TOPGEN   3392
#define XCD_BAR_WORDS 3456
#define XB_SPIN_CAP (1u << 18)

__device__ __forceinline__ unsigned xb_ld(unsigned* p)              { return __hip_atomic_load(p, __ATOMIC_RELAXED, __HIP_MEMORY_SCOPE_AGENT); }
__device__ __forceinline__ unsigned xb_add(unsigned* p, unsigned v) { return __hip_atomic_fetch_add(p, v, __ATOMIC_RELAXED, __HIP_MEMORY_SCOPE_AGENT); }
__device__ __forceinline__ unsigned xb_xcc_id() { return (unsigned)__builtin_amdgcn_s_getreg((3 << 11) | 20) & 0xFu; }
#define XB_SPIN(cond, bar) do { unsigned _sp = 0; while (cond) { __builtin_amdgcn_s_sleep(1); \
    if ((++_sp & 255u) == 0u) { if (xb_ld(&(bar)[XB_TMO])) break; if (_sp > XB_SPIN_CAP) { atomicAdd(&(bar)[XB_TMO], 1u); break; } } } } while (0)

struct XcdBarrier {
    unsigned* bar; unsigned x;
    volatile LAS unsigned* st;
};

__device__ __forceinline__ XcdBarrier xcd_barrier_post(unsigned* bar, volatile LAS unsigned* st) {
    XcdBarrier b; b.bar = bar; b.x = xb_xcc_id(); b.st = st;
    if (threadIdx.x == 0) (void)xb_add(&bar[XB_XCNT(b.x)], 1u);
    return b;
}
__device__ __forceinline__ void xcd_barrier_complete(unsigned* bar, unsigned x, unsigned& nloc, unsigned& nx) {
    const unsigned G = gridDim.x * gridDim.y * gridDim.z;
    unsigned sum, cnt, mine, sp = 0u;
    for (;;) {
        sum = 0u; cnt = 0u; mine = 0u;
#pragma unroll
        for (unsigned j = 0; j < 16; ++j) { const unsigned c = xb_ld(&bar[XB_XCNT(j)]); sum += c; cnt += (c > 0u) ? 1u : 0u; mine = (j == x) ? c : mine; }
        if (sum == G) break;
        __builtin_amdgcn_s_sleep(1);
        if ((++sp & 255u) == 0u) { if (xb_ld(&bar[XB_TMO])) break; if (sp > XB_SPIN_CAP) { atomicAdd(&bar[XB_TMO], 1u); break; } }
    }
    nloc = mine > 0u ? mine : 1u; nx = cnt > 0u ? cnt : 1u;
}

__device__ __forceinline__ void xcd_barrier(const XcdBarrier& b) {
    asm volatile("s_waitcnt vmcnt(0)" ::: "memory");
    __syncthreads();
    if (threadIdx.x == 0) {
        unsigned* bar = b.bar;
        __builtin_amdgcn_s_waitcnt(0);
        unsigned nloc = b.st[0], nx = b.st[1];
        if (nloc == 0u) { xcd_barrier_complete(bar, b.x, nloc, nx); b.st[0] = nloc; b.st[1] = nx; }
        const unsigned old = xb_add(&bar[XB_XSUB(b.x)], 1u);
        const unsigned gen = old / nloc;
        if (old + 1u == (gen + 1u) * nloc) {
            __builtin_amdgcn_fence(__ATOMIC_RELEASE, "agent");
            asm volatile("s_waitcnt vmcnt(0)" ::: "memory");
            const unsigned og = xb_add(&bar[XB_TOP], 1u);
            const unsigned tg = og / nx;
            if (og + 1u == (tg + 1u) * nx) xb_add(&bar[XB_TOPGEN], 1u);
            else XB_SPIN(xb_ld(&bar[XB_TOPGEN]) == tg, bar);
            __builtin_amdgcn_fence(__ATOMIC_ACQUIRE, "agent");
            xb_add(&bar[XB_XGEN(b.x)], 1u);
            asm volatile("s_waitcnt vmcnt(0)" ::: "memory");
        } else {
            XB_SPIN(xb_ld(&bar[XB_XGEN(b.x)]) == gen, bar);
            __builtin_amdgcn_fence(__ATOMIC_ACQUIRE, "agent");
            asm volatile("s_waitcnt vmcnt(0)" ::: "memory");
        }
    }
    __syncthreads();
}

typedef const float* fptr_t;
typedef __attribute__((address_space(4))) const fptr_t* in_tab_t;
struct Frame {
    LAS unsigned char* lds;
    int tid, lane, wave, G, bx;
    in_tab_t in;
    float* out;
    unsigned char* ws;
};
__device__ __forceinline__ unsigned long long uni64(unsigned long long v) { const unsigned lo = __builtin_amdgcn_readfirstlane((unsigned)v), hi = __builtin_amdgcn_readfirstlane((unsigned)(v >> 32)); return ((unsigned long long)hi << 32) | lo; }
__device__ __forceinline__ Frame launder(const Frame& F0) {
    Frame F = F0;
    int g_ = __builtin_amdgcn_readfirstlane(F0.G), b_ = __builtin_amdgcn_readfirstlane(F0.bx);
    unsigned long long w_ = uni64((unsigned long long)F0.ws), o_ = uni64((unsigned long long)F0.out), i_ = uni64((unsigned long long)F0.in);
    asm volatile("" : "+v"(F.tid), "+s"(g_), "+s"(b_), "+s"(w_), "+s"(o_), "+s"(i_));
    F.G = g_; F.bx = b_; F.ws = (unsigned char*)(GAS unsigned char*)w_; F.out = (float*)(GAS float*)o_; F.in = (in_tab_t)i_;
    F.lane = F.tid & 63; F.wave = __builtin_amdgcn_readfirstlane(F.tid >> 6);
    return F;
}
#define FIN(k) ((const float*)(const GAS float*)(F.in[k]))


__device__ __forceinline__ float wave_sum(float v) {
#pragma unroll
    for (int o = 1; o < 64; o <<= 1) v += __shfl_xor(v, o);
    return v;
}
__device__ __forceinline__ float silu_f(float x) { return x * __builtin_amdgcn_rcpf(1.f + __builtin_amdgcn_exp2f(-1.4426950408889634f * x)); }
__device__ __forceinline__ f32x4 silu4(f32x4 v) { return (f32x4){silu_f(v[0]), silu_f(v[1]), silu_f(v[2]), silu_f(v[3])}; }
__device__ __forceinline__ float dot4(f32x4 a, f32x4 b) { return (a[0] * b[0] + a[1] * b[1]) + (a[2] * b[2] + a[3] * b[3]); }
__device__ __forceinline__ u32x4 pack8(f32x4 a, f32x4 b) { u32x4 w; w.x = cvt_pk_bf16(a[0], a[1]); w.y = cvt_pk_bf16(a[2], a[3]); w.z = cvt_pk_bf16(b[0], b[1]); w.w = cvt_pk_bf16(b[2], b[3]); return w; }
__device__ __forceinline__ u32x2 pack4(f32x4 a) { u32x2 w; w.x = cvt_pk_bf16(a[0], a[1]); w.y = cvt_pk_bf16(a[2], a[3]); return w; }
__device__ __forceinline__ float bflo(unsigned w) { return __uint_as_float(w << 16); }
__device__ __forceinline__ float bfhi(unsigned w) { return __uint_as_float(w & 0xffff0000u); }
__device__ __forceinline__ void unpack8(u32x4 w, f32x4& a, f32x4& b) { a = (f32x4){bflo(w.x), bfhi(w.x), bflo(w.y), bfhi(w.y)}; b = (f32x4){bflo(w.z), bfhi(w.z), bflo(w.w), bfhi(w.w)}; }
__device__ __forceinline__ f32x4 unpack4(u32x2 w) { return (f32x4){bflo(w.x), bfhi(w.x), bflo(w.y), bfhi(w.y)}; }
__device__ __forceinline__ float rstd16(const float* p) {
    const f32x4 a = ((const f32x4*)p)[0], b = ((const f32x4*)p)[1], c = ((const f32x4*)p)[2], d = ((const f32x4*)p)[3];
    const f32x4 s = (a + b) + (c + d);
    return rsqrtf(((s[0] + s[1]) + (s[2] + s[3])) * (1.0f / D) + EPS);
}
__device__ __forceinline__ float rstd32(const float* p) {
    f32x4 s = ((const f32x4*)p)[0];
#pragma unroll
    for (int i = 1; i < 8; ++i) s += ((const f32x4*)p)[i];
    return rsqrtf(((s[0] + s[1]) + (s[2] + s[3])) * (1.0f / D) + EPS);
}
__host__ __device__ __forceinline__ int src_even(int n) {
    const int tile = n >> 8, o = n & 255;
    if (tile < 8) return n;
    if (tile < 12) return 3072 + (n - 2048);
    const int cb = tile - 12;
    return o < 128 ? 2048 + 128 * cb + o : 4096 + 128 * cb + (o - 128);
}
__host__ __device__ __forceinline__ int src_odd(int n) {
    const int pn = n >> 8, p = n & 255, q = ((p >> 7) << 1) | ((p >> 2) & 1), ch = 64 * pn + 16 * ((p >> 5) & 3) + 4 * ((p >> 3) & 3) + (p & 3);
    const int base = q == 0 ? 2048 : (q == 1 ? 4096 : (q == 2 ? 0 : 6144));
    return base + ch;
}

struct EpiG1Even {
    static constexpr bool PERM = true, AFTER_DRAIN = false, REP_EPI = (REP_MASK >> 12) & 1;
    const float* rsq; bf16_t* Z; float* vsq; float* pool_out;
    __device__ __forceinline__ void operator()(const f32x4 (&acc)[2][2][4][2], const Unit& u, int wr, int wc, int fr_, int fq_) const {
        int fr = fr_, fq = fq_; asm volatile("" : "+v"(fr), "+v"(fq));
        const int tile = u.pn, cw = wc * 32 + 8 * fq;
#pragma unroll
        for (int ai = 0; ai < 2; ++ai)
#pragma unroll
            for (int m = 0; m < 4; ++m) {
                const int row = u.pm * 256 + ai * 128 + wr * 64 + m * 16 + fr;
                const float rs = rstd16(rsq + (size_t)row * 16);
                if (tile < 12) {
                    const int kind = tile >> 2;
                    bf16_t* dst = Z + (size_t)kind * MP * D + (size_t)row * D + (tile & 3) * 256 + cw;
                    float ss = 0.f;
#pragma unroll
                    for (int bj = 0; bj < 2; ++bj) {
                        f32x4 v0 = acc[ai][bj][m][0] * rs, v1 = acc[ai][bj][m][1] * rs;
                        if (kind == 1) { v0 = silu4(v0); v1 = silu4(v1); }
                        if (kind == 2) ss += dot4(v0, v0) + dot4(v1, v1);
                        *(u32x4*)(dst + bj * 128) = pack8(v0, v1);
                        if (kind == 0 && (row & 2047) >= 2033) {
                            float* po = pool_out + ((size_t)(row >> 11) * 15 + ((row & 2047) - 2033)) * 1024 + (tile & 3) * 256 + bj * 128 + cw;
                            *(f32x4*)po = v0; *(f32x4*)(po + 4) = v1;
                        }
                    }
                    if (kind == 2) { ss += __shfl_xor(ss, 16); ss += __shfl_xor(ss, 32); if (fq == 0) vsq[(size_t)row * 16 + (tile - 8) * 4 + wc] = ss; }
                } else {
                    const int cb = tile - 12;
                    bf16_t* dst = Z + (size_t)3 * MP * D + (size_t)row * D + cb * 128 + cw;
                    const f32x4 u0 = acc[ai][0][m][0] * rs, u1 = acc[ai][0][m][1] * rs, g0 = acc[ai][1][m][0] * rs, g1 = acc[ai][1][m][1] * rs;
                    *(u32x4*)dst = pack8(u0 * silu4(g0), u1 * silu4(g1));
                }
            }
    }
};
__device__ __forceinline__ float dpp_shr1(float old, float v) { return __builtin_bit_cast(float, __builtin_amdgcn_update_dpp(__builtin_bit_cast(int, old), __builtin_bit_cast(int, v), 0x111, 0xf, 0xf, false)); }
__device__ __forceinline__ float dpp_shr2(float old, float v) { return __builtin_bit_cast(float, __builtin_amdgcn_update_dpp(__builtin_bit_cast(int, old), __builtin_bit_cast(int, v), 0x112, 0xf, 0xf, false)); }
struct EpiG1Odd {
    static constexpr bool PERM = true, AFTER_DRAIN = false, REP_EPI = false;
    const float* rsq; bf16_t* A2; const float* cw; float* conv_out; float* side; LAS float* halo;
    __device__ __forceinline__ void operator()(const f32x4 (&acc)[2][2][4][2], const Unit& u, int wr, int wc, int fr_, int fq_) const {
        int fr = fr_, fq = fq_; asm volatile("" : "+v"(fr), "+v"(fq));
        const int chl = wc * 16 + 4 * fq, ch = u.pn * 64 + chl;
        const f32x4 w0 = *(const f32x4*)(cw + ch), w1 = *(const f32x4*)(cw + 2048 + ch), w2 = *(const f32x4*)(cw + 4096 + ch);
        f32x4 e[2][4]; float rsv[2][4];
#pragma unroll
        for (int ai = 0; ai < 2; ++ai)
#pragma unroll
            for (int m = 0; m < 4; ++m) {
                const int rb = 8 * ai + 4 * wr + m, row = u.pm * 256 + 16 * rb + fr;
                const float rs = rstd16(rsq + (size_t)row * 16); rsv[ai][m] = rs;
                e[ai][m] = (acc[ai][0][m][0] * rs) * (acc[ai][0][m][1] * rs);
                if (fr >= 14) *(LAS f32x4*)(halo + (rb * 2 + (fr - 14)) * 64 + chl) = e[ai][m];
                if (m & 1) asm volatile("" ::: "memory");
            }
        asm volatile("s_waitcnt lgkmcnt(0)" ::: "memory"); __builtin_amdgcn_s_barrier(); asm volatile("" ::: "memory");
        float* sd = side + (size_t)u.pm * 6 * 2048 + ch;
#pragma unroll
        for (int ai = 0; ai < 2; ++ai)
#pragma unroll
            for (int m = 0; m < 4; ++m) {
                const int rb = 8 * ai + 4 * wr + m, row = u.pm * 256 + 16 * rb + fr;
                const float rs = rsv[ai][m];
                const f32x4 sg = (acc[ai][1][m][0] * rs) * silu4(acc[ai][1][m][1] * rs);
                f32x4 h0 = (f32x4){0.f, 0.f, 0.f, 0.f}, h1 = h0;
                if (rb > 0) { h0 = *(const LAS f32x4*)(halo + ((rb - 1) * 2 + 0) * 64 + chl); h1 = *(const LAS f32x4*)(halo + ((rb - 1) * 2 + 1) * 64 + chl); }
                const f32x4 hx = fr == 0 ? h0 : h1, ev = e[ai][m];
                f32x4 e1, e2;
#pragma unroll
                for (int k = 0; k < 4; ++k) { e1[k] = dpp_shr1(h1[k], ev[k]); e2[k] = dpp_shr2(hx[k], ev[k]); }
                const f32x4 a = sg * (w0 * e2 + w1 * e1 + w2 * ev);
                const bool top = (rb == 0 && fr < 2);
                if (!(top && (u.pm & 7) != 0)) *(u32x2*)(A2 + (size_t)row * 2048 + ch) = pack4(a);
                if (top) { *(f32x4*)(sd + fr * 2048) = ev; *(f32x4*)(sd + (4 + fr) * 2048) = sg; }
                if (rb == 15 && fr >= 14) {
                    *(f32x4*)(sd + (2 + fr - 14) * 2048) = ev;
                    if ((u.pm & 7) == 7) *(f32x4*)(conv_out + ((size_t)(u.pm >> 3) * 2 + (fr - 14)) * 2048 + ch) = ev;
                }
            }
    }
};
__device__ __forceinline__ void conv_fixup(const float* side, const float* cw, bf16_t* A2, int pm, int tid) {
    if ((pm & 7) == 0) return;
    const int ch = 4 * tid;
    const float* sp = side + (size_t)(pm - 1) * 6 * 2048 + ch; const float* sc = side + (size_t)pm * 6 * 2048 + ch;
    const f32x4 em2 = *(const f32x4*)(sp + 2 * 2048), em1 = *(const f32x4*)(sp + 3 * 2048), e0 = *(const f32x4*)sc, e1 = *(const f32x4*)(sc + 2048), s0 = *(const f32x4*)(sc + 4 * 2048), s1 = *(const f32x4*)(sc + 5 * 2048);
    const f32x4 w0 = *(const f32x4*)(cw + ch), w1 = *(const f32x4*)(cw + 2048 + ch), w2 = *(const f32x4*)(cw + 4096 + ch);
    *(u32x2*)(A2 + (size_t)(pm * 256) * 2048 + ch) = pack4(s0 * (w0 * em2 + w1 * em1 + w2 * e0));
    *(u32x2*)(A2 + (size_t)(pm * 256 + 1) * 2048 + ch) = pack4(s1 * (w0 * em1 + w1 * e0 + w2 * e1));
}
struct EpiRes {
    static constexpr bool PERM = true, AFTER_DRAIN = false, REP_EPI = false;
    bf16_t* xb; float* rsq;
    __device__ __forceinline__ void operator()(const f32x4 (&acc)[2][2][4][2], const Unit& u, int wr, int wc, int fr_, int fq_) const {
        int fr = fr_, fq = fq_; asm volatile("" : "+v"(fr), "+v"(fq));
        const int cw = wc * 32 + 8 * fq;
#pragma unroll
        for (int ai = 0; ai < 2; ++ai)
#pragma unroll
            for (int m = 0; m < 4; ++m) {
                const int row = u.pm * 256 + ai * 128 + wr * 64 + m * 16 + fr;
                float ss = 0.f;
#pragma unroll
                for (int bj = 0; bj < 2; ++bj) {
                    bf16_t* p = xb + (size_t)row * D + u.pn * 256 + bj * 128 + cw;
                    f32x4 b0, b1; unpack8(*(const u32x4*)p, b0, b1);
                    const u32x4 wv = pack8(b0 + acc[ai][bj][m][0], b1 + acc[ai][bj][m][1]);
                    *(u32x4*)p = wv;
                    f32x4 r0, r1; unpack8(wv, r0, r1);
                    ss += dot4(r0, r0) + dot4(r1, r1);
                }
                ss += __shfl_xor(ss, 16); ss += __shfl_xor(ss, 32);
                if (fq == 0) rsq[(size_t)row * 16 + u.pn * 4 + wc] = ss;
            }
    }
};
struct EpiQ {
    static constexpr bool PERM = true, AFTER_DRAIN = false, REP_EPI = false;
    const float* rsq; bf16_t* Q;
    __device__ __forceinline__ void operator()(const f32x4 (&acc)[2][2][4][2], const Unit& u, int wr, int wc, int fr_, int fq_) const {
        int fr = fr_, fq = fq_; asm volatile("" : "+v"(fr), "+v"(fq));
        const int cw = wc * 32 + 8 * fq;
#pragma unroll
        for (int ai = 0; ai < 2; ++ai)
#pragma unroll
            for (int m = 0; m < 4; ++m) {
                const int row = u.pm * 256 + ai * 128 + wr * 64 + m * 16 + fr;
                const float rs = rstd16(rsq + (size_t)row * 16);
#pragma unroll
                for (int bj = 0; bj < 2; ++bj) *(u32x4*)(Q + (size_t)row * D + u.pn * 256 + bj * 128 + cw) = pack8(acc[ai][bj][m][0] * rs, acc[ai][bj][m][1] * rs);
            }
    }
};
struct EpiMemKV {
    static constexpr bool PERM = true, AFTER_DRAIN = false, REP_EPI = false;
    const float* rstdm; float* outk; float* outv; bf16_t* kb; bf16_t* vb;
    __device__ __forceinline__ void operator()(const f32x4 (&acc)[2][2][4][2], const Unit& u, int wr, int wc, int fr_, int fq_) const {
        int fr = fr_, fq = fq_; asm volatile("" : "+v"(fr), "+v"(fq));
        const int layer = u.pn >> 3, isv = (u.pn >> 2) & 1, cw = (u.pn & 3) * 256 + wc * 32 + 8 * fq;
        float* of = (isv ? outv : outk) + (size_t)layer * MMEM * D; bf16_t* ob = (isv ? vb : kb) + (size_t)layer * MMEM * D;
#pragma unroll
        for (int ai = 0; ai < 2; ++ai)
#pragma unroll
            for (int m = 0; m < 4; ++m) {
                const int row = u.pm * 256 + ai * 128 + wr * 64 + m * 16 + fr;
                const float rs = rstdm[row];
#pragma unroll
                for (int bj = 0; bj < 2; ++bj) {
                    const size_t off = (size_t)row * D + bj * 128 + cw;
                    const f32x4 v0 = acc[ai][bj][m][0] * rs, v1 = acc[ai][bj][m][1] * rs;
                    *(f32x4*)(of + off) = v0; *(f32x4*)(of + off + 4) = v1;
                    *(u32x4*)(ob + off) = pack8(v0, v1);
                }
            }
    }
};

__device__ __forceinline__ void p0_tr_item(const float* W, int ldw, int k0, int srccol, const float* gk, float sc, bf16_t* WT, int K, int dstn0, LAS float* scr, int lane) {
    float v[32];
    const float* wp = W + (size_t)(k0 + (lane >> 5)) * ldw + srccol;
#pragma unroll
    for (int i = 0; i < 32; ++i) v[i] = wp[(size_t)(2 * i) * ldw];
#pragma unroll
    for (int i = 0; i < 32; ++i) scr[(2 * i + (lane >> 5)) * 33 + (lane & 31)] = v[i];
    LDS_WAIT(); asm volatile("" ::: "memory");
    const int c = lane & 7;
    f32x4 g0 = (f32x4){sc, sc, sc, sc}, g1 = g0;
    if (gk) { g0 = *(const f32x4*)(gk + k0 + 8 * c) * sc; g1 = *(const f32x4*)(gk + k0 + 8 * c + 4) * sc; }
#pragma unroll
    for (int jj = 0; jj < 4; ++jj) {
        const int n = (lane >> 3) + 8 * jj; const LAS float* s = scr + (8 * c) * 33 + n;
        u32x4 o; o.x = cvt_pk_bf16(s[0 * 33] * g0[0], s[1 * 33] * g0[1]); o.y = cvt_pk_bf16(s[2 * 33] * g0[2], s[3 * 33] * g0[3]); o.z = cvt_pk_bf16(s[4 * 33] * g1[0], s[5 * 33] * g1[1]); o.w = cvt_pk_bf16(s[6 * 33] * g1[2], s[7 * 33] * g1[3]);
        *(u32x4*)(WT + (size_t)(dstn0 + n) * K + k0 + 8 * c) = o;
    }
    LDS_WAIT(); asm volatile("" ::: "memory");
}
__device__ __forceinline__ void p0_tr_matrix(const float* W, int ldw, int K, int Nd, const float* gk, float sc, bf16_t* WT, int perm, int r, LAS float* scr, int lane) {
    const int nblk = Nd / 32, kb = r / nblk, nb = r % nblk, dstn0 = 32 * nb, dn = dstn0 + (lane & 31);
    const int srccol = perm == 0 ? dn : (perm == 1 ? src_even(dn) : src_odd(dn));
    p0_tr_item(W, ldw, 64 * kb, srccol, gk, sc, WT, K, dstn0, scr, lane);
}
__device__ __forceinline__ float p0_row(const float* src, bf16_t* dst, float* copy, int lane) {
    const f32x4* xr = (const f32x4*)src + lane;
    f32x4 v[4]; float s = 0.f;
#pragma unroll
    for (int jj = 0; jj < 4; ++jj) { v[jj] = xr[64 * jj]; s += dot4(v[jj], v[jj]); }
    s = wave_sum(s);
    u32x2* o8 = (u32x2*)dst + lane;
#pragma unroll
    for (int jj = 0; jj < 4; ++jj) o8[64 * jj] = pack4(v[jj]);
    if (copy) {
#pragma unroll
        for (int jj = 0; jj < 4; ++jj) ((f32x4*)copy + lane)[64 * jj] = v[jj];
    }
    return s;
}
__device__ __forceinline__ void p0_prologue(Frame& F0) {
    Frame F = launder(F0);
    LAS float* scr = (LAS float*)(F.lds + F.wave * 16384);
    const int gw = F.bx * NWAVES + F.wave, NGW = F.G * NWAVES, lane = F.lane;
    constexpr int I_AB1 = 16 * (NAB / 32), I_C1 = 16 * (NC / 32), I_2 = 32 * 32, I_SQ = 16 * 32, I_PM = 4 * 8;
    constexpr int NITEMS = 2 * I_AB1 + 2 * I_C1 + 4 * I_2 + 16 * I_SQ + 8 * I_PM;
    for (int it = gw; it < NITEMS; it += NGW) {
        int r = it;
        if (r < 2 * I_AB1) { const int jj = r / I_AB1; p0_tr_matrix(FIN(10) + (size_t)jj * D * NAB, NAB, D, NAB, FIN(7) + 2 * jj * D, 1.f, ((bf16_t*)(F.ws + WS_AB1)) + (size_t)jj * NAB * D, 1, r % I_AB1, scr, lane); continue; } r -= 2 * I_AB1;
        if (r < 2 * I_C1) { const int jj = r / I_C1; p0_tr_matrix(FIN(17) + (size_t)jj * D * NC, NC, D, NC, FIN(7) + (2 * jj + 1) * D, 1.f, ((bf16_t*)(F.ws + WS_C1)) + (size_t)jj * NC * D, 2, r % I_C1, scr, lane); continue; } r -= 2 * I_C1;
        if (r < 2 * I_2) { const int jj = r / I_2; p0_tr_matrix(FIN(16) + (size_t)jj * 2048 * D, D, 2048, D, nullptr, 1.f, ((bf16_t*)(F.ws + WS_AB2)) + (size_t)jj * D * 2048, 0, r % I_2, scr, lane); continue; } r -= 2 * I_2;
        if (r < 2 * I_2) { const int jj = r / I_2; p0_tr_matrix(FIN(19) + (size_t)jj * 2048 * D, D, 2048, D, nullptr, 1.f, ((bf16_t*)(F.ws + WS_C2)) + (size_t)jj * D * 2048, 0, r % I_2, scr, lane); continue; } r -= 2 * I_2;
        if (r < 4 * I_SQ) { const int l = r / I_SQ; p0_tr_matrix(FIN(20) + (size_t)l * D * D, D, D, D, FIN(8) + l * D, QSCALE, ((bf16_t*)(F.ws + WS_WQ)) + (size_t)l * D * D, 0, r % I_SQ, scr, lane); continue; } r -= 4 * I_SQ;
        if (r < 4 * I_SQ) { const int l = r / I_SQ; p0_tr_matrix(FIN(21) + (size_t)l * D * D, D, D, D, FIN(9) + l * D, 1.f, ((bf16_t*)(F.ws + WS_WKV)) + (size_t)(2 * l) * D * D, 0, r % I_SQ, scr, lane); continue; } r -= 4 * I_SQ;
        if (r < 4 * I_SQ) { const int l = r / I_SQ; p0_tr_matrix(FIN(22) + (size_t)l * D * D, D, D, D, FIN(9) + l * D, 1.f, ((bf16_t*)(F.ws + WS_WKV)) + (size_t)(2 * l + 1) * D * D, 0, r % I_SQ, scr, lane); continue; } r -= 4 * I_SQ;
        if (r < 4 * I_SQ) { const int l = r / I_SQ; p0_tr_matrix(FIN(23) + (size_t)l * D * D, D, D, D, nullptr, 1.f, ((bf16_t*)(F.ws + WS_WO)) + (size_t)l * D * D, 0, r % I_SQ, scr, lane); continue; } r -= 4 * I_SQ;
        { const int jg = r / I_PM; p0_tr_matrix(FIN(11) + (size_t)jg * 65536, 256, 256, 256, nullptr, 1.f, ((bf16_t*)(F.ws + WS_PMT)) + (size_t)jg * 65536, 0, r % I_PM, scr, lane); }
    }
    for (int m = gw; m < MP + MS + MMEM; m += NGW) {
        if (m < MP) {
            const float s = p0_row(FIN(0) + (size_t)m * D, ((bf16_t*)(F.ws + WS_XB)) + (size_t)m * D, nullptr, lane);
            if (lane < 16) ((float*)(F.ws + WS_RSQ))[(size_t)m * 16 + lane] = lane == 0 ? s : 0.f;
        } else if (m < MP + MS) {
            const int b = m - MP;
            const float s = p0_row(FIN(1) + (size_t)b * D, ((bf16_t*)(F.ws + WS_XB)) + (size_t)m * D, ((float*)(F.ws + WS_XS)) + (size_t)b * D, lane);
            if (lane < 32) ((float*)(F.ws + WS_SMALL))[b * 32 + lane] = lane == 0 ? s : 0.f;
        } else {
            const int t = m - MP - MS;
            const float s = p0_row(FIN(2) + (size_t)t * D, ((bf16_t*)(F.ws + WS_MEMB)) + (size_t)t * D, nullptr, lane);
            if (lane == 0) ((float*)(F.ws + WS_SMALL + 65536))[t] = rsqrtf(s * (1.0f / D) + EPS);
        }
    }
}

__device__ __forceinline__ bf16x8 tr_frag(LAS unsigned char* p0, LAS unsigned char* p1) {
    const s16x4 lo = __builtin_amdgcn_ds_read_tr16_b64_v4i16((LAS s16x4*)p0);
    const s16x4 hi = __builtin_amdgcn_ds_read_tr16_b64_v4i16((LAS s16x4*)p1);
    return (bf16x8){lo[0], lo[1], lo[2], lo[3], hi[0], hi[1], hi[2], hi[3]};
}
#define MFMA16(a, b, c) __builtin_amdgcn_mfma_f32_16x16x32_bf16((a), (b), (c), 0, 0, 0)

constexpr int SGU_AS = 0, SGU_VS = 34816, SGU_RV = 34816 + 67584;
__device__ __forceinline__ void sgu_unit(Frame& F0, int j, int n, int g) {
    Frame F = launder(F0);
    LAS unsigned char* lds = F.lds;
    const int tid = F.tid, lane = F.lane, w = F.wave, fr = lane & 15, fq = lane >> 4, row0 = n * 128;
    LAS float* rvs = (LAS float*)(lds + SGU_RV);
    if (tid < 128) rvs[tid] = rstd16(((float*)(F.ws + WS_VSQ)) + (size_t)(row0 + tid) * 16);
    const bf16_t* ZV = ((bf16_t*)(F.ws + WS_Z)) + (size_t)2 * MP * D;
#pragma unroll
    for (int i = 0; i < 8; ++i) {
        const int idx = tid + 512 * i, s = idx >> 5, c8 = idx & 31;
        *(LAS u32x4*)(lds + SGU_VS + s * 528 + c8 * 16) = *(const u32x4*)(ZV + (size_t)(row0 + s) * D + g * 256 + c8 * 8);
    }
    __syncthreads();
    const float* wg = FIN(13) + (size_t)(j * 4 + g) * 16384;
#pragma unroll
    for (int i = 0; i < 4; ++i) {
        const int idx = tid + 512 * i, t = idx >> 4, s0 = (idx & 15) * 8;
        const f32x4 a = *(const f32x4*)(wg + t * 128 + s0), b = *(const f32x4*)(wg + t * 128 + s0 + 4);
        float v[8];
#pragma unroll
        for (int e = 0; e < 4; ++e) { v[e] = (s0 + e <= t) ? a[e] * rvs[s0 + e] : 0.f; v[4 + e] = (s0 + 4 + e <= t) ? b[e] * rvs[s0 + 4 + e] : 0.f; }
        u32x4 o; o.x = cvt_pk_bf16(v[0], v[1]); o.y = cvt_pk_bf16(v[2], v[3]); o.z = cvt_pk_bf16(v[4], v[5]); o.w = cvt_pk_bf16(v[6], v[7]);
        *(LAS u32x4*)(lds + SGU_AS + t * 272 + s0 * 2) = o;
    }
    __syncthreads();
    f32x4 acc[8][2];
#pragma unroll
    for (int mt = 0; mt < 8; ++mt) { acc[mt][0] = (f32x4){0.f, 0.f, 0.f, 0.f}; acc[mt][1] = (f32x4){0.f, 0.f, 0.f, 0.f}; }
#pragma unroll
    for (int ks = 0; ks < 4; ++ks) {
        bf16x8 Bf[2];
#pragma unroll
        for (int nt = 0; nt < 2; ++nt) {
            LAS unsigned char* p = lds + SGU_VS + (32 * ks + 8 * fq + (fr >> 2)) * 528 + (32 * w + 16 * nt + 4 * (fr & 3)) * 2;
            Bf[nt] = tr_frag(p, p + 4 * 528);
        }
#pragma unroll
        for (int mt = 0; mt < 8; ++mt) {
            if (32 * ks <= 16 * mt + 15) {
                const bf16x8 Af = *(LAS bf16x8*)(lds + SGU_AS + (16 * mt + fr) * 272 + (32 * ks + 8 * fq) * 2);
                acc[mt][0] = MFMA16(Bf[0], Af, acc[mt][0]); acc[mt][1] = MFMA16(Bf[1], Af, acc[mt][1]);
            }
        }
    }
    const bf16_t* ZUG = ((bf16_t*)(F.ws + WS_Z)) + (size_t)3 * MP * D;
#pragma unroll
    for (int nt = 0; nt < 2; ++nt) {
        const int c = g * 256 + 32 * w + 16 * nt + 4 * fq;
        const f32x4 gg = *(const f32x4*)(FIN(15) + j * 1024 + c);
#pragma unroll
        for (int mt = 0; mt < 8; ++mt) {
            const int t = 16 * mt + fr;
            const float bb = FIN(14)[(j * 4 + g) * 128 + t];
            const f32x4 ug = unpack4(*(const u32x2*)(ZUG + (size_t)(row0 + t) * D + c));
            *(u32x2*)(((bf16_t*)(F.ws + WS_A2)) + (size_t)(row0 + t) * 2048 + 1024 + c) = pack4(ug * (acc[mt][nt] * gg + bb));
        }
    }
    __syncthreads();
}
__device__ __forceinline__ void pool_unit(Frame& F0, int j, int n, int g) {
    Frame F = launder(F0);
    LAS unsigned char* lds = F.lds;
    const int tid = F.tid, lane = F.lane, w = F.wave, fr = lane & 15, fq = lane >> 4, row0 = n * 128;
    {
        const int cb = tid & 31, t0 = (tid >> 5) * 8, win = 2 << g, pos0 = (row0 & 2047) + t0;
        const bf16_t* xa = ((bf16_t*)(F.ws + WS_Z)) + (size_t)(row0 + t0) * D + g * 256 + cb * 8;
        f32x4 S0 = (f32x4){0.f, 0.f, 0.f, 0.f}, S1 = S0;
        for (int i = 1; i < win; ++i) if (pos0 - i >= 0) { f32x4 a, b; unpack8(*(const u32x4*)(xa - (size_t)i * D), a, b); S0 += a; S1 += b; }
#pragma unroll
        for (int r = 0; r < 8; ++r) {
            f32x4 a, b; unpack8(*(const u32x4*)(xa + (size_t)r * D), a, b); S0 += a; S1 += b;
            const int cnt = (pos0 + r + 1) < win ? (pos0 + r + 1) : win; const float ic = 1.0f / (float)cnt;
            *(LAS u32x4*)(lds + (t0 + r) * 528 + cb * 16) = pack8(S0 * ic - a, S1 * ic - b);
            if (pos0 + r - (win - 1) >= 0) { f32x4 c, d; unpack8(*(const u32x4*)(xa + ((ptrdiff_t)r - (win - 1)) * D), c, d); S0 -= c; S1 -= d; }
        }
    }
    __syncthreads();
    f32x4 acc[8][2];
#pragma unroll
    for (int mt = 0; mt < 8; ++mt) { acc[mt][0] = (f32x4){0.f, 0.f, 0.f, 0.f}; acc[mt][1] = (f32x4){0.f, 0.f, 0.f, 0.f}; }
    const bf16_t* pm = ((bf16_t*)(F.ws + WS_PMT)) + (size_t)(j * 4 + g) * 65536 + (size_t)(32 * w + fr) * 256 + 8 * fq;
#pragma unroll
    for (int ks = 0; ks < 8; ++ks) {
        const bf16x8 B0 = *(const bf16x8*)(pm + 32 * ks), B1 = *(const bf16x8*)(pm + 16 * 256 + 32 * ks);
#pragma unroll
        for (int mt = 0; mt < 8; ++mt) {
            const bf16x8 Af = *(LAS bf16x8*)(lds + (16 * mt + fr) * 528 + (32 * ks + 8 * fq) * 2);
            acc[mt][0] = MFMA16(B0, Af, acc[mt][0]); acc[mt][1] = MFMA16(B1, Af, acc[mt][1]);
        }
    }
    const bf16_t* ZSGA = ((bf16_t*)(F.ws + WS_Z)) + (size_t)1 * MP * D;
#pragma unroll
    for (int nt = 0; nt < 2; ++nt) {
        const int c = g * 256 + 32 * w + 16 * nt + 4 * fq;
        const f32x4 ps = *(const f32x4*)(FIN(12) + j * 1024 + c);
#pragma unroll
        for (int mt = 0; mt < 8; ++mt) {
            const int t = 16 * mt + fr;
            const f32x4 sg = unpack4(*(const u32x2*)(ZSGA + (size_t)(row0 + t) * D + c));
            *(u32x2*)(((bf16_t*)(F.ws + WS_A2)) + (size_t)(row0 + t) * 2048 + c) = pack4(acc[mt][nt] * ps * sg);
        }
    }
    __syncthreads();
}
constexpr int ATT_SLOT = 64 * 528;
__device__ __forceinline__ void attn_prompt(Frame& F0, int layer) {
    Frame F = launder(F0);
    LAS unsigned char* lds = F.lds;
    const int tid = F.tid, lane = F.lane, w = F.wave, fr = lane & 15, fq = lane >> 4;
    const bf16_t* Kl = ((bf16_t*)(F.ws + WS_KB)) + (size_t)layer * MMEM * D; const bf16_t* Vl = ((bf16_t*)(F.ws + WS_VB)) + (size_t)layer * MMEM * D;
    for (int unit = F.bx; unit < 512; unit += F.G) {
        const int bh = unit >> 4, b = bh >> 2, h = bh & 3, qb = unit & 15;
        const size_t rowq = (size_t)b * SEQ + qb * 128 + 16 * w + fr;
        bf16x8 Qf[8];
#pragma unroll
        for (int ks = 0; ks < 8; ++ks) Qf[ks] = *(const bf16x8*)(((bf16_t*)(F.ws + WS_Q)) + rowq * D + h * 256 + 32 * ks + 8 * fq);
        const bf16_t* kbase = Kl + (size_t)(b * 256) * D + h * 256; const bf16_t* vbase = Vl + (size_t)(b * 256) * D + h * 256;
        u32x4 st[4];
#define ATT_GLOAD(c) do { const bf16_t* src_ = ((c) < 4 ? kbase : vbase) + (size_t)(64 * ((c) & 3)) * D; _Pragma("unroll") for (int i_ = 0; i_ < 4; ++i_) { const int idx_ = tid + 512 * i_; st[i_] = *(const u32x4*)(src_ + (size_t)(idx_ >> 5) * D + (idx_ & 31) * 8); } } while (0)
#define ATT_LSTORE(slot) do { _Pragma("unroll") for (int i_ = 0; i_ < 4; ++i_) { const int idx_ = tid + 512 * i_; *(LAS u32x4*)(lds + (slot) * ATT_SLOT + (idx_ >> 5) * 528 + (idx_ & 31) * 16) = st[i_]; } } while (0)
        f32x4 S[16], Oa[16]; bf16x8 Pf[8]; float inv = 0.f;
#pragma unroll
        for (int i = 0; i < 16; ++i) { S[i] = (f32x4){0.f, 0.f, 0.f, 0.f}; Oa[i] = (f32x4){0.f, 0.f, 0.f, 0.f}; }
        ATT_GLOAD(0); ATT_LSTORE(0); __syncthreads();
#pragma unroll
        for (int c = 0; c < 8; ++c) {
            if (c < 7) ATT_GLOAD(c + 1);
            LAS unsigned char* slot = lds + (c & 1) * ATT_SLOT;
            if (c < 4) {
#pragma unroll
                for (int ml = 0; ml < 4; ++ml)
#pragma unroll
                    for (int ks = 0; ks < 8; ++ks) {
                        const bf16x8 Kf = *(LAS bf16x8*)(slot + (16 * ml + fr) * 528 + (32 * ks + 8 * fq) * 2);
                        S[4 * c + ml] = MFMA16(Kf, Qf[ks], S[4 * c + ml]);
                    }
                if (c == 3) {
                    float mx = S[0][0];
#pragma unroll
                    for (int i = 0; i < 16; ++i) { mx = fmaxf(mx, fmaxf(fmaxf(S[i][0], S[i][1]), fmaxf(S[i][2], S[i][3]))); }
                    mx = fmaxf(mx, __shfl_xor(mx, 16)); mx = fmaxf(mx, __shfl_xor(mx, 32));
                    float sum = 0.f;
#pragma unroll
                    for (int i = 0; i < 16; ++i) {
#pragma unroll
                        for (int e = 0; e < 4; ++e) { S[i][e] = __builtin_amdgcn_exp2f(S[i][e] - mx); sum += S[i][e]; }
                    }
                    sum += __shfl_xor(sum, 16); sum += __shfl_xor(sum, 32);
                    inv = 1.0f / sum;
#pragma unroll
                    for (int a = 0; a < 8; ++a) {
                        u32x4 pw; pw.x = cvt_pk_bf16(S[2 * a][0], S[2 * a][1]); pw.y = cvt_pk_bf16(S[2 * a][2], S[2 * a][3]); pw.z = cvt_pk_bf16(S[2 * a + 1][0], S[2 * a + 1][1]); pw.w = cvt_pk_bf16(S[2 * a + 1][2], S[2 * a + 1][3]);
                        Pf[a] = __builtin_bit_cast(bf16x8, pw);
                    }
                }
            } else {
#pragma unroll
                for (int al = 0; al < 2; ++al)
#pragma unroll
                    for (int dt = 0; dt < 16; ++dt) {
                        LAS unsigned char* p = slot + (32 * al + 4 * fq + (fr >> 2)) * 528 + (16 * dt + 4 * (fr & 3)) * 2;
                        const bf16x8 Vf = tr_frag(p, p + 16 * 528);
                        Oa[dt] = MFMA16(Vf, Pf[2 * (c - 4) + al], Oa[dt]);
                    }
            }
            if (c < 7) ATT_LSTORE((c + 1) & 1);
            __syncthreads();
        }
#pragma unroll
        for (int dt = 0; dt < 16; ++dt) *(u32x2*)(((bf16_t*)(F.ws + WS_O)) + rowq * D + h * 256 + 16 * dt + 4 * fq) = pack4(Oa[dt] * inv);
#undef ATT_GLOAD
#undef ATT_LSTORE
    }
}

template <class Epi>
__device__ __forceinline__ void skinny_gemm(Frame& F0, const bf16_t* A, const bf16_t* Bt, int N, int K, const Epi& E) {
    Frame F = launder(F0);
    LAS unsigned char* lds = F.lds;
    const int tid = F.tid, lane = F.lane, w = F.wave, fr = lane & 15, fq = lane >> 4;
    const int nstrips = N / 32, kslice = K / 8, nks = kslice / 32;
    for (int strip = F.bx; strip < nstrips; strip += F.G) {
        f32x4 acc[8][2];
#pragma unroll
        for (int mt = 0; mt < 8; ++mt) { acc[mt][0] = (f32x4){0.f, 0.f, 0.f, 0.f}; acc[mt][1] = (f32x4){0.f, 0.f, 0.f, 0.f}; }
        const bf16_t* ap = A + (size_t)fr * K + w * kslice + 8 * fq; const bf16_t* bp = Bt + (size_t)(strip * 32 + fr) * K + w * kslice + 8 * fq;
#pragma unroll 2
        for (int ks = 0; ks < nks; ++ks) {
            const bf16x8 B0 = *(const bf16x8*)(bp + 32 * ks), B1 = *(const bf16x8*)(bp + (size_t)16 * K + 32 * ks);
#pragma unroll
            for (int mt = 0; mt < 8; ++mt) {
                const bf16x8 Af = *(const bf16x8*)(ap + (size_t)(16 * mt) * K + 32 * ks);
                acc[mt][0] = MFMA16(B0, Af, acc[mt][0]); acc[mt][1] = MFMA16(B1, Af, acc[mt][1]);
            }
        }
#pragma unroll
        for (int mt = 0; mt < 8; ++mt)
#pragma unroll
            for (int nt = 0; nt < 2; ++nt) *(LAS f32x4*)(lds + ((size_t)((w * 128 + 16 * mt + fr) * 32 + 16 * nt + 4 * fq)) * 4) = acc[mt][nt];
        __syncthreads();
        const int row = tid >> 2, cq = tid & 3;
        f32x4 s0 = (f32x4){0.f, 0.f, 0.f, 0.f}, s1 = s0;
#pragma unroll
        for (int ww = 0; ww < 8; ++ww) { const LAS f32x4* p = (const LAS f32x4*)(lds + ((size_t)((ww * 128 + row) * 32 + 8 * cq)) * 4); s0 += p[0]; s1 += p[1]; }
        E(row, strip, strip * 32 + 8 * cq, s0, s1);
        __syncthreads();
    }
}
struct SEpiZ {
    const float* rsqs; float* SZ; int ldz, mode;
    __device__ __forceinline__ void operator()(int row, int strip, int col, f32x4 s0, f32x4 s1) const {
        const float rs = rstd32(rsqs + row * 32); const int oc0 = mode == 0 ? src_even(col) : src_odd(col), oc1 = mode == 0 ? src_even(col + 4) : src_odd(col + 4);
        float* p = SZ + (size_t)row * ldz; *(f32x4*)(p + oc0) = s0 * rs; *(f32x4*)(p + oc1) = s1 * rs;
    }
};
struct SEpiRes {
    float* xs; bf16_t* xb; float* rsqs;
    __device__ __forceinline__ void operator()(int row, int strip, int col, f32x4 s0, f32x4 s1) const {
        float* p = xs + (size_t)row * D + col; const f32x4 o0 = *(const f32x4*)p + s0, o1 = *(const f32x4*)(p + 4) + s1;
        *(f32x4*)p = o0; *(f32x4*)(p + 4) = o1; *(u32x4*)(xb + (size_t)row * D + col) = pack8(o0, o1);
        float ss = dot4(o0, o0) + dot4(o1, o1); ss += __shfl_xor(ss, 1); ss += __shfl_xor(ss, 2);
        if ((col & 31) == 0) rsqs[row * 32 + strip] = ss;
    }
};
struct SEpiQ {
    const float* rsqs; float* SQ;
    __device__ __forceinline__ void operator()(int row, int strip, int col, f32x4 s0, f32x4 s1) const {
        const float rs = rstd32(rsqs + row * 32); float* p = SQ + (size_t)row * D + col; *(f32x4*)p = s0 * rs; *(f32x4*)(p + 4) = s1 * rs;
    }
};
__device__ __forceinline__ void sample_mix_even(Frame& F0, int j, int b) {
    Frame F = launder(F0);
    LAS float* pl = (LAS float*)F.lds; LAS float* red = pl + 1024;
    const int tid = F.tid, lane = F.lane, w = F.wave;
    const float* z = ((float*)(F.ws + WS_SZ)) + (size_t)b * 8192;
    float vv[2], ss = 0.f;
#pragma unroll
    for (int k = 0; k < 2; ++k) { vv[k] = z[3072 + tid + 512 * k]; ss += vv[k] * vv[k]; }
    ss = wave_sum(ss); if (lane == 0) red[w] = ss;
#pragma unroll
    for (int k = 0; k < 2; ++k) {
        const int c = tid + 512 * k, g = c >> 8, win = 2 << g; const float xa = z[c];
        const float* st = FIN(3) + ((size_t)(j * 128 + b) * 15) * 1024 + c;
        float s = xa; for (int r = 16 - win; r < 15; ++r) s += st[(size_t)r * 1024];
        pl[c] = s / (float)win - xa;
        float* po = F.out + O_POOLS + ((size_t)(j * 128 + b) * 15) * 1024 + c;
        for (int r = 0; r < 14; ++r) po[(size_t)r * 1024] = st[(size_t)(r + 1) * 1024];
        po[(size_t)14 * 1024] = xa;
    }
    __syncthreads();
    float tot = 0.f;
#pragma unroll
    for (int i = 0; i < 8; ++i) tot += red[i];
    const float rv = rsqrtf(tot * (1.0f / D) + EPS);
#pragma unroll
    for (int k = 0; k < 2; ++k) {
        const int d = tid + 512 * k, g = d >> 8, dd = d & 255;
        const float* pm = FIN(11) + (size_t)(j * 4 + g) * 65536 + dd; const LAS float* pg = pl + g * 256;
        float a = 0.f;
#pragma unroll 8
        for (int c = 0; c < 256; ++c) a += pg[c] * pm[(size_t)c * 256];
        const float ya = a * FIN(12)[j * 1024 + d] * silu_f(z[1024 + d]);
        const float vn = vv[k] * rv * FIN(15)[j * 1024 + d];
        F.out[O_SGUV + (size_t)(j * 128 + b) * 1024 + d] = vn;
        const float mixed = FIN(13)[(size_t)(j * 4 + g) * 16384] * vn + FIN(14)[(j * 4 + g) * 128];
        const float yb = z[2048 + d] * mixed * silu_f(z[4096 + d]);
        ((bf16_t*)(F.ws + WS_SA2))[(size_t)b * 2048 + d] = (bf16_t)(cvt_pk_bf16(ya, 0.f) & 0xffffu); ((bf16_t*)(F.ws + WS_SA2))[(size_t)b * 2048 + 1024 + d] = (bf16_t)(cvt_pk_bf16(yb, 0.f) & 0xffffu);
    }
    __syncthreads();
}
__device__ __forceinline__ void sample_conv_odd(Frame& F0, int j, int b) {
    Frame F = launder(F0);
    const int tid = F.tid;
    const float* z = ((float*)(F.ws + WS_SZ)) + (size_t)b * 8192;
    const float* cw = FIN(18) + (size_t)j * 3 * 2048;
#pragma unroll
    for (int k = 0; k < 4; ++k) {
        const int c = tid + 512 * k;
        const float e = z[2048 + c] * z[4096 + c];
        const float s0 = FIN(4)[((size_t)(j * 128 + b) * 2 + 0) * 2048 + c], s1 = FIN(4)[((size_t)(j * 128 + b) * 2 + 1) * 2048 + c];
        const float y = cw[c] * s0 + cw[2048 + c] * s1 + cw[4096 + c] * e;
        ((bf16_t*)(F.ws + WS_SA2))[(size_t)b * 2048 + c] = (bf16_t)(cvt_pk_bf16(z[c] * y * silu_f(z[6144 + c]), 0.f) & 0xffffu);
        float* po = F.out + O_CONVS + ((size_t)(j * 128 + b) * 2) * 2048 + c; po[0] = s1; po[2048] = e;
    }
}
__device__ __forceinline__ void attn_sample(Frame& F0, int layer) {
    Frame F = launder(F0);
    LAS float* sc = (LAS float*)F.lds;
    LAS float* red = sc + 512;
    const int tid = F.tid, lane = F.lane, w = F.wave;
    for (int item = F.bx; item < 256; item += F.G) {
        const int b = item >> 1, hp = item & 1;
        const float* qp = ((float*)(F.ws + WS_SQ)) + (size_t)b * D + hp * 512;
        const f32x4 q0 = *(const f32x4*)(qp + 4 * lane), q1 = *(const f32x4*)(qp + 256 + 4 * lane);
        const float* kp = FIN(5) + ((size_t)(layer * 128 + b) * 256) * 1024 + hp * 512 + 4 * lane;
        const float* vp = FIN(6) + ((size_t)(layer * 128 + b) * 256) * 1024 + hp * 512 + 4 * lane;
#pragma unroll 8
        for (int mi = 0; mi < 32; ++mi) {
            const int m = 32 * w + mi;
            const f32x4 k0 = __builtin_nontemporal_load((const f32x4*)(kp + (size_t)m * 1024)), k1 = __builtin_nontemporal_load((const f32x4*)(kp + (size_t)m * 1024 + 256));
            const float d0 = wave_sum(dot4(k0, q0)), d1 = wave_sum(dot4(k1, q1));
            if (lane == 0) { sc[m] = d0; sc[256 + m] = d1; }
        }
        __syncthreads();
        float p0[4], p1[4], mx0 = -INFINITY, mx1 = -INFINITY;
#pragma unroll
        for (int i = 0; i < 4; ++i) { p0[i] = sc[lane + 64 * i]; p1[i] = sc[256 + lane + 64 * i]; mx0 = fmaxf(mx0, p0[i]); mx1 = fmaxf(mx1, p1[i]); }
#pragma unroll
        for (int o = 1; o < 64; o <<= 1) { mx0 = fmaxf(mx0, __shfl_xor(mx0, o)); mx1 = fmaxf(mx1, __shfl_xor(mx1, o)); }
        float sm0 = 0.f, sm1 = 0.f;
#pragma unroll
        for (int i = 0; i < 4; ++i) { p0[i] = __builtin_amdgcn_exp2f(p0[i] - mx0); p1[i] = __builtin_amdgcn_exp2f(p1[i] - mx1); sm0 += p0[i]; sm1 += p1[i]; }
        sm0 = wave_sum(sm0); sm1 = wave_sum(sm1);
        const float i0 = 1.0f / sm0, i1 = 1.0f / sm1;
        __syncthreads();
        if (w == 0) {
#pragma unroll
            for (int i = 0; i < 4; ++i) { sc[lane + 64 * i] = p0[i] * i0; sc[256 + lane + 64 * i] = p1[i] * i1; }
        }
        __syncthreads();
        f32x4 a0 = (f32x4){0.f, 0.f, 0.f, 0.f}, a1 = a0;
#pragma unroll 8
        for (int mi = 0; mi < 32; ++mi) {
            const int m = 32 * w + mi;
            const f32x4 v0 = __builtin_nontemporal_load((const f32x4*)(vp + (size_t)m * 1024)), v1 = __builtin_nontemporal_load((const f32x4*)(vp + (size_t)m * 1024 + 256));
            a0 += v0 * sc[m]; a1 += v1 * sc[256 + m];
        }
        *(LAS f32x4*)(red + w * 512 + 4 * lane) = a0; *(LAS f32x4*)(red + w * 512 + 256 + 4 * lane) = a1;
        __syncthreads();
        {
            float o = 0.f;
#pragma unroll
            for (int ww = 0; ww < 8; ++ww) o += red[ww * 512 + tid];
            ((bf16_t*)(F.ws + WS_SO))[(size_t)b * D + hp * 512 + tid] = (bf16_t)(cvt_pk_bf16(o, 0.f) & 0xffffu);
        }
        __syncthreads();
    }
}
#define dpp_mov(v, ctrl, row_mask) __builtin_bit_cast(float, __builtin_amdgcn_update_dpp(0, __builtin_bit_cast(int, (float)(v)), (ctrl), (row_mask), 0xf, false))
__device__ __forceinline__ float wave_sum_dpp(float x) {
    x += dpp_mov(x, 0xB1, 0xf);
    x += dpp_mov(x, 0x4E, 0xf);
    x += dpp_mov(x, 0x141, 0xf);
    x += dpp_mov(x, 0x140, 0xf);
    x += dpp_mov(x, 0x142, 0xa);
    x += dpp_mov(x, 0x143, 0xc);
    return x;
}
constexpr int FA_SC = 69632, FA_RED = 71680;
__device__ __forceinline__ void attn_fused(Frame& F0, int layer) {
    Frame F = launder(F0);
    LAS unsigned char* lds = F.lds;
    const int tid = F.tid, lane = F.lane, w = F.wave, fr = lane & 15, fq = lane >> 4;
    const bf16_t* Kl = ((bf16_t*)(F.ws + WS_KB)) + (size_t)layer * MMEM * D; const bf16_t* Vl = ((bf16_t*)(F.ws + WS_VB)) + (size_t)layer * MMEM * D;
    LAS float* sc = (LAS float*)(lds + FA_SC); LAS float* red = (LAS float*)(lds + FA_RED);
    const int sb = F.bx >> 1, hp = F.bx & 1;
    const float* qp = ((float*)(F.ws + WS_SQ)) + (size_t)sb * D + hp * 512;
    const f32x4 q0 = *(const f32x4*)(qp + 4 * lane), q1 = *(const f32x4*)(qp + 256 + 4 * lane);
    const float* kp = FIN(5) + ((size_t)(layer * 128 + sb) * 256 + 4 * w) * 1024 + hp * 512;
    const float* vp = FIN(6) + ((size_t)(layer * 128 + sb) * 256 + 4 * w) * 1024 + hp * 512;
    const unsigned lo16 = (unsigned)lane * 16u;
    f32x4 sv[8]; f32x4 a0 = (f32x4){0.f, 0.f, 0.f, 0.f}, a1 = a0; float mx0 = 0.f, mx1 = 0.f, iv0 = 0.f, iv1 = 0.f;
#define FA_SLOAD(base, slice) do { unsigned long long pu_ = uni64((unsigned long long)((base) + (size_t)(32 * (slice)) * 1024)); asm volatile("" : "+s"(pu_)); const char* pc_ = (const char*)(const GAS char*)pu_; \
        _Pragma("unroll") for (int r_ = 0; r_ < 4; ++r_) { sv[2 * r_] = __builtin_nontemporal_load((const f32x4*)(pc_ + r_ * 4096 + lo16)); sv[2 * r_ + 1] = __builtin_nontemporal_load((const f32x4*)(pc_ + r_ * 4096 + 1024 + lo16)); } } while (0)
    FA_SLOAD(kp, 0);
#pragma unroll 1
    for (int ui = 0; ui < 2; ++ui) {
        const int unit = F.bx + 256 * ui;
        const int bh = unit >> 4, b = bh >> 2, h = bh & 3, qb = unit & 15;
        const size_t rowq = (size_t)b * SEQ + qb * 128 + 16 * w + fr;
        bf16x8 Qf[8];
#pragma unroll
        for (int ks = 0; ks < 8; ++ks) Qf[ks] = *(const bf16x8*)(((bf16_t*)(F.ws + WS_Q)) + rowq * D + h * 256 + 32 * ks + 8 * fq);
        const bf16_t* kbase = Kl + (size_t)(b * 256) * D + h * 256; const bf16_t* vbase = Vl + (size_t)(b * 256) * D + h * 256;
        u32x4 st[4];
        const unsigned goff = (unsigned)(tid >> 5) * (D * 2) + (unsigned)(tid & 31) * 16u, loff = (unsigned)(tid >> 5) * 528u + (unsigned)(tid & 31) * 16u;
#define ATT_GLOAD(c) do { unsigned long long pu_ = uni64((unsigned long long)(((c) < 4 ? kbase : vbase) + (size_t)(64 * ((c) & 3)) * D)); asm volatile("" : "+s"(pu_)); const char* pc_ = (const char*)(const GAS char*)pu_; \
        _Pragma("unroll") for (int i_ = 0; i_ < 4; ++i_) st[i_] = *(const u32x4*)(pc_ + (size_t)(16 * i_) * D * 2 + goff); } while (0)
#define ATT_LSTORE(slot) do { _Pragma("unroll") for (int i_ = 0; i_ < 4; ++i_) *(LAS u32x4*)(lds + (slot) * ATT_SLOT + 16 * i_ * 528 + loff) = st[i_]; } while (0)
        f32x4 S[16], Oa[16]; bf16x8 Pf[8]; float inv = 0.f;
        const f32x4 zero4 = (f32x4){0.f, 0.f, 0.f, 0.f};
        if (ui == 1) {
            float p0[4], p1[4]; mx0 = -INFINITY; mx1 = -INFINITY;
#pragma unroll
            for (int i = 0; i < 4; ++i) { p0[i] = sc[lane + 64 * i]; p1[i] = sc[256 + lane + 64 * i]; mx0 = fmaxf(mx0, p0[i]); mx1 = fmaxf(mx1, p1[i]); }
#pragma unroll
            for (int o = 1; o < 64; o <<= 1) { mx0 = fmaxf(mx0, __shfl_xor(mx0, o)); mx1 = fmaxf(mx1, __shfl_xor(mx1, o)); }
            float sm0 = 0.f, sm1 = 0.f;
#pragma unroll
            for (int i = 0; i < 4; ++i) { sm0 += __builtin_amdgcn_exp2f(p0[i] - mx0); sm1 += __builtin_amdgcn_exp2f(p1[i] - mx1); }
            sm0 = wave_sum(sm0); sm1 = wave_sum(sm1);
            iv0 = 1.0f / sm0; iv1 = 1.0f / sm1;
        }
        ATT_GLOAD(0); ATT_LSTORE(0); __syncthreads();
#pragma unroll
        for (int c = 0; c < 8; ++c) {
            if (c < 7) ATT_GLOAD(c + 1);
            if (ui == 0) {
#pragma unroll
                for (int r = 0; r < 4; ++r) {
                    const int m = 32 * c + 4 * w + r;
                    const float d0 = wave_sum_dpp(dot4(sv[2 * r], q0)), d1 = wave_sum_dpp(dot4(sv[2 * r + 1], q1));
                    if (lane == 63) { sc[m] = d0; sc[256 + m] = d1; }
                }
                if (c < 7) FA_SLOAD(kp, c + 1); else FA_SLOAD(vp, 0);
            } else {
#pragma unroll
                for (int r = 0; r < 4; ++r) {
                    const int m = 32 * c + 4 * w + r;
                    const float p0 = __builtin_amdgcn_exp2f(sc[m] - mx0) * iv0, p1 = __builtin_amdgcn_exp2f(sc[256 + m] - mx1) * iv1;
                    a0 += sv[2 * r] * p0; a1 += sv[2 * r + 1] * p1;
                }
                if (c < 7) FA_SLOAD(vp, c + 1);
            }
            LAS unsigned char* slot = lds + (c & 1) * ATT_SLOT;
            if (c < 4) {
#pragma unroll
                for (int ml = 0; ml < 4; ++ml)
#pragma unroll
                    for (int ks = 0; ks < 8; ++ks) {
                        const bf16x8 Kf = *(LAS bf16x8*)(slot + (16 * ml + fr) * 528 + (32 * ks + 8 * fq) * 2);
                        S[4 * c + ml] = MFMA16(Kf, Qf[ks], ks == 0 ? zero4 : S[4 * c + ml]);
                    }
                if (c == 3) {
                    float mx = S[0][0];
#pragma unroll
                    for (int i = 0; i < 16; ++i) { mx = fmaxf(mx, fmaxf(fmaxf(S[i][0], S[i][1]), fmaxf(S[i][2], S[i][3]))); }
                    mx = fmaxf(mx, __shfl_xor(mx, 16)); mx = fmaxf(mx, __shfl_xor(mx, 32));
                    float sum = 0.f;
#pragma unroll
                    for (int i = 0; i < 16; ++i) {
#pragma unroll
                        for (int e = 0; e < 4; ++e) { S[i][e] = __builtin_amdgcn_exp2f(S[i][e] - mx); sum += S[i][e]; }
                    }
                    sum += __shfl_xor(sum, 16); sum += __shfl_xor(sum, 32);
                    inv = 1.0f / sum;
#pragma unroll
                    for (int a = 0; a < 8; ++a) {
                        u32x4 pw; pw.x = cvt_pk_bf16(S[2 * a][0], S[2 * a][1]); pw.y = cvt_pk_bf16(S[2 * a][2], S[2 * a][3]); pw.z = cvt_pk_bf16(S[2 * a + 1][0], S[2 * a + 1][1]); pw.w = cvt_pk_bf16(S[2 * a + 1][2], S[2 * a + 1][3]);
                        Pf[a] = __builtin_bit_cast(bf16x8, pw);
                    }
                }
            } else {
#pragma unroll
                for (int al = 0; al < 2; ++al)
#pragma unroll
                    for (int dt = 0; dt < 16; ++dt) {
                        LAS unsigned char* p = slot + (32 * al + 4 * fq + (fr >> 2)) * 528 + (16 * dt + 4 * (fr & 3)) * 2;
                        const bf16x8 Vf = tr_frag(p, p + 16 * 528);
                        Oa[dt] = MFMA16(Vf, Pf[2 * (c - 4) + al], (c == 4 && al == 0) ? zero4 : Oa[dt]);
                    }
            }
            if (c < 7) ATT_LSTORE((c + 1) & 1);
            __syncthreads();
        }
#pragma unroll
        for (int dt = 0; dt < 16; ++dt) *(u32x2*)(((bf16_t*)(F.ws + WS_O)) + rowq * D + h * 256 + 16 * dt + 4 * fq) = pack4(Oa[dt] * inv);
#undef ATT_GLOAD
#undef ATT_LSTORE
    }
#undef FA_SLOAD
    *(LAS f32x4*)(red + w * 512 + 4 * lane) = a0; *(LAS f32x4*)(red + w * 512 + 256 + 4 * lane) = a1;
    __syncthreads();
    {
        float o = 0.f;
#pragma unroll
        for (int ww = 0; ww < 8; ++ww) o += red[ww * 512 + tid];
        ((bf16_t*)(F.ws + WS_SO))[(size_t)sb * D + hp * 512 + tid] = (bf16_t)(cvt_pk_bf16(o, 0.f) & 0xffffu);
    }
    __syncthreads();
}
__device__ __forceinline__ void final_norm(Frame& F0) {
    Frame F = launder(F0);
    const int gw = F.bx * NWAVES + F.wave, NGW = F.G * NWAVES, lane = F.lane;
    f32x4 g[4];
#pragma unroll
    for (int jj = 0; jj < 4; ++jj) g[jj] = ((const f32x4*)FIN(24) + lane)[64 * jj];
    for (int m = gw; m < MP + MS; m += NGW) {
        f32x4 v[4]; float s = 0.f;
        if (m < MP) {
            const u32x2* src = (const u32x2*)(((bf16_t*)(F.ws + WS_XB)) + (size_t)m * D) + lane;
#pragma unroll
            for (int jj = 0; jj < 4; ++jj) v[jj] = unpack4(src[64 * jj]);
        } else {
            const f32x4* src = (const f32x4*)(((float*)(F.ws + WS_XS)) + (size_t)(m - MP) * D) + lane;
#pragma unroll
            for (int jj = 0; jj < 4; ++jj) v[jj] = src[64 * jj];
        }
#pragma unroll
        for (int jj = 0; jj < 4; ++jj) s += dot4(v[jj], v[jj]);
        float* dst = m < MP ? F.out + O_Y + (size_t)m * D : F.out + O_YS + (size_t)(m - MP) * D;
        const float rs = rsqrtf(wave_sum(s) * (1.0f / D) + EPS);
#pragma unroll
        for (int jj = 0; jj < 4; ++jj) ((f32x4*)dst + lane)[64 * jj] = v[jj] * rs * g[jj];
    }
}

struct Args { const float* in[25]; float* out; unsigned char* ws; int ph_lo, ph_hi; };
#define REP(bit) for (int rep_ = 0; rep_ < 1 + ((REP_MASK >> (bit)) & 1); ++rep_)
#ifndef MK_SPLIT
#define MK_SPLIT 0
#endif
__global__ void __launch_bounds__(NWAVES * 64, 2) fwd(Args args) {
    extern __shared__ __attribute__((aligned(16))) unsigned char lds_raw[];
    Frame F0;
    F0.lds = (LAS unsigned char*)lds_raw;
    F0.tid = threadIdx.x; F0.lane = F0.tid & 63; F0.wave = __builtin_amdgcn_readfirstlane(F0.tid >> 6); F0.G = gridDim.x; F0.bx = blockIdx.x;
    F0.in = (in_tab_t)__builtin_amdgcn_kernarg_segment_ptr();     F0.out = args.out; F0.ws = args.ws;
    for (int u = F0.tid; u < (LDS_BYTES - LDSCTL_OFF) / 4; u += NWAVES * 64) ((LAS unsigned*)(F0.lds + LDSCTL_OFF))[u] = 0u;
    __syncthreads();
    XcdBarrier bar; bar.bar = (unsigned*)(args.ws + WS_CTL) + CW_BAR; bar.x = 0; bar.st = nullptr;
    if (!MK_SPLIT) bar = xcd_barrier_post((unsigned*)(args.ws + WS_CTL) + CW_BAR, (volatile LAS unsigned*)(F0.lds + MISC_OFF) + 8);
    int ph = 0;
    const int lo = args.ph_lo, hi = args.ph_hi;
#define PH_BEGIN if (ph >= lo && ph < hi) { Frame F = launder(F0);
#define PH_END } { const bool both_ = (ph >= lo && ph + 1 < hi); ++ph; if (!MK_SPLIT && both_) { XcdBarrier b2_ = bar; unsigned long long bp_ = uni64((unsigned long long)bar.bar); unsigned bx_ = __builtin_amdgcn_readfirstlane(bar.x); asm volatile("" : "+s"(bp_), "+s"(bx_)); b2_.bar = (unsigned*)(GAS unsigned*)bp_; b2_.x = bx_; xcd_barrier(b2_); } }

    PH_BEGIN REP(0) { p0_prologue(F0); __syncthreads(); } PH_END
    PH_BEGIN {
        pg8::Gemm g{((bf16_t*)(F.ws + WS_MEMB)), ((bf16_t*)(F.ws + WS_WKV)), MMEM, 8192, D}; pg8::StaticOrder S; S.init(MMEM, 8192, F.G, (int)F.bx);
        EpiMemKV E{((float*)(F.ws + WS_SMALL + 65536)), F.out + O_MEMK, F.out + O_MEMV, ((bf16_t*)(F.ws + WS_KB)), ((bf16_t*)(F.ws + WS_VB))};
        REP(1) pg8::gemm_phase<EpiMemKV, pg8::StaticOrder, true, true>(F.lds, g, S, E);
    } PH_END
#pragma unroll 1
    for (int l = 0; l < DEPTH; ++l) {
        const int j = l >> 1;
        if ((l & 1) == 0) {
            PH_BEGIN {
                pg8::Gemm g{((bf16_t*)(F.ws + WS_XB)), ((bf16_t*)(F.ws + WS_AB1)) + (size_t)j * NAB * D, MP, NAB, D}; pg8::StaticOrder S; S.init(MP, NAB, F.G, (int)F.bx);
                EpiG1Even E{((float*)(F.ws + WS_RSQ)), ((bf16_t*)(F.ws + WS_Z)), ((float*)(F.ws + WS_VSQ)), F.out + O_POOLP + (size_t)j * 8 * 15 * 1024};
                REP(2) pg8::gemm_phase<EpiG1Even, pg8::StaticOrder, true, true>(F.lds, g, S, E);
                SEpiZ SE{((float*)(F.ws + WS_SMALL)), ((float*)(F.ws + WS_SZ)), 8192, 0};
                REP(3) skinny_gemm<SEpiZ>(F, ((bf16_t*)(F.ws + WS_XB)) + (size_t)MP * D, ((bf16_t*)(F.ws + WS_AB1)) + (size_t)j * NAB * D, NAB, D, SE);
            } PH_END
            PH_BEGIN {
                REP(4) for (int un = F.bx; un < 1024; un += F.G) { const int kind = un & 1, g = (un >> 1) & 3, n = un >> 3; if (kind == 0) sgu_unit(F, j, n, g); else pool_unit(F, j, n, g); }
                REP(5) for (int b = F.bx; b < MS; b += F.G) sample_mix_even(F, j, b);
            } PH_END
        } else {
            PH_BEGIN {
                pg8::Gemm g{((bf16_t*)(F.ws + WS_XB)), ((bf16_t*)(F.ws + WS_C1)) + (size_t)j * NC * D, MP, NC, D}; pg8::StaticOrder S; S.init(MP, NC, F.G, (int)F.bx);
                EpiG1Odd E{((float*)(F.ws + WS_RSQ)), ((bf16_t*)(F.ws + WS_A2)), FIN(18) + (size_t)j * 3 * 2048, F.out + O_CONVP + (size_t)j * 8 * 2 * 2048, ((float*)(F.ws + WS_SIDE)), (LAS float*)(F.lds + HALO_OFF)};
                REP(6) pg8::gemm_phase<EpiG1Odd, pg8::StaticOrder, true, true>(F.lds, g, S, E);
                SEpiZ SE{((float*)(F.ws + WS_SMALL)), ((float*)(F.ws + WS_SZ)), 8192, 1};
                REP(3) skinny_gemm<SEpiZ>(F, ((bf16_t*)(F.ws + WS_XB)) + (size_t)MP * D, ((bf16_t*)(F.ws + WS_C1)) + (size_t)j * NC * D, NC, D, SE);
            } PH_END
            PH_BEGIN {
                REP(5) for (int b = F.bx; b < MS; b += F.G) sample_conv_odd(F, j, b);
            } PH_END
        }
        PH_BEGIN {
            const bf16_t* W2 = ((l & 1) ? ((bf16_t*)(F.ws + WS_C2)) : ((bf16_t*)(F.ws + WS_AB2))) + (size_t)j * D * 2048;
            pg8::Gemm g{((bf16_t*)(F.ws + WS_A2)), W2, MP, D, 2048}; pg8::StaticOrder S; S.init(MP, D, F.G, (int)F.bx);
            if (l & 1) { Unit fu; for (int i = 0; S.next(i, fu); ++i) conv_fixup(((float*)(F.ws + WS_SIDE)), FIN(18) + (size_t)j * 3 * 2048, ((bf16_t*)(F.ws + WS_A2)), fu.pm, F.tid); asm volatile("s_waitcnt vmcnt(0)" ::: "memory"); __syncthreads(); }
            EpiRes E{((bf16_t*)(F.ws + WS_XB)), ((float*)(F.ws + WS_RSQ))};
            pg8::gemm_phase<EpiRes, pg8::StaticOrder, true, true>(F.lds, g, S, E);
            SEpiRes SE{((float*)(F.ws + WS_XS)), ((bf16_t*)(F.ws + WS_XB)) + (size_t)MP * D, ((float*)(F.ws + WS_SMALL))};
            skinny_gemm<SEpiRes>(F, ((bf16_t*)(F.ws + WS_SA2)), W2, D, 2048, SE);
        } PH_END
        PH_BEGIN {
            pg8::Gemm g{((bf16_t*)(F.ws + WS_XB)), ((bf16_t*)(F.ws + WS_WQ)) + (size_t)l * D * D, MP, D, D}; pg8::StaticOrder S; S.init(MP, D, F.G, (int)F.bx);
            EpiQ E{((float*)(F.ws + WS_RSQ)), ((bf16_t*)(F.ws + WS_Q))};
            REP(8) pg8::gemm_phase<EpiQ, pg8::StaticOrder, true, true>(F.lds, g, S, E);
            SEpiQ SE{((float*)(F.ws + WS_SMALL)), ((float*)(F.ws + WS_SQ))};
            REP(9) skinny_gemm<SEpiQ>(F, ((bf16_t*)(F.ws + WS_XB)) + (size_t)MP * D, ((bf16_t*)(F.ws + WS_WQ)) + (size_t)l * D * D, D, D, SE);
        } PH_END
        PH_BEGIN {
            if (F.G == 256) { REP(10) attn_fused(F, l); }
            else { attn_prompt(F, l); attn_sample(F, l); }
        } PH_END
        PH_BEGIN {
            pg8::Gemm g{((bf16_t*)(F.ws + WS_O)), ((bf16_t*)(F.ws + WS_WO)) + (size_t)l * D * D, MP, D, D}; pg8::StaticOrder S; S.init(MP, D, F.G, (int)F.bx);
            EpiRes E{((bf16_t*)(F.ws + WS_XB)), ((float*)(F.ws + WS_RSQ))};
            pg8::gemm_phase<EpiRes, pg8::StaticOrder, true, true>(F.lds, g, S, E);
            SEpiRes SE{((float*)(F.ws + WS_XS)), ((bf16_t*)(F.ws + WS_XB)) + (size_t)MP * D, ((float*)(F.ws + WS_SMALL))};
            skinny_gemm<SEpiRes>(F, ((bf16_t*)(F.ws + WS_SO)), ((bf16_t*)(F.ws + WS_WO)) + (size_t)l * D * D, D, D, SE);
        } PH_END
    }
    PH_BEGIN final_norm(F0); PH_END
#undef PH_BEGIN
#undef PH_END
}
constexpr int N_PHASES = 2 + 6 * DEPTH + 1;

extern "C" void kernel_launch(void* const* d_in, const int* in_sizes, int n_in, void* d_out, int out_size, void* d_ws, size_t ws_size, hipStream_t stream) {
    static int grid = 0;
    if (grid == 0) {
        if (n_in != 25 || in_sizes[0] != MP * D || (size_t)out_size != O_END || ws_size < WS_END) { fprintf(stderr, "kernel_launch: unexpected shapes (n_in %d, in0 %d, out %d, ws %zu); nothing launched\n", n_in, n_in > 0 ? in_sizes[0] : -1, out_size, ws_size); grid = -1; return; }
        int dev = 0, cus = 0, per_cu = 0;
        if (hipGetDevice(&dev) != hipSuccess || hipDeviceGetAttribute(&cus, hipDeviceAttributeMultiprocessorCount, dev) != hipSuccess) { fprintf(stderr, "kernel_launch: device query failed\n"); grid = -1; return; }
        if (hipFuncSetAttribute((const void*)fwd, hipFuncAttributeMaxDynamicSharedMemorySize, LDS_BYTES) != hipSuccess) { fprintf(stderr, "kernel_launch: hipFuncSetAttribute failed\n"); grid = -1; return; }
        if (hipOccupancyMaxActiveBlocksPerMultiprocessor(&per_cu, (const void*)fwd, NWAVES * 64, LDS_BYTES) != hipSuccess || per_cu < 1) fprintf(stderr, "kernel_launch: note: occupancy query reports %d workgroups per CU\n", per_cu);
        (void)hipGetLastError();
        grid = cus;
    }
    if (grid < 0) return;
    if (hipMemsetAsync((char*)d_ws + WS_CTL, 0, CTL_ZERO_BYTES, stream) != hipSuccess) { fprintf(stderr, "kernel_launch: memset failed\n"); return; }
    Args a{};
    for (int i = 0; i < 25; ++i) a.in[i] = (const float*)d_in[i];
    a.out = (float*)d_out; a.ws = (unsigned char*)d_ws;
#if MK_SPLIT
    for (int p = 0; p < N_PHASES; ++p) { a.ph_lo = p; a.ph_hi = p + 1; hipLaunchKernelGGL(fwd, dim3(grid), dim3(NWAVES * 64), LDS_BYTES, stream, a); }
#else
    a.ph_lo = 0; a.ph_hi = N_PHASES;
    hipLaunchKernelGGL(fwd, dim3(grid), dim3(NWAVES * 64), LDS_BYTES, stream, a);
#endif
    const hipError_t le = hipPeekAtLastError();
    if (le != hipSuccess) fprintf(stderr, "kernel_launch: launch failed: %s\n", hipGetErrorName(le));
}
```

```cpp
#include <hip/hip_runtime.h>
#include <cstdio>
#include <cstdint>
#ifndef REP_MASK
#define REP_MASK 0
#endif
__device__ __forceinline__ int hw_lane() { int l; asm volatile("v_mbcnt_lo_u32_b32 %0, -1, 0\n\tv_mbcnt_hi_u32_b32 %0, -1, %0" : "=v"(l)); return l; }
namespace pg8 {
#define PG8_LAS __attribute__((address_space(3)))
typedef unsigned short bf16_t;
typedef short bf16x8 __attribute__((ext_vector_type(8)));
typedef float f32x4 __attribute__((ext_vector_type(4)));
typedef unsigned u32x4 __attribute__((ext_vector_type(4)));
constexpr int BM = 256, BK = 64, HALF = 128, HTB = HALF * BK * 2  , STAGE_BYTES = 8 * HTB, NXCD = 8, WGM = 8;

__host__ __device__ __forceinline__ int lds_byte(int r, int c) { const int st = (r >> 4) * 2 + (c >> 5), rr = r & 15, cc = c & 31, ob = rr * 64 + cc * 2; return st * 1024 + (ob ^ (((ob >> 9) & 1) << 5)); }
__host__ __device__ __forceinline__ void stage_rc(int b, int& R, int& C) { const int st = b / 1024, sb = b % 1024, swz = sb ^ (((sb >> 9) & 1) << 5); R = (st >> 1) * 16 + swz / 64; C = (st & 1) * 32 + (swz % 64) / 2; }
__host__ __device__ __forceinline__ int perm32(int rho) { const int n = rho >> 4, i = rho & 15; return 8 * (i >> 2) + 4 * n + (i & 3); }

struct Unit { int pm, pn; };
struct Gemm { const bf16_t* A; const bf16_t* Bt; int M, N, K; };

struct StaticOrder {
    int nM, nN, nwg, G, c;
    __host__ __device__ __forceinline__ void init(int M, int N, int G_, int c_) { nM = M / BM; nN = N / BM; nwg = nM * nN; G = G_; c = c_; }
    __host__ __device__ __forceinline__ bool next(int i, Unit& u) const {
        const long L = (long)i * G + c; if (L >= nwg) return false;
        int wgid = (int)L; { const int q = nwg / NXCD, r = nwg % NXCD, xcd = wgid % NXCD, off = wgid / NXCD; wgid = (xcd < r ? xcd * (q + 1) : r * (q + 1) + (xcd - r) * q) + off; }
        const int nig = WGM * nN, gid = wgid / nig, fm = gid * WGM, gsz = (nM - fm) < WGM ? (nM - fm) : WGM;
        u.pm = fm + ((wgid % nig) % gsz); u.pn = (wgid % nig) / gsz; return true;
    }
    __device__ __forceinline__ void a_ready(const Unit&) const {}
    __device__ __forceinline__ void done(const Unit&) const {}
};

typedef float f32x2cv __attribute__((ext_vector_type(2))); typedef __bf16 bf16x2cv __attribute__((ext_vector_type(2)));
__device__ __forceinline__ unsigned cvt_pk_bf16(float lo, float hi) { const f32x2cv v = {lo, hi}; return __builtin_bit_cast(unsigned, __builtin_convertvector(v, bf16x2cv)); }
template <class Epi, class Sched, bool ALIGN_EPI = false, bool SP2 = false>
__device__ __forceinline__ void gemm_phase(PG8_LAS unsigned char* lds, const Gemm g, const Sched& S, const Epi& E, const int wave_id) {
    int tid_ = (wave_id << 6) | hw_lane(); asm volatile("" : "+v"(tid_));
    const int tid = tid_, wid = __builtin_amdgcn_readfirstlane(tid >> 6), lane = tid & 63, wr = wid >> 2, wc = wid & 3, fr = lane & 15, fq = lane >> 4;
    const int K = g.K, nt = K / BK;
    unsigned voffA[2], voffB[2];
#pragma unroll
    for (int i = 0; i < 2; ++i) { int R, C; stage_rc(tid * 16 + i * 8192, R, C); const int Rb = Epi::PERM ? ((R & ~31) + perm32(R & 31)) : R;
        voffA[i] = (unsigned)(R * K + C) * 2u; voffB[i] = (unsigned)(Rb * K + C) * 2u; }
    const size_t kstep = (size_t)(BK * 2);
    const size_t hstep = (size_t)HALF * K * 2;
    const size_t tstep = 2 * hstep;
    const unsigned ldsw = (unsigned)wid * 1024u;
    const int aoff = lds_byte(wr * 64 + fr, fq * 8), boff = lds_byte(wc * 32 + fr, fq * 8);
#define PG8_SA(b, h) (((b) * 2 + (h)) * HTB)
#define PG8_SB(b, h) ((4 + (b) * 2 + (h)) * HTB)
#define PG8_STAGE(bufoff, gbase, voff) do { _Pragma("unroll") for (int _i = 0; _i < 2; ++_i) \
        __builtin_amdgcn_global_load_lds((const unsigned*)((const char*)(gbase) + (voff)[_i]), (PG8_LAS unsigned*)(lds + (bufoff) + ldsw + _i * 8192), 16, 0, 0); } while (0)
#define PG8_LDA(dst, b, h) do { _Pragma("unroll") for (int m = 0; m < 4; ++m) _Pragma("unroll") for (int k = 0; k < 2; ++k) dst[m][k] = *(const PG8_LAS bf16x8*)(lds + PG8_SA(b, h) + aoff + m * 2048 + k * 1024); } while (0)
#define PG8_LDB(dst, b, h) do { _Pragma("unroll") for (int n = 0; n < 2; ++n) _Pragma("unroll") for (int k = 0; k < 2; ++k) dst[n][k] = *(const PG8_LAS bf16x8*)(lds + PG8_SB(b, h) + boff + n * 2048 + k * 1024); } while (0)
#define PG8_MMA(ai, bj, At, Bt) do { __builtin_amdgcn_s_setprio(1); _Pragma("unroll") for (int m = 0; m < 4; ++m) _Pragma("unroll") for (int n = 0; n < 2; ++n) _Pragma("unroll") for (int k = 0; k < 2; ++k) \
        acc[ai][bj][m][n] = __builtin_amdgcn_mfma_f32_16x16x32_bf16(Bt[n][k], At[m][k], acc[ai][bj][m][n], 0, 0, 0); __builtin_amdgcn_s_setprio(0); } while (0)
#define PG8_WAIT_V(n) asm volatile("s_waitcnt vmcnt(" #n ")" ::: "memory")
#define PG8_WAIT_L(n) asm volatile("s_waitcnt lgkmcnt(" #n ")" ::: "memory")
#define PG8_BAR __builtin_amdgcn_s_barrier()
#define PG8_SCHED __builtin_amdgcn_sched_barrier(0)
    Unit cur, nxt; int ui = 0;
    if (!S.next(0, cur)) return;
    f32x4 acc[2][2][4][2];
#pragma unroll
    for (int a = 0; a < 2; ++a)
#pragma unroll
        for (int b = 0; b < 2; ++b)
#pragma unroll
            for (int m = 0; m < 4; ++m)
#pragma unroll
                for (int n = 0; n < 2; ++n) acc[a][b][m][n] = (f32x4){0.f, 0.f, 0.f, 0.f};
    bf16x8 At[4][2], B0[2][2], B1[2][2];
    const char* cA = (const char*)g.A + (size_t)cur.pm * tstep; const char* cB = (const char*)g.Bt + (size_t)cur.pn * tstep;
    S.a_ready(cur);
    if constexpr (SP2) {
        PG8_STAGE(PG8_SB(0, 0), cB, voffB); PG8_STAGE(PG8_SB(0, 1), cB + hstep, voffB); PG8_STAGE(PG8_SA(0, 0), cA, voffA); PG8_STAGE(PG8_SA(0, 1), cA + hstep, voffA);
        if (wr == 1) PG8_BAR;
        PG8_WAIT_V(2); PG8_BAR;
        PG8_STAGE(PG8_SB(1, 0), cB + kstep, voffB); PG8_STAGE(PG8_SA(1, 0), cA + kstep, voffA); PG8_STAGE(PG8_SB(1, 1), cB + hstep + kstep, voffB);
        PG8_WAIT_V(6); PG8_BAR;
    } else {
        PG8_STAGE(PG8_SB(0, 0), cB, voffB); PG8_STAGE(PG8_SA(0, 0), cA, voffA); PG8_STAGE(PG8_SB(0, 1), cB + hstep, voffB); PG8_STAGE(PG8_SA(0, 1), cA + hstep, voffA);
        if (wr == 1) PG8_BAR;
        PG8_WAIT_V(4); PG8_BAR;
        PG8_STAGE(PG8_SB(1, 0), cB + kstep, voffB); PG8_STAGE(PG8_SA(1, 0), cA + kstep, voffA); PG8_STAGE(PG8_SB(1, 1), cB + hstep + kstep, voffB);
        PG8_WAIT_V(6); PG8_BAR;
    }
    for (;;) {
        const bool has_next = S.next(ui + 1, nxt);
        const char* nA = has_next ? (const char*)g.A + (size_t)nxt.pm * tstep : cA; const char* nB = has_next ? (const char*)g.Bt + (size_t)nxt.pn * tstep : cB;
        for (int t = 0; t < nt; t += 2) {
            const bool last = (t == nt - 2);
            const char* a1 = cA + (size_t)(t + 1) * kstep;
            const char* a2 = last ? nA : cA + (size_t)(t + 2) * kstep; const char* b2 = last ? nB : cB + (size_t)(t + 2) * kstep;
            const char* a3 = a2 + kstep; const char* b3 = b2 + kstep;
            if (last && has_next) S.a_ready(nxt);
            if constexpr (SP2) {
            PG8_LDB(B0, 0, 0); PG8_LDB(B1, 0, 1); PG8_SCHED; PG8_LDA(At, 0, 0); PG8_STAGE(PG8_SA(1, 1), a1 + hstep, voffA);
            PG8_WAIT_V(8); PG8_WAIT_L(0); PG8_BAR; PG8_MMA(0, 0, At, B0); PG8_MMA(0, 1, At, B1); PG8_BAR; PG8_SCHED;
            PG8_LDA(At, 0, 1); PG8_STAGE(PG8_SB(0, 0), b2, voffB); PG8_STAGE(PG8_SB(0, 1), b2 + hstep, voffB); PG8_STAGE(PG8_SA(0, 0), a2, voffA);
            PG8_WAIT_V(8); PG8_WAIT_L(0); PG8_BAR; PG8_MMA(1, 0, At, B0); PG8_MMA(1, 1, At, B1); PG8_BAR; PG8_SCHED;
            PG8_LDB(B0, 1, 0); PG8_LDB(B1, 1, 1); PG8_SCHED; PG8_LDA(At, 1, 0); PG8_STAGE(PG8_SA(0, 1), a2 + hstep, voffA);
            PG8_WAIT_V(8); PG8_WAIT_L(0); PG8_BAR; PG8_MMA(0, 0, At, B0); PG8_MMA(0, 1, At, B1); PG8_BAR; PG8_SCHED;
            PG8_LDA(At, 1, 1); PG8_STAGE(PG8_SB(1, 0), b3, voffB); PG8_STAGE(PG8_SB(1, 1), b3 + hstep, voffB); PG8_STAGE(PG8_SA(1, 0), a3, voffA);
            PG8_WAIT_V(8); PG8_WAIT_L(0); PG8_BAR; PG8_MMA(1, 0, At, B0); PG8_MMA(1, 1, At, B1); PG8_BAR; PG8_SCHED;
            } else {
            PG8_LDB(B0, 0, 0); PG8_SCHED; PG8_LDA(At, 0, 0); PG8_STAGE(PG8_SA(1, 1), a1 + hstep, voffA);
            PG8_WAIT_L(8); PG8_BAR; PG8_WAIT_L(0); PG8_MMA(0, 0, At, B0); PG8_BAR; PG8_SCHED;
            PG8_LDB(B1, 0, 1); PG8_STAGE(PG8_SB(0, 0), b2, voffB);
            PG8_BAR; PG8_WAIT_L(0); PG8_MMA(0, 1, At, B1); PG8_BAR;
            PG8_LDA(At, 0, 1); PG8_STAGE(PG8_SA(0, 0), a2, voffA);
            PG8_BAR; PG8_WAIT_L(0); PG8_MMA(1, 0, At, B0); PG8_BAR; PG8_SCHED;
            PG8_STAGE(PG8_SB(0, 1), b2 + hstep, voffB);
            PG8_WAIT_V(6); PG8_BAR; PG8_MMA(1, 1, At, B1); PG8_BAR;
            PG8_LDB(B0, 1, 0); PG8_SCHED; PG8_LDA(At, 1, 0); PG8_STAGE(PG8_SA(0, 1), a2 + hstep, voffA);
            PG8_WAIT_L(8); PG8_BAR; PG8_WAIT_L(0); PG8_MMA(0, 0, At, B0); PG8_BAR; PG8_SCHED;
            PG8_LDB(B1, 1, 1); PG8_STAGE(PG8_SB(1, 0), b3, voffB);
            PG8_BAR; PG8_WAIT_L(0); PG8_MMA(0, 1, At, B1); PG8_BAR;
            PG8_LDA(At, 1, 1); PG8_STAGE(PG8_SA(1, 0), a3, voffA);
            PG8_BAR; PG8_WAIT_L(0); PG8_MMA(1, 0, At, B0); PG8_BAR; PG8_SCHED;
            PG8_STAGE(PG8_SB(1, 1), b3 + hstep, voffB);
            PG8_WAIT_V(6); PG8_BAR; PG8_MMA(1, 1, At, B1); PG8_BAR;
            }
        }
        if constexpr (ALIGN_EPI) { if (wr == 0) PG8_BAR; }
        if constexpr (!Epi::AFTER_DRAIN) { for (int rep_ = 0; rep_ < 1 + (Epi::REP_EPI ? 1 : 0); ++rep_) E(acc, cur, wr, wc, fr, fq); S.done(cur); }
        if (!has_next) break;
#pragma unroll
        for (int a = 0; a < 2; ++a)
#pragma unroll
            for (int b = 0; b < 2; ++b)
#pragma unroll
                for (int m = 0; m < 4; ++m)
#pragma unroll
                    for (int n = 0; n < 2; ++n) acc[a][b][m][n] = (f32x4){0.f, 0.f, 0.f, 0.f};
        cur = nxt; cA = nA; cB = nB; ++ui;
        if constexpr (ALIGN_EPI) { if (wr == 1) PG8_BAR; }
    }
    PG8_WAIT_V(0);
    if constexpr (!ALIGN_EPI) { if (wr == 0) PG8_BAR; }
    PG8_BAR;
    if constexpr (Epi::AFTER_DRAIN) { E.fused(acc, cur, wr, wc, fr, fq, lds, wid, lane); S.done(cur); }
#undef PG8_SA
#undef PG8_SB
#undef PG8_STAGE
#undef PG8_LDA
#undef PG8_LDB
#undef PG8_MMA
#undef PG8_WAIT_V
#undef PG8_WAIT_L
#undef PG8_BAR
#undef PG8_SCHED
}
}

using pg8::bf16_t; using pg8::bf16x8; using pg8::f32x4; using pg8::u32x4; using pg8::Unit; using pg8::cvt_pk_bf16;
#define GAS __attribute__((address_space(1)))
#define LAS __attribute__((address_space(3)))
typedef unsigned u32x2 __attribute__((ext_vector_type(2)));
typedef short s16x4 __attribute__((ext_vector_type(4)));
typedef GAS unsigned gu32;
#define RLX_AGENT __ATOMIC_RELAXED, __HIP_MEMORY_SCOPE_AGENT

constexpr int NWAVES = 8;
constexpr int D = 1024, MP = 16384, MS = 128, SEQ = 2048, NBATCH = 8, NMEM = 256, MMEM = 2048, DEPTH = 4;
constexpr int NAB = 5120, NC = 8192;
constexpr float EPS = 1e-6f;
constexpr float QSCALE = 0.0625f * 1.4426950408889634f;

constexpr size_t O_Y = 0, O_YS = O_Y + (size_t)MP * D, O_POOLP = O_YS + (size_t)MS * D, O_POOLS = O_POOLP + 2 * 8 * 15 * 1024,
                 O_CONVP = O_POOLS + (size_t)2 * 128 * 15 * 1024, O_CONVS = O_CONVP + 2 * 8 * 2 * 2048, O_SGUV = O_CONVS + (size_t)2 * 128 * 2 * 2048,
                 O_MEMK = O_SGUV + 2 * 128 * 1024, O_MEMV = O_MEMK + (size_t)4 * MMEM * D, O_END = O_MEMV + (size_t)4 * MMEM * D;
static_assert(O_END == 39239680, "output size");

constexpr size_t MiB = 1u << 20;
constexpr size_t WS_CTL = 0, CTL_ZERO_BYTES = 1 * MiB;
constexpr size_t WS_AB1 = 2 * MiB, WS_C1 = 22 * MiB, WS_AB2 = 54 * MiB, WS_C2 = 62 * MiB, WS_WQ = 70 * MiB, WS_WKV = 78 * MiB, WS_WO = 94 * MiB, WS_PMT = 102 * MiB;
constexpr size_t WS_XB = 104 * MiB;
constexpr size_t WS_RSQ = 137 * MiB, WS_VSQ = 138 * MiB;
constexpr size_t WS_SMALL = 139 * MiB;
constexpr size_t WS_Z = 140 * MiB;
constexpr size_t WS_A2 = 268 * MiB;
constexpr size_t WS_Q = 332 * MiB, WS_O = 364 * MiB;
constexpr size_t WS_MEMB = 396 * MiB, WS_KB = 400 * MiB, WS_VB = 416 * MiB;
constexpr size_t WS_XS = 432 * MiB, WS_SZ = 433 * MiB, WS_SA2 = 437 * MiB, WS_SQ = 438 * MiB, WS_SO = 439 * MiB, WS_SIDE = 440 * MiB  , WS_END = 444 * MiB;
constexpr int CW_BAR = 4096, CW_RANK = 8192;

constexpr int RING_BYTES = 131072, LDSCTL_OFF = RING_BYTES, MISC_OFF = LDSCTL_OFF + 320, HALO_OFF = RING_BYTES + 1024  , RSTD_OFF = HALO_OFF + 8192  , LDS_BYTES = 147456;

#define LDS_WAIT() asm volatile("s_waitcnt lgkmcnt(0)" ::: "memory")
#define LDS_BARRIER() asm volatile("s_waitcnt lgkmcnt(0)\n\ts_barrier" ::: "memory")

#define XB_TMO      128
#define XB_XCNT(j)  (256  + 64 * (j))
#define XB_XSUB(j)  (1280 + 64 * (j))
#define XB_XGEN(j)  (2304 + 64 * (j))
#define XB_TOP      3328
#define XB_TOPGEN   3392
#define XCD_BAR_WORDS 3456
#define XB_SPIN_CAP (1u << 18)

__device__ __forceinline__ unsigned xb_ld(unsigned* p)              { return __hip_atomic_load(p, __ATOMIC_RELAXED, __HIP_MEMORY_SCOPE_AGENT); }
__device__ __forceinline__ unsigned xb_add(unsigned* p, unsigned v) { return __hip_atomic_fetch_add(p, v, __ATOMIC_RELAXED, __HIP_MEMORY_SCOPE_AGENT); }
__device__ __forceinline__ unsigned xb_xcc_id() { return (unsigned)__builtin_amdgcn_s_getreg((3 << 11) | 20) & 0xFu; }
#define XB_SPIN(cond, bar) do { unsigned _sp = 0; while (cond) { __builtin_amdgcn_s_sleep(1); \
    if ((++_sp & 255u) == 0u) { if (xb_ld(&(bar)[XB_TMO])) break; if (_sp > XB_SPIN_CAP) { atomicAdd(&(bar)[XB_TMO], 1u); break; } } } } while (0)

struct XcdBarrier {
    int wave;
    unsigned* bar; unsigned x;
    volatile LAS unsigned* st;
};

__device__ __forceinline__ XcdBarrier xcd_barrier_post(unsigned* bar, volatile LAS unsigned* st, int wave) {
    XcdBarrier b; b.wave = wave; b.bar = bar; b.x = xb_xcc_id(); b.st = st;
    if (b.wave == 0 && hw_lane() == 0) (void)xb_add(&bar[XB_XCNT(b.x)], 1u);
    return b;
}
__device__ __forceinline__ void xcd_barrier_complete(unsigned* bar, unsigned x, unsigned& nloc, unsigned& nx) {
    const unsigned G = gridDim.x * gridDim.y * gridDim.z;
    unsigned sum, cnt, mine, sp = 0u;
    for (;;) {
        sum = 0u; cnt = 0u; mine = 0u;
#pragma unroll
        for (unsigned j = 0; j < 16; ++j) { const unsigned c = xb_ld(&bar[XB_XCNT(j)]); sum += c; cnt += (c > 0u) ? 1u : 0u; mine = (j == x) ? c : mine; }
        if (sum == G) break;
        __builtin_amdgcn_s_sleep(1);
        if ((++sp & 255u) == 0u) { if (xb_ld(&bar[XB_TMO])) break; if (sp > XB_SPIN_CAP) { atomicAdd(&bar[XB_TMO], 1u); break; } }
    }
    nloc = mine > 0u ? mine : 1u; nx = cnt > 0u ? cnt : 1u;
}

__device__ __forceinline__ void xcd_barrier(const XcdBarrier& b) {
    asm volatile("s_waitcnt vmcnt(0)" ::: "memory");
    __syncthreads();
    if (b.wave == 0 && hw_lane() == 0) {
        unsigned* bar = b.bar;
        __builtin_amdgcn_s_waitcnt(0);
        unsigned nloc = b.st[0], nx = b.st[1];
        if (nloc == 0u) { xcd_barrier_complete(bar, b.x, nloc, nx); b.st[0] = nloc; b.st[1] = nx; }
        const unsigned old = xb_add(&bar[XB_XSUB(b.x)], 1u);
        const unsigned gen = old / nloc;
        if (old + 1u == (gen + 1u) * nloc) {
            __builtin_amdgcn_fence(__ATOMIC_RELEASE, "agent");
            asm volatile("s_waitcnt vmcnt(0)" ::: "memory");
            const unsigned og = xb_add(&bar[XB_TOP], 1u);
            const unsigned tg = og / nx;
            if (og + 1u == (tg + 1u) * nx) xb_add(&bar[XB_TOPGEN], 1u);
            else XB_SPIN(xb_ld(&bar[XB_TOPGEN]) == tg, bar);
            __builtin_amdgcn_fence(__ATOMIC_ACQUIRE, "agent");
            xb_add(&bar[XB_XGEN(b.x)], 1u);
            asm volatile("s_waitcnt vmcnt(0)" ::: "memory");
        } else {
            XB_SPIN(xb_ld(&bar[XB_XGEN(b.x)]) == gen, bar);
            __builtin_amdgcn_fence(__ATOMIC_ACQUIRE, "agent");
            asm volatile("s_waitcnt vmcnt(0)" ::: "memory");
        }
    }
    __syncthreads();
}

typedef const float* fptr_t;
typedef __attribute__((address_space(4))) const fptr_t* in_tab_t;
struct Frame {
    LAS unsigned char* lds;
    int tid, lane, wave, G, bx, vid;
    in_tab_t in;
    float* out;
    unsigned char* ws;
};
__device__ __forceinline__ unsigned long long uni64(unsigned long long v) { const unsigned lo = __builtin_amdgcn_readfirstlane((unsigned)v), hi = __builtin_amdgcn_readfirstlane((unsigned)(v >> 32)); return ((unsigned long long)hi << 32) | lo; }
__device__ __forceinline__ Frame launder(const Frame& F0) {
    Frame F = F0;
    int wv_ = __builtin_amdgcn_readfirstlane(F0.wave);
    int ln_ = hw_lane();
    int g_ = __builtin_amdgcn_readfirstlane(F0.G), b_ = __builtin_amdgcn_readfirstlane(F0.bx), v_ = __builtin_amdgcn_readfirstlane(F0.vid);
    unsigned long long w_ = uni64((unsigned long long)F0.ws), o_ = uni64((unsigned long long)F0.out), i_ = uni64((unsigned long long)F0.in);
    asm volatile("" : "+v"(ln_), "+s"(wv_), "+s"(g_), "+s"(b_), "+s"(v_), "+s"(w_), "+s"(o_), "+s"(i_));
    F.tid = (wv_ << 6) | ln_; F.G = g_; F.bx = b_; F.vid = v_; F.ws = (unsigned char*)(GAS unsigned char*)w_; F.out = (float*)(GAS float*)o_; F.in = (in_tab_t)i_;
    F.lane = ln_; F.wave = wv_;
    return F;
}
#define FIN(k) ((const float*)(const GAS float*)(F.in[k]))


__device__ __forceinline__ float shx(float v, int mask, int lane) { return __builtin_bit_cast(float, __builtin_amdgcn_ds_bpermute((lane ^ mask) << 2, __builtin_bit_cast(int, v))); }
__device__ __forceinline__ float wave_sum(float v, int lane) {
#pragma unroll
    for (int o = 1; o < 64; o <<= 1) v += shx(v, o, lane);
    return v;
}
__device__ __forceinline__ float silu_f(float x) { return x * __builtin_amdgcn_rcpf(1.f + __builtin_amdgcn_exp2f(-1.4426950408889634f * x)); }
__device__ __forceinline__ f32x4 silu4(f32x4 v) { return (f32x4){silu_f(v[0]), silu_f(v[1]), silu_f(v[2]), silu_f(v[3])}; }
__device__ __forceinline__ float dot4(f32x4 a, f32x4 b) { return (a[0] * b[0] + a[1] * b[1]) + (a[2] * b[2] + a[3] * b[3]); }
__device__ __forceinline__ u32x4 pack8(f32x4 a, f32x4 b) { u32x4 w; w.x = cvt_pk_bf16(a[0], a[1]); w.y = cvt_pk_bf16(a[2], a[3]); w.z = cvt_pk_bf16(b[0], b[1]); w.w = cvt_pk_bf16(b[2], b[3]); return w; }
__device__ __forceinline__ u32x2 pack4(f32x4 a) { u32x2 w; w.x = cvt_pk_bf16(a[0], a[1]); w.y = cvt_pk_bf16(a[2], a[3]); return w; }
__device__ __forceinline__ float bflo(unsigned w) { return __uint_as_float(w << 16); }
__device__ __forceinline__ float bfhi(unsigned w) { return __uint_as_float(w & 0xffff0000u); }
__device__ __forceinline__ void unpack8(u32x4 w, f32x4& a, f32x4& b) { a = (f32x4){bflo(w.x), bfhi(w.x), bflo(w.y), bfhi(w.y)}; b = (f32x4){bflo(w.z), bfhi(w.z), bflo(w.w), bfhi(w.w)}; }
__device__ __forceinline__ f32x4 unpack4(u32x2 w) { return (f32x4){bflo(w.x), bfhi(w.x), bflo(w.y), bfhi(w.y)}; }
__device__ __forceinline__ float rstd16(const float* p) {
    const f32x4 a = ((const f32x4*)p)[0], b = ((const f32x4*)p)[1], c = ((const f32x4*)p)[2], d = ((const f32x4*)p)[3];
    const f32x4 s = (a + b) + (c + d);
    return rsqrtf(((s[0] + s[1]) + (s[2] + s[3])) * (1.0f / D) + EPS);
}
__device__ __forceinline__ float rstd32(const float* p) {
    f32x4 s = ((const f32x4*)p)[0];
#pragma unroll
    for (int i = 1; i < 8; ++i) s += ((const f32x4*)p)[i];
    return rsqrtf(((s[0] + s[1]) + (s[2] + s[3])) * (1.0f / D) + EPS);
}
__host__ __device__ __forceinline__ int src_even(int n) {
    const int tile = n >> 8, o = n & 255;
    if (tile < 8) return n;
    if (tile < 12) return 3072 + (n - 2048);
    const int cb = tile - 12;
    return o < 128 ? 2048 + 128 * cb + o : 4096 + 128 * cb + (o - 128);
}
__host__ __device__ __forceinline__ int src_odd(int n) {
    const int pn = n >> 8, p = n & 255, q = ((p >> 7) << 1) | ((p >> 2) & 1), ch = 64 * pn + 16 * ((p >> 5) & 3) + 4 * ((p >> 3) & 3) + (p & 3);
    const int base = q == 0 ? 2048 : (q == 1 ? 4096 : (q == 2 ? 0 : 6144));
    return base + ch;
}

__device__ __forceinline__ void rstd_table(const float* rsq, int pm, LAS float* tab, int tid) {
    if (tid < 256) tab[tid] = rstd16(rsq + ((size_t)pm * 256 + tid) * 16);
    LDS_BARRIER();
}
struct EpiG1Even {
    static constexpr bool PERM = true, AFTER_DRAIN = false, REP_EPI = (REP_MASK >> 12) & 1;
    const float* rsq; bf16_t* Z; float* vsq; float* pool_out; LAS const float* rtab; int pm0;
    __device__ __forceinline__ void operator()(const f32x4 (&acc)[2][2][4][2], const Unit& u, int wr, int wc, int fr_, int fq_) const {
        int fr = fr_, fq = fq_; asm volatile("" : "+v"(fr), "+v"(fq));
        const int tile = u.pn, cw = wc * 32 + 8 * fq;
#pragma unroll
        for (int ai = 0; ai < 2; ++ai)
#pragma unroll
            for (int m = 0; m < 4; ++m) {
                const int row = u.pm * 256 + ai * 128 + wr * 64 + m * 16 + fr;
                const float rs = u.pm == pm0 ? rtab[ai * 128 + wr * 64 + m * 16 + fr] : rstd16(rsq + (size_t)row * 16);
                if (tile < 12) {
                    const int kind = tile >> 2;
                    bf16_t* dst = Z + (size_t)kind * MP * D + (size_t)row * D + (tile & 3) * 256 + cw;
                    float ss = 0.f;
#pragma unroll
                    for (int bj = 0; bj < 2; ++bj) {
                        f32x4 v0 = acc[ai][bj][m][0] * rs, v1 = acc[ai][bj][m][1] * rs;
                        if (kind == 1) { v0 = silu4(v0); v1 = silu4(v1); }
                        if (kind == 2) ss += dot4(v0, v0) + dot4(v1, v1);
                        *(u32x4*)(dst + bj * 128) = pack8(v0, v1);
                        if (kind == 0 && (row & 2047) >= 2033) {
                            float* po = pool_out + ((size_t)(row >> 11) * 15 + ((row & 2047) - 2033)) * 1024 + (tile & 3) * 256 + bj * 128 + cw;
                            *(f32x4*)po = v0; *(f32x4*)(po + 4) = v1;
                        }
                    }
                    if (kind == 2) { ss += shx(ss, 16, 16 * fq + fr); ss += shx(ss, 32, 16 * fq + fr); if (fq == 0) vsq[(size_t)row * 16 + (tile - 8) * 4 + wc] = ss; }
                } else {
                    const int cb = tile - 12;
                    bf16_t* dst = Z + (size_t)3 * MP * D + (size_t)row * D + cb * 128 + cw;
                    const f32x4 u0 = acc[ai][0][m][0] * rs, u1 = acc[ai][0][m][1] * rs, g0 = acc[ai][1][m][0] * rs, g1 = acc[ai][1][m][1] * rs;
                    *(u32x4*)dst = pack8(u0 * silu4(g0), u1 * silu4(g1));
                }
            }
    }
};
__device__ __forceinline__ float dpp_shr1(float old, float v) { return __builtin_bit_cast(float, __builtin_amdgcn_update_dpp(__builtin_bit_cast(int, old), __builtin_bit_cast(int, v), 0x111, 0xf, 0xf, false)); }
__device__ __forceinline__ float dpp_shr2(float old, float v) { return __builtin_bit_cast(float, __builtin_amdgcn_update_dpp(__builtin_bit_cast(int, old), __builtin_bit_cast(int, v), 0x112, 0xf, 0xf, false)); }
struct EpiG1Odd {
    static constexpr bool PERM = true, AFTER_DRAIN = false, REP_EPI = false;
    const float* rsq; bf16_t* A2; const float* cw; float* conv_out; float* side; LAS float* halo; LAS const float* rtab; int pm0;
    __device__ __forceinline__ void operator()(const f32x4 (&acc)[2][2][4][2], const Unit& u, int wr, int wc, int fr_, int fq_) const {
        int fr = fr_, fq = fq_; asm volatile("" : "+v"(fr), "+v"(fq));
        const int chl = wc * 16 + 4 * fq, ch = u.pn * 64 + chl;
        const f32x4 w0 = *(const f32x4*)(cw + ch), w1 = *(const f32x4*)(cw + 2048 + ch), w2 = *(const f32x4*)(cw + 4096 + ch);
        f32x4 e[2][4]; float rsv[2][4];
#pragma unroll
        for (int ai = 0; ai < 2; ++ai)
#pragma unroll
            for (int m = 0; m < 4; ++m) {
                const int rb = 8 * ai + 4 * wr + m, row = u.pm * 256 + 16 * rb + fr;
                const float rs = u.pm == pm0 ? rtab[16 * rb + fr] : rstd16(rsq + (size_t)row * 16); rsv[ai][m] = rs;
                e[ai][m] = (acc[ai][0][m][0] * rs) * (acc[ai][0][m][1] * rs);
                if (fr >= 14) *(LAS f32x4*)(halo + (rb * 2 + (fr - 14)) * 64 + chl) = e[ai][m];
                if (m & 1) asm volatile("" ::: "memory");
            }
        asm volatile("s_waitcnt lgkmcnt(0)" ::: "memory"); __builtin_amdgcn_s_barrier(); asm volatile("" ::: "memory");
        float* sd = side + (size_t)u.pm * 6 * 2048 + ch;
#pragma unroll
        for (int ai = 0; ai < 2; ++ai)
#pragma unroll
            for (int m = 0; m < 4; ++m) {
                const int rb = 8 * ai + 4 * wr + m, row = u.pm * 256 + 16 * rb + fr;
                const float rs = rsv[ai][m];
                const f32x4 sg = (acc[ai][1][m][0] * rs) * silu4(acc[ai][1][m][1] * rs);
                f32x4 h0 = (f32x4){0.f, 0.f, 0.f, 0.f}, h1 = h0;
                if (rb > 0) { h0 = *(const LAS f32x4*)(halo + ((rb - 1) * 2 + 0) * 64 + chl); h1 = *(const LAS f32x4*)(halo + ((rb - 1) * 2 + 1) * 64 + chl); }
                const f32x4 hx = fr == 0 ? h0 : h1, ev = e[ai][m];
                f32x4 e1, e2;
#pragma unroll
                for (int k = 0; k < 4; ++k) { e1[k] = dpp_shr1(h1[k], ev[k]); e2[k] = dpp_shr2(hx[k], ev[k]); }
                const f32x4 a = sg * (w0 * e2 + w1 * e1 + w2 * ev);
                const bool top = (rb == 0 && fr < 2);
                if (!(top && (u.pm & 7) != 0)) *(u32x2*)(A2 + (size_t)row * 2048 + ch) = pack4(a);
                if (top) { *(f32x4*)(sd + fr * 2048) = ev; *(f32x4*)(sd + (4 + fr) * 2048) = sg; }
                if (rb == 15 && fr >= 14) {
                    *(f32x4*)(sd + (2 + fr - 14) * 2048) = ev;
                    if ((u.pm & 7) == 7) *(f32x4*)(conv_out + ((size_t)(u.pm >> 3) * 2 + (fr - 14)) * 2048 + ch) = ev;
                }
            }
    }
};
__device__ __forceinline__ void conv_fixup(const float* side, const float* cw, bf16_t* A2, int pm, int tid) {
    if ((pm & 7) == 0) return;
    const int ch = 4 * tid;
    const float* sp = side + (size_t)(pm - 1) * 6 * 2048 + ch; const float* sc = side + (size_t)pm * 6 * 2048 + ch;
    const f32x4 em2 = *(const f32x4*)(sp + 2 * 2048), em1 = *(const f32x4*)(sp + 3 * 2048), e0 = *(const f32x4*)sc, e1 = *(const f32x4*)(sc + 2048), s0 = *(const f32x4*)(sc + 4 * 2048), s1 = *(const f32x4*)(sc + 5 * 2048);
    const f32x4 w0 = *(const f32x4*)(cw + ch), w1 = *(const f32x4*)(cw + 2048 + ch), w2 = *(const f32x4*)(cw + 4096 + ch);
    *(u32x2*)(A2 + (size_t)(pm * 256) * 2048 + ch) = pack4(s0 * (w0 * em2 + w1 * em1 + w2 * e0));
    *(u32x2*)(A2 + (size_t)(pm * 256 + 1) * 2048 + ch) = pack4(s1 * (w0 * em1 + w1 * e0 + w2 * e1));
}
struct EpiRes {
    static constexpr bool PERM = true, AFTER_DRAIN = false, REP_EPI = false;
    bf16_t* xb; float* rsq;
    __device__ __forceinline__ void operator()(const f32x4 (&acc)[2][2][4][2], const Unit& u, int wr, int wc, int fr_, int fq_) const {
        int fr = fr_, fq = fq_; asm volatile("" : "+v"(fr), "+v"(fq));
        const int cw = wc * 32 + 8 * fq;
#pragma unroll
        for (int ai = 0; ai < 2; ++ai)
#pragma unroll
            for (int m = 0; m < 4; ++m) {
                const int row = u.pm * 256 + ai * 128 + wr * 64 + m * 16 + fr;
                float ss = 0.f;
#pragma unroll
                for (int bj = 0; bj < 2; ++bj) {
                    bf16_t* p = xb + (size_t)row * D + u.pn * 256 + bj * 128 + cw;
                    f32x4 b0, b1; unpack8(*(const u32x4*)p, b0, b1);
                    const u32x4 wv = pack8(b0 + acc[ai][bj][m][0], b1 + acc[ai][bj][m][1]);
                    *(u32x4*)p = wv;
                    f32x4 r0, r1; unpack8(wv, r0, r1);
                    ss += dot4(r0, r0) + dot4(r1, r1);
                }
                ss += shx(ss, 16, 16 * fq + fr); ss += shx(ss, 32, 16 * fq + fr);
                if (fq == 0) rsq[(size_t)row * 16 + u.pn * 4 + wc] = ss;
            }
    }
};
struct EpiProbe {
    static constexpr bool PERM = true, AFTER_DRAIN = false, REP_EPI = false;
    bf16_t* O; int ldc;
    __device__ __forceinline__ void operator()(const f32x4 (&acc)[2][2][4][2], const Unit& u, int wr, int wc, int fr_, int fq_) const {
        int fr = fr_, fq = fq_; asm volatile("" : "+v"(fr), "+v"(fq));
        const int cw = wc * 32 + 8 * fq;
#pragma unroll
        for (int ai = 0; ai < 2; ++ai)
#pragma unroll
            for (int m = 0; m < 4; ++m) {
                const int row = u.pm * 256 + ai * 128 + wr * 64 + m * 16 + fr;
#pragma unroll
                for (int bj = 0; bj < 2; ++bj) *(u32x4*)(O + (size_t)row * ldc + u.pn * 256 + bj * 128 + cw) = pack8(acc[ai][bj][m][0], acc[ai][bj][m][1]);
            }
    }
};
struct EpiQ {
    static constexpr bool PERM = true, AFTER_DRAIN = false, REP_EPI = false;
    const float* rsq; bf16_t* Q; LAS const float* rtab; int pm0;
    __device__ __forceinline__ void operator()(const f32x4 (&acc)[2][2][4][2], const Unit& u, int wr, int wc, int fr_, int fq_) const {
        int fr = fr_, fq = fq_; asm volatile("" : "+v"(fr), "+v"(fq));
        const int cw = wc * 32 + 8 * fq;
#pragma unroll
        for (int ai = 0; ai < 2; ++ai)
#pragma unroll
            for (int m = 0; m < 4; ++m) {
                const int row = u.pm * 256 + ai * 128 + wr * 64 + m * 16 + fr;
                const float rs = u.pm == pm0 ? rtab[ai * 128 + wr * 64 + m * 16 + fr] : rstd16(rsq + (size_t)row * 16);
#pragma unroll
                for (int bj = 0; bj < 2; ++bj) *(u32x4*)(Q + (size_t)row * D + u.pn * 256 + bj * 128 + cw) = pack8(acc[ai][bj][m][0] * rs, acc[ai][bj][m][1] * rs);
            }
    }
};
struct EpiMemKV {
    static constexpr bool PERM = true, AFTER_DRAIN = false, REP_EPI = false;
    const float* rstdm; float* outk; float* outv; bf16_t* kb; bf16_t* vb;
    __device__ __forceinline__ void operator()(const f32x4 (&acc)[2][2][4][2], const Unit& u, int wr, int wc, int fr_, int fq_) const {
        int fr = fr_, fq = fq_; asm volatile("" : "+v"(fr), "+v"(fq));
        const int layer = u.pn >> 3, isv = (u.pn >> 2) & 1, cw = (u.pn & 3) * 256 + wc * 32 + 8 * fq;
        float* of = (isv ? outv : outk) + (size_t)layer * MMEM * D; bf16_t* ob = (isv ? vb : kb) + (size_t)layer * MMEM * D;
#pragma unroll
        for (int ai = 0; ai < 2; ++ai)
#pragma unroll
            for (int m = 0; m < 4; ++m) {
                const int row = u.pm * 256 + ai * 128 + wr * 64 + m * 16 + fr;
                const float rs = rstdm[row];
#pragma unroll
                for (int bj = 0; bj < 2; ++bj) {
                    const size_t off = (size_t)row * D + bj * 128 + cw;
                    const f32x4 v0 = acc[ai][bj][m][0] * rs, v1 = acc[ai][bj][m][1] * rs;
                    *(f32x4*)(of + off) = v0; *(f32x4*)(of + off + 4) = v1;
                    *(u32x4*)(ob + off) = pack8(v0, v1);
                }
            }
    }
};

__device__ __forceinline__ void p0_tr_item(const float* W, int ldw, int k0, int srccol, const float* gk, float sc, bf16_t* WT, int K, int dstn0, LAS float* scr, int lane) {
    float v[32];
    const float* wp = W + (size_t)(k0 + (lane >> 5)) * ldw + srccol;
#pragma unroll
    for (int i = 0; i < 32; ++i) v[i] = wp[(size_t)(2 * i) * ldw];
#pragma unroll
    for (int i = 0; i < 32; ++i) scr[(2 * i + (lane >> 5)) * 33 + (lane & 31)] = v[i];
    LDS_WAIT(); asm volatile("" ::: "memory");
    const int c = lane & 7;
    f32x4 g0 = (f32x4){sc, sc, sc, sc}, g1 = g0;
    if (gk) { g0 = *(const f32x4*)(gk + k0 + 8 * c) * sc; g1 = *(const f32x4*)(gk + k0 + 8 * c + 4) * sc; }
#pragma unroll
    for (int jj = 0; jj < 4; ++jj) {
        const int n = (lane >> 3) + 8 * jj; const LAS float* s = scr + (8 * c) * 33 + n;
        u32x4 o; o.x = cvt_pk_bf16(s[0 * 33] * g0[0], s[1 * 33] * g0[1]); o.y = cvt_pk_bf16(s[2 * 33] * g0[2], s[3 * 33] * g0[3]); o.z = cvt_pk_bf16(s[4 * 33] * g1[0], s[5 * 33] * g1[1]); o.w = cvt_pk_bf16(s[6 * 33] * g1[2], s[7 * 33] * g1[3]);
        *(u32x4*)(WT + (size_t)(dstn0 + n) * K + k0 + 8 * c) = o;
    }
    LDS_WAIT(); asm volatile("" ::: "memory");
}
__device__ __forceinline__ void p0_tr_matrix(const float* W, int ldw, int K, int Nd, const float* gk, float sc, bf16_t* WT, int perm, int r, LAS float* scr, int lane) {
    const int nblk = Nd / 32, kb = r / nblk, nb = r % nblk, dstn0 = 32 * nb, dn = dstn0 + (lane & 31);
    const int srccol = perm == 0 ? dn : (perm == 1 ? src_even(dn) : src_odd(dn));
    p0_tr_item(W, ldw, 64 * kb, srccol, gk, sc, WT, K, dstn0, scr, lane);
}
__device__ __forceinline__ float p0_row(const float* src, bf16_t* dst, float* copy, int lane) {
    const f32x4* xr = (const f32x4*)src + lane;
    f32x4 v[4]; float s = 0.f;
#pragma unroll
    for (int jj = 0; jj < 4; ++jj) { v[jj] = xr[64 * jj]; s += dot4(v[jj], v[jj]); }
    s = wave_sum(s, lane);
    u32x2* o8 = (u32x2*)dst + lane;
#pragma unroll
    for (int jj = 0; jj < 4; ++jj) o8[64 * jj] = pack4(v[jj]);
    if (copy) {
#pragma unroll
        for (int jj = 0; jj < 4; ++jj) ((f32x4*)copy + lane)[64 * jj] = v[jj];
    }
    return s;
}
__device__ __forceinline__ void p0_prologue(Frame& F0) {
    Frame F = launder(F0);
    LAS float* scr = (LAS float*)(F.lds + F.wave * 16384);
    const int gw = F.bx * NWAVES + F.wave, NGW = F.G * NWAVES, lane = F.lane;
    constexpr int I_AB1 = 16 * (NAB / 32), I_C1 = 16 * (NC / 32), I_2 = 32 * 32, I_SQ = 16 * 32, I_PM = 4 * 8;
    constexpr int NITEMS = 2 * I_AB1 + 2 * I_C1 + 4 * I_2 + 16 * I_SQ + 8 * I_PM;
    for (int it = gw; it < NITEMS; it += NGW) {
        int r = it;
        if (r < 2 * I_AB1) { const int jj = r / I_AB1; p0_tr_matrix(FIN(10) + (size_t)jj * D * NAB, NAB, D, NAB, FIN(7) + 2 * jj * D, 1.f, ((bf16_t*)(F.ws + WS_AB1)) + (size_t)jj * NAB * D, 1, r % I_AB1, scr, lane); continue; } r -= 2 * I_AB1;
        if (r < 2 * I_C1) { const int jj = r / I_C1; p0_tr_matrix(FIN(17) + (size_t)jj * D * NC, NC, D, NC, FIN(7) + (2 * jj + 1) * D, 1.f, ((bf16_t*)(F.ws + WS_C1)) + (size_t)jj * NC * D, 2, r % I_C1, scr, lane); continue; } r -= 2 * I_C1;
        if (r < 2 * I_2) { const int jj = r / I_2; p0_tr_matrix(FIN(16) + (size_t)jj * 2048 * D, D, 2048, D, nullptr, 1.f, ((bf16_t*)(F.ws + WS_AB2)) + (size_t)jj * D * 2048, 0, r % I_2, scr, lane); continue; } r -= 2 * I_2;
        if (r < 2 * I_2) { const int jj = r / I_2; p0_tr_matrix(FIN(19) + (size_t)jj * 2048 * D, D, 2048, D, nullptr, 1.f, ((bf16_t*)(F.ws + WS_C2)) + (size_t)jj * D * 2048, 0, r % I_2, scr, lane); continue; } r -= 2 * I_2;
        if (r < 4 * I_SQ) { const int l = r / I_SQ; p0_tr_matrix(FIN(20) + (size_t)l * D * D, D, D, D, FIN(8) + l * D, QSCALE, ((bf16_t*)(F.ws + WS_WQ)) + (size_t)l * D * D, 0, r % I_SQ, scr, lane); continue; } r -= 4 * I_SQ;
        if (r < 4 * I_SQ) { const int l = r / I_SQ; p0_tr_matrix(FIN(21) + (size_t)l * D * D, D, D, D, FIN(9) + l * D, 1.f, ((bf16_t*)(F.ws + WS_WKV)) + (size_t)(2 * l) * D * D, 0, r % I_SQ, scr, lane); continue; } r -= 4 * I_SQ;
        if (r < 4 * I_SQ) { const int l = r / I_SQ; p0_tr_matrix(FIN(22) + (size_t)l * D * D, D, D, D, FIN(9) + l * D, 1.f, ((bf16_t*)(F.ws + WS_WKV)) + (size_t)(2 * l + 1) * D * D, 0, r % I_SQ, scr, lane); continue; } r -= 4 * I_SQ;
        if (r < 4 * I_SQ) { const int l = r / I_SQ; p0_tr_matrix(FIN(23) + (size_t)l * D * D, D, D, D, nullptr, 1.f, ((bf16_t*)(F.ws + WS_WO)) + (size_t)l * D * D, 0, r % I_SQ, scr, lane); continue; } r -= 4 * I_SQ;
        { const int jg = r / I_PM; p0_tr_matrix(FIN(11) + (size_t)jg * 65536, 256, 256, 256, nullptr, 1.f, ((bf16_t*)(F.ws + WS_PMT)) + (size_t)jg * 65536, 0, r % I_PM, scr, lane); }
    }
    for (int m = gw; m < MP + MS + MMEM; m += NGW) {
        if (m < MP) {
            const float s = p0_row(FIN(0) + (size_t)m * D, ((bf16_t*)(F.ws + WS_XB)) + (size_t)m * D, nullptr, lane);
            if (lane < 16) ((float*)(F.ws + WS_RSQ))[(size_t)m * 16 + lane] = lane == 0 ? s : 0.f;
        } else if (m < MP + MS) {
            const int b = m - MP;
            const float s = p0_row(FIN(1) + (size_t)b * D, ((bf16_t*)(F.ws + WS_XB)) + (size_t)m * D, ((float*)(F.ws + WS_XS)) + (size_t)b * D, lane);
            if (lane < 32) ((float*)(F.ws + WS_SMALL))[b * 32 + lane] = lane == 0 ? s : 0.f;
        } else {
            const int t = m - MP - MS;
            const float s = p0_row(FIN(2) + (size_t)t * D, ((bf16_t*)(F.ws + WS_MEMB)) + (size_t)t * D, nullptr, lane);
            if (lane == 0) ((float*)(F.ws + WS_SMALL + 65536))[t] = rsqrtf(s * (1.0f / D) + EPS);
        }
    }
}

__device__ __forceinline__ bf16x8 tr_frag(LAS unsigned char* p0, LAS unsigned char* p1) {
    const s16x4 lo = __builtin_amdgcn_ds_read_tr16_b64_v4i16((LAS s16x4*)p0);
    const s16x4 hi = __builtin_amdgcn_ds_read_tr16_b64_v4i16((LAS s16x4*)p1);
    return (bf16x8){lo[0], lo[1], lo[2], lo[3], hi[0], hi[1], hi[2], hi[3]};
}
#define MFMA16(a, b, c) __builtin_amdgcn_mfma_f32_16x16x32_bf16((a), (b), (c), 0, 0, 0)

constexpr int SGU_AS = 0, SGU_VS = 34816, SGU_RV = 34816 + 67584;
__device__ __forceinline__ void sgu_chunk(Frame& F0, int j, int n) {
    Frame F = launder(F0);
    LAS unsigned char* lds = F.lds;
    const int tid = F.tid, lane = F.lane, w = F.wave, fr = lane & 15, fq = lane >> 4, row0 = n * 128;
    LAS float* rvs = (LAS float*)(lds + SGU_RV);
    if (tid < 128) rvs[tid] = rstd16(((float*)(F.ws + WS_VSQ)) + (size_t)(row0 + tid) * 16);
    const bf16_t* ZV = ((bf16_t*)(F.ws + WS_Z)) + (size_t)2 * MP * D + (size_t)row0 * D;
    const bf16_t* ZUG = ((bf16_t*)(F.ws + WS_Z)) + (size_t)3 * MP * D + (size_t)row0 * D;
    bf16_t* A2 = ((bf16_t*)(F.ws + WS_A2)) + (size_t)row0 * 2048 + 1024;
    const unsigned voff = (unsigned)(tid >> 5) * (D * 2) + (unsigned)(tid & 31) * 16u;
    const unsigned woff = (unsigned)(tid >> 4) * 512u + (unsigned)(tid & 15) * 32u;
    const int wt_t = tid >> 4, wt_s0 = (tid & 15) * 8;
    const unsigned aoff = (unsigned)(tid >> 5) * 4096u + (unsigned)(tid & 31) * 16u;
    u32x4 vt[8]; f32x4 wt[8];
#define SGU_LOAD(g_) do { const char* vb_ = (const char*)(ZV + (g_) * 256); const char* wb_ = (const char*)(FIN(13) + (size_t)(j * 4 + (g_)) * 16384); \
        _Pragma("unroll") for (int i_ = 0; i_ < 8; ++i_) vt[i_] = *(const u32x4*)(vb_ + (size_t)(16 * i_) * D * 2 + voff); \
        _Pragma("unroll") for (int i_ = 0; i_ < 4; ++i_) { wt[2 * i_] = *(const f32x4*)(wb_ + (size_t)(32 * i_) * 512 + woff); wt[2 * i_ + 1] = *(const f32x4*)(wb_ + (size_t)(32 * i_) * 512 + woff + 16); } } while (0)
    SGU_LOAD(0);
    LDS_BARRIER();
#pragma unroll 1
    for (int g = 0; g < 4; ++g) {
#pragma unroll
        for (int i = 0; i < 8; ++i) *(LAS u32x4*)(lds + SGU_VS + ((tid >> 5) + 16 * i) * 528 + (tid & 31) * 16) = vt[i];
#pragma unroll
        for (int i = 0; i < 4; ++i) {
            const int t = wt_t + 32 * i; float v[8];
#pragma unroll
            for (int e = 0; e < 4; ++e) { v[e] = (wt_s0 + e <= t) ? wt[2 * i][e] * rvs[wt_s0 + e] : 0.f; v[4 + e] = (wt_s0 + 4 + e <= t) ? wt[2 * i + 1][e] * rvs[wt_s0 + 4 + e] : 0.f; }
            u32x4 o; o.x = cvt_pk_bf16(v[0], v[1]); o.y = cvt_pk_bf16(v[2], v[3]); o.z = cvt_pk_bf16(v[4], v[5]); o.w = cvt_pk_bf16(v[6], v[7]);
            *(LAS u32x4*)(lds + SGU_AS + t * 272 + wt_s0 * 2) = o;
        }
        LDS_BARRIER();
        if (g < 3) SGU_LOAD(g + 1);
        const int cg = g * 256 + 32 * w + 4 * fq;
        const unsigned lo_in = (unsigned)fr * (D * 2) + (unsigned)(32 * w + 4 * fq) * 2u, lo_out = (unsigned)fr * 4096u + (unsigned)(32 * w + 4 * fq) * 2u;
        u32x2 ugr[2][8];
#pragma unroll
        for (int nt = 0; nt < 2; ++nt)
#pragma unroll
            for (int mt = 0; mt < 8; ++mt) ugr[nt][mt] = *(const u32x2*)((const char*)(ZUG + (size_t)(16 * mt) * D + g * 256 + 16 * nt) + lo_in);
        f32x4 acc[8][2];
#pragma unroll
        for (int mt = 0; mt < 8; ++mt) { acc[mt][0] = (f32x4){0.f, 0.f, 0.f, 0.f}; acc[mt][1] = (f32x4){0.f, 0.f, 0.f, 0.f}; }
#pragma unroll
        for (int ks = 0; ks < 4; ++ks) {
            bf16x8 Bf[2];
#pragma unroll
            for (int nt = 0; nt < 2; ++nt) {
                LAS unsigned char* p = lds + SGU_VS + (32 * ks + 8 * fq + (fr >> 2)) * 528 + (32 * w + 16 * nt + 4 * (fr & 3)) * 2;
                Bf[nt] = tr_frag(p, p + 4 * 528);
            }
#pragma unroll
            for (int mt = 0; mt < 8; ++mt) {
                if (32 * ks <= 16 * mt + 15) {
                    const bf16x8 Af = *(LAS bf16x8*)(lds + SGU_AS + (16 * mt + fr) * 272 + (32 * ks + 8 * fq) * 2);
                    acc[mt][0] = MFMA16(Bf[0], Af, acc[mt][0]); acc[mt][1] = MFMA16(Bf[1], Af, acc[mt][1]);
                }
            }
        }
#pragma unroll
        for (int nt = 0; nt < 2; ++nt) {
            const int c = cg + 16 * nt;
            const f32x4 gg = *(const f32x4*)(FIN(15) + j * 1024 + c);
#pragma unroll
            for (int mt = 0; mt < 8; ++mt) {
                const int t = 16 * mt + fr;
                const float bb = FIN(14)[(j * 4 + g) * 128 + t];
                *(u32x2*)((char*)(A2 + (size_t)(16 * mt) * 2048 + g * 256 + 16 * nt) + lo_out) = pack4(unpack4(ugr[nt][mt]) * (acc[mt][nt] * gg + bb));
            }
        }
        LDS_BARRIER();
    }
#undef SGU_LOAD
}
template <int WIN> __device__ __forceinline__ void pool_load(const bf16_t* xau  , unsigned lo  , int pos0, u32x4 (&xr)[WIN + 7]) {
#pragma unroll
    for (int i = 0; i < WIN + 7; ++i) { const int rr = i - (WIN - 1); xr[i] = (u32x4){0u, 0u, 0u, 0u}; if (pos0 + rr >= 0) xr[i] = *(const u32x4*)((const char*)(xau + (ptrdiff_t)rr * D) + lo); }
}
template <int WIN> __device__ __forceinline__ void pool_build(const u32x4 (&xr)[WIN + 7], int pos0, LAS unsigned char* dst  ) {
    f32x4 S0 = (f32x4){0.f, 0.f, 0.f, 0.f}, S1 = S0;
#pragma unroll
    for (int i = 0; i < WIN - 1; ++i) { f32x4 a, b; unpack8(xr[i], a, b); S0 += a; S1 += b; }
#pragma unroll
    for (int r = 0; r < 8; ++r) {
        f32x4 a, b; unpack8(xr[WIN - 1 + r], a, b); S0 += a; S1 += b;
        const int cnt = (pos0 + r + 1) < WIN ? (pos0 + r + 1) : WIN; const float ic = 1.0f / (float)cnt;
        *(LAS u32x4*)(dst + r * 528) = pack8(S0 * ic - a, S1 * ic - b);
        f32x4 c, d; unpack8(xr[r], c, d); S0 -= c; S1 -= d;
    }
}
__device__ __forceinline__ void pool_mma_epi(Frame& F, int j, int g, int row0, const bf16_t* ZSGA, bf16_t* A2, LAS unsigned char* lds, int w, int fr, int fq) {
    const int cg = g * 256 + 32 * w + 4 * fq;
    const unsigned lo_in = (unsigned)fr * (D * 2) + (unsigned)(32 * w + 4 * fq) * 2u, lo_out = (unsigned)fr * 4096u + (unsigned)(32 * w + 4 * fq) * 2u, lo_pm = (unsigned)(32 * w + fr) * 512u + (unsigned)fq * 16u;
    u32x2 sgr[2][8];
#pragma unroll
    for (int nt = 0; nt < 2; ++nt)
#pragma unroll
        for (int mt = 0; mt < 8; ++mt) sgr[nt][mt] = *(const u32x2*)((const char*)(ZSGA + (size_t)(16 * mt) * D + g * 256 + 16 * nt) + lo_in);
    f32x4 acc[8][2];
#pragma unroll
    for (int mt = 0; mt < 8; ++mt) { acc[mt][0] = (f32x4){0.f, 0.f, 0.f, 0.f}; acc[mt][1] = (f32x4){0.f, 0.f, 0.f, 0.f}; }
    const bf16_t* pm = ((bf16_t*)(F.ws + WS_PMT)) + (size_t)(j * 4 + g) * 65536;
#pragma unroll
    for (int ks = 0; ks < 8; ++ks) {
        const bf16x8 B0 = *(const bf16x8*)((const char*)(pm + 32 * ks) + lo_pm), B1 = *(const bf16x8*)((const char*)(pm + 16 * 256 + 32 * ks) + lo_pm);
#pragma unroll
        for (int mt = 0; mt < 8; ++mt) {
            const bf16x8 Af = *(LAS bf16x8*)(lds + (16 * mt + fr) * 528 + (32 * ks + 8 * fq) * 2);
            acc[mt][0] = MFMA16(B0, Af, acc[mt][0]); acc[mt][1] = MFMA16(B1, Af, acc[mt][1]);
        }
    }
#pragma unroll
    for (int nt = 0; nt < 2; ++nt) {
        const int c = cg + 16 * nt;
        const f32x4 ps = *(const f32x4*)(FIN(12) + j * 1024 + c);
#pragma unroll
        for (int mt = 0; mt < 8; ++mt) *(u32x2*)((char*)(A2 + (size_t)(16 * mt) * 2048 + g * 256 + 16 * nt) + lo_out) = pack4(acc[mt][nt] * ps * unpack4(sgr[nt][mt]));
    }
}
__device__ __forceinline__ void pool_chunk(Frame& F0, int j, int n) {
    Frame F = launder(F0);
    LAS unsigned char* lds = F.lds;
    const int tid = F.tid, lane = F.lane, w = F.wave, fr = lane & 15, fq = lane >> 4, row0 = n * 128;
    const int cb = tid & 31, t0 = (tid >> 5) * 8, pos0 = (row0 & 2047) + t0;
    const bf16_t* xa = ((bf16_t*)(F.ws + WS_Z)) + (size_t)row0 * D; const unsigned xlo = (unsigned)(t0 * D + cb * 8) * 2u;
    const bf16_t* ZSGA = ((bf16_t*)(F.ws + WS_Z)) + (size_t)1 * MP * D + (size_t)row0 * D;
    bf16_t* A2 = ((bf16_t*)(F.ws + WS_A2)) + (size_t)row0 * 2048;
    LAS unsigned char* dst = lds + t0 * 528 + cb * 16;
    u32x4 x0[2 + 7]; pool_load<2>(xa, xlo, pos0, x0);
    pool_build<2>(x0, pos0, dst); LDS_BARRIER();
    u32x4 x1[4 + 7]; pool_load<4>(xa + 256, xlo, pos0, x1);
    pool_mma_epi(F, j, 0, row0, ZSGA, A2, lds, w, fr, fq); LDS_BARRIER();
    pool_build<4>(x1, pos0, dst); LDS_BARRIER();
    u32x4 x2[8 + 7]; pool_load<8>(xa + 512, xlo, pos0, x2);
    pool_mma_epi(F, j, 1, row0, ZSGA, A2, lds, w, fr, fq); LDS_BARRIER();
    pool_build<8>(x2, pos0, dst); LDS_BARRIER();
    pool_mma_epi(F, j, 2, row0, ZSGA, A2, lds, w, fr, fq); LDS_BARRIER();
    u32x4 x3[16 + 7]; pool_load<16>(xa + 768, xlo, pos0, x3);
    pool_build<16>(x3, pos0, dst); LDS_BARRIER();
    pool_mma_epi(F, j, 3, row0, ZSGA, A2, lds, w, fr, fq); LDS_BARRIER();
}
constexpr int ATT_SLOT = 64 * 528;
__device__ __forceinline__ void attn_prompt(Frame& F0, int layer) {
    Frame F = launder(F0);
    LAS unsigned char* lds = F.lds;
    const int tid = F.tid, lane = F.lane, w = F.wave, fr = lane & 15, fq = lane >> 4;
    const bf16_t* Kl = ((bf16_t*)(F.ws + WS_KB)) + (size_t)layer * MMEM * D; const bf16_t* Vl = ((bf16_t*)(F.ws + WS_VB)) + (size_t)layer * MMEM * D;
    for (int unit = F.bx; unit < 512; unit += F.G) {
        const int bh = unit >> 4, b = bh >> 2, h = bh & 3, qb = unit & 15;
        const size_t rowq = (size_t)b * SEQ + qb * 128 + 16 * w + fr;
        bf16x8 Qf[8];
#pragma unroll
        for (int ks = 0; ks < 8; ++ks) Qf[ks] = *(const bf16x8*)(((bf16_t*)(F.ws + WS_Q)) + rowq * D + h * 256 + 32 * ks + 8 * fq);
        const bf16_t* kbase = Kl + (size_t)(b * 256) * D + h * 256; const bf16_t* vbase = Vl + (size_t)(b * 256) * D + h * 256;
        u32x4 st[4];
#define ATT_GLOAD(c) do { const bf16_t* src_ = ((c) < 4 ? kbase : vbase) + (size_t)(64 * ((c) & 3)) * D; _Pragma("unroll") for (int i_ = 0; i_ < 4; ++i_) { const int idx_ = tid + 512 * i_; st[i_] = *(const u32x4*)(src_ + (size_t)(idx_ >> 5) * D + (idx_ & 31) * 8); } } while (0)
#define ATT_LSTORE(slot) do { _Pragma("unroll") for (int i_ = 0; i_ < 4; ++i_) { const int idx_ = tid + 512 * i_; *(LAS u32x4*)(lds + (slot) * ATT_SLOT + (idx_ >> 5) * 528 + (idx_ & 31) * 16) = st[i_]; } } while (0)
        f32x4 S[16], Oa[16]; bf16x8 Pf[8]; float inv = 0.f;
#pragma unroll
        for (int i = 0; i < 16; ++i) { S[i] = (f32x4){0.f, 0.f, 0.f, 0.f}; Oa[i] = (f32x4){0.f, 0.f, 0.f, 0.f}; }
        ATT_GLOAD(0); ATT_LSTORE(0); __syncthreads();
#pragma unroll
        for (int c = 0; c < 8; ++c) {
            if (c < 7) ATT_GLOAD(c + 1);
            LAS unsigned char* slot = lds + (c & 1) * ATT_SLOT;
            if (c < 4) {
#pragma unroll
                for (int ml = 0; ml < 4; ++ml)
#pragma unroll
                    for (int ks = 0; ks < 8; ++ks) {
                        const bf16x8 Kf = *(LAS bf16x8*)(slot + (16 * ml + fr) * 528 + (32 * ks + 8 * fq) * 2);
                        S[4 * c + ml] = MFMA16(Kf, Qf[ks], S[4 * c + ml]);
                    }
                if (c == 3) {
                    float mx = S[0][0];
#pragma unroll
                    for (int i = 0; i < 16; ++i) { mx = fmaxf(mx, fmaxf(fmaxf(S[i][0], S[i][1]), fmaxf(S[i][2], S[i][3]))); }
                    mx = fmaxf(mx, shx(mx, 16, lane)); mx = fmaxf(mx, shx(mx, 32, lane));
                    float sum = 0.f;
#pragma unroll
                    for (int i = 0; i < 16; ++i) {
#pragma unroll
                        for (int e = 0; e < 4; ++e) { S[i][e] = __builtin_amdgcn_exp2f(S[i][e] - mx); sum += S[i][e]; }
                    }
                    sum += shx(sum, 16, lane); sum += shx(sum, 32, lane);
                    inv = 1.0f / sum;
#pragma unroll
                    for (int a = 0; a < 8; ++a) {
                        u32x4 pw; pw.x = cvt_pk_bf16(S[2 * a][0], S[2 * a][1]); pw.y = cvt_pk_bf16(S[2 * a][2], S[2 * a][3]); pw.z = cvt_pk_bf16(S[2 * a + 1][0], S[2 * a + 1][1]); pw.w = cvt_pk_bf16(S[2 * a + 1][2], S[2 * a + 1][3]);
                        Pf[a] = __builtin_bit_cast(bf16x8, pw);
                    }
                }
            } else {
#pragma unroll
                for (int al = 0; al < 2; ++al)
#pragma unroll
                    for (int dt = 0; dt < 16; ++dt) {
                        LAS unsigned char* p = slot + (32 * al + 4 * fq + (fr >> 2)) * 528 + (16 * dt + 4 * (fr & 3)) * 2;
                        const bf16x8 Vf = tr_frag(p, p + 16 * 528);
                        Oa[dt] = MFMA16(Vf, Pf[2 * (c - 4) + al], Oa[dt]);
                    }
            }
            if (c < 7) ATT_LSTORE((c + 1) & 1);
            __syncthreads();
        }
#pragma unroll
        for (int dt = 0; dt < 16; ++dt) *(u32x2*)(((bf16_t*)(F.ws + WS_O)) + rowq * D + h * 256 + 16 * dt + 4 * fq) = pack4(Oa[dt] * inv);
#undef ATT_GLOAD
#undef ATT_LSTORE
    }
}

template <class Epi>
__device__ __forceinline__ void skinny_gemm(Frame& F0, const bf16_t* A, const bf16_t* Bt, int N, int K, const Epi& E) {
    Frame F = launder(F0);
    LAS unsigned char* lds = F.lds;
    const int tid = F.tid, lane = F.lane, w = F.wave, fr = lane & 15, fq = lane >> 4;
    const int nstrips = N / 32, kslice = K / 8, nks = kslice / 32;
    for (int strip = F.bx; strip < nstrips; strip += F.G) {
        f32x4 acc[8][2];
#pragma unroll
        for (int mt = 0; mt < 8; ++mt) { acc[mt][0] = (f32x4){0.f, 0.f, 0.f, 0.f}; acc[mt][1] = (f32x4){0.f, 0.f, 0.f, 0.f}; }
        const bf16_t* ap = A + (size_t)fr * K + w * kslice + 8 * fq; const bf16_t* bp = Bt + (size_t)(strip * 32 + fr) * K + w * kslice + 8 * fq;
#pragma unroll 2
        for (int ks = 0; ks < nks; ++ks) {
            const bf16x8 B0 = *(const bf16x8*)(bp + 32 * ks), B1 = *(const bf16x8*)(bp + (size_t)16 * K + 32 * ks);
#pragma unroll
            for (int mt = 0; mt < 8; ++mt) {
                const bf16x8 Af = *(const bf16x8*)(ap + (size_t)(16 * mt) * K + 32 * ks);
                acc[mt][0] = MFMA16(B0, Af, acc[mt][0]); acc[mt][1] = MFMA16(B1, Af, acc[mt][1]);
            }
        }
#pragma unroll
        for (int mt = 0; mt < 8; ++mt)
#pragma unroll
            for (int nt = 0; nt < 2; ++nt) *(LAS f32x4*)(lds + ((size_t)((w * 128 + 16 * mt + fr) * 32 + 16 * nt + 4 * fq)) * 4) = acc[mt][nt];
        __syncthreads();
        const int row = tid >> 2, cq = tid & 3;
        f32x4 s0 = (f32x4){0.f, 0.f, 0.f, 0.f}, s1 = s0;
#pragma unroll
        for (int ww = 0; ww < 8; ++ww) { const LAS f32x4* p = (const LAS f32x4*)(lds + ((size_t)((ww * 128 + row) * 32 + 8 * cq)) * 4); s0 += p[0]; s1 += p[1]; }
        E(row, strip, strip * 32 + 8 * cq, s0, s1);
        __syncthreads();
    }
}
struct SEpiZ {
    const float* rsqs; float* SZ; int ldz, mode;
    __device__ __forceinline__ void operator()(int row, int strip, int col, f32x4 s0, f32x4 s1) const {
        const float rs = rstd32(rsqs + row * 32); const int oc0 = mode == 0 ? src_even(col) : src_odd(col), oc1 = mode == 0 ? src_even(col + 4) : src_odd(col + 4);
        float* p = SZ + (size_t)row * ldz; *(f32x4*)(p + oc0) = s0 * rs; *(f32x4*)(p + oc1) = s1 * rs;
    }
};
struct SEpiRes {
    float* xs; bf16_t* xb; float* rsqs;
    __device__ __forceinline__ void operator()(int row, int strip, int col, f32x4 s0, f32x4 s1) const {
        float* p = xs + (size_t)row * D + col; const f32x4 o0 = *(const f32x4*)p + s0, o1 = *(const f32x4*)(p + 4) + s1;
        *(f32x4*)p = o0; *(f32x4*)(p + 4) = o1; *(u32x4*)(xb + (size_t)row * D + col) = pack8(o0, o1);
        const int ln = ((row & 15) << 2) | ((col >> 3) & 3);
        float ss = dot4(o0, o0) + dot4(o1, o1); ss += shx(ss, 1, ln); ss += shx(ss, 2, ln);
        if ((col & 31) == 0) rsqs[row * 32 + strip] = ss;
    }
};
struct SEpiQ {
    const float* rsqs; float* SQ;
    __device__ __forceinline__ void operator()(int row, int strip, int col, f32x4 s0, f32x4 s1) const {
        const float rs = rstd32(rsqs + row * 32); float* p = SQ + (size_t)row * D + col; *(f32x4*)p = s0 * rs; *(f32x4*)(p + 4) = s1 * rs;
    }
};
__device__ __forceinline__ void sample_mix_even(Frame& F0, int j, int b) {
    Frame F = launder(F0);
    LAS float* pl = (LAS float*)F.lds; LAS float* red = pl + 1024;
    const int tid = F.tid, lane = F.lane, w = F.wave;
    const float* z = ((float*)(F.ws + WS_SZ)) + (size_t)b * 8192;
    float vv[2], ss = 0.f;
#pragma unroll
    for (int k = 0; k < 2; ++k) { vv[k] = z[3072 + tid + 512 * k]; ss += vv[k] * vv[k]; }
    ss = wave_sum(ss, lane); if (lane == 0) red[w] = ss;
#pragma unroll
    for (int k = 0; k < 2; ++k) {
        const int c = tid + 512 * k, g = c >> 8, win = 2 << g; const float xa = z[c];
        const float* st = FIN(3) + ((size_t)(j * 128 + b) * 15) * 1024 + c;
        float s = xa; for (int r = 16 - win; r < 15; ++r) s += st[(size_t)r * 1024];
        pl[c] = s / (float)win - xa;
        float* po = F.out + O_POOLS + ((size_t)(j * 128 + b) * 15) * 1024 + c;
        for (int r = 0; r < 14; ++r) po[(size_t)r * 1024] = st[(size_t)(r + 1) * 1024];
        po[(size_t)14 * 1024] = xa;
    }
    __syncthreads();
    float tot = 0.f;
#pragma unroll
    for (int i = 0; i < 8; ++i) tot += red[i];
    const float rv = rsqrtf(tot * (1.0f / D) + EPS);
#pragma unroll
    for (int k = 0; k < 2; ++k) {
        const int d = tid + 512 * k, g = d >> 8, dd = d & 255;
        const float* pm = FIN(11) + (size_t)(j * 4 + g) * 65536 + dd; const LAS float* pg = pl + g * 256;
        float a = 0.f;
#pragma unroll 8
        for (int c = 0; c < 256; ++c) a += pg[c] * pm[(size_t)c * 256];
        const float ya = a * FIN(12)[j * 1024 + d] * silu_f(z[1024 + d]);
        const float vn = vv[k] * rv * FIN(15)[j * 1024 + d];
        F.out[O_SGUV + (size_t)(j * 128 + b) * 1024 + d] = vn;
        const float mixed = FIN(13)[(size_t)(j * 4 + g) * 16384] * vn + FIN(14)[(j * 4 + g) * 128];
        const float yb = z[2048 + d] * mixed * silu_f(z[4096 + d]);
        ((bf16_t*)(F.ws + WS_SA2))[(size_t)b * 2048 + d] = (bf16_t)(cvt_pk_bf16(ya, 0.f) & 0xffffu); ((bf16_t*)(F.ws + WS_SA2))[(size_t)b * 2048 + 1024 + d] = (bf16_t)(cvt_pk_bf16(yb, 0.f) & 0xffffu);
    }
    __syncthreads();
}
__device__ __forceinline__ void sample_conv_odd(Frame& F0, int j, int b) {
    Frame F = launder(F0);
    const int tid = F.tid;
    const float* z = ((float*)(F.ws + WS_SZ)) + (size_t)b * 8192;
    const float* cw = FIN(18) + (size_t)j * 3 * 2048;
#pragma unroll
    for (int k = 0; k < 4; ++k) {
        const int c = tid + 512 * k;
        const float e = z[2048 + c] * z[4096 + c];
        const float s0 = FIN(4)[((size_t)(j * 128 + b) * 2 + 0) * 2048 + c], s1 = FIN(4)[((size_t)(j * 128 + b) * 2 + 1) * 2048 + c];
        const float y = cw[c] * s0 + cw[2048 + c] * s1 + cw[4096 + c] * e;
        ((bf16_t*)(F.ws + WS_SA2))[(size_t)b * 2048 + c] = (bf16_t)(cvt_pk_bf16(z[c] * y * silu_f(z[6144 + c]), 0.f) & 0xffffu);
        float* po = F.out + O_CONVS + ((size_t)(j * 128 + b) * 2) * 2048 + c; po[0] = s1; po[2048] = e;
    }
}
__device__ __forceinline__ void attn_sample(Frame& F0, int layer) {
    Frame F = launder(F0);
    LAS float* sc = (LAS float*)F.lds;
    LAS float* red = sc + 512;
    const int tid = F.tid, lane = F.lane, w = F.wave;
    for (int item = F.bx; item < 256; item += F.G) {
        const int b = item >> 1, hp = item & 1;
        const float* qp = ((float*)(F.ws + WS_SQ)) + (size_t)b * D + hp * 512;
        const f32x4 q0 = *(const f32x4*)(qp + 4 * lane), q1 = *(const f32x4*)(qp + 256 + 4 * lane);
        const float* kp = FIN(5) + ((size_t)(layer * 128 + b) * 256) * 1024 + hp * 512 + 4 * lane;
        const float* vp = FIN(6) + ((size_t)(layer * 128 + b) * 256) * 1024 + hp * 512 + 4 * lane;
#pragma unroll 8
        for (int mi = 0; mi < 32; ++mi) {
            const int m = 32 * w + mi;
            const f32x4 k0 = __builtin_nontemporal_load((const f32x4*)(kp + (size_t)m * 1024)), k1 = __builtin_nontemporal_load((const f32x4*)(kp + (size_t)m * 1024 + 256));
            const float d0 = wave_sum(dot4(k0, q0), lane), d1 = wave_sum(dot4(k1, q1), lane);
            if (lane == 0) { sc[m] = d0; sc[256 + m] = d1; }
        }
        __syncthreads();
        float p0[4], p1[4], mx0 = -INFINITY, mx1 = -INFINITY;
#pragma unroll
        for (int i = 0; i < 4; ++i) { p0[i] = sc[lane + 64 * i]; p1[i] = sc[256 + lane + 64 * i]; mx0 = fmaxf(mx0, p0[i]); mx1 = fmaxf(mx1, p1[i]); }
#pragma unroll
        for (int o = 1; o < 64; o <<= 1) { mx0 = fmaxf(mx0, shx(mx0, o, lane)); mx1 = fmaxf(mx1, shx(mx1, o, lane)); }
        float sm0 = 0.f, sm1 = 0.f;
#pragma unroll
        for (int i = 0; i < 4; ++i) { p0[i] = __builtin_amdgcn_exp2f(p0[i] - mx0); p1[i] = __builtin_amdgcn_exp2f(p1[i] - mx1); sm0 += p0[i]; sm1 += p1[i]; }
        sm0 = wave_sum(sm0, lane); sm1 = wave_sum(sm1, lane);
        const float i0 = 1.0f / sm0, i1 = 1.0f / sm1;
        __syncthreads();
        if (w == 0) {
#pragma unroll
            for (int i = 0; i < 4; ++i) { sc[lane + 64 * i] = p0[i] * i0; sc[256 + lane + 64 * i] = p1[i] * i1; }
        }
        __syncthreads();
        f32x4 a0 = (f32x4){0.f, 0.f, 0.f, 0.f}, a1 = a0;
#pragma unroll 8
        for (int mi = 0; mi < 32; ++mi) {
            const int m = 32 * w + mi;
            const f32x4 v0 = __builtin_nontemporal_load((const f32x4*)(vp + (size_t)m * 1024)), v1 = __builtin_nontemporal_load((const f32x4*)(vp + (size_t)m * 1024 + 256));
            a0 += v0 * sc[m]; a1 += v1 * sc[256 + m];
        }
        *(LAS f32x4*)(red + w * 512 + 4 * lane) = a0; *(LAS f32x4*)(red + w * 512 + 256 + 4 * lane) = a1;
        __syncthreads();
        {
            float o = 0.f;
#pragma unroll
            for (int ww = 0; ww < 8; ++ww) o += red[ww * 512 + tid];
            ((bf16_t*)(F.ws + WS_SO))[(size_t)b * D + hp * 512 + tid] = (bf16_t)(cvt_pk_bf16(o, 0.f) & 0xffffu);
        }
        __syncthreads();
    }
}
#define dpp_mov(v, ctrl, row_mask) __builtin_bit_cast(float, __builtin_amdgcn_update_dpp(0, __builtin_bit_cast(int, (float)(v)), (ctrl), (row_mask), 0xf, false))
__device__ __forceinline__ float wave_sum_dpp(float x) {
    x += dpp_mov(x, 0xB1, 0xf);
    x += dpp_mov(x, 0x4E, 0xf);
    x += dpp_mov(x, 0x141, 0xf);
    x += dpp_mov(x, 0x140, 0xf);
    x += dpp_mov(x, 0x142, 0xa);
    x += dpp_mov(x, 0x143, 0xc);
    return x;
}
constexpr int FA_SC = 69632, FA_RED = 71680;
__device__ __forceinline__ void attn_fused(Frame& F0, int layer) {
    Frame F = launder(F0);
    LAS unsigned char* lds = F.lds;
    const int tid = F.tid, lane = F.lane, w = F.wave, fr = lane & 15, fq = lane >> 4;
    const bf16_t* Kl = ((bf16_t*)(F.ws + WS_KB)) + (size_t)layer * MMEM * D; const bf16_t* Vl = ((bf16_t*)(F.ws + WS_VB)) + (size_t)layer * MMEM * D;
    LAS float* sc = (LAS float*)(lds + FA_SC); LAS float* red = (LAS float*)(lds + FA_RED);
    const int sb = F.bx >> 1, hp = F.bx & 1;
    const float* qp = ((float*)(F.ws + WS_SQ)) + (size_t)sb * D + hp * 512;
    const f32x4 q0 = *(const f32x4*)(qp + 4 * lane), q1 = *(const f32x4*)(qp + 256 + 4 * lane);
    const float* kp = FIN(5) + ((size_t)(layer * 128 + sb) * 256 + 4 * w) * 1024 + hp * 512;
    const float* vp = FIN(6) + ((size_t)(layer * 128 + sb) * 256 + 4 * w) * 1024 + hp * 512;
    const unsigned lo16 = (unsigned)lane * 16u;
    f32x4 sv[8]; f32x4 a0 = (f32x4){0.f, 0.f, 0.f, 0.f}, a1 = a0; float mx0 = 0.f, mx1 = 0.f, iv0 = 0.f, iv1 = 0.f;
#define FA_SLOAD(base, slice) do { unsigned long long pu_ = uni64((unsigned long long)((base) + (size_t)(32 * (slice)) * 1024)); asm volatile("" : "+s"(pu_)); const char* pc_ = (const char*)(const GAS char*)pu_; \
        _Pragma("unroll") for (int r_ = 0; r_ < 4; ++r_) { sv[2 * r_] = __builtin_nontemporal_load((const f32x4*)(pc_ + r_ * 4096 + lo16)); sv[2 * r_ + 1] = __builtin_nontemporal_load((const f32x4*)(pc_ + r_ * 4096 + 1024 + lo16)); } } while (0)
    FA_SLOAD(kp, 0);
#pragma unroll 1
    for (int ui = 0; ui < 2; ++ui) {
        const int unit = F.bx + 256 * ui;
        const int bh = unit >> 4, b = bh >> 2, h = bh & 3, qb = unit & 15;
        const size_t rowq = (size_t)b * SEQ + qb * 128 + 16 * w + fr;
        bf16x8 Qf[8];
#pragma unroll
        for (int ks = 0; ks < 8; ++ks) Qf[ks] = *(const bf16x8*)(((bf16_t*)(F.ws + WS_Q)) + rowq * D + h * 256 + 32 * ks + 8 * fq);
        const bf16_t* kbase = Kl + (size_t)(b * 256) * D + h * 256; const bf16_t* vbase = Vl + (size_t)(b * 256) * D + h * 256;
        u32x4 st[4];
        const unsigned goff = (unsigned)(tid >> 5) * (D * 2) + (unsigned)(tid & 31) * 16u, loff = (unsigned)(tid >> 5) * 528u + (unsigned)(tid & 31) * 16u;
#define ATT_GLOAD(c) do { unsigned long long pu_ = uni64((unsigned long long)(((c) < 4 ? kbase : vbase) + (size_t)(64 * ((c) & 3)) * D)); asm volatile("" : "+s"(pu_)); const char* pc_ = (const char*)(const GAS char*)pu_; \
        _Pragma("unroll") for (int i_ = 0; i_ < 4; ++i_) st[i_] = *(const u32x4*)(pc_ + (size_t)(16 * i_) * D * 2 + goff); } while (0)
#define ATT_LSTORE(slot) do { _Pragma("unroll") for (int i_ = 0; i_ < 4; ++i_) *(LAS u32x4*)(lds + (slot) * ATT_SLOT + 16 * i_ * 528 + loff) = st[i_]; } while (0)
        f32x4 S[16], Oa[16]; bf16x8 Pf[8]; float inv = 0.f;
        const f32x4 zero4 = (f32x4){0.f, 0.f, 0.f, 0.f};
        if (ui == 1) {
            float p0[4], p1[4]; mx0 = -INFINITY; mx1 = -INFINITY;
#pragma unroll
            for (int i = 0; i < 4; ++i) { p0[i] = sc[lane + 64 * i]; p1[i] = sc[256 + lane + 64 * i]; mx0 = fmaxf(mx0, p0[i]); mx1 = fmaxf(mx1, p1[i]); }
#pragma unroll
            for (int o = 1; o < 64; o <<= 1) { mx0 = fmaxf(mx0, shx(mx0, o, lane)); mx1 = fmaxf(mx1, shx(mx1, o, lane)); }
            float sm0 = 0.f, sm1 = 0.f;
#pragma unroll
            for (int i = 0; i < 4; ++i) { sm0 += __builtin_amdgcn_exp2f(p0[i] - mx0); sm1 += __builtin_amdgcn_exp2f(p1[i] - mx1); }
            sm0 = wave_sum(sm0, lane); sm1 = wave_sum(sm1, lane);
            iv0 = 1.0f / sm0; iv1 = 1.0f / sm1;
        }
        ATT_GLOAD(0); ATT_LSTORE(0); __syncthreads();
#pragma unroll
        for (int c = 0; c < 8; ++c) {
            if (c < 7) ATT_GLOAD(c + 1);
            if (ui == 0) {
#pragma unroll
                for (int r = 0; r < 4; ++r) {
                    const int m = 32 * c + 4 * w + r;
                    const float d0 = wave_sum_dpp(dot4(sv[2 * r], q0)), d1 = wave_sum_dpp(dot4(sv[2 * r + 1], q1));
                    if (lane == 63) { sc[m] = d0; sc[256 + m] = d1; }
                }
                if (c < 7) FA_SLOAD(kp, c + 1); else FA_SLOAD(vp, 0);
            } else {
#pragma unroll
                for (int r = 0; r < 4; ++r) {
                    const int m = 32 * c + 4 * w + r;
                    const float p0 = __builtin_amdgcn_exp2f(sc[m] - mx0) * iv0, p1 = __builtin_amdgcn_exp2f(sc[256 + m] - mx1) * iv1;
                    a0 += sv[2 * r] * p0; a1 += sv[2 * r + 1] * p1;
                }
                if (c < 7) FA_SLOAD(vp, c + 1);
            }
            LAS unsigned char* slot = lds + (c & 1) * ATT_SLOT;
            if (c < 4) {
#pragma unroll
                for (int ml = 0; ml < 4; ++ml)
#pragma unroll
                    for (int ks = 0; ks < 8; ++ks) {
                        const bf16x8 Kf = *(LAS bf16x8*)(slot + (16 * ml + fr) * 528 + (32 * ks + 8 * fq) * 2);
                        S[4 * c + ml] = MFMA16(Kf, Qf[ks], ks == 0 ? zero4 : S[4 * c + ml]);
                    }
                if (c == 3) {
                    float mx = S[0][0];
#pragma unroll
                    for (int i = 0; i < 16; ++i) { mx = fmaxf(mx, fmaxf(fmaxf(S[i][0], S[i][1]), fmaxf(S[i][2], S[i][3]))); }
                    mx = fmaxf(mx, shx(mx, 16, lane)); mx = fmaxf(mx, shx(mx, 32, lane));
                    float sum = 0.f;
#pragma unroll
                    for (int i = 0; i < 16; ++i) {
#pragma unroll
                        for (int e = 0; e < 4; ++e) { S[i][e] = __builtin_amdgcn_exp2f(S[i][e] - mx); sum += S[i][e]; }
                    }
                    sum += shx(sum, 16, lane); sum += shx(sum, 32, lane);
                    inv = 1.0f / sum;
#pragma unroll
                    for (int a = 0; a < 8; ++a) {
                        u32x4 pw; pw.x = cvt_pk_bf16(S[2 * a][0], S[2 * a][1]); pw.y = cvt_pk_bf16(S[2 * a][2], S[2 * a][3]); pw.z = cvt_pk_bf16(S[2 * a + 1][0], S[2 * a + 1][1]); pw.w = cvt_pk_bf16(S[2 * a + 1][2], S[2 * a + 1][3]);
                        Pf[a] = __builtin_bit_cast(bf16x8, pw);
                    }
                }
            } else {
#pragma unroll
                for (int al = 0; al < 2; ++al)
#pragma unroll
                    for (int dt = 0; dt < 16; ++dt) {
                        LAS unsigned char* p = slot + (32 * al + 4 * fq + (fr >> 2)) * 528 + (16 * dt + 4 * (fr & 3)) * 2;
                        const bf16x8 Vf = tr_frag(p, p + 16 * 528);
                        Oa[dt] = MFMA16(Vf, Pf[2 * (c - 4) + al], (c == 4 && al == 0) ? zero4 : Oa[dt]);
                    }
            }
            if (c < 7) ATT_LSTORE((c + 1) & 1);
            __syncthreads();
        }
#pragma unroll
        for (int dt = 0; dt < 16; ++dt) *(u32x2*)(((bf16_t*)(F.ws + WS_O)) + rowq * D + h * 256 + 16 * dt + 4 * fq) = pack4(Oa[dt] * inv);
#undef ATT_GLOAD
#undef ATT_LSTORE
    }
#undef FA_SLOAD
    *(LAS f32x4*)(red + w * 512 + 4 * lane) = a0; *(LAS f32x4*)(red + w * 512 + 256 + 4 * lane) = a1;
    __syncthreads();
    {
        float o = 0.f;
#pragma unroll
        for (int ww = 0; ww < 8; ++ww) o += red[ww * 512 + tid];
        ((bf16_t*)(F.ws + WS_SO))[(size_t)sb * D + hp * 512 + tid] = (bf16_t)(cvt_pk_bf16(o, 0.f) & 0xffffu);
    }
    __syncthreads();
}
__device__ __forceinline__ void final_norm(Frame& F0) {
    Frame F = launder(F0);
    const int gw = F.bx * NWAVES + F.wave, NGW = F.G * NWAVES, lane = F.lane;
    f32x4 g[4];
#pragma unroll
    for (int jj = 0; jj < 4; ++jj) g[jj] = ((const f32x4*)FIN(24) + lane)[64 * jj];
    for (int m = gw; m < MP + MS; m += NGW) {
        f32x4 v[4]; float s = 0.f;
        if (m < MP) {
            const u32x2* src = (const u32x2*)(((bf16_t*)(F.ws + WS_XB)) + (size_t)m * D) + lane;
#pragma unroll
            for (int jj = 0; jj < 4; ++jj) v[jj] = unpack4(src[64 * jj]);
        } else {
            const f32x4* src = (const f32x4*)(((float*)(F.ws + WS_XS)) + (size_t)(m - MP) * D) + lane;
#pragma unroll
            for (int jj = 0; jj < 4; ++jj) v[jj] = src[64 * jj];
        }
#pragma unroll
        for (int jj = 0; jj < 4; ++jj) s += dot4(v[jj], v[jj]);
        float* dst = m < MP ? F.out + O_Y + (size_t)m * D : F.out + O_YS + (size_t)(m - MP) * D;
        const float rs = rsqrtf(wave_sum(s, lane) * (1.0f / D) + EPS);
#pragma unroll
        for (int jj = 0; jj < 4; ++jj) ((f32x4*)dst + lane)[64 * jj] = v[jj] * rs * g[jj];
    }
}

struct Args { const float* in[25]; float* out; unsigned char* ws; int ph_lo, ph_hi; };
#define REP(bit) for (int rep_ = 0; rep_ < 1 + ((REP_MASK >> (bit)) & 1); ++rep_)
#ifndef XCD_VID
#define XCD_VID 0
#endif
#ifndef MK_SPLIT
#define MK_SPLIT 0
#endif
__global__ void __launch_bounds__(NWAVES * 64, 2) fwd(Args args) {
    extern __shared__ __attribute__((aligned(16))) unsigned char lds_raw[];
    Frame F0;
    F0.lds = (LAS unsigned char*)lds_raw;
    F0.tid = threadIdx.x; F0.lane = F0.tid & 63; F0.wave = __builtin_amdgcn_readfirstlane(F0.tid >> 6); F0.G = gridDim.x; F0.bx = blockIdx.x;
    F0.in = (in_tab_t)__builtin_amdgcn_kernarg_segment_ptr();     F0.out = args.out; F0.ws = args.ws;
    for (int u = F0.tid; u < (LDS_BYTES - LDSCTL_OFF) / 4; u += NWAVES * 64) ((LAS unsigned*)(F0.lds + LDSCTL_OFF))[u] = 0u;
    __syncthreads();
    XcdBarrier bar; bar.wave = F0.wave; bar.bar = (unsigned*)(args.ws + WS_CTL) + CW_BAR; bar.x = 0; bar.st = nullptr;
    if (!MK_SPLIT) bar = xcd_barrier_post((unsigned*)(args.ws + WS_CTL) + CW_BAR, (volatile LAS unsigned*)(F0.lds + MISC_OFF) + 8, F0.wave);
    unsigned* rankw = (unsigned*)(args.ws + WS_CTL) + CW_RANK;
    const unsigned my_xcc = xb_xcc_id();
    unsigned my_rank = 0u;
    if (F0.tid == 0) ((volatile LAS unsigned*)(F0.lds + MISC_OFF))[12] = __hip_atomic_fetch_add(rankw + 64 * my_xcc, 1u, __ATOMIC_RELAXED, __HIP_MEMORY_SCOPE_AGENT);
    __syncthreads();
    my_rank = __builtin_amdgcn_readfirstlane(((volatile LAS unsigned*)(F0.lds + MISC_OFF))[12]);
    F0.vid = F0.bx;
    int ph = 0;
    const int lo = args.ph_lo, hi = args.ph_hi;
#define PH_BEGIN if (ph >= lo && ph < hi) { Frame F = launder(F0);
#define PH_END } { const bool both_ = (ph >= lo && ph + 1 < hi); ++ph; if (!MK_SPLIT && both_) { XcdBarrier b2_ = bar; unsigned long long bp_ = uni64((unsigned long long)bar.bar); unsigned bx_ = __builtin_amdgcn_readfirstlane(bar.x); int bw_ = __builtin_amdgcn_readfirstlane(bar.wave); asm volatile("" : "+s"(bp_), "+s"(bx_), "+s"(bw_)); b2_.bar = (unsigned*)(GAS unsigned*)bp_; b2_.x = bx_; b2_.wave = bw_; xcd_barrier(b2_); } }

    PH_BEGIN REP(0) { p0_prologue(F0); __syncthreads(); } PH_END
    if (!MK_SPLIT && lo == 0) {
        unsigned nx = 0u, xi = 0u; bool even = (F0.G % 8) == 0;
        for (unsigned jx = 0; jx < 16; ++jx) { const unsigned c_ = __hip_atomic_load(rankw + 64 * jx, __ATOMIC_RELAXED, __HIP_MEMORY_SCOPE_AGENT); if (c_) { if (c_ != (unsigned)F0.G / 8u) even = false; if (jx < my_xcc) ++xi; ++nx; } }
        if (XCD_VID && even && nx == 8u) F0.vid = (int)(my_rank * 8u + xi);
        if (((REP_MASK >> 18) & 1) && !(even && nx == 8u && (unsigned)(F0.bx % 8) == xi) && F0.tid == 0) F0.out[O_YS + F0.bx] = __builtin_nanf("");
        F0.vid = __builtin_amdgcn_readfirstlane(F0.vid);
    }
    PH_BEGIN {
        if ((REP_MASK >> 17) & 1) {
            f32x4 pa[8]; bf16x8 pb = (bf16x8){(short)F.tid, 1, 2, 3, 4, 5, 6, 7};
#pragma unroll
            for (int i = 0; i < 8; ++i) pa[i] = (f32x4){(float)F.tid, 1.f, 2.f, (float)i};
#pragma unroll 1
            for (int it = 0; it < 512; ++it) {
#pragma unroll
                for (int r = 0; r < 4; ++r)
#pragma unroll
                    for (int i = 0; i < 8; ++i) pa[i] = MFMA16(pb, pb, pa[i]);
            }
            float sacc = 0.f;
#pragma unroll
            for (int i = 0; i < 8; ++i) sacc += pa[i][0] + pa[i][3];
            if (sacc == 12345.678f) ((float*)(F.ws + WS_Z))[F.tid] = sacc;
        }
        if ((REP_MASK >> 15) & 3) { pg8::Gemm gp{((bf16_t*)(F.ws + WS_XB)), ((bf16_t*)(F.ws + WS_C1)), MP, NC, ((REP_MASK >> 15) & 1) ? 1024 : 512}; pg8::StaticOrder Sp; Sp.init(MP, NC, F.G, (int)F.vid); EpiProbe Ep{((bf16_t*)(F.ws + WS_Z)), NC}; pg8::gemm_phase<EpiProbe, pg8::StaticOrder, true, true>(F.lds, gp, Sp, Ep, F.wave); }
        pg8::Gemm g{((bf16_t*)(F.ws + WS_MEMB)), ((bf16_t*)(F.ws + WS_WKV)), MMEM, 8192, D}; pg8::StaticOrder S; S.init(MMEM, 8192, F.G, (int)F.vid);
        EpiMemKV E{((float*)(F.ws + WS_SMALL + 65536)), F.out + O_MEMK, F.out + O_MEMV, ((bf16_t*)(F.ws + WS_KB)), ((bf16_t*)(F.ws + WS_VB))};
        REP(1) pg8::gemm_phase<EpiMemKV, pg8::StaticOrder, true, true>(F.lds, g, S, E, F.wave);
    } PH_END
#pragma unroll 1
    for (int l = 0; l < DEPTH; ++l) {
        const int j = l >> 1;
        if ((l & 1) == 0) {
            PH_BEGIN {
                pg8::Gemm g{((bf16_t*)(F.ws + WS_XB)), ((bf16_t*)(F.ws + WS_AB1)) + (size_t)j * NAB * D, MP, NAB, D}; pg8::StaticOrder S; S.init(MP, NAB, F.G, (int)F.vid);
                Unit u0{0, 0}; S.next(0, u0); rstd_table(((float*)(F.ws + WS_RSQ)), u0.pm, (LAS float*)(F.lds + RSTD_OFF), F.tid);
                EpiG1Even E{((float*)(F.ws + WS_RSQ)), ((bf16_t*)(F.ws + WS_Z)), ((float*)(F.ws + WS_VSQ)), F.out + O_POOLP + (size_t)j * 8 * 15 * 1024, (LAS const float*)(F.lds + RSTD_OFF), u0.pm};
                REP(2) pg8::gemm_phase<EpiG1Even, pg8::StaticOrder, true, true>(F.lds, g, S, E, F.wave);
                SEpiZ SE{((float*)(F.ws + WS_SMALL)), ((float*)(F.ws + WS_SZ)), 8192, 0};
                REP(3) skinny_gemm<SEpiZ>(F, ((bf16_t*)(F.ws + WS_XB)) + (size_t)MP * D, ((bf16_t*)(F.ws + WS_AB1)) + (size_t)j * NAB * D, NAB, D, SE);
            } PH_END
            PH_BEGIN {
                REP(4) for (int un = F.bx; un < 256; un += F.G) { if ((un & 1) == 0) sgu_chunk(F, j, un >> 1); else pool_chunk(F, j, un >> 1); }
                REP(5) for (int b = F.bx; b < MS; b += F.G) sample_mix_even(F, j, b);
            } PH_END
        } else {
            PH_BEGIN {
                pg8::Gemm g{((bf16_t*)(F.ws + WS_XB)), ((bf16_t*)(F.ws + WS_C1)) + (size_t)j * NC * D, MP, NC, D}; pg8::StaticOrder S; S.init(MP, NC, F.G, (int)F.vid);
                Unit u0{0, 0}; S.next(0, u0); rstd_table(((float*)(F.ws + WS_RSQ)), u0.pm, (LAS float*)(F.lds + RSTD_OFF), F.tid);
                EpiG1Odd E{((float*)(F.ws + WS_RSQ)), ((bf16_t*)(F.ws + WS_A2)), FIN(18) + (size_t)j * 3 * 2048, F.out + O_CONVP + (size_t)j * 8 * 2 * 2048, ((float*)(F.ws + WS_SIDE)), (LAS float*)(F.lds + HALO_OFF), (LAS const float*)(F.lds + RSTD_OFF), u0.pm};
                REP(6) pg8::gemm_phase<EpiG1Odd, pg8::StaticOrder, true, true>(F.lds, g, S, E, F.wave);
                SEpiZ SE{((float*)(F.ws + WS_SMALL)), ((float*)(F.ws + WS_SZ)), 8192, 1};
                REP(3) skinny_gemm<SEpiZ>(F, ((bf16_t*)(F.ws + WS_XB)) + (size_t)MP * D, ((bf16_t*)(F.ws + WS_C1)) + (size_t)j * NC * D, NC, D, SE);
            } PH_END
            PH_BEGIN {
                REP(5) for (int b = F.bx; b < MS; b += F.G) sample_conv_odd(F, j, b);
            } PH_END
        }
        PH_BEGIN {
            const bf16_t* W2 = ((l & 1) ? ((bf16_t*)(F.ws + WS_C2)) : ((bf16_t*)(F.ws + WS_AB2))) + (size_t)j * D * 2048;
            pg8::Gemm g{((bf16_t*)(F.ws + WS_A2)), W2, MP, D, 2048}; pg8::StaticOrder S; S.init(MP, D, F.G, (int)F.vid);
            if (l & 1) { Unit fu; for (int i = 0; S.next(i, fu); ++i) conv_fixup(((float*)(F.ws + WS_SIDE)), FIN(18) + (size_t)j * 3 * 2048, ((bf16_t*)(F.ws + WS_A2)), fu.pm, F.tid); asm volatile("s_waitcnt vmcnt(0)" ::: "memory"); __syncthreads(); }
            EpiRes E{((bf16_t*)(F.ws + WS_XB)), ((float*)(F.ws + WS_RSQ))};
            pg8::gemm_phase<EpiRes, pg8::StaticOrder, true, true>(F.lds, g, S, E, F.wave);
            SEpiRes SE{((float*)(F.ws + WS_XS)), ((bf16_t*)(F.ws + WS_XB)) + (size_t)MP * D, ((float*)(F.ws + WS_SMALL))};
            skinny_gemm<SEpiRes>(F, ((bf16_t*)(F.ws + WS_SA2)), W2, D, 2048, SE);
        } PH_END
        PH_BEGIN {
            pg8::Gemm g{((bf16_t*)(F.ws + WS_XB)), ((bf16_t*)(F.ws + WS_WQ)) + (size_t)l * D * D, MP, D, D}; pg8::StaticOrder S; S.init(MP, D, F.G, (int)F.vid);
            Unit u0{0, 0}; S.next(0, u0); rstd_table(((float*)(F.ws + WS_RSQ)), u0.pm, (LAS float*)(F.lds + RSTD_OFF), F.tid);
            EpiQ E{((float*)(F.ws + WS_RSQ)), ((bf16_t*)(F.ws + WS_Q)), (LAS const float*)(F.lds + RSTD_OFF), u0.pm};
            REP(8) pg8::gemm_phase<EpiQ, pg8::StaticOrder, true, true>(F.lds, g, S, E, F.wave);
            SEpiQ SE{((float*)(F.ws + WS_SMALL)), ((float*)(F.ws + WS_SQ))};
            REP(9) skinny_gemm<SEpiQ>(F, ((bf16_t*)(F.ws + WS_XB)) + (size_t)MP * D, ((bf16_t*)(F.ws + WS_WQ)) + (size_t)l * D * D, D, D, SE);
        } PH_END
        PH_BEGIN {
            if (F.G == 256) { REP(10) attn_fused(F, l); }
            else { attn_prompt(F, l); attn_sample(F, l); }
        } PH_END
        PH_BEGIN {
            pg8::Gemm g{((bf16_t*)(F.ws + WS_O)), ((bf16_t*)(F.ws + WS_WO)) + (size_t)l * D * D, MP, D, D}; pg8::StaticOrder S; S.init(MP, D, F.G, (int)F.vid);
            EpiRes E{((bf16_t*)(F.ws + WS_XB)), ((float*)(F.ws + WS_RSQ))};
            pg8::gemm_phase<EpiRes, pg8::StaticOrder, true, true>(F.lds, g, S, E, F.wave);
            SEpiRes SE{((float*)(F.ws + WS_XS)), ((bf16_t*)(F.ws + WS_XB)) + (size_t)MP * D, ((float*)(F.ws + WS_SMALL))};
            skinny_gemm<SEpiRes>(F, ((bf16_t*)(F.ws + WS_SO)), ((bf16_t*)(F.ws + WS_WO)) + (size_t)l * D * D, D, D, SE);
        } PH_END
    }
    PH_BEGIN final_norm(F0); PH_END
#undef PH_BEGIN
#undef PH_END
}
constexpr int N_PHASES = 2 + 6 * DEPTH + 1;

extern "C" void kernel_launch(void* const* d_in, const int* in_sizes, int n_in, void* d_out, int out_size, void* d_ws, size_t ws_size, hipStream_t stream) {
    static int grid = 0;
    if (grid == 0) {
        if (n_in != 25 || in_sizes[0] != MP * D || (size_t)out_size != O_END || ws_size < WS_END) { fprintf(stderr, "kernel_launch: unexpected shapes (n_in %d, in0 %d, out %d, ws %zu); nothing launched\n", n_in, n_in > 0 ? in_sizes[0] : -1, out_size, ws_size); grid = -1; return; }
        int dev = 0, cus = 0, per_cu = 0;
        if (hipGetDevice(&dev) != hipSuccess || hipDeviceGetAttribute(&cus, hipDeviceAttributeMultiprocessorCount, dev) != hipSuccess) { fprintf(stderr, "kernel_launch: device query failed\n"); grid = -1; return; }
        if (hipFuncSetAttribute((const void*)fwd, hipFuncAttributeMaxDynamicSharedMemorySize, LDS_BYTES) != hipSuccess) { fprintf(stderr, "kernel_launch: hipFuncSetAttribute failed\n"); grid = -1; return; }
        if (hipOccupancyMaxActiveBlocksPerMultiprocessor(&per_cu, (const void*)fwd, NWAVES * 64, LDS_BYTES) != hipSuccess || per_cu < 1) fprintf(stderr, "kernel_launch: note: occupancy query reports %d workgroups per CU\n", per_cu);
        (void)hipGetLastError();
        grid = cus;
    }
    if (grid < 0) return;
    if (hipMemsetAsync((char*)d_ws + WS_CTL, 0, CTL_ZERO_BYTES, stream) != hipSuccess) { fprintf(stderr, "kernel_launch: memset failed\n"); return; }
    Args a{};
    for (int i = 0; i < 25; ++i) a.in[i] = (const float*)d_in[i];
    a.out = (float*)d_out; a.ws = (unsigned char*)d_ws;
#if MK_SPLIT
    for (int p = 0; p < N_PHASES; ++p) { a.ph_lo = p; a.ph_hi = p + 1; hipLaunchKernelGGL(fwd, dim3(grid), dim3(NWAVES * 64), LDS_BYTES, stream, a); }
#else
    a.ph_lo = 0; a.ph_hi = N_PHASES;
    hipLaunchKernelGGL(fwd, dim3(grid), dim3(NWAVES * 64), LDS_BYTES, stream, a);
#endif
    const hipError_t le = hipPeekAtLastError();
    if (le != hipSuccess) fprintf(stderr, "kernel_launch: launch failed: %s\n", hipGetErrorName(le));
}
```

```cpp
#include <hip/hip_runtime.h>
#include <cstdio>
#include <cstdint>
#ifndef REP_MASK
#define REP_MASK 0
#endif
__device__ __forceinline__ int hw_lane() { int l; asm volatile("v_mbcnt_lo_u32_b32 %0, -1, 0\n\tv_mbcnt_hi_u32_b32 %0, -1, %0" : "=v"(l)); return l; }
namespace pg8 {
#define PG8_LAS __attribute__((address_space(3)))
typedef unsigned short bf16_t;
typedef short bf16x8 __attribute__((ext_vector_type(8)));
typedef float f32x4 __attribute__((ext_vector_type(4)));
typedef unsigned u32x4 __attribute__((ext_vector_type(4)));
constexpr int BM = 256, BK = 64, HALF = 128, HTB = HALF * BK * 2  , STAGE_BYTES = 8 * HTB, NXCD = 8, WGM = 8;

__host__ __device__ __forceinline__ int lds_byte(int r, int c) { const int st = (r >> 4) * 2 + (c >> 5), rr = r & 15, cc = c & 31, ob = rr * 64 + cc * 2; return st * 1024 + (ob ^ (((ob >> 9) & 1) << 5)); }
__host__ __device__ __forceinline__ void stage_rc(int b, int& R, int& C) { const int st = b / 1024, sb = b % 1024, swz = sb ^ (((sb >> 9) & 1) << 5); R = (st >> 1) * 16 + swz / 64; C = (st & 1) * 32 + (swz % 64) / 2; }
__host__ __device__ __forceinline__ int perm32(int rho) { const int n = rho >> 4, i = rho & 15; return 8 * (i >> 2) + 4 * n + (i & 3); }

struct Unit { int pm, pn; };
struct Gemm { const bf16_t* A; const bf16_t* Bt; int M, N, K; };

struct StaticOrder {
    int nM, nN, nwg, G, c;
    __host__ __device__ __forceinline__ void init(int M, int N, int G_, int c_) { nM = M / BM; nN = N / BM; nwg = nM * nN; G = G_; c = c_; }
    __host__ __device__ __forceinline__ bool next(int i, Unit& u) const {
        const long L = (long)i * G + c; if (L >= nwg) return false;
        int wgid = (int)L; { const int q = nwg / NXCD, r = nwg % NXCD, xcd = wgid % NXCD, off = wgid / NXCD; wgid = (xcd < r ? xcd * (q + 1) : r * (q + 1) + (xcd - r) * q) + off; }
        const int nig = WGM * nN, gid = wgid / nig, fm = gid * WGM, gsz = (nM - fm) < WGM ? (nM - fm) : WGM;
        u.pm = fm + ((wgid % nig) % gsz); u.pn = (wgid % nig) / gsz; return true;
    }
    __device__ __forceinline__ void a_ready(const Unit&) const {}
    __device__ __forceinline__ void done(const Unit&) const {}
};

typedef float f32x2cv __attribute__((ext_vector_type(2))); typedef __bf16 bf16x2cv __attribute__((ext_vector_type(2)));
__device__ __forceinline__ unsigned cvt_pk_bf16(float lo, float hi) { const f32x2cv v = {lo, hi}; return __builtin_bit_cast(unsigned, __builtin_convertvector(v, bf16x2cv)); }
template <class Epi, class Sched, bool ALIGN_EPI = false, bool SP2 = false>
__device__ __forceinline__ void gemm_phase(PG8_LAS unsigned char* lds, const Gemm g, const Sched& S, const Epi& E, const int wave_id) {
    int tid_ = (wave_id << 6) | hw_lane(); asm volatile("" : "+v"(tid_));
    const int tid = tid_, wid = __builtin_amdgcn_readfirstlane(tid >> 6), lane = tid & 63, wr = wid >> 2, wc = wid & 3, fr = lane & 15, fq = lane >> 4;
    const int K = g.K, nt = K / BK;
    unsigned voffA[2], voffB[2];
#pragma unroll
    for (int i = 0; i < 2; ++i) { int R, C; stage_rc(tid * 16 + i * 8192, R, C); const int Rb = Epi::PERM ? ((R & ~31) + perm32(R & 31)) : R;
        voffA[i] = (unsigned)(R * K + C) * 2u; voffB[i] = (unsigned)(Rb * K + C) * 2u; }
    const size_t kstep = (size_t)(BK * 2);
    const size_t hstep = (size_t)HALF * K * 2;
    const size_t tstep = 2 * hstep;
    const unsigned ldsw = (unsigned)wid * 1024u;
    const int aoff = lds_byte(wr * 64 + fr, fq * 8), boff = lds_byte(wc * 32 + fr, fq * 8);
#define PG8_SA(b, h) (((b) * 2 + (h)) * HTB)
#define PG8_SB(b, h) ((4 + (b) * 2 + (h)) * HTB)
#define PG8_STAGE(bufoff, gbase, voff) do { _Pragma("unroll") for (int _i = 0; _i < 2; ++_i) \
        __builtin_amdgcn_global_load_lds((const unsigned*)((const char*)(gbase) + (voff)[_i]), (PG8_LAS unsigned*)(lds + (bufoff) + ldsw + _i * 8192), 16, 0, 0); } while (0)
#define PG8_LDA(dst, b, h) do { _Pragma("unroll") for (int m = 0; m < 4; ++m) _Pragma("unroll") for (int k = 0; k < 2; ++k) dst[m][k] = *(const PG8_LAS bf16x8*)(lds + PG8_SA(b, h) + aoff + m * 2048 + k * 1024); } while (0)
#define PG8_LDB(dst, b, h) do { _Pragma("unroll") for (int n = 0; n < 2; ++n) _Pragma("unroll") for (int k = 0; k < 2; ++k) dst[n][k] = *(const PG8_LAS bf16x8*)(lds + PG8_SB(b, h) + boff + n * 2048 + k * 1024); } while (0)
#define PG8_MMA(ai, bj, At, Bt) do { __builtin_amdgcn_s_setprio(1); _Pragma("unroll") for (int m = 0; m < 4; ++m) _Pragma("unroll") for (int n = 0; n < 2; ++n) _Pragma("unroll") for (int k = 0; k < 2; ++k) \
        acc[ai][bj][m][n] = __builtin_amdgcn_mfma_f32_16x16x32_bf16(Bt[n][k], At[m][k], acc[ai][bj][m][n], 0, 0, 0); __builtin_amdgcn_s_setprio(0); } while (0)
#define PG8_WAIT_V(n) asm volatile("s_waitcnt vmcnt(" #n ")" ::: "memory")
#define PG8_WAIT_L(n) asm volatile("s_waitcnt lgkmcnt(" #n ")" ::: "memory")
#define PG8_BAR __builtin_amdgcn_s_barrier()
#define PG8_SCHED __builtin_amdgcn_sched_barrier(0)
    Unit cur, nxt; int ui = 0;
    if (!S.next(0, cur)) return;
    f32x4 acc[2][2][4][2];
#pragma unroll
    for (int a = 0; a < 2; ++a)
#pragma unroll
        for (int b = 0; b < 2; ++b)
#pragma unroll
            for (int m = 0; m < 4; ++m)
#pragma unroll
                for (int n = 0; n < 2; ++n) acc[a][b][m][n] = (f32x4){0.f, 0.f, 0.f, 0.f};
    bf16x8 At[4][2], B0[2][2], B1[2][2];
    const char* cA = (const char*)g.A + (size_t)cur.pm * tstep; const char* cB = (const char*)g.Bt + (size_t)cur.pn * tstep;
    S.a_ready(cur);
    if constexpr (SP2) {
        PG8_STAGE(PG8_SB(0, 0), cB, voffB); PG8_STAGE(PG8_SB(0, 1), cB + hstep, voffB); PG8_STAGE(PG8_SA(0, 0), cA, voffA); PG8_STAGE(PG8_SA(0, 1), cA + hstep, voffA);
        if (wr == 1) PG8_BAR;
        PG8_WAIT_V(2); PG8_BAR;
        PG8_STAGE(PG8_SB(1, 0), cB + kstep, voffB); PG8_STAGE(PG8_SA(1, 0), cA + kstep, voffA); PG8_STAGE(PG8_SB(1, 1), cB + hstep + kstep, voffB);
        PG8_WAIT_V(6); PG8_BAR;
    } else {
        PG8_STAGE(PG8_SB(0, 0), cB, voffB); PG8_STAGE(PG8_SA(0, 0), cA, voffA); PG8_STAGE(PG8_SB(0, 1), cB + hstep, voffB); PG8_STAGE(PG8_SA(0, 1), cA + hstep, voffA);
        if (wr == 1) PG8_BAR;
        PG8_WAIT_V(4); PG8_BAR;
        PG8_STAGE(PG8_SB(1, 0), cB + kstep, voffB); PG8_STAGE(PG8_SA(1, 0), cA + kstep, voffA); PG8_STAGE(PG8_SB(1, 1), cB + hstep + kstep, voffB);
        PG8_WAIT_V(6); PG8_BAR;
    }
    for (;;) {
        const bool has_next = S.next(ui + 1, nxt);
        const char* nA = has_next ? (const char*)g.A + (size_t)nxt.pm * tstep : cA; const char* nB = has_next ? (const char*)g.Bt + (size_t)nxt.pn * tstep : cB;
        for (int t = 0; t < nt; t += 2) {
            const bool last = (t == nt - 2);
            const char* a1 = cA + (size_t)(t + 1) * kstep;
            const char* a2 = last ? nA : cA + (size_t)(t + 2) * kstep; const char* b2 = last ? nB : cB + (size_t)(t + 2) * kstep;
            const char* a3 = a2 + kstep; const char* b3 = b2 + kstep;
            if (last && has_next) S.a_ready(nxt);
            if constexpr (SP2) {
            PG8_LDB(B0, 0, 0); PG8_LDB(B1, 0, 1); PG8_SCHED; PG8_LDA(At, 0, 0); PG8_STAGE(PG8_SA(1, 1), a1 + hstep, voffA);
            PG8_WAIT_V(8); PG8_WAIT_L(0); PG8_BAR; PG8_MMA(0, 0, At, B0); PG8_MMA(0, 1, At, B1); PG8_BAR; PG8_SCHED;
            PG8_LDA(At, 0, 1); PG8_STAGE(PG8_SB(0, 0), b2, voffB); PG8_STAGE(PG8_SB(0, 1), b2 + hstep, voffB); PG8_STAGE(PG8_SA(0, 0), a2, voffA);
            PG8_WAIT_V(8); PG8_WAIT_L(0); PG8_BAR; PG8_MMA(1, 0, At, B0); PG8_MMA(1, 1, At, B1); PG8_BAR; PG8_SCHED;
            PG8_LDB(B0, 1, 0); PG8_LDB(B1, 1, 1); PG8_SCHED; PG8_LDA(At, 1, 0); PG8_STAGE(PG8_SA(0, 1), a2 + hstep, voffA);
            PG8_WAIT_V(8); PG8_WAIT_L(0); PG8_BAR; PG8_MMA(0, 0, At, B0); PG8_MMA(0, 1, At, B1); PG8_BAR; PG8_SCHED;
            PG8_LDA(At, 1, 1); PG8_STAGE(PG8_SB(1, 0), b3, voffB); PG8_STAGE(PG8_SB(1, 1), b3 + hstep, voffB); PG8_STAGE(PG8_SA(1, 0), a3, voffA);
            PG8_WAIT_V(8); PG8_WAIT_L(0); PG8_BAR; PG8_MMA(1, 0, At, B0); PG8_MMA(1, 1, At, B1); PG8_BAR; PG8_SCHED;
            } else {
            PG8_LDB(B0, 0, 0); PG8_SCHED; PG8_LDA(At, 0, 0); PG8_STAGE(PG8_SA(1, 1), a1 + hstep, voffA);
            PG8_WAIT_L(8); PG8_BAR; PG8_WAIT_L(0); PG8_MMA(0, 0, At, B0); PG8_BAR; PG8_SCHED;
            PG8_LDB(B1, 0, 1); PG8_STAGE(PG8_SB(0, 0), b2, voffB);
            PG8_BAR; PG8_WAIT_L(0); PG8_MMA(0, 1, At, B1); PG8_BAR;
            PG8_LDA(At, 0, 1); PG8_STAGE(PG8_SA(0, 0), a2, voffA);
            PG8_BAR; PG8_WAIT_L(0); PG8_MMA(1, 0, At, B0); PG8_BAR; PG8_SCHED;
            PG8_STAGE(PG8_SB(0, 1), b2 + hstep, voffB);
            PG8_WAIT_V(6); PG8_BAR; PG8_MMA(1, 1, At, B1); PG8_BAR;
            PG8_LDB(B0, 1, 0); PG8_SCHED; PG8_LDA(At, 1, 0); PG8_STAGE(PG8_SA(0, 1), a2 + hstep, voffA);
            PG8_WAIT_L(8); PG8_BAR; PG8_WAIT_L(0); PG8_MMA(0, 0, At, B0); PG8_BAR; PG8_SCHED;
            PG8_LDB(B1, 1, 1); PG8_STAGE(PG8_SB(1, 0), b3, voffB);
            PG8_BAR; PG8_WAIT_L(0); PG8_MMA(0, 1, At, B1); PG8_BAR;
            PG8_LDA(At, 1, 1); PG8_STAGE(PG8_SA(1, 0), a3, voffA);
            PG8_BAR; PG8_WAIT_L(0); PG8_MMA(1, 0, At, B0); PG8_BAR; PG8_SCHED;
            PG8_STAGE(PG8_SB(1, 1), b3 + hstep, voffB);
            PG8_WAIT_V(6); PG8_BAR; PG8_MMA(1, 1, At, B1); PG8_BAR;
            }
        }
        if constexpr (ALIGN_EPI) { if (wr == 0) PG8_BAR; }
        if constexpr (!Epi::AFTER_DRAIN) { for (int rep_ = 0; rep_ < 1 + (Epi::REP_EPI ? 1 : 0); ++rep_) E(acc, cur, wr, wc, fr, fq); S.done(cur); }
        if (!has_next) break;
#pragma unroll
        for (int a = 0; a < 2; ++a)
#pragma unroll
            for (int b = 0; b < 2; ++b)
#pragma unroll
                for (int m = 0; m < 4; ++m)
#pragma unroll
                    for (int n = 0; n < 2; ++n) acc[a][b][m][n] = (f32x4){0.f, 0.f, 0.f, 0.f};
        cur = nxt; cA = nA; cB = nB; ++ui;
        if constexpr (ALIGN_EPI) { if (wr == 1) PG8_BAR; }
    }
    PG8_WAIT_V(0);
    if constexpr (!ALIGN_EPI) { if (wr == 0) PG8_BAR; }
    PG8_BAR;
    if constexpr (Epi::AFTER_DRAIN) { E.fused(acc, cur, wr, wc, fr, fq, lds, wid, lane); S.done(cur); }
#undef PG8_SA
#undef PG8_SB
#undef PG8_STAGE
#undef PG8_LDA
#undef PG8_LDB
#undef PG8_MMA
#undef PG8_WAIT_V
#undef PG8_WAIT_L
#undef PG8_BAR
#undef PG8_SCHED
}
}

using pg8::bf16_t; using pg8::bf16x8; using pg8::f32x4; using pg8::u32x4; using pg8::Unit; using pg8::cvt_pk_bf16;
#define GAS __attribute__((address_space(1)))
#define LAS __attribute__((address_space(3)))
typedef unsigned u32x2 __attribute__((ext_vector_type(2)));
typedef short s16x4 __attribute__((ext_vector_type(4)));
typedef GAS unsigned gu32;
#define RLX_AGENT __ATOMIC_RELAXED, __HIP_MEMORY_SCOPE_AGENT

constexpr int NWAVES = 8;
constexpr int D = 1024, MP = 16384, MS = 128, SEQ = 2048, NBATCH = 8, NMEM = 256, MMEM = 2048, DEPTH = 4;
constexpr int NAB = 5120, NC = 8192;
constexpr float EPS = 1e-6f;
constexpr float QSCALE = 0.0625f * 1.4426950408889634f;

constexpr size_t O_Y = 0, O_YS = O_Y + (size_t)MP * D, O_POOLP = O_YS + (size_t)MS * D, O_POOLS = O_POOLP + 2 * 8 * 15 * 1024,
                 O_CONVP = O_POOLS + (size_t)2 * 128 * 15 * 1024, O_CONVS = O_CONVP + 2 * 8 * 2 * 2048, O_SGUV = O_CONVS + (size_t)2 * 128 * 2 * 2048,
                 O_MEMK = O_SGUV + 2 * 128 * 1024, O_MEMV = O_MEMK + (size_t)4 * MMEM * D, O_END = O_MEMV + (size_t)4 * MMEM * D;
static_assert(O_END == 39239680, "output size");

constexpr size_t MiB = 1u << 20;
constexpr size_t WS_CTL = 0, CTL_ZERO_BYTES = 1 * MiB;
constexpr size_t WS_AB1 = 2 * MiB, WS_C1 = 22 * MiB, WS_AB2 = 54 * MiB, WS_C2 = 62 * MiB, WS_WQ = 70 * MiB, WS_WKV = 78 * MiB, WS_WO = 94 * MiB, WS_PMT = 102 * MiB;
constexpr size_t WS_XB = 104 * MiB;
constexpr size_t WS_RSQ = 137 * MiB, WS_VSQ = 138 * MiB;
constexpr size_t WS_SMALL = 139 * MiB;
constexpr size_t WS_Z = 140 * MiB;
constexpr size_t WS_A2 = 268 * MiB;
constexpr size_t WS_Q = 332 * MiB, WS_O = 364 * MiB;
constexpr size_t WS_MEMB = 396 * MiB, WS_KB = 400 * MiB, WS_VB = 416 * MiB;
constexpr size_t WS_XS = 432 * MiB, WS_SZ = 433 * MiB, WS_SA2 = 437 * MiB, WS_SQ = 438 * MiB, WS_SO = 439 * MiB, WS_SIDE = 440 * MiB  , WS_END = 444 * MiB;
constexpr int CW_BAR = 4096, CW_RANK = 8192;

constexpr int RING_BYTES = 131072, LDSCTL_OFF = RING_BYTES, MISC_OFF = LDSCTL_OFF + 320, HALO_OFF = RING_BYTES + 1024  , RSTD_OFF = HALO_OFF + 8192  , CWL_OFF = RSTD_OFF + 1024  , LDS_BYTES = 155648;

#define LDS_WAIT() asm volatile("s_waitcnt lgkmcnt(0)" ::: "memory")
#define LDS_BARRIER() asm volatile("s_waitcnt lgkmcnt(0)\n\ts_barrier" ::: "memory")

#define XB_TMO      128
#define XB_XCNT(j)  (256  + 64 * (j))
#define XB_XSUB(j)  (1280 + 64 * (j))
#define XB_XGEN(j)  (2304 + 64 * (j))
#define XB_TOP      3328
#define XB_TOPGEN   3392
#define XCD_BAR_WORDS 3456
#define XB_SPIN_CAP (1u << 18)

__device__ __forceinline__ unsigned xb_ld(unsigned* p)              { return __hip_atomic_load(p, __ATOMIC_RELAXED, __HIP_MEMORY_SCOPE_AGENT); }
__device__ __forceinline__ unsigned xb_add(unsigned* p, unsigned v) { return __hip_atomic_fetch_add(p, v, __ATOMIC_RELAXED, __HIP_MEMORY_SCOPE_AGENT); }
__device__ __forceinline__ unsigned xb_xcc_id() { return (unsigned)__builtin_amdgcn_s_getreg((3 << 11) | 20) & 0xFu; }
#define XB_SPIN(cond, bar) do { unsigned _sp = 0; while (cond) { __builtin_amdgcn_s_sleep(1); \
    if ((++_sp & 255u) == 0u) { if (xb_ld(&(bar)[XB_TMO])) break; if (_sp > XB_SPIN_CAP) { atomicAdd(&(bar)[XB_TMO], 1u); break; } } } } while (0)

struct XcdBarrier {
    int wave;
    unsigned* bar; unsigned x;
    volatile LAS unsigned* st;
};

__device__ __forceinline__ XcdBarrier xcd_barrier_post(unsigned* bar, volatile LAS unsigned* st, int wave) {
    XcdBarrier b; b.wave = wave; b.bar = bar; b.x = xb_xcc_id(); b.st = st;
    if (b.wave == 0 && hw_lane() == 0) (void)xb_add(&bar[XB_XCNT(b.x)], 1u);
    return b;
}
__device__ __forceinline__ void xcd_barrier_complete(unsigned* bar, unsigned x, unsigned& nloc, unsigned& nx) {
    const unsigned G = gridDim.x * gridDim.y * gridDim.z;
    unsigned sum, cnt, mine, sp = 0u;
    for (;;) {
        sum = 0u; cnt = 0u; mine = 0u;
#pragma unroll
        for (unsigned j = 0; j < 16; ++j) { const unsigned c = xb_ld(&bar[XB_XCNT(j)]); sum += c; cnt += (c > 0u) ? 1u : 0u; mine = (j == x) ? c : mine; }
        if (sum == G) break;
        __builtin_amdgcn_s_sleep(1);
        if ((++sp & 255u) == 0u) { if (xb_ld(&bar[XB_TMO])) break; if (sp > XB_SPIN_CAP) { atomicAdd(&bar[XB_TMO], 1u); break; } }
    }
    nloc = mine > 0u ? mine : 1u; nx = cnt > 0u ? cnt : 1u;
}

__device__ __forceinline__ void xcd_barrier(const XcdBarrier& b) {
    asm volatile("s_waitcnt vmcnt(0)" ::: "memory");
    __syncthreads();
    if (b.wave == 0 && hw_lane() == 0) {
        unsigned* bar = b.bar;
        __builtin_amdgcn_s_waitcnt(0);
        unsigned nloc = b.st[0], nx = b.st[1];
        if (nloc == 0u) { xcd_barrier_complete(bar, b.x, nloc, nx); b.st[0] = nloc; b.st[1] = nx; }
        const unsigned old = xb_add(&bar[XB_XSUB(b.x)], 1u);
        const unsigned gen = old / nloc;
        if (old + 1u == (gen + 1u) * nloc) {
            __builtin_amdgcn_fence(__ATOMIC_RELEASE, "agent");
            asm volatile("s_waitcnt vmcnt(0)" ::: "memory");
            const unsigned og = xb_add(&bar[XB_TOP], 1u);
            const unsigned tg = og / nx;
            if (og + 1u == (tg + 1u) * nx) xb_add(&bar[XB_TOPGEN], 1u);
            else XB_SPIN(xb_ld(&bar[XB_TOPGEN]) == tg, bar);
            __builtin_amdgcn_fence(__ATOMIC_ACQUIRE, "agent");
            xb_add(&bar[XB_XGEN(b.x)], 1u);
            asm volatile("s_waitcnt vmcnt(0)" ::: "memory");
        } else {
            XB_SPIN(xb_ld(&bar[XB_XGEN(b.x)]) == gen, bar);
            __builtin_amdgcn_fence(__ATOMIC_ACQUIRE, "agent");
            asm volatile("s_waitcnt vmcnt(0)" ::: "memory");
        }
    }
    __syncthreads();
}

typedef const float* fptr_t;
typedef __attribute__((address_space(4))) const fptr_t* in_tab_t;
struct Frame {
    LAS unsigned char* lds;
    int tid, lane, wave, G, bx, vid;
    in_tab_t in;
    float* out;
    unsigned char* ws;
};
__device__ __forceinline__ unsigned long long uni64(unsigned long long v) { const unsigned lo = __builtin_amdgcn_readfirstlane((unsigned)v), hi = __builtin_amdgcn_readfirstlane((unsigned)(v >> 32)); return ((unsigned long long)hi << 32) | lo; }
__device__ __forceinline__ Frame launder(const Frame& F0) {
    Frame F = F0;
    int wv_ = __builtin_amdgcn_readfirstlane(F0.wave);
    int ln_ = hw_lane();
    int g_ = __builtin_amdgcn_readfirstlane(F0.G), b_ = __builtin_amdgcn_readfirstlane(F0.bx), v_ = __builtin_amdgcn_readfirstlane(F0.vid);
    unsigned long long w_ = uni64((unsigned long long)F0.ws), o_ = uni64((unsigned long long)F0.out), i_ = uni64((unsigned long long)F0.in);
    asm volatile("" : "+v"(ln_), "+s"(wv_), "+s"(g_), "+s"(b_), "+s"(v_), "+s"(w_), "+s"(o_), "+s"(i_));
    F.tid = (wv_ << 6) | ln_; F.G = g_; F.bx = b_; F.vid = v_; F.ws = (unsigned char*)(GAS unsigned char*)w_; F.out = (float*)(GAS float*)o_; F.in = (in_tab_t)i_;
    F.lane = ln_; F.wave = wv_;
    return F;
}
#define FIN(k) ((const float*)(const GAS float*)(F.in[k]))


__device__ __forceinline__ float shx(float v, int mask, int lane) { return __builtin_bit_cast(float, __builtin_amdgcn_ds_bpermute((lane ^ mask) << 2, __builtin_bit_cast(int, v))); }
__device__ __forceinline__ float wave_sum(float v, int lane) {
#pragma unroll
    for (int o = 1; o < 64; o <<= 1) v += shx(v, o, lane);
    return v;
}
__device__ __forceinline__ float silu_f(float x) { return x * __builtin_amdgcn_rcpf(1.f + __builtin_amdgcn_exp2f(-1.4426950408889634f * x)); }
__device__ __forceinline__ f32x4 silu4(f32x4 v) { return (f32x4){silu_f(v[0]), silu_f(v[1]), silu_f(v[2]), silu_f(v[3])}; }
__device__ __forceinline__ float dot4(f32x4 a, f32x4 b) { return (a[0] * b[0] + a[1] * b[1]) + (a[2] * b[2] + a[3] * b[3]); }
__device__ __forceinline__ u32x4 pack8(f32x4 a, f32x4 b) { u32x4 w; w.x = cvt_pk_bf16(a[0], a[1]); w.y = cvt_pk_bf16(a[2], a[3]); w.z = cvt_pk_bf16(b[0], b[1]); w.w = cvt_pk_bf16(b[2], b[3]); return w; }
__device__ __forceinline__ u32x2 pack4(f32x4 a) { u32x2 w; w.x = cvt_pk_bf16(a[0], a[1]); w.y = cvt_pk_bf16(a[2], a[3]); return w; }
__device__ __forceinline__ float bflo(unsigned w) { return __uint_as_float(w << 16); }
__device__ __forceinline__ float bfhi(unsigned w) { return __uint_as_float(w & 0xffff0000u); }
__device__ __forceinline__ void unpack8(u32x4 w, f32x4& a, f32x4& b) { a = (f32x4){bflo(w.x), bfhi(w.x), bflo(w.y), bfhi(w.y)}; b = (f32x4){bflo(w.z), bfhi(w.z), bflo(w.w), bfhi(w.w)}; }
__device__ __forceinline__ f32x4 unpack4(u32x2 w) { return (f32x4){bflo(w.x), bfhi(w.x), bflo(w.y), bfhi(w.y)}; }
__device__ __forceinline__ float rstd16(const float* p) {
    const f32x4 a = ((const f32x4*)p)[0], b = ((const f32x4*)p)[1], c = ((const f32x4*)p)[2], d = ((const f32x4*)p)[3];
    const f32x4 s = (a + b) + (c + d);
    return rsqrtf(((s[0] + s[1]) + (s[2] + s[3])) * (1.0f / D) + EPS);
}
__device__ __forceinline__ float rstd32(const float* p) {
    f32x4 s = ((const f32x4*)p)[0];
#pragma unroll
    for (int i = 1; i < 8; ++i) s += ((const f32x4*)p)[i];
    return rsqrtf(((s[0] + s[1]) + (s[2] + s[3])) * (1.0f / D) + EPS);
}
__host__ __device__ __forceinline__ int src_even(int n) {
    const int tile = n >> 8, o = n & 255;
    if (tile < 8) return n;
    if (tile < 12) return 3072 + (n - 2048);
    const int cb = tile - 12;
    return o < 128 ? 2048 + 128 * cb + o : 4096 + 128 * cb + (o - 128);
}
__host__ __device__ __forceinline__ int src_odd(int n) {
    const int pn = n >> 8, p = n & 255, q = ((p >> 7) << 1) | ((p >> 2) & 1), ch = 64 * pn + 16 * ((p >> 5) & 3) + 4 * ((p >> 3) & 3) + (p & 3);
    const int base = q == 0 ? 2048 : (q == 1 ? 4096 : (q == 2 ? 0 : 6144));
    return base + ch;
}

__device__ __forceinline__ void rstd_table(const float* rsq, int pm, LAS float* tab, int tid) {
    if (tid < 256) tab[tid] = rstd16(rsq + ((size_t)pm * 256 + tid) * 16);
    LDS_BARRIER();
}
struct EpiG1Even {
    static constexpr bool PERM = true, AFTER_DRAIN = false, REP_EPI = (REP_MASK >> 12) & 1;
    const float* rsq; bf16_t* Z; float* vsq; float* pool_out; LAS const float* rtab; int pm0;
    __device__ __forceinline__ void operator()(const f32x4 (&acc)[2][2][4][2], const Unit& u, int wr, int wc, int fr_, int fq_) const {
        int fr = fr_, fq = fq_; asm volatile("" : "+v"(fr), "+v"(fq));
        const int tile = u.pn, cw = wc * 32 + 8 * fq;
#pragma unroll
        for (int ai = 0; ai < 2; ++ai)
#pragma unroll
            for (int m = 0; m < 4; ++m) {
                const int row = u.pm * 256 + ai * 128 + wr * 64 + m * 16 + fr;
                const float rs = u.pm == pm0 ? rtab[ai * 128 + wr * 64 + m * 16 + fr] : rstd16(rsq + (size_t)row * 16);
                if (tile < 12) {
                    const int kind = tile >> 2;
                    bf16_t* dst = Z + (size_t)kind * MP * D + (size_t)row * D + (tile & 3) * 256 + cw;
                    float ss = 0.f;
#pragma unroll
                    for (int bj = 0; bj < 2; ++bj) {
                        f32x4 v0 = acc[ai][bj][m][0] * rs, v1 = acc[ai][bj][m][1] * rs;
                        if (kind == 1) { v0 = silu4(v0); v1 = silu4(v1); }
                        if (kind == 2) ss += dot4(v0, v0) + dot4(v1, v1);
                        *(u32x4*)(dst + bj * 128) = pack8(v0, v1);
                        if (kind == 0 && (row & 2047) >= 2033) {
                            float* po = pool_out + ((size_t)(row >> 11) * 15 + ((row & 2047) - 2033)) * 1024 + (tile & 3) * 256 + bj * 128 + cw;
                            *(f32x4*)po = v0; *(f32x4*)(po + 4) = v1;
                        }
                    }
                    if (kind == 2) { ss += shx(ss, 16, 16 * fq + fr); ss += shx(ss, 32, 16 * fq + fr); if (fq == 0) vsq[(size_t)row * 16 + (tile - 8) * 4 + wc] = ss; }
                } else {
                    const int cb = tile - 12;
                    bf16_t* dst = Z + (size_t)3 * MP * D + (size_t)row * D + cb * 128 + cw;
                    const f32x4 u0 = acc[ai][0][m][0] * rs, u1 = acc[ai][0][m][1] * rs, g0 = acc[ai][1][m][0] * rs, g1 = acc[ai][1][m][1] * rs;
                    *(u32x4*)dst = pack8(u0 * silu4(g0), u1 * silu4(g1));
                }
            }
    }
};
__device__ __forceinline__ float dpp_shr1(float old, float v) { return __builtin_bit_cast(float, __builtin_amdgcn_update_dpp(__builtin_bit_cast(int, old), __builtin_bit_cast(int, v), 0x111, 0xf, 0xf, false)); }
__device__ __forceinline__ float dpp_shr2(float old, float v) { return __builtin_bit_cast(float, __builtin_amdgcn_update_dpp(__builtin_bit_cast(int, old), __builtin_bit_cast(int, v), 0x112, 0xf, 0xf, false)); }
struct EpiG1Odd {
    static constexpr bool PERM = true, AFTER_DRAIN = false, REP_EPI = false;
    const float* rsq; bf16_t* A2; const float* cw; float* conv_out; float* side; LAS float* halo; LAS const float* rtab; int pm0; LAS const float* cwl; int pn0;
    __device__ __forceinline__ void operator()(const f32x4 (&acc)[2][2][4][2], const Unit& u, int wr, int wc, int fr_, int fq_) const {
        int fr = fr_, fq = fq_; asm volatile("" : "+v"(fr), "+v"(fq));
        const int chl = wc * 16 + 4 * fq, ch = u.pn * 64 + chl;
        f32x4 w0, w1, w2;
        { const int ui = (u.pn - pn0) >> 2;
          if (u.pm == pm0 && ui >= 0 && ui < 8 && ((u.pn - pn0) & 3) == 0) { w0 = *(const LAS f32x4*)(cwl + (ui * 3 + 0) * 64 + chl); w1 = *(const LAS f32x4*)(cwl + (ui * 3 + 1) * 64 + chl); w2 = *(const LAS f32x4*)(cwl + (ui * 3 + 2) * 64 + chl); }
          else { w0 = *(const f32x4*)(cw + ch); w1 = *(const f32x4*)(cw + 2048 + ch); w2 = *(const f32x4*)(cw + 4096 + ch); } }
        f32x4 e[2][4]; float rsv[2][4];
#pragma unroll
        for (int ai = 0; ai < 2; ++ai)
#pragma unroll
            for (int m = 0; m < 4; ++m) {
                const int rb = 8 * ai + 4 * wr + m, row = u.pm * 256 + 16 * rb + fr;
                const float rs = u.pm == pm0 ? rtab[16 * rb + fr] : rstd16(rsq + (size_t)row * 16); rsv[ai][m] = rs;
                e[ai][m] = (acc[ai][0][m][0] * rs) * (acc[ai][0][m][1] * rs);
                if (fr >= 14) *(LAS f32x4*)(halo + (rb * 2 + (fr - 14)) * 64 + chl) = e[ai][m];
                if (m & 1) asm volatile("" ::: "memory");
            }
        asm volatile("s_waitcnt lgkmcnt(0)" ::: "memory"); __builtin_amdgcn_s_barrier(); asm volatile("" ::: "memory");
        float* sd = side + (size_t)u.pm * 6 * 2048 + ch;
#pragma unroll
        for (int ai = 0; ai < 2; ++ai)
#pragma unroll
            for (int m = 0; m < 4; ++m) {
                const int rb = 8 * ai + 4 * wr + m, row = u.pm * 256 + 16 * rb + fr;
                const float rs = rsv[ai][m];
                const f32x4 sg = (acc[ai][1][m][0] * rs) * silu4(acc[ai][1][m][1] * rs);
                f32x4 h0 = (f32x4){0.f, 0.f, 0.f, 0.f}, h1 = h0;
                if (rb > 0) { h0 = *(const LAS f32x4*)(halo + ((rb - 1) * 2 + 0) * 64 + chl); h1 = *(const LAS f32x4*)(halo + ((rb - 1) * 2 + 1) * 64 + chl); }
                const f32x4 hx = fr == 0 ? h0 : h1, ev = e[ai][m];
                f32x4 e1, e2;
#pragma unroll
                for (int k = 0; k < 4; ++k) { e1[k] = dpp_shr1(h1[k], ev[k]); e2[k] = dpp_shr2(hx[k], ev[k]); }
                const f32x4 a = sg * (w0 * e2 + w1 * e1 + w2 * ev);
                const bool top = (rb == 0 && fr < 2);
                if (!(top && (u.pm & 7) != 0)) *(u32x2*)(A2 + (size_t)row * 2048 + ch) = pack4(a);
                if (top) { *(f32x4*)(sd + fr * 2048) = ev; *(f32x4*)(sd + (4 + fr) * 2048) = sg; }
                if (rb == 15 && fr >= 14) {
                    *(f32x4*)(sd + (2 + fr - 14) * 2048) = ev;
                    if ((u.pm & 7) == 7) *(f32x4*)(conv_out + ((size_t)(u.pm >> 3) * 2 + (fr - 14)) * 2048 + ch) = ev;
                }
            }
    }
};
__device__ __forceinline__ void conv_fixup(const float* side, const float* cw, bf16_t* A2, int pm, int tid) {
    if ((pm & 7) == 0) return;
    const int ch = 4 * tid;
    const float* sp = side + (size_t)(pm - 1) * 6 * 2048 + ch; const float* sc = side + (size_t)pm * 6 * 2048 + ch;
    const f32x4 em2 = *(const f32x4*)(sp + 2 * 2048), em1 = *(const f32x4*)(sp + 3 * 2048), e0 = *(const f32x4*)sc, e1 = *(const f32x4*)(sc + 2048), s0 = *(const f32x4*)(sc + 4 * 2048), s1 = *(const f32x4*)(sc + 5 * 2048);
    const f32x4 w0 = *(const f32x4*)(cw + ch), w1 = *(const f32x4*)(cw + 2048 + ch), w2 = *(const f32x4*)(cw + 4096 + ch);
    *(u32x2*)(A2 + (size_t)(pm * 256) * 2048 + ch) = pack4(s0 * (w0 * em2 + w1 * em1 + w2 * e0));
    *(u32x2*)(A2 + (size_t)(pm * 256 + 1) * 2048 + ch) = pack4(s1 * (w0 * em1 + w1 * e0 + w2 * e1));
}
struct EpiRes {
    static constexpr bool PERM = true, AFTER_DRAIN = false, REP_EPI = false;
    bf16_t* xb; float* rsq;
    __device__ __forceinline__ void operator()(const f32x4 (&acc)[2][2][4][2], const Unit& u, int wr, int wc, int fr_, int fq_) const {
        int fr = fr_, fq = fq_; asm volatile("" : "+v"(fr), "+v"(fq));
        const int cw = wc * 32 + 8 * fq;
#pragma unroll
        for (int ai = 0; ai < 2; ++ai) {
            u32x4 old[4][2];
#pragma unroll
            for (int m = 0; m < 4; ++m)
#pragma unroll
                for (int bj = 0; bj < 2; ++bj) old[m][bj] = *(const u32x4*)(xb + (size_t)(u.pm * 256 + ai * 128 + wr * 64 + m * 16 + fr) * D + u.pn * 256 + bj * 128 + cw);
#pragma unroll
            for (int m = 0; m < 4; ++m) {
                const int row = u.pm * 256 + ai * 128 + wr * 64 + m * 16 + fr;
                float ss = 0.f;
#pragma unroll
                for (int bj = 0; bj < 2; ++bj) {
                    f32x4 b0, b1; unpack8(old[m][bj], b0, b1);
                    const u32x4 wv = pack8(b0 + acc[ai][bj][m][0], b1 + acc[ai][bj][m][1]);
                    *(u32x4*)(xb + (size_t)row * D + u.pn * 256 + bj * 128 + cw) = wv;
                    f32x4 r0, r1; unpack8(wv, r0, r1);
                    ss += dot4(r0, r0) + dot4(r1, r1);
                }
                ss += shx(ss, 16, 16 * fq + fr); ss += shx(ss, 32, 16 * fq + fr);
                if (fq == 0) rsq[(size_t)row * 16 + u.pn * 4 + wc] = ss;
            }
        }
    }
};
struct EpiProbe {
    static constexpr bool PERM = true, AFTER_DRAIN = false, REP_EPI = false;
    bf16_t* O; int ldc;
    __device__ __forceinline__ void operator()(const f32x4 (&acc)[2][2][4][2], const Unit& u, int wr, int wc, int fr_, int fq_) const {
        int fr = fr_, fq = fq_; asm volatile("" : "+v"(fr), "+v"(fq));
        const int cw = wc * 32 + 8 * fq;
#pragma unroll
        for (int ai = 0; ai < 2; ++ai)
#pragma unroll
            for (int m = 0; m < 4; ++m) {
                const int row = u.pm * 256 + ai * 128 + wr * 64 + m * 16 + fr;
#pragma unroll
                for (int bj = 0; bj < 2; ++bj) *(u32x4*)(O + (size_t)row * ldc + u.pn * 256 + bj * 128 + cw) = pack8(acc[ai][bj][m][0], acc[ai][bj][m][1]);
            }
    }
};
struct EpiQ {
    static constexpr bool PERM = true, AFTER_DRAIN = false, REP_EPI = false;
    const float* rsq; bf16_t* Q; LAS const float* rtab; int pm0;
    __device__ __forceinline__ void operator()(const f32x4 (&acc)[2][2][4][2], const Unit& u, int wr, int wc, int fr_, int fq_) const {
        int fr = fr_, fq = fq_; asm volatile("" : "+v"(fr), "+v"(fq));
        const int cw = wc * 32 + 8 * fq;
#pragma unroll
        for (int ai = 0; ai < 2; ++ai)
#pragma unroll
            for (int m = 0; m < 4; ++m) {
                const int row = u.pm * 256 + ai * 128 + wr * 64 + m * 16 + fr;
                const float rs = u.pm == pm0 ? rtab[ai * 128 + wr * 64 + m * 16 + fr] : rstd16(rsq + (size_t)row * 16);
#pragma unroll
                for (int bj = 0; bj < 2; ++bj) *(u32x4*)(Q + (size_t)row * D + u.pn * 256 + bj * 128 + cw) = pack8(acc[ai][bj][m][0] * rs, acc[ai][bj][m][1] * rs);
            }
    }
};
struct EpiMemKV {
    static constexpr bool PERM = true, AFTER_DRAIN = false, REP_EPI = false;
    const float* rstdm; float* outk; float* outv; bf16_t* kb; bf16_t* vb;
    __device__ __forceinline__ void operator()(const f32x4 (&acc)[2][2][4][2], const Unit& u, int wr, int wc, int fr_, int fq_) const {
        int fr = fr_, fq = fq_; asm volatile("" : "+v"(fr), "+v"(fq));
        const int layer = u.pn >> 3, isv = (u.pn >> 2) & 1, cw = (u.pn & 3) * 256 + wc * 32 + 8 * fq;
        float* of = (isv ? outv : outk) + (size_t)layer * MMEM * D; bf16_t* ob = (isv ? vb : kb) + (size_t)layer * MMEM * D;
#pragma unroll
        for (int ai = 0; ai < 2; ++ai)
#pragma unroll
            for (int m = 0; m < 4; ++m) {
                const int row = u.pm * 256 + ai * 128 + wr * 64 + m * 16 + fr;
                const float rs = rstdm[row];
#pragma unroll
                for (int bj = 0; bj < 2; ++bj) {
                    const size_t off = (size_t)row * D + bj * 128 + cw;
                    const f32x4 v0 = acc[ai][bj][m][0] * rs, v1 = acc[ai][bj][m][1] * rs;
                    *(f32x4*)(of + off) = v0; *(f32x4*)(of + off + 4) = v1;
                    *(u32x4*)(ob + off) = pack8(v0, v1);
                }
            }
    }
};

__device__ __forceinline__ void p0_tr_item(const float* W, int ldw, int k0, int srccol, const float* gk, float sc, bf16_t* WT, int K, int dstn0, LAS float* scr, int lane) {
    float v[32];
    const int c = lane & 7;
    f32x4 g0 = (f32x4){sc, sc, sc, sc}, g1 = g0;
    if (gk) { g0 = *(const f32x4*)(gk + k0 + 8 * c) * sc; g1 = *(const f32x4*)(gk + k0 + 8 * c + 4) * sc; }
    const float* wp = W + (size_t)(k0 + (lane >> 5)) * ldw + srccol;
#pragma unroll
    for (int i = 0; i < 32; ++i) v[i] = wp[(size_t)(2 * i) * ldw];
#pragma unroll
    for (int i = 0; i < 32; ++i) scr[(2 * i + (lane >> 5)) * 33 + (lane & 31)] = v[i];
    LDS_WAIT(); asm volatile("" ::: "memory");
#pragma unroll
    for (int jj = 0; jj < 4; ++jj) {
        const int n = (lane >> 3) + 8 * jj; const LAS float* s = scr + (8 * c) * 33 + n;
        u32x4 o; o.x = cvt_pk_bf16(s[0 * 33] * g0[0], s[1 * 33] * g0[1]); o.y = cvt_pk_bf16(s[2 * 33] * g0[2], s[3 * 33] * g0[3]); o.z = cvt_pk_bf16(s[4 * 33] * g1[0], s[5 * 33] * g1[1]); o.w = cvt_pk_bf16(s[6 * 33] * g1[2], s[7 * 33] * g1[3]);
        *(u32x4*)(WT + (size_t)(dstn0 + n) * K + k0 + 8 * c) = o;
    }
    LDS_WAIT(); asm volatile("" ::: "memory");
}
__device__ __forceinline__ void p0_tr_matrix(const float* W, int ldw, int K, int Nd, const float* gk, float sc, bf16_t* WT, int perm, int r, LAS float* scr, int lane) {
    const int nblk = Nd / 32, kb = r / nblk, nb = r % nblk, dstn0 = 32 * nb, dn = dstn0 + (lane & 31);
    const int srccol = perm == 0 ? dn : (perm == 1 ? src_even(dn) : src_odd(dn));
    p0_tr_item(W, ldw, 64 * kb, srccol, gk, sc, WT, K, dstn0, scr, lane);
}
__device__ __forceinline__ float p0_row(const float* src, bf16_t* dst, float* copy, int lane) {
    const f32x4* xr = (const f32x4*)src + lane;
    f32x4 v[4]; float s = 0.f;
#pragma unroll
    for (int jj = 0; jj < 4; ++jj) { v[jj] = xr[64 * jj]; s += dot4(v[jj], v[jj]); }
    s = wave_sum(s, lane);
    u32x2* o8 = (u32x2*)dst + lane;
#pragma unroll
    for (int jj = 0; jj < 4; ++jj) o8[64 * jj] = pack4(v[jj]);
    if (copy) {
#pragma unroll
        for (int jj = 0; jj < 4; ++jj) ((f32x4*)copy + lane)[64 * jj] = v[jj];
    }
    return s;
}
__device__ __forceinline__ void p0_prologue(Frame& F0) {
    Frame F = launder(F0);
    LAS float* scr = (LAS float*)(F.lds + F.wave * 16384);
    const int gw = F.bx * NWAVES + F.wave, NGW = F.G * NWAVES, lane = F.lane;
    constexpr int I_AB1 = 16 * (NAB / 32), I_C1 = 16 * (NC / 32), I_2 = 32 * 32, I_SQ = 16 * 32, I_PM = 4 * 8;
    constexpr int NITEMS = 2 * I_AB1 + 2 * I_C1 + 4 * I_2 + 16 * I_SQ + 8 * I_PM;
    for (int it = gw; it < NITEMS; it += NGW) {
        int r = it;
        if (r < 2 * I_AB1) { const int jj = r / I_AB1; p0_tr_matrix(FIN(10) + (size_t)jj * D * NAB, NAB, D, NAB, FIN(7) + 2 * jj * D, 1.f, ((bf16_t*)(F.ws + WS_AB1)) + (size_t)jj * NAB * D, 1, r % I_AB1, scr, lane); continue; } r -= 2 * I_AB1;
        if (r < 2 * I_C1) { const int jj = r / I_C1; p0_tr_matrix(FIN(17) + (size_t)jj * D * NC, NC, D, NC, FIN(7) + (2 * jj + 1) * D, 1.f, ((bf16_t*)(F.ws + WS_C1)) + (size_t)jj * NC * D, 2, r % I_C1, scr, lane); continue; } r -= 2 * I_C1;
        if (r < 2 * I_2) { const int jj = r / I_2; p0_tr_matrix(FIN(16) + (size_t)jj * 2048 * D, D, 2048, D, nullptr, 1.f, ((bf16_t*)(F.ws + WS_AB2)) + (size_t)jj * D * 2048, 0, r % I_2, scr, lane); continue; } r -= 2 * I_2;
        if (r < 2 * I_2) { const int jj = r / I_2; p0_tr_matrix(FIN(19) + (size_t)jj * 2048 * D, D, 2048, D, nullptr, 1.f, ((bf16_t*)(F.ws + WS_C2)) + (size_t)jj * D * 2048, 0, r % I_2, scr, lane); continue; } r -= 2 * I_2;
        if (r < 4 * I_SQ) { const int l = r / I_SQ; p0_tr_matrix(FIN(20) + (size_t)l * D * D, D, D, D, FIN(8) + l * D, QSCALE, ((bf16_t*)(F.ws + WS_WQ)) + (size_t)l * D * D, 0, r % I_SQ, scr, lane); continue; } r -= 4 * I_SQ;
        if (r < 4 * I_SQ) { const int l = r / I_SQ; p0_tr_matrix(FIN(21) + (size_t)l * D * D, D, D, D, FIN(9) + l * D, 1.f, ((bf16_t*)(F.ws + WS_WKV)) + (size_t)(2 * l) * D * D, 0, r % I_SQ, scr, lane); continue; } r -= 4 * I_SQ;
        if (r < 4 * I_SQ) { const int l = r / I_SQ; p0_tr_matrix(FIN(22) + (size_t)l * D * D, D, D, D, FIN(9) + l * D, 1.f, ((bf16_t*)(F.ws + WS_WKV)) + (size_t)(2 * l + 1) * D * D, 0, r % I_SQ, scr, lane); continue; } r -= 4 * I_SQ;
        if (r < 4 * I_SQ) { const int l = r / I_SQ; p0_tr_matrix(FIN(23) + (size_t)l * D * D, D, D, D, nullptr, 1.f, ((bf16_t*)(F.ws + WS_WO)) + (size_t)l * D * D, 0, r % I_SQ, scr, lane); continue; } r -= 4 * I_SQ;
        { const int jg = r / I_PM; p0_tr_matrix(FIN(11) + (size_t)jg * 65536, 256, 256, 256, nullptr, 1.f, ((bf16_t*)(F.ws + WS_PMT)) + (size_t)jg * 65536, 0, r % I_PM, scr, lane); }
    }
    for (int m = gw; m < MP + MS + MMEM; m += NGW) {
        if (m < MP) {
            const float s = p0_row(FIN(0) + (size_t)m * D, ((bf16_t*)(F.ws + WS_XB)) + (size_t)m * D, nullptr, lane);
            if (lane < 16) ((float*)(F.ws + WS_RSQ))[(size_t)m * 16 + lane] = lane == 0 ? s : 0.f;
        } else if (m < MP + MS) {
            const int b = m - MP;
            const float s = p0_row(FIN(1) + (size_t)b * D, ((bf16_t*)(F.ws + WS_XB)) + (size_t)m * D, ((float*)(F.ws + WS_XS)) + (size_t)b * D, lane);
            if (lane < 32) ((float*)(F.ws + WS_SMALL))[b * 32 + lane] = lane == 0 ? s : 0.f;
        } else {
            const int t = m - MP - MS;
            const float s = p0_row(FIN(2) + (size_t)t * D, ((bf16_t*)(F.ws + WS_MEMB)) + (size_t)t * D, nullptr, lane);
            if (lane == 0) ((float*)(F.ws + WS_SMALL + 65536))[t] = rsqrtf(s * (1.0f / D) + EPS);
        }
    }
}

__device__ __forceinline__ bf16x8 tr_frag(LAS unsigned char* p0, LAS unsigned char* p1) {
    const s16x4 lo = __builtin_amdgcn_ds_read_tr16_b64_v4i16((LAS s16x4*)p0);
    const s16x4 hi = __builtin_amdgcn_ds_read_tr16_b64_v4i16((LAS s16x4*)p1);
    return (bf16x8){lo[0], lo[1], lo[2], lo[3], hi[0], hi[1], hi[2], hi[3]};
}
#define MFMA16(a, b, c) __builtin_amdgcn_mfma_f32_16x16x32_bf16((a), (b), (c), 0, 0, 0)

constexpr int SGU_AS = 0, SGU_VS = 34816, SGU_RV = 34816 + 67584;
__device__ __forceinline__ void sgu_chunk(Frame& F0, int j, int n) {
    Frame F = launder(F0);
    LAS unsigned char* lds = F.lds;
    const int tid = F.tid, lane = F.lane, w = F.wave, fr = lane & 15, fq = lane >> 4, row0 = n * 128;
    LAS float* rvs = (LAS float*)(lds + SGU_RV);
    if (tid < 128) rvs[tid] = rstd16(((float*)(F.ws + WS_VSQ)) + (size_t)(row0 + tid) * 16);
    const bf16_t* ZV = ((bf16_t*)(F.ws + WS_Z)) + (size_t)2 * MP * D + (size_t)row0 * D;
    const bf16_t* ZUG = ((bf16_t*)(F.ws + WS_Z)) + (size_t)3 * MP * D + (size_t)row0 * D;
    bf16_t* A2 = ((bf16_t*)(F.ws + WS_A2)) + (size_t)row0 * 2048 + 1024;
    const unsigned voff = (unsigned)(tid >> 5) * (D * 2) + (unsigned)(tid & 31) * 16u;
    const unsigned woff = (unsigned)(tid >> 4) * 512u + (unsigned)(tid & 15) * 32u;
    const int wt_t = tid >> 4, wt_s0 = (tid & 15) * 8;
    const unsigned aoff = (unsigned)(tid >> 5) * 4096u + (unsigned)(tid & 31) * 16u;
    u32x4 vt[8]; f32x4 wt[8];
#define SGU_LOAD(g_) do { const char* vb_ = (const char*)(ZV + (g_) * 256); const char* wb_ = (const char*)(FIN(13) + (size_t)(j * 4 + (g_)) * 16384); \
        _Pragma("unroll") for (int i_ = 0; i_ < 8; ++i_) vt[i_] = *(const u32x4*)(vb_ + (size_t)(16 * i_) * D * 2 + voff); \
        _Pragma("unroll") for (int i_ = 0; i_ < 4; ++i_) { wt[2 * i_] = *(const f32x4*)(wb_ + (size_t)(32 * i_) * 512 + woff); wt[2 * i_ + 1] = *(const f32x4*)(wb_ + (size_t)(32 * i_) * 512 + woff + 16); } } while (0)
    SGU_LOAD(0);
    LDS_BARRIER();
#pragma unroll 1
    for (int g = 0; g < 4; ++g) {
#pragma unroll
        for (int i = 0; i < 8; ++i) *(LAS u32x4*)(lds + SGU_VS + ((tid >> 5) + 16 * i) * 528 + (tid & 31) * 16) = vt[i];
#pragma unroll
        for (int i = 0; i < 4; ++i) {
            const int t = wt_t + 32 * i; float v[8];
#pragma unroll
            for (int e = 0; e < 4; ++e) { v[e] = (wt_s0 + e <= t) ? wt[2 * i][e] * rvs[wt_s0 + e] : 0.f; v[4 + e] = (wt_s0 + 4 + e <= t) ? wt[2 * i + 1][e] * rvs[wt_s0 + 4 + e] : 0.f; }
            u32x4 o; o.x = cvt_pk_bf16(v[0], v[1]); o.y = cvt_pk_bf16(v[2], v[3]); o.z = cvt_pk_bf16(v[4], v[5]); o.w = cvt_pk_bf16(v[6], v[7]);
            *(LAS u32x4*)(lds + SGU_AS + t * 272 + wt_s0 * 2) = o;
        }
        LDS_BARRIER();
        if (g < 3) SGU_LOAD(g + 1);
        const int cg = g * 256 + 32 * w + 4 * fq;
        const unsigned lo_in = (unsigned)fr * (D * 2) + (unsigned)(32 * w + 4 * fq) * 2u, lo_out = (unsigned)fr * 4096u + (unsigned)(32 * w + 4 * fq) * 2u;
        u32x2 ugr[2][8];
#pragma unroll
        for (int nt = 0; nt < 2; ++nt)
#pragma unroll
            for (int mt = 0; mt < 8; ++mt) ugr[nt][mt] = *(const u32x2*)((const char*)(ZUG + (size_t)(16 * mt) * D + g * 256 + 16 * nt) + lo_in);
        f32x4 acc[8][2];
#pragma unroll
        for (int mt = 0; mt < 8; ++mt) { acc[mt][0] = (f32x4){0.f, 0.f, 0.f, 0.f}; acc[mt][1] = (f32x4){0.f, 0.f, 0.f, 0.f}; }
#pragma unroll
        for (int ks = 0; ks < 4; ++ks) {
            bf16x8 Bf[2];
#pragma unroll
            for (int nt = 0; nt < 2; ++nt) {
                LAS unsigned char* p = lds + SGU_VS + (32 * ks + 8 * fq + (fr >> 2)) * 528 + (32 * w + 16 * nt + 4 * (fr & 3)) * 2;
                Bf[nt] = tr_frag(p, p + 4 * 528);
            }
#pragma unroll
            for (int mt = 0; mt < 8; ++mt) {
                if (32 * ks <= 16 * mt + 15) {
                    const bf16x8 Af = *(LAS bf16x8*)(lds + SGU_AS + (16 * mt + fr) * 272 + (32 * ks + 8 * fq) * 2);
                    acc[mt][0] = MFMA16(Bf[0], Af, acc[mt][0]); acc[mt][1] = MFMA16(Bf[1], Af, acc[mt][1]);
                }
            }
        }
#pragma unroll
        for (int nt = 0; nt < 2; ++nt) {
            const int c = cg + 16 * nt;
            const f32x4 gg = *(const f32x4*)(FIN(15) + j * 1024 + c);
#pragma unroll
            for (int mt = 0; mt < 8; ++mt) {
                const int t = 16 * mt + fr;
                const float bb = FIN(14)[(j * 4 + g) * 128 + t];
                *(u32x2*)((char*)(A2 + (size_t)(16 * mt) * 2048 + g * 256 + 16 * nt) + lo_out) = pack4(unpack4(ugr[nt][mt]) * (acc[mt][nt] * gg + bb));
            }
        }
        LDS_BARRIER();
    }
#undef SGU_LOAD
}
template <int WIN> __device__ __forceinline__ void pool_load(const bf16_t* xau  , unsigned lo  , int pos0, u32x4 (&xr)[WIN + 7]) {
#pragma unroll
    for (int i = 0; i < WIN + 7; ++i) { const int rr = i - (WIN - 1); xr[i] = (u32x4){0u, 0u, 0u, 0u}; if (pos0 + rr >= 0) xr[i] = *(const u32x4*)((const char*)(xau + (ptrdiff_t)rr * D) + lo); }
}
template <int WIN> __device__ __forceinline__ void pool_build(const u32x4 (&xr)[WIN + 7], int pos0, LAS unsigned char* dst  ) {
    f32x4 S0 = (f32x4){0.f, 0.f, 0.f, 0.f}, S1 = S0;
#pragma unroll
    for (int i = 0; i < WIN - 1; ++i) { f32x4 a, b; unpack8(xr[i], a, b); S0 += a; S1 += b; }
#pragma unroll
    for (int r = 0; r < 8; ++r) {
        f32x4 a, b; unpack8(xr[WIN - 1 + r], a, b); S0 += a; S1 += b;
        const int cnt = (pos0 + r + 1) < WIN ? (pos0 + r + 1) : WIN; const float ic = 1.0f / (float)cnt;
        *(LAS u32x4*)(dst + r * 528) = pack8(S0 * ic - a, S1 * ic - b);
        f32x4 c, d; unpack8(xr[r], c, d); S0 -= c; S1 -= d;
    }
}
__device__ __forceinline__ void pool_mma_epi(Frame& F, int j, int g, int row0, const bf16_t* ZSGA, bf16_t* A2, LAS unsigned char* lds, int w, int fr, int fq) {
    const int cg = g * 256 + 32 * w + 4 * fq;
    const unsigned lo_in = (unsigned)fr * (D * 2) + (unsigned)(32 * w + 4 * fq) * 2u, lo_out = (unsigned)fr * 4096u + (unsigned)(32 * w + 4 * fq) * 2u, lo_pm = (unsigned)(32 * w + fr) * 512u + (unsigned)fq * 16u;
    u32x2 sgr[2][8];
#pragma unroll
    for (int nt = 0; nt < 2; ++nt)
#pragma unroll
        for (int mt = 0; mt < 8; ++mt) sgr[nt][mt] = *(const u32x2*)((const char*)(ZSGA + (size_t)(16 * mt) * D + g * 256 + 16 * nt) + lo_in);
    f32x4 acc[8][2];
#pragma unroll
    for (int mt = 0; mt < 8; ++mt) { acc[mt][0] = (f32x4){0.f, 0.f, 0.f, 0.f}; acc[mt][1] = (f32x4){0.f, 0.f, 0.f, 0.f}; }
    const bf16_t* pm = ((bf16_t*)(F.ws + WS_PMT)) + (size_t)(j * 4 + g) * 65536;
#pragma unroll
    for (int ks = 0; ks < 8; ++ks) {
        const bf16x8 B0 = *(const bf16x8*)((const char*)(pm + 32 * ks) + lo_pm), B1 = *(const bf16x8*)((const char*)(pm + 16 * 256 + 32 * ks) + lo_pm);
#pragma unroll
        for (int mt = 0; mt < 8; ++mt) {
            const bf16x8 Af = *(LAS bf16x8*)(lds + (16 * mt + fr) * 528 + (32 * ks + 8 * fq) * 2);
            acc[mt][0] = MFMA16(B0, Af, acc[mt][0]); acc[mt][1] = MFMA16(B1, Af, acc[mt][1]);
        }
    }
#pragma unroll
    for (int nt = 0; nt < 2; ++nt) {
        const int c = cg + 16 * nt;
        const f32x4 ps = *(const f32x4*)(FIN(12) + j * 1024 + c);
#pragma unroll
        for (int mt = 0; mt < 8; ++mt) *(u32x2*)((char*)(A2 + (size_t)(16 * mt) * 2048 + g * 256 + 16 * nt) + lo_out) = pack4(acc[mt][nt] * ps * unpack4(sgr[nt][mt]));
    }
}
__device__ __forceinline__ void pool_chunk(Frame& F0, int j, int n) {
    Frame F = launder(F0);
    LAS unsigned char* lds = F.lds;
    const int tid = F.tid, lane = F.lane, w = F.wave, fr = lane & 15, fq = lane >> 4, row0 = n * 128;
    const int cb = tid & 31, t0 = (tid >> 5) * 8, pos0 = (row0 & 2047) + t0;
    const bf16_t* xa = ((bf16_t*)(F.ws + WS_Z)) + (size_t)row0 * D; const unsigned xlo = (unsigned)(t0 * D + cb * 8) * 2u;
    const bf16_t* ZSGA = ((bf16_t*)(F.ws + WS_Z)) + (size_t)1 * MP * D + (size_t)row0 * D;
    bf16_t* A2 = ((bf16_t*)(F.ws + WS_A2)) + (size_t)row0 * 2048;
    LAS unsigned char* dst = lds + t0 * 528 + cb * 16;
    u32x4 x0[2 + 7]; pool_load<2>(xa, xlo, pos0, x0);
    pool_build<2>(x0, pos0, dst); LDS_BARRIER();
    u32x4 x1[4 + 7]; pool_load<4>(xa + 256, xlo, pos0, x1);
    pool_mma_epi(F, j, 0, row0, ZSGA, A2, lds, w, fr, fq); LDS_BARRIER();
    pool_build<4>(x1, pos0, dst); LDS_BARRIER();
    u32x4 x2[8 + 7]; pool_load<8>(xa + 512, xlo, pos0, x2);
    pool_mma_epi(F, j, 1, row0, ZSGA, A2, lds, w, fr, fq); LDS_BARRIER();
    pool_build<8>(x2, pos0, dst); LDS_BARRIER();
    pool_mma_epi(F, j, 2, row0, ZSGA, A2, lds, w, fr, fq); LDS_BARRIER();
    u32x4 x3[16 + 7]; pool_load<16>(xa + 768, xlo, pos0, x3);
    pool_build<16>(x3, pos0, dst); LDS_BARRIER();
    pool_mma_epi(F, j, 3, row0, ZSGA, A2, lds, w, fr, fq); LDS_BARRIER();
}
constexpr int ATT_SLOT = 64 * 528;
__device__ __forceinline__ void attn_prompt(Frame& F0, int layer) {
    Frame F = launder(F0);
    LAS unsigned char* lds = F.lds;
    const int tid = F.tid, lane = F.lane, w = F.wave, fr = lane & 15, fq = lane >> 4;
    const bf16_t* Kl = ((bf16_t*)(F.ws + WS_KB)) + (size_t)layer * MMEM * D; const bf16_t* Vl = ((bf16_t*)(F.ws + WS_VB)) + (size_t)layer * MMEM * D;
    for (int unit = F.bx; unit < 512; unit += F.G) {
        const int bh = unit >> 4, b = bh >> 2, h = bh & 3, qb = unit & 15;
        const size_t rowq = (size_t)b * SEQ + qb * 128 + 16 * w + fr;
        bf16x8 Qf[8];
#pragma unroll
        for (int ks = 0; ks < 8; ++ks) Qf[ks] = *(const bf16x8*)(((bf16_t*)(F.ws + WS_Q)) + rowq * D + h * 256 + 32 * ks + 8 * fq);
        const bf16_t* kbase = Kl + (size_t)(b * 256) * D + h * 256; const bf16_t* vbase = Vl + (size_t)(b * 256) * D + h * 256;
        u32x4 st[4];
#define ATT_GLOAD(c) do { const bf16_t* src_ = ((c) < 4 ? kbase : vbase) + (size_t)(64 * ((c) & 3)) * D; _Pragma("unroll") for (int i_ = 0; i_ < 4; ++i_) { const int idx_ = tid + 512 * i_; st[i_] = *(const u32x4*)(src_ + (size_t)(idx_ >> 5) * D + (idx_ & 31) * 8); } } while (0)
#define ATT_LSTORE(slot) do { _Pragma("unroll") for (int i_ = 0; i_ < 4; ++i_) { const int idx_ = tid + 512 * i_; *(LAS u32x4*)(lds + (slot) * ATT_SLOT + (idx_ >> 5) * 528 + (idx_ & 31) * 16) = st[i_]; } } while (0)
        f32x4 S[16], Oa[16]; bf16x8 Pf[8]; float inv = 0.f;
#pragma unroll
        for (int i = 0; i < 16; ++i) { S[i] = (f32x4){0.f, 0.f, 0.f, 0.f}; Oa[i] = (f32x4){0.f, 0.f, 0.f, 0.f}; }
        ATT_GLOAD(0); ATT_LSTORE(0); __syncthreads();
#pragma unroll
        for (int c = 0; c < 8; ++c) {
            if (c < 7) ATT_GLOAD(c + 1);
            LAS unsigned char* slot = lds + (c & 1) * ATT_SLOT;
            if (c < 4) {
#pragma unroll
                for (int ml = 0; ml < 4; ++ml)
#pragma unroll
                    for (int ks = 0; ks < 8; ++ks) {
                        const bf16x8 Kf = *(LAS bf16x8*)(slot + (16 * ml + fr) * 528 + (32 * ks + 8 * fq) * 2);
                        S[4 * c + ml] = MFMA16(Kf, Qf[ks], S[4 * c + ml]);
                    }
                if (c == 3) {
                    float mx = S[0][0];
#pragma unroll
                    for (int i = 0; i < 16; ++i) { mx = fmaxf(mx, fmaxf(fmaxf(S[i][0], S[i][1]), fmaxf(S[i][2], S[i][3]))); }
                    mx = fmaxf(mx, shx(mx, 16, lane)); mx = fmaxf(mx, shx(mx, 32, lane));
                    float sum = 0.f;
#pragma unroll
                    for (int i = 0; i < 16; ++i) {
#pragma unroll
                        for (int e = 0; e < 4; ++e) { S[i][e] = __builtin_amdgcn_exp2f(S[i][e] - mx); sum += S[i][e]; }
                    }
                    sum += shx(sum, 16, lane); sum += shx(sum, 32, lane);
                    inv = 1.0f / sum;
#pragma unroll
                    for (int a = 0; a < 8; ++a) {
                        u32x4 pw; pw.x = cvt_pk_bf16(S[2 * a][0], S[2 * a][1]); pw.y = cvt_pk_bf16(S[2 * a][2], S[2 * a][3]); pw.z = cvt_pk_bf16(S[2 * a + 1][0], S[2 * a + 1][1]); pw.w = cvt_pk_bf16(S[2 * a + 1][2], S[2 * a + 1][3]);
                        Pf[a] = __builtin_bit_cast(bf16x8, pw);
                    }
                }
            } else {
#pragma unroll
                for (int al = 0; al < 2; ++al)
#pragma unroll
                    for (int dt = 0; dt < 16; ++dt) {
                        LAS unsigned char* p = slot + (32 * al + 4 * fq + (fr >> 2)) * 528 + (16 * dt + 4 * (fr & 3)) * 2;
                        const bf16x8 Vf = tr_frag(p, p + 16 * 528);
                        Oa[dt] = MFMA16(Vf, Pf[2 * (c - 4) + al], Oa[dt]);
                    }
            }
            if (c < 7) ATT_LSTORE((c + 1) & 1);
            __syncthreads();
        }
#pragma unroll
        for (int dt = 0; dt < 16; ++dt) *(u32x2*)(((bf16_t*)(F.ws + WS_O)) + rowq * D + h * 256 + 16 * dt + 4 * fq) = pack4(Oa[dt] * inv);
#undef ATT_GLOAD
#undef ATT_LSTORE
    }
}

template <class Epi>
__device__ __forceinline__ void skinny_gemm(Frame& F0, const bf16_t* A, const bf16_t* Bt, int N, int K, const Epi& E) {
    Frame F = launder(F0);
    LAS unsigned char* lds = F.lds;
    const int tid = F.tid, lane = F.lane, w = F.wave, fr = lane & 15, fq = lane >> 4;
    const int nstrips = N / 32, kslice = K / 8, nks = kslice / 32;
    for (int strip = F.bx; strip < nstrips; strip += F.G) {
        f32x4 acc[8][2];
#pragma unroll
        for (int mt = 0; mt < 8; ++mt) { acc[mt][0] = (f32x4){0.f, 0.f, 0.f, 0.f}; acc[mt][1] = (f32x4){0.f, 0.f, 0.f, 0.f}; }
        const bf16_t* ap = A + (size_t)fr * K + w * kslice + 8 * fq; const bf16_t* bp = Bt + (size_t)(strip * 32 + fr) * K + w * kslice + 8 * fq;
        for (int kb = 0; kb < nks; kb += 4) {
            bf16x8 Bf[4][2], Af[4][8];
#pragma unroll
            for (int k4 = 0; k4 < 4; ++k4) {
                Bf[k4][0] = *(const bf16x8*)(bp + 32 * (kb + k4)); Bf[k4][1] = *(const bf16x8*)(bp + (size_t)16 * K + 32 * (kb + k4));
#pragma unroll
                for (int mt = 0; mt < 8; ++mt) Af[k4][mt] = *(const bf16x8*)(ap + (size_t)(16 * mt) * K + 32 * (kb + k4));
            }
#pragma unroll
            for (int k4 = 0; k4 < 4; ++k4)
#pragma unroll
                for (int mt = 0; mt < 8; ++mt) { acc[mt][0] = MFMA16(Bf[k4][0], Af[k4][mt], acc[mt][0]); acc[mt][1] = MFMA16(Bf[k4][1], Af[k4][mt], acc[mt][1]); }
        }
#pragma unroll
        for (int mt = 0; mt < 8; ++mt)
#pragma unroll
            for (int nt = 0; nt < 2; ++nt) *(LAS f32x4*)(lds + ((size_t)((w * 128 + 16 * mt + fr) * 32 + 16 * nt + 4 * fq)) * 4) = acc[mt][nt];
        __syncthreads();
        const int row = tid >> 2, cq = tid & 3;
        f32x4 s0 = (f32x4){0.f, 0.f, 0.f, 0.f}, s1 = s0;
#pragma unroll
        for (int ww = 0; ww < 8; ++ww) { const LAS f32x4* p = (const LAS f32x4*)(lds + ((size_t)((ww * 128 + row) * 32 + 8 * cq)) * 4); s0 += p[0]; s1 += p[1]; }
        E(row, strip, strip * 32 + 8 * cq, s0, s1);
        __syncthreads();
    }
}
struct SEpiZ {
    const float* rsqs; float* SZ; int ldz, mode;
    __device__ __forceinline__ void operator()(int row, int strip, int col, f32x4 s0, f32x4 s1) const {
        const float rs = rstd32(rsqs + row * 32); const int oc0 = mode == 0 ? src_even(col) : src_odd(col), oc1 = mode == 0 ? src_even(col + 4) : src_odd(col + 4);
        float* p = SZ + (size_t)row * ldz; *(f32x4*)(p + oc0) = s0 * rs; *(f32x4*)(p + oc1) = s1 * rs;
    }
};
struct SEpiRes {
    float* xs; bf16_t* xb; float* rsqs;
    __device__ __forceinline__ void operator()(int row, int strip, int col, f32x4 s0, f32x4 s1) const {
        float* p = xs + (size_t)row * D + col; const f32x4 o0 = *(const f32x4*)p + s0, o1 = *(const f32x4*)(p + 4) + s1;
        *(f32x4*)p = o0; *(f32x4*)(p + 4) = o1; *(u32x4*)(xb + (size_t)row * D + col) = pack8(o0, o1);
        const int ln = ((row & 15) << 2) | ((col >> 3) & 3);
        float ss = dot4(o0, o0) + dot4(o1, o1); ss += shx(ss, 1, ln); ss += shx(ss, 2, ln);
        if ((col & 31) == 0) rsqs[row * 32 + strip] = ss;
    }
};
struct SEpiQ {
    const float* rsqs; float* SQ;
    __device__ __forceinline__ void operator()(int row, int strip, int col, f32x4 s0, f32x4 s1) const {
        const float rs = rstd32(rsqs + row * 32); float* p = SQ + (size_t)row * D + col; *(f32x4*)p = s0 * rs; *(f32x4*)(p + 4) = s1 * rs;
    }
};
__device__ __forceinline__ void sample_mix_even(Frame& F0, int j, int b) {
    Frame F = launder(F0);
    LAS float* pl = (LAS float*)F.lds; LAS float* red = pl + 1024;
    const int tid = F.tid, lane = F.lane, w = F.wave;
    const float* z = ((float*)(F.ws + WS_SZ)) + (size_t)b * 8192;
    float vv[2], ss = 0.f;
#pragma unroll
    for (int k = 0; k < 2; ++k) { vv[k] = z[3072 + tid + 512 * k]; ss += vv[k] * vv[k]; }
    ss = wave_sum(ss, lane); if (lane == 0) red[w] = ss;
#pragma unroll
    for (int k = 0; k < 2; ++k) {
        const int c = tid + 512 * k, g = c >> 8, win = 2 << g; const float xa = z[c];
        const float* st = FIN(3) + ((size_t)(j * 128 + b) * 15) * 1024 + c;
        float s = xa; for (int r = 16 - win; r < 15; ++r) s += st[(size_t)r * 1024];
        pl[c] = s / (float)win - xa;
        float* po = F.out + O_POOLS + ((size_t)(j * 128 + b) * 15) * 1024 + c;
        for (int r = 0; r < 14; ++r) po[(size_t)r * 1024] = st[(size_t)(r + 1) * 1024];
        po[(size_t)14 * 1024] = xa;
    }
    __syncthreads();
    float tot = 0.f;
#pragma unroll
    for (int i = 0; i < 8; ++i) tot += red[i];
    const float rv = rsqrtf(tot * (1.0f / D) + EPS);
#pragma unroll
    for (int k = 0; k < 2; ++k) {
        const int d = tid + 512 * k, g = d >> 8, dd = d & 255;
        const bf16_t* pm = ((bf16_t*)(F.ws + WS_PMT)) + (size_t)(j * 4 + g) * 65536 + (size_t)dd * 256; const LAS float* pg = pl + g * 256;
        float a = 0.f;
#pragma unroll
        for (int hb = 0; hb < 2; ++hb) {
            u32x4 pr[16];
#pragma unroll
            for (int i = 0; i < 16; ++i) pr[i] = *(const u32x4*)(pm + hb * 128 + i * 8);
#pragma unroll
            for (int i = 0; i < 16; ++i) { f32x4 p0, p1; unpack8(pr[i], p0, p1); const LAS float* q = pg + hb * 128 + i * 8; a += dot4(p0, *(const LAS f32x4*)q) + dot4(p1, *(const LAS f32x4*)(q + 4)); }
        }
        const float ya = a * FIN(12)[j * 1024 + d] * silu_f(z[1024 + d]);
        const float vn = vv[k] * rv * FIN(15)[j * 1024 + d];
        F.out[O_SGUV + (size_t)(j * 128 + b) * 1024 + d] = vn;
        const float mixed = FIN(13)[(size_t)(j * 4 + g) * 16384] * vn + FIN(14)[(j * 4 + g) * 128];
        const float yb = z[2048 + d] * mixed * silu_f(z[4096 + d]);
        ((bf16_t*)(F.ws + WS_SA2))[(size_t)b * 2048 + d] = (bf16_t)(cvt_pk_bf16(ya, 0.f) & 0xffffu); ((bf16_t*)(F.ws + WS_SA2))[(size_t)b * 2048 + 1024 + d] = (bf16_t)(cvt_pk_bf16(yb, 0.f) & 0xffffu);
    }
    __syncthreads();
}
__device__ __forceinline__ void sample_conv_odd(Frame& F0, int j, int b) {
    Frame F = launder(F0);
    const int tid = F.tid;
    const float* z = ((float*)(F.ws + WS_SZ)) + (size_t)b * 8192;
    const float* cw = FIN(18) + (size_t)j * 3 * 2048;
#pragma unroll
    for (int k = 0; k < 4; ++k) {
        const int c = tid + 512 * k;
        const float e = z[2048 + c] * z[4096 + c];
        const float s0 = FIN(4)[((size_t)(j * 128 + b) * 2 + 0) * 2048 + c], s1 = FIN(4)[((size_t)(j * 128 + b) * 2 + 1) * 2048 + c];
        const float y = cw[c] * s0 + cw[2048 + c] * s1 + cw[4096 + c] * e;
        ((bf16_t*)(F.ws + WS_SA2))[(size_t)b * 2048 + c] = (bf16_t)(cvt_pk_bf16(z[c] * y * silu_f(z[6144 + c]), 0.f) & 0xffffu);
        float* po = F.out + O_CONVS + ((size_t)(j * 128 + b) * 2) * 2048 + c; po[0] = s1; po[2048] = e;
    }
}
__device__ __forceinline__ void attn_sample(Frame& F0, int layer) {
    Frame F = launder(F0);
    LAS float* sc = (LAS float*)F.lds;
    LAS float* red = sc + 512;
    const int tid = F.tid, lane = F.lane, w = F.wave;
    for (int item = F.bx; item < 256; item += F.G) {
        const int b = item >> 1, hp = item & 1;
        const float* qp = ((float*)(F.ws + WS_SQ)) + (size_t)b * D + hp * 512;
        const f32x4 q0 = *(const f32x4*)(qp + 4 * lane), q1 = *(const f32x4*)(qp + 256 + 4 * lane);
        const float* kp = FIN(5) + ((size_t)(layer * 128 + b) * 256) * 1024 + hp * 512 + 4 * lane;
        const float* vp = FIN(6) + ((size_t)(layer * 128 + b) * 256) * 1024 + hp * 512 + 4 * lane;
#pragma unroll 8
        for (int mi = 0; mi < 32; ++mi) {
            const int m = 32 * w + mi;
            const f32x4 k0 = __builtin_nontemporal_load((const f32x4*)(kp + (size_t)m * 1024)), k1 = __builtin_nontemporal_load((const f32x4*)(kp + (size_t)m * 1024 + 256));
            const float d0 = wave_sum(dot4(k0, q0), lane), d1 = wave_sum(dot4(k1, q1), lane);
            if (lane == 0) { sc[m] = d0; sc[256 + m] = d1; }
        }
        __syncthreads();
        float p0[4], p1[4], mx0 = -INFINITY, mx1 = -INFINITY;
#pragma unroll
        for (int i = 0; i < 4; ++i) { p0[i] = sc[lane + 64 * i]; p1[i] = sc[256 + lane + 64 * i]; mx0 = fmaxf(mx0, p0[i]); mx1 = fmaxf(mx1, p1[i]); }
#pragma unroll
        for (int o = 1; o < 64; o <<= 1) { mx0 = fmaxf(mx0, shx(mx0, o, lane)); mx1 = fmaxf(mx1, shx(mx1, o, lane)); }
        float sm0 = 0.f, sm1 = 0.f;
#pragma unroll
        for (int i = 0; i < 4; ++i) { p0[i] = __builtin_amdgcn_exp2f(p0[i] - mx0); p1[i] = __builtin_amdgcn_exp2f(p1[i] - mx1); sm0 += p0[i]; sm1 += p1[i]; }
        sm0 = wave_sum(sm0, lane); sm1 = wave_sum(sm1, lane);
        const float i0 = 1.0f / sm0, i1 = 1.0f / sm1;
        __syncthreads();
        if (w == 0) {
#pragma unroll
            for (int i = 0; i < 4; ++i) { sc[lane + 64 * i] = p0[i] * i0; sc[256 + lane + 64 * i] = p1[i] * i1; }
        }
        __syncthreads();
        f32x4 a0 = (f32x4){0.f, 0.f, 0.f, 0.f}, a1 = a0;
#pragma unroll 8
        for (int mi = 0; mi < 32; ++mi) {
            const int m = 32 * w + mi;
            const f32x4 v0 = __builtin_nontemporal_load((const f32x4*)(vp + (size_t)m * 1024)), v1 = __builtin_nontemporal_load((const f32x4*)(vp + (size_t)m * 1024 + 256));
            a0 += v0 * sc[m]; a1 += v1 * sc[256 + m];
        }
        *(LAS f32x4*)(red + w * 512 + 4 * lane) = a0; *(LAS f32x4*)(red + w * 512 + 256 + 4 * lane) = a1;
        __syncthreads();
        {
            float o = 0.f;
#pragma unroll
            for (int ww = 0; ww < 8; ++ww) o += red[ww * 512 + tid];
            ((bf16_t*)(F.ws + WS_SO))[(size_t)b * D + hp * 512 + tid] = (bf16_t)(cvt_pk_bf16(o, 0.f) & 0xffffu);
        }
        __syncthreads();
    }
}
#define dpp_mov(v, ctrl, row_mask) __builtin_bit_cast(float, __builtin_amdgcn_update_dpp(0, __builtin_bit_cast(int, (float)(v)), (ctrl), (row_mask), 0xf, false))
__device__ __forceinline__ float wave_sum_dpp(float x) {
    x += dpp_mov(x, 0xB1, 0xf);
    x += dpp_mov(x, 0x4E, 0xf);
    x += dpp_mov(x, 0x141, 0xf);
    x += dpp_mov(x, 0x140, 0xf);
    x += dpp_mov(x, 0x142, 0xa);
    x += dpp_mov(x, 0x143, 0xc);
    return x;
}
constexpr int FA_SC = 69632, FA_RED = 71680;
__device__ __forceinline__ void attn_fused(Frame& F0, int layer) {
    Frame F = launder(F0);
    LAS unsigned char* lds = F.lds;
    const int tid = F.tid, lane = F.lane, w = F.wave, fr = lane & 15, fq = lane >> 4;
    const bf16_t* Kl = ((bf16_t*)(F.ws + WS_KB)) + (size_t)layer * MMEM * D; const bf16_t* Vl = ((bf16_t*)(F.ws + WS_VB)) + (size_t)layer * MMEM * D;
    LAS float* sc = (LAS float*)(lds + FA_SC); LAS float* red = (LAS float*)(lds + FA_RED);
    const int sb = F.bx >> 1, hp = F.bx & 1;
    const float* qp = ((float*)(F.ws + WS_SQ)) + (size_t)sb * D + hp * 512;
    const f32x4 q0 = *(const f32x4*)(qp + 4 * lane), q1 = *(const f32x4*)(qp + 256 + 4 * lane);
    const float* kp = FIN(5) + ((size_t)(layer * 128 + sb) * 256 + 4 * w) * 1024 + hp * 512;
    const float* vp = FIN(6) + ((size_t)(layer * 128 + sb) * 256 + 4 * w) * 1024 + hp * 512;
    const unsigned lo16 = (unsigned)lane * 16u;
    f32x4 sv[8]; f32x4 a0 = (f32x4){0.f, 0.f, 0.f, 0.f}, a1 = a0; float mx0 = 0.f, mx1 = 0.f, iv0 = 0.f, iv1 = 0.f;
#define FA_SLOAD(base, slice) do { unsigned long long pu_ = uni64((unsigned long long)((base) + (size_t)(32 * (slice)) * 1024)); asm volatile("" : "+s"(pu_)); const char* pc_ = (const char*)(const GAS char*)pu_; \
        _Pragma("unroll") for (int r_ = 0; r_ < 4; ++r_) { sv[2 * r_] = __builtin_nontemporal_load((const f32x4*)(pc_ + r_ * 4096 + lo16)); sv[2 * r_ + 1] = __builtin_nontemporal_load((const f32x4*)(pc_ + r_ * 4096 + 1024 + lo16)); } } while (0)
    FA_SLOAD(kp, 0);
#pragma unroll 1
    for (int ui = 0; ui < 2; ++ui) {
        const int unit = F.bx + 256 * ui;
        const int bh = unit >> 4, b = bh >> 2, h = bh & 3, qb = unit & 15;
        const size_t rowq = (size_t)b * SEQ + qb * 128 + 16 * w + fr;
        bf16x8 Qf[8];
#pragma unroll
        for (int ks = 0; ks < 8; ++ks) Qf[ks] = *(const bf16x8*)(((bf16_t*)(F.ws + WS_Q)) + rowq * D + h * 256 + 32 * ks + 8 * fq);
        const bf16_t* kbase = Kl + (size_t)(b * 256) * D + h * 256; const bf16_t* vbase = Vl + (size_t)(b * 256) * D + h * 256;
        u32x4 st[4];
        const unsigned goff = (unsigned)(tid >> 5) * (D * 2) + (unsigned)(tid & 31) * 16u, loff = (unsigned)(tid >> 5) * 528u + (unsigned)(tid & 31) * 16u;
#define ATT_GLOAD(c) do { unsigned long long pu_ = uni64((unsigned long long)(((c) < 4 ? kbase : vbase) + (size_t)(64 * ((c) & 3)) * D)); asm volatile("" : "+s"(pu_)); const char* pc_ = (const char*)(const GAS char*)pu_; \
        _Pragma("unroll") for (int i_ = 0; i_ < 4; ++i_) st[i_] = *(const u32x4*)(pc_ + (size_t)(16 * i_) * D * 2 + goff); } while (0)
#define ATT_LSTORE(slot) do { _Pragma("unroll") for (int i_ = 0; i_ < 4; ++i_) *(LAS u32x4*)(lds + (slot) * ATT_SLOT + 16 * i_ * 528 + loff) = st[i_]; } while (0)
        f32x4 S[16], Oa[16]; bf16x8 Pf[8]; float inv = 0.f;
        const f32x4 zero4 = (f32x4){0.f, 0.f, 0.f, 0.f};
        if (ui == 1) {
            float p0[4], p1[4]; mx0 = -INFINITY; mx1 = -INFINITY;
#pragma unroll
            for (int i = 0; i < 4; ++i) { p0[i] = sc[lane + 64 * i]; p1[i] = sc[256 + lane + 64 * i]; mx0 = fmaxf(mx0, p0[i]); mx1 = fmaxf(mx1, p1[i]); }
#pragma unroll
            for (int o = 1; o < 64; o <<= 1) { mx0 = fmaxf(mx0, shx(mx0, o, lane)); mx1 = fmaxf(mx1, shx(mx1, o, lane)); }
            float sm0 = 0.f, sm1 = 0.f;
#pragma unroll
            for (int i = 0; i < 4; ++i) { sm0 += __builtin_amdgcn_exp2f(p0[i] - mx0); sm1 += __builtin_amdgcn_exp2f(p1[i] - mx1); }
            sm0 = wave_sum(sm0, lane); sm1 = wave_sum(sm1, lane);
            iv0 = 1.0f / sm0; iv1 = 1.0f / sm1;
        }
        ATT_GLOAD(0); ATT_LSTORE(0); __syncthreads();
#pragma unroll
        for (int c = 0; c < 8; ++c) {
            if (c < 7) ATT_GLOAD(c + 1);
            if (ui == 0) {
#pragma unroll
                for (int r = 0; r < 4; ++r) {
                    const int m = 32 * c + 4 * w + r;
                    const float d0 = wave_sum_dpp(dot4(sv[2 * r], q0)), d1 = wave_sum_dpp(dot4(sv[2 * r + 1], q1));
                    if (lane == 63) { sc[m] = d0; sc[256 + m] = d1; }
                }
                if (c < 7) FA_SLOAD(kp, c + 1); else FA_SLOAD(vp, 0);
            } else {
#pragma unroll
                for (int r = 0; r < 4; ++r) {
                    const int m = 32 * c + 4 * w + r;
                    const float p0 = __builtin_amdgcn_exp2f(sc[m] - mx0) * iv0, p1 = __builtin_amdgcn_exp2f(sc[256 + m] - mx1) * iv1;
                    a0 += sv[2 * r] * p0; a1 += sv[2 * r + 1] * p1;
                }
                if (c < 7) FA_SLOAD(vp, c + 1);
            }
            LAS unsigned char* slot = lds + (c & 1) * ATT_SLOT;
            if (c < 4) {
#pragma unroll
                for (int ml = 0; ml < 4; ++ml)
#pragma unroll
                    for (int ks = 0; ks < 8; ++ks) {
                        const bf16x8 Kf = *(LAS bf16x8*)(slot + (16 * ml + fr) * 528 + (32 * ks + 8 * fq) * 2);
                        S[4 * c + ml] = MFMA16(Kf, Qf[ks], ks == 0 ? zero4 : S[4 * c + ml]);
                    }
                if (c == 3) {
                    float mx = S[0][0];
#pragma unroll
                    for (int i = 0; i < 16; ++i) { mx = fmaxf(mx, fmaxf(fmaxf(S[i][0], S[i][1]), fmaxf(S[i][2], S[i][3]))); }
                    mx = fmaxf(mx, shx(mx, 16, lane)); mx = fmaxf(mx, shx(mx, 32, lane));
                    float sum = 0.f;
#pragma unroll
                    for (int i = 0; i < 16; ++i) {
#pragma unroll
                        for (int e = 0; e < 4; ++e) { S[i][e] = __builtin_amdgcn_exp2f(S[i][e] - mx); sum += S[i][e]; }
                    }
                    sum += shx(sum, 16, lane); sum += shx(sum, 32, lane);
                    inv = 1.0f / sum;
#pragma unroll
                    for (int a = 0; a < 8; ++a) {
                        u32x4 pw; pw.x = cvt_pk_bf16(S[2 * a][0], S[2 * a][1]); pw.y = cvt_pk_bf16(S[2 * a][2], S[2 * a][3]); pw.z = cvt_pk_bf16(S[2 * a + 1][0], S[2 * a + 1][1]); pw.w = cvt_pk_bf16(S[2 * a + 1][2], S[2 * a + 1][3]);
                        Pf[a] = __builtin_bit_cast(bf16x8, pw);
                    }
                }
            } else {
#pragma unroll
                for (int al = 0; al < 2; ++al)
#pragma unroll
                    for (int dt = 0; dt < 16; ++dt) {
                        LAS unsigned char* p = slot + (32 * al + 4 * fq + (fr >> 2)) * 528 + (16 * dt + 4 * (fr & 3)) * 2;
                        const bf16x8 Vf = tr_frag(p, p + 16 * 528);
                        Oa[dt] = MFMA16(Vf, Pf[2 * (c - 4) + al], (c == 4 && al == 0) ? zero4 : Oa[dt]);
                    }
            }
            if (c < 7) ATT_LSTORE((c + 1) & 1);
            __syncthreads();
        }
#pragma unroll
        for (int dt = 0; dt < 16; ++dt) *(u32x2*)(((bf16_t*)(F.ws + WS_O)) + rowq * D + h * 256 + 16 * dt + 4 * fq) = pack4(Oa[dt] * inv);
#undef ATT_GLOAD
#undef ATT_LSTORE
    }
#undef FA_SLOAD
    *(LAS f32x4*)(red + w * 512 + 4 * lane) = a0; *(LAS f32x4*)(red + w * 512 + 256 + 4 * lane) = a1;
    __syncthreads();
    {
        float o = 0.f;
#pragma unroll
        for (int ww = 0; ww < 8; ++ww) o += red[ww * 512 + tid];
        ((bf16_t*)(F.ws + WS_SO))[(size_t)sb * D + hp * 512 + tid] = (bf16_t)(cvt_pk_bf16(o, 0.f) & 0xffffu);
    }
    __syncthreads();
}
__device__ __forceinline__ void final_norm(Frame& F0) {
    Frame F = launder(F0);
    const int gw = F.bx * NWAVES + F.wave, NGW = F.G * NWAVES, lane = F.lane;
    f32x4 g[4];
#pragma unroll
    for (int jj = 0; jj < 4; ++jj) g[jj] = ((const f32x4*)FIN(24) + lane)[64 * jj];
    for (int m0 = 2 * gw; m0 < MP + MS; m0 += 2 * NGW) {
        f32x4 v[2][4];
#pragma unroll
        for (int r = 0; r < 2; ++r) {
            const int m = m0 + r;
            if (m < MP) {
                const u32x2* src = (const u32x2*)(((bf16_t*)(F.ws + WS_XB)) + (size_t)m * D) + lane;
#pragma unroll
                for (int jj = 0; jj < 4; ++jj) v[r][jj] = unpack4(src[64 * jj]);
            } else {
                const f32x4* src = (const f32x4*)(((float*)(F.ws + WS_XS)) + (size_t)(m - MP) * D) + lane;
#pragma unroll
                for (int jj = 0; jj < 4; ++jj) v[r][jj] = src[64 * jj];
            }
        }
#pragma unroll
        for (int r = 0; r < 2; ++r) {
            const int m = m0 + r; float s = 0.f;
#pragma unroll
            for (int jj = 0; jj < 4; ++jj) s += dot4(v[r][jj], v[r][jj]);
            float* dst = m < MP ? F.out + O_Y + (size_t)m * D : F.out + O_YS + (size_t)(m - MP) * D;
            const float rs = rsqrtf(wave_sum(s, lane) * (1.0f / D) + EPS);
#pragma unroll
            for (int jj = 0; jj < 4; ++jj) ((f32x4*)dst + lane)[64 * jj] = v[r][jj] * rs * g[jj];
        }
    }
}

struct Args { const float* in[25]; float* out; unsigned char* ws; int ph_lo, ph_hi; };
#define REP(bit) for (int rep_ = 0; rep_ < 1 + ((REP_MASK >> (bit)) & 1); ++rep_)
#ifndef XCD_VID
#define XCD_VID 0
#endif
#ifndef MK_SPLIT
#define MK_SPLIT 0
#endif
__global__ void __launch_bounds__(NWAVES * 64, 2) fwd(Args args) {
    extern __shared__ __attribute__((aligned(16))) unsigned char lds_raw[];
    Frame F0;
    F0.lds = (LAS unsigned char*)lds_raw;
    F0.tid = threadIdx.x; F0.lane = F0.tid & 63; F0.wave = __builtin_amdgcn_readfirstlane(F0.tid >> 6); F0.G = gridDim.x; F0.bx = blockIdx.x;
    F0.in = (in_tab_t)__builtin_amdgcn_kernarg_segment_ptr();     F0.out = args.out; F0.ws = args.ws;
    for (int u = F0.tid; u < (LDS_BYTES - LDSCTL_OFF) / 4; u += NWAVES * 64) ((LAS unsigned*)(F0.lds + LDSCTL_OFF))[u] = 0u;
    __syncthreads();
    XcdBarrier bar; bar.wave = F0.wave; bar.bar = (unsigned*)(args.ws + WS_CTL) + CW_BAR; bar.x = 0; bar.st = nullptr;
    if (!MK_SPLIT) bar = xcd_barrier_post((unsigned*)(args.ws + WS_CTL) + CW_BAR, (volatile LAS unsigned*)(F0.lds + MISC_OFF) + 8, F0.wave);
    unsigned* rankw = (unsigned*)(args.ws + WS_CTL) + CW_RANK;
    const unsigned my_xcc = xb_xcc_id();
    unsigned my_rank = 0u;
    if (F0.tid == 0) ((volatile LAS unsigned*)(F0.lds + MISC_OFF))[12] = __hip_atomic_fetch_add(rankw + 64 * my_xcc, 1u, __ATOMIC_RELAXED, __HIP_MEMORY_SCOPE_AGENT);
    __syncthreads();
    my_rank = __builtin_amdgcn_readfirstlane(((volatile LAS unsigned*)(F0.lds + MISC_OFF))[12]);
    F0.vid = F0.bx;
    int ph = 0;
    const int lo = args.ph_lo, hi = args.ph_hi;
#define PH_BEGIN if (ph >= lo && ph < hi) { Frame F = launder(F0);
#define PH_END } { const bool both_ = (ph >= lo && ph + 1 < hi); ++ph; if (!MK_SPLIT && both_) { XcdBarrier b2_ = bar; unsigned long long bp_ = uni64((unsigned long long)bar.bar); unsigned bx_ = __builtin_amdgcn_readfirstlane(bar.x); int bw_ = __builtin_amdgcn_readfirstlane(bar.wave); asm volatile("" : "+s"(bp_), "+s"(bx_), "+s"(bw_)); b2_.bar = (unsigned*)(GAS unsigned*)bp_; b2_.x = bx_; b2_.wave = bw_; xcd_barrier(b2_); } }

    PH_BEGIN REP(0) { p0_prologue(F0); __syncthreads(); } PH_END
    if (!MK_SPLIT && lo == 0) {
        unsigned nx = 0u, xi = 0u; bool even = (F0.G % 8) == 0;
        for (unsigned jx = 0; jx < 16; ++jx) { const unsigned c_ = __hip_atomic_load(rankw + 64 * jx, __ATOMIC_RELAXED, __HIP_MEMORY_SCOPE_AGENT); if (c_) { if (c_ != (unsigned)F0.G / 8u) even = false; if (jx < my_xcc) ++xi; ++nx; } }
        if (XCD_VID && even && nx == 8u) F0.vid = (int)(my_rank * 8u + xi);
        if (((REP_MASK >> 18) & 1) && !(even && nx == 8u && (unsigned)(F0.bx % 8) == xi) && F0.tid == 0) F0.out[O_YS + F0.bx] = __builtin_nanf("");
        F0.vid = __builtin_amdgcn_readfirstlane(F0.vid);
    }
    PH_BEGIN {
        if ((REP_MASK >> 17) & 1) {
            f32x4 pa[8]; bf16x8 pb = (bf16x8){(short)F.tid, 1, 2, 3, 4, 5, 6, 7};
#pragma unroll
            for (int i = 0; i < 8; ++i) pa[i] = (f32x4){(float)F.tid, 1.f, 2.f, (float)i};
#pragma unroll 1
            for (int it = 0; it < 512; ++it) {
#pragma unroll
                for (int r = 0; r < 4; ++r)
#pragma unroll
                    for (int i = 0; i < 8; ++i) pa[i] = MFMA16(pb, pb, pa[i]);
            }
            float sacc = 0.f;
#pragma unroll
            for (int i = 0; i < 8; ++i) sacc += pa[i][0] + pa[i][3];
            if (sacc == 12345.678f) ((float*)(F.ws + WS_Z))[F.tid] = sacc;
        }
        if ((REP_MASK >> 15) & 3) { pg8::Gemm gp{((bf16_t*)(F.ws + WS_XB)), ((bf16_t*)(F.ws + WS_C1)), MP, NC, ((REP_MASK >> 15) & 1) ? 1024 : 512}; pg8::StaticOrder Sp; Sp.init(MP, NC, F.G, (int)F.vid); EpiProbe Ep{((bf16_t*)(F.ws + WS_Z)), NC}; pg8::gemm_phase<EpiProbe, pg8::StaticOrder, true, true>(F.lds, gp, Sp, Ep, F.wave); }
        pg8::Gemm g{((bf16_t*)(F.ws + WS_MEMB)), ((bf16_t*)(F.ws + WS_WKV)), MMEM, 8192, D}; pg8::StaticOrder S; S.init(MMEM, 8192, F.G, (int)F.vid);
        EpiMemKV E{((float*)(F.ws + WS_SMALL + 65536)), F.out + O_MEMK, F.out + O_MEMV, ((bf16_t*)(F.ws + WS_KB)), ((bf16_t*)(F.ws + WS_VB))};
        REP(1) pg8::gemm_phase<EpiMemKV, pg8::StaticOrder, true, true>(F.lds, g, S, E, F.wave);
    } PH_END
#pragma unroll 1
    for (int l = 0; l < DEPTH; ++l) {
        const int j = l >> 1;
        if ((l & 1) == 0) {
            PH_BEGIN {
                pg8::Gemm g{((bf16_t*)(F.ws + WS_XB)), ((bf16_t*)(F.ws + WS_AB1)) + (size_t)j * NAB * D, MP, NAB, D}; pg8::StaticOrder S; S.init(MP, NAB, F.G, (int)F.vid);
                Unit u0{0, 0}; S.next(0, u0); rstd_table(((float*)(F.ws + WS_RSQ)), u0.pm, (LAS float*)(F.lds + RSTD_OFF), F.tid);
                EpiG1Even E{((float*)(F.ws + WS_RSQ)), ((bf16_t*)(F.ws + WS_Z)), ((float*)(F.ws + WS_VSQ)), F.out + O_POOLP + (size_t)j * 8 * 15 * 1024, (LAS const float*)(F.lds + RSTD_OFF), u0.pm};
                REP(2) pg8::gemm_phase<EpiG1Even, pg8::StaticOrder, true, true>(F.lds, g, S, E, F.wave);
                SEpiZ SE{((float*)(F.ws + WS_SMALL)), ((float*)(F.ws + WS_SZ)), 8192, 0};
                REP(3) skinny_gemm<SEpiZ>(F, ((bf16_t*)(F.ws + WS_XB)) + (size_t)MP * D, ((bf16_t*)(F.ws + WS_AB1)) + (size_t)j * NAB * D, NAB, D, SE);
            } PH_END
            PH_BEGIN {
                REP(4) for (int un = F.bx; un < 256; un += F.G) { if ((un & 1) == 0) sgu_chunk(F, j, un >> 1); else pool_chunk(F, j, un >> 1); }
                REP(5) for (int b = F.bx; b < MS; b += F.G) sample_mix_even(F, j, b);
            } PH_END
        } else {
            PH_BEGIN {
                pg8::Gemm g{((bf16_t*)(F.ws + WS_XB)), ((bf16_t*)(F.ws + WS_C1)) + (size_t)j * NC * D, MP, NC, D}; pg8::StaticOrder S; S.init(MP, NC, F.G, (int)F.vid);
                Unit u0{0, 0}; S.next(0, u0);
                for (int i = F.tid; i < 8 * 3 * 64; i += NWAVES * 64) { const int ui = i / 192, q = (i / 64) % 3, c = i & 63, pn = u0.pn + 4 * ui; ((LAS float*)(F.lds + CWL_OFF))[i] = pn < NC / 256 ? (FIN(18) + (size_t)j * 3 * 2048)[q * 2048 + pn * 64 + c] : 0.f; }
                rstd_table(((float*)(F.ws + WS_RSQ)), u0.pm, (LAS float*)(F.lds + RSTD_OFF), F.tid);
                EpiG1Odd E{((float*)(F.ws + WS_RSQ)), ((bf16_t*)(F.ws + WS_A2)), FIN(18) + (size_t)j * 3 * 2048, F.out + O_CONVP + (size_t)j * 8 * 2 * 2048, ((float*)(F.ws + WS_SIDE)), (LAS float*)(F.lds + HALO_OFF), (LAS const float*)(F.lds + RSTD_OFF), u0.pm, (LAS const float*)(F.lds + CWL_OFF), u0.pn};
                REP(6) pg8::gemm_phase<EpiG1Odd, pg8::StaticOrder, true, true>(F.lds, g, S, E, F.wave);
                SEpiZ SE{((float*)(F.ws + WS_SMALL)), ((float*)(F.ws + WS_SZ)), 8192, 1};
                REP(3) skinny_gemm<SEpiZ>(F, ((bf16_t*)(F.ws + WS_XB)) + (size_t)MP * D, ((bf16_t*)(F.ws + WS_C1)) + (size_t)j * NC * D, NC, D, SE);
            } PH_END
            PH_BEGIN {
                REP(5) for (int b = F.bx; b < MS; b += F.G) sample_conv_odd(F, j, b);
            } PH_END
        }
        PH_BEGIN {
            const bf16_t* W2 = ((l & 1) ? ((bf16_t*)(F.ws + WS_C2)) : ((bf16_t*)(F.ws + WS_AB2))) + (size_t)j * D * 2048;
            pg8::Gemm g{((bf16_t*)(F.ws + WS_A2)), W2, MP, D, 2048}; pg8::StaticOrder S; S.init(MP, D, F.G, (int)F.vid);
            if (l & 1) { Unit fu; for (int i = 0; S.next(i, fu); ++i) conv_fixup(((float*)(F.ws + WS_SIDE)), FIN(18) + (size_t)j * 3 * 2048, ((bf16_t*)(F.ws + WS_A2)), fu.pm, F.tid); asm volatile("s_waitcnt vmcnt(0)" ::: "memory"); __syncthreads(); }
            EpiRes E{((bf16_t*)(F.ws + WS_XB)), ((float*)(F.ws + WS_RSQ))};
            pg8::gemm_phase<EpiRes, pg8::StaticOrder, true, true>(F.lds, g, S, E, F.wave);
            SEpiRes SE{((float*)(F.ws + WS_XS)), ((bf16_t*)(F.ws + WS_XB)) + (size_t)MP * D, ((float*)(F.ws + WS_SMALL))};
            skinny_gemm<SEpiRes>(F, ((bf16_t*)(F.ws + WS_SA2)), W2, D, 2048, SE);
        } PH_END
        PH_BEGIN {
            pg8::Gemm g{((bf16_t*)(F.ws + WS_XB)), ((bf16_t*)(F.ws + WS_WQ)) + (size_t)l * D * D, MP, D, D}; pg8::StaticOrder S; S.init(MP, D, F.G, (int)F.vid);
            Unit u0{0, 0}; S.next(0, u0); rstd_table(((float*)(F.ws + WS_RSQ)), u0.pm, (LAS float*)(F.lds + RSTD_OFF), F.tid);
            EpiQ E{((float*)(F.ws + WS_RSQ)), ((bf16_t*)(F.ws + WS_Q)), (LAS const float*)(F.lds + RSTD_OFF), u0.pm};
            REP(8) pg8::gemm_phase<EpiQ, pg8::StaticOrder, true, true>(F.lds, g, S, E, F.wave);
            SEpiQ SE{((float*)(F.ws + WS_SMALL)), ((float*)(F.ws + WS_SQ))};
            REP(9) skinny_gemm<SEpiQ>(F, ((bf16_t*)(F.ws + WS_XB)) + (size_t)MP * D, ((bf16_t*)(F.ws + WS_WQ)) + (size_t)l * D * D, D, D, SE);
        } PH_END
        PH_BEGIN {
            if (F.G == 256) { REP(10) attn_fused(F, l); }
            else { attn_prompt(F, l); attn_sample(F, l); }
        } PH_END
        PH_BEGIN {
            pg8::Gemm g{((bf16_t*)(F.ws + WS_O)), ((bf16_t*)(F.ws + WS_WO)) + (size_t)l * D * D, MP, D, D}; pg8::StaticOrder S; S.init(MP, D, F.G, (int)F.vid);
            EpiRes E{((bf16_t*)(F.ws + WS_XB)), ((float*)(F.ws + WS_RSQ))};
            pg8::gemm_phase<EpiRes, pg8::StaticOrder, true, true>(F.lds, g, S, E, F.wave);
            SEpiRes SE{((float*)(F.ws + WS_XS)), ((bf16_t*)(F.ws + WS_XB)) + (size_t)MP * D, ((float*)(F.ws + WS_SMALL))};
            skinny_gemm<SEpiRes>(F, ((bf16_t*)(F.ws + WS_SO)), ((bf16_t*)(F.ws + WS_WO)) + (size_t)l * D * D, D, D, SE);
        } PH_END
    }
    PH_BEGIN final_norm(F0); PH_END
#undef PH_BEGIN
#undef PH_END
}
constexpr int N_PHASES = 2 + 6 * DEPTH + 1;

extern "C" void kernel_launch(void* const* d_in, const int* in_sizes, int n_in, void* d_out, int out_size, void* d_ws, size_t ws_size, hipStream_t stream) {
    static int grid = 0;
    if (grid == 0) {
        if (n_in != 25 || in_sizes[0] != MP * D || (size_t)out_size != O_END || ws_size < WS_END) { fprintf(stderr, "kernel_launch: unexpected shapes (n_in %d, in0 %d, out %d, ws %zu); nothing launched\n", n_in, n_in > 0 ? in_sizes[0] : -1, out_size, ws_size); grid = -1; return; }
        int dev = 0, cus = 0, per_cu = 0;
        if (hipGetDevice(&dev) != hipSuccess || hipDeviceGetAttribute(&cus, hipDeviceAttributeMultiprocessorCount, dev) != hipSuccess) { fprintf(stderr, "kernel_launch: device query failed\n"); grid = -1; return; }
        if (hipFuncSetAttribute((const void*)fwd, hipFuncAttributeMaxDynamicSharedMemorySize, LDS_BYTES) != hipSuccess) { fprintf(stderr, "kernel_launch: hipFuncSetAttribute failed\n"); grid = -1; return; }
        if (hipOccupancyMaxActiveBlocksPerMultiprocessor(&per_cu, (const void*)fwd, NWAVES * 64, LDS_BYTES) != hipSuccess || per_cu < 1) fprintf(stderr, "kernel_launch: note: occupancy query reports %d workgroups per CU\n", per_cu);
        (void)hipGetLastError();
        grid = cus;
    }
    if (grid < 0) return;
    if (hipMemsetAsync((char*)d_ws + WS_CTL, 0, CTL_ZERO_BYTES, stream) != hipSuccess) { fprintf(stderr, "kernel_launch: memset failed\n"); return; }
    Args a{};
    for (int i = 0; i < 25; ++i) a.in[i] = (const float*)d_in[i];
    a.out = (float*)d_out; a.ws = (unsigned char*)d_ws;
#if MK_SPLIT
    for (int p = 0; p < N_PHASES; ++p) { a.ph_lo = p; a.ph_hi = p + 1; hipLaunchKernelGGL(fwd, dim3(grid), dim3(NWAVES * 64), LDS_BYTES, stream, a); }
#else
    a.ph_lo = 0; a.ph_hi = N_PHASES;
    hipLaunchKernelGGL(fwd, dim3(grid), dim3(NWAVES * 64), LDS_BYTES, stream, a);
#endif
    const hipError_t le = hipPeekAtLastError();
    if (le != hipSuccess) fprintf(stderr, "kernel_launch: launch failed: %s\n", hipGetErrorName(le));
}
```

```cpp
#include <hip/hip_runtime.h>
#include <cstdio>
#include <cstdint>
#ifndef REP_MASK
#define REP_MASK 0
#endif
__device__ __forceinline__ int hw_lane() { int l; asm volatile("v_mbcnt_lo_u32_b32 %0, -1, 0\n\tv_mbcnt_hi_u32_b32 %0, -1, %0" : "=v"(l)); return l; }
namespace pg8 {
#define PG8_LAS __attribute__((address_space(3)))
typedef unsigned short bf16_t;
typedef short bf16x8 __attribute__((ext_vector_type(8)));
typedef float f32x4 __attribute__((ext_vector_type(4)));
typedef unsigned u32x4 __attribute__((ext_vector_type(4)));
constexpr int BM = 256, BK = 64, HALF = 128, HTB = HALF * BK * 2  , STAGE_BYTES = 8 * HTB, NXCD = 8, WGM = 8;

__host__ __device__ __forceinline__ int lds_byte(int r, int c) { const int st = (r >> 4) * 2 + (c >> 5), rr = r & 15, cc = c & 31, ob = rr * 64 + cc * 2; return st * 1024 + (ob ^ (((ob >> 9) & 1) << 5)); }
__host__ __device__ __forceinline__ void stage_rc(int b, int& R, int& C) { const int st = b / 1024, sb = b % 1024, swz = sb ^ (((sb >> 9) & 1) << 5); R = (st >> 1) * 16 + swz / 64; C = (st & 1) * 32 + (swz % 64) / 2; }
__host__ __device__ __forceinline__ int perm32(int rho) { const int n = rho >> 4, i = rho & 15; return 8 * (i >> 2) + 4 * n + (i & 3); }

struct Unit { int pm, pn; };
struct Gemm { const bf16_t* A; const bf16_t* Bt; int M, N, K; };

struct StaticOrder {
    int nM, nN, nwg, G, c;
    __host__ __device__ __forceinline__ void init(int M, int N, int G_, int c_) { nM = M / BM; nN = N / BM; nwg = nM * nN; G = G_; c = c_; }
    __host__ __device__ __forceinline__ bool next(int i, Unit& u) const {
        const long L = (long)i * G + c; if (L >= nwg) return false;
        int wgid = (int)L; { const int q = nwg / NXCD, r = nwg % NXCD, xcd = wgid % NXCD, off = wgid / NXCD; wgid = (xcd < r ? xcd * (q + 1) : r * (q + 1) + (xcd - r) * q) + off; }
        const int nig = WGM * nN, gid = wgid / nig, fm = gid * WGM, gsz = (nM - fm) < WGM ? (nM - fm) : WGM;
        u.pm = fm + ((wgid % nig) % gsz); u.pn = (wgid % nig) / gsz; return true;
    }
    __device__ __forceinline__ void a_ready(const Unit&) const {}
    __device__ __forceinline__ void done(const Unit&) const {}
};

typedef float f32x2cv __attribute__((ext_vector_type(2))); typedef __bf16 bf16x2cv __attribute__((ext_vector_type(2)));
__device__ __forceinline__ unsigned cvt_pk_bf16(float lo, float hi) { const f32x2cv v = {lo, hi}; return __builtin_bit_cast(unsigned, __builtin_convertvector(v, bf16x2cv)); }
template <class Epi, class Sched, bool ALIGN_EPI = false, bool SP2 = false>
__device__ __forceinline__ void gemm_phase(PG8_LAS unsigned char* lds, const Gemm g, const Sched& S, const Epi& E, const int wave_id) {
    int tid_ = (wave_id << 6) | hw_lane(); asm volatile("" : "+v"(tid_));
    const int tid = tid_, wid = __builtin_amdgcn_readfirstlane(tid >> 6), lane = tid & 63, wr = wid >> 2, wc = wid & 3, fr = lane & 15, fq = lane >> 4;
    const int K = g.K, nt = K / BK;
    unsigned voffA[2], voffB[2];
#pragma unroll
    for (int i = 0; i < 2; ++i) { int R, C; stage_rc(tid * 16 + i * 8192, R, C); const int Rb = Epi::PERM ? ((R & ~31) + perm32(R & 31)) : R;
        voffA[i] = (unsigned)(R * K + C) * 2u; voffB[i] = (unsigned)(Rb * K + C) * 2u; }
    const size_t kstep = (size_t)(BK * 2);
    const size_t hstep = (size_t)HALF * K * 2;
    const size_t tstep = 2 * hstep;
    const unsigned ldsw = (unsigned)wid * 1024u;
    const int aoff = lds_byte(wr * 64 + fr, fq * 8), boff = lds_byte(wc * 32 + fr, fq * 8);
#define PG8_SA(b, h) (((b) * 2 + (h)) * HTB)
#define PG8_SB(b, h) ((4 + (b) * 2 + (h)) * HTB)
#define PG8_STAGE(bufoff, gbase, voff) do { _Pragma("unroll") for (int _i = 0; _i < 2; ++_i) \
        __builtin_amdgcn_global_load_lds((const unsigned*)((const char*)(gbase) + (voff)[_i]), (PG8_LAS unsigned*)(lds + (bufoff) + ldsw + _i * 8192), 16, 0, 0); } while (0)
#define PG8_LDA(dst, b, h) do { _Pragma("unroll") for (int m = 0; m < 4; ++m) _Pragma("unroll") for (int k = 0; k < 2; ++k) dst[m][k] = *(const PG8_LAS bf16x8*)(lds + PG8_SA(b, h) + aoff + m * 2048 + k * 1024); } while (0)
#define PG8_LDB(dst, b, h) do { _Pragma("unroll") for (int n = 0; n < 2; ++n) _Pragma("unroll") for (int k = 0; k < 2; ++k) dst[n][k] = *(const PG8_LAS bf16x8*)(lds + PG8_SB(b, h) + boff + n * 2048 + k * 1024); } while (0)
#define PG8_MMA(ai, bj, At, Bt) do { __builtin_amdgcn_s_setprio(1); _Pragma("unroll") for (int m = 0; m < 4; ++m) _Pragma("unroll") for (int n = 0; n < 2; ++n) _Pragma("unroll") for (int k = 0; k < 2; ++k) \
        acc[ai][bj][m][n] = __builtin_amdgcn_mfma_f32_16x16x32_bf16(Bt[n][k], At[m][k], acc[ai][bj][m][n], 0, 0, 0); __builtin_amdgcn_s_setprio(0); } while (0)
#define PG8_WAIT_V(n) asm volatile("s_waitcnt vmcnt(" #n ")" ::: "memory")
#define PG8_WAIT_L(n) asm volatile("s_waitcnt lgkmcnt(" #n ")" ::: "memory")
#define PG8_BAR __builtin_amdgcn_s_barrier()
#define PG8_SCHED __builtin_amdgcn_sched_barrier(0)
    Unit cur, nxt; int ui = 0;
    if (!S.next(0, cur)) return;
    f32x4 acc[2][2][4][2];
#pragma unroll
    for (int a = 0; a < 2; ++a)
#pragma unroll
        for (int b = 0; b < 2; ++b)
#pragma unroll
            for (int m = 0; m < 4; ++m)
#pragma unroll
                for (int n = 0; n < 2; ++n) acc[a][b][m][n] = (f32x4){0.f, 0.f, 0.f, 0.f};
    bf16x8 At[4][2], B0[2][2], B1[2][2];
    const char* cA = (const char*)g.A + (size_t)cur.pm * tstep; const char* cB = (const char*)g.Bt + (size_t)cur.pn * tstep;
    S.a_ready(cur);
    if constexpr (SP2) {
        PG8_STAGE(PG8_SB(0, 0), cB, voffB); PG8_STAGE(PG8_SB(0, 1), cB + hstep, voffB); PG8_STAGE(PG8_SA(0, 0), cA, voffA); PG8_STAGE(PG8_SA(0, 1), cA + hstep, voffA);
        if (wr == 1) PG8_BAR;
        PG8_WAIT_V(2); PG8_BAR;
        PG8_STAGE(PG8_SB(1, 0), cB + kstep, voffB); PG8_STAGE(PG8_SA(1, 0), cA + kstep, voffA); PG8_STAGE(PG8_SB(1, 1), cB + hstep + kstep, voffB);
        PG8_WAIT_V(6); PG8_BAR;
    } else {
        PG8_STAGE(PG8_SB(0, 0), cB, voffB); PG8_STAGE(PG8_SA(0, 0), cA, voffA); PG8_STAGE(PG8_SB(0, 1), cB + hstep, voffB); PG8_STAGE(PG8_SA(0, 1), cA + hstep, voffA);
        if (wr == 1) PG8_BAR;
        PG8_WAIT_V(4); PG8_BAR;
        PG8_STAGE(PG8_SB(1, 0), cB + kstep, voffB); PG8_STAGE(PG8_SA(1, 0), cA + kstep, voffA); PG8_STAGE(PG8_SB(1, 1), cB + hstep + kstep, voffB);
        PG8_WAIT_V(6); PG8_BAR;
    }
    for (;;) {
        const bool has_next = S.next(ui + 1, nxt);
        const char* nA = has_next ? (const char*)g.A + (size_t)nxt.pm * tstep : cA; const char* nB = has_next ? (const char*)g.Bt + (size_t)nxt.pn * tstep : cB;
        for (int t = 0; t < nt; t += 2) {
            const bool last = (t == nt - 2);
            const char* a1 = cA + (size_t)(t + 1) * kstep;
            const char* a2 = last ? nA : cA + (size_t)(t + 2) * kstep; const char* b2 = last ? nB : cB + (size_t)(t + 2) * kstep;
            const char* a3 = a2 + kstep; const char* b3 = b2 + kstep;
            if (last && has_next) S.a_ready(nxt);
            if constexpr (SP2) {
            PG8_LDB(B0, 0, 0); PG8_LDB(B1, 0, 1); PG8_SCHED; PG8_LDA(At, 0, 0); PG8_STAGE(PG8_SA(1, 1), a1 + hstep, voffA);
            PG8_WAIT_V(8); PG8_WAIT_L(0); PG8_BAR; PG8_MMA(0, 0, At, B0); PG8_MMA(0, 1, At, B1); PG8_BAR; PG8_SCHED;
            PG8_LDA(At, 0, 1); PG8_STAGE(PG8_SB(0, 0), b2, voffB); PG8_STAGE(PG8_SB(0, 1), b2 + hstep, voffB); PG8_STAGE(PG8_SA(0, 0), a2, voffA);
            PG8_WAIT_V(8); PG8_WAIT_L(0); PG8_BAR; PG8_MMA(1, 0, At, B0); PG8_MMA(1, 1, At, B1); PG8_BAR; PG8_SCHED;
            PG8_LDB(B0, 1, 0); PG8_LDB(B1, 1, 1); PG8_SCHED; PG8_LDA(At, 1, 0); PG8_STAGE(PG8_SA(0, 1), a2 + hstep, voffA);
            PG8_WAIT_V(8); PG8_WAIT_L(0); PG8_BAR; PG8_MMA(0, 0, At, B0); PG8_MMA(0, 1, At, B1); PG8_BAR; PG8_SCHED;
            PG8_LDA(At, 1, 1); PG8_STAGE(PG8_SB(1, 0), b3, voffB); PG8_STAGE(PG8_SB(1, 1), b3 + hstep, voffB); PG8_STAGE(PG8_SA(1, 0), a3, voffA);
            PG8_WAIT_V(8); PG8_WAIT_L(0); PG8_BAR; PG8_MMA(1, 0, At, B0); PG8_MMA(1, 1, At, B1); PG8_BAR; PG8_SCHED;
            } else {
            PG8_LDB(B0, 0, 0); PG8_SCHED; PG8_LDA(At, 0, 0); PG8_STAGE(PG8_SA(1, 1), a1 + hstep, voffA);
            PG8_WAIT_L(8); PG8_BAR; PG8_WAIT_L(0); PG8_MMA(0, 0, At, B0); PG8_BAR; PG8_SCHED;
            PG8_LDB(B1, 0, 1); PG8_STAGE(PG8_SB(0, 0), b2, voffB);
            PG8_BAR; PG8_WAIT_L(0); PG8_MMA(0, 1, At, B1); PG8_BAR;
            PG8_LDA(At, 0, 1); PG8_STAGE(PG8_SA(0, 0), a2, voffA);
            PG8_BAR; PG8_WAIT_L(0); PG8_MMA(1, 0, At, B0); PG8_BAR; PG8_SCHED;
            PG8_STAGE(PG8_SB(0, 1), b2 + hstep, voffB);
            PG8_WAIT_V(6); PG8_BAR; PG8_MMA(1, 1, At, B1); PG8_BAR;
            PG8_LDB(B0, 1, 0); PG8_SCHED; PG8_LDA(At, 1, 0); PG8_STAGE(PG8_SA(0, 1), a2 + hstep, voffA);
            PG8_WAIT_L(8); PG8_BAR; PG8_WAIT_L(0); PG8_MMA(0, 0, At, B0); PG8_BAR; PG8_SCHED;
            PG8_LDB(B1, 1, 1); PG8_STAGE(PG8_SB(1, 0), b3, voffB);
            PG8_BAR; PG8_WAIT_L(0); PG8_MMA(0, 1, At, B1); PG8_BAR;
            PG8_LDA(At, 1, 1); PG8_STAGE(PG8_SA(1, 0), a3, voffA);
            PG8_BAR; PG8_WAIT_L(0); PG8_MMA(1, 0, At, B0); PG8_BAR; PG8_SCHED;
            PG8_STAGE(PG8_SB(1, 1), b3 + hstep, voffB);
            PG8_WAIT_V(6); PG8_BAR; PG8_MMA(1, 1, At, B1); PG8_BAR;
            }
        }
        if constexpr (ALIGN_EPI) { if (wr == 0) PG8_BAR; }
        if constexpr (!Epi::AFTER_DRAIN) { for (int rep_ = 0; rep_ < 1 + (Epi::REP_EPI ? 1 : 0); ++rep_) E(acc, cur, wr, wc, fr, fq); S.done(cur); }
        if (!has_next) break;
#pragma unroll
        for (int a = 0; a < 2; ++a)
#pragma unroll
            for (int b = 0; b < 2; ++b)
#pragma unroll
                for (int m = 0; m < 4; ++m)
#pragma unroll
                    for (int n = 0; n < 2; ++n) acc[a][b][m][n] = (f32x4){0.f, 0.f, 0.f, 0.f};
        cur = nxt; cA = nA; cB = nB; ++ui;
        if constexpr (ALIGN_EPI) { if (wr == 1) PG8_BAR; }
    }
    PG8_WAIT_V(0);
    if constexpr (!ALIGN_EPI) { if (wr == 0) PG8_BAR; }
    PG8_BAR;
    if constexpr (Epi::AFTER_DRAIN) { E.fused(acc, cur, wr, wc, fr, fq, lds, wid, lane); S.done(cur); }
#undef PG8_SA
#undef PG8_SB
#undef PG8_STAGE
#undef PG8_LDA
#undef PG8_LDB
#undef PG8_MMA
#undef PG8_WAIT_V
#undef PG8_WAIT_L
#undef PG8_BAR
#undef PG8_SCHED
}
}

using pg8::bf16_t; using pg8::bf16x8; using pg8::f32x4; using pg8::u32x4; using pg8::Unit; using pg8::cvt_pk_bf16;
#define GAS __attribute__((address_space(1)))
#define LAS __attribute__((address_space(3)))
typedef unsigned u32x2 __attribute__((ext_vector_type(2)));
typedef short s16x4 __attribute__((ext_vector_type(4)));
typedef GAS unsigned gu32;
#define RLX_AGENT __ATOMIC_RELAXED, __HIP_MEMORY_SCOPE_AGENT

constexpr int NWAVES = 8;
constexpr int D = 1024, MP = 16384, MS = 128, SEQ = 2048, NBATCH = 8, NMEM = 256, MMEM = 2048, DEPTH = 4;
constexpr int NAB = 5120, NC = 8192;
constexpr float EPS = 1e-6f;
constexpr float QSCALE = 0.0625f * 1.4426950408889634f;

constexpr size_t O_Y = 0, O_YS = O_Y + (size_t)MP * D, O_POOLP = O_YS + (size_t)MS * D, O_POOLS = O_POOLP + 2 * 8 * 15 * 1024,
                 O_CONVP = O_POOLS + (size_t)2 * 128 * 15 * 1024, O_CONVS = O_CONVP + 2 * 8 * 2 * 2048, O_SGUV = O_CONVS + (size_t)2 * 128 * 2 * 2048,
                 O_MEMK = O_SGUV + 2 * 128 * 1024, O_MEMV = O_MEMK + (size_t)4 * MMEM * D, O_END = O_MEMV + (size_t)4 * MMEM * D;
static_assert(O_END == 39239680, "output size");

constexpr size_t MiB = 1u << 20;
constexpr size_t WS_CTL = 0, CTL_ZERO_BYTES = 1 * MiB;
constexpr size_t WS_AB1 = 2 * MiB, WS_C1 = 22 * MiB, WS_AB2 = 54 * MiB, WS_C2 = 62 * MiB, WS_WQ = 70 * MiB, WS_WKV = 78 * MiB, WS_WO = 94 * MiB, WS_PMT = 102 * MiB;
constexpr size_t WS_XB = 104 * MiB;
constexpr size_t WS_RSQ = 137 * MiB, WS_VSQ = 138 * MiB;
constexpr size_t WS_SMALL = 139 * MiB;
constexpr size_t WS_Z = 140 * MiB;
constexpr size_t WS_A2 = 268 * MiB;
constexpr size_t WS_Q = 332 * MiB, WS_O = 364 * MiB;
constexpr size_t WS_MEMB = 396 * MiB, WS_KB = 400 * MiB, WS_VB = 416 * MiB;
constexpr size_t WS_XS = 432 * MiB, WS_SZ = 433 * MiB, WS_SA2 = 437 * MiB, WS_SQ = 438 * MiB, WS_SO = 439 * MiB, WS_SIDE = 440 * MiB  , WS_END = 444 * MiB;
constexpr int CW_BAR = 4096, CW_RANK = 8192;

constexpr int RING_BYTES = 131072, LDSCTL_OFF = RING_BYTES, MISC_OFF = LDSCTL_OFF + 320, HALO_OFF = RING_BYTES + 1024  , RSTD_OFF = HALO_OFF + 8192  , CWL_OFF = RSTD_OFF + 1024  , LDS_BYTES = 155648;

#define LDS_WAIT() asm volatile("s_waitcnt lgkmcnt(0)" ::: "memory")
#define LDS_BARRIER() asm volatile("s_waitcnt lgkmcnt(0)\n\ts_barrier" ::: "memory")

#define XB_TMO      128
#define XB_XCNT(j)  (256  + 64 * (j))
#define XB_XSUB(j)  (1280 + 64 * (j))
#define XB_XGEN(j)  (2304 + 64 * (j))
#define XB_TOP      3328
#define XB_TOPGEN   3392
#define XCD_BAR_WORDS 3456
#define XB_SPIN_CAP (1u << 18)

__device__ __forceinline__ unsigned xb_ld(unsigned* p)              { return __hip_atomic_load(p, __ATOMIC_RELAXED, __HIP_MEMORY_SCOPE_AGENT); }
__device__ __forceinline__ unsigned xb_add(unsigned* p, unsigned v) { return __hip_atomic_fetch_add(p, v, __ATOMIC_RELAXED, __HIP_MEMORY_SCOPE_AGENT); }
__device__ __forceinline__ unsigned xb_xcc_id() { return (unsigned)__builtin_amdgcn_s_getreg((3 << 11) | 20) & 0xFu; }
#define XB_SPIN(cond, bar) do { unsigned _sp = 0; while (cond) { __builtin_amdgcn_s_sleep(1); \
    if ((++_sp & 255u) == 0u) { if (xb_ld(&(bar)[XB_TMO])) break; if (_sp > XB_SPIN_CAP) { atomicAdd(&(bar)[XB_TMO], 1u); break; } } } } while (0)

struct XcdBarrier {
    int wave;
    unsigned* bar; unsigned x;
    volatile LAS unsigned* st;
};

__device__ __forceinline__ XcdBarrier xcd_barrier_post(unsigned* bar, volatile LAS unsigned* st, int wave) {
    XcdBarrier b; b.wave = wave; b.bar = bar; b.x = xb_xcc_id(); b.st = st;
    if (b.wave == 0 && hw_lane() == 0) (void)xb_add(&bar[XB_XCNT(b.x)], 1u);
    return b;
}
__device__ __forceinline__ void xcd_barrier_complete(unsigned* bar, unsigned x, unsigned& nloc, unsigned& nx) {
    const unsigned G = gridDim.x * gridDim.y * gridDim.z;
    unsigned sum, cnt, mine, sp = 0u;
    for (;;) {
        sum = 0u; cnt = 0u; mine = 0u;
#pragma unroll
        for (unsigned j = 0; j < 16; ++j) { const unsigned c = xb_ld(&bar[XB_XCNT(j)]); sum += c; cnt += (c > 0u) ? 1u : 0u; mine = (j == x) ? c : mine; }
        if (sum == G) break;
        __builtin_amdgcn_s_sleep(1);
        if ((++sp & 255u) == 0u) { if (xb_ld(&bar[XB_TMO])) break; if (sp > XB_SPIN_CAP) { atomicAdd(&bar[XB_TMO], 1u); break; } }
    }
    nloc = mine > 0u ? mine : 1u; nx = cnt > 0u ? cnt : 1u;
}

__device__ __forceinline__ void xcd_barrier(const XcdBarrier& b) {
    asm volatile("s_waitcnt vmcnt(0)" ::: "memory");
    __syncthreads();
    if (b.wave == 0 && hw_lane() == 0) {
        unsigned* bar = b.bar;
        __builtin_amdgcn_s_waitcnt(0);
        unsigned nloc = b.st[0], nx = b.st[1];
        if (nloc == 0u) { xcd_barrier_complete(bar, b.x, nloc, nx); b.st[0] = nloc; b.st[1] = nx; }
        const unsigned old = xb_add(&bar[XB_XSUB(b.x)], 1u);
        const unsigned gen = old / nloc;
        if (old + 1u == (gen + 1u) * nloc) {
            __builtin_amdgcn_fence(__ATOMIC_RELEASE, "agent");
            asm volatile("s_waitcnt vmcnt(0)" ::: "memory");
            const unsigned og = xb_add(&bar[XB_TOP], 1u);
            const unsigned tg = og / nx;
            if (og + 1u == (tg + 1u) * nx) xb_add(&bar[XB_TOPGEN], 1u);
            else XB_SPIN(xb_ld(&bar[XB_TOPGEN]) == tg, bar);
            __builtin_amdgcn_fence(__ATOMIC_ACQUIRE, "agent");
            xb_add(&bar[XB_XGEN(b.x)], 1u);
            asm volatile("s_waitcnt vmcnt(0)" ::: "memory");
        } else {
            XB_SPIN(xb_ld(&bar[XB_XGEN(b.x)]) == gen, bar);
            __builtin_amdgcn_fence(__ATOMIC_ACQUIRE, "agent");
            asm volatile("s_waitcnt vmcnt(0)" ::: "memory");
        }
    }
    __syncthreads();
}

__device__ __forceinline__ void xcd_barrier_local(const XcdBarrier& b) {
    asm volatile("s_waitcnt vmcnt(0)" ::: "memory");
    __syncthreads();
    if (b.wave == 0 && hw_lane() == 0) {
        unsigned* bar = b.bar;
        __builtin_amdgcn_s_waitcnt(0);
        const unsigned nloc = b.st[0] ? b.st[0] : 1u;
        const unsigned old = xb_add(&bar[XB_XSUB(b.x)], 1u);
        const unsigned gen = old / nloc;
        if (old + 1u == (gen + 1u) * nloc) xb_add(&bar[XB_XGEN(b.x)], 1u);
        else XB_SPIN(xb_ld(&bar[XB_XGEN(b.x)]) == gen, bar);
        __builtin_amdgcn_fence(__ATOMIC_ACQUIRE, "agent");
        asm volatile("s_waitcnt vmcnt(0)" ::: "memory");
    }
    __syncthreads();
}

typedef const float* fptr_t;
typedef __attribute__((address_space(4))) const fptr_t* in_tab_t;
struct Frame {
    LAS unsigned char* lds;
    int tid, lane, wave, G, bx, vid, xq, rk, rw;
    in_tab_t in;
    float* out;
    unsigned char* ws;
};
__device__ __forceinline__ unsigned long long uni64(unsigned long long v) { const unsigned lo = __builtin_amdgcn_readfirstlane((unsigned)v), hi = __builtin_amdgcn_readfirstlane((unsigned)(v >> 32)); return ((unsigned long long)hi << 32) | lo; }
__device__ __forceinline__ Frame launder(const Frame& F0) {
    Frame F = F0;
    int wv_ = __builtin_amdgcn_readfirstlane(F0.wave);
    int ln_ = hw_lane();
    int g_ = __builtin_amdgcn_readfirstlane(F0.G), b_ = __builtin_amdgcn_readfirstlane(F0.bx), v_ = __builtin_amdgcn_readfirstlane(F0.vid);
    unsigned long long w_ = uni64((unsigned long long)F0.ws), o_ = uni64((unsigned long long)F0.out), i_ = uni64((unsigned long long)F0.in);
    asm volatile("" : "+v"(ln_), "+s"(wv_), "+s"(g_), "+s"(b_), "+s"(v_), "+s"(w_), "+s"(o_), "+s"(i_));
    F.tid = (wv_ << 6) | ln_; F.G = g_; F.bx = b_; F.vid = v_; F.xq = b_ & 7; F.rk = b_ >> 3; F.rw = (g_ - (b_ & 7) + 7) >> 3; F.ws = (unsigned char*)(GAS unsigned char*)w_; F.out = (float*)(GAS float*)o_; F.in = (in_tab_t)i_;
    F.lane = ln_; F.wave = wv_;
    return F;
}
#define FIN(k) ((const float*)(const GAS float*)(F.in[k]))


__device__ __forceinline__ float shx(float v, int mask, int lane) { return __builtin_bit_cast(float, __builtin_amdgcn_ds_bpermute((lane ^ mask) << 2, __builtin_bit_cast(int, v))); }
__device__ __forceinline__ float wave_sum(float v, int lane) {
#pragma unroll
    for (int o = 1; o < 64; o <<= 1) v += shx(v, o, lane);
    return v;
}
__device__ __forceinline__ float silu_f(float x) { return x * __builtin_amdgcn_rcpf(1.f + __builtin_amdgcn_exp2f(-1.4426950408889634f * x)); }
__device__ __forceinline__ f32x4 silu4(f32x4 v) { return (f32x4){silu_f(v[0]), silu_f(v[1]), silu_f(v[2]), silu_f(v[3])}; }
__device__ __forceinline__ float dot4(f32x4 a, f32x4 b) { return (a[0] * b[0] + a[1] * b[1]) + (a[2] * b[2] + a[3] * b[3]); }
__device__ __forceinline__ u32x4 pack8(f32x4 a, f32x4 b) { u32x4 w; w.x = cvt_pk_bf16(a[0], a[1]); w.y = cvt_pk_bf16(a[2], a[3]); w.z = cvt_pk_bf16(b[0], b[1]); w.w = cvt_pk_bf16(b[2], b[3]); return w; }
__device__ __forceinline__ u32x2 pack4(f32x4 a) { u32x2 w; w.x = cvt_pk_bf16(a[0], a[1]); w.y = cvt_pk_bf16(a[2], a[3]); return w; }
__device__ __forceinline__ float bflo(unsigned w) { return __uint_as_float(w << 16); }
__device__ __forceinline__ float bfhi(unsigned w) { return __uint_as_float(w & 0xffff0000u); }
__device__ __forceinline__ void unpack8(u32x4 w, f32x4& a, f32x4& b) { a = (f32x4){bflo(w.x), bfhi(w.x), bflo(w.y), bfhi(w.y)}; b = (f32x4){bflo(w.z), bfhi(w.z), bflo(w.w), bfhi(w.w)}; }
__device__ __forceinline__ f32x4 unpack4(u32x2 w) { return (f32x4){bflo(w.x), bfhi(w.x), bflo(w.y), bfhi(w.y)}; }
__device__ __forceinline__ float rstd16(const float* p) {
    const f32x4 a = ((const f32x4*)p)[0], b = ((const f32x4*)p)[1], c = ((const f32x4*)p)[2], d = ((const f32x4*)p)[3];
    const f32x4 s = (a + b) + (c + d);
    return rsqrtf(((s[0] + s[1]) + (s[2] + s[3])) * (1.0f / D) + EPS);
}
__device__ __forceinline__ float rstd32(const float* p) {
    f32x4 s = ((const f32x4*)p)[0];
#pragma unroll
    for (int i = 1; i < 8; ++i) s += ((const f32x4*)p)[i];
    return rsqrtf(((s[0] + s[1]) + (s[2] + s[3])) * (1.0f / D) + EPS);
}
__host__ __device__ __forceinline__ int src_even(int n) {
    const int tile = n >> 8, o = n & 255;
    if (tile < 8) return n;
    if (tile < 12) return 3072 + (n - 2048);
    const int cb = tile - 12;
    return o < 128 ? 2048 + 128 * cb + o : 4096 + 128 * cb + (o - 128);
}
__host__ __device__ __forceinline__ int src_odd(int n) {
    const int pn = n >> 8, p = n & 255, q = ((p >> 7) << 1) | ((p >> 2) & 1), ch = 64 * pn + 16 * ((p >> 5) & 3) + 4 * ((p >> 3) & 3) + (p & 3);
    const int base = q == 0 ? 2048 : (q == 1 ? 4096 : (q == 2 ? 0 : 6144));
    return base + ch;
}

__device__ __forceinline__ void rstd_table(const float* rsq, int pm, LAS float* tab, int tid) {
    if (tid < 256) tab[tid] = rstd16(rsq + ((size_t)pm * 256 + tid) * 16);
    LDS_BARRIER();
}
struct EpiG1Even {
    static constexpr bool PERM = true, AFTER_DRAIN = false, REP_EPI = (REP_MASK >> 12) & 1;
    const float* rsq; bf16_t* Z; float* vsq; float* pool_out; LAS const float* rtab; int pm0;
    __device__ __forceinline__ void operator()(const f32x4 (&acc)[2][2][4][2], const Unit& u, int wr, int wc, int fr_, int fq_) const {
        int fr = fr_, fq = fq_; asm volatile("" : "+v"(fr), "+v"(fq));
        const int tile = u.pn, cw = wc * 32 + 8 * fq;
#pragma unroll
        for (int ai = 0; ai < 2; ++ai)
#pragma unroll
            for (int m = 0; m < 4; ++m) {
                const int row = u.pm * 256 + ai * 128 + wr * 64 + m * 16 + fr;
                const float rs = u.pm == pm0 ? rtab[ai * 128 + wr * 64 + m * 16 + fr] : rstd16(rsq + (size_t)row * 16);
                if (tile < 12) {
                    const int kind = tile >> 2;
                    bf16_t* dst = Z + (size_t)kind * MP * D + (size_t)row * D + (tile & 3) * 256 + cw;
                    float ss = 0.f;
#pragma unroll
                    for (int bj = 0; bj < 2; ++bj) {
                        f32x4 v0 = acc[ai][bj][m][0] * rs, v1 = acc[ai][bj][m][1] * rs;
                        if (kind == 1) { v0 = silu4(v0); v1 = silu4(v1); }
                        if (kind == 2) ss += dot4(v0, v0) + dot4(v1, v1);
                        *(u32x4*)(dst + bj * 128) = pack8(v0, v1);
                        if (kind == 0 && (row & 2047) >= 2033) {
                            float* po = pool_out + ((size_t)(row >> 11) * 15 + ((row & 2047) - 2033)) * 1024 + (tile & 3) * 256 + bj * 128 + cw;
                            *(f32x4*)po = v0; *(f32x4*)(po + 4) = v1;
                        }
                    }
                    if (kind == 2) { ss += shx(ss, 16, 16 * fq + fr); ss += shx(ss, 32, 16 * fq + fr); if (fq == 0) vsq[(size_t)row * 16 + (tile - 8) * 4 + wc] = ss; }
                } else {
                    const int cb = tile - 12;
                    bf16_t* dst = Z + (size_t)3 * MP * D + (size_t)row * D + cb * 128 + cw;
                    const f32x4 u0 = acc[ai][0][m][0] * rs, u1 = acc[ai][0][m][1] * rs, g0 = acc[ai][1][m][0] * rs, g1 = acc[ai][1][m][1] * rs;
                    *(u32x4*)dst = pack8(u0 * silu4(g0), u1 * silu4(g1));
                }
            }
    }
};
__device__ __forceinline__ float dpp_shr1(float old, float v) { return __builtin_bit_cast(float, __builtin_amdgcn_update_dpp(__builtin_bit_cast(int, old), __builtin_bit_cast(int, v), 0x111, 0xf, 0xf, false)); }
__device__ __forceinline__ float dpp_shr2(float old, float v) { return __builtin_bit_cast(float, __builtin_amdgcn_update_dpp(__builtin_bit_cast(int, old), __builtin_bit_cast(int, v), 0x112, 0xf, 0xf, false)); }
struct EpiG1Odd {
    static constexpr bool PERM = true, AFTER_DRAIN = false, REP_EPI = false;
    const float* rsq; bf16_t* A2; const float* cw; float* conv_out; float* side; LAS float* halo; LAS const float* rtab; int pm0; LAS const float* cwl; int pn0;
    __device__ __forceinline__ void operator()(const f32x4 (&acc)[2][2][4][2], const Unit& u, int wr, int wc, int fr_, int fq_) const {
        int fr = fr_, fq = fq_; asm volatile("" : "+v"(fr), "+v"(fq));
        const int chl = wc * 16 + 4 * fq, ch = u.pn * 64 + chl;
        f32x4 w0, w1, w2;
        { const int ui = (u.pn - pn0) >> 2;
          if (u.pm == pm0 && ui >= 0 && ui < 8 && ((u.pn - pn0) & 3) == 0) { w0 = *(const LAS f32x4*)(cwl + (ui * 3 + 0) * 64 + chl); w1 = *(const LAS f32x4*)(cwl + (ui * 3 + 1) * 64 + chl); w2 = *(const LAS f32x4*)(cwl + (ui * 3 + 2) * 64 + chl); }
          else { w0 = *(const f32x4*)(cw + ch); w1 = *(const f32x4*)(cw + 2048 + ch); w2 = *(const f32x4*)(cw + 4096 + ch); } }
        f32x4 e[2][4]; float rsv[2][4];
#pragma unroll
        for (int ai = 0; ai < 2; ++ai)
#pragma unroll
            for (int m = 0; m < 4; ++m) {
                const int rb = 8 * ai + 4 * wr + m, row = u.pm * 256 + 16 * rb + fr;
                const float rs = u.pm == pm0 ? rtab[16 * rb + fr] : rstd16(rsq + (size_t)row * 16); rsv[ai][m] = rs;
                e[ai][m] = (acc[ai][0][m][0] * rs) * (acc[ai][0][m][1] * rs);
                if (fr >= 14) *(LAS f32x4*)(halo + (rb * 2 + (fr - 14)) * 64 + chl) = e[ai][m];
                if (m & 1) asm volatile("" ::: "memory");
            }
        asm volatile("s_waitcnt lgkmcnt(0)" ::: "memory"); __builtin_amdgcn_s_barrier(); asm volatile("" ::: "memory");
        float* sd = side + (size_t)u.pm * 6 * 2048 + ch;
#pragma unroll
        for (int ai = 0; ai < 2; ++ai)
#pragma unroll
            for (int m = 0; m < 4; ++m) {
                const int rb = 8 * ai + 4 * wr + m, row = u.pm * 256 + 16 * rb + fr;
                const float rs = rsv[ai][m];
                const f32x4 sg = (acc[ai][1][m][0] * rs) * silu4(acc[ai][1][m][1] * rs);
                f32x4 h0 = (f32x4){0.f, 0.f, 0.f, 0.f}, h1 = h0;
                if (rb > 0) { h0 = *(const LAS f32x4*)(halo + ((rb - 1) * 2 + 0) * 64 + chl); h1 = *(const LAS f32x4*)(halo + ((rb - 1) * 2 + 1) * 64 + chl); }
                const f32x4 hx = fr == 0 ? h0 : h1, ev = e[ai][m];
                f32x4 e1, e2;
#pragma unroll
                for (int k = 0; k < 4; ++k) { e1[k] = dpp_shr1(h1[k], ev[k]); e2[k] = dpp_shr2(hx[k], ev[k]); }
                const f32x4 a = sg * (w0 * e2 + w1 * e1 + w2 * ev);
                const bool top = (rb == 0 && fr < 2);
                if (!(top && (u.pm & 7) != 0)) *(u32x2*)(A2 + (size_t)row * 2048 + ch) = pack4(a);
                if (top) { *(f32x4*)(sd + fr * 2048) = ev; *(f32x4*)(sd + (4 + fr) * 2048) = sg; }
                if (rb == 15 && fr >= 14) {
                    *(f32x4*)(sd + (2 + fr - 14) * 2048) = ev;
                    if ((u.pm & 7) == 7) *(f32x4*)(conv_out + ((size_t)(u.pm >> 3) * 2 + (fr - 14)) * 2048 + ch) = ev;
                }
            }
    }
};
__device__ __forceinline__ void conv_fixup(const float* side, const float* cw, bf16_t* A2, int pm, int tid) {
    if ((pm & 7) == 0) return;
    const int ch = 4 * tid;
    const float* sp = side + (size_t)(pm - 1) * 6 * 2048 + ch; const float* sc = side + (size_t)pm * 6 * 2048 + ch;
    const f32x4 em2 = *(const f32x4*)(sp + 2 * 2048), em1 = *(const f32x4*)(sp + 3 * 2048), e0 = *(const f32x4*)sc, e1 = *(const f32x4*)(sc + 2048), s0 = *(const f32x4*)(sc + 4 * 2048), s1 = *(const f32x4*)(sc + 5 * 2048);
    const f32x4 w0 = *(const f32x4*)(cw + ch), w1 = *(const f32x4*)(cw + 2048 + ch), w2 = *(const f32x4*)(cw + 4096 + ch);
    *(u32x2*)(A2 + (size_t)(pm * 256) * 2048 + ch) = pack4(s0 * (w0 * em2 + w1 * em1 + w2 * e0));
    *(u32x2*)(A2 + (size_t)(pm * 256 + 1) * 2048 + ch) = pack4(s1 * (w0 * em1 + w1 * e0 + w2 * e1));
}
struct EpiRes {
    static constexpr bool PERM = true, AFTER_DRAIN = false, REP_EPI = false;
    bf16_t* xb; float* rsq;
    __device__ __forceinline__ void operator()(const f32x4 (&acc)[2][2][4][2], const Unit& u, int wr, int wc, int fr_, int fq_) const {
        int fr = fr_, fq = fq_; asm volatile("" : "+v"(fr), "+v"(fq));
        const int cw = wc * 32 + 8 * fq;
#pragma unroll
        for (int ai = 0; ai < 2; ++ai) {
            u32x4 old[4][2];
#pragma unroll
            for (int m = 0; m < 4; ++m)
#pragma unroll
                for (int bj = 0; bj < 2; ++bj) old[m][bj] = *(const u32x4*)(xb + (size_t)(u.pm * 256 + ai * 128 + wr * 64 + m * 16 + fr) * D + u.pn * 256 + bj * 128 + cw);
#pragma unroll
            for (int m = 0; m < 4; ++m) {
                const int row = u.pm * 256 + ai * 128 + wr * 64 + m * 16 + fr;
                float ss = 0.f;
#pragma unroll
                for (int bj = 0; bj < 2; ++bj) {
                    f32x4 b0, b1; unpack8(old[m][bj], b0, b1);
                    const u32x4 wv = pack8(b0 + acc[ai][bj][m][0], b1 + acc[ai][bj][m][1]);
                    *(u32x4*)(xb + (size_t)row * D + u.pn * 256 + bj * 128 + cw) = wv;
                    f32x4 r0, r1; unpack8(wv, r0, r1);
                    ss += dot4(r0, r0) + dot4(r1, r1);
                }
                ss += shx(ss, 16, 16 * fq + fr); ss += shx(ss, 32, 16 * fq + fr);
                if (fq == 0) rsq[(size_t)row * 16 + u.pn * 4 + wc] = ss;
            }
        }
    }
};
struct EpiProbe {
    static constexpr bool PERM = true, AFTER_DRAIN = false, REP_EPI = false;
    bf16_t* O; int ldc;
    __device__ __forceinline__ void operator()(const f32x4 (&acc)[2][2][4][2], const Unit& u, int wr, int wc, int fr_, int fq_) const {
        int fr = fr_, fq = fq_; asm volatile("" : "+v"(fr), "+v"(fq));
        const int cw = wc * 32 + 8 * fq;
#pragma unroll
        for (int ai = 0; ai < 2; ++ai)
#pragma unroll
            for (int m = 0; m < 4; ++m) {
                const int row = u.pm * 256 + ai * 128 + wr * 64 + m * 16 + fr;
#pragma unroll
                for (int bj = 0; bj < 2; ++bj) *(u32x4*)(O + (size_t)row * ldc + u.pn * 256 + bj * 128 + cw) = pack8(acc[ai][bj][m][0], acc[ai][bj][m][1]);
            }
    }
};
struct EpiQ {
    static constexpr bool PERM = true, AFTER_DRAIN = false, REP_EPI = false;
    const float* rsq; bf16_t* Q; LAS const float* rtab; int pm0;
    __device__ __forceinline__ void operator()(const f32x4 (&acc)[2][2][4][2], const Unit& u, int wr, int wc, int fr_, int fq_) const {
        int fr = fr_, fq = fq_; asm volatile("" : "+v"(fr), "+v"(fq));
        const int cw = wc * 32 + 8 * fq;
#pragma unroll
        for (int ai = 0; ai < 2; ++ai)
#pragma unroll
            for (int m = 0; m < 4; ++m) {
                const int row = u.pm * 256 + ai * 128 + wr * 64 + m * 16 + fr;
                const float rs = u.pm == pm0 ? rtab[ai * 128 + wr * 64 + m * 16 + fr] : rstd16(rsq + (size_t)row * 16);
#pragma unroll
                for (int bj = 0; bj < 2; ++bj) *(u32x4*)(Q + (size_t)row * D + u.pn * 256 + bj * 128 + cw) = pack8(acc[ai][bj][m][0] * rs, acc[ai][bj][m][1] * rs);
            }
    }
};
struct EpiMemKV {
    static constexpr bool PERM = true, AFTER_DRAIN = false, REP_EPI = false;
    const float* rstdm; float* outk; float* outv; bf16_t* kb; bf16_t* vb;
    __device__ __forceinline__ void operator()(const f32x4 (&acc)[2][2][4][2], const Unit& u, int wr, int wc, int fr_, int fq_) const {
        int fr = fr_, fq = fq_; asm volatile("" : "+v"(fr), "+v"(fq));
        const int layer = u.pn >> 3, isv = (u.pn >> 2) & 1, cw = (u.pn & 3) * 256 + wc * 32 + 8 * fq;
        float* of = (isv ? outv : outk) + (size_t)layer * MMEM * D; bf16_t* ob = (isv ? vb : kb) + (size_t)layer * MMEM * D;
#pragma unroll
        for (int ai = 0; ai < 2; ++ai)
#pragma unroll
            for (int m = 0; m < 4; ++m) {
                const int row = u.pm * 256 + ai * 128 + wr * 64 + m * 16 + fr;
                const float rs = rstdm[row];
#pragma unroll
                for (int bj = 0; bj < 2; ++bj) {
                    const size_t off = (size_t)row * D + bj * 128 + cw;
                    const f32x4 v0 = acc[ai][bj][m][0] * rs, v1 = acc[ai][bj][m][1] * rs;
                    *(f32x4*)(of + off) = v0; *(f32x4*)(of + off + 4) = v1;
                    *(u32x4*)(ob + off) = pack8(v0, v1);
                }
            }
    }
};

struct TrItem { const float* wp; int ldw; const float* gk; float sc; bf16_t* wt; int K; };
__device__ __forceinline__ void p0_tr_desc(const float* W, int ldw, int K, int Nd, const float* gk, float sc, bf16_t* WT, int perm, int r, int lane, TrItem& t) {
    const int nblk = Nd / 32, kb = r / nblk, nb = r % nblk, dstn0 = 32 * nb, dn = dstn0 + (lane & 31);
    const int srccol = perm == 0 ? dn : (perm == 1 ? src_even(dn) : src_odd(dn));
    t.wp = W + (size_t)(64 * kb + (lane >> 5)) * ldw + srccol; t.ldw = ldw; t.gk = gk ? gk + 64 * kb : nullptr; t.sc = sc; t.wt = WT + (size_t)dstn0 * K + 64 * kb; t.K = K;
}
__device__ __forceinline__ void p0_resolve(Frame& F, int it, int lane, TrItem& t) {
    constexpr int I_AB1 = 16 * (NAB / 32), I_C1 = 16 * (NC / 32), I_2 = 32 * 32, I_SQ = 16 * 32, I_PM = 4 * 8;
    int r = it;
    if (r < 2 * I_AB1) { const int jj = r / I_AB1; p0_tr_desc(FIN(10) + (size_t)jj * D * NAB, NAB, D, NAB, FIN(7) + 2 * jj * D, 1.f, ((bf16_t*)(F.ws + WS_AB1)) + (size_t)jj * NAB * D, 1, r % I_AB1, lane, t); return; } r -= 2 * I_AB1;
    if (r < 2 * I_C1) { const int jj = r / I_C1; p0_tr_desc(FIN(17) + (size_t)jj * D * NC, NC, D, NC, FIN(7) + (2 * jj + 1) * D, 1.f, ((bf16_t*)(F.ws + WS_C1)) + (size_t)jj * NC * D, 2, r % I_C1, lane, t); return; } r -= 2 * I_C1;
    if (r < 2 * I_2) { const int jj = r / I_2; p0_tr_desc(FIN(16) + (size_t)jj * 2048 * D, D, 2048, D, nullptr, 1.f, ((bf16_t*)(F.ws + WS_AB2)) + (size_t)jj * D * 2048, 0, r % I_2, lane, t); return; } r -= 2 * I_2;
    if (r < 2 * I_2) { const int jj = r / I_2; p0_tr_desc(FIN(19) + (size_t)jj * 2048 * D, D, 2048, D, nullptr, 1.f, ((bf16_t*)(F.ws + WS_C2)) + (size_t)jj * D * 2048, 0, r % I_2, lane, t); return; } r -= 2 * I_2;
    if (r < 4 * I_SQ) { const int l = r / I_SQ; p0_tr_desc(FIN(20) + (size_t)l * D * D, D, D, D, FIN(8) + l * D, QSCALE, ((bf16_t*)(F.ws + WS_WQ)) + (size_t)l * D * D, 0, r % I_SQ, lane, t); return; } r -= 4 * I_SQ;
    if (r < 4 * I_SQ) { const int l = r / I_SQ; p0_tr_desc(FIN(21) + (size_t)l * D * D, D, D, D, FIN(9) + l * D, 1.f, ((bf16_t*)(F.ws + WS_WKV)) + (size_t)(2 * l) * D * D, 0, r % I_SQ, lane, t); return; } r -= 4 * I_SQ;
    if (r < 4 * I_SQ) { const int l = r / I_SQ; p0_tr_desc(FIN(22) + (size_t)l * D * D, D, D, D, FIN(9) + l * D, 1.f, ((bf16_t*)(F.ws + WS_WKV)) + (size_t)(2 * l + 1) * D * D, 0, r % I_SQ, lane, t); return; } r -= 4 * I_SQ;
    if (r < 4 * I_SQ) { const int l = r / I_SQ; p0_tr_desc(FIN(23) + (size_t)l * D * D, D, D, D, nullptr, 1.f, ((bf16_t*)(F.ws + WS_WO)) + (size_t)l * D * D, 0, r % I_SQ, lane, t); return; } r -= 4 * I_SQ;
    { const int jg = r / I_PM; p0_tr_desc(FIN(11) + (size_t)jg * 65536, 256, 256, 256, nullptr, 1.f, ((bf16_t*)(F.ws + WS_PMT)) + (size_t)jg * 65536, 0, r % I_PM, lane, t); }
}
__device__ __forceinline__ void p0_tr_load(const TrItem& t, int lane, float (&v)[32], f32x4& g0, f32x4& g1) {
    const int c = lane & 7;
    g0 = (f32x4){t.sc, t.sc, t.sc, t.sc}; g1 = g0;
    if (t.gk) { g0 = *(const f32x4*)(t.gk + 8 * c) * t.sc; g1 = *(const f32x4*)(t.gk + 8 * c + 4) * t.sc; }
#pragma unroll
    for (int i = 0; i < 32; ++i) v[i] = t.wp[(size_t)(2 * i) * t.ldw];
}
__device__ __forceinline__ void p0_tr_finish(const TrItem& t, int lane, const float (&v)[32], f32x4 g0, f32x4 g1, LAS float* scr) {
#pragma unroll
    for (int i = 0; i < 32; ++i) scr[(2 * i + (lane >> 5)) * 33 + (lane & 31)] = v[i];
    LDS_WAIT(); asm volatile("" ::: "memory");
    const int c = lane & 7;
#pragma unroll
    for (int jj = 0; jj < 4; ++jj) {
        const int n = (lane >> 3) + 8 * jj; const LAS float* s = scr + (8 * c) * 33 + n;
        u32x4 o; o.x = cvt_pk_bf16(s[0 * 33] * g0[0], s[1 * 33] * g0[1]); o.y = cvt_pk_bf16(s[2 * 33] * g0[2], s[3 * 33] * g0[3]); o.z = cvt_pk_bf16(s[4 * 33] * g1[0], s[5 * 33] * g1[1]); o.w = cvt_pk_bf16(s[6 * 33] * g1[2], s[7 * 33] * g1[3]);
        *(u32x4*)(t.wt + (size_t)n * t.K + 8 * c) = o;
    }
    LDS_WAIT(); asm volatile("" ::: "memory");
}
__device__ __forceinline__ float p0_row_finish(const f32x4 (&v)[4], bf16_t* dst, float* copy, int lane) {
    float s = 0.f;
#pragma unroll
    for (int jj = 0; jj < 4; ++jj) s += dot4(v[jj], v[jj]);
    s = wave_sum(s, lane);
    u32x2* o8 = (u32x2*)dst + lane;
#pragma unroll
    for (int jj = 0; jj < 4; ++jj) o8[64 * jj] = pack4(v[jj]);
    if (copy) {
#pragma unroll
        for (int jj = 0; jj < 4; ++jj) ((f32x4*)copy + lane)[64 * jj] = v[jj];
    }
    return s;
}
__device__ __forceinline__ void p0_prologue(Frame& F0) {
    Frame F = launder(F0);
    LAS float* scr = (LAS float*)(F.lds + F.wave * 16384);
    const int gw = F.bx * NWAVES + F.wave, NGW = F.G * NWAVES, lane = F.lane;
    constexpr int I_AB1 = 16 * (NAB / 32), I_C1 = 16 * (NC / 32), I_2 = 32 * 32, I_SQ = 16 * 32, I_PM = 4 * 8;
    constexpr int NITEMS = 2 * I_AB1 + 2 * I_C1 + 4 * I_2 + 16 * I_SQ + 8 * I_PM;
    if (gw < NITEMS) {
        TrItem cur, nxt; float va[32], vb[32]; f32x4 ga0, ga1, gb0, gb1;
        p0_resolve(F, gw, lane, cur); p0_tr_load(cur, lane, va, ga0, ga1);
        for (int it = gw; it < NITEMS; it += 2 * NGW) {
            const bool h1 = it + NGW < NITEMS, h2 = it + 2 * NGW < NITEMS;
            if (h1) { p0_resolve(F, it + NGW, lane, nxt); p0_tr_load(nxt, lane, vb, gb0, gb1); }
            p0_tr_finish(cur, lane, va, ga0, ga1, scr);
            if (h2) { p0_resolve(F, it + 2 * NGW, lane, cur); p0_tr_load(cur, lane, va, ga0, ga1); }
            if (h1) p0_tr_finish(nxt, lane, vb, gb0, gb1, scr);
        }
    }
    for (int m0 = 2 * gw; m0 < MP + MS + MMEM; m0 += 2 * NGW) {
        f32x4 v[2][4];
#pragma unroll
        for (int r = 0; r < 2; ++r) {
            const int m = m0 + r;
            const float* src = m < MP ? FIN(0) + (size_t)m * D : (m < MP + MS ? FIN(1) + (size_t)(m - MP) * D : FIN(2) + (size_t)(m - MP - MS) * D);
#pragma unroll
            for (int jj = 0; jj < 4; ++jj) v[r][jj] = ((const f32x4*)src + lane)[64 * jj];
        }
#pragma unroll
        for (int r = 0; r < 2; ++r) {
            const int m = m0 + r;
            if (m < MP) {
                const float s = p0_row_finish(v[r], ((bf16_t*)(F.ws + WS_XB)) + (size_t)m * D, nullptr, lane);
                if (lane < 16) ((float*)(F.ws + WS_RSQ))[(size_t)m * 16 + lane] = lane == 0 ? s : 0.f;
            } else if (m < MP + MS) {
                const int b = m - MP;
                const float s = p0_row_finish(v[r], ((bf16_t*)(F.ws + WS_XB)) + (size_t)m * D, ((float*)(F.ws + WS_XS)) + (size_t)b * D, lane);
                if (lane < 32) ((float*)(F.ws + WS_SMALL))[b * 32 + lane] = lane == 0 ? s : 0.f;
            } else {
                const int t = m - MP - MS;
                const float s = p0_row_finish(v[r], ((bf16_t*)(F.ws + WS_MEMB)) + (size_t)t * D, nullptr, lane);
                if (lane == 0) ((float*)(F.ws + WS_SMALL + 65536))[t] = rsqrtf(s * (1.0f / D) + EPS);
            }
        }
    }
}

__device__ __forceinline__ bf16x8 tr_frag(LAS unsigned char* p0, LAS unsigned char* p1) {
    const s16x4 lo = __builtin_amdgcn_ds_read_tr16_b64_v4i16((LAS s16x4*)p0);
    const s16x4 hi = __builtin_amdgcn_ds_read_tr16_b64_v4i16((LAS s16x4*)p1);
    return (bf16x8){lo[0], lo[1], lo[2], lo[3], hi[0], hi[1], hi[2], hi[3]};
}
#define MFMA16(a, b, c) __builtin_amdgcn_mfma_f32_16x16x32_bf16((a), (b), (c), 0, 0, 0)

constexpr int SGU_AS = 0, SGU_VS = 34816, SGU_RV = 34816 + 67584;
__device__ __forceinline__ void sgu_chunk(Frame& F0, int j, int n) {
    Frame F = launder(F0);
    LAS unsigned char* lds = F.lds;
    const int tid = F.tid, lane = F.lane, w = F.wave, fr = lane & 15, fq = lane >> 4, row0 = n * 128;
    LAS float* rvs = (LAS float*)(lds + SGU_RV);
    if (tid < 128) rvs[tid] = rstd16(((float*)(F.ws + WS_VSQ)) + (size_t)(row0 + tid) * 16);
    const bf16_t* ZV = ((bf16_t*)(F.ws + WS_Z)) + (size_t)2 * MP * D + (size_t)row0 * D;
    const bf16_t* ZUG = ((bf16_t*)(F.ws + WS_Z)) + (size_t)3 * MP * D + (size_t)row0 * D;
    bf16_t* A2 = ((bf16_t*)(F.ws + WS_A2)) + (size_t)row0 * 2048 + 1024;
    const unsigned voff = (unsigned)(tid >> 5) * (D * 2) + (unsigned)(tid & 31) * 16u;
    const unsigned woff = (unsigned)(tid >> 4) * 512u + (unsigned)(tid & 15) * 32u;
    const int wt_t = tid >> 4, wt_s0 = (tid & 15) * 8;
    const unsigned aoff = (unsigned)(tid >> 5) * 4096u + (unsigned)(tid & 31) * 16u;
    u32x4 vt[8]; f32x4 wt[8];
#define SGU_LOAD(g_) do { const char* vb_ = (const char*)(ZV + (g_) * 256); const char* wb_ = (const char*)(FIN(13) + (size_t)(j * 4 + (g_)) * 16384); \
        _Pragma("unroll") for (int i_ = 0; i_ < 8; ++i_) vt[i_] = *(const u32x4*)(vb_ + (size_t)(16 * i_) * D * 2 + voff); \
        _Pragma("unroll") for (int i_ = 0; i_ < 4; ++i_) { wt[2 * i_] = *(const f32x4*)(wb_ + (size_t)(32 * i_) * 512 + woff); wt[2 * i_ + 1] = *(const f32x4*)(wb_ + (size_t)(32 * i_) * 512 + woff + 16); } } while (0)
    SGU_LOAD(0);
    LDS_BARRIER();
#pragma unroll 1
    for (int g = 0; g < 4; ++g) {
#pragma unroll
        for (int i = 0; i < 8; ++i) *(LAS u32x4*)(lds + SGU_VS + ((tid >> 5) + 16 * i) * 528 + (tid & 31) * 16) = vt[i];
#pragma unroll
        for (int i = 0; i < 4; ++i) {
            const int t = wt_t + 32 * i; float v[8];
#pragma unroll
            for (int e = 0; e < 4; ++e) { v[e] = (wt_s0 + e <= t) ? wt[2 * i][e] * rvs[wt_s0 + e] : 0.f; v[4 + e] = (wt_s0 + 4 + e <= t) ? wt[2 * i + 1][e] * rvs[wt_s0 + 4 + e] : 0.f; }
            u32x4 o; o.x = cvt_pk_bf16(v[0], v[1]); o.y = cvt_pk_bf16(v[2], v[3]); o.z = cvt_pk_bf16(v[4], v[5]); o.w = cvt_pk_bf16(v[6], v[7]);
            *(LAS u32x4*)(lds + SGU_AS + t * 272 + wt_s0 * 2) = o;
        }
        LDS_BARRIER();
        if (g < 3) SGU_LOAD(g + 1);
        const int cg = g * 256 + 32 * w + 4 * fq;
        const unsigned lo_in = (unsigned)fr * (D * 2) + (unsigned)(32 * w + 4 * fq) * 2u, lo_out = (unsigned)fr * 4096u + (unsigned)(32 * w + 4 * fq) * 2u;
        u32x2 ugr[2][8];
#pragma unroll
        for (int nt = 0; nt < 2; ++nt)
#pragma unroll
            for (int mt = 0; mt < 8; ++mt) ugr[nt][mt] = *(const u32x2*)((const char*)(ZUG + (size_t)(16 * mt) * D + g * 256 + 16 * nt) + lo_in);
        f32x4 acc[8][2];
#pragma unroll
        for (int mt = 0; mt < 8; ++mt) { acc[mt][0] = (f32x4){0.f, 0.f, 0.f, 0.f}; acc[mt][1] = (f32x4){0.f, 0.f, 0.f, 0.f}; }
#pragma unroll
        for (int ks = 0; ks < 4; ++ks) {
            bf16x8 Bf[2];
#pragma unroll
            for (int nt = 0; nt < 2; ++nt) {
                LAS unsigned char* p = lds + SGU_VS + (32 * ks + 8 * fq + (fr >> 2)) * 528 + (32 * w + 16 * nt + 4 * (fr & 3)) * 2;
                Bf[nt] = tr_frag(p, p + 4 * 528);
            }
#pragma unroll
            for (int mt = 0; mt < 8; ++mt) {
                if (32 * ks <= 16 * mt + 15) {
                    const bf16x8 Af = *(LAS bf16x8*)(lds + SGU_AS + (16 * mt + fr) * 272 + (32 * ks + 8 * fq) * 2);
                    acc[mt][0] = MFMA16(Bf[0], Af, acc[mt][0]); acc[mt][1] = MFMA16(Bf[1], Af, acc[mt][1]);
                }
            }
        }
#pragma unroll
        for (int nt = 0; nt < 2; ++nt) {
            const int c = cg + 16 * nt;
            const f32x4 gg = *(const f32x4*)(FIN(15) + j * 1024 + c);
#pragma unroll
            for (int mt = 0; mt < 8; ++mt) {
                const int t = 16 * mt + fr;
                const float bb = FIN(14)[(j * 4 + g) * 128 + t];
                *(u32x2*)((char*)(A2 + (size_t)(16 * mt) * 2048 + g * 256 + 16 * nt) + lo_out) = pack4(unpack4(ugr[nt][mt]) * (acc[mt][nt] * gg + bb));
            }
        }
        LDS_BARRIER();
    }
#undef SGU_LOAD
}
template <int WIN> __device__ __forceinline__ void pool_load(const bf16_t* xau  , unsigned lo  , int pos0, u32x4 (&xr)[WIN + 7]) {
#pragma unroll
    for (int i = 0; i < WIN + 7; ++i) { const int rr = i - (WIN - 1); xr[i] = (u32x4){0u, 0u, 0u, 0u}; if (pos0 + rr >= 0) xr[i] = *(const u32x4*)((const char*)(xau + (ptrdiff_t)rr * D) + lo); }
}
template <int WIN> __device__ __forceinline__ void pool_build(const u32x4 (&xr)[WIN + 7], int pos0, LAS unsigned char* dst  ) {
    f32x4 S0 = (f32x4){0.f, 0.f, 0.f, 0.f}, S1 = S0;
#pragma unroll
    for (int i = 0; i < WIN - 1; ++i) { f32x4 a, b; unpack8(xr[i], a, b); S0 += a; S1 += b; }
#pragma unroll
    for (int r = 0; r < 8; ++r) {
        f32x4 a, b; unpack8(xr[WIN - 1 + r], a, b); S0 += a; S1 += b;
        const int cnt = (pos0 + r + 1) < WIN ? (pos0 + r + 1) : WIN; const float ic = 1.0f / (float)cnt;
        *(LAS u32x4*)(dst + r * 528) = pack8(S0 * ic - a, S1 * ic - b);
        f32x4 c, d; unpack8(xr[r], c, d); S0 -= c; S1 -= d;
    }
}
__device__ __forceinline__ void pool_mma_epi(Frame& F, int j, int g, int row0, const bf16_t* ZSGA, bf16_t* A2, LAS unsigned char* lds, int w, int fr, int fq) {
    const int cg = g * 256 + 32 * w + 4 * fq;
    const unsigned lo_in = (unsigned)fr * (D * 2) + (unsigned)(32 * w + 4 * fq) * 2u, lo_out = (unsigned)fr * 4096u + (unsigned)(32 * w + 4 * fq) * 2u, lo_pm = (unsigned)(32 * w + fr) * 512u + (unsigned)fq * 16u;
    u32x2 sgr[2][8];
#pragma unroll
    for (int nt = 0; nt < 2; ++nt)
#pragma unroll
        for (int mt = 0; mt < 8; ++mt) sgr[nt][mt] = *(const u32x2*)((const char*)(ZSGA + (size_t)(16 * mt) * D + g * 256 + 16 * nt) + lo_in);
    f32x4 acc[8][2];
#pragma unroll
    for (int mt = 0; mt < 8; ++mt) { acc[mt][0] = (f32x4){0.f, 0.f, 0.f, 0.f}; acc[mt][1] = (f32x4){0.f, 0.f, 0.f, 0.f}; }
    const bf16_t* pm = ((bf16_t*)(F.ws + WS_PMT)) + (size_t)(j * 4 + g) * 65536;
#pragma unroll
    for (int ks = 0; ks < 8; ++ks) {
        const bf16x8 B0 = *(const bf16x8*)((const char*)(pm + 32 * ks) + lo_pm), B1 = *(const bf16x8*)((const char*)(pm + 16 * 256 + 32 * ks) + lo_pm);
#pragma unroll
        for (int mt = 0; mt < 8; ++mt) {
            const bf16x8 Af = *(LAS bf16x8*)(lds + (16 * mt + fr) * 528 + (32 * ks + 8 * fq) * 2);
            acc[mt][0] = MFMA16(B0, Af, acc[mt][0]); acc[mt][1] = MFMA16(B1, Af, acc[mt][1]);
        }
    }
#pragma unroll
    for (int nt = 0; nt < 2; ++nt) {
        const int c = cg + 16 * nt;
        const f32x4 ps = *(const f32x4*)(FIN(12) + j * 1024 + c);
#pragma unroll
        for (int mt = 0; mt < 8; ++mt) *(u32x2*)((char*)(A2 + (size_t)(16 * mt) * 2048 + g * 256 + 16 * nt) + lo_out) = pack4(acc[mt][nt] * ps * unpack4(sgr[nt][mt]));
    }
}
__device__ __forceinline__ void pool_chunk(Frame& F0, int j, int n) {
    Frame F = launder(F0);
    LAS unsigned char* lds = F.lds;
    const int tid = F.tid, lane = F.lane, w = F.wave, fr = lane & 15, fq = lane >> 4, row0 = n * 128;
    const int cb = tid & 31, t0 = (tid >> 5) * 8, pos0 = (row0 & 2047) + t0;
    const bf16_t* xa = ((bf16_t*)(F.ws + WS_Z)) + (size_t)row0 * D; const unsigned xlo = (unsigned)(t0 * D + cb * 8) * 2u;
    const bf16_t* ZSGA = ((bf16_t*)(F.ws + WS_Z)) + (size_t)1 * MP * D + (size_t)row0 * D;
    bf16_t* A2 = ((bf16_t*)(F.ws + WS_A2)) + (size_t)row0 * 2048;
    LAS unsigned char* dst = lds + t0 * 528 + cb * 16;
    u32x4 x0[2 + 7]; pool_load<2>(xa, xlo, pos0, x0);
    pool_build<2>(x0, pos0, dst); LDS_BARRIER();
    u32x4 x1[4 + 7]; pool_load<4>(xa + 256, xlo, pos0, x1);
    pool_mma_epi(F, j, 0, row0, ZSGA, A2, lds, w, fr, fq); LDS_BARRIER();
    pool_build<4>(x1, pos0, dst); LDS_BARRIER();
    u32x4 x2[8 + 7]; pool_load<8>(xa + 512, xlo, pos0, x2);
    pool_mma_epi(F, j, 1, row0, ZSGA, A2, lds, w, fr, fq); LDS_BARRIER();
    pool_build<8>(x2, pos0, dst); LDS_BARRIER();
    pool_mma_epi(F, j, 2, row0, ZSGA, A2, lds, w, fr, fq); LDS_BARRIER();
    u32x4 x3[16 + 7]; pool_load<16>(xa + 768, xlo, pos0, x3);
    pool_build<16>(x3, pos0, dst); LDS_BARRIER();
    pool_mma_epi(F, j, 3, row0, ZSGA, A2, lds, w, fr, fq); LDS_BARRIER();
}
constexpr int ATT_SLOT = 64 * 528;
__device__ __forceinline__ void attn_prompt(Frame& F0, int layer) {
    Frame F = launder(F0);
    LAS unsigned char* lds = F.lds;
    const int tid = F.tid, lane = F.lane, w = F.wave, fr = lane & 15, fq = lane >> 4;
    const bf16_t* Kl = ((bf16_t*)(F.ws + WS_KB)) + (size_t)layer * MMEM * D; const bf16_t* Vl = ((bf16_t*)(F.ws + WS_VB)) + (size_t)layer * MMEM * D;
    for (int kk = F.rk; kk < 64; kk += F.rw) {
        const int b = F.xq, h = kk >> 4, qb = kk & 15;
        const size_t rowq = (size_t)b * SEQ + qb * 128 + 16 * w + fr;
        bf16x8 Qf[8];
#pragma unroll
        for (int ks = 0; ks < 8; ++ks) Qf[ks] = *(const bf16x8*)(((bf16_t*)(F.ws + WS_Q)) + rowq * D + h * 256 + 32 * ks + 8 * fq);
        const bf16_t* kbase = Kl + (size_t)(b * 256) * D + h * 256; const bf16_t* vbase = Vl + (size_t)(b * 256) * D + h * 256;
        u32x4 st[4];
#define ATT_GLOAD(c) do { const bf16_t* src_ = ((c) < 4 ? kbase : vbase) + (size_t)(64 * ((c) & 3)) * D; _Pragma("unroll") for (int i_ = 0; i_ < 4; ++i_) { const int idx_ = tid + 512 * i_; st[i_] = *(const u32x4*)(src_ + (size_t)(idx_ >> 5) * D + (idx_ & 31) * 8); } } while (0)
#define ATT_LSTORE(slot) do { _Pragma("unroll") for (int i_ = 0; i_ < 4; ++i_) { const int idx_ = tid + 512 * i_; *(LAS u32x4*)(lds + (slot) * ATT_SLOT + (idx_ >> 5) * 528 + (idx_ & 31) * 16) = st[i_]; } } while (0)
        f32x4 S[16], Oa[16]; bf16x8 Pf[8]; float inv = 0.f;
#pragma unroll
        for (int i = 0; i < 16; ++i) { S[i] = (f32x4){0.f, 0.f, 0.f, 0.f}; Oa[i] = (f32x4){0.f, 0.f, 0.f, 0.f}; }
        ATT_GLOAD(0); ATT_LSTORE(0); __syncthreads();
#pragma unroll
        for (int c = 0; c < 8; ++c) {
            if (c < 7) ATT_GLOAD(c + 1);
            LAS unsigned char* slot = lds + (c & 1) * ATT_SLOT;
            if (c < 4) {
#pragma unroll
                for (int ml = 0; ml < 4; ++ml)
#pragma unroll
                    for (int ks = 0; ks < 8; ++ks) {
                        const bf16x8 Kf = *(LAS bf16x8*)(slot + (16 * ml + fr) * 528 + (32 * ks + 8 * fq) * 2);
                        S[4 * c + ml] = MFMA16(Kf, Qf[ks], S[4 * c + ml]);
                    }
                if (c == 3) {
                    float mx = S[0][0];
#pragma unroll
                    for (int i = 0; i < 16; ++i) { mx = fmaxf(mx, fmaxf(fmaxf(S[i][0], S[i][1]), fmaxf(S[i][2], S[i][3]))); }
                    mx = fmaxf(mx, shx(mx, 16, lane)); mx = fmaxf(mx, shx(mx, 32, lane));
                    float sum = 0.f;
#pragma unroll
                    for (int i = 0; i < 16; ++i) {
#pragma unroll
                        for (int e = 0; e < 4; ++e) { S[i][e] = __builtin_amdgcn_exp2f(S[i][e] - mx); sum += S[i][e]; }
                    }
                    sum += shx(sum, 16, lane); sum += shx(sum, 32, lane);
                    inv = 1.0f / sum;
#pragma unroll
                    for (int a = 0; a < 8; ++a) {
                        u32x4 pw; pw.x = cvt_pk_bf16(S[2 * a][0], S[2 * a][1]); pw.y = cvt_pk_bf16(S[2 * a][2], S[2 * a][3]); pw.z = cvt_pk_bf16(S[2 * a + 1][0], S[2 * a + 1][1]); pw.w = cvt_pk_bf16(S[2 * a + 1][2], S[2 * a + 1][3]);
                        Pf[a] = __builtin_bit_cast(bf16x8, pw);
                    }
                }
            } else {
#pragma unroll
                for (int al = 0; al < 2; ++al)
#pragma unroll
                    for (int dt = 0; dt < 16; ++dt) {
                        LAS unsigned char* p = slot + (32 * al + 4 * fq + (fr >> 2)) * 528 + (16 * dt + 4 * (fr & 3)) * 2;
                        const bf16x8 Vf = tr_frag(p, p + 16 * 528);
                        Oa[dt] = MFMA16(Vf, Pf[2 * (c - 4) + al], Oa[dt]);
                    }
            }
            if (c < 7) ATT_LSTORE((c + 1) & 1);
            __syncthreads();
        }
#pragma unroll
        for (int dt = 0; dt < 16; ++dt) *(u32x2*)(((bf16_t*)(F.ws + WS_O)) + rowq * D + h * 256 + 16 * dt + 4 * fq) = pack4(Oa[dt] * inv);
#undef ATT_GLOAD
#undef ATT_LSTORE
    }
}

template <class Epi, int N>
__device__ __forceinline__ void sgemm16(Frame& F0, const bf16_t* A, const bf16_t* Bt, int K, const Epi& E) {
    Frame F = launder(F0);
    LAS unsigned char* lds = F.lds;
    constexpr int CW = N / 32, NT = CW / 16, KS = NT == 2 ? 8 : (NT == 10 ? 4 : 2), NG = 8 / KS, NTW = NT / NG;
    static_assert(NT * 16 == CW && NTW * NG == NT && 2 * CW <= NWAVES * 64, "sgemm16 geometry");
    const int tid = F.tid, lane = F.lane, w = F.wave, fr = lane & 15, fq = lane >> 4;
    const int ksi = w % KS, ng = w / KS, kslice = K / KS, nkb = kslice / 128;
    const bf16_t* A16 = A + (size_t)(16 * F.xq) * K;
    for (int slot = F.rk; slot < 32; slot += F.rw) {
        const int erow = tid / (CW / 8), ecg = tid % (CW / 8); const bool eact = tid < 2 * CW;
        typename Epi::Pre pre{};
        if (eact) pre = E.pre(16 * F.xq + erow, slot * CW + 8 * ecg);
        f32x4 acc[NTW];
#pragma unroll
        for (int jn = 0; jn < NTW; ++jn) acc[jn] = (f32x4){0.f, 0.f, 0.f, 0.f};
        const bf16_t* ap = A16 + (size_t)fr * K + ksi * kslice + 8 * fq;
        const bf16_t* bp = Bt + (size_t)(slot * CW + (ng * NTW) * 16 + fr) * K + ksi * kslice + 8 * fq;
        for (int kb = 0; kb < nkb; ++kb) {
            bf16x8 Af[4], Bf[4][NTW];
#pragma unroll
            for (int k4 = 0; k4 < 4; ++k4) {
                Af[k4] = *(const bf16x8*)(ap + 128 * kb + 32 * k4);
#pragma unroll
                for (int jn = 0; jn < NTW; ++jn) Bf[k4][jn] = *(const bf16x8*)(bp + (size_t)(16 * jn) * K + 128 * kb + 32 * k4);
            }
#pragma unroll
            for (int k4 = 0; k4 < 4; ++k4)
#pragma unroll
                for (int jn = 0; jn < NTW; ++jn) acc[jn] = MFMA16(Bf[k4][jn], Af[k4], acc[jn]);
        }
#pragma unroll
        for (int jn = 0; jn < NTW; ++jn) *(LAS f32x4*)(lds + ((size_t)((ksi * 16 + fr) * CW + (ng * NTW + jn) * 16 + 4 * fq)) * 4) = acc[jn];
        __syncthreads();
        if (eact) {
            f32x4 s0 = (f32x4){0.f, 0.f, 0.f, 0.f}, s1 = s0;
#pragma unroll
            for (int kk = 0; kk < KS; ++kk) { const LAS f32x4* p = (const LAS f32x4*)(lds + ((size_t)((kk * 16 + erow) * CW + 8 * ecg)) * 4); s0 += p[0]; s1 += p[1]; }
            E(16 * F.xq + erow, slot, slot * CW + 8 * ecg, s0, s1, pre);
        }
        __syncthreads();
    }
}
struct SEpiZ {
    struct Pre { float rs; };
    const float* rsqs; float* SZ; int ldz, mode;
    __device__ __forceinline__ Pre pre(int row, int col) const { return Pre{rstd32(rsqs + row * 32)}; }
    __device__ __forceinline__ void operator()(int row, int strip, int col, f32x4 s0, f32x4 s1, const Pre& p) const {
        const int oc0 = mode == 0 ? src_even(col) : src_odd(col), oc1 = mode == 0 ? src_even(col + 4) : src_odd(col + 4);
        float* q = SZ + (size_t)row * ldz; *(f32x4*)(q + oc0) = s0 * p.rs; *(f32x4*)(q + oc1) = s1 * p.rs;
    }
};
struct SEpiRes {
    struct Pre { f32x4 x0, x1; };
    float* xs; bf16_t* xb; float* rsqs;
    __device__ __forceinline__ Pre pre(int row, int col) const { const float* q = xs + (size_t)row * D + col; return Pre{*(const f32x4*)q, *(const f32x4*)(q + 4)}; }
    __device__ __forceinline__ void operator()(int row, int strip, int col, f32x4 s0, f32x4 s1, const Pre& pr) const {
        float* p = xs + (size_t)row * D + col; const f32x4 o0 = pr.x0 + s0, o1 = pr.x1 + s1;
        *(f32x4*)p = o0; *(f32x4*)(p + 4) = o1; *(u32x4*)(xb + (size_t)row * D + col) = pack8(o0, o1);
        const int ln = ((row & 15) << 2) | ((col >> 3) & 3);
        float ss = dot4(o0, o0) + dot4(o1, o1); ss += shx(ss, 1, ln); ss += shx(ss, 2, ln);
        if ((col & 31) == 0) rsqs[row * 32 + strip] = ss;
    }
};
struct SEpiQ {
    struct Pre { float rs; };
    const float* rsqs; float* SQ;
    __device__ __forceinline__ Pre pre(int row, int col) const { return Pre{rstd32(rsqs + row * 32)}; }
    __device__ __forceinline__ void operator()(int row, int strip, int col, f32x4 s0, f32x4 s1, const Pre& p) const {
        float* q = SQ + (size_t)row * D + col; *(f32x4*)q = s0 * p.rs; *(f32x4*)(q + 4) = s1 * p.rs;
    }
};
__device__ __forceinline__ void sample_mix_even(Frame& F0, int j, int b) {
    Frame F = launder(F0);
    LAS float* pl = (LAS float*)F.lds; LAS float* red = pl + 1024;
    const int tid = F.tid, lane = F.lane, w = F.wave;
    const float* z = ((float*)(F.ws + WS_SZ)) + (size_t)b * 8192;
    float vv[2], ss = 0.f;
#pragma unroll
    for (int k = 0; k < 2; ++k) { vv[k] = z[3072 + tid + 512 * k]; ss += vv[k] * vv[k]; }
    ss = wave_sum(ss, lane); if (lane == 0) red[w] = ss;
#pragma unroll
    for (int k = 0; k < 2; ++k) {
        const int c = tid + 512 * k, g = c >> 8, win = 2 << g; const float xa = z[c];
        const float* st = FIN(3) + ((size_t)(j * 128 + b) * 15) * 1024 + c;
        float s = xa; for (int r = 16 - win; r < 15; ++r) s += st[(size_t)r * 1024];
        pl[c] = s / (float)win - xa;
        float* po = F.out + O_POOLS + ((size_t)(j * 128 + b) * 15) * 1024 + c;
        for (int r = 0; r < 14; ++r) po[(size_t)r * 1024] = st[(size_t)(r + 1) * 1024];
        po[(size_t)14 * 1024] = xa;
    }
    __syncthreads();
    float tot = 0.f;
#pragma unroll
    for (int i = 0; i < 8; ++i) tot += red[i];
    const float rv = rsqrtf(tot * (1.0f / D) + EPS);
#pragma unroll
    for (int k = 0; k < 2; ++k) {
        const int d = tid + 512 * k, g = d >> 8, dd = d & 255;
        const bf16_t* pm = ((bf16_t*)(F.ws + WS_PMT)) + (size_t)(j * 4 + g) * 65536 + (size_t)dd * 256; const LAS float* pg = pl + g * 256;
        float a = 0.f;
#pragma unroll
        for (int hb = 0; hb < 2; ++hb) {
            u32x4 pr[16];
#pragma unroll
            for (int i = 0; i < 16; ++i) pr[i] = *(const u32x4*)(pm + hb * 128 + i * 8);
#pragma unroll
            for (int i = 0; i < 16; ++i) { f32x4 p0, p1; unpack8(pr[i], p0, p1); const LAS float* q = pg + hb * 128 + i * 8; a += dot4(p0, *(const LAS f32x4*)q) + dot4(p1, *(const LAS f32x4*)(q + 4)); }
        }
        const float ya = a * FIN(12)[j * 1024 + d] * silu_f(z[1024 + d]);
        const float vn = vv[k] * rv * FIN(15)[j * 1024 + d];
        F.out[O_SGUV + (size_t)(j * 128 + b) * 1024 + d] = vn;
        const float mixed = FIN(13)[(size_t)(j * 4 + g) * 16384] * vn + FIN(14)[(j * 4 + g) * 128];
        const float yb = z[2048 + d] * mixed * silu_f(z[4096 + d]);
        ((bf16_t*)(F.ws + WS_SA2))[(size_t)b * 2048 + d] = (bf16_t)(cvt_pk_bf16(ya, 0.f) & 0xffffu); ((bf16_t*)(F.ws + WS_SA2))[(size_t)b * 2048 + 1024 + d] = (bf16_t)(cvt_pk_bf16(yb, 0.f) & 0xffffu);
    }
    __syncthreads();
}
__device__ __forceinline__ void sample_conv_odd(Frame& F0, int j, int b) {
    Frame F = launder(F0);
    const int tid = F.tid;
    const float* z = ((float*)(F.ws + WS_SZ)) + (size_t)b * 8192;
    const float* cw = FIN(18) + (size_t)j * 3 * 2048;
#pragma unroll
    for (int k = 0; k < 4; ++k) {
        const int c = tid + 512 * k;
        const float e = z[2048 + c] * z[4096 + c];
        const float s0 = FIN(4)[((size_t)(j * 128 + b) * 2 + 0) * 2048 + c], s1 = FIN(4)[((size_t)(j * 128 + b) * 2 + 1) * 2048 + c];
        const float y = cw[c] * s0 + cw[2048 + c] * s1 + cw[4096 + c] * e;
        ((bf16_t*)(F.ws + WS_SA2))[(size_t)b * 2048 + c] = (bf16_t)(cvt_pk_bf16(z[c] * y * silu_f(z[6144 + c]), 0.f) & 0xffffu);
        float* po = F.out + O_CONVS + ((size_t)(j * 128 + b) * 2) * 2048 + c; po[0] = s1; po[2048] = e;
    }
}
__device__ __forceinline__ void attn_sample(Frame& F0, int layer) {
    Frame F = launder(F0);
    LAS float* sc = (LAS float*)F.lds;
    LAS float* red = sc + 512;
    const int tid = F.tid, lane = F.lane, w = F.wave;
    for (int item = F.rk; item < 32; item += F.rw) {
        const int b = 16 * F.xq + (item >> 1), hp = item & 1;
        const float* qp = ((float*)(F.ws + WS_SQ)) + (size_t)b * D + hp * 512;
        const f32x4 q0 = *(const f32x4*)(qp + 4 * lane), q1 = *(const f32x4*)(qp + 256 + 4 * lane);
        const float* kp = FIN(5) + ((size_t)(layer * 128 + b) * 256) * 1024 + hp * 512 + 4 * lane;
        const float* vp = FIN(6) + ((size_t)(layer * 128 + b) * 256) * 1024 + hp * 512 + 4 * lane;
#pragma unroll 8
        for (int mi = 0; mi < 32; ++mi) {
            const int m = 32 * w + mi;
            const f32x4 k0 = __builtin_nontemporal_load((const f32x4*)(kp + (size_t)m * 1024)), k1 = __builtin_nontemporal_load((const f32x4*)(kp + (size_t)m * 1024 + 256));
            const float d0 = wave_sum(dot4(k0, q0), lane), d1 = wave_sum(dot4(k1, q1), lane);
            if (lane == 0) { sc[m] = d0; sc[256 + m] = d1; }
        }
        __syncthreads();
        float p0[4], p1[4], mx0 = -INFINITY, mx1 = -INFINITY;
#pragma unroll
        for (int i = 0; i < 4; ++i) { p0[i] = sc[lane + 64 * i]; p1[i] = sc[256 + lane + 64 * i]; mx0 = fmaxf(mx0, p0[i]); mx1 = fmaxf(mx1, p1[i]); }
#pragma unroll
        for (int o = 1; o < 64; o <<= 1) { mx0 = fmaxf(mx0, shx(mx0, o, lane)); mx1 = fmaxf(mx1, shx(mx1, o, lane)); }
        float sm0 = 0.f, sm1 = 0.f;
#pragma unroll
        for (int i = 0; i < 4; ++i) { p0[i] = __builtin_amdgcn_exp2f(p0[i] - mx0); p1[i] = __builtin_amdgcn_exp2f(p1[i] - mx1); sm0 += p0[i]; sm1 += p1[i]; }
        sm0 = wave_sum(sm0, lane); sm1 = wave_sum(sm1, lane);
        const float i0 = 1.0f / sm0, i1 = 1.0f / sm1;
        __syncthreads();
        if (w == 0) {
#pragma unroll
            for (int i = 0; i < 4; ++i) { sc[lane + 64 * i] = p0[i] * i0; sc[256 + lane + 64 * i] = p1[i] * i1; }
        }
        __syncthreads();
        f32x4 a0 = (f32x4){0.f, 0.f, 0.f, 0.f}, a1 = a0;
#pragma unroll 8
        for (int mi = 0; mi < 32; ++mi) {
            const int m = 32 * w + mi;
            const f32x4 v0 = __builtin_nontemporal_load((const f32x4*)(vp + (size_t)m * 1024)), v1 = __builtin_nontemporal_load((const f32x4*)(vp + (size_t)m * 1024 + 256));
            a0 += v0 * sc[m]; a1 += v1 * sc[256 + m];
        }
        *(LAS f32x4*)(red + w * 512 + 4 * lane) = a0; *(LAS f32x4*)(red + w * 512 + 256 + 4 * lane) = a1;
        __syncthreads();
        {
            float o = 0.f;
#pragma unroll
            for (int ww = 0; ww < 8; ++ww) o += red[ww * 512 + tid];
            ((bf16_t*)(F.ws + WS_SO))[(size_t)b * D + hp * 512 + tid] = (bf16_t)(cvt_pk_bf16(o, 0.f) & 0xffffu);
        }
        __syncthreads();
    }
}
#define dpp_mov(v, ctrl, row_mask) __builtin_bit_cast(float, __builtin_amdgcn_update_dpp(0, __builtin_bit_cast(int, (float)(v)), (ctrl), (row_mask), 0xf, false))
__device__ __forceinline__ float wave_sum_dpp(float x) {
    x += dpp_mov(x, 0xB1, 0xf);
    x += dpp_mov(x, 0x4E, 0xf);
    x += dpp_mov(x, 0x141, 0xf);
    x += dpp_mov(x, 0x140, 0xf);
    x += dpp_mov(x, 0x142, 0xa);
    x += dpp_mov(x, 0x143, 0xc);
    return x;
}
constexpr int FA_SC = 69632, FA_RED = 71680;
__device__ __forceinline__ void attn_fused(Frame& F0, int layer) {
    Frame F = launder(F0);
    LAS unsigned char* lds = F.lds;
    const int tid = F.tid, lane = F.lane, w = F.wave, fr = lane & 15, fq = lane >> 4;
    const bf16_t* Kl = ((bf16_t*)(F.ws + WS_KB)) + (size_t)layer * MMEM * D; const bf16_t* Vl = ((bf16_t*)(F.ws + WS_VB)) + (size_t)layer * MMEM * D;
    LAS float* sc = (LAS float*)(lds + FA_SC); LAS float* red = (LAS float*)(lds + FA_RED);
    const int sb = 16 * F.xq + (F.rk >> 1), hp = F.rk & 1;
    const float* qp = ((float*)(F.ws + WS_SQ)) + (size_t)sb * D + hp * 512;
    const f32x4 q0 = *(const f32x4*)(qp + 4 * lane), q1 = *(const f32x4*)(qp + 256 + 4 * lane);
    const float* kp = FIN(5) + ((size_t)(layer * 128 + sb) * 256 + 4 * w) * 1024 + hp * 512;
    const float* vp = FIN(6) + ((size_t)(layer * 128 + sb) * 256 + 4 * w) * 1024 + hp * 512;
    const unsigned lo16 = (unsigned)lane * 16u;
    f32x4 sv[8]; f32x4 a0 = (f32x4){0.f, 0.f, 0.f, 0.f}, a1 = a0; float mx0 = 0.f, mx1 = 0.f, iv0 = 0.f, iv1 = 0.f;
#define FA_SLOAD(base, slice) do { unsigned long long pu_ = uni64((unsigned long long)((base) + (size_t)(32 * (slice)) * 1024)); asm volatile("" : "+s"(pu_)); const char* pc_ = (const char*)(const GAS char*)pu_; \
        _Pragma("unroll") for (int r_ = 0; r_ < 4; ++r_) { sv[2 * r_] = __builtin_nontemporal_load((const f32x4*)(pc_ + r_ * 4096 + lo16)); sv[2 * r_ + 1] = __builtin_nontemporal_load((const f32x4*)(pc_ + r_ * 4096 + 1024 + lo16)); } } while (0)
    FA_SLOAD(kp, 0);
#pragma unroll 1
    for (int ui = 0; ui < 2; ++ui) {
        const int kk = 2 * F.rk + ui;
        const int b = F.xq, h = kk >> 4, qb = kk & 15;
        const size_t rowq = (size_t)b * SEQ + qb * 128 + 16 * w + fr;
        bf16x8 Qf[8];
#pragma unroll
        for (int ks = 0; ks < 8; ++ks) Qf[ks] = *(const bf16x8*)(((bf16_t*)(F.ws + WS_Q)) + rowq * D + h * 256 + 32 * ks + 8 * fq);
        const bf16_t* kbase = Kl + (size_t)(b * 256) * D + h * 256; const bf16_t* vbase = Vl + (size_t)(b * 256) * D + h * 256;
        u32x4 st[4];
        const unsigned goff = (unsigned)(tid >> 5) * (D * 2) + (unsigned)(tid & 31) * 16u, loff = (unsigned)(tid >> 5) * 528u + (unsigned)(tid & 31) * 16u;
#define ATT_GLOAD(c) do { unsigned long long pu_ = uni64((unsigned long long)(((c) < 4 ? kbase : vbase) + (size_t)(64 * ((c) & 3)) * D)); asm volatile("" : "+s"(pu_)); const char* pc_ = (const char*)(const GAS char*)pu_; \
        _Pragma("unroll") for (int i_ = 0; i_ < 4; ++i_) st[i_] = *(const u32x4*)(pc_ + (size_t)(16 * i_) * D * 2 + goff); } while (0)
#define ATT_LSTORE(slot) do { _Pragma("unroll") for (int i_ = 0; i_ < 4; ++i_) *(LAS u32x4*)(lds + (slot) * ATT_SLOT + 16 * i_ * 528 + loff) = st[i_]; } while (0)
        f32x4 S[16], Oa[16]; bf16x8 Pf[8]; float inv = 0.f;
        const f32x4 zero4 = (f32x4){0.f, 0.f, 0.f, 0.f};
        if (ui == 1) {
            float p0[4], p1[4]; mx0 = -INFINITY; mx1 = -INFINITY;
#pragma unroll
            for (int i = 0; i < 4; ++i) { p0[i] = sc[lane + 64 * i]; p1[i] = sc[256 + lane + 64 * i]; mx0 = fmaxf(mx0, p0[i]); mx1 = fmaxf(mx1, p1[i]); }
#pragma unroll
            for (int o = 1; o < 64; o <<= 1) { mx0 = fmaxf(mx0, shx(mx0, o, lane)); mx1 = fmaxf(mx1, shx(mx1, o, lane)); }
            float sm0 = 0.f, sm1 = 0.f;
#pragma unroll
            for (int i = 0; i < 4; ++i) { sm0 += __builtin_amdgcn_exp2f(p0[i] - mx0); sm1 += __builtin_amdgcn_exp2f(p1[i] - mx1); }
            sm0 = wave_sum(sm0, lane); sm1 = wave_sum(sm1, lane);
            iv0 = 1.0f / sm0; iv1 = 1.0f / sm1;
        }
        ATT_GLOAD(0); ATT_LSTORE(0); __syncthreads();
#pragma unroll
        for (int c = 0; c < 8; ++c) {
            if (c < 7) ATT_GLOAD(c + 1);
            if (ui == 0) {
#pragma unroll
                for (int r = 0; r < 4; ++r) {
                    const int m = 32 * c + 4 * w + r;
                    const float d0 = wave_sum_dpp(dot4(sv[2 * r], q0)), d1 = wave_sum_dpp(dot4(sv[2 * r + 1], q1));
                    if (lane == 63) { sc[m] = d0; sc[256 + m] = d1; }
                }
                if (c < 7) FA_SLOAD(kp, c + 1); else FA_SLOAD(vp, 0);
            } else {
#pragma unroll
                for (int r = 0; r < 4; ++r) {
                    const int m = 32 * c + 4 * w + r;
                    const float p0 = __builtin_amdgcn_exp2f(sc[m] - mx0) * iv0, p1 = __builtin_amdgcn_exp2f(sc[256 + m] - mx1) * iv1;
                    a0 += sv[2 * r] * p0; a1 += sv[2 * r + 1] * p1;
                }
                if (c < 7) FA_SLOAD(vp, c + 1);
            }
            LAS unsigned char* slot = lds + (c & 1) * ATT_SLOT;
            if (c < 4) {
#pragma unroll
                for (int ml = 0; ml < 4; ++ml)
#pragma unroll
                    for (int ks = 0; ks < 8; ++ks) {
                        const bf16x8 Kf = *(LAS bf16x8*)(slot + (16 * ml + fr) * 528 + (32 * ks + 8 * fq) * 2);
                        S[4 * c + ml] = MFMA16(Kf, Qf[ks], ks == 0 ? zero4 : S[4 * c + ml]);
                    }
                if (c == 3) {
                    float mx = S[0][0];
#pragma unroll
                    for (int i = 0; i < 16; ++i) { mx = fmaxf(mx, fmaxf(fmaxf(S[i][0], S[i][1]), fmaxf(S[i][2], S[i][3]))); }
                    mx = fmaxf(mx, shx(mx, 16, lane)); mx = fmaxf(mx, shx(mx, 32, lane));
                    float sum = 0.f;
#pragma unroll
                    for (int i = 0; i < 16; ++i) {
#pragma unroll
                        for (int e = 0; e < 4; ++e) { S[i][e] = __builtin_amdgcn_exp2f(S[i][e] - mx); sum += S[i][e]; }
                    }
                    sum += shx(sum, 16, lane); sum += shx(sum, 32, lane);
                    inv = 1.0f / sum;
#pragma unroll
                    for (int a = 0; a < 8; ++a) {
                        u32x4 pw; pw.x = cvt_pk_bf16(S[2 * a][0], S[2 * a][1]); pw.y = cvt_pk_bf16(S[2 * a][2], S[2 * a][3]); pw.z = cvt_pk_bf16(S[2 * a + 1][0], S[2 * a + 1][1]); pw.w = cvt_pk_bf16(S[2 * a + 1][2], S[2 * a + 1][3]);
                        Pf[a] = __builtin_bit_cast(bf16x8, pw);
                    }
                }
            } else {
#pragma unroll
                for (int al = 0; al < 2; ++al)
#pragma unroll
                    for (int dt = 0; dt < 16; ++dt) {
                        LAS unsigned char* p = slot + (32 * al + 4 * fq + (fr >> 2)) * 528 + (16 * dt + 4 * (fr & 3)) * 2;
                        const bf16x8 Vf = tr_frag(p, p + 16 * 528);
                        Oa[dt] = MFMA16(Vf, Pf[2 * (c - 4) + al], (c == 4 && al == 0) ? zero4 : Oa[dt]);
                    }
            }
            if (c < 7) ATT_LSTORE((c + 1) & 1);
            __syncthreads();
        }
#pragma unroll
        for (int dt = 0; dt < 16; ++dt) *(u32x2*)(((bf16_t*)(F.ws + WS_O)) + rowq * D + h * 256 + 16 * dt + 4 * fq) = pack4(Oa[dt] * inv);
#undef ATT_GLOAD
#undef ATT_LSTORE
    }
#undef FA_SLOAD
    *(LAS f32x4*)(red + w * 512 + 4 * lane) = a0; *(LAS f32x4*)(red + w * 512 + 256 + 4 * lane) = a1;
    __syncthreads();
    {
        float o = 0.f;
#pragma unroll
        for (int ww = 0; ww < 8; ++ww) o += red[ww * 512 + tid];
        ((bf16_t*)(F.ws + WS_SO))[(size_t)sb * D + hp * 512 + tid] = (bf16_t)(cvt_pk_bf16(o, 0.f) & 0xffffu);
    }
    __syncthreads();
}
__device__ __forceinline__ void final_norm(Frame& F0) {
    Frame F = launder(F0);
    const int gwx = F.rk * NWAVES + F.wave, NGX = F.rw * NWAVES, lane = F.lane;
    f32x4 g[4];
#pragma unroll
    for (int jj = 0; jj < 4; ++jj) g[jj] = ((const f32x4*)FIN(24) + lane)[64 * jj];
    for (int p = gwx; p < SEQ / 2 + 8; p += NGX) {
        const int m0 = p < SEQ / 2 ? F.xq * SEQ + 2 * p : MP + 16 * F.xq + 2 * (p - SEQ / 2);
        f32x4 v[2][4];
#pragma unroll
        for (int r = 0; r < 2; ++r) {
            const int m = m0 + r;
            if (m < MP) {
                const u32x2* src = (const u32x2*)(((bf16_t*)(F.ws + WS_XB)) + (size_t)m * D) + lane;
#pragma unroll
                for (int jj = 0; jj < 4; ++jj) v[r][jj] = unpack4(src[64 * jj]);
            } else {
                const f32x4* src = (const f32x4*)(((float*)(F.ws + WS_XS)) + (size_t)(m - MP) * D) + lane;
#pragma unroll
                for (int jj = 0; jj < 4; ++jj) v[r][jj] = src[64 * jj];
            }
        }
#pragma unroll
        for (int r = 0; r < 2; ++r) {
            const int m = m0 + r; float s = 0.f;
#pragma unroll
            for (int jj = 0; jj < 4; ++jj) s += dot4(v[r][jj], v[r][jj]);
            float* dst = m < MP ? F.out + O_Y + (size_t)m * D : F.out + O_YS + (size_t)(m - MP) * D;
            const float rs = rsqrtf(wave_sum(s, lane) * (1.0f / D) + EPS);
#pragma unroll
            for (int jj = 0; jj < 4; ++jj) ((f32x4*)dst + lane)[64 * jj] = v[r][jj] * rs * g[jj];
        }
    }
}

struct Args { const float* in[25]; float* out; unsigned char* ws; int ph_lo, ph_hi; };
#define REP(bit) for (int rep_ = 0; rep_ < 1 + ((REP_MASK >> (bit)) & 1); ++rep_)
#ifndef XCD_LOCAL
#define XCD_LOCAL 1
#endif
#ifndef XCD_VID
#define XCD_VID 0
#endif
#ifndef MK_SPLIT
#define MK_SPLIT 0
#endif
__global__ void __launch_bounds__(NWAVES * 64, 2) fwd(Args args) {
    extern __shared__ __attribute__((aligned(16))) unsigned char lds_raw[];
    Frame F0;
    F0.lds = (LAS unsigned char*)lds_raw;
    F0.tid = threadIdx.x; F0.lane = F0.tid & 63; F0.wave = __builtin_amdgcn_readfirstlane(F0.tid >> 6); F0.G = gridDim.x; F0.bx = blockIdx.x;
    F0.in = (in_tab_t)__builtin_amdgcn_kernarg_segment_ptr();     F0.out = args.out; F0.ws = args.ws;
    for (int u = F0.tid; u < (LDS_BYTES - LDSCTL_OFF) / 4; u += NWAVES * 64) ((LAS unsigned*)(F0.lds + LDSCTL_OFF))[u] = 0u;
    __syncthreads();
    XcdBarrier bar; bar.wave = F0.wave; bar.bar = (unsigned*)(args.ws + WS_CTL) + CW_BAR; bar.x = 0; bar.st = nullptr;
    if (!MK_SPLIT) bar = xcd_barrier_post((unsigned*)(args.ws + WS_CTL) + CW_BAR, (volatile LAS unsigned*)(F0.lds + MISC_OFF) + 8, F0.wave);
    unsigned* rankw = (unsigned*)(args.ws + WS_CTL) + CW_RANK;
    const unsigned my_xcc = xb_xcc_id();
    unsigned my_rank = 0u;
    if (F0.tid == 0) ((volatile LAS unsigned*)(F0.lds + MISC_OFF))[12] = __hip_atomic_fetch_add(rankw + 64 * my_xcc, 1u, __ATOMIC_RELAXED, __HIP_MEMORY_SCOPE_AGENT);
    __syncthreads();
    my_rank = __builtin_amdgcn_readfirstlane(((volatile LAS unsigned*)(F0.lds + MISC_OFF))[12]);
    F0.vid = F0.bx;
    int ph = 0;
    bool local_ok = false;
    const int lo = args.ph_lo, hi = args.ph_hi;
#define PH_BEGIN if (ph >= lo && ph < hi) { Frame F = launder(F0);
#define PH_END } { const bool both_ = (ph >= lo && ph + 1 < hi); ++ph; if (!MK_SPLIT && both_) { XcdBarrier b2_ = bar; unsigned long long bp_ = uni64((unsigned long long)bar.bar); unsigned bx_ = __builtin_amdgcn_readfirstlane(bar.x); int bw_ = __builtin_amdgcn_readfirstlane(bar.wave); asm volatile("" : "+s"(bp_), "+s"(bx_), "+s"(bw_)); b2_.bar = (unsigned*)(GAS unsigned*)bp_; b2_.x = bx_; b2_.wave = bw_; if (local_ok && ph > 2) xcd_barrier_local(b2_); else xcd_barrier(b2_); if ((REP_MASK >> 19) & 1) xcd_barrier(b2_); if (ph == 2) local_ok = XCD_LOCAL && lo == 0 && __builtin_amdgcn_readfirstlane(__hip_atomic_load(rankw + 64 * 20, __ATOMIC_RELAXED, __HIP_MEMORY_SCOPE_AGENT)) == 0u;     } }

    PH_BEGIN REP(0) { p0_prologue(F0); __syncthreads(); } PH_END
    if (!MK_SPLIT && lo == 0) {
        unsigned nx = 0u, xi = 0u; bool even = (F0.G % 8) == 0;
        for (unsigned jx = 0; jx < 16; ++jx) { const unsigned c_ = __hip_atomic_load(rankw + 64 * jx, __ATOMIC_RELAXED, __HIP_MEMORY_SCOPE_AGENT); if (c_) { if (c_ != (unsigned)F0.G / 8u) even = false; if (jx < my_xcc) ++xi; ++nx; } }
        if (XCD_VID && even && nx == 8u) F0.vid = (int)(my_rank * 8u + xi);
        if (!(even && nx == 8u && (unsigned)(F0.bx % 8) == xi) && F0.tid == 0) __hip_atomic_store(rankw + 64 * 20, 1u, __ATOMIC_RELAXED, __HIP_MEMORY_SCOPE_AGENT);
        if (((REP_MASK >> 18) & 1) && !(even && nx == 8u && (unsigned)(F0.bx % 8) == xi) && F0.tid == 0) F0.out[O_YS + F0.bx] = __builtin_nanf("");
        F0.vid = __builtin_amdgcn_readfirstlane(F0.vid);
    }
    PH_BEGIN {
        if ((REP_MASK >> 17) & 1) {
            f32x4 pa[8]; bf16x8 pb = (bf16x8){(short)F.tid, 1, 2, 3, 4, 5, 6, 7};
#pragma unroll
            for (int i = 0; i < 8; ++i) pa[i] = (f32x4){(float)F.tid, 1.f, 2.f, (float)i};
#pragma unroll 1
            for (int it = 0; it < 512; ++it) {
#pragma unroll
                for (int r = 0; r < 4; ++r)
#pragma unroll
                    for (int i = 0; i < 8; ++i) pa[i] = MFMA16(pb, pb, pa[i]);
            }
            float sacc = 0.f;
#pragma unroll
            for (int i = 0; i < 8; ++i) sacc += pa[i][0] + pa[i][3];
            if (sacc == 12345.678f) ((float*)(F.ws + WS_Z))[F.tid] = sacc;
        }
        if ((REP_MASK >> 15) & 3) { pg8::Gemm gp{((bf16_t*)(F.ws + WS_XB)), ((bf16_t*)(F.ws + WS_C1)), MP, NC, ((REP_MASK >> 15) & 1) ? 1024 : 512}; pg8::StaticOrder Sp; Sp.init(MP, NC, F.G, (int)F.vid); EpiProbe Ep{((bf16_t*)(F.ws + WS_Z)), NC}; pg8::gemm_phase<EpiProbe, pg8::StaticOrder, true, true>(F.lds, gp, Sp, Ep, F.wave); }
        pg8::Gemm g{((bf16_t*)(F.ws + WS_MEMB)), ((bf16_t*)(F.ws + WS_WKV)), MMEM, 8192, D}; pg8::StaticOrder S; S.init(MMEM, 8192, F.G, (int)F.vid);
        EpiMemKV E{((float*)(F.ws + WS_SMALL + 65536)), F.out + O_MEMK, F.out + O_MEMV, ((bf16_t*)(F.ws + WS_KB)), ((bf16_t*)(F.ws + WS_VB))};
        REP(1) pg8::gemm_phase<EpiMemKV, pg8::StaticOrder, true, true>(F.lds, g, S, E, F.wave);
    } PH_END
#pragma unroll 1
    for (int l = 0; l < DEPTH; ++l) {
        const int j = l >> 1;
        if ((l & 1) == 0) {
            PH_BEGIN {
                pg8::Gemm g{((bf16_t*)(F.ws + WS_XB)), ((bf16_t*)(F.ws + WS_AB1)) + (size_t)j * NAB * D, MP, NAB, D}; pg8::StaticOrder S; S.init(MP, NAB, F.G, (int)F.vid);
                Unit u0{0, 0}; S.next(0, u0); rstd_table(((float*)(F.ws + WS_RSQ)), u0.pm, (LAS float*)(F.lds + RSTD_OFF), F.tid);
                EpiG1Even E{((float*)(F.ws + WS_RSQ)), ((bf16_t*)(F.ws + WS_Z)), ((float*)(F.ws + WS_VSQ)), F.out + O_POOLP + (size_t)j * 8 * 15 * 1024, (LAS const float*)(F.lds + RSTD_OFF), u0.pm};
                SEpiZ SE{((float*)(F.ws + WS_SMALL)), ((float*)(F.ws + WS_SZ)), 8192, 0};
                const bool s_first = (F.rk & 1) != 0;
                if (s_first) { REP(3) sgemm16<SEpiZ, NAB>(F, ((bf16_t*)(F.ws + WS_XB)) + (size_t)MP * D, ((bf16_t*)(F.ws + WS_AB1)) + (size_t)j * NAB * D, D, SE); }
                REP(2) pg8::gemm_phase<EpiG1Even, pg8::StaticOrder, true, true>(F.lds, g, S, E, F.wave);
                if (!s_first) { REP(3) sgemm16<SEpiZ, NAB>(F, ((bf16_t*)(F.ws + WS_XB)) + (size_t)MP * D, ((bf16_t*)(F.ws + WS_AB1)) + (size_t)j * NAB * D, D, SE); }
            } PH_END
            PH_BEGIN {
                REP(4) for (int i = F.rk; i < 32; i += F.rw) { if ((i & 1) == 0) sgu_chunk(F, j, 16 * F.xq + (i >> 1)); else pool_chunk(F, j, 16 * F.xq + (i >> 1)); }
                REP(5) for (int i = F.rk; i < 16; i += F.rw) sample_mix_even(F, j, 16 * F.xq + i);
            } PH_END
        } else {
            PH_BEGIN {
                pg8::Gemm g{((bf16_t*)(F.ws + WS_XB)), ((bf16_t*)(F.ws + WS_C1)) + (size_t)j * NC * D, MP, NC, D}; pg8::StaticOrder S; S.init(MP, NC, F.G, (int)F.vid);
                Unit u0{0, 0}; S.next(0, u0);
                for (int i = F.tid; i < 8 * 3 * 64; i += NWAVES * 64) { const int ui = i / 192, q = (i / 64) % 3, c = i & 63, pn = u0.pn + 4 * ui; ((LAS float*)(F.lds + CWL_OFF))[i] = pn < NC / 256 ? (FIN(18) + (size_t)j * 3 * 2048)[q * 2048 + pn * 64 + c] : 0.f; }
                rstd_table(((float*)(F.ws + WS_RSQ)), u0.pm, (LAS float*)(F.lds + RSTD_OFF), F.tid);
                EpiG1Odd E{((float*)(F.ws + WS_RSQ)), ((bf16_t*)(F.ws + WS_A2)), FIN(18) + (size_t)j * 3 * 2048, F.out + O_CONVP + (size_t)j * 8 * 2 * 2048, ((float*)(F.ws + WS_SIDE)), (LAS float*)(F.lds + HALO_OFF), (LAS const float*)(F.lds + RSTD_OFF), u0.pm, (LAS const float*)(F.lds + CWL_OFF), u0.pn};
                SEpiZ SE{((float*)(F.ws + WS_SMALL)), ((float*)(F.ws + WS_SZ)), 8192, 1};
                const bool s_first = (F.rk & 1) != 0;
                if (s_first) { REP(3) sgemm16<SEpiZ, NC>(F, ((bf16_t*)(F.ws + WS_XB)) + (size_t)MP * D, ((bf16_t*)(F.ws + WS_C1)) + (size_t)j * NC * D, D, SE); }
                REP(6) pg8::gemm_phase<EpiG1Odd, pg8::StaticOrder, true, true>(F.lds, g, S, E, F.wave);
                if (!s_first) { REP(3) sgemm16<SEpiZ, NC>(F, ((bf16_t*)(F.ws + WS_XB)) + (size_t)MP * D, ((bf16_t*)(F.ws + WS_C1)) + (size_t)j * NC * D, D, SE); }
            } PH_END
            PH_BEGIN {
                REP(5) for (int i = F.rk; i < 16; i += F.rw) sample_conv_odd(F, j, 16 * F.xq + i);
            } PH_END
        }
        PH_BEGIN {
            const bf16_t* W2 = ((l & 1) ? ((bf16_t*)(F.ws + WS_C2)) : ((bf16_t*)(F.ws + WS_AB2))) + (size_t)j * D * 2048;
            pg8::Gemm g{((bf16_t*)(F.ws + WS_A2)), W2, MP, D, 2048}; pg8::StaticOrder S; S.init(MP, D, F.G, (int)F.vid);
            if (l & 1) { Unit fu; for (int i = 0; S.next(i, fu); ++i) conv_fixup(((float*)(F.ws + WS_SIDE)), FIN(18) + (size_t)j * 3 * 2048, ((bf16_t*)(F.ws + WS_A2)), fu.pm, F.tid); asm volatile("s_waitcnt vmcnt(0)" ::: "memory"); __syncthreads(); }
            EpiRes E{((bf16_t*)(F.ws + WS_XB)), ((float*)(F.ws + WS_RSQ))};
            pg8::gemm_phase<EpiRes, pg8::StaticOrder, true, true>(F.lds, g, S, E, F.wave);
            SEpiRes SE{((float*)(F.ws + WS_XS)), ((bf16_t*)(F.ws + WS_XB)) + (size_t)MP * D, ((float*)(F.ws + WS_SMALL))};
            sgemm16<SEpiRes, D>(F, ((bf16_t*)(F.ws + WS_SA2)), W2, 2048, SE);
        } PH_END
        PH_BEGIN {
            pg8::Gemm g{((bf16_t*)(F.ws + WS_XB)), ((bf16_t*)(F.ws + WS_WQ)) + (size_t)l * D * D, MP, D, D}; pg8::StaticOrder S; S.init(MP, D, F.G, (int)F.vid);
            Unit u0{0, 0}; S.next(0, u0); rstd_table(((float*)(F.ws + WS_RSQ)), u0.pm, (LAS float*)(F.lds + RSTD_OFF), F.tid);
            EpiQ E{((float*)(F.ws + WS_RSQ)), ((bf16_t*)(F.ws + WS_Q)), (LAS const float*)(F.lds + RSTD_OFF), u0.pm};
            REP(8) pg8::gemm_phase<EpiQ, pg8::StaticOrder, true, true>(F.lds, g, S, E, F.wave);
            SEpiQ SE{((float*)(F.ws + WS_SMALL)), ((float*)(F.ws + WS_SQ))};
            REP(9) sgemm16<SEpiQ, D>(F, ((bf16_t*)(F.ws + WS_XB)) + (size_t)MP * D, ((bf16_t*)(F.ws + WS_WQ)) + (size_t)l * D * D, D, SE);
        } PH_END
        PH_BEGIN {
            if (F.G == 256) { REP(10) attn_fused(F, l); }
            else { attn_prompt(F, l); attn_sample(F, l); }
        } PH_END
        PH_BEGIN {
            pg8::Gemm g{((bf16_t*)(F.ws + WS_O)), ((bf16_t*)(F.ws + WS_WO)) + (size_t)l * D * D, MP, D, D}; pg8::StaticOrder S; S.init(MP, D, F.G, (int)F.vid);
            EpiRes E{((bf16_t*)(F.ws + WS_XB)), ((float*)(F.ws + WS_RSQ))};
            pg8::gemm_phase<EpiRes, pg8::StaticOrder, true, true>(F.lds, g, S, E, F.wave);
            SEpiRes SE{((float*)(F.ws + WS_XS)), ((bf16_t*)(F.ws + WS_XB)) + (size_t)MP * D, ((float*)(F.ws + WS_SMALL))};
            sgemm16<SEpiRes, D>(F, ((bf16_t*)(F.ws + WS_SO)), ((bf16_t*)(F.ws + WS_WO)) + (size_t)l * D * D, D, SE);
        } PH_END
    }
    PH_BEGIN final_norm(F0); PH_END
#undef PH_BEGIN
#undef PH_END
}
constexpr int N_PHASES = 2 + 6 * DEPTH + 1;

extern "C" void kernel_launch(void* const* d_in, const int* in_sizes, int n_in, void* d_out, int out_size, void* d_ws, size_t ws_size, hipStream_t stream) {
    static int grid = 0;
    if (grid == 0) {
        if (n_in != 25 || in_sizes[0] != MP * D || (size_t)out_size != O_END || ws_size < WS_END) { fprintf(stderr, "kernel_launch: unexpected shapes (n_in %d, in0 %d, out %d, ws %zu); nothing launched\n", n_in, n_in > 0 ? in_sizes[0] : -1, out_size, ws_size); grid = -1; return; }
        int dev = 0, cus = 0, per_cu = 0;
        if (hipGetDevice(&dev) != hipSuccess || hipDeviceGetAttribute(&cus, hipDeviceAttributeMultiprocessorCount, dev) != hipSuccess) { fprintf(stderr, "kernel_launch: device query failed\n"); grid = -1; return; }
        if (hipFuncSetAttribute((const void*)fwd, hipFuncAttributeMaxDynamicSharedMemorySize, LDS_BYTES) != hipSuccess) { fprintf(stderr, "kernel_launch: hipFuncSetAttribute failed\n"); grid = -1; return; }
        if (hipOccupancyMaxActiveBlocksPerMultiprocessor(&per_cu, (const void*)fwd, NWAVES * 64, LDS_BYTES) != hipSuccess || per_cu < 1) fprintf(stderr, "kernel_launch: note: occupancy query reports %d workgroups per CU\n", per_cu);
        (void)hipGetLastError();
        grid = cus;
    }
    if (grid < 0) return;
    if (hipMemsetAsync((char*)d_ws + WS_CTL, 0, CTL_ZERO_BYTES, stream) != hipSuccess) { fprintf(stderr, "kernel_launch: memset failed\n"); return; }
    Args a{};
    for (int i = 0; i < 25; ++i) a.in[i] = (const float*)d_in[i];
    a.out = (float*)d_out; a.ws = (unsigned char*)d_ws;
#if MK_SPLIT
    for (int p = 0; p < N_PHASES; ++p) { a.ph_lo = p; a.ph_hi = p + 1; hipLaunchKernelGGL(fwd, dim3(grid), dim3(NWAVES * 64), LDS_BYTES, stream, a); }
#else
    a.ph_lo = 0; a.ph_hi = N_PHASES;
    hipLaunchKernelGGL(fwd, dim3(grid), dim3(NWAVES * 64), LDS_BYTES, stream, a);
#endif
    const hipError_t le = hipPeekAtLastError();
    if (le != hipSuccess) fprintf(stderr, "kernel_launch: launch failed: %s\n", hipGetErrorName(le));
}
```

```cpp
#include <hip/hip_runtime.h>
#include <cstdio>
#include <cstdint>
#ifndef REP_MASK
#define REP_MASK 0
#endif
#ifndef SPLIT_PROLOGUE
#define SPLIT_PROLOGUE 1
#endif
#ifndef XCD_LOCAL
#define XCD_LOCAL 1
#endif
#ifndef XCD_VID
#define XCD_VID 0
#endif
#ifndef MK_SPLIT
#define MK_SPLIT 0
#endif
__device__ __forceinline__ int hw_lane() { int l; asm volatile("v_mbcnt_lo_u32_b32 %0, -1, 0\n\tv_mbcnt_hi_u32_b32 %0, -1, %0" : "=v"(l)); return l; }
namespace pg8 {
#define PG8_LAS __attribute__((address_space(3)))
typedef unsigned short bf16_t;
typedef short bf16x8 __attribute__((ext_vector_type(8)));
typedef float f32x4 __attribute__((ext_vector_type(4)));
typedef unsigned u32x4 __attribute__((ext_vector_type(4)));
constexpr int BM = 256, BK = 64, HALF = 128, HTB = HALF * BK * 2  , STAGE_BYTES = 8 * HTB, NXCD = 8, WGM = 8;

__host__ __device__ __forceinline__ int lds_byte(int r, int c) { const int st = (r >> 4) * 2 + (c >> 5), rr = r & 15, cc = c & 31, ob = rr * 64 + cc * 2; return st * 1024 + (ob ^ (((ob >> 9) & 1) << 5)); }
__host__ __device__ __forceinline__ void stage_rc(int b, int& R, int& C) { const int st = b / 1024, sb = b % 1024, swz = sb ^ (((sb >> 9) & 1) << 5); R = (st >> 1) * 16 + swz / 64; C = (st & 1) * 32 + (swz % 64) / 2; }
__host__ __device__ __forceinline__ int perm32(int rho) { const int n = rho >> 4, i = rho & 15; return 8 * (i >> 2) + 4 * n + (i & 3); }

struct Unit { int pm, pn; };
struct Gemm { const bf16_t* A; const bf16_t* Bt; int M, N, K; };

struct StaticOrder {
    int nM, nN, nwg, G, c;
    __host__ __device__ __forceinline__ void init(int M, int N, int G_, int c_) { nM = M / BM; nN = N / BM; nwg = nM * nN; G = G_; c = c_; }
    __host__ __device__ __forceinline__ bool next(int i, Unit& u) const {
        const long L = (long)i * G + c; if (L >= nwg) return false;
        int wgid = (int)L; { const int q = nwg / NXCD, r = nwg % NXCD, xcd = wgid % NXCD, off = wgid / NXCD; wgid = (xcd < r ? xcd * (q + 1) : r * (q + 1) + (xcd - r) * q) + off; }
        const int nig = WGM * nN, gid = wgid / nig, fm = gid * WGM, gsz = (nM - fm) < WGM ? (nM - fm) : WGM;
        u.pm = fm + ((wgid % nig) % gsz); u.pn = (wgid % nig) / gsz; return true;
    }
    __device__ __forceinline__ void a_ready(const Unit&) const {}
    __device__ __forceinline__ void done(const Unit&) const {}
};

typedef float f32x2cv __attribute__((ext_vector_type(2))); typedef __bf16 bf16x2cv __attribute__((ext_vector_type(2)));
__device__ __forceinline__ unsigned cvt_pk_bf16(float lo, float hi) { const f32x2cv v = {lo, hi}; return __builtin_bit_cast(unsigned, __builtin_convertvector(v, bf16x2cv)); }
template <class Epi, class Sched, bool ALIGN_EPI = false, bool SP2 = false>
__device__ __forceinline__ void gemm_phase(PG8_LAS unsigned char* lds, const Gemm g, const Sched& S, const Epi& E, const int wave_id) {
    int tid_ = (wave_id << 6) | hw_lane(); asm volatile("" : "+v"(tid_));
    const int tid = tid_, wid = __builtin_amdgcn_readfirstlane(tid >> 6), lane = tid & 63, wr = wid >> 2, wc = wid & 3, fr = lane & 15, fq = lane >> 4;
    const int K = g.K, nt = K / BK;
    unsigned voffA[2], voffB[2];
#pragma unroll
    for (int i = 0; i < 2; ++i) { int R, C; stage_rc(tid * 16 + i * 8192, R, C); const int Rb = Epi::PERM ? ((R & ~31) + perm32(R & 31)) : R;
        voffA[i] = (unsigned)(R * K + C) * 2u; voffB[i] = (unsigned)(Rb * K + C) * 2u; }
    const size_t kstep = (size_t)(BK * 2);
    const size_t hstep = (size_t)HALF * K * 2;
    const size_t tstep = 2 * hstep;
    const unsigned ldsw = (unsigned)wid * 1024u;
    const int aoff = lds_byte(wr * 64 + fr, fq * 8), boff = lds_byte(wc * 32 + fr, fq * 8);
#define PG8_SA(b, h) (((b) * 2 + (h)) * HTB)
#define PG8_SB(b, h) ((4 + (b) * 2 + (h)) * HTB)
#define PG8_STAGE(bufoff, gbase, voff) do { _Pragma("unroll") for (int _i = 0; _i < 2; ++_i) \
        __builtin_amdgcn_global_load_lds((const unsigned*)((const char*)(gbase) + (voff)[_i]), (PG8_LAS unsigned*)(lds + (bufoff) + ldsw + _i * 8192), 16, 0, 0); } while (0)
#define PG8_LDA(dst, b, h) do { _Pragma("unroll") for (int m = 0; m < 4; ++m) _Pragma("unroll") for (int k = 0; k < 2; ++k) dst[m][k] = *(const PG8_LAS bf16x8*)(lds + PG8_SA(b, h) + aoff + m * 2048 + k * 1024); } while (0)
#define PG8_LDB(dst, b, h) do { _Pragma("unroll") for (int n = 0; n < 2; ++n) _Pragma("unroll") for (int k = 0; k < 2; ++k) dst[n][k] = *(const PG8_LAS bf16x8*)(lds + PG8_SB(b, h) + boff + n * 2048 + k * 1024); } while (0)
#define PG8_MMA(ai, bj, At, Bt) do { __builtin_amdgcn_s_setprio(1); _Pragma("unroll") for (int m = 0; m < 4; ++m) _Pragma("unroll") for (int n = 0; n < 2; ++n) _Pragma("unroll") for (int k = 0; k < 2; ++k) \
        acc[ai][bj][m][n] = __builtin_amdgcn_mfma_f32_16x16x32_bf16(Bt[n][k], At[m][k], acc[ai][bj][m][n], 0, 0, 0); __builtin_amdgcn_s_setprio(0); } while (0)
#define PG8_WAIT_V(n) asm volatile("s_waitcnt vmcnt(" #n ")" ::: "memory")
#define PG8_WAIT_L(n) asm volatile("s_waitcnt lgkmcnt(" #n ")" ::: "memory")
#define PG8_BAR __builtin_amdgcn_s_barrier()
#define PG8_SCHED __builtin_amdgcn_sched_barrier(0)
    Unit cur, nxt; int ui = 0;
    if (!S.next(0, cur)) return;
    f32x4 acc[2][2][4][2];
#pragma unroll
    for (int a = 0; a < 2; ++a)
#pragma unroll
        for (int b = 0; b < 2; ++b)
#pragma unroll
            for (int m = 0; m < 4; ++m)
#pragma unroll
                for (int n = 0; n < 2; ++n) acc[a][b][m][n] = (f32x4){0.f, 0.f, 0.f, 0.f};
    bf16x8 At[4][2], B0[2][2], B1[2][2];
    const char* cA = (const char*)g.A + (size_t)cur.pm * tstep; const char* cB = (const char*)g.Bt + (size_t)cur.pn * tstep;
    S.a_ready(cur);
    if constexpr (SP2) {
        PG8_STAGE(PG8_SB(0, 0), cB, voffB); PG8_STAGE(PG8_SB(0, 1), cB + hstep, voffB); PG8_STAGE(PG8_SA(0, 0), cA, voffA); PG8_STAGE(PG8_SA(0, 1), cA + hstep, voffA);
        if (wr == 1) PG8_BAR;
        PG8_WAIT_V(2); PG8_BAR;
        PG8_STAGE(PG8_SB(1, 0), cB + kstep, voffB); PG8_STAGE(PG8_SA(1, 0), cA + kstep, voffA); PG8_STAGE(PG8_SB(1, 1), cB + hstep + kstep, voffB);
        PG8_WAIT_V(6); PG8_BAR;
    } else {
        PG8_STAGE(PG8_SB(0, 0), cB, voffB); PG8_STAGE(PG8_SA(0, 0), cA, voffA); PG8_STAGE(PG8_SB(0, 1), cB + hstep, voffB); PG8_STAGE(PG8_SA(0, 1), cA + hstep, voffA);
        if (wr == 1) PG8_BAR;
        PG8_WAIT_V(4); PG8_BAR;
        PG8_STAGE(PG8_SB(1, 0), cB + kstep, voffB); PG8_STAGE(PG8_SA(1, 0), cA + kstep, voffA); PG8_STAGE(PG8_SB(1, 1), cB + hstep + kstep, voffB);
        PG8_WAIT_V(6); PG8_BAR;
    }
    for (;;) {
        const bool has_next = S.next(ui + 1, nxt);
        const char* nA = has_next ? (const char*)g.A + (size_t)nxt.pm * tstep : cA; const char* nB = has_next ? (const char*)g.Bt + (size_t)nxt.pn * tstep : cB;
        for (int t = 0; t < nt; t += 2) {
            const bool last = (t == nt - 2);
            const char* a1 = cA + (size_t)(t + 1) * kstep;
            const char* a2 = last ? nA : cA + (size_t)(t + 2) * kstep; const char* b2 = last ? nB : cB + (size_t)(t + 2) * kstep;
            const char* a3 = a2 + kstep; const char* b3 = b2 + kstep;
            if (last && has_next) S.a_ready(nxt);
            if constexpr (SP2) {
            PG8_LDB(B0, 0, 0); PG8_LDB(B1, 0, 1); PG8_SCHED; PG8_LDA(At, 0, 0); PG8_STAGE(PG8_SA(1, 1), a1 + hstep, voffA);
            PG8_WAIT_V(8); PG8_WAIT_L(0); PG8_BAR; PG8_MMA(0, 0, At, B0); PG8_MMA(0, 1, At, B1); PG8_BAR; PG8_SCHED;
            PG8_LDA(At, 0, 1); PG8_STAGE(PG8_SB(0, 0), b2, voffB); PG8_STAGE(PG8_SB(0, 1), b2 + hstep, voffB); PG8_STAGE(PG8_SA(0, 0), a2, voffA);
            PG8_WAIT_V(8); PG8_WAIT_L(0); PG8_BAR; PG8_MMA(1, 0, At, B0); PG8_MMA(1, 1, At, B1); PG8_BAR; PG8_SCHED;
            PG8_LDB(B0, 1, 0); PG8_LDB(B1, 1, 1); PG8_SCHED; PG8_LDA(At, 1, 0); PG8_STAGE(PG8_SA(0, 1), a2 + hstep, voffA);
            PG8_WAIT_V(8); PG8_WAIT_L(0); PG8_BAR; PG8_MMA(0, 0, At, B0); PG8_MMA(0, 1, At, B1); PG8_BAR; PG8_SCHED;
            PG8_LDA(At, 1, 1); PG8_STAGE(PG8_SB(1, 0), b3, voffB); PG8_STAGE(PG8_SB(1, 1), b3 + hstep, voffB); PG8_STAGE(PG8_SA(1, 0), a3, voffA);
            PG8_WAIT_V(8); PG8_WAIT_L(0); PG8_BAR; PG8_MMA(1, 0, At, B0); PG8_MMA(1, 1, At, B1); PG8_BAR; PG8_SCHED;
            } else {
            PG8_LDB(B0, 0, 0); PG8_SCHED; PG8_LDA(At, 0, 0); PG8_STAGE(PG8_SA(1, 1), a1 + hstep, voffA);
            PG8_WAIT_L(8); PG8_BAR; PG8_WAIT_L(0); PG8_MMA(0, 0, At, B0); PG8_BAR; PG8_SCHED;
            PG8_LDB(B1, 0, 1); PG8_STAGE(PG8_SB(0, 0), b2, voffB);
            PG8_BAR; PG8_WAIT_L(0); PG8_MMA(0, 1, At, B1); PG8_BAR;
            PG8_LDA(At, 0, 1); PG8_STAGE(PG8_SA(0, 0), a2, voffA);
            PG8_BAR; PG8_WAIT_L(0); PG8_MMA(1, 0, At, B0); PG8_BAR; PG8_SCHED;
            PG8_STAGE(PG8_SB(0, 1), b2 + hstep, voffB);
            PG8_WAIT_V(6); PG8_BAR; PG8_MMA(1, 1, At, B1); PG8_BAR;
            PG8_LDB(B0, 1, 0); PG8_SCHED; PG8_LDA(At, 1, 0); PG8_STAGE(PG8_SA(0, 1), a2 + hstep, voffA);
            PG8_WAIT_L(8); PG8_BAR; PG8_WAIT_L(0); PG8_MMA(0, 0, At, B0); PG8_BAR; PG8_SCHED;
            PG8_LDB(B1, 1, 1); PG8_STAGE(PG8_SB(1, 0), b3, voffB);
            PG8_BAR; PG8_WAIT_L(0); PG8_MMA(0, 1, At, B1); PG8_BAR;
            PG8_LDA(At, 1, 1); PG8_STAGE(PG8_SA(1, 0), a3, voffA);
            PG8_BAR; PG8_WAIT_L(0); PG8_MMA(1, 0, At, B0); PG8_BAR; PG8_SCHED;
            PG8_STAGE(PG8_SB(1, 1), b3 + hstep, voffB);
            PG8_WAIT_V(6); PG8_BAR; PG8_MMA(1, 1, At, B1); PG8_BAR;
            }
        }
        if constexpr (ALIGN_EPI) { if (wr == 0) PG8_BAR; }
        if constexpr (!Epi::AFTER_DRAIN) { for (int rep_ = 0; rep_ < 1 + (Epi::REP_EPI ? 1 : 0); ++rep_) E(acc, cur, wr, wc, fr, fq); S.done(cur); }
        if (!has_next) break;
#pragma unroll
        for (int a = 0; a < 2; ++a)
#pragma unroll
            for (int b = 0; b < 2; ++b)
#pragma unroll
                for (int m = 0; m < 4; ++m)
#pragma unroll
                    for (int n = 0; n < 2; ++n) acc[a][b][m][n] = (f32x4){0.f, 0.f, 0.f, 0.f};
        cur = nxt; cA = nA; cB = nB; ++ui;
        if constexpr (ALIGN_EPI) { if (wr == 1) PG8_BAR; }
    }
    PG8_WAIT_V(0);
    if constexpr (!ALIGN_EPI) { if (wr == 0) PG8_BAR; }
    PG8_BAR;
    if constexpr (Epi::AFTER_DRAIN) { E.fused(acc, cur, wr, wc, fr, fq, lds, wid, lane); S.done(cur); }
#undef PG8_SA
#undef PG8_SB
#undef PG8_STAGE
#undef PG8_LDA
#undef PG8_LDB
#undef PG8_MMA
#undef PG8_WAIT_V
#undef PG8_WAIT_L
#undef PG8_BAR
#undef PG8_SCHED
}
}

using pg8::bf16_t; using pg8::bf16x8; using pg8::f32x4; using pg8::u32x4; using pg8::Unit; using pg8::cvt_pk_bf16;
#define GAS __attribute__((address_space(1)))
#define LAS __attribute__((address_space(3)))
typedef unsigned u32x2 __attribute__((ext_vector_type(2)));
typedef short s16x4 __attribute__((ext_vector_type(4)));
typedef GAS unsigned gu32;
#define RLX_AGENT __ATOMIC_RELAXED, __HIP_MEMORY_SCOPE_AGENT

constexpr int NWAVES = 8;
constexpr int D = 1024, MP = 16384, MS = 128, SEQ = 2048, NBATCH = 8, NMEM = 256, MMEM = 2048, DEPTH = 4;
constexpr int NAB = 5120, NC = 8192;
constexpr float EPS = 1e-6f;
constexpr float QSCALE = 0.0625f * 1.4426950408889634f;

constexpr size_t O_Y = 0, O_YS = O_Y + (size_t)MP * D, O_POOLP = O_YS + (size_t)MS * D, O_POOLS = O_POOLP + 2 * 8 * 15 * 1024,
                 O_CONVP = O_POOLS + (size_t)2 * 128 * 15 * 1024, O_CONVS = O_CONVP + 2 * 8 * 2 * 2048, O_SGUV = O_CONVS + (size_t)2 * 128 * 2 * 2048,
                 O_MEMK = O_SGUV + 2 * 128 * 1024, O_MEMV = O_MEMK + (size_t)4 * MMEM * D, O_END = O_MEMV + (size_t)4 * MMEM * D;
static_assert(O_END == 39239680, "output size");

constexpr size_t MiB = 1u << 20;
constexpr size_t WS_CTL = 0, CTL_ZERO_BYTES = 1 * MiB;
constexpr size_t WS_AB1 = 2 * MiB, WS_C1 = 22 * MiB, WS_AB2 = 54 * MiB, WS_C2 = 62 * MiB, WS_WQ = 70 * MiB, WS_WKV = 78 * MiB, WS_WO = 94 * MiB, WS_PMT = 102 * MiB;
constexpr size_t WS_XB = 104 * MiB;
constexpr size_t WS_RSQ = 137 * MiB, WS_VSQ = 138 * MiB;
constexpr size_t WS_SMALL = 139 * MiB;
constexpr size_t WS_Z = 140 * MiB;
constexpr size_t WS_A2 = 268 * MiB;
constexpr size_t WS_Q = 332 * MiB, WS_O = 364 * MiB;
constexpr size_t WS_MEMB = 396 * MiB, WS_KB = 400 * MiB, WS_VB = 416 * MiB;
constexpr size_t WS_XS = 432 * MiB, WS_SZ = 433 * MiB, WS_SA2 = 437 * MiB, WS_SQ = 438 * MiB, WS_SO = 439 * MiB, WS_SIDE = 440 * MiB  , WS_END = 444 * MiB;
constexpr int CW_BAR = 4096, CW_RANK = 8192;

constexpr int RING_BYTES = 131072, LDSCTL_OFF = RING_BYTES, MISC_OFF = LDSCTL_OFF + 320, HALO_OFF = RING_BYTES + 1024  , RSTD_OFF = HALO_OFF + 8192  , CWL_OFF = RSTD_OFF + 1024  , LDS_BYTES = 155648;

#define LDS_WAIT() asm volatile("s_waitcnt lgkmcnt(0)" ::: "memory")
#define LDS_BARRIER() asm volatile("s_waitcnt lgkmcnt(0)\n\ts_barrier" ::: "memory")

#define XB_TMO      128
#define XB_XCNT(j)  (256  + 64 * (j))
#define XB_XSUB(j)  (1280 + 64 * (j))
#define XB_XGEN(j)  (2304 + 64 * (j))
#define XB_TOP      3328
#define XB_TOPGEN   3392
#define XCD_BAR_WORDS 3456
#define XB_SPIN_CAP (1u << 18)

__device__ __forceinline__ unsigned xb_ld(unsigned* p)              { return __hip_atomic_load(p, __ATOMIC_RELAXED, __HIP_MEMORY_SCOPE_AGENT); }
__device__ __forceinline__ unsigned xb_add(unsigned* p, unsigned v) { return __hip_atomic_fetch_add(p, v, __ATOMIC_RELAXED, __HIP_MEMORY_SCOPE_AGENT); }
__device__ __forceinline__ unsigned xb_xcc_id() { return (unsigned)__builtin_amdgcn_s_getreg((3 << 11) | 20) & 0xFu; }
#define XB_SPIN(cond, bar) do { unsigned _sp = 0; while (cond) { __builtin_amdgcn_s_sleep(1); \
    if ((++_sp & 255u) == 0u) { if (xb_ld(&(bar)[XB_TMO])) break; if (_sp > XB_SPIN_CAP) { atomicAdd(&(bar)[XB_TMO], 1u); break; } } } } while (0)

struct XcdBarrier {
    int wave;
    unsigned* bar; unsigned x;
    volatile LAS unsigned* st;
};

__device__ __forceinline__ XcdBarrier xcd_barrier_post(unsigned* bar, volatile LAS unsigned* st, int wave) {
    XcdBarrier b; b.wave = wave; b.bar = bar; b.x = xb_xcc_id(); b.st = st;
    if (b.wave == 0 && hw_lane() == 0) (void)xb_add(&bar[XB_XCNT(b.x)], 1u);
    return b;
}
__device__ __forceinline__ void xcd_barrier_complete(unsigned* bar, unsigned x, unsigned& nloc, unsigned& nx) {
    const unsigned G = gridDim.x * gridDim.y * gridDim.z;
    unsigned sum, cnt, mine, sp = 0u;
    for (;;) {
        sum = 0u; cnt = 0u; mine = 0u;
#pragma unroll
        for (unsigned j = 0; j < 16; ++j) { const unsigned c = xb_ld(&bar[XB_XCNT(j)]); sum += c; cnt += (c > 0u) ? 1u : 0u; mine = (j == x) ? c : mine; }
        if (sum == G) break;
        __builtin_amdgcn_s_sleep(1);
        if ((++sp & 255u) == 0u) { if (xb_ld(&bar[XB_TMO])) break; if (sp > XB_SPIN_CAP) { atomicAdd(&bar[XB_TMO], 1u); break; } }
    }
    nloc = mine > 0u ? mine : 1u; nx = cnt > 0u ? cnt : 1u;
}

__device__ __forceinline__ void xcd_barrier(const XcdBarrier& b) {
    asm volatile("s_waitcnt vmcnt(0)" ::: "memory");
    __syncthreads();
    if (b.wave == 0 && hw_lane() == 0) {
        unsigned* bar = b.bar;
        __builtin_amdgcn_s_waitcnt(0);
        unsigned nloc = b.st[0], nx = b.st[1];
        if (nloc == 0u) { xcd_barrier_complete(bar, b.x, nloc, nx); b.st[0] = nloc; b.st[1] = nx; }
        const unsigned old = xb_add(&bar[XB_XSUB(b.x)], 1u);
        const unsigned gen = old / nloc;
        if (old + 1u == (gen + 1u) * nloc) {
            __builtin_amdgcn_fence(__ATOMIC_RELEASE, "agent");
            asm volatile("s_waitcnt vmcnt(0)" ::: "memory");
            const unsigned og = xb_add(&bar[XB_TOP], 1u);
            const unsigned tg = og / nx;
            if (og + 1u == (tg + 1u) * nx) xb_add(&bar[XB_TOPGEN], 1u);
            else XB_SPIN(xb_ld(&bar[XB_TOPGEN]) == tg, bar);
            __builtin_amdgcn_fence(__ATOMIC_ACQUIRE, "agent");
            xb_add(&bar[XB_XGEN(b.x)], 1u);
            asm volatile("s_waitcnt vmcnt(0)" ::: "memory");
        } else {
            XB_SPIN(xb_ld(&bar[XB_XGEN(b.x)]) == gen, bar);
            __builtin_amdgcn_fence(__ATOMIC_ACQUIRE, "agent");
            asm volatile("s_waitcnt vmcnt(0)" ::: "memory");
        }
    }
    __syncthreads();
}

__device__ __forceinline__ void xcd_barrier_local(const XcdBarrier& b) {
    asm volatile("s_waitcnt vmcnt(0)" ::: "memory");
    __syncthreads();
    if (b.wave == 0 && hw_lane() == 0) {
        unsigned* bar = b.bar;
        __builtin_amdgcn_s_waitcnt(0);
        const unsigned nloc = b.st[0] ? b.st[0] : 1u;
        const unsigned old = xb_add(&bar[XB_XSUB(b.x)], 1u);
        const unsigned gen = old / nloc;
        if (old + 1u == (gen + 1u) * nloc) xb_add(&bar[XB_XGEN(b.x)], 1u);
        else XB_SPIN(xb_ld(&bar[XB_XGEN(b.x)]) == gen, bar);
        __builtin_amdgcn_fence(__ATOMIC_ACQUIRE, "agent");
        asm volatile("s_waitcnt vmcnt(0)" ::: "memory");
    }
    __syncthreads();
}

typedef const float* fptr_t;
typedef __attribute__((address_space(4))) const fptr_t* in_tab_t;
struct Frame {
    LAS unsigned char* lds;
    int tid, lane, wave, G, bx, vid, xq, rk, rw;
    in_tab_t in;
    float* out;
    unsigned char* ws;
};
__device__ __forceinline__ unsigned long long uni64(unsigned long long v) { const unsigned lo = __builtin_amdgcn_readfirstlane((unsigned)v), hi = __builtin_amdgcn_readfirstlane((unsigned)(v >> 32)); return ((unsigned long long)hi << 32) | lo; }
__device__ __forceinline__ Frame launder(const Frame& F0) {
    Frame F = F0;
    int wv_ = __builtin_amdgcn_readfirstlane(F0.wave);
    int ln_ = hw_lane();
    int g_ = __builtin_amdgcn_readfirstlane(F0.G), b_ = __builtin_amdgcn_readfirstlane(F0.bx), v_ = __builtin_amdgcn_readfirstlane(F0.vid);
    unsigned long long w_ = uni64((unsigned long long)F0.ws), o_ = uni64((unsigned long long)F0.out), i_ = uni64((unsigned long long)F0.in);
    asm volatile("" : "+v"(ln_), "+s"(wv_), "+s"(g_), "+s"(b_), "+s"(v_), "+s"(w_), "+s"(o_), "+s"(i_));
    F.tid = (wv_ << 6) | ln_; F.G = g_; F.bx = b_; F.vid = v_; F.xq = b_ & 7; F.rk = b_ >> 3; F.rw = (g_ - (b_ & 7) + 7) >> 3; F.ws = (unsigned char*)(GAS unsigned char*)w_; F.out = (float*)(GAS float*)o_; F.in = (in_tab_t)i_;
    F.lane = ln_; F.wave = wv_;
    return F;
}
#define FIN(k) ((const float*)(const GAS float*)(F.in[k]))


__device__ __forceinline__ float shx(float v, int mask, int lane) { return __builtin_bit_cast(float, __builtin_amdgcn_ds_bpermute((lane ^ mask) << 2, __builtin_bit_cast(int, v))); }
__device__ __forceinline__ float wave_sum(float v, int lane) {
#pragma unroll
    for (int o = 1; o < 64; o <<= 1) v += shx(v, o, lane);
    return v;
}
__device__ __forceinline__ float silu_f(float x) { return x * __builtin_amdgcn_rcpf(1.f + __builtin_amdgcn_exp2f(-1.4426950408889634f * x)); }
__device__ __forceinline__ f32x4 silu4(f32x4 v) { return (f32x4){silu_f(v[0]), silu_f(v[1]), silu_f(v[2]), silu_f(v[3])}; }
__device__ __forceinline__ float dot4(f32x4 a, f32x4 b) { return (a[0] * b[0] + a[1] * b[1]) + (a[2] * b[2] + a[3] * b[3]); }
__device__ __forceinline__ u32x4 pack8(f32x4 a, f32x4 b) { u32x4 w; w.x = cvt_pk_bf16(a[0], a[1]); w.y = cvt_pk_bf16(a[2], a[3]); w.z = cvt_pk_bf16(b[0], b[1]); w.w = cvt_pk_bf16(b[2], b[3]); return w; }
__device__ __forceinline__ u32x2 pack4(f32x4 a) { u32x2 w; w.x = cvt_pk_bf16(a[0], a[1]); w.y = cvt_pk_bf16(a[2], a[3]); return w; }
__device__ __forceinline__ float bflo(unsigned w) { return __uint_as_float(w << 16); }
__device__ __forceinline__ float bfhi(unsigned w) { return __uint_as_float(w & 0xffff0000u); }
__device__ __forceinline__ void unpack8(u32x4 w, f32x4& a, f32x4& b) { a = (f32x4){bflo(w.x), bfhi(w.x), bflo(w.y), bfhi(w.y)}; b = (f32x4){bflo(w.z), bfhi(w.z), bflo(w.w), bfhi(w.w)}; }
__device__ __forceinline__ f32x4 unpack4(u32x2 w) { return (f32x4){bflo(w.x), bfhi(w.x), bflo(w.y), bfhi(w.y)}; }
__device__ __forceinline__ float rstd16(const float* p) {
    const f32x4 a = ((const f32x4*)p)[0], b = ((const f32x4*)p)[1], c = ((const f32x4*)p)[2], d = ((const f32x4*)p)[3];
    const f32x4 s = (a + b) + (c + d);
    return rsqrtf(((s[0] + s[1]) + (s[2] + s[3])) * (1.0f / D) + EPS);
}
__device__ __forceinline__ float rstd32(const float* p) {
    f32x4 s = ((const f32x4*)p)[0];
#pragma unroll
    for (int i = 1; i < 8; ++i) s += ((const f32x4*)p)[i];
    return rsqrtf(((s[0] + s[1]) + (s[2] + s[3])) * (1.0f / D) + EPS);
}
__host__ __device__ __forceinline__ int src_even(int n) {
    const int tile = n >> 8, o = n & 255;
    if (tile < 8) return n;
    if (tile < 12) return 3072 + (n - 2048);
    const int cb = tile - 12;
    return o < 128 ? 2048 + 128 * cb + o : 4096 + 128 * cb + (o - 128);
}
__host__ __device__ __forceinline__ int src_odd(int n) {
    const int pn = n >> 8, p = n & 255, q = ((p >> 7) << 1) | ((p >> 2) & 1), ch = 64 * pn + 16 * ((p >> 5) & 3) + 4 * ((p >> 3) & 3) + (p & 3);
    const int base = q == 0 ? 2048 : (q == 1 ? 4096 : (q == 2 ? 0 : 6144));
    return base + ch;
}

__device__ __forceinline__ void rstd_table(const float* rsq, int pm, LAS float* tab, int tid) {
    if (tid < 256) tab[tid] = rstd16(rsq + ((size_t)pm * 256 + tid) * 16);
    LDS_BARRIER();
}
struct EpiG1Even {
    static constexpr bool PERM = true, AFTER_DRAIN = false, REP_EPI = (REP_MASK >> 12) & 1;
    const float* rsq; bf16_t* Z; float* vsq; float* pool_out; LAS const float* rtab; int pm0;
    __device__ __forceinline__ void operator()(const f32x4 (&acc)[2][2][4][2], const Unit& u, int wr, int wc, int fr_, int fq_) const {
        int fr = fr_, fq = fq_; asm volatile("" : "+v"(fr), "+v"(fq));
        const int tile = u.pn, cw = wc * 32 + 8 * fq;
#pragma unroll
        for (int ai = 0; ai < 2; ++ai)
#pragma unroll
            for (int m = 0; m < 4; ++m) {
                const int row = u.pm * 256 + ai * 128 + wr * 64 + m * 16 + fr;
                const float rs = u.pm == pm0 ? rtab[ai * 128 + wr * 64 + m * 16 + fr] : rstd16(rsq + (size_t)row * 16);
                if (tile < 12) {
                    const int kind = tile >> 2;
                    bf16_t* dst = Z + (size_t)kind * MP * D + (size_t)row * D + (tile & 3) * 256 + cw;
                    float ss = 0.f;
#pragma unroll
                    for (int bj = 0; bj < 2; ++bj) {
                        f32x4 v0 = acc[ai][bj][m][0] * rs, v1 = acc[ai][bj][m][1] * rs;
                        if (kind == 1) { v0 = silu4(v0); v1 = silu4(v1); }
                        if (kind == 2) ss += dot4(v0, v0) + dot4(v1, v1);
                        *(u32x4*)(dst + bj * 128) = pack8(v0, v1);
                        if (kind == 0 && (row & 2047) >= 2033) {
                            float* po = pool_out + ((size_t)(row >> 11) * 15 + ((row & 2047) - 2033)) * 1024 + (tile & 3) * 256 + bj * 128 + cw;
                            *(f32x4*)po = v0; *(f32x4*)(po + 4) = v1;
                        }
                    }
                    if (kind == 2) { ss += shx(ss, 16, 16 * fq + fr); ss += shx(ss, 32, 16 * fq + fr); if (fq == 0) vsq[(size_t)row * 16 + (tile - 8) * 4 + wc] = ss; }
                } else {
                    const int cb = tile - 12;
                    bf16_t* dst = Z + (size_t)3 * MP * D + (size_t)row * D + cb * 128 + cw;
                    const f32x4 u0 = acc[ai][0][m][0] * rs, u1 = acc[ai][0][m][1] * rs, g0 = acc[ai][1][m][0] * rs, g1 = acc[ai][1][m][1] * rs;
                    *(u32x4*)dst = pack8(u0 * silu4(g0), u1 * silu4(g1));
                }
            }
    }
};
__device__ __forceinline__ float dpp_shr1(float old, float v) { return __builtin_bit_cast(float, __builtin_amdgcn_update_dpp(__builtin_bit_cast(int, old), __builtin_bit_cast(int, v), 0x111, 0xf, 0xf, false)); }
__device__ __forceinline__ float dpp_shr2(float old, float v) { return __builtin_bit_cast(float, __builtin_amdgcn_update_dpp(__builtin_bit_cast(int, old), __builtin_bit_cast(int, v), 0x112, 0xf, 0xf, false)); }
struct EpiG1Odd {
    static constexpr bool PERM = true, AFTER_DRAIN = false, REP_EPI = false;
    const float* rsq; bf16_t* A2; const float* cw; float* conv_out; float* side; LAS float* halo; LAS const float* rtab; int pm0; LAS const float* cwl; int pn0;
    __device__ __forceinline__ void operator()(const f32x4 (&acc)[2][2][4][2], const Unit& u, int wr, int wc, int fr_, int fq_) const {
        int fr = fr_, fq = fq_; asm volatile("" : "+v"(fr), "+v"(fq));
        const int chl = wc * 16 + 4 * fq, ch = u.pn * 64 + chl;
        f32x4 w0, w1, w2;
        { const int ui = (u.pn - pn0) >> 2;
          if (u.pm == pm0 && ui >= 0 && ui < 8 && ((u.pn - pn0) & 3) == 0) { w0 = *(const LAS f32x4*)(cwl + (ui * 3 + 0) * 64 + chl); w1 = *(const LAS f32x4*)(cwl + (ui * 3 + 1) * 64 + chl); w2 = *(const LAS f32x4*)(cwl + (ui * 3 + 2) * 64 + chl); }
          else { w0 = *(const f32x4*)(cw + ch); w1 = *(const f32x4*)(cw + 2048 + ch); w2 = *(const f32x4*)(cw + 4096 + ch); } }
        f32x4 e[2][4]; float rsv[2][4];
#pragma unroll
        for (int ai = 0; ai < 2; ++ai)
#pragma unroll
            for (int m = 0; m < 4; ++m) {
                const int rb = 8 * ai + 4 * wr + m, row = u.pm * 256 + 16 * rb + fr;
                const float rs = u.pm == pm0 ? rtab[16 * rb + fr] : rstd16(rsq + (size_t)row * 16); rsv[ai][m] = rs;
                e[ai][m] = (acc[ai][0][m][0] * rs) * (acc[ai][0][m][1] * rs);
                if (fr >= 14) *(LAS f32x4*)(halo + (rb * 2 + (fr - 14)) * 64 + chl) = e[ai][m];
                if (m & 1) asm volatile("" ::: "memory");
            }
        asm volatile("s_waitcnt lgkmcnt(0)" ::: "memory"); __builtin_amdgcn_s_barrier(); asm volatile("" ::: "memory");
        float* sd = side + (size_t)u.pm * 6 * 2048 + ch;
#pragma unroll
        for (int ai = 0; ai < 2; ++ai)
#pragma unroll
            for (int m = 0; m < 4; ++m) {
                const int rb = 8 * ai + 4 * wr + m, row = u.pm * 256 + 16 * rb + fr;
                const float rs = rsv[ai][m];
                const f32x4 sg = (acc[ai][1][m][0] * rs) * silu4(acc[ai][1][m][1] * rs);
                f32x4 h0 = (f32x4){0.f, 0.f, 0.f, 0.f}, h1 = h0;
                if (rb > 0) { h0 = *(const LAS f32x4*)(halo + ((rb - 1) * 2 + 0) * 64 + chl); h1 = *(const LAS f32x4*)(halo + ((rb - 1) * 2 + 1) * 64 + chl); }
                const f32x4 hx = fr == 0 ? h0 : h1, ev = e[ai][m];
                f32x4 e1, e2;
#pragma unroll
                for (int k = 0; k < 4; ++k) { e1[k] = dpp_shr1(h1[k], ev[k]); e2[k] = dpp_shr2(hx[k], ev[k]); }
                const f32x4 a = sg * (w0 * e2 + w1 * e1 + w2 * ev);
                const bool top = (rb == 0 && fr < 2);
                if (!(top && (u.pm & 7) != 0)) *(u32x2*)(A2 + (size_t)row * 2048 + ch) = pack4(a);
                if (top) { *(f32x4*)(sd + fr * 2048) = ev; *(f32x4*)(sd + (4 + fr) * 2048) = sg; }
                if (rb == 15 && fr >= 14) {
                    *(f32x4*)(sd + (2 + fr - 14) * 2048) = ev;
                    if ((u.pm & 7) == 7) *(f32x4*)(conv_out + ((size_t)(u.pm >> 3) * 2 + (fr - 14)) * 2048 + ch) = ev;
                }
            }
    }
};
__device__ __forceinline__ void conv_fixup(const float* side, const float* cw, bf16_t* A2, int pm, int tid) {
    if ((pm & 7) == 0) return;
    const int ch = 4 * tid;
    const float* sp = side + (size_t)(pm - 1) * 6 * 2048 + ch; const float* sc = side + (size_t)pm * 6 * 2048 + ch;
    const f32x4 em2 = *(const f32x4*)(sp + 2 * 2048), em1 = *(const f32x4*)(sp + 3 * 2048), e0 = *(const f32x4*)sc, e1 = *(const f32x4*)(sc + 2048), s0 = *(const f32x4*)(sc + 4 * 2048), s1 = *(const f32x4*)(sc + 5 * 2048);
    const f32x4 w0 = *(const f32x4*)(cw + ch), w1 = *(const f32x4*)(cw + 2048 + ch), w2 = *(const f32x4*)(cw + 4096 + ch);
    *(u32x2*)(A2 + (size_t)(pm * 256) * 2048 + ch) = pack4(s0 * (w0 * em2 + w1 * em1 + w2 * e0));
    *(u32x2*)(A2 + (size_t)(pm * 256 + 1) * 2048 + ch) = pack4(s1 * (w0 * em1 + w1 * e0 + w2 * e1));
}
struct EpiRes {
    static constexpr bool PERM = true, AFTER_DRAIN = false, REP_EPI = false;
    bf16_t* xb; float* rsq;
    __device__ __forceinline__ void operator()(const f32x4 (&acc)[2][2][4][2], const Unit& u, int wr, int wc, int fr_, int fq_) const {
        int fr = fr_, fq = fq_; asm volatile("" : "+v"(fr), "+v"(fq));
        const int cw = wc * 32 + 8 * fq;
#pragma unroll
        for (int ai = 0; ai < 2; ++ai) {
            u32x4 old[4][2];
#pragma unroll
            for (int m = 0; m < 4; ++m)
#pragma unroll
                for (int bj = 0; bj < 2; ++bj) old[m][bj] = *(const u32x4*)(xb + (size_t)(u.pm * 256 + ai * 128 + wr * 64 + m * 16 + fr) * D + u.pn * 256 + bj * 128 + cw);
#pragma unroll
            for (int m = 0; m < 4; ++m) {
                const int row = u.pm * 256 + ai * 128 + wr * 64 + m * 16 + fr;
                float ss = 0.f;
#pragma unroll
                for (int bj = 0; bj < 2; ++bj) {
                    f32x4 b0, b1; unpack8(old[m][bj], b0, b1);
                    const u32x4 wv = pack8(b0 + acc[ai][bj][m][0], b1 + acc[ai][bj][m][1]);
                    *(u32x4*)(xb + (size_t)row * D + u.pn * 256 + bj * 128 + cw) = wv;
                    f32x4 r0, r1; unpack8(wv, r0, r1);
                    ss += dot4(r0, r0) + dot4(r1, r1);
                }
                ss += shx(ss, 16, 16 * fq + fr); ss += shx(ss, 32, 16 * fq + fr);
                if (fq == 0) rsq[(size_t)row * 16 + u.pn * 4 + wc] = ss;
            }
        }
    }
};
struct EpiProbe {
    static constexpr bool PERM = true, AFTER_DRAIN = false, REP_EPI = false;
    bf16_t* O; int ldc;
    __device__ __forceinline__ void operator()(const f32x4 (&acc)[2][2][4][2], const Unit& u, int wr, int wc, int fr_, int fq_) const {
        int fr = fr_, fq = fq_; asm volatile("" : "+v"(fr), "+v"(fq));
        const int cw = wc * 32 + 8 * fq;
#pragma unroll
        for (int ai = 0; ai < 2; ++ai)
#pragma unroll
            for (int m = 0; m < 4; ++m) {
                const int row = u.pm * 256 + ai * 128 + wr * 64 + m * 16 + fr;
#pragma unroll
                for (int bj = 0; bj < 2; ++bj) *(u32x4*)(O + (size_t)row * ldc + u.pn * 256 + bj * 128 + cw) = pack8(acc[ai][bj][m][0], acc[ai][bj][m][1]);
            }
    }
};
struct EpiQ {
    static constexpr bool PERM = true, AFTER_DRAIN = false, REP_EPI = false;
    const float* rsq; bf16_t* Q; LAS const float* rtab; int pm0;
    __device__ __forceinline__ void operator()(const f32x4 (&acc)[2][2][4][2], const Unit& u, int wr, int wc, int fr_, int fq_) const {
        int fr = fr_, fq = fq_; asm volatile("" : "+v"(fr), "+v"(fq));
        const int cw = wc * 32 + 8 * fq;
#pragma unroll
        for (int ai = 0; ai < 2; ++ai)
#pragma unroll
            for (int m = 0; m < 4; ++m) {
                const int row = u.pm * 256 + ai * 128 + wr * 64 + m * 16 + fr;
                const float rs = u.pm == pm0 ? rtab[ai * 128 + wr * 64 + m * 16 + fr] : rstd16(rsq + (size_t)row * 16);
#pragma unroll
                for (int bj = 0; bj < 2; ++bj) *(u32x4*)(Q + (size_t)row * D + u.pn * 256 + bj * 128 + cw) = pack8(acc[ai][bj][m][0] * rs, acc[ai][bj][m][1] * rs);
            }
    }
};
struct EpiMemKV {
    static constexpr bool PERM = true, AFTER_DRAIN = false, REP_EPI = false;
    const float* rstdm; float* outk; float* outv; bf16_t* kb; bf16_t* vb;
    __device__ __forceinline__ void operator()(const f32x4 (&acc)[2][2][4][2], const Unit& u, int wr, int wc, int fr_, int fq_) const {
        int fr = fr_, fq = fq_; asm volatile("" : "+v"(fr), "+v"(fq));
        const int layer = u.pn >> 3, isv = (u.pn >> 2) & 1, cw = (u.pn & 3) * 256 + wc * 32 + 8 * fq;
        float* of = (isv ? outv : outk) + (size_t)layer * MMEM * D; bf16_t* ob = (isv ? vb : kb) + (size_t)layer * MMEM * D;
#pragma unroll
        for (int ai = 0; ai < 2; ++ai)
#pragma unroll
            for (int m = 0; m < 4; ++m) {
                const int row = u.pm * 256 + ai * 128 + wr * 64 + m * 16 + fr;
                const float rs = rstdm[row];
#pragma unroll
                for (int bj = 0; bj < 2; ++bj) {
                    const size_t off = (size_t)row * D + bj * 128 + cw;
                    const f32x4 v0 = acc[ai][bj][m][0] * rs, v1 = acc[ai][bj][m][1] * rs;
                    *(f32x4*)(of + off) = v0; *(f32x4*)(of + off + 4) = v1;
                    *(u32x4*)(ob + off) = pack8(v0, v1);
                }
            }
    }
};

struct TrItem { const float* wp; int ldw; const float* gk; float sc; bf16_t* wt; int K; };
__device__ __forceinline__ void p0_tr_desc(const float* W, int ldw, int K, int Nd, const float* gk, float sc, bf16_t* WT, int perm, int r, int lane, TrItem& t) {
    const int nblk = Nd / 32, kb = r / nblk, nb = r % nblk, dstn0 = 32 * nb, dn = dstn0 + (lane & 31);
    const int srccol = perm == 0 ? dn : (perm == 1 ? src_even(dn) : src_odd(dn));
    t.wp = W + (size_t)(64 * kb + (lane >> 5)) * ldw + srccol; t.ldw = ldw; t.gk = gk ? gk + 64 * kb : nullptr; t.sc = sc; t.wt = WT + (size_t)dstn0 * K + 64 * kb; t.K = K;
}
__device__ __forceinline__ void p0_resolve(Frame& F, int it, int lane, TrItem& t) {
    constexpr int I_AB1 = 16 * (NAB / 32), I_C1 = 16 * (NC / 32), I_2 = 32 * 32, I_SQ = 16 * 32, I_PM = 4 * 8;
    int r = it;
    if (r < 2 * I_AB1) { const int jj = r / I_AB1; p0_tr_desc(FIN(10) + (size_t)jj * D * NAB, NAB, D, NAB, FIN(7) + 2 * jj * D, 1.f, ((bf16_t*)(F.ws + WS_AB1)) + (size_t)jj * NAB * D, 1, r % I_AB1, lane, t); return; } r -= 2 * I_AB1;
    if (r < 2 * I_C1) { const int jj = r / I_C1; p0_tr_desc(FIN(17) + (size_t)jj * D * NC, NC, D, NC, FIN(7) + (2 * jj + 1) * D, 1.f, ((bf16_t*)(F.ws + WS_C1)) + (size_t)jj * NC * D, 2, r % I_C1, lane, t); return; } r -= 2 * I_C1;
    if (r < 2 * I_2) { const int jj = r / I_2; p0_tr_desc(FIN(16) + (size_t)jj * 2048 * D, D, 2048, D, nullptr, 1.f, ((bf16_t*)(F.ws + WS_AB2)) + (size_t)jj * D * 2048, 0, r % I_2, lane, t); return; } r -= 2 * I_2;
    if (r < 2 * I_2) { const int jj = r / I_2; p0_tr_desc(FIN(19) + (size_t)jj * 2048 * D, D, 2048, D, nullptr, 1.f, ((bf16_t*)(F.ws + WS_C2)) + (size_t)jj * D * 2048, 0, r % I_2, lane, t); return; } r -= 2 * I_2;
    if (r < 4 * I_SQ) { const int l = r / I_SQ; p0_tr_desc(FIN(20) + (size_t)l * D * D, D, D, D, FIN(8) + l * D, QSCALE, ((bf16_t*)(F.ws + WS_WQ)) + (size_t)l * D * D, 0, r % I_SQ, lane, t); return; } r -= 4 * I_SQ;
    if (r < 4 * I_SQ) { const int l = r / I_SQ; p0_tr_desc(FIN(21) + (size_t)l * D * D, D, D, D, FIN(9) + l * D, 1.f, ((bf16_t*)(F.ws + WS_WKV)) + (size_t)(2 * l) * D * D, 0, r % I_SQ, lane, t); return; } r -= 4 * I_SQ;
    if (r < 4 * I_SQ) { const int l = r / I_SQ; p0_tr_desc(FIN(22) + (size_t)l * D * D, D, D, D, FIN(9) + l * D, 1.f, ((bf16_t*)(F.ws + WS_WKV)) + (size_t)(2 * l + 1) * D * D, 0, r % I_SQ, lane, t); return; } r -= 4 * I_SQ;
    if (r < 4 * I_SQ) { const int l = r / I_SQ; p0_tr_desc(FIN(23) + (size_t)l * D * D, D, D, D, nullptr, 1.f, ((bf16_t*)(F.ws + WS_WO)) + (size_t)l * D * D, 0, r % I_SQ, lane, t); return; } r -= 4 * I_SQ;
    { const int jg = r / I_PM; p0_tr_desc(FIN(11) + (size_t)jg * 65536, 256, 256, 256, nullptr, 1.f, ((bf16_t*)(F.ws + WS_PMT)) + (size_t)jg * 65536, 0, r % I_PM, lane, t); }
}
__device__ __forceinline__ void p0_tr_load(const TrItem& t, int lane, float (&v)[32], f32x4& g0, f32x4& g1) {
    const int c = lane & 7;
    g0 = (f32x4){t.sc, t.sc, t.sc, t.sc}; g1 = g0;
    if (t.gk) { g0 = *(const f32x4*)(t.gk + 8 * c) * t.sc; g1 = *(const f32x4*)(t.gk + 8 * c + 4) * t.sc; }
#pragma unroll
    for (int i = 0; i < 32; ++i) v[i] = t.wp[(size_t)(2 * i) * t.ldw];
}
__device__ __forceinline__ void p0_tr_finish(const TrItem& t, int lane, const float (&v)[32], f32x4 g0, f32x4 g1, LAS float* scr) {
#pragma unroll
    for (int i = 0; i < 32; ++i) scr[(2 * i + (lane >> 5)) * 33 + (lane & 31)] = v[i];
    LDS_WAIT(); asm volatile("" ::: "memory");
    const int c = lane & 7;
#pragma unroll
    for (int jj = 0; jj < 4; ++jj) {
        const int n = (lane >> 3) + 8 * jj; const LAS float* s = scr + (8 * c) * 33 + n;
        u32x4 o; o.x = cvt_pk_bf16(s[0 * 33] * g0[0], s[1 * 33] * g0[1]); o.y = cvt_pk_bf16(s[2 * 33] * g0[2], s[3 * 33] * g0[3]); o.z = cvt_pk_bf16(s[4 * 33] * g1[0], s[5 * 33] * g1[1]); o.w = cvt_pk_bf16(s[6 * 33] * g1[2], s[7 * 33] * g1[3]);
        *(u32x4*)(t.wt + (size_t)n * t.K + 8 * c) = o;
    }
    LDS_WAIT(); asm volatile("" ::: "memory");
}
__device__ __forceinline__ float p0_row_finish(const f32x4 (&v)[4], bf16_t* dst, float* copy, int lane) {
    float s = 0.f;
#pragma unroll
    for (int jj = 0; jj < 4; ++jj) s += dot4(v[jj], v[jj]);
    s = wave_sum(s, lane);
    u32x2* o8 = (u32x2*)dst + lane;
#pragma unroll
    for (int jj = 0; jj < 4; ++jj) o8[64 * jj] = pack4(v[jj]);
    if (copy) {
#pragma unroll
        for (int jj = 0; jj < 4; ++jj) ((f32x4*)copy + lane)[64 * jj] = v[jj];
    }
    return s;
}
namespace p0seg {
constexpr int I_AB1 = 16 * (NAB / 32), I_C1 = 16 * (NC / 32), I_2 = 32 * 32, I_SQ = 16 * 32, I_PM = 4 * 8;
constexpr int O_AB1 = 0, O_C1 = 2 * I_AB1, O_AB2 = O_C1 + 2 * I_C1, O_C2 = O_AB2 + 2 * I_2, O_Q = O_C2 + 2 * I_2, O_K = O_Q + 4 * I_SQ, O_V = O_K + 4 * I_SQ, O_O = O_V + 4 * I_SQ, O_P = O_O + 4 * I_SQ, NITEMS = O_P + 8 * I_PM;
constexpr int NA = I_AB1 + I_2 + I_SQ + 8 * I_SQ + I_SQ + 4 * I_PM, NB = NITEMS - NA;
__device__ __forceinline__ int item_a(int i) {
    if (i < I_AB1) return O_AB1 + i; i -= I_AB1;
    if (i < I_2) return O_AB2 + i; i -= I_2;
    if (i < I_SQ) return O_Q + i; i -= I_SQ;
    if (i < 8 * I_SQ) return O_K + i; i -= 8 * I_SQ;
    if (i < I_SQ) return O_O + i; i -= I_SQ;
    return O_P + i;
}
__device__ __forceinline__ int item_b(int i) {
    if (i < I_AB1) return O_AB1 + I_AB1 + i; i -= I_AB1;
    if (i < 2 * I_C1) return O_C1 + i; i -= 2 * I_C1;
    if (i < I_2) return O_AB2 + I_2 + i; i -= I_2;
    if (i < 2 * I_2) return O_C2 + i; i -= 2 * I_2;
    if (i < 3 * I_SQ) return O_Q + I_SQ + i; i -= 3 * I_SQ;
    if (i < 3 * I_SQ) return O_O + I_SQ + i; i -= 3 * I_SQ;
    return O_P + 4 * I_PM + i;
}
}
__device__ __forceinline__ void p0_weights(Frame& F0, int part, int gw, int NGW) {
    Frame F = launder(F0);
    LAS float* scr = (LAS float*)(F.lds + F.wave * 16384);
    const int lane = F.lane;
    const int n = part == 0 ? p0seg::NA : (part == 1 ? p0seg::NB : p0seg::NITEMS);
#define P0_ITEM(i_) (part == 0 ? p0seg::item_a(i_) : (part == 1 ? p0seg::item_b(i_) : (i_)))
    if (gw < n) {
        TrItem cur, nxt; float va[32], vb[32]; f32x4 ga0, ga1, gb0, gb1;
        p0_resolve(F, P0_ITEM(gw), lane, cur); p0_tr_load(cur, lane, va, ga0, ga1);
        for (int it = gw; it < n; it += 2 * NGW) {
            const bool h1 = it + NGW < n, h2 = it + 2 * NGW < n;
            if (h1) { p0_resolve(F, P0_ITEM(it + NGW), lane, nxt); p0_tr_load(nxt, lane, vb, gb0, gb1); }
            p0_tr_finish(cur, lane, va, ga0, ga1, scr);
            if (h2) { p0_resolve(F, P0_ITEM(it + 2 * NGW), lane, cur); p0_tr_load(cur, lane, va, ga0, ga1); }
            if (h1) p0_tr_finish(nxt, lane, vb, gb0, gb1, scr);
        }
    }
#undef P0_ITEM
}
__device__ __forceinline__ void p0_prologue(Frame& F0) {
    Frame F = launder(F0);
    const int gw = F.bx * NWAVES + F.wave, NGW = F.G * NWAVES, lane = F.lane;
    p0_weights(F0, (!MK_SPLIT && SPLIT_PROLOGUE) ? 0 : 2, gw, NGW);
    for (int m0 = 2 * gw; m0 < MP + MS + MMEM; m0 += 2 * NGW) {
        f32x4 v[2][4];
#pragma unroll
        for (int r = 0; r < 2; ++r) {
            const int m = m0 + r;
            const float* src = m < MP ? FIN(0) + (size_t)m * D : (m < MP + MS ? FIN(1) + (size_t)(m - MP) * D : FIN(2) + (size_t)(m - MP - MS) * D);
#pragma unroll
            for (int jj = 0; jj < 4; ++jj) v[r][jj] = ((const f32x4*)src + lane)[64 * jj];
        }
#pragma unroll
        for (int r = 0; r < 2; ++r) {
            const int m = m0 + r;
            if (m < MP) {
                const float s = p0_row_finish(v[r], ((bf16_t*)(F.ws + WS_XB)) + (size_t)m * D, nullptr, lane);
                if (lane < 16) ((float*)(F.ws + WS_RSQ))[(size_t)m * 16 + lane] = lane == 0 ? s : 0.f;
            } else if (m < MP + MS) {
                const int b = m - MP;
                const float s = p0_row_finish(v[r], ((bf16_t*)(F.ws + WS_XB)) + (size_t)m * D, ((float*)(F.ws + WS_XS)) + (size_t)b * D, lane);
                if (lane < 32) ((float*)(F.ws + WS_SMALL))[b * 32 + lane] = lane == 0 ? s : 0.f;
            } else {
                const int t = m - MP - MS;
                const float s = p0_row_finish(v[r], ((bf16_t*)(F.ws + WS_MEMB)) + (size_t)t * D, nullptr, lane);
                if (lane == 0) ((float*)(F.ws + WS_SMALL + 65536))[t] = rsqrtf(s * (1.0f / D) + EPS);
            }
        }
    }
}

__device__ __forceinline__ bf16x8 tr_frag(LAS unsigned char* p0, LAS unsigned char* p1) {
    const s16x4 lo = __builtin_amdgcn_ds_read_tr16_b64_v4i16((LAS s16x4*)p0);
    const s16x4 hi = __builtin_amdgcn_ds_read_tr16_b64_v4i16((LAS s16x4*)p1);
    return (bf16x8){lo[0], lo[1], lo[2], lo[3], hi[0], hi[1], hi[2], hi[3]};
}
#define MFMA16(a, b, c) __builtin_amdgcn_mfma_f32_16x16x32_bf16((a), (b), (c), 0, 0, 0)

constexpr int SGU_AS = 0, SGU_VS = 34816, SGU_RV = 34816 + 67584;
__device__ __forceinline__ void sgu_chunk(Frame& F0, int j, int n) {
    Frame F = launder(F0);
    LAS unsigned char* lds = F.lds;
    const int tid = F.tid, lane = F.lane, w = F.wave, fr = lane & 15, fq = lane >> 4, row0 = n * 128;
    LAS float* rvs = (LAS float*)(lds + SGU_RV);
    if (tid < 128) rvs[tid] = rstd16(((float*)(F.ws + WS_VSQ)) + (size_t)(row0 + tid) * 16);
    const bf16_t* ZV = ((bf16_t*)(F.ws + WS_Z)) + (size_t)2 * MP * D + (size_t)row0 * D;
    const bf16_t* ZUG = ((bf16_t*)(F.ws + WS_Z)) + (size_t)3 * MP * D + (size_t)row0 * D;
    bf16_t* A2 = ((bf16_t*)(F.ws + WS_A2)) + (size_t)row0 * 2048 + 1024;
    const unsigned voff = (unsigned)(tid >> 5) * (D * 2) + (unsigned)(tid & 31) * 16u;
    const unsigned woff = (unsigned)(tid >> 4) * 512u + (unsigned)(tid & 15) * 32u;
    const int wt_t = tid >> 4, wt_s0 = (tid & 15) * 8;
    const unsigned aoff = (unsigned)(tid >> 5) * 4096u + (unsigned)(tid & 31) * 16u;
    u32x4 vt[8]; f32x4 wt[8];
#define SGU_LOAD(g_) do { const char* vb_ = (const char*)(ZV + (g_) * 256); const char* wb_ = (const char*)(FIN(13) + (size_t)(j * 4 + (g_)) * 16384); \
        _Pragma("unroll") for (int i_ = 0; i_ < 8; ++i_) vt[i_] = *(const u32x4*)(vb_ + (size_t)(16 * i_) * D * 2 + voff); \
        _Pragma("unroll") for (int i_ = 0; i_ < 4; ++i_) { wt[2 * i_] = *(const f32x4*)(wb_ + (size_t)(32 * i_) * 512 + woff); wt[2 * i_ + 1] = *(const f32x4*)(wb_ + (size_t)(32 * i_) * 512 + woff + 16); } } while (0)
    SGU_LOAD(0);
    LDS_BARRIER();
#pragma unroll 1
    for (int g = 0; g < 4; ++g) {
#pragma unroll
        for (int i = 0; i < 8; ++i) *(LAS u32x4*)(lds + SGU_VS + ((tid >> 5) + 16 * i) * 528 + (tid & 31) * 16) = vt[i];
#pragma unroll
        for (int i = 0; i < 4; ++i) {
            const int t = wt_t + 32 * i; float v[8];
#pragma unroll
            for (int e = 0; e < 4; ++e) { v[e] = (wt_s0 + e <= t) ? wt[2 * i][e] * rvs[wt_s0 + e] : 0.f; v[4 + e] = (wt_s0 + 4 + e <= t) ? wt[2 * i + 1][e] * rvs[wt_s0 + 4 + e] : 0.f; }
            u32x4 o; o.x = cvt_pk_bf16(v[0], v[1]); o.y = cvt_pk_bf16(v[2], v[3]); o.z = cvt_pk_bf16(v[4], v[5]); o.w = cvt_pk_bf16(v[6], v[7]);
            *(LAS u32x4*)(lds + SGU_AS + t * 272 + wt_s0 * 2) = o;
        }
        LDS_BARRIER();
        if (g < 3) SGU_LOAD(g + 1);
        const int cg = g * 256 + 32 * w + 4 * fq;
        const unsigned lo_in = (unsigned)fr * (D * 2) + (unsigned)(32 * w + 4 * fq) * 2u, lo_out = (unsigned)fr * 4096u + (unsigned)(32 * w + 4 * fq) * 2u;
        u32x2 ugr[2][8];
#pragma unroll
        for (int nt = 0; nt < 2; ++nt)
#pragma unroll
            for (int mt = 0; mt < 8; ++mt) ugr[nt][mt] = *(const u32x2*)((const char*)(ZUG + (size_t)(16 * mt) * D + g * 256 + 16 * nt) + lo_in);
        f32x4 acc[8][2];
#pragma unroll
        for (int mt = 0; mt < 8; ++mt) { acc[mt][0] = (f32x4){0.f, 0.f, 0.f, 0.f}; acc[mt][1] = (f32x4){0.f, 0.f, 0.f, 0.f}; }
#pragma unroll
        for (int ks = 0; ks < 4; ++ks) {
            bf16x8 Bf[2];
#pragma unroll
            for (int nt = 0; nt < 2; ++nt) {
                LAS unsigned char* p = lds + SGU_VS + (32 * ks + 8 * fq + (fr >> 2)) * 528 + (32 * w + 16 * nt + 4 * (fr & 3)) * 2;
                Bf[nt] = tr_frag(p, p + 4 * 528);
            }
#pragma unroll
            for (int mt = 0; mt < 8; ++mt) {
                if (32 * ks <= 16 * mt + 15) {
                    const bf16x8 Af = *(LAS bf16x8*)(lds + SGU_AS + (16 * mt + fr) * 272 + (32 * ks + 8 * fq) * 2);
                    acc[mt][0] = MFMA16(Bf[0], Af, acc[mt][0]); acc[mt][1] = MFMA16(Bf[1], Af, acc[mt][1]);
                }
            }
        }
#pragma unroll
        for (int nt = 0; nt < 2; ++nt) {
            const int c = cg + 16 * nt;
            const f32x4 gg = *(const f32x4*)(FIN(15) + j * 1024 + c);
#pragma unroll
            for (int mt = 0; mt < 8; ++mt) {
                const int t = 16 * mt + fr;
                const float bb = FIN(14)[(j * 4 + g) * 128 + t];
                *(u32x2*)((char*)(A2 + (size_t)(16 * mt) * 2048 + g * 256 + 16 * nt) + lo_out) = pack4(unpack4(ugr[nt][mt]) * (acc[mt][nt] * gg + bb));
            }
        }
        LDS_BARRIER();
    }
#undef SGU_LOAD
}
template <int WIN> __device__ __forceinline__ void pool_load(const bf16_t* xau  , unsigned lo  , int pos0, u32x4 (&xr)[WIN + 7]) {
#pragma unroll
    for (int i = 0; i < WIN + 7; ++i) { const int rr = i - (WIN - 1); xr[i] = (u32x4){0u, 0u, 0u, 0u}; if (pos0 + rr >= 0) xr[i] = *(const u32x4*)((const char*)(xau + (ptrdiff_t)rr * D) + lo); }
}
template <int WIN> __device__ __forceinline__ void pool_build(const u32x4 (&xr)[WIN + 7], int pos0, LAS unsigned char* dst  ) {
    f32x4 S0 = (f32x4){0.f, 0.f, 0.f, 0.f}, S1 = S0;
#pragma unroll
    for (int i = 0; i < WIN - 1; ++i) { f32x4 a, b; unpack8(xr[i], a, b); S0 += a; S1 += b; }
#pragma unroll
    for (int r = 0; r < 8; ++r) {
        f32x4 a, b; unpack8(xr[WIN - 1 + r], a, b); S0 += a; S1 += b;
        const int cnt = (pos0 + r + 1) < WIN ? (pos0 + r + 1) : WIN; const float ic = 1.0f / (float)cnt;
        *(LAS u32x4*)(dst + r * 528) = pack8(S0 * ic - a, S1 * ic - b);
        f32x4 c, d; unpack8(xr[r], c, d); S0 -= c; S1 -= d;
    }
}
__device__ __forceinline__ void pool_mma_epi(Frame& F, int j, int g, int row0, const bf16_t* ZSGA, bf16_t* A2, LAS unsigned char* lds, int w, int fr, int fq) {
    const int cg = g * 256 + 32 * w + 4 * fq;
    const unsigned lo_in = (unsigned)fr * (D * 2) + (unsigned)(32 * w + 4 * fq) * 2u, lo_out = (unsigned)fr * 4096u + (unsigned)(32 * w + 4 * fq) * 2u, lo_pm = (unsigned)(32 * w + fr) * 512u + (unsigned)fq * 16u;
    u32x2 sgr[2][8];
#pragma unroll
    for (int nt = 0; nt < 2; ++nt)
#pragma unroll
        for (int mt = 0; mt < 8; ++mt) sgr[nt][mt] = *(const u32x2*)((const char*)(ZSGA + (size_t)(16 * mt) * D + g * 256 + 16 * nt) + lo_in);
    f32x4 acc[8][2];
#pragma unroll
    for (int mt = 0; mt < 8; ++mt) { acc[mt][0] = (f32x4){0.f, 0.f, 0.f, 0.f}; acc[mt][1] = (f32x4){0.f, 0.f, 0.f, 0.f}; }
    const bf16_t* pm = ((bf16_t*)(F.ws + WS_PMT)) + (size_t)(j * 4 + g) * 65536;
#pragma unroll
    for (int ks = 0; ks < 8; ++ks) {
        const bf16x8 B0 = *(const bf16x8*)((const char*)(pm + 32 * ks) + lo_pm), B1 = *(const bf16x8*)((const char*)(pm + 16 * 256 + 32 * ks) + lo_pm);
#pragma unroll
        for (int mt = 0; mt < 8; ++mt) {
            const bf16x8 Af = *(LAS bf16x8*)(lds + (16 * mt + fr) * 528 + (32 * ks + 8 * fq) * 2);
            acc[mt][0] = MFMA16(B0, Af, acc[mt][0]); acc[mt][1] = MFMA16(B1, Af, acc[mt][1]);
        }
    }
#pragma unroll
    for (int nt = 0; nt < 2; ++nt) {
        const int c = cg + 16 * nt;
        const f32x4 ps = *(const f32x4*)(FIN(12) + j * 1024 + c);
#pragma unroll
        for (int mt = 0; mt < 8; ++mt) *(u32x2*)((char*)(A2 + (size_t)(16 * mt) * 2048 + g * 256 + 16 * nt) + lo_out) = pack4(acc[mt][nt] * ps * unpack4(sgr[nt][mt]));
    }
}
__device__ __forceinline__ void pool_chunk(Frame& F0, int j, int n) {
    Frame F = launder(F0);
    LAS unsigned char* lds = F.lds;
    const int tid = F.tid, lane = F.lane, w = F.wave, fr = lane & 15, fq = lane >> 4, row0 = n * 128;
    const int cb = tid & 31, t0 = (tid >> 5) * 8, pos0 = (row0 & 2047) + t0;
    const bf16_t* xa = ((bf16_t*)(F.ws + WS_Z)) + (size_t)row0 * D; const unsigned xlo = (unsigned)(t0 * D + cb * 8) * 2u;
    const bf16_t* ZSGA = ((bf16_t*)(F.ws + WS_Z)) + (size_t)1 * MP * D + (size_t)row0 * D;
    bf16_t* A2 = ((bf16_t*)(F.ws + WS_A2)) + (size_t)row0 * 2048;
    LAS unsigned char* dst = lds + t0 * 528 + cb * 16;
    u32x4 x0[2 + 7]; pool_load<2>(xa, xlo, pos0, x0);
    pool_build<2>(x0, pos0, dst); LDS_BARRIER();
    u32x4 x1[4 + 7]; pool_load<4>(xa + 256, xlo, pos0, x1);
    pool_mma_epi(F, j, 0, row0, ZSGA, A2, lds, w, fr, fq); LDS_BARRIER();
    pool_build<4>(x1, pos0, dst); LDS_BARRIER();
    u32x4 x2[8 + 7]; pool_load<8>(xa + 512, xlo, pos0, x2);
    pool_mma_epi(F, j, 1, row0, ZSGA, A2, lds, w, fr, fq); LDS_BARRIER();
    pool_build<8>(x2, pos0, dst); LDS_BARRIER();
    pool_mma_epi(F, j, 2, row0, ZSGA, A2, lds, w, fr, fq); LDS_BARRIER();
    u32x4 x3[16 + 7]; pool_load<16>(xa + 768, xlo, pos0, x3);
    pool_build<16>(x3, pos0, dst); LDS_BARRIER();
    pool_mma_epi(F, j, 3, row0, ZSGA, A2, lds, w, fr, fq); LDS_BARRIER();
}
constexpr int ATT_SLOT = 64 * 528;
__device__ __forceinline__ void attn_prompt(Frame& F0, int layer) {
    Frame F = launder(F0);
    LAS unsigned char* lds = F.lds;
    const int tid = F.tid, lane = F.lane, w = F.wave, fr = lane & 15, fq = lane >> 4;
    const bf16_t* Kl = ((bf16_t*)(F.ws + WS_KB)) + (size_t)layer * MMEM * D; const bf16_t* Vl = ((bf16_t*)(F.ws + WS_VB)) + (size_t)layer * MMEM * D;
    for (int kk = F.rk; kk < 64; kk += F.rw) {
        const int b = F.xq, h = kk >> 4, qb = kk & 15;
        const size_t rowq = (size_t)b * SEQ + qb * 128 + 16 * w + fr;
        bf16x8 Qf[8];
#pragma unroll
        for (int ks = 0; ks < 8; ++ks) Qf[ks] = *(const bf16x8*)(((bf16_t*)(F.ws + WS_Q)) + rowq * D + h * 256 + 32 * ks + 8 * fq);
        const bf16_t* kbase = Kl + (size_t)(b * 256) * D + h * 256; const bf16_t* vbase = Vl + (size_t)(b * 256) * D + h * 256;
        u32x4 st[4];
#define ATT_GLOAD(c) do { const bf16_t* src_ = ((c) < 4 ? kbase : vbase) + (size_t)(64 * ((c) & 3)) * D; _Pragma("unroll") for (int i_ = 0; i_ < 4; ++i_) { const int idx_ = tid + 512 * i_; st[i_] = *(const u32x4*)(src_ + (size_t)(idx_ >> 5) * D + (idx_ & 31) * 8); } } while (0)
#define ATT_LSTORE(slot) do { _Pragma("unroll") for (int i_ = 0; i_ < 4; ++i_) { const int idx_ = tid + 512 * i_; *(LAS u32x4*)(lds + (slot) * ATT_SLOT + (idx_ >> 5) * 528 + (idx_ & 31) * 16) = st[i_]; } } while (0)
        f32x4 S[16], Oa[16]; bf16x8 Pf[8]; float inv = 0.f;
#pragma unroll
        for (int i = 0; i < 16; ++i) { S[i] = (f32x4){0.f, 0.f, 0.f, 0.f}; Oa[i] = (f32x4){0.f, 0.f, 0.f, 0.f}; }
        ATT_GLOAD(0); ATT_LSTORE(0); __syncthreads();
#pragma unroll
        for (int c = 0; c < 8; ++c) {
            if (c < 7) ATT_GLOAD(c + 1);
            LAS unsigned char* slot = lds + (c & 1) * ATT_SLOT;
            if (c < 4) {
#pragma unroll
                for (int ml = 0; ml < 4; ++ml)
#pragma unroll
                    for (int ks = 0; ks < 8; ++ks) {
                        const bf16x8 Kf = *(LAS bf16x8*)(slot + (16 * ml + fr) * 528 + (32 * ks + 8 * fq) * 2);
                        S[4 * c + ml] = MFMA16(Kf, Qf[ks], S[4 * c + ml]);
                    }
                if (c == 3) {
                    float mx = S[0][0];
#pragma unroll
                    for (int i = 0; i < 16; ++i) { mx = fmaxf(mx, fmaxf(fmaxf(S[i][0], S[i][1]), fmaxf(S[i][2], S[i][3]))); }
                    mx = fmaxf(mx, shx(mx, 16, lane)); mx = fmaxf(mx, shx(mx, 32, lane));
                    float sum = 0.f;
#pragma unroll
                    for (int i = 0; i < 16; ++i) {
#pragma unroll
                        for (int e = 0; e < 4; ++e) { S[i][e] = __builtin_amdgcn_exp2f(S[i][e] - mx); sum += S[i][e]; }
                    }
                    sum += shx(sum, 16, lane); sum += shx(sum, 32, lane);
                    inv = 1.0f / sum;
#pragma unroll
                    for (int a = 0; a < 8; ++a) {
                        u32x4 pw; pw.x = cvt_pk_bf16(S[2 * a][0], S[2 * a][1]); pw.y = cvt_pk_bf16(S[2 * a][2], S[2 * a][3]); pw.z = cvt_pk_bf16(S[2 * a + 1][0], S[2 * a + 1][1]); pw.w = cvt_pk_bf16(S[2 * a + 1][2], S[2 * a + 1][3]);
                        Pf[a] = __builtin_bit_cast(bf16x8, pw);
                    }
                }
            } else {
#pragma unroll
                for (int al = 0; al < 2; ++al)
#pragma unroll
                    for (int dt = 0; dt < 16; ++dt) {
                        LAS unsigned char* p = slot + (32 * al + 4 * fq + (fr >> 2)) * 528 + (16 * dt + 4 * (fr & 3)) * 2;
                        const bf16x8 Vf = tr_frag(p, p + 16 * 528);
                        Oa[dt] = MFMA16(Vf, Pf[2 * (c - 4) + al], Oa[dt]);
                    }
            }
            if (c < 7) ATT_LSTORE((c + 1) & 1);
            __syncthreads();
        }
#pragma unroll
        for (int dt = 0; dt < 16; ++dt) *(u32x2*)(((bf16_t*)(F.ws + WS_O)) + rowq * D + h * 256 + 16 * dt + 4 * fq) = pack4(Oa[dt] * inv);
#undef ATT_GLOAD
#undef ATT_LSTORE
    }
}

template <class Epi, int N>
__device__ __forceinline__ void sgemm16(Frame& F0, const bf16_t* A, const bf16_t* Bt, int K, const Epi& E) {
    Frame F = launder(F0);
    LAS unsigned char* lds = F.lds;
    constexpr int CW = N / 32, NT = CW / 16, KS = NT == 2 ? 8 : (NT == 10 ? 4 : 2), NG = 8 / KS, NTW = NT / NG;
    static_assert(NT * 16 == CW && NTW * NG == NT && 2 * CW <= NWAVES * 64, "sgemm16 geometry");
    const int tid = F.tid, lane = F.lane, w = F.wave, fr = lane & 15, fq = lane >> 4;
    const int ksi = w % KS, ng = w / KS, kslice = K / KS, nkb = kslice / 128;
    const bf16_t* A16 = A + (size_t)(16 * F.xq) * K;
    for (int slot = F.rk; slot < 32; slot += F.rw) {
        const int erow = tid / (CW / 8), ecg = tid % (CW / 8); const bool eact = tid < 2 * CW;
        typename Epi::Pre pre{};
        if (eact) pre = E.pre(16 * F.xq + erow, slot * CW + 8 * ecg);
        f32x4 acc[NTW];
#pragma unroll
        for (int jn = 0; jn < NTW; ++jn) acc[jn] = (f32x4){0.f, 0.f, 0.f, 0.f};
        const bf16_t* ap = A16 + (size_t)fr * K + ksi * kslice + 8 * fq;
        const bf16_t* bp = Bt + (size_t)(slot * CW + (ng * NTW) * 16 + fr) * K + ksi * kslice + 8 * fq;
        for (int kb = 0; kb < nkb; ++kb) {
            bf16x8 Af[4], Bf[4][NTW];
#pragma unroll
            for (int k4 = 0; k4 < 4; ++k4) {
                Af[k4] = *(const bf16x8*)(ap + 128 * kb + 32 * k4);
#pragma unroll
                for (int jn = 0; jn < NTW; ++jn) Bf[k4][jn] = *(const bf16x8*)(bp + (size_t)(16 * jn) * K + 128 * kb + 32 * k4);
            }
#pragma unroll
            for (int k4 = 0; k4 < 4; ++k4)
#pragma unroll
                for (int jn = 0; jn < NTW; ++jn) acc[jn] = MFMA16(Bf[k4][jn], Af[k4], acc[jn]);
        }
#pragma unroll
        for (int jn = 0; jn < NTW; ++jn) *(LAS f32x4*)(lds + ((size_t)((ksi * 16 + fr) * CW + (ng * NTW + jn) * 16 + 4 * fq)) * 4) = acc[jn];
        __syncthreads();
        if (eact) {
            f32x4 s0 = (f32x4){0.f, 0.f, 0.f, 0.f}, s1 = s0;
#pragma unroll
            for (int kk = 0; kk < KS; ++kk) { const LAS f32x4* p = (const LAS f32x4*)(lds + ((size_t)((kk * 16 + erow) * CW + 8 * ecg)) * 4); s0 += p[0]; s1 += p[1]; }
            E(16 * F.xq + erow, slot, slot * CW + 8 * ecg, s0, s1, pre);
        }
        __syncthreads();
    }
}
struct SEpiZ {
    struct Pre { float rs; };
    const float* rsqs; float* SZ; int ldz, mode;
    __device__ __forceinline__ Pre pre(int row, int col) const { return Pre{rstd32(rsqs + row * 32)}; }
    __device__ __forceinline__ void operator()(int row, int strip, int col, f32x4 s0, f32x4 s1, const Pre& p) const {
        const int oc0 = mode == 0 ? src_even(col) : src_odd(col), oc1 = mode == 0 ? src_even(col + 4) : src_odd(col + 4);
        float* q = SZ + (size_t)row * ldz; *(f32x4*)(q + oc0) = s0 * p.rs; *(f32x4*)(q + oc1) = s1 * p.rs;
    }
};
struct SEpiRes {
    struct Pre { f32x4 x0, x1; };
    float* xs; bf16_t* xb; float* rsqs;
    __device__ __forceinline__ Pre pre(int row, int col) const { const float* q = xs + (size_t)row * D + col; return Pre{*(const f32x4*)q, *(const f32x4*)(q + 4)}; }
    __device__ __forceinline__ void operator()(int row, int strip, int col, f32x4 s0, f32x4 s1, const Pre& pr) const {
        float* p = xs + (size_t)row * D + col; const f32x4 o0 = pr.x0 + s0, o1 = pr.x1 + s1;
        *(f32x4*)p = o0; *(f32x4*)(p + 4) = o1; *(u32x4*)(xb + (size_t)row * D + col) = pack8(o0, o1);
        const int ln = ((row & 15) << 2) | ((col >> 3) & 3);
        float ss = dot4(o0, o0) + dot4(o1, o1); ss += shx(ss, 1, ln); ss += shx(ss, 2, ln);
        if ((col & 31) == 0) rsqs[row * 32 + strip] = ss;
    }
};
struct SEpiQ {
    struct Pre { float rs; };
    const float* rsqs; float* SQ;
    __device__ __forceinline__ Pre pre(int row, int col) const { return Pre{rstd32(rsqs + row * 32)}; }
    __device__ __forceinline__ void operator()(int row, int strip, int col, f32x4 s0, f32x4 s1, const Pre& p) const {
        float* q = SQ + (size_t)row * D + col; *(f32x4*)q = s0 * p.rs; *(f32x4*)(q + 4) = s1 * p.rs;
    }
};
__device__ __forceinline__ void sample_mix_even(Frame& F0, int j, int b) {
    Frame F = launder(F0);
    LAS float* pl = (LAS float*)F.lds; LAS float* red = pl + 1024;
    const int tid = F.tid, lane = F.lane, w = F.wave;
    const float* z = ((float*)(F.ws + WS_SZ)) + (size_t)b * 8192;
    float vv[2], ss = 0.f;
#pragma unroll
    for (int k = 0; k < 2; ++k) { vv[k] = z[3072 + tid + 512 * k]; ss += vv[k] * vv[k]; }
    ss = wave_sum(ss, lane); if (lane == 0) red[w] = ss;
#pragma unroll
    for (int k = 0; k < 2; ++k) {
        const int c = tid + 512 * k, g = c >> 8, win = 2 << g; const float xa = z[c];
        const float* st = FIN(3) + ((size_t)(j * 128 + b) * 15) * 1024 + c;
        float s = xa; for (int r = 16 - win; r < 15; ++r) s += st[(size_t)r * 1024];
        pl[c] = s / (float)win - xa;
        float* po = F.out + O_POOLS + ((size_t)(j * 128 + b) * 15) * 1024 + c;
        for (int r = 0; r < 14; ++r) po[(size_t)r * 1024] = st[(size_t)(r + 1) * 1024];
        po[(size_t)14 * 1024] = xa;
    }
    __syncthreads();
    float tot = 0.f;
#pragma unroll
    for (int i = 0; i < 8; ++i) tot += red[i];
    const float rv = rsqrtf(tot * (1.0f / D) + EPS);
#pragma unroll
    for (int k = 0; k < 2; ++k) {
        const int d = tid + 512 * k, g = d >> 8, dd = d & 255;
        const bf16_t* pm = ((bf16_t*)(F.ws + WS_PMT)) + (size_t)(j * 4 + g) * 65536 + (size_t)dd * 256; const LAS float* pg = pl + g * 256;
        float a = 0.f;
#pragma unroll
        for (int hb = 0; hb < 2; ++hb) {
            u32x4 pr[16];
#pragma unroll
            for (int i = 0; i < 16; ++i) pr[i] = *(const u32x4*)(pm + hb * 128 + i * 8);
#pragma unroll
            for (int i = 0; i < 16; ++i) { f32x4 p0, p1; unpack8(pr[i], p0, p1); const LAS float* q = pg + hb * 128 + i * 8; a += dot4(p0, *(const LAS f32x4*)q) + dot4(p1, *(const LAS f32x4*)(q + 4)); }
        }
        const float ya = a * FIN(12)[j * 1024 + d] * silu_f(z[1024 + d]);
        const float vn = vv[k] * rv * FIN(15)[j * 1024 + d];
        F.out[O_SGUV + (size_t)(j * 128 + b) * 1024 + d] = vn;
        const float mixed = FIN(13)[(size_t)(j * 4 + g) * 16384] * vn + FIN(14)[(j * 4 + g) * 128];
        const float yb = z[2048 + d] * mixed * silu_f(z[4096 + d]);
        ((bf16_t*)(F.ws + WS_SA2))[(size_t)b * 2048 + d] = (bf16_t)(cvt_pk_bf16(ya, 0.f) & 0xffffu); ((bf16_t*)(F.ws + WS_SA2))[(size_t)b * 2048 + 1024 + d] = (bf16_t)(cvt_pk_bf16(yb, 0.f) & 0xffffu);
    }
    __syncthreads();
}
__device__ __forceinline__ void sample_conv_odd(Frame& F0, int j, int b) {
    Frame F = launder(F0);
    const int tid = F.tid;
    const float* z = ((float*)(F.ws + WS_SZ)) + (size_t)b * 8192;
    const float* cw = FIN(18) + (size_t)j * 3 * 2048;
#pragma unroll
    for (int k = 0; k < 4; ++k) {
        const int c = tid + 512 * k;
        const float e = z[2048 + c] * z[4096 + c];
        const float s0 = FIN(4)[((size_t)(j * 128 + b) * 2 + 0) * 2048 + c], s1 = FIN(4)[((size_t)(j * 128 + b) * 2 + 1) * 2048 + c];
        const float y = cw[c] * s0 + cw[2048 + c] * s1 + cw[4096 + c] * e;
        ((bf16_t*)(F.ws + WS_SA2))[(size_t)b * 2048 + c] = (bf16_t)(cvt_pk_bf16(z[c] * y * silu_f(z[6144 + c]), 0.f) & 0xffffu);
        float* po = F.out + O_CONVS + ((size_t)(j * 128 + b) * 2) * 2048 + c; po[0] = s1; po[2048] = e;
    }
}
__device__ __forceinline__ void attn_sample(Frame& F0, int layer) {
    Frame F = launder(F0);
    LAS float* sc = (LAS float*)F.lds;
    LAS float* red = sc + 512;
    const int tid = F.tid, lane = F.lane, w = F.wave;
    for (int item = F.rk; item < 32; item += F.rw) {
        const int b = 16 * F.xq + (item >> 1), hp = item & 1;
        const float* qp = ((float*)(F.ws + WS_SQ)) + (size_t)b * D + hp * 512;
        const f32x4 q0 = *(const f32x4*)(qp + 4 * lane), q1 = *(const f32x4*)(qp + 256 + 4 * lane);
        const float* kp = FIN(5) + ((size_t)(layer * 128 + b) * 256) * 1024 + hp * 512 + 4 * lane;
        const float* vp = FIN(6) + ((size_t)(layer * 128 + b) * 256) * 1024 + hp * 512 + 4 * lane;
#pragma unroll 8
        for (int mi = 0; mi < 32; ++mi) {
            const int m = 32 * w + mi;
            const f32x4 k0 = __builtin_nontemporal_load((const f32x4*)(kp + (size_t)m * 1024)), k1 = __builtin_nontemporal_load((const f32x4*)(kp + (size_t)m * 1024 + 256));
            const float d0 = wave_sum(dot4(k0, q0), lane), d1 = wave_sum(dot4(k1, q1), lane);
            if (lane == 0) { sc[m] = d0; sc[256 + m] = d1; }
        }
        __syncthreads();
        float p0[4], p1[4], mx0 = -INFINITY, mx1 = -INFINITY;
#pragma unroll
        for (int i = 0; i < 4; ++i) { p0[i] = sc[lane + 64 * i]; p1[i] = sc[256 + lane + 64 * i]; mx0 = fmaxf(mx0, p0[i]); mx1 = fmaxf(mx1, p1[i]); }
#pragma unroll
        for (int o = 1; o < 64; o <<= 1) { mx0 = fmaxf(mx0, shx(mx0, o, lane)); mx1 = fmaxf(mx1, shx(mx1, o, lane)); }
        float sm0 = 0.f, sm1 = 0.f;
#pragma unroll
        for (int i = 0; i < 4; ++i) { p0[i] = __builtin_amdgcn_exp2f(p0[i] - mx0); p1[i] = __builtin_amdgcn_exp2f(p1[i] - mx1); sm0 += p0[i]; sm1 += p1[i]; }
        sm0 = wave_sum(sm0, lane); sm1 = wave_sum(sm1, lane);
        const float i0 = 1.0f / sm0, i1 = 1.0f / sm1;
        __syncthreads();
        if (w == 0) {
#pragma unroll
            for (int i = 0; i < 4; ++i) { sc[lane + 64 * i] = p0[i] * i0; sc[256 + lane + 64 * i] = p1[i] * i1; }
        }
        __syncthreads();
        f32x4 a0 = (f32x4){0.f, 0.f, 0.f, 0.f}, a1 = a0;
#pragma unroll 8
        for (int mi = 0; mi < 32; ++mi) {
            const int m = 32 * w + mi;
            const f32x4 v0 = __builtin_nontemporal_load((const f32x4*)(vp + (size_t)m * 1024)), v1 = __builtin_nontemporal_load((const f32x4*)(vp + (size_t)m * 1024 + 256));
            a0 += v0 * sc[m]; a1 += v1 * sc[256 + m];
        }
        *(LAS f32x4*)(red + w * 512 + 4 * lane) = a0; *(LAS f32x4*)(red + w * 512 + 256 + 4 * lane) = a1;
        __syncthreads();
        {
            float o = 0.f;
#pragma unroll
            for (int ww = 0; ww < 8; ++ww) o += red[ww * 512 + tid];
            ((bf16_t*)(F.ws + WS_SO))[(size_t)b * D + hp * 512 + tid] = (bf16_t)(cvt_pk_bf16(o, 0.f) & 0xffffu);
        }
        __syncthreads();
    }
}
#define dpp_mov(v, ctrl, row_mask) __builtin_bit_cast(float, __builtin_amdgcn_update_dpp(0, __builtin_bit_cast(int, (float)(v)), (ctrl), (row_mask), 0xf, false))
__device__ __forceinline__ float wave_sum_dpp(float x) {
    x += dpp_mov(x, 0xB1, 0xf);
    x += dpp_mov(x, 0x4E, 0xf);
    x += dpp_mov(x, 0x141, 0xf);
    x += dpp_mov(x, 0x140, 0xf);
    x += dpp_mov(x, 0x142, 0xa);
    x += dpp_mov(x, 0x143, 0xc);
    return x;
}
constexpr int FA_SC = 69632, FA_RED = 71680;
__device__ __forceinline__ void attn_fused(Frame& F0, int layer) {
    Frame F = launder(F0);
    LAS unsigned char* lds = F.lds;
    const int tid = F.tid, lane = F.lane, w = F.wave, fr = lane & 15, fq = lane >> 4;
    const bf16_t* Kl = ((bf16_t*)(F.ws + WS_KB)) + (size_t)layer * MMEM * D; const bf16_t* Vl = ((bf16_t*)(F.ws + WS_VB)) + (size_t)layer * MMEM * D;
    LAS float* sc = (LAS float*)(lds + FA_SC); LAS float* red = (LAS float*)(lds + FA_RED);
    const int sb = 16 * F.xq + (F.rk >> 1), hp = F.rk & 1;
    const float* qp = ((float*)(F.ws + WS_SQ)) + (size_t)sb * D + hp * 512;
    const f32x4 q0 = *(const f32x4*)(qp + 4 * lane), q1 = *(const f32x4*)(qp + 256 + 4 * lane);
    const float* kp = FIN(5) + ((size_t)(layer * 128 + sb) * 256 + 4 * w) * 1024 + hp * 512;
    const float* vp = FIN(6) + ((size_t)(layer * 128 + sb) * 256 + 4 * w) * 1024 + hp * 512;
    const unsigned lo16 = (unsigned)lane * 16u;
    f32x4 sv[8]; f32x4 a0 = (f32x4){0.f, 0.f, 0.f, 0.f}, a1 = a0; float mx0 = 0.f, mx1 = 0.f, iv0 = 0.f, iv1 = 0.f;
#define FA_SLOAD(base, slice) do { unsigned long long pu_ = uni64((unsigned long long)((base) + (size_t)(32 * (slice)) * 1024)); asm volatile("" : "+s"(pu_)); const char* pc_ = (const char*)(const GAS char*)pu_; \
        _Pragma("unroll") for (int r_ = 0; r_ < 4; ++r_) { sv[2 * r_] = __builtin_nontemporal_load((const f32x4*)(pc_ + r_ * 4096 + lo16)); sv[2 * r_ + 1] = __builtin_nontemporal_load((const f32x4*)(pc_ + r_ * 4096 + 1024 + lo16)); } } while (0)
    FA_SLOAD(kp, 0);
#pragma unroll 1
    for (int ui = 0; ui < 2; ++ui) {
        const int kk = 2 * F.rk + ui;
        const int b = F.xq, h = kk >> 4, qb = kk & 15;
        const size_t rowq = (size_t)b * SEQ + qb * 128 + 16 * w + fr;
        bf16x8 Qf[8];
#pragma unroll
        for (int ks = 0; ks < 8; ++ks) Qf[ks] = *(const bf16x8*)(((bf16_t*)(F.ws + WS_Q)) + rowq * D + h * 256 + 32 * ks + 8 * fq);
        const bf16_t* kbase = Kl + (size_t)(b * 256) * D + h * 256; const bf16_t* vbase = Vl + (size_t)(b * 256) * D + h * 256;
        u32x4 st[4];
        const unsigned goff = (unsigned)(tid >> 5) * (D * 2) + (unsigned)(tid & 31) * 16u, loff = (unsigned)(tid >> 5) * 528u + (unsigned)(tid & 31) * 16u;
#define ATT_GLOAD(c) do { unsigned long long pu_ = uni64((unsigned long long)(((c) < 4 ? kbase : vbase) + (size_t)(64 * ((c) & 3)) * D)); asm volatile("" : "+s"(pu_)); const char* pc_ = (const char*)(const GAS char*)pu_; \
        _Pragma("unroll") for (int i_ = 0; i_ < 4; ++i_) st[i_] = *(const u32x4*)(pc_ + (size_t)(16 * i_) * D * 2 + goff); } while (0)
#define ATT_LSTORE(slot) do { _Pragma("unroll") for (int i_ = 0; i_ < 4; ++i_) *(LAS u32x4*)(lds + (slot) * ATT_SLOT + 16 * i_ * 528 + loff) = st[i_]; } while (0)
        f32x4 S[16], Oa[16]; bf16x8 Pf[8]; float inv = 0.f;
        const f32x4 zero4 = (f32x4){0.f, 0.f, 0.f, 0.f};
        if (ui == 1) {
            float p0[4], p1[4]; mx0 = -INFINITY; mx1 = -INFINITY;
#pragma unroll
            for (int i = 0; i < 4; ++i) { p0[i] = sc[lane + 64 * i]; p1[i] = sc[256 + lane + 64 * i]; mx0 = fmaxf(mx0, p0[i]); mx1 = fmaxf(mx1, p1[i]); }
#pragma unroll
            for (int o = 1; o < 64; o <<= 1) { mx0 = fmaxf(mx0, shx(mx0, o, lane)); mx1 = fmaxf(mx1, shx(mx1, o, lane)); }
            float sm0 = 0.f, sm1 = 0.f;
#pragma unroll
            for (int i = 0; i < 4; ++i) { sm0 += __builtin_amdgcn_exp2f(p0[i] - mx0); sm1 += __builtin_amdgcn_exp2f(p1[i] - mx1); }
            sm0 = wave_sum(sm0, lane); sm1 = wave_sum(sm1, lane);
            iv0 = 1.0f / sm0; iv1 = 1.0f / sm1;
        }
        ATT_GLOAD(0); ATT_LSTORE(0); __syncthreads();
#pragma unroll
        for (int c = 0; c < 8; ++c) {
            if (c < 7) ATT_GLOAD(c + 1);
            if (ui == 0) {
#pragma unroll
                for (int r = 0; r < 4; ++r) {
                    const int m = 32 * c + 4 * w + r;
                    const float d0 = wave_sum_dpp(dot4(sv[2 * r], q0)), d1 = wave_sum_dpp(dot4(sv[2 * r + 1], q1));
                    if (lane == 63) { sc[m] = d0; sc[256 + m] = d1; }
                }
                if (c < 7) FA_SLOAD(kp, c + 1); else FA_SLOAD(vp, 0);
            } else {
#pragma unroll
                for (int r = 0; r < 4; ++r) {
                    const int m = 32 * c + 4 * w + r;
                    const float p0 = __builtin_amdgcn_exp2f(sc[m] - mx0) * iv0, p1 = __builtin_amdgcn_exp2f(sc[256 + m] - mx1) * iv1;
                    a0 += sv[2 * r] * p0; a1 += sv[2 * r + 1] * p1;
                }
                if (c < 7) FA_SLOAD(vp, c + 1);
            }
            LAS unsigned char* slot = lds + (c & 1) * ATT_SLOT;
            if (c < 4) {
#pragma unroll
                for (int ml = 0; ml < 4; ++ml)
#pragma unroll
                    for (int ks = 0; ks < 8; ++ks) {
                        const bf16x8 Kf = *(LAS bf16x8*)(slot + (16 * ml + fr) * 528 + (32 * ks + 8 * fq) * 2);
                        S[4 * c + ml] = MFMA16(Kf, Qf[ks], ks == 0 ? zero4 : S[4 * c + ml]);
                    }
                if (c == 3) {
                    float mx = S[0][0];
#pragma unroll
                    for (int i = 0; i < 16; ++i) { mx = fmaxf(mx, fmaxf(fmaxf(S[i][0], S[i][1]), fmaxf(S[i][2], S[i][3]))); }
                    mx = fmaxf(mx, shx(mx, 16, lane)); mx = fmaxf(mx, shx(mx, 32, lane));
                    float sum = 0.f;
#pragma unroll
                    for (int i = 0; i < 16; ++i) {
#pragma unroll
                        for (int e = 0; e < 4; ++e) { S[i][e] = __builtin_amdgcn_exp2f(S[i][e] - mx); sum += S[i][e]; }
                    }
                    sum += shx(sum, 16, lane); sum += shx(sum, 32, lane);
                    inv = 1.0f / sum;
#pragma unroll
                    for (int a = 0; a < 8; ++a) {
                        u32x4 pw; pw.x = cvt_pk_bf16(S[2 * a][0], S[2 * a][1]); pw.y = cvt_pk_bf16(S[2 * a][2], S[2 * a][3]); pw.z = cvt_pk_bf16(S[2 * a + 1][0], S[2 * a + 1][1]); pw.w = cvt_pk_bf16(S[2 * a + 1][2], S[2 * a + 1][3]);
                        Pf[a] = __builtin_bit_cast(bf16x8, pw);
                    }
                }
            } else {
#pragma unroll
                for (int al = 0; al < 2; ++al)
#pragma unroll
                    for (int dt = 0; dt < 16; ++dt) {
                        LAS unsigned char* p = slot + (32 * al + 4 * fq + (fr >> 2)) * 528 + (16 * dt + 4 * (fr & 3)) * 2;
                        const bf16x8 Vf = tr_frag(p, p + 16 * 528);
                        Oa[dt] = MFMA16(Vf, Pf[2 * (c - 4) + al], (c == 4 && al == 0) ? zero4 : Oa[dt]);
                    }
            }
            if (c < 7) ATT_LSTORE((c + 1) & 1);
            __syncthreads();
        }
#pragma unroll
        for (int dt = 0; dt < 16; ++dt) *(u32x2*)(((bf16_t*)(F.ws + WS_O)) + rowq * D + h * 256 + 16 * dt + 4 * fq) = pack4(Oa[dt] * inv);
#undef ATT_GLOAD
#undef ATT_LSTORE
    }
#undef FA_SLOAD
    *(LAS f32x4*)(red + w * 512 + 4 * lane) = a0; *(LAS f32x4*)(red + w * 512 + 256 + 4 * lane) = a1;
    __syncthreads();
    {
        float o = 0.f;
#pragma unroll
        for (int ww = 0; ww < 8; ++ww) o += red[ww * 512 + tid];
        ((bf16_t*)(F.ws + WS_SO))[(size_t)sb * D + hp * 512 + tid] = (bf16_t)(cvt_pk_bf16(o, 0.f) & 0xffffu);
    }
    __syncthreads();
}
__device__ __forceinline__ void final_norm(Frame& F0) {
    Frame F = launder(F0);
    const int gwx = F.rk * NWAVES + F.wave, NGX = F.rw * NWAVES, lane = F.lane;
    f32x4 g[4];
#pragma unroll
    for (int jj = 0; jj < 4; ++jj) g[jj] = ((const f32x4*)FIN(24) + lane)[64 * jj];
    for (int p = gwx; p < SEQ / 2 + 8; p += NGX) {
        const int m0 = p < SEQ / 2 ? F.xq * SEQ + 2 * p : MP + 16 * F.xq + 2 * (p - SEQ / 2);
        f32x4 v[2][4];
#pragma unroll
        for (int r = 0; r < 2; ++r) {
            const int m = m0 + r;
            if (m < MP) {
                const u32x2* src = (const u32x2*)(((bf16_t*)(F.ws + WS_XB)) + (size_t)m * D) + lane;
#pragma unroll
                for (int jj = 0; jj < 4; ++jj) v[r][jj] = unpack4(src[64 * jj]);
            } else {
                const f32x4* src = (const f32x4*)(((float*)(F.ws + WS_XS)) + (size_t)(m - MP) * D) + lane;
#pragma unroll
                for (int jj = 0; jj < 4; ++jj) v[r][jj] = src[64 * jj];
            }
        }
#pragma unroll
        for (int r = 0; r < 2; ++r) {
            const int m = m0 + r; float s = 0.f;
#pragma unroll
            for (int jj = 0; jj < 4; ++jj) s += dot4(v[r][jj], v[r][jj]);
            float* dst = m < MP ? F.out + O_Y + (size_t)m * D : F.out + O_YS + (size_t)(m - MP) * D;
            const float rs = rsqrtf(wave_sum(s, lane) * (1.0f / D) + EPS);
#pragma unroll
            for (int jj = 0; jj < 4; ++jj) ((f32x4*)dst + lane)[64 * jj] = v[r][jj] * rs * g[jj];
        }
    }
}

struct Args { const float* in[25]; float* out; unsigned char* ws; int ph_lo, ph_hi; };
#define REP(bit) for (int rep_ = 0; rep_ < 1 + ((REP_MASK >> (bit)) & 1); ++rep_)
__global__ void __launch_bounds__(NWAVES * 64, 2) fwd(Args args) {
    extern __shared__ __attribute__((aligned(16))) unsigned char lds_raw[];
    Frame F0;
    F0.lds = (LAS unsigned char*)lds_raw;
    F0.tid = threadIdx.x; F0.lane = F0.tid & 63; F0.wave = __builtin_amdgcn_readfirstlane(F0.tid >> 6); F0.G = gridDim.x; F0.bx = blockIdx.x;
    F0.in = (in_tab_t)__builtin_amdgcn_kernarg_segment_ptr();     F0.out = args.out; F0.ws = args.ws;
    for (int u = F0.tid; u < (LDS_BYTES - LDSCTL_OFF) / 4; u += NWAVES * 64) ((LAS unsigned*)(F0.lds + LDSCTL_OFF))[u] = 0u;
    __syncthreads();
    XcdBarrier bar; bar.wave = F0.wave; bar.bar = (unsigned*)(args.ws + WS_CTL) + CW_BAR; bar.x = 0; bar.st = nullptr;
    if (!MK_SPLIT) bar = xcd_barrier_post((unsigned*)(args.ws + WS_CTL) + CW_BAR, (volatile LAS unsigned*)(F0.lds + MISC_OFF) + 8, F0.wave);
    unsigned* rankw = (unsigned*)(args.ws + WS_CTL) + CW_RANK;
    const unsigned my_xcc = xb_xcc_id();
    unsigned my_rank = 0u;
    if (F0.tid == 0) ((volatile LAS unsigned*)(F0.lds + MISC_OFF))[12] = __hip_atomic_fetch_add(rankw + 64 * my_xcc, 1u, __ATOMIC_RELAXED, __HIP_MEMORY_SCOPE_AGENT);
    __syncthreads();
    my_rank = __builtin_amdgcn_readfirstlane(((volatile LAS unsigned*)(F0.lds + MISC_OFF))[12]);
    F0.vid = F0.bx;
    int ph = 0;
    bool local_ok = false;
    const int lo = args.ph_lo, hi = args.ph_hi;
#define PH_BEGIN if (ph >= lo && ph < hi) { Frame F = launder(F0);
#define PH_END } { const bool both_ = (ph >= lo && ph + 1 < hi); ++ph; if (!MK_SPLIT && both_) { XcdBarrier b2_ = bar; unsigned long long bp_ = uni64((unsigned long long)bar.bar); unsigned bx_ = __builtin_amdgcn_readfirstlane(bar.x); int bw_ = __builtin_amdgcn_readfirstlane(bar.wave); asm volatile("" : "+s"(bp_), "+s"(bx_), "+s"(bw_)); b2_.bar = (unsigned*)(GAS unsigned*)bp_; b2_.x = bx_; b2_.wave = bw_; if (local_ok && ph > 2) xcd_barrier_local(b2_); else xcd_barrier(b2_); if ((REP_MASK >> 19) & 1) xcd_barrier(b2_); if (ph == 2) local_ok = XCD_LOCAL && lo == 0 && __builtin_amdgcn_readfirstlane(__hip_atomic_load(rankw + 64 * 20, __ATOMIC_RELAXED, __HIP_MEMORY_SCOPE_AGENT)) == 0u;     } }

    PH_BEGIN REP(0) { p0_prologue(F0); __syncthreads(); } PH_END
    if (!MK_SPLIT && lo == 0) {
        unsigned nx = 0u, xi = 0u; bool even = (F0.G % 8) == 0;
        for (unsigned jx = 0; jx < 16; ++jx) { const unsigned c_ = __hip_atomic_load(rankw + 64 * jx, __ATOMIC_RELAXED, __HIP_MEMORY_SCOPE_AGENT); if (c_) { if (c_ != (unsigned)F0.G / 8u) even = false; if (jx < my_xcc) ++xi; ++nx; } }
        if (XCD_VID && even && nx == 8u) F0.vid = (int)(my_rank * 8u + xi);
        if (!(even && nx == 8u && (unsigned)(F0.bx % 8) == xi) && F0.tid == 0) __hip_atomic_store(rankw + 64 * 20, 1u, __ATOMIC_RELAXED, __HIP_MEMORY_SCOPE_AGENT);
        if (((REP_MASK >> 18) & 1) && !(even && nx == 8u && (unsigned)(F0.bx % 8) == xi) && F0.tid == 0) F0.out[O_YS + F0.bx] = __builtin_nanf("");
        F0.vid = __builtin_amdgcn_readfirstlane(F0.vid);
    }
    PH_BEGIN {
        if ((REP_MASK >> 17) & 1) {
            f32x4 pa[8]; bf16x8 pb = (bf16x8){(short)F.tid, 1, 2, 3, 4, 5, 6, 7};
#pragma unroll
            for (int i = 0; i < 8; ++i) pa[i] = (f32x4){(float)F.tid, 1.f, 2.f, (float)i};
#pragma unroll 1
            for (int it = 0; it < 512; ++it) {
#pragma unroll
                for (int r = 0; r < 4; ++r)
#pragma unroll
                    for (int i = 0; i < 8; ++i) pa[i] = MFMA16(pb, pb, pa[i]);
            }
            float sacc = 0.f;
#pragma unroll
            for (int i = 0; i < 8; ++i) sacc += pa[i][0] + pa[i][3];
            if (sacc == 12345.678f) ((float*)(F.ws + WS_Z))[F.tid] = sacc;
        }
        if ((REP_MASK >> 15) & 3) { pg8::Gemm gp{((bf16_t*)(F.ws + WS_XB)), ((bf16_t*)(F.ws + WS_C1)), MP, NC, ((REP_MASK >> 15) & 1) ? 1024 : 512}; pg8::StaticOrder Sp; Sp.init(MP, NC, F.G, (int)F.vid); EpiProbe Ep{((bf16_t*)(F.ws + WS_Z)), NC}; pg8::gemm_phase<EpiProbe, pg8::StaticOrder, true, true>(F.lds, gp, Sp, Ep, F.wave); }
        pg8::Gemm g{((bf16_t*)(F.ws + WS_MEMB)), ((bf16_t*)(F.ws + WS_WKV)), MMEM, 8192, D}; pg8::StaticOrder S; S.init(MMEM, 8192, F.G, (int)F.vid);
        EpiMemKV E{((float*)(F.ws + WS_SMALL + 65536)), F.out + O_MEMK, F.out + O_MEMV, ((bf16_t*)(F.ws + WS_KB)), ((bf16_t*)(F.ws + WS_VB))};
        REP(1) pg8::gemm_phase<EpiMemKV, pg8::StaticOrder, true, true>(F.lds, g, S, E, F.wave);
    } PH_END
    unsigned* pbw = (unsigned*)(args.ws + WS_CTL) + CW_RANK + 64 * 24;
    if (!MK_SPLIT && SPLIT_PROLOGUE && lo == 0 && (F0.bx & 1)) {
        p0_weights(F0, 1, (F0.bx >> 1) * NWAVES + F0.wave, ((F0.G + 1) >> 1) * NWAVES);
        asm volatile("s_waitcnt vmcnt(0)" ::: "memory"); __syncthreads();
        if (F0.wave == 0 && hw_lane() == 0) { __builtin_amdgcn_fence(__ATOMIC_RELEASE, "agent"); asm volatile("s_waitcnt vmcnt(0)" ::: "memory"); (void)__hip_atomic_fetch_add(pbw, 1u, __ATOMIC_RELAXED, __HIP_MEMORY_SCOPE_AGENT); }
    }
#pragma unroll 1
    for (int l = 0; l < DEPTH; ++l) {
        const int j = l >> 1;
        if (!MK_SPLIT && SPLIT_PROLOGUE && lo == 0 && l == 1) {
            if (F0.wave == 0 && hw_lane() == 0) {
                const unsigned want = (unsigned)F0.G >> 1; unsigned sp = 0u;
                while (__hip_atomic_load(pbw, __ATOMIC_RELAXED, __HIP_MEMORY_SCOPE_AGENT) < want) { __builtin_amdgcn_s_sleep(2); if (++sp > (1u << 22)) { atomicAdd((unsigned*)(args.ws + WS_CTL) + CW_BAR + XB_TMO, 1u); break; } }
                __builtin_amdgcn_fence(__ATOMIC_ACQUIRE, "agent"); asm volatile("s_waitcnt vmcnt(0)" ::: "memory");
            }
            __syncthreads();
        }
        if ((l & 1) == 0) {
            PH_BEGIN {
                pg8::Gemm g{((bf16_t*)(F.ws + WS_XB)), ((bf16_t*)(F.ws + WS_AB1)) + (size_t)j * NAB * D, MP, NAB, D}; pg8::StaticOrder S; S.init(MP, NAB, F.G, (int)F.vid);
                Unit u0{0, 0}; S.next(0, u0); rstd_table(((float*)(F.ws + WS_RSQ)), u0.pm, (LAS float*)(F.lds + RSTD_OFF), F.tid);
                EpiG1Even E{((float*)(F.ws + WS_RSQ)), ((bf16_t*)(F.ws + WS_Z)), ((float*)(F.ws + WS_VSQ)), F.out + O_POOLP + (size_t)j * 8 * 15 * 1024, (LAS const float*)(F.lds + RSTD_OFF), u0.pm};
                SEpiZ SE{((float*)(F.ws + WS_SMALL)), ((float*)(F.ws + WS_SZ)), 8192, 0};
                const bool s_first = (F.rk & 1) != 0;
                if (s_first) { REP(3) sgemm16<SEpiZ, NAB>(F, ((bf16_t*)(F.ws + WS_XB)) + (size_t)MP * D, ((bf16_t*)(F.ws + WS_AB1)) + (size_t)j * NAB * D, D, SE); }
                REP(2) pg8::gemm_phase<EpiG1Even, pg8::StaticOrder, true, true>(F.lds, g, S, E, F.wave);
                if (!s_first) { REP(3) sgemm16<SEpiZ, NAB>(F, ((bf16_t*)(F.ws + WS_XB)) + (size_t)MP * D, ((bf16_t*)(F.ws + WS_AB1)) + (size_t)j * NAB * D, D, SE); }
            } PH_END
            PH_BEGIN {
                REP(4) for (int i = F.rk; i < 32; i += F.rw) { if ((i & 1) == 0) sgu_chunk(F, j, 16 * F.xq + (i >> 1)); else pool_chunk(F, j, 16 * F.xq + (i >> 1)); }
                REP(5) for (int i = F.rk; i < 16; i += F.rw) sample_mix_even(F, j, 16 * F.xq + i);
            } PH_END
        } else {
            PH_BEGIN {
                pg8::Gemm g{((bf16_t*)(F.ws + WS_XB)), ((bf16_t*)(F.ws + WS_C1)) + (size_t)j * NC * D, MP, NC, D}; pg8::StaticOrder S; S.init(MP, NC, F.G, (int)F.vid);
                Unit u0{0, 0}; S.next(0, u0);
                for (int i = F.tid; i < 8 * 3 * 64; i += NWAVES * 64) { const int ui = i / 192, q = (i / 64) % 3, c = i & 63, pn = u0.pn + 4 * ui; ((LAS float*)(F.lds + CWL_OFF))[i] = pn < NC / 256 ? (FIN(18) + (size_t)j * 3 * 2048)[q * 2048 + pn * 64 + c] : 0.f; }
                rstd_table(((float*)(F.ws + WS_RSQ)), u0.pm, (LAS float*)(F.lds + RSTD_OFF), F.tid);
                EpiG1Odd E{((float*)(F.ws + WS_RSQ)), ((bf16_t*)(F.ws + WS_A2)), FIN(18) + (size_t)j * 3 * 2048, F.out + O_CONVP + (size_t)j * 8 * 2 * 2048, ((float*)(F.ws + WS_SIDE)), (LAS float*)(F.lds + HALO_OFF), (LAS const float*)(F.lds + RSTD_OFF), u0.pm, (LAS const float*)(F.lds + CWL_OFF), u0.pn};
                SEpiZ SE{((float*)(F.ws + WS_SMALL)), ((float*)(F.ws + WS_SZ)), 8192, 1};
                const bool s_first = (F.rk & 1) != 0;
                if (s_first) { REP(3) sgemm16<SEpiZ, NC>(F, ((bf16_t*)(F.ws + WS_XB)) + (size_t)MP * D, ((bf16_t*)(F.ws + WS_C1)) + (size_t)j * NC * D, D, SE); }
                REP(6) pg8::gemm_phase<EpiG1Odd, pg8::StaticOrder, true, true>(F.lds, g, S, E, F.wave);
                if (!s_first) { REP(3) sgemm16<SEpiZ, NC>(F, ((bf16_t*)(F.ws + WS_XB)) + (size_t)MP * D, ((bf16_t*)(F.ws + WS_C1)) + (size_t)j * NC * D, D, SE); }
            } PH_END
            PH_BEGIN {
                REP(5) for (int i = F.rk; i < 16; i += F.rw) sample_conv_odd(F, j, 16 * F.xq + i);
            } PH_END
        }
        PH_BEGIN {
            const bf16_t* W2 = ((l & 1) ? ((bf16_t*)(F.ws + WS_C2)) : ((bf16_t*)(F.ws + WS_AB2))) + (size_t)j * D * 2048;
            pg8::Gemm g{((bf16_t*)(F.ws + WS_A2)), W2, MP, D, 2048}; pg8::StaticOrder S; S.init(MP, D, F.G, (int)F.vid);
            if (l & 1) { Unit fu; for (int i = 0; S.next(i, fu); ++i) conv_fixup(((float*)(F.ws + WS_SIDE)), FIN(18) + (size_t)j * 3 * 2048, ((bf16_t*)(F.ws + WS_A2)), fu.pm, F.tid); asm volatile("s_waitcnt vmcnt(0)" ::: "memory"); __syncthreads(); }
            EpiRes E{((bf16_t*)(F.ws + WS_XB)), ((float*)(F.ws + WS_RSQ))};
            pg8::gemm_phase<EpiRes, pg8::StaticOrder, true, true>(F.lds, g, S, E, F.wave);
            SEpiRes SE{((float*)(F.ws + WS_XS)), ((bf16_t*)(F.ws + WS_XB)) + (size_t)MP * D, ((float*)(F.ws + WS_SMALL))};
            sgemm16<SEpiRes, D>(F, ((bf16_t*)(F.ws + WS_SA2)), W2, 2048, SE);
        } PH_END
        PH_BEGIN {
            pg8::Gemm g{((bf16_t*)(F.ws + WS_XB)), ((bf16_t*)(F.ws + WS_WQ)) + (size_t)l * D * D, MP, D, D}; pg8::StaticOrder S; S.init(MP, D, F.G, (int)F.vid);
            Unit u0{0, 0}; S.next(0, u0); rstd_table(((float*)(F.ws + WS_RSQ)), u0.pm, (LAS float*)(F.lds + RSTD_OFF), F.tid);
            EpiQ E{((float*)(F.ws + WS_RSQ)), ((bf16_t*)(F.ws + WS_Q)), (LAS const float*)(F.lds + RSTD_OFF), u0.pm};
            REP(8) pg8::gemm_phase<EpiQ, pg8::StaticOrder, true, true>(F.lds, g, S, E, F.wave);
            SEpiQ SE{((float*)(F.ws + WS_SMALL)), ((float*)(F.ws + WS_SQ))};
            REP(9) sgemm16<SEpiQ, D>(F, ((bf16_t*)(F.ws + WS_XB)) + (size_t)MP * D, ((bf16_t*)(F.ws + WS_WQ)) + (size_t)l * D * D, D, SE);
        } PH_END
        PH_BEGIN {
            if (F.G == 256) { REP(10) attn_fused(F, l); }
            else { attn_prompt(F, l); attn_sample(F, l); }
        } PH_END
        PH_BEGIN {
            pg8::Gemm g{((bf16_t*)(F.ws + WS_O)), ((bf16_t*)(F.ws + WS_WO)) + (size_t)l * D * D, MP, D, D}; pg8::StaticOrder S; S.init(MP, D, F.G, (int)F.vid);
            EpiRes E{((bf16_t*)(F.ws + WS_XB)), ((float*)(F.ws + WS_RSQ))};
            pg8::gemm_phase<EpiRes, pg8::StaticOrder, true, true>(F.lds, g, S, E, F.wave);
            SEpiRes SE{((float*)(F.ws + WS_XS)), ((bf16_t*)(F.ws + WS_XB)) + (size_t)MP * D, ((float*)(F.ws + WS_SMALL))};
            sgemm16<SEpiRes, D>(F, ((bf16_t*)(F.ws + WS_SO)), ((bf16_t*)(F.ws + WS_WO)) + (size_t)l * D * D, D, SE);
        } PH_END
    }
    PH_BEGIN final_norm(F0); PH_END
#undef PH_BEGIN
#undef PH_END
}
constexpr int N_PHASES = 2 + 6 * DEPTH + 1;

extern "C" void kernel_launch(void* const* d_in, const int* in_sizes, int n_in, void* d_out, int out_size, void* d_ws, size_t ws_size, hipStream_t stream) {
    static int grid = 0;
    if (grid == 0) {
        if (n_in != 25 || in_sizes[0] != MP * D || (size_t)out_size != O_END || ws_size < WS_END) { fprintf(stderr, "kernel_launch: unexpected shapes (n_in %d, in0 %d, out %d, ws %zu); nothing launched\n", n_in, n_in > 0 ? in_sizes[0] : -1, out_size, ws_size); grid = -1; return; }
        int dev = 0, cus = 0, per_cu = 0;
        if (hipGetDevice(&dev) != hipSuccess || hipDeviceGetAttribute(&cus, hipDeviceAttributeMultiprocessorCount, dev) != hipSuccess) { fprintf(stderr, "kernel_launch: device query failed\n"); grid = -1; return; }
        if (hipFuncSetAttribute((const void*)fwd, hipFuncAttributeMaxDynamicSharedMemorySize, LDS_BYTES) != hipSuccess) { fprintf(stderr, "kernel_launch: hipFuncSetAttribute failed\n"); grid = -1; return; }
        if (hipOccupancyMaxActiveBlocksPerMultiprocessor(&per_cu, (const void*)fwd, NWAVES * 64, LDS_BYTES) != hipSuccess || per_cu < 1) fprintf(stderr, "kernel_launch: note: occupancy query reports %d workgroups per CU\n", per_cu);
        (void)hipGetLastError();
        grid = cus;
    }
    if (grid < 0) return;
    if (hipMemsetAsync((char*)d_ws + WS_CTL, 0, CTL_ZERO_BYTES, stream) != hipSuccess) { fprintf(stderr, "kernel_launch: memset failed\n"); return; }
    Args a{};
    for (int i = 0; i < 25; ++i) a.in[i] = (const float*)d_in[i];
    a.out = (float*)d_out; a.ws = (unsigned char*)d_ws;
#if MK_SPLIT
    for (int p = 0; p < N_PHASES; ++p) { a.ph_lo = p; a.ph_hi = p + 1; hipLaunchKernelGGL(fwd, dim3(grid), dim3(NWAVES * 64), LDS_BYTES, stream, a); }
#else
    a.ph_lo = 0; a.ph_hi = N_PHASES;
    hipLaunchKernelGGL(fwd, dim3(grid), dim3(NWAVES * 64), LDS_BYTES, stream, a);
#endif
    const hipError_t le = hipPeekAtLastError();
    if (le != hipSuccess) fprintf(stderr, "kernel_launch: launch failed: %s\n", hipGetErrorName(le));
}
```

```cpp
#include <hip/hip_runtime.h>
#include <cstdio>
#include <cstdint>
#ifndef REP_MASK
#define REP_MASK 0
#endif
#ifndef STAGGER_TICKS
#define STAGGER_TICKS 0
#endif
#ifndef PB_ODD_PCT
#define PB_ODD_PCT 100
#endif
#ifndef SPLIT_PROLOGUE
#define SPLIT_PROLOGUE 1
#endif
#ifndef XCD_LOCAL
#define XCD_LOCAL 1
#endif
#ifndef XCD_VID
#define XCD_VID 0
#endif
#ifndef MK_SPLIT
#define MK_SPLIT 0
#endif
__device__ __forceinline__ int hw_lane() { int l; asm volatile("v_mbcnt_lo_u32_b32 %0, -1, 0\n\tv_mbcnt_hi_u32_b32 %0, -1, %0" : "=v"(l)); return l; }
namespace pg8 {
#define PG8_LAS __attribute__((address_space(3)))
typedef unsigned short bf16_t;
typedef short bf16x8 __attribute__((ext_vector_type(8)));
typedef float f32x4 __attribute__((ext_vector_type(4)));
typedef unsigned u32x4 __attribute__((ext_vector_type(4)));
constexpr int BM = 256, BK = 64, HALF = 128, HTB = HALF * BK * 2  , STAGE_BYTES = 8 * HTB, NXCD = 8, WGM = 8;

__host__ __device__ __forceinline__ int lds_byte(int r, int c) { const int st = (r >> 4) * 2 + (c >> 5), rr = r & 15, cc = c & 31, ob = rr * 64 + cc * 2; return st * 1024 + (ob ^ (((ob >> 9) & 1) << 5)); }
__host__ __device__ __forceinline__ void stage_rc(int b, int& R, int& C) { const int st = b / 1024, sb = b % 1024, swz = sb ^ (((sb >> 9) & 1) << 5); R = (st >> 1) * 16 + swz / 64; C = (st & 1) * 32 + (swz % 64) / 2; }
__host__ __device__ __forceinline__ int perm32(int rho) { const int n = rho >> 4, i = rho & 15; return 8 * (i >> 2) + 4 * n + (i & 3); }

struct Unit { int pm, pn; };
struct Gemm { const bf16_t* A; const bf16_t* Bt; int M, N, K; };

struct StaticOrder {
    int nM, nN, nwg, G, c;
    __host__ __device__ __forceinline__ void init(int M, int N, int G_, int c_) { nM = M / BM; nN = N / BM; nwg = nM * nN; G = G_; c = c_; }
    __host__ __device__ __forceinline__ bool next(int i, Unit& u) const {
        const long L = (long)i * G + c; if (L >= nwg) return false;
        int wgid = (int)L; { const int q = nwg / NXCD, r = nwg % NXCD, xcd = wgid % NXCD, off = wgid / NXCD; wgid = (xcd < r ? xcd * (q + 1) : r * (q + 1) + (xcd - r) * q) + off; }
        const int nig = WGM * nN, gid = wgid / nig, fm = gid * WGM, gsz = (nM - fm) < WGM ? (nM - fm) : WGM;
        u.pm = fm + ((wgid % nig) % gsz); u.pn = (wgid % nig) / gsz; return true;
    }
    __device__ __forceinline__ void a_ready(const Unit&) const {}
    __device__ __forceinline__ void done(const Unit&) const {}
};

typedef float f32x2cv __attribute__((ext_vector_type(2))); typedef __bf16 bf16x2cv __attribute__((ext_vector_type(2)));
__device__ __forceinline__ unsigned cvt_pk_bf16(float lo, float hi) { const f32x2cv v = {lo, hi}; return __builtin_bit_cast(unsigned, __builtin_convertvector(v, bf16x2cv)); }
template <class Epi, class Sched, bool ALIGN_EPI = false, bool SP2 = false>
__device__ __forceinline__ void gemm_phase(PG8_LAS unsigned char* lds, const Gemm g, const Sched& S, const Epi& E, const int wave_id) {
    int tid_ = (wave_id << 6) | hw_lane(); asm volatile("" : "+v"(tid_));
    const int tid = tid_, wid = __builtin_amdgcn_readfirstlane(tid >> 6), lane = tid & 63, wr = wid >> 2, wc = wid & 3, fr = lane & 15, fq = lane >> 4;
    const int K = g.K, nt = K / BK;
    unsigned voffA[2], voffB[2];
#pragma unroll
    for (int i = 0; i < 2; ++i) { int R, C; stage_rc(tid * 16 + i * 8192, R, C); const int Rb = Epi::PERM ? ((R & ~31) + perm32(R & 31)) : R;
        voffA[i] = (unsigned)(R * K + C) * 2u; voffB[i] = (unsigned)(Rb * K + C) * 2u; }
    const size_t kstep = (size_t)(BK * 2);
    const size_t hstep = (size_t)HALF * K * 2;
    const size_t tstep = 2 * hstep;
    const unsigned ldsw = (unsigned)wid * 1024u;
    const int aoff = lds_byte(wr * 64 + fr, fq * 8), boff = lds_byte(wc * 32 + fr, fq * 8);
#define PG8_SA(b, h) (((b) * 2 + (h)) * HTB)
#define PG8_SB(b, h) ((4 + (b) * 2 + (h)) * HTB)
#define PG8_STAGE(bufoff, gbase, voff) do { _Pragma("unroll") for (int _i = 0; _i < 2; ++_i) \
        __builtin_amdgcn_global_load_lds((const unsigned*)((const char*)(gbase) + (voff)[_i]), (PG8_LAS unsigned*)(lds + (bufoff) + ldsw + _i * 8192), 16, 0, 0); } while (0)
#define PG8_LDA(dst, b, h) do { _Pragma("unroll") for (int m = 0; m < 4; ++m) _Pragma("unroll") for (int k = 0; k < 2; ++k) dst[m][k] = *(const PG8_LAS bf16x8*)(lds + PG8_SA(b, h) + aoff + m * 2048 + k * 1024); } while (0)
#define PG8_LDB(dst, b, h) do { _Pragma("unroll") for (int n = 0; n < 2; ++n) _Pragma("unroll") for (int k = 0; k < 2; ++k) dst[n][k] = *(const PG8_LAS bf16x8*)(lds + PG8_SB(b, h) + boff + n * 2048 + k * 1024); } while (0)
#define PG8_MMA(ai, bj, At, Bt) do { __builtin_amdgcn_s_setprio(1); _Pragma("unroll") for (int m = 0; m < 4; ++m) _Pragma("unroll") for (int n = 0; n < 2; ++n) _Pragma("unroll") for (int k = 0; k < 2; ++k) \
        acc[ai][bj][m][n] = __builtin_amdgcn_mfma_f32_16x16x32_bf16(Bt[n][k], At[m][k], acc[ai][bj][m][n], 0, 0, 0); __builtin_amdgcn_s_setprio(0); } while (0)
#define PG8_WAIT_V(n) asm volatile("s_waitcnt vmcnt(" #n ")" ::: "memory")
#define PG8_WAIT_L(n) asm volatile("s_waitcnt lgkmcnt(" #n ")" ::: "memory")
#define PG8_BAR __builtin_amdgcn_s_barrier()
#define PG8_SCHED __builtin_amdgcn_sched_barrier(0)
    Unit cur, nxt; int ui = 0;
    if (!S.next(0, cur)) return;
    f32x4 acc[2][2][4][2];
#pragma unroll
    for (int a = 0; a < 2; ++a)
#pragma unroll
        for (int b = 0; b < 2; ++b)
#pragma unroll
            for (int m = 0; m < 4; ++m)
#pragma unroll
                for (int n = 0; n < 2; ++n) acc[a][b][m][n] = (f32x4){0.f, 0.f, 0.f, 0.f};
    bf16x8 At[4][2], B0[2][2], B1[2][2];
    const char* cA = (const char*)g.A + (size_t)cur.pm * tstep; const char* cB = (const char*)g.Bt + (size_t)cur.pn * tstep;
    S.a_ready(cur);
    if constexpr (SP2) {
        PG8_STAGE(PG8_SB(0, 0), cB, voffB); PG8_STAGE(PG8_SB(0, 1), cB + hstep, voffB); PG8_STAGE(PG8_SA(0, 0), cA, voffA); PG8_STAGE(PG8_SA(0, 1), cA + hstep, voffA);
        if (wr == 1) PG8_BAR;
        PG8_WAIT_V(2); PG8_BAR;
        PG8_STAGE(PG8_SB(1, 0), cB + kstep, voffB); PG8_STAGE(PG8_SA(1, 0), cA + kstep, voffA); PG8_STAGE(PG8_SB(1, 1), cB + hstep + kstep, voffB);
        PG8_WAIT_V(6); PG8_BAR;
    } else {
        PG8_STAGE(PG8_SB(0, 0), cB, voffB); PG8_STAGE(PG8_SA(0, 0), cA, voffA); PG8_STAGE(PG8_SB(0, 1), cB + hstep, voffB); PG8_STAGE(PG8_SA(0, 1), cA + hstep, voffA);
        if (wr == 1) PG8_BAR;
        PG8_WAIT_V(4); PG8_BAR;
        PG8_STAGE(PG8_SB(1, 0), cB + kstep, voffB); PG8_STAGE(PG8_SA(1, 0), cA + kstep, voffA); PG8_STAGE(PG8_SB(1, 1), cB + hstep + kstep, voffB);
        PG8_WAIT_V(6); PG8_BAR;
    }
    for (;;) {
        const bool has_next = S.next(ui + 1, nxt);
        const char* nA = has_next ? (const char*)g.A + (size_t)nxt.pm * tstep : cA; const char* nB = has_next ? (const char*)g.Bt + (size_t)nxt.pn * tstep : cB;
        for (int t = 0; t < nt; t += 2) {
            const bool last = (t == nt - 2);
            const char* a1 = cA + (size_t)(t + 1) * kstep;
            const char* a2 = last ? nA : cA + (size_t)(t + 2) * kstep; const char* b2 = last ? nB : cB + (size_t)(t + 2) * kstep;
            const char* a3 = a2 + kstep; const char* b3 = b2 + kstep;
            if (last && has_next) S.a_ready(nxt);
            if constexpr (SP2) {
            PG8_LDB(B0, 0, 0); PG8_LDB(B1, 0, 1); PG8_SCHED; PG8_LDA(At, 0, 0); PG8_STAGE(PG8_SA(1, 1), a1 + hstep, voffA);
            PG8_WAIT_V(8); PG8_WAIT_L(0); PG8_BAR; PG8_MMA(0, 0, At, B0); PG8_MMA(0, 1, At, B1); PG8_BAR; PG8_SCHED;
            PG8_LDA(At, 0, 1); PG8_STAGE(PG8_SB(0, 0), b2, voffB); PG8_STAGE(PG8_SB(0, 1), b2 + hstep, voffB); PG8_STAGE(PG8_SA(0, 0), a2, voffA);
            PG8_WAIT_V(8); PG8_WAIT_L(0); PG8_BAR; PG8_MMA(1, 0, At, B0); PG8_MMA(1, 1, At, B1); PG8_BAR; PG8_SCHED;
            PG8_LDB(B0, 1, 0); PG8_LDB(B1, 1, 1); PG8_SCHED; PG8_LDA(At, 1, 0); PG8_STAGE(PG8_SA(0, 1), a2 + hstep, voffA);
            PG8_WAIT_V(8); PG8_WAIT_L(0); PG8_BAR; PG8_MMA(0, 0, At, B0); PG8_MMA(0, 1, At, B1); PG8_BAR; PG8_SCHED;
            PG8_LDA(At, 1, 1); PG8_STAGE(PG8_SB(1, 0), b3, voffB); PG8_STAGE(PG8_SB(1, 1), b3 + hstep, voffB); PG8_STAGE(PG8_SA(1, 0), a3, voffA);
            PG8_WAIT_V(8); PG8_WAIT_L(0); PG8_BAR; PG8_MMA(1, 0, At, B0); PG8_MMA(1, 1, At, B1); PG8_BAR; PG8_SCHED;
            } else {
            PG8_LDB(B0, 0, 0); PG8_SCHED; PG8_LDA(At, 0, 0); PG8_STAGE(PG8_SA(1, 1), a1 + hstep, voffA);
            PG8_WAIT_L(8); PG8_BAR; PG8_WAIT_L(0); PG8_MMA(0, 0, At, B0); PG8_BAR; PG8_SCHED;
            PG8_LDB(B1, 0, 1); PG8_STAGE(PG8_SB(0, 0), b2, voffB);
            PG8_BAR; PG8_WAIT_L(0); PG8_MMA(0, 1, At, B1); PG8_BAR;
            PG8_LDA(At, 0, 1); PG8_STAGE(PG8_SA(0, 0), a2, voffA);
            PG8_BAR; PG8_WAIT_L(0); PG8_MMA(1, 0, At, B0); PG8_BAR; PG8_SCHED;
            PG8_STAGE(PG8_SB(0, 1), b2 + hstep, voffB);
            PG8_WAIT_V(6); PG8_BAR; PG8_MMA(1, 1, At, B1); PG8_BAR;
            PG8_LDB(B0, 1, 0); PG8_SCHED; PG8_LDA(At, 1, 0); PG8_STAGE(PG8_SA(0, 1), a2 + hstep, voffA);
            PG8_WAIT_L(8); PG8_BAR; PG8_WAIT_L(0); PG8_MMA(0, 0, At, B0); PG8_BAR; PG8_SCHED;
            PG8_LDB(B1, 1, 1); PG8_STAGE(PG8_SB(1, 0), b3, voffB);
            PG8_BAR; PG8_WAIT_L(0); PG8_MMA(0, 1, At, B1); PG8_BAR;
            PG8_LDA(At, 1, 1); PG8_STAGE(PG8_SA(1, 0), a3, voffA);
            PG8_BAR; PG8_WAIT_L(0); PG8_MMA(1, 0, At, B0); PG8_BAR; PG8_SCHED;
            PG8_STAGE(PG8_SB(1, 1), b3 + hstep, voffB);
            PG8_WAIT_V(6); PG8_BAR; PG8_MMA(1, 1, At, B1); PG8_BAR;
            }
        }
        if constexpr (ALIGN_EPI) { if (wr == 0) PG8_BAR; }
        if constexpr (!Epi::AFTER_DRAIN) { for (int rep_ = 0; rep_ < 1 + (Epi::REP_EPI ? 1 : 0); ++rep_) E(acc, cur, wr, wc, fr, fq); S.done(cur); }
        if (!has_next) break;
#pragma unroll
        for (int a = 0; a < 2; ++a)
#pragma unroll
            for (int b = 0; b < 2; ++b)
#pragma unroll
                for (int m = 0; m < 4; ++m)
#pragma unroll
                    for (int n = 0; n < 2; ++n) acc[a][b][m][n] = (f32x4){0.f, 0.f, 0.f, 0.f};
        cur = nxt; cA = nA; cB = nB; ++ui;
        if constexpr (ALIGN_EPI) { if (wr == 1) PG8_BAR; }
    }
    PG8_WAIT_V(0);
    if constexpr (!ALIGN_EPI) { if (wr == 0) PG8_BAR; }
    PG8_BAR;
    if constexpr (Epi::AFTER_DRAIN) { E.fused(acc, cur, wr, wc, fr, fq, lds, wid, lane); S.done(cur); }
#undef PG8_SA
#undef PG8_SB
#undef PG8_STAGE
#undef PG8_LDA
#undef PG8_LDB
#undef PG8_MMA
#undef PG8_WAIT_V
#undef PG8_WAIT_L
#undef PG8_BAR
#undef PG8_SCHED
}
}

using pg8::bf16_t; using pg8::bf16x8; using pg8::f32x4; using pg8::u32x4; using pg8::Unit; using pg8::cvt_pk_bf16;
#define GAS __attribute__((address_space(1)))
#define LAS __attribute__((address_space(3)))
typedef unsigned u32x2 __attribute__((ext_vector_type(2)));
typedef short s16x4 __attribute__((ext_vector_type(4)));
typedef GAS unsigned gu32;
#define RLX_AGENT __ATOMIC_RELAXED, __HIP_MEMORY_SCOPE_AGENT

constexpr int NWAVES = 8;
constexpr int D = 1024, MP = 16384, MS = 128, SEQ = 2048, NBATCH = 8, NMEM = 256, MMEM = 2048, DEPTH = 4;
constexpr int NAB = 5120, NC = 8192;
constexpr float EPS = 1e-6f;
constexpr float QSCALE = 0.0625f * 1.4426950408889634f;

constexpr size_t O_Y = 0, O_YS = O_Y + (size_t)MP * D, O_POOLP = O_YS + (size_t)MS * D, O_POOLS = O_POOLP + 2 * 8 * 15 * 1024,
                 O_CONVP = O_POOLS + (size_t)2 * 128 * 15 * 1024, O_CONVS = O_CONVP + 2 * 8 * 2 * 2048, O_SGUV = O_CONVS + (size_t)2 * 128 * 2 * 2048,
                 O_MEMK = O_SGUV + 2 * 128 * 1024, O_MEMV = O_MEMK + (size_t)4 * MMEM * D, O_END = O_MEMV + (size_t)4 * MMEM * D;
static_assert(O_END == 39239680, "output size");

constexpr size_t MiB = 1u << 20;
constexpr size_t WS_CTL = 0, CTL_ZERO_BYTES = 1 * MiB;
constexpr size_t WS_AB1 = 2 * MiB, WS_C1 = 22 * MiB, WS_AB2 = 54 * MiB, WS_C2 = 62 * MiB, WS_WQ = 70 * MiB, WS_WKV = 78 * MiB, WS_WO = 94 * MiB, WS_PMT = 102 * MiB;
constexpr size_t WS_XB = 104 * MiB;
constexpr size_t WS_RSQ = 137 * MiB, WS_VSQ = 138 * MiB;
constexpr size_t WS_SMALL = 139 * MiB;
constexpr size_t WS_Z = 140 * MiB;
constexpr size_t WS_A2 = 268 * MiB;
constexpr size_t WS_Q = 332 * MiB, WS_O = 364 * MiB;
constexpr size_t WS_MEMB = 396 * MiB, WS_KB = 400 * MiB, WS_VB = 416 * MiB;
constexpr size_t WS_XS = 432 * MiB, WS_SZ = 433 * MiB, WS_SA2 = 437 * MiB, WS_SQ = 438 * MiB, WS_SO = 439 * MiB, WS_SIDE = 440 * MiB  , WS_END = 444 * MiB;
constexpr int CW_BAR = 4096, CW_RANK = 8192;

constexpr int RING_BYTES = 131072, LDSCTL_OFF = RING_BYTES, MISC_OFF = LDSCTL_OFF + 320, HALO_OFF = RING_BYTES + 1024  , RSTD_OFF = HALO_OFF + 8192  , CWL_OFF = RSTD_OFF + 1024  , LDS_BYTES = 155648;

#define LDS_WAIT() asm volatile("s_waitcnt lgkmcnt(0)" ::: "memory")
#define LDS_BARRIER() asm volatile("s_waitcnt lgkmcnt(0)\n\ts_barrier" ::: "memory")

#define XB_TMO      128
#define XB_XCNT(j)  (256  + 64 * (j))
#define XB_XSUB(j)  (1280 + 64 * (j))
#define XB_XGEN(j)  (2304 + 64 * (j))
#define XB_TOP      3328
#define XB_TOPGEN   3392
#define XCD_BAR_WORDS 3456
#define XB_SPIN_CAP (1u << 18)

__device__ __forceinline__ unsigned xb_ld(unsigned* p)              { return __hip_atomic_load(p, __ATOMIC_RELAXED, __HIP_MEMORY_SCOPE_AGENT); }
__device__ __forceinline__ unsigned xb_add(unsigned* p, unsigned v) { return __hip_atomic_fetch_add(p, v, __ATOMIC_RELAXED, __HIP_MEMORY_SCOPE_AGENT); }
__device__ __forceinline__ unsigned xb_xcc_id() { return (unsigned)__builtin_amdgcn_s_getreg((3 << 11) | 20) & 0xFu; }
#define XB_SPIN(cond, bar) do { unsigned _sp = 0; while (cond) { __builtin_amdgcn_s_sleep(1); \
    if ((++_sp & 255u) == 0u) { if (xb_ld(&(bar)[XB_TMO])) break; if (_sp > XB_SPIN_CAP) { atomicAdd(&(bar)[XB_TMO], 1u); break; } } } } while (0)

struct XcdBarrier {
    int wave;
    unsigned* bar; unsigned x;
    volatile LAS unsigned* st;
};

__device__ __forceinline__ XcdBarrier xcd_barrier_post(unsigned* bar, volatile LAS unsigned* st, int wave) {
    XcdBarrier b; b.wave = wave; b.bar = bar; b.x = xb_xcc_id(); b.st = st;
    if (b.wave == 0 && hw_lane() == 0) (void)xb_add(&bar[XB_XCNT(b.x)], 1u);
    return b;
}
__device__ __forceinline__ void xcd_barrier_complete(unsigned* bar, unsigned x, unsigned& nloc, unsigned& nx) {
    const unsigned G = gridDim.x * gridDim.y * gridDim.z;
    unsigned sum, cnt, mine, sp = 0u;
    for (;;) {
        sum = 0u; cnt = 0u; mine = 0u;
#pragma unroll
        for (unsigned j = 0; j < 16; ++j) { const unsigned c = xb_ld(&bar[XB_XCNT(j)]); sum += c; cnt += (c > 0u) ? 1u : 0u; mine = (j == x) ? c : mine; }
        if (sum == G) break;
        __builtin_amdgcn_s_sleep(1);
        if ((++sp & 255u) == 0u) { if (xb_ld(&bar[XB_TMO])) break; if (sp > XB_SPIN_CAP) { atomicAdd(&bar[XB_TMO], 1u); break; } }
    }
    nloc = mine > 0u ? mine : 1u; nx = cnt > 0u ? cnt : 1u;
}

__device__ __forceinline__ void xcd_barrier(const XcdBarrier& b) {
    asm volatile("s_waitcnt vmcnt(0)" ::: "memory");
    __syncthreads();
    if (b.wave == 0 && hw_lane() == 0) {
        unsigned* bar = b.bar;
        __builtin_amdgcn_s_waitcnt(0);
        unsigned nloc = b.st[0], nx = b.st[1];
        if (nloc == 0u) { xcd_barrier_complete(bar, b.x, nloc, nx); b.st[0] = nloc; b.st[1] = nx; }
        const unsigned old = xb_add(&bar[XB_XSUB(b.x)], 1u);
        const unsigned gen = old / nloc;
        if (old + 1u == (gen + 1u) * nloc) {
            __builtin_amdgcn_fence(__ATOMIC_RELEASE, "agent");
            asm volatile("s_waitcnt vmcnt(0)" ::: "memory");
            const unsigned og = xb_add(&bar[XB_TOP], 1u);
            const unsigned tg = og / nx;
            if (og + 1u == (tg + 1u) * nx) xb_add(&bar[XB_TOPGEN], 1u);
            else XB_SPIN(xb_ld(&bar[XB_TOPGEN]) == tg, bar);
            __builtin_amdgcn_fence(__ATOMIC_ACQUIRE, "agent");
            xb_add(&bar[XB_XGEN(b.x)], 1u);
            asm volatile("s_waitcnt vmcnt(0)" ::: "memory");
        } else {
            XB_SPIN(xb_ld(&bar[XB_XGEN(b.x)]) == gen, bar);
            __builtin_amdgcn_fence(__ATOMIC_ACQUIRE, "agent");
            asm volatile("s_waitcnt vmcnt(0)" ::: "memory");
        }
    }
    __syncthreads();
}

__device__ __forceinline__ void xcd_barrier_local(const XcdBarrier& b) {
    asm volatile("s_waitcnt vmcnt(0)" ::: "memory");
    __syncthreads();
    if (b.wave == 0 && hw_lane() == 0) {
        unsigned* bar = b.bar;
        __builtin_amdgcn_s_waitcnt(0);
        const unsigned nloc = b.st[0] ? b.st[0] : 1u;
        const unsigned old = xb_add(&bar[XB_XSUB(b.x)], 1u);
        const unsigned gen = old / nloc;
        if (old + 1u == (gen + 1u) * nloc) xb_add(&bar[XB_XGEN(b.x)], 1u);
        else XB_SPIN(xb_ld(&bar[XB_XGEN(b.x)]) == gen, bar);
        __builtin_amdgcn_fence(__ATOMIC_ACQUIRE, "agent");
        asm volatile("s_waitcnt vmcnt(0)" ::: "memory");
    }
    __syncthreads();
}

typedef const float* fptr_t;
typedef __attribute__((address_space(4))) const fptr_t* in_tab_t;
struct Frame {
    LAS unsigned char* lds;
    int tid, lane, wave, G, bx, vid, xq, rk, rw;
    in_tab_t in;
    float* out;
    unsigned char* ws;
};
__device__ __forceinline__ unsigned long long uni64(unsigned long long v) { const unsigned lo = __builtin_amdgcn_readfirstlane((unsigned)v), hi = __builtin_amdgcn_readfirstlane((unsigned)(v >> 32)); return ((unsigned long long)hi << 32) | lo; }
__device__ __forceinline__ Frame launder(const Frame& F0) {
    Frame F = F0;
    int wv_ = __builtin_amdgcn_readfirstlane(F0.wave);
    int ln_ = hw_lane();
    int g_ = __builtin_amdgcn_readfirstlane(F0.G), b_ = __builtin_amdgcn_readfirstlane(F0.bx), v_ = __builtin_amdgcn_readfirstlane(F0.vid);
    unsigned long long w_ = uni64((unsigned long long)F0.ws), o_ = uni64((unsigned long long)F0.out), i_ = uni64((unsigned long long)F0.in);
    asm volatile("" : "+v"(ln_), "+s"(wv_), "+s"(g_), "+s"(b_), "+s"(v_), "+s"(w_), "+s"(o_), "+s"(i_));
    F.tid = (wv_ << 6) | ln_; F.G = g_; F.bx = b_; F.vid = v_; F.xq = b_ & 7; F.rk = b_ >> 3; F.rw = (g_ - (b_ & 7) + 7) >> 3; F.ws = (unsigned char*)(GAS unsigned char*)w_; F.out = (float*)(GAS float*)o_; F.in = (in_tab_t)i_;
    F.lane = ln_; F.wave = wv_;
    return F;
}
#define FIN(k) ((const float*)(const GAS float*)(F.in[k]))


__device__ __forceinline__ float shx(float v, int mask, int lane) { return __builtin_bit_cast(float, __builtin_amdgcn_ds_bpermute((lane ^ mask) << 2, __builtin_bit_cast(int, v))); }
__device__ __forceinline__ float wave_sum(float v, int lane) {
#pragma unroll
    for (int o = 1; o < 64; o <<= 1) v += shx(v, o, lane);
    return v;
}
__device__ __forceinline__ float silu_f(float x) { return x * __builtin_amdgcn_rcpf(1.f + __builtin_amdgcn_exp2f(-1.4426950408889634f * x)); }
__device__ __forceinline__ f32x4 silu4(f32x4 v) { return (f32x4){silu_f(v[0]), silu_f(v[1]), silu_f(v[2]), silu_f(v[3])}; }
__device__ __forceinline__ float dot4(f32x4 a, f32x4 b) { return (a[0] * b[0] + a[1] * b[1]) + (a[2] * b[2] + a[3] * b[3]); }
__device__ __forceinline__ u32x4 pack8(f32x4 a, f32x4 b) { u32x4 w; w.x = cvt_pk_bf16(a[0], a[1]); w.y = cvt_pk_bf16(a[2], a[3]); w.z = cvt_pk_bf16(b[0], b[1]); w.w = cvt_pk_bf16(b[2], b[3]); return w; }
__device__ __forceinline__ u32x2 pack4(f32x4 a) { u32x2 w; w.x = cvt_pk_bf16(a[0], a[1]); w.y = cvt_pk_bf16(a[2], a[3]); return w; }
__device__ __forceinline__ float bflo(unsigned w) { return __uint_as_float(w << 16); }
__device__ __forceinline__ float bfhi(unsigned w) { return __uint_as_float(w & 0xffff0000u); }
__device__ __forceinline__ void unpack8(u32x4 w, f32x4& a, f32x4& b) { a = (f32x4){bflo(w.x), bfhi(w.x), bflo(w.y), bfhi(w.y)}; b = (f32x4){bflo(w.z), bfhi(w.z), bflo(w.w), bfhi(w.w)}; }
__device__ __forceinline__ f32x4 unpack4(u32x2 w) { return (f32x4){bflo(w.x), bfhi(w.x), bflo(w.y), bfhi(w.y)}; }
__device__ __forceinline__ float rstd16(const float* p) {
    const f32x4 a = ((const f32x4*)p)[0], b = ((const f32x4*)p)[1], c = ((const f32x4*)p)[2], d = ((const f32x4*)p)[3];
    const f32x4 s = (a + b) + (c + d);
    return rsqrtf(((s[0] + s[1]) + (s[2] + s[3])) * (1.0f / D) + EPS);
}
__device__ __forceinline__ float rstd32(const float* p) {
    f32x4 s = ((const f32x4*)p)[0];
#pragma unroll
    for (int i = 1; i < 8; ++i) s += ((const f32x4*)p)[i];
    return rsqrtf(((s[0] + s[1]) + (s[2] + s[3])) * (1.0f / D) + EPS);
}
__host__ __device__ __forceinline__ int src_even(int n) {
    const int tile = n >> 8, o = n & 255;
    if (tile < 8) return n;
    if (tile < 12) return 3072 + (n - 2048);
    const int cb = tile - 12;
    return o < 128 ? 2048 + 128 * cb + o : 4096 + 128 * cb + (o - 128);
}
__host__ __device__ __forceinline__ int src_odd(int n) {
    const int pn = n >> 8, p = n & 255, q = ((p >> 7) << 1) | ((p >> 2) & 1), ch = 64 * pn + 16 * ((p >> 5) & 3) + 4 * ((p >> 3) & 3) + (p & 3);
    const int base = q == 0 ? 2048 : (q == 1 ? 4096 : (q == 2 ? 0 : 6144));
    return base + ch;
}

__device__ __forceinline__ void rstd_table(const float* rsq, int pm, LAS float* tab, int tid) {
    if (tid < 256) tab[tid] = rstd16(rsq + ((size_t)pm * 256 + tid) * 16);
    LDS_BARRIER();
}
struct EpiG1Even {
    static constexpr bool PERM = true, AFTER_DRAIN = false, REP_EPI = (REP_MASK >> 12) & 1;
    const float* rsq; bf16_t* Z; float* vsq; float* pool_out; LAS const float* rtab; int pm0;
    __device__ __forceinline__ void operator()(const f32x4 (&acc)[2][2][4][2], const Unit& u, int wr, int wc, int fr_, int fq_) const {
        int fr = fr_, fq = fq_; asm volatile("" : "+v"(fr), "+v"(fq));
        const int tile = u.pn, cw = wc * 32 + 8 * fq;
#pragma unroll
        for (int ai = 0; ai < 2; ++ai)
#pragma unroll
            for (int m = 0; m < 4; ++m) {
                const int row = u.pm * 256 + ai * 128 + wr * 64 + m * 16 + fr;
                const float rs = u.pm == pm0 ? rtab[ai * 128 + wr * 64 + m * 16 + fr] : rstd16(rsq + (size_t)row * 16);
                if (tile < 12) {
                    const int kind = tile >> 2;
                    bf16_t* dst = Z + (size_t)kind * MP * D + (size_t)row * D + (tile & 3) * 256 + cw;
                    float ss = 0.f;
#pragma unroll
                    for (int bj = 0; bj < 2; ++bj) {
                        f32x4 v0 = acc[ai][bj][m][0] * rs, v1 = acc[ai][bj][m][1] * rs;
                        if (kind == 1) { v0 = silu4(v0); v1 = silu4(v1); }
                        if (kind == 2) ss += dot4(v0, v0) + dot4(v1, v1);
                        *(u32x4*)(dst + bj * 128) = pack8(v0, v1);
                        if (kind == 0 && (row & 2047) >= 2033) {
                            float* po = pool_out + ((size_t)(row >> 11) * 15 + ((row & 2047) - 2033)) * 1024 + (tile & 3) * 256 + bj * 128 + cw;
                            *(f32x4*)po = v0; *(f32x4*)(po + 4) = v1;
                        }
                    }
                    if (kind == 2) { ss += shx(ss, 16, 16 * fq + fr); ss += shx(ss, 32, 16 * fq + fr); if (fq == 0) vsq[(size_t)row * 16 + (tile - 8) * 4 + wc] = ss; }
                } else {
                    const int cb = tile - 12;
                    bf16_t* dst = Z + (size_t)3 * MP * D + (size_t)row * D + cb * 128 + cw;
                    const f32x4 u0 = acc[ai][0][m][0] * rs, u1 = acc[ai][0][m][1] * rs, g0 = acc[ai][1][m][0] * rs, g1 = acc[ai][1][m][1] * rs;
                    *(u32x4*)dst = pack8(u0 * silu4(g0), u1 * silu4(g1));
                }
            }
    }
};
__device__ __forceinline__ float dpp_shr1(float old, float v) { return __builtin_bit_cast(float, __builtin_amdgcn_update_dpp(__builtin_bit_cast(int, old), __builtin_bit_cast(int, v), 0x111, 0xf, 0xf, false)); }
__device__ __forceinline__ float dpp_shr2(float old, float v) { return __builtin_bit_cast(float, __builtin_amdgcn_update_dpp(__builtin_bit_cast(int, old), __builtin_bit_cast(int, v), 0x112, 0xf, 0xf, false)); }
struct EpiG1Odd {
    static constexpr bool PERM = true, AFTER_DRAIN = false, REP_EPI = false;
    const float* rsq; bf16_t* A2; const float* cw; float* conv_out; float* side; LAS float* halo; LAS const float* rtab; int pm0; LAS const float* cwl; int pn0;
    __device__ __forceinline__ void operator()(const f32x4 (&acc)[2][2][4][2], const Unit& u, int wr, int wc, int fr_, int fq_) const {
        int fr = fr_, fq = fq_; asm volatile("" : "+v"(fr), "+v"(fq));
        const int chl = wc * 16 + 4 * fq, ch = u.pn * 64 + chl;
        f32x4 w0, w1, w2;
        { const int ui = (u.pn - pn0) >> 2;
          if (u.pm == pm0 && ui >= 0 && ui < 8 && ((u.pn - pn0) & 3) == 0) { w0 = *(const LAS f32x4*)(cwl + (ui * 3 + 0) * 64 + chl); w1 = *(const LAS f32x4*)(cwl + (ui * 3 + 1) * 64 + chl); w2 = *(const LAS f32x4*)(cwl + (ui * 3 + 2) * 64 + chl); }
          else { w0 = *(const f32x4*)(cw + ch); w1 = *(const f32x4*)(cw + 2048 + ch); w2 = *(const f32x4*)(cw + 4096 + ch); } }
        f32x4 e[2][4]; float rsv[2][4];
#pragma unroll
        for (int ai = 0; ai < 2; ++ai)
#pragma unroll
            for (int m = 0; m < 4; ++m) {
                const int rb = 8 * ai + 4 * wr + m, row = u.pm * 256 + 16 * rb + fr;
                const float rs = u.pm == pm0 ? rtab[16 * rb + fr] : rstd16(rsq + (size_t)row * 16); rsv[ai][m] = rs;
                e[ai][m] = (acc[ai][0][m][0] * rs) * (acc[ai][0][m][1] * rs);
                if (fr >= 14) *(LAS f32x4*)(halo + (rb * 2 + (fr - 14)) * 64 + chl) = e[ai][m];
                if (m & 1) asm volatile("" ::: "memory");
            }
        asm volatile("s_waitcnt lgkmcnt(0)" ::: "memory"); __builtin_amdgcn_s_barrier(); asm volatile("" ::: "memory");
        float* sd = side + (size_t)u.pm * 6 * 2048 + ch;
#pragma unroll
        for (int ai = 0; ai < 2; ++ai)
#pragma unroll
            for (int m = 0; m < 4; ++m) {
                const int rb = 8 * ai + 4 * wr + m, row = u.pm * 256 + 16 * rb + fr;
                const float rs = rsv[ai][m];
                const f32x4 sg = (acc[ai][1][m][0] * rs) * silu4(acc[ai][1][m][1] * rs);
                f32x4 h0 = (f32x4){0.f, 0.f, 0.f, 0.f}, h1 = h0;
                if (rb > 0) { h0 = *(const LAS f32x4*)(halo + ((rb - 1) * 2 + 0) * 64 + chl); h1 = *(const LAS f32x4*)(halo + ((rb - 1) * 2 + 1) * 64 + chl); }
                const f32x4 hx = fr == 0 ? h0 : h1, ev = e[ai][m];
                f32x4 e1, e2;
#pragma unroll
                for (int k = 0; k < 4; ++k) { e1[k] = dpp_shr1(h1[k], ev[k]); e2[k] = dpp_shr2(hx[k], ev[k]); }
                const f32x4 a = sg * (w0 * e2 + w1 * e1 + w2 * ev);
                const bool top = (rb == 0 && fr < 2);
                if (!(top && (u.pm & 7) != 0)) *(u32x2*)(A2 + (size_t)row * 2048 + ch) = pack4(a);
                if (top) { *(f32x4*)(sd + fr * 2048) = ev; *(f32x4*)(sd + (4 + fr) * 2048) = sg; }
                if (rb == 15 && fr >= 14) {
                    *(f32x4*)(sd + (2 + fr - 14) * 2048) = ev;
                    if ((u.pm & 7) == 7) *(f32x4*)(conv_out + ((size_t)(u.pm >> 3) * 2 + (fr - 14)) * 2048 + ch) = ev;
                }
            }
    }
};
__device__ __forceinline__ void conv_fixup(const float* side, const float* cw, bf16_t* A2, int pm, int tid) {
    if ((pm & 7) == 0) return;
    const int ch = 4 * tid;
    const float* sp = side + (size_t)(pm - 1) * 6 * 2048 + ch; const float* sc = side + (size_t)pm * 6 * 2048 + ch;
    const f32x4 em2 = *(const f32x4*)(sp + 2 * 2048), em1 = *(const f32x4*)(sp + 3 * 2048), e0 = *(const f32x4*)sc, e1 = *(const f32x4*)(sc + 2048), s0 = *(const f32x4*)(sc + 4 * 2048), s1 = *(const f32x4*)(sc + 5 * 2048);
    const f32x4 w0 = *(const f32x4*)(cw + ch), w1 = *(const f32x4*)(cw + 2048 + ch), w2 = *(const f32x4*)(cw + 4096 + ch);
    *(u32x2*)(A2 + (size_t)(pm * 256) * 2048 + ch) = pack4(s0 * (w0 * em2 + w1 * em1 + w2 * e0));
    *(u32x2*)(A2 + (size_t)(pm * 256 + 1) * 2048 + ch) = pack4(s1 * (w0 * em1 + w1 * e0 + w2 * e1));
}
struct EpiRes {
    static constexpr bool PERM = true, AFTER_DRAIN = false, REP_EPI = false;
    bf16_t* xb; float* rsq;
    __device__ __forceinline__ void operator()(const f32x4 (&acc)[2][2][4][2], const Unit& u, int wr, int wc, int fr_, int fq_) const {
        int fr = fr_, fq = fq_; asm volatile("" : "+v"(fr), "+v"(fq));
        const int cw = wc * 32 + 8 * fq;
#pragma unroll
        for (int ai = 0; ai < 2; ++ai) {
            u32x4 old[4][2];
#pragma unroll
            for (int m = 0; m < 4; ++m)
#pragma unroll
                for (int bj = 0; bj < 2; ++bj) old[m][bj] = *(const u32x4*)(xb + (size_t)(u.pm * 256 + ai * 128 + wr * 64 + m * 16 + fr) * D + u.pn * 256 + bj * 128 + cw);
#pragma unroll
            for (int m = 0; m < 4; ++m) {
                const int row = u.pm * 256 + ai * 128 + wr * 64 + m * 16 + fr;
                float ss = 0.f;
#pragma unroll
                for (int bj = 0; bj < 2; ++bj) {
                    f32x4 b0, b1; unpack8(old[m][bj], b0, b1);
                    const u32x4 wv = pack8(b0 + acc[ai][bj][m][0], b1 + acc[ai][bj][m][1]);
                    *(u32x4*)(xb + (size_t)row * D + u.pn * 256 + bj * 128 + cw) = wv;
                    f32x4 r0, r1; unpack8(wv, r0, r1);
                    ss += dot4(r0, r0) + dot4(r1, r1);
                }
                ss += shx(ss, 16, 16 * fq + fr); ss += shx(ss, 32, 16 * fq + fr);
                if (fq == 0) rsq[(size_t)row * 16 + u.pn * 4 + wc] = ss;
            }
        }
    }
};
struct EpiProbe {
    static constexpr bool PERM = true, AFTER_DRAIN = false, REP_EPI = false;
    bf16_t* O; int ldc;
    __device__ __forceinline__ void operator()(const f32x4 (&acc)[2][2][4][2], const Unit& u, int wr, int wc, int fr_, int fq_) const {
        int fr = fr_, fq = fq_; asm volatile("" : "+v"(fr), "+v"(fq));
        const int cw = wc * 32 + 8 * fq;
#pragma unroll
        for (int ai = 0; ai < 2; ++ai)
#pragma unroll
            for (int m = 0; m < 4; ++m) {
                const int row = u.pm * 256 + ai * 128 + wr * 64 + m * 16 + fr;
#pragma unroll
                for (int bj = 0; bj < 2; ++bj) *(u32x4*)(O + (size_t)row * ldc + u.pn * 256 + bj * 128 + cw) = pack8(acc[ai][bj][m][0], acc[ai][bj][m][1]);
            }
    }
};
struct EpiQ {
    static constexpr bool PERM = true, AFTER_DRAIN = false, REP_EPI = false;
    const float* rsq; bf16_t* Q; LAS const float* rtab; int pm0;
    __device__ __forceinline__ void operator()(const f32x4 (&acc)[2][2][4][2], const Unit& u, int wr, int wc, int fr_, int fq_) const {
        int fr = fr_, fq = fq_; asm volatile("" : "+v"(fr), "+v"(fq));
        const int cw = wc * 32 + 8 * fq;
#pragma unroll
        for (int ai = 0; ai < 2; ++ai)
#pragma unroll
            for (int m = 0; m < 4; ++m) {
                const int row = u.pm * 256 + ai * 128 + wr * 64 + m * 16 + fr;
                const float rs = u.pm == pm0 ? rtab[ai * 128 + wr * 64 + m * 16 + fr] : rstd16(rsq + (size_t)row * 16);
#pragma unroll
                for (int bj = 0; bj < 2; ++bj) *(u32x4*)(Q + (size_t)row * D + u.pn * 256 + bj * 128 + cw) = pack8(acc[ai][bj][m][0] * rs, acc[ai][bj][m][1] * rs);
            }
    }
};
struct EpiMemKV {
    static constexpr bool PERM = true, AFTER_DRAIN = false, REP_EPI = false;
    const float* rstdm; float* outk; float* outv; bf16_t* kb; bf16_t* vb;
    __device__ __forceinline__ void operator()(const f32x4 (&acc)[2][2][4][2], const Unit& u, int wr, int wc, int fr_, int fq_) const {
        int fr = fr_, fq = fq_; asm volatile("" : "+v"(fr), "+v"(fq));
        const int layer = u.pn >> 3, isv = (u.pn >> 2) & 1, cw = (u.pn & 3) * 256 + wc * 32 + 8 * fq;
        float* of = (isv ? outv : outk) + (size_t)layer * MMEM * D; bf16_t* ob = (isv ? vb : kb) + (size_t)layer * MMEM * D;
#pragma unroll
        for (int ai = 0; ai < 2; ++ai)
#pragma unroll
            for (int m = 0; m < 4; ++m) {
                const int row = u.pm * 256 + ai * 128 + wr * 64 + m * 16 + fr;
                const float rs = rstdm[row];
#pragma unroll
                for (int bj = 0; bj < 2; ++bj) {
                    const size_t off = (size_t)row * D + bj * 128 + cw;
                    const f32x4 v0 = acc[ai][bj][m][0] * rs, v1 = acc[ai][bj][m][1] * rs;
                    *(f32x4*)(of + off) = v0; *(f32x4*)(of + off + 4) = v1;
                    *(u32x4*)(ob + off) = pack8(v0, v1);
                }
            }
    }
};

struct TrItem { const float* wp; int ldw; const float* gk; float sc; bf16_t* wt; int K; };
__device__ __forceinline__ void p0_tr_desc(const float* W, int ldw, int K, int Nd, const float* gk, float sc, bf16_t* WT, int perm, int r, int lane, TrItem& t) {
    const int nblk = Nd / 32, kb = r / nblk, nb = r % nblk, dstn0 = 32 * nb, dn = dstn0 + (lane & 31);
    const int srccol = perm == 0 ? dn : (perm == 1 ? src_even(dn) : src_odd(dn));
    t.wp = W + (size_t)(64 * kb + (lane >> 5)) * ldw + srccol; t.ldw = ldw; t.gk = gk ? gk + 64 * kb : nullptr; t.sc = sc; t.wt = WT + (size_t)dstn0 * K + 64 * kb; t.K = K;
}
__device__ __forceinline__ void p0_resolve(Frame& F, int it, int lane, TrItem& t) {
    constexpr int I_AB1 = 16 * (NAB / 32), I_C1 = 16 * (NC / 32), I_2 = 32 * 32, I_SQ = 16 * 32, I_PM = 4 * 8;
    int r = it;
    if (r < 2 * I_AB1) { const int jj = r / I_AB1; p0_tr_desc(FIN(10) + (size_t)jj * D * NAB, NAB, D, NAB, FIN(7) + 2 * jj * D, 1.f, ((bf16_t*)(F.ws + WS_AB1)) + (size_t)jj * NAB * D, 1, r % I_AB1, lane, t); return; } r -= 2 * I_AB1;
    if (r < 2 * I_C1) { const int jj = r / I_C1; p0_tr_desc(FIN(17) + (size_t)jj * D * NC, NC, D, NC, FIN(7) + (2 * jj + 1) * D, 1.f, ((bf16_t*)(F.ws + WS_C1)) + (size_t)jj * NC * D, 2, r % I_C1, lane, t); return; } r -= 2 * I_C1;
    if (r < 2 * I_2) { const int jj = r / I_2; p0_tr_desc(FIN(16) + (size_t)jj * 2048 * D, D, 2048, D, nullptr, 1.f, ((bf16_t*)(F.ws + WS_AB2)) + (size_t)jj * D * 2048, 0, r % I_2, lane, t); return; } r -= 2 * I_2;
    if (r < 2 * I_2) { const int jj = r / I_2; p0_tr_desc(FIN(19) + (size_t)jj * 2048 * D, D, 2048, D, nullptr, 1.f, ((bf16_t*)(F.ws + WS_C2)) + (size_t)jj * D * 2048, 0, r % I_2, lane, t); return; } r -= 2 * I_2;
    if (r < 4 * I_SQ) { const int l = r / I_SQ; p0_tr_desc(FIN(20) + (size_t)l * D * D, D, D, D, FIN(8) + l * D, QSCALE, ((bf16_t*)(F.ws + WS_WQ)) + (size_t)l * D * D, 0, r % I_SQ, lane, t); return; } r -= 4 * I_SQ;
    if (r < 4 * I_SQ) { const int l = r / I_SQ; p0_tr_desc(FIN(21) + (size_t)l * D * D, D, D, D, FIN(9) + l * D, 1.f, ((bf16_t*)(F.ws + WS_WKV)) + (size_t)(2 * l) * D * D, 0, r % I_SQ, lane, t); return; } r -= 4 * I_SQ;
    if (r < 4 * I_SQ) { const int l = r / I_SQ; p0_tr_desc(FIN(22) + (size_t)l * D * D, D, D, D, FIN(9) + l * D, 1.f, ((bf16_t*)(F.ws + WS_WKV)) + (size_t)(2 * l + 1) * D * D, 0, r % I_SQ, lane, t); return; } r -= 4 * I_SQ;
    if (r < 4 * I_SQ) { const int l = r / I_SQ; p0_tr_desc(FIN(23) + (size_t)l * D * D, D, D, D, nullptr, 1.f, ((bf16_t*)(F.ws + WS_WO)) + (size_t)l * D * D, 0, r % I_SQ, lane, t); return; } r -= 4 * I_SQ;
    { const int jg = r / I_PM; p0_tr_desc(FIN(11) + (size_t)jg * 65536, 256, 256, 256, nullptr, 1.f, ((bf16_t*)(F.ws + WS_PMT)) + (size_t)jg * 65536, 0, r % I_PM, lane, t); }
}
__device__ __forceinline__ void p0_tr_load(const TrItem& t, int lane, float (&v)[32], f32x4& g0, f32x4& g1) {
    const int c = lane & 7;
    g0 = (f32x4){t.sc, t.sc, t.sc, t.sc}; g1 = g0;
    if (t.gk) { g0 = *(const f32x4*)(t.gk + 8 * c) * t.sc; g1 = *(const f32x4*)(t.gk + 8 * c + 4) * t.sc; }
#pragma unroll
    for (int i = 0; i < 32; ++i) v[i] = t.wp[(size_t)(2 * i) * t.ldw];
}
__device__ __forceinline__ void p0_tr_finish(const TrItem& t, int lane, const float (&v)[32], f32x4 g0, f32x4 g1, LAS float* scr) {
#pragma unroll
    for (int i = 0; i < 32; ++i) scr[(2 * i + (lane >> 5)) * 33 + (lane & 31)] = v[i];
    LDS_WAIT(); asm volatile("" ::: "memory");
    const int c = lane & 7;
#pragma unroll
    for (int jj = 0; jj < 4; ++jj) {
        const int n = (lane >> 3) + 8 * jj; const LAS float* s = scr + (8 * c) * 33 + n;
        u32x4 o; o.x = cvt_pk_bf16(s[0 * 33] * g0[0], s[1 * 33] * g0[1]); o.y = cvt_pk_bf16(s[2 * 33] * g0[2], s[3 * 33] * g0[3]); o.z = cvt_pk_bf16(s[4 * 33] * g1[0], s[5 * 33] * g1[1]); o.w = cvt_pk_bf16(s[6 * 33] * g1[2], s[7 * 33] * g1[3]);
        *(u32x4*)(t.wt + (size_t)n * t.K + 8 * c) = o;
    }
    LDS_WAIT(); asm volatile("" ::: "memory");
}
__device__ __forceinline__ float p0_row_finish(const f32x4 (&v)[4], bf16_t* dst, float* copy, int lane) {
    float s = 0.f;
#pragma unroll
    for (int jj = 0; jj < 4; ++jj) s += dot4(v[jj], v[jj]);
    s = wave_sum(s, lane);
    u32x2* o8 = (u32x2*)dst + lane;
#pragma unroll
    for (int jj = 0; jj < 4; ++jj) o8[64 * jj] = pack4(v[jj]);
    if (copy) {
#pragma unroll
        for (int jj = 0; jj < 4; ++jj) ((f32x4*)copy + lane)[64 * jj] = v[jj];
    }
    return s;
}
namespace p0seg {
constexpr int I_AB1 = 16 * (NAB / 32), I_C1 = 16 * (NC / 32), I_2 = 32 * 32, I_SQ = 16 * 32, I_PM = 4 * 8;
constexpr int O_AB1 = 0, O_C1 = 2 * I_AB1, O_AB2 = O_C1 + 2 * I_C1, O_C2 = O_AB2 + 2 * I_2, O_Q = O_C2 + 2 * I_2, O_K = O_Q + 4 * I_SQ, O_V = O_K + 4 * I_SQ, O_O = O_V + 4 * I_SQ, O_P = O_O + 4 * I_SQ, NITEMS = O_P + 8 * I_PM;
constexpr int NA = I_AB1 + I_2 + I_SQ + 8 * I_SQ + I_SQ + 4 * I_PM, NB = NITEMS - NA;
__device__ __forceinline__ int item_a(int i) {
    if (i < I_AB1) return O_AB1 + i; i -= I_AB1;
    if (i < I_2) return O_AB2 + i; i -= I_2;
    if (i < I_SQ) return O_Q + i; i -= I_SQ;
    if (i < 8 * I_SQ) return O_K + i; i -= 8 * I_SQ;
    if (i < I_SQ) return O_O + i; i -= I_SQ;
    return O_P + i;
}
__device__ __forceinline__ int item_b(int i) {
    if (i < I_AB1) return O_AB1 + I_AB1 + i; i -= I_AB1;
    if (i < 2 * I_C1) return O_C1 + i; i -= 2 * I_C1;
    if (i < I_2) return O_AB2 + I_2 + i; i -= I_2;
    if (i < 2 * I_2) return O_C2 + i; i -= 2 * I_2;
    if (i < 3 * I_SQ) return O_Q + I_SQ + i; i -= 3 * I_SQ;
    if (i < 3 * I_SQ) return O_O + I_SQ + i; i -= 3 * I_SQ;
    return O_P + 4 * I_PM + i;
}
}
__device__ __forceinline__ void p0_weights(Frame& F0, int part, int gw, int NGW, int half = -1) {
    Frame F = launder(F0);
    LAS float* scr = (LAS float*)(F.lds + F.wave * 16384);
    const int lane = F.lane;
    constexpr int NB_ODD = (int)((long)p0seg::NB * PB_ODD_PCT / 100);
    const int base = (part == 1 && half == 0) ? NB_ODD : 0;
    const int n = part == 0 ? p0seg::NA : (part == 1 ? (half == 1 ? NB_ODD : (half == 0 ? p0seg::NB - NB_ODD : p0seg::NB)) : p0seg::NITEMS);
#define P0_ITEM(i_) (part == 0 ? p0seg::item_a(i_) : (part == 1 ? p0seg::item_b(base + (i_)) : (i_)))
    if (gw < n) {
        TrItem cur, nxt; float va[32], vb[32]; f32x4 ga0, ga1, gb0, gb1;
        p0_resolve(F, P0_ITEM(gw), lane, cur); p0_tr_load(cur, lane, va, ga0, ga1);
        for (int it = gw; it < n; it += 2 * NGW) {
            const bool h1 = it + NGW < n, h2 = it + 2 * NGW < n;
            if (h1) { p0_resolve(F, P0_ITEM(it + NGW), lane, nxt); p0_tr_load(nxt, lane, vb, gb0, gb1); }
            p0_tr_finish(cur, lane, va, ga0, ga1, scr);
            if (h2) { p0_resolve(F, P0_ITEM(it + 2 * NGW), lane, cur); p0_tr_load(cur, lane, va, ga0, ga1); }
            if (h1) p0_tr_finish(nxt, lane, vb, gb0, gb1, scr);
        }
    }
#undef P0_ITEM
}
__device__ __forceinline__ void p0_prologue(Frame& F0) {
    Frame F = launder(F0);
    const int gw = F.bx * NWAVES + F.wave, NGW = F.G * NWAVES, lane = F.lane;
    p0_weights(F0, (!MK_SPLIT && SPLIT_PROLOGUE) ? 0 : 2, gw, NGW);
    for (int m0 = 2 * gw; m0 < MP + MS + MMEM; m0 += 2 * NGW) {
        f32x4 v[2][4];
#pragma unroll
        for (int r = 0; r < 2; ++r) {
            const int m = m0 + r;
            const float* src = m < MP ? FIN(0) + (size_t)m * D : (m < MP + MS ? FIN(1) + (size_t)(m - MP) * D : FIN(2) + (size_t)(m - MP - MS) * D);
#pragma unroll
            for (int jj = 0; jj < 4; ++jj) v[r][jj] = ((const f32x4*)src + lane)[64 * jj];
        }
#pragma unroll
        for (int r = 0; r < 2; ++r) {
            const int m = m0 + r;
            if (m < MP) {
                const float s = p0_row_finish(v[r], ((bf16_t*)(F.ws + WS_XB)) + (size_t)m * D, nullptr, lane);
                if (lane < 16) ((float*)(F.ws + WS_RSQ))[(size_t)m * 16 + lane] = lane == 0 ? s : 0.f;
            } else if (m < MP + MS) {
                const int b = m - MP;
                const float s = p0_row_finish(v[r], ((bf16_t*)(F.ws + WS_XB)) + (size_t)m * D, ((float*)(F.ws + WS_XS)) + (size_t)b * D, lane);
                if (lane < 32) ((float*)(F.ws + WS_SMALL))[b * 32 + lane] = lane == 0 ? s : 0.f;
            } else {
                const int t = m - MP - MS;
                const float s = p0_row_finish(v[r], ((bf16_t*)(F.ws + WS_MEMB)) + (size_t)t * D, nullptr, lane);
                if (lane == 0) ((float*)(F.ws + WS_SMALL + 65536))[t] = rsqrtf(s * (1.0f / D) + EPS);
            }
        }
    }
}

__device__ __forceinline__ bf16x8 tr_frag(LAS unsigned char* p0, LAS unsigned char* p1) {
    const s16x4 lo = __builtin_amdgcn_ds_read_tr16_b64_v4i16((LAS s16x4*)p0);
    const s16x4 hi = __builtin_amdgcn_ds_read_tr16_b64_v4i16((LAS s16x4*)p1);
    return (bf16x8){lo[0], lo[1], lo[2], lo[3], hi[0], hi[1], hi[2], hi[3]};
}
#define MFMA16(a, b, c) __builtin_amdgcn_mfma_f32_16x16x32_bf16((a), (b), (c), 0, 0, 0)

constexpr int SGU_AS = 0, SGU_VS = 34816, SGU_RV = 34816 + 67584;
__device__ __forceinline__ void sgu_chunk(Frame& F0, int j, int n) {
    Frame F = launder(F0);
    LAS unsigned char* lds = F.lds;
    const int tid = F.tid, lane = F.lane, w = F.wave, fr = lane & 15, fq = lane >> 4, row0 = n * 128;
    LAS float* rvs = (LAS float*)(lds + SGU_RV);
    if (tid < 128) rvs[tid] = rstd16(((float*)(F.ws + WS_VSQ)) + (size_t)(row0 + tid) * 16);
    const bf16_t* ZV = ((bf16_t*)(F.ws + WS_Z)) + (size_t)2 * MP * D + (size_t)row0 * D;
    const bf16_t* ZUG = ((bf16_t*)(F.ws + WS_Z)) + (size_t)3 * MP * D + (size_t)row0 * D;
    bf16_t* A2 = ((bf16_t*)(F.ws + WS_A2)) + (size_t)row0 * 2048 + 1024;
    const unsigned voff = (unsigned)(tid >> 5) * (D * 2) + (unsigned)(tid & 31) * 16u;
    const unsigned woff = (unsigned)(tid >> 4) * 512u + (unsigned)(tid & 15) * 32u;
    const int wt_t = tid >> 4, wt_s0 = (tid & 15) * 8;
    const unsigned aoff = (unsigned)(tid >> 5) * 4096u + (unsigned)(tid & 31) * 16u;
    u32x4 vt[8]; f32x4 wt[8];
#define SGU_LOAD(g_) do { const char* vb_ = (const char*)(ZV + (g_) * 256); const char* wb_ = (const char*)(FIN(13) + (size_t)(j * 4 + (g_)) * 16384); \
        _Pragma("unroll") for (int i_ = 0; i_ < 8; ++i_) vt[i_] = *(const u32x4*)(vb_ + (size_t)(16 * i_) * D * 2 + voff); \
        _Pragma("unroll") for (int i_ = 0; i_ < 4; ++i_) { wt[2 * i_] = *(const f32x4*)(wb_ + (size_t)(32 * i_) * 512 + woff); wt[2 * i_ + 1] = *(const f32x4*)(wb_ + (size_t)(32 * i_) * 512 + woff + 16); } } while (0)
    SGU_LOAD(0);
    LDS_BARRIER();
#pragma unroll 1
    for (int g = 0; g < 4; ++g) {
#pragma unroll
        for (int i = 0; i < 8; ++i) *(LAS u32x4*)(lds + SGU_VS + ((tid >> 5) + 16 * i) * 528 + (tid & 31) * 16) = vt[i];
#pragma unroll
        for (int i = 0; i < 4; ++i) {
            const int t = wt_t + 32 * i; float v[8];
#pragma unroll
            for (int e = 0; e < 4; ++e) { v[e] = (wt_s0 + e <= t) ? wt[2 * i][e] * rvs[wt_s0 + e] : 0.f; v[4 + e] = (wt_s0 + 4 + e <= t) ? wt[2 * i + 1][e] * rvs[wt_s0 + 4 + e] : 0.f; }
            u32x4 o; o.x = cvt_pk_bf16(v[0], v[1]); o.y = cvt_pk_bf16(v[2], v[3]); o.z = cvt_pk_bf16(v[4], v[5]); o.w = cvt_pk_bf16(v[6], v[7]);
            *(LAS u32x4*)(lds + SGU_AS + t * 272 + wt_s0 * 2) = o;
        }
        LDS_BARRIER();
        if (g < 3) SGU_LOAD(g + 1);
        const int cg = g * 256 + 32 * w + 4 * fq;
        const unsigned lo_in = (unsigned)fr * (D * 2) + (unsigned)(32 * w + 4 * fq) * 2u, lo_out = (unsigned)fr * 4096u + (unsigned)(32 * w + 4 * fq) * 2u;
        u32x2 ugr[2][8];
#pragma unroll
        for (int nt = 0; nt < 2; ++nt)
#pragma unroll
            for (int mt = 0; mt < 8; ++mt) ugr[nt][mt] = *(const u32x2*)((const char*)(ZUG + (size_t)(16 * mt) * D + g * 256 + 16 * nt) + lo_in);
        f32x4 ggv[2]; float bbv[8];
#pragma unroll
        for (int nt = 0; nt < 2; ++nt) ggv[nt] = *(const f32x4*)(FIN(15) + j * 1024 + cg + 16 * nt);
#pragma unroll
        for (int mt = 0; mt < 8; ++mt) bbv[mt] = FIN(14)[(j * 4 + g) * 128 + 16 * mt + fr];
        f32x4 acc[8][2];
#pragma unroll
        for (int mt = 0; mt < 8; ++mt) { acc[mt][0] = (f32x4){0.f, 0.f, 0.f, 0.f}; acc[mt][1] = (f32x4){0.f, 0.f, 0.f, 0.f}; }
#pragma unroll
        for (int ks = 0; ks < 4; ++ks) {
            bf16x8 Bf[2];
#pragma unroll
            for (int nt = 0; nt < 2; ++nt) {
                LAS unsigned char* p = lds + SGU_VS + (32 * ks + 8 * fq + (fr >> 2)) * 528 + (32 * w + 16 * nt + 4 * (fr & 3)) * 2;
                Bf[nt] = tr_frag(p, p + 4 * 528);
            }
#pragma unroll
            for (int mt = 0; mt < 8; ++mt) {
                if (32 * ks <= 16 * mt + 15) {
                    const bf16x8 Af = *(LAS bf16x8*)(lds + SGU_AS + (16 * mt + fr) * 272 + (32 * ks + 8 * fq) * 2);
                    acc[mt][0] = MFMA16(Bf[0], Af, acc[mt][0]); acc[mt][1] = MFMA16(Bf[1], Af, acc[mt][1]);
                }
            }
        }
#pragma unroll
        for (int nt = 0; nt < 2; ++nt) {
            const int c = cg + 16 * nt;
            const f32x4 gg = ggv[nt];
#pragma unroll
            for (int mt = 0; mt < 8; ++mt) {
                const int t = 16 * mt + fr;
                const float bb = bbv[mt];
                *(u32x2*)((char*)(A2 + (size_t)(16 * mt) * 2048 + g * 256 + 16 * nt) + lo_out) = pack4(unpack4(ugr[nt][mt]) * (acc[mt][nt] * gg + bb));
            }
        }
        LDS_BARRIER();
    }
#undef SGU_LOAD
}
template <int WIN> __device__ __forceinline__ void pool_load(const bf16_t* xau  , unsigned lo  , int pos0, u32x4 (&xr)[WIN + 7]) {
#pragma unroll
    for (int i = 0; i < WIN + 7; ++i) { const int rr = i - (WIN - 1); xr[i] = (u32x4){0u, 0u, 0u, 0u}; if (pos0 + rr >= 0) xr[i] = *(const u32x4*)((const char*)(xau + (ptrdiff_t)rr * D) + lo); }
}
template <int WIN> __device__ __forceinline__ void pool_build(const u32x4 (&xr)[WIN + 7], int pos0, LAS unsigned char* dst  ) {
    f32x4 S0 = (f32x4){0.f, 0.f, 0.f, 0.f}, S1 = S0;
#pragma unroll
    for (int i = 0; i < WIN - 1; ++i) { f32x4 a, b; unpack8(xr[i], a, b); S0 += a; S1 += b; }
#pragma unroll
    for (int r = 0; r < 8; ++r) {
        f32x4 a, b; unpack8(xr[WIN - 1 + r], a, b); S0 += a; S1 += b;
        const int cnt = (pos0 + r + 1) < WIN ? (pos0 + r + 1) : WIN; const float ic = 1.0f / (float)cnt;
        *(LAS u32x4*)(dst + r * 528) = pack8(S0 * ic - a, S1 * ic - b);
        f32x4 c, d; unpack8(xr[r], c, d); S0 -= c; S1 -= d;
    }
}
__device__ __forceinline__ void pool_mma_epi(Frame& F, int j, int g, int row0, const bf16_t* ZSGA, bf16_t* A2, LAS unsigned char* lds, int w, int fr, int fq) {
    const int cg = g * 256 + 32 * w + 4 * fq;
    const unsigned lo_in = (unsigned)fr * (D * 2) + (unsigned)(32 * w + 4 * fq) * 2u, lo_out = (unsigned)fr * 4096u + (unsigned)(32 * w + 4 * fq) * 2u, lo_pm = (unsigned)(32 * w + fr) * 512u + (unsigned)fq * 16u;
    u32x2 sgr[2][8];
#pragma unroll
    for (int nt = 0; nt < 2; ++nt)
#pragma unroll
        for (int mt = 0; mt < 8; ++mt) sgr[nt][mt] = *(const u32x2*)((const char*)(ZSGA + (size_t)(16 * mt) * D + g * 256 + 16 * nt) + lo_in);
    f32x4 acc[8][2];
#pragma unroll
    for (int mt = 0; mt < 8; ++mt) { acc[mt][0] = (f32x4){0.f, 0.f, 0.f, 0.f}; acc[mt][1] = (f32x4){0.f, 0.f, 0.f, 0.f}; }
    const bf16_t* pm = ((bf16_t*)(F.ws + WS_PMT)) + (size_t)(j * 4 + g) * 65536;
    bf16x8 Bq[8][2]; f32x4 psv[2];
#pragma unroll
    for (int ks = 0; ks < 8; ++ks) { Bq[ks][0] = *(const bf16x8*)((const char*)(pm + 32 * ks) + lo_pm); Bq[ks][1] = *(const bf16x8*)((const char*)(pm + 16 * 256 + 32 * ks) + lo_pm); }
#pragma unroll
    for (int nt = 0; nt < 2; ++nt) psv[nt] = *(const f32x4*)(FIN(12) + j * 1024 + cg + 16 * nt);
#pragma unroll
    for (int ks = 0; ks < 8; ++ks) {
#pragma unroll
        for (int mt = 0; mt < 8; ++mt) {
            const bf16x8 Af = *(LAS bf16x8*)(lds + (16 * mt + fr) * 528 + (32 * ks + 8 * fq) * 2);
            acc[mt][0] = MFMA16(Bq[ks][0], Af, acc[mt][0]); acc[mt][1] = MFMA16(Bq[ks][1], Af, acc[mt][1]);
        }
    }
#pragma unroll
    for (int nt = 0; nt < 2; ++nt) {
        const int c = cg + 16 * nt;
        const f32x4 ps = psv[nt];
#pragma unroll
        for (int mt = 0; mt < 8; ++mt) *(u32x2*)((char*)(A2 + (size_t)(16 * mt) * 2048 + g * 256 + 16 * nt) + lo_out) = pack4(acc[mt][nt] * ps * unpack4(sgr[nt][mt]));
    }
}
__device__ __forceinline__ void pool_chunk(Frame& F0, int j, int n) {
    Frame F = launder(F0);
    LAS unsigned char* lds = F.lds;
    const int tid = F.tid, lane = F.lane, w = F.wave, fr = lane & 15, fq = lane >> 4, row0 = n * 128;
    const int cb = tid & 31, t0 = (tid >> 5) * 8, pos0 = (row0 & 2047) + t0;
    const bf16_t* xa = ((bf16_t*)(F.ws + WS_Z)) + (size_t)row0 * D; const unsigned xlo = (unsigned)(t0 * D + cb * 8) * 2u;
    const bf16_t* ZSGA = ((bf16_t*)(F.ws + WS_Z)) + (size_t)1 * MP * D + (size_t)row0 * D;
    bf16_t* A2 = ((bf16_t*)(F.ws + WS_A2)) + (size_t)row0 * 2048;
    LAS unsigned char* dst = lds + t0 * 528 + cb * 16;
    u32x4 x0[2 + 7]; pool_load<2>(xa, xlo, pos0, x0);
    pool_build<2>(x0, pos0, dst); LDS_BARRIER();
    u32x4 x1[4 + 7]; pool_load<4>(xa + 256, xlo, pos0, x1);
    pool_mma_epi(F, j, 0, row0, ZSGA, A2, lds, w, fr, fq); LDS_BARRIER();
    pool_build<4>(x1, pos0, dst); LDS_BARRIER();
    pool_mma_epi(F, j, 1, row0, ZSGA, A2, lds, w, fr, fq); LDS_BARRIER();
    u32x4 x2[8 + 7]; pool_load<8>(xa + 512, xlo, pos0, x2);
    pool_build<8>(x2, pos0, dst); LDS_BARRIER();
    pool_mma_epi(F, j, 2, row0, ZSGA, A2, lds, w, fr, fq); LDS_BARRIER();
    u32x4 x3[16 + 7]; pool_load<16>(xa + 768, xlo, pos0, x3);
    pool_build<16>(x3, pos0, dst); LDS_BARRIER();
    pool_mma_epi(F, j, 3, row0, ZSGA, A2, lds, w, fr, fq); LDS_BARRIER();
}
constexpr int ATT_SLOT = 64 * 528;
__device__ __forceinline__ void attn_prompt(Frame& F0, int layer) {
    Frame F = launder(F0);
    LAS unsigned char* lds = F.lds;
    const int tid = F.tid, lane = F.lane, w = F.wave, fr = lane & 15, fq = lane >> 4;
    const bf16_t* Kl = ((bf16_t*)(F.ws + WS_KB)) + (size_t)layer * MMEM * D; const bf16_t* Vl = ((bf16_t*)(F.ws + WS_VB)) + (size_t)layer * MMEM * D;
    for (int kk = F.rk; kk < 64; kk += F.rw) {
        const int b = F.xq, h = kk >> 4, qb = kk & 15;
        const size_t rowq = (size_t)b * SEQ + qb * 128 + 16 * w + fr;
        bf16x8 Qf[8];
#pragma unroll
        for (int ks = 0; ks < 8; ++ks) Qf[ks] = *(const bf16x8*)(((bf16_t*)(F.ws + WS_Q)) + rowq * D + h * 256 + 32 * ks + 8 * fq);
        const bf16_t* kbase = Kl + (size_t)(b * 256) * D + h * 256; const bf16_t* vbase = Vl + (size_t)(b * 256) * D + h * 256;
        u32x4 st[4];
#define ATT_GLOAD(c) do { const bf16_t* src_ = ((c) < 4 ? kbase : vbase) + (size_t)(64 * ((c) & 3)) * D; _Pragma("unroll") for (int i_ = 0; i_ < 4; ++i_) { const int idx_ = tid + 512 * i_; st[i_] = *(const u32x4*)(src_ + (size_t)(idx_ >> 5) * D + (idx_ & 31) * 8); } } while (0)
#define ATT_LSTORE(slot) do { _Pragma("unroll") for (int i_ = 0; i_ < 4; ++i_) { const int idx_ = tid + 512 * i_; *(LAS u32x4*)(lds + (slot) * ATT_SLOT + (idx_ >> 5) * 528 + (idx_ & 31) * 16) = st[i_]; } } while (0)
        f32x4 S[16], Oa[16]; bf16x8 Pf[8]; float inv = 0.f;
#pragma unroll
        for (int i = 0; i < 16; ++i) { S[i] = (f32x4){0.f, 0.f, 0.f, 0.f}; Oa[i] = (f32x4){0.f, 0.f, 0.f, 0.f}; }
        ATT_GLOAD(0); ATT_LSTORE(0); __syncthreads();
#pragma unroll
        for (int c = 0; c < 8; ++c) {
            if (c < 7) ATT_GLOAD(c + 1);
            LAS unsigned char* slot = lds + (c & 1) * ATT_SLOT;
            if (c < 4) {
#pragma unroll
                for (int ml = 0; ml < 4; ++ml)
#pragma unroll
                    for (int ks = 0; ks < 8; ++ks) {
                        const bf16x8 Kf = *(LAS bf16x8*)(slot + (16 * ml + fr) * 528 + (32 * ks + 8 * fq) * 2);
                        S[4 * c + ml] = MFMA16(Kf, Qf[ks], S[4 * c + ml]);
                    }
                if (c == 3) {
                    float mx = S[0][0];
#pragma unroll
                    for (int i = 0; i < 16; ++i) { mx = fmaxf(mx, fmaxf(fmaxf(S[i][0], S[i][1]), fmaxf(S[i][2], S[i][3]))); }
                    mx = fmaxf(mx, shx(mx, 16, lane)); mx = fmaxf(mx, shx(mx, 32, lane));
                    float sum = 0.f;
#pragma unroll
                    for (int i = 0; i < 16; ++i) {
#pragma unroll
                        for (int e = 0; e < 4; ++e) { S[i][e] = __builtin_amdgcn_exp2f(S[i][e] - mx); sum += S[i][e]; }
                    }
                    sum += shx(sum, 16, lane); sum += shx(sum, 32, lane);
                    inv = 1.0f / sum;
#pragma unroll
                    for (int a = 0; a < 8; ++a) {
                        u32x4 pw; pw.x = cvt_pk_bf16(S[2 * a][0], S[2 * a][1]); pw.y = cvt_pk_bf16(S[2 * a][2], S[2 * a][3]); pw.z = cvt_pk_bf16(S[2 * a + 1][0], S[2 * a + 1][1]); pw.w = cvt_pk_bf16(S[2 * a + 1][2], S[2 * a + 1][3]);
                        Pf[a] = __builtin_bit_cast(bf16x8, pw);
                    }
                }
            } else {
#pragma unroll
                for (int al = 0; al < 2; ++al)
#pragma unroll
                    for (int dt = 0; dt < 16; ++dt) {
                        LAS unsigned char* p = slot + (32 * al + 4 * fq + (fr >> 2)) * 528 + (16 * dt + 4 * (fr & 3)) * 2;
                        const bf16x8 Vf = tr_frag(p, p + 16 * 528);
                        Oa[dt] = MFMA16(Vf, Pf[2 * (c - 4) + al], Oa[dt]);
                    }
            }
            if (c < 7) ATT_LSTORE((c + 1) & 1);
            __syncthreads();
        }
#pragma unroll
        for (int dt = 0; dt < 16; ++dt) *(u32x2*)(((bf16_t*)(F.ws + WS_O)) + rowq * D + h * 256 + 16 * dt + 4 * fq) = pack4(Oa[dt] * inv);
#undef ATT_GLOAD
#undef ATT_LSTORE
    }
}

template <class Epi, int N>
__device__ __forceinline__ void sgemm16(Frame& F0, const bf16_t* A, const bf16_t* Bt, int K, const Epi& E) {
    Frame F = launder(F0);
    LAS unsigned char* lds = F.lds;
    constexpr int CW = N / 32, NT = CW / 16, KS = NT == 2 ? 8 : (NT == 10 ? 4 : 2), NG = 8 / KS, NTW = NT / NG;
    static_assert(NT * 16 == CW && NTW * NG == NT && 2 * CW <= NWAVES * 64, "sgemm16 geometry");
    const int tid = F.tid, lane = F.lane, w = F.wave, fr = lane & 15, fq = lane >> 4;
    const int ksi = w % KS, ng = w / KS, kslice = K / KS, nkb = kslice / 128;
    const bf16_t* A16 = A + (size_t)(16 * F.xq) * K;
    for (int slot = F.rk; slot < 32; slot += F.rw) {
        const int erow = tid / (CW / 8), ecg = tid % (CW / 8); const bool eact = tid < 2 * CW;
        typename Epi::Pre pre{};
        if (eact) pre = E.pre(16 * F.xq + erow, slot * CW + 8 * ecg);
        f32x4 acc[NTW];
#pragma unroll
        for (int jn = 0; jn < NTW; ++jn) acc[jn] = (f32x4){0.f, 0.f, 0.f, 0.f};
        const bf16_t* ap = A16 + (size_t)fr * K + ksi * kslice + 8 * fq;
        const bf16_t* bp = Bt + (size_t)(slot * CW + (ng * NTW) * 16 + fr) * K + ksi * kslice + 8 * fq;
        for (int kb = 0; kb < nkb; ++kb) {
            bf16x8 Af[4], Bf[4][NTW];
#pragma unroll
            for (int k4 = 0; k4 < 4; ++k4) {
                Af[k4] = *(const bf16x8*)(ap + 128 * kb + 32 * k4);
#pragma unroll
                for (int jn = 0; jn < NTW; ++jn) Bf[k4][jn] = *(const bf16x8*)(bp + (size_t)(16 * jn) * K + 128 * kb + 32 * k4);
            }
#pragma unroll
            for (int k4 = 0; k4 < 4; ++k4)
#pragma unroll
                for (int jn = 0; jn < NTW; ++jn) acc[jn] = MFMA16(Bf[k4][jn], Af[k4], acc[jn]);
        }
#pragma unroll
        for (int jn = 0; jn < NTW; ++jn) *(LAS f32x4*)(lds + ((size_t)((ksi * 16 + fr) * CW + (ng * NTW + jn) * 16 + 4 * fq)) * 4) = acc[jn];
        LDS_BARRIER();
        if (eact) {
            f32x4 s0 = (f32x4){0.f, 0.f, 0.f, 0.f}, s1 = s0;
#pragma unroll
            for (int kk = 0; kk < KS; ++kk) { const LAS f32x4* p = (const LAS f32x4*)(lds + ((size_t)((kk * 16 + erow) * CW + 8 * ecg)) * 4); s0 += p[0]; s1 += p[1]; }
            E(16 * F.xq + erow, slot, slot * CW + 8 * ecg, s0, s1, pre);
        }
        LDS_BARRIER();
    }
}
struct SEpiZ {
    struct Pre { float rs; };
    const float* rsqs; float* SZ; int ldz, mode;
    __device__ __forceinline__ Pre pre(int row, int col) const { return Pre{rstd32(rsqs + row * 32)}; }
    __device__ __forceinline__ void operator()(int row, int strip, int col, f32x4 s0, f32x4 s1, const Pre& p) const {
        const int oc0 = mode == 0 ? src_even(col) : src_odd(col), oc1 = mode == 0 ? src_even(col + 4) : src_odd(col + 4);
        float* q = SZ + (size_t)row * ldz; *(f32x4*)(q + oc0) = s0 * p.rs; *(f32x4*)(q + oc1) = s1 * p.rs;
    }
};
struct SEpiRes {
    struct Pre { f32x4 x0, x1; };
    float* xs; bf16_t* xb; float* rsqs;
    __device__ __forceinline__ Pre pre(int row, int col) const { const float* q = xs + (size_t)row * D + col; return Pre{*(const f32x4*)q, *(const f32x4*)(q + 4)}; }
    __device__ __forceinline__ void operator()(int row, int strip, int col, f32x4 s0, f32x4 s1, const Pre& pr) const {
        float* p = xs + (size_t)row * D + col; const f32x4 o0 = pr.x0 + s0, o1 = pr.x1 + s1;
        *(f32x4*)p = o0; *(f32x4*)(p + 4) = o1; *(u32x4*)(xb + (size_t)row * D + col) = pack8(o0, o1);
        const int ln = ((row & 15) << 2) | ((col >> 3) & 3);
        float ss = dot4(o0, o0) + dot4(o1, o1); ss += shx(ss, 1, ln); ss += shx(ss, 2, ln);
        if ((col & 31) == 0) rsqs[row * 32 + strip] = ss;
    }
};
struct SEpiQ {
    struct Pre { float rs; };
    const float* rsqs; float* SQ;
    __device__ __forceinline__ Pre pre(int row, int col) const { return Pre{rstd32(rsqs + row * 32)}; }
    __device__ __forceinline__ void operator()(int row, int strip, int col, f32x4 s0, f32x4 s1, const Pre& p) const {
        float* q = SQ + (size_t)row * D + col; *(f32x4*)q = s0 * p.rs; *(f32x4*)(q + 4) = s1 * p.rs;
    }
};
__device__ __forceinline__ void sample_mix_even(Frame& F0, int j, int b) {
    Frame F = launder(F0);
    LAS float* pl = (LAS float*)F.lds; LAS float* red = pl + 1024;
    const int tid = F.tid, lane = F.lane, w = F.wave;
    const float* z = ((float*)(F.ws + WS_SZ)) + (size_t)b * 8192;
    float vv[2], ss = 0.f;
#pragma unroll
    for (int k = 0; k < 2; ++k) { vv[k] = z[3072 + tid + 512 * k]; ss += vv[k] * vv[k]; }
    ss = wave_sum(ss, lane); if (lane == 0) red[w] = ss;
#pragma unroll
    for (int k = 0; k < 2; ++k) {
        const int c = tid + 512 * k, g = c >> 8, win = 2 << g; const float xa = z[c];
        const float* st = FIN(3) + ((size_t)(j * 128 + b) * 15) * 1024 + c;
        float s = xa; for (int r = 16 - win; r < 15; ++r) s += st[(size_t)r * 1024];
        pl[c] = s / (float)win - xa;
        float* po = F.out + O_POOLS + ((size_t)(j * 128 + b) * 15) * 1024 + c;
        for (int r = 0; r < 14; ++r) po[(size_t)r * 1024] = st[(size_t)(r + 1) * 1024];
        po[(size_t)14 * 1024] = xa;
    }
    __syncthreads();
    float tot = 0.f;
#pragma unroll
    for (int i = 0; i < 8; ++i) tot += red[i];
    const float rv = rsqrtf(tot * (1.0f / D) + EPS);
#pragma unroll
    for (int k = 0; k < 2; ++k) {
        const int d = tid + 512 * k, g = d >> 8, dd = d & 255;
        const bf16_t* pm = ((bf16_t*)(F.ws + WS_PMT)) + (size_t)(j * 4 + g) * 65536 + (size_t)dd * 256; const LAS float* pg = pl + g * 256;
        float a = 0.f;
#pragma unroll
        for (int hb = 0; hb < 2; ++hb) {
            u32x4 pr[16];
#pragma unroll
            for (int i = 0; i < 16; ++i) pr[i] = *(const u32x4*)(pm + hb * 128 + i * 8);
#pragma unroll
            for (int i = 0; i < 16; ++i) { f32x4 p0, p1; unpack8(pr[i], p0, p1); const LAS float* q = pg + hb * 128 + i * 8; a += dot4(p0, *(const LAS f32x4*)q) + dot4(p1, *(const LAS f32x4*)(q + 4)); }
        }
        const float ya = a * FIN(12)[j * 1024 + d] * silu_f(z[1024 + d]);
        const float vn = vv[k] * rv * FIN(15)[j * 1024 + d];
        F.out[O_SGUV + (size_t)(j * 128 + b) * 1024 + d] = vn;
        const float mixed = FIN(13)[(size_t)(j * 4 + g) * 16384] * vn + FIN(14)[(j * 4 + g) * 128];
        const float yb = z[2048 + d] * mixed * silu_f(z[4096 + d]);
        ((bf16_t*)(F.ws + WS_SA2))[(size_t)b * 2048 + d] = (bf16_t)(cvt_pk_bf16(ya, 0.f) & 0xffffu); ((bf16_t*)(F.ws + WS_SA2))[(size_t)b * 2048 + 1024 + d] = (bf16_t)(cvt_pk_bf16(yb, 0.f) & 0xffffu);
    }
    __syncthreads();
}
__device__ __forceinline__ void sample_conv_odd(Frame& F0, int j, int b) {
    Frame F = launder(F0);
    const int tid = F.tid;
    const float* z = ((float*)(F.ws + WS_SZ)) + (size_t)b * 8192;
    const float* cw = FIN(18) + (size_t)j * 3 * 2048;
#pragma unroll
    for (int k = 0; k < 4; ++k) {
        const int c = tid + 512 * k;
        const float e = z[2048 + c] * z[4096 + c];
        const float s0 = FIN(4)[((size_t)(j * 128 + b) * 2 + 0) * 2048 + c], s1 = FIN(4)[((size_t)(j * 128 + b) * 2 + 1) * 2048 + c];
        const float y = cw[c] * s0 + cw[2048 + c] * s1 + cw[4096 + c] * e;
        ((bf16_t*)(F.ws + WS_SA2))[(size_t)b * 2048 + c] = (bf16_t)(cvt_pk_bf16(z[c] * y * silu_f(z[6144 + c]), 0.f) & 0xffffu);
        float* po = F.out + O_CONVS + ((size_t)(j * 128 + b) * 2) * 2048 + c; po[0] = s1; po[2048] = e;
    }
}
__device__ __forceinline__ void attn_sample(Frame& F0, int layer) {
    Frame F = launder(F0);
    LAS float* sc = (LAS float*)F.lds;
    LAS float* red = sc + 512;
    const int tid = F.tid, lane = F.lane, w = F.wave;
    for (int item = F.rk; item < 32; item += F.rw) {
        const int b = 16 * F.xq + (item >> 1), hp = item & 1;
        const float* qp = ((float*)(F.ws + WS_SQ)) + (size_t)b * D + hp * 512;
        const f32x4 q0 = *(const f32x4*)(qp + 4 * lane), q1 = *(const f32x4*)(qp + 256 + 4 * lane);
        const float* kp = FIN(5) + ((size_t)(layer * 128 + b) * 256) * 1024 + hp * 512 + 4 * lane;
        const float* vp = FIN(6) + ((size_t)(layer * 128 + b) * 256) * 1024 + hp * 512 + 4 * lane;
#pragma unroll 8
        for (int mi = 0; mi < 32; ++mi) {
            const int m = 32 * w + mi;
            const f32x4 k0 = __builtin_nontemporal_load((const f32x4*)(kp + (size_t)m * 1024)), k1 = __builtin_nontemporal_load((const f32x4*)(kp + (size_t)m * 1024 + 256));
            const float d0 = wave_sum(dot4(k0, q0), lane), d1 = wave_sum(dot4(k1, q1), lane);
            if (lane == 0) { sc[m] = d0; sc[256 + m] = d1; }
        }
        __syncthreads();
        float p0[4], p1[4], mx0 = -INFINITY, mx1 = -INFINITY;
#pragma unroll
        for (int i = 0; i < 4; ++i) { p0[i] = sc[lane + 64 * i]; p1[i] = sc[256 + lane + 64 * i]; mx0 = fmaxf(mx0, p0[i]); mx1 = fmaxf(mx1, p1[i]); }
#pragma unroll
        for (int o = 1; o < 64; o <<= 1) { mx0 = fmaxf(mx0, shx(mx0, o, lane)); mx1 = fmaxf(mx1, shx(mx1, o, lane)); }
        float sm0 = 0.f, sm1 = 0.f;
#pragma unroll
        for (int i = 0; i < 4; ++i) { p0[i] = __builtin_amdgcn_exp2f(p0[i] - mx0); p1[i] = __builtin_amdgcn_exp2f(p1[i] - mx1); sm0 += p0[i]; sm1 += p1[i]; }
        sm0 = wave_sum(sm0, lane); sm1 = wave_sum(sm1, lane);
        const float i0 = 1.0f / sm0, i1 = 1.0f / sm1;
        __syncthreads();
        if (w == 0) {
#pragma unroll
            for (int i = 0; i < 4; ++i) { sc[lane + 64 * i] = p0[i] * i0; sc[256 + lane + 64 * i] = p1[i] * i1; }
        }
        __syncthreads();
        f32x4 a0 = (f32x4){0.f, 0.f, 0.f, 0.f}, a1 = a0;
#pragma unroll 8
        for (int mi = 0; mi < 32; ++mi) {
            const int m = 32 * w + mi;
            const f32x4 v0 = __builtin_nontemporal_load((const f32x4*)(vp + (size_t)m * 1024)), v1 = __builtin_nontemporal_load((const f32x4*)(vp + (size_t)m * 1024 + 256));
            a0 += v0 * sc[m]; a1 += v1 * sc[256 + m];
        }
        *(LAS f32x4*)(red + w * 512 + 4 * lane) = a0; *(LAS f32x4*)(red + w * 512 + 256 + 4 * lane) = a1;
        __syncthreads();
        {
            float o = 0.f;
#pragma unroll
            for (int ww = 0; ww < 8; ++ww) o += red[ww * 512 + tid];
            ((bf16_t*)(F.ws + WS_SO))[(size_t)b * D + hp * 512 + tid] = (bf16_t)(cvt_pk_bf16(o, 0.f) & 0xffffu);
        }
        __syncthreads();
    }
}
#define dpp_mov(v, ctrl, row_mask) __builtin_bit_cast(float, __builtin_amdgcn_update_dpp(0, __builtin_bit_cast(int, (float)(v)), (ctrl), (row_mask), 0xf, false))
__device__ __forceinline__ float wave_sum_dpp(float x) {
    x += dpp_mov(x, 0xB1, 0xf);
    x += dpp_mov(x, 0x4E, 0xf);
    x += dpp_mov(x, 0x141, 0xf);
    x += dpp_mov(x, 0x140, 0xf);
    x += dpp_mov(x, 0x142, 0xa);
    x += dpp_mov(x, 0x143, 0xc);
    return x;
}
constexpr int FA_SC = 69632, FA_RED = 71680;
__device__ __forceinline__ void attn_fused(Frame& F0, int layer) {
    Frame F = launder(F0);
    LAS unsigned char* lds = F.lds;
    const int tid = F.tid, lane = F.lane, w = F.wave, fr = lane & 15, fq = lane >> 4;
    const bf16_t* Kl = ((bf16_t*)(F.ws + WS_KB)) + (size_t)layer * MMEM * D; const bf16_t* Vl = ((bf16_t*)(F.ws + WS_VB)) + (size_t)layer * MMEM * D;
    LAS float* sc = (LAS float*)(lds + FA_SC); LAS float* red = (LAS float*)(lds + FA_RED);
    const int sb = 16 * F.xq + (F.rk >> 1), hp = F.rk & 1;
    const float* qp = ((float*)(F.ws + WS_SQ)) + (size_t)sb * D + hp * 512;
    const f32x4 q0 = *(const f32x4*)(qp + 4 * lane), q1 = *(const f32x4*)(qp + 256 + 4 * lane);
    const float* kp = FIN(5) + ((size_t)(layer * 128 + sb) * 256 + 4 * w) * 1024 + hp * 512;
    const float* vp = FIN(6) + ((size_t)(layer * 128 + sb) * 256 + 4 * w) * 1024 + hp * 512;
    const unsigned lo16 = (unsigned)lane * 16u;
    f32x4 sv[8]; f32x4 a0 = (f32x4){0.f, 0.f, 0.f, 0.f}, a1 = a0; float mx0 = 0.f, mx1 = 0.f, iv0 = 0.f, iv1 = 0.f;
#define FA_SLOAD(base, slice) do { unsigned long long pu_ = uni64((unsigned long long)((base) + (size_t)(32 * (slice)) * 1024)); asm volatile("" : "+s"(pu_)); const char* pc_ = (const char*)(const GAS char*)pu_; \
        _Pragma("unroll") for (int r_ = 0; r_ < 4; ++r_) { sv[2 * r_] = __builtin_nontemporal_load((const f32x4*)(pc_ + r_ * 4096 + lo16)); sv[2 * r_ + 1] = __builtin_nontemporal_load((const f32x4*)(pc_ + r_ * 4096 + 1024 + lo16)); } } while (0)
    FA_SLOAD(kp, 0);
#pragma unroll 1
    for (int ui = 0; ui < 2; ++ui) {
        const int kk = 2 * F.rk + ui;
        const int b = F.xq, h = kk >> 4, qb = kk & 15;
        const size_t rowq = (size_t)b * SEQ + qb * 128 + 16 * w + fr;
        bf16x8 Qf[8];
#pragma unroll
        for (int ks = 0; ks < 8; ++ks) Qf[ks] = *(const bf16x8*)(((bf16_t*)(F.ws + WS_Q)) + rowq * D + h * 256 + 32 * ks + 8 * fq);
        const bf16_t* kbase = Kl + (size_t)(b * 256) * D + h * 256; const bf16_t* vbase = Vl + (size_t)(b * 256) * D + h * 256;
        u32x4 st[4];
        const unsigned goff = (unsigned)(tid >> 5) * (D * 2) + (unsigned)(tid & 31) * 16u, loff = (unsigned)(tid >> 5) * 528u + (unsigned)(tid & 31) * 16u;
#define ATT_GLOAD(c) do { unsigned long long pu_ = uni64((unsigned long long)(((c) < 4 ? kbase : vbase) + (size_t)(64 * ((c) & 3)) * D)); asm volatile("" : "+s"(pu_)); const char* pc_ = (const char*)(const GAS char*)pu_; \
        _Pragma("unroll") for (int i_ = 0; i_ < 4; ++i_) st[i_] = *(const u32x4*)(pc_ + (size_t)(16 * i_) * D * 2 + goff); } while (0)
#define ATT_LSTORE(slot) do { _Pragma("unroll") for (int i_ = 0; i_ < 4; ++i_) *(LAS u32x4*)(lds + (slot) * ATT_SLOT + 16 * i_ * 528 + loff) = st[i_]; } while (0)
        f32x4 S[16], Oa[16]; bf16x8 Pf[8]; float inv = 0.f;
        const f32x4 zero4 = (f32x4){0.f, 0.f, 0.f, 0.f};
        if (ui == 1) {
            float p0[4], p1[4]; mx0 = -INFINITY; mx1 = -INFINITY;
#pragma unroll
            for (int i = 0; i < 4; ++i) { p0[i] = sc[lane + 64 * i]; p1[i] = sc[256 + lane + 64 * i]; mx0 = fmaxf(mx0, p0[i]); mx1 = fmaxf(mx1, p1[i]); }
#pragma unroll
            for (int o = 1; o < 64; o <<= 1) { mx0 = fmaxf(mx0, shx(mx0, o, lane)); mx1 = fmaxf(mx1, shx(mx1, o, lane)); }
            float sm0 = 0.f, sm1 = 0.f;
#pragma unroll
            for (int i = 0; i < 4; ++i) { sm0 += __builtin_amdgcn_exp2f(p0[i] - mx0); sm1 += __builtin_amdgcn_exp2f(p1[i] - mx1); }
            sm0 = wave_sum(sm0, lane); sm1 = wave_sum(sm1, lane);
            iv0 = 1.0f / sm0; iv1 = 1.0f / sm1;
        }
        ATT_GLOAD(0); ATT_LSTORE(0); __syncthreads();
#pragma unroll
        for (int c = 0; c < 8; ++c) {
            if (c < 7) ATT_GLOAD(c + 1);
            if (ui == 0) {
#pragma unroll
                for (int r = 0; r < 4; ++r) {
                    const int m = 32 * c + 4 * w + r;
                    const float d0 = wave_sum_dpp(dot4(sv[2 * r], q0)), d1 = wave_sum_dpp(dot4(sv[2 * r + 1], q1));
                    if (lane == 63) { sc[m] = d0; sc[256 + m] = d1; }
                }
                if (c < 7) FA_SLOAD(kp, c + 1); else FA_SLOAD(vp, 0);
            } else {
#pragma unroll
                for (int r = 0; r < 4; ++r) {
                    const int m = 32 * c + 4 * w + r;
                    const float p0 = __builtin_amdgcn_exp2f(sc[m] - mx0) * iv0, p1 = __builtin_amdgcn_exp2f(sc[256 + m] - mx1) * iv1;
                    a0 += sv[2 * r] * p0; a1 += sv[2 * r + 1] * p1;
                }
                if (c < 7) FA_SLOAD(vp, c + 1);
            }
            LAS unsigned char* slot = lds + (c & 1) * ATT_SLOT;
            if (c < 4) {
#pragma unroll
                for (int ml = 0; ml < 4; ++ml)
#pragma unroll
                    for (int ks = 0; ks < 8; ++ks) {
                        const bf16x8 Kf = *(LAS bf16x8*)(slot + (16 * ml + fr) * 528 + (32 * ks + 8 * fq) * 2);
                        S[4 * c + ml] = MFMA16(Kf, Qf[ks], ks == 0 ? zero4 : S[4 * c + ml]);
                    }
                if (c == 3) {
                    float mx = S[0][0];
#pragma unroll
                    for (int i = 0; i < 16; ++i) { mx = fmaxf(mx, fmaxf(fmaxf(S[i][0], S[i][1]), fmaxf(S[i][2], S[i][3]))); }
                    mx = fmaxf(mx, shx(mx, 16, lane)); mx = fmaxf(mx, shx(mx, 32, lane));
                    float sum = 0.f;
#pragma unroll
                    for (int i = 0; i < 16; ++i) {
#pragma unroll
                        for (int e = 0; e < 4; ++e) { S[i][e] = __builtin_amdgcn_exp2f(S[i][e] - mx); sum += S[i][e]; }
                    }
                    sum += shx(sum, 16, lane); sum += shx(sum, 32, lane);
                    inv = 1.0f / sum;
#pragma unroll
                    for (int a = 0; a < 8; ++a) {
                        u32x4 pw; pw.x = cvt_pk_bf16(S[2 * a][0], S[2 * a][1]); pw.y = cvt_pk_bf16(S[2 * a][2], S[2 * a][3]); pw.z = cvt_pk_bf16(S[2 * a + 1][0], S[2 * a + 1][1]); pw.w = cvt_pk_bf16(S[2 * a + 1][2], S[2 * a + 1][3]);
                        Pf[a] = __builtin_bit_cast(bf16x8, pw);
                    }
                }
            } else {
#pragma unroll
                for (int al = 0; al < 2; ++al)
#pragma unroll
                    for (int dt = 0; dt < 16; ++dt) {
                        LAS unsigned char* p = slot + (32 * al + 4 * fq + (fr >> 2)) * 528 + (16 * dt + 4 * (fr & 3)) * 2;
                        const bf16x8 Vf = tr_frag(p, p + 16 * 528);
                        Oa[dt] = MFMA16(Vf, Pf[2 * (c - 4) + al], (c == 4 && al == 0) ? zero4 : Oa[dt]);
                    }
            }
            if (c < 7) ATT_LSTORE((c + 1) & 1);
            __syncthreads();
        }
#pragma unroll
        for (int dt = 0; dt < 16; ++dt) *(u32x2*)(((bf16_t*)(F.ws + WS_O)) + rowq * D + h * 256 + 16 * dt + 4 * fq) = pack4(Oa[dt] * inv);
#undef ATT_GLOAD
#undef ATT_LSTORE
    }
#undef FA_SLOAD
    *(LAS f32x4*)(red + w * 512 + 4 * lane) = a0; *(LAS f32x4*)(red + w * 512 + 256 + 4 * lane) = a1;
    __syncthreads();
    {
        float o = 0.f;
#pragma unroll
        for (int ww = 0; ww < 8; ++ww) o += red[ww * 512 + tid];
        ((bf16_t*)(F.ws + WS_SO))[(size_t)sb * D + hp * 512 + tid] = (bf16_t)(cvt_pk_bf16(o, 0.f) & 0xffffu);
    }
    __syncthreads();
}
__device__ __forceinline__ void final_norm(Frame& F0) {
    Frame F = launder(F0);
    const int gwx = F.rk * NWAVES + F.wave, NGX = F.rw * NWAVES, lane = F.lane;
    f32x4 g[4];
#pragma unroll
    for (int jj = 0; jj < 4; ++jj) g[jj] = ((const f32x4*)FIN(24) + lane)[64 * jj];
    for (int p = gwx; p < SEQ / 2 + 8; p += NGX) {
        const int m0 = p < SEQ / 2 ? F.xq * SEQ + 2 * p : MP + 16 * F.xq + 2 * (p - SEQ / 2);
        f32x4 v[2][4];
#pragma unroll
        for (int r = 0; r < 2; ++r) {
            const int m = m0 + r;
            if (m < MP) {
                const u32x2* src = (const u32x2*)(((bf16_t*)(F.ws + WS_XB)) + (size_t)m * D) + lane;
#pragma unroll
                for (int jj = 0; jj < 4; ++jj) v[r][jj] = unpack4(src[64 * jj]);
            } else {
                const f32x4* src = (const f32x4*)(((float*)(F.ws + WS_XS)) + (size_t)(m - MP) * D) + lane;
#pragma unroll
                for (int jj = 0; jj < 4; ++jj) v[r][jj] = src[64 * jj];
            }
        }
#pragma unroll
        for (int r = 0; r < 2; ++r) {
            const int m = m0 + r; float s = 0.f;
#pragma unroll
            for (int jj = 0; jj < 4; ++jj) s += dot4(v[r][jj], v[r][jj]);
            float* dst = m < MP ? F.out + O_Y + (size_t)m * D : F.out + O_YS + (size_t)(m - MP) * D;
            const float rs = rsqrtf(wave_sum(s, lane) * (1.0f / D) + EPS);
#pragma unroll
            for (int jj = 0; jj < 4; ++jj) ((f32x4*)dst + lane)[64 * jj] = v[r][jj] * rs * g[jj];
        }
    }
}

struct Args { const float* in[25]; float* out; unsigned char* ws; int ph_lo, ph_hi; };
#define REP(bit) for (int rep_ = 0; rep_ < 1 + ((REP_MASK >> (bit)) & 1); ++rep_)
__global__ void __launch_bounds__(NWAVES * 64, 2) fwd(Args args) {
    extern __shared__ __attribute__((aligned(16))) unsigned char lds_raw[];
    Frame F0;
    F0.lds = (LAS unsigned char*)lds_raw;
    F0.tid = threadIdx.x; F0.lane = F0.tid & 63; F0.wave = __builtin_amdgcn_readfirstlane(F0.tid >> 6); F0.G = gridDim.x; F0.bx = blockIdx.x;
    F0.in = (in_tab_t)__builtin_amdgcn_kernarg_segment_ptr();     F0.out = args.out; F0.ws = args.ws;
    for (int u = F0.tid; u < (LDS_BYTES - LDSCTL_OFF) / 4; u += NWAVES * 64) ((LAS unsigned*)(F0.lds + LDSCTL_OFF))[u] = 0u;
    __syncthreads();
    XcdBarrier bar; bar.wave = F0.wave; bar.bar = (unsigned*)(args.ws + WS_CTL) + CW_BAR; bar.x = 0; bar.st = nullptr;
    if (!MK_SPLIT) bar = xcd_barrier_post((unsigned*)(args.ws + WS_CTL) + CW_BAR, (volatile LAS unsigned*)(F0.lds + MISC_OFF) + 8, F0.wave);
    unsigned* rankw = (unsigned*)(args.ws + WS_CTL) + CW_RANK;
    const unsigned my_xcc = xb_xcc_id();
    unsigned my_rank = 0u;
    if (F0.tid == 0) ((volatile LAS unsigned*)(F0.lds + MISC_OFF))[12] = __hip_atomic_fetch_add(rankw + 64 * my_xcc, 1u, __ATOMIC_RELAXED, __HIP_MEMORY_SCOPE_AGENT);
    __syncthreads();
    my_rank = __builtin_amdgcn_readfirstlane(((volatile LAS unsigned*)(F0.lds + MISC_OFF))[12]);
    F0.vid = F0.bx;
    int ph = 0;
    bool local_ok = false;
    const int lo = args.ph_lo, hi = args.ph_hi;
#define PH_BEGIN if (ph >= lo && ph < hi) { Frame F = launder(F0);
#define PH_END } { const bool both_ = (ph >= lo && ph + 1 < hi); ++ph; if (!MK_SPLIT && both_) { XcdBarrier b2_ = bar; unsigned long long bp_ = uni64((unsigned long long)bar.bar); unsigned bx_ = __builtin_amdgcn_readfirstlane(bar.x); int bw_ = __builtin_amdgcn_readfirstlane(bar.wave); asm volatile("" : "+s"(bp_), "+s"(bx_), "+s"(bw_)); b2_.bar = (unsigned*)(GAS unsigned*)bp_; b2_.x = bx_; b2_.wave = bw_; if (local_ok && ph > 2) xcd_barrier_local(b2_); else xcd_barrier(b2_); if ((REP_MASK >> 19) & 1) xcd_barrier(b2_); if (ph == 2) local_ok = XCD_LOCAL && lo == 0 && __builtin_amdgcn_readfirstlane(__hip_atomic_load(rankw + 64 * 20, __ATOMIC_RELAXED, __HIP_MEMORY_SCOPE_AGENT)) == 0u;     } }

    PH_BEGIN REP(0) { p0_prologue(F0); __syncthreads(); } PH_END
    if (!MK_SPLIT && lo == 0) {
        unsigned nx = 0u, xi = 0u; bool even = (F0.G % 8) == 0;
        for (unsigned jx = 0; jx < 16; ++jx) { const unsigned c_ = __hip_atomic_load(rankw + 64 * jx, __ATOMIC_RELAXED, __HIP_MEMORY_SCOPE_AGENT); if (c_) { if (c_ != (unsigned)F0.G / 8u) even = false; if (jx < my_xcc) ++xi; ++nx; } }
        if (XCD_VID && even && nx == 8u) F0.vid = (int)(my_rank * 8u + xi);
        if (!(even && nx == 8u && (unsigned)(F0.bx % 8) == xi) && F0.tid == 0) __hip_atomic_store(rankw + 64 * 20, 1u, __ATOMIC_RELAXED, __HIP_MEMORY_SCOPE_AGENT);
        if (((REP_MASK >> 18) & 1) && !(even && nx == 8u && (unsigned)(F0.bx % 8) == xi) && F0.tid == 0) F0.out[O_YS + F0.bx] = __builtin_nanf("");
        F0.vid = __builtin_amdgcn_readfirstlane(F0.vid);
    }
    PH_BEGIN {
        if ((REP_MASK >> 17) & 1) {
            f32x4 pa[8]; bf16x8 pb = (bf16x8){(short)F.tid, 1, 2, 3, 4, 5, 6, 7};
#pragma unroll
            for (int i = 0; i < 8; ++i) pa[i] = (f32x4){(float)F.tid, 1.f, 2.f, (float)i};
#pragma unroll 1
            for (int it = 0; it < 512; ++it) {
#pragma unroll
                for (int r = 0; r < 4; ++r)
#pragma unroll
                    for (int i = 0; i < 8; ++i) pa[i] = MFMA16(pb, pb, pa[i]);
            }
            float sacc = 0.f;
#pragma unroll
            for (int i = 0; i < 8; ++i) sacc += pa[i][0] + pa[i][3];
            if (sacc == 12345.678f) ((float*)(F.ws + WS_Z))[F.tid] = sacc;
        }
        if ((REP_MASK >> 15) & 3) { pg8::Gemm gp{((bf16_t*)(F.ws + WS_XB)), ((bf16_t*)(F.ws + WS_C1)), MP, NC, ((REP_MASK >> 15) & 1) ? 1024 : 512}; pg8::StaticOrder Sp; Sp.init(MP, NC, F.G, (int)F.vid); EpiProbe Ep{((bf16_t*)(F.ws + WS_Z)), NC}; pg8::gemm_phase<EpiProbe, pg8::StaticOrder, true, true>(F.lds, gp, Sp, Ep, F.wave); }
        pg8::Gemm g{((bf16_t*)(F.ws + WS_MEMB)), ((bf16_t*)(F.ws + WS_WKV)), MMEM, 8192, D}; pg8::StaticOrder S; S.init(MMEM, 8192, F.G, (int)F.vid);
        EpiMemKV E{((float*)(F.ws + WS_SMALL + 65536)), F.out + O_MEMK, F.out + O_MEMV, ((bf16_t*)(F.ws + WS_KB)), ((bf16_t*)(F.ws + WS_VB))};
        REP(1) pg8::gemm_phase<EpiMemKV, pg8::StaticOrder, true, true>(F.lds, g, S, E, F.wave);
    } PH_END
    if (STAGGER_TICKS != 0 && lo == 0 && ((F0.bx & 1) == (STAGGER_TICKS > 0 ? 1 : 0))) { const unsigned long long t0_ = __builtin_amdgcn_s_memrealtime(); const unsigned long long tk_ = (unsigned long long)(STAGGER_TICKS > 0 ? STAGGER_TICKS : -STAGGER_TICKS); while (__builtin_amdgcn_s_memrealtime() - t0_ < tk_) __builtin_amdgcn_s_sleep(8); }
    unsigned* pbw = (unsigned*)(args.ws + WS_CTL) + CW_RANK + 64 * 24;
    if (!MK_SPLIT && SPLIT_PROLOGUE && lo == 0) {
        const int half = F0.bx & 1, hw = (half ? (F0.G >> 1) : ((F0.G + 1) >> 1)) * NWAVES, hi_ = (F0.bx >> 1) * NWAVES + F0.wave;
        p0_weights(F0, 1, hi_, hw, half);
        asm volatile("s_waitcnt vmcnt(0)" ::: "memory"); __syncthreads();
        if (F0.wave == 0 && hw_lane() == 0) { __builtin_amdgcn_fence(__ATOMIC_RELEASE, "agent"); asm volatile("s_waitcnt vmcnt(0)" ::: "memory"); (void)__hip_atomic_fetch_add(pbw, 1u, __ATOMIC_RELAXED, __HIP_MEMORY_SCOPE_AGENT); }
    }
#pragma unroll 1
    for (int l = 0; l < DEPTH; ++l) {
        const int j = l >> 1;
        if (!MK_SPLIT && SPLIT_PROLOGUE && lo == 0 && l == 1) {
            if (F0.wave == 0 && hw_lane() == 0) {
                const unsigned want = (unsigned)F0.G; unsigned sp = 0u;
                while (__hip_atomic_load(pbw, __ATOMIC_RELAXED, __HIP_MEMORY_SCOPE_AGENT) < want) { __builtin_amdgcn_s_sleep(2); if (++sp > (1u << 22)) { atomicAdd((unsigned*)(args.ws + WS_CTL) + CW_BAR + XB_TMO, 1u); break; } }
                __builtin_amdgcn_fence(__ATOMIC_ACQUIRE, "agent"); asm volatile("s_waitcnt vmcnt(0)" ::: "memory");
            }
            __syncthreads();
        }
        if ((l & 1) == 0) {
            PH_BEGIN {
                pg8::Gemm g{((bf16_t*)(F.ws + WS_XB)), ((bf16_t*)(F.ws + WS_AB1)) + (size_t)j * NAB * D, MP, NAB, D}; pg8::StaticOrder S; S.init(MP, NAB, F.G, (int)F.vid);
                Unit u0{0, 0}; S.next(0, u0); rstd_table(((float*)(F.ws + WS_RSQ)), u0.pm, (LAS float*)(F.lds + RSTD_OFF), F.tid);
                EpiG1Even E{((float*)(F.ws + WS_RSQ)), ((bf16_t*)(F.ws + WS_Z)), ((float*)(F.ws + WS_VSQ)), F.out + O_POOLP + (size_t)j * 8 * 15 * 1024, (LAS const float*)(F.lds + RSTD_OFF), u0.pm};
                SEpiZ SE{((float*)(F.ws + WS_SMALL)), ((float*)(F.ws + WS_SZ)), 8192, 0};
                const bool s_first = (F.rk & 1) != 0;
                if (s_first) { REP(3) sgemm16<SEpiZ, NAB>(F, ((bf16_t*)(F.ws + WS_XB)) + (size_t)MP * D, ((bf16_t*)(F.ws + WS_AB1)) + (size_t)j * NAB * D, D, SE); }
                REP(2) pg8::gemm_phase<EpiG1Even, pg8::StaticOrder, true, true>(F.lds, g, S, E, F.wave);
                if (!s_first) { REP(3) sgemm16<SEpiZ, NAB>(F, ((bf16_t*)(F.ws + WS_XB)) + (size_t)MP * D, ((bf16_t*)(F.ws + WS_AB1)) + (size_t)j * NAB * D, D, SE); }
            } PH_END
            PH_BEGIN {
                for (int rep_ = 0; rep_ < 1 + (((REP_MASK >> 4) & 1) | ((REP_MASK >> 20) & 3 ? 1 : 0)); ++rep_) for (int i = F.rk; i < 32; i += F.rw) { const bool only_s = rep_ && ((REP_MASK >> 20) & 1), only_p = rep_ && ((REP_MASK >> 21) & 1); if ((i & 1) == 0) { if (!only_p) sgu_chunk(F, j, 16 * F.xq + (i >> 1)); } else { if (!only_s) pool_chunk(F, j, 16 * F.xq + (i >> 1)); } }
                REP(5) for (int i = F.rk; i < 16; i += F.rw) sample_mix_even(F, j, 16 * F.xq + i);
            } PH_END
        } else {
            PH_BEGIN {
                pg8::Gemm g{((bf16_t*)(F.ws + WS_XB)), ((bf16_t*)(F.ws + WS_C1)) + (size_t)j * NC * D, MP, NC, D}; pg8::StaticOrder S; S.init(MP, NC, F.G, (int)F.vid);
                Unit u0{0, 0}; S.next(0, u0);
                for (int i = F.tid; i < 8 * 3 * 64; i += NWAVES * 64) { const int ui = i / 192, q = (i / 64) % 3, c = i & 63, pn = u0.pn + 4 * ui; ((LAS float*)(F.lds + CWL_OFF))[i] = pn < NC / 256 ? (FIN(18) + (size_t)j * 3 * 2048)[q * 2048 + pn * 64 + c] : 0.f; }
                rstd_table(((float*)(F.ws + WS_RSQ)), u0.pm, (LAS float*)(F.lds + RSTD_OFF), F.tid);
                EpiG1Odd E{((float*)(F.ws + WS_RSQ)), ((bf16_t*)(F.ws + WS_A2)), FIN(18) + (size_t)j * 3 * 2048, F.out + O_CONVP + (size_t)j * 8 * 2 * 2048, ((float*)(F.ws + WS_SIDE)), (LAS float*)(F.lds + HALO_OFF), (LAS const float*)(F.lds + RSTD_OFF), u0.pm, (LAS const float*)(F.lds + CWL_OFF), u0.pn};
                SEpiZ SE{((float*)(F.ws + WS_SMALL)), ((float*)(F.ws + WS_SZ)), 8192, 1};
                const bool s_first = (F.rk & 1) != 0;
                if (s_first) { REP(3) sgemm16<SEpiZ, NC>(F, ((bf16_t*)(F.ws + WS_XB)) + (size_t)MP * D, ((bf16_t*)(F.ws + WS_C1)) + (size_t)j * NC * D, D, SE); }
                REP(6) pg8::gemm_phase<EpiG1Odd, pg8::StaticOrder, true, true>(F.lds, g, S, E, F.wave);
                if (!s_first) { REP(3) sgemm16<SEpiZ, NC>(F, ((bf16_t*)(F.ws + WS_XB)) + (size_t)MP * D, ((bf16_t*)(F.ws + WS_C1)) + (size_t)j * NC * D, D, SE); }
            } PH_END
            PH_BEGIN {
                REP(5) for (int i = F.rk; i < 16; i += F.rw) sample_conv_odd(F, j, 16 * F.xq + i);
            } PH_END
        }
        PH_BEGIN {
            const bf16_t* W2 = ((l & 1) ? ((bf16_t*)(F.ws + WS_C2)) : ((bf16_t*)(F.ws + WS_AB2))) + (size_t)j * D * 2048;
            pg8::Gemm g{((bf16_t*)(F.ws + WS_A2)), W2, MP, D, 2048}; pg8::StaticOrder S; S.init(MP, D, F.G, (int)F.vid);
            if (l & 1) { Unit fu; for (int i = 0; S.next(i, fu); ++i) conv_fixup(((float*)(F.ws + WS_SIDE)), FIN(18) + (size_t)j * 3 * 2048, ((bf16_t*)(F.ws + WS_A2)), fu.pm, F.tid); asm volatile("s_waitcnt vmcnt(0)" ::: "memory"); __syncthreads(); }
            EpiRes E{((bf16_t*)(F.ws + WS_XB)), ((float*)(F.ws + WS_RSQ))};
            pg8::gemm_phase<EpiRes, pg8::StaticOrder, true, true>(F.lds, g, S, E, F.wave);
            SEpiRes SE{((float*)(F.ws + WS_XS)), ((bf16_t*)(F.ws + WS_XB)) + (size_t)MP * D, ((float*)(F.ws + WS_SMALL))};
            sgemm16<SEpiRes, D>(F, ((bf16_t*)(F.ws + WS_SA2)), W2, 2048, SE);
        } PH_END
        PH_BEGIN {
            pg8::Gemm g{((bf16_t*)(F.ws + WS_XB)), ((bf16_t*)(F.ws + WS_WQ)) + (size_t)l * D * D, MP, D, D}; pg8::StaticOrder S; S.init(MP, D, F.G, (int)F.vid);
            Unit u0{0, 0}; S.next(0, u0); rstd_table(((float*)(F.ws + WS_RSQ)), u0.pm, (LAS float*)(F.lds + RSTD_OFF), F.tid);
            EpiQ E{((float*)(F.ws + WS_RSQ)), ((bf16_t*)(F.ws + WS_Q)), (LAS const float*)(F.lds + RSTD_OFF), u0.pm};
            REP(8) pg8::gemm_phase<EpiQ, pg8::StaticOrder, true, true>(F.lds, g, S, E, F.wave);
            SEpiQ SE{((float*)(F.ws + WS_SMALL)), ((float*)(F.ws + WS_SQ))};
            REP(9) sgemm16<SEpiQ, D>(F, ((bf16_t*)(F.ws + WS_XB)) + (size_t)MP * D, ((bf16_t*)(F.ws + WS_WQ)) + (size_t)l * D * D, D, SE);
        } PH_END
        PH_BEGIN {
            if (F.G == 256) { REP(10) attn_fused(F, l); }
            else { attn_prompt(F, l); attn_sample(F, l); }
        } PH_END
        PH_BEGIN {
            pg8::Gemm g{((bf16_t*)(F.ws + WS_O)), ((bf16_t*)(F.ws + WS_WO)) + (size_t)l * D * D, MP, D, D}; pg8::StaticOrder S; S.init(MP, D, F.G, (int)F.vid);
            EpiRes E{((bf16_t*)(F.ws + WS_XB)), ((float*)(F.ws + WS_RSQ))};
            pg8::gemm_phase<EpiRes, pg8::StaticOrder, true, true>(F.lds, g, S, E, F.wave);
            SEpiRes SE{((float*)(F.ws + WS_XS)), ((bf16_t*)(F.ws + WS_XB)) + (size_t)MP * D, ((float*)(F.ws + WS_SMALL))};
            sgemm16<SEpiRes, D>(F, ((bf16_t*)(F.ws + WS_SO)), ((bf16_t*)(F.ws + WS_WO)) + (size_t)l * D * D, D, SE);
        } PH_END
    }
    PH_BEGIN final_norm(F0); PH_END
#undef PH_BEGIN
#undef PH_END
}
constexpr int N_PHASES = 2 + 6 * DEPTH + 1;

extern "C" void kernel_launch(void* const* d_in, const int* in_sizes, int n_in, void* d_out, int out_size, void* d_ws, size_t ws_size, hipStream_t stream) {
    static int grid = 0;
    if (grid == 0) {
        if (n_in != 25 || in_sizes[0] != MP * D || (size_t)out_size != O_END || ws_size < WS_END) { fprintf(stderr, "kernel_launch: unexpected shapes (n_in %d, in0 %d, out %d, ws %zu); nothing launched\n", n_in, n_in > 0 ? in_sizes[0] : -1, out_size, ws_size); grid = -1; return; }
        int dev = 0, cus = 0, per_cu = 0;
        if (hipGetDevice(&dev) != hipSuccess || hipDeviceGetAttribute(&cus, hipDeviceAttributeMultiprocessorCount, dev) != hipSuccess) { fprintf(stderr, "kernel_launch: device query failed\n"); grid = -1; return; }
        if (hipFuncSetAttribute((const void*)fwd, hipFuncAttributeMaxDynamicSharedMemorySize, LDS_BYTES) != hipSuccess) { fprintf(stderr, "kernel_launch: hipFuncSetAttribute failed\n"); grid = -1; return; }
        if (hipOccupancyMaxActiveBlocksPerMultiprocessor(&per_cu, (const void*)fwd, NWAVES * 64, LDS_BYTES) != hipSuccess || per_cu < 1) fprintf(stderr, "kernel_launch: note: occupancy query reports %d workgroups per CU\n", per_cu);
        (void)hipGetLastError();
        grid = cus;
    }
    if (grid < 0) return;
    if (hipMemsetAsync((char*)d_ws + WS_CTL, 0, CTL_ZERO_BYTES, stream) != hipSuccess) { fprintf(stderr, "kernel_launch: memset failed\n"); return; }
    Args a{};
    for (int i = 0; i < 25; ++i) a.in[i] = (const float*)d_in[i];
    a.out = (float*)d_out; a.ws = (unsigned char*)d_ws;
#if MK_SPLIT
    for (int p = 0; p < N_PHASES; ++p) { a.ph_lo = p; a.ph_hi = p + 1; hipLaunchKernelGGL(fwd, dim3(grid), dim3(NWAVES * 64), LDS_BYTES, stream, a); }
#else
    a.ph_lo = 0; a.ph_hi = N_PHASES;
    hipLaunchKernelGGL(fwd, dim3(grid), dim3(NWAVES * 64), LDS_BYTES, stream, a);
#endif
    const hipError_t le = hipPeekAtLastError();
    if (le != hipSuccess) fprintf(stderr, "kernel_launch: launch failed: %s\n", hipGetErrorName(le));
}
```

```cpp
#include <hip/hip_runtime.h>
#include <cstdio>
#include <cstdint>
#ifndef REP_MASK
#define REP_MASK 0
#endif
#ifndef STAGGER_TICKS
#define STAGGER_TICKS 0
#endif
#ifndef PB_ODD_PCT
#define PB_ODD_PCT 100
#endif
#ifndef SPLIT_PROLOGUE
#define SPLIT_PROLOGUE 1
#endif
#ifndef XCD_LOCAL
#define XCD_LOCAL 1
#endif
#ifndef XCD_VID
#define XCD_VID 0
#endif
#ifndef MK_SPLIT
#define MK_SPLIT 0
#endif
__device__ __forceinline__ int hw_lane() { int l; asm volatile("v_mbcnt_lo_u32_b32 %0, -1, 0\n\tv_mbcnt_hi_u32_b32 %0, -1, %0" : "=v"(l)); return l; }
namespace pg8 {
#define PG8_LAS __attribute__((address_space(3)))
typedef unsigned short bf16_t;
typedef short bf16x8 __attribute__((ext_vector_type(8)));
typedef float f32x4 __attribute__((ext_vector_type(4)));
typedef unsigned u32x4 __attribute__((ext_vector_type(4)));
constexpr int BM = 256, BK = 64, HALF = 128, HTB = HALF * BK * 2  , STAGE_BYTES = 8 * HTB, NXCD = 8, WGM = 8;

__host__ __device__ __forceinline__ int lds_byte(int r, int c) { const int st = (r >> 4) * 2 + (c >> 5), rr = r & 15, cc = c & 31, ob = rr * 64 + cc * 2; return st * 1024 + (ob ^ (((ob >> 9) & 1) << 5)); }
__host__ __device__ __forceinline__ void stage_rc(int b, int& R, int& C) { const int st = b / 1024, sb = b % 1024, swz = sb ^ (((sb >> 9) & 1) << 5); R = (st >> 1) * 16 + swz / 64; C = (st & 1) * 32 + (swz % 64) / 2; }
__host__ __device__ __forceinline__ int perm32(int rho) { const int n = rho >> 4, i = rho & 15; return 8 * (i >> 2) + 4 * n + (i & 3); }

struct Unit { int pm, pn; };
struct Gemm { const bf16_t* A; const bf16_t* Bt; int M, N, K; };

struct StaticOrder {
    int nM, nN, nwg, G, c;
    __host__ __device__ __forceinline__ void init(int M, int N, int G_, int c_) { nM = M / BM; nN = N / BM; nwg = nM * nN; G = G_; c = c_; }
    __host__ __device__ __forceinline__ bool next(int i, Unit& u) const {
        const long L = (long)i * G + c; if (L >= nwg) return false;
        int wgid = (int)L; { const int q = nwg / NXCD, r = nwg % NXCD, xcd = wgid % NXCD, off = wgid / NXCD; wgid = (xcd < r ? xcd * (q + 1) : r * (q + 1) + (xcd - r) * q) + off; }
        const int nig = WGM * nN, gid = wgid / nig, fm = gid * WGM, gsz = (nM - fm) < WGM ? (nM - fm) : WGM;
        u.pm = fm + ((wgid % nig) % gsz); u.pn = (wgid % nig) / gsz; return true;
    }
    __device__ __forceinline__ void a_ready(const Unit&) const {}
    __device__ __forceinline__ void done(const Unit&) const {}
};

typedef float f32x2cv __attribute__((ext_vector_type(2))); typedef __bf16 bf16x2cv __attribute__((ext_vector_type(2)));
__device__ __forceinline__ unsigned cvt_pk_bf16(float lo, float hi) { const f32x2cv v = {lo, hi}; return __builtin_bit_cast(unsigned, __builtin_convertvector(v, bf16x2cv)); }
template <class Epi, class Sched, bool ALIGN_EPI = false, bool SP2 = false>
__device__ __forceinline__ void gemm_phase(PG8_LAS unsigned char* lds, const Gemm g, const Sched& S, const Epi& E, const int wave_id) {
    int tid_ = (wave_id << 6) | hw_lane(); asm volatile("" : "+v"(tid_));
    const int tid = tid_, wid = __builtin_amdgcn_readfirstlane(tid >> 6), lane = tid & 63, wr = wid >> 2, wc = wid & 3, fr = lane & 15, fq = lane >> 4;
    const int K = g.K, nt = K / BK;
    unsigned voffA[2], voffB[2];
#pragma unroll
    for (int i = 0; i < 2; ++i) { int R, C; stage_rc(tid * 16 + i * 8192, R, C); const int Rb = Epi::PERM ? ((R & ~31) + perm32(R & 31)) : R;
        voffA[i] = (unsigned)(R * K + C) * 2u; voffB[i] = (unsigned)(Rb * K + C) * 2u; }
    const size_t kstep = (size_t)(BK * 2);
    const size_t hstep = (size_t)HALF * K * 2;
    const size_t tstep = 2 * hstep;
    const unsigned ldsw = (unsigned)wid * 1024u;
    const int aoff = lds_byte(wr * 64 + fr, fq * 8), boff = lds_byte(wc * 32 + fr, fq * 8);
#define PG8_SA(b, h) (((b) * 2 + (h)) * HTB)
#define PG8_SB(b, h) ((4 + (b) * 2 + (h)) * HTB)
#define PG8_STAGE(bufoff, gbase, voff) do { _Pragma("unroll") for (int _i = 0; _i < 2; ++_i) \
        __builtin_amdgcn_global_load_lds((const unsigned*)((const char*)(gbase) + (voff)[_i]), (PG8_LAS unsigned*)(lds + (bufoff) + ldsw + _i * 8192), 16, 0, 0); } while (0)
#define PG8_LDA(dst, b, h) do { _Pragma("unroll") for (int m = 0; m < 4; ++m) _Pragma("unroll") for (int k = 0; k < 2; ++k) dst[m][k] = *(const PG8_LAS bf16x8*)(lds + PG8_SA(b, h) + aoff + m * 2048 + k * 1024); } while (0)
#define PG8_LDB(dst, b, h) do { _Pragma("unroll") for (int n = 0; n < 2; ++n) _Pragma("unroll") for (int k = 0; k < 2; ++k) dst[n][k] = *(const PG8_LAS bf16x8*)(lds + PG8_SB(b, h) + boff + n * 2048 + k * 1024); } while (0)
#define PG8_MMA(ai, bj, At, Bt) do { __builtin_amdgcn_s_setprio(1); _Pragma("unroll") for (int m = 0; m < 4; ++m) _Pragma("unroll") for (int n = 0; n < 2; ++n) _Pragma("unroll") for (int k = 0; k < 2; ++k) \
        acc[ai][bj][m][n] = __builtin_amdgcn_mfma_f32_16x16x32_bf16(Bt[n][k], At[m][k], acc[ai][bj][m][n], 0, 0, 0); __builtin_amdgcn_s_setprio(0); } while (0)
#define PG8_WAIT_V(n) asm volatile("s_waitcnt vmcnt(" #n ")" ::: "memory")
#define PG8_WAIT_L(n) asm volatile("s_waitcnt lgkmcnt(" #n ")" ::: "memory")
#define PG8_BAR __builtin_amdgcn_s_barrier()
#define PG8_SCHED __builtin_amdgcn_sched_barrier(0)
    Unit cur, nxt; int ui = 0;
    if (!S.next(0, cur)) return;
    f32x4 acc[2][2][4][2];
#pragma unroll
    for (int a = 0; a < 2; ++a)
#pragma unroll
        for (int b = 0; b < 2; ++b)
#pragma unroll
            for (int m = 0; m < 4; ++m)
#pragma unroll
                for (int n = 0; n < 2; ++n) acc[a][b][m][n] = (f32x4){0.f, 0.f, 0.f, 0.f};
    bf16x8 At[4][2], B0[2][2], B1[2][2];
    const char* cA = (const char*)g.A + (size_t)cur.pm * tstep; const char* cB = (const char*)g.Bt + (size_t)cur.pn * tstep;
    S.a_ready(cur);
    if constexpr (SP2) {
        PG8_STAGE(PG8_SB(0, 0), cB, voffB); PG8_STAGE(PG8_SB(0, 1), cB + hstep, voffB); PG8_STAGE(PG8_SA(0, 0), cA, voffA); PG8_STAGE(PG8_SA(0, 1), cA + hstep, voffA);
        if (wr == 1) PG8_BAR;
        PG8_WAIT_V(2); PG8_BAR;
        PG8_STAGE(PG8_SB(1, 0), cB + kstep, voffB); PG8_STAGE(PG8_SA(1, 0), cA + kstep, voffA); PG8_STAGE(PG8_SB(1, 1), cB + hstep + kstep, voffB);
        PG8_WAIT_V(6); PG8_BAR;
    } else {
        PG8_STAGE(PG8_SB(0, 0), cB, voffB); PG8_STAGE(PG8_SA(0, 0), cA, voffA); PG8_STAGE(PG8_SB(0, 1), cB + hstep, voffB); PG8_STAGE(PG8_SA(0, 1), cA + hstep, voffA);
        if (wr == 1) PG8_BAR;
        PG8_WAIT_V(4); PG8_BAR;
        PG8_STAGE(PG8_SB(1, 0), cB + kstep, voffB); PG8_STAGE(PG8_SA(1, 0), cA + kstep, voffA); PG8_STAGE(PG8_SB(1, 1), cB + hstep + kstep, voffB);
        PG8_WAIT_V(6); PG8_BAR;
    }
    for (;;) {
        const bool has_next = S.next(ui + 1, nxt);
        const char* nA = has_next ? (const char*)g.A + (size_t)nxt.pm * tstep : cA; const char* nB = has_next ? (const char*)g.Bt + (size_t)nxt.pn * tstep : cB;
        for (int t = 0; t < nt; t += 2) {
            const bool last = (t == nt - 2);
            const char* a1 = cA + (size_t)(t + 1) * kstep;
            const char* a2 = last ? nA : cA + (size_t)(t + 2) * kstep; const char* b2 = last ? nB : cB + (size_t)(t + 2) * kstep;
            const char* a3 = a2 + kstep; const char* b3 = b2 + kstep;
            if (last && has_next) S.a_ready(nxt);
            if constexpr (SP2) {
            PG8_LDB(B0, 0, 0); PG8_LDB(B1, 0, 1); PG8_SCHED; PG8_LDA(At, 0, 0); PG8_STAGE(PG8_SA(1, 1), a1 + hstep, voffA);
            PG8_WAIT_V(8); PG8_WAIT_L(0); PG8_BAR; PG8_MMA(0, 0, At, B0); PG8_MMA(0, 1, At, B1); PG8_BAR; PG8_SCHED;
            PG8_LDA(At, 0, 1); PG8_STAGE(PG8_SB(0, 0), b2, voffB); PG8_STAGE(PG8_SB(0, 1), b2 + hstep, voffB); PG8_STAGE(PG8_SA(0, 0), a2, voffA);
            PG8_WAIT_V(8); PG8_WAIT_L(0); PG8_BAR; PG8_MMA(1, 0, At, B0); PG8_MMA(1, 1, At, B1); PG8_BAR; PG8_SCHED;
            PG8_LDB(B0, 1, 0); PG8_LDB(B1, 1, 1); PG8_SCHED; PG8_LDA(At, 1, 0); PG8_STAGE(PG8_SA(0, 1), a2 + hstep, voffA);
            PG8_WAIT_V(8); PG8_WAIT_L(0); PG8_BAR; PG8_MMA(0, 0, At, B0); PG8_MMA(0, 1, At, B1); PG8_BAR; PG8_SCHED;
            PG8_LDA(At, 1, 1); PG8_STAGE(PG8_SB(1, 0), b3, voffB); PG8_STAGE(PG8_SB(1, 1), b3 + hstep, voffB); PG8_STAGE(PG8_SA(1, 0), a3, voffA);
            PG8_WAIT_V(8); PG8_WAIT_L(0); PG8_BAR; PG8_MMA(1, 0, At, B0); PG8_MMA(1, 1, At, B1); PG8_BAR; PG8_SCHED;
            } else {
            PG8_LDB(B0, 0, 0); PG8_SCHED; PG8_LDA(At, 0, 0); PG8_STAGE(PG8_SA(1, 1), a1 + hstep, voffA);
            PG8_WAIT_L(8); PG8_BAR; PG8_WAIT_L(0); PG8_MMA(0, 0, At, B0); PG8_BAR; PG8_SCHED;
            PG8_LDB(B1, 0, 1); PG8_STAGE(PG8_SB(0, 0), b2, voffB);
            PG8_BAR; PG8_WAIT_L(0); PG8_MMA(0, 1, At, B1); PG8_BAR;
            PG8_LDA(At, 0, 1); PG8_STAGE(PG8_SA(0, 0), a2, voffA);
            PG8_BAR; PG8_WAIT_L(0); PG8_MMA(1, 0, At, B0); PG8_BAR; PG8_SCHED;
            PG8_STAGE(PG8_SB(0, 1), b2 + hstep, voffB);
            PG8_WAIT_V(6); PG8_BAR; PG8_MMA(1, 1, At, B1); PG8_BAR;
            PG8_LDB(B0, 1, 0); PG8_SCHED; PG8_LDA(At, 1, 0); PG8_STAGE(PG8_SA(0, 1), a2 + hstep, voffA);
            PG8_WAIT_L(8); PG8_BAR; PG8_WAIT_L(0); PG8_MMA(0, 0, At, B0); PG8_BAR; PG8_SCHED;
            PG8_LDB(B1, 1, 1); PG8_STAGE(PG8_SB(1, 0), b3, voffB);
            PG8_BAR; PG8_WAIT_L(0); PG8_MMA(0, 1, At, B1); PG8_BAR;
            PG8_LDA(At, 1, 1); PG8_STAGE(PG8_SA(1, 0), a3, voffA);
            PG8_BAR; PG8_WAIT_L(0); PG8_MMA(1, 0, At, B0); PG8_BAR; PG8_SCHED;
            PG8_STAGE(PG8_SB(1, 1), b3 + hstep, voffB);
            PG8_WAIT_V(6); PG8_BAR; PG8_MMA(1, 1, At, B1); PG8_BAR;
            }
        }
        if constexpr (ALIGN_EPI) { if (wr == 0) PG8_BAR; }
        if constexpr (!Epi::AFTER_DRAIN) { for (int rep_ = 0; rep_ < 1 + (Epi::REP_EPI ? 1 : 0); ++rep_) E(acc, cur, wr, wc, fr, fq); S.done(cur); }
        if (!has_next) break;
#pragma unroll
        for (int a = 0; a < 2; ++a)
#pragma unroll
            for (int b = 0; b < 2; ++b)
#pragma unroll
                for (int m = 0; m < 4; ++m)
#pragma unroll
                    for (int n = 0; n < 2; ++n) acc[a][b][m][n] = (f32x4){0.f, 0.f, 0.f, 0.f};
        cur = nxt; cA = nA; cB = nB; ++ui;
        if constexpr (ALIGN_EPI) { if (wr == 1) PG8_BAR; }
    }
    PG8_WAIT_V(0);
    if constexpr (!ALIGN_EPI) { if (wr == 0) PG8_BAR; }
    PG8_BAR;
    if constexpr (Epi::AFTER_DRAIN) { E.fused(acc, cur, wr, wc, fr, fq, lds, wid, lane); S.done(cur); }
#undef PG8_SA
#undef PG8_SB
#undef PG8_STAGE
#undef PG8_LDA
#undef PG8_LDB
#undef PG8_MMA
#undef PG8_WAIT_V
#undef PG8_WAIT_L
#undef PG8_BAR
#undef PG8_SCHED
}
}

using pg8::bf16_t; using pg8::bf16x8; using pg8::f32x4; using pg8::u32x4; using pg8::Unit; using pg8::cvt_pk_bf16;
#define GAS __attribute__((address_space(1)))
#define LAS __attribute__((address_space(3)))
typedef unsigned u32x2 __attribute__((ext_vector_type(2)));
typedef short s16x4 __attribute__((ext_vector_type(4)));
typedef GAS unsigned gu32;
#define RLX_AGENT __ATOMIC_RELAXED, __HIP_MEMORY_SCOPE_AGENT

constexpr int NWAVES = 8;
constexpr int D = 1024, MP = 16384, MS = 128, SEQ = 2048, NBATCH = 8, NMEM = 256, MMEM = 2048, DEPTH = 4;
constexpr int NAB = 5120, NC = 8192;
constexpr float EPS = 1e-6f;
constexpr float QSCALE = 0.0625f * 1.4426950408889634f;

constexpr size_t O_Y = 0, O_YS = O_Y + (size_t)MP * D, O_POOLP = O_YS + (size_t)MS * D, O_POOLS = O_POOLP + 2 * 8 * 15 * 1024,
                 O_CONVP = O_POOLS + (size_t)2 * 128 * 15 * 1024, O_CONVS = O_CONVP + 2 * 8 * 2 * 2048, O_SGUV = O_CONVS + (size_t)2 * 128 * 2 * 2048,
                 O_MEMK = O_SGUV + 2 * 128 * 1024, O_MEMV = O_MEMK + (size_t)4 * MMEM * D, O_END = O_MEMV + (size_t)4 * MMEM * D;
static_assert(O_END == 39239680, "output size");

constexpr size_t MiB = 1u << 20;
constexpr size_t WS_CTL = 0, CTL_ZERO_BYTES = 1 * MiB;
constexpr size_t WS_AB1 = 2 * MiB, WS_C1 = 22 * MiB, WS_AB2 = 54 * MiB, WS_C2 = 62 * MiB, WS_WQ = 70 * MiB, WS_WKV = 78 * MiB, WS_WO = 94 * MiB, WS_PMT = 102 * MiB;
constexpr size_t WS_XB = 104 * MiB;
constexpr size_t WS_RSQ = 137 * MiB, WS_VSQ = 138 * MiB;
constexpr size_t WS_SMALL = 139 * MiB;
constexpr size_t WS_Z = 140 * MiB;
constexpr size_t WS_A2 = 268 * MiB;
constexpr size_t WS_Q = 332 * MiB, WS_O = 364 * MiB;
constexpr size_t WS_MEMB = 396 * MiB, WS_KB = 400 * MiB, WS_VB = 416 * MiB;
constexpr size_t WS_XS = 432 * MiB, WS_SZ = 433 * MiB, WS_SA2 = 437 * MiB, WS_SQ = 438 * MiB, WS_SO = 439 * MiB, WS_SIDE = 440 * MiB  , WS_END = 444 * MiB;
constexpr int CW_BAR = 4096, CW_RANK = 8192;

constexpr int RING_BYTES = 131072, LDSCTL_OFF = RING_BYTES, MISC_OFF = LDSCTL_OFF + 320, HALO_OFF = RING_BYTES + 1024  , RSTD_OFF = HALO_OFF + 8192  , CWL_OFF = RSTD_OFF + 1024  , LDS_BYTES = 155648;

#define LDS_WAIT() asm volatile("s_waitcnt lgkmcnt(0)" ::: "memory")
#define LDS_BARRIER() asm volatile("s_waitcnt lgkmcnt(0)\n\ts_barrier" ::: "memory")

#define XB_TMO      128
#define XB_XCNT(j)  (256  + 64 * (j))
#define XB_XSUB(j)  (1280 + 64 * (j))
#define XB_XGEN(j)  (2304 + 64 * (j))
#define XB_TOP      3328
#define XB_TOPGEN   3392
#define XCD_BAR_WORDS 3456
#define XB_SPIN_CAP (1u << 18)

__device__ __forceinline__ unsigned xb_ld(unsigned* p)              { return __hip_atomic_load(p, __ATOMIC_RELAXED, __HIP_MEMORY_SCOPE_AGENT); }
__device__ __forceinline__ unsigned xb_add(unsigned* p, unsigned v) { return __hip_atomic_fetch_add(p, v, __ATOMIC_RELAXED, __HIP_MEMORY_SCOPE_AGENT); }
__device__ __forceinline__ unsigned xb_xcc_id() { return (unsigned)__builtin_amdgcn_s_getreg((3 << 11) | 20) & 0xFu; }
#define XB_SPIN(cond, bar) do { unsigned _sp = 0; while (cond) { __builtin_amdgcn_s_sleep(1); \
    if ((++_sp & 255u) == 0u) { if (xb_ld(&(bar)[XB_TMO])) break; if (_sp > XB_SPIN_CAP) { atomicAdd(&(bar)[XB_TMO], 1u); break; } } } } while (0)

struct XcdBarrier {
    int wave;
    unsigned* bar; unsigned x;
    volatile LAS unsigned* st;
};

__device__ __forceinline__ XcdBarrier xcd_barrier_post(unsigned* bar, volatile LAS unsigned* st, int wave) {
    XcdBarrier b; b.wave = wave; b.bar = bar; b.x = xb_xcc_id(); b.st = st;
    if (b.wave == 0 && hw_lane() == 0) (void)xb_add(&bar[XB_XCNT(b.x)], 1u);
    return b;
}
__device__ __forceinline__ void xcd_barrier_complete(unsigned* bar, unsigned x, unsigned& nloc, unsigned& nx) {
    const unsigned G = gridDim.x * gridDim.y * gridDim.z;
    unsigned sum, cnt, mine, sp = 0u;
    for (;;) {
        sum = 0u; cnt = 0u; mine = 0u;
#pragma unroll
        for (unsigned j = 0; j < 16; ++j) { const unsigned c = xb_ld(&bar[XB_XCNT(j)]); sum += c; cnt += (c > 0u) ? 1u : 0u; mine = (j == x) ? c : mine; }
        if (sum == G) break;
        __builtin_amdgcn_s_sleep(1);
        if ((++sp & 255u) == 0u) { if (xb_ld(&bar[XB_TMO])) break; if (sp > XB_SPIN_CAP) { atomicAdd(&bar[XB_TMO], 1u); break; } }
    }
    nloc = mine > 0u ? mine : 1u; nx = cnt > 0u ? cnt : 1u;
}

__device__ __forceinline__ void xcd_barrier(const XcdBarrier& b) {
    asm volatile("s_waitcnt vmcnt(0)" ::: "memory");
    __syncthreads();
    if (b.wave == 0 && hw_lane() == 0) {
        unsigned* bar = b.bar;
        __builtin_amdgcn_s_waitcnt(0);
        unsigned nloc = b.st[0], nx = b.st[1];
        if (nloc == 0u) { xcd_barrier_complete(bar, b.x, nloc, nx); b.st[0] = nloc; b.st[1] = nx; }
        const unsigned old = xb_add(&bar[XB_XSUB(b.x)], 1u);
        const unsigned gen = old / nloc;
        if (old + 1u == (gen + 1u) * nloc) {
            __builtin_amdgcn_fence(__ATOMIC_RELEASE, "agent");
            asm volatile("s_waitcnt vmcnt(0)" ::: "memory");
            const unsigned og = xb_add(&bar[XB_TOP], 1u);
            const unsigned tg = og / nx;
            if (og + 1u == (tg + 1u) * nx) xb_add(&bar[XB_TOPGEN], 1u);
            else XB_SPIN(xb_ld(&bar[XB_TOPGEN]) == tg, bar);
            __builtin_amdgcn_fence(__ATOMIC_ACQUIRE, "agent");
            xb_add(&bar[XB_XGEN(b.x)], 1u);
            asm volatile("s_waitcnt vmcnt(0)" ::: "memory");
        } else {
            XB_SPIN(xb_ld(&bar[XB_XGEN(b.x)]) == gen, bar);
            __builtin_amdgcn_fence(__ATOMIC_ACQUIRE, "agent");
            asm volatile("s_waitcnt vmcnt(0)" ::: "memory");
        }
    }
    __syncthreads();
}

__device__ __forceinline__ void xcd_barrier_local(const XcdBarrier& b) {
    asm volatile("s_waitcnt vmcnt(0)" ::: "memory");
    __syncthreads();
    if (b.wave == 0 && hw_lane() == 0) {
        unsigned* bar = b.bar;
        __builtin_amdgcn_s_waitcnt(0);
        const unsigned nloc = b.st[0] ? b.st[0] : 1u;
        const unsigned old = xb_add(&bar[XB_XSUB(b.x)], 1u);
        const unsigned gen = old / nloc;
        if (old + 1u == (gen + 1u) * nloc) xb_add(&bar[XB_XGEN(b.x)], 1u);
        else XB_SPIN(xb_ld(&bar[XB_XGEN(b.x)]) == gen, bar);
        __builtin_amdgcn_fence(__ATOMIC_ACQUIRE, "agent");
        asm volatile("s_waitcnt vmcnt(0)" ::: "memory");
    }
    __syncthreads();
}

typedef const float* fptr_t;
typedef __attribute__((address_space(4))) const fptr_t* in_tab_t;
struct Frame {
    LAS unsigned char* lds;
    int tid, lane, wave, G, bx, vid, xq, rk, rw;
    in_tab_t in;
    float* out;
    unsigned char* ws;
};
__device__ __forceinline__ unsigned long long uni64(unsigned long long v) { const unsigned lo = __builtin_amdgcn_readfirstlane((unsigned)v), hi = __builtin_amdgcn_readfirstlane((unsigned)(v >> 32)); return ((unsigned long long)hi << 32) | lo; }
__device__ __forceinline__ Frame launder(const Frame& F0) {
    Frame F = F0;
    int wv_ = __builtin_amdgcn_readfirstlane(F0.wave);
    int ln_ = hw_lane();
    int g_ = __builtin_amdgcn_readfirstlane(F0.G), b_ = __builtin_amdgcn_readfirstlane(F0.bx), v_ = __builtin_amdgcn_readfirstlane(F0.vid);
    unsigned long long w_ = uni64((unsigned long long)F0.ws), o_ = uni64((unsigned long long)F0.out), i_ = uni64((unsigned long long)F0.in);
    asm volatile("" : "+v"(ln_), "+s"(wv_), "+s"(g_), "+s"(b_), "+s"(v_), "+s"(w_), "+s"(o_), "+s"(i_));
    F.tid = (wv_ << 6) | ln_; F.G = g_; F.bx = b_; F.vid = v_; F.xq = b_ & 7; F.rk = b_ >> 3; F.rw = (g_ - (b_ & 7) + 7) >> 3; F.ws = (unsigned char*)(GAS unsigned char*)w_; F.out = (float*)(GAS float*)o_; F.in = (in_tab_t)i_;
    F.lane = ln_; F.wave = wv_;
    return F;
}
#define FIN(k) ((const float*)(const GAS float*)(F.in[k]))


__device__ __forceinline__ float shx(float v, int mask, int lane) { return __builtin_bit_cast(float, __builtin_amdgcn_ds_bpermute((lane ^ mask) << 2, __builtin_bit_cast(int, v))); }
__device__ __forceinline__ float wave_sum(float v, int lane) {
#pragma unroll
    for (int o = 1; o < 64; o <<= 1) v += shx(v, o, lane);
    return v;
}
__device__ __forceinline__ float silu_f(float x) { return x * __builtin_amdgcn_rcpf(1.f + __builtin_amdgcn_exp2f(-1.4426950408889634f * x)); }
__device__ __forceinline__ f32x4 silu4(f32x4 v) { return (f32x4){silu_f(v[0]), silu_f(v[1]), silu_f(v[2]), silu_f(v[3])}; }
__device__ __forceinline__ float dot4(f32x4 a, f32x4 b) { return (a[0] * b[0] + a[1] * b[1]) + (a[2] * b[2] + a[3] * b[3]); }
__device__ __forceinline__ u32x4 pack8(f32x4 a, f32x4 b) { u32x4 w; w.x = cvt_pk_bf16(a[0], a[1]); w.y = cvt_pk_bf16(a[2], a[3]); w.z = cvt_pk_bf16(b[0], b[1]); w.w = cvt_pk_bf16(b[2], b[3]); return w; }
__device__ __forceinline__ u32x2 pack4(f32x4 a) { u32x2 w; w.x = cvt_pk_bf16(a[0], a[1]); w.y = cvt_pk_bf16(a[2], a[3]); return w; }
__device__ __forceinline__ float bflo(unsigned w) { return __uint_as_float(w << 16); }
__device__ __forceinline__ float bfhi(unsigned w) { return __uint_as_float(w & 0xffff0000u); }
__device__ __forceinline__ void unpack8(u32x4 w, f32x4& a, f32x4& b) { a = (f32x4){bflo(w.x), bfhi(w.x), bflo(w.y), bfhi(w.y)}; b = (f32x4){bflo(w.z), bfhi(w.z), bflo(w.w), bfhi(w.w)}; }
__device__ __forceinline__ f32x4 unpack4(u32x2 w) { return (f32x4){bflo(w.x), bfhi(w.x), bflo(w.y), bfhi(w.y)}; }
__device__ __forceinline__ float rstd16(const float* p) {
    const f32x4 a = ((const f32x4*)p)[0], b = ((const f32x4*)p)[1], c = ((const f32x4*)p)[2], d = ((const f32x4*)p)[3];
    const f32x4 s = (a + b) + (c + d);
    return rsqrtf(((s[0] + s[1]) + (s[2] + s[3])) * (1.0f / D) + EPS);
}
__device__ __forceinline__ float rstd32(const float* p) {
    f32x4 s = ((const f32x4*)p)[0];
#pragma unroll
    for (int i = 1; i < 8; ++i) s += ((const f32x4*)p)[i];
    return rsqrtf(((s[0] + s[1]) + (s[2] + s[3])) * (1.0f / D) + EPS);
}
__host__ __device__ __forceinline__ int src_even(int n) {
    const int tile = n >> 8, o = n & 255;
    if (tile < 8) return n;
    if (tile < 12) return 3072 + (n - 2048);
    const int cb = tile - 12;
    return o < 128 ? 2048 + 128 * cb + o : 4096 + 128 * cb + (o - 128);
}
__host__ __device__ __forceinline__ int src_odd(int n) {
    const int pn = n >> 8, p = n & 255, q = ((p >> 7) << 1) | ((p >> 2) & 1), ch = 64 * pn + 16 * ((p >> 5) & 3) + 4 * ((p >> 3) & 3) + (p & 3);
    const int base = q == 0 ? 2048 : (q == 1 ? 4096 : (q == 2 ? 0 : 6144));
    return base + ch;
}

__device__ __forceinline__ void rstd_table(const float* rsq, int pm, LAS float* tab, int tid) {
    if (tid < 256) tab[tid] = rstd16(rsq + ((size_t)pm * 256 + tid) * 16);
    LDS_BARRIER();
}
struct EpiG1Even {
    static constexpr bool PERM = true, AFTER_DRAIN = false, REP_EPI = (REP_MASK >> 12) & 1;
    const float* rsq; bf16_t* Z; float* vsq; float* pool_out; LAS const float* rtab; int pm0;
    __device__ __forceinline__ void operator()(const f32x4 (&acc)[2][2][4][2], const Unit& u, int wr, int wc, int fr_, int fq_) const {
        int fr = fr_, fq = fq_; asm volatile("" : "+v"(fr), "+v"(fq));
        const int tile = u.pn, cw = wc * 32 + 8 * fq;
#pragma unroll
        for (int ai = 0; ai < 2; ++ai)
#pragma unroll
            for (int m = 0; m < 4; ++m) {
                const int row = u.pm * 256 + ai * 128 + wr * 64 + m * 16 + fr;
                const float rs = u.pm == pm0 ? rtab[ai * 128 + wr * 64 + m * 16 + fr] : rstd16(rsq + (size_t)row * 16);
                if (tile < 12) {
                    const int kind = tile >> 2;
                    bf16_t* dst = Z + (size_t)kind * MP * D + (size_t)row * D + (tile & 3) * 256 + cw;
                    float ss = 0.f;
#pragma unroll
                    for (int bj = 0; bj < 2; ++bj) {
                        f32x4 v0 = acc[ai][bj][m][0] * rs, v1 = acc[ai][bj][m][1] * rs;
                        if (kind == 1) { v0 = silu4(v0); v1 = silu4(v1); }
                        if (kind == 2) ss += dot4(v0, v0) + dot4(v1, v1);
                        *(u32x4*)(dst + bj * 128) = pack8(v0, v1);
                        if (kind == 0 && (row & 2047) >= 2033) {
                            float* po = pool_out + ((size_t)(row >> 11) * 15 + ((row & 2047) - 2033)) * 1024 + (tile & 3) * 256 + bj * 128 + cw;
                            *(f32x4*)po = v0; *(f32x4*)(po + 4) = v1;
                        }
                    }
                    if (kind == 2) { ss += shx(ss, 16, 16 * fq + fr); ss += shx(ss, 32, 16 * fq + fr); if (fq == 0) vsq[(size_t)row * 16 + (tile - 8) * 4 + wc] = ss; }
                } else {
                    const int cb = tile - 12;
                    bf16_t* dst = Z + (size_t)3 * MP * D + (size_t)row * D + cb * 128 + cw;
                    const f32x4 u0 = acc[ai][0][m][0] * rs, u1 = acc[ai][0][m][1] * rs, g0 = acc[ai][1][m][0] * rs, g1 = acc[ai][1][m][1] * rs;
                    *(u32x4*)dst = pack8(u0 * silu4(g0), u1 * silu4(g1));
                }
            }
    }
};
__device__ __forceinline__ float dpp_shr1(float old, float v) { return __builtin_bit_cast(float, __builtin_amdgcn_update_dpp(__builtin_bit_cast(int, old), __builtin_bit_cast(int, v), 0x111, 0xf, 0xf, false)); }
__device__ __forceinline__ float dpp_shr2(float old, float v) { return __builtin_bit_cast(float, __builtin_amdgcn_update_dpp(__builtin_bit_cast(int, old), __builtin_bit_cast(int, v), 0x112, 0xf, 0xf, false)); }
struct EpiG1Odd {
    static constexpr bool PERM = true, AFTER_DRAIN = false, REP_EPI = false;
    const float* rsq; bf16_t* A2; const float* cw; float* conv_out; float* side; LAS float* halo; LAS const float* rtab; int pm0; LAS const float* cwl; int pn0;
    __device__ __forceinline__ void operator()(const f32x4 (&acc)[2][2][4][2], const Unit& u, int wr, int wc, int fr_, int fq_) const {
        int fr = fr_, fq = fq_; asm volatile("" : "+v"(fr), "+v"(fq));
        const int chl = wc * 16 + 4 * fq, ch = u.pn * 64 + chl;
        f32x4 w0, w1, w2;
        { const int ui = (u.pn - pn0) >> 2;
          if (u.pm == pm0 && ui >= 0 && ui < 8 && ((u.pn - pn0) & 3) == 0) { w0 = *(const LAS f32x4*)(cwl + (ui * 3 + 0) * 64 + chl); w1 = *(const LAS f32x4*)(cwl + (ui * 3 + 1) * 64 + chl); w2 = *(const LAS f32x4*)(cwl + (ui * 3 + 2) * 64 + chl); }
          else { w0 = *(const f32x4*)(cw + ch); w1 = *(const f32x4*)(cw + 2048 + ch); w2 = *(const f32x4*)(cw + 4096 + ch); } }
        f32x4 e[2][4]; float rsv[2][4];
#pragma unroll
        for (int ai = 0; ai < 2; ++ai)
#pragma unroll
            for (int m = 0; m < 4; ++m) {
                const int rb = 8 * ai + 4 * wr + m, row = u.pm * 256 + 16 * rb + fr;
                const float rs = u.pm == pm0 ? rtab[16 * rb + fr] : rstd16(rsq + (size_t)row * 16); rsv[ai][m] = rs;
                e[ai][m] = (acc[ai][0][m][0] * rs) * (acc[ai][0][m][1] * rs);
                if (fr >= 14) *(LAS f32x4*)(halo + (rb * 2 + (fr - 14)) * 64 + chl) = e[ai][m];
                if (m & 1) asm volatile("" ::: "memory");
            }
        asm volatile("s_waitcnt lgkmcnt(0)" ::: "memory"); __builtin_amdgcn_s_barrier(); asm volatile("" ::: "memory");
        float* sd = side + (size_t)u.pm * 6 * 2048 + ch;
#pragma unroll
        for (int ai = 0; ai < 2; ++ai)
#pragma unroll
            for (int m = 0; m < 4; ++m) {
                const int rb = 8 * ai + 4 * wr + m, row = u.pm * 256 + 16 * rb + fr;
                const float rs = rsv[ai][m];
                const f32x4 sg = (acc[ai][1][m][0] * rs) * silu4(acc[ai][1][m][1] * rs);
                f32x4 h0 = (f32x4){0.f, 0.f, 0.f, 0.f}, h1 = h0;
                if (rb > 0) { h0 = *(const LAS f32x4*)(halo + ((rb - 1) * 2 + 0) * 64 + chl); h1 = *(const LAS f32x4*)(halo + ((rb - 1) * 2 + 1) * 64 + chl); }
                const f32x4 hx = fr == 0 ? h0 : h1, ev = e[ai][m];
                f32x4 e1, e2;
#pragma unroll
                for (int k = 0; k < 4; ++k) { e1[k] = dpp_shr1(h1[k], ev[k]); e2[k] = dpp_shr2(hx[k], ev[k]); }
                const f32x4 a = sg * (w0 * e2 + w1 * e1 + w2 * ev);
                const bool top = (rb == 0 && fr < 2);
                if (!(top && (u.pm & 7) != 0)) *(u32x2*)(A2 + (size_t)row * 2048 + ch) = pack4(a);
                if (top) { *(f32x4*)(sd + fr * 2048) = ev; *(f32x4*)(sd + (4 + fr) * 2048) = sg; }
                if (rb == 15 && fr >= 14) {
                    *(f32x4*)(sd + (2 + fr - 14) * 2048) = ev;
                    if ((u.pm & 7) == 7) *(f32x4*)(conv_out + ((size_t)(u.pm >> 3) * 2 + (fr - 14)) * 2048 + ch) = ev;
                }
            }
    }
};
__device__ __forceinline__ void conv_fixup(const float* side, const float* cw, bf16_t* A2, int pm, int tid) {
    if ((pm & 7) == 0) return;
    const int ch = 4 * tid;
    const float* sp = side + (size_t)(pm - 1) * 6 * 2048 + ch; const float* sc = side + (size_t)pm * 6 * 2048 + ch;
    const f32x4 em2 = *(const f32x4*)(sp + 2 * 2048), em1 = *(const f32x4*)(sp + 3 * 2048), e0 = *(const f32x4*)sc, e1 = *(const f32x4*)(sc + 2048), s0 = *(const f32x4*)(sc + 4 * 2048), s1 = *(const f32x4*)(sc + 5 * 2048);
    const f32x4 w0 = *(const f32x4*)(cw + ch), w1 = *(const f32x4*)(cw + 2048 + ch), w2 = *(const f32x4*)(cw + 4096 + ch);
    *(u32x2*)(A2 + (size_t)(pm * 256) * 2048 + ch) = pack4(s0 * (w0 * em2 + w1 * em1 + w2 * e0));
    *(u32x2*)(A2 + (size_t)(pm * 256 + 1) * 2048 + ch) = pack4(s1 * (w0 * em1 + w1 * e0 + w2 * e1));
}
struct EpiRes {
    static constexpr bool PERM = true, AFTER_DRAIN = false, REP_EPI = false;
    bf16_t* xb; float* rsq;
    __device__ __forceinline__ void operator()(const f32x4 (&acc)[2][2][4][2], const Unit& u, int wr, int wc, int fr_, int fq_) const {
        int fr = fr_, fq = fq_; asm volatile("" : "+v"(fr), "+v"(fq));
        const int cw = wc * 32 + 8 * fq;
#pragma unroll
        for (int ai = 0; ai < 2; ++ai) {
            u32x4 old[4][2];
#pragma unroll
            for (int m = 0; m < 4; ++m)
#pragma unroll
                for (int bj = 0; bj < 2; ++bj) old[m][bj] = *(const u32x4*)(xb + (size_t)(u.pm * 256 + ai * 128 + wr * 64 + m * 16 + fr) * D + u.pn * 256 + bj * 128 + cw);
#pragma unroll
            for (int m = 0; m < 4; ++m) {
                const int row = u.pm * 256 + ai * 128 + wr * 64 + m * 16 + fr;
                float ss = 0.f;
#pragma unroll
                for (int bj = 0; bj < 2; ++bj) {
                    f32x4 b0, b1; unpack8(old[m][bj], b0, b1);
                    const u32x4 wv = pack8(b0 + acc[ai][bj][m][0], b1 + acc[ai][bj][m][1]);
                    *(u32x4*)(xb + (size_t)row * D + u.pn * 256 + bj * 128 + cw) = wv;
                    f32x4 r0, r1; unpack8(wv, r0, r1);
                    ss += dot4(r0, r0) + dot4(r1, r1);
                }
                ss += shx(ss, 16, 16 * fq + fr); ss += shx(ss, 32, 16 * fq + fr);
                if (fq == 0) rsq[(size_t)row * 16 + u.pn * 4 + wc] = ss;
            }
        }
    }
};
struct EpiProbe {
    static constexpr bool PERM = true, AFTER_DRAIN = false, REP_EPI = false;
    bf16_t* O; int ldc;
    __device__ __forceinline__ void operator()(const f32x4 (&acc)[2][2][4][2], const Unit& u, int wr, int wc, int fr_, int fq_) const {
        int fr = fr_, fq = fq_; asm volatile("" : "+v"(fr), "+v"(fq));
        const int cw = wc * 32 + 8 * fq;
#pragma unroll
        for (int ai = 0; ai < 2; ++ai)
#pragma unroll
            for (int m = 0; m < 4; ++m) {
                const int row = u.pm * 256 + ai * 128 + wr * 64 + m * 16 + fr;
#pragma unroll
                for (int bj = 0; bj < 2; ++bj) *(u32x4*)(O + (size_t)row * ldc + u.pn * 256 + bj * 128 + cw) = pack8(acc[ai][bj][m][0], acc[ai][bj][m][1]);
            }
    }
};
struct EpiQ {
    static constexpr bool PERM = true, AFTER_DRAIN = false, REP_EPI = false;
    const float* rsq; bf16_t* Q; LAS const float* rtab; int pm0;
    __device__ __forceinline__ void operator()(const f32x4 (&acc)[2][2][4][2], const Unit& u, int wr, int wc, int fr_, int fq_) const {
        int fr = fr_, fq = fq_; asm volatile("" : "+v"(fr), "+v"(fq));
        const int cw = wc * 32 + 8 * fq;
#pragma unroll
        for (int ai = 0; ai < 2; ++ai)
#pragma unroll
            for (int m = 0; m < 4; ++m) {
                const int row = u.pm * 256 + ai * 128 + wr * 64 + m * 16 + fr;
                const float rs = u.pm == pm0 ? rtab[ai * 128 + wr * 64 + m * 16 + fr] : rstd16(rsq + (size_t)row * 16);
#pragma unroll
                for (int bj = 0; bj < 2; ++bj) *(u32x4*)(Q + (size_t)row * D + u.pn * 256 + bj * 128 + cw) = pack8(acc[ai][bj][m][0] * rs, acc[ai][bj][m][1] * rs);
            }
    }
};
struct EpiMemKV {
    static constexpr bool PERM = true, AFTER_DRAIN = false, REP_EPI = false;
    const float* rstdm; float* outk; float* outv; bf16_t* kb; bf16_t* vb;
    __device__ __forceinline__ void operator()(const f32x4 (&acc)[2][2][4][2], const Unit& u, int wr, int wc, int fr_, int fq_) const {
        int fr = fr_, fq = fq_; asm volatile("" : "+v"(fr), "+v"(fq));
        const int layer = u.pn >> 3, isv = (u.pn >> 2) & 1, cw = (u.pn & 3) * 256 + wc * 32 + 8 * fq;
        float* of = (isv ? outv : outk) + (size_t)layer * MMEM * D; bf16_t* ob = (isv ? vb : kb) + (size_t)layer * MMEM * D;
#pragma unroll
        for (int ai = 0; ai < 2; ++ai)
#pragma unroll
            for (int m = 0; m < 4; ++m) {
                const int row = u.pm * 256 + ai * 128 + wr * 64 + m * 16 + fr;
                const float rs = rstdm[row];
#pragma unroll
                for (int bj = 0; bj < 2; ++bj) {
                    const size_t off = (size_t)row * D + bj * 128 + cw;
                    const f32x4 v0 = acc[ai][bj][m][0] * rs, v1 = acc[ai][bj][m][1] * rs;
                    *(f32x4*)(of + off) = v0; *(f32x4*)(of + off + 4) = v1;
                    *(u32x4*)(ob + off) = pack8(v0, v1);
                }
            }
    }
};

struct TrItem { const float* wp; int ldw; const float* gk; float sc; bf16_t* wt; int K; };
__device__ __forceinline__ void p0_tr_desc(const float* W, int ldw, int K, int Nd, const float* gk, float sc, bf16_t* WT, int perm, int r, int lane, TrItem& t) {
    const int nblk = Nd / 32, kb = r / nblk, nb = r % nblk, dstn0 = 32 * nb, dn = dstn0 + (lane & 31);
    const int srccol = perm == 0 ? dn : (perm == 1 ? src_even(dn) : src_odd(dn));
    t.wp = W + (size_t)(64 * kb + (lane >> 5)) * ldw + srccol; t.ldw = ldw; t.gk = gk ? gk + 64 * kb : nullptr; t.sc = sc; t.wt = WT + (size_t)dstn0 * K + 64 * kb; t.K = K;
}
__device__ __forceinline__ void p0_resolve(Frame& F, int it, int lane, TrItem& t) {
    constexpr int I_AB1 = 16 * (NAB / 32), I_C1 = 16 * (NC / 32), I_2 = 32 * 32, I_SQ = 16 * 32, I_PM = 4 * 8;
    int r = it;
    if (r < 2 * I_AB1) { const int jj = r / I_AB1; p0_tr_desc(FIN(10) + (size_t)jj * D * NAB, NAB, D, NAB, FIN(7) + 2 * jj * D, 1.f, ((bf16_t*)(F.ws + WS_AB1)) + (size_t)jj * NAB * D, 1, r % I_AB1, lane, t); return; } r -= 2 * I_AB1;
    if (r < 2 * I_C1) { const int jj = r / I_C1; p0_tr_desc(FIN(17) + (size_t)jj * D * NC, NC, D, NC, FIN(7) + (2 * jj + 1) * D, 1.f, ((bf16_t*)(F.ws + WS_C1)) + (size_t)jj * NC * D, 2, r % I_C1, lane, t); return; } r -= 2 * I_C1;
    if (r < 2 * I_2) { const int jj = r / I_2; p0_tr_desc(FIN(16) + (size_t)jj * 2048 * D, D, 2048, D, nullptr, 1.f, ((bf16_t*)(F.ws + WS_AB2)) + (size_t)jj * D * 2048, 0, r % I_2, lane, t); return; } r -= 2 * I_2;
    if (r < 2 * I_2) { const int jj = r / I_2; p0_tr_desc(FIN(19) + (size_t)jj * 2048 * D, D, 2048, D, nullptr, 1.f, ((bf16_t*)(F.ws + WS_C2)) + (size_t)jj * D * 2048, 0, r % I_2, lane, t); return; } r -= 2 * I_2;
    if (r < 4 * I_SQ) { const int l = r / I_SQ; p0_tr_desc(FIN(20) + (size_t)l * D * D, D, D, D, FIN(8) + l * D, QSCALE, ((bf16_t*)(F.ws + WS_WQ)) + (size_t)l * D * D, 0, r % I_SQ, lane, t); return; } r -= 4 * I_SQ;
    if (r < 4 * I_SQ) { const int l = r / I_SQ; p0_tr_desc(FIN(21) + (size_t)l * D * D, D, D, D, FIN(9) + l * D, 1.f, ((bf16_t*)(F.ws + WS_WKV)) + (size_t)(2 * l) * D * D, 0, r % I_SQ, lane, t); return; } r -= 4 * I_SQ;
    if (r < 4 * I_SQ) { const int l = r / I_SQ; p0_tr_desc(FIN(22) + (size_t)l * D * D, D, D, D, FIN(9) + l * D, 1.f, ((bf16_t*)(F.ws + WS_WKV)) + (size_t)(2 * l + 1) * D * D, 0, r % I_SQ, lane, t); return; } r -= 4 * I_SQ;
    if (r < 4 * I_SQ) { const int l = r / I_SQ; p0_tr_desc(FIN(23) + (size_t)l * D * D, D, D, D, nullptr, 1.f, ((bf16_t*)(F.ws + WS_WO)) + (size_t)l * D * D, 0, r % I_SQ, lane, t); return; } r -= 4 * I_SQ;
    { const int jg = r / I_PM; p0_tr_desc(FIN(11) + (size_t)jg * 65536, 256, 256, 256, nullptr, 1.f, ((bf16_t*)(F.ws + WS_PMT)) + (size_t)jg * 65536, 0, r % I_PM, lane, t); }
}
__device__ __forceinline__ void p0_tr_load(const TrItem& t, int lane, float (&v)[32], f32x4& g0, f32x4& g1) {
    const int c = lane & 7;
    g0 = (f32x4){t.sc, t.sc, t.sc, t.sc}; g1 = g0;
    if (t.gk) { g0 = *(const f32x4*)(t.gk + 8 * c) * t.sc; g1 = *(const f32x4*)(t.gk + 8 * c + 4) * t.sc; }
#pragma unroll
    for (int i = 0; i < 32; ++i) v[i] = t.wp[(size_t)(2 * i) * t.ldw];
}
__device__ __forceinline__ void p0_tr_finish(const TrItem& t, int lane, const float (&v)[32], f32x4 g0, f32x4 g1, LAS float* scr) {
#pragma unroll
    for (int i = 0; i < 32; ++i) scr[(2 * i + (lane >> 5)) * 33 + (lane & 31)] = v[i];
    LDS_WAIT(); asm volatile("" ::: "memory");
    const int c = lane & 7;
#pragma unroll
    for (int jj = 0; jj < 4; ++jj) {
        const int n = (lane >> 3) + 8 * jj; const LAS float* s = scr + (8 * c) * 33 + n;
        u32x4 o; o.x = cvt_pk_bf16(s[0 * 33] * g0[0], s[1 * 33] * g0[1]); o.y = cvt_pk_bf16(s[2 * 33] * g0[2], s[3 * 33] * g0[3]); o.z = cvt_pk_bf16(s[4 * 33] * g1[0], s[5 * 33] * g1[1]); o.w = cvt_pk_bf16(s[6 * 33] * g1[2], s[7 * 33] * g1[3]);
        *(u32x4*)(t.wt + (size_t)n * t.K + 8 * c) = o;
    }
    LDS_WAIT(); asm volatile("" ::: "memory");
}
__device__ __forceinline__ float p0_row_finish(const f32x4 (&v)[4], bf16_t* dst, float* copy, int lane) {
    float s = 0.f;
#pragma unroll
    for (int jj = 0; jj < 4; ++jj) s += dot4(v[jj], v[jj]);
    s = wave_sum(s, lane);
    u32x2* o8 = (u32x2*)dst + lane;
#pragma unroll
    for (int jj = 0; jj < 4; ++jj) o8[64 * jj] = pack4(v[jj]);
    if (copy) {
#pragma unroll
        for (int jj = 0; jj < 4; ++jj) ((f32x4*)copy + lane)[64 * jj] = v[jj];
    }
    return s;
}
namespace p0seg {
constexpr int I_AB1 = 16 * (NAB / 32), I_C1 = 16 * (NC / 32), I_2 = 32 * 32, I_SQ = 16 * 32, I_PM = 4 * 8;
constexpr int O_AB1 = 0, O_C1 = 2 * I_AB1, O_AB2 = O_C1 + 2 * I_C1, O_C2 = O_AB2 + 2 * I_2, O_Q = O_C2 + 2 * I_2, O_K = O_Q + 4 * I_SQ, O_V = O_K + 4 * I_SQ, O_O = O_V + 4 * I_SQ, O_P = O_O + 4 * I_SQ, NITEMS = O_P + 8 * I_PM;
constexpr int NA = I_AB1 + I_2 + I_SQ + 8 * I_SQ + I_SQ + 4 * I_PM, NB = NITEMS - NA;
__device__ __forceinline__ int item_a(int i) {
    if (i < I_AB1) return O_AB1 + i; i -= I_AB1;
    if (i < I_2) return O_AB2 + i; i -= I_2;
    if (i < I_SQ) return O_Q + i; i -= I_SQ;
    if (i < 8 * I_SQ) return O_K + i; i -= 8 * I_SQ;
    if (i < I_SQ) return O_O + i; i -= I_SQ;
    return O_P + i;
}
__device__ __forceinline__ int item_b(int i) {
    if (i < I_AB1) return O_AB1 + I_AB1 + i; i -= I_AB1;
    if (i < 2 * I_C1) return O_C1 + i; i -= 2 * I_C1;
    if (i < I_2) return O_AB2 + I_2 + i; i -= I_2;
    if (i < 2 * I_2) return O_C2 + i; i -= 2 * I_2;
    if (i < 3 * I_SQ) return O_Q + I_SQ + i; i -= 3 * I_SQ;
    if (i < 3 * I_SQ) return O_O + I_SQ + i; i -= 3 * I_SQ;
    return O_P + 4 * I_PM + i;
}
}
__device__ __forceinline__ void p0_weights(Frame& F0, int part, int gw, int NGW, int half = -1) {
    Frame F = launder(F0);
    LAS float* scr = (LAS float*)(F.lds + F.wave * 16384);
    const int lane = F.lane;
    constexpr int NB_ODD = (int)((long)p0seg::NB * PB_ODD_PCT / 100);
    const int base = (part == 1 && half == 0) ? NB_ODD : 0;
    const int n = part == 0 ? p0seg::NA : (part == 1 ? (half == 1 ? NB_ODD : (half == 0 ? p0seg::NB - NB_ODD : p0seg::NB)) : p0seg::NITEMS);
#define P0_ITEM(i_) (part == 0 ? p0seg::item_a(i_) : (part == 1 ? p0seg::item_b(base + (i_)) : (i_)))
    if (gw < n) {
        TrItem cur, nxt; float va[32], vb[32]; f32x4 ga0, ga1, gb0, gb1;
        p0_resolve(F, P0_ITEM(gw), lane, cur); p0_tr_load(cur, lane, va, ga0, ga1);
        for (int it = gw; it < n; it += 2 * NGW) {
            const bool h1 = it + NGW < n, h2 = it + 2 * NGW < n;
            if (h1) { p0_resolve(F, P0_ITEM(it + NGW), lane, nxt); p0_tr_load(nxt, lane, vb, gb0, gb1); }
            p0_tr_finish(cur, lane, va, ga0, ga1, scr);
            if (h2) { p0_resolve(F, P0_ITEM(it + 2 * NGW), lane, cur); p0_tr_load(cur, lane, va, ga0, ga1); }
            if (h1) p0_tr_finish(nxt, lane, vb, gb0, gb1, scr);
        }
    }
#undef P0_ITEM
}
__device__ __forceinline__ void p0_prologue(Frame& F0) {
    Frame F = launder(F0);
    const int gw = F.bx * NWAVES + F.wave, NGW = F.G * NWAVES, lane = F.lane;
    p0_weights(F0, (!MK_SPLIT && SPLIT_PROLOGUE) ? 0 : 2, gw, NGW);
    for (int m0 = 2 * gw; m0 < MP + MS + MMEM; m0 += 2 * NGW) {
        f32x4 v[2][4];
#pragma unroll
        for (int r = 0; r < 2; ++r) {
            const int m = m0 + r;
            const float* src = m < MP ? FIN(0) + (size_t)m * D : (m < MP + MS ? FIN(1) + (size_t)(m - MP) * D : FIN(2) + (size_t)(m - MP - MS) * D);
#pragma unroll
            for (int jj = 0; jj < 4; ++jj) v[r][jj] = ((const f32x4*)src + lane)[64 * jj];
        }
#pragma unroll
        for (int r = 0; r < 2; ++r) {
            const int m = m0 + r;
            if (m < MP) {
                const float s = p0_row_finish(v[r], ((bf16_t*)(F.ws + WS_XB)) + (size_t)m * D, nullptr, lane);
                if (lane < 16) ((float*)(F.ws + WS_RSQ))[(size_t)m * 16 + lane] = lane == 0 ? s : 0.f;
            } else if (m < MP + MS) {
                const int b = m - MP;
                const float s = p0_row_finish(v[r], ((bf16_t*)(F.ws + WS_XB)) + (size_t)m * D, ((float*)(F.ws + WS_XS)) + (size_t)b * D, lane);
                if (lane < 32) ((float*)(F.ws + WS_SMALL))[b * 32 + lane] = lane == 0 ? s : 0.f;
            } else {
                const int t = m - MP - MS;
                const float s = p0_row_finish(v[r], ((bf16_t*)(F.ws + WS_MEMB)) + (size_t)t * D, nullptr, lane);
                if (lane == 0) ((float*)(F.ws + WS_SMALL + 65536))[t] = rsqrtf(s * (1.0f / D) + EPS);
            }
        }
    }
}

__device__ __forceinline__ bf16x8 tr_frag(LAS unsigned char* p0, LAS unsigned char* p1) {
    const s16x4 lo = __builtin_amdgcn_ds_read_tr16_b64_v4i16((LAS s16x4*)p0);
    const s16x4 hi = __builtin_amdgcn_ds_read_tr16_b64_v4i16((LAS s16x4*)p1);
    return (bf16x8){lo[0], lo[1], lo[2], lo[3], hi[0], hi[1], hi[2], hi[3]};
}
#define MFMA16(a, b, c) __builtin_amdgcn_mfma_f32_16x16x32_bf16((a), (b), (c), 0, 0, 0)

constexpr int SGU_AS = 0, SGU_VS = 36864, SGU_RV = 36864 + 69632;
__device__ __forceinline__ void sgu_chunk(Frame& F0, int j, int n) {
    Frame F = launder(F0);
    LAS unsigned char* lds = F.lds;
    const int tid = F.tid, lane = F.lane, w = F.wave, fr = lane & 15, fq = lane >> 4, row0 = n * 128;
    LAS float* rvs = (LAS float*)(lds + SGU_RV);
    if (tid < 128) rvs[tid] = rstd16(((float*)(F.ws + WS_VSQ)) + (size_t)(row0 + tid) * 16);
    const bf16_t* ZV = ((bf16_t*)(F.ws + WS_Z)) + (size_t)2 * MP * D + (size_t)row0 * D;
    const bf16_t* ZUG = ((bf16_t*)(F.ws + WS_Z)) + (size_t)3 * MP * D + (size_t)row0 * D;
    bf16_t* A2 = ((bf16_t*)(F.ws + WS_A2)) + (size_t)row0 * 2048 + 1024;
    const unsigned voff = (unsigned)(tid >> 5) * (D * 2) + (unsigned)(tid & 31) * 16u;
    const unsigned woff = (unsigned)(tid >> 4) * 512u + (unsigned)(tid & 15) * 32u;
    const int wt_t = tid >> 4, wt_s0 = (tid & 15) * 8;
    const unsigned aoff = (unsigned)(tid >> 5) * 4096u + (unsigned)(tid & 31) * 16u;
    u32x4 vt[8]; f32x4 wt[8];
#define SGU_LOAD(g_) do { const char* vb_ = (const char*)(ZV + (g_) * 256); const char* wb_ = (const char*)(FIN(13) + (size_t)(j * 4 + (g_)) * 16384); \
        _Pragma("unroll") for (int i_ = 0; i_ < 8; ++i_) vt[i_] = *(const u32x4*)(vb_ + (size_t)(16 * i_) * D * 2 + voff); \
        _Pragma("unroll") for (int i_ = 0; i_ < 4; ++i_) { wt[2 * i_] = *(const f32x4*)(wb_ + (size_t)(32 * i_) * 512 + woff); wt[2 * i_ + 1] = *(const f32x4*)(wb_ + (size_t)(32 * i_) * 512 + woff + 16); } } while (0)
    SGU_LOAD(0);
    LDS_BARRIER();
#pragma unroll 1
    for (int g = 0; g < 4; ++g) {
#pragma unroll
        for (int i = 0; i < 8; ++i) *(LAS u32x4*)(lds + SGU_VS + ((tid >> 5) + 16 * i) * 544 + (tid & 31) * 16) = vt[i];
#pragma unroll
        for (int i = 0; i < 4; ++i) {
            const int t = wt_t + 32 * i; float v[8];
#pragma unroll
            for (int e = 0; e < 4; ++e) { v[e] = (wt_s0 + e <= t) ? wt[2 * i][e] * rvs[wt_s0 + e] : 0.f; v[4 + e] = (wt_s0 + 4 + e <= t) ? wt[2 * i + 1][e] * rvs[wt_s0 + 4 + e] : 0.f; }
            u32x4 o; o.x = cvt_pk_bf16(v[0], v[1]); o.y = cvt_pk_bf16(v[2], v[3]); o.z = cvt_pk_bf16(v[4], v[5]); o.w = cvt_pk_bf16(v[6], v[7]);
            *(LAS u32x4*)(lds + SGU_AS + t * 288 + wt_s0 * 2) = o;
        }
        LDS_BARRIER();
        if (g < 3) SGU_LOAD(g + 1);
        const int cg = g * 256 + 32 * w + 4 * fq;
        const unsigned lo_in = (unsigned)fr * (D * 2) + (unsigned)(32 * w + 4 * fq) * 2u, lo_out = (unsigned)fr * 4096u + (unsigned)(32 * w + 4 * fq) * 2u;
        u32x2 ugr[2][8];
#pragma unroll
        for (int nt = 0; nt < 2; ++nt)
#pragma unroll
            for (int mt = 0; mt < 8; ++mt) ugr[nt][mt] = *(const u32x2*)((const char*)(ZUG + (size_t)(16 * mt) * D + g * 256 + 16 * nt) + lo_in);
        f32x4 ggv[2]; float bbv[8];
#pragma unroll
        for (int nt = 0; nt < 2; ++nt) ggv[nt] = *(const f32x4*)(FIN(15) + j * 1024 + cg + 16 * nt);
#pragma unroll
        for (int mt = 0; mt < 8; ++mt) bbv[mt] = FIN(14)[(j * 4 + g) * 128 + 16 * mt + fr];
        f32x4 acc[8][2];
#pragma unroll
        for (int mt = 0; mt < 8; ++mt) { acc[mt][0] = (f32x4){0.f, 0.f, 0.f, 0.f}; acc[mt][1] = (f32x4){0.f, 0.f, 0.f, 0.f}; }
#pragma unroll
        for (int ks = 0; ks < 4; ++ks) {
            bf16x8 Bf[2];
#pragma unroll
            for (int nt = 0; nt < 2; ++nt) {
                LAS unsigned char* p = lds + SGU_VS + (32 * ks + 8 * fq + (fr >> 2)) * 544 + (32 * w + 16 * nt + 4 * (fr & 3)) * 2;
                Bf[nt] = tr_frag(p, p + 4 * 544);
            }
            bf16x8 Af[8];
#pragma unroll
            for (int mt = 0; mt < 8; ++mt) if (32 * ks <= 16 * mt + 15) Af[mt] = *(LAS bf16x8*)(lds + SGU_AS + (16 * mt + fr) * 288 + (32 * ks + 8 * fq) * 2);
#pragma unroll
            for (int mt = 0; mt < 8; ++mt) if (32 * ks <= 16 * mt + 15) { acc[mt][0] = MFMA16(Bf[0], Af[mt], acc[mt][0]); acc[mt][1] = MFMA16(Bf[1], Af[mt], acc[mt][1]); }
        }
#pragma unroll
        for (int nt = 0; nt < 2; ++nt) {
            const int c = cg + 16 * nt;
            const f32x4 gg = ggv[nt];
#pragma unroll
            for (int mt = 0; mt < 8; ++mt) {
                const int t = 16 * mt + fr;
                const float bb = bbv[mt];
                *(u32x2*)((char*)(A2 + (size_t)(16 * mt) * 2048 + g * 256 + 16 * nt) + lo_out) = pack4(unpack4(ugr[nt][mt]) * (acc[mt][nt] * gg + bb));
            }
        }
        LDS_BARRIER();
    }
#undef SGU_LOAD
}
template <int WIN> __device__ __forceinline__ void pool_load(const bf16_t* xau  , unsigned lo  , int pos0, u32x4 (&xr)[WIN + 7]) {
#pragma unroll
    for (int i = 0; i < WIN + 7; ++i) { const int rr = i - (WIN - 1); xr[i] = (u32x4){0u, 0u, 0u, 0u}; if (pos0 + rr >= 0) xr[i] = *(const u32x4*)((const char*)(xau + (ptrdiff_t)rr * D) + lo); }
}
template <int WIN> __device__ __forceinline__ void pool_build(const u32x4 (&xr)[WIN + 7], int pos0, LAS unsigned char* dst  ) {
    f32x4 S0 = (f32x4){0.f, 0.f, 0.f, 0.f}, S1 = S0;
#pragma unroll
    for (int i = 0; i < WIN - 1; ++i) { f32x4 a, b; unpack8(xr[i], a, b); S0 += a; S1 += b; }
#pragma unroll
    for (int r = 0; r < 8; ++r) {
        f32x4 a, b; unpack8(xr[WIN - 1 + r], a, b); S0 += a; S1 += b;
        const int cnt = (pos0 + r + 1) < WIN ? (pos0 + r + 1) : WIN; const float ic = 1.0f / (float)cnt;
        *(LAS u32x4*)(dst + r * 544) = pack8(S0 * ic - a, S1 * ic - b);
        f32x4 c, d; unpack8(xr[r], c, d); S0 -= c; S1 -= d;
    }
}
__device__ __forceinline__ void pool_mma_epi(Frame& F, int j, int g, int row0, const bf16_t* ZSGA, bf16_t* A2, LAS unsigned char* lds, int w, int fr, int fq) {
    const int cg = g * 256 + 32 * w + 4 * fq;
    const unsigned lo_in = (unsigned)fr * (D * 2) + (unsigned)(32 * w + 4 * fq) * 2u, lo_out = (unsigned)fr * 4096u + (unsigned)(32 * w + 4 * fq) * 2u, lo_pm = (unsigned)(32 * w + fr) * 512u + (unsigned)fq * 16u;
    u32x2 sgr[2][8];
#pragma unroll
    for (int nt = 0; nt < 2; ++nt)
#pragma unroll
        for (int mt = 0; mt < 8; ++mt) sgr[nt][mt] = *(const u32x2*)((const char*)(ZSGA + (size_t)(16 * mt) * D + g * 256 + 16 * nt) + lo_in);
    f32x4 acc[8][2];
#pragma unroll
    for (int mt = 0; mt < 8; ++mt) { acc[mt][0] = (f32x4){0.f, 0.f, 0.f, 0.f}; acc[mt][1] = (f32x4){0.f, 0.f, 0.f, 0.f}; }
    const bf16_t* pm = ((bf16_t*)(F.ws + WS_PMT)) + (size_t)(j * 4 + g) * 65536;
    bf16x8 Bq[8][2]; f32x4 psv[2];
#pragma unroll
    for (int ks = 0; ks < 8; ++ks) { Bq[ks][0] = *(const bf16x8*)((const char*)(pm + 32 * ks) + lo_pm); Bq[ks][1] = *(const bf16x8*)((const char*)(pm + 16 * 256 + 32 * ks) + lo_pm); }
#pragma unroll
    for (int nt = 0; nt < 2; ++nt) psv[nt] = *(const f32x4*)(FIN(12) + j * 1024 + cg + 16 * nt);
#pragma unroll
    for (int ks = 0; ks < 8; ++ks) {
#pragma unroll
        for (int mh = 0; mh < 2; ++mh) {
            bf16x8 Af[4];
#pragma unroll
            for (int m4 = 0; m4 < 4; ++m4) Af[m4] = *(LAS bf16x8*)(lds + (16 * (4 * mh + m4) + fr) * 544 + (32 * ks + 8 * fq) * 2);
#pragma unroll
            for (int m4 = 0; m4 < 4; ++m4) { const int mt = 4 * mh + m4; acc[mt][0] = MFMA16(Bq[ks][0], Af[m4], acc[mt][0]); acc[mt][1] = MFMA16(Bq[ks][1], Af[m4], acc[mt][1]); }
        }
    }
#pragma unroll
    for (int nt = 0; nt < 2; ++nt) {
        const int c = cg + 16 * nt;
        const f32x4 ps = psv[nt];
#pragma unroll
        for (int mt = 0; mt < 8; ++mt) *(u32x2*)((char*)(A2 + (size_t)(16 * mt) * 2048 + g * 256 + 16 * nt) + lo_out) = pack4(acc[mt][nt] * ps * unpack4(sgr[nt][mt]));
    }
}
__device__ __forceinline__ void pool_chunk(Frame& F0, int j, int n) {
    Frame F = launder(F0);
    LAS unsigned char* lds = F.lds;
    const int tid = F.tid, lane = F.lane, w = F.wave, fr = lane & 15, fq = lane >> 4, row0 = n * 128;
    const int cb = tid & 31, t0 = (tid >> 5) * 8, pos0 = (row0 & 2047) + t0;
    const bf16_t* xa = ((bf16_t*)(F.ws + WS_Z)) + (size_t)row0 * D; const unsigned xlo = (unsigned)(t0 * D + cb * 8) * 2u;
    const bf16_t* ZSGA = ((bf16_t*)(F.ws + WS_Z)) + (size_t)1 * MP * D + (size_t)row0 * D;
    bf16_t* A2 = ((bf16_t*)(F.ws + WS_A2)) + (size_t)row0 * 2048;
    LAS unsigned char* dst = lds + t0 * 544 + cb * 16;
    u32x4 x0[2 + 7]; pool_load<2>(xa, xlo, pos0, x0);
    pool_build<2>(x0, pos0, dst); LDS_BARRIER();
    u32x4 x1[4 + 7]; pool_load<4>(xa + 256, xlo, pos0, x1);
    pool_mma_epi(F, j, 0, row0, ZSGA, A2, lds, w, fr, fq); LDS_BARRIER();
    pool_build<4>(x1, pos0, dst); LDS_BARRIER();
    pool_mma_epi(F, j, 1, row0, ZSGA, A2, lds, w, fr, fq); LDS_BARRIER();
    u32x4 x2[8 + 7]; pool_load<8>(xa + 512, xlo, pos0, x2);
    pool_build<8>(x2, pos0, dst); LDS_BARRIER();
    pool_mma_epi(F, j, 2, row0, ZSGA, A2, lds, w, fr, fq); LDS_BARRIER();
    u32x4 x3[16 + 7]; pool_load<16>(xa + 768, xlo, pos0, x3);
    pool_build<16>(x3, pos0, dst); LDS_BARRIER();
    pool_mma_epi(F, j, 3, row0, ZSGA, A2, lds, w, fr, fq); LDS_BARRIER();
}
constexpr int ATT_SLOT = 64 * 544;
__device__ __forceinline__ void attn_prompt(Frame& F0, int layer) {
    Frame F = launder(F0);
    LAS unsigned char* lds = F.lds;
    const int tid = F.tid, lane = F.lane, w = F.wave, fr = lane & 15, fq = lane >> 4;
    const bf16_t* Kl = ((bf16_t*)(F.ws + WS_KB)) + (size_t)layer * MMEM * D; const bf16_t* Vl = ((bf16_t*)(F.ws + WS_VB)) + (size_t)layer * MMEM * D;
    for (int kk = F.rk; kk < 64; kk += F.rw) {
        const int b = F.xq, h = kk >> 4, qb = kk & 15;
        const size_t rowq = (size_t)b * SEQ + qb * 128 + 16 * w + fr;
        bf16x8 Qf[8];
#pragma unroll
        for (int ks = 0; ks < 8; ++ks) Qf[ks] = *(const bf16x8*)(((bf16_t*)(F.ws + WS_Q)) + rowq * D + h * 256 + 32 * ks + 8 * fq);
        const bf16_t* kbase = Kl + (size_t)(b * 256) * D + h * 256; const bf16_t* vbase = Vl + (size_t)(b * 256) * D + h * 256;
        u32x4 st[4];
#define ATT_GLOAD(c) do { const bf16_t* src_ = ((c) < 4 ? kbase : vbase) + (size_t)(64 * ((c) & 3)) * D; _Pragma("unroll") for (int i_ = 0; i_ < 4; ++i_) { const int idx_ = tid + 512 * i_; st[i_] = *(const u32x4*)(src_ + (size_t)(idx_ >> 5) * D + (idx_ & 31) * 8); } } while (0)
#define ATT_LSTORE(slot) do { _Pragma("unroll") for (int i_ = 0; i_ < 4; ++i_) { const int idx_ = tid + 512 * i_; *(LAS u32x4*)(lds + (slot) * ATT_SLOT + (idx_ >> 5) * 544 + (idx_ & 31) * 16) = st[i_]; } } while (0)
        f32x4 S[16], Oa[16]; bf16x8 Pf[8]; float inv = 0.f;
#pragma unroll
        for (int i = 0; i < 16; ++i) { S[i] = (f32x4){0.f, 0.f, 0.f, 0.f}; Oa[i] = (f32x4){0.f, 0.f, 0.f, 0.f}; }
        ATT_GLOAD(0); ATT_LSTORE(0); __syncthreads();
#pragma unroll
        for (int c = 0; c < 8; ++c) {
            if (c < 7) ATT_GLOAD(c + 1);
            LAS unsigned char* slot = lds + (c & 1) * ATT_SLOT;
            if (c < 4) {
#pragma unroll
                for (int ml = 0; ml < 4; ++ml)
#pragma unroll
                    for (int ks = 0; ks < 8; ++ks) {
                        const bf16x8 Kf = *(LAS bf16x8*)(slot + (16 * ml + fr) * 544 + (32 * ks + 8 * fq) * 2);
                        S[4 * c + ml] = MFMA16(Kf, Qf[ks], S[4 * c + ml]);
                    }
                if (c == 3) {
                    float mx = S[0][0];
#pragma unroll
                    for (int i = 0; i < 16; ++i) { mx = fmaxf(mx, fmaxf(fmaxf(S[i][0], S[i][1]), fmaxf(S[i][2], S[i][3]))); }
                    mx = fmaxf(mx, shx(mx, 16, lane)); mx = fmaxf(mx, shx(mx, 32, lane));
                    float sum = 0.f;
#pragma unroll
                    for (int i = 0; i < 16; ++i) {
#pragma unroll
                        for (int e = 0; e < 4; ++e) { S[i][e] = __builtin_amdgcn_exp2f(S[i][e] - mx); sum += S[i][e]; }
                    }
                    sum += shx(sum, 16, lane); sum += shx(sum, 32, lane);
                    inv = 1.0f / sum;
#pragma unroll
                    for (int a = 0; a < 8; ++a) {
                        u32x4 pw; pw.x = cvt_pk_bf16(S[2 * a][0], S[2 * a][1]); pw.y = cvt_pk_bf16(S[2 * a][2], S[2 * a][3]); pw.z = cvt_pk_bf16(S[2 * a + 1][0], S[2 * a + 1][1]); pw.w = cvt_pk_bf16(S[2 * a + 1][2], S[2 * a + 1][3]);
                        Pf[a] = __builtin_bit_cast(bf16x8, pw);
                    }
                }
            } else {
#pragma unroll
                for (int al = 0; al < 2; ++al)
#pragma unroll
                    for (int dt = 0; dt < 16; ++dt) {
                        LAS unsigned char* p = slot + (32 * al + 4 * fq + (fr >> 2)) * 544 + (16 * dt + 4 * (fr & 3)) * 2;
                        const bf16x8 Vf = tr_frag(p, p + 16 * 544);
                        Oa[dt] = MFMA16(Vf, Pf[2 * (c - 4) + al], Oa[dt]);
                    }
            }
            if (c < 7) ATT_LSTORE((c + 1) & 1);
            __syncthreads();
        }
#pragma unroll
        for (int dt = 0; dt < 16; ++dt) *(u32x2*)(((bf16_t*)(F.ws + WS_O)) + rowq * D + h * 256 + 16 * dt + 4 * fq) = pack4(Oa[dt] * inv);
#undef ATT_GLOAD
#undef ATT_LSTORE
    }
}

template <class Epi, int N>
__device__ __forceinline__ void sgemm16(Frame& F0, const bf16_t* A, const bf16_t* Bt, int K, const Epi& E) {
    Frame F = launder(F0);
    LAS unsigned char* lds = F.lds;
    constexpr int CW = N / 32, NT = CW / 16, KS = NT == 2 ? 8 : (NT == 10 ? 4 : 2), NG = 8 / KS, NTW = NT / NG;
    static_assert(NT * 16 == CW && NTW * NG == NT && 2 * CW <= NWAVES * 64, "sgemm16 geometry");
    const int tid = F.tid, lane = F.lane, w = F.wave, fr = lane & 15, fq = lane >> 4;
    const int ksi = w % KS, ng = w / KS, kslice = K / KS, nkb = kslice / 128;
    const bf16_t* A16 = A + (size_t)(16 * F.xq) * K;
    for (int slot = F.rk; slot < 32; slot += F.rw) {
        const int erow = tid / (CW / 8), ecg = tid % (CW / 8); const bool eact = tid < 2 * CW;
        typename Epi::Pre pre{};
        if (eact) pre = E.pre(16 * F.xq + erow, slot * CW + 8 * ecg);
        f32x4 acc[NTW];
#pragma unroll
        for (int jn = 0; jn < NTW; ++jn) acc[jn] = (f32x4){0.f, 0.f, 0.f, 0.f};
        const bf16_t* ap = A16 + (size_t)fr * K + ksi * kslice + 8 * fq;
        const bf16_t* bp = Bt + (size_t)(slot * CW + (ng * NTW) * 16 + fr) * K + ksi * kslice + 8 * fq;
        for (int kb = 0; kb < nkb; ++kb) {
            bf16x8 Af[4], Bf[4][NTW];
#pragma unroll
            for (int k4 = 0; k4 < 4; ++k4) {
                Af[k4] = *(const bf16x8*)(ap + 128 * kb + 32 * k4);
#pragma unroll
                for (int jn = 0; jn < NTW; ++jn) Bf[k4][jn] = *(const bf16x8*)(bp + (size_t)(16 * jn) * K + 128 * kb + 32 * k4);
            }
#pragma unroll
            for (int k4 = 0; k4 < 4; ++k4)
#pragma unroll
                for (int jn = 0; jn < NTW; ++jn) acc[jn] = MFMA16(Bf[k4][jn], Af[k4], acc[jn]);
        }
#pragma unroll
        for (int jn = 0; jn < NTW; ++jn) *(LAS f32x4*)(lds + ((size_t)((ksi * 16 + fr) * CW + (ng * NTW + jn) * 16 + 4 * fq)) * 4) = acc[jn];
        LDS_BARRIER();
        if (eact) {
            f32x4 s0 = (f32x4){0.f, 0.f, 0.f, 0.f}, s1 = s0;
#pragma unroll
            for (int kk = 0; kk < KS; ++kk) { const LAS f32x4* p = (const LAS f32x4*)(lds + ((size_t)((kk * 16 + erow) * CW + 8 * ecg)) * 4); s0 += p[0]; s1 += p[1]; }
            E(16 * F.xq + erow, slot, slot * CW + 8 * ecg, s0, s1, pre);
        }
        LDS_BARRIER();
    }
}
struct SEpiZ {
    struct Pre { float rs; };
    const float* rsqs; float* SZ; int ldz, mode;
    __device__ __forceinline__ Pre pre(int row, int col) const { return Pre{rstd32(rsqs + row * 32)}; }
    __device__ __forceinline__ void operator()(int row, int strip, int col, f32x4 s0, f32x4 s1, const Pre& p) const {
        const int oc0 = mode == 0 ? src_even(col) : src_odd(col), oc1 = mode == 0 ? src_even(col + 4) : src_odd(col + 4);
        float* q = SZ + (size_t)row * ldz; *(f32x4*)(q + oc0) = s0 * p.rs; *(f32x4*)(q + oc1) = s1 * p.rs;
    }
};
struct SEpiRes {
    struct Pre { f32x4 x0, x1; };
    float* xs; bf16_t* xb; float* rsqs;
    __device__ __forceinline__ Pre pre(int row, int col) const { const float* q = xs + (size_t)row * D + col; return Pre{*(const f32x4*)q, *(const f32x4*)(q + 4)}; }
    __device__ __forceinline__ void operator()(int row, int strip, int col, f32x4 s0, f32x4 s1, const Pre& pr) const {
        float* p = xs + (size_t)row * D + col; const f32x4 o0 = pr.x0 + s0, o1 = pr.x1 + s1;
        *(f32x4*)p = o0; *(f32x4*)(p + 4) = o1; *(u32x4*)(xb + (size_t)row * D + col) = pack8(o0, o1);
        const int ln = ((row & 15) << 2) | ((col >> 3) & 3);
        float ss = dot4(o0, o0) + dot4(o1, o1); ss += shx(ss, 1, ln); ss += shx(ss, 2, ln);
        if ((col & 31) == 0) rsqs[row * 32 + strip] = ss;
    }
};
struct SEpiQ {
    struct Pre { float rs; };
    const float* rsqs; float* SQ;
    __device__ __forceinline__ Pre pre(int row, int col) const { return Pre{rstd32(rsqs + row * 32)}; }
    __device__ __forceinline__ void operator()(int row, int strip, int col, f32x4 s0, f32x4 s1, const Pre& p) const {
        float* q = SQ + (size_t)row * D + col; *(f32x4*)q = s0 * p.rs; *(f32x4*)(q + 4) = s1 * p.rs;
    }
};
__device__ __forceinline__ void sample_mix_even(Frame& F0, int j, int b) {
    Frame F = launder(F0);
    LAS float* pl = (LAS float*)F.lds; LAS float* red = pl + 1024;
    const int tid = F.tid, lane = F.lane, w = F.wave;
    const float* z = ((float*)(F.ws + WS_SZ)) + (size_t)b * 8192;
    float vv[2], ss = 0.f;
#pragma unroll
    for (int k = 0; k < 2; ++k) { vv[k] = z[3072 + tid + 512 * k]; ss += vv[k] * vv[k]; }
    ss = wave_sum(ss, lane); if (lane == 0) red[w] = ss;
#pragma unroll
    for (int k = 0; k < 2; ++k) {
        const int c = tid + 512 * k, g = c >> 8, win = 2 << g; const float xa = z[c];
        const float* st = FIN(3) + ((size_t)(j * 128 + b) * 15) * 1024 + c;
        float s = xa; for (int r = 16 - win; r < 15; ++r) s += st[(size_t)r * 1024];
        pl[c] = s / (float)win - xa;
        float* po = F.out + O_POOLS + ((size_t)(j * 128 + b) * 15) * 1024 + c;
        for (int r = 0; r < 14; ++r) po[(size_t)r * 1024] = st[(size_t)(r + 1) * 1024];
        po[(size_t)14 * 1024] = xa;
    }
    __syncthreads();
    float tot = 0.f;
#pragma unroll
    for (int i = 0; i < 8; ++i) tot += red[i];
    const float rv = rsqrtf(tot * (1.0f / D) + EPS);
#pragma unroll
    for (int k = 0; k < 2; ++k) {
        const int d = tid + 512 * k, g = d >> 8, dd = d & 255;
        const bf16_t* pm = ((bf16_t*)(F.ws + WS_PMT)) + (size_t)(j * 4 + g) * 65536 + (size_t)dd * 256; const LAS float* pg = pl + g * 256;
        float a = 0.f;
#pragma unroll
        for (int hb = 0; hb < 2; ++hb) {
            u32x4 pr[16];
#pragma unroll
            for (int i = 0; i < 16; ++i) pr[i] = *(const u32x4*)(pm + hb * 128 + i * 8);
#pragma unroll
            for (int i = 0; i < 16; ++i) { f32x4 p0, p1; unpack8(pr[i], p0, p1); const LAS float* q = pg + hb * 128 + i * 8; a += dot4(p0, *(const LAS f32x4*)q) + dot4(p1, *(const LAS f32x4*)(q + 4)); }
        }
        const float ya = a * FIN(12)[j * 1024 + d] * silu_f(z[1024 + d]);
        const float vn = vv[k] * rv * FIN(15)[j * 1024 + d];
        F.out[O_SGUV + (size_t)(j * 128 + b) * 1024 + d] = vn;
        const float mixed = FIN(13)[(size_t)(j * 4 + g) * 16384] * vn + FIN(14)[(j * 4 + g) * 128];
        const float yb = z[2048 + d] * mixed * silu_f(z[4096 + d]);
        ((bf16_t*)(F.ws + WS_SA2))[(size_t)b * 2048 + d] = (bf16_t)(cvt_pk_bf16(ya, 0.f) & 0xffffu); ((bf16_t*)(F.ws + WS_SA2))[(size_t)b * 2048 + 1024 + d] = (bf16_t)(cvt_pk_bf16(yb, 0.f) & 0xffffu);
    }
    __syncthreads();
}
__device__ __forceinline__ void sample_conv_odd(Frame& F0, int j, int b) {
    Frame F = launder(F0);
    const int tid = F.tid;
    const float* z = ((float*)(F.ws + WS_SZ)) + (size_t)b * 8192;
    const float* cw = FIN(18) + (size_t)j * 3 * 2048;
#pragma unroll
    for (int k = 0; k < 4; ++k) {
        const int c = tid + 512 * k;
        const float e = z[2048 + c] * z[4096 + c];
        const float s0 = FIN(4)[((size_t)(j * 128 + b) * 2 + 0) * 2048 + c], s1 = FIN(4)[((size_t)(j * 128 + b) * 2 + 1) * 2048 + c];
        const float y = cw[c] * s0 + cw[2048 + c] * s1 + cw[4096 + c] * e;
        ((bf16_t*)(F.ws + WS_SA2))[(size_t)b * 2048 + c] = (bf16_t)(cvt_pk_bf16(z[c] * y * silu_f(z[6144 + c]), 0.f) & 0xffffu);
        float* po = F.out + O_CONVS + ((size_t)(j * 128 + b) * 2) * 2048 + c; po[0] = s1; po[2048] = e;
    }
}
__device__ __forceinline__ void attn_sample(Frame& F0, int layer) {
    Frame F = launder(F0);
    LAS float* sc = (LAS float*)F.lds;
    LAS float* red = sc + 512;
    const int tid = F.tid, lane = F.lane, w = F.wave;
    for (int item = F.rk; item < 32; item += F.rw) {
        const int b = 16 * F.xq + (item >> 1), hp = item & 1;
        const float* qp = ((float*)(F.ws + WS_SQ)) + (size_t)b * D + hp * 512;
        const f32x4 q0 = *(const f32x4*)(qp + 4 * lane), q1 = *(const f32x4*)(qp + 256 + 4 * lane);
        const float* kp = FIN(5) + ((size_t)(layer * 128 + b) * 256) * 1024 + hp * 512 + 4 * lane;
        const float* vp = FIN(6) + ((size_t)(layer * 128 + b) * 256) * 1024 + hp * 512 + 4 * lane;
#pragma unroll 8
        for (int mi = 0; mi < 32; ++mi) {
            const int m = 32 * w + mi;
            const f32x4 k0 = __builtin_nontemporal_load((const f32x4*)(kp + (size_t)m * 1024)), k1 = __builtin_nontemporal_load((const f32x4*)(kp + (size_t)m * 1024 + 256));
            const float d0 = wave_sum(dot4(k0, q0), lane), d1 = wave_sum(dot4(k1, q1), lane);
            if (lane == 0) { sc[m] = d0; sc[256 + m] = d1; }
        }
        __syncthreads();
        float p0[4], p1[4], mx0 = -INFINITY, mx1 = -INFINITY;
#pragma unroll
        for (int i = 0; i < 4; ++i) { p0[i] = sc[lane + 64 * i]; p1[i] = sc[256 + lane + 64 * i]; mx0 = fmaxf(mx0, p0[i]); mx1 = fmaxf(mx1, p1[i]); }
#pragma unroll
        for (int o = 1; o < 64; o <<= 1) { mx0 = fmaxf(mx0, shx(mx0, o, lane)); mx1 = fmaxf(mx1, shx(mx1, o, lane)); }
        float sm0 = 0.f, sm1 = 0.f;
#pragma unroll
        for (int i = 0; i < 4; ++i) { p0[i] = __builtin_amdgcn_exp2f(p0[i] - mx0); p1[i] = __builtin_amdgcn_exp2f(p1[i] - mx1); sm0 += p0[i]; sm1 += p1[i]; }
        sm0 = wave_sum(sm0, lane); sm1 = wave_sum(sm1, lane);
        const float i0 = 1.0f / sm0, i1 = 1.0f / sm1;
        __syncthreads();
        if (w == 0) {
#pragma unroll
            for (int i = 0; i < 4; ++i) { sc[lane + 64 * i] = p0[i] * i0; sc[256 + lane + 64 * i] = p1[i] * i1; }
        }
        __syncthreads();
        f32x4 a0 = (f32x4){0.f, 0.f, 0.f, 0.f}, a1 = a0;
#pragma unroll 8
        for (int mi = 0; mi < 32; ++mi) {
            const int m = 32 * w + mi;
            const f32x4 v0 = __builtin_nontemporal_load((const f32x4*)(vp + (size_t)m * 1024)), v1 = __builtin_nontemporal_load((const f32x4*)(vp + (size_t)m * 1024 + 256));
            a0 += v0 * sc[m]; a1 += v1 * sc[256 + m];
        }
        *(LAS f32x4*)(red + w * 512 + 4 * lane) = a0; *(LAS f32x4*)(red + w * 512 + 256 + 4 * lane) = a1;
        __syncthreads();
        {
            float o = 0.f;
#pragma unroll
            for (int ww = 0; ww < 8; ++ww) o += red[ww * 512 + tid];
            ((bf16_t*)(F.ws + WS_SO))[(size_t)b * D + hp * 512 + tid] = (bf16_t)(cvt_pk_bf16(o, 0.f) & 0xffffu);
        }
        __syncthreads();
    }
}
#define dpp_mov(v, ctrl, row_mask) __builtin_bit_cast(float, __builtin_amdgcn_update_dpp(0, __builtin_bit_cast(int, (float)(v)), (ctrl), (row_mask), 0xf, false))
__device__ __forceinline__ float wave_sum_dpp(float x) {
    x += dpp_mov(x, 0xB1, 0xf);
    x += dpp_mov(x, 0x4E, 0xf);
    x += dpp_mov(x, 0x141, 0xf);
    x += dpp_mov(x, 0x140, 0xf);
    x += dpp_mov(x, 0x142, 0xa);
    x += dpp_mov(x, 0x143, 0xc);
    return x;
}
constexpr int FA_SC = 69632, FA_RED = 71680;
__device__ __forceinline__ void attn_fused(Frame& F0, int layer) {
    Frame F = launder(F0);
    LAS unsigned char* lds = F.lds;
    const int tid = F.tid, lane = F.lane, w = F.wave, fr = lane & 15, fq = lane >> 4;
    const bf16_t* Kl = ((bf16_t*)(F.ws + WS_KB)) + (size_t)layer * MMEM * D; const bf16_t* Vl = ((bf16_t*)(F.ws + WS_VB)) + (size_t)layer * MMEM * D;
    LAS float* sc = (LAS float*)(lds + FA_SC); LAS float* red = (LAS float*)(lds + FA_RED);
    const int sb = 16 * F.xq + (F.rk >> 1), hp = F.rk & 1;
    const float* qp = ((float*)(F.ws + WS_SQ)) + (size_t)sb * D + hp * 512;
    const f32x4 q0 = *(const f32x4*)(qp + 4 * lane), q1 = *(const f32x4*)(qp + 256 + 4 * lane);
    const float* kp = FIN(5) + ((size_t)(layer * 128 + sb) * 256 + 4 * w) * 1024 + hp * 512;
    const float* vp = FIN(6) + ((size_t)(layer * 128 + sb) * 256 + 4 * w) * 1024 + hp * 512;
    const unsigned lo16 = (unsigned)lane * 16u;
    f32x4 sv[8]; f32x4 a0 = (f32x4){0.f, 0.f, 0.f, 0.f}, a1 = a0; float mx0 = 0.f, mx1 = 0.f, iv0 = 0.f, iv1 = 0.f;
#define FA_SLOAD(base, slice) do { unsigned long long pu_ = uni64((unsigned long long)((base) + (size_t)(32 * (slice)) * 1024)); asm volatile("" : "+s"(pu_)); const char* pc_ = (const char*)(const GAS char*)pu_; \
        _Pragma("unroll") for (int r_ = 0; r_ < 4; ++r_) { sv[2 * r_] = __builtin_nontemporal_load((const f32x4*)(pc_ + r_ * 4096 + lo16)); sv[2 * r_ + 1] = __builtin_nontemporal_load((const f32x4*)(pc_ + r_ * 4096 + 1024 + lo16)); } } while (0)
    FA_SLOAD(kp, 0);
#pragma unroll 1
    for (int ui = 0; ui < 2; ++ui) {
        const int kk = 2 * F.rk + ui;
        const int b = F.xq, h = kk >> 4, qb = kk & 15;
        const size_t rowq = (size_t)b * SEQ + qb * 128 + 16 * w + fr;
        bf16x8 Qf[8];
#pragma unroll
        for (int ks = 0; ks < 8; ++ks) Qf[ks] = *(const bf16x8*)(((bf16_t*)(F.ws + WS_Q)) + rowq * D + h * 256 + 32 * ks + 8 * fq);
        const bf16_t* kbase = Kl + (size_t)(b * 256) * D + h * 256; const bf16_t* vbase = Vl + (size_t)(b * 256) * D + h * 256;
        u32x4 st[4];
        const unsigned goff = (unsigned)(tid >> 5) * (D * 2) + (unsigned)(tid & 31) * 16u, loff = (unsigned)(tid >> 5) * 544u + (unsigned)(tid & 31) * 16u;
#define ATT_GLOAD(c) do { unsigned long long pu_ = uni64((unsigned long long)(((c) < 4 ? kbase : vbase) + (size_t)(64 * ((c) & 3)) * D)); asm volatile("" : "+s"(pu_)); const char* pc_ = (const char*)(const GAS char*)pu_; \
        _Pragma("unroll") for (int i_ = 0; i_ < 4; ++i_) st[i_] = *(const u32x4*)(pc_ + (size_t)(16 * i_) * D * 2 + goff); } while (0)
#define ATT_LSTORE(c) do { _Pragma("unroll") for (int i_ = 0; i_ < 4; ++i_) *(LAS u32x4*)(lds + ((c) & 1) * ATT_SLOT + 16 * i_ * 544 + loff) = st[i_]; } while (0)
        f32x4 S[16], Oa[16]; bf16x8 Pf[8]; float inv = 0.f;
        const f32x4 zero4 = (f32x4){0.f, 0.f, 0.f, 0.f};
        if (ui == 1) {
            float p0[4], p1[4]; mx0 = -INFINITY; mx1 = -INFINITY;
#pragma unroll
            for (int i = 0; i < 4; ++i) { p0[i] = sc[lane + 64 * i]; p1[i] = sc[256 + lane + 64 * i]; mx0 = fmaxf(mx0, p0[i]); mx1 = fmaxf(mx1, p1[i]); }
#pragma unroll
            for (int o = 1; o < 64; o <<= 1) { mx0 = fmaxf(mx0, shx(mx0, o, lane)); mx1 = fmaxf(mx1, shx(mx1, o, lane)); }
            float sm0 = 0.f, sm1 = 0.f;
#pragma unroll
            for (int i = 0; i < 4; ++i) { sm0 += __builtin_amdgcn_exp2f(p0[i] - mx0); sm1 += __builtin_amdgcn_exp2f(p1[i] - mx1); }
            sm0 = wave_sum(sm0, lane); sm1 = wave_sum(sm1, lane);
            iv0 = 1.0f / sm0; iv1 = 1.0f / sm1;
        }
        ATT_GLOAD(0); ATT_LSTORE(0); __syncthreads();
#pragma unroll
        for (int c = 0; c < 8; ++c) {
            if (c < 7) ATT_GLOAD(c + 1);
            if (ui == 0) {
#pragma unroll
                for (int r = 0; r < 4; ++r) {
                    const int m = 32 * c + 4 * w + r;
                    const float d0 = wave_sum_dpp(dot4(sv[2 * r], q0)), d1 = wave_sum_dpp(dot4(sv[2 * r + 1], q1));
                    if (lane == 63) { sc[m] = d0; sc[256 + m] = d1; }
                }
                if (c < 7) FA_SLOAD(kp, c + 1); else FA_SLOAD(vp, 0);
            } else {
#pragma unroll
                for (int r = 0; r < 4; ++r) {
                    const int m = 32 * c + 4 * w + r;
                    const float p0 = __builtin_amdgcn_exp2f(sc[m] - mx0) * iv0, p1 = __builtin_amdgcn_exp2f(sc[256 + m] - mx1) * iv1;
                    a0 += sv[2 * r] * p0; a1 += sv[2 * r + 1] * p1;
                }
                if (c < 7) FA_SLOAD(vp, c + 1);
            }
            LAS unsigned char* slot = lds + (c & 1) * ATT_SLOT;
            if (c < 4) {
                {
                    bf16x8 Kf[2][4];
#pragma unroll
                    for (int ml = 0; ml < 4; ++ml) Kf[0][ml] = *(LAS bf16x8*)(slot + (16 * ml + fr) * 544 + (8 * fq) * 2);
                    __builtin_amdgcn_sched_group_barrier(0x100, 4, 0);
#pragma unroll
                    for (int ks = 0; ks < 8; ++ks) {
                        if (ks < 7) {
#pragma unroll
                            for (int ml = 0; ml < 4; ++ml) Kf[(ks + 1) & 1][ml] = *(LAS bf16x8*)(slot + (16 * ml + fr) * 544 + (32 * (ks + 1) + 8 * fq) * 2);
                        }
#pragma unroll
                        for (int ml = 0; ml < 4; ++ml) S[4 * c + ml] = MFMA16(Kf[ks & 1][ml], Qf[ks], ks == 0 ? zero4 : S[4 * c + ml]);
                        __builtin_amdgcn_sched_group_barrier(0x100, 4, 0); __builtin_amdgcn_sched_group_barrier(0x008, 4, 0);
                    }
                }
                if (c == 3) {
                    float mx = S[0][0];
#pragma unroll
                    for (int i = 0; i < 16; ++i) { mx = fmaxf(mx, fmaxf(fmaxf(S[i][0], S[i][1]), fmaxf(S[i][2], S[i][3]))); }
                    mx = fmaxf(mx, shx(mx, 16, lane)); mx = fmaxf(mx, shx(mx, 32, lane));
                    float sum = 0.f;
#pragma unroll
                    for (int i = 0; i < 16; ++i) {
#pragma unroll
                        for (int e = 0; e < 4; ++e) { S[i][e] = __builtin_amdgcn_exp2f(S[i][e] - mx); sum += S[i][e]; }
                    }
                    sum += shx(sum, 16, lane); sum += shx(sum, 32, lane);
                    inv = 1.0f / sum;
#pragma unroll
                    for (int a = 0; a < 8; ++a) {
                        u32x4 pw; pw.x = cvt_pk_bf16(S[2 * a][0], S[2 * a][1]); pw.y = cvt_pk_bf16(S[2 * a][2], S[2 * a][3]); pw.z = cvt_pk_bf16(S[2 * a + 1][0], S[2 * a + 1][1]); pw.w = cvt_pk_bf16(S[2 * a + 1][2], S[2 * a + 1][3]);
                        Pf[a] = __builtin_bit_cast(bf16x8, pw);
                    }
                }
            } else {
                {
                    bf16x8 Vf[2][4];
#define ATT_VREAD(n_, buf_) do { _Pragma("unroll") for (int d_ = 0; d_ < 4; ++d_) { LAS unsigned char* p_ = slot + (32 * ((n_) >> 2) + 4 * fq + (fr >> 2)) * 544 + (16 * (4 * ((n_) & 3) + d_) + 4 * (fr & 3)) * 2; Vf[buf_][d_] = tr_frag(p_, p_ + 16 * 544); } } while (0)
                    ATT_VREAD(0, 0);
                    __builtin_amdgcn_sched_group_barrier(0x100, 8, 0);
#pragma unroll
                    for (int n = 0; n < 8; ++n) {
                        if (n < 7) ATT_VREAD(n + 1, (n + 1) & 1);
#pragma unroll
                        for (int d = 0; d < 4; ++d) { const int al = n >> 2, dt = 4 * (n & 3) + d; Oa[dt] = MFMA16(Vf[n & 1][d], Pf[2 * (c - 4) + al], (c == 4 && al == 0) ? zero4 : Oa[dt]); }
                        __builtin_amdgcn_sched_group_barrier(0x100, 8, 0); __builtin_amdgcn_sched_group_barrier(0x008, 4, 0);
                    }
#undef ATT_VREAD
                }
            }
            if (c < 7) ATT_LSTORE(c + 1);
            LDS_BARRIER();
        }
#pragma unroll
        for (int dt = 0; dt < 16; ++dt) *(u32x2*)(((bf16_t*)(F.ws + WS_O)) + rowq * D + h * 256 + 16 * dt + 4 * fq) = pack4(Oa[dt] * inv);
#undef ATT_GLOAD
#undef ATT_LSTORE
    }
#undef FA_SLOAD
    *(LAS f32x4*)(red + w * 512 + 4 * lane) = a0; *(LAS f32x4*)(red + w * 512 + 256 + 4 * lane) = a1;
    __syncthreads();
    {
        float o = 0.f;
#pragma unroll
        for (int ww = 0; ww < 8; ++ww) o += red[ww * 512 + tid];
        ((bf16_t*)(F.ws + WS_SO))[(size_t)sb * D + hp * 512 + tid] = (bf16_t)(cvt_pk_bf16(o, 0.f) & 0xffffu);
    }
    __syncthreads();
}
__device__ __forceinline__ void final_norm(Frame& F0) {
    Frame F = launder(F0);
    const int gwx = F.rk * NWAVES + F.wave, NGX = F.rw * NWAVES, lane = F.lane;
    f32x4 g[4];
#pragma unroll
    for (int jj = 0; jj < 4; ++jj) g[jj] = ((const f32x4*)FIN(24) + lane)[64 * jj];
    for (int p = gwx; p < SEQ / 2 + 8; p += NGX) {
        const int m0 = p < SEQ / 2 ? F.xq * SEQ + 2 * p : MP + 16 * F.xq + 2 * (p - SEQ / 2);
        f32x4 v[2][4];
#pragma unroll
        for (int r = 0; r < 2; ++r) {
            const int m = m0 + r;
            if (m < MP) {
                const u32x2* src = (const u32x2*)(((bf16_t*)(F.ws + WS_XB)) + (size_t)m * D) + lane;
#pragma unroll
                for (int jj = 0; jj < 4; ++jj) v[r][jj] = unpack4(src[64 * jj]);
            } else {
                const f32x4* src = (const f32x4*)(((float*)(F.ws + WS_XS)) + (size_t)(m - MP) * D) + lane;
#pragma unroll
                for (int jj = 0; jj < 4; ++jj) v[r][jj] = src[64 * jj];
            }
        }
#pragma unroll
        for (int r = 0; r < 2; ++r) {
            const int m = m0 + r; float s = 0.f;
#pragma unroll
            for (int jj = 0; jj < 4; ++jj) s += dot4(v[r][jj], v[r][jj]);
            float* dst = m < MP ? F.out + O_Y + (size_t)m * D : F.out + O_YS + (size_t)(m - MP) * D;
            const float rs = rsqrtf(wave_sum(s, lane) * (1.0f / D) + EPS);
#pragma unroll
            for (int jj = 0; jj < 4; ++jj) ((f32x4*)dst + lane)[64 * jj] = v[r][jj] * rs * g[jj];
        }
    }
}

struct Args { const float* in[25]; float* out; unsigned char* ws; int ph_lo, ph_hi; };
#define REP(bit) for (int rep_ = 0; rep_ < 1 + ((REP_MASK >> (bit)) & 1); ++rep_)
__global__ void __launch_bounds__(NWAVES * 64, 2) fwd(Args args) {
    extern __shared__ __attribute__((aligned(16))) unsigned char lds_raw[];
    Frame F0;
    F0.lds = (LAS unsigned char*)lds_raw;
    F0.tid = threadIdx.x; F0.lane = F0.tid & 63; F0.wave = __builtin_amdgcn_readfirstlane(F0.tid >> 6); F0.G = gridDim.x; F0.bx = blockIdx.x;
    F0.in = (in_tab_t)__builtin_amdgcn_kernarg_segment_ptr();     F0.out = args.out; F0.ws = args.ws;
    for (int u = F0.tid; u < (LDS_BYTES - LDSCTL_OFF) / 4; u += NWAVES * 64) ((LAS unsigned*)(F0.lds + LDSCTL_OFF))[u] = 0u;
    __syncthreads();
    XcdBarrier bar; bar.wave = F0.wave; bar.bar = (unsigned*)(args.ws + WS_CTL) + CW_BAR; bar.x = 0; bar.st = nullptr;
    if (!MK_SPLIT) bar = xcd_barrier_post((unsigned*)(args.ws + WS_CTL) + CW_BAR, (volatile LAS unsigned*)(F0.lds + MISC_OFF) + 8, F0.wave);
    unsigned* rankw = (unsigned*)(args.ws + WS_CTL) + CW_RANK;
    const unsigned my_xcc = xb_xcc_id();
    unsigned my_rank = 0u;
    if (F0.tid == 0) ((volatile LAS unsigned*)(F0.lds + MISC_OFF))[12] = __hip_atomic_fetch_add(rankw + 64 * my_xcc, 1u, __ATOMIC_RELAXED, __HIP_MEMORY_SCOPE_AGENT);
    __syncthreads();
    my_rank = __builtin_amdgcn_readfirstlane(((volatile LAS unsigned*)(F0.lds + MISC_OFF))[12]);
    F0.vid = F0.bx;
    int ph = 0;
    bool local_ok = false;
    const int lo = args.ph_lo, hi = args.ph_hi;
#define PH_BEGIN if (ph >= lo && ph < hi) { Frame F = launder(F0);
#define PH_END } { const bool both_ = (ph >= lo && ph + 1 < hi); ++ph; if (!MK_SPLIT && both_) { XcdBarrier b2_ = bar; unsigned long long bp_ = uni64((unsigned long long)bar.bar); unsigned bx_ = __builtin_amdgcn_readfirstlane(bar.x); int bw_ = __builtin_amdgcn_readfirstlane(bar.wave); asm volatile("" : "+s"(bp_), "+s"(bx_), "+s"(bw_)); b2_.bar = (unsigned*)(GAS unsigned*)bp_; b2_.x = bx_; b2_.wave = bw_; if (local_ok && ph > 2) xcd_barrier_local(b2_); else xcd_barrier(b2_); if ((REP_MASK >> 19) & 1) xcd_barrier(b2_); if (ph == 2) local_ok = XCD_LOCAL && lo == 0 && __builtin_amdgcn_readfirstlane(__hip_atomic_load(rankw + 64 * 20, __ATOMIC_RELAXED, __HIP_MEMORY_SCOPE_AGENT)) == 0u;     } }

    PH_BEGIN REP(0) { p0_prologue(F0); __syncthreads(); } PH_END
    if (!MK_SPLIT && lo == 0) {
        unsigned nx = 0u, xi = 0u; bool even = (F0.G % 8) == 0;
        for (unsigned jx = 0; jx < 16; ++jx) { const unsigned c_ = __hip_atomic_load(rankw + 64 * jx, __ATOMIC_RELAXED, __HIP_MEMORY_SCOPE_AGENT); if (c_) { if (c_ != (unsigned)F0.G / 8u) even = false; if (jx < my_xcc) ++xi; ++nx; } }
        if (XCD_VID && even && nx == 8u) F0.vid = (int)(my_rank * 8u + xi);
        if (!(even && nx == 8u && (unsigned)(F0.bx % 8) == xi) && F0.tid == 0) __hip_atomic_store(rankw + 64 * 20, 1u, __ATOMIC_RELAXED, __HIP_MEMORY_SCOPE_AGENT);
        if (((REP_MASK >> 18) & 1) && !(even && nx == 8u && (unsigned)(F0.bx % 8) == xi) && F0.tid == 0) F0.out[O_YS + F0.bx] = __builtin_nanf("");
        F0.vid = __builtin_amdgcn_readfirstlane(F0.vid);
    }
    PH_BEGIN {
        if ((REP_MASK >> 17) & 1) {
            f32x4 pa[8]; bf16x8 pb = (bf16x8){(short)F.tid, 1, 2, 3, 4, 5, 6, 7};
#pragma unroll
            for (int i = 0; i < 8; ++i) pa[i] = (f32x4){(float)F.tid, 1.f, 2.f, (float)i};
#pragma unroll 1
            for (int it = 0; it < 512; ++it) {
#pragma unroll
                for (int r = 0; r < 4; ++r)
#pragma unroll
                    for (int i = 0; i < 8; ++i) pa[i] = MFMA16(pb, pb, pa[i]);
            }
            float sacc = 0.f;
#pragma unroll
            for (int i = 0; i < 8; ++i) sacc += pa[i][0] + pa[i][3];
            if (sacc == 12345.678f) ((float*)(F.ws + WS_Z))[F.tid] = sacc;
        }
        if ((REP_MASK >> 15) & 3) { pg8::Gemm gp{((bf16_t*)(F.ws + WS_XB)), ((bf16_t*)(F.ws + WS_C1)), MP, NC, ((REP_MASK >> 15) & 1) ? 1024 : 512}; pg8::StaticOrder Sp; Sp.init(MP, NC, F.G, (int)F.vid); EpiProbe Ep{((bf16_t*)(F.ws + WS_Z)), NC}; pg8::gemm_phase<EpiProbe, pg8::StaticOrder, true, true>(F.lds, gp, Sp, Ep, F.wave); }
        pg8::Gemm g{((bf16_t*)(F.ws + WS_MEMB)), ((bf16_t*)(F.ws + WS_WKV)), MMEM, 8192, D}; pg8::StaticOrder S; S.init(MMEM, 8192, F.G, (int)F.vid);
        EpiMemKV E{((float*)(F.ws + WS_SMALL + 65536)), F.out + O_MEMK, F.out + O_MEMV, ((bf16_t*)(F.ws + WS_KB)), ((bf16_t*)(F.ws + WS_VB))};
        REP(1) pg8::gemm_phase<EpiMemKV, pg8::StaticOrder, true, true>(F.lds, g, S, E, F.wave);
    } PH_END
    if (STAGGER_TICKS != 0 && lo == 0 && ((F0.bx & 1) == (STAGGER_TICKS > 0 ? 1 : 0))) { const unsigned long long t0_ = __builtin_amdgcn_s_memrealtime(); const unsigned long long tk_ = (unsigned long long)(STAGGER_TICKS > 0 ? STAGGER_TICKS : -STAGGER_TICKS); while (__builtin_amdgcn_s_memrealtime() - t0_ < tk_) __builtin_amdgcn_s_sleep(8); }
    unsigned* pbw = (unsigned*)(args.ws + WS_CTL) + CW_RANK + 64 * 24;
    if (!MK_SPLIT && SPLIT_PROLOGUE && lo == 0) {
        const int half = F0.bx & 1, hw = (half ? (F0.G >> 1) : ((F0.G + 1) >> 1)) * NWAVES, hi_ = (F0.bx >> 1) * NWAVES + F0.wave;
        p0_weights(F0, 1, hi_, hw, half);
        asm volatile("s_waitcnt vmcnt(0)" ::: "memory"); __syncthreads();
        if (F0.wave == 0 && hw_lane() == 0) { __builtin_amdgcn_fence(__ATOMIC_RELEASE, "agent"); asm volatile("s_waitcnt vmcnt(0)" ::: "memory"); (void)__hip_atomic_fetch_add(pbw, 1u, __ATOMIC_RELAXED, __HIP_MEMORY_SCOPE_AGENT); }
    }
#pragma unroll 1
    for (int l = 0; l < DEPTH; ++l) {
        const int j = l >> 1;
        if (!MK_SPLIT && SPLIT_PROLOGUE && lo == 0 && l == 1) {
            if (F0.wave == 0 && hw_lane() == 0) {
                const unsigned want = (unsigned)F0.G; unsigned sp = 0u;
                while (__hip_atomic_load(pbw, __ATOMIC_RELAXED, __HIP_MEMORY_SCOPE_AGENT) < want) { __builtin_amdgcn_s_sleep(2); if (++sp > (1u << 22)) { atomicAdd((unsigned*)(args.ws + WS_CTL) + CW_BAR + XB_TMO, 1u); break; } }
                __builtin_amdgcn_fence(__ATOMIC_ACQUIRE, "agent"); asm volatile("s_waitcnt vmcnt(0)" ::: "memory");
            }
            __syncthreads();
        }
        if ((l & 1) == 0) {
            PH_BEGIN {
                pg8::Gemm g{((bf16_t*)(F.ws + WS_XB)), ((bf16_t*)(F.ws + WS_AB1)) + (size_t)j * NAB * D, MP, NAB, D}; pg8::StaticOrder S; S.init(MP, NAB, F.G, (int)F.vid);
                Unit u0{0, 0}; S.next(0, u0); rstd_table(((float*)(F.ws + WS_RSQ)), u0.pm, (LAS float*)(F.lds + RSTD_OFF), F.tid);
                EpiG1Even E{((float*)(F.ws + WS_RSQ)), ((bf16_t*)(F.ws + WS_Z)), ((float*)(F.ws + WS_VSQ)), F.out + O_POOLP + (size_t)j * 8 * 15 * 1024, (LAS const float*)(F.lds + RSTD_OFF), u0.pm};
                SEpiZ SE{((float*)(F.ws + WS_SMALL)), ((float*)(F.ws + WS_SZ)), 8192, 0};
                const bool s_first = (F.rk & 1) != 0;
                if (s_first) { REP(3) sgemm16<SEpiZ, NAB>(F, ((bf16_t*)(F.ws + WS_XB)) + (size_t)MP * D, ((bf16_t*)(F.ws + WS_AB1)) + (size_t)j * NAB * D, D, SE); }
                REP(2) pg8::gemm_phase<EpiG1Even, pg8::StaticOrder, true, true>(F.lds, g, S, E, F.wave);
                if (!s_first) { REP(3) sgemm16<SEpiZ, NAB>(F, ((bf16_t*)(F.ws + WS_XB)) + (size_t)MP * D, ((bf16_t*)(F.ws + WS_AB1)) + (size_t)j * NAB * D, D, SE); }
            } PH_END
            PH_BEGIN {
                for (int rep_ = 0; rep_ < 1 + (((REP_MASK >> 4) & 1) | ((REP_MASK >> 20) & 3 ? 1 : 0)); ++rep_) for (int i = F.rk; i < 32; i += F.rw) { const bool only_s = rep_ && ((REP_MASK >> 20) & 1), only_p = rep_ && ((REP_MASK >> 21) & 1); if ((i & 1) == 0) { if (!only_p) sgu_chunk(F, j, 16 * F.xq + (i >> 1)); } else { if (!only_s) pool_chunk(F, j, 16 * F.xq + (i >> 1)); } }
                REP(5) for (int i = F.rk; i < 16; i += F.rw) sample_mix_even(F, j, 16 * F.xq + i);
            } PH_END
        } else {
            PH_BEGIN {
                pg8::Gemm g{((bf16_t*)(F.ws + WS_XB)), ((bf16_t*)(F.ws + WS_C1)) + (size_t)j * NC * D, MP, NC, D}; pg8::StaticOrder S; S.init(MP, NC, F.G, (int)F.vid);
                Unit u0{0, 0}; S.next(0, u0);
                for (int i = F.tid; i < 8 * 3 * 64; i += NWAVES * 64) { const int ui = i / 192, q = (i / 64) % 3, c = i & 63, pn = u0.pn + 4 * ui; ((LAS float*)(F.lds + CWL_OFF))[i] = pn < NC / 256 ? (FIN(18) + (size_t)j * 3 * 2048)[q * 2048 + pn * 64 + c] : 0.f; }
                rstd_table(((float*)(F.ws + WS_RSQ)), u0.pm, (LAS float*)(F.lds + RSTD_OFF), F.tid);
                EpiG1Odd E{((float*)(F.ws + WS_RSQ)), ((bf16_t*)(F.ws + WS_A2)), FIN(18) + (size_t)j * 3 * 2048, F.out + O_CONVP + (size_t)j * 8 * 2 * 2048, ((float*)(F.ws + WS_SIDE)), (LAS float*)(F.lds + HALO_OFF), (LAS const float*)(F.lds + RSTD_OFF), u0.pm, (LAS const float*)(F.lds + CWL_OFF), u0.pn};
                SEpiZ SE{((float*)(F.ws + WS_SMALL)), ((float*)(F.ws + WS_SZ)), 8192, 1};
                const bool s_first = (F.rk & 1) != 0;
                if (s_first) { REP(3) sgemm16<SEpiZ, NC>(F, ((bf16_t*)(F.ws + WS_XB)) + (size_t)MP * D, ((bf16_t*)(F.ws + WS_C1)) + (size_t)j * NC * D, D, SE); }
                REP(6) pg8::gemm_phase<EpiG1Odd, pg8::StaticOrder, true, true>(F.lds, g, S, E, F.wave);
                if (!s_first) { REP(3) sgemm16<SEpiZ, NC>(F, ((bf16_t*)(F.ws + WS_XB)) + (size_t)MP * D, ((bf16_t*)(F.ws + WS_C1)) + (size_t)j * NC * D, D, SE); }
            } PH_END
            PH_BEGIN {
                REP(5) for (int i = F.rk; i < 16; i += F.rw) sample_conv_odd(F, j, 16 * F.xq + i);
            } PH_END
        }
        PH_BEGIN {
            const bf16_t* W2 = ((l & 1) ? ((bf16_t*)(F.ws + WS_C2)) : ((bf16_t*)(F.ws + WS_AB2))) + (size_t)j * D * 2048;
            pg8::Gemm g{((bf16_t*)(F.ws + WS_A2)), W2, MP, D, 2048}; pg8::StaticOrder S; S.init(MP, D, F.G, (int)F.vid);
            if (l & 1) { Unit fu; for (int i = 0; S.next(i, fu); ++i) conv_fixup(((float*)(F.ws + WS_SIDE)), FIN(18) + (size_t)j * 3 * 2048, ((bf16_t*)(F.ws + WS_A2)), fu.pm, F.tid); asm volatile("s_waitcnt vmcnt(0)" ::: "memory"); __syncthreads(); }
            EpiRes E{((bf16_t*)(F.ws + WS_XB)), ((float*)(F.ws + WS_RSQ))};
            pg8::gemm_phase<EpiRes, pg8::StaticOrder, true, true>(F.lds, g, S, E, F.wave);
            SEpiRes SE{((float*)(F.ws + WS_XS)), ((bf16_t*)(F.ws + WS_XB)) + (size_t)MP * D, ((float*)(F.ws + WS_SMALL))};
            sgemm16<SEpiRes, D>(F, ((bf16_t*)(F.ws + WS_SA2)), W2, 2048, SE);
        } PH_END
        PH_BEGIN {
            pg8::Gemm g{((bf16_t*)(F.ws + WS_XB)), ((bf16_t*)(F.ws + WS_WQ)) + (size_t)l * D * D, MP, D, D}; pg8::StaticOrder S; S.init(MP, D, F.G, (int)F.vid);
            Unit u0{0, 0}; S.next(0, u0); rstd_table(((float*)(F.ws + WS_RSQ)), u0.pm, (LAS float*)(F.lds + RSTD_OFF), F.tid);
            EpiQ E{((float*)(F.ws + WS_RSQ)), ((bf16_t*)(F.ws + WS_Q)), (LAS const float*)(F.lds + RSTD_OFF), u0.pm};
            REP(8) pg8::gemm_phase<EpiQ, pg8::StaticOrder, true, true>(F.lds, g, S, E, F.wave);
            SEpiQ SE{((float*)(F.ws + WS_SMALL)), ((float*)(F.ws + WS_SQ))};
            REP(9) sgemm16<SEpiQ, D>(F, ((bf16_t*)(F.ws + WS_XB)) + (size_t)MP * D, ((bf16_t*)(F.ws + WS_WQ)) + (size_t)l * D * D, D, SE);
        } PH_END
        PH_BEGIN {
            if (F.G == 256) { REP(10) attn_fused(F, l); }
            else { attn_prompt(F, l); attn_sample(F, l); }
        } PH_END
        PH_BEGIN {
            pg8::Gemm g{((bf16_t*)(F.ws + WS_O)), ((bf16_t*)(F.ws + WS_WO)) + (size_t)l * D * D, MP, D, D}; pg8::StaticOrder S; S.init(MP, D, F.G, (int)F.vid);
            EpiRes E{((bf16_t*)(F.ws + WS_XB)), ((float*)(F.ws + WS_RSQ))};
            pg8::gemm_phase<EpiRes, pg8::StaticOrder, true, true>(F.lds, g, S, E, F.wave);
            SEpiRes SE{((float*)(F.ws + WS_XS)), ((bf16_t*)(F.ws + WS_XB)) + (size_t)MP * D, ((float*)(F.ws + WS_SMALL))};
            sgemm16<SEpiRes, D>(F, ((bf16_t*)(F.ws + WS_SO)), ((bf16_t*)(F.ws + WS_WO)) + (size_t)l * D * D, D, SE);
        } PH_END
    }
    PH_BEGIN final_norm(F0); PH_END
#undef PH_BEGIN
#undef PH_END
}
constexpr int N_PHASES = 2 + 6 * DEPTH + 1;

extern "C" void kernel_launch(void* const* d_in, const int* in_sizes, int n_in, void* d_out, int out_size, void* d_ws, size_t ws_size, hipStream_t stream) {
    static int grid = 0;
    if (grid == 0) {
        if (n_in != 25 || in_sizes[0] != MP * D || (size_t)out_size != O_END || ws_size < WS_END) { fprintf(stderr, "kernel_launch: unexpected shapes (n_in %d, in0 %d, out %d, ws %zu); nothing launched\n", n_in, n_in > 0 ? in_sizes[0] : -1, out_size, ws_size); grid = -1; return; }
        int dev = 0, cus = 0, per_cu = 0;
        if (hipGetDevice(&dev) != hipSuccess || hipDeviceGetAttribute(&cus, hipDeviceAttributeMultiprocessorCount, dev) != hipSuccess) { fprintf(stderr, "kernel_launch: device query failed\n"); grid = -1; return; }
        if (hipFuncSetAttribute((const void*)fwd, hipFuncAttributeMaxDynamicSharedMemorySize, LDS_BYTES) != hipSuccess) { fprintf(stderr, "kernel_launch: hipFuncSetAttribute failed\n"); grid = -1; return; }
        if (hipOccupancyMaxActiveBlocksPerMultiprocessor(&per_cu, (const void*)fwd, NWAVES * 64, LDS_BYTES) != hipSuccess || per_cu < 1) fprintf(stderr, "kernel_launch: note: occupancy query reports %d workgroups per CU\n", per_cu);
        (void)hipGetLastError();
        grid = cus;
    }
    if (grid < 0) return;
    if (hipMemsetAsync((char*)d_ws + WS_CTL, 0, CTL_ZERO_BYTES, stream) != hipSuccess) { fprintf(stderr, "kernel_launch: memset failed\n"); return; }
    Args a{};
    for (int i = 0; i < 25; ++i) a.in[i] = (const float*)d_in[i];
    a.out = (float*)d_out; a.ws = (unsigned char*)d_ws;
#if MK_SPLIT
    for (int p = 0; p < N_PHASES; ++p) { a.ph_lo = p; a.ph_hi = p + 1; hipLaunchKernelGGL(fwd, dim3(grid), dim3(NWAVES * 64), LDS_BYTES, stream, a); }
#else
    a.ph_lo = 0; a.ph_hi = N_PHASES;
    hipLaunchKernelGGL(fwd, dim3(grid), dim3(NWAVES * 64), LDS_BYTES, stream, a);
#endif
    const hipError_t le = hipPeekAtLastError();
    if (le != hipSuccess) fprintf(stderr, "kernel_launch: launch failed: %s\n", hipGetErrorName(le));
}
```

```cpp
#include <hip/hip_runtime.h>
#include <cstdio>
#include <cstdint>
#ifndef REP_MASK
#define REP_MASK 0
#endif
#ifndef STAGGER_TICKS
#define STAGGER_TICKS 0
#endif
#ifndef PB_ODD_PCT
#define PB_ODD_PCT 100
#endif
#ifndef SPLIT_PROLOGUE
#define SPLIT_PROLOGUE 1
#endif
#ifndef XCD_LOCAL
#define XCD_LOCAL 1
#endif
#ifndef XCD_VID
#define XCD_VID 0
#endif
#ifndef MK_SPLIT
#define MK_SPLIT 0
#endif
__device__ __forceinline__ int hw_lane() { int l; asm volatile("v_mbcnt_lo_u32_b32 %0, -1, 0\n\tv_mbcnt_hi_u32_b32 %0, -1, %0" : "=v"(l)); return l; }
namespace pg8 {
#define PG8_LAS __attribute__((address_space(3)))
typedef unsigned short bf16_t;
typedef short bf16x8 __attribute__((ext_vector_type(8)));
typedef float f32x4 __attribute__((ext_vector_type(4)));
typedef unsigned u32x4 __attribute__((ext_vector_type(4)));
constexpr int BM = 256, BK = 64, HALF = 128, HTB = HALF * BK * 2  , STAGE_BYTES = 8 * HTB, NXCD = 8, WGM = 8;

__host__ __device__ __forceinline__ int lds_byte(int r, int c) { const int st = (r >> 4) * 2 + (c >> 5), rr = r & 15, cc = c & 31, ob = rr * 64 + cc * 2; return st * 1024 + (ob ^ (((ob >> 9) & 1) << 5)); }
__host__ __device__ __forceinline__ void stage_rc(int b, int& R, int& C) { const int st = b / 1024, sb = b % 1024, swz = sb ^ (((sb >> 9) & 1) << 5); R = (st >> 1) * 16 + swz / 64; C = (st & 1) * 32 + (swz % 64) / 2; }
__host__ __device__ __forceinline__ int perm32(int rho) { const int n = rho >> 4, i = rho & 15; return 8 * (i >> 2) + 4 * n + (i & 3); }

struct Unit { int pm, pn; };
struct Gemm { const bf16_t* A; const bf16_t* Bt; int M, N, K; };

struct StaticOrder {
    int nM, nN, nwg, G, c;
    __host__ __device__ __forceinline__ void init(int M, int N, int G_, int c_) { nM = M / BM; nN = N / BM; nwg = nM * nN; G = G_; c = c_; }
    __host__ __device__ __forceinline__ bool next(int i, Unit& u) const {
        const long L = (long)i * G + c; if (L >= nwg) return false;
        int wgid = (int)L; { const int q = nwg / NXCD, r = nwg % NXCD, xcd = wgid % NXCD, off = wgid / NXCD; wgid = (xcd < r ? xcd * (q + 1) : r * (q + 1) + (xcd - r) * q) + off; }
        const int nig = WGM * nN, gid = wgid / nig, fm = gid * WGM, gsz = (nM - fm) < WGM ? (nM - fm) : WGM;
        u.pm = fm + ((wgid % nig) % gsz); u.pn = (wgid % nig) / gsz; return true;
    }
    __device__ __forceinline__ void a_ready(const Unit&) const {}
    __device__ __forceinline__ void done(const Unit&) const {}
};

typedef float f32x2cv __attribute__((ext_vector_type(2))); typedef __bf16 bf16x2cv __attribute__((ext_vector_type(2)));
__device__ __forceinline__ unsigned cvt_pk_bf16(float lo, float hi) { const f32x2cv v = {lo, hi}; return __builtin_bit_cast(unsigned, __builtin_convertvector(v, bf16x2cv)); }
template <class Epi, class Sched, bool ALIGN_EPI = false, bool SP2 = false>
__device__ __forceinline__ void gemm_phase(PG8_LAS unsigned char* lds, const Gemm g, const Sched& S, const Epi& E, const int wave_id) {
    int tid_ = (wave_id << 6) | hw_lane(); asm volatile("" : "+v"(tid_));
    const int tid = tid_, wid = __builtin_amdgcn_readfirstlane(tid >> 6), lane = tid & 63, wr = wid >> 2, wc = wid & 3, fr = lane & 15, fq = lane >> 4;
    const int K = g.K, nt = K / BK;
    unsigned voffA[2], voffB[2];
#pragma unroll
    for (int i = 0; i < 2; ++i) { int R, C; stage_rc(tid * 16 + i * 8192, R, C); const int Rb = Epi::PERM ? ((R & ~31) + perm32(R & 31)) : R;
        voffA[i] = (unsigned)(R * K + C) * 2u; voffB[i] = (unsigned)(Rb * K + C) * 2u; }
    const size_t kstep = (size_t)(BK * 2);
    const size_t hstep = (size_t)HALF * K * 2;
    const size_t tstep = 2 * hstep;
    const unsigned ldsw = (unsigned)wid * 1024u;
    const int aoff = lds_byte(wr * 64 + fr, fq * 8), boff = lds_byte(wc * 32 + fr, fq * 8);
#define PG8_SA(b, h) (((b) * 2 + (h)) * HTB)
#define PG8_SB(b, h) ((4 + (b) * 2 + (h)) * HTB)
#define PG8_STAGE(bufoff, gbase, voff) do { _Pragma("unroll") for (int _i = 0; _i < 2; ++_i) \
        __builtin_amdgcn_global_load_lds((const unsigned*)((const char*)(gbase) + (voff)[_i]), (PG8_LAS unsigned*)(lds + (bufoff) + ldsw + _i * 8192), 16, 0, 0); } while (0)
#define PG8_LDA(dst, b, h) do { _Pragma("unroll") for (int m = 0; m < 4; ++m) _Pragma("unroll") for (int k = 0; k < 2; ++k) dst[m][k] = *(const PG8_LAS bf16x8*)(lds + PG8_SA(b, h) + aoff + m * 2048 + k * 1024); } while (0)
#define PG8_LDB(dst, b, h) do { _Pragma("unroll") for (int n = 0; n < 2; ++n) _Pragma("unroll") for (int k = 0; k < 2; ++k) dst[n][k] = *(const PG8_LAS bf16x8*)(lds + PG8_SB(b, h) + boff + n * 2048 + k * 1024); } while (0)
#define PG8_MMA(ai, bj, At, Bt) do { __builtin_amdgcn_s_setprio(1); _Pragma("unroll") for (int m = 0; m < 4; ++m) _Pragma("unroll") for (int n = 0; n < 2; ++n) _Pragma("unroll") for (int k = 0; k < 2; ++k) \
        acc[ai][bj][m][n] = __builtin_amdgcn_mfma_f32_16x16x32_bf16(Bt[n][k], At[m][k], acc[ai][bj][m][n], 0, 0, 0); __builtin_amdgcn_s_setprio(0); } while (0)
#define PG8_WAIT_V(n) asm volatile("s_waitcnt vmcnt(" #n ")" ::: "memory")
#define PG8_WAIT_L(n) asm volatile("s_waitcnt lgkmcnt(" #n ")" ::: "memory")
#define PG8_BAR __builtin_amdgcn_s_barrier()
#define PG8_SCHED __builtin_amdgcn_sched_barrier(0)
    Unit cur, nxt; int ui = 0;
    if (!S.next(0, cur)) return;
    f32x4 acc[2][2][4][2];
#pragma unroll
    for (int a = 0; a < 2; ++a)
#pragma unroll
        for (int b = 0; b < 2; ++b)
#pragma unroll
            for (int m = 0; m < 4; ++m)
#pragma unroll
                for (int n = 0; n < 2; ++n) acc[a][b][m][n] = (f32x4){0.f, 0.f, 0.f, 0.f};
    bf16x8 At[4][2], B0[2][2], B1[2][2];
    const char* cA = (const char*)g.A + (size_t)cur.pm * tstep; const char* cB = (const char*)g.Bt + (size_t)cur.pn * tstep;
    S.a_ready(cur);
    if constexpr (SP2) {
        PG8_STAGE(PG8_SB(0, 0), cB, voffB); PG8_STAGE(PG8_SB(0, 1), cB + hstep, voffB); PG8_STAGE(PG8_SA(0, 0), cA, voffA); PG8_STAGE(PG8_SA(0, 1), cA + hstep, voffA);
        if (wr == 1) PG8_BAR;
        PG8_WAIT_V(2); PG8_BAR;
        PG8_STAGE(PG8_SB(1, 0), cB + kstep, voffB); PG8_STAGE(PG8_SA(1, 0), cA + kstep, voffA); PG8_STAGE(PG8_SB(1, 1), cB + hstep + kstep, voffB);
        PG8_WAIT_V(6); PG8_BAR;
    } else {
        PG8_STAGE(PG8_SB(0, 0), cB, voffB); PG8_STAGE(PG8_SA(0, 0), cA, voffA); PG8_STAGE(PG8_SB(0, 1), cB + hstep, voffB); PG8_STAGE(PG8_SA(0, 1), cA + hstep, voffA);
        if (wr == 1) PG8_BAR;
        PG8_WAIT_V(4); PG8_BAR;
        PG8_STAGE(PG8_SB(1, 0), cB + kstep, voffB); PG8_STAGE(PG8_SA(1, 0), cA + kstep, voffA); PG8_STAGE(PG8_SB(1, 1), cB + hstep + kstep, voffB);
        PG8_WAIT_V(6); PG8_BAR;
    }
    for (;;) {
        const bool has_next = S.next(ui + 1, nxt);
        const char* nA = has_next ? (const char*)g.A + (size_t)nxt.pm * tstep : cA; const char* nB = has_next ? (const char*)g.Bt + (size_t)nxt.pn * tstep : cB;
        for (int t = 0; t < nt; t += 2) {
            const bool last = (t == nt - 2);
            const char* a1 = cA + (size_t)(t + 1) * kstep;
            const char* a2 = last ? nA : cA + (size_t)(t + 2) * kstep; const char* b2 = last ? nB : cB + (size_t)(t + 2) * kstep;
            const char* a3 = a2 + kstep; const char* b3 = b2 + kstep;
            if (last && has_next) S.a_ready(nxt);
            if constexpr (SP2) {
            PG8_LDB(B0, 0, 0); PG8_LDB(B1, 0, 1); PG8_SCHED; PG8_LDA(At, 0, 0); PG8_STAGE(PG8_SA(1, 1), a1 + hstep, voffA);
            PG8_WAIT_V(8); PG8_WAIT_L(0); PG8_BAR; PG8_MMA(0, 0, At, B0); PG8_MMA(0, 1, At, B1); PG8_BAR; PG8_SCHED;
            PG8_LDA(At, 0, 1); PG8_STAGE(PG8_SB(0, 0), b2, voffB); PG8_STAGE(PG8_SB(0, 1), b2 + hstep, voffB); PG8_STAGE(PG8_SA(0, 0), a2, voffA);
            PG8_WAIT_V(8); PG8_WAIT_L(0); PG8_BAR; PG8_MMA(1, 0, At, B0); PG8_MMA(1, 1, At, B1); PG8_BAR; PG8_SCHED;
            PG8_LDB(B0, 1, 0); PG8_LDB(B1, 1, 1); PG8_SCHED; PG8_LDA(At, 1, 0); PG8_STAGE(PG8_SA(0, 1), a2 + hstep, voffA);
            PG8_WAIT_V(8); PG8_WAIT_L(0); PG8_BAR; PG8_MMA(0, 0, At, B0); PG8_MMA(0, 1, At, B1); PG8_BAR; PG8_SCHED;
            PG8_LDA(At, 1, 1); PG8_STAGE(PG8_SB(1, 0), b3, voffB); PG8_STAGE(PG8_SB(1, 1), b3 + hstep, voffB); PG8_STAGE(PG8_SA(1, 0), a3, voffA);
            PG8_WAIT_V(8); PG8_WAIT_L(0); PG8_BAR; PG8_MMA(1, 0, At, B0); PG8_MMA(1, 1, At, B1); PG8_BAR; PG8_SCHED;
            } else {
            PG8_LDB(B0, 0, 0); PG8_SCHED; PG8_LDA(At, 0, 0); PG8_STAGE(PG8_SA(1, 1), a1 + hstep, voffA);
            PG8_WAIT_L(8); PG8_BAR; PG8_WAIT_L(0); PG8_MMA(0, 0, At, B0); PG8_BAR; PG8_SCHED;
            PG8_LDB(B1, 0, 1); PG8_STAGE(PG8_SB(0, 0), b2, voffB);
            PG8_BAR; PG8_WAIT_L(0); PG8_MMA(0, 1, At, B1); PG8_BAR;
            PG8_LDA(At, 0, 1); PG8_STAGE(PG8_SA(0, 0), a2, voffA);
            PG8_BAR; PG8_WAIT_L(0); PG8_MMA(1, 0, At, B0); PG8_BAR; PG8_SCHED;
            PG8_STAGE(PG8_SB(0, 1), b2 + hstep, voffB);
            PG8_WAIT_V(6); PG8_BAR; PG8_MMA(1, 1, At, B1); PG8_BAR;
            PG8_LDB(B0, 1, 0); PG8_SCHED; PG8_LDA(At, 1, 0); PG8_STAGE(PG8_SA(0, 1), a2 + hstep, voffA);
            PG8_WAIT_L(8); PG8_BAR; PG8_WAIT_L(0); PG8_MMA(0, 0, At, B0); PG8_BAR; PG8_SCHED;
            PG8_LDB(B1, 1, 1); PG8_STAGE(PG8_SB(1, 0), b3, voffB);
            PG8_BAR; PG8_WAIT_L(0); PG8_MMA(0, 1, At, B1); PG8_BAR;
            PG8_LDA(At, 1, 1); PG8_STAGE(PG8_SA(1, 0), a3, voffA);
            PG8_BAR; PG8_WAIT_L(0); PG8_MMA(1, 0, At, B0); PG8_BAR; PG8_SCHED;
            PG8_STAGE(PG8_SB(1, 1), b3 + hstep, voffB);
            PG8_WAIT_V(6); PG8_BAR; PG8_MMA(1, 1, At, B1); PG8_BAR;
            }
        }
        if constexpr (ALIGN_EPI) { if (wr == 0) PG8_BAR; }
        if constexpr (!Epi::AFTER_DRAIN) { for (int rep_ = 0; rep_ < 1 + (Epi::REP_EPI ? 1 : 0); ++rep_) E(acc, cur, wr, wc, fr, fq); S.done(cur); }
        if (!has_next) break;
#pragma unroll
        for (int a = 0; a < 2; ++a)
#pragma unroll
            for (int b = 0; b < 2; ++b)
#pragma unroll
                for (int m = 0; m < 4; ++m)
#pragma unroll
                    for (int n = 0; n < 2; ++n) acc[a][b][m][n] = (f32x4){0.f, 0.f, 0.f, 0.f};
        cur = nxt; cA = nA; cB = nB; ++ui;
        if constexpr (ALIGN_EPI) { if (wr == 1) PG8_BAR; }
    }
    PG8_WAIT_V(0);
    if constexpr (!ALIGN_EPI) { if (wr == 0) PG8_BAR; }
    PG8_BAR;
    if constexpr (Epi::AFTER_DRAIN) { E.fused(acc, cur, wr, wc, fr, fq, lds, wid, lane); S.done(cur); }
#undef PG8_SA
#undef PG8_SB
#undef PG8_STAGE
#undef PG8_LDA
#undef PG8_LDB
#undef PG8_MMA
#undef PG8_WAIT_V
#undef PG8_WAIT_L
#undef PG8_BAR
#undef PG8_SCHED
}
}

using pg8::bf16_t; using pg8::bf16x8; using pg8::f32x4; using pg8::u32x4; using pg8::Unit; using pg8::cvt_pk_bf16;
#define GAS __attribute__((address_space(1)))
#define LAS __attribute__((address_space(3)))
typedef unsigned u32x2 __attribute__((ext_vector_type(2)));
typedef short s16x4 __attribute__((ext_vector_type(4)));
typedef GAS unsigned gu32;
#define RLX_AGENT __ATOMIC_RELAXED, __HIP_MEMORY_SCOPE_AGENT

constexpr int NWAVES = 8;
constexpr int D = 1024, MP = 16384, MS = 128, SEQ = 2048, NBATCH = 8, NMEM = 256, MMEM = 2048, DEPTH = 4;
constexpr int NAB = 5120, NC = 8192;
constexpr float EPS = 1e-6f;
constexpr float QSCALE = 0.0625f * 1.4426950408889634f;

constexpr size_t O_Y = 0, O_YS = O_Y + (size_t)MP * D, O_POOLP = O_YS + (size_t)MS * D, O_POOLS = O_POOLP + 2 * 8 * 15 * 1024,
                 O_CONVP = O_POOLS + (size_t)2 * 128 * 15 * 1024, O_CONVS = O_CONVP + 2 * 8 * 2 * 2048, O_SGUV = O_CONVS + (size_t)2 * 128 * 2 * 2048,
                 O_MEMK = O_SGUV + 2 * 128 * 1024, O_MEMV = O_MEMK + (size_t)4 * MMEM * D, O_END = O_MEMV + (size_t)4 * MMEM * D;
static_assert(O_END == 39239680, "output size");

constexpr size_t MiB = 1u << 20;
constexpr size_t WS_CTL = 0, CTL_ZERO_BYTES = 1 * MiB;
constexpr size_t WS_AB1 = 2 * MiB, WS_C1 = 22 * MiB, WS_AB2 = 54 * MiB, WS_C2 = 62 * MiB, WS_WQ = 70 * MiB, WS_WKV = 78 * MiB, WS_WO = 94 * MiB, WS_PMT = 102 * MiB;
constexpr size_t WS_XB = 104 * MiB;
constexpr size_t WS_RSQ = 137 * MiB, WS_VSQ = 138 * MiB;
constexpr size_t WS_SMALL = 139 * MiB;
constexpr size_t WS_Z = 140 * MiB;
constexpr size_t WS_A2 = 268 * MiB;
constexpr size_t WS_Q = 332 * MiB, WS_O = 364 * MiB;
constexpr size_t WS_MEMB = 396 * MiB, WS_KB = 400 * MiB, WS_VB = 416 * MiB;
constexpr size_t WS_XS = 432 * MiB, WS_SZ = 433 * MiB, WS_SA2 = 437 * MiB, WS_SQ = 438 * MiB, WS_SO = 439 * MiB, WS_SIDE = 440 * MiB  , WS_END = 444 * MiB;
constexpr int CW_BAR = 4096, CW_RANK = 8192;

constexpr int RING_BYTES = 131072, LDSCTL_OFF = RING_BYTES, MISC_OFF = LDSCTL_OFF + 320, HALO_OFF = RING_BYTES + 1024  , RSTD_OFF = HALO_OFF + 8192  , CWL_OFF = RSTD_OFF + 1024  , LDS_BYTES = 155648;

#define LDS_WAIT() asm volatile("s_waitcnt lgkmcnt(0)" ::: "memory")
#define LDS_BARRIER() asm volatile("s_waitcnt lgkmcnt(0)\n\ts_barrier" ::: "memory")

#define XB_TMO      128
#define XB_XCNT(j)  (256  + 64 * (j))
#define XB_XSUB(j)  (1280 + 64 * (j))
#define XB_XGEN(j)  (2304 + 64 * (j))
#define XB_TOP      3328
#define XB_TOPGEN   3392
#define XCD_BAR_WORDS 3456
#define XB_SPIN_CAP (1u << 18)

__device__ __forceinline__ unsigned xb_ld(unsigned* p)              { return __hip_atomic_load(p, __ATOMIC_RELAXED, __HIP_MEMORY_SCOPE_AGENT); }
__device__ __forceinline__ unsigned xb_add(unsigned* p, unsigned v) { return __hip_atomic_fetch_add(p, v, __ATOMIC_RELAXED, __HIP_MEMORY_SCOPE_AGENT); }
__device__ __forceinline__ unsigned xb_xcc_id() { return (unsigned)__builtin_amdgcn_s_getreg((3 << 11) | 20) & 0xFu; }
#define XB_SPIN(cond, bar) do { unsigned _sp = 0; while (cond) { __builtin_amdgcn_s_sleep(1); \
    if ((++_sp & 255u) == 0u) { if (xb_ld(&(bar)[XB_TMO])) break; if (_sp > XB_SPIN_CAP) { atomicAdd(&(bar)[XB_TMO], 1u); break; } } } } while (0)

struct XcdBarrier {
    int wave;
    unsigned* bar; unsigned x;
    volatile LAS unsigned* st;
};

__device__ __forceinline__ XcdBarrier xcd_barrier_post(unsigned* bar, volatile LAS unsigned* st, int wave) {
    XcdBarrier b; b.wave = wave; b.bar = bar; b.x = xb_xcc_id(); b.st = st;
    if (b.wave == 0 && hw_lane() == 0) (void)xb_add(&bar[XB_XCNT(b.x)], 1u);
    return b;
}
__device__ __forceinline__ void xcd_barrier_complete(unsigned* bar, unsigned x, unsigned& nloc, unsigned& nx) {
    const unsigned G = gridDim.x * gridDim.y * gridDim.z;
    unsigned sum, cnt, mine, sp = 0u;
    for (;;) {
        sum = 0u; cnt = 0u; mine = 0u;
#pragma unroll
        for (unsigned j = 0; j < 16; ++j) { const unsigned c = xb_ld(&bar[XB_XCNT(j)]); sum += c; cnt += (c > 0u) ? 1u : 0u; mine = (j == x) ? c : mine; }
        if (sum == G) break;
        __builtin_amdgcn_s_sleep(1);
        if ((++sp & 255u) == 0u) { if (xb_ld(&bar[XB_TMO])) break; if (sp > XB_SPIN_CAP) { atomicAdd(&bar[XB_TMO], 1u); break; } }
    }
    nloc = mine > 0u ? mine : 1u; nx = cnt > 0u ? cnt : 1u;
}

__device__ __forceinline__ void xcd_barrier(const XcdBarrier& b) {
    asm volatile("s_waitcnt vmcnt(0)" ::: "memory");
    __syncthreads();
    if (b.wave == 0 && hw_lane() == 0) {
        unsigned* bar = b.bar;
        __builtin_amdgcn_s_waitcnt(0);
        unsigned nloc = b.st[0], nx = b.st[1];
        if (nloc == 0u) { xcd_barrier_complete(bar, b.x, nloc, nx); b.st[0] = nloc; b.st[1] = nx; }
        const unsigned old = xb_add(&bar[XB_XSUB(b.x)], 1u);
        const unsigned gen = old / nloc;
        if (old + 1u == (gen + 1u) * nloc) {
            __builtin_amdgcn_fence(__ATOMIC_RELEASE, "agent");
            asm volatile("s_waitcnt vmcnt(0)" ::: "memory");
            const unsigned og = xb_add(&bar[XB_TOP], 1u);
            const unsigned tg = og / nx;
            if (og + 1u == (tg + 1u) * nx) xb_add(&bar[XB_TOPGEN], 1u);
            else XB_SPIN(xb_ld(&bar[XB_TOPGEN]) == tg, bar);
            __builtin_amdgcn_fence(__ATOMIC_ACQUIRE, "agent");
            xb_add(&bar[XB_XGEN(b.x)], 1u);
            asm volatile("s_waitcnt vmcnt(0)" ::: "memory");
        } else {
            XB_SPIN(xb_ld(&bar[XB_XGEN(b.x)]) == gen, bar);
            __builtin_amdgcn_fence(__ATOMIC_ACQUIRE, "agent");
            asm volatile("s_waitcnt vmcnt(0)" ::: "memory");
        }
    }
    __syncthreads();
}

__device__ __forceinline__ void xcd_barrier_local(const XcdBarrier& b) {
    asm volatile("s_waitcnt vmcnt(0)" ::: "memory");
    __syncthreads();
    if (b.wave == 0 && hw_lane() == 0) {
        unsigned* bar = b.bar;
        __builtin_amdgcn_s_waitcnt(0);
        const unsigned nloc = b.st[0] ? b.st[0] : 1u;
        const unsigned old = xb_add(&bar[XB_XSUB(b.x)], 1u);
        const unsigned gen = old / nloc;
        if (old + 1u == (gen + 1u) * nloc) xb_add(&bar[XB_XGEN(b.x)], 1u);
        else XB_SPIN(xb_ld(&bar[XB_XGEN(b.x)]) == gen, bar);
        __builtin_amdgcn_fence(__ATOMIC_ACQUIRE, "agent");
        asm volatile("s_waitcnt vmcnt(0)" ::: "memory");
    }
    __syncthreads();
}

typedef const float* fptr_t;
typedef __attribute__((address_space(4))) const fptr_t* in_tab_t;
struct Frame {
    LAS unsigned char* lds;
    int tid, lane, wave, G, bx, vid, xq, rk, rw;
    in_tab_t in;
    float* out;
    unsigned char* ws;
};
__device__ __forceinline__ unsigned long long uni64(unsigned long long v) { const unsigned lo = __builtin_amdgcn_readfirstlane((unsigned)v), hi = __builtin_amdgcn_readfirstlane((unsigned)(v >> 32)); return ((unsigned long long)hi << 32) | lo; }
__device__ __forceinline__ Frame launder(const Frame& F0) {
    Frame F = F0;
    int wv_ = __builtin_amdgcn_readfirstlane(F0.wave);
    int ln_ = hw_lane();
    int g_ = __builtin_amdgcn_readfirstlane(F0.G), b_ = __builtin_amdgcn_readfirstlane(F0.bx), v_ = __builtin_amdgcn_readfirstlane(F0.vid);
    unsigned long long w_ = uni64((unsigned long long)F0.ws), o_ = uni64((unsigned long long)F0.out), i_ = uni64((unsigned long long)F0.in);
    asm volatile("" : "+v"(ln_), "+s"(wv_), "+s"(g_), "+s"(b_), "+s"(v_), "+s"(w_), "+s"(o_), "+s"(i_));
    F.tid = (wv_ << 6) | ln_; F.G = g_; F.bx = b_; F.vid = v_; F.xq = b_ & 7; F.rk = b_ >> 3; F.rw = (g_ - (b_ & 7) + 7) >> 3; F.ws = (unsigned char*)(GAS unsigned char*)w_; F.out = (float*)(GAS float*)o_; F.in = (in_tab_t)i_;
    F.lane = ln_; F.wave = wv_;
    return F;
}
#define FIN(k) ((const float*)(const GAS float*)(F.in[k]))


__device__ __forceinline__ float shx(float v, int mask, int lane) { return __builtin_bit_cast(float, __builtin_amdgcn_ds_bpermute((lane ^ mask) << 2, __builtin_bit_cast(int, v))); }
__device__ __forceinline__ float wave_sum(float v, int lane) {
#pragma unroll
    for (int o = 1; o < 64; o <<= 1) v += shx(v, o, lane);
    return v;
}
__device__ __forceinline__ float silu_f(float x) { return x * __builtin_amdgcn_rcpf(1.f + __builtin_amdgcn_exp2f(-1.4426950408889634f * x)); }
__device__ __forceinline__ f32x4 silu4(f32x4 v) { return (f32x4){silu_f(v[0]), silu_f(v[1]), silu_f(v[2]), silu_f(v[3])}; }
__device__ __forceinline__ float dot4(f32x4 a, f32x4 b) { return (a[0] * b[0] + a[1] * b[1]) + (a[2] * b[2] + a[3] * b[3]); }
__device__ __forceinline__ u32x4 pack8(f32x4 a, f32x4 b) { u32x4 w; w.x = cvt_pk_bf16(a[0], a[1]); w.y = cvt_pk_bf16(a[2], a[3]); w.z = cvt_pk_bf16(b[0], b[1]); w.w = cvt_pk_bf16(b[2], b[3]); return w; }
__device__ __forceinline__ u32x2 pack4(f32x4 a) { u32x2 w; w.x = cvt_pk_bf16(a[0], a[1]); w.y = cvt_pk_bf16(a[2], a[3]); return w; }
__device__ __forceinline__ float bflo(unsigned w) { return __uint_as_float(w << 16); }
__device__ __forceinline__ float bfhi(unsigned w) { return __uint_as_float(w & 0xffff0000u); }
__device__ __forceinline__ void unpack8(u32x4 w, f32x4& a, f32x4& b) { a = (f32x4){bflo(w.x), bfhi(w.x), bflo(w.y), bfhi(w.y)}; b = (f32x4){bflo(w.z), bfhi(w.z), bflo(w.w), bfhi(w.w)}; }
__device__ __forceinline__ f32x4 unpack4(u32x2 w) { return (f32x4){bflo(w.x), bfhi(w.x), bflo(w.y), bfhi(w.y)}; }
__device__ __forceinline__ float rstd16(const float* p) {
    const f32x4 a = ((const f32x4*)p)[0], b = ((const f32x4*)p)[1], c = ((const f32x4*)p)[2], d = ((const f32x4*)p)[3];
    const f32x4 s = (a + b) + (c + d);
    return rsqrtf(((s[0] + s[1]) + (s[2] + s[3])) * (1.0f / D) + EPS);
}
__device__ __forceinline__ float rstd32(const float* p) {
    f32x4 s = ((const f32x4*)p)[0];
#pragma unroll
    for (int i = 1; i < 8; ++i) s += ((const f32x4*)p)[i];
    return rsqrtf(((s[0] + s[1]) + (s[2] + s[3])) * (1.0f / D) + EPS);
}
__host__ __device__ __forceinline__ int src_even(int n) {
    const int tile = n >> 8, o = n & 255;
    if (tile < 8) return n;
    if (tile < 12) return 3072 + (n - 2048);
    const int cb = tile - 12;
    return o < 128 ? 2048 + 128 * cb + o : 4096 + 128 * cb + (o - 128);
}
__host__ __device__ __forceinline__ int src_odd(int n) {
    const int pn = n >> 8, p = n & 255, q = ((p >> 7) << 1) | ((p >> 2) & 1), ch = 64 * pn + 16 * ((p >> 5) & 3) + 4 * ((p >> 3) & 3) + (p & 3);
    const int base = q == 0 ? 2048 : (q == 1 ? 4096 : (q == 2 ? 0 : 6144));
    return base + ch;
}

__device__ __forceinline__ void rstd_table(const float* rsq, int pm, LAS float* tab, int tid) {
    if (tid < 256) tab[tid] = rstd16(rsq + ((size_t)pm * 256 + tid) * 16);
    LDS_BARRIER();
}
struct EpiG1Even {
    static constexpr bool PERM = true, AFTER_DRAIN = false, REP_EPI = (REP_MASK >> 12) & 1;
    const float* rsq; bf16_t* Z; float* vsq; float* pool_out; LAS const float* rtab; int pm0;
    __device__ __forceinline__ void operator()(const f32x4 (&acc)[2][2][4][2], const Unit& u, int wr, int wc, int fr_, int fq_) const {
        int fr = fr_, fq = fq_; asm volatile("" : "+v"(fr), "+v"(fq));
        const int tile = u.pn, cw = wc * 32 + 8 * fq;
#pragma unroll
        for (int ai = 0; ai < 2; ++ai)
#pragma unroll
            for (int m = 0; m < 4; ++m) {
                const int row = u.pm * 256 + ai * 128 + wr * 64 + m * 16 + fr;
                const float rs = u.pm == pm0 ? rtab[ai * 128 + wr * 64 + m * 16 + fr] : rstd16(rsq + (size_t)row * 16);
                if (tile < 12) {
                    const int kind = tile >> 2;
                    bf16_t* dst = Z + (size_t)kind * MP * D + (size_t)row * D + (tile & 3) * 256 + cw;
                    float ss = 0.f;
#pragma unroll
                    for (int bj = 0; bj < 2; ++bj) {
                        f32x4 v0 = acc[ai][bj][m][0] * rs, v1 = acc[ai][bj][m][1] * rs;
                        if (kind == 1) { v0 = silu4(v0); v1 = silu4(v1); }
                        if (kind == 2) ss += dot4(v0, v0) + dot4(v1, v1);
                        *(u32x4*)(dst + bj * 128) = pack8(v0, v1);
                        if (kind == 0 && (row & 2047) >= 2033) {
                            float* po = pool_out + ((size_t)(row >> 11) * 15 + ((row & 2047) - 2033)) * 1024 + (tile & 3) * 256 + bj * 128 + cw;
                            *(f32x4*)po = v0; *(f32x4*)(po + 4) = v1;
                        }
                    }
                    if (kind == 2) { ss += shx(ss, 16, 16 * fq + fr); ss += shx(ss, 32, 16 * fq + fr); if (fq == 0) vsq[(size_t)row * 16 + (tile - 8) * 4 + wc] = ss; }
                } else {
                    const int cb = tile - 12;
                    bf16_t* dst = Z + (size_t)3 * MP * D + (size_t)row * D + cb * 128 + cw;
                    const f32x4 u0 = acc[ai][0][m][0] * rs, u1 = acc[ai][0][m][1] * rs, g0 = acc[ai][1][m][0] * rs, g1 = acc[ai][1][m][1] * rs;
                    *(u32x4*)dst = pack8(u0 * silu4(g0), u1 * silu4(g1));
                }
            }
    }
};
__device__ __forceinline__ float dpp_shr1(float old, float v) { return __builtin_bit_cast(float, __builtin_amdgcn_update_dpp(__builtin_bit_cast(int, old), __builtin_bit_cast(int, v), 0x111, 0xf, 0xf, false)); }
__device__ __forceinline__ float dpp_shr2(float old, float v) { return __builtin_bit_cast(float, __builtin_amdgcn_update_dpp(__builtin_bit_cast(int, old), __builtin_bit_cast(int, v), 0x112, 0xf, 0xf, false)); }
struct EpiG1Odd {
    static constexpr bool PERM = true, AFTER_DRAIN = false, REP_EPI = false;
    const float* rsq; bf16_t* A2; const float* cw; float* conv_out; float* side; LAS float* halo; LAS const float* rtab; int pm0; LAS const float* cwl; int pn0;
    __device__ __forceinline__ void operator()(const f32x4 (&acc)[2][2][4][2], const Unit& u, int wr, int wc, int fr_, int fq_) const {
        int fr = fr_, fq = fq_; asm volatile("" : "+v"(fr), "+v"(fq));
        const int chl = wc * 16 + 4 * fq, ch = u.pn * 64 + chl;
        f32x4 w0, w1, w2;
        { const int ui = (u.pn - pn0) >> 2;
          if (u.pm == pm0 && ui >= 0 && ui < 8 && ((u.pn - pn0) & 3) == 0) { w0 = *(const LAS f32x4*)(cwl + (ui * 3 + 0) * 64 + chl); w1 = *(const LAS f32x4*)(cwl + (ui * 3 + 1) * 64 + chl); w2 = *(const LAS f32x4*)(cwl + (ui * 3 + 2) * 64 + chl); }
          else { w0 = *(const f32x4*)(cw + ch); w1 = *(const f32x4*)(cw + 2048 + ch); w2 = *(const f32x4*)(cw + 4096 + ch); } }
        f32x4 e[2][4]; float rsv[2][4];
#pragma unroll
        for (int ai = 0; ai < 2; ++ai)
#pragma unroll
            for (int m = 0; m < 4; ++m) {
                const int rb = 8 * ai + 4 * wr + m, row = u.pm * 256 + 16 * rb + fr;
                const float rs = u.pm == pm0 ? rtab[16 * rb + fr] : rstd16(rsq + (size_t)row * 16); rsv[ai][m] = rs;
                e[ai][m] = (acc[ai][0][m][0] * rs) * (acc[ai][0][m][1] * rs);
                if (fr >= 14) *(LAS f32x4*)(halo + (rb * 2 + (fr - 14)) * 64 + chl) = e[ai][m];
                if (m & 1) asm volatile("" ::: "memory");
            }
        asm volatile("s_waitcnt lgkmcnt(0)" ::: "memory"); __builtin_amdgcn_s_barrier(); asm volatile("" ::: "memory");
        float* sd = side + (size_t)u.pm * 6 * 2048 + ch;
#pragma unroll
        for (int ai = 0; ai < 2; ++ai)
#pragma unroll
            for (int m = 0; m < 4; ++m) {
                const int rb = 8 * ai + 4 * wr + m, row = u.pm * 256 + 16 * rb + fr;
                const float rs = rsv[ai][m];
                const f32x4 sg = (acc[ai][1][m][0] * rs) * silu4(acc[ai][1][m][1] * rs);
                f32x4 h0 = (f32x4){0.f, 0.f, 0.f, 0.f}, h1 = h0;
                if (rb > 0) { h0 = *(const LAS f32x4*)(halo + ((rb - 1) * 2 + 0) * 64 + chl); h1 = *(const LAS f32x4*)(halo + ((rb - 1) * 2 + 1) * 64 + chl); }
                const f32x4 hx = fr == 0 ? h0 : h1, ev = e[ai][m];
                f32x4 e1, e2;
#pragma unroll
                for (int k = 0; k < 4; ++k) { e1[k] = dpp_shr1(h1[k], ev[k]); e2[k] = dpp_shr2(hx[k], ev[k]); }
                const f32x4 a = sg * (w0 * e2 + w1 * e1 + w2 * ev);
                const bool top = (rb == 0 && fr < 2);
                if (!(top && (u.pm & 7) != 0)) *(u32x2*)(A2 + (size_t)row * 2048 + ch) = pack4(a);
                if (top) { *(f32x4*)(sd + fr * 2048) = ev; *(f32x4*)(sd + (4 + fr) * 2048) = sg; }
                if (rb == 15 && fr >= 14) {
                    *(f32x4*)(sd + (2 + fr - 14) * 2048) = ev;
                    if ((u.pm & 7) == 7) *(f32x4*)(conv_out + ((size_t)(u.pm >> 3) * 2 + (fr - 14)) * 2048 + ch) = ev;
                }
            }
    }
};
__device__ __forceinline__ void conv_fixup(const float* side, const float* cw, bf16_t* A2, int pm, int tid) {
    if ((pm & 7) == 0) return;
    const int ch = 4 * tid;
    const float* sp = side + (size_t)(pm - 1) * 6 * 2048 + ch; const float* sc = side + (size_t)pm * 6 * 2048 + ch;
    const f32x4 em2 = *(const f32x4*)(sp + 2 * 2048), em1 = *(const f32x4*)(sp + 3 * 2048), e0 = *(const f32x4*)sc, e1 = *(const f32x4*)(sc + 2048), s0 = *(const f32x4*)(sc + 4 * 2048), s1 = *(const f32x4*)(sc + 5 * 2048);
    const f32x4 w0 = *(const f32x4*)(cw + ch), w1 = *(const f32x4*)(cw + 2048 + ch), w2 = *(const f32x4*)(cw + 4096 + ch);
    *(u32x2*)(A2 + (size_t)(pm * 256) * 2048 + ch) = pack4(s0 * (w0 * em2 + w1 * em1 + w2 * e0));
    *(u32x2*)(A2 + (size_t)(pm * 256 + 1) * 2048 + ch) = pack4(s1 * (w0 * em1 + w1 * e0 + w2 * e1));
}
struct EpiRes {
    static constexpr bool PERM = true, AFTER_DRAIN = false, REP_EPI = false;
    bf16_t* xb; float* rsq;
    __device__ __forceinline__ void operator()(const f32x4 (&acc)[2][2][4][2], const Unit& u, int wr, int wc, int fr_, int fq_) const {
        int fr = fr_, fq = fq_; asm volatile("" : "+v"(fr), "+v"(fq));
        const int cw = wc * 32 + 8 * fq;
#pragma unroll
        for (int ai = 0; ai < 2; ++ai) {
            u32x4 old[4][2];
#pragma unroll
            for (int m = 0; m < 4; ++m)
#pragma unroll
                for (int bj = 0; bj < 2; ++bj) old[m][bj] = *(const u32x4*)(xb + (size_t)(u.pm * 256 + ai * 128 + wr * 64 + m * 16 + fr) * D + u.pn * 256 + bj * 128 + cw);
#pragma unroll
            for (int m = 0; m < 4; ++m) {
                const int row = u.pm * 256 + ai * 128 + wr * 64 + m * 16 + fr;
                float ss = 0.f;
#pragma unroll
                for (int bj = 0; bj < 2; ++bj) {
                    f32x4 b0, b1; unpack8(old[m][bj], b0, b1);
                    const u32x4 wv = pack8(b0 + acc[ai][bj][m][0], b1 + acc[ai][bj][m][1]);
                    *(u32x4*)(xb + (size_t)row * D + u.pn * 256 + bj * 128 + cw) = wv;
                    f32x4 r0, r1; unpack8(wv, r0, r1);
                    ss += dot4(r0, r0) + dot4(r1, r1);
                }
                ss += shx(ss, 16, 16 * fq + fr); ss += shx(ss, 32, 16 * fq + fr);
                if (fq == 0) rsq[(size_t)row * 16 + u.pn * 4 + wc] = ss;
            }
        }
    }
};
struct EpiProbe {
    static constexpr bool PERM = true, AFTER_DRAIN = false, REP_EPI = false;
    bf16_t* O; int ldc;
    __device__ __forceinline__ void operator()(const f32x4 (&acc)[2][2][4][2], const Unit& u, int wr, int wc, int fr_, int fq_) const {
        int fr = fr_, fq = fq_; asm volatile("" : "+v"(fr), "+v"(fq));
        const int cw = wc * 32 + 8 * fq;
#pragma unroll
        for (int ai = 0; ai < 2; ++ai)
#pragma unroll
            for (int m = 0; m < 4; ++m) {
                const int row = u.pm * 256 + ai * 128 + wr * 64 + m * 16 + fr;
#pragma unroll
                for (int bj = 0; bj < 2; ++bj) *(u32x4*)(O + (size_t)row * ldc + u.pn * 256 + bj * 128 + cw) = pack8(acc[ai][bj][m][0], acc[ai][bj][m][1]);
            }
    }
};
struct EpiQ {
    static constexpr bool PERM = true, AFTER_DRAIN = false, REP_EPI = false;
    const float* rsq; bf16_t* Q; LAS const float* rtab; int pm0;
    __device__ __forceinline__ void operator()(const f32x4 (&acc)[2][2][4][2], const Unit& u, int wr, int wc, int fr_, int fq_) const {
        int fr = fr_, fq = fq_; asm volatile("" : "+v"(fr), "+v"(fq));
        const int cw = wc * 32 + 8 * fq;
#pragma unroll
        for (int ai = 0; ai < 2; ++ai)
#pragma unroll
            for (int m = 0; m < 4; ++m) {
                const int row = u.pm * 256 + ai * 128 + wr * 64 + m * 16 + fr;
                const float rs = u.pm == pm0 ? rtab[ai * 128 + wr * 64 + m * 16 + fr] : rstd16(rsq + (size_t)row * 16);
#pragma unroll
                for (int bj = 0; bj < 2; ++bj) *(u32x4*)(Q + (size_t)row * D + u.pn * 256 + bj * 128 + cw) = pack8(acc[ai][bj][m][0] * rs, acc[ai][bj][m][1] * rs);
            }
    }
};
struct EpiMemKV {
    static constexpr bool PERM = true, AFTER_DRAIN = false, REP_EPI = false;
    const float* rstdm; float* outk; float* outv; bf16_t* kb; bf16_t* vb;
    __device__ __forceinline__ void operator()(const f32x4 (&acc)[2][2][4][2], const Unit& u, int wr, int wc, int fr_, int fq_) const {
        int fr = fr_, fq = fq_; asm volatile("" : "+v"(fr), "+v"(fq));
        const int layer = u.pn >> 3, isv = (u.pn >> 2) & 1, cw = (u.pn & 3) * 256 + wc * 32 + 8 * fq;
        float* of = (isv ? outv : outk) + (size_t)layer * MMEM * D; bf16_t* ob = (isv ? vb : kb) + (size_t)layer * MMEM * D;
#pragma unroll
        for (int ai = 0; ai < 2; ++ai)
#pragma unroll
            for (int m = 0; m < 4; ++m) {
                const int row = u.pm * 256 + ai * 128 + wr * 64 + m * 16 + fr;
                const float rs = rstdm[row];
#pragma unroll
                for (int bj = 0; bj < 2; ++bj) {
                    const size_t off = (size_t)row * D + bj * 128 + cw;
                    const f32x4 v0 = acc[ai][bj][m][0] * rs, v1 = acc[ai][bj][m][1] * rs;
                    *(f32x4*)(of + off) = v0; *(f32x4*)(of + off + 4) = v1;
                    *(u32x4*)(ob + off) = pack8(v0, v1);
                }
            }
    }
};

struct TrItem { const float* wp; int ldw; const float* gk; float sc; bf16_t* wt; int K; };
__device__ __forceinline__ void p0_tr_desc(const float* W, int ldw, int K, int Nd, const float* gk, float sc, bf16_t* WT, int perm, int r, int lane, TrItem& t) {
    const int nblk = Nd / 32, kb = r / nblk, nb = r % nblk, dstn0 = 32 * nb, dn = dstn0 + (lane & 31);
    const int srccol = perm == 0 ? dn : (perm == 1 ? src_even(dn) : src_odd(dn));
    t.wp = W + (size_t)(64 * kb + (lane >> 5)) * ldw + srccol; t.ldw = ldw; t.gk = gk ? gk + 64 * kb : nullptr; t.sc = sc; t.wt = WT + (size_t)dstn0 * K + 64 * kb; t.K = K;
}
__device__ __forceinline__ void p0_resolve(Frame& F, int it, int lane, TrItem& t) {
    constexpr int I_AB1 = 16 * (NAB / 32), I_C1 = 16 * (NC / 32), I_2 = 32 * 32, I_SQ = 16 * 32, I_PM = 4 * 8;
    int r = it;
    if (r < 2 * I_AB1) { const int jj = r / I_AB1; p0_tr_desc(FIN(10) + (size_t)jj * D * NAB, NAB, D, NAB, FIN(7) + 2 * jj * D, 1.f, ((bf16_t*)(F.ws + WS_AB1)) + (size_t)jj * NAB * D, 1, r % I_AB1, lane, t); return; } r -= 2 * I_AB1;
    if (r < 2 * I_C1) { const int jj = r / I_C1; p0_tr_desc(FIN(17) + (size_t)jj * D * NC, NC, D, NC, FIN(7) + (2 * jj + 1) * D, 1.f, ((bf16_t*)(F.ws + WS_C1)) + (size_t)jj * NC * D, 2, r % I_C1, lane, t); return; } r -= 2 * I_C1;
    if (r < 2 * I_2) { const int jj = r / I_2; p0_tr_desc(FIN(16) + (size_t)jj * 2048 * D, D, 2048, D, nullptr, 1.f, ((bf16_t*)(F.ws + WS_AB2)) + (size_t)jj * D * 2048, 0, r % I_2, lane, t); return; } r -= 2 * I_2;
    if (r < 2 * I_2) { const int jj = r / I_2; p0_tr_desc(FIN(19) + (size_t)jj * 2048 * D, D, 2048, D, nullptr, 1.f, ((bf16_t*)(F.ws + WS_C2)) + (size_t)jj * D * 2048, 0, r % I_2, lane, t); return; } r -= 2 * I_2;
    if (r < 4 * I_SQ) { const int l = r / I_SQ; p0_tr_desc(FIN(20) + (size_t)l * D * D, D, D, D, FIN(8) + l * D, QSCALE, ((bf16_t*)(F.ws + WS_WQ)) + (size_t)l * D * D, 0, r % I_SQ, lane, t); return; } r -= 4 * I_SQ;
    if (r < 4 * I_SQ) { const int l = r / I_SQ; p0_tr_desc(FIN(21) + (size_t)l * D * D, D, D, D, FIN(9) + l * D, 1.f, ((bf16_t*)(F.ws + WS_WKV)) + (size_t)(2 * l) * D * D, 0, r % I_SQ, lane, t); return; } r -= 4 * I_SQ;
    if (r < 4 * I_SQ) { const int l = r / I_SQ; p0_tr_desc(FIN(22) + (size_t)l * D * D, D, D, D, FIN(9) + l * D, 1.f, ((bf16_t*)(F.ws + WS_WKV)) + (size_t)(2 * l + 1) * D * D, 0, r % I_SQ, lane, t); return; } r -= 4 * I_SQ;
    if (r < 4 * I_SQ) { const int l = r / I_SQ; p0_tr_desc(FIN(23) + (size_t)l * D * D, D, D, D, nullptr, 1.f, ((bf16_t*)(F.ws + WS_WO)) + (size_t)l * D * D, 0, r % I_SQ, lane, t); return; } r -= 4 * I_SQ;
    { const int jg = r / I_PM; p0_tr_desc(FIN(11) + (size_t)jg * 65536, 256, 256, 256, nullptr, 1.f, ((bf16_t*)(F.ws + WS_PMT)) + (size_t)jg * 65536, 0, r % I_PM, lane, t); }
}
__device__ __forceinline__ void p0_tr_load(const TrItem& t, int lane, float (&v)[32], f32x4& g0, f32x4& g1) {
    const int c = lane & 7;
    g0 = (f32x4){t.sc, t.sc, t.sc, t.sc}; g1 = g0;
    if (t.gk) { g0 = *(const f32x4*)(t.gk + 8 * c) * t.sc; g1 = *(const f32x4*)(t.gk + 8 * c + 4) * t.sc; }
#pragma unroll
    for (int i = 0; i < 32; ++i) v[i] = t.wp[(size_t)(2 * i) * t.ldw];
}
__device__ __forceinline__ void p0_tr_finish(const TrItem& t, int lane, const float (&v)[32], f32x4 g0, f32x4 g1, LAS float* scr) {
#pragma unroll
    for (int i = 0; i < 32; ++i) scr[(2 * i + (lane >> 5)) * 33 + (lane & 31)] = v[i];
    LDS_WAIT(); asm volatile("" ::: "memory");
    const int c = lane & 7;
#pragma unroll
    for (int jj = 0; jj < 4; ++jj) {
        const int n = (lane >> 3) + 8 * jj; const LAS float* s = scr + (8 * c) * 33 + n;
        u32x4 o; o.x = cvt_pk_bf16(s[0 * 33] * g0[0], s[1 * 33] * g0[1]); o.y = cvt_pk_bf16(s[2 * 33] * g0[2], s[3 * 33] * g0[3]); o.z = cvt_pk_bf16(s[4 * 33] * g1[0], s[5 * 33] * g1[1]); o.w = cvt_pk_bf16(s[6 * 33] * g1[2], s[7 * 33] * g1[3]);
        *(u32x4*)(t.wt + (size_t)n * t.K + 8 * c) = o;
    }
    LDS_WAIT(); asm volatile("" ::: "memory");
}
__device__ __forceinline__ float p0_row_finish(const f32x4 (&v)[4], bf16_t* dst, float* copy, int lane) {
    float s = 0.f;
#pragma unroll
    for (int jj = 0; jj < 4; ++jj) s += dot4(v[jj], v[jj]);
    s = wave_sum(s, lane);
    u32x2* o8 = (u32x2*)dst + lane;
#pragma unroll
    for (int jj = 0; jj < 4; ++jj) o8[64 * jj] = pack4(v[jj]);
    if (copy) {
#pragma unroll
        for (int jj = 0; jj < 4; ++jj) ((f32x4*)copy + lane)[64 * jj] = v[jj];
    }
    return s;
}
namespace p0seg {
constexpr int I_AB1 = 16 * (NAB / 32), I_C1 = 16 * (NC / 32), I_2 = 32 * 32, I_SQ = 16 * 32, I_PM = 4 * 8;
constexpr int O_AB1 = 0, O_C1 = 2 * I_AB1, O_AB2 = O_C1 + 2 * I_C1, O_C2 = O_AB2 + 2 * I_2, O_Q = O_C2 + 2 * I_2, O_K = O_Q + 4 * I_SQ, O_V = O_K + 4 * I_SQ, O_O = O_V + 4 * I_SQ, O_P = O_O + 4 * I_SQ, NITEMS = O_P + 8 * I_PM;
constexpr int NA = I_AB1 + I_2 + I_SQ + 8 * I_SQ + I_SQ + 4 * I_PM, NB = NITEMS - NA;
__device__ __forceinline__ int item_a(int i) {
    if (i < I_AB1) return O_AB1 + i; i -= I_AB1;
    if (i < I_2) return O_AB2 + i; i -= I_2;
    if (i < I_SQ) return O_Q + i; i -= I_SQ;
    if (i < 8 * I_SQ) return O_K + i; i -= 8 * I_SQ;
    if (i < I_SQ) return O_O + i; i -= I_SQ;
    return O_P + i;
}
__device__ __forceinline__ int item_b(int i) {
    if (i < I_AB1) return O_AB1 + I_AB1 + i; i -= I_AB1;
    if (i < 2 * I_C1) return O_C1 + i; i -= 2 * I_C1;
    if (i < I_2) return O_AB2 + I_2 + i; i -= I_2;
    if (i < 2 * I_2) return O_C2 + i; i -= 2 * I_2;
    if (i < 3 * I_SQ) return O_Q + I_SQ + i; i -= 3 * I_SQ;
    if (i < 3 * I_SQ) return O_O + I_SQ + i; i -= 3 * I_SQ;
    return O_P + 4 * I_PM + i;
}
}
__device__ __forceinline__ void p0_weights(Frame& F0, int part, int gw, int NGW, int half = -1) {
    Frame F = launder(F0);
    LAS float* scr = (LAS float*)(F.lds + F.wave * 16384);
    const int lane = F.lane;
    constexpr int NB_ODD = (int)((long)p0seg::NB * PB_ODD_PCT / 100);
    const int base = (part == 1 && half == 0) ? NB_ODD : 0;
    const int n = part == 0 ? p0seg::NA : (part == 1 ? (half == 1 ? NB_ODD : (half == 0 ? p0seg::NB - NB_ODD : p0seg::NB)) : p0seg::NITEMS);
#define P0_ITEM(i_) (part == 0 ? p0seg::item_a(i_) : (part == 1 ? p0seg::item_b(base + (i_)) : (i_)))
    if (gw < n) {
        TrItem cur, nxt; float va[32], vb[32]; f32x4 ga0, ga1, gb0, gb1;
        p0_resolve(F, P0_ITEM(gw), lane, cur); p0_tr_load(cur, lane, va, ga0, ga1);
        for (int it = gw; it < n; it += 2 * NGW) {
            const bool h1 = it + NGW < n, h2 = it + 2 * NGW < n;
            if (h1) { p0_resolve(F, P0_ITEM(it + NGW), lane, nxt); p0_tr_load(nxt, lane, vb, gb0, gb1); }
            p0_tr_finish(cur, lane, va, ga0, ga1, scr);
            if (h2) { p0_resolve(F, P0_ITEM(it + 2 * NGW), lane, cur); p0_tr_load(cur, lane, va, ga0, ga1); }
            if (h1) p0_tr_finish(nxt, lane, vb, gb0, gb1, scr);
        }
    }
#undef P0_ITEM
}
__device__ __forceinline__ void p0_prologue(Frame& F0) {
    Frame F = launder(F0);
    const int gw = F.bx * NWAVES + F.wave, NGW = F.G * NWAVES, lane = F.lane;
    p0_weights(F0, (!MK_SPLIT && SPLIT_PROLOGUE) ? 0 : 2, gw, NGW);
    for (int m0 = 2 * gw; m0 < MP + MS + MMEM; m0 += 2 * NGW) {
        f32x4 v[2][4];
#pragma unroll
        for (int r = 0; r < 2; ++r) {
            const int m = m0 + r;
            const float* src = m < MP ? FIN(0) + (size_t)m * D : (m < MP + MS ? FIN(1) + (size_t)(m - MP) * D : FIN(2) + (size_t)(m - MP - MS) * D);
#pragma unroll
            for (int jj = 0; jj < 4; ++jj) v[r][jj] = ((const f32x4*)src + lane)[64 * jj];
        }
#pragma unroll
        for (int r = 0; r < 2; ++r) {
            const int m = m0 + r;
            if (m < MP) {
                const float s = p0_row_finish(v[r], ((bf16_t*)(F.ws + WS_XB)) + (size_t)m * D, nullptr, lane);
                if (lane < 16) ((float*)(F.ws + WS_RSQ))[(size_t)m * 16 + lane] = lane == 0 ? s : 0.f;
            } else if (m < MP + MS) {
                const int b = m - MP;
                const float s = p0_row_finish(v[r], ((bf16_t*)(F.ws + WS_XB)) + (size_t)m * D, ((float*)(F.ws + WS_XS)) + (size_t)b * D, lane);
                if (lane < 32) ((float*)(F.ws + WS_SMALL))[b * 32 + lane] = lane == 0 ? s : 0.f;
            } else {
                const int t = m - MP - MS;
                const float s = p0_row_finish(v[r], ((bf16_t*)(F.ws + WS_MEMB)) + (size_t)t * D, nullptr, lane);
                if (lane == 0) ((float*)(F.ws + WS_SMALL + 65536))[t] = rsqrtf(s * (1.0f / D) + EPS);
            }
        }
    }
}

__device__ __forceinline__ bf16x8 tr_frag(LAS unsigned char* p0, LAS unsigned char* p1) {
    const s16x4 lo = __builtin_amdgcn_ds_read_tr16_b64_v4i16((LAS s16x4*)p0);
    const s16x4 hi = __builtin_amdgcn_ds_read_tr16_b64_v4i16((LAS s16x4*)p1);
    return (bf16x8){lo[0], lo[1], lo[2], lo[3], hi[0], hi[1], hi[2], hi[3]};
}
#define MFMA16(a, b, c) __builtin_amdgcn_mfma_f32_16x16x32_bf16((a), (b), (c), 0, 0, 0)

constexpr int SGU_AS = 0, SGU_VS = 36864, SGU_RV = 36864 + 69632;
__device__ __forceinline__ void sgu_chunk(Frame& F0, int j, int n, const int g0, const int g1) {
    Frame F = launder(F0);
    LAS unsigned char* lds = F.lds;
    const int tid = F.tid, lane = F.lane, w = F.wave, fr = lane & 15, fq = lane >> 4, row0 = n * 128;
    LAS float* rvs = (LAS float*)(lds + SGU_RV);
    if (tid < 128) rvs[tid] = rstd16(((float*)(F.ws + WS_VSQ)) + (size_t)(row0 + tid) * 16);
    const bf16_t* ZV = ((bf16_t*)(F.ws + WS_Z)) + (size_t)2 * MP * D + (size_t)row0 * D;
    const bf16_t* ZUG = ((bf16_t*)(F.ws + WS_Z)) + (size_t)3 * MP * D + (size_t)row0 * D;
    bf16_t* A2 = ((bf16_t*)(F.ws + WS_A2)) + (size_t)row0 * 2048 + 1024;
    const unsigned voff = (unsigned)(tid >> 5) * (D * 2) + (unsigned)(tid & 31) * 16u;
    const unsigned woff = (unsigned)(tid >> 4) * 512u + (unsigned)(tid & 15) * 32u;
    const int wt_t = tid >> 4, wt_s0 = (tid & 15) * 8;
    const unsigned aoff = (unsigned)(tid >> 5) * 4096u + (unsigned)(tid & 31) * 16u;
    u32x4 vt[8]; f32x4 wt[8];
#define SGU_LOAD(g_) do { const char* vb_ = (const char*)(ZV + (g_) * 256); const char* wb_ = (const char*)(FIN(13) + (size_t)(j * 4 + (g_)) * 16384); \
        _Pragma("unroll") for (int i_ = 0; i_ < 8; ++i_) vt[i_] = *(const u32x4*)(vb_ + (size_t)(16 * i_) * D * 2 + voff); \
        _Pragma("unroll") for (int i_ = 0; i_ < 4; ++i_) { wt[2 * i_] = *(const f32x4*)(wb_ + (size_t)(32 * i_) * 512 + woff); wt[2 * i_ + 1] = *(const f32x4*)(wb_ + (size_t)(32 * i_) * 512 + woff + 16); } } while (0)
    SGU_LOAD(g0);
    LDS_BARRIER();
#pragma unroll 1
    for (int g = g0; g < g1; ++g) {
#pragma unroll
        for (int i = 0; i < 8; ++i) *(LAS u32x4*)(lds + SGU_VS + ((tid >> 5) + 16 * i) * 544 + (tid & 31) * 16) = vt[i];
#pragma unroll
        for (int i = 0; i < 4; ++i) {
            const int t = wt_t + 32 * i; float v[8];
#pragma unroll
            for (int e = 0; e < 4; ++e) { v[e] = (wt_s0 + e <= t) ? wt[2 * i][e] * rvs[wt_s0 + e] : 0.f; v[4 + e] = (wt_s0 + 4 + e <= t) ? wt[2 * i + 1][e] * rvs[wt_s0 + 4 + e] : 0.f; }
            u32x4 o; o.x = cvt_pk_bf16(v[0], v[1]); o.y = cvt_pk_bf16(v[2], v[3]); o.z = cvt_pk_bf16(v[4], v[5]); o.w = cvt_pk_bf16(v[6], v[7]);
            *(LAS u32x4*)(lds + SGU_AS + t * 288 + wt_s0 * 2) = o;
        }
        LDS_BARRIER();
        if (g + 1 < g1) SGU_LOAD(g + 1);
        const int cg = g * 256 + 32 * w + 4 * fq;
        const unsigned lo_in = (unsigned)fr * (D * 2) + (unsigned)(32 * w + 4 * fq) * 2u, lo_out = (unsigned)fr * 4096u + (unsigned)(32 * w + 4 * fq) * 2u;
        u32x2 ugr[2][8];
#pragma unroll
        for (int nt = 0; nt < 2; ++nt)
#pragma unroll
            for (int mt = 0; mt < 8; ++mt) ugr[nt][mt] = *(const u32x2*)((const char*)(ZUG + (size_t)(16 * mt) * D + g * 256 + 16 * nt) + lo_in);
        f32x4 ggv[2]; float bbv[8];
#pragma unroll
        for (int nt = 0; nt < 2; ++nt) ggv[nt] = *(const f32x4*)(FIN(15) + j * 1024 + cg + 16 * nt);
#pragma unroll
        for (int mt = 0; mt < 8; ++mt) bbv[mt] = FIN(14)[(j * 4 + g) * 128 + 16 * mt + fr];
        f32x4 acc[8][2];
#pragma unroll
        for (int mt = 0; mt < 8; ++mt) { acc[mt][0] = (f32x4){0.f, 0.f, 0.f, 0.f}; acc[mt][1] = (f32x4){0.f, 0.f, 0.f, 0.f}; }
#pragma unroll
        for (int ks = 0; ks < 4; ++ks) {
            bf16x8 Bf[2];
#pragma unroll
            for (int nt = 0; nt < 2; ++nt) {
                LAS unsigned char* p = lds + SGU_VS + (32 * ks + 8 * fq + (fr >> 2)) * 544 + (32 * w + 16 * nt + 4 * (fr & 3)) * 2;
                Bf[nt] = tr_frag(p, p + 4 * 544);
            }
            bf16x8 Af[8];
#pragma unroll
            for (int mt = 0; mt < 8; ++mt) if (32 * ks <= 16 * mt + 15) Af[mt] = *(LAS bf16x8*)(lds + SGU_AS + (16 * mt + fr) * 288 + (32 * ks + 8 * fq) * 2);
#pragma unroll
            for (int mt = 0; mt < 8; ++mt) if (32 * ks <= 16 * mt + 15) { acc[mt][0] = MFMA16(Bf[0], Af[mt], acc[mt][0]); acc[mt][1] = MFMA16(Bf[1], Af[mt], acc[mt][1]); }
        }
#pragma unroll
        for (int nt = 0; nt < 2; ++nt) {
            const int c = cg + 16 * nt;
            const f32x4 gg = ggv[nt];
#pragma unroll
            for (int mt = 0; mt < 8; ++mt) {
                const int t = 16 * mt + fr;
                const float bb = bbv[mt];
                *(u32x2*)((char*)(A2 + (size_t)(16 * mt) * 2048 + g * 256 + 16 * nt) + lo_out) = pack4(unpack4(ugr[nt][mt]) * (acc[mt][nt] * gg + bb));
            }
        }
        LDS_BARRIER();
    }
#undef SGU_LOAD
}
template <int WIN> __device__ __forceinline__ void pool_load(const bf16_t* xau  , unsigned lo  , int pos0, u32x4 (&xr)[WIN + 7]) {
#pragma unroll
    for (int i = 0; i < WIN + 7; ++i) { const int rr = i - (WIN - 1); xr[i] = (u32x4){0u, 0u, 0u, 0u}; if (pos0 + rr >= 0) xr[i] = *(const u32x4*)((const char*)(xau + (ptrdiff_t)rr * D) + lo); }
}
template <int WIN> __device__ __forceinline__ void pool_build(const u32x4 (&xr)[WIN + 7], int pos0, LAS unsigned char* dst  ) {
    f32x4 S0 = (f32x4){0.f, 0.f, 0.f, 0.f}, S1 = S0;
#pragma unroll
    for (int i = 0; i < WIN - 1; ++i) { f32x4 a, b; unpack8(xr[i], a, b); S0 += a; S1 += b; }
#pragma unroll
    for (int r = 0; r < 8; ++r) {
        f32x4 a, b; unpack8(xr[WIN - 1 + r], a, b); S0 += a; S1 += b;
        const int cnt = (pos0 + r + 1) < WIN ? (pos0 + r + 1) : WIN; const float ic = 1.0f / (float)cnt;
        *(LAS u32x4*)(dst + r * 544) = pack8(S0 * ic - a, S1 * ic - b);
        f32x4 c, d; unpack8(xr[r], c, d); S0 -= c; S1 -= d;
    }
}
__device__ __forceinline__ void pool_mma_epi(Frame& F, int j, int g, int row0, const bf16_t* ZSGA, bf16_t* A2, LAS unsigned char* lds, int w, int fr, int fq) {
    const int cg = g * 256 + 32 * w + 4 * fq;
    const unsigned lo_in = (unsigned)fr * (D * 2) + (unsigned)(32 * w + 4 * fq) * 2u, lo_out = (unsigned)fr * 4096u + (unsigned)(32 * w + 4 * fq) * 2u, lo_pm = (unsigned)(32 * w + fr) * 512u + (unsigned)fq * 16u;
    u32x2 sgr[2][8];
#pragma unroll
    for (int nt = 0; nt < 2; ++nt)
#pragma unroll
        for (int mt = 0; mt < 8; ++mt) sgr[nt][mt] = *(const u32x2*)((const char*)(ZSGA + (size_t)(16 * mt) * D + g * 256 + 16 * nt) + lo_in);
    f32x4 acc[8][2];
#pragma unroll
    for (int mt = 0; mt < 8; ++mt) { acc[mt][0] = (f32x4){0.f, 0.f, 0.f, 0.f}; acc[mt][1] = (f32x4){0.f, 0.f, 0.f, 0.f}; }
    const bf16_t* pm = ((bf16_t*)(F.ws + WS_PMT)) + (size_t)(j * 4 + g) * 65536;
    bf16x8 Bq[8][2]; f32x4 psv[2];
#pragma unroll
    for (int ks = 0; ks < 8; ++ks) { Bq[ks][0] = *(const bf16x8*)((const char*)(pm + 32 * ks) + lo_pm); Bq[ks][1] = *(const bf16x8*)((const char*)(pm + 16 * 256 + 32 * ks) + lo_pm); }
#pragma unroll
    for (int nt = 0; nt < 2; ++nt) psv[nt] = *(const f32x4*)(FIN(12) + j * 1024 + cg + 16 * nt);
    {
        bf16x8 Af[2][4];
#define POOL_AREAD(n_, buf_) do { _Pragma("unroll") for (int m4_ = 0; m4_ < 4; ++m4_) Af[buf_][m4_] = *(LAS bf16x8*)(lds + (16 * (4 * ((n_) & 1) + m4_) + fr) * 544 + (32 * ((n_) >> 1) + 8 * fq) * 2); } while (0)
        POOL_AREAD(0, 0);
        __builtin_amdgcn_sched_group_barrier(0x100, 4, 0);
#pragma unroll
        for (int n = 0; n < 16; ++n) {
            if (n < 15) POOL_AREAD(n + 1, (n + 1) & 1);
#pragma unroll
            for (int m4 = 0; m4 < 4; ++m4) { const int mt = 4 * (n & 1) + m4, ks = n >> 1; acc[mt][0] = MFMA16(Bq[ks][0], Af[n & 1][m4], acc[mt][0]); acc[mt][1] = MFMA16(Bq[ks][1], Af[n & 1][m4], acc[mt][1]); }
            if (n < 15) __builtin_amdgcn_sched_group_barrier(0x100, 4, 0);
            __builtin_amdgcn_sched_group_barrier(0x008, 8, 0);
        }
#undef POOL_AREAD
    }
#pragma unroll
    for (int nt = 0; nt < 2; ++nt) {
        const int c = cg + 16 * nt;
        const f32x4 ps = psv[nt];
#pragma unroll
        for (int mt = 0; mt < 8; ++mt) *(u32x2*)((char*)(A2 + (size_t)(16 * mt) * 2048 + g * 256 + 16 * nt) + lo_out) = pack4(acc[mt][nt] * ps * unpack4(sgr[nt][mt]));
    }
}
template <int GA, int GB> __device__ __forceinline__ void pool_pair(Frame& F0, int j, int n) {
    Frame F = launder(F0);
    LAS unsigned char* lds = F.lds;
    const int tid = F.tid, lane = F.lane, w = F.wave, fr = lane & 15, fq = lane >> 4, row0 = n * 128;
    const int cb = tid & 31, t0 = (tid >> 5) * 8, pos0 = (row0 & 2047) + t0;
    const bf16_t* xa = ((bf16_t*)(F.ws + WS_Z)) + (size_t)row0 * D; const unsigned xlo = (unsigned)(t0 * D + cb * 8) * 2u;
    const bf16_t* ZSGA = ((bf16_t*)(F.ws + WS_Z)) + (size_t)1 * MP * D + (size_t)row0 * D;
    bf16_t* A2 = ((bf16_t*)(F.ws + WS_A2)) + (size_t)row0 * 2048;
    LAS unsigned char* dst = lds + t0 * 544 + cb * 16;
    constexpr int WA = 2 << GA, WB = 2 << GB;
    u32x4 xa_r[WA + 7]; pool_load<WA>(xa + GA * 256, xlo, pos0, xa_r);
    pool_build<WA>(xa_r, pos0, dst); LDS_BARRIER();
    pool_mma_epi(F, j, GA, row0, ZSGA, A2, lds, w, fr, fq); LDS_BARRIER();
    u32x4 xb_r[WB + 7]; pool_load<WB>(xa + GB * 256, xlo, pos0, xb_r);
    pool_build<WB>(xb_r, pos0, dst); LDS_BARRIER();
    pool_mma_epi(F, j, GB, row0, ZSGA, A2, lds, w, fr, fq); LDS_BARRIER();
}
constexpr int ATT_SLOT = 64 * 544;
__device__ __forceinline__ void attn_prompt(Frame& F0, int layer) {
    Frame F = launder(F0);
    LAS unsigned char* lds = F.lds;
    const int tid = F.tid, lane = F.lane, w = F.wave, fr = lane & 15, fq = lane >> 4;
    const bf16_t* Kl = ((bf16_t*)(F.ws + WS_KB)) + (size_t)layer * MMEM * D; const bf16_t* Vl = ((bf16_t*)(F.ws + WS_VB)) + (size_t)layer * MMEM * D;
    for (int kk = F.rk; kk < 64; kk += F.rw) {
        const int b = F.xq, h = kk >> 4, qb = kk & 15;
        const size_t rowq = (size_t)b * SEQ + qb * 128 + 16 * w + fr;
        bf16x8 Qf[8];
#pragma unroll
        for (int ks = 0; ks < 8; ++ks) Qf[ks] = *(const bf16x8*)(((bf16_t*)(F.ws + WS_Q)) + rowq * D + h * 256 + 32 * ks + 8 * fq);
        const bf16_t* kbase = Kl + (size_t)(b * 256) * D + h * 256; const bf16_t* vbase = Vl + (size_t)(b * 256) * D + h * 256;
        u32x4 st[4];
#define ATT_GLOAD(c) do { const bf16_t* src_ = ((c) < 4 ? kbase : vbase) + (size_t)(64 * ((c) & 3)) * D; _Pragma("unroll") for (int i_ = 0; i_ < 4; ++i_) { const int idx_ = tid + 512 * i_; st[i_] = *(const u32x4*)(src_ + (size_t)(idx_ >> 5) * D + (idx_ & 31) * 8); } } while (0)
#define ATT_LSTORE(slot) do { _Pragma("unroll") for (int i_ = 0; i_ < 4; ++i_) { const int idx_ = tid + 512 * i_; *(LAS u32x4*)(lds + (slot) * ATT_SLOT + (idx_ >> 5) * 544 + (idx_ & 31) * 16) = st[i_]; } } while (0)
        f32x4 S[16], Oa[16]; bf16x8 Pf[8]; float inv = 0.f;
#pragma unroll
        for (int i = 0; i < 16; ++i) { S[i] = (f32x4){0.f, 0.f, 0.f, 0.f}; Oa[i] = (f32x4){0.f, 0.f, 0.f, 0.f}; }
        ATT_GLOAD(0); ATT_LSTORE(0); __syncthreads();
#pragma unroll
        for (int c = 0; c < 8; ++c) {
            if (c < 7) ATT_GLOAD(c + 1);
            LAS unsigned char* slot = lds + (c & 1) * ATT_SLOT;
            if (c < 4) {
#pragma unroll
                for (int ml = 0; ml < 4; ++ml)
#pragma unroll
                    for (int ks = 0; ks < 8; ++ks) {
                        const bf16x8 Kf = *(LAS bf16x8*)(slot + (16 * ml + fr) * 544 + (32 * ks + 8 * fq) * 2);
                        S[4 * c + ml] = MFMA16(Kf, Qf[ks], S[4 * c + ml]);
                    }
                if (c == 3) {
                    float mx = S[0][0];
#pragma unroll
                    for (int i = 0; i < 16; ++i) { mx = fmaxf(mx, fmaxf(fmaxf(S[i][0], S[i][1]), fmaxf(S[i][2], S[i][3]))); }
                    mx = fmaxf(mx, shx(mx, 16, lane)); mx = fmaxf(mx, shx(mx, 32, lane));
                    float sum = 0.f;
#pragma unroll
                    for (int i = 0; i < 16; ++i) {
#pragma unroll
                        for (int e = 0; e < 4; ++e) { S[i][e] = __builtin_amdgcn_exp2f(S[i][e] - mx); sum += S[i][e]; }
                    }
                    sum += shx(sum, 16, lane); sum += shx(sum, 32, lane);
                    inv = 1.0f / sum;
#pragma unroll
                    for (int a = 0; a < 8; ++a) {
                        u32x4 pw; pw.x = cvt_pk_bf16(S[2 * a][0], S[2 * a][1]); pw.y = cvt_pk_bf16(S[2 * a][2], S[2 * a][3]); pw.z = cvt_pk_bf16(S[2 * a + 1][0], S[2 * a + 1][1]); pw.w = cvt_pk_bf16(S[2 * a + 1][2], S[2 * a + 1][3]);
                        Pf[a] = __builtin_bit_cast(bf16x8, pw);
                    }
                }
            } else {
#pragma unroll
                for (int al = 0; al < 2; ++al)
#pragma unroll
                    for (int dt = 0; dt < 16; ++dt) {
                        LAS unsigned char* p = slot + (32 * al + 4 * fq + (fr >> 2)) * 544 + (16 * dt + 4 * (fr & 3)) * 2;
                        const bf16x8 Vf = tr_frag(p, p + 16 * 544);
                        Oa[dt] = MFMA16(Vf, Pf[2 * (c - 4) + al], Oa[dt]);
                    }
            }
            if (c < 7) ATT_LSTORE((c + 1) & 1);
            __syncthreads();
        }
#pragma unroll
        for (int dt = 0; dt < 16; ++dt) *(u32x2*)(((bf16_t*)(F.ws + WS_O)) + rowq * D + h * 256 + 16 * dt + 4 * fq) = pack4(Oa[dt] * inv);
#undef ATT_GLOAD
#undef ATT_LSTORE
    }
}

template <class Epi, int N>
__device__ __forceinline__ void sgemm16(Frame& F0, const bf16_t* A, const bf16_t* Bt, int K, const Epi& E) {
    Frame F = launder(F0);
    LAS unsigned char* lds = F.lds;
    constexpr int CW = N / 32, NT = CW / 16, KS = NT == 2 ? 8 : (NT == 10 ? 4 : 2), NG = 8 / KS, NTW = NT / NG;
    static_assert(NT * 16 == CW && NTW * NG == NT && 2 * CW <= NWAVES * 64, "sgemm16 geometry");
    const int tid = F.tid, lane = F.lane, w = F.wave, fr = lane & 15, fq = lane >> 4;
    const int ksi = w % KS, ng = w / KS, kslice = K / KS, nkb = kslice / 128;
    const bf16_t* A16 = A + (size_t)(16 * F.xq) * K;
    for (int slot = F.rk; slot < 32; slot += F.rw) {
        const int erow = tid / (CW / 8), ecg = tid % (CW / 8); const bool eact = tid < 2 * CW;
        typename Epi::Pre pre{};
        if (eact) pre = E.pre(16 * F.xq + erow, slot * CW + 8 * ecg);
        f32x4 acc[NTW];
#pragma unroll
        for (int jn = 0; jn < NTW; ++jn) acc[jn] = (f32x4){0.f, 0.f, 0.f, 0.f};
        const bf16_t* ap = A16 + (size_t)fr * K + ksi * kslice + 8 * fq;
        const bf16_t* bp = Bt + (size_t)(slot * CW + (ng * NTW) * 16 + fr) * K + ksi * kslice + 8 * fq;
        for (int kb = 0; kb < nkb; ++kb) {
            bf16x8 Af[4], Bf[4][NTW];
#pragma unroll
            for (int k4 = 0; k4 < 4; ++k4) {
                Af[k4] = *(const bf16x8*)(ap + 128 * kb + 32 * k4);
#pragma unroll
                for (int jn = 0; jn < NTW; ++jn) Bf[k4][jn] = *(const bf16x8*)(bp + (size_t)(16 * jn) * K + 128 * kb + 32 * k4);
            }
#pragma unroll
            for (int k4 = 0; k4 < 4; ++k4)
#pragma unroll
                for (int jn = 0; jn < NTW; ++jn) acc[jn] = MFMA16(Bf[k4][jn], Af[k4], acc[jn]);
        }
#pragma unroll
        for (int jn = 0; jn < NTW; ++jn) *(LAS f32x4*)(lds + ((size_t)((ksi * 16 + fr) * CW + (ng * NTW + jn) * 16 + 4 * fq)) * 4) = acc[jn];
        LDS_BARRIER();
        if (eact) {
            f32x4 s0 = (f32x4){0.f, 0.f, 0.f, 0.f}, s1 = s0;
#pragma unroll
            for (int kk = 0; kk < KS; ++kk) { const LAS f32x4* p = (const LAS f32x4*)(lds + ((size_t)((kk * 16 + erow) * CW + 8 * ecg)) * 4); s0 += p[0]; s1 += p[1]; }
            E(16 * F.xq + erow, slot, slot * CW + 8 * ecg, s0, s1, pre);
        }
        LDS_BARRIER();
    }
}
struct SEpiZ {
    struct Pre { float rs; };
    const float* rsqs; float* SZ; int ldz, mode;
    __device__ __forceinline__ Pre pre(int row, int col) const { return Pre{rstd32(rsqs + row * 32)}; }
    __device__ __forceinline__ void operator()(int row, int strip, int col, f32x4 s0, f32x4 s1, const Pre& p) const {
        const int oc0 = mode == 0 ? src_even(col) : src_odd(col), oc1 = mode == 0 ? src_even(col + 4) : src_odd(col + 4);
        float* q = SZ + (size_t)row * ldz; *(f32x4*)(q + oc0) = s0 * p.rs; *(f32x4*)(q + oc1) = s1 * p.rs;
    }
};
struct SEpiRes {
    struct Pre { f32x4 x0, x1; };
    float* xs; bf16_t* xb; float* rsqs;
    __device__ __forceinline__ Pre pre(int row, int col) const { const float* q = xs + (size_t)row * D + col; return Pre{*(const f32x4*)q, *(const f32x4*)(q + 4)}; }
    __device__ __forceinline__ void operator()(int row, int strip, int col, f32x4 s0, f32x4 s1, const Pre& pr) const {
        float* p = xs + (size_t)row * D + col; const f32x4 o0 = pr.x0 + s0, o1 = pr.x1 + s1;
        *(f32x4*)p = o0; *(f32x4*)(p + 4) = o1; *(u32x4*)(xb + (size_t)row * D + col) = pack8(o0, o1);
        const int ln = ((row & 15) << 2) | ((col >> 3) & 3);
        float ss = dot4(o0, o0) + dot4(o1, o1); ss += shx(ss, 1, ln); ss += shx(ss, 2, ln);
        if ((col & 31) == 0) rsqs[row * 32 + strip] = ss;
    }
};
struct SEpiQ {
    struct Pre { float rs; };
    const float* rsqs; float* SQ;
    __device__ __forceinline__ Pre pre(int row, int col) const { return Pre{rstd32(rsqs + row * 32)}; }
    __device__ __forceinline__ void operator()(int row, int strip, int col, f32x4 s0, f32x4 s1, const Pre& p) const {
        float* q = SQ + (size_t)row * D + col; *(f32x4*)q = s0 * p.rs; *(f32x4*)(q + 4) = s1 * p.rs;
    }
};
__device__ __forceinline__ void sample_mix_even(Frame& F0, int j, int b) {
    Frame F = launder(F0);
    LAS float* pl = (LAS float*)F.lds; LAS float* red = pl + 1024;
    const int tid = F.tid, lane = F.lane, w = F.wave;
    const float* z = ((float*)(F.ws + WS_SZ)) + (size_t)b * 8192;
    float vv[2], ss = 0.f;
#pragma unroll
    for (int k = 0; k < 2; ++k) { vv[k] = z[3072 + tid + 512 * k]; ss += vv[k] * vv[k]; }
    ss = wave_sum(ss, lane); if (lane == 0) red[w] = ss;
#pragma unroll
    for (int k = 0; k < 2; ++k) {
        const int c = tid + 512 * k, g = c >> 8, win = 2 << g; const float xa = z[c];
        const float* st = FIN(3) + ((size_t)(j * 128 + b) * 15) * 1024 + c;
        float s = xa; for (int r = 16 - win; r < 15; ++r) s += st[(size_t)r * 1024];
        pl[c] = s / (float)win - xa;
        float* po = F.out + O_POOLS + ((size_t)(j * 128 + b) * 15) * 1024 + c;
        for (int r = 0; r < 14; ++r) po[(size_t)r * 1024] = st[(size_t)(r + 1) * 1024];
        po[(size_t)14 * 1024] = xa;
    }
    __syncthreads();
    float tot = 0.f;
#pragma unroll
    for (int i = 0; i < 8; ++i) tot += red[i];
    const float rv = rsqrtf(tot * (1.0f / D) + EPS);
#pragma unroll
    for (int k = 0; k < 2; ++k) {
        const int d = tid + 512 * k, g = d >> 8, dd = d & 255;
        const bf16_t* pm = ((bf16_t*)(F.ws + WS_PMT)) + (size_t)(j * 4 + g) * 65536 + (size_t)dd * 256; const LAS float* pg = pl + g * 256;
        float a = 0.f;
#pragma unroll
        for (int hb = 0; hb < 2; ++hb) {
            u32x4 pr[16];
#pragma unroll
            for (int i = 0; i < 16; ++i) pr[i] = *(const u32x4*)(pm + hb * 128 + i * 8);
#pragma unroll
            for (int i = 0; i < 16; ++i) { f32x4 p0, p1; unpack8(pr[i], p0, p1); const LAS float* q = pg + hb * 128 + i * 8; a += dot4(p0, *(const LAS f32x4*)q) + dot4(p1, *(const LAS f32x4*)(q + 4)); }
        }
        const float ya = a * FIN(12)[j * 1024 + d] * silu_f(z[1024 + d]);
        const float vn = vv[k] * rv * FIN(15)[j * 1024 + d];
        F.out[O_SGUV + (size_t)(j * 128 + b) * 1024 + d] = vn;
        const float mixed = FIN(13)[(size_t)(j * 4 + g) * 16384] * vn + FIN(14)[(j * 4 + g) * 128];
        const float yb = z[2048 + d] * mixed * silu_f(z[4096 + d]);
        ((bf16_t*)(F.ws + WS_SA2))[(size_t)b * 2048 + d] = (bf16_t)(cvt_pk_bf16(ya, 0.f) & 0xffffu); ((bf16_t*)(F.ws + WS_SA2))[(size_t)b * 2048 + 1024 + d] = (bf16_t)(cvt_pk_bf16(yb, 0.f) & 0xffffu);
    }
    __syncthreads();
}
__device__ __forceinline__ void sample_conv_odd(Frame& F0, int j, int b) {
    Frame F = launder(F0);
    const int tid = F.tid;
    const float* z = ((float*)(F.ws + WS_SZ)) + (size_t)b * 8192;
    const float* cw = FIN(18) + (size_t)j * 3 * 2048;
#pragma unroll
    for (int k = 0; k < 4; ++k) {
        const int c = tid + 512 * k;
        const float e = z[2048 + c] * z[4096 + c];
        const float s0 = FIN(4)[((size_t)(j * 128 + b) * 2 + 0) * 2048 + c], s1 = FIN(4)[((size_t)(j * 128 + b) * 2 + 1) * 2048 + c];
        const float y = cw[c] * s0 + cw[2048 + c] * s1 + cw[4096 + c] * e;
        ((bf16_t*)(F.ws + WS_SA2))[(size_t)b * 2048 + c] = (bf16_t)(cvt_pk_bf16(z[c] * y * silu_f(z[6144 + c]), 0.f) & 0xffffu);
        float* po = F.out + O_CONVS + ((size_t)(j * 128 + b) * 2) * 2048 + c; po[0] = s1; po[2048] = e;
    }
}
__device__ __forceinline__ void attn_sample(Frame& F0, int layer) {
    Frame F = launder(F0);
    LAS float* sc = (LAS float*)F.lds;
    LAS float* red = sc + 512;
    const int tid = F.tid, lane = F.lane, w = F.wave;
    for (int item = F.rk; item < 32; item += F.rw) {
        const int b = 16 * F.xq + (item >> 1), hp = item & 1;
        const float* qp = ((float*)(F.ws + WS_SQ)) + (size_t)b * D + hp * 512;
        const f32x4 q0 = *(const f32x4*)(qp + 4 * lane), q1 = *(const f32x4*)(qp + 256 + 4 * lane);
        const float* kp = FIN(5) + ((size_t)(layer * 128 + b) * 256) * 1024 + hp * 512 + 4 * lane;
        const float* vp = FIN(6) + ((size_t)(layer * 128 + b) * 256) * 1024 + hp * 512 + 4 * lane;
#pragma unroll 8
        for (int mi = 0; mi < 32; ++mi) {
            const int m = 32 * w + mi;
            const f32x4 k0 = __builtin_nontemporal_load((const f32x4*)(kp + (size_t)m * 1024)), k1 = __builtin_nontemporal_load((const f32x4*)(kp + (size_t)m * 1024 + 256));
            const float d0 = wave_sum(dot4(k0, q0), lane), d1 = wave_sum(dot4(k1, q1), lane);
            if (lane == 0) { sc[m] = d0; sc[256 + m] = d1; }
        }
        __syncthreads();
        float p0[4], p1[4], mx0 = -INFINITY, mx1 = -INFINITY;
#pragma unroll
        for (int i = 0; i < 4; ++i) { p0[i] = sc[lane + 64 * i]; p1[i] = sc[256 + lane + 64 * i]; mx0 = fmaxf(mx0, p0[i]); mx1 = fmaxf(mx1, p1[i]); }
#pragma unroll
        for (int o = 1; o < 64; o <<= 1) { mx0 = fmaxf(mx0, shx(mx0, o, lane)); mx1 = fmaxf(mx1, shx(mx1, o, lane)); }
        float sm0 = 0.f, sm1 = 0.f;
#pragma unroll
        for (int i = 0; i < 4; ++i) { p0[i] = __builtin_amdgcn_exp2f(p0[i] - mx0); p1[i] = __builtin_amdgcn_exp2f(p1[i] - mx1); sm0 += p0[i]; sm1 += p1[i]; }
        sm0 = wave_sum(sm0, lane); sm1 = wave_sum(sm1, lane);
        const float i0 = 1.0f / sm0, i1 = 1.0f / sm1;
        __syncthreads();
        if (w == 0) {
#pragma unroll
            for (int i = 0; i < 4; ++i) { sc[lane + 64 * i] = p0[i] * i0; sc[256 + lane + 64 * i] = p1[i] * i1; }
        }
        __syncthreads();
        f32x4 a0 = (f32x4){0.f, 0.f, 0.f, 0.f}, a1 = a0;
#pragma unroll 8
        for (int mi = 0; mi < 32; ++mi) {
            const int m = 32 * w + mi;
            const f32x4 v0 = __builtin_nontemporal_load((const f32x4*)(vp + (size_t)m * 1024)), v1 = __builtin_nontemporal_load((const f32x4*)(vp + (size_t)m * 1024 + 256));
            a0 += v0 * sc[m]; a1 += v1 * sc[256 + m];
        }
        *(LAS f32x4*)(red + w * 512 + 4 * lane) = a0; *(LAS f32x4*)(red + w * 512 + 256 + 4 * lane) = a1;
        __syncthreads();
        {
            float o = 0.f;
#pragma unroll
            for (int ww = 0; ww < 8; ++ww) o += red[ww * 512 + tid];
            ((bf16_t*)(F.ws + WS_SO))[(size_t)b * D + hp * 512 + tid] = (bf16_t)(cvt_pk_bf16(o, 0.f) & 0xffffu);
        }
        __syncthreads();
    }
}
#define dpp_mov(v, ctrl, row_mask) __builtin_bit_cast(float, __builtin_amdgcn_update_dpp(0, __builtin_bit_cast(int, (float)(v)), (ctrl), (row_mask), 0xf, false))
__device__ __forceinline__ float wave_sum_dpp(float x) {
    x += dpp_mov(x, 0xB1, 0xf);
    x += dpp_mov(x, 0x4E, 0xf);
    x += dpp_mov(x, 0x141, 0xf);
    x += dpp_mov(x, 0x140, 0xf);
    x += dpp_mov(x, 0x142, 0xa);
    x += dpp_mov(x, 0x143, 0xc);
    return x;
}
constexpr int FA_SC = 69632, FA_RED = 71680;
__device__ __forceinline__ void attn_fused(Frame& F0, int layer) {
    Frame F = launder(F0);
    LAS unsigned char* lds = F.lds;
    const int tid = F.tid, lane = F.lane, w = F.wave, fr = lane & 15, fq = lane >> 4;
    const bf16_t* Kl = ((bf16_t*)(F.ws + WS_KB)) + (size_t)layer * MMEM * D; const bf16_t* Vl = ((bf16_t*)(F.ws + WS_VB)) + (size_t)layer * MMEM * D;
    LAS float* sc = (LAS float*)(lds + FA_SC); LAS float* red = (LAS float*)(lds + FA_RED);
    const int sb = 16 * F.xq + (F.rk >> 1), hp = F.rk & 1;
    const float* qp = ((float*)(F.ws + WS_SQ)) + (size_t)sb * D + hp * 512;
    const f32x4 q0 = *(const f32x4*)(qp + 4 * lane), q1 = *(const f32x4*)(qp + 256 + 4 * lane);
    const float* kp = FIN(5) + ((size_t)(layer * 128 + sb) * 256 + 4 * w) * 1024 + hp * 512;
    const float* vp = FIN(6) + ((size_t)(layer * 128 + sb) * 256 + 4 * w) * 1024 + hp * 512;
    const unsigned lo16 = (unsigned)lane * 16u;
    f32x4 sv[8]; f32x4 a0 = (f32x4){0.f, 0.f, 0.f, 0.f}, a1 = a0; float mx0 = 0.f, mx1 = 0.f, iv0 = 0.f, iv1 = 0.f;
#define FA_SLOAD(base, slice) do { unsigned long long pu_ = uni64((unsigned long long)((base) + (size_t)(32 * (slice)) * 1024)); asm volatile("" : "+s"(pu_)); const char* pc_ = (const char*)(const GAS char*)pu_; \
        _Pragma("unroll") for (int r_ = 0; r_ < 4; ++r_) { sv[2 * r_] = __builtin_nontemporal_load((const f32x4*)(pc_ + r_ * 4096 + lo16)); sv[2 * r_ + 1] = __builtin_nontemporal_load((const f32x4*)(pc_ + r_ * 4096 + 1024 + lo16)); } } while (0)
    FA_SLOAD(kp, 0);
#pragma unroll 1
    for (int ui = 0; ui < 2; ++ui) {
        const int kk = 2 * F.rk + ui;
        const int b = F.xq, h = kk >> 4, qb = kk & 15;
        const size_t rowq = (size_t)b * SEQ + qb * 128 + 16 * w + fr;
        bf16x8 Qf[8];
#pragma unroll
        for (int ks = 0; ks < 8; ++ks) Qf[ks] = *(const bf16x8*)(((bf16_t*)(F.ws + WS_Q)) + rowq * D + h * 256 + 32 * ks + 8 * fq);
        const bf16_t* kbase = Kl + (size_t)(b * 256) * D + h * 256; const bf16_t* vbase = Vl + (size_t)(b * 256) * D + h * 256;
        u32x4 st[4];
        const unsigned goff = (unsigned)(tid >> 5) * (D * 2) + (unsigned)(tid & 31) * 16u, loff = (unsigned)(tid >> 5) * 544u + (unsigned)(tid & 31) * 16u;
#define ATT_GLOAD(c) do { unsigned long long pu_ = uni64((unsigned long long)(((c) < 4 ? kbase : vbase) + (size_t)(64 * ((c) & 3)) * D)); asm volatile("" : "+s"(pu_)); const char* pc_ = (const char*)(const GAS char*)pu_; \
        _Pragma("unroll") for (int i_ = 0; i_ < 4; ++i_) st[i_] = *(const u32x4*)(pc_ + (size_t)(16 * i_) * D * 2 + goff); } while (0)
#define ATT_LSTORE(c) do { _Pragma("unroll") for (int i_ = 0; i_ < 4; ++i_) *(LAS u32x4*)(lds + ((c) & 1) * ATT_SLOT + 16 * i_ * 544 + loff) = st[i_]; } while (0)
        f32x4 S[16], Oa[16]; bf16x8 Pf[8]; float inv = 0.f;
        const f32x4 zero4 = (f32x4){0.f, 0.f, 0.f, 0.f};
        if (ui == 1) {
            float p0[4], p1[4]; mx0 = -INFINITY; mx1 = -INFINITY;
#pragma unroll
            for (int i = 0; i < 4; ++i) { p0[i] = sc[lane + 64 * i]; p1[i] = sc[256 + lane + 64 * i]; mx0 = fmaxf(mx0, p0[i]); mx1 = fmaxf(mx1, p1[i]); }
#pragma unroll
            for (int o = 1; o < 64; o <<= 1) { mx0 = fmaxf(mx0, shx(mx0, o, lane)); mx1 = fmaxf(mx1, shx(mx1, o, lane)); }
            float sm0 = 0.f, sm1 = 0.f;
#pragma unroll
            for (int i = 0; i < 4; ++i) { sm0 += __builtin_amdgcn_exp2f(p0[i] - mx0); sm1 += __builtin_amdgcn_exp2f(p1[i] - mx1); }
            sm0 = wave_sum(sm0, lane); sm1 = wave_sum(sm1, lane);
            iv0 = 1.0f / sm0; iv1 = 1.0f / sm1;
        }
        ATT_GLOAD(0); ATT_LSTORE(0); __syncthreads();
#pragma unroll
        for (int c = 0; c < 8; ++c) {
            if (c < 7) ATT_GLOAD(c + 1);
            if (ui == 0) {
#pragma unroll
                for (int r = 0; r < 4; ++r) {
                    const int m = 32 * c + 4 * w + r;
                    const float d0 = wave_sum_dpp(dot4(sv[2 * r], q0)), d1 = wave_sum_dpp(dot4(sv[2 * r + 1], q1));
                    if (lane == 63) { sc[m] = d0; sc[256 + m] = d1; }
                }
                if (c < 7) FA_SLOAD(kp, c + 1); else FA_SLOAD(vp, 0);
            } else {
#pragma unroll
                for (int r = 0; r < 4; ++r) {
                    const int m = 32 * c + 4 * w + r;
                    const float p0 = __builtin_amdgcn_exp2f(sc[m] - mx0) * iv0, p1 = __builtin_amdgcn_exp2f(sc[256 + m] - mx1) * iv1;
                    a0 += sv[2 * r] * p0; a1 += sv[2 * r + 1] * p1;
                }
                if (c < 7) FA_SLOAD(vp, c + 1);
            }
            LAS unsigned char* slot = lds + (c & 1) * ATT_SLOT;
            if (c < 4) {
                {
                    bf16x8 Kf[2][4];
#pragma unroll
                    for (int ml = 0; ml < 4; ++ml) Kf[0][ml] = *(LAS bf16x8*)(slot + (16 * ml + fr) * 544 + (8 * fq) * 2);
                    __builtin_amdgcn_sched_group_barrier(0x100, 4, 0);
#pragma unroll
                    for (int ks = 0; ks < 8; ++ks) {
                        if (ks < 7) {
#pragma unroll
                            for (int ml = 0; ml < 4; ++ml) Kf[(ks + 1) & 1][ml] = *(LAS bf16x8*)(slot + (16 * ml + fr) * 544 + (32 * (ks + 1) + 8 * fq) * 2);
                        }
#pragma unroll
                        for (int ml = 0; ml < 4; ++ml) S[4 * c + ml] = MFMA16(Kf[ks & 1][ml], Qf[ks], ks == 0 ? zero4 : S[4 * c + ml]);
                        __builtin_amdgcn_sched_group_barrier(0x100, 4, 0); __builtin_amdgcn_sched_group_barrier(0x008, 4, 0);
                    }
                }
                if (c == 3) {
                    float mx = S[0][0];
#pragma unroll
                    for (int i = 0; i < 16; ++i) { mx = fmaxf(mx, fmaxf(fmaxf(S[i][0], S[i][1]), fmaxf(S[i][2], S[i][3]))); }
                    mx = fmaxf(mx, shx(mx, 16, lane)); mx = fmaxf(mx, shx(mx, 32, lane));
                    float sum = 0.f;
#pragma unroll
                    for (int i = 0; i < 16; ++i) {
#pragma unroll
                        for (int e = 0; e < 4; ++e) { S[i][e] = __builtin_amdgcn_exp2f(S[i][e] - mx); sum += S[i][e]; }
                    }
                    sum += shx(sum, 16, lane); sum += shx(sum, 32, lane);
                    inv = 1.0f / sum;
#pragma unroll
                    for (int a = 0; a < 8; ++a) {
                        u32x4 pw; pw.x = cvt_pk_bf16(S[2 * a][0], S[2 * a][1]); pw.y = cvt_pk_bf16(S[2 * a][2], S[2 * a][3]); pw.z = cvt_pk_bf16(S[2 * a + 1][0], S[2 * a + 1][1]); pw.w = cvt_pk_bf16(S[2 * a + 1][2], S[2 * a + 1][3]);
                        Pf[a] = __builtin_bit_cast(bf16x8, pw);
                    }
                }
            } else {
                {
                    bf16x8 Vf[2][4];
#define ATT_VREAD(n_, buf_) do { _Pragma("unroll") for (int d_ = 0; d_ < 4; ++d_) { LAS unsigned char* p_ = slot + (32 * ((n_) >> 2) + 4 * fq + (fr >> 2)) * 544 + (16 * (4 * ((n_) & 3) + d_) + 4 * (fr & 3)) * 2; Vf[buf_][d_] = tr_frag(p_, p_ + 16 * 544); } } while (0)
                    ATT_VREAD(0, 0);
                    __builtin_amdgcn_sched_group_barrier(0x100, 8, 0);
#pragma unroll
                    for (int n = 0; n < 8; ++n) {
                        if (n < 7) ATT_VREAD(n + 1, (n + 1) & 1);
#pragma unroll
                        for (int d = 0; d < 4; ++d) { const int al = n >> 2, dt = 4 * (n & 3) + d; Oa[dt] = MFMA16(Vf[n & 1][d], Pf[2 * (c - 4) + al], (c == 4 && al == 0) ? zero4 : Oa[dt]); }
                        __builtin_amdgcn_sched_group_barrier(0x100, 8, 0); __builtin_amdgcn_sched_group_barrier(0x008, 4, 0);
                    }
#undef ATT_VREAD
                }
            }
            if (c < 7) ATT_LSTORE(c + 1);
            LDS_BARRIER();
        }
#pragma unroll
        for (int dt = 0; dt < 16; ++dt) *(u32x2*)(((bf16_t*)(F.ws + WS_O)) + rowq * D + h * 256 + 16 * dt + 4 * fq) = pack4(Oa[dt] * inv);
#undef ATT_GLOAD
#undef ATT_LSTORE
    }
#undef FA_SLOAD
    *(LAS f32x4*)(red + w * 512 + 4 * lane) = a0; *(LAS f32x4*)(red + w * 512 + 256 + 4 * lane) = a1;
    __syncthreads();
    {
        float o = 0.f;
#pragma unroll
        for (int ww = 0; ww < 8; ++ww) o += red[ww * 512 + tid];
        ((bf16_t*)(F.ws + WS_SO))[(size_t)sb * D + hp * 512 + tid] = (bf16_t)(cvt_pk_bf16(o, 0.f) & 0xffffu);
    }
    __syncthreads();
}
__device__ __forceinline__ void final_norm(Frame& F0) {
    Frame F = launder(F0);
    const int gwx = F.rk * NWAVES + F.wave, NGX = F.rw * NWAVES, lane = F.lane;
    f32x4 g[4];
#pragma unroll
    for (int jj = 0; jj < 4; ++jj) g[jj] = ((const f32x4*)FIN(24) + lane)[64 * jj];
    for (int p = gwx; p < SEQ / 2 + 8; p += NGX) {
        const int m0 = p < SEQ / 2 ? F.xq * SEQ + 2 * p : MP + 16 * F.xq + 2 * (p - SEQ / 2);
        f32x4 v[2][4];
#pragma unroll
        for (int r = 0; r < 2; ++r) {
            const int m = m0 + r;
            if (m < MP) {
                const u32x2* src = (const u32x2*)(((bf16_t*)(F.ws + WS_XB)) + (size_t)m * D) + lane;
#pragma unroll
                for (int jj = 0; jj < 4; ++jj) v[r][jj] = unpack4(src[64 * jj]);
            } else {
                const f32x4* src = (const f32x4*)(((float*)(F.ws + WS_XS)) + (size_t)(m - MP) * D) + lane;
#pragma unroll
                for (int jj = 0; jj < 4; ++jj) v[r][jj] = src[64 * jj];
            }
        }
#pragma unroll
        for (int r = 0; r < 2; ++r) {
            const int m = m0 + r; float s = 0.f;
#pragma unroll
            for (int jj = 0; jj < 4; ++jj) s += dot4(v[r][jj], v[r][jj]);
            float* dst = m < MP ? F.out + O_Y + (size_t)m * D : F.out + O_YS + (size_t)(m - MP) * D;
            const float rs = rsqrtf(wave_sum(s, lane) * (1.0f / D) + EPS);
#pragma unroll
            for (int jj = 0; jj < 4; ++jj) ((f32x4*)dst + lane)[64 * jj] = v[r][jj] * rs * g[jj];
        }
    }
}

struct Args { const float* in[25]; float* out; unsigned char* ws; int ph_lo, ph_hi; };
#define REP(bit) for (int rep_ = 0; rep_ < 1 + ((REP_MASK >> (bit)) & 1); ++rep_)
__global__ void __launch_bounds__(NWAVES * 64, 2) fwd(Args args) {
    extern __shared__ __attribute__((aligned(16))) unsigned char lds_raw[];
    Frame F0;
    F0.lds = (LAS unsigned char*)lds_raw;
    F0.tid = threadIdx.x; F0.lane = F0.tid & 63; F0.wave = __builtin_amdgcn_readfirstlane(F0.tid >> 6); F0.G = gridDim.x; F0.bx = blockIdx.x;
    F0.in = (in_tab_t)__builtin_amdgcn_kernarg_segment_ptr();     F0.out = args.out; F0.ws = args.ws;
    for (int u = F0.tid; u < (LDS_BYTES - LDSCTL_OFF) / 4; u += NWAVES * 64) ((LAS unsigned*)(F0.lds + LDSCTL_OFF))[u] = 0u;
    __syncthreads();
    XcdBarrier bar; bar.wave = F0.wave; bar.bar = (unsigned*)(args.ws + WS_CTL) + CW_BAR; bar.x = 0; bar.st = nullptr;
    if (!MK_SPLIT) bar = xcd_barrier_post((unsigned*)(args.ws + WS_CTL) + CW_BAR, (volatile LAS unsigned*)(F0.lds + MISC_OFF) + 8, F0.wave);
    unsigned* rankw = (unsigned*)(args.ws + WS_CTL) + CW_RANK;
    const unsigned my_xcc = xb_xcc_id();
    unsigned my_rank = 0u;
    if (F0.tid == 0) ((volatile LAS unsigned*)(F0.lds + MISC_OFF))[12] = __hip_atomic_fetch_add(rankw + 64 * my_xcc, 1u, __ATOMIC_RELAXED, __HIP_MEMORY_SCOPE_AGENT);
    __syncthreads();
    my_rank = __builtin_amdgcn_readfirstlane(((volatile LAS unsigned*)(F0.lds + MISC_OFF))[12]);
    F0.vid = F0.bx;
    int ph = 0;
    bool local_ok = false;
    const int lo = args.ph_lo, hi = args.ph_hi;
#define PH_BEGIN if (ph >= lo && ph < hi) { Frame F = launder(F0);
#define PH_END } { const bool both_ = (ph >= lo && ph + 1 < hi); ++ph; if (!MK_SPLIT && both_) { XcdBarrier b2_ = bar; unsigned long long bp_ = uni64((unsigned long long)bar.bar); unsigned bx_ = __builtin_amdgcn_readfirstlane(bar.x); int bw_ = __builtin_amdgcn_readfirstlane(bar.wave); asm volatile("" : "+s"(bp_), "+s"(bx_), "+s"(bw_)); b2_.bar = (unsigned*)(GAS unsigned*)bp_; b2_.x = bx_; b2_.wave = bw_; if (local_ok && ph > 2) xcd_barrier_local(b2_); else xcd_barrier(b2_); if ((REP_MASK >> 19) & 1) xcd_barrier(b2_); if (ph == 2) local_ok = XCD_LOCAL && lo == 0 && __builtin_amdgcn_readfirstlane(__hip_atomic_load(rankw + 64 * 20, __ATOMIC_RELAXED, __HIP_MEMORY_SCOPE_AGENT)) == 0u;     } }

    PH_BEGIN REP(0) { p0_prologue(F0); __syncthreads(); } PH_END
    if (!MK_SPLIT && lo == 0) {
        unsigned nx = 0u, xi = 0u; bool even = (F0.G % 8) == 0;
        for (unsigned jx = 0; jx < 16; ++jx) { const unsigned c_ = __hip_atomic_load(rankw + 64 * jx, __ATOMIC_RELAXED, __HIP_MEMORY_SCOPE_AGENT); if (c_) { if (c_ != (unsigned)F0.G / 8u) even = false; if (jx < my_xcc) ++xi; ++nx; } }
        if (XCD_VID && even && nx == 8u) F0.vid = (int)(my_rank * 8u + xi);
        if (!(even && nx == 8u && (unsigned)(F0.bx % 8) == xi) && F0.tid == 0) __hip_atomic_store(rankw + 64 * 20, 1u, __ATOMIC_RELAXED, __HIP_MEMORY_SCOPE_AGENT);
        if (((REP_MASK >> 18) & 1) && !(even && nx == 8u && (unsigned)(F0.bx % 8) == xi) && F0.tid == 0) F0.out[O_YS + F0.bx] = __builtin_nanf("");
        F0.vid = __builtin_amdgcn_readfirstlane(F0.vid);
    }
    PH_BEGIN {
        if ((REP_MASK >> 17) & 1) {
            f32x4 pa[8]; bf16x8 pb = (bf16x8){(short)F.tid, 1, 2, 3, 4, 5, 6, 7};
#pragma unroll
            for (int i = 0; i < 8; ++i) pa[i] = (f32x4){(float)F.tid, 1.f, 2.f, (float)i};
#pragma unroll 1
            for (int it = 0; it < 512; ++it) {
#pragma unroll
                for (int r = 0; r < 4; ++r)
#pragma unroll
                    for (int i = 0; i < 8; ++i) pa[i] = MFMA16(pb, pb, pa[i]);
            }
            float sacc = 0.f;
#pragma unroll
            for (int i = 0; i < 8; ++i) sacc += pa[i][0] + pa[i][3];
            if (sacc == 12345.678f) ((float*)(F.ws + WS_Z))[F.tid] = sacc;
        }
        if ((REP_MASK >> 15) & 3) { pg8::Gemm gp{((bf16_t*)(F.ws + WS_XB)), ((bf16_t*)(F.ws + WS_C1)), MP, NC, ((REP_MASK >> 15) & 1) ? 1024 : 512}; pg8::StaticOrder Sp; Sp.init(MP, NC, F.G, (int)F.vid); EpiProbe Ep{((bf16_t*)(F.ws + WS_Z)), NC}; pg8::gemm_phase<EpiProbe, pg8::StaticOrder, true, true>(F.lds, gp, Sp, Ep, F.wave); }
        pg8::Gemm g{((bf16_t*)(F.ws + WS_MEMB)), ((bf16_t*)(F.ws + WS_WKV)), MMEM, 8192, D}; pg8::StaticOrder S; S.init(MMEM, 8192, F.G, (int)F.vid);
        EpiMemKV E{((float*)(F.ws + WS_SMALL + 65536)), F.out + O_MEMK, F.out + O_MEMV, ((bf16_t*)(F.ws + WS_KB)), ((bf16_t*)(F.ws + WS_VB))};
        REP(1) pg8::gemm_phase<EpiMemKV, pg8::StaticOrder, true, true>(F.lds, g, S, E, F.wave);
    } PH_END
    if (STAGGER_TICKS != 0 && lo == 0 && ((F0.bx & 1) == (STAGGER_TICKS > 0 ? 1 : 0))) { const unsigned long long t0_ = __builtin_amdgcn_s_memrealtime(); const unsigned long long tk_ = (unsigned long long)(STAGGER_TICKS > 0 ? STAGGER_TICKS : -STAGGER_TICKS); while (__builtin_amdgcn_s_memrealtime() - t0_ < tk_) __builtin_amdgcn_s_sleep(8); }
    unsigned* pbw = (unsigned*)(args.ws + WS_CTL) + CW_RANK + 64 * 24;
    if (!MK_SPLIT && SPLIT_PROLOGUE && lo == 0) {
        const int half = F0.bx & 1, hw = (half ? (F0.G >> 1) : ((F0.G + 1) >> 1)) * NWAVES, hi_ = (F0.bx >> 1) * NWAVES + F0.wave;
        p0_weights(F0, 1, hi_, hw, half);
        asm volatile("s_waitcnt vmcnt(0)" ::: "memory"); __syncthreads();
        if (F0.wave == 0 && hw_lane() == 0) { __builtin_amdgcn_fence(__ATOMIC_RELEASE, "agent"); asm volatile("s_waitcnt vmcnt(0)" ::: "memory"); (void)__hip_atomic_fetch_add(pbw, 1u, __ATOMIC_RELAXED, __HIP_MEMORY_SCOPE_AGENT); }
    }
#pragma unroll 1
    for (int l = 0; l < DEPTH; ++l) {
        const int j = l >> 1;
        if (!MK_SPLIT && SPLIT_PROLOGUE && lo == 0 && l == 1) {
            if (F0.wave == 0 && hw_lane() == 0) {
                const unsigned want = (unsigned)F0.G; unsigned sp = 0u;
                while (__hip_atomic_load(pbw, __ATOMIC_RELAXED, __HIP_MEMORY_SCOPE_AGENT) < want) { __builtin_amdgcn_s_sleep(2); if (++sp > (1u << 22)) { atomicAdd((unsigned*)(args.ws + WS_CTL) + CW_BAR + XB_TMO, 1u); break; } }
                __builtin_amdgcn_fence(__ATOMIC_ACQUIRE, "agent"); asm volatile("s_waitcnt vmcnt(0)" ::: "memory");
            }
            __syncthreads();
        }
        if ((l & 1) == 0) {
            PH_BEGIN {
                pg8::Gemm g{((bf16_t*)(F.ws + WS_XB)), ((bf16_t*)(F.ws + WS_AB1)) + (size_t)j * NAB * D, MP, NAB, D}; pg8::StaticOrder S; S.init(MP, NAB, F.G, (int)F.vid);
                Unit u0{0, 0}; S.next(0, u0); rstd_table(((float*)(F.ws + WS_RSQ)), u0.pm, (LAS float*)(F.lds + RSTD_OFF), F.tid);
                EpiG1Even E{((float*)(F.ws + WS_RSQ)), ((bf16_t*)(F.ws + WS_Z)), ((float*)(F.ws + WS_VSQ)), F.out + O_POOLP + (size_t)j * 8 * 15 * 1024, (LAS const float*)(F.lds + RSTD_OFF), u0.pm};
                SEpiZ SE{((float*)(F.ws + WS_SMALL)), ((float*)(F.ws + WS_SZ)), 8192, 0};
                const bool s_first = (F.rk & 1) != 0;
                if (s_first) { REP(3) sgemm16<SEpiZ, NAB>(F, ((bf16_t*)(F.ws + WS_XB)) + (size_t)MP * D, ((bf16_t*)(F.ws + WS_AB1)) + (size_t)j * NAB * D, D, SE); }
                REP(2) pg8::gemm_phase<EpiG1Even, pg8::StaticOrder, true, true>(F.lds, g, S, E, F.wave);
                if (!s_first) { REP(3) sgemm16<SEpiZ, NAB>(F, ((bf16_t*)(F.ws + WS_XB)) + (size_t)MP * D, ((bf16_t*)(F.ws + WS_AB1)) + (size_t)j * NAB * D, D, SE); }
            } PH_END
            PH_BEGIN {
                REP(4) for (int i = F.rk; i < 32; i += F.rw) {
                    const int n = 16 * F.xq + (i >> 1);
                    if ((i & 1) == 0) { sgu_chunk(F, j, n, 0, 2); pool_pair<0, 3>(F, j, n); } else { sgu_chunk(F, j, n, 2, 4); pool_pair<1, 2>(F, j, n); }
                }
                REP(5) for (int i = F.rk; i < 16; i += F.rw) sample_mix_even(F, j, 16 * F.xq + i);
            } PH_END
        } else {
            PH_BEGIN {
                pg8::Gemm g{((bf16_t*)(F.ws + WS_XB)), ((bf16_t*)(F.ws + WS_C1)) + (size_t)j * NC * D, MP, NC, D}; pg8::StaticOrder S; S.init(MP, NC, F.G, (int)F.vid);
                Unit u0{0, 0}; S.next(0, u0);
                for (int i = F.tid; i < 8 * 3 * 64; i += NWAVES * 64) { const int ui = i / 192, q = (i / 64) % 3, c = i & 63, pn = u0.pn + 4 * ui; ((LAS float*)(F.lds + CWL_OFF))[i] = pn < NC / 256 ? (FIN(18) + (size_t)j * 3 * 2048)[q * 2048 + pn * 64 + c] : 0.f; }
                rstd_table(((float*)(F.ws + WS_RSQ)), u0.pm, (LAS float*)(F.lds + RSTD_OFF), F.tid);
                EpiG1Odd E{((float*)(F.ws + WS_RSQ)), ((bf16_t*)(F.ws + WS_A2)), FIN(18) + (size_t)j * 3 * 2048, F.out + O_CONVP + (size_t)j * 8 * 2 * 2048, ((float*)(F.ws + WS_SIDE)), (LAS float*)(F.lds + HALO_OFF), (LAS const float*)(F.lds + RSTD_OFF), u0.pm, (LAS const float*)(F.lds + CWL_OFF), u0.pn};
                SEpiZ SE{((float*)(F.ws + WS_SMALL)), ((float*)(F.ws + WS_SZ)), 8192, 1};
                const bool s_first = (F.rk & 1) != 0;
                if (s_first) { REP(3) sgemm16<SEpiZ, NC>(F, ((bf16_t*)(F.ws + WS_XB)) + (size_t)MP * D, ((bf16_t*)(F.ws + WS_C1)) + (size_t)j * NC * D, D, SE); }
                REP(6) pg8::gemm_phase<EpiG1Odd, pg8::StaticOrder, true, true>(F.lds, g, S, E, F.wave);
                if (!s_first) { REP(3) sgemm16<SEpiZ, NC>(F, ((bf16_t*)(F.ws + WS_XB)) + (size_t)MP * D, ((bf16_t*)(F.ws + WS_C1)) + (size_t)j * NC * D, D, SE); }
            } PH_END
            PH_BEGIN {
                REP(5) for (int i = F.rk; i < 16; i += F.rw) sample_conv_odd(F, j, 16 * F.xq + i);
            } PH_END
        }
        PH_BEGIN {
            const bf16_t* W2 = ((l & 1) ? ((bf16_t*)(F.ws + WS_C2)) : ((bf16_t*)(F.ws + WS_AB2))) + (size_t)j * D * 2048;
            pg8::Gemm g{((bf16_t*)(F.ws + WS_A2)), W2, MP, D, 2048}; pg8::StaticOrder S; S.init(MP, D, F.G, (int)F.vid);
            if (l & 1) { Unit fu; for (int i = 0; S.next(i, fu); ++i) conv_fixup(((float*)(F.ws + WS_SIDE)), FIN(18) + (size_t)j * 3 * 2048, ((bf16_t*)(F.ws + WS_A2)), fu.pm, F.tid); asm volatile("s_waitcnt vmcnt(0)" ::: "memory"); __syncthreads(); }
            EpiRes E{((bf16_t*)(F.ws + WS_XB)), ((float*)(F.ws + WS_RSQ))};
            pg8::gemm_phase<EpiRes, pg8::StaticOrder, true, true>(F.lds, g, S, E, F.wave);
            SEpiRes SE{((float*)(F.ws + WS_XS)), ((bf16_t*)(F.ws + WS_XB)) + (size_t)MP * D, ((float*)(F.ws + WS_SMALL))};
            sgemm16<SEpiRes, D>(F, ((bf16_t*)(F.ws + WS_SA2)), W2, 2048, SE);
        } PH_END
        PH_BEGIN {
            pg8::Gemm g{((bf16_t*)(F.ws + WS_XB)), ((bf16_t*)(F.ws + WS_WQ)) + (size_t)l * D * D, MP, D, D}; pg8::StaticOrder S; S.init(MP, D, F.G, (int)F.vid);
            Unit u0{0, 0}; S.next(0, u0); rstd_table(((float*)(F.ws + WS_RSQ)), u0.pm, (LAS float*)(F.lds + RSTD_OFF), F.tid);
            EpiQ E{((float*)(F.ws + WS_RSQ)), ((bf16_t*)(F.ws + WS_Q)), (LAS const float*)(F.lds + RSTD_OFF), u0.pm};
            REP(8) pg8::gemm_phase<EpiQ, pg8::StaticOrder, true, true>(F.lds, g, S, E, F.wave);
            SEpiQ SE{((float*)(F.ws + WS_SMALL)), ((float*)(F.ws + WS_SQ))};
            REP(9) sgemm16<SEpiQ, D>(F, ((bf16_t*)(F.ws + WS_XB)) + (size_t)MP * D, ((bf16_t*)(F.ws + WS_WQ)) + (size_t)l * D * D, D, SE);
        } PH_END
        PH_BEGIN {
            if (F.G == 256) { REP(10) attn_fused(F, l); }
            else { attn_prompt(F, l); attn_sample(F, l); }
        } PH_END
        PH_BEGIN {
            pg8::Gemm g{((bf16_t*)(F.ws + WS_O)), ((bf16_t*)(F.ws + WS_WO)) + (size_t)l * D * D, MP, D, D}; pg8::StaticOrder S; S.init(MP, D, F.G, (int)F.vid);
            EpiRes E{((bf16_t*)(F.ws + WS_XB)), ((float*)(F.ws + WS_RSQ))};
            pg8::gemm_phase<EpiRes, pg8::StaticOrder, true, true>(F.lds, g, S, E, F.wave);
            SEpiRes SE{((float*)(F.ws + WS_XS)), ((bf16_t*)(F.ws + WS_XB)) + (size_t)MP * D, ((float*)(F.ws + WS_SMALL))};
            sgemm16<SEpiRes, D>(F, ((bf16_t*)(F.ws + WS_SO)), ((bf16_t*)(F.ws + WS_WO)) + (size_t)l * D * D, D, SE);
        } PH_END
    }
    PH_BEGIN final_norm(F0); PH_END
#undef PH_BEGIN
#undef PH_END
}
constexpr int N_PHASES = 2 + 6 * DEPTH + 1;

extern "C" void kernel_launch(void* const* d_in, const int* in_sizes, int n_in, void* d_out, int out_size, void* d_ws, size_t ws_size, hipStream_t stream) {
    static int grid = 0;
    if (grid == 0) {
        if (n_in != 25 || in_sizes[0] != MP * D || (size_t)out_size != O_END || ws_size < WS_END) { fprintf(stderr, "kernel_launch: unexpected shapes (n_in %d, in0 %d, out %d, ws %zu); nothing launched\n", n_in, n_in > 0 ? in_sizes[0] : -1, out_size, ws_size); grid = -1; return; }
        int dev = 0, cus = 0, per_cu = 0;
        if (hipGetDevice(&dev) != hipSuccess || hipDeviceGetAttribute(&cus, hipDeviceAttributeMultiprocessorCount, dev) != hipSuccess) { fprintf(stderr, "kernel_launch: device query failed\n"); grid = -1; return; }
        if (hipFuncSetAttribute((const void*)fwd, hipFuncAttributeMaxDynamicSharedMemorySize, LDS_BYTES) != hipSuccess) { fprintf(stderr, "kernel_launch: hipFuncSetAttribute failed\n"); grid = -1; return; }
        if (hipOccupancyMaxActiveBlocksPerMultiprocessor(&per_cu, (const void*)fwd, NWAVES * 64, LDS_BYTES) != hipSuccess || per_cu < 1) fprintf(stderr, "kernel_launch: note: occupancy query reports %d workgroups per CU\n", per_cu);
        (void)hipGetLastError();
        grid = cus;
    }
    if (grid < 0) return;
    if (hipMemsetAsync((char*)d_ws + WS_CTL, 0, CTL_ZERO_BYTES, stream) != hipSuccess) { fprintf(stderr, "kernel_launch: memset failed\n"); return; }
    Args a{};
    for (int i = 0; i < 25; ++i) a.in[i] = (const float*)d_in[i];
    a.out = (float*)d_out; a.ws = (unsigned char*)d_ws;
#if MK_SPLIT
    for (int p = 0; p < N_PHASES; ++p) { a.ph_lo = p; a.ph_hi = p + 1; hipLaunchKernelGGL(fwd, dim3(grid), dim3(NWAVES * 64), LDS_BYTES, stream, a); }
#else
    a.ph_lo = 0; a.ph_hi = N_PHASES;
    hipLaunchKernelGGL(fwd, dim3(grid), dim3(NWAVES * 64), LDS_BYTES, stream, a);
#endif
    const hipError_t le = hipPeekAtLastError();
    if (le != hipSuccess) fprintf(stderr, "kernel_launch: launch failed: %s\n", hipGetErrorName(le));
}
```

```cpp
#include <hip/hip_runtime.h>
#include <cstdio>
#include <cstdint>
#ifndef REP_MASK
#define REP_MASK 0
#endif
#ifndef STAGGER_TICKS
#define STAGGER_TICKS 0
#endif
#ifndef PB_ODD_PCT
#define PB_ODD_PCT 100
#endif
#ifndef SPLIT_PROLOGUE
#define SPLIT_PROLOGUE 1
#endif
#ifndef XCD_LOCAL
#define XCD_LOCAL 1
#endif
#ifndef XCD_VID
#define XCD_VID 0
#endif
#ifndef MK_SPLIT
#define MK_SPLIT 0
#endif
__device__ __forceinline__ int hw_lane() { int l; asm volatile("v_mbcnt_lo_u32_b32 %0, -1, 0\n\tv_mbcnt_hi_u32_b32 %0, -1, %0" : "=v"(l)); return l; }
namespace pg8 {
#define PG8_LAS __attribute__((address_space(3)))
typedef unsigned short bf16_t;
typedef short bf16x8 __attribute__((ext_vector_type(8)));
typedef float f32x4 __attribute__((ext_vector_type(4)));
typedef unsigned u32x4 __attribute__((ext_vector_type(4)));
constexpr int BM = 256, BK = 64, HALF = 128, HTB = HALF * BK * 2  , STAGE_BYTES = 8 * HTB, NXCD = 8, WGM = 8;

__host__ __device__ __forceinline__ int lds_byte(int r, int c) { const int st = (r >> 4) * 2 + (c >> 5), rr = r & 15, cc = c & 31, ob = rr * 64 + cc * 2; return st * 1024 + (ob ^ (((ob >> 9) & 1) << 5)); }
__host__ __device__ __forceinline__ void stage_rc(int b, int& R, int& C) { const int st = b / 1024, sb = b % 1024, swz = sb ^ (((sb >> 9) & 1) << 5); R = (st >> 1) * 16 + swz / 64; C = (st & 1) * 32 + (swz % 64) / 2; }
__host__ __device__ __forceinline__ int perm32(int rho) { const int n = rho >> 4, i = rho & 15; return 8 * (i >> 2) + 4 * n + (i & 3); }

struct Unit { int pm, pn; };
struct Gemm { const bf16_t* A; const bf16_t* Bt; int M, N, K; };

struct StaticOrder {
    int nM, nN, nwg, G, c;
    __host__ __device__ __forceinline__ void init(int M, int N, int G_, int c_) { nM = M / BM; nN = N / BM; nwg = nM * nN; G = G_; c = c_; }
    __host__ __device__ __forceinline__ bool next(int i, Unit& u) const {
        const long L = (long)i * G + c; if (L >= nwg) return false;
        int wgid = (int)L; { const int q = nwg / NXCD, r = nwg % NXCD, xcd = wgid % NXCD, off = wgid / NXCD; wgid = (xcd < r ? xcd * (q + 1) : r * (q + 1) + (xcd - r) * q) + off; }
        const int nig = WGM * nN, gid = wgid / nig, fm = gid * WGM, gsz = (nM - fm) < WGM ? (nM - fm) : WGM;
        u.pm = fm + ((wgid % nig) % gsz); u.pn = (wgid % nig) / gsz; return true;
    }
    __device__ __forceinline__ void a_ready(const Unit&) const {}
    __device__ __forceinline__ void done(const Unit&) const {}
};

typedef float f32x2cv __attribute__((ext_vector_type(2))); typedef __bf16 bf16x2cv __attribute__((ext_vector_type(2)));
__device__ __forceinline__ unsigned cvt_pk_bf16(float lo, float hi) { const f32x2cv v = {lo, hi}; return __builtin_bit_cast(unsigned, __builtin_convertvector(v, bf16x2cv)); }
template <class Epi, class Sched, bool ALIGN_EPI = false, bool SP2 = false>
__device__ __forceinline__ void gemm_phase(PG8_LAS unsigned char* lds, const Gemm g, const Sched& S, const Epi& E, const int wave_id) {
    int tid_ = (wave_id << 6) | hw_lane(); asm volatile("" : "+v"(tid_));
    const int tid = tid_, wid = __builtin_amdgcn_readfirstlane(tid >> 6), lane = tid & 63, wr = wid >> 2, wc = wid & 3, fr = lane & 15, fq = lane >> 4;
    const int K = g.K, nt = K / BK;
    unsigned voffA[2], voffB[2];
#pragma unroll
    for (int i = 0; i < 2; ++i) { int R, C; stage_rc(tid * 16 + i * 8192, R, C); const int Rb = Epi::PERM ? ((R & ~31) + perm32(R & 31)) : R;
        voffA[i] = (unsigned)(R * K + C) * 2u; voffB[i] = (unsigned)(Rb * K + C) * 2u; }
    const size_t kstep = (size_t)(BK * 2);
    const size_t hstep = (size_t)HALF * K * 2;
    const size_t tstep = 2 * hstep;
    const unsigned ldsw = (unsigned)wid * 1024u;
    const int aoff = lds_byte(wr * 64 + fr, fq * 8), boff = lds_byte(wc * 32 + fr, fq * 8);
#define PG8_SA(b, h) (((b) * 2 + (h)) * HTB)
#define PG8_SB(b, h) ((4 + (b) * 2 + (h)) * HTB)
#define PG8_STAGE(bufoff, gbase, voff) do { _Pragma("unroll") for (int _i = 0; _i < 2; ++_i) \
        __builtin_amdgcn_global_load_lds((const unsigned*)((const char*)(gbase) + (voff)[_i]), (PG8_LAS unsigned*)(lds + (bufoff) + ldsw + _i * 8192), 16, 0, 0); } while (0)
#define PG8_LDA(dst, b, h) do { _Pragma("unroll") for (int m = 0; m < 4; ++m) _Pragma("unroll") for (int k = 0; k < 2; ++k) dst[m][k] = *(const PG8_LAS bf16x8*)(lds + PG8_SA(b, h) + aoff + m * 2048 + k * 1024); } while (0)
#define PG8_LDB(dst, b, h) do { _Pragma("unroll") for (int n = 0; n < 2; ++n) _Pragma("unroll") for (int k = 0; k < 2; ++k) dst[n][k] = *(const PG8_LAS bf16x8*)(lds + PG8_SB(b, h) + boff + n * 2048 + k * 1024); } while (0)
#define PG8_MMA(ai, bj, At, Bt) do { __builtin_amdgcn_s_setprio(1); _Pragma("unroll") for (int m = 0; m < 4; ++m) _Pragma("unroll") for (int n = 0; n < 2; ++n) _Pragma("unroll") for (int k = 0; k < 2; ++k) \
        acc[ai][bj][m][n] = __builtin_amdgcn_mfma_f32_16x16x32_bf16(Bt[n][k], At[m][k], acc[ai][bj][m][n], 0, 0, 0); __builtin_amdgcn_s_setprio(0); } while (0)
#define PG8_WAIT_V(n) asm volatile("s_waitcnt vmcnt(" #n ")" ::: "memory")
#define PG8_WAIT_L(n) asm volatile("s_waitcnt lgkmcnt(" #n ")" ::: "memory")
#define PG8_BAR __builtin_amdgcn_s_barrier()
#define PG8_SCHED __builtin_amdgcn_sched_barrier(0)
    Unit cur, nxt; int ui = 0;
    if (!S.next(0, cur)) return;
    f32x4 acc[2][2][4][2];
#pragma unroll
    for (int a = 0; a < 2; ++a)
#pragma unroll
        for (int b = 0; b < 2; ++b)
#pragma unroll
            for (int m = 0; m < 4; ++m)
#pragma unroll
                for (int n = 0; n < 2; ++n) acc[a][b][m][n] = (f32x4){0.f, 0.f, 0.f, 0.f};
    bf16x8 At[4][2], B0[2][2], B1[2][2];
    const char* cA = (const char*)g.A + (size_t)cur.pm * tstep; const char* cB = (const char*)g.Bt + (size_t)cur.pn * tstep;
    S.a_ready(cur);
    if constexpr (SP2) {
        PG8_STAGE(PG8_SB(0, 0), cB, voffB); PG8_STAGE(PG8_SB(0, 1), cB + hstep, voffB); PG8_STAGE(PG8_SA(0, 0), cA, voffA); PG8_STAGE(PG8_SA(0, 1), cA + hstep, voffA);
        if (wr == 1) PG8_BAR;
        PG8_WAIT_V(2); PG8_BAR;
        PG8_STAGE(PG8_SB(1, 0), cB + kstep, voffB); PG8_STAGE(PG8_SA(1, 0), cA + kstep, voffA); PG8_STAGE(PG8_SB(1, 1), cB + hstep + kstep, voffB);
        PG8_WAIT_V(6); PG8_BAR;
    } else {
        PG8_STAGE(PG8_SB(0, 0), cB, voffB); PG8_STAGE(PG8_SA(0, 0), cA, voffA); PG8_STAGE(PG8_SB(0, 1), cB + hstep, voffB); PG8_STAGE(PG8_SA(0, 1), cA + hstep, voffA);
        if (wr == 1) PG8_BAR;
        PG8_WAIT_V(4); PG8_BAR;
        PG8_STAGE(PG8_SB(1, 0), cB + kstep, voffB); PG8_STAGE(PG8_SA(1, 0), cA + kstep, voffA); PG8_STAGE(PG8_SB(1, 1), cB + hstep + kstep, voffB);
        PG8_WAIT_V(6); PG8_BAR;
    }
    for (;;) {
        const bool has_next = S.next(ui + 1, nxt);
        const char* nA = has_next ? (const char*)g.A + (size_t)nxt.pm * tstep : cA; const char* nB = has_next ? (const char*)g.Bt + (size_t)nxt.pn * tstep : cB;
        for (int t = 0; t < nt; t += 2) {
            const bool last = (t == nt - 2);
            const char* a1 = cA + (size_t)(t + 1) * kstep;
            const char* a2 = last ? nA : cA + (size_t)(t + 2) * kstep; const char* b2 = last ? nB : cB + (size_t)(t + 2) * kstep;
            const char* a3 = a2 + kstep; const char* b3 = b2 + kstep;
            if (last && has_next) S.a_ready(nxt);
            if constexpr (SP2) {
            PG8_LDB(B0, 0, 0); PG8_LDB(B1, 0, 1); PG8_SCHED; PG8_LDA(At, 0, 0); PG8_STAGE(PG8_SA(1, 1), a1 + hstep, voffA);
            PG8_WAIT_V(8); PG8_WAIT_L(0); PG8_BAR; PG8_MMA(0, 0, At, B0); PG8_MMA(0, 1, At, B1); PG8_BAR; PG8_SCHED;
            PG8_LDA(At, 0, 1); PG8_STAGE(PG8_SB(0, 0), b2, voffB); PG8_STAGE(PG8_SB(0, 1), b2 + hstep, voffB); PG8_STAGE(PG8_SA(0, 0), a2, voffA);
            PG8_WAIT_V(8); PG8_WAIT_L(0); PG8_BAR; PG8_MMA(1, 0, At, B0); PG8_MMA(1, 1, At, B1); PG8_BAR; PG8_SCHED;
            PG8_LDB(B0, 1, 0); PG8_LDB(B1, 1, 1); PG8_SCHED; PG8_LDA(At, 1, 0); PG8_STAGE(PG8_SA(0, 1), a2 + hstep, voffA);
            PG8_WAIT_V(8); PG8_WAIT_L(0); PG8_BAR; PG8_MMA(0, 0, At, B0); PG8_MMA(0, 1, At, B1); PG8_BAR; PG8_SCHED;
            PG8_LDA(At, 1, 1); PG8_STAGE(PG8_SB(1, 0), b3, voffB); PG8_STAGE(PG8_SB(1, 1), b3 + hstep, voffB); PG8_STAGE(PG8_SA(1, 0), a3, voffA);
            PG8_WAIT_V(8); PG8_WAIT_L(0); PG8_BAR; PG8_MMA(1, 0, At, B0); PG8_MMA(1, 1, At, B1); PG8_BAR; PG8_SCHED;
            } else {
            PG8_LDB(B0, 0, 0); PG8_SCHED; PG8_LDA(At, 0, 0); PG8_STAGE(PG8_SA(1, 1), a1 + hstep, voffA);
            PG8_WAIT_L(8); PG8_BAR; PG8_WAIT_L(0); PG8_MMA(0, 0, At, B0); PG8_BAR; PG8_SCHED;
            PG8_LDB(B1, 0, 1); PG8_STAGE(PG8_SB(0, 0), b2, voffB);
            PG8_BAR; PG8_WAIT_L(0); PG8_MMA(0, 1, At, B1); PG8_BAR;
            PG8_LDA(At, 0, 1); PG8_STAGE(PG8_SA(0, 0), a2, voffA);
            PG8_BAR; PG8_WAIT_L(0); PG8_MMA(1, 0, At, B0); PG8_BAR; PG8_SCHED;
            PG8_STAGE(PG8_SB(0, 1), b2 + hstep, voffB);
            PG8_WAIT_V(6); PG8_BAR; PG8_MMA(1, 1, At, B1); PG8_BAR;
            PG8_LDB(B0, 1, 0); PG8_SCHED; PG8_LDA(At, 1, 0); PG8_STAGE(PG8_SA(0, 1), a2 + hstep, voffA);
            PG8_WAIT_L(8); PG8_BAR; PG8_WAIT_L(0); PG8_MMA(0, 0, At, B0); PG8_BAR; PG8_SCHED;
            PG8_LDB(B1, 1, 1); PG8_STAGE(PG8_SB(1, 0), b3, voffB);
            PG8_BAR; PG8_WAIT_L(0); PG8_MMA(0, 1, At, B1); PG8_BAR;
            PG8_LDA(At, 1, 1); PG8_STAGE(PG8_SA(1, 0), a3, voffA);
            PG8_BAR; PG8_WAIT_L(0); PG8_MMA(1, 0, At, B0); PG8_BAR; PG8_SCHED;
            PG8_STAGE(PG8_SB(1, 1), b3 + hstep, voffB);
            PG8_WAIT_V(6); PG8_BAR; PG8_MMA(1, 1, At, B1); PG8_BAR;
            }
        }
        if constexpr (ALIGN_EPI) { if (wr == 0) PG8_BAR; }
        if constexpr (!Epi::AFTER_DRAIN) { for (int rep_ = 0; rep_ < 1 + (Epi::REP_EPI ? 1 : 0); ++rep_) E(acc, cur, wr, wc, fr, fq); S.done(cur); }
        if (!has_next) break;
#pragma unroll
        for (int a = 0; a < 2; ++a)
#pragma unroll
            for (int b = 0; b < 2; ++b)
#pragma unroll
                for (int m = 0; m < 4; ++m)
#pragma unroll
                    for (int n = 0; n < 2; ++n) acc[a][b][m][n] = (f32x4){0.f, 0.f, 0.f, 0.f};
        cur = nxt; cA = nA; cB = nB; ++ui;
        if constexpr (ALIGN_EPI) { if (wr == 1) PG8_BAR; }
    }
    PG8_WAIT_V(0);
    if constexpr (!ALIGN_EPI) { if (wr == 0) PG8_BAR; }
    PG8_BAR;
    if constexpr (Epi::AFTER_DRAIN) { E.fused(acc, cur, wr, wc, fr, fq, lds, wid, lane); S.done(cur); }
#undef PG8_SA
#undef PG8_SB
#undef PG8_STAGE
#undef PG8_LDA
#undef PG8_LDB
#undef PG8_MMA
#undef PG8_WAIT_V
#undef PG8_WAIT_L
#undef PG8_BAR
#undef PG8_SCHED
}
}

using pg8::bf16_t; using pg8::bf16x8; using pg8::f32x4; using pg8::u32x4; using pg8::Unit; using pg8::cvt_pk_bf16;
#define GAS __attribute__((address_space(1)))
#define LAS __attribute__((address_space(3)))
typedef unsigned u32x2 __attribute__((ext_vector_type(2)));
typedef short s16x4 __attribute__((ext_vector_type(4)));
typedef GAS unsigned gu32;
#define RLX_AGENT __ATOMIC_RELAXED, __HIP_MEMORY_SCOPE_AGENT

constexpr int NWAVES = 8;
constexpr int D = 1024, MP = 16384, MS = 128, SEQ = 2048, NBATCH = 8, NMEM = 256, MMEM = 2048, DEPTH = 4;
constexpr int NAB = 5120, NC = 8192;
constexpr float EPS = 1e-6f;
constexpr float QSCALE = 0.0625f * 1.4426950408889634f;

constexpr size_t O_Y = 0, O_YS = O_Y + (size_t)MP * D, O_POOLP = O_YS + (size_t)MS * D, O_POOLS = O_POOLP + 2 * 8 * 15 * 1024,
                 O_CONVP = O_POOLS + (size_t)2 * 128 * 15 * 1024, O_CONVS = O_CONVP + 2 * 8 * 2 * 2048, O_SGUV = O_CONVS + (size_t)2 * 128 * 2 * 2048,
                 O_MEMK = O_SGUV + 2 * 128 * 1024, O_MEMV = O_MEMK + (size_t)4 * MMEM * D, O_END = O_MEMV + (size_t)4 * MMEM * D;
static_assert(O_END == 39239680, "output size");

constexpr size_t MiB = 1u << 20;
constexpr size_t WS_CTL = 0, CTL_ZERO_BYTES = 1 * MiB;
constexpr size_t WS_AB1 = 2 * MiB, WS_C1 = 22 * MiB, WS_AB2 = 54 * MiB, WS_C2 = 62 * MiB, WS_WQ = 70 * MiB, WS_WKV = 78 * MiB, WS_WO = 94 * MiB, WS_PMT = 102 * MiB;
constexpr size_t WS_XB = 104 * MiB;
constexpr size_t WS_RSQ = 137 * MiB, WS_VSQ = 138 * MiB;
constexpr size_t WS_SMALL = 139 * MiB;
constexpr size_t WS_Z = 140 * MiB;
constexpr size_t WS_A2 = 268 * MiB;
constexpr size_t WS_Q = 332 * MiB, WS_O = 364 * MiB;
constexpr size_t WS_MEMB = 396 * MiB, WS_KB = 400 * MiB, WS_VB = 416 * MiB;
constexpr size_t WS_XS = 432 * MiB, WS_SZ = 433 * MiB, WS_SA2 = 437 * MiB, WS_SQ = 438 * MiB, WS_SO = 439 * MiB, WS_SIDE = 440 * MiB  , WS_END = 444 * MiB;
constexpr int CW_BAR = 4096, CW_RANK = 8192;

constexpr int RING_BYTES = 131072, LDSCTL_OFF = RING_BYTES, MISC_OFF = LDSCTL_OFF + 320, HALO_OFF = RING_BYTES + 1024  , RSTD_OFF = HALO_OFF + 8192  , CWL_OFF = RSTD_OFF + 1024  , LDS_BYTES = 155648;

#define LDS_WAIT() asm volatile("s_waitcnt lgkmcnt(0)" ::: "memory")
#define LDS_BARRIER() asm volatile("s_waitcnt lgkmcnt(0)\n\ts_barrier" ::: "memory")

#define XB_TMO      128
#define XB_XCNT(j)  (256  + 64 * (j))
#define XB_XSUB(j)  (1280 + 64 * (j))
#define XB_XGEN(j)  (2304 + 64 * (j))
#define XB_TOP      3328
#define XB_TOPGEN   3392
#define XCD_BAR_WORDS 3456
#define XB_SPIN_CAP (1u << 18)

__device__ __forceinline__ unsigned xb_ld(unsigned* p)              { return __hip_atomic_load(p, __ATOMIC_RELAXED, __HIP_MEMORY_SCOPE_AGENT); }
__device__ __forceinline__ unsigned xb_add(unsigned* p, unsigned v) { return __hip_atomic_fetch_add(p, v, __ATOMIC_RELAXED, __HIP_MEMORY_SCOPE_AGENT); }
__device__ __forceinline__ unsigned xb_xcc_id() { return (unsigned)__builtin_amdgcn_s_getreg((3 << 11) | 20) & 0xFu; }
#define XB_SPIN(cond, bar) do { unsigned _sp = 0; while (cond) { __builtin_amdgcn_s_sleep(1); \
    if ((++_sp & 255u) == 0u) { if (xb_ld(&(bar)[XB_TMO])) break; if (_sp > XB_SPIN_CAP) { atomicAdd(&(bar)[XB_TMO], 1u); break; } } } } while (0)

struct XcdBarrier {
    int wave;
    unsigned* bar; unsigned x;
    volatile LAS unsigned* st;
};

__device__ __forceinline__ XcdBarrier xcd_barrier_post(unsigned* bar, volatile LAS unsigned* st, int wave) {
    XcdBarrier b; b.wave = wave; b.bar = bar; b.x = xb_xcc_id(); b.st = st;
    if (b.wave == 0 && hw_lane() == 0) (void)xb_add(&bar[XB_XCNT(b.x)], 1u);
    return b;
}
__device__ __forceinline__ void xcd_barrier_complete(unsigned* bar, unsigned x, unsigned& nloc, unsigned& nx) {
    const unsigned G = gridDim.x * gridDim.y * gridDim.z;
    unsigned sum, cnt, mine, sp = 0u;
    for (;;) {
        sum = 0u; cnt = 0u; mine = 0u;
#pragma unroll
        for (unsigned j = 0; j < 16; ++j) { const unsigned c = xb_ld(&bar[XB_XCNT(j)]); sum += c; cnt += (c > 0u) ? 1u : 0u; mine = (j == x) ? c : mine; }
        if (sum == G) break;
        __builtin_amdgcn_s_sleep(1);
        if ((++sp & 255u) == 0u) { if (xb_ld(&bar[XB_TMO])) break; if (sp > XB_SPIN_CAP) { atomicAdd(&bar[XB_TMO], 1u); break; } }
    }
    nloc = mine > 0u ? mine : 1u; nx = cnt > 0u ? cnt : 1u;
}

__device__ __forceinline__ void xcd_barrier(const XcdBarrier& b) {
    asm volatile("s_waitcnt vmcnt(0)" ::: "memory");
    __syncthreads();
    if (b.wave == 0 && hw_lane() == 0) {
        unsigned* bar = b.bar;
        __builtin_amdgcn_s_waitcnt(0);
        unsigned nloc = b.st[0], nx = b.st[1];
        if (nloc == 0u) { xcd_barrier_complete(bar, b.x, nloc, nx); b.st[0] = nloc; b.st[1] = nx; }
        const unsigned old = xb_add(&bar[XB_XSUB(b.x)], 1u);
        const unsigned gen = old / nloc;
        if (old + 1u == (gen + 1u) * nloc) {
            __builtin_amdgcn_fence(__ATOMIC_RELEASE, "agent");
            asm volatile("s_waitcnt vmcnt(0)" ::: "memory");
            const unsigned og = xb_add(&bar[XB_TOP], 1u);
            const unsigned tg = og / nx;
            if (og + 1u == (tg + 1u) * nx) xb_add(&bar[XB_TOPGEN], 1u);
            else XB_SPIN(xb_ld(&bar[XB_TOPGEN]) == tg, bar);
            __builtin_amdgcn_fence(__ATOMIC_ACQUIRE, "agent");
            xb_add(&bar[XB_XGEN(b.x)], 1u);
            asm volatile("s_waitcnt vmcnt(0)" ::: "memory");
        } else {
            XB_SPIN(xb_ld(&bar[XB_XGEN(b.x)]) == gen, bar);
            __builtin_amdgcn_fence(__ATOMIC_ACQUIRE, "agent");
            asm volatile("s_waitcnt vmcnt(0)" ::: "memory");
        }
    }
    __syncthreads();
}

__device__ __forceinline__ void xcd_barrier_local(const XcdBarrier& b) {
    asm volatile("s_waitcnt vmcnt(0)" ::: "memory");
    __syncthreads();
    if (b.wave == 0 && hw_lane() == 0) {
        unsigned* bar = b.bar;
        __builtin_amdgcn_s_waitcnt(0);
        const unsigned nloc = b.st[0] ? b.st[0] : 1u;
        const unsigned old = xb_add(&bar[XB_XSUB(b.x)], 1u);
        const unsigned gen = old / nloc;
        if (old + 1u == (gen + 1u) * nloc) xb_add(&bar[XB_XGEN(b.x)], 1u);
        else XB_SPIN(xb_ld(&bar[XB_XGEN(b.x)]) == gen, bar);
        __builtin_amdgcn_fence(__ATOMIC_ACQUIRE, "agent");
        asm volatile("s_waitcnt vmcnt(0)" ::: "memory");
    }
    __syncthreads();
}

typedef const float* fptr_t;
typedef __attribute__((address_space(4))) const fptr_t* in_tab_t;
struct Frame {
    LAS unsigned char* lds;
    int tid, lane, wave, G, bx, vid, xq, rk, rw;
    in_tab_t in;
    float* out;
    unsigned char* ws;
};
__device__ __forceinline__ unsigned long long uni64(unsigned long long v) { const unsigned lo = __builtin_amdgcn_readfirstlane((unsigned)v), hi = __builtin_amdgcn_readfirstlane((unsigned)(v >> 32)); return ((unsigned long long)hi << 32) | lo; }
__device__ __forceinline__ Frame launder(const Frame& F0) {
    Frame F = F0;
    int wv_ = __builtin_amdgcn_readfirstlane(F0.wave);
    int ln_ = hw_lane();
    int g_ = __builtin_amdgcn_readfirstlane(F0.G), b_ = __builtin_amdgcn_readfirstlane(F0.bx), v_ = __builtin_amdgcn_readfirstlane(F0.vid);
    unsigned long long w_ = uni64((unsigned long long)F0.ws), o_ = uni64((unsigned long long)F0.out), i_ = uni64((unsigned long long)F0.in);
    asm volatile("" : "+v"(ln_), "+s"(wv_), "+s"(g_), "+s"(b_), "+s"(v_), "+s"(w_), "+s"(o_), "+s"(i_));
    F.tid = (wv_ << 6) | ln_; F.G = g_; F.bx = b_; F.vid = v_; F.xq = b_ & 7; F.rk = b_ >> 3; F.rw = (g_ - (b_ & 7) + 7) >> 3; F.ws = (unsigned char*)(GAS unsigned char*)w_; F.out = (float*)(GAS float*)o_; F.in = (in_tab_t)i_;
    F.lane = ln_; F.wave = wv_;
    return F;
}
#define FIN(k) ((const float*)(const GAS float*)(F.in[k]))


__device__ __forceinline__ float shx(float v, int mask, int lane) { return __builtin_bit_cast(float, __builtin_amdgcn_ds_bpermute((lane ^ mask) << 2, __builtin_bit_cast(int, v))); }
__device__ __forceinline__ float wave_sum(float v, int lane) {
#pragma unroll
    for (int o = 1; o < 64; o <<= 1) v += shx(v, o, lane);
    return v;
}
__device__ __forceinline__ float silu_f(float x) { return x * __builtin_amdgcn_rcpf(1.f + __builtin_amdgcn_exp2f(-1.4426950408889634f * x)); }
__device__ __forceinline__ f32x4 silu4(f32x4 v) { return (f32x4){silu_f(v[0]), silu_f(v[1]), silu_f(v[2]), silu_f(v[3])}; }
__device__ __forceinline__ float dot4(f32x4 a, f32x4 b) { return (a[0] * b[0] + a[1] * b[1]) + (a[2] * b[2] + a[3] * b[3]); }
__device__ __forceinline__ u32x4 pack8(f32x4 a, f32x4 b) { u32x4 w; w.x = cvt_pk_bf16(a[0], a[1]); w.y = cvt_pk_bf16(a[2], a[3]); w.z = cvt_pk_bf16(b[0], b[1]); w.w = cvt_pk_bf16(b[2], b[3]); return w; }
__device__ __forceinline__ u32x2 pack4(f32x4 a) { u32x2 w; w.x = cvt_pk_bf16(a[0], a[1]); w.y = cvt_pk_bf16(a[2], a[3]); return w; }
__device__ __forceinline__ float bflo(unsigned w) { return __uint_as_float(w << 16); }
__device__ __forceinline__ float bfhi(unsigned w) { return __uint_as_float(w & 0xffff0000u); }
__device__ __forceinline__ void unpack8(u32x4 w, f32x4& a, f32x4& b) { a = (f32x4){bflo(w.x), bfhi(w.x), bflo(w.y), bfhi(w.y)}; b = (f32x4){bflo(w.z), bfhi(w.z), bflo(w.w), bfhi(w.w)}; }
__device__ __forceinline__ f32x4 unpack4(u32x2 w) { return (f32x4){bflo(w.x), bfhi(w.x), bflo(w.y), bfhi(w.y)}; }
__device__ __forceinline__ float rstd16(const float* p) {
    const f32x4 a = ((const f32x4*)p)[0], b = ((const f32x4*)p)[1], c = ((const f32x4*)p)[2], d = ((const f32x4*)p)[3];
    const f32x4 s = (a + b) + (c + d);
    return rsqrtf(((s[0] + s[1]) + (s[2] + s[3])) * (1.0f / D) + EPS);
}
__device__ __forceinline__ float rstd32(const float* p) {
    f32x4 s = ((const f32x4*)p)[0];
#pragma unroll
    for (int i = 1; i < 8; ++i) s += ((const f32x4*)p)[i];
    return rsqrtf(((s[0] + s[1]) + (s[2] + s[3])) * (1.0f / D) + EPS);
}
__host__ __device__ __forceinline__ int src_even(int n) {
    const int tile = n >> 8, o = n & 255;
    if (tile < 8) return n;
    if (tile < 12) return 3072 + (n - 2048);
    const int cb = tile - 12;
    return o < 128 ? 2048 + 128 * cb + o : 4096 + 128 * cb + (o - 128);
}
__host__ __device__ __forceinline__ int src_odd(int n) {
    const int pn = n >> 8, p = n & 255, q = ((p >> 7) << 1) | ((p >> 2) & 1), ch = 64 * pn + 16 * ((p >> 5) & 3) + 4 * ((p >> 3) & 3) + (p & 3);
    const int base = q == 0 ? 2048 : (q == 1 ? 4096 : (q == 2 ? 0 : 6144));
    return base + ch;
}

__device__ __forceinline__ void rstd_table(const float* rsq, int pm, LAS float* tab, int tid) {
    if (tid < 256) tab[tid] = rstd16(rsq + ((size_t)pm * 256 + tid) * 16);
    LDS_BARRIER();
}
struct EpiG1Even {
    static constexpr bool PERM = true, AFTER_DRAIN = false, REP_EPI = (REP_MASK >> 12) & 1;
    const float* rsq; bf16_t* Z; float* vsq; float* pool_out; LAS const float* rtab; int pm0;
    __device__ __forceinline__ void operator()(const f32x4 (&acc)[2][2][4][2], const Unit& u, int wr, int wc, int fr_, int fq_) const {
        int fr = fr_, fq = fq_; asm volatile("" : "+v"(fr), "+v"(fq));
        const int tile = u.pn, cw = wc * 32 + 8 * fq;
#pragma unroll
        for (int ai = 0; ai < 2; ++ai)
#pragma unroll
            for (int m = 0; m < 4; ++m) {
                const int row = u.pm * 256 + ai * 128 + wr * 64 + m * 16 + fr;
                const float rs = u.pm == pm0 ? rtab[ai * 128 + wr * 64 + m * 16 + fr] : rstd16(rsq + (size_t)row * 16);
                if (tile < 12) {
                    const int kind = tile >> 2;
                    bf16_t* dst = Z + (size_t)kind * MP * D + (size_t)row * D + (tile & 3) * 256 + cw;
                    float ss = 0.f;
#pragma unroll
                    for (int bj = 0; bj < 2; ++bj) {
                        f32x4 v0 = acc[ai][bj][m][0] * rs, v1 = acc[ai][bj][m][1] * rs;
                        if (kind == 1) { v0 = silu4(v0); v1 = silu4(v1); }
                        if (kind == 2) ss += dot4(v0, v0) + dot4(v1, v1);
                        *(u32x4*)(dst + bj * 128) = pack8(v0, v1);
                        if (kind == 0 && (row & 2047) >= 2033) {
                            float* po = pool_out + ((size_t)(row >> 11) * 15 + ((row & 2047) - 2033)) * 1024 + (tile & 3) * 256 + bj * 128 + cw;
                            *(f32x4*)po = v0; *(f32x4*)(po + 4) = v1;
                        }
                    }
                    if (kind == 2) { ss += shx(ss, 16, 16 * fq + fr); ss += shx(ss, 32, 16 * fq + fr); if (fq == 0) vsq[(size_t)row * 16 + (tile - 8) * 4 + wc] = ss; }
                } else {
                    const int cb = tile - 12;
                    bf16_t* dst = Z + (size_t)3 * MP * D + (size_t)row * D + cb * 128 + cw;
                    const f32x4 u0 = acc[ai][0][m][0] * rs, u1 = acc[ai][0][m][1] * rs, g0 = acc[ai][1][m][0] * rs, g1 = acc[ai][1][m][1] * rs;
                    *(u32x4*)dst = pack8(u0 * silu4(g0), u1 * silu4(g1));
                }
            }
    }
};
__device__ __forceinline__ float dpp_shr1(float old, float v) { return __builtin_bit_cast(float, __builtin_amdgcn_update_dpp(__builtin_bit_cast(int, old), __builtin_bit_cast(int, v), 0x111, 0xf, 0xf, false)); }
__device__ __forceinline__ float dpp_shr2(float old, float v) { return __builtin_bit_cast(float, __builtin_amdgcn_update_dpp(__builtin_bit_cast(int, old), __builtin_bit_cast(int, v), 0x112, 0xf, 0xf, false)); }
struct EpiG1Odd {
    static constexpr bool PERM = true, AFTER_DRAIN = false, REP_EPI = false;
    const float* rsq; bf16_t* A2; const float* cw; float* conv_out; float* side; LAS float* halo; LAS const float* rtab; int pm0; LAS const float* cwl; int pn0;
    __device__ __forceinline__ void operator()(const f32x4 (&acc)[2][2][4][2], const Unit& u, int wr, int wc, int fr_, int fq_) const {
        int fr = fr_, fq = fq_; asm volatile("" : "+v"(fr), "+v"(fq));
        const int chl = wc * 16 + 4 * fq, ch = u.pn * 64 + chl;
        f32x4 w0, w1, w2;
        { const int ui = (u.pn - pn0) >> 2;
          if (u.pm == pm0 && ui >= 0 && ui < 8 && ((u.pn - pn0) & 3) == 0) { w0 = *(const LAS f32x4*)(cwl + (ui * 3 + 0) * 64 + chl); w1 = *(const LAS f32x4*)(cwl + (ui * 3 + 1) * 64 + chl); w2 = *(const LAS f32x4*)(cwl + (ui * 3 + 2) * 64 + chl); }
          else { w0 = *(const f32x4*)(cw + ch); w1 = *(const f32x4*)(cw + 2048 + ch); w2 = *(const f32x4*)(cw + 4096 + ch); } }
        f32x4 e[2][4]; float rsv[2][4];
#pragma unroll
        for (int ai = 0; ai < 2; ++ai)
#pragma unroll
            for (int m = 0; m < 4; ++m) {
                const int rb = 8 * ai + 4 * wr + m, row = u.pm * 256 + 16 * rb + fr;
                const float rs = u.pm == pm0 ? rtab[16 * rb + fr] : rstd16(rsq + (size_t)row * 16); rsv[ai][m] = rs;
                e[ai][m] = (acc[ai][0][m][0] * rs) * (acc[ai][0][m][1] * rs);
                if (fr >= 14) *(LAS f32x4*)(halo + (rb * 2 + (fr - 14)) * 64 + chl) = e[ai][m];
                if (m & 1) asm volatile("" ::: "memory");
            }
        asm volatile("s_waitcnt lgkmcnt(0)" ::: "memory"); __builtin_amdgcn_s_barrier(); asm volatile("" ::: "memory");
        float* sd = side + (size_t)u.pm * 6 * 2048 + ch;
#pragma unroll
        for (int ai = 0; ai < 2; ++ai)
#pragma unroll
            for (int m = 0; m < 4; ++m) {
                const int rb = 8 * ai + 4 * wr + m, row = u.pm * 256 + 16 * rb + fr;
                const float rs = rsv[ai][m];
                const f32x4 sg = (acc[ai][1][m][0] * rs) * silu4(acc[ai][1][m][1] * rs);
                f32x4 h0 = (f32x4){0.f, 0.f, 0.f, 0.f}, h1 = h0;
                if (rb > 0) { h0 = *(const LAS f32x4*)(halo + ((rb - 1) * 2 + 0) * 64 + chl); h1 = *(const LAS f32x4*)(halo + ((rb - 1) * 2 + 1) * 64 + chl); }
                const f32x4 hx = fr == 0 ? h0 : h1, ev = e[ai][m];
                f32x4 e1, e2;
#pragma unroll
                for (int k = 0; k < 4; ++k) { e1[k] = dpp_shr1(h1[k], ev[k]); e2[k] = dpp_shr2(hx[k], ev[k]); }
                const f32x4 a = sg * (w0 * e2 + w1 * e1 + w2 * ev);
                const bool top = (rb == 0 && fr < 2);
                if (!(top && (u.pm & 7) != 0)) *(u32x2*)(A2 + (size_t)row * 2048 + ch) = pack4(a);
                if (top) { *(f32x4*)(sd + fr * 2048) = ev; *(f32x4*)(sd + (4 + fr) * 2048) = sg; }
                if (rb == 15 && fr >= 14) {
                    *(f32x4*)(sd + (2 + fr - 14) * 2048) = ev;
                    if ((u.pm & 7) == 7) *(f32x4*)(conv_out + ((size_t)(u.pm >> 3) * 2 + (fr - 14)) * 2048 + ch) = ev;
                }
            }
    }
};
__device__ __forceinline__ void conv_fixup(const float* side, const float* cw, bf16_t* A2, int pm, int tid) {
    if ((pm & 7) == 0) return;
    const int ch = 4 * tid;
    const float* sp = side + (size_t)(pm - 1) * 6 * 2048 + ch; const float* sc = side + (size_t)pm * 6 * 2048 + ch;
    const f32x4 em2 = *(const f32x4*)(sp + 2 * 2048), em1 = *(const f32x4*)(sp + 3 * 2048), e0 = *(const f32x4*)sc, e1 = *(const f32x4*)(sc + 2048), s0 = *(const f32x4*)(sc + 4 * 2048), s1 = *(const f32x4*)(sc + 5 * 2048);
    const f32x4 w0 = *(const f32x4*)(cw + ch), w1 = *(const f32x4*)(cw + 2048 + ch), w2 = *(const f32x4*)(cw + 4096 + ch);
    *(u32x2*)(A2 + (size_t)(pm * 256) * 2048 + ch) = pack4(s0 * (w0 * em2 + w1 * em1 + w2 * e0));
    *(u32x2*)(A2 + (size_t)(pm * 256 + 1) * 2048 + ch) = pack4(s1 * (w0 * em1 + w1 * e0 + w2 * e1));
}
struct EpiRes {
    static constexpr bool PERM = true, AFTER_DRAIN = false, REP_EPI = false;
    bf16_t* xb; float* rsq;
    __device__ __forceinline__ void operator()(const f32x4 (&acc)[2][2][4][2], const Unit& u, int wr, int wc, int fr_, int fq_) const {
        int fr = fr_, fq = fq_; asm volatile("" : "+v"(fr), "+v"(fq));
        const int cw = wc * 32 + 8 * fq;
#pragma unroll
        for (int ai = 0; ai < 2; ++ai) {
            u32x4 old[4][2];
#pragma unroll
            for (int m = 0; m < 4; ++m)
#pragma unroll
                for (int bj = 0; bj < 2; ++bj) old[m][bj] = *(const u32x4*)(xb + (size_t)(u.pm * 256 + ai * 128 + wr * 64 + m * 16 + fr) * D + u.pn * 256 + bj * 128 + cw);
#pragma unroll
            for (int m = 0; m < 4; ++m) {
                const int row = u.pm * 256 + ai * 128 + wr * 64 + m * 16 + fr;
                float ss = 0.f;
#pragma unroll
                for (int bj = 0; bj < 2; ++bj) {
                    f32x4 b0, b1; unpack8(old[m][bj], b0, b1);
                    const u32x4 wv = pack8(b0 + acc[ai][bj][m][0], b1 + acc[ai][bj][m][1]);
                    *(u32x4*)(xb + (size_t)row * D + u.pn * 256 + bj * 128 + cw) = wv;
                    f32x4 r0, r1; unpack8(wv, r0, r1);
                    ss += dot4(r0, r0) + dot4(r1, r1);
                }
                ss += shx(ss, 16, 16 * fq + fr); ss += shx(ss, 32, 16 * fq + fr);
                if (fq == 0) rsq[(size_t)row * 16 + u.pn * 4 + wc] = ss;
            }
        }
    }
};
struct EpiProbe {
    static constexpr bool PERM = true, AFTER_DRAIN = false, REP_EPI = false;
    bf16_t* O; int ldc;
    __device__ __forceinline__ void operator()(const f32x4 (&acc)[2][2][4][2], const Unit& u, int wr, int wc, int fr_, int fq_) const {
        int fr = fr_, fq = fq_; asm volatile("" : "+v"(fr), "+v"(fq));
        const int cw = wc * 32 + 8 * fq;
#pragma unroll
        for (int ai = 0; ai < 2; ++ai)
#pragma unroll
            for (int m = 0; m < 4; ++m) {
                const int row = u.pm * 256 + ai * 128 + wr * 64 + m * 16 + fr;
#pragma unroll
                for (int bj = 0; bj < 2; ++bj) *(u32x4*)(O + (size_t)row * ldc + u.pn * 256 + bj * 128 + cw) = pack8(acc[ai][bj][m][0], acc[ai][bj][m][1]);
            }
    }
};
struct EpiQ {
    static constexpr bool PERM = true, AFTER_DRAIN = false, REP_EPI = false;
    const float* rsq; bf16_t* Q; LAS const float* rtab; int pm0;
    __device__ __forceinline__ void operator()(const f32x4 (&acc)[2][2][4][2], const Unit& u, int wr, int wc, int fr_, int fq_) const {
        int fr = fr_, fq = fq_; asm volatile("" : "+v"(fr), "+v"(fq));
        const int cw = wc * 32 + 8 * fq;
#pragma unroll
        for (int ai = 0; ai < 2; ++ai)
#pragma unroll
            for (int m = 0; m < 4; ++m) {
                const int row = u.pm * 256 + ai * 128 + wr * 64 + m * 16 + fr;
                const float rs = u.pm == pm0 ? rtab[ai * 128 + wr * 64 + m * 16 + fr] : rstd16(rsq + (size_t)row * 16);
#pragma unroll
                for (int bj = 0; bj < 2; ++bj) *(u32x4*)(Q + (size_t)row * D + u.pn * 256 + bj * 128 + cw) = pack8(acc[ai][bj][m][0] * rs, acc[ai][bj][m][1] * rs);
            }
    }
};
struct EpiMemKV {
    static constexpr bool PERM = true, AFTER_DRAIN = false, REP_EPI = false;
    const float* rstdm; float* outk; float* outv; bf16_t* kb; bf16_t* vb;
    __device__ __forceinline__ void operator()(const f32x4 (&acc)[2][2][4][2], const Unit& u, int wr, int wc, int fr_, int fq_) const {
        int fr = fr_, fq = fq_; asm volatile("" : "+v"(fr), "+v"(fq));
        const int layer = u.pn >> 3, isv = (u.pn >> 2) & 1, cw = (u.pn & 3) * 256 + wc * 32 + 8 * fq;
        float* of = (isv ? outv : outk) + (size_t)layer * MMEM * D; bf16_t* ob = (isv ? vb : kb) + (size_t)layer * MMEM * D;
#pragma unroll
        for (int ai = 0; ai < 2; ++ai)
#pragma unroll
            for (int m = 0; m < 4; ++m) {
                const int row = u.pm * 256 + ai * 128 + wr * 64 + m * 16 + fr;
                const float rs = rstdm[row];
#pragma unroll
                for (int bj = 0; bj < 2; ++bj) {
                    const size_t off = (size_t)row * D + bj * 128 + cw;
                    const f32x4 v0 = acc[ai][bj][m][0] * rs, v1 = acc[ai][bj][m][1] * rs;
                    *(f32x4*)(of + off) = v0; *(f32x4*)(of + off + 4) = v1;
                    *(u32x4*)(ob + off) = pack8(v0, v1);
                }
            }
    }
};

struct TrItem { const float* wp; int ldw; const float* gk; float sc; bf16_t* wt; int K; };
__device__ __forceinline__ void p0_tr_desc(const float* W, int ldw, int K, int Nd, const float* gk, float sc, bf16_t* WT, int perm, int r, int lane, TrItem& t) {
    const int nblk = Nd / 32, kb = r / nblk, nb = r % nblk, dstn0 = 32 * nb, dn = dstn0 + (lane & 31);
    const int srccol = perm == 0 ? dn : (perm == 1 ? src_even(dn) : src_odd(dn));
    t.wp = W + (size_t)(64 * kb + (lane >> 5)) * ldw + srccol; t.ldw = ldw; t.gk = gk ? gk + 64 * kb : nullptr; t.sc = sc; t.wt = WT + (size_t)dstn0 * K + 64 * kb; t.K = K;
}
__device__ __forceinline__ void p0_resolve(Frame& F, int it, int lane, TrItem& t) {
    constexpr int I_AB1 = 16 * (NAB / 32), I_C1 = 16 * (NC / 32), I_2 = 32 * 32, I_SQ = 16 * 32, I_PM = 4 * 8;
    int r = it;
    if (r < 2 * I_AB1) { const int jj = r / I_AB1; p0_tr_desc(FIN(10) + (size_t)jj * D * NAB, NAB, D, NAB, FIN(7) + 2 * jj * D, 1.f, ((bf16_t*)(F.ws + WS_AB1)) + (size_t)jj * NAB * D, 1, r % I_AB1, lane, t); return; } r -= 2 * I_AB1;
    if (r < 2 * I_C1) { const int jj = r / I_C1; p0_tr_desc(FIN(17) + (size_t)jj * D * NC, NC, D, NC, FIN(7) + (2 * jj + 1) * D, 1.f, ((bf16_t*)(F.ws + WS_C1)) + (size_t)jj * NC * D, 2, r % I_C1, lane, t); return; } r -= 2 * I_C1;
    if (r < 2 * I_2) { const int jj = r / I_2; p0_tr_desc(FIN(16) + (size_t)jj * 2048 * D, D, 2048, D, nullptr, 1.f, ((bf16_t*)(F.ws + WS_AB2)) + (size_t)jj * D * 2048, 0, r % I_2, lane, t); return; } r -= 2 * I_2;
    if (r < 2 * I_2) { const int jj = r / I_2; p0_tr_desc(FIN(19) + (size_t)jj * 2048 * D, D, 2048, D, nullptr, 1.f, ((bf16_t*)(F.ws + WS_C2)) + (size_t)jj * D * 2048, 0, r % I_2, lane, t); return; } r -= 2 * I_2;
    if (r < 4 * I_SQ) { const int l = r / I_SQ; p0_tr_desc(FIN(20) + (size_t)l * D * D, D, D, D, FIN(8) + l * D, QSCALE, ((bf16_t*)(F.ws + WS_WQ)) + (size_t)l * D * D, 0, r % I_SQ, lane, t); return; } r -= 4 * I_SQ;
    if (r < 4 * I_SQ) { const int l = r / I_SQ; p0_tr_desc(FIN(21) + (size_t)l * D * D, D, D, D, FIN(9) + l * D, 1.f, ((bf16_t*)(F.ws + WS_WKV)) + (size_t)(2 * l) * D * D, 0, r % I_SQ, lane, t); return; } r -= 4 * I_SQ;
    if (r < 4 * I_SQ) { const int l = r / I_SQ; p0_tr_desc(FIN(22) + (size_t)l * D * D, D, D, D, FIN(9) + l * D, 1.f, ((bf16_t*)(F.ws + WS_WKV)) + (size_t)(2 * l + 1) * D * D, 0, r % I_SQ, lane, t); return; } r -= 4 * I_SQ;
    if (r < 4 * I_SQ) { const int l = r / I_SQ; p0_tr_desc(FIN(23) + (size_t)l * D * D, D, D, D, nullptr, 1.f, ((bf16_t*)(F.ws + WS_WO)) + (size_t)l * D * D, 0, r % I_SQ, lane, t); return; } r -= 4 * I_SQ;
    { const int jg = r / I_PM; p0_tr_desc(FIN(11) + (size_t)jg * 65536, 256, 256, 256, nullptr, 1.f, ((bf16_t*)(F.ws + WS_PMT)) + (size_t)jg * 65536, 0, r % I_PM, lane, t); }
}
__device__ __forceinline__ void p0_tr_load(const TrItem& t, int lane, float (&v)[32], f32x4& g0, f32x4& g1) {
    const int c = lane & 7;
    g0 = (f32x4){t.sc, t.sc, t.sc, t.sc}; g1 = g0;
    if (t.gk) { g0 = *(const f32x4*)(t.gk + 8 * c) * t.sc; g1 = *(const f32x4*)(t.gk + 8 * c + 4) * t.sc; }
#pragma unroll
    for (int i = 0; i < 32; ++i) v[i] = t.wp[(size_t)(2 * i) * t.ldw];
}
__device__ __forceinline__ void p0_tr_finish(const TrItem& t, int lane, const float (&v)[32], f32x4 g0, f32x4 g1, LAS float* scr) {
#pragma unroll
    for (int i = 0; i < 32; ++i) scr[(2 * i + (lane >> 5)) * 33 + (lane & 31)] = v[i];
    LDS_WAIT(); asm volatile("" ::: "memory");
    const int c = lane & 7;
#pragma unroll
    for (int jj = 0; jj < 4; ++jj) {
        const int n = (lane >> 3) + 8 * jj; const LAS float* s = scr + (8 * c) * 33 + n;
        u32x4 o; o.x = cvt_pk_bf16(s[0 * 33] * g0[0], s[1 * 33] * g0[1]); o.y = cvt_pk_bf16(s[2 * 33] * g0[2], s[3 * 33] * g0[3]); o.z = cvt_pk_bf16(s[4 * 33] * g1[0], s[5 * 33] * g1[1]); o.w = cvt_pk_bf16(s[6 * 33] * g1[2], s[7 * 33] * g1[3]);
        *(u32x4*)(t.wt + (size_t)n * t.K + 8 * c) = o;
    }
    LDS_WAIT(); asm volatile("" ::: "memory");
}
__device__ __forceinline__ float p0_row_finish(const f32x4 (&v)[4], bf16_t* dst, float* copy, int lane) {
    float s = 0.f;
#pragma unroll
    for (int jj = 0; jj < 4; ++jj) s += dot4(v[jj], v[jj]);
    s = wave_sum(s, lane);
    u32x2* o8 = (u32x2*)dst + lane;
#pragma unroll
    for (int jj = 0; jj < 4; ++jj) o8[64 * jj] = pack4(v[jj]);
    if (copy) {
#pragma unroll
        for (int jj = 0; jj < 4; ++jj) ((f32x4*)copy + lane)[64 * jj] = v[jj];
    }
    return s;
}
namespace p0seg {
constexpr int I_AB1 = 16 * (NAB / 32), I_C1 = 16 * (NC / 32), I_2 = 32 * 32, I_SQ = 16 * 32, I_PM = 4 * 8;
constexpr int O_AB1 = 0, O_C1 = 2 * I_AB1, O_AB2 = O_C1 + 2 * I_C1, O_C2 = O_AB2 + 2 * I_2, O_Q = O_C2 + 2 * I_2, O_K = O_Q + 4 * I_SQ, O_V = O_K + 4 * I_SQ, O_O = O_V + 4 * I_SQ, O_P = O_O + 4 * I_SQ, NITEMS = O_P + 8 * I_PM;
constexpr int NA = I_AB1 + I_2 + I_SQ + 8 * I_SQ + I_SQ + 4 * I_PM, NB = NITEMS - NA;
__device__ __forceinline__ int item_a(int i) {
    if (i < I_AB1) return O_AB1 + i; i -= I_AB1;
    if (i < I_2) return O_AB2 + i; i -= I_2;
    if (i < I_SQ) return O_Q + i; i -= I_SQ;
    if (i < 8 * I_SQ) return O_K + i; i -= 8 * I_SQ;
    if (i < I_SQ) return O_O + i; i -= I_SQ;
    return O_P + i;
}
__device__ __forceinline__ int item_b(int i) {
    if (i < I_AB1) return O_AB1 + I_AB1 + i; i -= I_AB1;
    if (i < 2 * I_C1) return O_C1 + i; i -= 2 * I_C1;
    if (i < I_2) return O_AB2 + I_2 + i; i -= I_2;
    if (i < 2 * I_2) return O_C2 + i; i -= 2 * I_2;
    if (i < 3 * I_SQ) return O_Q + I_SQ + i; i -= 3 * I_SQ;
    if (i < 3 * I_SQ) return O_O + I_SQ + i; i -= 3 * I_SQ;
    return O_P + 4 * I_PM + i;
}
}
__device__ __forceinline__ void p0_weights(Frame& F0, int part, int gw, int NGW, int half = -1) {
    Frame F = launder(F0);
    LAS float* scr = (LAS float*)(F.lds + F.wave * 16384);
    const int lane = F.lane;
    constexpr int NB_ODD = (int)((long)p0seg::NB * PB_ODD_PCT / 100);
    const int base = (part == 1 && half == 0) ? NB_ODD : 0;
    const int n = part == 0 ? p0seg::NA : (part == 1 ? (half == 1 ? NB_ODD : (half == 0 ? p0seg::NB - NB_ODD : p0seg::NB)) : p0seg::NITEMS);
#define P0_ITEM(i_) (part == 0 ? p0seg::item_a(i_) : (part == 1 ? p0seg::item_b(base + (i_)) : (i_)))
    if (gw < n) {
        TrItem cur, nxt; float va[32], vb[32]; f32x4 ga0, ga1, gb0, gb1;
        p0_resolve(F, P0_ITEM(gw), lane, cur); p0_tr_load(cur, lane, va, ga0, ga1);
        for (int it = gw; it < n; it += 2 * NGW) {
            const bool h1 = it + NGW < n, h2 = it + 2 * NGW < n;
            if (h1) { p0_resolve(F, P0_ITEM(it + NGW), lane, nxt); p0_tr_load(nxt, lane, vb, gb0, gb1); }
            p0_tr_finish(cur, lane, va, ga0, ga1, scr);
            if (h2) { p0_resolve(F, P0_ITEM(it + 2 * NGW), lane, cur); p0_tr_load(cur, lane, va, ga0, ga1); }
            if (h1) p0_tr_finish(nxt, lane, vb, gb0, gb1, scr);
        }
    }
#undef P0_ITEM
}
__device__ __forceinline__ void p0_prologue(Frame& F0) {
    Frame F = launder(F0);
    const int gw = F.bx * NWAVES + F.wave, NGW = F.G * NWAVES, lane = F.lane;
    p0_weights(F0, (!MK_SPLIT && SPLIT_PROLOGUE) ? 0 : 2, gw, NGW);
    for (int m0 = 2 * gw; m0 < MP + MS + MMEM; m0 += 2 * NGW) {
        f32x4 v[2][4];
#pragma unroll
        for (int r = 0; r < 2; ++r) {
            const int m = m0 + r;
            const float* src = m < MP ? FIN(0) + (size_t)m * D : (m < MP + MS ? FIN(1) + (size_t)(m - MP) * D : FIN(2) + (size_t)(m - MP - MS) * D);
#pragma unroll
            for (int jj = 0; jj < 4; ++jj) v[r][jj] = ((const f32x4*)src + lane)[64 * jj];
        }
#pragma unroll
        for (int r = 0; r < 2; ++r) {
            const int m = m0 + r;
            if (m < MP) {
                const float s = p0_row_finish(v[r], ((bf16_t*)(F.ws + WS_XB)) + (size_t)m * D, nullptr, lane);
                if (lane < 16) ((float*)(F.ws + WS_RSQ))[(size_t)m * 16 + lane] = lane == 0 ? s : 0.f;
            } else if (m < MP + MS) {
                const int b = m - MP;
                const float s = p0_row_finish(v[r], ((bf16_t*)(F.ws + WS_XB)) + (size_t)m * D, ((float*)(F.ws + WS_XS)) + (size_t)b * D, lane);
                if (lane < 32) ((float*)(F.ws + WS_SMALL))[b * 32 + lane] = lane == 0 ? s : 0.f;
            } else {
                const int t = m - MP - MS;
                const float s = p0_row_finish(v[r], ((bf16_t*)(F.ws + WS_MEMB)) + (size_t)t * D, nullptr, lane);
                if (lane == 0) ((float*)(F.ws + WS_SMALL + 65536))[t] = rsqrtf(s * (1.0f / D) + EPS);
            }
        }
    }
}

__device__ __forceinline__ bf16x8 tr_frag(LAS unsigned char* p0, LAS unsigned char* p1) {
    const s16x4 lo = __builtin_amdgcn_ds_read_tr16_b64_v4i16((LAS s16x4*)p0);
    const s16x4 hi = __builtin_amdgcn_ds_read_tr16_b64_v4i16((LAS s16x4*)p1);
    return (bf16x8){lo[0], lo[1], lo[2], lo[3], hi[0], hi[1], hi[2], hi[3]};
}
#define MFMA16(a, b, c) __builtin_amdgcn_mfma_f32_16x16x32_bf16((a), (b), (c), 0, 0, 0)

constexpr int SGU_AS = 0, SGU_VS = 36864, SGU_RV = 36864 + 69632;
__device__ __forceinline__ void sgu_chunk(Frame& F0, int j, int n, const int g0, const int g1) {
    Frame F = launder(F0);
    LAS unsigned char* lds = F.lds;
    const int tid = F.tid, lane = F.lane, w = F.wave, fr = lane & 15, fq = lane >> 4, row0 = n * 128;
    LAS float* rvs = (LAS float*)(lds + SGU_RV);
    if (tid < 128) rvs[tid] = rstd16(((float*)(F.ws + WS_VSQ)) + (size_t)(row0 + tid) * 16);
    const bf16_t* ZV = ((bf16_t*)(F.ws + WS_Z)) + (size_t)2 * MP * D + (size_t)row0 * D;
    const bf16_t* ZUG = ((bf16_t*)(F.ws + WS_Z)) + (size_t)3 * MP * D + (size_t)row0 * D;
    bf16_t* A2 = ((bf16_t*)(F.ws + WS_A2)) + (size_t)row0 * 2048 + 1024;
    const unsigned voff = (unsigned)(tid >> 5) * (D * 2) + (unsigned)(tid & 31) * 16u;
    const unsigned woff = (unsigned)(tid >> 4) * 512u + (unsigned)(tid & 15) * 32u;
    const int wt_t = tid >> 4, wt_s0 = (tid & 15) * 8;
    const unsigned aoff = (unsigned)(tid >> 5) * 4096u + (unsigned)(tid & 31) * 16u;
    u32x4 vt[8]; f32x4 wt[8];
#define SGU_LOAD(g_) do { const char* vb_ = (const char*)(ZV + (g_) * 256); const char* wb_ = (const char*)(FIN(13) + (size_t)(j * 4 + (g_)) * 16384); \
        _Pragma("unroll") for (int i_ = 0; i_ < 8; ++i_) vt[i_] = *(const u32x4*)(vb_ + (size_t)(16 * i_) * D * 2 + voff); \
        _Pragma("unroll") for (int i_ = 0; i_ < 4; ++i_) { wt[2 * i_] = *(const f32x4*)(wb_ + (size_t)(32 * i_) * 512 + woff); wt[2 * i_ + 1] = *(const f32x4*)(wb_ + (size_t)(32 * i_) * 512 + woff + 16); } } while (0)
    SGU_LOAD(g0);
    LDS_BARRIER();
#pragma unroll 1
    for (int g = g0; g < g1; ++g) {
#pragma unroll
        for (int i = 0; i < 8; ++i) *(LAS u32x4*)(lds + SGU_VS + ((tid >> 5) + 16 * i) * 544 + (tid & 31) * 16) = vt[i];
#pragma unroll
        for (int i = 0; i < 4; ++i) {
            const int t = wt_t + 32 * i; float v[8];
#pragma unroll
            for (int e = 0; e < 4; ++e) { v[e] = (wt_s0 + e <= t) ? wt[2 * i][e] * rvs[wt_s0 + e] : 0.f; v[4 + e] = (wt_s0 + 4 + e <= t) ? wt[2 * i + 1][e] * rvs[wt_s0 + 4 + e] : 0.f; }
            u32x4 o; o.x = cvt_pk_bf16(v[0], v[1]); o.y = cvt_pk_bf16(v[2], v[3]); o.z = cvt_pk_bf16(v[4], v[5]); o.w = cvt_pk_bf16(v[6], v[7]);
            *(LAS u32x4*)(lds + SGU_AS + t * 288 + wt_s0 * 2) = o;
        }
        LDS_BARRIER();
        if (g + 1 < g1) SGU_LOAD(g + 1);
        const int cg = g * 256 + 32 * w + 4 * fq;
        const unsigned lo_in = (unsigned)fr * (D * 2) + (unsigned)(32 * w + 4 * fq) * 2u, lo_out = (unsigned)fr * 4096u + (unsigned)(32 * w + 4 * fq) * 2u;
        u32x2 ugr[2][8];
#pragma unroll
        for (int nt = 0; nt < 2; ++nt)
#pragma unroll
            for (int mt = 0; mt < 8; ++mt) ugr[nt][mt] = *(const u32x2*)((const char*)(ZUG + (size_t)(16 * mt) * D + g * 256 + 16 * nt) + lo_in);
        f32x4 ggv[2]; float bbv[8];
#pragma unroll
        for (int nt = 0; nt < 2; ++nt) ggv[nt] = *(const f32x4*)(FIN(15) + j * 1024 + cg + 16 * nt);
#pragma unroll
        for (int mt = 0; mt < 8; ++mt) bbv[mt] = FIN(14)[(j * 4 + g) * 128 + 16 * mt + fr];
        f32x4 acc[8][2];
#pragma unroll
        for (int mt = 0; mt < 8; ++mt) { acc[mt][0] = (f32x4){0.f, 0.f, 0.f, 0.f}; acc[mt][1] = (f32x4){0.f, 0.f, 0.f, 0.f}; }
#pragma unroll
        for (int ks = 0; ks < 4; ++ks) {
            bf16x8 Bf[2];
#pragma unroll
            for (int nt = 0; nt < 2; ++nt) {
                LAS unsigned char* p = lds + SGU_VS + (32 * ks + 8 * fq + (fr >> 2)) * 544 + (32 * w + 16 * nt + 4 * (fr & 3)) * 2;
                Bf[nt] = tr_frag(p, p + 4 * 544);
            }
            bf16x8 Af[8];
#pragma unroll
            for (int mt = 0; mt < 8; ++mt) if (32 * ks <= 16 * mt + 15) Af[mt] = *(LAS bf16x8*)(lds + SGU_AS + (16 * mt + fr) * 288 + (32 * ks + 8 * fq) * 2);
#pragma unroll
            for (int mt = 0; mt < 8; ++mt) if (32 * ks <= 16 * mt + 15) { acc[mt][0] = MFMA16(Bf[0], Af[mt], acc[mt][0]); acc[mt][1] = MFMA16(Bf[1], Af[mt], acc[mt][1]); }
        }
#pragma unroll
        for (int nt = 0; nt < 2; ++nt) {
            const int c = cg + 16 * nt;
            const f32x4 gg = ggv[nt];
#pragma unroll
            for (int mt = 0; mt < 8; ++mt) {
                const int t = 16 * mt + fr;
                const float bb = bbv[mt];
                *(u32x2*)((char*)(A2 + (size_t)(16 * mt) * 2048 + g * 256 + 16 * nt) + lo_out) = pack4(unpack4(ugr[nt][mt]) * (acc[mt][nt] * gg + bb));
            }
        }
        LDS_BARRIER();
    }
#undef SGU_LOAD
}
template <int WIN> __device__ __forceinline__ void pool_load(const bf16_t* xau  , unsigned lo  , int pos0, u32x4 (&xr)[WIN + 7]) {
#pragma unroll
    for (int i = 0; i < WIN + 7; ++i) { const int rr = i - (WIN - 1); xr[i] = (u32x4){0u, 0u, 0u, 0u}; if (pos0 + rr >= 0) xr[i] = *(const u32x4*)((const char*)(xau + (ptrdiff_t)rr * D) + lo); }
}
template <int WIN> __device__ __forceinline__ void pool_build(const u32x4 (&xr)[WIN + 7], int pos0, LAS unsigned char* dst  ) {
    f32x4 S0 = (f32x4){0.f, 0.f, 0.f, 0.f}, S1 = S0;
#pragma unroll
    for (int i = 0; i < WIN - 1; ++i) { f32x4 a, b; unpack8(xr[i], a, b); S0 += a; S1 += b; }
#pragma unroll
    for (int r = 0; r < 8; ++r) {
        f32x4 a, b; unpack8(xr[WIN - 1 + r], a, b); S0 += a; S1 += b;
        const int cnt = (pos0 + r + 1) < WIN ? (pos0 + r + 1) : WIN; const float ic = 1.0f / (float)cnt;
        *(LAS u32x4*)(dst + r * 544) = pack8(S0 * ic - a, S1 * ic - b);
        f32x4 c, d; unpack8(xr[r], c, d); S0 -= c; S1 -= d;
    }
}
__device__ __forceinline__ void pool_mma_epi(Frame& F, int j, int g, int row0, const bf16_t* ZSGA, bf16_t* A2, LAS unsigned char* lds, int w, int fr, int fq) {
    const int cg = g * 256 + 32 * w + 4 * fq;
    const unsigned lo_in = (unsigned)fr * (D * 2) + (unsigned)(32 * w + 4 * fq) * 2u, lo_out = (unsigned)fr * 4096u + (unsigned)(32 * w + 4 * fq) * 2u, lo_pm = (unsigned)(32 * w + fr) * 512u + (unsigned)fq * 16u;
    u32x2 sgr[2][8];
#pragma unroll
    for (int nt = 0; nt < 2; ++nt)
#pragma unroll
        for (int mt = 0; mt < 8; ++mt) sgr[nt][mt] = *(const u32x2*)((const char*)(ZSGA + (size_t)(16 * mt) * D + g * 256 + 16 * nt) + lo_in);
    f32x4 acc[8][2];
#pragma unroll
    for (int mt = 0; mt < 8; ++mt) { acc[mt][0] = (f32x4){0.f, 0.f, 0.f, 0.f}; acc[mt][1] = (f32x4){0.f, 0.f, 0.f, 0.f}; }
    const bf16_t* pm = ((bf16_t*)(F.ws + WS_PMT)) + (size_t)(j * 4 + g) * 65536;
    bf16x8 Bq[8][2]; f32x4 psv[2];
#pragma unroll
    for (int ks = 0; ks < 8; ++ks) { Bq[ks][0] = *(const bf16x8*)((const char*)(pm + 32 * ks) + lo_pm); Bq[ks][1] = *(const bf16x8*)((const char*)(pm + 16 * 256 + 32 * ks) + lo_pm); }
#pragma unroll
    for (int nt = 0; nt < 2; ++nt) psv[nt] = *(const f32x4*)(FIN(12) + j * 1024 + cg + 16 * nt);
    {
        bf16x8 Af[2][4];
#define POOL_AREAD(n_, buf_) do { _Pragma("unroll") for (int m4_ = 0; m4_ < 4; ++m4_) Af[buf_][m4_] = *(LAS bf16x8*)(lds + (16 * (4 * ((n_) & 1) + m4_) + fr) * 544 + (32 * ((n_) >> 1) + 8 * fq) * 2); } while (0)
        POOL_AREAD(0, 0);
        __builtin_amdgcn_sched_group_barrier(0x100, 4, 0);
#pragma unroll
        for (int n = 0; n < 16; ++n) {
            if (n < 15) POOL_AREAD(n + 1, (n + 1) & 1);
#pragma unroll
            for (int m4 = 0; m4 < 4; ++m4) { const int mt = 4 * (n & 1) + m4, ks = n >> 1; acc[mt][0] = MFMA16(Bq[ks][0], Af[n & 1][m4], acc[mt][0]); acc[mt][1] = MFMA16(Bq[ks][1], Af[n & 1][m4], acc[mt][1]); }
            if (n < 15) __builtin_amdgcn_sched_group_barrier(0x100, 4, 0);
            __builtin_amdgcn_sched_group_barrier(0x008, 8, 0);
        }
#undef POOL_AREAD
    }
#pragma unroll
    for (int nt = 0; nt < 2; ++nt) {
        const int c = cg + 16 * nt;
        const f32x4 ps = psv[nt];
#pragma unroll
        for (int mt = 0; mt < 8; ++mt) *(u32x2*)((char*)(A2 + (size_t)(16 * mt) * 2048 + g * 256 + 16 * nt) + lo_out) = pack4(acc[mt][nt] * ps * unpack4(sgr[nt][mt]));
    }
}
template <int GA, int GB> __device__ __forceinline__ void pool_pair(Frame& F0, int j, int n) {
    Frame F = launder(F0);
    LAS unsigned char* lds = F.lds;
    const int tid = F.tid, lane = F.lane, w = F.wave, fr = lane & 15, fq = lane >> 4, row0 = n * 128;
    const int cb = tid & 31, t0 = (tid >> 5) * 8, pos0 = (row0 & 2047) + t0;
    const bf16_t* xa = ((bf16_t*)(F.ws + WS_Z)) + (size_t)row0 * D; const unsigned xlo = (unsigned)(t0 * D + cb * 8) * 2u;
    const bf16_t* ZSGA = ((bf16_t*)(F.ws + WS_Z)) + (size_t)1 * MP * D + (size_t)row0 * D;
    bf16_t* A2 = ((bf16_t*)(F.ws + WS_A2)) + (size_t)row0 * 2048;
    LAS unsigned char* dst = lds + t0 * 544 + cb * 16;
    constexpr int WA = 2 << GA, WB = 2 << GB;
    u32x4 xa_r[WA + 7]; pool_load<WA>(xa + GA * 256, xlo, pos0, xa_r);
    pool_build<WA>(xa_r, pos0, dst); LDS_BARRIER();
    pool_mma_epi(F, j, GA, row0, ZSGA, A2, lds, w, fr, fq); LDS_BARRIER();
    u32x4 xb_r[WB + 7]; pool_load<WB>(xa + GB * 256, xlo, pos0, xb_r);
    pool_build<WB>(xb_r, pos0, dst); LDS_BARRIER();
    pool_mma_epi(F, j, GB, row0, ZSGA, A2, lds, w, fr, fq); LDS_BARRIER();
}
constexpr int ATT_SLOT = 64 * 544;
__device__ __forceinline__ void attn_prompt(Frame& F0, int layer) {
    Frame F = launder(F0);
    LAS unsigned char* lds = F.lds;
    const int tid = F.tid, lane = F.lane, w = F.wave, fr = lane & 15, fq = lane >> 4;
    const bf16_t* Kl = ((bf16_t*)(F.ws + WS_KB)) + (size_t)layer * MMEM * D; const bf16_t* Vl = ((bf16_t*)(F.ws + WS_VB)) + (size_t)layer * MMEM * D;
    for (int kk = F.rk; kk < 64; kk += F.rw) {
        const int b = F.xq, h = kk >> 4, qb = kk & 15;
        const size_t rowq = (size_t)b * SEQ + qb * 128 + 16 * w + fr;
        bf16x8 Qf[8];
#pragma unroll
        for (int ks = 0; ks < 8; ++ks) Qf[ks] = *(const bf16x8*)(((bf16_t*)(F.ws + WS_Q)) + rowq * D + h * 256 + 32 * ks + 8 * fq);
        const bf16_t* kbase = Kl + (size_t)(b * 256) * D + h * 256; const bf16_t* vbase = Vl + (size_t)(b * 256) * D + h * 256;
        u32x4 st[4];
#define ATT_GLOAD(c) do { const bf16_t* src_ = ((c) < 4 ? kbase : vbase) + (size_t)(64 * ((c) & 3)) * D; _Pragma("unroll") for (int i_ = 0; i_ < 4; ++i_) { const int idx_ = tid + 512 * i_; st[i_] = *(const u32x4*)(src_ + (size_t)(idx_ >> 5) * D + (idx_ & 31) * 8); } } while (0)
#define ATT_LSTORE(slot) do { _Pragma("unroll") for (int i_ = 0; i_ < 4; ++i_) { const int idx_ = tid + 512 * i_; *(LAS u32x4*)(lds + (slot) * ATT_SLOT + (idx_ >> 5) * 544 + (idx_ & 31) * 16) = st[i_]; } } while (0)
        f32x4 S[16], Oa[16]; bf16x8 Pf[8]; float inv = 0.f;
#pragma unroll
        for (int i = 0; i < 16; ++i) { S[i] = (f32x4){0.f, 0.f, 0.f, 0.f}; Oa[i] = (f32x4){0.f, 0.f, 0.f, 0.f}; }
        ATT_GLOAD(0); ATT_LSTORE(0); __syncthreads();
#pragma unroll
        for (int c = 0; c < 8; ++c) {
            if (c < 7) ATT_GLOAD(c + 1);
            LAS unsigned char* slot = lds + (c & 1) * ATT_SLOT;
            if (c < 4) {
#pragma unroll
                for (int ml = 0; ml < 4; ++ml)
#pragma unroll
                    for (int ks = 0; ks < 8; ++ks) {
                        const bf16x8 Kf = *(LAS bf16x8*)(slot + (16 * ml + fr) * 544 + (32 * ks + 8 * fq) * 2);
                        S[4 * c + ml] = MFMA16(Kf, Qf[ks], S[4 * c + ml]);
                    }
                if (c == 3) {
                    float mx = S[0][0];
#pragma unroll
                    for (int i = 0; i < 16; ++i) { mx = fmaxf(mx, fmaxf(fmaxf(S[i][0], S[i][1]), fmaxf(S[i][2], S[i][3]))); }
                    mx = fmaxf(mx, shx(mx, 16, lane)); mx = fmaxf(mx, shx(mx, 32, lane));
                    float sum = 0.f;
#pragma unroll
                    for (int i = 0; i < 16; ++i) {
#pragma unroll
                        for (int e = 0; e < 4; ++e) { S[i][e] = __builtin_amdgcn_exp2f(S[i][e] - mx); sum += S[i][e]; }
                    }
                    sum += shx(sum, 16, lane); sum += shx(sum, 32, lane);
                    inv = 1.0f / sum;
#pragma unroll
                    for (int a = 0; a < 8; ++a) {
                        u32x4 pw; pw.x = cvt_pk_bf16(S[2 * a][0], S[2 * a][1]); pw.y = cvt_pk_bf16(S[2 * a][2], S[2 * a][3]); pw.z = cvt_pk_bf16(S[2 * a + 1][0], S[2 * a + 1][1]); pw.w = cvt_pk_bf16(S[2 * a + 1][2], S[2 * a + 1][3]);
                        Pf[a] = __builtin_bit_cast(bf16x8, pw);
                    }
                }
            } else {
#pragma unroll
                for (int al = 0; al < 2; ++al)
#pragma unroll
                    for (int dt = 0; dt < 16; ++dt) {
                        LAS unsigned char* p = slot + (32 * al + 4 * fq + (fr >> 2)) * 544 + (16 * dt + 4 * (fr & 3)) * 2;
                        const bf16x8 Vf = tr_frag(p, p + 16 * 544);
                        Oa[dt] = MFMA16(Vf, Pf[2 * (c - 4) + al], Oa[dt]);
                    }
            }
            if (c < 7) ATT_LSTORE((c + 1) & 1);
            __syncthreads();
        }
#pragma unroll
        for (int dt = 0; dt < 16; ++dt) *(u32x2*)(((bf16_t*)(F.ws + WS_O)) + rowq * D + h * 256 + 16 * dt + 4 * fq) = pack4(Oa[dt] * inv);
#undef ATT_GLOAD
#undef ATT_LSTORE
    }
}

template <class Epi, int N>
__device__ __forceinline__ void sgemm16(Frame& F0, const bf16_t* A, const bf16_t* Bt, int K, const Epi& E) {
    Frame F = launder(F0);
    LAS unsigned char* lds = F.lds;
    constexpr int CW = N / 32, NT = CW / 16, KS = NT == 2 ? 8 : (NT == 10 ? 4 : 2), NG = 8 / KS, NTW = NT / NG;
    static_assert(NT * 16 == CW && NTW * NG == NT && 2 * CW <= NWAVES * 64, "sgemm16 geometry");
    const int tid = F.tid, lane = F.lane, w = F.wave, fr = lane & 15, fq = lane >> 4;
    const int ksi = w % KS, ng = w / KS, kslice = K / KS, nkb = kslice / 128;
    const bf16_t* A16 = A + (size_t)(16 * F.xq) * K;
    for (int slot = F.rk; slot < 32; slot += F.rw) {
        const int erow = tid / (CW / 8), ecg = tid % (CW / 8); const bool eact = tid < 2 * CW;
        typename Epi::Pre pre{};
        if (eact) pre = E.pre(16 * F.xq + erow, slot * CW + 8 * ecg);
        f32x4 acc[NTW];
#pragma unroll
        for (int jn = 0; jn < NTW; ++jn) acc[jn] = (f32x4){0.f, 0.f, 0.f, 0.f};
        const bf16_t* ap = A16 + (size_t)fr * K + ksi * kslice + 8 * fq;
        const bf16_t* bp = Bt + (size_t)(slot * CW + (ng * NTW) * 16 + fr) * K + ksi * kslice + 8 * fq;
        {
            bf16x8 Af[2][4], Bf[2][4][NTW];
#define SG_LOAD(kb_, buf_) do { _Pragma("unroll") for (int k4 = 0; k4 < 4; ++k4) { Af[buf_][k4] = *(const bf16x8*)(ap + 128 * (kb_) + 32 * k4); \
                _Pragma("unroll") for (int jn = 0; jn < NTW; ++jn) Bf[buf_][k4][jn] = *(const bf16x8*)(bp + (size_t)(16 * jn) * K + 128 * (kb_) + 32 * k4); } } while (0)
            SG_LOAD(0, 0);
            for (int kb = 0; kb < nkb; kb += 2) {
                if (kb + 1 < nkb) SG_LOAD(kb + 1, 1);
#pragma unroll
                for (int k4 = 0; k4 < 4; ++k4)
#pragma unroll
                    for (int jn = 0; jn < NTW; ++jn) acc[jn] = MFMA16(Bf[0][k4][jn], Af[0][k4], acc[jn]);
                if (kb + 1 < nkb) {
                    if (kb + 2 < nkb) SG_LOAD(kb + 2, 0);
#pragma unroll
                    for (int k4 = 0; k4 < 4; ++k4)
#pragma unroll
                        for (int jn = 0; jn < NTW; ++jn) acc[jn] = MFMA16(Bf[1][k4][jn], Af[1][k4], acc[jn]);
                }
            }
#undef SG_LOAD
        }
#pragma unroll
        for (int jn = 0; jn < NTW; ++jn) *(LAS f32x4*)(lds + ((size_t)((ksi * 16 + fr) * CW + (ng * NTW + jn) * 16 + 4 * fq)) * 4) = acc[jn];
        LDS_BARRIER();
        if (eact) {
            f32x4 s0 = (f32x4){0.f, 0.f, 0.f, 0.f}, s1 = s0;
#pragma unroll
            for (int kk = 0; kk < KS; ++kk) { const LAS f32x4* p = (const LAS f32x4*)(lds + ((size_t)((kk * 16 + erow) * CW + 8 * ecg)) * 4); s0 += p[0]; s1 += p[1]; }
            E(16 * F.xq + erow, slot, slot * CW + 8 * ecg, s0, s1, pre);
        }
        LDS_BARRIER();
    }
}
struct SEpiZ {
    struct Pre { float rs; };
    const float* rsqs; float* SZ; int ldz, mode;
    __device__ __forceinline__ Pre pre(int row, int col) const { return Pre{rstd32(rsqs + row * 32)}; }
    __device__ __forceinline__ void operator()(int row, int strip, int col, f32x4 s0, f32x4 s1, const Pre& p) const {
        const int oc0 = mode == 0 ? src_even(col) : src_odd(col), oc1 = mode == 0 ? src_even(col + 4) : src_odd(col + 4);
        float* q = SZ + (size_t)row * ldz; *(f32x4*)(q + oc0) = s0 * p.rs; *(f32x4*)(q + oc1) = s1 * p.rs;
    }
};
struct SEpiRes {
    struct Pre { f32x4 x0, x1; };
    float* xs; bf16_t* xb; float* rsqs;
    __device__ __forceinline__ Pre pre(int row, int col) const { const float* q = xs + (size_t)row * D + col; return Pre{*(const f32x4*)q, *(const f32x4*)(q + 4)}; }
    __device__ __forceinline__ void operator()(int row, int strip, int col, f32x4 s0, f32x4 s1, const Pre& pr) const {
        float* p = xs + (size_t)row * D + col; const f32x4 o0 = pr.x0 + s0, o1 = pr.x1 + s1;
        *(f32x4*)p = o0; *(f32x4*)(p + 4) = o1; *(u32x4*)(xb + (size_t)row * D + col) = pack8(o0, o1);
        const int ln = ((row & 15) << 2) | ((col >> 3) & 3);
        float ss = dot4(o0, o0) + dot4(o1, o1); ss += shx(ss, 1, ln); ss += shx(ss, 2, ln);
        if ((col & 31) == 0) rsqs[row * 32 + strip] = ss;
    }
};
struct SEpiQ {
    struct Pre { float rs; };
    const float* rsqs; float* SQ;
    __device__ __forceinline__ Pre pre(int row, int col) const { return Pre{rstd32(rsqs + row * 32)}; }
    __device__ __forceinline__ void operator()(int row, int strip, int col, f32x4 s0, f32x4 s1, const Pre& p) const {
        float* q = SQ + (size_t)row * D + col; *(f32x4*)q = s0 * p.rs; *(f32x4*)(q + 4) = s1 * p.rs;
    }
};
__device__ __forceinline__ void sample_mix_even(Frame& F0, int j, int b) {
    Frame F = launder(F0);
    LAS float* pl = (LAS float*)F.lds; LAS float* red = pl + 1024;
    const int tid = F.tid, lane = F.lane, w = F.wave;
    const float* z = ((float*)(F.ws + WS_SZ)) + (size_t)b * 8192;
    float vv[2], ss = 0.f;
#pragma unroll
    for (int k = 0; k < 2; ++k) { vv[k] = z[3072 + tid + 512 * k]; ss += vv[k] * vv[k]; }
    ss = wave_sum(ss, lane); if (lane == 0) red[w] = ss;
#pragma unroll
    for (int k = 0; k < 2; ++k) {
        const int c = tid + 512 * k, g = c >> 8, win = 2 << g; const float xa = z[c];
        const float* st = FIN(3) + ((size_t)(j * 128 + b) * 15) * 1024 + c;
        float sr[15];
#pragma unroll
        for (int r = 0; r < 15; ++r) sr[r] = st[(size_t)r * 1024];
        float s = xa;
#pragma unroll
        for (int r = 0; r < 15; ++r) s += (r >= 16 - win) ? sr[r] : 0.f;
        pl[c] = s / (float)win - xa;
        float* po = F.out + O_POOLS + ((size_t)(j * 128 + b) * 15) * 1024 + c;
#pragma unroll
        for (int r = 0; r < 14; ++r) po[(size_t)r * 1024] = sr[r + 1];
        po[(size_t)14 * 1024] = xa;
    }
    __syncthreads();
    float tot = 0.f;
#pragma unroll
    for (int i = 0; i < 8; ++i) tot += red[i];
    const float rv = rsqrtf(tot * (1.0f / D) + EPS);
#pragma unroll
    for (int k = 0; k < 2; ++k) {
        const int d = tid + 512 * k, g = d >> 8, dd = d & 255;
        const bf16_t* pm = ((bf16_t*)(F.ws + WS_PMT)) + (size_t)(j * 4 + g) * 65536 + (size_t)dd * 256; const LAS float* pg = pl + g * 256;
        float a = 0.f;
#pragma unroll
        for (int hb = 0; hb < 2; ++hb) {
            u32x4 pr[16];
#pragma unroll
            for (int i = 0; i < 16; ++i) pr[i] = *(const u32x4*)(pm + hb * 128 + i * 8);
#pragma unroll
            for (int i = 0; i < 16; ++i) { f32x4 p0, p1; unpack8(pr[i], p0, p1); const LAS float* q = pg + hb * 128 + i * 8; a += dot4(p0, *(const LAS f32x4*)q) + dot4(p1, *(const LAS f32x4*)(q + 4)); }
        }
        const float ya = a * FIN(12)[j * 1024 + d] * silu_f(z[1024 + d]);
        const float vn = vv[k] * rv * FIN(15)[j * 1024 + d];
        F.out[O_SGUV + (size_t)(j * 128 + b) * 1024 + d] = vn;
        const float mixed = FIN(13)[(size_t)(j * 4 + g) * 16384] * vn + FIN(14)[(j * 4 + g) * 128];
        const float yb = z[2048 + d] * mixed * silu_f(z[4096 + d]);
        ((bf16_t*)(F.ws + WS_SA2))[(size_t)b * 2048 + d] = (bf16_t)(cvt_pk_bf16(ya, 0.f) & 0xffffu); ((bf16_t*)(F.ws + WS_SA2))[(size_t)b * 2048 + 1024 + d] = (bf16_t)(cvt_pk_bf16(yb, 0.f) & 0xffffu);
    }
    __syncthreads();
}
__device__ __forceinline__ void sample_conv_odd(Frame& F0, int j, int b) {
    Frame F = launder(F0);
    const int tid = F.tid;
    const float* z = ((float*)(F.ws + WS_SZ)) + (size_t)b * 8192;
    const float* cw = FIN(18) + (size_t)j * 3 * 2048;
#pragma unroll
    for (int k = 0; k < 4; ++k) {
        const int c = tid + 512 * k;
        const float e = z[2048 + c] * z[4096 + c];
        const float s0 = FIN(4)[((size_t)(j * 128 + b) * 2 + 0) * 2048 + c], s1 = FIN(4)[((size_t)(j * 128 + b) * 2 + 1) * 2048 + c];
        const float y = cw[c] * s0 + cw[2048 + c] * s1 + cw[4096 + c] * e;
        ((bf16_t*)(F.ws + WS_SA2))[(size_t)b * 2048 + c] = (bf16_t)(cvt_pk_bf16(z[c] * y * silu_f(z[6144 + c]), 0.f) & 0xffffu);
        float* po = F.out + O_CONVS + ((size_t)(j * 128 + b) * 2) * 2048 + c; po[0] = s1; po[2048] = e;
    }
}
__device__ __forceinline__ void attn_sample(Frame& F0, int layer) {
    Frame F = launder(F0);
    LAS float* sc = (LAS float*)F.lds;
    LAS float* red = sc + 512;
    const int tid = F.tid, lane = F.lane, w = F.wave;
    for (int item = F.rk; item < 32; item += F.rw) {
        const int b = 16 * F.xq + (item >> 1), hp = item & 1;
        const float* qp = ((float*)(F.ws + WS_SQ)) + (size_t)b * D + hp * 512;
        const f32x4 q0 = *(const f32x4*)(qp + 4 * lane), q1 = *(const f32x4*)(qp + 256 + 4 * lane);
        const float* kp = FIN(5) + ((size_t)(layer * 128 + b) * 256) * 1024 + hp * 512 + 4 * lane;
        const float* vp = FIN(6) + ((size_t)(layer * 128 + b) * 256) * 1024 + hp * 512 + 4 * lane;
#pragma unroll 8
        for (int mi = 0; mi < 32; ++mi) {
            const int m = 32 * w + mi;
            const f32x4 k0 = __builtin_nontemporal_load((const f32x4*)(kp + (size_t)m * 1024)), k1 = __builtin_nontemporal_load((const f32x4*)(kp + (size_t)m * 1024 + 256));
            const float d0 = wave_sum(dot4(k0, q0), lane), d1 = wave_sum(dot4(k1, q1), lane);
            if (lane == 0) { sc[m] = d0; sc[256 + m] = d1; }
        }
        __syncthreads();
        float p0[4], p1[4], mx0 = -INFINITY, mx1 = -INFINITY;
#pragma unroll
        for (int i = 0; i < 4; ++i) { p0[i] = sc[lane + 64 * i]; p1[i] = sc[256 + lane + 64 * i]; mx0 = fmaxf(mx0, p0[i]); mx1 = fmaxf(mx1, p1[i]); }
#pragma unroll
        for (int o = 1; o < 64; o <<= 1) { mx0 = fmaxf(mx0, shx(mx0, o, lane)); mx1 = fmaxf(mx1, shx(mx1, o, lane)); }
        float sm0 = 0.f, sm1 = 0.f;
#pragma unroll
        for (int i = 0; i < 4; ++i) { p0[i] = __builtin_amdgcn_exp2f(p0[i] - mx0); p1[i] = __builtin_amdgcn_exp2f(p1[i] - mx1); sm0 += p0[i]; sm1 += p1[i]; }
        sm0 = wave_sum(sm0, lane); sm1 = wave_sum(sm1, lane);
        const float i0 = 1.0f / sm0, i1 = 1.0f / sm1;
        __syncthreads();
        if (w == 0) {
#pragma unroll
            for (int i = 0; i < 4; ++i) { sc[lane + 64 * i] = p0[i] * i0; sc[256 + lane + 64 * i] = p1[i] * i1; }
        }
        __syncthreads();
        f32x4 a0 = (f32x4){0.f, 0.f, 0.f, 0.f}, a1 = a0;
#pragma unroll 8
        for (int mi = 0; mi < 32; ++mi) {
            const int m = 32 * w + mi;
            const f32x4 v0 = __builtin_nontemporal_load((const f32x4*)(vp + (size_t)m * 1024)), v1 = __builtin_nontemporal_load((const f32x4*)(vp + (size_t)m * 1024 + 256));
            a0 += v0 * sc[m]; a1 += v1 * sc[256 + m];
        }
        *(LAS f32x4*)(red + w * 512 + 4 * lane) = a0; *(LAS f32x4*)(red + w * 512 + 256 + 4 * lane) = a1;
        __syncthreads();
        {
            float o = 0.f;
#pragma unroll
            for (int ww = 0; ww < 8; ++ww) o += red[ww * 512 + tid];
            ((bf16_t*)(F.ws + WS_SO))[(size_t)b * D + hp * 512 + tid] = (bf16_t)(cvt_pk_bf16(o, 0.f) & 0xffffu);
        }
        __syncthreads();
    }
}
#define dpp_mov(v, ctrl, row_mask) __builtin_bit_cast(float, __builtin_amdgcn_update_dpp(0, __builtin_bit_cast(int, (float)(v)), (ctrl), (row_mask), 0xf, false))
__device__ __forceinline__ float wave_sum_dpp(float x) {
    x += dpp_mov(x, 0xB1, 0xf);
    x += dpp_mov(x, 0x4E, 0xf);
    x += dpp_mov(x, 0x141, 0xf);
    x += dpp_mov(x, 0x140, 0xf);
    x += dpp_mov(x, 0x142, 0xa);
    x += dpp_mov(x, 0x143, 0xc);
    return x;
}
constexpr int FA_SC = 69632, FA_RED = 71680;
__device__ __forceinline__ void attn_fused(Frame& F0, int layer) {
    Frame F = launder(F0);
    LAS unsigned char* lds = F.lds;
    const int tid = F.tid, lane = F.lane, w = F.wave, fr = lane & 15, fq = lane >> 4;
    const bf16_t* Kl = ((bf16_t*)(F.ws + WS_KB)) + (size_t)layer * MMEM * D; const bf16_t* Vl = ((bf16_t*)(F.ws + WS_VB)) + (size_t)layer * MMEM * D;
    LAS float* sc = (LAS float*)(lds + FA_SC); LAS float* red = (LAS float*)(lds + FA_RED);
    const int sb = 16 * F.xq + (F.rk >> 1), hp = F.rk & 1;
    const float* qp = ((float*)(F.ws + WS_SQ)) + (size_t)sb * D + hp * 512;
    const f32x4 q0 = *(const f32x4*)(qp + 4 * lane), q1 = *(const f32x4*)(qp + 256 + 4 * lane);
    const float* kp = FIN(5) + ((size_t)(layer * 128 + sb) * 256 + 4 * w) * 1024 + hp * 512;
    const float* vp = FIN(6) + ((size_t)(layer * 128 + sb) * 256 + 4 * w) * 1024 + hp * 512;
    const unsigned lo16 = (unsigned)lane * 16u;
    f32x4 sv[8]; f32x4 a0 = (f32x4){0.f, 0.f, 0.f, 0.f}, a1 = a0; float mx0 = 0.f, mx1 = 0.f, iv0 = 0.f, iv1 = 0.f;
#define FA_SLOAD(base, slice) do { unsigned long long pu_ = uni64((unsigned long long)((base) + (size_t)(32 * (slice)) * 1024)); asm volatile("" : "+s"(pu_)); const char* pc_ = (const char*)(const GAS char*)pu_; \
        _Pragma("unroll") for (int r_ = 0; r_ < 4; ++r_) { sv[2 * r_] = __builtin_nontemporal_load((const f32x4*)(pc_ + r_ * 4096 + lo16)); sv[2 * r_ + 1] = __builtin_nontemporal_load((const f32x4*)(pc_ + r_ * 4096 + 1024 + lo16)); } } while (0)
    FA_SLOAD(kp, 0);
#pragma unroll 1
    for (int ui = 0; ui < 2; ++ui) {
        const int kk = 2 * F.rk + ui;
        const int b = F.xq, h = kk >> 4, qb = kk & 15;
        const size_t rowq = (size_t)b * SEQ + qb * 128 + 16 * w + fr;
        bf16x8 Qf[8];
#pragma unroll
        for (int ks = 0; ks < 8; ++ks) Qf[ks] = *(const bf16x8*)(((bf16_t*)(F.ws + WS_Q)) + rowq * D + h * 256 + 32 * ks + 8 * fq);
        const bf16_t* kbase = Kl + (size_t)(b * 256) * D + h * 256; const bf16_t* vbase = Vl + (size_t)(b * 256) * D + h * 256;
        u32x4 st[4];
        const unsigned goff = (unsigned)(tid >> 5) * (D * 2) + (unsigned)(tid & 31) * 16u, loff = (unsigned)(tid >> 5) * 544u + (unsigned)(tid & 31) * 16u;
#define ATT_GLOAD(c) do { unsigned long long pu_ = uni64((unsigned long long)(((c) < 4 ? kbase : vbase) + (size_t)(64 * ((c) & 3)) * D)); asm volatile("" : "+s"(pu_)); const char* pc_ = (const char*)(const GAS char*)pu_; \
        _Pragma("unroll") for (int i_ = 0; i_ < 4; ++i_) st[i_] = *(const u32x4*)(pc_ + (size_t)(16 * i_) * D * 2 + goff); } while (0)
#define ATT_LSTORE(c) do { _Pragma("unroll") for (int i_ = 0; i_ < 4; ++i_) *(LAS u32x4*)(lds + ((c) & 1) * ATT_SLOT + 16 * i_ * 544 + loff) = st[i_]; } while (0)
        f32x4 S[16], Oa[16]; bf16x8 Pf[8]; float inv = 0.f;
        const f32x4 zero4 = (f32x4){0.f, 0.f, 0.f, 0.f};
        if (ui == 1) {
            float p0[4], p1[4]; mx0 = -INFINITY; mx1 = -INFINITY;
#pragma unroll
            for (int i = 0; i < 4; ++i) { p0[i] = sc[lane + 64 * i]; p1[i] = sc[256 + lane + 64 * i]; mx0 = fmaxf(mx0, p0[i]); mx1 = fmaxf(mx1, p1[i]); }
#pragma unroll
            for (int o = 1; o < 64; o <<= 1) { mx0 = fmaxf(mx0, shx(mx0, o, lane)); mx1 = fmaxf(mx1, shx(mx1, o, lane)); }
            float sm0 = 0.f, sm1 = 0.f;
#pragma unroll
            for (int i = 0; i < 4; ++i) { sm0 += __builtin_amdgcn_exp2f(p0[i] - mx0); sm1 += __builtin_amdgcn_exp2f(p1[i] - mx1); }
            sm0 = wave_sum(sm0, lane); sm1 = wave_sum(sm1, lane);
            iv0 = 1.0f / sm0; iv1 = 1.0f / sm1;
        }
        ATT_GLOAD(0); ATT_LSTORE(0); __syncthreads();
#pragma unroll
        for (int c = 0; c < 8; ++c) {
            if (c < 7) ATT_GLOAD(c + 1);
            if (ui == 0) {
#pragma unroll
                for (int r = 0; r < 4; ++r) {
                    const int m = 32 * c + 4 * w + r;
                    const float d0 = wave_sum_dpp(dot4(sv[2 * r], q0)), d1 = wave_sum_dpp(dot4(sv[2 * r + 1], q1));
                    if (lane == 63) { sc[m] = d0; sc[256 + m] = d1; }
                }
                if (c < 7) FA_SLOAD(kp, c + 1); else FA_SLOAD(vp, 0);
            } else {
#pragma unroll
                for (int r = 0; r < 4; ++r) {
                    const int m = 32 * c + 4 * w + r;
                    const float p0 = __builtin_amdgcn_exp2f(sc[m] - mx0) * iv0, p1 = __builtin_amdgcn_exp2f(sc[256 + m] - mx1) * iv1;
                    a0 += sv[2 * r] * p0; a1 += sv[2 * r + 1] * p1;
                }
                if (c < 7) FA_SLOAD(vp, c + 1);
            }
            LAS unsigned char* slot = lds + (c & 1) * ATT_SLOT;
            if (c < 4) {
                {
                    bf16x8 Kf[2][4];
#pragma unroll
                    for (int ml = 0; ml < 4; ++ml) Kf[0][ml] = *(LAS bf16x8*)(slot + (16 * ml + fr) * 544 + (8 * fq) * 2);
                    __builtin_amdgcn_sched_group_barrier(0x100, 4, 0);
#pragma unroll
                    for (int ks = 0; ks < 8; ++ks) {
                        if (ks < 7) {
#pragma unroll
                            for (int ml = 0; ml < 4; ++ml) Kf[(ks + 1) & 1][ml] = *(LAS bf16x8*)(slot + (16 * ml + fr) * 544 + (32 * (ks + 1) + 8 * fq) * 2);
                        }
#pragma unroll
                        for (int ml = 0; ml < 4; ++ml) S[4 * c + ml] = MFMA16(Kf[ks & 1][ml], Qf[ks], ks == 0 ? zero4 : S[4 * c + ml]);
                        __builtin_amdgcn_sched_group_barrier(0x100, 4, 0); __builtin_amdgcn_sched_group_barrier(0x008, 4, 0);
                    }
                }
                if (c == 3) {
                    float mx = S[0][0];
#pragma unroll
                    for (int i = 0; i < 16; ++i) { mx = fmaxf(mx, fmaxf(fmaxf(S[i][0], S[i][1]), fmaxf(S[i][2], S[i][3]))); }
                    mx = fmaxf(mx, shx(mx, 16, lane)); mx = fmaxf(mx, shx(mx, 32, lane));
                    float sum = 0.f;
#pragma unroll
                    for (int i = 0; i < 16; ++i) {
#pragma unroll
                        for (int e = 0; e < 4; ++e) { S[i][e] = __builtin_amdgcn_exp2f(S[i][e] - mx); sum += S[i][e]; }
                    }
                    sum += shx(sum, 16, lane); sum += shx(sum, 32, lane);
                    inv = 1.0f / sum;
#pragma unroll
                    for (int a = 0; a < 8; ++a) {
                        u32x4 pw; pw.x = cvt_pk_bf16(S[2 * a][0], S[2 * a][1]); pw.y = cvt_pk_bf16(S[2 * a][2], S[2 * a][3]); pw.z = cvt_pk_bf16(S[2 * a + 1][0], S[2 * a + 1][1]); pw.w = cvt_pk_bf16(S[2 * a + 1][2], S[2 * a + 1][3]);
                        Pf[a] = __builtin_bit_cast(bf16x8, pw);
                    }
                }
            } else {
                {
                    bf16x8 Vf[2][4];
#define ATT_VREAD(n_, buf_) do { _Pragma("unroll") for (int d_ = 0; d_ < 4; ++d_) { LAS unsigned char* p_ = slot + (32 * ((n_) >> 2) + 4 * fq + (fr >> 2)) * 544 + (16 * (4 * ((n_) & 3) + d_) + 4 * (fr & 3)) * 2; Vf[buf_][d_] = tr_frag(p_, p_ + 16 * 544); } } while (0)
                    ATT_VREAD(0, 0);
                    __builtin_amdgcn_sched_group_barrier(0x100, 8, 0);
#pragma unroll
                    for (int n = 0; n < 8; ++n) {
                        if (n < 7) ATT_VREAD(n + 1, (n + 1) & 1);
#pragma unroll
                        for (int d = 0; d < 4; ++d) { const int al = n >> 2, dt = 4 * (n & 3) + d; Oa[dt] = MFMA16(Vf[n & 1][d], Pf[2 * (c - 4) + al], (c == 4 && al == 0) ? zero4 : Oa[dt]); }
                        __builtin_amdgcn_sched_group_barrier(0x100, 8, 0); __builtin_amdgcn_sched_group_barrier(0x008, 4, 0);
                    }
#undef ATT_VREAD
                }
            }
            if (c < 7) ATT_LSTORE(c + 1);
            LDS_BARRIER();
        }
#pragma unroll
        for (int dt = 0; dt < 16; ++dt) *(u32x2*)(((bf16_t*)(F.ws + WS_O)) + rowq * D + h * 256 + 16 * dt + 4 * fq) = pack4(Oa[dt] * inv);
#undef ATT_GLOAD
#undef ATT_LSTORE
    }
#undef FA_SLOAD
    *(LAS f32x4*)(red + w * 512 + 4 * lane) = a0; *(LAS f32x4*)(red + w * 512 + 256 + 4 * lane) = a1;
    __syncthreads();
    {
        float o = 0.f;
#pragma unroll
        for (int ww = 0; ww < 8; ++ww) o += red[ww * 512 + tid];
        ((bf16_t*)(F.ws + WS_SO))[(size_t)sb * D + hp * 512 + tid] = (bf16_t)(cvt_pk_bf16(o, 0.f) & 0xffffu);
    }
    __syncthreads();
}
__device__ __forceinline__ void final_norm(Frame& F0) {
    Frame F = launder(F0);
    const int gwx = F.rk * NWAVES + F.wave, NGX = F.rw * NWAVES, lane = F.lane;
    f32x4 g[4];
#pragma unroll
    for (int jj = 0; jj < 4; ++jj) g[jj] = ((const f32x4*)FIN(24) + lane)[64 * jj];
    for (int p = gwx; p < SEQ / 2 + 8; p += NGX) {
        const int m0 = p < SEQ / 2 ? F.xq * SEQ + 2 * p : MP + 16 * F.xq + 2 * (p - SEQ / 2);
        f32x4 v[2][4];
#pragma unroll
        for (int r = 0; r < 2; ++r) {
            const int m = m0 + r;
            if (m < MP) {
                const u32x2* src = (const u32x2*)(((bf16_t*)(F.ws + WS_XB)) + (size_t)m * D) + lane;
#pragma unroll
                for (int jj = 0; jj < 4; ++jj) v[r][jj] = unpack4(src[64 * jj]);
            } else {
                const f32x4* src = (const f32x4*)(((float*)(F.ws + WS_XS)) + (size_t)(m - MP) * D) + lane;
#pragma unroll
                for (int jj = 0; jj < 4; ++jj) v[r][jj] = src[64 * jj];
            }
        }
#pragma unroll
        for (int r = 0; r < 2; ++r) {
            const int m = m0 + r; float s = 0.f;
#pragma unroll
            for (int jj = 0; jj < 4; ++jj) s += dot4(v[r][jj], v[r][jj]);
            float* dst = m < MP ? F.out + O_Y + (size_t)m * D : F.out + O_YS + (size_t)(m - MP) * D;
            const float rs = rsqrtf(wave_sum(s, lane) * (1.0f / D) + EPS);
#pragma unroll
            for (int jj = 0; jj < 4; ++jj) ((f32x4*)dst + lane)[64 * jj] = v[r][jj] * rs * g[jj];
        }
    }
}

struct Args { const float* in[25]; float* out; unsigned char* ws; int ph_lo, ph_hi; };
#define REP(bit) for (int rep_ = 0; rep_ < 1 + ((REP_MASK >> (bit)) & 1); ++rep_)
__global__ void __launch_bounds__(NWAVES * 64, 2) fwd(Args args) {
    extern __shared__ __attribute__((aligned(16))) unsigned char lds_raw[];
    Frame F0;
    F0.lds = (LAS unsigned char*)lds_raw;
    F0.tid = threadIdx.x; F0.lane = F0.tid & 63; F0.wave = __builtin_amdgcn_readfirstlane(F0.tid >> 6); F0.G = gridDim.x; F0.bx = blockIdx.x;
    F0.in = (in_tab_t)__builtin_amdgcn_kernarg_segment_ptr();     F0.out = args.out; F0.ws = args.ws;
    for (int u = F0.tid; u < (LDS_BYTES - LDSCTL_OFF) / 4; u += NWAVES * 64) ((LAS unsigned*)(F0.lds + LDSCTL_OFF))[u] = 0u;
    __syncthreads();
    XcdBarrier bar; bar.wave = F0.wave; bar.bar = (unsigned*)(args.ws + WS_CTL) + CW_BAR; bar.x = 0; bar.st = nullptr;
    if (!MK_SPLIT) bar = xcd_barrier_post((unsigned*)(args.ws + WS_CTL) + CW_BAR, (volatile LAS unsigned*)(F0.lds + MISC_OFF) + 8, F0.wave);
    unsigned* rankw = (unsigned*)(args.ws + WS_CTL) + CW_RANK;
    const unsigned my_xcc = xb_xcc_id();
    unsigned my_rank = 0u;
    if (F0.tid == 0) ((volatile LAS unsigned*)(F0.lds + MISC_OFF))[12] = __hip_atomic_fetch_add(rankw + 64 * my_xcc, 1u, __ATOMIC_RELAXED, __HIP_MEMORY_SCOPE_AGENT);
    __syncthreads();
    my_rank = __builtin_amdgcn_readfirstlane(((volatile LAS unsigned*)(F0.lds + MISC_OFF))[12]);
    F0.vid = F0.bx;
    int ph = 0;
    bool local_ok = false;
    const int lo = args.ph_lo, hi = args.ph_hi;
#define PH_BEGIN if (ph >= lo && ph < hi) { Frame F = launder(F0);
#define PH_END } { const bool both_ = (ph >= lo && ph + 1 < hi); ++ph; if (!MK_SPLIT && both_) { XcdBarrier b2_ = bar; unsigned long long bp_ = uni64((unsigned long long)bar.bar); unsigned bx_ = __builtin_amdgcn_readfirstlane(bar.x); int bw_ = __builtin_amdgcn_readfirstlane(bar.wave); asm volatile("" : "+s"(bp_), "+s"(bx_), "+s"(bw_)); b2_.bar = (unsigned*)(GAS unsigned*)bp_; b2_.x = bx_; b2_.wave = bw_; if (local_ok && ph > 2) xcd_barrier_local(b2_); else xcd_barrier(b2_); if ((REP_MASK >> 19) & 1) xcd_barrier(b2_); if (ph == 2) local_ok = XCD_LOCAL && lo == 0 && __builtin_amdgcn_readfirstlane(__hip_atomic_load(rankw + 64 * 20, __ATOMIC_RELAXED, __HIP_MEMORY_SCOPE_AGENT)) == 0u;     } }

    PH_BEGIN REP(0) { p0_prologue(F0); __syncthreads(); } PH_END
    if (!MK_SPLIT && lo == 0) {
        unsigned nx = 0u, xi = 0u; bool even = (F0.G % 8) == 0;
        for (unsigned jx = 0; jx < 16; ++jx) { const unsigned c_ = __hip_atomic_load(rankw + 64 * jx, __ATOMIC_RELAXED, __HIP_MEMORY_SCOPE_AGENT); if (c_) { if (c_ != (unsigned)F0.G / 8u) even = false; if (jx < my_xcc) ++xi; ++nx; } }
        if (XCD_VID && even && nx == 8u) F0.vid = (int)(my_rank * 8u + xi);
        if (!(even && nx == 8u && (unsigned)(F0.bx % 8) == xi) && F0.tid == 0) __hip_atomic_store(rankw + 64 * 20, 1u, __ATOMIC_RELAXED, __HIP_MEMORY_SCOPE_AGENT);
        if (((REP_MASK >> 18) & 1) && !(even && nx == 8u && (unsigned)(F0.bx % 8) == xi) && F0.tid == 0) F0.out[O_YS + F0.bx] = __builtin_nanf("");
        F0.vid = __builtin_amdgcn_readfirstlane(F0.vid);
    }
    PH_BEGIN {
        if ((REP_MASK >> 17) & 1) {
            f32x4 pa[8]; bf16x8 pb = (bf16x8){(short)F.tid, 1, 2, 3, 4, 5, 6, 7};
#pragma unroll
            for (int i = 0; i < 8; ++i) pa[i] = (f32x4){(float)F.tid, 1.f, 2.f, (float)i};
#pragma unroll 1
            for (int it = 0; it < 512; ++it) {
#pragma unroll
                for (int r = 0; r < 4; ++r)
#pragma unroll
                    for (int i = 0; i < 8; ++i) pa[i] = MFMA16(pb, pb, pa[i]);
            }
            float sacc = 0.f;
#pragma unroll
            for (int i = 0; i < 8; ++i) sacc += pa[i][0] + pa[i][3];
            if (sacc == 12345.678f) ((float*)(F.ws + WS_Z))[F.tid] = sacc;
        }
        if ((REP_MASK >> 15) & 3) { pg8::Gemm gp{((bf16_t*)(F.ws + WS_XB)), ((bf16_t*)(F.ws + WS_C1)), MP, NC, ((REP_MASK >> 15) & 1) ? 1024 : 512}; pg8::StaticOrder Sp; Sp.init(MP, NC, F.G, (int)F.vid); EpiProbe Ep{((bf16_t*)(F.ws + WS_Z)), NC}; pg8::gemm_phase<EpiProbe, pg8::StaticOrder, true, true>(F.lds, gp, Sp, Ep, F.wave); }
        pg8::Gemm g{((bf16_t*)(F.ws + WS_MEMB)), ((bf16_t*)(F.ws + WS_WKV)), MMEM, 8192, D}; pg8::StaticOrder S; S.init(MMEM, 8192, F.G, (int)F.vid);
        EpiMemKV E{((float*)(F.ws + WS_SMALL + 65536)), F.out + O_MEMK, F.out + O_MEMV, ((bf16_t*)(F.ws + WS_KB)), ((bf16_t*)(F.ws + WS_VB))};
        REP(1) pg8::gemm_phase<EpiMemKV, pg8::StaticOrder, true, true>(F.lds, g, S, E, F.wave);
    } PH_END
    if (STAGGER_TICKS != 0 && lo == 0 && ((F0.bx & 1) == (STAGGER_TICKS > 0 ? 1 : 0))) { const unsigned long long t0_ = __builtin_amdgcn_s_memrealtime(); const unsigned long long tk_ = (unsigned long long)(STAGGER_TICKS > 0 ? STAGGER_TICKS : -STAGGER_TICKS); while (__builtin_amdgcn_s_memrealtime() - t0_ < tk_) __builtin_amdgcn_s_sleep(8); }
    unsigned* pbw = (unsigned*)(args.ws + WS_CTL) + CW_RANK + 64 * 24;
    if (!MK_SPLIT && SPLIT_PROLOGUE && lo == 0) {
        const int half = F0.bx & 1, hw = (half ? (F0.G >> 1) : ((F0.G + 1) >> 1)) * NWAVES, hi_ = (F0.bx >> 1) * NWAVES + F0.wave;
        p0_weights(F0, 1, hi_, hw, half);
        asm volatile("s_waitcnt vmcnt(0)" ::: "memory"); __syncthreads();
        if (F0.wave == 0 && hw_lane() == 0) { __builtin_amdgcn_fence(__ATOMIC_RELEASE, "agent"); asm volatile("s_waitcnt vmcnt(0)" ::: "memory"); (void)__hip_atomic_fetch_add(pbw, 1u, __ATOMIC_RELAXED, __HIP_MEMORY_SCOPE_AGENT); }
    }
#pragma unroll 1
    for (int l = 0; l < DEPTH; ++l) {
        const int j = l >> 1;
        if (!MK_SPLIT && SPLIT_PROLOGUE && lo == 0 && l == 1) {
            if (F0.wave == 0 && hw_lane() == 0) {
                const unsigned want = (unsigned)F0.G; unsigned sp = 0u;
                while (__hip_atomic_load(pbw, __ATOMIC_RELAXED, __HIP_MEMORY_SCOPE_AGENT) < want) { __builtin_amdgcn_s_sleep(2); if (++sp > (1u << 22)) { atomicAdd((unsigned*)(args.ws + WS_CTL) + CW_BAR + XB_TMO, 1u); break; } }
                __builtin_amdgcn_fence(__ATOMIC_ACQUIRE, "agent"); asm volatile("s_waitcnt vmcnt(0)" ::: "memory");
            }
            __syncthreads();
        }
        if ((l & 1) == 0) {
            PH_BEGIN {
                pg8::Gemm g{((bf16_t*)(F.ws + WS_XB)), ((bf16_t*)(F.ws + WS_AB1)) + (size_t)j * NAB * D, MP, NAB, D}; pg8::StaticOrder S; S.init(MP, NAB, F.G, (int)F.vid);
                Unit u0{0, 0}; S.next(0, u0); rstd_table(((float*)(F.ws + WS_RSQ)), u0.pm, (LAS float*)(F.lds + RSTD_OFF), F.tid);
                EpiG1Even E{((float*)(F.ws + WS_RSQ)), ((bf16_t*)(F.ws + WS_Z)), ((float*)(F.ws + WS_VSQ)), F.out + O_POOLP + (size_t)j * 8 * 15 * 1024, (LAS const float*)(F.lds + RSTD_OFF), u0.pm};
                SEpiZ SE{((float*)(F.ws + WS_SMALL)), ((float*)(F.ws + WS_SZ)), 8192, 0};
                const bool s_first = (F.rk & 1) != 0;
                if (s_first) { REP(3) sgemm16<SEpiZ, NAB>(F, ((bf16_t*)(F.ws + WS_XB)) + (size_t)MP * D, ((bf16_t*)(F.ws + WS_AB1)) + (size_t)j * NAB * D, D, SE); }
                REP(2) pg8::gemm_phase<EpiG1Even, pg8::StaticOrder, true, true>(F.lds, g, S, E, F.wave);
                if (!s_first) { REP(3) sgemm16<SEpiZ, NAB>(F, ((bf16_t*)(F.ws + WS_XB)) + (size_t)MP * D, ((bf16_t*)(F.ws + WS_AB1)) + (size_t)j * NAB * D, D, SE); }
            } PH_END
            PH_BEGIN {
                REP(4) for (int i = F.rk; i < 32; i += F.rw) {
                    const int n = 16 * F.xq + (i >> 1);
                    if ((i & 1) == 0) { sgu_chunk(F, j, n, 0, 2); pool_pair<0, 3>(F, j, n); } else { sgu_chunk(F, j, n, 2, 4); pool_pair<1, 2>(F, j, n); }
                }
                REP(5) for (int i = F.rk; i < 16; i += F.rw) sample_mix_even(F, j, 16 * F.xq + i);
            } PH_END
        } else {
            PH_BEGIN {
                pg8::Gemm g{((bf16_t*)(F.ws + WS_XB)), ((bf16_t*)(F.ws + WS_C1)) + (size_t)j * NC * D, MP, NC, D}; pg8::StaticOrder S; S.init(MP, NC, F.G, (int)F.vid);
                Unit u0{0, 0}; S.next(0, u0);
                for (int i = F.tid; i < 8 * 3 * 64; i += NWAVES * 64) { const int ui = i / 192, q = (i / 64) % 3, c = i & 63, pn = u0.pn + 4 * ui; ((LAS float*)(F.lds + CWL_OFF))[i] = pn < NC / 256 ? (FIN(18) + (size_t)j * 3 * 2048)[q * 2048 + pn * 64 + c] : 0.f; }
                rstd_table(((float*)(F.ws + WS_RSQ)), u0.pm, (LAS float*)(F.lds + RSTD_OFF), F.tid);
                EpiG1Odd E{((float*)(F.ws + WS_RSQ)), ((bf16_t*)(F.ws + WS_A2)), FIN(18) + (size_t)j * 3 * 2048, F.out + O_CONVP + (size_t)j * 8 * 2 * 2048, ((float*)(F.ws + WS_SIDE)), (LAS float*)(F.lds + HALO_OFF), (LAS const float*)(F.lds + RSTD_OFF), u0.pm, (LAS const float*)(F.lds + CWL_OFF), u0.pn};
                SEpiZ SE{((float*)(F.ws + WS_SMALL)), ((float*)(F.ws + WS_SZ)), 8192, 1};
                const bool s_first = (F.rk & 1) != 0;
                if (s_first) { REP(3) sgemm16<SEpiZ, NC>(F, ((bf16_t*)(F.ws + WS_XB)) + (size_t)MP * D, ((bf16_t*)(F.ws + WS_C1)) + (size_t)j * NC * D, D, SE); }
                REP(6) pg8::gemm_phase<EpiG1Odd, pg8::StaticOrder, true, true>(F.lds, g, S, E, F.wave);
                if (!s_first) { REP(3) sgemm16<SEpiZ, NC>(F, ((bf16_t*)(F.ws + WS_XB)) + (size_t)MP * D, ((bf16_t*)(F.ws + WS_C1)) + (size_t)j * NC * D, D, SE); }
            } PH_END
            PH_BEGIN {
                REP(5) for (int i = F.rk; i < 16; i += F.rw) sample_conv_odd(F, j, 16 * F.xq + i);
            } PH_END
        }
        PH_BEGIN {
            const bf16_t* W2 = ((l & 1) ? ((bf16_t*)(F.ws + WS_C2)) : ((bf16_t*)(F.ws + WS_AB2))) + (size_t)j * D * 2048;
            pg8::Gemm g{((bf16_t*)(F.ws + WS_A2)), W2, MP, D, 2048}; pg8::StaticOrder S; S.init(MP, D, F.G, (int)F.vid);
            if (l & 1) { Unit fu; for (int i = 0; S.next(i, fu); ++i) conv_fixup(((float*)(F.ws + WS_SIDE)), FIN(18) + (size_t)j * 3 * 2048, ((bf16_t*)(F.ws + WS_A2)), fu.pm, F.tid); asm volatile("s_waitcnt vmcnt(0)" ::: "memory"); __syncthreads(); }
            EpiRes E{((bf16_t*)(F.ws + WS_XB)), ((float*)(F.ws + WS_RSQ))};
            pg8::gemm_phase<EpiRes, pg8::StaticOrder, true, true>(F.lds, g, S, E, F.wave);
            SEpiRes SE{((float*)(F.ws + WS_XS)), ((bf16_t*)(F.ws + WS_XB)) + (size_t)MP * D, ((float*)(F.ws + WS_SMALL))};
            sgemm16<SEpiRes, D>(F, ((bf16_t*)(F.ws + WS_SA2)), W2, 2048, SE);
        } PH_END
        PH_BEGIN {
            pg8::Gemm g{((bf16_t*)(F.ws + WS_XB)), ((bf16_t*)(F.ws + WS_WQ)) + (size_t)l * D * D, MP, D, D}; pg8::StaticOrder S; S.init(MP, D, F.G, (int)F.vid);
            Unit u0{0, 0}; S.next(0, u0); rstd_table(((float*)(F.ws + WS_RSQ)), u0.pm, (LAS float*)(F.lds + RSTD_OFF), F.tid);
            EpiQ E{((float*)(F.ws + WS_RSQ)), ((bf16_t*)(F.ws + WS_Q)), (LAS const float*)(F.lds + RSTD_OFF), u0.pm};
            REP(8) pg8::gemm_phase<EpiQ, pg8::StaticOrder, true, true>(F.lds, g, S, E, F.wave);
            SEpiQ SE{((float*)(F.ws + WS_SMALL)), ((float*)(F.ws + WS_SQ))};
            REP(9) sgemm16<SEpiQ, D>(F, ((bf16_t*)(F.ws + WS_XB)) + (size_t)MP * D, ((bf16_t*)(F.ws + WS_WQ)) + (size_t)l * D * D, D, SE);
        } PH_END
        PH_BEGIN {
            if (F.G == 256) { REP(10) attn_fused(F, l); }
            else { attn_prompt(F, l); attn_sample(F, l); }
        } PH_END
        PH_BEGIN {
            pg8::Gemm g{((bf16_t*)(F.ws + WS_O)), ((bf16_t*)(F.ws + WS_WO)) + (size_t)l * D * D, MP, D, D}; pg8::StaticOrder S; S.init(MP, D, F.G, (int)F.vid);
            EpiRes E{((bf16_t*)(F.ws + WS_XB)), ((float*)(F.ws + WS_RSQ))};
            pg8::gemm_phase<EpiRes, pg8::StaticOrder, true, true>(F.lds, g, S, E, F.wave);
            SEpiRes SE{((float*)(F.ws + WS_XS)), ((bf16_t*)(F.ws + WS_XB)) + (size_t)MP * D, ((float*)(F.ws + WS_SMALL))};
            sgemm16<SEpiRes, D>(F, ((bf16_t*)(F.ws + WS_SO)), ((bf16_t*)(F.ws + WS_WO)) + (size_t)l * D * D, D, SE);
        } PH_END
    }
    PH_BEGIN final_norm(F0); PH_END
#undef PH_BEGIN
#undef PH_END
}
constexpr int N_PHASES = 2 + 6 * DEPTH + 1;

extern "C" void kernel_launch(void* const* d_in, const int* in_sizes, int n_in, void* d_out, int out_size, void* d_ws, size_t ws_size, hipStream_t stream) {
    static int grid = 0;
    if (grid == 0) {
        if (n_in != 25 || in_sizes[0] != MP * D || (size_t)out_size != O_END || ws_size < WS_END) { fprintf(stderr, "kernel_launch: unexpected shapes (n_in %d, in0 %d, out %d, ws %zu); nothing launched\n", n_in, n_in > 0 ? in_sizes[0] : -1, out_size, ws_size); grid = -1; return; }
        int dev = 0, cus = 0, per_cu = 0;
        if (hipGetDevice(&dev) != hipSuccess || hipDeviceGetAttribute(&cus, hipDeviceAttributeMultiprocessorCount, dev) != hipSuccess) { fprintf(stderr, "kernel_launch: device query failed\n"); grid = -1; return; }
        if (hipFuncSetAttribute((const void*)fwd, hipFuncAttributeMaxDynamicSharedMemorySize, LDS_BYTES) != hipSuccess) { fprintf(stderr, "kernel_launch: hipFuncSetAttribute failed\n"); grid = -1; return; }
        if (hipOccupancyMaxActiveBlocksPerMultiprocessor(&per_cu, (const void*)fwd, NWAVES * 64, LDS_BYTES) != hipSuccess || per_cu < 1) fprintf(stderr, "kernel_launch: note: occupancy query reports %d workgroups per CU\n", per_cu);
        (void)hipGetLastError();
        grid = cus;
    }
    if (grid < 0) return;
    if (hipMemsetAsync((char*)d_ws + WS_CTL, 0, CTL_ZERO_BYTES, stream) != hipSuccess) { fprintf(stderr, "kernel_launch: memset failed\n"); return; }
    Args a{};
    for (int i = 0; i < 25; ++i) a.in[i] = (const float*)d_in[i];
    a.out = (float*)d_out; a.ws = (unsigned char*)d_ws;
#if MK_SPLIT
    for (int p = 0; p < N_PHASES; ++p) { a.ph_lo = p; a.ph_hi = p + 1; hipLaunchKernelGGL(fwd, dim3(grid), dim3(NWAVES * 64), LDS_BYTES, stream, a); }
#else
    a.ph_lo = 0; a.ph_hi = N_PHASES;
    hipLaunchKernelGGL(fwd, dim3(grid), dim3(NWAVES * 64), LDS_BYTES, stream, a);
#endif
    const hipError_t le = hipPeekAtLastError();
    if (le != hipSuccess) fprintf(stderr, "kernel_launch: launch failed: %s\n", hipGetErrorName(le));
}
```

```cpp
#include <hip/hip_runtime.h>
#include <cstdio>
#include <cstdint>
#ifndef REP_MASK
#define REP_MASK 0
#endif
#ifndef STAGGER_TICKS
#define STAGGER_TICKS 0
#endif
#ifndef PB_ODD_PCT
#define PB_ODD_PCT 100
#endif
#ifndef SPLIT_PROLOGUE
#define SPLIT_PROLOGUE 1
#endif
#ifndef XCD_LOCAL
#define XCD_LOCAL 1
#endif
#ifndef XCD_VID
#define XCD_VID 0
#endif
#ifndef MK_SPLIT
#define MK_SPLIT 0
#endif
__device__ __forceinline__ int hw_lane() { int l; asm volatile("v_mbcnt_lo_u32_b32 %0, -1, 0\n\tv_mbcnt_hi_u32_b32 %0, -1, %0" : "=v"(l)); return l; }
namespace pg8 {
#define PG8_LAS __attribute__((address_space(3)))
typedef unsigned short bf16_t;
typedef short bf16x8 __attribute__((ext_vector_type(8)));
typedef float f32x4 __attribute__((ext_vector_type(4)));
typedef unsigned u32x4 __attribute__((ext_vector_type(4)));
constexpr int BM = 256, BK = 64, HALF = 128, HTB = HALF * BK * 2  , STAGE_BYTES = 8 * HTB, NXCD = 8, WGM = 8;

__host__ __device__ __forceinline__ int lds_byte(int r, int c) { const int st = (r >> 4) * 2 + (c >> 5), rr = r & 15, cc = c & 31, ob = rr * 64 + cc * 2; return st * 1024 + (ob ^ (((ob >> 9) & 1) << 5)); }
__host__ __device__ __forceinline__ void stage_rc(int b, int& R, int& C) { const int st = b / 1024, sb = b % 1024, swz = sb ^ (((sb >> 9) & 1) << 5); R = (st >> 1) * 16 + swz / 64; C = (st & 1) * 32 + (swz % 64) / 2; }
__host__ __device__ __forceinline__ int perm32(int rho) { const int n = rho >> 4, i = rho & 15; return 8 * (i >> 2) + 4 * n + (i & 3); }

struct Unit { int pm, pn; };
struct Gemm { const bf16_t* A; const bf16_t* Bt; int M, N, K; };

struct StaticOrder {
    int nM, nN, nwg, G, c;
    __host__ __device__ __forceinline__ void init(int M, int N, int G_, int c_) { nM = M / BM; nN = N / BM; nwg = nM * nN; G = G_; c = c_; }
    __host__ __device__ __forceinline__ bool next(int i, Unit& u) const {
        const long L = (long)i * G + c; if (L >= nwg) return false;
        int wgid = (int)L; { const int q = nwg / NXCD, r = nwg % NXCD, xcd = wgid % NXCD, off = wgid / NXCD; wgid = (xcd < r ? xcd * (q + 1) : r * (q + 1) + (xcd - r) * q) + off; }
        const int nig = WGM * nN, gid = wgid / nig, fm = gid * WGM, gsz = (nM - fm) < WGM ? (nM - fm) : WGM;
        u.pm = fm + ((wgid % nig) % gsz); u.pn = (wgid % nig) / gsz; return true;
    }
    __device__ __forceinline__ void a_ready(const Unit&) const {}
    __device__ __forceinline__ void done(const Unit&) const {}
};

typedef float f32x2cv __attribute__((ext_vector_type(2))); typedef __bf16 bf16x2cv __attribute__((ext_vector_type(2)));
__device__ __forceinline__ unsigned cvt_pk_bf16(float lo, float hi) { const f32x2cv v = {lo, hi}; return __builtin_bit_cast(unsigned, __builtin_convertvector(v, bf16x2cv)); }
template <class Epi, class Sched, bool ALIGN_EPI = false, bool SP2 = false>
__device__ __forceinline__ void gemm_phase(PG8_LAS unsigned char* lds, const Gemm g, const Sched& S, const Epi& E, const int wave_id) {
    int tid_ = (wave_id << 6) | hw_lane(); asm volatile("" : "+v"(tid_));
    const int tid = tid_, wid = __builtin_amdgcn_readfirstlane(tid >> 6), lane = tid & 63, wr = wid >> 2, wc = wid & 3, fr = lane & 15, fq = lane >> 4;
    const int K = g.K, nt = K / BK;
    unsigned voffA[2], voffB[2];
#pragma unroll
    for (int i = 0; i < 2; ++i) { int R, C; stage_rc(tid * 16 + i * 8192, R, C); const int Rb = Epi::PERM ? ((R & ~31) + perm32(R & 31)) : R;
        voffA[i] = (unsigned)(R * K + C) * 2u; voffB[i] = (unsigned)(Rb * K + C) * 2u; }
    const size_t kstep = (size_t)(BK * 2);
    const size_t hstep = (size_t)HALF * K * 2;
    const size_t tstep = 2 * hstep;
    const unsigned ldsw = (unsigned)wid * 1024u;
    const int aoff = lds_byte(wr * 64 + fr, fq * 8), boff = lds_byte(wc * 32 + fr, fq * 8);
#define PG8_SA(b, h) (((b) * 2 + (h)) * HTB)
#define PG8_SB(b, h) ((4 + (b) * 2 + (h)) * HTB)
#define PG8_STAGE(bufoff, gbase, voff) do { _Pragma("unroll") for (int _i = 0; _i < 2; ++_i) \
        __builtin_amdgcn_global_load_lds((const unsigned*)((const char*)(gbase) + (voff)[_i]), (PG8_LAS unsigned*)(lds + (bufoff) + ldsw + _i * 8192), 16, 0, 0); } while (0)
#define PG8_LDA(dst, b, h) do { _Pragma("unroll") for (int m = 0; m < 4; ++m) _Pragma("unroll") for (int k = 0; k < 2; ++k) dst[m][k] = *(const PG8_LAS bf16x8*)(lds + PG8_SA(b, h) + aoff + m * 2048 + k * 1024); } while (0)
#define PG8_LDB(dst, b, h) do { _Pragma("unroll") for (int n = 0; n < 2; ++n) _Pragma("unroll") for (int k = 0; k < 2; ++k) dst[n][k] = *(const PG8_LAS bf16x8*)(lds + PG8_SB(b, h) + boff + n * 2048 + k * 1024); } while (0)
#define PG8_MMA(ai, bj, At, Bt) do { __builtin_amdgcn_s_setprio(1); _Pragma("unroll") for (int m = 0; m < 4; ++m) _Pragma("unroll") for (int n = 0; n < 2; ++n) _Pragma("unroll") for (int k = 0; k < 2; ++k) \
        acc[ai][bj][m][n] = __builtin_amdgcn_mfma_f32_16x16x32_bf16(Bt[n][k], At[m][k], acc[ai][bj][m][n], 0, 0, 0); __builtin_amdgcn_s_setprio(0); } while (0)
#define PG8_WAIT_V(n) asm volatile("s_waitcnt vmcnt(" #n ")" ::: "memory")
#define PG8_WAIT_L(n) asm volatile("s_waitcnt lgkmcnt(" #n ")" ::: "memory")
#define PG8_BAR __builtin_amdgcn_s_barrier()
#define PG8_SCHED __builtin_amdgcn_sched_barrier(0)
    Unit cur, nxt; int ui = 0;
    if (!S.next(0, cur)) return;
    f32x4 acc[2][2][4][2];
#pragma unroll
    for (int a = 0; a < 2; ++a)
#pragma unroll
        for (int b = 0; b < 2; ++b)
#pragma unroll
            for (int m = 0; m < 4; ++m)
#pragma unroll
                for (int n = 0; n < 2; ++n) acc[a][b][m][n] = (f32x4){0.f, 0.f, 0.f, 0.f};
    bf16x8 At[4][2], B0[2][2], B1[2][2];
    const char* cA = (const char*)g.A + (size_t)cur.pm * tstep; const char* cB = (const char*)g.Bt + (size_t)cur.pn * tstep;
    S.a_ready(cur);
    if constexpr (SP2) {
        PG8_STAGE(PG8_SB(0, 0), cB, voffB); PG8_STAGE(PG8_SB(0, 1), cB + hstep, voffB); PG8_STAGE(PG8_SA(0, 0), cA, voffA); PG8_STAGE(PG8_SA(0, 1), cA + hstep, voffA);
        if (wr == 1) PG8_BAR;
        PG8_WAIT_V(2); PG8_BAR;
        PG8_STAGE(PG8_SB(1, 0), cB + kstep, voffB); PG8_STAGE(PG8_SA(1, 0), cA + kstep, voffA); PG8_STAGE(PG8_SB(1, 1), cB + hstep + kstep, voffB);
        PG8_WAIT_V(6); PG8_BAR;
    } else {
        PG8_STAGE(PG8_SB(0, 0), cB, voffB); PG8_STAGE(PG8_SA(0, 0), cA, voffA); PG8_STAGE(PG8_SB(0, 1), cB + hstep, voffB); PG8_STAGE(PG8_SA(0, 1), cA + hstep, voffA);
        if (wr == 1) PG8_BAR;
        PG8_WAIT_V(4); PG8_BAR;
        PG8_STAGE(PG8_SB(1, 0), cB + kstep, voffB); PG8_STAGE(PG8_SA(1, 0), cA + kstep, voffA); PG8_STAGE(PG8_SB(1, 1), cB + hstep + kstep, voffB);
        PG8_WAIT_V(6); PG8_BAR;
    }
    for (;;) {
        const bool has_next = S.next(ui + 1, nxt);
        const char* nA = has_next ? (const char*)g.A + (size_t)nxt.pm * tstep : cA; const char* nB = has_next ? (const char*)g.Bt + (size_t)nxt.pn * tstep : cB;
        for (int t = 0; t < nt; t += 2) {
            const bool last = (t == nt - 2);
            const char* a1 = cA + (size_t)(t + 1) * kstep;
            const char* a2 = last ? nA : cA + (size_t)(t + 2) * kstep; const char* b2 = last ? nB : cB + (size_t)(t + 2) * kstep;
            const char* a3 = a2 + kstep; const char* b3 = b2 + kstep;
            if (last && has_next) S.a_ready(nxt);
            if constexpr (SP2) {
            PG8_LDB(B0, 0, 0); PG8_LDB(B1, 0, 1); PG8_SCHED; PG8_LDA(At, 0, 0); PG8_STAGE(PG8_SA(1, 1), a1 + hstep, voffA);
            PG8_WAIT_V(8); PG8_WAIT_L(0); PG8_BAR; PG8_MMA(0, 0, At, B0); PG8_MMA(0, 1, At, B1); PG8_BAR; PG8_SCHED;
            PG8_LDA(At, 0, 1); PG8_STAGE(PG8_SB(0, 0), b2, voffB); PG8_STAGE(PG8_SB(0, 1), b2 + hstep, voffB); PG8_STAGE(PG8_SA(0, 0), a2, voffA);
            PG8_WAIT_V(8); PG8_WAIT_L(0); PG8_BAR; PG8_MMA(1, 0, At, B0); PG8_MMA(1, 1, At, B1); PG8_BAR; PG8_SCHED;
            PG8_LDB(B0, 1, 0); PG8_LDB(B1, 1, 1); PG8_SCHED; PG8_LDA(At, 1, 0); PG8_STAGE(PG8_SA(0, 1), a2 + hstep, voffA);
            PG8_WAIT_V(8); PG8_WAIT_L(0); PG8_BAR; PG8_MMA(0, 0, At, B0); PG8_MMA(0, 1, At, B1); PG8_BAR; PG8_SCHED;
            PG8_LDA(At, 1, 1); PG8_STAGE(PG8_SB(1, 0), b3, voffB); PG8_STAGE(PG8_SB(1, 1), b3 + hstep, voffB); PG8_STAGE(PG8_SA(1, 0), a3, voffA);
            PG8_WAIT_V(8); PG8_WAIT_L(0); PG8_BAR; PG8_MMA(1, 0, At, B0); PG8_MMA(1, 1, At, B1); PG8_BAR; PG8_SCHED;
            } else {
            PG8_LDB(B0, 0, 0); PG8_SCHED; PG8_LDA(At, 0, 0); PG8_STAGE(PG8_SA(1, 1), a1 + hstep, voffA);
            PG8_WAIT_L(8); PG8_BAR; PG8_WAIT_L(0); PG8_MMA(0, 0, At, B0); PG8_BAR; PG8_SCHED;
            PG8_LDB(B1, 0, 1); PG8_STAGE(PG8_SB(0, 0), b2, voffB);
            PG8_BAR; PG8_WAIT_L(0); PG8_MMA(0, 1, At, B1); PG8_BAR;
            PG8_LDA(At, 0, 1); PG8_STAGE(PG8_SA(0, 0), a2, voffA);
            PG8_BAR; PG8_WAIT_L(0); PG8_MMA(1, 0, At, B0); PG8_BAR; PG8_SCHED;
            PG8_STAGE(PG8_SB(0, 1), b2 + hstep, voffB);
            PG8_WAIT_V(6); PG8_BAR; PG8_MMA(1, 1, At, B1); PG8_BAR;
            PG8_LDB(B0, 1, 0); PG8_SCHED; PG8_LDA(At, 1, 0); PG8_STAGE(PG8_SA(0, 1), a2 + hstep, voffA);
            PG8_WAIT_L(8); PG8_BAR; PG8_WAIT_L(0); PG8_MMA(0, 0, At, B0); PG8_BAR; PG8_SCHED;
            PG8_LDB(B1, 1, 1); PG8_STAGE(PG8_SB(1, 0), b3, voffB);
            PG8_BAR; PG8_WAIT_L(0); PG8_MMA(0, 1, At, B1); PG8_BAR;
            PG8_LDA(At, 1, 1); PG8_STAGE(PG8_SA(1, 0), a3, voffA);
            PG8_BAR; PG8_WAIT_L(0); PG8_MMA(1, 0, At, B0); PG8_BAR; PG8_SCHED;
            PG8_STAGE(PG8_SB(1, 1), b3 + hstep, voffB);
            PG8_WAIT_V(6); PG8_BAR; PG8_MMA(1, 1, At, B1); PG8_BAR;
            }
        }
        if constexpr (ALIGN_EPI) { if (wr == 0) PG8_BAR; }
        if constexpr (!Epi::AFTER_DRAIN) { for (int rep_ = 0; rep_ < 1 + (Epi::REP_EPI ? 1 : 0); ++rep_) E(acc, cur, wr, wc, fr, fq); S.done(cur); }
        if (!has_next) break;
#pragma unroll
        for (int a = 0; a < 2; ++a)
#pragma unroll
            for (int b = 0; b < 2; ++b)
#pragma unroll
                for (int m = 0; m < 4; ++m)
#pragma unroll
                    for (int n = 0; n < 2; ++n) acc[a][b][m][n] = (f32x4){0.f, 0.f, 0.f, 0.f};
        cur = nxt; cA = nA; cB = nB; ++ui;
        if constexpr (ALIGN_EPI) { if (wr == 1) PG8_BAR; }
    }
    PG8_WAIT_V(0);
    if constexpr (!ALIGN_EPI) { if (wr == 0) PG8_BAR; }
    PG8_BAR;
    if constexpr (Epi::AFTER_DRAIN) { E.fused(acc, cur, wr, wc, fr, fq, lds, wid, lane); S.done(cur); }
#undef PG8_SA
#undef PG8_SB
#undef PG8_STAGE
#undef PG8_LDA
#undef PG8_LDB
#undef PG8_MMA
#undef PG8_WAIT_V
#undef PG8_WAIT_L
#undef PG8_BAR
#undef PG8_SCHED
}
}

using pg8::bf16_t; using pg8::bf16x8; using pg8::f32x4; using pg8::u32x4; using pg8::Unit; using pg8::cvt_pk_bf16;
#define GAS __attribute__((address_space(1)))
#define LAS __attribute__((address_space(3)))
typedef unsigned u32x2 __attribute__((ext_vector_type(2)));
typedef short s16x4 __attribute__((ext_vector_type(4)));
typedef GAS unsigned gu32;
#define RLX_AGENT __ATOMIC_RELAXED, __HIP_MEMORY_SCOPE_AGENT

constexpr int NWAVES = 8;
constexpr int D = 1024, MP = 16384, MS = 128, SEQ = 2048, NBATCH = 8, NMEM = 256, MMEM = 2048, DEPTH = 4;
constexpr int NAB = 5120, NC = 8192;
constexpr float EPS = 1e-6f;
constexpr float QSCALE = 0.0625f * 1.4426950408889634f;

constexpr size_t O_Y = 0, O_YS = O_Y + (size_t)MP * D, O_POOLP = O_YS + (size_t)MS * D, O_POOLS = O_POOLP + 2 * 8 * 15 * 1024,
                 O_CONVP = O_POOLS + (size_t)2 * 128 * 15 * 1024, O_CONVS = O_CONVP + 2 * 8 * 2 * 2048, O_SGUV = O_CONVS + (size_t)2 * 128 * 2 * 2048,
                 O_MEMK = O_SGUV + 2 * 128 * 1024, O_MEMV = O_MEMK + (size_t)4 * MMEM * D, O_END = O_MEMV + (size_t)4 * MMEM * D;
static_assert(O_END == 39239680, "output size");

constexpr size_t MiB = 1u << 20;
constexpr size_t WS_CTL = 0, CTL_ZERO_BYTES = 1 * MiB;
constexpr size_t WS_AB1 = 2 * MiB, WS_C1 = 22 * MiB, WS_AB2 = 54 * MiB, WS_C2 = 62 * MiB, WS_WQ = 70 * MiB, WS_WKV = 78 * MiB, WS_WO = 94 * MiB, WS_PMT = 102 * MiB;
constexpr size_t WS_XB = 104 * MiB;
constexpr size_t WS_RSQ = 137 * MiB, WS_VSQ = 138 * MiB;
constexpr size_t WS_SMALL = 139 * MiB;
constexpr size_t WS_Z = 140 * MiB;
constexpr size_t WS_A2 = 268 * MiB;
constexpr size_t WS_Q = 332 * MiB, WS_O = WS_Q;
constexpr size_t WS_MEMB = 396 * MiB, WS_KB = 400 * MiB, WS_VB = 416 * MiB;
constexpr size_t WS_XS = 432 * MiB, WS_SZ = 433 * MiB, WS_SA2 = 437 * MiB, WS_SQ = 438 * MiB, WS_SO = 439 * MiB, WS_SIDE = 440 * MiB  , WS_END = 444 * MiB;
constexpr int CW_BAR = 4096, CW_RANK = 8192;

constexpr int RING_BYTES = 131072, LDSCTL_OFF = RING_BYTES, MISC_OFF = LDSCTL_OFF + 320, HALO_OFF = RING_BYTES + 1024  , RSTD_OFF = HALO_OFF + 8192  , CWL_OFF = RSTD_OFF + 1024  , LDS_BYTES = 155648;

#define LDS_WAIT() asm volatile("s_waitcnt lgkmcnt(0)" ::: "memory")
#define LDS_BARRIER() asm volatile("s_waitcnt lgkmcnt(0)\n\ts_barrier" ::: "memory")

#define XB_TMO      128
#define XB_XCNT(j)  (256  + 64 * (j))
#define XB_XSUB(j)  (1280 + 64 * (j))
#define XB_XGEN(j)  (2304 + 64 * (j))
#define XB_TOP      3328
#define XB_TOPGEN   3392
#define XCD_BAR_WORDS 3456
#define XB_SPIN_CAP (1u << 18)

__device__ __forceinline__ unsigned xb_ld(unsigned* p)              { return __hip_atomic_load(p, __ATOMIC_RELAXED, __HIP_MEMORY_SCOPE_AGENT); }
__device__ __forceinline__ unsigned xb_add(unsigned* p, unsigned v) { return __hip_atomic_fetch_add(p, v, __ATOMIC_RELAXED, __HIP_MEMORY_SCOPE_AGENT); }
__device__ __forceinline__ unsigned xb_xcc_id() { return (unsigned)__builtin_amdgcn_s_getreg((3 << 11) | 20) & 0xFu; }
#define XB_SPIN(cond, bar) do { unsigned _sp = 0; while (cond) { __builtin_amdgcn_s_sleep(1); \
    if ((++_sp & 255u) == 0u) { if (xb_ld(&(bar)[XB_TMO])) break; if (_sp > XB_SPIN_CAP) { atomicAdd(&(bar)[XB_TMO], 1u); break; } } } } while (0)

struct XcdBarrier {
    int wave;
    unsigned* bar; unsigned x;
    volatile LAS unsigned* st;
};

__device__ __forceinline__ XcdBarrier xcd_barrier_post(unsigned* bar, volatile LAS unsigned* st, int wave) {
    XcdBarrier b; b.wave = wave; b.bar = bar; b.x = xb_xcc_id(); b.st = st;
    if (b.wave == 0 && hw_lane() == 0) (void)xb_add(&bar[XB_XCNT(b.x)], 1u);
    return b;
}
__device__ __forceinline__ void xcd_barrier_complete(unsigned* bar, unsigned x, unsigned& nloc, unsigned& nx) {
    const unsigned G = gridDim.x * gridDim.y * gridDim.z;
    unsigned sum, cnt, mine, sp = 0u;
    for (;;) {
        sum = 0u; cnt = 0u; mine = 0u;
#pragma unroll
        for (unsigned j = 0; j < 16; ++j) { const unsigned c = xb_ld(&bar[XB_XCNT(j)]); sum += c; cnt += (c > 0u) ? 1u : 0u; mine = (j == x) ? c : mine; }
        if (sum == G) break;
        __builtin_amdgcn_s_sleep(1);
        if ((++sp & 255u) == 0u) { if (xb_ld(&bar[XB_TMO])) break; if (sp > XB_SPIN_CAP) { atomicAdd(&bar[XB_TMO], 1u); break; } }
    }
    nloc = mine > 0u ? mine : 1u; nx = cnt > 0u ? cnt : 1u;
}

__device__ __forceinline__ void xcd_barrier(const XcdBarrier& b) {
    asm volatile("s_waitcnt vmcnt(0)" ::: "memory");
    __syncthreads();
    if (b.wave == 0 && hw_lane() == 0) {
        unsigned* bar = b.bar;
        __builtin_amdgcn_s_waitcnt(0);
        unsigned nloc = b.st[0], nx = b.st[1];
        if (nloc == 0u) { xcd_barrier_complete(bar, b.x, nloc, nx); b.st[0] = nloc; b.st[1] = nx; }
        const unsigned old = xb_add(&bar[XB_XSUB(b.x)], 1u);
        const unsigned gen = old / nloc;
        if (old + 1u == (gen + 1u) * nloc) {
            __builtin_amdgcn_fence(__ATOMIC_RELEASE, "agent");
            asm volatile("s_waitcnt vmcnt(0)" ::: "memory");
            const unsigned og = xb_add(&bar[XB_TOP], 1u);
            const unsigned tg = og / nx;
            if (og + 1u == (tg + 1u) * nx) xb_add(&bar[XB_TOPGEN], 1u);
            else XB_SPIN(xb_ld(&bar[XB_TOPGEN]) == tg, bar);
            __builtin_amdgcn_fence(__ATOMIC_ACQUIRE, "agent");
            xb_add(&bar[XB_XGEN(b.x)], 1u);
            asm volatile("s_waitcnt vmcnt(0)" ::: "memory");
        } else {
            XB_SPIN(xb_ld(&bar[XB_XGEN(b.x)]) == gen, bar);
            __builtin_amdgcn_fence(__ATOMIC_ACQUIRE, "agent");
            asm volatile("s_waitcnt vmcnt(0)" ::: "memory");
        }
    }
    __syncthreads();
}

__device__ __forceinline__ void xcd_barrier_local(const XcdBarrier& b) {
    asm volatile("s_waitcnt vmcnt(0)" ::: "memory");
    __syncthreads();
    if (b.wave == 0 && hw_lane() == 0) {
        unsigned* bar = b.bar;
        __builtin_amdgcn_s_waitcnt(0);
        const unsigned nloc = b.st[0] ? b.st[0] : 1u;
        const unsigned old = xb_add(&bar[XB_XSUB(b.x)], 1u);
        const unsigned gen = old / nloc;
        if (old + 1u == (gen + 1u) * nloc) xb_add(&bar[XB_XGEN(b.x)], 1u);
        else XB_SPIN(xb_ld(&bar[XB_XGEN(b.x)]) == gen, bar);
        __builtin_amdgcn_fence(__ATOMIC_ACQUIRE, "agent");
        asm volatile("s_waitcnt vmcnt(0)" ::: "memory");
    }
    __syncthreads();
}

typedef const float* fptr_t;
typedef __attribute__((address_space(4))) const fptr_t* in_tab_t;
struct Frame {
    LAS unsigned char* lds;
    int tid, lane, wave, G, bx, vid, xq, rk, rw;
    in_tab_t in;
    float* out;
    unsigned char* ws;
};
__device__ __forceinline__ unsigned long long uni64(unsigned long long v) { const unsigned lo = __builtin_amdgcn_readfirstlane((unsigned)v), hi = __builtin_amdgcn_readfirstlane((unsigned)(v >> 32)); return ((unsigned long long)hi << 32) | lo; }
__device__ __forceinline__ Frame launder(const Frame& F0) {
    Frame F = F0;
    int wv_ = __builtin_amdgcn_readfirstlane(F0.wave);
    int ln_ = hw_lane();
    int g_ = __builtin_amdgcn_readfirstlane(F0.G), b_ = __builtin_amdgcn_readfirstlane(F0.bx), v_ = __builtin_amdgcn_readfirstlane(F0.vid);
    unsigned long long w_ = uni64((unsigned long long)F0.ws), o_ = uni64((unsigned long long)F0.out), i_ = uni64((unsigned long long)F0.in);
    asm volatile("" : "+v"(ln_), "+s"(wv_), "+s"(g_), "+s"(b_), "+s"(v_), "+s"(w_), "+s"(o_), "+s"(i_));
    F.tid = (wv_ << 6) | ln_; F.G = g_; F.bx = b_; F.vid = v_; F.xq = b_ & 7; F.rk = b_ >> 3; F.rw = (g_ - (b_ & 7) + 7) >> 3; F.ws = (unsigned char*)(GAS unsigned char*)w_; F.out = (float*)(GAS float*)o_; F.in = (in_tab_t)i_;
    F.lane = ln_; F.wave = wv_;
    return F;
}
#define FIN(k) ((const float*)(const GAS float*)(F.in[k]))


__device__ __forceinline__ float shx(float v, int mask, int lane) { return __builtin_bit_cast(float, __builtin_amdgcn_ds_bpermute((lane ^ mask) << 2, __builtin_bit_cast(int, v))); }
__device__ __forceinline__ float wave_sum(float v, int lane) {
#pragma unroll
    for (int o = 1; o < 64; o <<= 1) v += shx(v, o, lane);
    return v;
}
__device__ __forceinline__ float silu_f(float x) { return x * __builtin_amdgcn_rcpf(1.f + __builtin_amdgcn_exp2f(-1.4426950408889634f * x)); }
__device__ __forceinline__ f32x4 silu4(f32x4 v) { return (f32x4){silu_f(v[0]), silu_f(v[1]), silu_f(v[2]), silu_f(v[3])}; }
__device__ __forceinline__ float dot4(f32x4 a, f32x4 b) { return (a[0] * b[0] + a[1] * b[1]) + (a[2] * b[2] + a[3] * b[3]); }
__device__ __forceinline__ u32x4 pack8(f32x4 a, f32x4 b) { u32x4 w; w.x = cvt_pk_bf16(a[0], a[1]); w.y = cvt_pk_bf16(a[2], a[3]); w.z = cvt_pk_bf16(b[0], b[1]); w.w = cvt_pk_bf16(b[2], b[3]); return w; }
__device__ __forceinline__ u32x2 pack4(f32x4 a) { u32x2 w; w.x = cvt_pk_bf16(a[0], a[1]); w.y = cvt_pk_bf16(a[2], a[3]); return w; }
__device__ __forceinline__ float bflo(unsigned w) { return __uint_as_float(w << 16); }
__device__ __forceinline__ float bfhi(unsigned w) { return __uint_as_float(w & 0xffff0000u); }
__device__ __forceinline__ void unpack8(u32x4 w, f32x4& a, f32x4& b) { a = (f32x4){bflo(w.x), bfhi(w.x), bflo(w.y), bfhi(w.y)}; b = (f32x4){bflo(w.z), bfhi(w.z), bflo(w.w), bfhi(w.w)}; }
__device__ __forceinline__ f32x4 unpack4(u32x2 w) { return (f32x4){bflo(w.x), bfhi(w.x), bflo(w.y), bfhi(w.y)}; }
__device__ __forceinline__ float rstd16(const float* p) {
    const f32x4 a = ((const f32x4*)p)[0], b = ((const f32x4*)p)[1], c = ((const f32x4*)p)[2], d = ((const f32x4*)p)[3];
    const f32x4 s = (a + b) + (c + d);
    return rsqrtf(((s[0] + s[1]) + (s[2] + s[3])) * (1.0f / D) + EPS);
}
__device__ __forceinline__ float rstd32(const float* p) {
    f32x4 s = ((const f32x4*)p)[0];
#pragma unroll
    for (int i = 1; i < 8; ++i) s += ((const f32x4*)p)[i];
    return rsqrtf(((s[0] + s[1]) + (s[2] + s[3])) * (1.0f / D) + EPS);
}
__host__ __device__ __forceinline__ int src_even(int n) {
    const int tile = n >> 8, o = n & 255;
    if (tile < 8) return n;
    if (tile < 12) return 3072 + (n - 2048);
    const int cb = tile - 12;
    return o < 128 ? 2048 + 128 * cb + o : 4096 + 128 * cb + (o - 128);
}
__host__ __device__ __forceinline__ int src_odd(int n) {
    const int pn = n >> 8, p = n & 255, q = ((p >> 7) << 1) | ((p >> 2) & 1), ch = 64 * pn + 16 * ((p >> 5) & 3) + 4 * ((p >> 3) & 3) + (p & 3);
    const int base = q == 0 ? 2048 : (q == 1 ? 4096 : (q == 2 ? 0 : 6144));
    return base + ch;
}

__device__ __forceinline__ void rstd_table(const float* rsq, int pm, LAS float* tab, int tid) {
    if (tid < 256) tab[tid] = rstd16(rsq + ((size_t)pm * 256 + tid) * 16);
    LDS_BARRIER();
}
struct EpiG1Even {
    static constexpr bool PERM = true, AFTER_DRAIN = false, REP_EPI = (REP_MASK >> 12) & 1;
    const float* rsq; bf16_t* Z; float* vsq; float* pool_out; LAS const float* rtab; int pm0;
    __device__ __forceinline__ void operator()(const f32x4 (&acc)[2][2][4][2], const Unit& u, int wr, int wc, int fr_, int fq_) const {
        int fr = fr_, fq = fq_; asm volatile("" : "+v"(fr), "+v"(fq));
        const int tile = u.pn, cw = wc * 32 + 8 * fq;
#pragma unroll
        for (int ai = 0; ai < 2; ++ai)
#pragma unroll
            for (int m = 0; m < 4; ++m) {
                const int row = u.pm * 256 + ai * 128 + wr * 64 + m * 16 + fr;
                const float rs = u.pm == pm0 ? rtab[ai * 128 + wr * 64 + m * 16 + fr] : rstd16(rsq + (size_t)row * 16);
                if (tile < 12) {
                    const int kind = tile >> 2;
                    bf16_t* dst = Z + (size_t)kind * MP * D + (size_t)row * D + (tile & 3) * 256 + cw;
                    float ss = 0.f;
#pragma unroll
                    for (int bj = 0; bj < 2; ++bj) {
                        f32x4 v0 = acc[ai][bj][m][0] * rs, v1 = acc[ai][bj][m][1] * rs;
                        if (kind == 1) { v0 = silu4(v0); v1 = silu4(v1); }
                        if (kind == 2) ss += dot4(v0, v0) + dot4(v1, v1);
                        *(u32x4*)(dst + bj * 128) = pack8(v0, v1);
                        if (kind == 0 && (row & 2047) >= 2033) {
                            float* po = pool_out + ((size_t)(row >> 11) * 15 + ((row & 2047) - 2033)) * 1024 + (tile & 3) * 256 + bj * 128 + cw;
                            *(f32x4*)po = v0; *(f32x4*)(po + 4) = v1;
                        }
                    }
                    if (kind == 2) { ss += shx(ss, 16, 16 * fq + fr); ss += shx(ss, 32, 16 * fq + fr); if (fq == 0) vsq[(size_t)row * 16 + (tile - 8) * 4 + wc] = ss; }
                } else {
                    const int cb = tile - 12;
                    bf16_t* dst = Z + (size_t)3 * MP * D + (size_t)row * D + cb * 128 + cw;
                    const f32x4 u0 = acc[ai][0][m][0] * rs, u1 = acc[ai][0][m][1] * rs, g0 = acc[ai][1][m][0] * rs, g1 = acc[ai][1][m][1] * rs;
                    *(u32x4*)dst = pack8(u0 * silu4(g0), u1 * silu4(g1));
                }
            }
    }
};
__device__ __forceinline__ float dpp_shr1(float old, float v) { return __builtin_bit_cast(float, __builtin_amdgcn_update_dpp(__builtin_bit_cast(int, old), __builtin_bit_cast(int, v), 0x111, 0xf, 0xf, false)); }
__device__ __forceinline__ float dpp_shr2(float old, float v) { return __builtin_bit_cast(float, __builtin_amdgcn_update_dpp(__builtin_bit_cast(int, old), __builtin_bit_cast(int, v), 0x112, 0xf, 0xf, false)); }
struct EpiG1Odd {
    static constexpr bool PERM = true, AFTER_DRAIN = false, REP_EPI = false;
    const float* rsq; bf16_t* A2; const float* cw; float* conv_out; float* side; LAS float* halo; LAS const float* rtab; int pm0; LAS const float* cwl; int pn0;
    __device__ __forceinline__ void operator()(const f32x4 (&acc)[2][2][4][2], const Unit& u, int wr, int wc, int fr_, int fq_) const {
        int fr = fr_, fq = fq_; asm volatile("" : "+v"(fr), "+v"(fq));
        const int chl = wc * 16 + 4 * fq, ch = u.pn * 64 + chl;
        f32x4 w0, w1, w2;
        { const int ui = (u.pn - pn0) >> 2;
          if (u.pm == pm0 && ui >= 0 && ui < 8 && ((u.pn - pn0) & 3) == 0) { w0 = *(const LAS f32x4*)(cwl + (ui * 3 + 0) * 64 + chl); w1 = *(const LAS f32x4*)(cwl + (ui * 3 + 1) * 64 + chl); w2 = *(const LAS f32x4*)(cwl + (ui * 3 + 2) * 64 + chl); }
          else { w0 = *(const f32x4*)(cw + ch); w1 = *(const f32x4*)(cw + 2048 + ch); w2 = *(const f32x4*)(cw + 4096 + ch); } }
        f32x4 e[2][4]; float rsv[2][4];
#pragma unroll
        for (int ai = 0; ai < 2; ++ai)
#pragma unroll
            for (int m = 0; m < 4; ++m) {
                const int rb = 8 * ai + 4 * wr + m, row = u.pm * 256 + 16 * rb + fr;
                const float rs = u.pm == pm0 ? rtab[16 * rb + fr] : rstd16(rsq + (size_t)row * 16); rsv[ai][m] = rs;
                e[ai][m] = (acc[ai][0][m][0] * rs) * (acc[ai][0][m][1] * rs);
                if (fr >= 14) *(LAS f32x4*)(halo + (rb * 2 + (fr - 14)) * 64 + chl) = e[ai][m];
                if (m & 1) asm volatile("" ::: "memory");
            }
        asm volatile("s_waitcnt lgkmcnt(0)" ::: "memory"); __builtin_amdgcn_s_barrier(); asm volatile("" ::: "memory");
        float* sd = side + (size_t)u.pm * 6 * 2048 + ch;
#pragma unroll
        for (int ai = 0; ai < 2; ++ai)
#pragma unroll
            for (int m = 0; m < 4; ++m) {
                const int rb = 8 * ai + 4 * wr + m, row = u.pm * 256 + 16 * rb + fr;
                const float rs = rsv[ai][m];
                const f32x4 sg = (acc[ai][1][m][0] * rs) * silu4(acc[ai][1][m][1] * rs);
                f32x4 h0 = (f32x4){0.f, 0.f, 0.f, 0.f}, h1 = h0;
                if (rb > 0) { h0 = *(const LAS f32x4*)(halo + ((rb - 1) * 2 + 0) * 64 + chl); h1 = *(const LAS f32x4*)(halo + ((rb - 1) * 2 + 1) * 64 + chl); }
                const f32x4 hx = fr == 0 ? h0 : h1, ev = e[ai][m];
                f32x4 e1, e2;
#pragma unroll
                for (int k = 0; k < 4; ++k) { e1[k] = dpp_shr1(h1[k], ev[k]); e2[k] = dpp_shr2(hx[k], ev[k]); }
                const f32x4 a = sg * (w0 * e2 + w1 * e1 + w2 * ev);
                const bool top = (rb == 0 && fr < 2);
                if (!(top && (u.pm & 7) != 0)) *(u32x2*)(A2 + (size_t)row * 2048 + ch) = pack4(a);
                if (top) { *(f32x4*)(sd + fr * 2048) = ev; *(f32x4*)(sd + (4 + fr) * 2048) = sg; }
                if (rb == 15 && fr >= 14) {
                    *(f32x4*)(sd + (2 + fr - 14) * 2048) = ev;
                    if ((u.pm & 7) == 7) *(f32x4*)(conv_out + ((size_t)(u.pm >> 3) * 2 + (fr - 14)) * 2048 + ch) = ev;
                }
            }
    }
};
__device__ __forceinline__ void conv_fixup(const float* side, const float* cw, bf16_t* A2, int pm, int tid) {
    if ((pm & 7) == 0) return;
    const int ch = 4 * tid;
    const float* sp = side + (size_t)(pm - 1) * 6 * 2048 + ch; const float* sc = side + (size_t)pm * 6 * 2048 + ch;
    const f32x4 em2 = *(const f32x4*)(sp + 2 * 2048), em1 = *(const f32x4*)(sp + 3 * 2048), e0 = *(const f32x4*)sc, e1 = *(const f32x4*)(sc + 2048), s0 = *(const f32x4*)(sc + 4 * 2048), s1 = *(const f32x4*)(sc + 5 * 2048);
    const f32x4 w0 = *(const f32x4*)(cw + ch), w1 = *(const f32x4*)(cw + 2048 + ch), w2 = *(const f32x4*)(cw + 4096 + ch);
    *(u32x2*)(A2 + (size_t)(pm * 256) * 2048 + ch) = pack4(s0 * (w0 * em2 + w1 * em1 + w2 * e0));
    *(u32x2*)(A2 + (size_t)(pm * 256 + 1) * 2048 + ch) = pack4(s1 * (w0 * em1 + w1 * e0 + w2 * e1));
}
struct EpiRes {
    static constexpr bool PERM = true, AFTER_DRAIN = false, REP_EPI = false;
    bf16_t* xb; float* rsq;
    __device__ __forceinline__ void operator()(const f32x4 (&acc)[2][2][4][2], const Unit& u, int wr, int wc, int fr_, int fq_) const {
        int fr = fr_, fq = fq_; asm volatile("" : "+v"(fr), "+v"(fq));
        const int cw = wc * 32 + 8 * fq;
#pragma unroll
        for (int ai = 0; ai < 2; ++ai) {
            u32x4 old[4][2];
#pragma unroll
            for (int m = 0; m < 4; ++m)
#pragma unroll
                for (int bj = 0; bj < 2; ++bj) old[m][bj] = *(const u32x4*)(xb + (size_t)(u.pm * 256 + ai * 128 + wr * 64 + m * 16 + fr) * D + u.pn * 256 + bj * 128 + cw);
#pragma unroll
            for (int m = 0; m < 4; ++m) {
                const int row = u.pm * 256 + ai * 128 + wr * 64 + m * 16 + fr;
                float ss = 0.f;
#pragma unroll
                for (int bj = 0; bj < 2; ++bj) {
                    f32x4 b0, b1; unpack8(old[m][bj], b0, b1);
                    const u32x4 wv = pack8(b0 + acc[ai][bj][m][0], b1 + acc[ai][bj][m][1]);
                    *(u32x4*)(xb + (size_t)row * D + u.pn * 256 + bj * 128 + cw) = wv;
                    f32x4 r0, r1; unpack8(wv, r0, r1);
                    ss += dot4(r0, r0) + dot4(r1, r1);
                }
                ss += shx(ss, 16, 16 * fq + fr); ss += shx(ss, 32, 16 * fq + fr);
                if (fq == 0) rsq[(size_t)row * 16 + u.pn * 4 + wc] = ss;
            }
        }
    }
};
struct EpiProbe {
    static constexpr bool PERM = true, AFTER_DRAIN = false, REP_EPI = false;
    bf16_t* O; int ldc;
    __device__ __forceinline__ void operator()(const f32x4 (&acc)[2][2][4][2], const Unit& u, int wr, int wc, int fr_, int fq_) const {
        int fr = fr_, fq = fq_; asm volatile("" : "+v"(fr), "+v"(fq));
        const int cw = wc * 32 + 8 * fq;
#pragma unroll
        for (int ai = 0; ai < 2; ++ai)
#pragma unroll
            for (int m = 0; m < 4; ++m) {
                const int row = u.pm * 256 + ai * 128 + wr * 64 + m * 16 + fr;
#pragma unroll
                for (int bj = 0; bj < 2; ++bj) *(u32x4*)(O + (size_t)row * ldc + u.pn * 256 + bj * 128 + cw) = pack8(acc[ai][bj][m][0], acc[ai][bj][m][1]);
            }
    }
};
struct EpiQ {
    static constexpr bool PERM = true, AFTER_DRAIN = false, REP_EPI = false;
    const float* rsq; bf16_t* Q; LAS const float* rtab; int pm0;
    __device__ __forceinline__ void operator()(const f32x4 (&acc)[2][2][4][2], const Unit& u, int wr, int wc, int fr_, int fq_) const {
        int fr = fr_, fq = fq_; asm volatile("" : "+v"(fr), "+v"(fq));
        const int cw = wc * 32 + 8 * fq;
#pragma unroll
        for (int ai = 0; ai < 2; ++ai)
#pragma unroll
            for (int m = 0; m < 4; ++m) {
                const int row = u.pm * 256 + ai * 128 + wr * 64 + m * 16 + fr;
                const float rs = u.pm == pm0 ? rtab[ai * 128 + wr * 64 + m * 16 + fr] : rstd16(rsq + (size_t)row * 16);
#pragma unroll
                for (int bj = 0; bj < 2; ++bj) *(u32x4*)(Q + (size_t)row * D + u.pn * 256 + bj * 128 + cw) = pack8(acc[ai][bj][m][0] * rs, acc[ai][bj][m][1] * rs);
            }
    }
};
struct EpiMemKV {
    static constexpr bool PERM = true, AFTER_DRAIN = false, REP_EPI = false;
    const float* rstdm; float* outk; float* outv; bf16_t* kb; bf16_t* vb;
    __device__ __forceinline__ void operator()(const f32x4 (&acc)[2][2][4][2], const Unit& u, int wr, int wc, int fr_, int fq_) const {
        int fr = fr_, fq = fq_; asm volatile("" : "+v"(fr), "+v"(fq));
        const int layer = u.pn >> 3, isv = (u.pn >> 2) & 1, cw = (u.pn & 3) * 256 + wc * 32 + 8 * fq;
        float* of = (isv ? outv : outk) + (size_t)layer * MMEM * D; bf16_t* ob = (isv ? vb : kb) + (size_t)layer * MMEM * D;
#pragma unroll
        for (int ai = 0; ai < 2; ++ai)
#pragma unroll
            for (int m = 0; m < 4; ++m) {
                const int row = u.pm * 256 + ai * 128 + wr * 64 + m * 16 + fr;
                const float rs = rstdm[row];
#pragma unroll
                for (int bj = 0; bj < 2; ++bj) {
                    const size_t off = (size_t)row * D + bj * 128 + cw;
                    const f32x4 v0 = acc[ai][bj][m][0] * rs, v1 = acc[ai][bj][m][1] * rs;
                    *(f32x4*)(of + off) = v0; *(f32x4*)(of + off + 4) = v1;
                    *(u32x4*)(ob + off) = pack8(v0, v1);
                }
            }
    }
};

struct TrItem { const float* wp; int ldw; const float* gk; float sc; bf16_t* wt; int K; };
__device__ __forceinline__ void p0_tr_desc(const float* W, int ldw, int K, int Nd, const float* gk, float sc, bf16_t* WT, int perm, int r, int lane, TrItem& t) {
    const int nblk = Nd / 32, kb = r / nblk, nb = r % nblk, dstn0 = 32 * nb, dn = dstn0 + (lane & 31);
    const int srccol = perm == 0 ? dn : (perm == 1 ? src_even(dn) : src_odd(dn));
    t.wp = W + (size_t)(64 * kb + (lane >> 5)) * ldw + srccol; t.ldw = ldw; t.gk = gk ? gk + 64 * kb : nullptr; t.sc = sc; t.wt = WT + (size_t)dstn0 * K + 64 * kb; t.K = K;
}
__device__ __forceinline__ void p0_resolve(Frame& F, int it, int lane, TrItem& t) {
    constexpr int I_AB1 = 16 * (NAB / 32), I_C1 = 16 * (NC / 32), I_2 = 32 * 32, I_SQ = 16 * 32, I_PM = 4 * 8;
    int r = it;
    if (r < 2 * I_AB1) { const int jj = r / I_AB1; p0_tr_desc(FIN(10) + (size_t)jj * D * NAB, NAB, D, NAB, FIN(7) + 2 * jj * D, 1.f, ((bf16_t*)(F.ws + WS_AB1)) + (size_t)jj * NAB * D, 1, r % I_AB1, lane, t); return; } r -= 2 * I_AB1;
    if (r < 2 * I_C1) { const int jj = r / I_C1; p0_tr_desc(FIN(17) + (size_t)jj * D * NC, NC, D, NC, FIN(7) + (2 * jj + 1) * D, 1.f, ((bf16_t*)(F.ws + WS_C1)) + (size_t)jj * NC * D, 2, r % I_C1, lane, t); return; } r -= 2 * I_C1;
    if (r < 2 * I_2) { const int jj = r / I_2; p0_tr_desc(FIN(16) + (size_t)jj * 2048 * D, D, 2048, D, nullptr, 1.f, ((bf16_t*)(F.ws + WS_AB2)) + (size_t)jj * D * 2048, 0, r % I_2, lane, t); return; } r -= 2 * I_2;
    if (r < 2 * I_2) { const int jj = r / I_2; p0_tr_desc(FIN(19) + (size_t)jj * 2048 * D, D, 2048, D, nullptr, 1.f, ((bf16_t*)(F.ws + WS_C2)) + (size_t)jj * D * 2048, 0, r % I_2, lane, t); return; } r -= 2 * I_2;
    if (r < 4 * I_SQ) { const int l = r / I_SQ; p0_tr_desc(FIN(20) + (size_t)l * D * D, D, D, D, FIN(8) + l * D, QSCALE, ((bf16_t*)(F.ws + WS_WQ)) + (size_t)l * D * D, 0, r % I_SQ, lane, t); return; } r -= 4 * I_SQ;
    if (r < 4 * I_SQ) { const int l = r / I_SQ; p0_tr_desc(FIN(21) + (size_t)l * D * D, D, D, D, FIN(9) + l * D, 1.f, ((bf16_t*)(F.ws + WS_WKV)) + (size_t)(2 * l) * D * D, 0, r % I_SQ, lane, t); return; } r -= 4 * I_SQ;
    if (r < 4 * I_SQ) { const int l = r / I_SQ; p0_tr_desc(FIN(22) + (size_t)l * D * D, D, D, D, FIN(9) + l * D, 1.f, ((bf16_t*)(F.ws + WS_WKV)) + (size_t)(2 * l + 1) * D * D, 0, r % I_SQ, lane, t); return; } r -= 4 * I_SQ;
    if (r < 4 * I_SQ) { const int l = r / I_SQ; p0_tr_desc(FIN(23) + (size_t)l * D * D, D, D, D, nullptr, 1.f, ((bf16_t*)(F.ws + WS_WO)) + (size_t)l * D * D, 0, r % I_SQ, lane, t); return; } r -= 4 * I_SQ;
    { const int jg = r / I_PM; p0_tr_desc(FIN(11) + (size_t)jg * 65536, 256, 256, 256, nullptr, 1.f, ((bf16_t*)(F.ws + WS_PMT)) + (size_t)jg * 65536, 0, r % I_PM, lane, t); }
}
__device__ __forceinline__ void p0_tr_load(const TrItem& t, int lane, float (&v)[32], f32x4& g0, f32x4& g1) {
    const int c = lane & 7;
    g0 = (f32x4){t.sc, t.sc, t.sc, t.sc}; g1 = g0;
    if (t.gk) { g0 = *(const f32x4*)(t.gk + 8 * c) * t.sc; g1 = *(const f32x4*)(t.gk + 8 * c + 4) * t.sc; }
#pragma unroll
    for (int i = 0; i < 32; ++i) v[i] = t.wp[(size_t)(2 * i) * t.ldw];
}
__device__ __forceinline__ void p0_tr_finish(const TrItem& t, int lane, const float (&v)[32], f32x4 g0, f32x4 g1, LAS float* scr) {
#pragma unroll
    for (int i = 0; i < 32; ++i) scr[(2 * i + (lane >> 5)) * 33 + (lane & 31)] = v[i];
    LDS_WAIT(); asm volatile("" ::: "memory");
    const int c = lane & 7;
#pragma unroll
    for (int jj = 0; jj < 4; ++jj) {
        const int n = (lane >> 3) + 8 * jj; const LAS float* s = scr + (8 * c) * 33 + n;
        u32x4 o; o.x = cvt_pk_bf16(s[0 * 33] * g0[0], s[1 * 33] * g0[1]); o.y = cvt_pk_bf16(s[2 * 33] * g0[2], s[3 * 33] * g0[3]); o.z = cvt_pk_bf16(s[4 * 33] * g1[0], s[5 * 33] * g1[1]); o.w = cvt_pk_bf16(s[6 * 33] * g1[2], s[7 * 33] * g1[3]);
        *(u32x4*)(t.wt + (size_t)n * t.K + 8 * c) = o;
    }
    LDS_WAIT(); asm volatile("" ::: "memory");
}
__device__ __forceinline__ float p0_row_finish(const f32x4 (&v)[4], bf16_t* dst, float* copy, int lane) {
    float s = 0.f;
#pragma unroll
    for (int jj = 0; jj < 4; ++jj) s += dot4(v[jj], v[jj]);
    s = wave_sum(s, lane);
    u32x2* o8 = (u32x2*)dst + lane;
#pragma unroll
    for (int jj = 0; jj < 4; ++jj) o8[64 * jj] = pack4(v[jj]);
    if (copy) {
#pragma unroll
        for (int jj = 0; jj < 4; ++jj) ((f32x4*)copy + lane)[64 * jj] = v[jj];
    }
    return s;
}
namespace p0seg {
constexpr int I_AB1 = 16 * (NAB / 32), I_C1 = 16 * (NC / 32), I_2 = 32 * 32, I_SQ = 16 * 32, I_PM = 4 * 8;
constexpr int O_AB1 = 0, O_C1 = 2 * I_AB1, O_AB2 = O_C1 + 2 * I_C1, O_C2 = O_AB2 + 2 * I_2, O_Q = O_C2 + 2 * I_2, O_K = O_Q + 4 * I_SQ, O_V = O_K + 4 * I_SQ, O_O = O_V + 4 * I_SQ, O_P = O_O + 4 * I_SQ, NITEMS = O_P + 8 * I_PM;
constexpr int NA = I_AB1 + I_2 + I_SQ + 8 * I_SQ + I_SQ + 4 * I_PM, NB = NITEMS - NA;
__device__ __forceinline__ int item_a(int i) {
    if (i < I_AB1) return O_AB1 + i; i -= I_AB1;
    if (i < I_2) return O_AB2 + i; i -= I_2;
    if (i < I_SQ) return O_Q + i; i -= I_SQ;
    if (i < 8 * I_SQ) return O_K + i; i -= 8 * I_SQ;
    if (i < I_SQ) return O_O + i; i -= I_SQ;
    return O_P + i;
}
__device__ __forceinline__ int item_b(int i) {
    if (i < I_AB1) return O_AB1 + I_AB1 + i; i -= I_AB1;
    if (i < 2 * I_C1) return O_C1 + i; i -= 2 * I_C1;
    if (i < I_2) return O_AB2 + I_2 + i; i -= I_2;
    if (i < 2 * I_2) return O_C2 + i; i -= 2 * I_2;
    if (i < 3 * I_SQ) return O_Q + I_SQ + i; i -= 3 * I_SQ;
    if (i < 3 * I_SQ) return O_O + I_SQ + i; i -= 3 * I_SQ;
    return O_P + 4 * I_PM + i;
}
}
__device__ __forceinline__ void p0_weights(Frame& F0, int part, int gw, int NGW, int half = -1) {
    Frame F = launder(F0);
    LAS float* scr = (LAS float*)(F.lds + F.wave * 16384);
    const int lane = F.lane;
    constexpr int NB_ODD = (int)((long)p0seg::NB * PB_ODD_PCT / 100);
    const int base = (part == 1 && half == 0) ? NB_ODD : 0;
    const int n = part == 0 ? p0seg::NA : (part == 1 ? (half == 1 ? NB_ODD : (half == 0 ? p0seg::NB - NB_ODD : p0seg::NB)) : p0seg::NITEMS);
#define P0_ITEM(i_) (part == 0 ? p0seg::item_a(i_) : (part == 1 ? p0seg::item_b(base + (i_)) : (i_)))
    if (gw < n) {
        TrItem cur, nxt; float va[32], vb[32]; f32x4 ga0, ga1, gb0, gb1;
        p0_resolve(F, P0_ITEM(gw), lane, cur); p0_tr_load(cur, lane, va, ga0, ga1);
        for (int it = gw; it < n; it += 2 * NGW) {
            const bool h1 = it + NGW < n, h2 = it + 2 * NGW < n;
            if (h1) { p0_resolve(F, P0_ITEM(it + NGW), lane, nxt); p0_tr_load(nxt, lane, vb, gb0, gb1); }
            p0_tr_finish(cur, lane, va, ga0, ga1, scr);
            if (h2) { p0_resolve(F, P0_ITEM(it + 2 * NGW), lane, cur); p0_tr_load(cur, lane, va, ga0, ga1); }
            if (h1) p0_tr_finish(nxt, lane, vb, gb0, gb1, scr);
        }
    }
#undef P0_ITEM
}
__device__ __forceinline__ void p0_prologue(Frame& F0) {
    Frame F = launder(F0);
    const int gw = F.bx * NWAVES + F.wave, NGW = F.G * NWAVES, lane = F.lane;
    p0_weights(F0, (!MK_SPLIT && SPLIT_PROLOGUE) ? 0 : 2, gw, NGW);
    for (int m0 = 2 * gw; m0 < MP + MS + MMEM; m0 += 2 * NGW) {
        f32x4 v[2][4];
#pragma unroll
        for (int r = 0; r < 2; ++r) {
            const int m = m0 + r;
            const float* src = m < MP ? FIN(0) + (size_t)m * D : (m < MP + MS ? FIN(1) + (size_t)(m - MP) * D : FIN(2) + (size_t)(m - MP - MS) * D);
#pragma unroll
            for (int jj = 0; jj < 4; ++jj) v[r][jj] = ((const f32x4*)src + lane)[64 * jj];
        }
#pragma unroll
        for (int r = 0; r < 2; ++r) {
            const int m = m0 + r;
            if (m < MP) {
                const float s = p0_row_finish(v[r], ((bf16_t*)(F.ws + WS_XB)) + (size_t)m * D, nullptr, lane);
                if (lane < 16) ((float*)(F.ws + WS_RSQ))[(size_t)m * 16 + lane] = lane == 0 ? s : 0.f;
            } else if (m < MP + MS) {
                const int b = m - MP;
                const float s = p0_row_finish(v[r], ((bf16_t*)(F.ws + WS_XB)) + (size_t)m * D, ((float*)(F.ws + WS_XS)) + (size_t)b * D, lane);
                if (lane < 32) ((float*)(F.ws + WS_SMALL))[b * 32 + lane] = lane == 0 ? s : 0.f;
            } else {
                const int t = m - MP - MS;
                const float s = p0_row_finish(v[r], ((bf16_t*)(F.ws + WS_MEMB)) + (size_t)t * D, nullptr, lane);
                if (lane == 0) ((float*)(F.ws + WS_SMALL + 65536))[t] = rsqrtf(s * (1.0f / D) + EPS);
            }
        }
    }
}

__device__ __forceinline__ bf16x8 tr_frag(LAS unsigned char* p0, LAS unsigned char* p1) {
    const s16x4 lo = __builtin_amdgcn_ds_read_tr16_b64_v4i16((LAS s16x4*)p0);
    const s16x4 hi = __builtin_amdgcn_ds_read_tr16_b64_v4i16((LAS s16x4*)p1);
    return (bf16x8){lo[0], lo[1], lo[2], lo[3], hi[0], hi[1], hi[2], hi[3]};
}
#define MFMA16(a, b, c) __builtin_amdgcn_mfma_f32_16x16x32_bf16((a), (b), (c), 0, 0, 0)

constexpr int SGU_AS = 0, SGU_VS = 36864, SGU_RV = 36864 + 69632;
struct NoHook { __device__ __forceinline__ void operator()() const {} };
template <class Hook> __device__ __forceinline__ void sgu_chunk(Frame& F0, int j, int n, const int g0, const int g1, const Hook& hook) {
    Frame F = launder(F0);
    LAS unsigned char* lds = F.lds;
    const int tid = F.tid, lane = F.lane, w = F.wave, fr = lane & 15, fq = lane >> 4, row0 = n * 128;
    LAS float* rvs = (LAS float*)(lds + SGU_RV);
    if (tid < 128) rvs[tid] = rstd16(((float*)(F.ws + WS_VSQ)) + (size_t)(row0 + tid) * 16);
    const bf16_t* ZV = ((bf16_t*)(F.ws + WS_Z)) + (size_t)2 * MP * D + (size_t)row0 * D;
    const bf16_t* ZUG = ((bf16_t*)(F.ws + WS_Z)) + (size_t)3 * MP * D + (size_t)row0 * D;
    bf16_t* A2 = ((bf16_t*)(F.ws + WS_A2)) + (size_t)row0 * 2048 + 1024;
    const unsigned voff = (unsigned)(tid >> 5) * (D * 2) + (unsigned)(tid & 31) * 16u;
    const unsigned woff = (unsigned)(tid >> 4) * 512u + (unsigned)(tid & 15) * 32u;
    const int wt_t = tid >> 4, wt_s0 = (tid & 15) * 8;
    const unsigned aoff = (unsigned)(tid >> 5) * 4096u + (unsigned)(tid & 31) * 16u;
    u32x4 vt[8]; f32x4 wt[8];
#define SGU_LOAD(g_) do { const char* vb_ = (const char*)(ZV + (g_) * 256); const char* wb_ = (const char*)(FIN(13) + (size_t)(j * 4 + (g_)) * 16384); \
        _Pragma("unroll") for (int i_ = 0; i_ < 8; ++i_) vt[i_] = *(const u32x4*)(vb_ + (size_t)(16 * i_) * D * 2 + voff); \
        _Pragma("unroll") for (int i_ = 0; i_ < 4; ++i_) { wt[2 * i_] = *(const f32x4*)(wb_ + (size_t)(32 * i_) * 512 + woff); wt[2 * i_ + 1] = *(const f32x4*)(wb_ + (size_t)(32 * i_) * 512 + woff + 16); } } while (0)
    SGU_LOAD(g0);
    LDS_BARRIER();
#pragma unroll
    for (int g = g0; g < g1; ++g) {
#pragma unroll
        for (int i = 0; i < 8; ++i) *(LAS u32x4*)(lds + SGU_VS + ((tid >> 5) + 16 * i) * 544 + (tid & 31) * 16) = vt[i];
#pragma unroll
        for (int i = 0; i < 4; ++i) {
            const int t = wt_t + 32 * i; float v[8];
#pragma unroll
            for (int e = 0; e < 4; ++e) { v[e] = (wt_s0 + e <= t) ? wt[2 * i][e] * rvs[wt_s0 + e] : 0.f; v[4 + e] = (wt_s0 + 4 + e <= t) ? wt[2 * i + 1][e] * rvs[wt_s0 + 4 + e] : 0.f; }
            u32x4 o; o.x = cvt_pk_bf16(v[0], v[1]); o.y = cvt_pk_bf16(v[2], v[3]); o.z = cvt_pk_bf16(v[4], v[5]); o.w = cvt_pk_bf16(v[6], v[7]);
            *(LAS u32x4*)(lds + SGU_AS + t * 288 + wt_s0 * 2) = o;
        }
        LDS_BARRIER();
        const int cg = g * 256 + 32 * w + 4 * fq;
        const unsigned lo_in = (unsigned)fr * (D * 2) + (unsigned)(32 * w + 4 * fq) * 2u, lo_out = (unsigned)fr * 4096u + (unsigned)(32 * w + 4 * fq) * 2u;
        u32x2 ugr[2][8];
#pragma unroll
        for (int nt = 0; nt < 2; ++nt)
#pragma unroll
            for (int mt = 0; mt < 8; ++mt) ugr[nt][mt] = *(const u32x2*)((const char*)(ZUG + (size_t)(16 * mt) * D + g * 256 + 16 * nt) + lo_in);
        f32x4 ggv[2]; float bbv[8];
#pragma unroll
        for (int nt = 0; nt < 2; ++nt) ggv[nt] = *(const f32x4*)(FIN(15) + j * 1024 + cg + 16 * nt);
#pragma unroll
        for (int mt = 0; mt < 8; ++mt) bbv[mt] = FIN(14)[(j * 4 + g) * 128 + 16 * mt + fr];
        if (g + 1 < g1) SGU_LOAD(g + 1); else hook();
        f32x4 acc[8][2];
#pragma unroll
        for (int mt = 0; mt < 8; ++mt) { acc[mt][0] = (f32x4){0.f, 0.f, 0.f, 0.f}; acc[mt][1] = (f32x4){0.f, 0.f, 0.f, 0.f}; }
#pragma unroll
        for (int ks = 0; ks < 4; ++ks) {
            bf16x8 Bf[2];
#pragma unroll
            for (int nt = 0; nt < 2; ++nt) {
                LAS unsigned char* p = lds + SGU_VS + (32 * ks + 8 * fq + (fr >> 2)) * 544 + (32 * w + 16 * nt + 4 * (fr & 3)) * 2;
                Bf[nt] = tr_frag(p, p + 4 * 544);
            }
            bf16x8 Af[8];
#pragma unroll
            for (int mt = 0; mt < 8; ++mt) if (32 * ks <= 16 * mt + 15) Af[mt] = *(LAS bf16x8*)(lds + SGU_AS + (16 * mt + fr) * 288 + (32 * ks + 8 * fq) * 2);
#pragma unroll
            for (int mt = 0; mt < 8; ++mt) if (32 * ks <= 16 * mt + 15) { acc[mt][0] = MFMA16(Bf[0], Af[mt], acc[mt][0]); acc[mt][1] = MFMA16(Bf[1], Af[mt], acc[mt][1]); }
        }
#pragma unroll
        for (int nt = 0; nt < 2; ++nt) {
            const int c = cg + 16 * nt;
            const f32x4 gg = ggv[nt];
#pragma unroll
            for (int mt = 0; mt < 8; ++mt) {
                const int t = 16 * mt + fr;
                const float bb = bbv[mt];
                *(u32x2*)((char*)(A2 + (size_t)(16 * mt) * 2048 + g * 256 + 16 * nt) + lo_out) = pack4(unpack4(ugr[nt][mt]) * (acc[mt][nt] * gg + bb));
            }
        }
        LDS_BARRIER();
    }
#undef SGU_LOAD
}
constexpr int POOL_AP = 15 * 544;
__device__ __forceinline__ void pool_fetch(const bf16_t* xau  , int tid, int posc  , u32x4 (&own)[8], u32x4& halo) {
    asm volatile("" : "+v"(tid));
    const int cb = tid & 31, hr = tid >> 5;
    const char* base = (const char*)xau + (unsigned)((hr * 8) * D + cb * 8) * 2u;
#pragma unroll
    for (int r = 0; r < 8; ++r) own[r] = *(const u32x4*)(base + (size_t)r * D * 2);
    halo = (u32x4){0u, 0u, 0u, 0u};
    if (hr < 15 && posc > 0) halo = *(const u32x4*)((const char*)(xau + (ptrdiff_t)(hr - 15) * D) + cb * 16);
}
template <int WIN> __device__ __forceinline__ void pool_stage(const u32x4 (&own)[8], const u32x4& halo, LAS unsigned char* lds, int tid, int pos0) {
    const int cb = tid & 31, hr = tid >> 5;
    LAS unsigned char* rawp = lds + (15 + hr * 8) * 544 + cb * 16;
#pragma unroll
    for (int r = 0; r < 8; ++r) *(LAS u32x4*)(rawp + r * 544) = own[r];
    if (hr < 15) *(LAS u32x4*)(lds + hr * 544 + cb * 16) = halo;
    LDS_BARRIER();
    f32x4 S0 = (f32x4){0.f, 0.f, 0.f, 0.f}, S1 = S0;
#pragma unroll
    for (int i = 0; i < WIN - 1; ++i) { f32x4 a, b; unpack8(*(LAS u32x4*)(rawp + (i - (WIN - 1)) * 544), a, b); S0 += a; S1 += b; }
    u32x4 out[8];
#pragma unroll
    for (int r = 0; r < 8; ++r) {
        f32x4 a, b; unpack8(own[r], a, b); S0 += a; S1 += b;
        const int cnt = (pos0 + r + 1) < WIN ? (pos0 + r + 1) : WIN; const float ic = 1.0f / (float)cnt;
        out[r] = pack8(S0 * ic - a, S1 * ic - b);
        f32x4 c, d; unpack8(*(LAS u32x4*)(rawp + (r - (WIN - 1)) * 544), c, d); S0 -= c; S1 -= d;
    }
    LDS_BARRIER();
#pragma unroll
    for (int r = 0; r < 8; ++r) *(LAS u32x4*)(rawp + r * 544) = out[r];
    LDS_BARRIER();
}
template <class Hook> __device__ __forceinline__ void pool_mma_epi(Frame& F, int j, int g, int row0, const bf16_t* ZSGA, bf16_t* A2, LAS unsigned char* lds  , int w, int fr, int fq, const Hook& hook) {
    const int cg = g * 256 + 32 * w + 8 * fq;
    const unsigned lo_in = (unsigned)fr * (D * 2) + (unsigned)(32 * w + 8 * fq) * 2u, lo_out = (unsigned)fr * 4096u + (unsigned)(32 * w + 8 * fq) * 2u, lo_pm = (unsigned)(32 * w + 8 * (fr >> 2) + (fr & 3)) * 512u + (unsigned)fq * 16u;
    u32x4 sgr[8];
#pragma unroll
    for (int mt = 0; mt < 8; ++mt) sgr[mt] = *(const u32x4*)((const char*)(ZSGA + (size_t)(16 * mt) * D + g * 256) + lo_in);
    f32x4 acc[8][2];
#pragma unroll
    for (int mt = 0; mt < 8; ++mt) { acc[mt][0] = (f32x4){0.f, 0.f, 0.f, 0.f}; acc[mt][1] = (f32x4){0.f, 0.f, 0.f, 0.f}; }
    const bf16_t* pm = ((bf16_t*)(F.ws + WS_PMT)) + (size_t)(j * 4 + g) * 65536;
    bf16x8 Bq[8][2]; f32x4 psv[2];
#pragma unroll
    for (int ks = 0; ks < 8; ++ks) { Bq[ks][0] = *(const bf16x8*)((const char*)(pm + 32 * ks) + lo_pm); Bq[ks][1] = *(const bf16x8*)((const char*)(pm + 4 * 256 + 32 * ks) + lo_pm); }
#pragma unroll
    for (int nt = 0; nt < 2; ++nt) psv[nt] = *(const f32x4*)(FIN(12) + j * 1024 + cg + 4 * nt);
    hook();
    {
        bf16x8 Af[2][4];
#define POOL_AREAD(n_, buf_) do { _Pragma("unroll") for (int m4_ = 0; m4_ < 4; ++m4_) Af[buf_][m4_] = *(LAS bf16x8*)(lds + (16 * (4 * ((n_) & 1) + m4_) + fr) * 544 + (32 * ((n_) >> 1) + 8 * fq) * 2); } while (0)
        POOL_AREAD(0, 0);
        __builtin_amdgcn_sched_group_barrier(0x100, 4, 0);
#pragma unroll
        for (int n = 0; n < 16; ++n) {
            if (n < 15) POOL_AREAD(n + 1, (n + 1) & 1);
#pragma unroll
            for (int m4 = 0; m4 < 4; ++m4) { const int mt = 4 * (n & 1) + m4, ks = n >> 1; acc[mt][0] = MFMA16(Bq[ks][0], Af[n & 1][m4], acc[mt][0]); acc[mt][1] = MFMA16(Bq[ks][1], Af[n & 1][m4], acc[mt][1]); }
            if (n < 15) __builtin_amdgcn_sched_group_barrier(0x100, 4, 0);
            __builtin_amdgcn_sched_group_barrier(0x008, 8, 0);
        }
#undef POOL_AREAD
    }
#pragma unroll
    for (int mt = 0; mt < 8; ++mt) {
        f32x4 s0, s1; unpack8(sgr[mt], s0, s1);
        *(u32x4*)((char*)(A2 + (size_t)(16 * mt) * 2048 + g * 256) + lo_out) = pack8(acc[mt][0] * psv[0] * s0, acc[mt][1] * psv[1] * s1);
    }
}
template <int GA, int GB> __device__ __forceinline__ void pool_pair(Frame& F0, int j, int n, const u32x4 (&ownA)[8], const u32x4& haloA) {
    Frame F = launder(F0);
    LAS unsigned char* lds = F.lds;
    const int tid = F.tid, lane = F.lane, w = F.wave, fr = lane & 15, fq = lane >> 4, row0 = n * 128;
    const int pos0 = (row0 & 2047) + (tid >> 5) * 8;
    const bf16_t* xa = ((bf16_t*)(F.ws + WS_Z)) + (size_t)row0 * D;
    const bf16_t* ZSGA = ((bf16_t*)(F.ws + WS_Z)) + (size_t)1 * MP * D + (size_t)row0 * D;
    bf16_t* A2 = ((bf16_t*)(F.ws + WS_A2)) + (size_t)row0 * 2048;
    constexpr int WA = 2 << GA, WB = 2 << GB;
    pool_stage<WA>(ownA, haloA, lds, tid, pos0);
    u32x4 ownB[8], haloB;
    pool_mma_epi(F, j, GA, row0, ZSGA, A2, lds + POOL_AP, w, fr, fq, [&]() { pool_fetch(xa + GB * 256, tid, row0 & 2047, ownB, haloB); }); LDS_BARRIER();
    pool_stage<WB>(ownB, haloB, lds, tid, pos0);
    pool_mma_epi(F, j, GB, row0, ZSGA, A2, lds + POOL_AP, w, fr, fq, NoHook{}); LDS_BARRIER();
}
constexpr int ATT_SLOT = 64 * 544;
__device__ __forceinline__ void attn_prompt(Frame& F0, int layer) {
    Frame F = launder(F0);
    LAS unsigned char* lds = F.lds;
    const int tid = F.tid, lane = F.lane, w = F.wave, fr = lane & 15, fq = lane >> 4;
    const bf16_t* Kl = ((bf16_t*)(F.ws + WS_KB)) + (size_t)layer * MMEM * D; const bf16_t* Vl = ((bf16_t*)(F.ws + WS_VB)) + (size_t)layer * MMEM * D;
    for (int kk = F.rk; kk < 64; kk += F.rw) {
        const int b = F.xq, h = kk >> 4, qb = kk & 15;
        const size_t rowq = (size_t)b * SEQ + qb * 128 + 16 * w + fr;
        bf16x8 Qf[8];
#pragma unroll
        for (int ks = 0; ks < 8; ++ks) Qf[ks] = *(const bf16x8*)(((bf16_t*)(F.ws + WS_Q)) + rowq * D + h * 256 + 32 * ks + 8 * fq);
        const bf16_t* kbase = Kl + (size_t)(b * 256) * D + h * 256; const bf16_t* vbase = Vl + (size_t)(b * 256) * D + h * 256;
        u32x4 st[4];
#define ATT_GLOAD(c) do { const bf16_t* src_ = ((c) < 4 ? kbase : vbase) + (size_t)(64 * ((c) & 3)) * D; _Pragma("unroll") for (int i_ = 0; i_ < 4; ++i_) { const int idx_ = tid + 512 * i_; st[i_] = *(const u32x4*)(src_ + (size_t)(idx_ >> 5) * D + (idx_ & 31) * 8); } } while (0)
#define ATT_LSTORE(slot) do { _Pragma("unroll") for (int i_ = 0; i_ < 4; ++i_) { const int idx_ = tid + 512 * i_; *(LAS u32x4*)(lds + (slot) * ATT_SLOT + (idx_ >> 5) * 544 + (idx_ & 31) * 16) = st[i_]; } } while (0)
        f32x4 S[16], Oa[16]; bf16x8 Pf[8]; float inv = 0.f;
#pragma unroll
        for (int i = 0; i < 16; ++i) { S[i] = (f32x4){0.f, 0.f, 0.f, 0.f}; Oa[i] = (f32x4){0.f, 0.f, 0.f, 0.f}; }
        ATT_GLOAD(0); ATT_LSTORE(0); __syncthreads();
#pragma unroll
        for (int c = 0; c < 8; ++c) {
            if (c < 7) ATT_GLOAD(c + 1);
            LAS unsigned char* slot = lds + (c & 1) * ATT_SLOT;
            if (c < 4) {
#pragma unroll
                for (int ml = 0; ml < 4; ++ml)
#pragma unroll
                    for (int ks = 0; ks < 8; ++ks) {
                        const bf16x8 Kf = *(LAS bf16x8*)(slot + (16 * ml + fr) * 544 + (32 * ks + 8 * fq) * 2);
                        S[4 * c + ml] = MFMA16(Kf, Qf[ks], S[4 * c + ml]);
                    }
                if (c == 3) {
                    float mx = S[0][0];
#pragma unroll
                    for (int i = 0; i < 16; ++i) { mx = fmaxf(mx, fmaxf(fmaxf(S[i][0], S[i][1]), fmaxf(S[i][2], S[i][3]))); }
                    mx = fmaxf(mx, shx(mx, 16, lane)); mx = fmaxf(mx, shx(mx, 32, lane));
                    float sum = 0.f;
#pragma unroll
                    for (int i = 0; i < 16; ++i) {
#pragma unroll
                        for (int e = 0; e < 4; ++e) { S[i][e] = __builtin_amdgcn_exp2f(S[i][e] - mx); sum += S[i][e]; }
                    }
                    sum += shx(sum, 16, lane); sum += shx(sum, 32, lane);
                    inv = 1.0f / sum;
#pragma unroll
                    for (int a = 0; a < 8; ++a) {
                        u32x4 pw; pw.x = cvt_pk_bf16(S[2 * a][0], S[2 * a][1]); pw.y = cvt_pk_bf16(S[2 * a][2], S[2 * a][3]); pw.z = cvt_pk_bf16(S[2 * a + 1][0], S[2 * a + 1][1]); pw.w = cvt_pk_bf16(S[2 * a + 1][2], S[2 * a + 1][3]);
                        Pf[a] = __builtin_bit_cast(bf16x8, pw);
                    }
                }
            } else {
#pragma unroll
                for (int al = 0; al < 2; ++al)
#pragma unroll
                    for (int dt = 0; dt < 16; ++dt) {
                        LAS unsigned char* p = slot + (32 * al + 4 * fq + (fr >> 2)) * 544 + (16 * dt + 4 * (fr & 3)) * 2;
                        const bf16x8 Vf = tr_frag(p, p + 16 * 544);
                        Oa[dt] = MFMA16(Vf, Pf[2 * (c - 4) + al], Oa[dt]);
                    }
            }
            if (c < 7) ATT_LSTORE((c + 1) & 1);
            __syncthreads();
        }
#pragma unroll
        for (int dt = 0; dt < 16; ++dt) *(u32x2*)(((bf16_t*)(F.ws + WS_O)) + rowq * D + h * 256 + 16 * dt + 4 * fq) = pack4(Oa[dt] * inv);
#undef ATT_GLOAD
#undef ATT_LSTORE
    }
}

template <class Epi, int N>
__device__ __forceinline__ void sgemm16(Frame& F0, const bf16_t* A, const bf16_t* Bt, int K, const Epi& E) {
    Frame F = launder(F0);
    LAS unsigned char* lds = F.lds;
    constexpr int CW = N / 32, NT = CW / 16, KS = NT == 2 ? 8 : (NT == 10 ? 4 : 2), NG = 8 / KS, NTW = NT / NG;
    static_assert(NT * 16 == CW && NTW * NG == NT && 2 * CW <= NWAVES * 64, "sgemm16 geometry");
    const int tid = F.tid, lane = F.lane, w = F.wave, fr = lane & 15, fq = lane >> 4;
    const int ksi = w % KS, ng = w / KS, kslice = K / KS, nkb = kslice / 128;
    const bf16_t* A16 = A + (size_t)(16 * F.xq) * K;
    for (int slot = F.rk; slot < 32; slot += F.rw) {
        const int erow = tid / (CW / 8), ecg = tid % (CW / 8); const bool eact = tid < 2 * CW;
        typename Epi::Pre pre{};
        if (eact) pre = E.pre(16 * F.xq + erow, slot * CW + 8 * ecg);
        f32x4 acc[NTW];
#pragma unroll
        for (int jn = 0; jn < NTW; ++jn) acc[jn] = (f32x4){0.f, 0.f, 0.f, 0.f};
        const bf16_t* ap = A16 + (size_t)fr * K + ksi * kslice + 8 * fq;
        const bf16_t* bp = Bt + (size_t)(slot * CW + (ng * NTW) * 16 + fr) * K + ksi * kslice + 8 * fq;
        {
            bf16x8 Af[2][4], Bf[2][4][NTW];
#define SG_LOAD(kb_, buf_) do { _Pragma("unroll") for (int k4 = 0; k4 < 4; ++k4) { Af[buf_][k4] = *(const bf16x8*)(ap + 128 * (kb_) + 32 * k4); \
                _Pragma("unroll") for (int jn = 0; jn < NTW; ++jn) Bf[buf_][k4][jn] = *(const bf16x8*)(bp + (size_t)(16 * jn) * K + 128 * (kb_) + 32 * k4); } } while (0)
            SG_LOAD(0, 0);
            for (int kb = 0; kb < nkb; kb += 2) {
                if (kb + 1 < nkb) SG_LOAD(kb + 1, 1);
#pragma unroll
                for (int k4 = 0; k4 < 4; ++k4)
#pragma unroll
                    for (int jn = 0; jn < NTW; ++jn) acc[jn] = MFMA16(Bf[0][k4][jn], Af[0][k4], acc[jn]);
                if (kb + 1 < nkb) {
                    if (kb + 2 < nkb) SG_LOAD(kb + 2, 0);
#pragma unroll
                    for (int k4 = 0; k4 < 4; ++k4)
#pragma unroll
                        for (int jn = 0; jn < NTW; ++jn) acc[jn] = MFMA16(Bf[1][k4][jn], Af[1][k4], acc[jn]);
                }
            }
#undef SG_LOAD
        }
#pragma unroll
        for (int jn = 0; jn < NTW; ++jn) *(LAS f32x4*)(lds + ((size_t)((ksi * 16 + fr) * CW + (ng * NTW + jn) * 16 + 4 * fq)) * 4) = acc[jn];
        LDS_BARRIER();
        if (eact) {
            f32x4 s0 = (f32x4){0.f, 0.f, 0.f, 0.f}, s1 = s0;
#pragma unroll
            for (int kk = 0; kk < KS; ++kk) { const LAS f32x4* p = (const LAS f32x4*)(lds + ((size_t)((kk * 16 + erow) * CW + 8 * ecg)) * 4); s0 += p[0]; s1 += p[1]; }
            E(16 * F.xq + erow, slot, slot * CW + 8 * ecg, s0, s1, pre);
        }
        LDS_BARRIER();
    }
}
struct SEpiZ {
    struct Pre { float rs; };
    const float* rsqs; float* SZ; int ldz, mode;
    __device__ __forceinline__ Pre pre(int row, int col) const { return Pre{rstd32(rsqs + row * 32)}; }
    __device__ __forceinline__ void operator()(int row, int strip, int col, f32x4 s0, f32x4 s1, const Pre& p) const {
        const int oc0 = mode == 0 ? src_even(col) : src_odd(col), oc1 = mode == 0 ? src_even(col + 4) : src_odd(col + 4);
        float* q = SZ + (size_t)row * ldz; *(f32x4*)(q + oc0) = s0 * p.rs; *(f32x4*)(q + oc1) = s1 * p.rs;
    }
};
struct SEpiRes {
    struct Pre { f32x4 x0, x1; };
    float* xs; bf16_t* xb; float* rsqs;
    __device__ __forceinline__ Pre pre(int row, int col) const { const float* q = xs + (size_t)row * D + col; return Pre{*(const f32x4*)q, *(const f32x4*)(q + 4)}; }
    __device__ __forceinline__ void operator()(int row, int strip, int col, f32x4 s0, f32x4 s1, const Pre& pr) const {
        float* p = xs + (size_t)row * D + col; const f32x4 o0 = pr.x0 + s0, o1 = pr.x1 + s1;
        *(f32x4*)p = o0; *(f32x4*)(p + 4) = o1; *(u32x4*)(xb + (size_t)row * D + col) = pack8(o0, o1);
        const int ln = ((row & 15) << 2) | ((col >> 3) & 3);
        float ss = dot4(o0, o0) + dot4(o1, o1); ss += shx(ss, 1, ln); ss += shx(ss, 2, ln);
        if ((col & 31) == 0) rsqs[row * 32 + strip] = ss;
    }
};
struct SEpiQ {
    struct Pre { float rs; };
    const float* rsqs; float* SQ;
    __device__ __forceinline__ Pre pre(int row, int col) const { return Pre{rstd32(rsqs + row * 32)}; }
    __device__ __forceinline__ void operator()(int row, int strip, int col, f32x4 s0, f32x4 s1, const Pre& p) const {
        float* q = SQ + (size_t)row * D + col; *(f32x4*)q = s0 * p.rs; *(f32x4*)(q + 4) = s1 * p.rs;
    }
};
__device__ __forceinline__ void sample_mix_even(Frame& F0, int j, int b) {
    Frame F = launder(F0);
    LAS float* pl = (LAS float*)F.lds; LAS float* red = pl + 1024;
    const int tid = F.tid, lane = F.lane, w = F.wave;
    const float* z = ((float*)(F.ws + WS_SZ)) + (size_t)b * 8192;
    float vv[2], ss = 0.f;
#pragma unroll
    for (int k = 0; k < 2; ++k) { vv[k] = z[3072 + tid + 512 * k]; ss += vv[k] * vv[k]; }
    ss = wave_sum(ss, lane); if (lane == 0) red[w] = ss;
#pragma unroll
    for (int k = 0; k < 2; ++k) {
        const int c = tid + 512 * k, g = c >> 8, win = 2 << g; const float xa = z[c];
        const float* st = FIN(3) + ((size_t)(j * 128 + b) * 15) * 1024 + c;
        float sr[15];
#pragma unroll
        for (int r = 0; r < 15; ++r) sr[r] = st[(size_t)r * 1024];
        float s = xa;
#pragma unroll
        for (int r = 0; r < 15; ++r) s += (r >= 16 - win) ? sr[r] : 0.f;
        pl[c] = s / (float)win - xa;
        float* po = F.out + O_POOLS + ((size_t)(j * 128 + b) * 15) * 1024 + c;
#pragma unroll
        for (int r = 0; r < 14; ++r) po[(size_t)r * 1024] = sr[r + 1];
        po[(size_t)14 * 1024] = xa;
    }
    __syncthreads();
    float tot = 0.f;
#pragma unroll
    for (int i = 0; i < 8; ++i) tot += red[i];
    const float rv = rsqrtf(tot * (1.0f / D) + EPS);
#pragma unroll
    for (int k = 0; k < 2; ++k) {
        const int d = tid + 512 * k, g = d >> 8, dd = d & 255;
        const bf16_t* pm = ((bf16_t*)(F.ws + WS_PMT)) + (size_t)(j * 4 + g) * 65536 + (size_t)dd * 256; const LAS float* pg = pl + g * 256;
        float a = 0.f;
#pragma unroll
        for (int hb = 0; hb < 2; ++hb) {
            u32x4 pr[16];
#pragma unroll
            for (int i = 0; i < 16; ++i) pr[i] = *(const u32x4*)(pm + hb * 128 + i * 8);
#pragma unroll
            for (int i = 0; i < 16; ++i) { f32x4 p0, p1; unpack8(pr[i], p0, p1); const LAS float* q = pg + hb * 128 + i * 8; a += dot4(p0, *(const LAS f32x4*)q) + dot4(p1, *(const LAS f32x4*)(q + 4)); }
        }
        const float ya = a * FIN(12)[j * 1024 + d] * silu_f(z[1024 + d]);
        const float vn = vv[k] * rv * FIN(15)[j * 1024 + d];
        F.out[O_SGUV + (size_t)(j * 128 + b) * 1024 + d] = vn;
        const float mixed = FIN(13)[(size_t)(j * 4 + g) * 16384] * vn + FIN(14)[(j * 4 + g) * 128];
        const float yb = z[2048 + d] * mixed * silu_f(z[4096 + d]);
        ((bf16_t*)(F.ws + WS_SA2))[(size_t)b * 2048 + d] = (bf16_t)(cvt_pk_bf16(ya, 0.f) & 0xffffu); ((bf16_t*)(F.ws + WS_SA2))[(size_t)b * 2048 + 1024 + d] = (bf16_t)(cvt_pk_bf16(yb, 0.f) & 0xffffu);
    }
    __syncthreads();
}
__device__ __forceinline__ void sample_conv_odd(Frame& F0, int j, int b) {
    Frame F = launder(F0);
    const int tid = F.tid;
    const float* z = ((float*)(F.ws + WS_SZ)) + (size_t)b * 8192;
    const float* cw = FIN(18) + (size_t)j * 3 * 2048;
#pragma unroll
    for (int k = 0; k < 4; ++k) {
        const int c = tid + 512 * k;
        const float e = z[2048 + c] * z[4096 + c];
        const float s0 = FIN(4)[((size_t)(j * 128 + b) * 2 + 0) * 2048 + c], s1 = FIN(4)[((size_t)(j * 128 + b) * 2 + 1) * 2048 + c];
        const float y = cw[c] * s0 + cw[2048 + c] * s1 + cw[4096 + c] * e;
        ((bf16_t*)(F.ws + WS_SA2))[(size_t)b * 2048 + c] = (bf16_t)(cvt_pk_bf16(z[c] * y * silu_f(z[6144 + c]), 0.f) & 0xffffu);
        float* po = F.out + O_CONVS + ((size_t)(j * 128 + b) * 2) * 2048 + c; po[0] = s1; po[2048] = e;
    }
}
__device__ __forceinline__ void attn_sample(Frame& F0, int layer) {
    Frame F = launder(F0);
    LAS float* sc = (LAS float*)F.lds;
    LAS float* red = sc + 512;
    const int tid = F.tid, lane = F.lane, w = F.wave;
    for (int item = F.rk; item < 32; item += F.rw) {
        const int b = 16 * F.xq + (item >> 1), hp = item & 1;
        const float* qp = ((float*)(F.ws + WS_SQ)) + (size_t)b * D + hp * 512;
        const f32x4 q0 = *(const f32x4*)(qp + 4 * lane), q1 = *(const f32x4*)(qp + 256 + 4 * lane);
        const float* kp = FIN(5) + ((size_t)(layer * 128 + b) * 256) * 1024 + hp * 512 + 4 * lane;
        const float* vp = FIN(6) + ((size_t)(layer * 128 + b) * 256) * 1024 + hp * 512 + 4 * lane;
#pragma unroll 8
        for (int mi = 0; mi < 32; ++mi) {
            const int m = 32 * w + mi;
            const f32x4 k0 = __builtin_nontemporal_load((const f32x4*)(kp + (size_t)m * 1024)), k1 = __builtin_nontemporal_load((const f32x4*)(kp + (size_t)m * 1024 + 256));
            const float d0 = wave_sum(dot4(k0, q0), lane), d1 = wave_sum(dot4(k1, q1), lane);
            if (lane == 0) { sc[m] = d0; sc[256 + m] = d1; }
        }
        __syncthreads();
        float p0[4], p1[4], mx0 = -INFINITY, mx1 = -INFINITY;
#pragma unroll
        for (int i = 0; i < 4; ++i) { p0[i] = sc[lane + 64 * i]; p1[i] = sc[256 + lane + 64 * i]; mx0 = fmaxf(mx0, p0[i]); mx1 = fmaxf(mx1, p1[i]); }
#pragma unroll
        for (int o = 1; o < 64; o <<= 1) { mx0 = fmaxf(mx0, shx(mx0, o, lane)); mx1 = fmaxf(mx1, shx(mx1, o, lane)); }
        float sm0 = 0.f, sm1 = 0.f;
#pragma unroll
        for (int i = 0; i < 4; ++i) { p0[i] = __builtin_amdgcn_exp2f(p0[i] - mx0); p1[i] = __builtin_amdgcn_exp2f(p1[i] - mx1); sm0 += p0[i]; sm1 += p1[i]; }
        sm0 = wave_sum(sm0, lane); sm1 = wave_sum(sm1, lane);
        const float i0 = 1.0f / sm0, i1 = 1.0f / sm1;
        __syncthreads();
        if (w == 0) {
#pragma unroll
            for (int i = 0; i < 4; ++i) { sc[lane + 64 * i] = p0[i] * i0; sc[256 + lane + 64 * i] = p1[i] * i1; }
        }
        __syncthreads();
        f32x4 a0 = (f32x4){0.f, 0.f, 0.f, 0.f}, a1 = a0;
#pragma unroll 8
        for (int mi = 0; mi < 32; ++mi) {
            const int m = 32 * w + mi;
            const f32x4 v0 = __builtin_nontemporal_load((const f32x4*)(vp + (size_t)m * 1024)), v1 = __builtin_nontemporal_load((const f32x4*)(vp + (size_t)m * 1024 + 256));
            a0 += v0 * sc[m]; a1 += v1 * sc[256 + m];
        }
        *(LAS f32x4*)(red + w * 512 + 4 * lane) = a0; *(LAS f32x4*)(red + w * 512 + 256 + 4 * lane) = a1;
        __syncthreads();
        {
            float o = 0.f;
#pragma unroll
            for (int ww = 0; ww < 8; ++ww) o += red[ww * 512 + tid];
            ((bf16_t*)(F.ws + WS_SO))[(size_t)b * D + hp * 512 + tid] = (bf16_t)(cvt_pk_bf16(o, 0.f) & 0xffffu);
        }
        __syncthreads();
    }
}
#define dpp_mov(v, ctrl, row_mask) __builtin_bit_cast(float, __builtin_amdgcn_update_dpp(0, __builtin_bit_cast(int, (float)(v)), (ctrl), (row_mask), 0xf, false))
__device__ __forceinline__ float wave_sum_dpp(float x) {
    x += dpp_mov(x, 0xB1, 0xf);
    x += dpp_mov(x, 0x4E, 0xf);
    x += dpp_mov(x, 0x141, 0xf);
    x += dpp_mov(x, 0x140, 0xf);
    x += dpp_mov(x, 0x142, 0xa);
    x += dpp_mov(x, 0x143, 0xc);
    return x;
}
constexpr int FA_SC = 69632, FA_RED = 71680;
__device__ __forceinline__ void attn_fused(Frame& F0, int layer) {
    Frame F = launder(F0);
    LAS unsigned char* lds = F.lds;
    const int tid = F.tid, lane = F.lane, w = F.wave, fr = lane & 15, fq = lane >> 4;
    const bf16_t* Kl = ((bf16_t*)(F.ws + WS_KB)) + (size_t)layer * MMEM * D; const bf16_t* Vl = ((bf16_t*)(F.ws + WS_VB)) + (size_t)layer * MMEM * D;
    LAS float* sc = (LAS float*)(lds + FA_SC); LAS float* red = (LAS float*)(lds + FA_RED);
    const int sb = 16 * F.xq + (F.rk >> 1), hp = F.rk & 1;
    const float* qp = ((float*)(F.ws + WS_SQ)) + (size_t)sb * D + hp * 512;
    const f32x4 q0 = *(const f32x4*)(qp + 4 * lane), q1 = *(const f32x4*)(qp + 256 + 4 * lane);
    const float* kp = FIN(5) + ((size_t)(layer * 128 + sb) * 256 + 4 * w) * 1024 + hp * 512;
    const float* vp = FIN(6) + ((size_t)(layer * 128 + sb) * 256 + 4 * w) * 1024 + hp * 512;
    const unsigned lo16 = (unsigned)lane * 16u;
    f32x4 sv[8]; f32x4 a0 = (f32x4){0.f, 0.f, 0.f, 0.f}, a1 = a0; float mx0 = 0.f, mx1 = 0.f, iv0 = 0.f, iv1 = 0.f;
#define FA_SLOAD(base, slice) do { unsigned long long pu_ = uni64((unsigned long long)((base) + (size_t)(32 * (slice)) * 1024)); asm volatile("" : "+s"(pu_)); const char* pc_ = (const char*)(const GAS char*)pu_; \
        _Pragma("unroll") for (int r_ = 0; r_ < 4; ++r_) { sv[2 * r_] = __builtin_nontemporal_load((const f32x4*)(pc_ + r_ * 4096 + lo16)); sv[2 * r_ + 1] = __builtin_nontemporal_load((const f32x4*)(pc_ + r_ * 4096 + 1024 + lo16)); } } while (0)
    FA_SLOAD(kp, 0);
#pragma unroll 1
    for (int ui = 0; ui < 2; ++ui) {
        const int kk = 2 * F.rk + ui;
        const int b = F.xq, h = kk >> 4, qb = kk & 15;
        const size_t rowq = (size_t)b * SEQ + qb * 128 + 16 * w + fr;
        bf16x8 Qf[8];
#pragma unroll
        for (int ks = 0; ks < 8; ++ks) Qf[ks] = *(const bf16x8*)(((bf16_t*)(F.ws + WS_Q)) + rowq * D + h * 256 + 32 * ks + 8 * fq);
        const bf16_t* kbase = Kl + (size_t)(b * 256) * D + h * 256; const bf16_t* vbase = Vl + (size_t)(b * 256) * D + h * 256;
        u32x4 st[4];
        const unsigned goff = (unsigned)(tid >> 5) * (D * 2) + (unsigned)(tid & 31) * 16u, loff = (unsigned)(tid >> 5) * 544u + (unsigned)(tid & 31) * 16u;
#define ATT_GLOAD(c) do { unsigned long long pu_ = uni64((unsigned long long)(((c) < 4 ? kbase : vbase) + (size_t)(64 * ((c) & 3)) * D)); asm volatile("" : "+s"(pu_)); const char* pc_ = (const char*)(const GAS char*)pu_; \
        _Pragma("unroll") for (int i_ = 0; i_ < 4; ++i_) st[i_] = *(const u32x4*)(pc_ + (size_t)(16 * i_) * D * 2 + goff); } while (0)
#define ATT_LSTORE(c) do { _Pragma("unroll") for (int i_ = 0; i_ < 4; ++i_) *(LAS u32x4*)(lds + ((c) & 1) * ATT_SLOT + 16 * i_ * 544 + loff) = st[i_]; } while (0)
        f32x4 S[16], Oa[16]; bf16x8 Pf[8]; float inv = 0.f;
        const f32x4 zero4 = (f32x4){0.f, 0.f, 0.f, 0.f};
        if (ui == 1) {
            float p0[4], p1[4]; mx0 = -INFINITY; mx1 = -INFINITY;
#pragma unroll
            for (int i = 0; i < 4; ++i) { p0[i] = sc[lane + 64 * i]; p1[i] = sc[256 + lane + 64 * i]; mx0 = fmaxf(mx0, p0[i]); mx1 = fmaxf(mx1, p1[i]); }
#pragma unroll
            for (int o = 1; o < 64; o <<= 1) { mx0 = fmaxf(mx0, shx(mx0, o, lane)); mx1 = fmaxf(mx1, shx(mx1, o, lane)); }
            float sm0 = 0.f, sm1 = 0.f;
#pragma unroll
            for (int i = 0; i < 4; ++i) { sm0 += __builtin_amdgcn_exp2f(p0[i] - mx0); sm1 += __builtin_amdgcn_exp2f(p1[i] - mx1); }
            sm0 = wave_sum(sm0, lane); sm1 = wave_sum(sm1, lane);
            iv0 = 1.0f / sm0; iv1 = 1.0f / sm1;
        }
        ATT_GLOAD(0); ATT_LSTORE(0); __syncthreads();
#pragma unroll
        for (int c = 0; c < 8; ++c) {
            if (c < 7) ATT_GLOAD(c + 1);
            if (ui == 0) {
#pragma unroll
                for (int r = 0; r < 4; ++r) {
                    const int m = 32 * c + 4 * w + r;
                    const float d0 = wave_sum_dpp(dot4(sv[2 * r], q0)), d1 = wave_sum_dpp(dot4(sv[2 * r + 1], q1));
                    if (lane == 63) { sc[m] = d0; sc[256 + m] = d1; }
                }
                if (c < 7) FA_SLOAD(kp, c + 1); else FA_SLOAD(vp, 0);
            } else {
#pragma unroll
                for (int r = 0; r < 4; ++r) {
                    const int m = 32 * c + 4 * w + r;
                    const float p0 = __builtin_amdgcn_exp2f(sc[m] - mx0) * iv0, p1 = __builtin_amdgcn_exp2f(sc[256 + m] - mx1) * iv1;
                    a0 += sv[2 * r] * p0; a1 += sv[2 * r + 1] * p1;
                }
                if (c < 7) FA_SLOAD(vp, c + 1);
            }
            LAS unsigned char* slot = lds + (c & 1) * ATT_SLOT;
            if (c < 4) {
                {
                    bf16x8 Kf[2][4];
#pragma unroll
                    for (int ml = 0; ml < 4; ++ml) Kf[0][ml] = *(LAS bf16x8*)(slot + (16 * ml + fr) * 544 + (8 * fq) * 2);
                    __builtin_amdgcn_sched_group_barrier(0x100, 4, 0);
#pragma unroll
                    for (int ks = 0; ks < 8; ++ks) {
                        if (ks < 7) {
#pragma unroll
                            for (int ml = 0; ml < 4; ++ml) Kf[(ks + 1) & 1][ml] = *(LAS bf16x8*)(slot + (16 * ml + fr) * 544 + (32 * (ks + 1) + 8 * fq) * 2);
                        }
#pragma unroll
                        for (int ml = 0; ml < 4; ++ml) S[4 * c + ml] = MFMA16(Kf[ks & 1][ml], Qf[ks], ks == 0 ? zero4 : S[4 * c + ml]);
                        __builtin_amdgcn_sched_group_barrier(0x100, 4, 0); __builtin_amdgcn_sched_group_barrier(0x008, 4, 0);
                    }
                }
                if (c == 3) {
                    float mx = S[0][0];
#pragma unroll
                    for (int i = 0; i < 16; ++i) { mx = fmaxf(mx, fmaxf(fmaxf(S[i][0], S[i][1]), fmaxf(S[i][2], S[i][3]))); }
                    mx = fmaxf(mx, shx(mx, 16, lane)); mx = fmaxf(mx, shx(mx, 32, lane));
                    float sum = 0.f;
#pragma unroll
                    for (int i = 0; i < 16; ++i) {
#pragma unroll
                        for (int e = 0; e < 4; ++e) { S[i][e] = __builtin_amdgcn_exp2f(S[i][e] - mx); sum += S[i][e]; }
                    }
                    sum += shx(sum, 16, lane); sum += shx(sum, 32, lane);
                    inv = 1.0f / sum;
#pragma unroll
                    for (int a = 0; a < 8; ++a) {
                        u32x4 pw; pw.x = cvt_pk_bf16(S[2 * a][0], S[2 * a][1]); pw.y = cvt_pk_bf16(S[2 * a][2], S[2 * a][3]); pw.z = cvt_pk_bf16(S[2 * a + 1][0], S[2 * a + 1][1]); pw.w = cvt_pk_bf16(S[2 * a + 1][2], S[2 * a + 1][3]);
                        Pf[a] = __builtin_bit_cast(bf16x8, pw);
                    }
                }
            } else {
                {
                    bf16x8 Vf[2][4];
#define ATT_VREAD(n_, buf_) do { _Pragma("unroll") for (int d_ = 0; d_ < 4; ++d_) { LAS unsigned char* p_ = slot + (32 * ((n_) >> 2) + 4 * fq + (fr >> 2)) * 544 + (16 * (4 * ((n_) & 3) + d_) + 4 * (fr & 3)) * 2; Vf[buf_][d_] = tr_frag(p_, p_ + 16 * 544); } } while (0)
                    ATT_VREAD(0, 0);
                    __builtin_amdgcn_sched_group_barrier(0x100, 8, 0);
#pragma unroll
                    for (int n = 0; n < 8; ++n) {
                        if (n < 7) ATT_VREAD(n + 1, (n + 1) & 1);
#pragma unroll
                        for (int d = 0; d < 4; ++d) { const int al = n >> 2, dt = 4 * (n & 3) + d; Oa[dt] = MFMA16(Vf[n & 1][d], Pf[2 * (c - 4) + al], (c == 4 && al == 0) ? zero4 : Oa[dt]); }
                        __builtin_amdgcn_sched_group_barrier(0x100, 8, 0); __builtin_amdgcn_sched_group_barrier(0x008, 4, 0);
                    }
#undef ATT_VREAD
                }
            }
            if (c < 7) ATT_LSTORE(c + 1);
            LDS_BARRIER();
        }
#pragma unroll
        for (int dt = 0; dt < 16; ++dt) *(u32x2*)(((bf16_t*)(F.ws + WS_O)) + rowq * D + h * 256 + 16 * dt + 4 * fq) = pack4(Oa[dt] * inv);
#undef ATT_GLOAD
#undef ATT_LSTORE
    }
#undef FA_SLOAD
    *(LAS f32x4*)(red + w * 512 + 4 * lane) = a0; *(LAS f32x4*)(red + w * 512 + 256 + 4 * lane) = a1;
    __syncthreads();
    {
        float o = 0.f;
#pragma unroll
        for (int ww = 0; ww < 8; ++ww) o += red[ww * 512 + tid];
        ((bf16_t*)(F.ws + WS_SO))[(size_t)sb * D + hp * 512 + tid] = (bf16_t)(cvt_pk_bf16(o, 0.f) & 0xffffu);
    }
    __syncthreads();
}
__device__ __forceinline__ void final_norm(Frame& F0) {
    Frame F = launder(F0);
    const int gwx = F.rk * NWAVES + F.wave, NGX = F.rw * NWAVES, lane = F.lane;
    f32x4 g[4];
#pragma unroll
    for (int jj = 0; jj < 4; ++jj) g[jj] = ((const f32x4*)FIN(24) + lane)[64 * jj];
    const bool has_s = gwx < 16;
    f32x4 sv[4];
    if (has_s) {
        const f32x4* src = (const f32x4*)(((float*)(F.ws + WS_XS)) + (size_t)(16 * F.xq + gwx) * D) + lane;
#pragma unroll
        for (int jj = 0; jj < 4; ++jj) sv[jj] = src[64 * jj];
    }
    for (int p = gwx; p < SEQ / 8; p += NGX) {
        const int m0 = F.xq * SEQ + 8 * p;
        u32x2 pk[8][4];
#pragma unroll
        for (int r = 0; r < 8; ++r) {
            const u32x2* src = (const u32x2*)(((bf16_t*)(F.ws + WS_XB)) + (size_t)(m0 + r) * D) + lane;
#pragma unroll
            for (int jj = 0; jj < 4; ++jj) pk[r][jj] = src[64 * jj];
        }
        float s[8];
#pragma unroll
        for (int r = 0; r < 8; ++r) {
            s[r] = 0.f;
#pragma unroll
            for (int jj = 0; jj < 4; ++jj) { const f32x4 t = unpack4(pk[r][jj]); s[r] += dot4(t, t); }
        }
#pragma unroll
        for (int r = 0; r < 8; ++r) s[r] = rsqrtf(wave_sum(s[r], lane) * (1.0f / D) + EPS);
#pragma unroll
        for (int r = 0; r < 8; ++r) {
            f32x4* dst = (f32x4*)(F.out + O_Y + (size_t)(m0 + r) * D) + lane;
#pragma unroll
            for (int jj = 0; jj < 4; ++jj) dst[64 * jj] = unpack4(pk[r][jj]) * s[r] * g[jj];
        }
    }
    if (has_s) {
        float s = 0.f;
#pragma unroll
        for (int jj = 0; jj < 4; ++jj) s += dot4(sv[jj], sv[jj]);
        const float rs = rsqrtf(wave_sum(s, lane) * (1.0f / D) + EPS);
        f32x4* dst = (f32x4*)(F.out + O_YS + (size_t)(16 * F.xq + gwx) * D) + lane;
#pragma unroll
        for (int jj = 0; jj < 4; ++jj) dst[64 * jj] = sv[jj] * rs * g[jj];
    }
}

struct Args { const float* in[25]; float* out; unsigned char* ws; int ph_lo, ph_hi; };
#define REP(bit) for (int rep_ = 0; rep_ < 1 + ((REP_MASK >> (bit)) & 1); ++rep_)
__global__ void __launch_bounds__(NWAVES * 64, 2) fwd(Args args) {
    extern __shared__ __attribute__((aligned(16))) unsigned char lds_raw[];
    Frame F0;
    F0.lds = (LAS unsigned char*)lds_raw;
    F0.tid = threadIdx.x; F0.lane = F0.tid & 63; F0.wave = __builtin_amdgcn_readfirstlane(F0.tid >> 6); F0.G = gridDim.x; F0.bx = blockIdx.x;
    F0.in = (in_tab_t)__builtin_amdgcn_kernarg_segment_ptr();     F0.out = args.out; F0.ws = args.ws;
    for (int u = F0.tid; u < (LDS_BYTES - LDSCTL_OFF) / 4; u += NWAVES * 64) ((LAS unsigned*)(F0.lds + LDSCTL_OFF))[u] = 0u;
    __syncthreads();
    XcdBarrier bar; bar.wave = F0.wave; bar.bar = (unsigned*)(args.ws + WS_CTL) + CW_BAR; bar.x = 0; bar.st = nullptr;
    if (!MK_SPLIT) bar = xcd_barrier_post((unsigned*)(args.ws + WS_CTL) + CW_BAR, (volatile LAS unsigned*)(F0.lds + MISC_OFF) + 8, F0.wave);
    unsigned* rankw = (unsigned*)(args.ws + WS_CTL) + CW_RANK;
    const unsigned my_xcc = xb_xcc_id();
    unsigned my_rank = 0u;
    if (F0.tid == 0) ((volatile LAS unsigned*)(F0.lds + MISC_OFF))[12] = __hip_atomic_fetch_add(rankw + 64 * my_xcc, 1u, __ATOMIC_RELAXED, __HIP_MEMORY_SCOPE_AGENT);
    if (F0.tid == 0) (void)__hip_atomic_fetch_or(rankw + 64 * (32 + (F0.bx & 7)), 1u << my_xcc, __ATOMIC_RELAXED, __HIP_MEMORY_SCOPE_AGENT);
    __syncthreads();
    my_rank = __builtin_amdgcn_readfirstlane(((volatile LAS unsigned*)(F0.lds + MISC_OFF))[12]);
    F0.vid = F0.bx;
    int ph = 0;
    bool local_ok = false;
    const int lo = args.ph_lo, hi = args.ph_hi;
#define PH_BEGIN if (ph >= lo && ph < hi) { Frame F = launder(F0);
#define PH_END } { const bool both_ = (ph >= lo && ph + 1 < hi); ++ph; if (!MK_SPLIT && both_) { XcdBarrier b2_ = bar; unsigned long long bp_ = uni64((unsigned long long)bar.bar); unsigned bx_ = __builtin_amdgcn_readfirstlane(bar.x); int bw_ = __builtin_amdgcn_readfirstlane(bar.wave); asm volatile("" : "+s"(bp_), "+s"(bx_), "+s"(bw_)); b2_.bar = (unsigned*)(GAS unsigned*)bp_; b2_.x = bx_; b2_.wave = bw_; if (local_ok && ph > 2) xcd_barrier_local(b2_); else xcd_barrier(b2_); if ((REP_MASK >> 19) & 1) xcd_barrier(b2_); if (ph == 2) local_ok = XCD_LOCAL && lo == 0 && __builtin_amdgcn_readfirstlane(__hip_atomic_load(rankw + 64 * 20, __ATOMIC_RELAXED, __HIP_MEMORY_SCOPE_AGENT)) == 0u;     } }

    PH_BEGIN REP(0) { p0_prologue(F0); __syncthreads(); } PH_END
    if (!MK_SPLIT && lo == 0) {
        unsigned nx = 0u, xi = 0u; bool even = (F0.G % 8) == 0;
        for (unsigned jx = 0; jx < 16; ++jx) { const unsigned c_ = __hip_atomic_load(rankw + 64 * jx, __ATOMIC_RELAXED, __HIP_MEMORY_SCOPE_AGENT); if (c_) { if (c_ != (unsigned)F0.G / 8u) even = false; if (jx < my_xcc) ++xi; ++nx; } }
        if (XCD_VID && even && nx == 8u) F0.vid = (int)(my_rank * 8u + xi);
        unsigned all_ = 0u; bool one2one = true;
        for (unsigned m_ = 0; m_ < 8; ++m_) { const unsigned k_ = __hip_atomic_load(rankw + 64 * (32 + m_), __ATOMIC_RELAXED, __HIP_MEMORY_SCOPE_AGENT); if (__builtin_popcount(k_) != 1 || (all_ & k_)) one2one = false; all_ |= k_; }
        if (!(even && nx == 8u && one2one) && F0.tid == 0) __hip_atomic_store(rankw + 64 * 20, 1u, __ATOMIC_RELAXED, __HIP_MEMORY_SCOPE_AGENT);
        if (((REP_MASK >> 18) & 1) && !(even && nx == 8u && (unsigned)(F0.bx % 8) == xi) && F0.tid == 0) F0.out[O_YS + F0.bx] = __builtin_nanf("");
        F0.vid = __builtin_amdgcn_readfirstlane(F0.vid);
    }
    PH_BEGIN {
        if ((REP_MASK >> 17) & 1) {
            f32x4 pa[8]; bf16x8 pb = (bf16x8){(short)F.tid, 1, 2, 3, 4, 5, 6, 7};
#pragma unroll
            for (int i = 0; i < 8; ++i) pa[i] = (f32x4){(float)F.tid, 1.f, 2.f, (float)i};
#pragma unroll 1
            for (int it = 0; it < 512; ++it) {
#pragma unroll
                for (int r = 0; r < 4; ++r)
#pragma unroll
                    for (int i = 0; i < 8; ++i) pa[i] = MFMA16(pb, pb, pa[i]);
            }
            float sacc = 0.f;
#pragma unroll
            for (int i = 0; i < 8; ++i) sacc += pa[i][0] + pa[i][3];
            if (sacc == 12345.678f) ((float*)(F.ws + WS_Z))[F.tid] = sacc;
        }
        if ((REP_MASK >> 15) & 3) { pg8::Gemm gp{((bf16_t*)(F.ws + WS_XB)), ((bf16_t*)(F.ws + WS_C1)), MP, NC, ((REP_MASK >> 15) & 1) ? 1024 : 512}; pg8::StaticOrder Sp; Sp.init(MP, NC, F.G, (int)F.vid); EpiProbe Ep{((bf16_t*)(F.ws + WS_Z)), NC}; pg8::gemm_phase<EpiProbe, pg8::StaticOrder, true, true>(F.lds, gp, Sp, Ep, F.wave); }
        pg8::Gemm g{((bf16_t*)(F.ws + WS_MEMB)), ((bf16_t*)(F.ws + WS_WKV)), MMEM, 8192, D}; pg8::StaticOrder S; S.init(MMEM, 8192, F.G, (int)F.vid);
        EpiMemKV E{((float*)(F.ws + WS_SMALL + 65536)), F.out + O_MEMK, F.out + O_MEMV, ((bf16_t*)(F.ws + WS_KB)), ((bf16_t*)(F.ws + WS_VB))};
        REP(1) pg8::gemm_phase<EpiMemKV, pg8::StaticOrder, true, true>(F.lds, g, S, E, F.wave);
    } PH_END
    if (STAGGER_TICKS != 0 && lo == 0 && ((F0.bx & 1) == (STAGGER_TICKS > 0 ? 1 : 0))) { const unsigned long long t0_ = __builtin_amdgcn_s_memrealtime(); const unsigned long long tk_ = (unsigned long long)(STAGGER_TICKS > 0 ? STAGGER_TICKS : -STAGGER_TICKS); while (__builtin_amdgcn_s_memrealtime() - t0_ < tk_) __builtin_amdgcn_s_sleep(8); }
    unsigned* pbw = (unsigned*)(args.ws + WS_CTL) + CW_RANK + 64 * 24;
    if (!MK_SPLIT && SPLIT_PROLOGUE && lo == 0) {
        const int half = F0.bx & 1, hw = (half ? (F0.G >> 1) : ((F0.G + 1) >> 1)) * NWAVES, hi_ = (F0.bx >> 1) * NWAVES + F0.wave;
        p0_weights(F0, 1, hi_, hw, half);
        asm volatile("s_waitcnt vmcnt(0)" ::: "memory"); __syncthreads();
        if (F0.wave == 0 && hw_lane() == 0) { __builtin_amdgcn_fence(__ATOMIC_RELEASE, "agent"); asm volatile("s_waitcnt vmcnt(0)" ::: "memory"); (void)__hip_atomic_fetch_add(pbw, 1u, __ATOMIC_RELAXED, __HIP_MEMORY_SCOPE_AGENT); }
    }
#pragma unroll 1
    for (int l = 0; l < DEPTH; ++l) {
        const int j = l >> 1;
        if (!MK_SPLIT && SPLIT_PROLOGUE && lo == 0 && l == 1) {
            if (F0.wave == 0 && hw_lane() == 0) {
                const unsigned want = (unsigned)F0.G; unsigned sp = 0u;
                while (__hip_atomic_load(pbw, __ATOMIC_RELAXED, __HIP_MEMORY_SCOPE_AGENT) < want) { __builtin_amdgcn_s_sleep(2); if (++sp > (1u << 22)) { atomicAdd((unsigned*)(args.ws + WS_CTL) + CW_BAR + XB_TMO, 1u); break; } }
                __builtin_amdgcn_fence(__ATOMIC_ACQUIRE, "agent"); asm volatile("s_waitcnt vmcnt(0)" ::: "memory");
            }
            __syncthreads();
        }
        if ((l & 1) == 0) {
            PH_BEGIN {
                pg8::Gemm g{((bf16_t*)(F.ws + WS_XB)), ((bf16_t*)(F.ws + WS_AB1)) + (size_t)j * NAB * D, MP, NAB, D}; pg8::StaticOrder S; S.init(MP, NAB, F.G, (int)F.vid);
                Unit u0{0, 0}; S.next(0, u0); rstd_table(((float*)(F.ws + WS_RSQ)), u0.pm, (LAS float*)(F.lds + RSTD_OFF), F.tid);
                EpiG1Even E{((float*)(F.ws + WS_RSQ)), ((bf16_t*)(F.ws + WS_Z)), ((float*)(F.ws + WS_VSQ)), F.out + O_POOLP + (size_t)j * 8 * 15 * 1024, (LAS const float*)(F.lds + RSTD_OFF), u0.pm};
                SEpiZ SE{((float*)(F.ws + WS_SMALL)), ((float*)(F.ws + WS_SZ)), 8192, 0};
                const bool s_first = (F.rk & 1) != 0;
                if (s_first) { REP(3) sgemm16<SEpiZ, NAB>(F, ((bf16_t*)(F.ws + WS_XB)) + (size_t)MP * D, ((bf16_t*)(F.ws + WS_AB1)) + (size_t)j * NAB * D, D, SE); }
                REP(2) pg8::gemm_phase<EpiG1Even, pg8::StaticOrder, true, true>(F.lds, g, S, E, F.wave);
                if (!s_first) { REP(3) sgemm16<SEpiZ, NAB>(F, ((bf16_t*)(F.ws + WS_XB)) + (size_t)MP * D, ((bf16_t*)(F.ws + WS_AB1)) + (size_t)j * NAB * D, D, SE); }
            } PH_END
            PH_BEGIN {
                REP(4) for (int i = F.rk; i < 32; i += F.rw) {
                    const int n = 16 * F.xq + (i >> 1);
                    const bf16_t* xan = ((bf16_t*)(F.ws + WS_Z)) + (size_t)(n * 128) * D; u32x4 pown[8], phalo;
                    if ((i & 1) == 0) { sgu_chunk(F, j, n, 0, 2, [&]() { pool_fetch(xan + 0 * 256, F.tid, (n * 128) & 2047, pown, phalo); }); pool_pair<0, 3>(F, j, n, pown, phalo); }
                    else { sgu_chunk(F, j, n, 2, 4, [&]() { pool_fetch(xan + 1 * 256, F.tid, (n * 128) & 2047, pown, phalo); }); pool_pair<1, 2>(F, j, n, pown, phalo); }
                }
                REP(5) for (int i = F.rk; i < 16; i += F.rw) sample_mix_even(F, j, 16 * F.xq + i);
            } PH_END
        } else {
            PH_BEGIN {
                pg8::Gemm g{((bf16_t*)(F.ws + WS_XB)), ((bf16_t*)(F.ws + WS_C1)) + (size_t)j * NC * D, MP, NC, D}; pg8::StaticOrder S; S.init(MP, NC, F.G, (int)F.vid);
                Unit u0{0, 0}; S.next(0, u0);
                for (int i = F.tid; i < 8 * 3 * 64; i += NWAVES * 64) { const int ui = i / 192, q = (i / 64) % 3, c = i & 63, pn = u0.pn + 4 * ui; ((LAS float*)(F.lds + CWL_OFF))[i] = pn < NC / 256 ? (FIN(18) + (size_t)j * 3 * 2048)[q * 2048 + pn * 64 + c] : 0.f; }
                rstd_table(((float*)(F.ws + WS_RSQ)), u0.pm, (LAS float*)(F.lds + RSTD_OFF), F.tid);
                EpiG1Odd E{((float*)(F.ws + WS_RSQ)), ((bf16_t*)(F.ws + WS_A2)), FIN(18) + (size_t)j * 3 * 2048, F.out + O_CONVP + (size_t)j * 8 * 2 * 2048, ((float*)(F.ws + WS_SIDE)), (LAS float*)(F.lds + HALO_OFF), (LAS const float*)(F.lds + RSTD_OFF), u0.pm, (LAS const float*)(F.lds + CWL_OFF), u0.pn};
                SEpiZ SE{((float*)(F.ws + WS_SMALL)), ((float*)(F.ws + WS_SZ)), 8192, 1};
                const bool s_first = (F.rk & 1) != 0;
                if (s_first) { REP(3) sgemm16<SEpiZ, NC>(F, ((bf16_t*)(F.ws + WS_XB)) + (size_t)MP * D, ((bf16_t*)(F.ws + WS_C1)) + (size_t)j * NC * D, D, SE); }
                REP(6) pg8::gemm_phase<EpiG1Odd, pg8::StaticOrder, true, true>(F.lds, g, S, E, F.wave);
                if (!s_first) { REP(3) sgemm16<SEpiZ, NC>(F, ((bf16_t*)(F.ws + WS_XB)) + (size_t)MP * D, ((bf16_t*)(F.ws + WS_C1)) + (size_t)j * NC * D, D, SE); }
            } PH_END
            PH_BEGIN {
                for (int p = F.rk; p < 24; p += F.rw) if (p >= 16) conv_fixup(((float*)(F.ws + WS_SIDE)), FIN(18) + (size_t)j * 3 * 2048, ((bf16_t*)(F.ws + WS_A2)), 8 * F.xq + (p - 16), F.tid);
                REP(5) for (int i = F.rk; i < 16; i += F.rw) sample_conv_odd(F, j, 16 * F.xq + i);
            } PH_END
        }
        PH_BEGIN {
            const bf16_t* W2 = ((l & 1) ? ((bf16_t*)(F.ws + WS_C2)) : ((bf16_t*)(F.ws + WS_AB2))) + (size_t)j * D * 2048;
            pg8::Gemm g{((bf16_t*)(F.ws + WS_A2)), W2, MP, D, 2048}; pg8::StaticOrder S; S.init(MP, D, F.G, (int)F.vid);
            EpiRes E{((bf16_t*)(F.ws + WS_XB)), ((float*)(F.ws + WS_RSQ))};
            pg8::gemm_phase<EpiRes, pg8::StaticOrder, true, true>(F.lds, g, S, E, F.wave);
            SEpiRes SE{((float*)(F.ws + WS_XS)), ((bf16_t*)(F.ws + WS_XB)) + (size_t)MP * D, ((float*)(F.ws + WS_SMALL))};
            sgemm16<SEpiRes, D>(F, ((bf16_t*)(F.ws + WS_SA2)), W2, 2048, SE);
        } PH_END
        PH_BEGIN {
            pg8::Gemm g{((bf16_t*)(F.ws + WS_XB)), ((bf16_t*)(F.ws + WS_WQ)) + (size_t)l * D * D, MP, D, D}; pg8::StaticOrder S; S.init(MP, D, F.G, (int)F.vid);
            Unit u0{0, 0}; S.next(0, u0); rstd_table(((float*)(F.ws + WS_RSQ)), u0.pm, (LAS float*)(F.lds + RSTD_OFF), F.tid);
            EpiQ E{((float*)(F.ws + WS_RSQ)), ((bf16_t*)(F.ws + WS_Q)), (LAS const float*)(F.lds + RSTD_OFF), u0.pm};
            REP(8) pg8::gemm_phase<EpiQ, pg8::StaticOrder, true, true>(F.lds, g, S, E, F.wave);
            SEpiQ SE{((float*)(F.ws + WS_SMALL)), ((float*)(F.ws + WS_SQ))};
            REP(9) sgemm16<SEpiQ, D>(F, ((bf16_t*)(F.ws + WS_XB)) + (size_t)MP * D, ((bf16_t*)(F.ws + WS_WQ)) + (size_t)l * D * D, D, SE);
        } PH_END
        PH_BEGIN {
            if (F.G == 256) { REP(10) attn_fused(F, l); }
            else { attn_prompt(F, l); attn_sample(F, l); }
        } PH_END
        PH_BEGIN {
            pg8::Gemm g{((bf16_t*)(F.ws + WS_O)), ((bf16_t*)(F.ws + WS_WO)) + (size_t)l * D * D, MP, D, D}; pg8::StaticOrder S; S.init(MP, D, F.G, (int)F.vid);
            EpiRes E{((bf16_t*)(F.ws + WS_XB)), ((float*)(F.ws + WS_RSQ))};
            pg8::gemm_phase<EpiRes, pg8::StaticOrder, true, true>(F.lds, g, S, E, F.wave);
            SEpiRes SE{((float*)(F.ws + WS_XS)), ((bf16_t*)(F.ws + WS_XB)) + (size_t)MP * D, ((float*)(F.ws + WS_SMALL))};
            sgemm16<SEpiRes, D>(F, ((bf16_t*)(F.ws + WS_SO)), ((bf16_t*)(F.ws + WS_WO)) + (size_t)l * D * D, D, SE);
        } PH_END
    }
    PH_BEGIN final_norm(F0); PH_END
#undef PH_BEGIN
#undef PH_END
}
constexpr int N_PHASES = 2 + 6 * DEPTH + 1;

extern "C" void kernel_launch(void* const* d_in, const int* in_sizes, int n_in, void* d_out, int out_size, void* d_ws, size_t ws_size, hipStream_t stream) {
    static int grid = 0;
    if (grid == 0) {
        if (n_in != 25 || in_sizes[0] != MP * D || (size_t)out_size != O_END || ws_size < WS_END) { fprintf(stderr, "kernel_launch: unexpected shapes (n_in %d, in0 %d, out %d, ws %zu); nothing launched\n", n_in, n_in > 0 ? in_sizes[0] : -1, out_size, ws_size); grid = -1; return; }
        int dev = 0, cus = 0, per_cu = 0;
        if (hipGetDevice(&dev) != hipSuccess || hipDeviceGetAttribute(&cus, hipDeviceAttributeMultiprocessorCount, dev) != hipSuccess) { fprintf(stderr, "kernel_launch: device query failed\n"); grid = -1; return; }
        if (hipFuncSetAttribute((const void*)fwd, hipFuncAttributeMaxDynamicSharedMemorySize, LDS_BYTES) != hipSuccess) { fprintf(stderr, "kernel_launch: hipFuncSetAttribute failed\n"); grid = -1; return; }
        if (hipOccupancyMaxActiveBlocksPerMultiprocessor(&per_cu, (const void*)fwd, NWAVES * 64, LDS_BYTES) != hipSuccess || per_cu < 1) fprintf(stderr, "kernel_launch: note: occupancy query reports %d workgroups per CU\n", per_cu);
        (void)hipGetLastError();
        grid = cus;
    }
    if (grid < 0) return;
    if (hipMemsetAsync((char*)d_ws + WS_CTL, 0, CTL_ZERO_BYTES, stream) != hipSuccess) { fprintf(stderr, "kernel_launch: memset failed\n"); return; }
    Args a{};
    for (int i = 0; i < 25; ++i) a.in[i] = (const float*)d_in[i];
    a.out = (float*)d_out; a.ws = (unsigned char*)d_ws;
#if MK_SPLIT
    for (int p = 0; p < N_PHASES; ++p) { a.ph_lo = p; a.ph_hi = p + 1; hipLaunchKernelGGL(fwd, dim3(grid), dim3(NWAVES * 64), LDS_BYTES, stream, a); }
#else
    a.ph_lo = 0; a.ph_hi = N_PHASES;
    hipLaunchKernelGGL(fwd, dim3(grid), dim3(NWAVES * 64), LDS_BYTES, stream, a);
#endif
    const hipError_t le = hipPeekAtLastError();
    if (le != hipSuccess) fprintf(stderr, "kernel_launch: launch failed: %s\n", hipGetErrorName(le));
}
```

```cpp
#include <hip/hip_runtime.h>
#include <cstdio>
#include <cstdint>
#ifndef REP_MASK
#define REP_MASK 0
#endif
#ifndef STAGGER_TICKS
#define STAGGER_TICKS 0
#endif
#ifndef PB_ODD_PCT
#define PB_ODD_PCT 100
#endif
#ifndef SPLIT_PROLOGUE
#define SPLIT_PROLOGUE 1
#endif
#ifndef XCD_LOCAL
#define XCD_LOCAL 1
#endif
#ifndef XCD_VID
#define XCD_VID 0
#endif
#ifndef MK_SPLIT
#define MK_SPLIT 0
#endif
__device__ __forceinline__ int hw_lane() { int l; asm volatile("v_mbcnt_lo_u32_b32 %0, -1, 0\n\tv_mbcnt_hi_u32_b32 %0, -1, %0" : "=v"(l)); return l; }
namespace pg8 {
#define PG8_LAS __attribute__((address_space(3)))
typedef unsigned short bf16_t;
typedef short bf16x8 __attribute__((ext_vector_type(8)));
typedef float f32x4 __attribute__((ext_vector_type(4)));
typedef unsigned u32x4 __attribute__((ext_vector_type(4)));
constexpr int BM = 256, BK = 64, HALF = 128, HTB = HALF * BK * 2  , STAGE_BYTES = 8 * HTB, NXCD = 8, WGM = 8;

__host__ __device__ __forceinline__ int lds_byte(int r, int c) { const int st = (r >> 4) * 2 + (c >> 5), rr = r & 15, cc = c & 31, ob = rr * 64 + cc * 2; return st * 1024 + (ob ^ (((ob >> 9) & 1) << 5)); }
__host__ __device__ __forceinline__ void stage_rc(int b, int& R, int& C) { const int st = b / 1024, sb = b % 1024, swz = sb ^ (((sb >> 9) & 1) << 5); R = (st >> 1) * 16 + swz / 64; C = (st & 1) * 32 + (swz % 64) / 2; }
__host__ __device__ __forceinline__ int perm32(int rho) { const int n = rho >> 4, i = rho & 15; return 8 * (i >> 2) + 4 * n + (i & 3); }

struct Unit { int pm, pn; };
struct Gemm { const bf16_t* A; const bf16_t* Bt; int M, N, K; };

struct StaticOrder {
    int nM, nN, nwg, G, c;
    __host__ __device__ __forceinline__ void init(int M, int N, int G_, int c_) { nM = M / BM; nN = N / BM; nwg = nM * nN; G = G_; c = c_; }
    __host__ __device__ __forceinline__ bool next(int i, Unit& u) const {
        const long L = (long)i * G + c; if (L >= nwg) return false;
        int wgid = (int)L; { const int q = nwg / NXCD, r = nwg % NXCD, xcd = wgid % NXCD, off = wgid / NXCD; wgid = (xcd < r ? xcd * (q + 1) : r * (q + 1) + (xcd - r) * q) + off; }
        const int nig = WGM * nN, gid = wgid / nig, fm = gid * WGM, gsz = (nM - fm) < WGM ? (nM - fm) : WGM;
        u.pm = fm + ((wgid % nig) % gsz); u.pn = (wgid % nig) / gsz; return true;
    }
    __device__ __forceinline__ void a_ready(const Unit&) const {}
    __device__ __forceinline__ void done(const Unit&) const {}
};

typedef float f32x2cv __attribute__((ext_vector_type(2))); typedef __bf16 bf16x2cv __attribute__((ext_vector_type(2)));
__device__ __forceinline__ unsigned cvt_pk_bf16(float lo, float hi) { const f32x2cv v = {lo, hi}; return __builtin_bit_cast(unsigned, __builtin_convertvector(v, bf16x2cv)); }
template <class Epi, class Sched, bool ALIGN_EPI = false, bool SP2 = false>
__device__ __forceinline__ void gemm_phase(PG8_LAS unsigned char* lds, const Gemm g, const Sched& S, const Epi& E, const int wave_id) {
    int tid_ = (wave_id << 6) | hw_lane(); asm volatile("" : "+v"(tid_));
    const int tid = tid_, wid = __builtin_amdgcn_readfirstlane(tid >> 6), lane = tid & 63, wr = wid >> 2, wc = wid & 3, fr = lane & 15, fq = lane >> 4;
    const int K = g.K, nt = K / BK;
    unsigned voffA[2], voffB[2];
#pragma unroll
    for (int i = 0; i < 2; ++i) { int R, C; stage_rc(tid * 16 + i * 8192, R, C); const int Rb = Epi::PERM ? ((R & ~31) + perm32(R & 31)) : R;
        voffA[i] = (unsigned)(R * K + C) * 2u; voffB[i] = (unsigned)(Rb * K + C) * 2u; }
    const size_t kstep = (size_t)(BK * 2);
    const size_t hstep = (size_t)HALF * K * 2;
    const size_t tstep = 2 * hstep;
    const unsigned ldsw = (unsigned)wid * 1024u;
    const int aoff = lds_byte(wr * 64 + fr, fq * 8), boff = lds_byte(wc * 32 + fr, fq * 8);
#define PG8_SA(b, h) (((b) * 2 + (h)) * HTB)
#define PG8_SB(b, h) ((4 + (b) * 2 + (h)) * HTB)
#define PG8_STAGE(bufoff, gbase, voff) do { _Pragma("unroll") for (int _i = 0; _i < 2; ++_i) \
        __builtin_amdgcn_global_load_lds((const unsigned*)((const char*)(gbase) + (voff)[_i]), (PG8_LAS unsigned*)(lds + (bufoff) + ldsw + _i * 8192), 16, 0, 0); } while (0)
#define PG8_LDA(dst, b, h) do { _Pragma("unroll") for (int m = 0; m < 4; ++m) _Pragma("unroll") for (int k = 0; k < 2; ++k) dst[m][k] = *(const PG8_LAS bf16x8*)(lds + PG8_SA(b, h) + aoff + m * 2048 + k * 1024); } while (0)
#define PG8_LDB(dst, b, h) do { _Pragma("unroll") for (int n = 0; n < 2; ++n) _Pragma("unroll") for (int k = 0; k < 2; ++k) dst[n][k] = *(const PG8_LAS bf16x8*)(lds + PG8_SB(b, h) + boff + n * 2048 + k * 1024); } while (0)
#define PG8_MMA(ai, bj, At, Bt) do { __builtin_amdgcn_s_setprio(1); _Pragma("unroll") for (int m = 0; m < 4; ++m) _Pragma("unroll") for (int n = 0; n < 2; ++n) _Pragma("unroll") for (int k = 0; k < 2; ++k) \
        acc[ai][bj][m][n] = __builtin_amdgcn_mfma_f32_16x16x32_bf16(Bt[n][k], At[m][k], acc[ai][bj][m][n], 0, 0, 0); __builtin_amdgcn_s_setprio(0); } while (0)
#define PG8_WAIT_V(n) asm volatile("s_waitcnt vmcnt(" #n ")" ::: "memory")
#define PG8_WAIT_L(n) asm volatile("s_waitcnt lgkmcnt(" #n ")" ::: "memory")
#define PG8_BAR __builtin_amdgcn_s_barrier()
#define PG8_SCHED __builtin_amdgcn_sched_barrier(0)
    Unit cur, nxt; int ui = 0;
    if (!S.next(0, cur)) return;
    f32x4 acc[2][2][4][2];
#pragma unroll
    for (int a = 0; a < 2; ++a)
#pragma unroll
        for (int b = 0; b < 2; ++b)
#pragma unroll
            for (int m = 0; m < 4; ++m)
#pragma unroll
                for (int n = 0; n < 2; ++n) acc[a][b][m][n] = (f32x4){0.f, 0.f, 0.f, 0.f};
    bf16x8 At[4][2], B0[2][2], B1[2][2];
    const char* cA = (const char*)g.A + (size_t)cur.pm * tstep; const char* cB = (const char*)g.Bt + (size_t)cur.pn * tstep;
    S.a_ready(cur);
    if constexpr (SP2) {
        PG8_STAGE(PG8_SB(0, 0), cB, voffB); PG8_STAGE(PG8_SB(0, 1), cB + hstep, voffB); PG8_STAGE(PG8_SA(0, 0), cA, voffA); PG8_STAGE(PG8_SA(0, 1), cA + hstep, voffA);
        if (wr == 1) PG8_BAR;
        PG8_WAIT_V(2); PG8_BAR;
        PG8_STAGE(PG8_SB(1, 0), cB + kstep, voffB); PG8_STAGE(PG8_SA(1, 0), cA + kstep, voffA); PG8_STAGE(PG8_SB(1, 1), cB + hstep + kstep, voffB);
        PG8_WAIT_V(6); PG8_BAR;
    } else {
        PG8_STAGE(PG8_SB(0, 0), cB, voffB); PG8_STAGE(PG8_SA(0, 0), cA, voffA); PG8_STAGE(PG8_SB(0, 1), cB + hstep, voffB); PG8_STAGE(PG8_SA(0, 1), cA + hstep, voffA);
        if (wr == 1) PG8_BAR;
        PG8_WAIT_V(4); PG8_BAR;
        PG8_STAGE(PG8_SB(1, 0), cB + kstep, voffB); PG8_STAGE(PG8_SA(1, 0), cA + kstep, voffA); PG8_STAGE(PG8_SB(1, 1), cB + hstep + kstep, voffB);
        PG8_WAIT_V(6); PG8_BAR;
    }
    for (;;) {
        const bool has_next = S.next(ui + 1, nxt);
        const char* nA = has_next ? (const char*)g.A + (size_t)nxt.pm * tstep : cA; const char* nB = has_next ? (const char*)g.Bt + (size_t)nxt.pn * tstep : cB;
        for (int t = 0; t < nt; t += 2) {
            const bool last = (t == nt - 2);
            const char* a1 = cA + (size_t)(t + 1) * kstep;
            const char* a2 = last ? nA : cA + (size_t)(t + 2) * kstep; const char* b2 = last ? nB : cB + (size_t)(t + 2) * kstep;
            const char* a3 = a2 + kstep; const char* b3 = b2 + kstep;
            if (last && has_next) S.a_ready(nxt);
            if constexpr (SP2) {
            PG8_LDB(B0, 0, 0); PG8_LDB(B1, 0, 1); PG8_SCHED; PG8_LDA(At, 0, 0); PG8_STAGE(PG8_SA(1, 1), a1 + hstep, voffA);
            PG8_WAIT_V(8); PG8_WAIT_L(0); PG8_BAR; PG8_MMA(0, 0, At, B0); PG8_MMA(0, 1, At, B1); PG8_BAR; PG8_SCHED;
            PG8_LDA(At, 0, 1); PG8_STAGE(PG8_SB(0, 0), b2, voffB); PG8_STAGE(PG8_SB(0, 1), b2 + hstep, voffB); PG8_STAGE(PG8_SA(0, 0), a2, voffA);
            PG8_WAIT_V(8); PG8_WAIT_L(0); PG8_BAR; PG8_MMA(1, 0, At, B0); PG8_MMA(1, 1, At, B1); PG8_BAR; PG8_SCHED;
            PG8_LDB(B0, 1, 0); PG8_LDB(B1, 1, 1); PG8_SCHED; PG8_LDA(At, 1, 0); PG8_STAGE(PG8_SA(0, 1), a2 + hstep, voffA);
            PG8_WAIT_V(8); PG8_WAIT_L(0); PG8_BAR; PG8_MMA(0, 0, At, B0); PG8_MMA(0, 1, At, B1); PG8_BAR; PG8_SCHED;
            PG8_LDA(At, 1, 1); PG8_STAGE(PG8_SB(1, 0), b3, voffB); PG8_STAGE(PG8_SB(1, 1), b3 + hstep, voffB); PG8_STAGE(PG8_SA(1, 0), a3, voffA);
            PG8_WAIT_V(8); PG8_WAIT_L(0); PG8_BAR; PG8_MMA(1, 0, At, B0); PG8_MMA(1, 1, At, B1); PG8_BAR; PG8_SCHED;
            } else {
            PG8_LDB(B0, 0, 0); PG8_SCHED; PG8_LDA(At, 0, 0); PG8_STAGE(PG8_SA(1, 1), a1 + hstep, voffA);
            PG8_WAIT_L(8); PG8_BAR; PG8_WAIT_L(0); PG8_MMA(0, 0, At, B0); PG8_BAR; PG8_SCHED;
            PG8_LDB(B1, 0, 1); PG8_STAGE(PG8_SB(0, 0), b2, voffB);
            PG8_BAR; PG8_WAIT_L(0); PG8_MMA(0, 1, At, B1); PG8_BAR;
            PG8_LDA(At, 0, 1); PG8_STAGE(PG8_SA(0, 0), a2, voffA);
            PG8_BAR; PG8_WAIT_L(0); PG8_MMA(1, 0, At, B0); PG8_BAR; PG8_SCHED;
            PG8_STAGE(PG8_SB(0, 1), b2 + hstep, voffB);
            PG8_WAIT_V(6); PG8_BAR; PG8_MMA(1, 1, At, B1); PG8_BAR;
            PG8_LDB(B0, 1, 0); PG8_SCHED; PG8_LDA(At, 1, 0); PG8_STAGE(PG8_SA(0, 1), a2 + hstep, voffA);
            PG8_WAIT_L(8); PG8_BAR; PG8_WAIT_L(0); PG8_MMA(0, 0, At, B0); PG8_BAR; PG8_SCHED;
            PG8_LDB(B1, 1, 1); PG8_STAGE(PG8_SB(1, 0), b3, voffB);
            PG8_BAR; PG8_WAIT_L(0); PG8_MMA(0, 1, At, B1); PG8_BAR;
            PG8_LDA(At, 1, 1); PG8_STAGE(PG8_SA(1, 0), a3, voffA);
            PG8_BAR; PG8_WAIT_L(0); PG8_MMA(1, 0, At, B0); PG8_BAR; PG8_SCHED;
            PG8_STAGE(PG8_SB(1, 1), b3 + hstep, voffB);
            PG8_WAIT_V(6); PG8_BAR; PG8_MMA(1, 1, At, B1); PG8_BAR;
            }
        }
        if constexpr (ALIGN_EPI) { if (wr == 0) PG8_BAR; }
        if constexpr (!Epi::AFTER_DRAIN) { for (int rep_ = 0; rep_ < 1 + (Epi::REP_EPI ? 1 : 0); ++rep_) E(acc, cur, wr, wc, fr, fq); S.done(cur); }
        if (!has_next) break;
#pragma unroll
        for (int a = 0; a < 2; ++a)
#pragma unroll
            for (int b = 0; b < 2; ++b)
#pragma unroll
                for (int m = 0; m < 4; ++m)
#pragma unroll
                    for (int n = 0; n < 2; ++n) acc[a][b][m][n] = (f32x4){0.f, 0.f, 0.f, 0.f};
        cur = nxt; cA = nA; cB = nB; ++ui;
        if constexpr (ALIGN_EPI) { if (wr == 1) PG8_BAR; }
    }
    PG8_WAIT_V(0);
    if constexpr (!ALIGN_EPI) { if (wr == 0) PG8_BAR; }
    PG8_BAR;
    if constexpr (Epi::AFTER_DRAIN) { E.fused(acc, cur, wr, wc, fr, fq, lds, wid, lane); S.done(cur); }
#undef PG8_SA
#undef PG8_SB
#undef PG8_STAGE
#undef PG8_LDA
#undef PG8_LDB
#undef PG8_MMA
#undef PG8_WAIT_V
#undef PG8_WAIT_L
#undef PG8_BAR
#undef PG8_SCHED
}
}

using pg8::bf16_t; using pg8::bf16x8; using pg8::f32x4; using pg8::u32x4; using pg8::Unit; using pg8::cvt_pk_bf16;
#define GAS __attribute__((address_space(1)))
#define LAS __attribute__((address_space(3)))
typedef unsigned u32x2 __attribute__((ext_vector_type(2)));
typedef short s16x4 __attribute__((ext_vector_type(4)));
typedef GAS unsigned gu32;
#define RLX_AGENT __ATOMIC_RELAXED, __HIP_MEMORY_SCOPE_AGENT

constexpr int NWAVES = 8;
constexpr int D = 1024, MP = 16384, MS = 128, SEQ = 2048, NBATCH = 8, NMEM = 256, MMEM = 2048, DEPTH = 4;
constexpr int NAB = 5120, NC = 8192;
constexpr float EPS = 1e-6f;
constexpr float QSCALE = 0.0625f * 1.4426950408889634f;

constexpr size_t O_Y = 0, O_YS = O_Y + (size_t)MP * D, O_POOLP = O_YS + (size_t)MS * D, O_POOLS = O_POOLP + 2 * 8 * 15 * 1024,
                 O_CONVP = O_POOLS + (size_t)2 * 128 * 15 * 1024, O_CONVS = O_CONVP + 2 * 8 * 2 * 2048, O_SGUV = O_CONVS + (size_t)2 * 128 * 2 * 2048,
                 O_MEMK = O_SGUV + 2 * 128 * 1024, O_MEMV = O_MEMK + (size_t)4 * MMEM * D, O_END = O_MEMV + (size_t)4 * MMEM * D;
static_assert(O_END == 39239680, "output size");

constexpr size_t MiB = 1u << 20;
constexpr size_t WS_CTL = 0, CTL_ZERO_BYTES = 1 * MiB;
constexpr size_t WS_AB1 = 2 * MiB, WS_C1 = 22 * MiB, WS_AB2 = 54 * MiB, WS_C2 = 62 * MiB, WS_WQ = 70 * MiB, WS_WKV = 78 * MiB, WS_WO = 94 * MiB, WS_PMT = 102 * MiB;
constexpr size_t WS_XB = 104 * MiB;
constexpr size_t WS_RSQ = 137 * MiB, WS_VSQ = 138 * MiB;
constexpr size_t WS_SMALL = 139 * MiB;
constexpr size_t WS_Z = 140 * MiB;
constexpr size_t WS_A2 = 268 * MiB;
constexpr size_t WS_Q = 332 * MiB, WS_O = WS_Q;
constexpr size_t WS_MEMB = 396 * MiB, WS_KB = 400 * MiB, WS_VB = 416 * MiB;
constexpr size_t WS_XS = 432 * MiB, WS_SZ = 433 * MiB, WS_SA2 = 437 * MiB, WS_SQ = 438 * MiB, WS_SO = 439 * MiB, WS_SIDE = 440 * MiB  , WS_END = 444 * MiB;
constexpr int CW_BAR = 4096, CW_RANK = 8192;

constexpr int RING_BYTES = 131072, LDSCTL_OFF = RING_BYTES, MISC_OFF = LDSCTL_OFF + 320, HALO_OFF = RING_BYTES + 1024  , RSTD_OFF = HALO_OFF + 8192  , CWL_OFF = RSTD_OFF + 1024  , LDS_BYTES = 155648;

#define LDS_WAIT() asm volatile("s_waitcnt lgkmcnt(0)" ::: "memory")
#define LDS_BARRIER() asm volatile("s_waitcnt lgkmcnt(0)\n\ts_barrier" ::: "memory")

#define XB_TMO      128
#define XB_XCNT(j)  (256  + 64 * (j))
#define XB_XSUB(j)  (1280 + 64 * (j))
#define XB_XGEN(j)  (2304 + 64 * (j))
#define XB_TOP      3328
#define XB_TOPGEN   3392
#define XCD_BAR_WORDS 3456
#define XB_SPIN_CAP (1u << 18)

__device__ __forceinline__ unsigned xb_ld(unsigned* p)              { return __hip_atomic_load(p, __ATOMIC_RELAXED, __HIP_MEMORY_SCOPE_AGENT); }
__device__ __forceinline__ unsigned xb_add(unsigned* p, unsigned v) { return __hip_atomic_fetch_add(p, v, __ATOMIC_RELAXED, __HIP_MEMORY_SCOPE_AGENT); }
__device__ __forceinline__ unsigned xb_xcc_id() { return (unsigned)__builtin_amdgcn_s_getreg((3 << 11) | 20) & 0xFu; }
#define XB_SPIN(cond, bar) do { unsigned _sp = 0; while (cond) { __builtin_amdgcn_s_sleep(1); \
    if ((++_sp & 255u) == 0u) { if (xb_ld(&(bar)[XB_TMO])) break; if (_sp > XB_SPIN_CAP) { atomicAdd(&(bar)[XB_TMO], 1u); break; } } } } while (0)

struct XcdBarrier {
    int wave;
    unsigned* bar; unsigned x;
    volatile LAS unsigned* st;
};

__device__ __forceinline__ XcdBarrier xcd_barrier_post(unsigned* bar, volatile LAS unsigned* st, int wave) {
    XcdBarrier b; b.wave = wave; b.bar = bar; b.x = xb_xcc_id(); b.st = st;
    if (b.wave == 0 && hw_lane() == 0) (void)xb_add(&bar[XB_XCNT(b.x)], 1u);
    return b;
}
__device__ __forceinline__ void xcd_barrier_complete(unsigned* bar, unsigned x, unsigned& nloc, unsigned& nx) {
    const unsigned G = gridDim.x * gridDim.y * gridDim.z;
    unsigned sum, cnt, mine, sp = 0u;
    for (;;) {
        sum = 0u; cnt = 0u; mine = 0u;
#pragma unroll
        for (unsigned j = 0; j < 16; ++j) { const unsigned c = xb_ld(&bar[XB_XCNT(j)]); sum += c; cnt += (c > 0u) ? 1u : 0u; mine = (j == x) ? c : mine; }
        if (sum == G) break;
        __builtin_amdgcn_s_sleep(1);
        if ((++sp & 255u) == 0u) { if (xb_ld(&bar[XB_TMO])) break; if (sp > XB_SPIN_CAP) { atomicAdd(&bar[XB_TMO], 1u); break; } }
    }
    nloc = mine > 0u ? mine : 1u; nx = cnt > 0u ? cnt : 1u;
}

__device__ __forceinline__ void xcd_barrier(const XcdBarrier& b) {
    asm volatile("s_waitcnt vmcnt(0)" ::: "memory");
    __syncthreads();
    if (b.wave == 0 && hw_lane() == 0) {
        unsigned* bar = b.bar;
        __builtin_amdgcn_s_waitcnt(0);
        unsigned nloc = b.st[0], nx = b.st[1];
        if (nloc == 0u) { xcd_barrier_complete(bar, b.x, nloc, nx); b.st[0] = nloc; b.st[1] = nx; }
        const unsigned old = xb_add(&bar[XB_XSUB(b.x)], 1u);
        const unsigned gen = old / nloc;
        if (old + 1u == (gen + 1u) * nloc) {
            __builtin_amdgcn_fence(__ATOMIC_RELEASE, "agent");
            asm volatile("s_waitcnt vmcnt(0)" ::: "memory");
            const unsigned og = xb_add(&bar[XB_TOP], 1u);
            const unsigned tg = og / nx;
            if (og + 1u == (tg + 1u) * nx) xb_add(&bar[XB_TOPGEN], 1u);
            else XB_SPIN(xb_ld(&bar[XB_TOPGEN]) == tg, bar);
            __builtin_amdgcn_fence(__ATOMIC_ACQUIRE, "agent");
            xb_add(&bar[XB_XGEN(b.x)], 1u);
            asm volatile("s_waitcnt vmcnt(0)" ::: "memory");
        } else {
            XB_SPIN(xb_ld(&bar[XB_XGEN(b.x)]) == gen, bar);
            __builtin_amdgcn_fence(__ATOMIC_ACQUIRE, "agent");
            asm volatile("s_waitcnt vmcnt(0)" ::: "memory");
        }
    }
    __syncthreads();
}

__device__ __forceinline__ void xcd_barrier_local(const XcdBarrier& b) {
    asm volatile("s_waitcnt vmcnt(0)" ::: "memory");
    __syncthreads();
    if (b.wave == 0 && hw_lane() == 0) {
        unsigned* bar = b.bar;
        __builtin_amdgcn_s_waitcnt(0);
        const unsigned nloc = b.st[0] ? b.st[0] : 1u;
        const unsigned old = xb_add(&bar[XB_XSUB(b.x)], 1u);
        const unsigned gen = old / nloc;
        if (old + 1u == (gen + 1u) * nloc) xb_add(&bar[XB_XGEN(b.x)], 1u);
        else XB_SPIN(xb_ld(&bar[XB_XGEN(b.x)]) == gen, bar);
        __builtin_amdgcn_fence(__ATOMIC_ACQUIRE, "agent");
        asm volatile("s_waitcnt vmcnt(0)" ::: "memory");
    }
    __syncthreads();
}

typedef const float* fptr_t;
typedef __attribute__((address_space(4))) const fptr_t* in_tab_t;
struct Frame {
    LAS unsigned char* lds;
    int tid, lane, wave, G, bx, vid, xq, rk, rw;
    in_tab_t in;
    float* out;
    unsigned char* ws;
};
__device__ __forceinline__ unsigned long long uni64(unsigned long long v) { const unsigned lo = __builtin_amdgcn_readfirstlane((unsigned)v), hi = __builtin_amdgcn_readfirstlane((unsigned)(v >> 32)); return ((unsigned long long)hi << 32) | lo; }
__device__ __forceinline__ Frame launder(const Frame& F0) {
    Frame F = F0;
    int wv_ = __builtin_amdgcn_readfirstlane(F0.wave);
    int ln_ = hw_lane();
    int g_ = __builtin_amdgcn_readfirstlane(F0.G), b_ = __builtin_amdgcn_readfirstlane(F0.bx), v_ = __builtin_amdgcn_readfirstlane(F0.vid);
    unsigned long long w_ = uni64((unsigned long long)F0.ws), o_ = uni64((unsigned long long)F0.out), i_ = uni64((unsigned long long)F0.in);
    asm volatile("" : "+v"(ln_), "+s"(wv_), "+s"(g_), "+s"(b_), "+s"(v_), "+s"(w_), "+s"(o_), "+s"(i_));
    F.tid = (wv_ << 6) | ln_; F.G = g_; F.bx = b_; F.vid = v_; F.xq = b_ & 7; F.rk = b_ >> 3; F.rw = (g_ - (b_ & 7) + 7) >> 3; F.ws = (unsigned char*)(GAS unsigned char*)w_; F.out = (float*)(GAS float*)o_; F.in = (in_tab_t)i_;
    F.lane = ln_; F.wave = wv_;
    return F;
}
#define FIN(k) ((const float*)(const GAS float*)(F.in[k]))


__device__ __forceinline__ float shx(float v, int mask, int lane) { return __builtin_bit_cast(float, __builtin_amdgcn_ds_bpermute((lane ^ mask) << 2, __builtin_bit_cast(int, v))); }
__device__ __forceinline__ float wave_sum(float v, int lane) {
#pragma unroll
    for (int o = 1; o < 64; o <<= 1) v += shx(v, o, lane);
    return v;
}
__device__ __forceinline__ float silu_f(float x) { return x * __builtin_amdgcn_rcpf(1.f + __builtin_amdgcn_exp2f(-1.4426950408889634f * x)); }
__device__ __forceinline__ f32x4 silu4(f32x4 v) { return (f32x4){silu_f(v[0]), silu_f(v[1]), silu_f(v[2]), silu_f(v[3])}; }
__device__ __forceinline__ float dot4(f32x4 a, f32x4 b) { return (a[0] * b[0] + a[1] * b[1]) + (a[2] * b[2] + a[3] * b[3]); }
__device__ __forceinline__ u32x4 pack8(f32x4 a, f32x4 b) { u32x4 w; w.x = cvt_pk_bf16(a[0], a[1]); w.y = cvt_pk_bf16(a[2], a[3]); w.z = cvt_pk_bf16(b[0], b[1]); w.w = cvt_pk_bf16(b[2], b[3]); return w; }
__device__ __forceinline__ u32x2 pack4(f32x4 a) { u32x2 w; w.x = cvt_pk_bf16(a[0], a[1]); w.y = cvt_pk_bf16(a[2], a[3]); return w; }
__device__ __forceinline__ float bflo(unsigned w) { return __uint_as_float(w << 16); }
__device__ __forceinline__ float bfhi(unsigned w) { return __uint_as_float(w & 0xffff0000u); }
__device__ __forceinline__ void unpack8(u32x4 w, f32x4& a, f32x4& b) { a = (f32x4){bflo(w.x), bfhi(w.x), bflo(w.y), bfhi(w.y)}; b = (f32x4){bflo(w.z), bfhi(w.z), bflo(w.w), bfhi(w.w)}; }
__device__ __forceinline__ f32x4 unpack4(u32x2 w) { return (f32x4){bflo(w.x), bfhi(w.x), bflo(w.y), bfhi(w.y)}; }
__device__ __forceinline__ float rstd16(const float* p) {
    const f32x4 a = ((const f32x4*)p)[0], b = ((const f32x4*)p)[1], c = ((const f32x4*)p)[2], d = ((const f32x4*)p)[3];
    const f32x4 s = (a + b) + (c + d);
    return rsqrtf(((s[0] + s[1]) + (s[2] + s[3])) * (1.0f / D) + EPS);
}
__device__ __forceinline__ float rstd32(const float* p) {
    f32x4 s = ((const f32x4*)p)[0];
#pragma unroll
    for (int i = 1; i < 8; ++i) s += ((const f32x4*)p)[i];
    return rsqrtf(((s[0] + s[1]) + (s[2] + s[3])) * (1.0f / D) + EPS);
}
__host__ __device__ __forceinline__ int src_even(int n) {
    const int tile = n >> 8, o = n & 255;
    if (tile < 8) return n;
    if (tile < 12) return 3072 + (n - 2048);
    const int cb = tile - 12;
    return o < 128 ? 2048 + 128 * cb + o : 4096 + 128 * cb + (o - 128);
}
__host__ __device__ __forceinline__ int src_odd(int n) {
    const int pn = n >> 8, p = n & 255, q = ((p >> 7) << 1) | ((p >> 2) & 1), ch = 64 * pn + 16 * ((p >> 5) & 3) + 4 * ((p >> 3) & 3) + (p & 3);
    const int base = q == 0 ? 2048 : (q == 1 ? 4096 : (q == 2 ? 0 : 6144));
    return base + ch;
}

__device__ __forceinline__ void rstd_table(const float* rsq, int pm, LAS float* tab, int tid) {
    if (tid < 256) tab[tid] = rstd16(rsq + ((size_t)pm * 256 + tid) * 16);
    LDS_BARRIER();
}
struct EpiG1Even {
    static constexpr bool PERM = true, AFTER_DRAIN = false, REP_EPI = (REP_MASK >> 12) & 1;
    const float* rsq; bf16_t* Z; float* vsq; float* pool_out; LAS const float* rtab; int pm0;
    __device__ __forceinline__ void operator()(const f32x4 (&acc)[2][2][4][2], const Unit& u, int wr, int wc, int fr_, int fq_) const {
        int fr = fr_, fq = fq_; asm volatile("" : "+v"(fr), "+v"(fq));
        const int tile = u.pn, cw = wc * 32 + 8 * fq;
#pragma unroll
        for (int ai = 0; ai < 2; ++ai)
#pragma unroll
            for (int m = 0; m < 4; ++m) {
                const int row = u.pm * 256 + ai * 128 + wr * 64 + m * 16 + fr;
                const float rs = u.pm == pm0 ? rtab[ai * 128 + wr * 64 + m * 16 + fr] : rstd16(rsq + (size_t)row * 16);
                if (tile < 12) {
                    const int kind = tile >> 2;
                    bf16_t* dst = Z + (size_t)kind * MP * D + (size_t)row * D + (tile & 3) * 256 + cw;
                    float ss = 0.f;
#pragma unroll
                    for (int bj = 0; bj < 2; ++bj) {
                        f32x4 v0 = acc[ai][bj][m][0] * rs, v1 = acc[ai][bj][m][1] * rs;
                        if (kind == 1) { v0 = silu4(v0); v1 = silu4(v1); }
                        if (kind == 2) ss += dot4(v0, v0) + dot4(v1, v1);
                        *(u32x4*)(dst + bj * 128) = pack8(v0, v1);
                        if (kind == 0 && (row & 2047) >= 2033) {
                            float* po = pool_out + ((size_t)(row >> 11) * 15 + ((row & 2047) - 2033)) * 1024 + (tile & 3) * 256 + bj * 128 + cw;
                            *(f32x4*)po = v0; *(f32x4*)(po + 4) = v1;
                        }
                    }
                    if (kind == 2) { ss += shx(ss, 16, 16 * fq + fr); ss += shx(ss, 32, 16 * fq + fr); if (fq == 0) vsq[(size_t)row * 16 + (tile - 8) * 4 + wc] = ss; }
                } else {
                    const int cb = tile - 12;
                    bf16_t* dst = Z + (size_t)3 * MP * D + (size_t)row * D + cb * 128 + cw;
                    const f32x4 u0 = acc[ai][0][m][0] * rs, u1 = acc[ai][0][m][1] * rs, g0 = acc[ai][1][m][0] * rs, g1 = acc[ai][1][m][1] * rs;
                    *(u32x4*)dst = pack8(u0 * silu4(g0), u1 * silu4(g1));
                }
            }
    }
};
__device__ __forceinline__ float dpp_shr1(float old, float v) { return __builtin_bit_cast(float, __builtin_amdgcn_update_dpp(__builtin_bit_cast(int, old), __builtin_bit_cast(int, v), 0x111, 0xf, 0xf, false)); }
__device__ __forceinline__ float dpp_shr2(float old, float v) { return __builtin_bit_cast(float, __builtin_amdgcn_update_dpp(__builtin_bit_cast(int, old), __builtin_bit_cast(int, v), 0x112, 0xf, 0xf, false)); }
struct EpiG1Odd {
    static constexpr bool PERM = true, AFTER_DRAIN = false, REP_EPI = false;
    const float* rsq; bf16_t* A2; const float* cw; float* conv_out; float* side; LAS float* halo; LAS const float* rtab; int pm0; LAS const float* cwl; int pn0;
    __device__ __forceinline__ void operator()(const f32x4 (&acc)[2][2][4][2], const Unit& u, int wr, int wc, int fr_, int fq_) const {
        int fr = fr_, fq = fq_; asm volatile("" : "+v"(fr), "+v"(fq));
        const int chl = wc * 16 + 4 * fq, ch = u.pn * 64 + chl;
        f32x4 w0, w1, w2;
        { const int ui = (u.pn - pn0) >> 2;
          if (u.pm == pm0 && ui >= 0 && ui < 8 && ((u.pn - pn0) & 3) == 0) { w0 = *(const LAS f32x4*)(cwl + (ui * 3 + 0) * 64 + chl); w1 = *(const LAS f32x4*)(cwl + (ui * 3 + 1) * 64 + chl); w2 = *(const LAS f32x4*)(cwl + (ui * 3 + 2) * 64 + chl); }
          else { w0 = *(const f32x4*)(cw + ch); w1 = *(const f32x4*)(cw + 2048 + ch); w2 = *(const f32x4*)(cw + 4096 + ch); } }
        f32x4 e[2][4]; float rsv[2][4];
#pragma unroll
        for (int ai = 0; ai < 2; ++ai)
#pragma unroll
            for (int m = 0; m < 4; ++m) {
                const int rb = 8 * ai + 4 * wr + m, row = u.pm * 256 + 16 * rb + fr;
                const float rs = u.pm == pm0 ? rtab[16 * rb + fr] : rstd16(rsq + (size_t)row * 16); rsv[ai][m] = rs;
                e[ai][m] = (acc[ai][0][m][0] * rs) * (acc[ai][0][m][1] * rs);
                if (fr >= 14) *(LAS f32x4*)(halo + (rb * 2 + (fr - 14)) * 64 + chl) = e[ai][m];
                if (m & 1) asm volatile("" ::: "memory");
            }
        asm volatile("s_waitcnt lgkmcnt(0)" ::: "memory"); __builtin_amdgcn_s_barrier(); asm volatile("" ::: "memory");
        float* sd = side + (size_t)u.pm * 6 * 2048 + ch;
#pragma unroll
        for (int ai = 0; ai < 2; ++ai)
#pragma unroll
            for (int m = 0; m < 4; ++m) {
                const int rb = 8 * ai + 4 * wr + m, row = u.pm * 256 + 16 * rb + fr;
                const float rs = rsv[ai][m];
                const f32x4 sg = (acc[ai][1][m][0] * rs) * silu4(acc[ai][1][m][1] * rs);
                f32x4 h0 = (f32x4){0.f, 0.f, 0.f, 0.f}, h1 = h0;
                if (rb > 0) { h0 = *(const LAS f32x4*)(halo + ((rb - 1) * 2 + 0) * 64 + chl); h1 = *(const LAS f32x4*)(halo + ((rb - 1) * 2 + 1) * 64 + chl); }
                const f32x4 hx = fr == 0 ? h0 : h1, ev = e[ai][m];
                f32x4 e1, e2;
#pragma unroll
                for (int k = 0; k < 4; ++k) { e1[k] = dpp_shr1(h1[k], ev[k]); e2[k] = dpp_shr2(hx[k], ev[k]); }
                const f32x4 a = sg * (w0 * e2 + w1 * e1 + w2 * ev);
                const bool top = (rb == 0 && fr < 2);
                if (!(top && (u.pm & 7) != 0)) *(u32x2*)(A2 + (size_t)row * 2048 + ch) = pack4(a);
                if (top) { *(f32x4*)(sd + fr * 2048) = ev; *(f32x4*)(sd + (4 + fr) * 2048) = sg; }
                if (rb == 15 && fr >= 14) {
                    *(f32x4*)(sd + (2 + fr - 14) * 2048) = ev;
                    if ((u.pm & 7) == 7) *(f32x4*)(conv_out + ((size_t)(u.pm >> 3) * 2 + (fr - 14)) * 2048 + ch) = ev;
                }
            }
    }
};
__device__ __forceinline__ void conv_fixup(const float* side, const float* cw, bf16_t* A2, int pm, int tid) {
    if ((pm & 7) == 0) return;
    const int ch = 4 * tid;
    const float* sp = side + (size_t)(pm - 1) * 6 * 2048 + ch; const float* sc = side + (size_t)pm * 6 * 2048 + ch;
    const f32x4 em2 = *(const f32x4*)(sp + 2 * 2048), em1 = *(const f32x4*)(sp + 3 * 2048), e0 = *(const f32x4*)sc, e1 = *(const f32x4*)(sc + 2048), s0 = *(const f32x4*)(sc + 4 * 2048), s1 = *(const f32x4*)(sc + 5 * 2048);
    const f32x4 w0 = *(const f32x4*)(cw + ch), w1 = *(const f32x4*)(cw + 2048 + ch), w2 = *(const f32x4*)(cw + 4096 + ch);
    *(u32x2*)(A2 + (size_t)(pm * 256) * 2048 + ch) = pack4(s0 * (w0 * em2 + w1 * em1 + w2 * e0));
    *(u32x2*)(A2 + (size_t)(pm * 256 + 1) * 2048 + ch) = pack4(s1 * (w0 * em1 + w1 * e0 + w2 * e1));
}
struct EpiRes {
    static constexpr bool PERM = true, AFTER_DRAIN = false, REP_EPI = false;
    bf16_t* xb; float* rsq;
    __device__ __forceinline__ void operator()(const f32x4 (&acc)[2][2][4][2], const Unit& u, int wr, int wc, int fr_, int fq_) const {
        int fr = fr_, fq = fq_; asm volatile("" : "+v"(fr), "+v"(fq));
        const int cw = wc * 32 + 8 * fq;
#pragma unroll
        for (int ai = 0; ai < 2; ++ai) {
            u32x4 old[4][2];
#pragma unroll
            for (int m = 0; m < 4; ++m)
#pragma unroll
                for (int bj = 0; bj < 2; ++bj) old[m][bj] = *(const u32x4*)(xb + (size_t)(u.pm * 256 + ai * 128 + wr * 64 + m * 16 + fr) * D + u.pn * 256 + bj * 128 + cw);
#pragma unroll
            for (int m = 0; m < 4; ++m) {
                const int row = u.pm * 256 + ai * 128 + wr * 64 + m * 16 + fr;
                float ss = 0.f;
#pragma unroll
                for (int bj = 0; bj < 2; ++bj) {
                    f32x4 b0, b1; unpack8(old[m][bj], b0, b1);
                    const u32x4 wv = pack8(b0 + acc[ai][bj][m][0], b1 + acc[ai][bj][m][1]);
                    *(u32x4*)(xb + (size_t)row * D + u.pn * 256 + bj * 128 + cw) = wv;
                    f32x4 r0, r1; unpack8(wv, r0, r1);
                    ss += dot4(r0, r0) + dot4(r1, r1);
                }
                ss += shx(ss, 16, 16 * fq + fr); ss += shx(ss, 32, 16 * fq + fr);
                if (fq == 0) rsq[(size_t)row * 16 + u.pn * 4 + wc] = ss;
            }
        }
    }
};
struct EpiProbe {
    static constexpr bool PERM = true, AFTER_DRAIN = false, REP_EPI = false;
    bf16_t* O; int ldc;
    __device__ __forceinline__ void operator()(const f32x4 (&acc)[2][2][4][2], const Unit& u, int wr, int wc, int fr_, int fq_) const {
        int fr = fr_, fq = fq_; asm volatile("" : "+v"(fr), "+v"(fq));
        const int cw = wc * 32 + 8 * fq;
#pragma unroll
        for (int ai = 0; ai < 2; ++ai)
#pragma unroll
            for (int m = 0; m < 4; ++m) {
                const int row = u.pm * 256 + ai * 128 + wr * 64 + m * 16 + fr;
#pragma unroll
                for (int bj = 0; bj < 2; ++bj) *(u32x4*)(O + (size_t)row * ldc + u.pn * 256 + bj * 128 + cw) = pack8(acc[ai][bj][m][0], acc[ai][bj][m][1]);
            }
    }
};
struct EpiQ {
    static constexpr bool PERM = true, AFTER_DRAIN = false, REP_EPI = false;
    const float* rsq; bf16_t* Q; LAS const float* rtab; int pm0;
    __device__ __forceinline__ void operator()(const f32x4 (&acc)[2][2][4][2], const Unit& u, int wr, int wc, int fr_, int fq_) const {
        int fr = fr_, fq = fq_; asm volatile("" : "+v"(fr), "+v"(fq));
        const int cw = wc * 32 + 8 * fq;
#pragma unroll
        for (int ai = 0; ai < 2; ++ai)
#pragma unroll
            for (int m = 0; m < 4; ++m) {
                const int row = u.pm * 256 + ai * 128 + wr * 64 + m * 16 + fr;
                const float rs = u.pm == pm0 ? rtab[ai * 128 + wr * 64 + m * 16 + fr] : rstd16(rsq + (size_t)row * 16);
#pragma unroll
                for (int bj = 0; bj < 2; ++bj) *(u32x4*)(Q + (size_t)row * D + u.pn * 256 + bj * 128 + cw) = pack8(acc[ai][bj][m][0] * rs, acc[ai][bj][m][1] * rs);
            }
    }
};
struct EpiMemKV {
    static constexpr bool PERM = true, AFTER_DRAIN = false, REP_EPI = false;
    const float* rstdm; float* outk; float* outv; bf16_t* kb; bf16_t* vb;
    __device__ __forceinline__ void operator()(const f32x4 (&acc)[2][2][4][2], const Unit& u, int wr, int wc, int fr_, int fq_) const {
        int fr = fr_, fq = fq_; asm volatile("" : "+v"(fr), "+v"(fq));
        const int layer = u.pn >> 3, isv = (u.pn >> 2) & 1, cw = (u.pn & 3) * 256 + wc * 32 + 8 * fq;
        float* of = (isv ? outv : outk) + (size_t)layer * MMEM * D; bf16_t* ob = (isv ? vb : kb) + (size_t)layer * MMEM * D;
#pragma unroll
        for (int ai = 0; ai < 2; ++ai)
#pragma unroll
            for (int m = 0; m < 4; ++m) {
                const int row = u.pm * 256 + ai * 128 + wr * 64 + m * 16 + fr;
                const float rs = rstdm[row];
#pragma unroll
                for (int bj = 0; bj < 2; ++bj) {
                    const size_t off = (size_t)row * D + bj * 128 + cw;
                    const f32x4 v0 = acc[ai][bj][m][0] * rs, v1 = acc[ai][bj][m][1] * rs;
                    *(f32x4*)(of + off) = v0; *(f32x4*)(of + off + 4) = v1;
                    *(u32x4*)(ob + off) = pack8(v0, v1);
                }
            }
    }
};

struct TrItem { const float* wp; int ldw; const float* gk; float sc; bf16_t* wt; int K; };
__device__ __forceinline__ void p0_tr_desc(const float* W, int ldw, int K, int Nd, const float* gk, float sc, bf16_t* WT, int perm, int r, int lane, TrItem& t) {
    const int nblk = Nd / 32, kb = r / nblk, nb = r % nblk, dstn0 = 32 * nb, dn = dstn0 + (lane & 31);
    const int srccol = perm == 0 ? dn : (perm == 1 ? src_even(dn) : src_odd(dn));
    t.wp = W + (size_t)(64 * kb + (lane >> 5)) * ldw + srccol; t.ldw = ldw; t.gk = gk ? gk + 64 * kb : nullptr; t.sc = sc; t.wt = WT + (size_t)dstn0 * K + 64 * kb; t.K = K;
}
__device__ __forceinline__ void p0_resolve(Frame& F, int it, int lane, TrItem& t) {
    constexpr int I_AB1 = 16 * (NAB / 32), I_C1 = 16 * (NC / 32), I_2 = 32 * 32, I_SQ = 16 * 32, I_PM = 4 * 8;
    int r = it;
    if (r < 2 * I_AB1) { const int jj = r / I_AB1; p0_tr_desc(FIN(10) + (size_t)jj * D * NAB, NAB, D, NAB, FIN(7) + 2 * jj * D, 1.f, ((bf16_t*)(F.ws + WS_AB1)) + (size_t)jj * NAB * D, 1, r % I_AB1, lane, t); return; } r -= 2 * I_AB1;
    if (r < 2 * I_C1) { const int jj = r / I_C1; p0_tr_desc(FIN(17) + (size_t)jj * D * NC, NC, D, NC, FIN(7) + (2 * jj + 1) * D, 1.f, ((bf16_t*)(F.ws + WS_C1)) + (size_t)jj * NC * D, 2, r % I_C1, lane, t); return; } r -= 2 * I_C1;
    if (r < 2 * I_2) { const int jj = r / I_2; p0_tr_desc(FIN(16) + (size_t)jj * 2048 * D, D, 2048, D, nullptr, 1.f, ((bf16_t*)(F.ws + WS_AB2)) + (size_t)jj * D * 2048, 0, r % I_2, lane, t); return; } r -= 2 * I_2;
    if (r < 2 * I_2) { const int jj = r / I_2; p0_tr_desc(FIN(19) + (size_t)jj * 2048 * D, D, 2048, D, nullptr, 1.f, ((bf16_t*)(F.ws + WS_C2)) + (size_t)jj * D * 2048, 0, r % I_2, lane, t); return; } r -= 2 * I_2;
    if (r < 4 * I_SQ) { const int l = r / I_SQ; p0_tr_desc(FIN(20) + (size_t)l * D * D, D, D, D, FIN(8) + l * D, QSCALE, ((bf16_t*)(F.ws + WS_WQ)) + (size_t)l * D * D, 0, r % I_SQ, lane, t); return; } r -= 4 * I_SQ;
    if (r < 4 * I_SQ) { const int l = r / I_SQ; p0_tr_desc(FIN(21) + (size_t)l * D * D, D, D, D, FIN(9) + l * D, 1.f, ((bf16_t*)(F.ws + WS_WKV)) + (size_t)(2 * l) * D * D, 0, r % I_SQ, lane, t); return; } r -= 4 * I_SQ;
    if (r < 4 * I_SQ) { const int l = r / I_SQ; p0_tr_desc(FIN(22) + (size_t)l * D * D, D, D, D, FIN(9) + l * D, 1.f, ((bf16_t*)(F.ws + WS_WKV)) + (size_t)(2 * l + 1) * D * D, 0, r % I_SQ, lane, t); return; } r -= 4 * I_SQ;
    if (r < 4 * I_SQ) { const int l = r / I_SQ; p0_tr_desc(FIN(23) + (size_t)l * D * D, D, D, D, nullptr, 1.f, ((bf16_t*)(F.ws + WS_WO)) + (size_t)l * D * D, 0, r % I_SQ, lane, t); return; } r -= 4 * I_SQ;
    { const int jg = r / I_PM; p0_tr_desc(FIN(11) + (size_t)jg * 65536, 256, 256, 256, nullptr, 1.f, ((bf16_t*)(F.ws + WS_PMT)) + (size_t)jg * 65536, 0, r % I_PM, lane, t); }
}
__device__ __forceinline__ void p0_tr_load(const TrItem& t, int lane, float (&v)[32], f32x4& g0, f32x4& g1) {
    const int c = lane & 7;
    g0 = (f32x4){t.sc, t.sc, t.sc, t.sc}; g1 = g0;
    if (t.gk) { g0 = *(const f32x4*)(t.gk + 8 * c) * t.sc; g1 = *(const f32x4*)(t.gk + 8 * c + 4) * t.sc; }
#pragma unroll
    for (int i = 0; i < 32; ++i) v[i] = t.wp[(size_t)(2 * i) * t.ldw];
}
__device__ __forceinline__ void p0_tr_finish(const TrItem& t, int lane, const float (&v)[32], f32x4 g0, f32x4 g1, LAS float* scr) {
#pragma unroll
    for (int i = 0; i < 32; ++i) scr[(2 * i + (lane >> 5)) * 33 + (lane & 31)] = v[i];
    LDS_WAIT(); asm volatile("" ::: "memory");
    const int c = lane & 7;
#pragma unroll
    for (int jj = 0; jj < 4; ++jj) {
        const int n = (lane >> 3) + 8 * jj; const LAS float* s = scr + (8 * c) * 33 + n;
        u32x4 o; o.x = cvt_pk_bf16(s[0 * 33] * g0[0], s[1 * 33] * g0[1]); o.y = cvt_pk_bf16(s[2 * 33] * g0[2], s[3 * 33] * g0[3]); o.z = cvt_pk_bf16(s[4 * 33] * g1[0], s[5 * 33] * g1[1]); o.w = cvt_pk_bf16(s[6 * 33] * g1[2], s[7 * 33] * g1[3]);
        *(u32x4*)(t.wt + (size_t)n * t.K + 8 * c) = o;
    }
    LDS_WAIT(); asm volatile("" ::: "memory");
}
__device__ __forceinline__ float p0_row_finish(const f32x4 (&v)[4], bf16_t* dst, float* copy, int lane) {
    float s = 0.f;
#pragma unroll
    for (int jj = 0; jj < 4; ++jj) s += dot4(v[jj], v[jj]);
    s = wave_sum(s, lane);
    u32x2* o8 = (u32x2*)dst + lane;
#pragma unroll
    for (int jj = 0; jj < 4; ++jj) o8[64 * jj] = pack4(v[jj]);
    if (copy) {
#pragma unroll
        for (int jj = 0; jj < 4; ++jj) ((f32x4*)copy + lane)[64 * jj] = v[jj];
    }
    return s;
}
namespace p0seg {
constexpr int I_AB1 = 16 * (NAB / 32), I_C1 = 16 * (NC / 32), I_2 = 32 * 32, I_SQ = 16 * 32, I_PM = 4 * 8;
constexpr int O_AB1 = 0, O_C1 = 2 * I_AB1, O_AB2 = O_C1 + 2 * I_C1, O_C2 = O_AB2 + 2 * I_2, O_Q = O_C2 + 2 * I_2, O_K = O_Q + 4 * I_SQ, O_V = O_K + 4 * I_SQ, O_O = O_V + 4 * I_SQ, O_P = O_O + 4 * I_SQ, NITEMS = O_P + 8 * I_PM;
constexpr int NA = I_AB1 + I_2 + I_SQ + 8 * I_SQ + I_SQ + 4 * I_PM, NB = NITEMS - NA;
__device__ __forceinline__ int item_a(int i) {
    if (i < I_AB1) return O_AB1 + i; i -= I_AB1;
    if (i < I_2) return O_AB2 + i; i -= I_2;
    if (i < I_SQ) return O_Q + i; i -= I_SQ;
    if (i < 8 * I_SQ) return O_K + i; i -= 8 * I_SQ;
    if (i < I_SQ) return O_O + i; i -= I_SQ;
    return O_P + i;
}
__device__ __forceinline__ int item_b(int i) {
    if (i < I_AB1) return O_AB1 + I_AB1 + i; i -= I_AB1;
    if (i < 2 * I_C1) return O_C1 + i; i -= 2 * I_C1;
    if (i < I_2) return O_AB2 + I_2 + i; i -= I_2;
    if (i < 2 * I_2) return O_C2 + i; i -= 2 * I_2;
    if (i < 3 * I_SQ) return O_Q + I_SQ + i; i -= 3 * I_SQ;
    if (i < 3 * I_SQ) return O_O + I_SQ + i; i -= 3 * I_SQ;
    return O_P + 4 * I_PM + i;
}
}
__device__ __forceinline__ void p0_weights(Frame& F0, int part, int gw, int NGW, int half = -1) {
    Frame F = launder(F0);
    LAS float* scr = (LAS float*)(F.lds + F.wave * 16384);
    const int lane = F.lane;
    constexpr int NB_ODD = (int)((long)p0seg::NB * PB_ODD_PCT / 100);
    const int base = (part == 1 && half == 0) ? NB_ODD : 0;
    const int n = part == 0 ? p0seg::NA : (part == 1 ? (half == 1 ? NB_ODD : (half == 0 ? p0seg::NB - NB_ODD : p0seg::NB)) : p0seg::NITEMS);
#define P0_ITEM(i_) (part == 0 ? p0seg::item_a(i_) : (part == 1 ? p0seg::item_b(base + (i_)) : (i_)))
    if (gw < n) {
        TrItem cur, nxt; float va[32], vb[32]; f32x4 ga0, ga1, gb0, gb1;
        p0_resolve(F, P0_ITEM(gw), lane, cur); p0_tr_load(cur, lane, va, ga0, ga1);
        for (int it = gw; it < n; it += 2 * NGW) {
            const bool h1 = it + NGW < n, h2 = it + 2 * NGW < n;
            if (h1) { p0_resolve(F, P0_ITEM(it + NGW), lane, nxt); p0_tr_load(nxt, lane, vb, gb0, gb1); }
            p0_tr_finish(cur, lane, va, ga0, ga1, scr);
            if (h2) { p0_resolve(F, P0_ITEM(it + 2 * NGW), lane, cur); p0_tr_load(cur, lane, va, ga0, ga1); }
            if (h1) p0_tr_finish(nxt, lane, vb, gb0, gb1, scr);
        }
    }
#undef P0_ITEM
}
__device__ __forceinline__ void p0_prologue(Frame& F0) {
    Frame F = launder(F0);
    const int gw = F.bx * NWAVES + F.wave, NGW = F.G * NWAVES, lane = F.lane;
    p0_weights(F0, (!MK_SPLIT && SPLIT_PROLOGUE) ? 0 : 2, gw, NGW);
    for (int m0 = 2 * gw; m0 < MP + MS + MMEM; m0 += 2 * NGW) {
        f32x4 v[2][4];
#pragma unroll
        for (int r = 0; r < 2; ++r) {
            const int m = m0 + r;
            const float* src = m < MP ? FIN(0) + (size_t)m * D : (m < MP + MS ? FIN(1) + (size_t)(m - MP) * D : FIN(2) + (size_t)(m - MP - MS) * D);
#pragma unroll
            for (int jj = 0; jj < 4; ++jj) v[r][jj] = ((const f32x4*)src + lane)[64 * jj];
        }
#pragma unroll
        for (int r = 0; r < 2; ++r) {
            const int m = m0 + r;
            if (m < MP) {
                const float s = p0_row_finish(v[r], ((bf16_t*)(F.ws + WS_XB)) + (size_t)m * D, nullptr, lane);
                if (lane < 16) ((float*)(F.ws + WS_RSQ))[(size_t)m * 16 + lane] = lane == 0 ? s : 0.f;
            } else if (m < MP + MS) {
                const int b = m - MP;
                const float s = p0_row_finish(v[r], ((bf16_t*)(F.ws + WS_XB)) + (size_t)m * D, ((float*)(F.ws + WS_XS)) + (size_t)b * D, lane);
                if (lane < 32) ((float*)(F.ws + WS_SMALL))[b * 32 + lane] = lane == 0 ? s : 0.f;
            } else {
                const int t = m - MP - MS;
                const float s = p0_row_finish(v[r], ((bf16_t*)(F.ws + WS_MEMB)) + (size_t)t * D, nullptr, lane);
                if (lane == 0) ((float*)(F.ws + WS_SMALL + 65536))[t] = rsqrtf(s * (1.0f / D) + EPS);
            }
        }
    }
}

__device__ __forceinline__ bf16x8 tr_frag(LAS unsigned char* p0, LAS unsigned char* p1) {
    const s16x4 lo = __builtin_amdgcn_ds_read_tr16_b64_v4i16((LAS s16x4*)p0);
    const s16x4 hi = __builtin_amdgcn_ds_read_tr16_b64_v4i16((LAS s16x4*)p1);
    return (bf16x8){lo[0], lo[1], lo[2], lo[3], hi[0], hi[1], hi[2], hi[3]};
}
#define MFMA16(a, b, c) __builtin_amdgcn_mfma_f32_16x16x32_bf16((a), (b), (c), 0, 0, 0)

constexpr int SGU_AS = 0, SGU_VS = 36864, SGU_RV = 36864 + 69632;
struct NoHook { __device__ __forceinline__ void operator()() const {} };
template <class Hook> __device__ __forceinline__ void sgu_chunk(Frame& F0, int j, int n, const int g0, const int g1, const Hook& hook) {
    Frame F = launder(F0);
    LAS unsigned char* lds = F.lds;
    const int tid = F.tid, lane = F.lane, w = F.wave, fr = lane & 15, fq = lane >> 4, row0 = n * 128;
    LAS float* rvs = (LAS float*)(lds + SGU_RV);
    if (tid < 128) rvs[tid] = rstd16(((float*)(F.ws + WS_VSQ)) + (size_t)(row0 + tid) * 16);
    const bf16_t* ZV = ((bf16_t*)(F.ws + WS_Z)) + (size_t)2 * MP * D + (size_t)row0 * D;
    const bf16_t* ZUG = ((bf16_t*)(F.ws + WS_Z)) + (size_t)3 * MP * D + (size_t)row0 * D;
    bf16_t* A2 = ((bf16_t*)(F.ws + WS_A2)) + (size_t)row0 * 2048 + 1024;
    const unsigned voff = (unsigned)(tid >> 5) * (D * 2) + (unsigned)(tid & 31) * 16u;
    const unsigned woff = (unsigned)(tid >> 4) * 512u + (unsigned)(tid & 15) * 32u;
    const int wt_t = tid >> 4, wt_s0 = (tid & 15) * 8;
    const unsigned aoff = (unsigned)(tid >> 5) * 4096u + (unsigned)(tid & 31) * 16u;
    u32x4 vt[8]; f32x4 wt[8];
#define SGU_LOAD(g_) do { const char* vb_ = (const char*)(ZV + (g_) * 256); const char* wb_ = (const char*)(FIN(13) + (size_t)(j * 4 + (g_)) * 16384); \
        _Pragma("unroll") for (int i_ = 0; i_ < 8; ++i_) vt[i_] = *(const u32x4*)(vb_ + (size_t)(16 * i_) * D * 2 + voff); \
        _Pragma("unroll") for (int i_ = 0; i_ < 4; ++i_) { wt[2 * i_] = *(const f32x4*)(wb_ + (size_t)(32 * i_) * 512 + woff); wt[2 * i_ + 1] = *(const f32x4*)(wb_ + (size_t)(32 * i_) * 512 + woff + 16); } } while (0)
    SGU_LOAD(g0);
    LDS_BARRIER();
#pragma unroll
    for (int g = g0; g < g1; ++g) {
#pragma unroll
        for (int i = 0; i < 8; ++i) *(LAS u32x4*)(lds + SGU_VS + ((tid >> 5) + 16 * i) * 544 + (tid & 31) * 16) = vt[i];
#pragma unroll
        for (int i = 0; i < 4; ++i) {
            const int t = wt_t + 32 * i; float v[8];
#pragma unroll
            for (int e = 0; e < 4; ++e) { v[e] = (wt_s0 + e <= t) ? wt[2 * i][e] * rvs[wt_s0 + e] : 0.f; v[4 + e] = (wt_s0 + 4 + e <= t) ? wt[2 * i + 1][e] * rvs[wt_s0 + 4 + e] : 0.f; }
            u32x4 o; o.x = cvt_pk_bf16(v[0], v[1]); o.y = cvt_pk_bf16(v[2], v[3]); o.z = cvt_pk_bf16(v[4], v[5]); o.w = cvt_pk_bf16(v[6], v[7]);
            *(LAS u32x4*)(lds + SGU_AS + t * 288 + wt_s0 * 2) = o;
        }
        LDS_BARRIER();
        const int cg = g * 256 + 32 * w + 8 * fq;
        const unsigned lo_in = (unsigned)fr * (D * 2) + (unsigned)(32 * w + 8 * fq) * 2u, lo_out = (unsigned)fr * 4096u + (unsigned)(32 * w + 8 * fq) * 2u;
        u32x4 ugr[8];
#pragma unroll
        for (int mt = 0; mt < 8; ++mt) ugr[mt] = *(const u32x4*)((const char*)(ZUG + (size_t)(16 * mt) * D + g * 256) + lo_in);
        f32x4 ggv[2]; float bbv[8];
#pragma unroll
        for (int nt = 0; nt < 2; ++nt) ggv[nt] = *(const f32x4*)(FIN(15) + j * 1024 + cg + 4 * nt);
#pragma unroll
        for (int mt = 0; mt < 8; ++mt) bbv[mt] = FIN(14)[(j * 4 + g) * 128 + 16 * mt + fr];
        if (g + 1 < g1) SGU_LOAD(g + 1); else hook();
        f32x4 acc[8][2];
#pragma unroll
        for (int mt = 0; mt < 8; ++mt) { acc[mt][0] = (f32x4){0.f, 0.f, 0.f, 0.f}; acc[mt][1] = (f32x4){0.f, 0.f, 0.f, 0.f}; }
#pragma unroll
        for (int ks = 0; ks < 4; ++ks) {
            bf16x8 Bf[2];
#pragma unroll
            for (int nt = 0; nt < 2; ++nt) {
                LAS unsigned char* p = lds + SGU_VS + (32 * ks + 8 * fq + (fr >> 2)) * 544 + (32 * w + 8 * (fr & 3) + 4 * nt) * 2;
                Bf[nt] = tr_frag(p, p + 4 * 544);
            }
            bf16x8 Af[8];
#pragma unroll
            for (int mt = 0; mt < 8; ++mt) if (32 * ks <= 16 * mt + 15) Af[mt] = *(LAS bf16x8*)(lds + SGU_AS + (16 * mt + fr) * 288 + (32 * ks + 8 * fq) * 2);
#pragma unroll
            for (int mt = 0; mt < 8; ++mt) if (32 * ks <= 16 * mt + 15) { acc[mt][0] = MFMA16(Bf[0], Af[mt], acc[mt][0]); acc[mt][1] = MFMA16(Bf[1], Af[mt], acc[mt][1]); }
        }
#pragma unroll
        for (int mt = 0; mt < 8; ++mt) {
            const float bb = bbv[mt];
            f32x4 u0, u1; unpack8(ugr[mt], u0, u1);
            *(u32x4*)((char*)(A2 + (size_t)(16 * mt) * 2048 + g * 256) + lo_out) = pack8(u0 * (acc[mt][0] * ggv[0] + bb), u1 * (acc[mt][1] * ggv[1] + bb));
        }
        LDS_BARRIER();
    }
#undef SGU_LOAD
}
constexpr int POOL_AP = 15 * 544;
__device__ __forceinline__ void pool_fetch(const bf16_t* xau  , int tid, int posc  , u32x4 (&own)[8], u32x4& halo) {
    asm volatile("" : "+v"(tid));
    const int cb = tid & 31, hr = tid >> 5;
    const char* base = (const char*)xau + (unsigned)((hr * 8) * D + cb * 8) * 2u;
#pragma unroll
    for (int r = 0; r < 8; ++r) own[r] = *(const u32x4*)(base + (size_t)r * D * 2);
    halo = (u32x4){0u, 0u, 0u, 0u};
    if (hr < 15 && posc > 0) halo = *(const u32x4*)((const char*)(xau + (ptrdiff_t)(hr - 15) * D) + cb * 16);
}
template <int WIN> __device__ __forceinline__ void pool_stage(const u32x4 (&own)[8], const u32x4& halo, LAS unsigned char* lds, int tid, int pos0) {
    const int cb = tid & 31, hr = tid >> 5;
    LAS unsigned char* rawp = lds + (15 + hr * 8) * 544 + cb * 16;
#pragma unroll
    for (int r = 0; r < 8; ++r) *(LAS u32x4*)(rawp + r * 544) = own[r];
    if (hr < 15) *(LAS u32x4*)(lds + hr * 544 + cb * 16) = halo;
    LDS_BARRIER();
    f32x4 S0 = (f32x4){0.f, 0.f, 0.f, 0.f}, S1 = S0;
#pragma unroll
    for (int i = 0; i < WIN - 1; ++i) { f32x4 a, b; unpack8(*(LAS u32x4*)(rawp + (i - (WIN - 1)) * 544), a, b); S0 += a; S1 += b; }
    u32x4 out[8];
#pragma unroll
    for (int r = 0; r < 8; ++r) {
        f32x4 a, b; unpack8(own[r], a, b); S0 += a; S1 += b;
        const int cnt = (pos0 + r + 1) < WIN ? (pos0 + r + 1) : WIN; const float ic = 1.0f / (float)cnt;
        out[r] = pack8(S0 * ic - a, S1 * ic - b);
        f32x4 c, d; unpack8(*(LAS u32x4*)(rawp + (r - (WIN - 1)) * 544), c, d); S0 -= c; S1 -= d;
    }
    LDS_BARRIER();
#pragma unroll
    for (int r = 0; r < 8; ++r) *(LAS u32x4*)(rawp + r * 544) = out[r];
    LDS_BARRIER();
}
template <class Hook> __device__ __forceinline__ void pool_mma_epi(Frame& F, int j, int g, int row0, const bf16_t* ZSGA, bf16_t* A2, LAS unsigned char* lds  , int w, int fr, int fq, const Hook& hook) {
    const int cg = g * 256 + 32 * w + 8 * fq;
    const unsigned lo_in = (unsigned)fr * (D * 2) + (unsigned)(32 * w + 8 * fq) * 2u, lo_out = (unsigned)fr * 4096u + (unsigned)(32 * w + 8 * fq) * 2u, lo_pm = (unsigned)(32 * w + 8 * (fr >> 2) + (fr & 3)) * 512u + (unsigned)fq * 16u;
    u32x4 sgr[8];
#pragma unroll
    for (int mt = 0; mt < 8; ++mt) sgr[mt] = *(const u32x4*)((const char*)(ZSGA + (size_t)(16 * mt) * D + g * 256) + lo_in);
    f32x4 acc[8][2];
#pragma unroll
    for (int mt = 0; mt < 8; ++mt) { acc[mt][0] = (f32x4){0.f, 0.f, 0.f, 0.f}; acc[mt][1] = (f32x4){0.f, 0.f, 0.f, 0.f}; }
    const bf16_t* pm = ((bf16_t*)(F.ws + WS_PMT)) + (size_t)(j * 4 + g) * 65536;
    bf16x8 Bq[8][2]; f32x4 psv[2];
#pragma unroll
    for (int ks = 0; ks < 8; ++ks) { Bq[ks][0] = *(const bf16x8*)((const char*)(pm + 32 * ks) + lo_pm); Bq[ks][1] = *(const bf16x8*)((const char*)(pm + 4 * 256 + 32 * ks) + lo_pm); }
#pragma unroll
    for (int nt = 0; nt < 2; ++nt) psv[nt] = *(const f32x4*)(FIN(12) + j * 1024 + cg + 4 * nt);
    hook();
    {
        bf16x8 Af[2][4];
#define POOL_AREAD(n_, buf_) do { _Pragma("unroll") for (int m4_ = 0; m4_ < 4; ++m4_) Af[buf_][m4_] = *(LAS bf16x8*)(lds + (16 * (4 * ((n_) & 1) + m4_) + fr) * 544 + (32 * ((n_) >> 1) + 8 * fq) * 2); } while (0)
        POOL_AREAD(0, 0);
        __builtin_amdgcn_sched_group_barrier(0x100, 4, 0);
#pragma unroll
        for (int n = 0; n < 16; ++n) {
            if (n < 15) POOL_AREAD(n + 1, (n + 1) & 1);
#pragma unroll
            for (int m4 = 0; m4 < 4; ++m4) { const int mt = 4 * (n & 1) + m4, ks = n >> 1; acc[mt][0] = MFMA16(Bq[ks][0], Af[n & 1][m4], acc[mt][0]); acc[mt][1] = MFMA16(Bq[ks][1], Af[n & 1][m4], acc[mt][1]); }
            if (n < 15) __builtin_amdgcn_sched_group_barrier(0x100, 4, 0);
            __builtin_amdgcn_sched_group_barrier(0x008, 8, 0);
        }
#undef POOL_AREAD
    }
#pragma unroll
    for (int mt = 0; mt < 8; ++mt) {
        f32x4 s0, s1; unpack8(sgr[mt], s0, s1);
        *(u32x4*)((char*)(A2 + (size_t)(16 * mt) * 2048 + g * 256) + lo_out) = pack8(acc[mt][0] * psv[0] * s0, acc[mt][1] * psv[1] * s1);
    }
}
template <int GA, int GB> __device__ __forceinline__ void pool_pair(Frame& F0, int j, int n, const u32x4 (&ownA)[8], const u32x4& haloA) {
    Frame F = launder(F0);
    LAS unsigned char* lds = F.lds;
    const int tid = F.tid, lane = F.lane, w = F.wave, fr = lane & 15, fq = lane >> 4, row0 = n * 128;
    const int pos0 = (row0 & 2047) + (tid >> 5) * 8;
    const bf16_t* xa = ((bf16_t*)(F.ws + WS_Z)) + (size_t)row0 * D;
    const bf16_t* ZSGA = ((bf16_t*)(F.ws + WS_Z)) + (size_t)1 * MP * D + (size_t)row0 * D;
    bf16_t* A2 = ((bf16_t*)(F.ws + WS_A2)) + (size_t)row0 * 2048;
    constexpr int WA = 2 << GA, WB = 2 << GB;
    pool_stage<WA>(ownA, haloA, lds, tid, pos0);
    u32x4 ownB[8], haloB;
    pool_mma_epi(F, j, GA, row0, ZSGA, A2, lds + POOL_AP, w, fr, fq, [&]() { pool_fetch(xa + GB * 256, tid, row0 & 2047, ownB, haloB); }); LDS_BARRIER();
    pool_stage<WB>(ownB, haloB, lds, tid, pos0);
    pool_mma_epi(F, j, GB, row0, ZSGA, A2, lds + POOL_AP, w, fr, fq, NoHook{}); LDS_BARRIER();
}
constexpr int ATT_SLOT = 64 * 544;
__device__ __forceinline__ void attn_prompt(Frame& F0, int layer) {
    Frame F = launder(F0);
    LAS unsigned char* lds = F.lds;
    const int tid = F.tid, lane = F.lane, w = F.wave, fr = lane & 15, fq = lane >> 4;
    const bf16_t* Kl = ((bf16_t*)(F.ws + WS_KB)) + (size_t)layer * MMEM * D; const bf16_t* Vl = ((bf16_t*)(F.ws + WS_VB)) + (size_t)layer * MMEM * D;
    for (int kk = F.rk; kk < 64; kk += F.rw) {
        const int b = F.xq, h = kk >> 4, qb = kk & 15;
        const size_t rowq = (size_t)b * SEQ + qb * 128 + 16 * w + fr;
        bf16x8 Qf[8];
#pragma unroll
        for (int ks = 0; ks < 8; ++ks) Qf[ks] = *(const bf16x8*)(((bf16_t*)(F.ws + WS_Q)) + rowq * D + h * 256 + 32 * ks + 8 * fq);
        const bf16_t* kbase = Kl + (size_t)(b * 256) * D + h * 256; const bf16_t* vbase = Vl + (size_t)(b * 256) * D + h * 256;
        u32x4 st[4];
#define ATT_GLOAD(c) do { const bf16_t* src_ = ((c) < 4 ? kbase : vbase) + (size_t)(64 * ((c) & 3)) * D; _Pragma("unroll") for (int i_ = 0; i_ < 4; ++i_) { const int idx_ = tid + 512 * i_; st[i_] = *(const u32x4*)(src_ + (size_t)(idx_ >> 5) * D + (idx_ & 31) * 8); } } while (0)
#define ATT_LSTORE(slot) do { _Pragma("unroll") for (int i_ = 0; i_ < 4; ++i_) { const int idx_ = tid + 512 * i_; *(LAS u32x4*)(lds + (slot) * ATT_SLOT + (idx_ >> 5) * 544 + (idx_ & 31) * 16) = st[i_]; } } while (0)
        f32x4 S[16], Oa[16]; bf16x8 Pf[8]; float inv = 0.f;
#pragma unroll
        for (int i = 0; i < 16; ++i) { S[i] = (f32x4){0.f, 0.f, 0.f, 0.f}; Oa[i] = (f32x4){0.f, 0.f, 0.f, 0.f}; }
        ATT_GLOAD(0); ATT_LSTORE(0); __syncthreads();
#pragma unroll
        for (int c = 0; c < 8; ++c) {
            if (c < 7) ATT_GLOAD(c + 1);
            LAS unsigned char* slot = lds + (c & 1) * ATT_SLOT;
            if (c < 4) {
#pragma unroll
                for (int ml = 0; ml < 4; ++ml)
#pragma unroll
                    for (int ks = 0; ks < 8; ++ks) {
                        const bf16x8 Kf = *(LAS bf16x8*)(slot + (16 * ml + fr) * 544 + (32 * ks + 8 * fq) * 2);
                        S[4 * c + ml] = MFMA16(Kf, Qf[ks], S[4 * c + ml]);
                    }
                if (c == 3) {
                    float mx = S[0][0];
#pragma unroll
                    for (int i = 0; i < 16; ++i) { mx = fmaxf(mx, fmaxf(fmaxf(S[i][0], S[i][1]), fmaxf(S[i][2], S[i][3]))); }
                    mx = fmaxf(mx, shx(mx, 16, lane)); mx = fmaxf(mx, shx(mx, 32, lane));
                    float sum = 0.f;
#pragma unroll
                    for (int i = 0; i < 16; ++i) {
#pragma unroll
                        for (int e = 0; e < 4; ++e) { S[i][e] = __builtin_amdgcn_exp2f(S[i][e] - mx); sum += S[i][e]; }
                    }
                    sum += shx(sum, 16, lane); sum += shx(sum, 32, lane);
                    inv = 1.0f / sum;
#pragma unroll
                    for (int a = 0; a < 8; ++a) {
                        u32x4 pw; pw.x = cvt_pk_bf16(S[2 * a][0], S[2 * a][1]); pw.y = cvt_pk_bf16(S[2 * a][2], S[2 * a][3]); pw.z = cvt_pk_bf16(S[2 * a + 1][0], S[2 * a + 1][1]); pw.w = cvt_pk_bf16(S[2 * a + 1][2], S[2 * a + 1][3]);
                        Pf[a] = __builtin_bit_cast(bf16x8, pw);
                    }
                }
            } else {
#pragma unroll
                for (int al = 0; al < 2; ++al)
#pragma unroll
                    for (int dt = 0; dt < 16; ++dt) {
                        LAS unsigned char* p = slot + (32 * al + 4 * fq + (fr >> 2)) * 544 + (16 * dt + 4 * (fr & 3)) * 2;
                        const bf16x8 Vf = tr_frag(p, p + 16 * 544);
                        Oa[dt] = MFMA16(Vf, Pf[2 * (c - 4) + al], Oa[dt]);
                    }
            }
            if (c < 7) ATT_LSTORE((c + 1) & 1);
            __syncthreads();
        }
#pragma unroll
        for (int dt = 0; dt < 16; ++dt) *(u32x2*)(((bf16_t*)(F.ws + WS_O)) + rowq * D + h * 256 + 16 * dt + 4 * fq) = pack4(Oa[dt] * inv);
#undef ATT_GLOAD
#undef ATT_LSTORE
    }
}

template <class Epi, int N>
__device__ __forceinline__ void sgemm16(Frame& F0, const bf16_t* A, const bf16_t* Bt, int K, const Epi& E) {
    Frame F = launder(F0);
    LAS unsigned char* lds = F.lds;
    constexpr int CW = N / 32, NT = CW / 16, KS = NT == 2 ? 8 : (NT == 10 ? 4 : 2), NG = 8 / KS, NTW = NT / NG;
    static_assert(NT * 16 == CW && NTW * NG == NT && 2 * CW <= NWAVES * 64, "sgemm16 geometry");
    const int tid = F.tid, lane = F.lane, w = F.wave, fr = lane & 15, fq = lane >> 4;
    const int ksi = w % KS, ng = w / KS, kslice = K / KS, nkb = kslice / 128;
    const bf16_t* A16 = A + (size_t)(16 * F.xq) * K;
    for (int slot = F.rk; slot < 32; slot += F.rw) {
        const int erow = tid / (CW / 8), ecg = tid % (CW / 8); const bool eact = tid < 2 * CW;
        typename Epi::Pre pre{};
        if (eact) pre = E.pre(16 * F.xq + erow, slot * CW + 8 * ecg);
        f32x4 acc[NTW];
#pragma unroll
        for (int jn = 0; jn < NTW; ++jn) acc[jn] = (f32x4){0.f, 0.f, 0.f, 0.f};
        const bf16_t* ap = A16 + (size_t)fr * K + ksi * kslice + 8 * fq;
        const bf16_t* bp = Bt + (size_t)(slot * CW + (ng * NTW) * 16 + fr) * K + ksi * kslice + 8 * fq;
        {
            bf16x8 Af[2][4], Bf[2][4][NTW];
#define SG_LOAD(kb_, buf_) do { _Pragma("unroll") for (int k4 = 0; k4 < 4; ++k4) { Af[buf_][k4] = *(const bf16x8*)(ap + 128 * (kb_) + 32 * k4); \
                _Pragma("unroll") for (int jn = 0; jn < NTW; ++jn) Bf[buf_][k4][jn] = *(const bf16x8*)(bp + (size_t)(16 * jn) * K + 128 * (kb_) + 32 * k4); } } while (0)
            SG_LOAD(0, 0);
            for (int kb = 0; kb < nkb; kb += 2) {
                if (kb + 1 < nkb) SG_LOAD(kb + 1, 1);
#pragma unroll
                for (int k4 = 0; k4 < 4; ++k4)
#pragma unroll
                    for (int jn = 0; jn < NTW; ++jn) acc[jn] = MFMA16(Bf[0][k4][jn], Af[0][k4], acc[jn]);
                if (kb + 1 < nkb) {
                    if (kb + 2 < nkb) SG_LOAD(kb + 2, 0);
#pragma unroll
                    for (int k4 = 0; k4 < 4; ++k4)
#pragma unroll
                        for (int jn = 0; jn < NTW; ++jn) acc[jn] = MFMA16(Bf[1][k4][jn], Af[1][k4], acc[jn]);
                }
            }
#undef SG_LOAD
        }
#pragma unroll
        for (int jn = 0; jn < NTW; ++jn) *(LAS f32x4*)(lds + ((size_t)((ksi * 16 + fr) * CW + (ng * NTW + jn) * 16 + 4 * fq)) * 4) = acc[jn];
        LDS_BARRIER();
        if (eact) {
            f32x4 s0 = (f32x4){0.f, 0.f, 0.f, 0.f}, s1 = s0;
#pragma unroll
            for (int kk = 0; kk < KS; ++kk) { const LAS f32x4* p = (const LAS f32x4*)(lds + ((size_t)((kk * 16 + erow) * CW + 8 * ecg)) * 4); s0 += p[0]; s1 += p[1]; }
            E(16 * F.xq + erow, slot, slot * CW + 8 * ecg, s0, s1, pre);
        }
        LDS_BARRIER();
    }
}
struct SEpiZ {
    struct Pre { float rs; };
    const float* rsqs; float* SZ; int ldz, mode;
    __device__ __forceinline__ Pre pre(int row, int col) const { return Pre{rstd32(rsqs + row * 32)}; }
    __device__ __forceinline__ void operator()(int row, int strip, int col, f32x4 s0, f32x4 s1, const Pre& p) const {
        const int oc0 = mode == 0 ? src_even(col) : src_odd(col), oc1 = mode == 0 ? src_even(col + 4) : src_odd(col + 4);
        float* q = SZ + (size_t)row * ldz; *(f32x4*)(q + oc0) = s0 * p.rs; *(f32x4*)(q + oc1) = s1 * p.rs;
    }
};
struct SEpiRes {
    struct Pre { f32x4 x0, x1; };
    float* xs; bf16_t* xb; float* rsqs;
    __device__ __forceinline__ Pre pre(int row, int col) const { const float* q = xs + (size_t)row * D + col; return Pre{*(const f32x4*)q, *(const f32x4*)(q + 4)}; }
    __device__ __forceinline__ void operator()(int row, int strip, int col, f32x4 s0, f32x4 s1, const Pre& pr) const {
        float* p = xs + (size_t)row * D + col; const f32x4 o0 = pr.x0 + s0, o1 = pr.x1 + s1;
        *(f32x4*)p = o0; *(f32x4*)(p + 4) = o1; *(u32x4*)(xb + (size_t)row * D + col) = pack8(o0, o1);
        const int ln = ((row & 15) << 2) | ((col >> 3) & 3);
        float ss = dot4(o0, o0) + dot4(o1, o1); ss += shx(ss, 1, ln); ss += shx(ss, 2, ln);
        if ((col & 31) == 0) rsqs[row * 32 + strip] = ss;
    }
};
struct SEpiQ {
    struct Pre { float rs; };
    const float* rsqs; float* SQ;
    __device__ __forceinline__ Pre pre(int row, int col) const { return Pre{rstd32(rsqs + row * 32)}; }
    __device__ __forceinline__ void operator()(int row, int strip, int col, f32x4 s0, f32x4 s1, const Pre& p) const {
        float* q = SQ + (size_t)row * D + col; *(f32x4*)q = s0 * p.rs; *(f32x4*)(q + 4) = s1 * p.rs;
    }
};
__device__ __forceinline__ void sample_mix_even(Frame& F0, int j, int b) {
    Frame F = launder(F0);
    LAS float* pl = (LAS float*)F.lds; LAS float* red = pl + 1024;
    const int tid = F.tid, lane = F.lane, w = F.wave;
    const float* z = ((float*)(F.ws + WS_SZ)) + (size_t)b * 8192;
    float vv[2], ss = 0.f;
#pragma unroll
    for (int k = 0; k < 2; ++k) { vv[k] = z[3072 + tid + 512 * k]; ss += vv[k] * vv[k]; }
    ss = wave_sum(ss, lane); if (lane == 0) red[w] = ss;
#pragma unroll
    for (int k = 0; k < 2; ++k) {
        const int c = tid + 512 * k, g = c >> 8, win = 2 << g; const float xa = z[c];
        const float* st = FIN(3) + ((size_t)(j * 128 + b) * 15) * 1024 + c;
        float sr[15];
#pragma unroll
        for (int r = 0; r < 15; ++r) sr[r] = st[(size_t)r * 1024];
        float s = xa;
#pragma unroll
        for (int r = 0; r < 15; ++r) s += (r >= 16 - win) ? sr[r] : 0.f;
        pl[c] = s / (float)win - xa;
        float* po = F.out + O_POOLS + ((size_t)(j * 128 + b) * 15) * 1024 + c;
#pragma unroll
        for (int r = 0; r < 14; ++r) po[(size_t)r * 1024] = sr[r + 1];
        po[(size_t)14 * 1024] = xa;
    }
    __syncthreads();
    float tot = 0.f;
#pragma unroll
    for (int i = 0; i < 8; ++i) tot += red[i];
    const float rv = rsqrtf(tot * (1.0f / D) + EPS);
#pragma unroll
    for (int k = 0; k < 2; ++k) {
        const int d = tid + 512 * k, g = d >> 8, dd = d & 255;
        const bf16_t* pm = ((bf16_t*)(F.ws + WS_PMT)) + (size_t)(j * 4 + g) * 65536 + (size_t)dd * 256; const LAS float* pg = pl + g * 256;
        float a = 0.f;
#pragma unroll
        for (int hb = 0; hb < 2; ++hb) {
            u32x4 pr[16];
#pragma unroll
            for (int i = 0; i < 16; ++i) pr[i] = *(const u32x4*)(pm + hb * 128 + i * 8);
#pragma unroll
            for (int i = 0; i < 16; ++i) { f32x4 p0, p1; unpack8(pr[i], p0, p1); const LAS float* q = pg + hb * 128 + i * 8; a += dot4(p0, *(const LAS f32x4*)q) + dot4(p1, *(const LAS f32x4*)(q + 4)); }
        }
        const float ya = a * FIN(12)[j * 1024 + d] * silu_f(z[1024 + d]);
        const float vn = vv[k] * rv * FIN(15)[j * 1024 + d];
        F.out[O_SGUV + (size_t)(j * 128 + b) * 1024 + d] = vn;
        const float mixed = FIN(13)[(size_t)(j * 4 + g) * 16384] * vn + FIN(14)[(j * 4 + g) * 128];
        const float yb = z[2048 + d] * mixed * silu_f(z[4096 + d]);
        ((bf16_t*)(F.ws + WS_SA2))[(size_t)b * 2048 + d] = (bf16_t)(cvt_pk_bf16(ya, 0.f) & 0xffffu); ((bf16_t*)(F.ws + WS_SA2))[(size_t)b * 2048 + 1024 + d] = (bf16_t)(cvt_pk_bf16(yb, 0.f) & 0xffffu);
    }
    __syncthreads();
}
__device__ __forceinline__ void sample_conv_odd(Frame& F0, int j, int b) {
    Frame F = launder(F0);
    const int tid = F.tid;
    const float* z = ((float*)(F.ws + WS_SZ)) + (size_t)b * 8192;
    const float* cw = FIN(18) + (size_t)j * 3 * 2048;
#pragma unroll
    for (int k = 0; k < 4; ++k) {
        const int c = tid + 512 * k;
        const float e = z[2048 + c] * z[4096 + c];
        const float s0 = FIN(4)[((size_t)(j * 128 + b) * 2 + 0) * 2048 + c], s1 = FIN(4)[((size_t)(j * 128 + b) * 2 + 1) * 2048 + c];
        const float y = cw[c] * s0 + cw[2048 + c] * s1 + cw[4096 + c] * e;
        ((bf16_t*)(F.ws + WS_SA2))[(size_t)b * 2048 + c] = (bf16_t)(cvt_pk_bf16(z[c] * y * silu_f(z[6144 + c]), 0.f) & 0xffffu);
        float* po = F.out + O_CONVS + ((size_t)(j * 128 + b) * 2) * 2048 + c; po[0] = s1; po[2048] = e;
    }
}
__device__ __forceinline__ void attn_sample(Frame& F0, int layer) {
    Frame F = launder(F0);
    LAS float* sc = (LAS float*)F.lds;
    LAS float* red = sc + 512;
    const int tid = F.tid, lane = F.lane, w = F.wave;
    for (int item = F.rk; item < 32; item += F.rw) {
        const int b = 16 * F.xq + (item >> 1), hp = item & 1;
        const float* qp = ((float*)(F.ws + WS_SQ)) + (size_t)b * D + hp * 512;
        const f32x4 q0 = *(const f32x4*)(qp + 4 * lane), q1 = *(const f32x4*)(qp + 256 + 4 * lane);
        const float* kp = FIN(5) + ((size_t)(layer * 128 + b) * 256) * 1024 + hp * 512 + 4 * lane;
        const float* vp = FIN(6) + ((size_t)(layer * 128 + b) * 256) * 1024 + hp * 512 + 4 * lane;
#pragma unroll 8
        for (int mi = 0; mi < 32; ++mi) {
            const int m = 32 * w + mi;
            const f32x4 k0 = __builtin_nontemporal_load((const f32x4*)(kp + (size_t)m * 1024)), k1 = __builtin_nontemporal_load((const f32x4*)(kp + (size_t)m * 1024 + 256));
            const float d0 = wave_sum(dot4(k0, q0), lane), d1 = wave_sum(dot4(k1, q1), lane);
            if (lane == 0) { sc[m] = d0; sc[256 + m] = d1; }
        }
        __syncthreads();
        float p0[4], p1[4], mx0 = -INFINITY, mx1 = -INFINITY;
#pragma unroll
        for (int i = 0; i < 4; ++i) { p0[i] = sc[lane + 64 * i]; p1[i] = sc[256 + lane + 64 * i]; mx0 = fmaxf(mx0, p0[i]); mx1 = fmaxf(mx1, p1[i]); }
#pragma unroll
        for (int o = 1; o < 64; o <<= 1) { mx0 = fmaxf(mx0, shx(mx0, o, lane)); mx1 = fmaxf(mx1, shx(mx1, o, lane)); }
        float sm0 = 0.f, sm1 = 0.f;
#pragma unroll
        for (int i = 0; i < 4; ++i) { p0[i] = __builtin_amdgcn_exp2f(p0[i] - mx0); p1[i] = __builtin_amdgcn_exp2f(p1[i] - mx1); sm0 += p0[i]; sm1 += p1[i]; }
        sm0 = wave_sum(sm0, lane); sm1 = wave_sum(sm1, lane);
        const float i0 = 1.0f / sm0, i1 = 1.0f / sm1;
        __syncthreads();
        if (w == 0) {
#pragma unroll
            for (int i = 0; i < 4; ++i) { sc[lane + 64 * i] = p0[i] * i0; sc[256 + lane + 64 * i] = p1[i] * i1; }
        }
        __syncthreads();
        f32x4 a0 = (f32x4){0.f, 0.f, 0.f, 0.f}, a1 = a0;
#pragma unroll 8
        for (int mi = 0; mi < 32; ++mi) {
            const int m = 32 * w + mi;
            const f32x4 v0 = __builtin_nontemporal_load((const f32x4*)(vp + (size_t)m * 1024)), v1 = __builtin_nontemporal_load((const f32x4*)(vp + (size_t)m * 1024 + 256));
            a0 += v0 * sc[m]; a1 += v1 * sc[256 + m];
        }
        *(LAS f32x4*)(red + w * 512 + 4 * lane) = a0; *(LAS f32x4*)(red + w * 512 + 256 + 4 * lane) = a1;
        __syncthreads();
        {
            float o = 0.f;
#pragma unroll
            for (int ww = 0; ww < 8; ++ww) o += red[ww * 512 + tid];
            ((bf16_t*)(F.ws + WS_SO))[(size_t)b * D + hp * 512 + tid] = (bf16_t)(cvt_pk_bf16(o, 0.f) & 0xffffu);
        }
        __syncthreads();
    }
}
#define dpp_mov(v, ctrl, row_mask) __builtin_bit_cast(float, __builtin_amdgcn_update_dpp(0, __builtin_bit_cast(int, (float)(v)), (ctrl), (row_mask), 0xf, false))
__device__ __forceinline__ float wave_sum_dpp(float x) {
    x += dpp_mov(x, 0xB1, 0xf);
    x += dpp_mov(x, 0x4E, 0xf);
    x += dpp_mov(x, 0x141, 0xf);
    x += dpp_mov(x, 0x140, 0xf);
    x += dpp_mov(x, 0x142, 0xa);
    x += dpp_mov(x, 0x143, 0xc);
    return x;
}
constexpr int FA_SC = 69632, FA_RED = 71680;
__device__ __forceinline__ void attn_fused(Frame& F0, int layer) {
    Frame F = launder(F0);
    LAS unsigned char* lds = F.lds;
    const int tid = F.tid, lane = F.lane, w = F.wave, fr = lane & 15, fq = lane >> 4;
    const bf16_t* Kl = ((bf16_t*)(F.ws + WS_KB)) + (size_t)layer * MMEM * D; const bf16_t* Vl = ((bf16_t*)(F.ws + WS_VB)) + (size_t)layer * MMEM * D;
    LAS float* sc = (LAS float*)(lds + FA_SC); LAS float* red = (LAS float*)(lds + FA_RED);
    const int sb = 16 * F.xq + (F.rk >> 1), hp = F.rk & 1;
    const float* qp = ((float*)(F.ws + WS_SQ)) + (size_t)sb * D + hp * 512;
    const f32x4 q0 = *(const f32x4*)(qp + 4 * lane), q1 = *(const f32x4*)(qp + 256 + 4 * lane);
    const float* kp = FIN(5) + ((size_t)(layer * 128 + sb) * 256 + 4 * w) * 1024 + hp * 512;
    const float* vp = FIN(6) + ((size_t)(layer * 128 + sb) * 256 + 4 * w) * 1024 + hp * 512;
    const unsigned lo16 = (unsigned)lane * 16u;
    f32x4 sv[8]; f32x4 a0 = (f32x4){0.f, 0.f, 0.f, 0.f}, a1 = a0; float mx0 = 0.f, mx1 = 0.f, iv0 = 0.f, iv1 = 0.f;
#define FA_SLOAD(base, slice) do { unsigned long long pu_ = uni64((unsigned long long)((base) + (size_t)(32 * (slice)) * 1024)); asm volatile("" : "+s"(pu_)); const char* pc_ = (const char*)(const GAS char*)pu_; \
        _Pragma("unroll") for (int r_ = 0; r_ < 4; ++r_) { sv[2 * r_] = __builtin_nontemporal_load((const f32x4*)(pc_ + r_ * 4096 + lo16)); sv[2 * r_ + 1] = __builtin_nontemporal_load((const f32x4*)(pc_ + r_ * 4096 + 1024 + lo16)); } } while (0)
    FA_SLOAD(kp, 0);
#pragma unroll 1
    for (int ui = 0; ui < 2; ++ui) {
        const int kk = 2 * F.rk + ui;
        const int b = F.xq, h = kk >> 4, qb = kk & 15;
        const size_t rowq = (size_t)b * SEQ + qb * 128 + 16 * w + fr;
        bf16x8 Qf[8];
#pragma unroll
        for (int ks = 0; ks < 8; ++ks) Qf[ks] = *(const bf16x8*)(((bf16_t*)(F.ws + WS_Q)) + rowq * D + h * 256 + 32 * ks + 8 * fq);
        const bf16_t* kbase = Kl + (size_t)(b * 256) * D + h * 256; const bf16_t* vbase = Vl + (size_t)(b * 256) * D + h * 256;
        u32x4 st[4];
        const unsigned goff = (unsigned)(tid >> 5) * (D * 2) + (unsigned)(tid & 31) * 16u, loff = (unsigned)(tid >> 5) * 544u + (unsigned)(tid & 31) * 16u;
#define ATT_GLOAD(c) do { unsigned long long pu_ = uni64((unsigned long long)(((c) < 4 ? kbase : vbase) + (size_t)(64 * ((c) & 3)) * D)); asm volatile("" : "+s"(pu_)); const char* pc_ = (const char*)(const GAS char*)pu_; \
        _Pragma("unroll") for (int i_ = 0; i_ < 4; ++i_) st[i_] = *(const u32x4*)(pc_ + (size_t)(16 * i_) * D * 2 + goff); } while (0)
#define ATT_LSTORE(c) do { _Pragma("unroll") for (int i_ = 0; i_ < 4; ++i_) *(LAS u32x4*)(lds + ((c) & 1) * ATT_SLOT + 16 * i_ * 544 + loff) = st[i_]; } while (0)
        f32x4 S[16], Oa[16]; bf16x8 Pf[8]; float inv = 0.f;
        const f32x4 zero4 = (f32x4){0.f, 0.f, 0.f, 0.f};
        if (ui == 1) {
            float p0[4], p1[4]; mx0 = -INFINITY; mx1 = -INFINITY;
#pragma unroll
            for (int i = 0; i < 4; ++i) { p0[i] = sc[lane + 64 * i]; p1[i] = sc[256 + lane + 64 * i]; mx0 = fmaxf(mx0, p0[i]); mx1 = fmaxf(mx1, p1[i]); }
#pragma unroll
            for (int o = 1; o < 64; o <<= 1) { mx0 = fmaxf(mx0, shx(mx0, o, lane)); mx1 = fmaxf(mx1, shx(mx1, o, lane)); }
            float sm0 = 0.f, sm1 = 0.f;
#pragma unroll
            for (int i = 0; i < 4; ++i) { sm0 += __builtin_amdgcn_exp2f(p0[i] - mx0); sm1 += __builtin_amdgcn_exp2f(p1[i] - mx1); }
            sm0 = wave_sum(sm0, lane); sm1 = wave_sum(sm1, lane);
            iv0 = 1.0f / sm0; iv1 = 1.0f / sm1;
        }
        ATT_GLOAD(0); ATT_LSTORE(0); __syncthreads();
#pragma unroll
        for (int c = 0; c < 8; ++c) {
            if (c < 7) ATT_GLOAD(c + 1);
            if (ui == 0) {
#pragma unroll
                for (int r = 0; r < 4; ++r) {
                    const int m = 32 * c + 4 * w + r;
                    const float d0 = wave_sum_dpp(dot4(sv[2 * r], q0)), d1 = wave_sum_dpp(dot4(sv[2 * r + 1], q1));
                    if (lane == 63) { sc[m] = d0; sc[256 + m] = d1; }
                }
                if (c < 7) FA_SLOAD(kp, c + 1); else FA_SLOAD(vp, 0);
            } else {
#pragma unroll
                for (int r = 0; r < 4; ++r) {
                    const int m = 32 * c + 4 * w + r;
                    const float p0 = __builtin_amdgcn_exp2f(sc[m] - mx0) * iv0, p1 = __builtin_amdgcn_exp2f(sc[256 + m] - mx1) * iv1;
                    a0 += sv[2 * r] * p0; a1 += sv[2 * r + 1] * p1;
                }
                if (c < 7) FA_SLOAD(vp, c + 1);
            }
            LAS unsigned char* slot = lds + (c & 1) * ATT_SLOT;
            if (c < 4) {
                {
                    bf16x8 Kf[2][4];
#pragma unroll
                    for (int ml = 0; ml < 4; ++ml) Kf[0][ml] = *(LAS bf16x8*)(slot + (16 * ml + fr) * 544 + (8 * fq) * 2);
                    __builtin_amdgcn_sched_group_barrier(0x100, 4, 0);
#pragma unroll
                    for (int ks = 0; ks < 8; ++ks) {
                        if (ks < 7) {
#pragma unroll
                            for (int ml = 0; ml < 4; ++ml) Kf[(ks + 1) & 1][ml] = *(LAS bf16x8*)(slot + (16 * ml + fr) * 544 + (32 * (ks + 1) + 8 * fq) * 2);
                        }
#pragma unroll
                        for (int ml = 0; ml < 4; ++ml) S[4 * c + ml] = MFMA16(Kf[ks & 1][ml], Qf[ks], ks == 0 ? zero4 : S[4 * c + ml]);
                        __builtin_amdgcn_sched_group_barrier(0x100, 4, 0); __builtin_amdgcn_sched_group_barrier(0x008, 4, 0);
                    }
                }
                if (c == 3) {
                    float mx = S[0][0];
#pragma unroll
                    for (int i = 0; i < 16; ++i) { mx = fmaxf(mx, fmaxf(fmaxf(S[i][0], S[i][1]), fmaxf(S[i][2], S[i][3]))); }
                    mx = fmaxf(mx, shx(mx, 16, lane)); mx = fmaxf(mx, shx(mx, 32, lane));
                    float sum = 0.f;
#pragma unroll
                    for (int i = 0; i < 16; ++i) {
#pragma unroll
                        for (int e = 0; e < 4; ++e) { S[i][e] = __builtin_amdgcn_exp2f(S[i][e] - mx); sum += S[i][e]; }
                    }
                    sum += shx(sum, 16, lane); sum += shx(sum, 32, lane);
                    inv = 1.0f / sum;
#pragma unroll
                    for (int a = 0; a < 8; ++a) {
                        u32x4 pw; pw.x = cvt_pk_bf16(S[2 * a][0], S[2 * a][1]); pw.y = cvt_pk_bf16(S[2 * a][2], S[2 * a][3]); pw.z = cvt_pk_bf16(S[2 * a + 1][0], S[2 * a + 1][1]); pw.w = cvt_pk_bf16(S[2 * a + 1][2], S[2 * a + 1][3]);
                        Pf[a] = __builtin_bit_cast(bf16x8, pw);
                    }
                }
            } else {
                {
                    bf16x8 Vf[2][4];
#define ATT_VREAD(n_, buf_) do { _Pragma("unroll") for (int d_ = 0; d_ < 4; ++d_) { LAS unsigned char* p_ = slot + (32 * ((n_) >> 2) + 4 * fq + (fr >> 2)) * 544 + (16 * (4 * ((n_) & 3) + d_) + 4 * (fr & 3)) * 2; Vf[buf_][d_] = tr_frag(p_, p_ + 16 * 544); } } while (0)
                    ATT_VREAD(0, 0);
                    __builtin_amdgcn_sched_group_barrier(0x100, 8, 0);
#pragma unroll
                    for (int n = 0; n < 8; ++n) {
                        if (n < 7) ATT_VREAD(n + 1, (n + 1) & 1);
#pragma unroll
                        for (int d = 0; d < 4; ++d) { const int al = n >> 2, dt = 4 * (n & 3) + d; Oa[dt] = MFMA16(Vf[n & 1][d], Pf[2 * (c - 4) + al], (c == 4 && al == 0) ? zero4 : Oa[dt]); }
                        __builtin_amdgcn_sched_group_barrier(0x100, 8, 0); __builtin_amdgcn_sched_group_barrier(0x008, 4, 0);
                    }
#undef ATT_VREAD
                }
            }
            if (c < 7) ATT_LSTORE(c + 1);
            LDS_BARRIER();
        }
#pragma unroll
        for (int dt = 0; dt < 16; ++dt) *(u32x2*)(((bf16_t*)(F.ws + WS_O)) + rowq * D + h * 256 + 16 * dt + 4 * fq) = pack4(Oa[dt] * inv);
#undef ATT_GLOAD
#undef ATT_LSTORE
    }
#undef FA_SLOAD
    *(LAS f32x4*)(red + w * 512 + 4 * lane) = a0; *(LAS f32x4*)(red + w * 512 + 256 + 4 * lane) = a1;
    __syncthreads();
    {
        float o = 0.f;
#pragma unroll
        for (int ww = 0; ww < 8; ++ww) o += red[ww * 512 + tid];
        ((bf16_t*)(F.ws + WS_SO))[(size_t)sb * D + hp * 512 + tid] = (bf16_t)(cvt_pk_bf16(o, 0.f) & 0xffffu);
    }
    __syncthreads();
}
__device__ __forceinline__ void final_norm(Frame& F0) {
    Frame F = launder(F0);
    const int gwx = F.rk * NWAVES + F.wave, NGX = F.rw * NWAVES, lane = F.lane;
    f32x4 g[4];
#pragma unroll
    for (int jj = 0; jj < 4; ++jj) g[jj] = ((const f32x4*)FIN(24) + lane)[64 * jj];
    const bool has_s = gwx < 16;
    f32x4 sv[4];
    if (has_s) {
        const f32x4* src = (const f32x4*)(((float*)(F.ws + WS_XS)) + (size_t)(16 * F.xq + gwx) * D) + lane;
#pragma unroll
        for (int jj = 0; jj < 4; ++jj) sv[jj] = src[64 * jj];
    }
    for (int p = gwx; p < SEQ / 8; p += NGX) {
        const int m0 = F.xq * SEQ + 8 * p;
        u32x2 pk[8][4];
#pragma unroll
        for (int r = 0; r < 8; ++r) {
            const u32x2* src = (const u32x2*)(((bf16_t*)(F.ws + WS_XB)) + (size_t)(m0 + r) * D) + lane;
#pragma unroll
            for (int jj = 0; jj < 4; ++jj) pk[r][jj] = src[64 * jj];
        }
        float s[8];
#pragma unroll
        for (int r = 0; r < 8; ++r) {
            s[r] = 0.f;
#pragma unroll
            for (int jj = 0; jj < 4; ++jj) { const f32x4 t = unpack4(pk[r][jj]); s[r] += dot4(t, t); }
        }
#pragma unroll
        for (int r = 0; r < 8; ++r) s[r] = rsqrtf(wave_sum(s[r], lane) * (1.0f / D) + EPS);
#pragma unroll
        for (int r = 0; r < 8; ++r) {
            f32x4* dst = (f32x4*)(F.out + O_Y + (size_t)(m0 + r) * D) + lane;
#pragma unroll
            for (int jj = 0; jj < 4; ++jj) dst[64 * jj] = unpack4(pk[r][jj]) * s[r] * g[jj];
        }
    }
    if (has_s) {
        float s = 0.f;
#pragma unroll
        for (int jj = 0; jj < 4; ++jj) s += dot4(sv[jj], sv[jj]);
        const float rs = rsqrtf(wave_sum(s, lane) * (1.0f / D) + EPS);
        f32x4* dst = (f32x4*)(F.out + O_YS + (size_t)(16 * F.xq + gwx) * D) + lane;
#pragma unroll
        for (int jj = 0; jj < 4; ++jj) dst[64 * jj] = sv[jj] * rs * g[jj];
    }
}

struct Args { const float* in[25]; float* out; unsigned char* ws; int ph_lo, ph_hi; };
#define REP(bit) for (int rep_ = 0; rep_ < 1 + ((REP_MASK >> (bit)) & 1); ++rep_)
__global__ void __launch_bounds__(NWAVES * 64, 2) fwd(Args args) {
    extern __shared__ __attribute__((aligned(16))) unsigned char lds_raw[];
    Frame F0;
    F0.lds = (LAS unsigned char*)lds_raw;
    F0.tid = threadIdx.x; F0.lane = F0.tid & 63; F0.wave = __builtin_amdgcn_readfirstlane(F0.tid >> 6); F0.G = gridDim.x; F0.bx = blockIdx.x;
    F0.in = (in_tab_t)__builtin_amdgcn_kernarg_segment_ptr();     F0.out = args.out; F0.ws = args.ws;
    for (int u = F0.tid; u < (LDS_BYTES - LDSCTL_OFF) / 4; u += NWAVES * 64) ((LAS unsigned*)(F0.lds + LDSCTL_OFF))[u] = 0u;
    __syncthreads();
    XcdBarrier bar; bar.wave = F0.wave; bar.bar = (unsigned*)(args.ws + WS_CTL) + CW_BAR; bar.x = 0; bar.st = nullptr;
    if (!MK_SPLIT) bar = xcd_barrier_post((unsigned*)(args.ws + WS_CTL) + CW_BAR, (volatile LAS unsigned*)(F0.lds + MISC_OFF) + 8, F0.wave);
    unsigned* rankw = (unsigned*)(args.ws + WS_CTL) + CW_RANK;
    const unsigned my_xcc = xb_xcc_id();
    unsigned my_rank = 0u;
    if (F0.tid == 0) ((volatile LAS unsigned*)(F0.lds + MISC_OFF))[12] = __hip_atomic_fetch_add(rankw + 64 * my_xcc, 1u, __ATOMIC_RELAXED, __HIP_MEMORY_SCOPE_AGENT);
    if (F0.tid == 0) (void)__hip_atomic_fetch_or(rankw + 64 * (32 + (F0.bx & 7)), 1u << my_xcc, __ATOMIC_RELAXED, __HIP_MEMORY_SCOPE_AGENT);
    __syncthreads();
    my_rank = __builtin_amdgcn_readfirstlane(((volatile LAS unsigned*)(F0.lds + MISC_OFF))[12]);
    F0.vid = F0.bx;
    int ph = 0;
    bool local_ok = false;
    const int lo = args.ph_lo, hi = args.ph_hi;
#define PH_BEGIN if (ph >= lo && ph < hi) { Frame F = launder(F0);
#define PH_END } { const bool both_ = (ph >= lo && ph + 1 < hi); ++ph; if (!MK_SPLIT && both_) { XcdBarrier b2_ = bar; unsigned long long bp_ = uni64((unsigned long long)bar.bar); unsigned bx_ = __builtin_amdgcn_readfirstlane(bar.x); int bw_ = __builtin_amdgcn_readfirstlane(bar.wave); asm volatile("" : "+s"(bp_), "+s"(bx_), "+s"(bw_)); b2_.bar = (unsigned*)(GAS unsigned*)bp_; b2_.x = bx_; b2_.wave = bw_; if (local_ok && ph > 2) xcd_barrier_local(b2_); else xcd_barrier(b2_); if ((REP_MASK >> 19) & 1) xcd_barrier(b2_); if (ph == 2) local_ok = XCD_LOCAL && lo == 0 && __builtin_amdgcn_readfirstlane(__hip_atomic_load(rankw + 64 * 20, __ATOMIC_RELAXED, __HIP_MEMORY_SCOPE_AGENT)) == 0u;     } }

    PH_BEGIN REP(0) { p0_prologue(F0); __syncthreads(); } PH_END
    if (!MK_SPLIT && lo == 0) {
        unsigned nx = 0u, xi = 0u; bool even = (F0.G % 8) == 0;
        for (unsigned jx = 0; jx < 16; ++jx) { const unsigned c_ = __hip_atomic_load(rankw + 64 * jx, __ATOMIC_RELAXED, __HIP_MEMORY_SCOPE_AGENT); if (c_) { if (c_ != (unsigned)F0.G / 8u) even = false; if (jx < my_xcc) ++xi; ++nx; } }
        if (XCD_VID && even && nx == 8u) F0.vid = (int)(my_rank * 8u + xi);
        unsigned all_ = 0u; bool one2one = true;
        for (unsigned m_ = 0; m_ < 8; ++m_) { const unsigned k_ = __hip_atomic_load(rankw + 64 * (32 + m_), __ATOMIC_RELAXED, __HIP_MEMORY_SCOPE_AGENT); if (__builtin_popcount(k_) != 1 || (all_ & k_)) one2one = false; all_ |= k_; }
        if (!(even && nx == 8u && one2one) && F0.tid == 0) __hip_atomic_store(rankw + 64 * 20, 1u, __ATOMIC_RELAXED, __HIP_MEMORY_SCOPE_AGENT);
        if (((REP_MASK >> 18) & 1) && !(even && nx == 8u && (unsigned)(F0.bx % 8) == xi) && F0.tid == 0) F0.out[O_YS + F0.bx] = __builtin_nanf("");
        F0.vid = __builtin_amdgcn_readfirstlane(F0.vid);
    }
    PH_BEGIN {
        if ((REP_MASK >> 17) & 1) {
            f32x4 pa[8]; bf16x8 pb = (bf16x8){(short)F.tid, 1, 2, 3, 4, 5, 6, 7};
#pragma unroll
            for (int i = 0; i < 8; ++i) pa[i] = (f32x4){(float)F.tid, 1.f, 2.f, (float)i};
#pragma unroll 1
            for (int it = 0; it < 512; ++it) {
#pragma unroll
                for (int r = 0; r < 4; ++r)
#pragma unroll
                    for (int i = 0; i < 8; ++i) pa[i] = MFMA16(pb, pb, pa[i]);
            }
            float sacc = 0.f;
#pragma unroll
            for (int i = 0; i < 8; ++i) sacc += pa[i][0] + pa[i][3];
            if (sacc == 12345.678f) ((float*)(F.ws + WS_Z))[F.tid] = sacc;
        }
        if ((REP_MASK >> 15) & 3) { pg8::Gemm gp{((bf16_t*)(F.ws + WS_XB)), ((bf16_t*)(F.ws + WS_C1)), MP, NC, ((REP_MASK >> 15) & 1) ? 1024 : 512}; pg8::StaticOrder Sp; Sp.init(MP, NC, F.G, (int)F.vid); EpiProbe Ep{((bf16_t*)(F.ws + WS_Z)), NC}; pg8::gemm_phase<EpiProbe, pg8::StaticOrder, true, true>(F.lds, gp, Sp, Ep, F.wave); }
        pg8::Gemm g{((bf16_t*)(F.ws + WS_MEMB)), ((bf16_t*)(F.ws + WS_WKV)), MMEM, 8192, D}; pg8::StaticOrder S; S.init(MMEM, 8192, F.G, (int)F.vid);
        EpiMemKV E{((float*)(F.ws + WS_SMALL + 65536)), F.out + O_MEMK, F.out + O_MEMV, ((bf16_t*)(F.ws + WS_KB)), ((bf16_t*)(F.ws + WS_VB))};
        REP(1) pg8::gemm_phase<EpiMemKV, pg8::StaticOrder, true, true>(F.lds, g, S, E, F.wave);
    } PH_END
    if (STAGGER_TICKS != 0 && lo == 0 && ((F0.bx & 1) == (STAGGER_TICKS > 0 ? 1 : 0))) { const unsigned long long t0_ = __builtin_amdgcn_s_memrealtime(); const unsigned long long tk_ = (unsigned long long)(STAGGER_TICKS > 0 ? STAGGER_TICKS : -STAGGER_TICKS); while (__builtin_amdgcn_s_memrealtime() - t0_ < tk_) __builtin_amdgcn_s_sleep(8); }
    unsigned* pbw = (unsigned*)(args.ws + WS_CTL) + CW_RANK + 64 * 24;
    if (!MK_SPLIT && SPLIT_PROLOGUE && lo == 0) {
        const int half = F0.bx & 1, hw = (half ? (F0.G >> 1) : ((F0.G + 1) >> 1)) * NWAVES, hi_ = (F0.bx >> 1) * NWAVES + F0.wave;
        p0_weights(F0, 1, hi_, hw, half);
        asm volatile("s_waitcnt vmcnt(0)" ::: "memory"); __syncthreads();
        if (F0.wave == 0 && hw_lane() == 0) { __builtin_amdgcn_fence(__ATOMIC_RELEASE, "agent"); asm volatile("s_waitcnt vmcnt(0)" ::: "memory"); (void)__hip_atomic_fetch_add(pbw, 1u, __ATOMIC_RELAXED, __HIP_MEMORY_SCOPE_AGENT); }
    }
#pragma unroll 1
    for (int l = 0; l < DEPTH; ++l) {
        const int j = l >> 1;
        if (!MK_SPLIT && SPLIT_PROLOGUE && lo == 0 && l == 1) {
            if (F0.wave == 0 && hw_lane() == 0) {
                const unsigned want = (unsigned)F0.G; unsigned sp = 0u;
                while (__hip_atomic_load(pbw, __ATOMIC_RELAXED, __HIP_MEMORY_SCOPE_AGENT) < want) { __builtin_amdgcn_s_sleep(2); if (++sp > (1u << 22)) { atomicAdd((unsigned*)(args.ws + WS_CTL) + CW_BAR + XB_TMO, 1u); break; } }
                __builtin_amdgcn_fence(__ATOMIC_ACQUIRE, "agent"); asm volatile("s_waitcnt vmcnt(0)" ::: "memory");
            }
            __syncthreads();
        }
        if ((l & 1) == 0) {
            PH_BEGIN {
                pg8::Gemm g{((bf16_t*)(F.ws + WS_XB)), ((bf16_t*)(F.ws + WS_AB1)) + (size_t)j * NAB * D, MP, NAB, D}; pg8::StaticOrder S; S.init(MP, NAB, F.G, (int)F.vid);
                Unit u0{0, 0}; S.next(0, u0); rstd_table(((float*)(F.ws + WS_RSQ)), u0.pm, (LAS float*)(F.lds + RSTD_OFF), F.tid);
                EpiG1Even E{((float*)(F.ws + WS_RSQ)), ((bf16_t*)(F.ws + WS_Z)), ((float*)(F.ws + WS_VSQ)), F.out + O_POOLP + (size_t)j * 8 * 15 * 1024, (LAS const float*)(F.lds + RSTD_OFF), u0.pm};
                SEpiZ SE{((float*)(F.ws + WS_SMALL)), ((float*)(F.ws + WS_SZ)), 8192, 0};
                const bool s_first = (F.rk & 1) != 0;
                if (s_first) { REP(3) sgemm16<SEpiZ, NAB>(F, ((bf16_t*)(F.ws + WS_XB)) + (size_t)MP * D, ((bf16_t*)(F.ws + WS_AB1)) + (size_t)j * NAB * D, D, SE); }
                REP(2) pg8::gemm_phase<EpiG1Even, pg8::StaticOrder, true, true>(F.lds, g, S, E, F.wave);
                if (!s_first) { REP(3) sgemm16<SEpiZ, NAB>(F, ((bf16_t*)(F.ws + WS_XB)) + (size_t)MP * D, ((bf16_t*)(F.ws + WS_AB1)) + (size_t)j * NAB * D, D, SE); }
            } PH_END
            PH_BEGIN {
                REP(4) for (int i = F.rk; i < 32; i += F.rw) {
                    const int n = 16 * F.xq + (i >> 1);
                    const bf16_t* xan = ((bf16_t*)(F.ws + WS_Z)) + (size_t)(n * 128) * D; u32x4 pown[8], phalo;
                    if ((i & 1) == 0) { sgu_chunk(F, j, n, 0, 2, [&]() { pool_fetch(xan + 0 * 256, F.tid, (n * 128) & 2047, pown, phalo); }); pool_pair<0, 3>(F, j, n, pown, phalo); }
                    else { sgu_chunk(F, j, n, 2, 4, [&]() { pool_fetch(xan + 1 * 256, F.tid, (n * 128) & 2047, pown, phalo); }); pool_pair<1, 2>(F, j, n, pown, phalo); }
                }
                REP(5) for (int i = F.rk; i < 16; i += F.rw) sample_mix_even(F, j, 16 * F.xq + i);
            } PH_END
        } else {
            PH_BEGIN {
                pg8::Gemm g{((bf16_t*)(F.ws + WS_XB)), ((bf16_t*)(F.ws + WS_C1)) + (size_t)j * NC * D, MP, NC, D}; pg8::StaticOrder S; S.init(MP, NC, F.G, (int)F.vid);
                Unit u0{0, 0}; S.next(0, u0);
                for (int i = F.tid; i < 8 * 3 * 64; i += NWAVES * 64) { const int ui = i / 192, q = (i / 64) % 3, c = i & 63, pn = u0.pn + 4 * ui; ((LAS float*)(F.lds + CWL_OFF))[i] = pn < NC / 256 ? (FIN(18) + (size_t)j * 3 * 2048)[q * 2048 + pn * 64 + c] : 0.f; }
                rstd_table(((float*)(F.ws + WS_RSQ)), u0.pm, (LAS float*)(F.lds + RSTD_OFF), F.tid);
                EpiG1Odd E{((float*)(F.ws + WS_RSQ)), ((bf16_t*)(F.ws + WS_A2)), FIN(18) + (size_t)j * 3 * 2048, F.out + O_CONVP + (size_t)j * 8 * 2 * 2048, ((float*)(F.ws + WS_SIDE)), (LAS float*)(F.lds + HALO_OFF), (LAS const float*)(F.lds + RSTD_OFF), u0.pm, (LAS const float*)(F.lds + CWL_OFF), u0.pn};
                SEpiZ SE{((float*)(F.ws + WS_SMALL)), ((float*)(F.ws + WS_SZ)), 8192, 1};
                const bool s_first = (F.rk & 1) != 0;
                if (s_first) { REP(3) sgemm16<SEpiZ, NC>(F, ((bf16_t*)(F.ws + WS_XB)) + (size_t)MP * D, ((bf16_t*)(F.ws + WS_C1)) + (size_t)j * NC * D, D, SE); }
                REP(6) pg8::gemm_phase<EpiG1Odd, pg8::StaticOrder, true, true>(F.lds, g, S, E, F.wave);
                if (!s_first) { REP(3) sgemm16<SEpiZ, NC>(F, ((bf16_t*)(F.ws + WS_XB)) + (size_t)MP * D, ((bf16_t*)(F.ws + WS_C1)) + (size_t)j * NC * D, D, SE); }
            } PH_END
            PH_BEGIN {
                for (int p = F.rk; p < 24; p += F.rw) if (p >= 16) conv_fixup(((float*)(F.ws + WS_SIDE)), FIN(18) + (size_t)j * 3 * 2048, ((bf16_t*)(F.ws + WS_A2)), 8 * F.xq + (p - 16), F.tid);
                REP(5) for (int i = F.rk; i < 16; i += F.rw) sample_conv_odd(F, j, 16 * F.xq + i);
            } PH_END
        }
        PH_BEGIN {
            const bf16_t* W2 = ((l & 1) ? ((bf16_t*)(F.ws + WS_C2)) : ((bf16_t*)(F.ws + WS_AB2))) + (size_t)j * D * 2048;
            pg8::Gemm g{((bf16_t*)(F.ws + WS_A2)), W2, MP, D, 2048}; pg8::StaticOrder S; S.init(MP, D, F.G, (int)F.vid);
            EpiRes E{((bf16_t*)(F.ws + WS_XB)), ((float*)(F.ws + WS_RSQ))};
            pg8::gemm_phase<EpiRes, pg8::StaticOrder, true, true>(F.lds, g, S, E, F.wave);
            SEpiRes SE{((float*)(F.ws + WS_XS)), ((bf16_t*)(F.ws + WS_XB)) + (size_t)MP * D, ((float*)(F.ws + WS_SMALL))};
            sgemm16<SEpiRes, D>(F, ((bf16_t*)(F.ws + WS_SA2)), W2, 2048, SE);
        } PH_END
        PH_BEGIN {
            pg8::Gemm g{((bf16_t*)(F.ws + WS_XB)), ((bf16_t*)(F.ws + WS_WQ)) + (size_t)l * D * D, MP, D, D}; pg8::StaticOrder S; S.init(MP, D, F.G, (int)F.vid);
            Unit u0{0, 0}; S.next(0, u0); rstd_table(((float*)(F.ws + WS_RSQ)), u0.pm, (LAS float*)(F.lds + RSTD_OFF), F.tid);
            EpiQ E{((float*)(F.ws + WS_RSQ)), ((bf16_t*)(F.ws + WS_Q)), (LAS const float*)(F.lds + RSTD_OFF), u0.pm};
            REP(8) pg8::gemm_phase<EpiQ, pg8::StaticOrder, true, true>(F.lds, g, S, E, F.wave);
            SEpiQ SE{((float*)(F.ws + WS_SMALL)), ((float*)(F.ws + WS_SQ))};
            REP(9) sgemm16<SEpiQ, D>(F, ((bf16_t*)(F.ws + WS_XB)) + (size_t)MP * D, ((bf16_t*)(F.ws + WS_WQ)) + (size_t)l * D * D, D, SE);
        } PH_END
        PH_BEGIN {
            if (F.G == 256) { REP(10) attn_fused(F, l); }
            else { attn_prompt(F, l); attn_sample(F, l); }
        } PH_END
        PH_BEGIN {
            pg8::Gemm g{((bf16_t*)(F.ws + WS_O)), ((bf16_t*)(F.ws + WS_WO)) + (size_t)l * D * D, MP, D, D}; pg8::StaticOrder S; S.init(MP, D, F.G, (int)F.vid);
            EpiRes E{((bf16_t*)(F.ws + WS_XB)), ((float*)(F.ws + WS_RSQ))};
            pg8::gemm_phase<EpiRes, pg8::StaticOrder, true, true>(F.lds, g, S, E, F.wave);
            SEpiRes SE{((float*)(F.ws + WS_XS)), ((bf16_t*)(F.ws + WS_XB)) + (size_t)MP * D, ((float*)(F.ws + WS_SMALL))};
            sgemm16<SEpiRes, D>(F, ((bf16_t*)(F.ws + WS_SO)), ((bf16_t*)(F.ws + WS_WO)) + (size_t)l * D * D, D, SE);
        } PH_END
    }
    PH_BEGIN final_norm(F0); PH_END
#undef PH_BEGIN
#undef PH_END
}
constexpr int N_PHASES = 2 + 6 * DEPTH + 1;

extern "C" void kernel_launch(void* const* d_in, const int* in_sizes, int n_in, void* d_out, int out_size, void* d_ws, size_t ws_size, hipStream_t stream) {
    static int grid = 0;
    if (grid == 0) {
        if (n_in != 25 || in_sizes[0] != MP * D || (size_t)out_size != O_END || ws_size < WS_END) { fprintf(stderr, "kernel_launch: unexpected shapes (n_in %d, in0 %d, out %d, ws %zu); nothing launched\n", n_in, n_in > 0 ? in_sizes[0] : -1, out_size, ws_size); grid = -1; return; }
        int dev = 0, cus = 0, per_cu = 0;
        if (hipGetDevice(&dev) != hipSuccess || hipDeviceGetAttribute(&cus, hipDeviceAttributeMultiprocessorCount, dev) != hipSuccess) { fprintf(stderr, "kernel_launch: device query failed\n"); grid = -1; return; }
        if (hipFuncSetAttribute((const void*)fwd, hipFuncAttributeMaxDynamicSharedMemorySize, LDS_BYTES) != hipSuccess) { fprintf(stderr, "kernel_launch: hipFuncSetAttribute failed\n"); grid = -1; return; }
        if (hipOccupancyMaxActiveBlocksPerMultiprocessor(&per_cu, (const void*)fwd, NWAVES * 64, LDS_BYTES) != hipSuccess || per_cu < 1) fprintf(stderr, "kernel_launch: note: occupancy query reports %d workgroups per CU\n", per_cu);
        (void)hipGetLastError();
        grid = cus;
    }
    if (grid < 0) return;
    if (hipMemsetAsync((char*)d_ws + WS_CTL, 0, CTL_ZERO_BYTES, stream) != hipSuccess) { fprintf(stderr, "kernel_launch: memset failed\n"); return; }
    Args a{};
    for (int i = 0; i < 25; ++i) a.in[i] = (const float*)d_in[i];
    a.out = (float*)d_out; a.ws = (unsigned char*)d_ws;
#if MK_SPLIT
    for (int p = 0; p < N_PHASES; ++p) { a.ph_lo = p; a.ph_hi = p + 1; hipLaunchKernelGGL(fwd, dim3(grid), dim3(NWAVES * 64), LDS_BYTES, stream, a); }
#else
    a.ph_lo = 0; a.ph_hi = N_PHASES;
    hipLaunchKernelGGL(fwd, dim3(grid), dim3(NWAVES * 64), LDS_BYTES, stream, a);
#endif
    const hipError_t le = hipPeekAtLastError();
    if (le != hipSuccess) fprintf(stderr, "kernel_launch: launch failed: %s\n", hipGetErrorName(le));
}
```

```cpp
#include <hip/hip_runtime.h>
#include <cstdio>
#include <cstdint>
#ifndef REP_MASK
#define REP_MASK 0
#endif
#ifndef STAGGER_TICKS
#define STAGGER_TICKS 0
#endif
#ifndef PB_ODD_PCT
#define PB_ODD_PCT 100
#endif
#ifndef SPLIT_PROLOGUE
#define SPLIT_PROLOGUE 1
#endif
#ifndef XCD_LOCAL
#define XCD_LOCAL 1
#endif
#ifndef XCD_VID
#define XCD_VID 0
#endif
#ifndef MK_SPLIT
#define MK_SPLIT 0
#endif
__device__ __forceinline__ int hw_lane() { int l; asm volatile("v_mbcnt_lo_u32_b32 %0, -1, 0\n\tv_mbcnt_hi_u32_b32 %0, -1, %0" : "=v"(l)); return l; }
namespace pg8 {
#define PG8_LAS __attribute__((address_space(3)))
typedef unsigned short bf16_t;
typedef short bf16x8 __attribute__((ext_vector_type(8)));
typedef float f32x4 __attribute__((ext_vector_type(4)));
typedef unsigned u32x4 __attribute__((ext_vector_type(4)));
constexpr int BM = 256, BK = 64, HALF = 128, HTB = HALF * BK * 2  , STAGE_BYTES = 8 * HTB, NXCD = 8, WGM = 8;

__host__ __device__ __forceinline__ int lds_byte(int r, int c) { const int st = (r >> 4) * 2 + (c >> 5), rr = r & 15, cc = c & 31, ob = rr * 64 + cc * 2; return st * 1024 + (ob ^ (((ob >> 9) & 1) << 5)); }
__host__ __device__ __forceinline__ void stage_rc(int b, int& R, int& C) { const int st = b / 1024, sb = b % 1024, swz = sb ^ (((sb >> 9) & 1) << 5); R = (st >> 1) * 16 + swz / 64; C = (st & 1) * 32 + (swz % 64) / 2; }
__host__ __device__ __forceinline__ int perm32(int rho) { const int n = rho >> 4, i = rho & 15; return 8 * (i >> 2) + 4 * n + (i & 3); }

struct Unit { int pm, pn; };
struct Gemm { const bf16_t* A; const bf16_t* Bt; int M, N, K; };

struct StaticOrder {
    int nM, nN, nwg, G, c;
    __host__ __device__ __forceinline__ void init(int M, int N, int G_, int c_) { nM = M / BM; nN = N / BM; nwg = nM * nN; G = G_; c = c_; }
    __host__ __device__ __forceinline__ bool next(int i, Unit& u) const {
        const long L = (long)i * G + c; if (L >= nwg) return false;
        int wgid = (int)L; { const int q = nwg / NXCD, r = nwg % NXCD, xcd = wgid % NXCD, off = wgid / NXCD; wgid = (xcd < r ? xcd * (q + 1) : r * (q + 1) + (xcd - r) * q) + off; }
        const int nig = WGM * nN, gid = wgid / nig, fm = gid * WGM, gsz = (nM - fm) < WGM ? (nM - fm) : WGM;
        u.pm = fm + ((wgid % nig) % gsz); u.pn = (wgid % nig) / gsz; return true;
    }
    __device__ __forceinline__ void a_ready(const Unit&) const {}
    __device__ __forceinline__ void done(const Unit&) const {}
};

typedef float f32x2cv __attribute__((ext_vector_type(2))); typedef __bf16 bf16x2cv __attribute__((ext_vector_type(2)));
__device__ __forceinline__ unsigned cvt_pk_bf16(float lo, float hi) { const f32x2cv v = {lo, hi}; return __builtin_bit_cast(unsigned, __builtin_convertvector(v, bf16x2cv)); }
template <class Epi, class Sched, bool ALIGN_EPI = false, bool SP2 = false>
__device__ __forceinline__ void gemm_phase(PG8_LAS unsigned char* lds, const Gemm g, const Sched& S, const Epi& E, const int wave_id) {
    int tid_ = (wave_id << 6) | hw_lane(); asm volatile("" : "+v"(tid_));
    const int tid = tid_, wid = __builtin_amdgcn_readfirstlane(tid >> 6), lane = tid & 63, wr = wid >> 2, wc = wid & 3, fr = lane & 15, fq = lane >> 4;
    const int K = g.K, nt = K / BK;
    unsigned voffA[2], voffB[2];
#pragma unroll
    for (int i = 0; i < 2; ++i) { int R, C; stage_rc(tid * 16 + i * 8192, R, C); const int Rb = Epi::PERM ? ((R & ~31) + perm32(R & 31)) : R;
        voffA[i] = (unsigned)(R * K + C) * 2u; voffB[i] = (unsigned)(Rb * K + C) * 2u; }
    const size_t kstep = (size_t)(BK * 2);
    const size_t hstep = (size_t)HALF * K * 2;
    const size_t tstep = 2 * hstep;
    const unsigned ldsw = (unsigned)wid * 1024u;
    const int aoff = lds_byte(wr * 64 + fr, fq * 8), boff = lds_byte(wc * 32 + fr, fq * 8);
#define PG8_SA(b, h) (((b) * 2 + (h)) * HTB)
#define PG8_SB(b, h) ((4 + (b) * 2 + (h)) * HTB)
#define PG8_STAGE(bufoff, gbase, voff) do { _Pragma("unroll") for (int _i = 0; _i < 2; ++_i) \
        __builtin_amdgcn_global_load_lds((const unsigned*)((const char*)(gbase) + (voff)[_i]), (PG8_LAS unsigned*)(lds + (bufoff) + ldsw + _i * 8192), 16, 0, 0); } while (0)
#define PG8_LDA(dst, b, h) do { _Pragma("unroll") for (int m = 0; m < 4; ++m) _Pragma("unroll") for (int k = 0; k < 2; ++k) dst[m][k] = *(const PG8_LAS bf16x8*)(lds + PG8_SA(b, h) + aoff + m * 2048 + k * 1024); } while (0)
#define PG8_LDB(dst, b, h) do { _Pragma("unroll") for (int n = 0; n < 2; ++n) _Pragma("unroll") for (int k = 0; k < 2; ++k) dst[n][k] = *(const PG8_LAS bf16x8*)(lds + PG8_SB(b, h) + boff + n * 2048 + k * 1024); } while (0)
#define PG8_MMA(ai, bj, At, Bt) do { __builtin_amdgcn_s_setprio(1); _Pragma("unroll") for (int m = 0; m < 4; ++m) _Pragma("unroll") for (int n = 0; n < 2; ++n) _Pragma("unroll") for (int k = 0; k < 2; ++k) \
        acc[ai][bj][m][n] = __builtin_amdgcn_mfma_f32_16x16x32_bf16(Bt[n][k], At[m][k], acc[ai][bj][m][n], 0, 0, 0); __builtin_amdgcn_s_setprio(0); } while (0)
#define PG8_WAIT_V(n) asm volatile("s_waitcnt vmcnt(" #n ")" ::: "memory")
#define PG8_WAIT_L(n) asm volatile("s_waitcnt lgkmcnt(" #n ")" ::: "memory")
#define PG8_BAR __builtin_amdgcn_s_barrier()
#define PG8_SCHED __builtin_amdgcn_sched_barrier(0)
    Unit cur, nxt; int ui = 0;
    if (!S.next(0, cur)) return;
    f32x4 acc[2][2][4][2];
#pragma unroll
    for (int a = 0; a < 2; ++a)
#pragma unroll
        for (int b = 0; b < 2; ++b)
#pragma unroll
            for (int m = 0; m < 4; ++m)
#pragma unroll
                for (int n = 0; n < 2; ++n) acc[a][b][m][n] = (f32x4){0.f, 0.f, 0.f, 0.f};
    bf16x8 At[4][2], B0[2][2], B1[2][2];
    const char* cA = (const char*)g.A + (size_t)cur.pm * tstep; const char* cB = (const char*)g.Bt + (size_t)cur.pn * tstep;
    S.a_ready(cur);
    if constexpr (SP2) {
        PG8_STAGE(PG8_SB(0, 0), cB, voffB); PG8_STAGE(PG8_SB(0, 1), cB + hstep, voffB); PG8_STAGE(PG8_SA(0, 0), cA, voffA); PG8_STAGE(PG8_SA(0, 1), cA + hstep, voffA);
        if (wr == 1) PG8_BAR;
        PG8_WAIT_V(2); PG8_BAR;
        PG8_STAGE(PG8_SB(1, 0), cB + kstep, voffB); PG8_STAGE(PG8_SA(1, 0), cA + kstep, voffA); PG8_STAGE(PG8_SB(1, 1), cB + hstep + kstep, voffB);
        PG8_WAIT_V(6); PG8_BAR;
    } else {
        PG8_STAGE(PG8_SB(0, 0), cB, voffB); PG8_STAGE(PG8_SA(0, 0), cA, voffA); PG8_STAGE(PG8_SB(0, 1), cB + hstep, voffB); PG8_STAGE(PG8_SA(0, 1), cA + hstep, voffA);
        if (wr == 1) PG8_BAR;
        PG8_WAIT_V(4); PG8_BAR;
        PG8_STAGE(PG8_SB(1, 0), cB + kstep, voffB); PG8_STAGE(PG8_SA(1, 0), cA + kstep, voffA); PG8_STAGE(PG8_SB(1, 1), cB + hstep + kstep, voffB);
        PG8_WAIT_V(6); PG8_BAR;
    }
    for (;;) {
        const bool has_next = S.next(ui + 1, nxt);
        const char* nA = has_next ? (const char*)g.A + (size_t)nxt.pm * tstep : cA; const char* nB = has_next ? (const char*)g.Bt + (size_t)nxt.pn * tstep : cB;
        for (int t = 0; t < nt; t += 2) {
            const bool last = (t == nt - 2);
            const char* a1 = cA + (size_t)(t + 1) * kstep;
            const char* a2 = last ? nA : cA + (size_t)(t + 2) * kstep; const char* b2 = last ? nB : cB + (size_t)(t + 2) * kstep;
            const char* a3 = a2 + kstep; const char* b3 = b2 + kstep;
            if (last && has_next) S.a_ready(nxt);
            if constexpr (SP2) {
            PG8_LDB(B0, 0, 0); PG8_LDB(B1, 0, 1); PG8_SCHED; PG8_LDA(At, 0, 0); PG8_STAGE(PG8_SA(1, 1), a1 + hstep, voffA);
            PG8_WAIT_V(8); PG8_WAIT_L(0); PG8_BAR; PG8_MMA(0, 0, At, B0); PG8_MMA(0, 1, At, B1); PG8_BAR; PG8_SCHED;
            PG8_LDA(At, 0, 1); PG8_STAGE(PG8_SB(0, 0), b2, voffB); PG8_STAGE(PG8_SB(0, 1), b2 + hstep, voffB); PG8_STAGE(PG8_SA(0, 0), a2, voffA);
            PG8_WAIT_V(8); PG8_WAIT_L(0); PG8_BAR; PG8_MMA(1, 0, At, B0); PG8_MMA(1, 1, At, B1); PG8_BAR; PG8_SCHED;
            PG8_LDB(B0, 1, 0); PG8_LDB(B1, 1, 1); PG8_SCHED; PG8_LDA(At, 1, 0); PG8_STAGE(PG8_SA(0, 1), a2 + hstep, voffA);
            PG8_WAIT_V(8); PG8_WAIT_L(0); PG8_BAR; PG8_MMA(0, 0, At, B0); PG8_MMA(0, 1, At, B1); PG8_BAR; PG8_SCHED;
            PG8_LDA(At, 1, 1); PG8_STAGE(PG8_SB(1, 0), b3, voffB); PG8_STAGE(PG8_SB(1, 1), b3 + hstep, voffB); PG8_STAGE(PG8_SA(1, 0), a3, voffA);
            PG8_WAIT_V(8); PG8_WAIT_L(0); PG8_BAR; PG8_MMA(1, 0, At, B0); PG8_MMA(1, 1, At, B1); PG8_BAR; PG8_SCHED;
            } else {
            PG8_LDB(B0, 0, 0); PG8_SCHED; PG8_LDA(At, 0, 0); PG8_STAGE(PG8_SA(1, 1), a1 + hstep, voffA);
            PG8_WAIT_L(8); PG8_BAR; PG8_WAIT_L(0); PG8_MMA(0, 0, At, B0); PG8_BAR; PG8_SCHED;
            PG8_LDB(B1, 0, 1); PG8_STAGE(PG8_SB(0, 0), b2, voffB);
            PG8_BAR; PG8_WAIT_L(0); PG8_MMA(0, 1, At, B1); PG8_BAR;
            PG8_LDA(At, 0, 1); PG8_STAGE(PG8_SA(0, 0), a2, voffA);
            PG8_BAR; PG8_WAIT_L(0); PG8_MMA(1, 0, At, B0); PG8_BAR; PG8_SCHED;
            PG8_STAGE(PG8_SB(0, 1), b2 + hstep, voffB);
            PG8_WAIT_V(6); PG8_BAR; PG8_MMA(1, 1, At, B1); PG8_BAR;
            PG8_LDB(B0, 1, 0); PG8_SCHED; PG8_LDA(At, 1, 0); PG8_STAGE(PG8_SA(0, 1), a2 + hstep, voffA);
            PG8_WAIT_L(8); PG8_BAR; PG8_WAIT_L(0); PG8_MMA(0, 0, At, B0); PG8_BAR; PG8_SCHED;
            PG8_LDB(B1, 1, 1); PG8_STAGE(PG8_SB(1, 0), b3, voffB);
            PG8_BAR; PG8_WAIT_L(0); PG8_MMA(0, 1, At, B1); PG8_BAR;
            PG8_LDA(At, 1, 1); PG8_STAGE(PG8_SA(1, 0), a3, voffA);
            PG8_BAR; PG8_WAIT_L(0); PG8_MMA(1, 0, At, B0); PG8_BAR; PG8_SCHED;
            PG8_STAGE(PG8_SB(1, 1), b3 + hstep, voffB);
            PG8_WAIT_V(6); PG8_BAR; PG8_MMA(1, 1, At, B1); PG8_BAR;
            }
        }
        if constexpr (ALIGN_EPI) { if (wr == 0) PG8_BAR; }
        if constexpr (!Epi::AFTER_DRAIN) { for (int rep_ = 0; rep_ < 1 + (Epi::REP_EPI ? 1 : 0); ++rep_) E(acc, cur, wr, wc, fr, fq); S.done(cur); }
        if (!has_next) break;
#pragma unroll
        for (int a = 0; a < 2; ++a)
#pragma unroll
            for (int b = 0; b < 2; ++b)
#pragma unroll
                for (int m = 0; m < 4; ++m)
#pragma unroll
                    for (int n = 0; n < 2; ++n) acc[a][b][m][n] = (f32x4){0.f, 0.f, 0.f, 0.f};
        cur = nxt; cA = nA; cB = nB; ++ui;
        if constexpr (ALIGN_EPI) { if (wr == 1) PG8_BAR; }
    }
    PG8_WAIT_V(0);
    if constexpr (!ALIGN_EPI) { if (wr == 0) PG8_BAR; }
    PG8_BAR;
    if constexpr (Epi::AFTER_DRAIN) { E.fused(acc, cur, wr, wc, fr, fq, lds, wid, lane); S.done(cur); }
#undef PG8_SA
#undef PG8_SB
#undef PG8_STAGE
#undef PG8_LDA
#undef PG8_LDB
#undef PG8_MMA
#undef PG8_WAIT_V
#undef PG8_WAIT_L
#undef PG8_BAR
#undef PG8_SCHED
}
}

using pg8::bf16_t; using pg8::bf16x8; using pg8::f32x4; using pg8::u32x4; using pg8::Unit; using pg8::cvt_pk_bf16;
#define GAS __attribute__((address_space(1)))
#define LAS __attribute__((address_space(3)))
typedef unsigned u32x2 __attribute__((ext_vector_type(2)));
typedef short s16x4 __attribute__((ext_vector_type(4)));
typedef GAS unsigned gu32;
#define RLX_AGENT __ATOMIC_RELAXED, __HIP_MEMORY_SCOPE_AGENT

constexpr int NWAVES = 8;
constexpr int D = 1024, MP = 16384, MS = 128, SEQ = 2048, NBATCH = 8, NMEM = 256, MMEM = 2048, DEPTH = 4;
constexpr int NAB = 5120, NC = 8192;
constexpr float EPS = 1e-6f;
constexpr float QSCALE = 0.0625f * 1.4426950408889634f;

constexpr size_t O_Y = 0, O_YS = O_Y + (size_t)MP * D, O_POOLP = O_YS + (size_t)MS * D, O_POOLS = O_POOLP + 2 * 8 * 15 * 1024,
                 O_CONVP = O_POOLS + (size_t)2 * 128 * 15 * 1024, O_CONVS = O_CONVP + 2 * 8 * 2 * 2048, O_SGUV = O_CONVS + (size_t)2 * 128 * 2 * 2048,
                 O_MEMK = O_SGUV + 2 * 128 * 1024, O_MEMV = O_MEMK + (size_t)4 * MMEM * D, O_END = O_MEMV + (size_t)4 * MMEM * D;
static_assert(O_END == 39239680, "output size");

constexpr size_t MiB = 1u << 20;
constexpr size_t WS_CTL = 0, CTL_ZERO_BYTES = 1 * MiB;
constexpr size_t WS_AB1 = 2 * MiB, WS_C1 = 22 * MiB, WS_AB2 = 54 * MiB, WS_C2 = 62 * MiB, WS_WQ = 70 * MiB, WS_WKV = 78 * MiB, WS_WO = 94 * MiB, WS_PMT = 102 * MiB;
constexpr size_t WS_XB = 104 * MiB;
constexpr size_t WS_RSQ = 137 * MiB, WS_VSQ = 138 * MiB;
constexpr size_t WS_SMALL = 139 * MiB;
constexpr size_t WS_Z = 140 * MiB;
constexpr size_t WS_A2 = 268 * MiB;
constexpr size_t WS_Q = 332 * MiB, WS_O = WS_Q;
constexpr size_t WS_MEMB = 396 * MiB, WS_KB = 400 * MiB, WS_VB = 416 * MiB;
constexpr size_t WS_XS = 432 * MiB, WS_SZ = 433 * MiB, WS_SA2 = 437 * MiB, WS_SQ = 438 * MiB, WS_SO = 439 * MiB, WS_SIDE = 440 * MiB  , WS_END = 444 * MiB;
constexpr int CW_BAR = 4096, CW_RANK = 8192;

constexpr int RING_BYTES = 131072, LDSCTL_OFF = RING_BYTES, MISC_OFF = LDSCTL_OFF + 320, HALO_OFF = RING_BYTES + 1024  , RSTD_OFF = HALO_OFF + 8192  , CWL_OFF = RSTD_OFF + 1024  , LDS_BYTES = 155648;

#define LDS_WAIT() asm volatile("s_waitcnt lgkmcnt(0)" ::: "memory")
#define LDS_BARRIER() asm volatile("s_waitcnt lgkmcnt(0)\n\ts_barrier" ::: "memory")

#define XB_TMO      128
#define XB_XCNT(j)  (256  + 64 * (j))
#define XB_XSUB(j)  (1280 + 64 * (j))
#define XB_XGEN(j)  (2304 + 64 * (j))
#define XB_TOP      3328
#define XB_TOPGEN   3392
#define XCD_BAR_WORDS 3456
#define XB_SPIN_CAP (1u << 18)

__device__ __forceinline__ unsigned xb_ld(unsigned* p)              { return __hip_atomic_load(p, __ATOMIC_RELAXED, __HIP_MEMORY_SCOPE_AGENT); }
__device__ __forceinline__ unsigned xb_add(unsigned* p, unsigned v) { return __hip_atomic_fetch_add(p, v, __ATOMIC_RELAXED, __HIP_MEMORY_SCOPE_AGENT); }
__device__ __forceinline__ unsigned xb_xcc_id() { return (unsigned)__builtin_amdgcn_s_getreg((3 << 11) | 20) & 0xFu; }
#define XB_SPIN(cond, bar) do { unsigned _sp = 0; while (cond) { __builtin_amdgcn_s_sleep(1); \
    if ((++_sp & 255u) == 0u) { if (xb_ld(&(bar)[XB_TMO])) break; if (_sp > XB_SPIN_CAP) { atomicAdd(&(bar)[XB_TMO], 1u); break; } } } } while (0)

struct XcdBarrier {
    int wave;
    unsigned* bar; unsigned x;
    volatile LAS unsigned* st;
};

__device__ __forceinline__ XcdBarrier xcd_barrier_post(unsigned* bar, volatile LAS unsigned* st, int wave) {
    XcdBarrier b; b.wave = wave; b.bar = bar; b.x = xb_xcc_id(); b.st = st;
    if (b.wave == 0 && hw_lane() == 0) (void)xb_add(&bar[XB_XCNT(b.x)], 1u);
    return b;
}
__device__ __forceinline__ void xcd_barrier_complete(unsigned* bar, unsigned x, unsigned& nloc, unsigned& nx) {
    const unsigned G = gridDim.x * gridDim.y * gridDim.z;
    unsigned sum, cnt, mine, sp = 0u;
    for (;;) {
        sum = 0u; cnt = 0u; mine = 0u;
#pragma unroll
        for (unsigned j = 0; j < 16; ++j) { const unsigned c = xb_ld(&bar[XB_XCNT(j)]); sum += c; cnt += (c > 0u) ? 1u : 0u; mine = (j == x) ? c : mine; }
        if (sum == G) break;
        __builtin_amdgcn_s_sleep(1);
        if ((++sp & 255u) == 0u) { if (xb_ld(&bar[XB_TMO])) break; if (sp > XB_SPIN_CAP) { atomicAdd(&bar[XB_TMO], 1u); break; } }
    }
    nloc = mine > 0u ? mine : 1u; nx = cnt > 0u ? cnt : 1u;
}

__device__ __forceinline__ void xcd_barrier(const XcdBarrier& b) {
    asm volatile("s_waitcnt vmcnt(0)" ::: "memory");
    __syncthreads();
    if (b.wave == 0 && hw_lane() == 0) {
        unsigned* bar = b.bar;
        __builtin_amdgcn_s_waitcnt(0);
        unsigned nloc = b.st[0], nx = b.st[1];
        if (nloc == 0u) { xcd_barrier_complete(bar, b.x, nloc, nx); b.st[0] = nloc; b.st[1] = nx; }
        const unsigned old = xb_add(&bar[XB_XSUB(b.x)], 1u);
        const unsigned gen = old / nloc;
        if (old + 1u == (gen + 1u) * nloc) {
            __builtin_amdgcn_fence(__ATOMIC_RELEASE, "agent");
            asm volatile("s_waitcnt vmcnt(0)" ::: "memory");
            const unsigned og = xb_add(&bar[XB_TOP], 1u);
            const unsigned tg = og / nx;
            if (og + 1u == (tg + 1u) * nx) xb_add(&bar[XB_TOPGEN], 1u);
            else XB_SPIN(xb_ld(&bar[XB_TOPGEN]) == tg, bar);
            __builtin_amdgcn_fence(__ATOMIC_ACQUIRE, "agent");
            xb_add(&bar[XB_XGEN(b.x)], 1u);
            asm volatile("s_waitcnt vmcnt(0)" ::: "memory");
        } else {
            XB_SPIN(xb_ld(&bar[XB_XGEN(b.x)]) == gen, bar);
            __builtin_amdgcn_fence(__ATOMIC_ACQUIRE, "agent");
            asm volatile("s_waitcnt vmcnt(0)" ::: "memory");
        }
    }
    __syncthreads();
}

__device__ __forceinline__ void xcd_barrier_local(const XcdBarrier& b) {
    asm volatile("s_waitcnt vmcnt(0)" ::: "memory");
    __syncthreads();
    if (b.wave == 0 && hw_lane() == 0) {
        unsigned* bar = b.bar;
        __builtin_amdgcn_s_waitcnt(0);
        const unsigned nloc = b.st[0] ? b.st[0] : 1u;
        const unsigned old = xb_add(&bar[XB_XSUB(b.x)], 1u);
        const unsigned gen = old / nloc;
        if (old + 1u == (gen + 1u) * nloc) xb_add(&bar[XB_XGEN(b.x)], 1u);
        else XB_SPIN(xb_ld(&bar[XB_XGEN(b.x)]) == gen, bar);
        __builtin_amdgcn_fence(__ATOMIC_ACQUIRE, "agent");
        asm volatile("s_waitcnt vmcnt(0)" ::: "memory");
    }
    __syncthreads();
}

typedef const float* fptr_t;
typedef __attribute__((address_space(4))) const fptr_t* in_tab_t;
struct Frame {
    LAS unsigned char* lds;
    int tid, lane, wave, G, bx, vid, xq, rk, rw;
    in_tab_t in;
    float* out;
    unsigned char* ws;
};
__device__ __forceinline__ unsigned long long uni64(unsigned long long v) { const unsigned lo = __builtin_amdgcn_readfirstlane((unsigned)v), hi = __builtin_amdgcn_readfirstlane((unsigned)(v >> 32)); return ((unsigned long long)hi << 32) | lo; }
__device__ __forceinline__ Frame launder(const Frame& F0) {
    Frame F = F0;
    int wv_ = __builtin_amdgcn_readfirstlane(F0.wave);
    int ln_ = hw_lane();
    int g_ = __builtin_amdgcn_readfirstlane(F0.G), b_ = __builtin_amdgcn_readfirstlane(F0.bx), v_ = __builtin_amdgcn_readfirstlane(F0.vid);
    unsigned long long w_ = uni64((unsigned long long)F0.ws), o_ = uni64((unsigned long long)F0.out), i_ = uni64((unsigned long long)F0.in);
    asm volatile("" : "+v"(ln_), "+s"(wv_), "+s"(g_), "+s"(b_), "+s"(v_), "+s"(w_), "+s"(o_), "+s"(i_));
    F.tid = (wv_ << 6) | ln_; F.G = g_; F.bx = b_; F.vid = v_; F.xq = b_ & 7; F.rk = b_ >> 3; F.rw = (g_ - (b_ & 7) + 7) >> 3; F.ws = (unsigned char*)(GAS unsigned char*)w_; F.out = (float*)(GAS float*)o_; F.in = (in_tab_t)i_;
    F.lane = ln_; F.wave = wv_;
    return F;
}
#define FIN(k) ((const float*)(const GAS float*)(F.in[k]))


__device__ __forceinline__ float shx(float v, int mask, int lane) { return __builtin_bit_cast(float, __builtin_amdgcn_ds_bpermute((lane ^ mask) << 2, __builtin_bit_cast(int, v))); }
__device__ __forceinline__ float wave_sum(float v, int lane) {
#pragma unroll
    for (int o = 1; o < 64; o <<= 1) v += shx(v, o, lane);
    return v;
}
__device__ __forceinline__ float silu_f(float x) { return x * __builtin_amdgcn_rcpf(1.f + __builtin_amdgcn_exp2f(-1.4426950408889634f * x)); }
__device__ __forceinline__ f32x4 silu4(f32x4 v) { return (f32x4){silu_f(v[0]), silu_f(v[1]), silu_f(v[2]), silu_f(v[3])}; }
__device__ __forceinline__ float dot4(f32x4 a, f32x4 b) { return (a[0] * b[0] + a[1] * b[1]) + (a[2] * b[2] + a[3] * b[3]); }
__device__ __forceinline__ u32x4 pack8(f32x4 a, f32x4 b) { u32x4 w; w.x = cvt_pk_bf16(a[0], a[1]); w.y = cvt_pk_bf16(a[2], a[3]); w.z = cvt_pk_bf16(b[0], b[1]); w.w = cvt_pk_bf16(b[2], b[3]); return w; }
__device__ __forceinline__ u32x2 pack4(f32x4 a) { u32x2 w; w.x = cvt_pk_bf16(a[0], a[1]); w.y = cvt_pk_bf16(a[2], a[3]); return w; }
__device__ __forceinline__ float bflo(unsigned w) { return __uint_as_float(w << 16); }
__device__ __forceinline__ float bfhi(unsigned w) { return __uint_as_float(w & 0xffff0000u); }
__device__ __forceinline__ void unpack8(u32x4 w, f32x4& a, f32x4& b) { a = (f32x4){bflo(w.x), bfhi(w.x), bflo(w.y), bfhi(w.y)}; b = (f32x4){bflo(w.z), bfhi(w.z), bflo(w.w), bfhi(w.w)}; }
__device__ __forceinline__ f32x4 unpack4(u32x2 w) { return (f32x4){bflo(w.x), bfhi(w.x), bflo(w.y), bfhi(w.y)}; }
__device__ __forceinline__ float rstd16(const float* p) {
    const f32x4 a = ((const f32x4*)p)[0], b = ((const f32x4*)p)[1], c = ((const f32x4*)p)[2], d = ((const f32x4*)p)[3];
    const f32x4 s = (a + b) + (c + d);
    return rsqrtf(((s[0] + s[1]) + (s[2] + s[3])) * (1.0f / D) + EPS);
}
__device__ __forceinline__ float rstd32(const float* p) {
    f32x4 s = ((const f32x4*)p)[0];
#pragma unroll
    for (int i = 1; i < 8; ++i) s += ((const f32x4*)p)[i];
    return rsqrtf(((s[0] + s[1]) + (s[2] + s[3])) * (1.0f / D) + EPS);
}
__host__ __device__ __forceinline__ int src_even(int n) {
    const int tile = n >> 8, o = n & 255;
    if (tile < 8) return n;
    if (tile < 12) return 3072 + (n - 2048);
    const int cb = tile - 12;
    return o < 128 ? 2048 + 128 * cb + o : 4096 + 128 * cb + (o - 128);
}
__host__ __device__ __forceinline__ int src_odd(int n) {
    const int pn = n >> 8, p = n & 255, q = ((p >> 7) << 1) | ((p >> 2) & 1), ch = 64 * pn + 16 * ((p >> 5) & 3) + 4 * ((p >> 3) & 3) + (p & 3);
    const int base = q == 0 ? 2048 : (q == 1 ? 4096 : (q == 2 ? 0 : 6144));
    return base + ch;
}

__device__ __forceinline__ void rstd_table(const float* rsq, int pm, LAS float* tab, int tid) {
    if (tid < 256) tab[tid] = rstd16(rsq + ((size_t)pm * 256 + tid) * 16);
    LDS_BARRIER();
}
struct EpiG1Even {
    static constexpr bool PERM = true, AFTER_DRAIN = false, REP_EPI = (REP_MASK >> 12) & 1;
    const float* rsq; bf16_t* Z; float* vsq; float* pool_out; LAS const float* rtab; int pm0;
    __device__ __forceinline__ void operator()(const f32x4 (&acc)[2][2][4][2], const Unit& u, int wr, int wc, int fr_, int fq_) const {
        int fr = fr_, fq = fq_; asm volatile("" : "+v"(fr), "+v"(fq));
        const int tile = u.pn, cw = wc * 32 + 8 * fq;
#pragma unroll
        for (int ai = 0; ai < 2; ++ai)
#pragma unroll
            for (int m = 0; m < 4; ++m) {
                const int row = u.pm * 256 + ai * 128 + wr * 64 + m * 16 + fr;
                const float rs = u.pm == pm0 ? rtab[ai * 128 + wr * 64 + m * 16 + fr] : rstd16(rsq + (size_t)row * 16);
                if (tile < 12) {
                    const int kind = tile >> 2;
                    bf16_t* dst = Z + (size_t)kind * MP * D + (size_t)row * D + (tile & 3) * 256 + cw;
                    float ss = 0.f;
#pragma unroll
                    for (int bj = 0; bj < 2; ++bj) {
                        f32x4 v0 = acc[ai][bj][m][0] * rs, v1 = acc[ai][bj][m][1] * rs;
                        if (kind == 1) { v0 = silu4(v0); v1 = silu4(v1); }
                        if (kind == 2) ss += dot4(v0, v0) + dot4(v1, v1);
                        *(u32x4*)(dst + bj * 128) = pack8(v0, v1);
                        if (kind == 0 && (row & 2047) >= 2033) {
                            float* po = pool_out + ((size_t)(row >> 11) * 15 + ((row & 2047) - 2033)) * 1024 + (tile & 3) * 256 + bj * 128 + cw;
                            *(f32x4*)po = v0; *(f32x4*)(po + 4) = v1;
                        }
                    }
                    if (kind == 2) { ss += shx(ss, 16, 16 * fq + fr); ss += shx(ss, 32, 16 * fq + fr); if (fq == 0) vsq[(size_t)row * 16 + (tile - 8) * 4 + wc] = ss; }
                } else {
                    const int cb = tile - 12;
                    bf16_t* dst = Z + (size_t)3 * MP * D + (size_t)row * D + cb * 128 + cw;
                    const f32x4 u0 = acc[ai][0][m][0] * rs, u1 = acc[ai][0][m][1] * rs, g0 = acc[ai][1][m][0] * rs, g1 = acc[ai][1][m][1] * rs;
                    *(u32x4*)dst = pack8(u0 * silu4(g0), u1 * silu4(g1));
                }
            }
    }
};
__device__ __forceinline__ float dpp_shr1(float old, float v) { return __builtin_bit_cast(float, __builtin_amdgcn_update_dpp(__builtin_bit_cast(int, old), __builtin_bit_cast(int, v), 0x111, 0xf, 0xf, false)); }
__device__ __forceinline__ float dpp_shr2(float old, float v) { return __builtin_bit_cast(float, __builtin_amdgcn_update_dpp(__builtin_bit_cast(int, old), __builtin_bit_cast(int, v), 0x112, 0xf, 0xf, false)); }
struct EpiG1Odd {
    static constexpr bool PERM = true, AFTER_DRAIN = false, REP_EPI = false;
    const float* rsq; bf16_t* A2; const float* cw; float* conv_out; float* side; LAS float* halo; LAS const float* rtab; int pm0; LAS const float* cwl; int pn0;
    __device__ __forceinline__ void operator()(const f32x4 (&acc)[2][2][4][2], const Unit& u, int wr, int wc, int fr_, int fq_) const {
        int fr = fr_, fq = fq_; asm volatile("" : "+v"(fr), "+v"(fq));
        const int chl = wc * 16 + 4 * fq, ch = u.pn * 64 + chl;
        f32x4 w0, w1, w2;
        { const int ui = (u.pn - pn0) >> 2;
          if (u.pm == pm0 && ui >= 0 && ui < 8 && ((u.pn - pn0) & 3) == 0) { w0 = *(const LAS f32x4*)(cwl + (ui * 3 + 0) * 64 + chl); w1 = *(const LAS f32x4*)(cwl + (ui * 3 + 1) * 64 + chl); w2 = *(const LAS f32x4*)(cwl + (ui * 3 + 2) * 64 + chl); }
          else { w0 = *(const f32x4*)(cw + ch); w1 = *(const f32x4*)(cw + 2048 + ch); w2 = *(const f32x4*)(cw + 4096 + ch); } }
        f32x4 e[2][4]; float rsv[2][4];
#pragma unroll
        for (int ai = 0; ai < 2; ++ai)
#pragma unroll
            for (int m = 0; m < 4; ++m) {
                const int rb = 8 * ai + 4 * wr + m, row = u.pm * 256 + 16 * rb + fr;
                const float rs = u.pm == pm0 ? rtab[16 * rb + fr] : rstd16(rsq + (size_t)row * 16); rsv[ai][m] = rs;
                e[ai][m] = (acc[ai][0][m][0] * rs) * (acc[ai][0][m][1] * rs);
                if (fr >= 14) *(LAS f32x4*)(halo + (rb * 2 + (fr - 14)) * 64 + chl) = e[ai][m];
                if (m & 1) asm volatile("" ::: "memory");
            }
        asm volatile("s_waitcnt lgkmcnt(0)" ::: "memory"); __builtin_amdgcn_s_barrier(); asm volatile("" ::: "memory");
        float* sd = side + (size_t)u.pm * 6 * 2048 + ch;
#pragma unroll
        for (int ai = 0; ai < 2; ++ai)
#pragma unroll
            for (int m = 0; m < 4; ++m) {
                const int rb = 8 * ai + 4 * wr + m, row = u.pm * 256 + 16 * rb + fr;
                const float rs = rsv[ai][m];
                const f32x4 sg = (acc[ai][1][m][0] * rs) * silu4(acc[ai][1][m][1] * rs);
                f32x4 h0 = (f32x4){0.f, 0.f, 0.f, 0.f}, h1 = h0;
                if (rb > 0) { h0 = *(const LAS f32x4*)(halo + ((rb - 1) * 2 + 0) * 64 + chl); h1 = *(const LAS f32x4*)(halo + ((rb - 1) * 2 + 1) * 64 + chl); }
                const f32x4 hx = fr == 0 ? h0 : h1, ev = e[ai][m];
                f32x4 e1, e2;
#pragma unroll
                for (int k = 0; k < 4; ++k) { e1[k] = dpp_shr1(h1[k], ev[k]); e2[k] = dpp_shr2(hx[k], ev[k]); }
                const f32x4 a = sg * (w0 * e2 + w1 * e1 + w2 * ev);
                const bool top = (rb == 0 && fr < 2);
                if (!(top && (u.pm & 7) != 0)) *(u32x2*)(A2 + (size_t)row * 2048 + ch) = pack4(a);
                if (top) { *(f32x4*)(sd + fr * 2048) = ev; *(f32x4*)(sd + (4 + fr) * 2048) = sg; }
                if (rb == 15 && fr >= 14) {
                    *(f32x4*)(sd + (2 + fr - 14) * 2048) = ev;
                    if ((u.pm & 7) == 7) *(f32x4*)(conv_out + ((size_t)(u.pm >> 3) * 2 + (fr - 14)) * 2048 + ch) = ev;
                }
            }
    }
};
__device__ __forceinline__ void conv_fixup(const float* side, const float* cw, bf16_t* A2, int pm, int tid) {
    if ((pm & 7) == 0) return;
    const int ch = 4 * tid;
    const float* sp = side + (size_t)(pm - 1) * 6 * 2048 + ch; const float* sc = side + (size_t)pm * 6 * 2048 + ch;
    const f32x4 em2 = *(const f32x4*)(sp + 2 * 2048), em1 = *(const f32x4*)(sp + 3 * 2048), e0 = *(const f32x4*)sc, e1 = *(const f32x4*)(sc + 2048), s0 = *(const f32x4*)(sc + 4 * 2048), s1 = *(const f32x4*)(sc + 5 * 2048);
    const f32x4 w0 = *(const f32x4*)(cw + ch), w1 = *(const f32x4*)(cw + 2048 + ch), w2 = *(const f32x4*)(cw + 4096 + ch);
    *(u32x2*)(A2 + (size_t)(pm * 256) * 2048 + ch) = pack4(s0 * (w0 * em2 + w1 * em1 + w2 * e0));
    *(u32x2*)(A2 + (size_t)(pm * 256 + 1) * 2048 + ch) = pack4(s1 * (w0 * em1 + w1 * e0 + w2 * e1));
}
struct EpiRes {
    static constexpr bool PERM = true, AFTER_DRAIN = false, REP_EPI = false;
    bf16_t* xb; float* rsq;
    __device__ __forceinline__ void operator()(const f32x4 (&acc)[2][2][4][2], const Unit& u, int wr, int wc, int fr_, int fq_) const {
        int fr = fr_, fq = fq_; asm volatile("" : "+v"(fr), "+v"(fq));
        const int cw = wc * 32 + 8 * fq;
#pragma unroll
        for (int ai = 0; ai < 2; ++ai) {
            u32x4 old[4][2];
#pragma unroll
            for (int m = 0; m < 4; ++m)
#pragma unroll
                for (int bj = 0; bj < 2; ++bj) old[m][bj] = *(const u32x4*)(xb + (size_t)(u.pm * 256 + ai * 128 + wr * 64 + m * 16 + fr) * D + u.pn * 256 + bj * 128 + cw);
#pragma unroll
            for (int m = 0; m < 4; ++m) {
                const int row = u.pm * 256 + ai * 128 + wr * 64 + m * 16 + fr;
                float ss = 0.f;
#pragma unroll
                for (int bj = 0; bj < 2; ++bj) {
                    f32x4 b0, b1; unpack8(old[m][bj], b0, b1);
                    const u32x4 wv = pack8(b0 + acc[ai][bj][m][0], b1 + acc[ai][bj][m][1]);
                    *(u32x4*)(xb + (size_t)row * D + u.pn * 256 + bj * 128 + cw) = wv;
                    f32x4 r0, r1; unpack8(wv, r0, r1);
                    ss += dot4(r0, r0) + dot4(r1, r1);
                }
                ss += shx(ss, 16, 16 * fq + fr); ss += shx(ss, 32, 16 * fq + fr);
                if (fq == 0) rsq[(size_t)row * 16 + u.pn * 4 + wc] = ss;
            }
        }
    }
};
struct EpiProbe {
    static constexpr bool PERM = true, AFTER_DRAIN = false, REP_EPI = false;
    bf16_t* O; int ldc;
    __device__ __forceinline__ void operator()(const f32x4 (&acc)[2][2][4][2], const Unit& u, int wr, int wc, int fr_, int fq_) const {
        int fr = fr_, fq = fq_; asm volatile("" : "+v"(fr), "+v"(fq));
        const int cw = wc * 32 + 8 * fq;
#pragma unroll
        for (int ai = 0; ai < 2; ++ai)
#pragma unroll
            for (int m = 0; m < 4; ++m) {
                const int row = u.pm * 256 + ai * 128 + wr * 64 + m * 16 + fr;
#pragma unroll
                for (int bj = 0; bj < 2; ++bj) *(u32x4*)(O + (size_t)row * ldc + u.pn * 256 + bj * 128 + cw) = pack8(acc[ai][bj][m][0], acc[ai][bj][m][1]);
            }
    }
};
struct EpiQ {
    static constexpr bool PERM = true, AFTER_DRAIN = false, REP_EPI = false;
    const float* rsq; bf16_t* Q; LAS const float* rtab; int pm0;
    __device__ __forceinline__ void operator()(const f32x4 (&acc)[2][2][4][2], const Unit& u, int wr, int wc, int fr_, int fq_) const {
        int fr = fr_, fq = fq_; asm volatile("" : "+v"(fr), "+v"(fq));
        const int cw = wc * 32 + 8 * fq;
#pragma unroll
        for (int ai = 0; ai < 2; ++ai)
#pragma unroll
            for (int m = 0; m < 4; ++m) {
                const int row = u.pm * 256 + ai * 128 + wr * 64 + m * 16 + fr;
                const float rs = u.pm == pm0 ? rtab[ai * 128 + wr * 64 + m * 16 + fr] : rstd16(rsq + (size_t)row * 16);
#pragma unroll
                for (int bj = 0; bj < 2; ++bj) *(u32x4*)(Q + (size_t)row * D + u.pn * 256 + bj * 128 + cw) = pack8(acc[ai][bj][m][0] * rs, acc[ai][bj][m][1] * rs);
            }
    }
};
struct EpiMemKV {
    static constexpr bool PERM = true, AFTER_DRAIN = false, REP_EPI = false;
    const float* rstdm; float* outk; float* outv; bf16_t* kb; bf16_t* vb;
    __device__ __forceinline__ void operator()(const f32x4 (&acc)[2][2][4][2], const Unit& u, int wr, int wc, int fr_, int fq_) const {
        int fr = fr_, fq = fq_; asm volatile("" : "+v"(fr), "+v"(fq));
        const int layer = u.pn >> 3, isv = (u.pn >> 2) & 1, cw = (u.pn & 3) * 256 + wc * 32 + 8 * fq;
        float* of = (isv ? outv : outk) + (size_t)layer * MMEM * D; bf16_t* ob = (isv ? vb : kb) + (size_t)layer * MMEM * D;
#pragma unroll
        for (int ai = 0; ai < 2; ++ai)
#pragma unroll
            for (int m = 0; m < 4; ++m) {
                const int row = u.pm * 256 + ai * 128 + wr * 64 + m * 16 + fr;
                const float rs = rstdm[row];
#pragma unroll
                for (int bj = 0; bj < 2; ++bj) {
                    const size_t off = (size_t)row * D + bj * 128 + cw;
                    const f32x4 v0 = acc[ai][bj][m][0] * rs, v1 = acc[ai][bj][m][1] * rs;
                    *(f32x4*)(of + off) = v0; *(f32x4*)(of + off + 4) = v1;
                    *(u32x4*)(ob + off) = pack8(v0, v1);
                }
            }
    }
};

struct TrItem { const float* wp; int ldw; const float* gk; float sc; bf16_t* wt; int K; };
__device__ __forceinline__ void p0_tr_desc(const float* W, int ldw, int K, int Nd, const float* gk, float sc, bf16_t* WT, int perm, int r, int lane, TrItem& t) {
    const int nblk = Nd / 32, kb = r / nblk, nb = r % nblk, dstn0 = 32 * nb, dn = dstn0 + (lane & 31);
    const int srccol = perm == 0 ? dn : (perm == 1 ? src_even(dn) : src_odd(dn));
    t.wp = W + (size_t)(64 * kb + (lane >> 5)) * ldw + srccol; t.ldw = ldw; t.gk = gk ? gk + 64 * kb : nullptr; t.sc = sc; t.wt = WT + (size_t)dstn0 * K + 64 * kb; t.K = K;
}
__device__ __forceinline__ void p0_resolve(Frame& F, int it, int lane, TrItem& t) {
    constexpr int I_AB1 = 16 * (NAB / 32), I_C1 = 16 * (NC / 32), I_2 = 32 * 32, I_SQ = 16 * 32, I_PM = 4 * 8;
    int r = it;
    if (r < 2 * I_AB1) { const int jj = r / I_AB1; p0_tr_desc(FIN(10) + (size_t)jj * D * NAB, NAB, D, NAB, FIN(7) + 2 * jj * D, 1.f, ((bf16_t*)(F.ws + WS_AB1)) + (size_t)jj * NAB * D, 1, r % I_AB1, lane, t); return; } r -= 2 * I_AB1;
    if (r < 2 * I_C1) { const int jj = r / I_C1; p0_tr_desc(FIN(17) + (size_t)jj * D * NC, NC, D, NC, FIN(7) + (2 * jj + 1) * D, 1.f, ((bf16_t*)(F.ws + WS_C1)) + (size_t)jj * NC * D, 2, r % I_C1, lane, t); return; } r -= 2 * I_C1;
    if (r < 2 * I_2) { const int jj = r / I_2; p0_tr_desc(FIN(16) + (size_t)jj * 2048 * D, D, 2048, D, nullptr, 1.f, ((bf16_t*)(F.ws + WS_AB2)) + (size_t)jj * D * 2048, 0, r % I_2, lane, t); return; } r -= 2 * I_2;
    if (r < 2 * I_2) { const int jj = r / I_2; p0_tr_desc(FIN(19) + (size_t)jj * 2048 * D, D, 2048, D, nullptr, 1.f, ((bf16_t*)(F.ws + WS_C2)) + (size_t)jj * D * 2048, 0, r % I_2, lane, t); return; } r -= 2 * I_2;
    if (r < 4 * I_SQ) { const int l = r / I_SQ; p0_tr_desc(FIN(20) + (size_t)l * D * D, D, D, D, FIN(8) + l * D, QSCALE, ((bf16_t*)(F.ws + WS_WQ)) + (size_t)l * D * D, 0, r % I_SQ, lane, t); return; } r -= 4 * I_SQ;
    if (r < 4 * I_SQ) { const int l = r / I_SQ; p0_tr_desc(FIN(21) + (size_t)l * D * D, D, D, D, FIN(9) + l * D, 1.f, ((bf16_t*)(F.ws + WS_WKV)) + (size_t)(2 * l) * D * D, 0, r % I_SQ, lane, t); return; } r -= 4 * I_SQ;
    if (r < 4 * I_SQ) { const int l = r / I_SQ; p0_tr_desc(FIN(22) + (size_t)l * D * D, D, D, D, FIN(9) + l * D, 1.f, ((bf16_t*)(F.ws + WS_WKV)) + (size_t)(2 * l + 1) * D * D, 0, r % I_SQ, lane, t); return; } r -= 4 * I_SQ;
    if (r < 4 * I_SQ) { const int l = r / I_SQ; p0_tr_desc(FIN(23) + (size_t)l * D * D, D, D, D, nullptr, 1.f, ((bf16_t*)(F.ws + WS_WO)) + (size_t)l * D * D, 0, r % I_SQ, lane, t); return; } r -= 4 * I_SQ;
    { const int jg = r / I_PM; p0_tr_desc(FIN(11) + (size_t)jg * 65536, 256, 256, 256, nullptr, 1.f, ((bf16_t*)(F.ws + WS_PMT)) + (size_t)jg * 65536, 0, r % I_PM, lane, t); }
}
__device__ __forceinline__ void p0_tr_load(const TrItem& t, int lane, float (&v)[32], f32x4& g0, f32x4& g1) {
    const int c = lane & 7;
    g0 = (f32x4){t.sc, t.sc, t.sc, t.sc}; g1 = g0;
    if (t.gk) { g0 = *(const f32x4*)(t.gk + 8 * c) * t.sc; g1 = *(const f32x4*)(t.gk + 8 * c + 4) * t.sc; }
#pragma unroll
    for (int i = 0; i < 32; ++i) v[i] = t.wp[(size_t)(2 * i) * t.ldw];
}
__device__ __forceinline__ void p0_tr_finish(const TrItem& t, int lane, const float (&v)[32], f32x4 g0, f32x4 g1, LAS float* scr) {
#pragma unroll
    for (int i = 0; i < 32; ++i) scr[(2 * i + (lane >> 5)) * 33 + (lane & 31)] = v[i];
    LDS_WAIT(); asm volatile("" ::: "memory");
    const int c = lane & 7;
#pragma unroll
    for (int jj = 0; jj < 4; ++jj) {
        const int n = (lane >> 3) + 8 * jj; const LAS float* s = scr + (8 * c) * 33 + n;
        u32x4 o; o.x = cvt_pk_bf16(s[0 * 33] * g0[0], s[1 * 33] * g0[1]); o.y = cvt_pk_bf16(s[2 * 33] * g0[2], s[3 * 33] * g0[3]); o.z = cvt_pk_bf16(s[4 * 33] * g1[0], s[5 * 33] * g1[1]); o.w = cvt_pk_bf16(s[6 * 33] * g1[2], s[7 * 33] * g1[3]);
        *(u32x4*)(t.wt + (size_t)n * t.K + 8 * c) = o;
    }
    LDS_WAIT(); asm volatile("" ::: "memory");
}
__device__ __forceinline__ float p0_row_finish(const f32x4 (&v)[4], bf16_t* dst, float* copy, int lane) {
    float s = 0.f;
#pragma unroll
    for (int jj = 0; jj < 4; ++jj) s += dot4(v[jj], v[jj]);
    s = wave_sum(s, lane);
    u32x2* o8 = (u32x2*)dst + lane;
#pragma unroll
    for (int jj = 0; jj < 4; ++jj) o8[64 * jj] = pack4(v[jj]);
    if (copy) {
#pragma unroll
        for (int jj = 0; jj < 4; ++jj) ((f32x4*)copy + lane)[64 * jj] = v[jj];
    }
    return s;
}
namespace p0seg {
constexpr int I_AB1 = 16 * (NAB / 32), I_C1 = 16 * (NC / 32), I_2 = 32 * 32, I_SQ = 16 * 32, I_PM = 4 * 8;
constexpr int O_AB1 = 0, O_C1 = 2 * I_AB1, O_AB2 = O_C1 + 2 * I_C1, O_C2 = O_AB2 + 2 * I_2, O_Q = O_C2 + 2 * I_2, O_K = O_Q + 4 * I_SQ, O_V = O_K + 4 * I_SQ, O_O = O_V + 4 * I_SQ, O_P = O_O + 4 * I_SQ, NITEMS = O_P + 8 * I_PM;
constexpr int NA = I_AB1 + I_2 + I_SQ + 8 * I_SQ + I_SQ + 4 * I_PM, NB = NITEMS - NA;
__device__ __forceinline__ int item_a(int i) {
    if (i < I_AB1) return O_AB1 + i; i -= I_AB1;
    if (i < I_2) return O_AB2 + i; i -= I_2;
    if (i < I_SQ) return O_Q + i; i -= I_SQ;
    if (i < 8 * I_SQ) return O_K + i; i -= 8 * I_SQ;
    if (i < I_SQ) return O_O + i; i -= I_SQ;
    return O_P + i;
}
__device__ __forceinline__ int item_b(int i) {
    if (i < I_AB1) return O_AB1 + I_AB1 + i; i -= I_AB1;
    if (i < 2 * I_C1) return O_C1 + i; i -= 2 * I_C1;
    if (i < I_2) return O_AB2 + I_2 + i; i -= I_2;
    if (i < 2 * I_2) return O_C2 + i; i -= 2 * I_2;
    if (i < 3 * I_SQ) return O_Q + I_SQ + i; i -= 3 * I_SQ;
    if (i < 3 * I_SQ) return O_O + I_SQ + i; i -= 3 * I_SQ;
    return O_P + 4 * I_PM + i;
}
}
__device__ __forceinline__ void p0_weights(Frame& F0, int part, int gw, int NGW, int half = -1) {
    Frame F = launder(F0);
    LAS float* scr = (LAS float*)(F.lds + F.wave * 16384);
    const int lane = F.lane;
    constexpr int NB_ODD = (int)((long)p0seg::NB * PB_ODD_PCT / 100);
    const int base = (part == 1 && half == 0) ? NB_ODD : 0;
    const int n = part == 0 ? p0seg::NA : (part == 1 ? (half == 1 ? NB_ODD : (half == 0 ? p0seg::NB - NB_ODD : p0seg::NB)) : p0seg::NITEMS);
#define P0_ITEM(i_) (part == 0 ? p0seg::item_a(i_) : (part == 1 ? p0seg::item_b(base + (i_)) : (i_)))
    if (gw < n) {
        TrItem cur, nxt; float va[32], vb[32]; f32x4 ga0, ga1, gb0, gb1;
        p0_resolve(F, P0_ITEM(gw), lane, cur); p0_tr_load(cur, lane, va, ga0, ga1);
        for (int it = gw; it < n; it += 2 * NGW) {
            const bool h1 = it + NGW < n, h2 = it + 2 * NGW < n;
            if (h1) { p0_resolve(F, P0_ITEM(it + NGW), lane, nxt); p0_tr_load(nxt, lane, vb, gb0, gb1); }
            p0_tr_finish(cur, lane, va, ga0, ga1, scr);
            if (h2) { p0_resolve(F, P0_ITEM(it + 2 * NGW), lane, cur); p0_tr_load(cur, lane, va, ga0, ga1); }
            if (h1) p0_tr_finish(nxt, lane, vb, gb0, gb1, scr);
        }
    }
#undef P0_ITEM
}
__device__ __forceinline__ void p0_prologue(Frame& F0) {
    Frame F = launder(F0);
    const int gw = F.bx * NWAVES + F.wave, NGW = F.G * NWAVES, lane = F.lane;
    p0_weights(F0, (!MK_SPLIT && SPLIT_PROLOGUE) ? 0 : 2, gw, NGW);
    for (int m0 = 2 * gw; m0 < MP + MS + MMEM; m0 += 2 * NGW) {
        f32x4 v[2][4];
#pragma unroll
        for (int r = 0; r < 2; ++r) {
            const int m = m0 + r;
            const float* src = m < MP ? FIN(0) + (size_t)m * D : (m < MP + MS ? FIN(1) + (size_t)(m - MP) * D : FIN(2) + (size_t)(m - MP - MS) * D);
#pragma unroll
            for (int jj = 0; jj < 4; ++jj) v[r][jj] = ((const f32x4*)src + lane)[64 * jj];
        }
#pragma unroll
        for (int r = 0; r < 2; ++r) {
            const int m = m0 + r;
            if (m < MP) {
                const float s = p0_row_finish(v[r], ((bf16_t*)(F.ws + WS_XB)) + (size_t)m * D, nullptr, lane);
                if (lane < 16) ((float*)(F.ws + WS_RSQ))[(size_t)m * 16 + lane] = lane == 0 ? s : 0.f;
            } else if (m < MP + MS) {
                const int b = m - MP;
                const float s = p0_row_finish(v[r], ((bf16_t*)(F.ws + WS_XB)) + (size_t)m * D, ((float*)(F.ws + WS_XS)) + (size_t)b * D, lane);
                if (lane < 32) ((float*)(F.ws + WS_SMALL))[b * 32 + lane] = lane == 0 ? s : 0.f;
            } else {
                const int t = m - MP - MS;
                const float s = p0_row_finish(v[r], ((bf16_t*)(F.ws + WS_MEMB)) + (size_t)t * D, nullptr, lane);
                if (lane == 0) ((float*)(F.ws + WS_SMALL + 65536))[t] = rsqrtf(s * (1.0f / D) + EPS);
            }
        }
    }
}

__device__ __forceinline__ bf16x8 tr_frag(LAS unsigned char* p0, LAS unsigned char* p1) {
    const s16x4 lo = __builtin_amdgcn_ds_read_tr16_b64_v4i16((LAS s16x4*)p0);
    const s16x4 hi = __builtin_amdgcn_ds_read_tr16_b64_v4i16((LAS s16x4*)p1);
    return (bf16x8){lo[0], lo[1], lo[2], lo[3], hi[0], hi[1], hi[2], hi[3]};
}
#define MFMA16(a, b, c) __builtin_amdgcn_mfma_f32_16x16x32_bf16((a), (b), (c), 0, 0, 0)

constexpr int SGU_AS = 0, SGU_VS = 36864, SGU_RV = 36864 + 69632;
struct NoHook { __device__ __forceinline__ void operator()() const {} };
template <class Hook> __device__ __forceinline__ void sgu_chunk(Frame& F0, int j, int n, const int g0, const int g1, const Hook& hook) {
    Frame F = launder(F0);
    LAS unsigned char* lds = F.lds;
    const int tid = F.tid, lane = F.lane, w = F.wave, fr = lane & 15, fq = lane >> 4, row0 = n * 128;
    LAS float* rvs = (LAS float*)(lds + SGU_RV);
    if (tid < 128) rvs[tid] = rstd16(((float*)(F.ws + WS_VSQ)) + (size_t)(row0 + tid) * 16);
    const bf16_t* ZV = ((bf16_t*)(F.ws + WS_Z)) + (size_t)2 * MP * D + (size_t)row0 * D;
    const bf16_t* ZUG = ((bf16_t*)(F.ws + WS_Z)) + (size_t)3 * MP * D + (size_t)row0 * D;
    bf16_t* A2 = ((bf16_t*)(F.ws + WS_A2)) + (size_t)row0 * 2048 + 1024;
    const unsigned voff = (unsigned)(tid >> 5) * (D * 2) + (unsigned)(tid & 31) * 16u;
    const unsigned woff = (unsigned)(tid >> 4) * 512u + (unsigned)(tid & 15) * 32u;
    const int wt_t = tid >> 4, wt_s0 = (tid & 15) * 8;
    const unsigned aoff = (unsigned)(tid >> 5) * 4096u + (unsigned)(tid & 31) * 16u;
    u32x4 vt[8]; f32x4 wt[8];
#define SGU_LOAD(g_) do { const char* vb_ = (const char*)(ZV + (g_) * 256); const char* wb_ = (const char*)(FIN(13) + (size_t)(j * 4 + (g_)) * 16384); \
        _Pragma("unroll") for (int i_ = 0; i_ < 8; ++i_) vt[i_] = *(const u32x4*)(vb_ + (size_t)(16 * i_) * D * 2 + voff); \
        _Pragma("unroll") for (int i_ = 0; i_ < 4; ++i_) { wt[2 * i_] = *(const f32x4*)(wb_ + (size_t)(32 * i_) * 512 + woff); wt[2 * i_ + 1] = *(const f32x4*)(wb_ + (size_t)(32 * i_) * 512 + woff + 16); } } while (0)
    SGU_LOAD(g0);
    LDS_BARRIER();
#pragma unroll
    for (int g = g0; g < g1; ++g) {
#pragma unroll
        for (int i = 0; i < 8; ++i) *(LAS u32x4*)(lds + SGU_VS + ((tid >> 5) + 16 * i) * 544 + (tid & 31) * 16) = vt[i];
#pragma unroll
        for (int i = 0; i < 4; ++i) {
            const int t = wt_t + 32 * i; float v[8];
#pragma unroll
            for (int e = 0; e < 4; ++e) { v[e] = (wt_s0 + e <= t) ? wt[2 * i][e] * rvs[wt_s0 + e] : 0.f; v[4 + e] = (wt_s0 + 4 + e <= t) ? wt[2 * i + 1][e] * rvs[wt_s0 + 4 + e] : 0.f; }
            u32x4 o; o.x = cvt_pk_bf16(v[0], v[1]); o.y = cvt_pk_bf16(v[2], v[3]); o.z = cvt_pk_bf16(v[4], v[5]); o.w = cvt_pk_bf16(v[6], v[7]);
            *(LAS u32x4*)(lds + SGU_AS + t * 288 + wt_s0 * 2) = o;
        }
        LDS_BARRIER();
        const int cg = g * 256 + 32 * w + 8 * fq;
        const unsigned lo_in = (unsigned)fr * (D * 2) + (unsigned)(32 * w + 8 * fq) * 2u, lo_out = (unsigned)fr * 4096u + (unsigned)(32 * w + 8 * fq) * 2u;
        u32x4 ugr[8];
#pragma unroll
        for (int mt = 0; mt < 8; ++mt) ugr[mt] = *(const u32x4*)((const char*)(ZUG + (size_t)(16 * mt) * D + g * 256) + lo_in);
        f32x4 ggv[2]; float bbv[8];
#pragma unroll
        for (int nt = 0; nt < 2; ++nt) ggv[nt] = *(const f32x4*)(FIN(15) + j * 1024 + cg + 4 * nt);
#pragma unroll
        for (int mt = 0; mt < 8; ++mt) bbv[mt] = FIN(14)[(j * 4 + g) * 128 + 16 * mt + fr];
        if (g + 1 < g1) SGU_LOAD(g + 1); else hook();
        f32x4 acc[8][2];
#pragma unroll
        for (int mt = 0; mt < 8; ++mt) { acc[mt][0] = (f32x4){0.f, 0.f, 0.f, 0.f}; acc[mt][1] = (f32x4){0.f, 0.f, 0.f, 0.f}; }
#pragma unroll
        for (int ks = 0; ks < 4; ++ks) {
            bf16x8 Bf[2];
#pragma unroll
            for (int nt = 0; nt < 2; ++nt) {
                LAS unsigned char* p = lds + SGU_VS + (32 * ks + 8 * fq + (fr >> 2)) * 544 + (32 * w + 8 * (fr & 3) + 4 * nt) * 2;
                Bf[nt] = tr_frag(p, p + 4 * 544);
            }
            bf16x8 Af[8];
#pragma unroll
            for (int mt = 0; mt < 8; ++mt) if (32 * ks <= 16 * mt + 15) Af[mt] = *(LAS bf16x8*)(lds + SGU_AS + (16 * mt + fr) * 288 + (32 * ks + 8 * fq) * 2);
#pragma unroll
            for (int mt = 0; mt < 8; ++mt) if (32 * ks <= 16 * mt + 15) { acc[mt][0] = MFMA16(Bf[0], Af[mt], acc[mt][0]); acc[mt][1] = MFMA16(Bf[1], Af[mt], acc[mt][1]); }
        }
#pragma unroll
        for (int mt = 0; mt < 8; ++mt) {
            const float bb = bbv[mt];
            f32x4 u0, u1; unpack8(ugr[mt], u0, u1);
            *(u32x4*)((char*)(A2 + (size_t)(16 * mt) * 2048 + g * 256) + lo_out) = pack8(u0 * (acc[mt][0] * ggv[0] + bb), u1 * (acc[mt][1] * ggv[1] + bb));
        }
        LDS_BARRIER();
    }
#undef SGU_LOAD
}
constexpr int POOL_AP = 15 * 544;
__device__ __forceinline__ void pool_fetch(const bf16_t* xau  , int tid, int posc  , u32x4 (&own)[8], u32x4& halo) {
    asm volatile("" : "+v"(tid));
    const int cb = tid & 31, hr = tid >> 5;
    const char* base = (const char*)xau + (unsigned)((hr * 8) * D + cb * 8) * 2u;
#pragma unroll
    for (int r = 0; r < 8; ++r) own[r] = *(const u32x4*)(base + (size_t)r * D * 2);
    halo = (u32x4){0u, 0u, 0u, 0u};
    if (hr < 15 && posc > 0) halo = *(const u32x4*)((const char*)(xau + (ptrdiff_t)(hr - 15) * D) + cb * 16);
}
template <int WIN> __device__ __forceinline__ void pool_stage(const u32x4 (&own)[8], const u32x4& halo, LAS unsigned char* lds, int tid, int pos0) {
    const int cb = tid & 31, hr = tid >> 5;
    LAS unsigned char* rawp = lds + (15 + hr * 8) * 544 + cb * 16;
#pragma unroll
    for (int r = 0; r < 8; ++r) *(LAS u32x4*)(rawp + r * 544) = own[r];
    if (hr < 15) *(LAS u32x4*)(lds + hr * 544 + cb * 16) = halo;
    LDS_BARRIER();
    f32x4 S0 = (f32x4){0.f, 0.f, 0.f, 0.f}, S1 = S0;
#pragma unroll
    for (int i = 0; i < WIN - 1; ++i) { f32x4 a, b; unpack8(*(LAS u32x4*)(rawp + (i - (WIN - 1)) * 544), a, b); S0 += a; S1 += b; }
    u32x4 out[8];
#pragma unroll
    for (int r = 0; r < 8; ++r) {
        f32x4 a, b; unpack8(own[r], a, b); S0 += a; S1 += b;
        const int cnt = (pos0 + r + 1) < WIN ? (pos0 + r + 1) : WIN; const float ic = 1.0f / (float)cnt;
        out[r] = pack8(S0 * ic - a, S1 * ic - b);
        f32x4 c, d; unpack8(*(LAS u32x4*)(rawp + (r - (WIN - 1)) * 544), c, d); S0 -= c; S1 -= d;
    }
    LDS_BARRIER();
#pragma unroll
    for (int r = 0; r < 8; ++r) *(LAS u32x4*)(rawp + r * 544) = out[r];
    LDS_BARRIER();
}
__device__ __forceinline__ void pool_gate_fetch(const bf16_t* zsga  , int g, int lane, int w, u32x4 (&sgr)[8]) {
    asm volatile("" : "+v"(lane));
    const unsigned lo_in = (unsigned)(lane & 15) * (D * 2) + (unsigned)(32 * w + 8 * (lane >> 4)) * 2u;
#pragma unroll
    for (int mt = 0; mt < 8; ++mt) sgr[mt] = *(const u32x4*)((const char*)(zsga + (size_t)(16 * mt) * D + g * 256) + lo_in);
}
template <class Hook> __device__ __forceinline__ void pool_mma_epi(Frame& F, int j, int g, int row0, const u32x4 (&sgr)[8], bf16_t* A2, LAS unsigned char* lds  , int w, int fr, int fq, const Hook& hook) {
    const int cg = g * 256 + 32 * w + 8 * fq;
    const unsigned lo_out = (unsigned)fr * 4096u + (unsigned)(32 * w + 8 * fq) * 2u, lo_pm = (unsigned)(32 * w + 8 * (fr >> 2) + (fr & 3)) * 512u + (unsigned)fq * 16u;
    f32x4 acc[8][2];
#pragma unroll
    for (int mt = 0; mt < 8; ++mt) { acc[mt][0] = (f32x4){0.f, 0.f, 0.f, 0.f}; acc[mt][1] = (f32x4){0.f, 0.f, 0.f, 0.f}; }
    const bf16_t* pm = ((bf16_t*)(F.ws + WS_PMT)) + (size_t)(j * 4 + g) * 65536;
    bf16x8 Bq[8][2]; f32x4 psv[2];
#pragma unroll
    for (int ks = 0; ks < 8; ++ks) { Bq[ks][0] = *(const bf16x8*)((const char*)(pm + 32 * ks) + lo_pm); Bq[ks][1] = *(const bf16x8*)((const char*)(pm + 4 * 256 + 32 * ks) + lo_pm); }
#pragma unroll
    for (int nt = 0; nt < 2; ++nt) psv[nt] = *(const f32x4*)(FIN(12) + j * 1024 + cg + 4 * nt);
    hook();
    {
        bf16x8 Af[2][4];
#define POOL_AREAD(n_, buf_) do { _Pragma("unroll") for (int m4_ = 0; m4_ < 4; ++m4_) Af[buf_][m4_] = *(LAS bf16x8*)(lds + (16 * (4 * ((n_) & 1) + m4_) + fr) * 544 + (32 * ((n_) >> 1) + 8 * fq) * 2); } while (0)
        POOL_AREAD(0, 0);
        __builtin_amdgcn_sched_group_barrier(0x100, 4, 0);
#pragma unroll
        for (int n = 0; n < 16; ++n) {
            if (n < 15) POOL_AREAD(n + 1, (n + 1) & 1);
#pragma unroll
            for (int m4 = 0; m4 < 4; ++m4) { const int mt = 4 * (n & 1) + m4, ks = n >> 1; acc[mt][0] = MFMA16(Bq[ks][0], Af[n & 1][m4], acc[mt][0]); acc[mt][1] = MFMA16(Bq[ks][1], Af[n & 1][m4], acc[mt][1]); }
            if (n < 15) __builtin_amdgcn_sched_group_barrier(0x100, 4, 0);
            __builtin_amdgcn_sched_group_barrier(0x008, 8, 0);
        }
#undef POOL_AREAD
    }
#pragma unroll
    for (int mt = 0; mt < 8; ++mt) {
        f32x4 s0, s1; unpack8(sgr[mt], s0, s1);
        *(u32x4*)((char*)(A2 + (size_t)(16 * mt) * 2048 + g * 256) + lo_out) = pack8(acc[mt][0] * psv[0] * s0, acc[mt][1] * psv[1] * s1);
    }
}
template <int GA, int GB> __device__ __forceinline__ void pool_pair(Frame& F0, int j, int n, const u32x4 (&ownA)[8], const u32x4& haloA, const u32x4 (&sgrA)[8]) {
    Frame F = launder(F0);
    LAS unsigned char* lds = F.lds;
    const int tid = F.tid, lane = F.lane, w = F.wave, fr = lane & 15, fq = lane >> 4, row0 = n * 128;
    const int pos0 = (row0 & 2047) + (tid >> 5) * 8;
    const bf16_t* xa = ((bf16_t*)(F.ws + WS_Z)) + (size_t)row0 * D;
    const bf16_t* ZSGA = ((bf16_t*)(F.ws + WS_Z)) + (size_t)1 * MP * D + (size_t)row0 * D;
    bf16_t* A2 = ((bf16_t*)(F.ws + WS_A2)) + (size_t)row0 * 2048;
    constexpr int WA = 2 << GA, WB = 2 << GB;
    pool_stage<WA>(ownA, haloA, lds, tid, pos0);
    u32x4 ownB[8], haloB, sgrB[8];
    pool_mma_epi(F, j, GA, row0, sgrA, A2, lds + POOL_AP, w, fr, fq, [&]() { pool_fetch(xa + GB * 256, tid, row0 & 2047, ownB, haloB); pool_gate_fetch(ZSGA, GB, lane, w, sgrB); }); LDS_BARRIER();
    pool_stage<WB>(ownB, haloB, lds, tid, pos0);
    pool_mma_epi(F, j, GB, row0, sgrB, A2, lds + POOL_AP, w, fr, fq, NoHook{}); LDS_BARRIER();
}
constexpr int ATT_SLOT = 64 * 544;
__device__ __forceinline__ void attn_prompt(Frame& F0, int layer) {
    Frame F = launder(F0);
    LAS unsigned char* lds = F.lds;
    const int tid = F.tid, lane = F.lane, w = F.wave, fr = lane & 15, fq = lane >> 4;
    const bf16_t* Kl = ((bf16_t*)(F.ws + WS_KB)) + (size_t)layer * MMEM * D; const bf16_t* Vl = ((bf16_t*)(F.ws + WS_VB)) + (size_t)layer * MMEM * D;
    for (int kk = F.rk; kk < 64; kk += F.rw) {
        const int b = F.xq, h = kk >> 4, qb = kk & 15;
        const size_t rowq = (size_t)b * SEQ + qb * 128 + 16 * w + fr;
        bf16x8 Qf[8];
#pragma unroll
        for (int ks = 0; ks < 8; ++ks) Qf[ks] = *(const bf16x8*)(((bf16_t*)(F.ws + WS_Q)) + rowq * D + h * 256 + 32 * ks + 8 * fq);
        const bf16_t* kbase = Kl + (size_t)(b * 256) * D + h * 256; const bf16_t* vbase = Vl + (size_t)(b * 256) * D + h * 256;
        u32x4 st[4];
#define ATT_GLOAD(c) do { const bf16_t* src_ = ((c) < 4 ? kbase : vbase) + (size_t)(64 * ((c) & 3)) * D; _Pragma("unroll") for (int i_ = 0; i_ < 4; ++i_) { const int idx_ = tid + 512 * i_; st[i_] = *(const u32x4*)(src_ + (size_t)(idx_ >> 5) * D + (idx_ & 31) * 8); } } while (0)
#define ATT_LSTORE(slot) do { _Pragma("unroll") for (int i_ = 0; i_ < 4; ++i_) { const int idx_ = tid + 512 * i_; *(LAS u32x4*)(lds + (slot) * ATT_SLOT + (idx_ >> 5) * 544 + (idx_ & 31) * 16) = st[i_]; } } while (0)
        f32x4 S[16], Oa[16]; bf16x8 Pf[8]; float inv = 0.f;
#pragma unroll
        for (int i = 0; i < 16; ++i) { S[i] = (f32x4){0.f, 0.f, 0.f, 0.f}; Oa[i] = (f32x4){0.f, 0.f, 0.f, 0.f}; }
        ATT_GLOAD(0); ATT_LSTORE(0); __syncthreads();
#pragma unroll
        for (int c = 0; c < 8; ++c) {
            if (c < 7) ATT_GLOAD(c + 1);
            LAS unsigned char* slot = lds + (c & 1) * ATT_SLOT;
            if (c < 4) {
#pragma unroll
                for (int ml = 0; ml < 4; ++ml)
#pragma unroll
                    for (int ks = 0; ks < 8; ++ks) {
                        const bf16x8 Kf = *(LAS bf16x8*)(slot + (16 * ml + fr) * 544 + (32 * ks + 8 * fq) * 2);
                        S[4 * c + ml] = MFMA16(Kf, Qf[ks], S[4 * c + ml]);
                    }
                if (c == 3) {
                    float mx = S[0][0];
#pragma unroll
                    for (int i = 0; i < 16; ++i) { mx = fmaxf(mx, fmaxf(fmaxf(S[i][0], S[i][1]), fmaxf(S[i][2], S[i][3]))); }
                    mx = fmaxf(mx, shx(mx, 16, lane)); mx = fmaxf(mx, shx(mx, 32, lane));
                    float sum = 0.f;
#pragma unroll
                    for (int i = 0; i < 16; ++i) {
#pragma unroll
                        for (int e = 0; e < 4; ++e) { S[i][e] = __builtin_amdgcn_exp2f(S[i][e] - mx); sum += S[i][e]; }
                    }
                    sum += shx(sum, 16, lane); sum += shx(sum, 32, lane);
                    inv = 1.0f / sum;
#pragma unroll
                    for (int a = 0; a < 8; ++a) {
                        u32x4 pw; pw.x = cvt_pk_bf16(S[2 * a][0], S[2 * a][1]); pw.y = cvt_pk_bf16(S[2 * a][2], S[2 * a][3]); pw.z = cvt_pk_bf16(S[2 * a + 1][0], S[2 * a + 1][1]); pw.w = cvt_pk_bf16(S[2 * a + 1][2], S[2 * a + 1][3]);
                        Pf[a] = __builtin_bit_cast(bf16x8, pw);
                    }
                }
            } else {
#pragma unroll
                for (int al = 0; al < 2; ++al)
#pragma unroll
                    for (int dt = 0; dt < 16; ++dt) {
                        LAS unsigned char* p = slot + (32 * al + 4 * fq + (fr >> 2)) * 544 + (16 * dt + 4 * (fr & 3)) * 2;
                        const bf16x8 Vf = tr_frag(p, p + 16 * 544);
                        Oa[dt] = MFMA16(Vf, Pf[2 * (c - 4) + al], Oa[dt]);
                    }
            }
            if (c < 7) ATT_LSTORE((c + 1) & 1);
            __syncthreads();
        }
#pragma unroll
        for (int dt = 0; dt < 16; ++dt) *(u32x2*)(((bf16_t*)(F.ws + WS_O)) + rowq * D + h * 256 + 16 * dt + 4 * fq) = pack4(Oa[dt] * inv);
#undef ATT_GLOAD
#undef ATT_LSTORE
    }
}

template <class Epi, int N>
__device__ __forceinline__ void sgemm16(Frame& F0, const bf16_t* A, const bf16_t* Bt, int K, const Epi& E) {
    Frame F = launder(F0);
    LAS unsigned char* lds = F.lds;
    constexpr int CW = N / 32, NT = CW / 16, KS = NT == 2 ? 8 : (NT == 10 ? 4 : 2), NG = 8 / KS, NTW = NT / NG;
    static_assert(NT * 16 == CW && NTW * NG == NT && 2 * CW <= NWAVES * 64, "sgemm16 geometry");
    const int tid = F.tid, lane = F.lane, w = F.wave, fr = lane & 15, fq = lane >> 4;
    const int ksi = w % KS, ng = w / KS, kslice = K / KS, nkb = kslice / 128;
    const bf16_t* A16 = A + (size_t)(16 * F.xq) * K;
    for (int slot = F.rk; slot < 32; slot += F.rw) {
        const int erow = tid / (CW / 8), ecg = tid % (CW / 8); const bool eact = tid < 2 * CW;
        typename Epi::Pre pre{};
        if (eact) pre = E.pre(16 * F.xq + erow, slot * CW + 8 * ecg);
        f32x4 acc[NTW];
#pragma unroll
        for (int jn = 0; jn < NTW; ++jn) acc[jn] = (f32x4){0.f, 0.f, 0.f, 0.f};
        const bf16_t* ap = A16 + (size_t)fr * K + ksi * kslice + 8 * fq;
        const bf16_t* bp = Bt + (size_t)(slot * CW + (ng * NTW) * 16 + fr) * K + ksi * kslice + 8 * fq;
        {
            bf16x8 Af[2][4], Bf[2][4][NTW];
#define SG_LOAD(kb_, buf_) do { _Pragma("unroll") for (int k4 = 0; k4 < 4; ++k4) { Af[buf_][k4] = *(const bf16x8*)(ap + 128 * (kb_) + 32 * k4); \
                _Pragma("unroll") for (int jn = 0; jn < NTW; ++jn) Bf[buf_][k4][jn] = *(const bf16x8*)(bp + (size_t)(16 * jn) * K + 128 * (kb_) + 32 * k4); } } while (0)
            SG_LOAD(0, 0);
            for (int kb = 0; kb < nkb; kb += 2) {
                if (kb + 1 < nkb) SG_LOAD(kb + 1, 1);
#pragma unroll
                for (int k4 = 0; k4 < 4; ++k4)
#pragma unroll
                    for (int jn = 0; jn < NTW; ++jn) acc[jn] = MFMA16(Bf[0][k4][jn], Af[0][k4], acc[jn]);
                if (kb + 1 < nkb) {
                    if (kb + 2 < nkb) SG_LOAD(kb + 2, 0);
#pragma unroll
                    for (int k4 = 0; k4 < 4; ++k4)
#pragma unroll
                        for (int jn = 0; jn < NTW; ++jn) acc[jn] = MFMA16(Bf[1][k4][jn], Af[1][k4], acc[jn]);
                }
            }
#undef SG_LOAD
        }
#pragma unroll
        for (int jn = 0; jn < NTW; ++jn) *(LAS f32x4*)(lds + ((size_t)((ksi * 16 + fr) * CW + (ng * NTW + jn) * 16 + 4 * fq)) * 4) = acc[jn];
        LDS_BARRIER();
        if (eact) {
            f32x4 s0 = (f32x4){0.f, 0.f, 0.f, 0.f}, s1 = s0;
#pragma unroll
            for (int kk = 0; kk < KS; ++kk) { const LAS f32x4* p = (const LAS f32x4*)(lds + ((size_t)((kk * 16 + erow) * CW + 8 * ecg)) * 4); s0 += p[0]; s1 += p[1]; }
            E(16 * F.xq + erow, slot, slot * CW + 8 * ecg, s0, s1, pre);
        }
        LDS_BARRIER();
    }
}
struct SEpiZ {
    struct Pre { float rs; };
    const float* rsqs; float* SZ; int ldz, mode;
    __device__ __forceinline__ Pre pre(int row, int col) const { return Pre{rstd32(rsqs + row * 32)}; }
    __device__ __forceinline__ void operator()(int row, int strip, int col, f32x4 s0, f32x4 s1, const Pre& p) const {
        const int oc0 = mode == 0 ? src_even(col) : src_odd(col), oc1 = mode == 0 ? src_even(col + 4) : src_odd(col + 4);
        float* q = SZ + (size_t)row * ldz; *(f32x4*)(q + oc0) = s0 * p.rs; *(f32x4*)(q + oc1) = s1 * p.rs;
    }
};
struct SEpiRes {
    struct Pre { f32x4 x0, x1; };
    float* xs; bf16_t* xb; float* rsqs;
    __device__ __forceinline__ Pre pre(int row, int col) const { const float* q = xs + (size_t)row * D + col; return Pre{*(const f32x4*)q, *(const f32x4*)(q + 4)}; }
    __device__ __forceinline__ void operator()(int row, int strip, int col, f32x4 s0, f32x4 s1, const Pre& pr) const {
        float* p = xs + (size_t)row * D + col; const f32x4 o0 = pr.x0 + s0, o1 = pr.x1 + s1;
        *(f32x4*)p = o0; *(f32x4*)(p + 4) = o1; *(u32x4*)(xb + (size_t)row * D + col) = pack8(o0, o1);
        const int ln = ((row & 15) << 2) | ((col >> 3) & 3);
        float ss = dot4(o0, o0) + dot4(o1, o1); ss += shx(ss, 1, ln); ss += shx(ss, 2, ln);
        if ((col & 31) == 0) rsqs[row * 32 + strip] = ss;
    }
};
struct SEpiQ {
    struct Pre { float rs; };
    const float* rsqs; float* SQ;
    __device__ __forceinline__ Pre pre(int row, int col) const { return Pre{rstd32(rsqs + row * 32)}; }
    __device__ __forceinline__ void operator()(int row, int strip, int col, f32x4 s0, f32x4 s1, const Pre& p) const {
        float* q = SQ + (size_t)row * D + col; *(f32x4*)q = s0 * p.rs; *(f32x4*)(q + 4) = s1 * p.rs;
    }
};
__device__ __forceinline__ void sample_mix_even(Frame& F0, int j, int b) {
    Frame F = launder(F0);
    LAS float* pl = (LAS float*)F.lds; LAS float* red = pl + 1024;
    const int tid = F.tid, lane = F.lane, w = F.wave;
    const float* z = ((float*)(F.ws + WS_SZ)) + (size_t)b * 8192;
    float vv[2], ss = 0.f;
#pragma unroll
    for (int k = 0; k < 2; ++k) { vv[k] = z[3072 + tid + 512 * k]; ss += vv[k] * vv[k]; }
    ss = wave_sum(ss, lane); if (lane == 0) red[w] = ss;
#pragma unroll
    for (int k = 0; k < 2; ++k) {
        const int c = tid + 512 * k, g = c >> 8, win = 2 << g; const float xa = z[c];
        const float* st = FIN(3) + ((size_t)(j * 128 + b) * 15) * 1024 + c;
        float sr[15];
#pragma unroll
        for (int r = 0; r < 15; ++r) sr[r] = st[(size_t)r * 1024];
        float s = xa;
#pragma unroll
        for (int r = 0; r < 15; ++r) s += (r >= 16 - win) ? sr[r] : 0.f;
        pl[c] = s / (float)win - xa;
        float* po = F.out + O_POOLS + ((size_t)(j * 128 + b) * 15) * 1024 + c;
#pragma unroll
        for (int r = 0; r < 14; ++r) po[(size_t)r * 1024] = sr[r + 1];
        po[(size_t)14 * 1024] = xa;
    }
    __syncthreads();
    float tot = 0.f;
#pragma unroll
    for (int i = 0; i < 8; ++i) tot += red[i];
    const float rv = rsqrtf(tot * (1.0f / D) + EPS);
#pragma unroll
    for (int k = 0; k < 2; ++k) {
        const int d = tid + 512 * k, g = d >> 8, dd = d & 255;
        const bf16_t* pm = ((bf16_t*)(F.ws + WS_PMT)) + (size_t)(j * 4 + g) * 65536 + (size_t)dd * 256; const LAS float* pg = pl + g * 256;
        float a = 0.f;
#pragma unroll
        for (int hb = 0; hb < 2; ++hb) {
            u32x4 pr[16];
#pragma unroll
            for (int i = 0; i < 16; ++i) pr[i] = *(const u32x4*)(pm + hb * 128 + i * 8);
#pragma unroll
            for (int i = 0; i < 16; ++i) { f32x4 p0, p1; unpack8(pr[i], p0, p1); const LAS float* q = pg + hb * 128 + i * 8; a += dot4(p0, *(const LAS f32x4*)q) + dot4(p1, *(const LAS f32x4*)(q + 4)); }
        }
        const float ya = a * FIN(12)[j * 1024 + d] * silu_f(z[1024 + d]);
        const float vn = vv[k] * rv * FIN(15)[j * 1024 + d];
        F.out[O_SGUV + (size_t)(j * 128 + b) * 1024 + d] = vn;
        const float mixed = FIN(13)[(size_t)(j * 4 + g) * 16384] * vn + FIN(14)[(j * 4 + g) * 128];
        const float yb = z[2048 + d] * mixed * silu_f(z[4096 + d]);
        ((bf16_t*)(F.ws + WS_SA2))[(size_t)b * 2048 + d] = (bf16_t)(cvt_pk_bf16(ya, 0.f) & 0xffffu); ((bf16_t*)(F.ws + WS_SA2))[(size_t)b * 2048 + 1024 + d] = (bf16_t)(cvt_pk_bf16(yb, 0.f) & 0xffffu);
    }
    __syncthreads();
}
__device__ __forceinline__ void sample_conv_odd(Frame& F0, int j, int b) {
    Frame F = launder(F0);
    const int tid = F.tid;
    const float* z = ((float*)(F.ws + WS_SZ)) + (size_t)b * 8192;
    const float* cw = FIN(18) + (size_t)j * 3 * 2048;
#pragma unroll
    for (int k = 0; k < 4; ++k) {
        const int c = tid + 512 * k;
        const float e = z[2048 + c] * z[4096 + c];
        const float s0 = FIN(4)[((size_t)(j * 128 + b) * 2 + 0) * 2048 + c], s1 = FIN(4)[((size_t)(j * 128 + b) * 2 + 1) * 2048 + c];
        const float y = cw[c] * s0 + cw[2048 + c] * s1 + cw[4096 + c] * e;
        ((bf16_t*)(F.ws + WS_SA2))[(size_t)b * 2048 + c] = (bf16_t)(cvt_pk_bf16(z[c] * y * silu_f(z[6144 + c]), 0.f) & 0xffffu);
        float* po = F.out + O_CONVS + ((size_t)(j * 128 + b) * 2) * 2048 + c; po[0] = s1; po[2048] = e;
    }
}
__device__ __forceinline__ void attn_sample(Frame& F0, int layer) {
    Frame F = launder(F0);
    LAS float* sc = (LAS float*)F.lds;
    LAS float* red = sc + 512;
    const int tid = F.tid, lane = F.lane, w = F.wave;
    for (int item = F.rk; item < 32; item += F.rw) {
        const int b = 16 * F.xq + (item >> 1), hp = item & 1;
        const float* qp = ((float*)(F.ws + WS_SQ)) + (size_t)b * D + hp * 512;
        const f32x4 q0 = *(const f32x4*)(qp + 4 * lane), q1 = *(const f32x4*)(qp + 256 + 4 * lane);
        const float* kp = FIN(5) + ((size_t)(layer * 128 + b) * 256) * 1024 + hp * 512 + 4 * lane;
        const float* vp = FIN(6) + ((size_t)(layer * 128 + b) * 256) * 1024 + hp * 512 + 4 * lane;
#pragma unroll 8
        for (int mi = 0; mi < 32; ++mi) {
            const int m = 32 * w + mi;
            const f32x4 k0 = __builtin_nontemporal_load((const f32x4*)(kp + (size_t)m * 1024)), k1 = __builtin_nontemporal_load((const f32x4*)(kp + (size_t)m * 1024 + 256));
            const float d0 = wave_sum(dot4(k0, q0), lane), d1 = wave_sum(dot4(k1, q1), lane);
            if (lane == 0) { sc[m] = d0; sc[256 + m] = d1; }
        }
        __syncthreads();
        float p0[4], p1[4], mx0 = -INFINITY, mx1 = -INFINITY;
#pragma unroll
        for (int i = 0; i < 4; ++i) { p0[i] = sc[lane + 64 * i]; p1[i] = sc[256 + lane + 64 * i]; mx0 = fmaxf(mx0, p0[i]); mx1 = fmaxf(mx1, p1[i]); }
#pragma unroll
        for (int o = 1; o < 64; o <<= 1) { mx0 = fmaxf(mx0, shx(mx0, o, lane)); mx1 = fmaxf(mx1, shx(mx1, o, lane)); }
        float sm0 = 0.f, sm1 = 0.f;
#pragma unroll
        for (int i = 0; i < 4; ++i) { p0[i] = __builtin_amdgcn_exp2f(p0[i] - mx0); p1[i] = __builtin_amdgcn_exp2f(p1[i] - mx1); sm0 += p0[i]; sm1 += p1[i]; }
        sm0 = wave_sum(sm0, lane); sm1 = wave_sum(sm1, lane);
        const float i0 = 1.0f / sm0, i1 = 1.0f / sm1;
        __syncthreads();
        if (w == 0) {
#pragma unroll
            for (int i = 0; i < 4; ++i) { sc[lane + 64 * i] = p0[i] * i0; sc[256 + lane + 64 * i] = p1[i] * i1; }
        }
        __syncthreads();
        f32x4 a0 = (f32x4){0.f, 0.f, 0.f, 0.f}, a1 = a0;
#pragma unroll 8
        for (int mi = 0; mi < 32; ++mi) {
            const int m = 32 * w + mi;
            const f32x4 v0 = __builtin_nontemporal_load((const f32x4*)(vp + (size_t)m * 1024)), v1 = __builtin_nontemporal_load((const f32x4*)(vp + (size_t)m * 1024 + 256));
            a0 += v0 * sc[m]; a1 += v1 * sc[256 + m];
        }
        *(LAS f32x4*)(red + w * 512 + 4 * lane) = a0; *(LAS f32x4*)(red + w * 512 + 256 + 4 * lane) = a1;
        __syncthreads();
        {
            float o = 0.f;
#pragma unroll
            for (int ww = 0; ww < 8; ++ww) o += red[ww * 512 + tid];
            ((bf16_t*)(F.ws + WS_SO))[(size_t)b * D + hp * 512 + tid] = (bf16_t)(cvt_pk_bf16(o, 0.f) & 0xffffu);
        }
        __syncthreads();
    }
}
#define dpp_mov(v, ctrl, row_mask) __builtin_bit_cast(float, __builtin_amdgcn_update_dpp(0, __builtin_bit_cast(int, (float)(v)), (ctrl), (row_mask), 0xf, false))
__device__ __forceinline__ float wave_sum_dpp(float x) {
    x += dpp_mov(x, 0xB1, 0xf);
    x += dpp_mov(x, 0x4E, 0xf);
    x += dpp_mov(x, 0x141, 0xf);
    x += dpp_mov(x, 0x140, 0xf);
    x += dpp_mov(x, 0x142, 0xa);
    x += dpp_mov(x, 0x143, 0xc);
    return x;
}
constexpr int FA_SC = 69632, FA_RED = 71680;
__device__ __forceinline__ void attn_fused(Frame& F0, int layer) {
    Frame F = launder(F0);
    LAS unsigned char* lds = F.lds;
    const int tid = F.tid, lane = F.lane, w = F.wave, fr = lane & 15, fq = lane >> 4;
    const bf16_t* Kl = ((bf16_t*)(F.ws + WS_KB)) + (size_t)layer * MMEM * D; const bf16_t* Vl = ((bf16_t*)(F.ws + WS_VB)) + (size_t)layer * MMEM * D;
    LAS float* sc = (LAS float*)(lds + FA_SC); LAS float* red = (LAS float*)(lds + FA_RED);
    const int sb = 16 * F.xq + (F.rk >> 1), hp = F.rk & 1;
    const float* qp = ((float*)(F.ws + WS_SQ)) + (size_t)sb * D + hp * 512;
    const f32x4 q0 = *(const f32x4*)(qp + 4 * lane), q1 = *(const f32x4*)(qp + 256 + 4 * lane);
    const float* kp = FIN(5) + ((size_t)(layer * 128 + sb) * 256 + 4 * w) * 1024 + hp * 512;
    const float* vp = FIN(6) + ((size_t)(layer * 128 + sb) * 256 + 4 * w) * 1024 + hp * 512;
    const unsigned lo16 = (unsigned)lane * 16u;
    f32x4 sv[8]; f32x4 a0 = (f32x4){0.f, 0.f, 0.f, 0.f}, a1 = a0; float mx0 = 0.f, mx1 = 0.f, iv0 = 0.f, iv1 = 0.f;
#define FA_SLOAD(base, slice) do { unsigned long long pu_ = uni64((unsigned long long)((base) + (size_t)(32 * (slice)) * 1024)); asm volatile("" : "+s"(pu_)); const char* pc_ = (const char*)(const GAS char*)pu_; \
        _Pragma("unroll") for (int r_ = 0; r_ < 4; ++r_) { sv[2 * r_] = __builtin_nontemporal_load((const f32x4*)(pc_ + r_ * 4096 + lo16)); sv[2 * r_ + 1] = __builtin_nontemporal_load((const f32x4*)(pc_ + r_ * 4096 + 1024 + lo16)); } } while (0)
    FA_SLOAD(kp, 0);
#pragma unroll 1
    for (int ui = 0; ui < 2; ++ui) {
        const int kk = 2 * F.rk + ui;
        const int b = F.xq, h = kk >> 4, qb = kk & 15;
        const size_t rowq = (size_t)b * SEQ + qb * 128 + 16 * w + fr;
        bf16x8 Qf[8];
#pragma unroll
        for (int ks = 0; ks < 8; ++ks) Qf[ks] = *(const bf16x8*)(((bf16_t*)(F.ws + WS_Q)) + rowq * D + h * 256 + 32 * ks + 8 * fq);
        const bf16_t* kbase = Kl + (size_t)(b * 256) * D + h * 256; const bf16_t* vbase = Vl + (size_t)(b * 256) * D + h * 256;
        u32x4 st[4];
        const unsigned goff = (unsigned)(tid >> 5) * (D * 2) + (unsigned)(tid & 31) * 16u, loff = (unsigned)(tid >> 5) * 544u + (unsigned)(tid & 31) * 16u;
#define ATT_GLOAD(c) do { unsigned long long pu_ = uni64((unsigned long long)(((c) < 4 ? kbase : vbase) + (size_t)(64 * ((c) & 3)) * D)); asm volatile("" : "+s"(pu_)); const char* pc_ = (const char*)(const GAS char*)pu_; \
        _Pragma("unroll") for (int i_ = 0; i_ < 4; ++i_) st[i_] = *(const u32x4*)(pc_ + (size_t)(16 * i_) * D * 2 + goff); } while (0)
#define ATT_LSTORE(c) do { _Pragma("unroll") for (int i_ = 0; i_ < 4; ++i_) *(LAS u32x4*)(lds + ((c) & 1) * ATT_SLOT + 16 * i_ * 544 + loff) = st[i_]; } while (0)
        f32x4 S[16], Oa[16]; bf16x8 Pf[8]; float inv = 0.f;
        const f32x4 zero4 = (f32x4){0.f, 0.f, 0.f, 0.f};
        if (ui == 1) {
            float p0[4], p1[4]; mx0 = -INFINITY; mx1 = -INFINITY;
#pragma unroll
            for (int i = 0; i < 4; ++i) { p0[i] = sc[lane + 64 * i]; p1[i] = sc[256 + lane + 64 * i]; mx0 = fmaxf(mx0, p0[i]); mx1 = fmaxf(mx1, p1[i]); }
#pragma unroll
            for (int o = 1; o < 64; o <<= 1) { mx0 = fmaxf(mx0, shx(mx0, o, lane)); mx1 = fmaxf(mx1, shx(mx1, o, lane)); }
            float sm0 = 0.f, sm1 = 0.f;
#pragma unroll
            for (int i = 0; i < 4; ++i) { sm0 += __builtin_amdgcn_exp2f(p0[i] - mx0); sm1 += __builtin_amdgcn_exp2f(p1[i] - mx1); }
            sm0 = wave_sum(sm0, lane); sm1 = wave_sum(sm1, lane);
            iv0 = 1.0f / sm0; iv1 = 1.0f / sm1;
        }
        ATT_GLOAD(0); ATT_LSTORE(0); __syncthreads();
#pragma unroll
        for (int c = 0; c < 8; ++c) {
            if (c < 7) ATT_GLOAD(c + 1);
            if (ui == 0) {
#pragma unroll
                for (int r = 0; r < 4; ++r) {
                    const int m = 32 * c + 4 * w + r;
                    const float d0 = wave_sum_dpp(dot4(sv[2 * r], q0)), d1 = wave_sum_dpp(dot4(sv[2 * r + 1], q1));
                    if (lane == 63) { sc[m] = d0; sc[256 + m] = d1; }
                }
                if (c < 7) FA_SLOAD(kp, c + 1); else FA_SLOAD(vp, 0);
            } else {
#pragma unroll
                for (int r = 0; r < 4; ++r) {
                    const int m = 32 * c + 4 * w + r;
                    const float p0 = __builtin_amdgcn_exp2f(sc[m] - mx0) * iv0, p1 = __builtin_amdgcn_exp2f(sc[256 + m] - mx1) * iv1;
                    a0 += sv[2 * r] * p0; a1 += sv[2 * r + 1] * p1;
                }
                if (c < 7) FA_SLOAD(vp, c + 1);
            }
            LAS unsigned char* slot = lds + (c & 1) * ATT_SLOT;
            if (c < 4) {
                {
                    bf16x8 Kf[2][4];
#pragma unroll
                    for (int ml = 0; ml < 4; ++ml) Kf[0][ml] = *(LAS bf16x8*)(slot + (16 * ml + fr) * 544 + (8 * fq) * 2);
                    __builtin_amdgcn_sched_group_barrier(0x100, 4, 0);
#pragma unroll
                    for (int ks = 0; ks < 8; ++ks) {
                        if (ks < 7) {
#pragma unroll
                            for (int ml = 0; ml < 4; ++ml) Kf[(ks + 1) & 1][ml] = *(LAS bf16x8*)(slot + (16 * ml + fr) * 544 + (32 * (ks + 1) + 8 * fq) * 2);
                        }
#pragma unroll
                        for (int ml = 0; ml < 4; ++ml) S[4 * c + ml] = MFMA16(Kf[ks & 1][ml], Qf[ks], ks == 0 ? zero4 : S[4 * c + ml]);
                        __builtin_amdgcn_sched_group_barrier(0x100, 4, 0); __builtin_amdgcn_sched_group_barrier(0x008, 4, 0);
                    }
                }
                if (c == 3) {
                    float mx = S[0][0];
#pragma unroll
                    for (int i = 0; i < 16; ++i) { mx = fmaxf(mx, fmaxf(fmaxf(S[i][0], S[i][1]), fmaxf(S[i][2], S[i][3]))); }
                    mx = fmaxf(mx, shx(mx, 16, lane)); mx = fmaxf(mx, shx(mx, 32, lane));
                    float sum = 0.f;
#pragma unroll
                    for (int i = 0; i < 16; ++i) {
#pragma unroll
                        for (int e = 0; e < 4; ++e) { S[i][e] = __builtin_amdgcn_exp2f(S[i][e] - mx); sum += S[i][e]; }
                    }
                    sum += shx(sum, 16, lane); sum += shx(sum, 32, lane);
                    inv = 1.0f / sum;
#pragma unroll
                    for (int a = 0; a < 8; ++a) {
                        u32x4 pw; pw.x = cvt_pk_bf16(S[2 * a][0], S[2 * a][1]); pw.y = cvt_pk_bf16(S[2 * a][2], S[2 * a][3]); pw.z = cvt_pk_bf16(S[2 * a + 1][0], S[2 * a + 1][1]); pw.w = cvt_pk_bf16(S[2 * a + 1][2], S[2 * a + 1][3]);
                        Pf[a] = __builtin_bit_cast(bf16x8, pw);
                    }
                }
            } else {
                {
                    bf16x8 Vf[2][4];
#define ATT_VREAD(n_, buf_) do { _Pragma("unroll") for (int d_ = 0; d_ < 4; ++d_) { LAS unsigned char* p_ = slot + (32 * ((n_) >> 2) + 4 * fq + (fr >> 2)) * 544 + (16 * (4 * ((n_) & 3) + d_) + 4 * (fr & 3)) * 2; Vf[buf_][d_] = tr_frag(p_, p_ + 16 * 544); } } while (0)
                    ATT_VREAD(0, 0);
                    __builtin_amdgcn_sched_group_barrier(0x100, 8, 0);
#pragma unroll
                    for (int n = 0; n < 8; ++n) {
                        if (n < 7) ATT_VREAD(n + 1, (n + 1) & 1);
#pragma unroll
                        for (int d = 0; d < 4; ++d) { const int al = n >> 2, dt = 4 * (n & 3) + d; Oa[dt] = MFMA16(Vf[n & 1][d], Pf[2 * (c - 4) + al], (c == 4 && al == 0) ? zero4 : Oa[dt]); }
                        __builtin_amdgcn_sched_group_barrier(0x100, 8, 0); __builtin_amdgcn_sched_group_barrier(0x008, 4, 0);
                    }
#undef ATT_VREAD
                }
            }
            if (c < 7) ATT_LSTORE(c + 1);
            LDS_BARRIER();
        }
#pragma unroll
        for (int dt = 0; dt < 16; ++dt) *(u32x2*)(((bf16_t*)(F.ws + WS_O)) + rowq * D + h * 256 + 16 * dt + 4 * fq) = pack4(Oa[dt] * inv);
#undef ATT_GLOAD
#undef ATT_LSTORE
    }
#undef FA_SLOAD
    *(LAS f32x4*)(red + w * 512 + 4 * lane) = a0; *(LAS f32x4*)(red + w * 512 + 256 + 4 * lane) = a1;
    __syncthreads();
    {
        float o = 0.f;
#pragma unroll
        for (int ww = 0; ww < 8; ++ww) o += red[ww * 512 + tid];
        ((bf16_t*)(F.ws + WS_SO))[(size_t)sb * D + hp * 512 + tid] = (bf16_t)(cvt_pk_bf16(o, 0.f) & 0xffffu);
    }
    __syncthreads();
}
__device__ __forceinline__ void final_norm(Frame& F0) {
    Frame F = launder(F0);
    const int gwx = F.rk * NWAVES + F.wave, NGX = F.rw * NWAVES, lane = F.lane;
    f32x4 g[4];
#pragma unroll
    for (int jj = 0; jj < 4; ++jj) g[jj] = ((const f32x4*)FIN(24) + lane)[64 * jj];
    const bool has_s = gwx < 16;
    f32x4 sv[4];
    if (has_s) {
        const f32x4* src = (const f32x4*)(((float*)(F.ws + WS_XS)) + (size_t)(16 * F.xq + gwx) * D) + lane;
#pragma unroll
        for (int jj = 0; jj < 4; ++jj) sv[jj] = src[64 * jj];
    }
    for (int p = gwx; p < SEQ / 8; p += NGX) {
        const int m0 = F.xq * SEQ + 8 * p;
        u32x2 pk[8][4];
#pragma unroll
        for (int r = 0; r < 8; ++r) {
            const u32x2* src = (const u32x2*)(((bf16_t*)(F.ws + WS_XB)) + (size_t)(m0 + r) * D) + lane;
#pragma unroll
            for (int jj = 0; jj < 4; ++jj) pk[r][jj] = src[64 * jj];
        }
        float s[8];
#pragma unroll
        for (int r = 0; r < 8; ++r) {
            s[r] = 0.f;
#pragma unroll
            for (int jj = 0; jj < 4; ++jj) { const f32x4 t = unpack4(pk[r][jj]); s[r] += dot4(t, t); }
        }
#pragma unroll
        for (int r = 0; r < 8; ++r) s[r] = rsqrtf(wave_sum(s[r], lane) * (1.0f / D) + EPS);
#pragma unroll
        for (int r = 0; r < 8; ++r) {
            f32x4* dst = (f32x4*)(F.out + O_Y + (size_t)(m0 + r) * D) + lane;
#pragma unroll
            for (int jj = 0; jj < 4; ++jj) dst[64 * jj] = unpack4(pk[r][jj]) * s[r] * g[jj];
        }
    }
    if (has_s) {
        float s = 0.f;
#pragma unroll
        for (int jj = 0; jj < 4; ++jj) s += dot4(sv[jj], sv[jj]);
        const float rs = rsqrtf(wave_sum(s, lane) * (1.0f / D) + EPS);
        f32x4* dst = (f32x4*)(F.out + O_YS + (size_t)(16 * F.xq + gwx) * D) + lane;
#pragma unroll
        for (int jj = 0; jj < 4; ++jj) dst[64 * jj] = sv[jj] * rs * g[jj];
    }
}

struct Args { const float* in[25]; float* out; unsigned char* ws; int ph_lo, ph_hi; };
#define REP(bit) for (int rep_ = 0; rep_ < 1 + ((REP_MASK >> (bit)) & 1); ++rep_)
__global__ void __launch_bounds__(NWAVES * 64, 2) fwd(Args args) {
    extern __shared__ __attribute__((aligned(16))) unsigned char lds_raw[];
    Frame F0;
    F0.lds = (LAS unsigned char*)lds_raw;
    F0.tid = threadIdx.x; F0.lane = F0.tid & 63; F0.wave = __builtin_amdgcn_readfirstlane(F0.tid >> 6); F0.G = gridDim.x; F0.bx = blockIdx.x;
    F0.in = (in_tab_t)__builtin_amdgcn_kernarg_segment_ptr();     F0.out = args.out; F0.ws = args.ws;
    for (int u = F0.tid; u < (LDS_BYTES - LDSCTL_OFF) / 4; u += NWAVES * 64) ((LAS unsigned*)(F0.lds + LDSCTL_OFF))[u] = 0u;
    __syncthreads();
    XcdBarrier bar; bar.wave = F0.wave; bar.bar = (unsigned*)(args.ws + WS_CTL) + CW_BAR; bar.x = 0; bar.st = nullptr;
    if (!MK_SPLIT) bar = xcd_barrier_post((unsigned*)(args.ws + WS_CTL) + CW_BAR, (volatile LAS unsigned*)(F0.lds + MISC_OFF) + 8, F0.wave);
    unsigned* rankw = (unsigned*)(args.ws + WS_CTL) + CW_RANK;
    const unsigned my_xcc = xb_xcc_id();
    unsigned my_rank = 0u;
    if (F0.tid == 0) ((volatile LAS unsigned*)(F0.lds + MISC_OFF))[12] = __hip_atomic_fetch_add(rankw + 64 * my_xcc, 1u, __ATOMIC_RELAXED, __HIP_MEMORY_SCOPE_AGENT);
    if (F0.tid == 0) (void)__hip_atomic_fetch_or(rankw + 64 * (32 + (F0.bx & 7)), 1u << my_xcc, __ATOMIC_RELAXED, __HIP_MEMORY_SCOPE_AGENT);
    __syncthreads();
    my_rank = __builtin_amdgcn_readfirstlane(((volatile LAS unsigned*)(F0.lds + MISC_OFF))[12]);
    F0.vid = F0.bx;
    int ph = 0;
    bool local_ok = false;
    const int lo = args.ph_lo, hi = args.ph_hi;
#define PH_BEGIN if (ph >= lo && ph < hi) { Frame F = launder(F0);
#define PH_END } { const bool both_ = (ph >= lo && ph + 1 < hi); ++ph; if (!MK_SPLIT && both_) { XcdBarrier b2_ = bar; unsigned long long bp_ = uni64((unsigned long long)bar.bar); unsigned bx_ = __builtin_amdgcn_readfirstlane(bar.x); int bw_ = __builtin_amdgcn_readfirstlane(bar.wave); asm volatile("" : "+s"(bp_), "+s"(bx_), "+s"(bw_)); b2_.bar = (unsigned*)(GAS unsigned*)bp_; b2_.x = bx_; b2_.wave = bw_; if (local_ok && ph > 2) xcd_barrier_local(b2_); else xcd_barrier(b2_); if ((REP_MASK >> 19) & 1) xcd_barrier(b2_); if (ph == 2) local_ok = XCD_LOCAL && lo == 0 && __builtin_amdgcn_readfirstlane(__hip_atomic_load(rankw + 64 * 20, __ATOMIC_RELAXED, __HIP_MEMORY_SCOPE_AGENT)) == 0u;     } }

    PH_BEGIN REP(0) { p0_prologue(F0); __syncthreads(); } PH_END
    if (!MK_SPLIT && lo == 0) {
        unsigned nx = 0u, xi = 0u; bool even = (F0.G % 8) == 0;
        for (unsigned jx = 0; jx < 16; ++jx) { const unsigned c_ = __hip_atomic_load(rankw + 64 * jx, __ATOMIC_RELAXED, __HIP_MEMORY_SCOPE_AGENT); if (c_) { if (c_ != (unsigned)F0.G / 8u) even = false; if (jx < my_xcc) ++xi; ++nx; } }
        if (XCD_VID && even && nx == 8u) F0.vid = (int)(my_rank * 8u + xi);
        unsigned all_ = 0u; bool one2one = true;
        for (unsigned m_ = 0; m_ < 8; ++m_) { const unsigned k_ = __hip_atomic_load(rankw + 64 * (32 + m_), __ATOMIC_RELAXED, __HIP_MEMORY_SCOPE_AGENT); if (__builtin_popcount(k_) != 1 || (all_ & k_)) one2one = false; all_ |= k_; }
        if (!(even && nx == 8u && one2one) && F0.tid == 0) __hip_atomic_store(rankw + 64 * 20, 1u, __ATOMIC_RELAXED, __HIP_MEMORY_SCOPE_AGENT);
        if (((REP_MASK >> 18) & 1) && !(even && nx == 8u && (unsigned)(F0.bx % 8) == xi) && F0.tid == 0) F0.out[O_YS + F0.bx] = __builtin_nanf("");
        F0.vid = __builtin_amdgcn_readfirstlane(F0.vid);
    }
    PH_BEGIN {
        if ((REP_MASK >> 17) & 1) {
            f32x4 pa[8]; bf16x8 pb = (bf16x8){(short)F.tid, 1, 2, 3, 4, 5, 6, 7};
#pragma unroll
            for (int i = 0; i < 8; ++i) pa[i] = (f32x4){(float)F.tid, 1.f, 2.f, (float)i};
#pragma unroll 1
            for (int it = 0; it < 512; ++it) {
#pragma unroll
                for (int r = 0; r < 4; ++r)
#pragma unroll
                    for (int i = 0; i < 8; ++i) pa[i] = MFMA16(pb, pb, pa[i]);
            }
            float sacc = 0.f;
#pragma unroll
            for (int i = 0; i < 8; ++i) sacc += pa[i][0] + pa[i][3];
            if (sacc == 12345.678f) ((float*)(F.ws + WS_Z))[F.tid] = sacc;
        }
        if ((REP_MASK >> 15) & 3) { pg8::Gemm gp{((bf16_t*)(F.ws + WS_XB)), ((bf16_t*)(F.ws + WS_C1)), MP, NC, ((REP_MASK >> 15) & 1) ? 1024 : 512}; pg8::StaticOrder Sp; Sp.init(MP, NC, F.G, (int)F.vid); EpiProbe Ep{((bf16_t*)(F.ws + WS_Z)), NC}; pg8::gemm_phase<EpiProbe, pg8::StaticOrder, true, true>(F.lds, gp, Sp, Ep, F.wave); }
        pg8::Gemm g{((bf16_t*)(F.ws + WS_MEMB)), ((bf16_t*)(F.ws + WS_WKV)), MMEM, 8192, D}; pg8::StaticOrder S; S.init(MMEM, 8192, F.G, (int)F.vid);
        EpiMemKV E{((float*)(F.ws + WS_SMALL + 65536)), F.out + O_MEMK, F.out + O_MEMV, ((bf16_t*)(F.ws + WS_KB)), ((bf16_t*)(F.ws + WS_VB))};
        REP(1) pg8::gemm_phase<EpiMemKV, pg8::StaticOrder, true, true>(F.lds, g, S, E, F.wave);
    } PH_END
    if (STAGGER_TICKS != 0 && lo == 0 && ((F0.bx & 1) == (STAGGER_TICKS > 0 ? 1 : 0))) { const unsigned long long t0_ = __builtin_amdgcn_s_memrealtime(); const unsigned long long tk_ = (unsigned long long)(STAGGER_TICKS > 0 ? STAGGER_TICKS : -STAGGER_TICKS); while (__builtin_amdgcn_s_memrealtime() - t0_ < tk_) __builtin_amdgcn_s_sleep(8); }
    unsigned* pbw = (unsigned*)(args.ws + WS_CTL) + CW_RANK + 64 * 24;
    if (!MK_SPLIT && SPLIT_PROLOGUE && lo == 0) {
        const int half = F0.bx & 1, hw = (half ? (F0.G >> 1) : ((F0.G + 1) >> 1)) * NWAVES, hi_ = (F0.bx >> 1) * NWAVES + F0.wave;
        p0_weights(F0, 1, hi_, hw, half);
        asm volatile("s_waitcnt vmcnt(0)" ::: "memory"); __syncthreads();
        if (F0.wave == 0 && hw_lane() == 0) { __builtin_amdgcn_fence(__ATOMIC_RELEASE, "agent"); asm volatile("s_waitcnt vmcnt(0)" ::: "memory"); (void)__hip_atomic_fetch_add(pbw, 1u, __ATOMIC_RELAXED, __HIP_MEMORY_SCOPE_AGENT); }
    }
#pragma unroll 1
    for (int l = 0; l < DEPTH; ++l) {
        const int j = l >> 1;
        if (!MK_SPLIT && SPLIT_PROLOGUE && lo == 0 && l == 1) {
            if (F0.wave == 0 && hw_lane() == 0) {
                const unsigned want = (unsigned)F0.G; unsigned sp = 0u;
                while (__hip_atomic_load(pbw, __ATOMIC_RELAXED, __HIP_MEMORY_SCOPE_AGENT) < want) { __builtin_amdgcn_s_sleep(2); if (++sp > (1u << 22)) { atomicAdd((unsigned*)(args.ws + WS_CTL) + CW_BAR + XB_TMO, 1u); break; } }
                __builtin_amdgcn_fence(__ATOMIC_ACQUIRE, "agent"); asm volatile("s_waitcnt vmcnt(0)" ::: "memory");
            }
            __syncthreads();
        }
        if ((l & 1) == 0) {
            PH_BEGIN {
                pg8::Gemm g{((bf16_t*)(F.ws + WS_XB)), ((bf16_t*)(F.ws + WS_AB1)) + (size_t)j * NAB * D, MP, NAB, D}; pg8::StaticOrder S; S.init(MP, NAB, F.G, (int)F.vid);
                Unit u0{0, 0}; S.next(0, u0); rstd_table(((float*)(F.ws + WS_RSQ)), u0.pm, (LAS float*)(F.lds + RSTD_OFF), F.tid);
                EpiG1Even E{((float*)(F.ws + WS_RSQ)), ((bf16_t*)(F.ws + WS_Z)), ((float*)(F.ws + WS_VSQ)), F.out + O_POOLP + (size_t)j * 8 * 15 * 1024, (LAS const float*)(F.lds + RSTD_OFF), u0.pm};
                SEpiZ SE{((float*)(F.ws + WS_SMALL)), ((float*)(F.ws + WS_SZ)), 8192, 0};
                const bool s_first = (F.rk & 1) != 0;
                if (s_first) { REP(3) sgemm16<SEpiZ, NAB>(F, ((bf16_t*)(F.ws + WS_XB)) + (size_t)MP * D, ((bf16_t*)(F.ws + WS_AB1)) + (size_t)j * NAB * D, D, SE); }
                REP(2) pg8::gemm_phase<EpiG1Even, pg8::StaticOrder, true, true>(F.lds, g, S, E, F.wave);
                if (!s_first) { REP(3) sgemm16<SEpiZ, NAB>(F, ((bf16_t*)(F.ws + WS_XB)) + (size_t)MP * D, ((bf16_t*)(F.ws + WS_AB1)) + (size_t)j * NAB * D, D, SE); }
            } PH_END
            PH_BEGIN {
                REP(4) for (int i = F.rk; i < 32; i += F.rw) {
                    const int n = 16 * F.xq + (i >> 1);
                    const bf16_t* xan = ((bf16_t*)(F.ws + WS_Z)) + (size_t)(n * 128) * D; u32x4 pown[8], phalo, psg[8];
                    const bf16_t* zsg = xan + (size_t)MP * D;
                    if ((i & 1) == 0) { sgu_chunk(F, j, n, 0, 2, [&]() { pool_fetch(xan + 0 * 256, F.tid, (n * 128) & 2047, pown, phalo); pool_gate_fetch(zsg, 0, F.lane, F.wave, psg); }); pool_pair<0, 3>(F, j, n, pown, phalo, psg); }
                    else { sgu_chunk(F, j, n, 2, 4, [&]() { pool_fetch(xan + 1 * 256, F.tid, (n * 128) & 2047, pown, phalo); pool_gate_fetch(zsg, 1, F.lane, F.wave, psg); }); pool_pair<1, 2>(F, j, n, pown, phalo, psg); }
                }
                REP(5) for (int i = F.rk; i < 16; i += F.rw) sample_mix_even(F, j, 16 * F.xq + i);
            } PH_END
        } else {
            PH_BEGIN {
                pg8::Gemm g{((bf16_t*)(F.ws + WS_XB)), ((bf16_t*)(F.ws + WS_C1)) + (size_t)j * NC * D, MP, NC, D}; pg8::StaticOrder S; S.init(MP, NC, F.G, (int)F.vid);
                Unit u0{0, 0}; S.next(0, u0);
                for (int i = F.tid; i < 8 * 3 * 64; i += NWAVES * 64) { const int ui = i / 192, q = (i / 64) % 3, c = i & 63, pn = u0.pn + 4 * ui; ((LAS float*)(F.lds + CWL_OFF))[i] = pn < NC / 256 ? (FIN(18) + (size_t)j * 3 * 2048)[q * 2048 + pn * 64 + c] : 0.f; }
                rstd_table(((float*)(F.ws + WS_RSQ)), u0.pm, (LAS float*)(F.lds + RSTD_OFF), F.tid);
                EpiG1Odd E{((float*)(F.ws + WS_RSQ)), ((bf16_t*)(F.ws + WS_A2)), FIN(18) + (size_t)j * 3 * 2048, F.out + O_CONVP + (size_t)j * 8 * 2 * 2048, ((float*)(F.ws + WS_SIDE)), (LAS float*)(F.lds + HALO_OFF), (LAS const float*)(F.lds + RSTD_OFF), u0.pm, (LAS const float*)(F.lds + CWL_OFF), u0.pn};
                SEpiZ SE{((float*)(F.ws + WS_SMALL)), ((float*)(F.ws + WS_SZ)), 8192, 1};
                const bool s_first = (F.rk & 1) != 0;
                if (s_first) { REP(3) sgemm16<SEpiZ, NC>(F, ((bf16_t*)(F.ws + WS_XB)) + (size_t)MP * D, ((bf16_t*)(F.ws + WS_C1)) + (size_t)j * NC * D, D, SE); }
                REP(6) pg8::gemm_phase<EpiG1Odd, pg8::StaticOrder, true, true>(F.lds, g, S, E, F.wave);
                if (!s_first) { REP(3) sgemm16<SEpiZ, NC>(F, ((bf16_t*)(F.ws + WS_XB)) + (size_t)MP * D, ((bf16_t*)(F.ws + WS_C1)) + (size_t)j * NC * D, D, SE); }
            } PH_END
            PH_BEGIN {
                for (int p = F.rk; p < 24; p += F.rw) if (p >= 16) conv_fixup(((float*)(F.ws + WS_SIDE)), FIN(18) + (size_t)j * 3 * 2048, ((bf16_t*)(F.ws + WS_A2)), 8 * F.xq + (p - 16), F.tid);
                REP(5) for (int i = F.rk; i < 16; i += F.rw) sample_conv_odd(F, j, 16 * F.xq + i);
            } PH_END
        }
        PH_BEGIN {
            const bf16_t* W2 = ((l & 1) ? ((bf16_t*)(F.ws + WS_C2)) : ((bf16_t*)(F.ws + WS_AB2))) + (size_t)j * D * 2048;
            pg8::Gemm g{((bf16_t*)(F.ws + WS_A2)), W2, MP, D, 2048}; pg8::StaticOrder S; S.init(MP, D, F.G, (int)F.vid);
            EpiRes E{((bf16_t*)(F.ws + WS_XB)), ((float*)(F.ws + WS_RSQ))};
            pg8::gemm_phase<EpiRes, pg8::StaticOrder, true, true>(F.lds, g, S, E, F.wave);
            SEpiRes SE{((float*)(F.ws + WS_XS)), ((bf16_t*)(F.ws + WS_XB)) + (size_t)MP * D, ((float*)(F.ws + WS_SMALL))};
            sgemm16<SEpiRes, D>(F, ((bf16_t*)(F.ws + WS_SA2)), W2, 2048, SE);
        } PH_END
        PH_BEGIN {
            pg8::Gemm g{((bf16_t*)(F.ws + WS_XB)), ((bf16_t*)(F.ws + WS_WQ)) + (size_t)l * D * D, MP, D, D}; pg8::StaticOrder S; S.init(MP, D, F.G, (int)F.vid);
            Unit u0{0, 0}; S.next(0, u0); rstd_table(((float*)(F.ws + WS_RSQ)), u0.pm, (LAS float*)(F.lds + RSTD_OFF), F.tid);
            EpiQ E{((float*)(F.ws + WS_RSQ)), ((bf16_t*)(F.ws + WS_Q)), (LAS const float*)(F.lds + RSTD_OFF), u0.pm};
            REP(8) pg8::gemm_phase<EpiQ, pg8::StaticOrder, true, true>(F.lds, g, S, E, F.wave);
            SEpiQ SE{((float*)(F.ws + WS_SMALL)), ((float*)(F.ws + WS_SQ))};
            REP(9) sgemm16<SEpiQ, D>(F, ((bf16_t*)(F.ws + WS_XB)) + (size_t)MP * D, ((bf16_t*)(F.ws + WS_WQ)) + (size_t)l * D * D, D, SE);
        } PH_END
        PH_BEGIN {
            if (F.G == 256) { REP(10) attn_fused(F, l); }
            else { attn_prompt(F, l); attn_sample(F, l); }
        } PH_END
        PH_BEGIN {
            pg8::Gemm g{((bf16_t*)(F.ws + WS_O)), ((bf16_t*)(F.ws + WS_WO)) + (size_t)l * D * D, MP, D, D}; pg8::StaticOrder S; S.init(MP, D, F.G, (int)F.vid);
            EpiRes E{((bf16_t*)(F.ws + WS_XB)), ((float*)(F.ws + WS_RSQ))};
            pg8::gemm_phase<EpiRes, pg8::StaticOrder, true, true>(F.lds, g, S, E, F.wave);
            SEpiRes SE{((float*)(F.ws + WS_XS)), ((bf16_t*)(F.ws + WS_XB)) + (size_t)MP * D, ((float*)(F.ws + WS_SMALL))};
            sgemm16<SEpiRes, D>(F, ((bf16_t*)(F.ws + WS_SO)), ((bf16_t*)(F.ws + WS_WO)) + (size_t)l * D * D, D, SE);
        } PH_END
    }
    PH_BEGIN final_norm(F0); PH_END
#undef PH_BEGIN
#undef PH_END
}
constexpr int N_PHASES = 2 + 6 * DEPTH + 1;

extern "C" void kernel_launch(void* const* d_in, const int* in_sizes, int n_in, void* d_out, int out_size, void* d_ws, size_t ws_size, hipStream_t stream) {
    static int grid = 0;
    if (grid == 0) {
        if (n_in != 25 || in_sizes[0] != MP * D || (size_t)out_size != O_END || ws_size < WS_END) { fprintf(stderr, "kernel_launch: unexpected shapes (n_in %d, in0 %d, out %d, ws %zu); nothing launched\n", n_in, n_in > 0 ? in_sizes[0] : -1, out_size, ws_size); grid = -1; return; }
        int dev = 0, cus = 0, per_cu = 0;
        if (hipGetDevice(&dev) != hipSuccess || hipDeviceGetAttribute(&cus, hipDeviceAttributeMultiprocessorCount, dev) != hipSuccess) { fprintf(stderr, "kernel_launch: device query failed\n"); grid = -1; return; }
        if (hipFuncSetAttribute((const void*)fwd, hipFuncAttributeMaxDynamicSharedMemorySize, LDS_BYTES) != hipSuccess) { fprintf(stderr, "kernel_launch: hipFuncSetAttribute failed\n"); grid = -1; return; }
        if (hipOccupancyMaxActiveBlocksPerMultiprocessor(&per_cu, (const void*)fwd, NWAVES * 64, LDS_BYTES) != hipSuccess || per_cu < 1) fprintf(stderr, "kernel_launch: note: occupancy query reports %d workgroups per CU\n", per_cu);
        (void)hipGetLastError();
        grid = cus;
    }
    if (grid < 0) return;
    if (hipMemsetAsync((char*)d_ws + WS_CTL, 0, CTL_ZERO_BYTES, stream) != hipSuccess) { fprintf(stderr, "kernel_launch: memset failed\n"); return; }
    Args a{};
    for (int i = 0; i < 25; ++i) a.in[i] = (const float*)d_in[i];
    a.out = (float*)d_out; a.ws = (unsigned char*)d_ws;
#if MK_SPLIT
    for (int p = 0; p < N_PHASES; ++p) { a.ph_lo = p; a.ph_hi = p + 1; hipLaunchKernelGGL(fwd, dim3(grid), dim3(NWAVES * 64), LDS_BYTES, stream, a); }
#else
    a.ph_lo = 0; a.ph_hi = N_PHASES;
    hipLaunchKernelGGL(fwd, dim3(grid), dim3(NWAVES * 64), LDS_BYTES, stream, a);
#endif
    const hipError_t le = hipPeekAtLastError();
    if (le != hipSuccess) fprintf(stderr, "kernel_launch: launch failed: %s\n", hipGetErrorName(le));
}
```
